# Optimizing an MI355X kernel written in HIP

```python
import math
import jax, jax.numpy as jnp
from jax import lax
import numpy as np

D_MODEL = 1024
BATCH = 2
SEQ = 8192
DEPTH = 2

GRID_W = 64
HEAD_DIM = 64
D_MIX = D_MODEL
C_WIDTH = D_MIX // 4
A_WIDTH = ((D_MIX - C_WIDTH) // 2 // HEAD_DIM) * HEAD_DIM
B_WIDTH = D_MIX - C_WIDTH - A_WIDTH
A_HEADS = A_WIDTH // HEAD_DIM
B_HEADS = B_WIDTH // HEAD_DIM
NA_KH = 8
NA_KW = 16
POOL_WINDOWS = (2, 4, 8, 16)
N_POOL_GROUPS = 4
POOL_CH = C_WIDTH // N_POOL_GROUPS
R_W = 32
R_A = 32
R_G = 64
DECAY_SCALE = math.exp(-0.5)
GN_EPS = 64e-5
IN_WIDTH = 3 * A_WIDTH + 3 * B_WIDTH + R_W + R_A + R_G + C_WIDTH
N_GROUPS = 4
EXPERTS_PER_GROUP = 8
N_EXPERTS = N_GROUPS * EXPERTS_PER_GROUP
TOP_K = 2
D_EXPERT = 512
MOE_BLOCK = 128
ALPHA = (2 * DEPTH) ** 0.25
BETA = (8 * DEPTH) ** -0.25
LN_EPS = 1e-5
NEG_INF = -1e30

kernel_name = "hybrid_natten_rwkv7_pool_hmoe_encoder"


def layer_norm(x, eps=LN_EPS):
    xf = x.astype(jnp.float32)
    mu = jnp.mean(xf, axis=-1, keepdims=True)
    var = jnp.mean(jnp.square(xf - mu), axis=-1, keepdims=True)
    return ((xf - mu) * lax.rsqrt(var + eps)).astype(x.dtype)


def neighbourhood_attention(q, k, v, rpb):
    bn, s, _ = q.shape
    rows = s // GRID_W
    kh = min(NA_KH, rows)
    shp = (bn, rows, GRID_W, A_HEADS, HEAD_DIM)
    q, k, v = q.reshape(shp), k.reshape(shp), v.reshape(shp)
    ridx = jnp.arange(rows)
    rstart = jnp.clip(ridx - kh // 2, 0, rows - kh)
    key_rows = rstart[:, None] + jnp.arange(kh)[None, :]
    k_rows = k[:, key_rows]
    v_rows = v[:, key_rows]
    scores = jnp.einsum('brqhd,brkchd->brhqkc', q, k_rows).astype(jnp.float32) * (HEAD_DIM ** -0.5)
    col = jnp.arange(GRID_W)
    cstart = jnp.clip(col - NA_KW // 2, 0, GRID_W - NA_KW)
    in_win = (col[None, :] >= cstart[:, None]) & (col[None, :] < cstart[:, None] + NA_KW)
    dr = key_rows - ridx[:, None] + (NA_KH - 1)
    dc = jnp.clip(col[None, :] - col[:, None], -(NA_KW - 1), NA_KW - 1) + (NA_KW - 1)
    bias = rpb.astype(jnp.float32)[:, dr][..., dc]
    scores = scores + jnp.transpose(bias, (1, 0, 3, 2, 4))[None]
    scores = jnp.where(in_win[:, None, :], scores, NEG_INF)
    p = jax.nn.softmax(scores, axis=(-2, -1)).astype(v.dtype)
    out = jnp.einsum('brhqkc,brkchd->brqhd', p, v_rows)
    return out.reshape(bn, s, A_WIDTH)


def centred_conv3(z, w):
    zp = jnp.pad(z, ((0, 0), (1, 1), (0, 0)))
    return zp[:, :-2] * w[0] + zp[:, 1:-1] * w[1] + zp[:, 2:] * w[2]


def _heads(z):
    return z.reshape(z.shape[:-1] + (B_HEADS, HEAD_DIM))


def _rwkv_step(state, inp):
    r, w, k, v, kk, a = inp
    sa = jnp.einsum('dbhij,dbhj->dbhi', state, -kk)
    state = (state * w[..., None, :] + sa[..., :, None] * (kk * a)[..., None, :]
             + v[..., :, None] * k[..., None, :])
    y = jnp.einsum('dbhij,dbhj->dbhi', state, r)
    return state, y


def rwkv7_bidirectional(rkv, wl, al, gl, conv_w, w0, w_up, a0, a_up, g_up, k_k, k_a, r_k, gn_gain, gn_bias):
    bn, s, _ = rkv.shape
    dt = rkv.dtype
    rkv = centred_conv3(rkv, conv_w)
    r, k, v = jnp.split(rkv, 3, axis=-1)
    w = jnp.exp(-DECAY_SCALE * jax.nn.sigmoid(
        (w0[:, None, None, :] + jnp.einsum('bsr,nrc->nbsc', jnp.tanh(wl), w_up)).astype(jnp.float32)))
    a = jax.nn.sigmoid((a0[:, None, None, :] + jnp.einsum('bsr,nrc->nbsc', al, a_up)).astype(jnp.float32))
    g = (jax.nn.sigmoid(gl) @ g_up).astype(jnp.float32)
    rf = _heads(r.astype(jnp.float32))
    kf = _heads(k.astype(jnp.float32))
    vf = _heads(v.astype(jnp.float32))
    kk = kf * _heads(k_k.astype(jnp.float32))
    kk = kk * lax.rsqrt(jnp.maximum(jnp.sum(kk * kk, axis=-1, keepdims=True), 1e-24))
    a_h = _heads(a)
    k_dir = kf[None] * (1.0 + (a_h - 1.0) * _heads(k_a.astype(jnp.float32)))

    def to_scan(z):
        z = jnp.broadcast_to(z, (2,) + z.shape[-4:])
        z = jnp.stack([z[0], z[1][:, ::-1]])
        return jnp.moveaxis(z, 2, 0)

    xs = (to_scan(rf), to_scan(_heads(w)), to_scan(k_dir), to_scan(vf), to_scan(kk), to_scan(a_h))
    state0 = jnp.zeros((2, bn, B_HEADS, HEAD_DIM, HEAD_DIM), jnp.float32)
    _, ys = lax.scan(_rwkv_step, state0, xs)
    ys = jnp.moveaxis(ys, 0, 2)
    y = ys[0] + ys[1][:, ::-1]
    mu = jnp.mean(y, axis=-1, keepdims=True)
    var = jnp.mean(jnp.square(y - mu), axis=-1, keepdims=True)
    yn = ((y - mu) * lax.rsqrt(var + GN_EPS)).reshape(bn, s, B_WIDTH) * gn_gain + gn_bias
    bonus = jnp.sum(jnp.sum(rf[None] * k_dir * r_k.astype(jnp.float32), axis=-1, keepdims=True) * vf[None], axis=0)
    return ((yn + bonus.reshape(bn, s, B_WIDTH)) * g).astype(dt)


def multiscale_pool(p, pool_w, pool_scale):
    bn, s, cdim = p.shape
    pf = p.astype(jnp.float32)
    cs = jnp.concatenate([jnp.zeros((bn, 1, cdim), jnp.float32), jnp.cumsum(pf, axis=1)], axis=1)
    t = jnp.arange(s)
    outs = []
    for gi, win in enumerate(POOL_WINDOWS):
        lo = jnp.clip(t - win // 2, 0, s - 1)
        hi = jnp.clip(t + win // 2 - 1, 0, s - 1)
        sl = slice(gi * POOL_CH, (gi + 1) * POOL_CH)
        tot = cs[:, hi + 1, sl] - cs[:, lo, sl]
        cnt = (hi - lo + 1).astype(jnp.float32)
        outs.append(tot / cnt[None, :, None] - pf[:, :, sl])
    pooled = jnp.stack(outs, axis=2).astype(p.dtype)
    y = jnp.einsum('bsgc,gce->bsge', pooled, pool_w).reshape(bn, s, cdim)
    return y * pool_scale


def hierarchical_moe(u, w_group, b_group, w_expert, b_expert, w_gate, w_up, w_down):
    bn, s, d = u.shape
    t = bn * s
    xt = u.reshape(t, d)
    gl = (xt @ w_group + b_group).astype(jnp.float32)
    pg = jax.nn.softmax(gl, axis=-1)
    g_idx = jnp.argmax(gl, axis=-1)
    pg_sel = jnp.take_along_axis(pg, g_idx[:, None], axis=-1)[:, 0]
    el = (xt @ w_expert + b_expert).astype(jnp.float32).reshape(t, N_GROUPS, EXPERTS_PER_GROUP)
    el = jnp.take_along_axis(el, g_idx[:, None, None], axis=1)[:, 0]
    top_l, top_i = lax.top_k(el, TOP_K)
    gate = pg_sel[:, None] * jax.nn.softmax(top_l, axis=-1)
    e_flat = (g_idx[:, None] * EXPERTS_PER_GROUP + top_i).reshape(-1)
    w_flat = gate.reshape(-1)
    tok = jnp.repeat(jnp.arange(t), TOP_K)
    n_assign = t * TOP_K
    order = jnp.argsort(e_flat)
    se, stok, sw = e_flat[order], tok[order], w_flat[order]
    counts = jnp.bincount(e_flat, length=N_EXPERTS)
    starts = jnp.cumsum(counts) - counts
    padded = ((counts + MOE_BLOCK - 1) // MOE_BLOCK) * MOE_BLOCK
    pends = jnp.cumsum(padded)
    pstarts = pends - padded
    dest = pstarts[se] + (jnp.arange(n_assign) - starts[se])
    n_blocks = -(-n_assign // MOE_BLOCK) + N_EXPERTS
    total = n_blocks * MOE_BLOCK
    buf_tok = jnp.full((total,), t, jnp.int32).at[dest].set(stok.astype(jnp.int32))
    buf_w = jnp.zeros((total,), jnp.float32).at[dest].set(sw)
    block_e = jnp.clip(jnp.searchsorted(pends, jnp.arange(n_blocks) * MOE_BLOCK, side='right'), 0, N_EXPERTS - 1)
    x_pad = jnp.concatenate([xt, jnp.zeros((1, d), xt.dtype)], axis=0)

    def expert_block(args):
        ti, e, wt = args
        xb = x_pad[ti]
        hb = jax.nn.silu(xb @ w_gate[e]) * (xb @ w_up[e])
        return (hb @ w_down[e]) * wt[:, None]

    y = lax.map(expert_block, (buf_tok.reshape(n_blocks, MOE_BLOCK), block_e,
                               buf_w.reshape(n_blocks, MOE_BLOCK).astype(u.dtype)))
    out = jax.ops.segment_sum(y.reshape(total, d), buf_tok, num_segments=t + 1)[:t]
    return out.reshape(bn, s, d)


def setup_inputs(seed: int = 0) -> dict:
    key = jax.random.key(seed)
    ks = jax.random.split(key, 32)
    f32 = jnp.float32
    L = DEPTH

    def nrm(k, shape, scale):
        return jax.random.normal(k, shape, f32) * scale

    col_scale = (jnp.ones((IN_WIDTH,), f32)
                 .at[2 * A_WIDTH:3 * A_WIDTH].set(BETA)
                 .at[3 * A_WIDTH + 2 * B_WIDTH:3 * A_WIDTH + 3 * B_WIDTH].set(BETA))
    return {
        "x": nrm(ks[0], (BATCH, SEQ, D_MODEL), 1.0),
        "c": nrm(ks[1], (BATCH, D_MODEL), 1.0),
        "w_mod": nrm(ks[2], (L, D_MODEL, 6 * D_MODEL), 0.5 * D_MODEL ** -0.5),
        "b_mod": nrm(ks[3], (L, 6 * D_MODEL), 0.02),
        "w_in": nrm(ks[4], (L, D_MODEL, IN_WIDTH), D_MODEL ** -0.5) * col_scale,
        "na_rpb": nrm(ks[5], (L, A_HEADS, 2 * NA_KH - 1, 2 * NA_KW - 1), 0.1),
        "rw_conv": jnp.array([0.25, 0.5, 0.25], f32)[:, None] + nrm(ks[6], (L, 3, 3 * B_WIDTH), 0.05),
        "rw_w0": jax.random.uniform(ks[7], (L, 2, B_WIDTH), f32, -3.0, 1.0),
        "rw_w_up": nrm(ks[8], (L, 2, R_W, B_WIDTH), 0.5 * R_W ** -0.5),
        "rw_a0": nrm(ks[9], (L, 2, B_WIDTH), 0.5),
        "rw_a_up": nrm(ks[10], (L, 2, R_A, B_WIDTH), 0.5 * R_A ** -0.5),
        "rw_g_up": nrm(ks[11], (L, R_G, B_WIDTH), R_G ** -0.5),
        "rw_k_k": 0.85 + nrm(ks[12], (L, B_WIDTH), 0.05),
        "rw_k_a": 1.0 + nrm(ks[13], (L, B_WIDTH), 0.05),
        "rw_r_k": nrm(ks[14], (L, B_HEADS, HEAD_DIM), 0.1),
        "rw_gn_gain": 1.0 + nrm(ks[15], (L, B_WIDTH), 0.05),
        "rw_gn_bias": nrm(ks[16], (L, B_WIDTH), 0.01),
        "pool_w": nrm(ks[17], (L, N_POOL_GROUPS, POOL_CH, POOL_CH), POOL_CH ** -0.5),
        "pool_scale": 1.0 + nrm(ks[18], (L, C_WIDTH), 0.05),
        "w_out": nrm(ks[19], (L, D_MIX, D_MODEL), BETA * D_MIX ** -0.5),
        "ln1_gain": 1.0 + nrm(ks[20], (L, D_MODEL), 0.05),
        "ln1_bias": nrm(ks[21], (L, D_MODEL), 0.01),
        "ln2_gain": 1.0 + nrm(ks[22], (L, D_MODEL), 0.05),
        "ln2_bias": nrm(ks[23], (L, D_MODEL), 0.01),
        "moe_w_group": nrm(ks[24], (L, D_MODEL, N_GROUPS), D_MODEL ** -0.5),
        "moe_b_group": nrm(ks[25], (L, N_GROUPS), 0.01),
        "moe_w_expert": nrm(ks[26], (L, D_MODEL, N_EXPERTS), D_MODEL ** -0.5),
        "moe_b_expert": nrm(ks[27], (L, N_EXPERTS), 0.01),
        "moe_w_gate": nrm(ks[28], (L, N_EXPERTS, D_MODEL, D_EXPERT), D_MODEL ** -0.5),
        "moe_w_up": nrm(ks[29], (L, N_EXPERTS, D_MODEL, D_EXPERT), BETA * D_MODEL ** -0.5),
        "moe_w_down": nrm(ks[30], (L, N_EXPERTS, D_EXPERT, D_MODEL), BETA * D_EXPERT ** -0.5),
    }


def reference(x, c, w_mod, b_mod, w_in, na_rpb, rw_conv, rw_w0, rw_w_up, rw_a0, rw_a_up, rw_g_up,
              rw_k_k, rw_k_a, rw_r_k, rw_gn_gain, rw_gn_bias, pool_w, pool_scale, w_out,
              ln1_gain, ln1_bias, ln2_gain, ln2_bias, moe_w_group, moe_b_group, moe_w_expert,
              moe_b_expert, moe_w_gate, moe_w_up, moe_w_down):
    o_a = 3 * A_WIDTH
    o_b = o_a + 3 * B_WIDTH
    o_w = o_b + R_W
    o_al = o_w + R_A
    o_g = o_al + R_G
    for l in range(DEPTH):
        mod = jax.nn.silu(c) @ w_mod[l] + b_mod[l]
        sh1, sc1, g1, sh2, sc2, g2 = [m[:, None, :] for m in jnp.split(mod, 6, axis=-1)]
        u = layer_norm(x) * (1.0 + sc1) + sh1
        h = u @ w_in[l]
        qa, ka, va = jnp.split(h[..., :o_a], 3, axis=-1)
        y_a = neighbourhood_attention(qa, ka, va, na_rpb[l])
        y_b = rwkv7_bidirectional(h[..., o_a:o_b], h[..., o_b:o_w], h[..., o_w:o_al], h[..., o_al:o_g],
                                  rw_conv[l], rw_w0[l], rw_w_up[l], rw_a0[l], rw_a_up[l], rw_g_up[l],
                                  rw_k_k[l], rw_k_a[l], rw_r_k[l], rw_gn_gain[l], rw_gn_bias[l])
        y_c = multiscale_pool(h[..., o_g:], pool_w[l], pool_scale[l])
        mix = jnp.concatenate([y_a, y_b.astype(y_a.dtype), y_c.astype(y_a.dtype)], axis=-1) @ w_out[l]
        x = layer_norm(ALPHA * x + g1 * mix) * ln1_gain[l] + ln1_bias[l]
        u2 = layer_norm(x) * (1.0 + sc2) + sh2
        f = hierarchical_moe(u2, moe_w_group[l], moe_b_group[l], moe_w_expert[l], moe_b_expert[l],
                             moe_w_gate[l], moe_w_up[l], moe_w_down[l])
        x = layer_norm(ALPHA * x + g2 * f) * ln2_gain[l] + ln2_bias[l]
    return x
```

```cpp
#include <hip/hip_runtime.h>
#include <stdint.h>

namespace cfg {
constexpr int D = 1024, NB = 2, S = 8192, T = NB * S, L = 2;
constexpr int GW = 64, ROWS = 128;
constexpr int HD = 64, AW = 384, BW = 384, CW = 256, AH = 6, BH = 6;
constexpr int KH = 8, KW = 16;
constexpr int RW = 32, RA = 32, RG = 64;
constexpr int INW = 2688;
constexpr int O_A = 1152, O_B = 2304, O_W = 2336, O_AL = 2368, O_G = 2432;
constexpr int NG = 4, EPG = 8, NE = 32, DE = 512;
constexpr int MODW = 6 * D;
constexpr float ALPHA = 1.41421356237309515f;
constexpr float LN_EPS = 1e-5f, GN_EPS = 64e-5f;
constexpr float DECAY = 0.60653065971263342f;
}
using namespace cfg;

__device__ __forceinline__ float wave_sum(float v) {
#pragma unroll
    for (int o = 32; o > 0; o >>= 1) v += __shfl_xor(v, o);
    return v;
}
__device__ __forceinline__ float sigm(float x) { return 1.f / (1.f + expf(-x)); }

__global__ void k_mod(const float* __restrict__ c, const float* __restrict__ w_mod, const float* __restrict__ b_mod, float* __restrict__ mod) {
    __shared__ float sc[NB * D];
    for (int i = threadIdx.x; i < NB * D; i += blockDim.x) { float v = c[i]; sc[i] = v * sigm(v); }
    __syncthreads();
    int idx = blockIdx.x * blockDim.x + threadIdx.x;
    int l = idx / MODW, n = idx % MODW;
    const float* w = w_mod + (size_t)l * D * MODW + n;
    float a0 = 0.f, a1 = 0.f;
    for (int k = 0; k < D; ++k) { float wv = w[(size_t)k * MODW]; a0 += sc[k] * wv; a1 += sc[D + k] * wv; }
    float bb = b_mod[l * MODW + n];
    mod[(size_t)(l * NB + 0) * MODW + n] = a0 + bb;
    mod[(size_t)(l * NB + 1) * MODW + n] = a1 + bb;
}

__global__ void k_ln_mod(const float* __restrict__ xin, const float* __restrict__ modl, int off_sh, int off_sc, float* __restrict__ uout) {
    int row = (blockIdx.x * blockDim.x + threadIdx.x) >> 6, lane = threadIdx.x & 63;
    if (row >= T) return;
    int b = row / S;
    const float4* xr = (const float4*)(xin + (size_t)row * D);
    float4 v[4]; float s = 0.f;
#pragma unroll
    for (int j = 0; j < 4; ++j) { v[j] = xr[lane + 64 * j]; s += (v[j].x + v[j].y) + (v[j].z + v[j].w); }
    float mean = wave_sum(s) * (1.f / D); float q = 0.f;
#pragma unroll
    for (int j = 0; j < 4; ++j) { v[j].x -= mean; v[j].y -= mean; v[j].z -= mean; v[j].w -= mean; q += (v[j].x * v[j].x + v[j].y * v[j].y) + (v[j].z * v[j].z + v[j].w * v[j].w); }
    float rstd = 1.f / sqrtf(wave_sum(q) * (1.f / D) + LN_EPS);
    const float* md = modl + (size_t)b * MODW;
    float4* orow = (float4*)(uout + (size_t)row * D);
#pragma unroll
    for (int j = 0; j < 4; ++j) {
        int col = 4 * lane + 256 * j;
        float4 scv = *(const float4*)(md + off_sc + col), shv = *(const float4*)(md + off_sh + col);
        float4 o;
        o.x = v[j].x * rstd * (1.f + scv.x) + shv.x; o.y = v[j].y * rstd * (1.f + scv.y) + shv.y;
        o.z = v[j].z * rstd * (1.f + scv.z) + shv.z; o.w = v[j].w * rstd * (1.f + scv.w) + shv.w;
        orow[lane + 64 * j] = o;
    }
}

__global__ void k_post(const float* xin, const float* br, const float* __restrict__ modl, int off_gate,
                       const float* __restrict__ gain, const float* __restrict__ bias, float* xout,
                       float* u2out, int off_sh2, int off_sc2) {
    int row = (blockIdx.x * blockDim.x + threadIdx.x) >> 6, lane = threadIdx.x & 63;
    if (row >= T) return;
    int b = row / S;
    const float* md = modl + (size_t)b * MODW;
    const float4* xr = (const float4*)(xin + (size_t)row * D);
    const float4* brr = (const float4*)(br + (size_t)row * D);
    float4 v[4]; float s = 0.f;
#pragma unroll
    for (int j = 0; j < 4; ++j) {
        int col = 4 * lane + 256 * j;
        float4 xv = xr[lane + 64 * j], bv = brr[lane + 64 * j], g = *(const float4*)(md + off_gate + col);
        v[j].x = ALPHA * xv.x + g.x * bv.x; v[j].y = ALPHA * xv.y + g.y * bv.y; v[j].z = ALPHA * xv.z + g.z * bv.z; v[j].w = ALPHA * xv.w + g.w * bv.w;
        s += (v[j].x + v[j].y) + (v[j].z + v[j].w);
    }
    float mean = wave_sum(s) * (1.f / D); float q = 0.f;
#pragma unroll
    for (int j = 0; j < 4; ++j) { v[j].x -= mean; v[j].y -= mean; v[j].z -= mean; v[j].w -= mean; q += (v[j].x * v[j].x + v[j].y * v[j].y) + (v[j].z * v[j].z + v[j].w * v[j].w); }
    float rstd = 1.f / sqrtf(wave_sum(q) * (1.f / D) + LN_EPS);
    float4* orow = (float4*)(xout + (size_t)row * D);
    s = 0.f;
#pragma unroll
    for (int j = 0; j < 4; ++j) {
        int col = 4 * lane + 256 * j;
        float4 gn = *(const float4*)(gain + col), bs = *(const float4*)(bias + col);
        v[j].x = v[j].x * rstd * gn.x + bs.x; v[j].y = v[j].y * rstd * gn.y + bs.y; v[j].z = v[j].z * rstd * gn.z + bs.z; v[j].w = v[j].w * rstd * gn.w + bs.w;
        orow[lane + 64 * j] = v[j];
        s += (v[j].x + v[j].y) + (v[j].z + v[j].w);
    }
    if (u2out == nullptr) return;
    mean = wave_sum(s) * (1.f / D); q = 0.f;
#pragma unroll
    for (int j = 0; j < 4; ++j) { v[j].x -= mean; v[j].y -= mean; v[j].z -= mean; v[j].w -= mean; q += (v[j].x * v[j].x + v[j].y * v[j].y) + (v[j].z * v[j].z + v[j].w * v[j].w); }
    rstd = 1.f / sqrtf(wave_sum(q) * (1.f / D) + LN_EPS);
    float4* urow = (float4*)(u2out + (size_t)row * D);
#pragma unroll
    for (int j = 0; j < 4; ++j) {
        int col = 4 * lane + 256 * j;
        float4 scv = *(const float4*)(md + off_sc2 + col), shv = *(const float4*)(md + off_sh2 + col);
        float4 o;
        o.x = v[j].x * rstd * (1.f + scv.x) + shv.x; o.y = v[j].y * rstd * (1.f + scv.y) + shv.y;
        o.z = v[j].z * rstd * (1.f + scv.z) + shv.z; o.w = v[j].w * rstd * (1.f + scv.w) + shv.w;
        urow[lane + 64 * j] = o;
    }
}

__global__ void __launch_bounds__(256) k_gemm_f32(const float* __restrict__ A, int lda, const float* __restrict__ B, int ldb, float* __restrict__ C, int ldc, int K) {
    __shared__ float As[16][65];
    __shared__ float Bs[16][64];
    const int tx = threadIdx.x & 15, ty = threadIdx.x >> 4;
    const int m0 = blockIdx.y * 64, n0 = blockIdx.x * 64;
    float acc[4][4];
#pragma unroll
    for (int i = 0; i < 4; ++i)
#pragma unroll
        for (int j = 0; j < 4; ++j) acc[i][j] = 0.f;
    for (int k0 = 0; k0 < K; k0 += 16) {
#pragma unroll
        for (int i = 0; i < 4; ++i) { int e = threadIdx.x + 256 * i; int m = e >> 4, k = e & 15; As[k][m] = A[(size_t)(m0 + m) * lda + k0 + k]; }
#pragma unroll
        for (int i = 0; i < 4; ++i) { int e = threadIdx.x + 256 * i; int k = e >> 6, n = e & 63; Bs[k][n] = B[(size_t)(k0 + k) * ldb + n0 + n]; }
        __syncthreads();
#pragma unroll
        for (int k = 0; k < 16; ++k) {
            float a[4], b[4];
#pragma unroll
            for (int i = 0; i < 4; ++i) { a[i] = As[k][ty * 4 + i]; b[i] = Bs[k][tx * 4 + i]; }
#pragma unroll
            for (int i = 0; i < 4; ++i)
#pragma unroll
                for (int j = 0; j < 4; ++j) acc[i][j] += a[i] * b[j];
        }
        __syncthreads();
    }
#pragma unroll
    for (int i = 0; i < 4; ++i) {
        float4 o = make_float4(acc[i][0], acc[i][1], acc[i][2], acc[i][3]);
        *(float4*)(C + (size_t)(m0 + ty * 4 + i) * ldc + n0 + tx * 4) = o;
    }
}

__global__ void __launch_bounds__(64) k_attn_naive(const float* __restrict__ h, const float* __restrict__ rpb, float* __restrict__ concat) {
    int idx = blockIdx.x * blockDim.x + threadIdx.x;
    if (idx >= T * AH) return;
    int head = idx % AH, tok = idx / AH;
    int b = tok / S, t = tok % S, r = t / GW, cq = t % GW;
    int rstart = r - KH / 2; rstart = rstart < 0 ? 0 : (rstart > ROWS - KH ? ROWS - KH : rstart);
    int cstart = cq - KW / 2; cstart = cstart < 0 ? 0 : (cstart > GW - KW ? GW - KW : cstart);
    float q[HD], acc[HD];
    const float* qp = h + (size_t)tok * INW + head * HD;
#pragma unroll
    for (int d = 0; d < HD; ++d) { q[d] = qp[d]; acc[d] = 0.f; }
    float m = -1e30f, l = 0.f;
    const float* rp = rpb + (size_t)head * (2 * KH - 1) * (2 * KW - 1);
    for (int kk = 0; kk < KH; ++kk) {
        int kr = rstart + kk; int dr = kr - r + (KH - 1);
        for (int j = 0; j < KW; ++j) {
            int ck = cstart + j; int dc = ck - cq; dc = dc < -(KW - 1) ? -(KW - 1) : (dc > KW - 1 ? KW - 1 : dc); dc += KW - 1;
            size_t krow = (size_t)(b * S + kr * GW + ck) * INW;
            const float* kp = h + krow + AW + head * HD;
            const float* vp = h + krow + 2 * AW + head * HD;
            float s = 0.f;
#pragma unroll
            for (int d = 0; d < HD; ++d) s += q[d] * kp[d];
            s = s * 0.125f + rp[dr * (2 * KW - 1) + dc];
            float mn = fmaxf(m, s); float corr = expf(m - mn); float p = expf(s - mn);
            l = l * corr + p;
#pragma unroll
            for (int d = 0; d < HD; ++d) acc[d] = acc[d] * corr + p * vp[d];
            m = mn;
        }
    }
    float inv = 1.f / l;
    float* op = concat + (size_t)tok * D + head * HD;
#pragma unroll
    for (int d = 0; d < HD; ++d) op[d] = acc[d] * inv;
}

__global__ void __launch_bounds__(256) k_pool_naive(const float* __restrict__ h, const float* __restrict__ pool_w, const float* __restrict__ pool_scale, float* __restrict__ concat) {
    __shared__ float pooled[CW];
    int tok = blockIdx.x; int b = tok / S, t = tok % S; int ch = threadIdx.x; int g = ch / 64;
    int win = 2 << g;
    int lo = t - win / 2; lo = lo < 0 ? 0 : (lo > S - 1 ? S - 1 : lo);
    int hi = t + win / 2 - 1; hi = hi < 0 ? 0 : (hi > S - 1 ? S - 1 : hi);
    float s = 0.f;
    for (int u = lo; u <= hi; ++u) s += h[(size_t)(b * S + u) * INW + O_G + ch];
    pooled[ch] = s / (float)(hi - lo + 1) - h[(size_t)tok * INW + O_G + ch];
    __syncthreads();
    int e = ch % 64;
    const float* pw = pool_w + (size_t)g * 64 * 64 + e;
    float a = 0.f;
    for (int c2 = 0; c2 < 64; ++c2) a += pooled[g * 64 + c2] * pw[c2 * 64];
    concat[(size_t)tok * D + AW + BW + ch] = a * pool_scale[ch];
}

struct RwP { const float *conv, *w0, *w_up, *a0, *a_up, *g_up, *k_k, *k_a, *r_k, *gn_gain, *gn_bias; };

__global__ void __launch_bounds__(64) k_rwkv_scan_naive(const float* __restrict__ h, RwP p, float* __restrict__ ys) {
    const int lane = threadIdx.x;
    const int dir = blockIdx.x / (NB * BH), b = (blockIdx.x / BH) % NB, hd = blockIdx.x % BH;
    const int ch = hd * HD + lane;
    float st[HD];
#pragma unroll
    for (int j = 0; j < HD; ++j) st[j] = 0.f;
    float wup[RW], aup[RA];
#pragma unroll
    for (int m = 0; m < RW; ++m) { wup[m] = p.w_up[(size_t)(dir * RW + m) * BW + ch]; aup[m] = p.a_up[(size_t)(dir * RA + m) * BW + ch]; }
    const float w0 = p.w0[dir * BW + ch], a0 = p.a0[dir * BW + ch], kkw = p.k_k[ch], kaw = p.k_a[ch];
    float cr[3], ck[3], cv[3];
#pragma unroll
    for (int x = 0; x < 3; ++x) { cr[x] = p.conv[x * 3 * BW + ch]; ck[x] = p.conv[x * 3 * BW + BW + ch]; cv[x] = p.conv[x * 3 * BW + 2 * BW + ch]; }
    for (int step = 0; step < S; ++step) {
        const int t = dir ? (S - 1 - step) : step;
        const size_t row = (size_t)(b * S + t) * INW;
        float r = 0.f, k = 0.f, v = 0.f;
#pragma unroll
        for (int x = 0; x < 3; ++x) {
            int tt = t + x - 1;
            if (tt >= 0 && tt < S) {
                const float* hp = h + (size_t)(b * S + tt) * INW + O_A + ch;
                r += hp[0] * cr[x]; k += hp[BW] * ck[x]; v += hp[2 * BW] * cv[x];
            }
        }
        float lv = h[row + O_B + lane];
        float lt = lane < RW ? tanhf(lv) : lv;
        float zw = w0, za = a0;
#pragma unroll
        for (int m = 0; m < RW; ++m) { zw += __shfl(lt, m) * wup[m]; za += __shfl(lt, RW + m) * aup[m]; }
        const float w = expf(-DECAY * sigm(zw));
        const float a = sigm(za);
        float kk = k * kkw;
        float ss = wave_sum(kk * kk);
        kk = kk * (1.f / sqrtf(fmaxf(ss, 1e-24f)));
        const float kd = k * (1.f + (a - 1.f) * kaw);
        const float kka = kk * a;
        float sa = 0.f;
#pragma unroll
        for (int j = 0; j < HD; ++j) sa += st[j] * (-__shfl(kk, j));
        float y = 0.f;
#pragma unroll
        for (int j = 0; j < HD; ++j) {
            st[j] = st[j] * __shfl(w, j) + sa * __shfl(kka, j) + v * __shfl(kd, j);
            y += st[j] * __shfl(r, j);
        }
        ys[((size_t)dir * T + b * S + t) * BW + ch] = y;
    }
}

__global__ void __launch_bounds__(384) k_rwkv_finish_naive(const float* __restrict__ h, RwP p, const float* __restrict__ ys, float* __restrict__ concat) {
    __shared__ float lw[RW], la[RA], sg[RG];
    const int tok = blockIdx.x, b = tok / S, t = tok % S, ch = threadIdx.x, hd = ch / HD, j = ch % HD;
    const size_t row = (size_t)tok * INW;
    if (ch < RW) lw[ch] = tanhf(h[row + O_B + ch]);
    else if (ch < RW + RA) la[ch - RW] = h[row + O_W + (ch - RW)];
    else if (ch < RW + RA + RG) sg[ch - RW - RA] = sigm(h[row + O_AL + (ch - RW - RA)]);
    __syncthreads();
    float r = 0.f, k = 0.f, v = 0.f;
#pragma unroll
    for (int x = 0; x < 3; ++x) {
        int tt = t + x - 1;
        if (tt >= 0 && tt < S) {
            const float* hp = h + (size_t)(b * S + tt) * INW + O_A + ch;
            r += hp[0] * p.conv[x * 3 * BW + ch]; k += hp[BW] * p.conv[x * 3 * BW + BW + ch]; v += hp[2 * BW] * p.conv[x * 3 * BW + 2 * BW + ch];
        }
    }
    float bon = 0.f;
    for (int dir = 0; dir < 2; ++dir) {
        float za = p.a0[dir * BW + ch];
        for (int m = 0; m < RA; ++m) za += la[m] * p.a_up[(size_t)(dir * RA + m) * BW + ch];
        float a = sigm(za);
        float kd = k * (1.f + (a - 1.f) * p.k_a[ch]);
        bon += wave_sum(r * kd * p.r_k[hd * HD + j]);
    }
    bon *= v;
    float y = ys[(size_t)tok * BW + ch] + ys[((size_t)T + tok) * BW + ch];
    float mu = wave_sum(y) * (1.f / HD);
    float dy = y - mu;
    float var = wave_sum(dy * dy) * (1.f / HD);
    float yn = dy * (1.f / sqrtf(var + GN_EPS)) * p.gn_gain[ch] + p.gn_bias[ch];
    float g = 0.f;
    for (int m = 0; m < RG; ++m) g += sg[m] * p.g_up[(size_t)m * BW + ch];
    concat[(size_t)tok * D + AW + ch] = (yn + bon) * g;
}

__global__ void k_router(const float* __restrict__ u2, const float* __restrict__ wg, const float* __restrict__ bg, const float* __restrict__ we, const float* __restrict__ be,
                         int* __restrict__ tok_e, float* __restrict__ tok_w) {
    int row = (blockIdx.x * blockDim.x + threadIdx.x) >> 6, lane = threadIdx.x & 63;
    if (row >= T) return;
    float gl[NG], el[NE];
#pragma unroll
    for (int n = 0; n < NG; ++n) gl[n] = 0.f;
#pragma unroll
    for (int n = 0; n < NE; ++n) el[n] = 0.f;
    for (int i = 0; i < 16; ++i) {
        int k = lane + 64 * i;
        float x = u2[(size_t)row * D + k];
#pragma unroll
        for (int n = 0; n < NG; ++n) gl[n] += x * wg[k * NG + n];
#pragma unroll
        for (int n = 0; n < NE; ++n) el[n] += x * we[k * NE + n];
    }
#pragma unroll
    for (int n = 0; n < NG; ++n) gl[n] = wave_sum(gl[n]) + bg[n];
#pragma unroll
    for (int n = 0; n < NE; ++n) el[n] = wave_sum(el[n]) + be[n];
    int gi = 0; float gm = gl[0];
#pragma unroll
    for (int n = 1; n < NG; ++n) if (gl[n] > gm) { gm = gl[n]; gi = n; }
    float se = 0.f;
#pragma unroll
    for (int n = 0; n < NG; ++n) se += expf(gl[n] - gm);
    float pg = 1.f / se;
    float l1 = -3.0e38f, l2 = -3.0e38f; int i1 = 0, i2 = 0;
#pragma unroll
    for (int n = 0; n < NE; ++n) {
        if ((n >> 3) == gi) {
            float v = el[n]; int e = n & 7;
            if (v > l1) { l2 = l1; i2 = i1; l1 = v; i1 = e; }
            else if (v > l2) { l2 = v; i2 = e; }
        }
    }
    float e2 = expf(l2 - l1);
    float w1 = pg / (1.f + e2), w2 = pg * e2 / (1.f + e2);
    if (lane == 0) { tok_e[row * 2] = gi * EPG + i1; tok_e[row * 2 + 1] = gi * EPG + i2; tok_w[row * 2] = w1; tok_w[row * 2 + 1] = w2; }
}

__global__ void __launch_bounds__(256) k_moe_naive(const float* __restrict__ u2, const int* __restrict__ tok_e, const float* __restrict__ tok_w,
                                                    const float* __restrict__ wgate, const float* __restrict__ wup, const float* __restrict__ wdown, float* __restrict__ f) {
    __shared__ float xs[D]; __shared__ float hb[DE];
    const int tok = blockIdx.x, tid = threadIdx.x;
    for (int i = tid; i < D; i += 256) xs[i] = u2[(size_t)tok * D + i];
    float o[4] = {0.f, 0.f, 0.f, 0.f};
    for (int kk = 0; kk < 2; ++kk) {
        const int e = tok_e[tok * 2 + kk]; const float wt = tok_w[tok * 2 + kk];
        __syncthreads();
        const float* g = wgate + (size_t)e * D * DE; const float* u = wup + (size_t)e * D * DE;
        float ag0 = 0.f, ag1 = 0.f, au0 = 0.f, au1 = 0.f;
        for (int k = 0; k < D; ++k) { float x = xs[k]; ag0 += x * g[(size_t)k * DE + tid]; ag1 += x * g[(size_t)k * DE + 256 + tid]; au0 += x * u[(size_t)k * DE + tid]; au1 += x * u[(size_t)k * DE + 256 + tid]; }
        hb[tid] = ag0 * sigm(ag0) * au0; hb[256 + tid] = ag1 * sigm(ag1) * au1;
        __syncthreads();
        const float* dn = wdown + (size_t)e * DE * D;
        float a[4] = {0.f, 0.f, 0.f, 0.f};
        for (int k = 0; k < DE; ++k) { float x = hb[k];
#pragma unroll
            for (int j = 0; j < 4; ++j) a[j] += x * dn[(size_t)k * D + tid + 256 * j]; }
#pragma unroll
        for (int j = 0; j < 4; ++j) o[j] += a[j] * wt;
    }
#pragma unroll
    for (int j = 0; j < 4; ++j) f[(size_t)tok * D + tid + 256 * j] = o[j];
}

extern "C" void kernel_launch(void* const* d_in, const int* in_sizes, int n_in, void* d_out, int out_size, void* d_ws, size_t ws_size, hipStream_t stream) {
    const float* x = (const float*)d_in[0]; const float* c = (const float*)d_in[1];
    const float* w_mod = (const float*)d_in[2]; const float* b_mod = (const float*)d_in[3];
    const float* w_in = (const float*)d_in[4]; const float* na_rpb = (const float*)d_in[5];
    const float* rw_conv = (const float*)d_in[6]; const float* rw_w0 = (const float*)d_in[7]; const float* rw_w_up = (const float*)d_in[8];
    const float* rw_a0 = (const float*)d_in[9]; const float* rw_a_up = (const float*)d_in[10]; const float* rw_g_up = (const float*)d_in[11];
    const float* rw_k_k = (const float*)d_in[12]; const float* rw_k_a = (const float*)d_in[13]; const float* rw_r_k = (const float*)d_in[14];
    const float* rw_gn_gain = (const float*)d_in[15]; const float* rw_gn_bias = (const float*)d_in[16];
    const float* pool_w = (const float*)d_in[17]; const float* pool_scale = (const float*)d_in[18]; const float* w_out = (const float*)d_in[19];
    const float* ln1_gain = (const float*)d_in[20]; const float* ln1_bias = (const float*)d_in[21];
    const float* ln2_gain = (const float*)d_in[22]; const float* ln2_bias = (const float*)d_in[23];
    const float* moe_w_group = (const float*)d_in[24]; const float* moe_b_group = (const float*)d_in[25];
    const float* moe_w_expert = (const float*)d_in[26]; const float* moe_b_expert = (const float*)d_in[27];
    const float* moe_w_gate = (const float*)d_in[28]; const float* moe_w_up = (const float*)d_in[29]; const float* moe_w_down = (const float*)d_in[30];
    float* out = (float*)d_out;
    char* ws = (char*)d_ws;
    const size_t MiB = 1u << 20;
    float* MOD = (float*)(ws + 0);
    int* TOKE = (int*)(ws + 1 * MiB);
    float* TOKW = (float*)(ws + 1 * MiB + 512 * 1024);
    float* XA = (float*)(ws + 2 * MiB);
    float* U = (float*)(ws + 66 * MiB);
    float* HF = (float*)(ws + 130 * MiB);
    float* CONCAT = (float*)(ws + 298 * MiB);
    float* YS = (float*)(ws + 362 * MiB);
    float* F = HF;

    k_mod<<<L * MODW / 256, 256, 0, stream>>>(c, w_mod, b_mod, MOD);
    const float* xin = x;
    for (int l = 0; l < L; ++l) {
        const float* modl = MOD + (size_t)l * NB * MODW;
        k_ln_mod<<<T / 4, 256, 0, stream>>>(xin, modl, 0, D, U);
        k_gemm_f32<<<dim3(INW / 64, T / 64), 256, 0, stream>>>(U, D, w_in + (size_t)l * D * INW, INW, HF, INW, D);
        k_attn_naive<<<T * AH / 64, 64, 0, stream>>>(HF, na_rpb + (size_t)l * AH * 15 * 31, CONCAT);
        k_pool_naive<<<T, 256, 0, stream>>>(HF, pool_w + (size_t)l * NG * 64 * 64, pool_scale + (size_t)l * CW, CONCAT);
        RwP p;
        p.conv = rw_conv + (size_t)l * 3 * 3 * BW; p.w0 = rw_w0 + (size_t)l * 2 * BW; p.w_up = rw_w_up + (size_t)l * 2 * RW * BW;
        p.a0 = rw_a0 + (size_t)l * 2 * BW; p.a_up = rw_a_up + (size_t)l * 2 * RA * BW; p.g_up = rw_g_up + (size_t)l * RG * BW;
        p.k_k = rw_k_k + (size_t)l * BW; p.k_a = rw_k_a + (size_t)l * BW; p.r_k = rw_r_k + (size_t)l * BH * HD;
        p.gn_gain = rw_gn_gain + (size_t)l * BW; p.gn_bias = rw_gn_bias + (size_t)l * BW;
        k_rwkv_scan_naive<<<2 * NB * BH, 64, 0, stream>>>(HF, p, YS);
        k_rwkv_finish_naive<<<T, 384, 0, stream>>>(HF, p, YS, CONCAT);
        k_gemm_f32<<<dim3(D / 64, T / 64), 256, 0, stream>>>(CONCAT, D, w_out + (size_t)l * D * D, D, U, D, D);
        k_post<<<T / 4, 256, 0, stream>>>(xin, U, modl, 2 * D, ln1_gain + (size_t)l * D, ln1_bias + (size_t)l * D, XA, U, 3 * D, 4 * D);
        k_router<<<T / 4, 256, 0, stream>>>(U, moe_w_group + (size_t)l * D * NG, moe_b_group + (size_t)l * NG, moe_w_expert + (size_t)l * D * NE, moe_b_expert + (size_t)l * NE, TOKE, TOKW);
        k_moe_naive<<<T, 256, 0, stream>>>(U, TOKE, TOKW, moe_w_gate + (size_t)l * NE * D * DE, moe_w_up + (size_t)l * NE * D * DE, moe_w_down + (size_t)l * NE * DE * D, F);
        k_post<<<T / 4, 256, 0, stream>>>(XA, F, modl, 5 * D, ln2_gain + (size_t)l * D, ln2_bias + (size_t)l * D, out, nullptr, 0, 0);
        xin = out;
    }
}
```

```cpp
#define TESTMODE 0
#define MK_MODE 0
#include <hip/hip_runtime.h>
#include <hip/hip_cooperative_groups.h>
#include <stdint.h>
namespace cg = cooperative_groups;

#ifndef TESTMODE
#define TESTMODE 0
#endif
#define DI __device__ __forceinline__
#define LAS __attribute__((address_space(3)))
typedef unsigned short bf16_t;
typedef short bf16x8 __attribute__((ext_vector_type(8)));
typedef float f32x4 __attribute__((ext_vector_type(4)));
typedef float f32x16 __attribute__((ext_vector_type(16)));
typedef unsigned u32x4 __attribute__((ext_vector_type(4)));
typedef unsigned u32x2 __attribute__((ext_vector_type(2)));
typedef float f32x2_t __attribute__((ext_vector_type(2)));
typedef __bf16 bf16x2_t __attribute__((ext_vector_type(2)));

namespace cfg {
constexpr int D = 1024, NB = 2, S = 8192, T = NB * S, L = 2;
constexpr int GW = 64, ROWS = 128;
constexpr int HD = 64, AW = 384, BW = 384, CW = 256, AH = 6, BH = 6;
constexpr int KH = 8, KW = 16;
constexpr int RW = 32, RA = 32, RG = 64;
constexpr int INW = 2688;
constexpr int NG = 4, EPG = 8, NE = 32, DE = 512;
constexpr int MODW = 6 * D;
constexpr float ALPHA = 1.41421356237309515f;
constexpr float LN_EPS = 1e-5f, GN_EPS = 64e-5f;
constexpr float DECAY = 0.60653065971263342f;
constexpr float LOG2E = 1.44269504088896341f;
constexpr int HW = 2304, HQ = 0, HK = 384, HR = 768, HWL = 1920, HAL = 1952, HGL = 1984, HP = 2048;
constexpr int NCH = S / 64;
constexpr int NUNIT = 2 * NB * BH * NCH;
constexpr int XSROWS = 2 * T + NE * 256;
}
using namespace cfg;

constexpr size_t MiB = 1u << 20;
constexpr size_t WS_CTL = 0;
constexpr size_t CTL_BYTES = 65536;
constexpr int CW_BAR = 0;
constexpr int CW_CNT = 8192;
constexpr size_t WS_MOD = 1 * MiB;
constexpr size_t WS_TOKSLOT = 1 * MiB + 128 * 1024;
constexpr size_t WS_SLOTW = 1 * MiB + 256 * 1024;
constexpr size_t WS_ELIST = 2 * MiB;
constexpr size_t WS_EW = 4 * MiB;
constexpr size_t WS_WIN = 6 * MiB;
constexpr size_t WIN_LAYER = (size_t)2816 * 1024 * 2;
constexpr size_t WS_WOUT = 17 * MiB;
constexpr size_t WS_WGU = 21 * MiB;
constexpr size_t WS_WD = 85 * MiB;
constexpr size_t WS_XA = 117 * MiB;
constexpr size_t WS_U = 181 * MiB;
constexpr size_t WS_HB = 213 * MiB;
constexpr size_t WS_S0 = 213 * MiB;
constexpr size_t WS_VT = 285 * MiB;
constexpr size_t WS_CONCAT = 301 * MiB;
constexpr size_t WS_MP = 333 * MiB;
constexpr size_t WS_NB = 357 * MiB;
constexpr size_t WS_MIX = 333 * MiB;
constexpr size_t WS_QT = 405 * MiB;
constexpr size_t WS_WT = 429 * MiB;
constexpr size_t WS_VTB = 453 * MiB;
constexpr size_t WS_GB = 465 * MiB;
constexpr size_t WS_VC = 477 * MiB;
constexpr size_t WS_BS = 489 * MiB;
constexpr size_t WS_XS = 213 * MiB;
constexpr size_t WS_HM = 293 * MiB;
constexpr size_t WS_YS = 333 * MiB;
constexpr size_t WS_END = 490 * MiB;

constexpr int NWAVES = 8, NTHREADS = 512;
constexpr int LDS_BYTES = 152 * 1024;

DI unsigned cvtpk(float lo, float hi) { f32x2_t v = {lo, hi}; bf16x2_t b = __builtin_convertvector(v, bf16x2_t); return __builtin_bit_cast(unsigned, b); }
DI float bflo(unsigned w) { return __uint_as_float(w << 16); }
DI float bfhi(unsigned w) { return __uint_as_float(w & 0xffff0000u); }
DI float bf2f(unsigned short h) { return __uint_as_float((unsigned)h << 16); }
DI unsigned short f2bf(float f) { return (unsigned short)(cvtpk(f, 0.f) & 0xffffu); }
DI float wave_sum(float v) {
#pragma unroll
    for (int o = 32; o > 0; o >>= 1) v += __shfl_xor(v, o);
    return v;
}
DI float sigm(float x) { return 1.f / (1.f + __expf(-x)); }
#define LDS_WAIT() asm volatile("s_waitcnt lgkmcnt(0)" ::: "memory")
#define VM_WAIT() asm volatile("s_waitcnt vmcnt(0)" ::: "memory")
DI int swap23(int i) { return (i & ~12) | ((i & 4) << 1) | ((i & 8) >> 1); }

namespace pg8 {
constexpr int BM = 256, BK = 64, HALF = 128, HTB = HALF * BK * 2, STAGE_BYTES = 8 * HTB, NXCD = 8, WGM = 8;
__host__ __device__ __forceinline__ int lds_byte(int r, int c) { const int st = (r >> 4) * 2 + (c >> 5), rr = r & 15, cc = c & 31, ob = rr * 64 + cc * 2; return st * 1024 + (ob ^ (((ob >> 9) & 1) << 5)); }
__host__ __device__ __forceinline__ void stage_rc(int b, int& R, int& C) { const int st = b / 1024, sb = b % 1024, swz = sb ^ (((sb >> 9) & 1) << 5); R = (st >> 1) * 16 + swz / 64; C = (st & 1) * 32 + (swz % 64) / 2; }
__host__ __device__ __forceinline__ int perm32(int rho) { const int n = rho >> 4, i = rho & 15; return 8 * (i >> 2) + 4 * n + (i & 3); }

struct Unit { int pm, pn, aux; };

DI int xcd_remap(int L, int nwg) { const int q = nwg / NXCD, r = nwg % NXCD, xcd = L % NXCD, off = L / NXCD; return (xcd < r ? xcd * (q + 1) : r * (q + 1) + (xcd - r) * q) + off; }

struct PlainOrder {
    const bf16_t* A; const bf16_t* Bt; int K; int nM, nN, nwg, G, c;
    DI void init(const bf16_t* A_, const bf16_t* Bt_, int M, int N, int K_, int G_, int c_) { A = A_; Bt = Bt_; K = K_; nM = M / BM; nN = N / BM; nwg = nM * nN; G = G_; c = c_; }
    DI bool next(int i, Unit& u) const {
        const int Lx = i * G + c; if (Lx >= nwg) return false;
        const int wgid = xcd_remap(Lx, nwg);
        const int nig = WGM * nN, gid = wgid / nig, fm = gid * WGM, gsz = (nM - fm) < WGM ? (nM - fm) : WGM;
        u.pm = fm + ((wgid % nig) % gsz); u.pn = (wgid % nig) / gsz; u.aux = 0; return true;
    }
    DI const char* aptr(const Unit& u) const { return (const char*)A + (size_t)u.pm * (2 * HALF) * K * 2; }
    DI const char* bptr(const Unit& u) const { return (const char*)Bt + (size_t)u.pn * (2 * HALF) * K * 2; }
};
struct Gemm1Order {
    const bf16_t* U; const bf16_t* Win; const bf16_t* Wv; int G, c;
    static constexpr int nM = T / BM, nN = HW / BM, nMain = nM * nN, nV = 2 * (T / BM), nwg = nMain + nV, K = D;
    DI bool next(int i, Unit& u) const {
        const int Lx = i * G + c; if (Lx >= nwg) return false;
        if (Lx < nMain) {
            const int wgid = xcd_remap(Lx, nMain);
            const int nig = WGM * nN, gid = wgid / nig, fm = gid * WGM, gsz = (nM - fm) < WGM ? (nM - fm) : WGM;
            u.pm = fm + ((wgid % nig) % gsz); u.pn = (wgid % nig) / gsz; u.aux = 0;
        } else { const int v = Lx - nMain; u.pm = v & 1; u.pn = v >> 1; u.aux = 1; }
        return true;
    }
    DI const char* aptr(const Unit& u) const { return (const char*)(u.aux ? Wv : U) + (size_t)u.pm * BM * K * 2; }
    DI const char* bptr(const Unit& u) const { return (const char*)(u.aux ? U : Win) + (size_t)u.pn * BM * K * 2; }
};
struct GroupedOrder {
    const bf16_t* A; const bf16_t* Bt; int K; size_t estride; const LAS int* tile_e; int ntiles, nwg, G, c;
    DI bool next(int i, Unit& u) const {
        const int Lx = i * G + c; if (Lx >= nwg) return false;
        const int wgid = xcd_remap(Lx, nwg);
        u.pm = wgid >> 2; u.pn = wgid & 3; u.aux = tile_e[u.pm]; return true;
    }
    DI const char* aptr(const Unit& u) const { return (const char*)A + (size_t)u.pm * BM * K * 2; }
    DI const char* bptr(const Unit& u) const { return (const char*)Bt + ((size_t)u.aux * estride + (size_t)u.pn * BM * K) * 2; }
};

struct EpiStore {
    bf16_t* O0; int ld0; bf16_t* O1; int ld1;
    DI void operator()(const f32x4 (&acc)[2][2][4][2], const Unit& u, int wr, int wc, int fr, int fq) const {
        bf16_t* base = u.aux ? O1 : O0; const int ldc = u.aux ? ld1 : ld0;
        const int row0 = u.pm * BM + wr * 64 + fr, col0 = u.pn * BM + wc * 32 + 8 * fq;
#pragma unroll
        for (int ai = 0; ai < 2; ++ai)
#pragma unroll
            for (int m = 0; m < 4; ++m) { bf16_t* rowp = base + (size_t)(row0 + ai * HALF + m * 16) * ldc + col0;
#pragma unroll
                for (int bj = 0; bj < 2; ++bj) { const f32x4 v0 = acc[ai][bj][m][0], v1 = acc[ai][bj][m][1];
                    u32x4 w; w.x = cvtpk(v0[0], v0[1]); w.y = cvtpk(v0[2], v0[3]); w.z = cvtpk(v1[0], v1[1]); w.w = cvtpk(v1[2], v1[3]);
                    *(u32x4*)(rowp + bj * HALF) = w; } }
    }
};
struct EpiSwiGlu {
    bf16_t* O;
    DI void operator()(const f32x4 (&acc)[2][2][4][2], const Unit& u, int wr, int wc, int fr, int fq) const {
        const int row0 = u.pm * BM + wr * 64 + fr, col0 = u.pn * HALF + wc * 32 + 8 * fq;
#pragma unroll
        for (int ai = 0; ai < 2; ++ai)
#pragma unroll
            for (int m = 0; m < 4; ++m) { bf16_t* rowp = O + (size_t)(row0 + ai * HALF + m * 16) * DE + col0;
                float hv[8];
#pragma unroll
                for (int n = 0; n < 2; ++n)
#pragma unroll
                    for (int e = 0; e < 4; ++e) { const float g = acc[ai][0][m][n][e], up = acc[ai][1][m][n][e]; hv[4 * n + e] = g * sigm(g) * up; }
                u32x4 w; w.x = cvtpk(hv[0], hv[1]); w.y = cvtpk(hv[2], hv[3]); w.z = cvtpk(hv[4], hv[5]); w.w = cvtpk(hv[6], hv[7]);
                *(u32x4*)rowp = w; }
    }
};
struct EpiRowScale {
    bf16_t* O; const float* roww;
    DI void operator()(const f32x4 (&acc)[2][2][4][2], const Unit& u, int wr, int wc, int fr, int fq) const {
        const int row0 = u.pm * BM + wr * 64 + fr, col0 = u.pn * BM + wc * 32 + 8 * fq;
#pragma unroll
        for (int ai = 0; ai < 2; ++ai)
#pragma unroll
            for (int m = 0; m < 4; ++m) { const int row = row0 + ai * HALF + m * 16;
#ifdef MOEB_NOSCALE
                const float s = 1.f;
#else
                const float s = roww[row];
#endif
                bf16_t* rowp = O + (size_t)row * D + col0;
#pragma unroll
                for (int bj = 0; bj < 2; ++bj) { const f32x4 v0 = acc[ai][bj][m][0] * s, v1 = acc[ai][bj][m][1] * s;
                    u32x4 w; w.x = cvtpk(v0[0], v0[1]); w.y = cvtpk(v0[2], v0[3]); w.z = cvtpk(v1[0], v1[1]); w.w = cvtpk(v1[2], v1[3]);
                    *(u32x4*)(rowp + bj * HALF) = w; } }
    }
};

template <class Epi, class Sched>
DI void gemm_phase(LAS unsigned char* lds, const int tid, const int K, const Sched& S, const Epi& E) {
    const int wid = __builtin_amdgcn_readfirstlane(tid >> 6), lane = tid & 63, wr = wid >> 2, wc = wid & 3, fr = lane & 15, fq = lane >> 4;
    const int nt = K / BK;
    unsigned voffA[2], voffB[2];
#pragma unroll
    for (int i = 0; i < 2; ++i) { int R, C; stage_rc(tid * 16 + i * 8192, R, C); const int Rb = (R & ~31) + perm32(R & 31);
        voffA[i] = (unsigned)(R * K + C) * 2u; voffB[i] = (unsigned)(Rb * K + C) * 2u; }
    const size_t kstep = (size_t)(BK * 2);
    const size_t hstep = (size_t)HALF * K * 2;
    const unsigned ldsw = (unsigned)wid * 1024u;
    const int aoff = lds_byte(wr * 64 + fr, fq * 8), boff = lds_byte(wc * 32 + fr, fq * 8);
#define PG8_SA(b, h) (((b) * 2 + (h)) * HTB)
#define PG8_SB(b, h) ((4 + (b) * 2 + (h)) * HTB)
#define PG8_STAGE(bufoff, gbase, voff) do { _Pragma("unroll") for (int _i = 0; _i < 2; ++_i) \
        __builtin_amdgcn_global_load_lds((const unsigned*)((const char*)(gbase) + (voff)[_i]), (LAS unsigned*)(lds + (bufoff) + ldsw + _i * 8192), 16, 0, 0); } while (0)
#define PG8_LDA(dst, b, h) do { _Pragma("unroll") for (int m = 0; m < 4; ++m) _Pragma("unroll") for (int k = 0; k < 2; ++k) dst[m][k] = *(const LAS bf16x8*)(lds + PG8_SA(b, h) + aoff + m * 2048 + k * 1024); } while (0)
#define PG8_LDB(dst, b, h) do { _Pragma("unroll") for (int n = 0; n < 2; ++n) _Pragma("unroll") for (int k = 0; k < 2; ++k) dst[n][k] = *(const LAS bf16x8*)(lds + PG8_SB(b, h) + boff + n * 2048 + k * 1024); } while (0)
#define PG8_MMA(ai, bj, At, Bt) do { __builtin_amdgcn_s_setprio(1); _Pragma("unroll") for (int m = 0; m < 4; ++m) _Pragma("unroll") for (int n = 0; n < 2; ++n) _Pragma("unroll") for (int k = 0; k < 2; ++k) \
        acc[ai][bj][m][n] = __builtin_amdgcn_mfma_f32_16x16x32_bf16(Bt[n][k], At[m][k], acc[ai][bj][m][n], 0, 0, 0); __builtin_amdgcn_s_setprio(0); } while (0)
#define PG8_WAIT_V(n) asm volatile("s_waitcnt vmcnt(" #n ")" ::: "memory")
#define PG8_WAIT_L(n) asm volatile("s_waitcnt lgkmcnt(" #n ")" ::: "memory")
#define PG8_BAR __builtin_amdgcn_s_barrier()
#define PG8_SCHED __builtin_amdgcn_sched_barrier(0)
    Unit cur, nxt; int ui = 0;
    if (!S.next(0, cur)) return;
    f32x4 acc[2][2][4][2];
#pragma unroll
    for (int a = 0; a < 2; ++a)
#pragma unroll
        for (int b = 0; b < 2; ++b)
#pragma unroll
            for (int m = 0; m < 4; ++m)
#pragma unroll
                for (int n = 0; n < 2; ++n) acc[a][b][m][n] = (f32x4){0.f, 0.f, 0.f, 0.f};
    bf16x8 At[4][2], B0[2][2], B1[2][2];
    const char* cA = S.aptr(cur); const char* cB = S.bptr(cur);
    PG8_STAGE(PG8_SB(0, 0), cB, voffB); PG8_STAGE(PG8_SB(0, 1), cB + hstep, voffB); PG8_STAGE(PG8_SA(0, 0), cA, voffA); PG8_STAGE(PG8_SA(0, 1), cA + hstep, voffA);
    if (wr == 1) PG8_BAR;
    PG8_WAIT_V(2); PG8_BAR;
    PG8_STAGE(PG8_SB(1, 0), cB + kstep, voffB); PG8_STAGE(PG8_SA(1, 0), cA + kstep, voffA); PG8_STAGE(PG8_SB(1, 1), cB + hstep + kstep, voffB);
    PG8_WAIT_V(6); PG8_BAR;
    for (;;) {
        const bool has_next = S.next(ui + 1, nxt);
        const char* nA = has_next ? S.aptr(nxt) : cA; const char* nB = has_next ? S.bptr(nxt) : cB;
        for (int t = 0; t < nt; t += 2) {
            const bool last = (t == nt - 2);
            const char* a1 = cA + (size_t)(t + 1) * kstep;
            const char* a2 = last ? nA : cA + (size_t)(t + 2) * kstep; const char* b2 = last ? nB : cB + (size_t)(t + 2) * kstep;
            const char* a3 = a2 + kstep; const char* b3 = b2 + kstep;
            PG8_LDB(B0, 0, 0); PG8_LDB(B1, 0, 1); PG8_SCHED; PG8_LDA(At, 0, 0); PG8_STAGE(PG8_SA(1, 1), a1 + hstep, voffA);
            PG8_WAIT_V(8); PG8_WAIT_L(0); PG8_BAR; PG8_MMA(0, 0, At, B0); PG8_MMA(0, 1, At, B1); PG8_BAR; PG8_SCHED;
            PG8_LDA(At, 0, 1); PG8_STAGE(PG8_SB(0, 0), b2, voffB); PG8_STAGE(PG8_SB(0, 1), b2 + hstep, voffB); PG8_STAGE(PG8_SA(0, 0), a2, voffA);
            PG8_WAIT_V(8); PG8_WAIT_L(0); PG8_BAR; PG8_MMA(1, 0, At, B0); PG8_MMA(1, 1, At, B1); PG8_BAR; PG8_SCHED;
            PG8_LDB(B0, 1, 0); PG8_LDB(B1, 1, 1); PG8_SCHED; PG8_LDA(At, 1, 0); PG8_STAGE(PG8_SA(0, 1), a2 + hstep, voffA);
            PG8_WAIT_V(8); PG8_WAIT_L(0); PG8_BAR; PG8_MMA(0, 0, At, B0); PG8_MMA(0, 1, At, B1); PG8_BAR; PG8_SCHED;
            PG8_LDA(At, 1, 1); PG8_STAGE(PG8_SB(1, 0), b3, voffB); PG8_STAGE(PG8_SB(1, 1), b3 + hstep, voffB); PG8_STAGE(PG8_SA(1, 0), a3, voffA);
            PG8_WAIT_V(8); PG8_WAIT_L(0); PG8_BAR; PG8_MMA(1, 0, At, B0); PG8_MMA(1, 1, At, B1); PG8_BAR; PG8_SCHED;
        }
        if (wr == 0) PG8_BAR;
        E(acc, cur, wr, wc, fr, fq);
        if (!has_next) break;
#pragma unroll
        for (int a = 0; a < 2; ++a)
#pragma unroll
            for (int b = 0; b < 2; ++b)
#pragma unroll
                for (int m = 0; m < 4; ++m)
#pragma unroll
                    for (int n = 0; n < 2; ++n) acc[a][b][m][n] = (f32x4){0.f, 0.f, 0.f, 0.f};
        cur = nxt; cA = nA; cB = nB; ++ui;
        if (wr == 1) PG8_BAR;
    }
    PG8_WAIT_V(0);
    PG8_BAR;
#undef PG8_SA
#undef PG8_SB
#undef PG8_STAGE
#undef PG8_LDA
#undef PG8_LDB
#undef PG8_MMA
#undef PG8_WAIT_V
#undef PG8_WAIT_L
#undef PG8_BAR
#undef PG8_SCHED
}
}

#define XB_TMO      128
#define XB_XCNT(j)  (256  + 64 * (j))
#define XB_XSUB(j)  (1280 + 64 * (j))
#define XB_XGEN(j)  (2304 + 64 * (j))
#define XB_TOP      3328
#define XB_TOPGEN   3392
#define XCD_BAR_WORDS 3456
#define XB_SPIN_CAP (1u << 20)
DI unsigned xb_ld(unsigned* p)              { return __hip_atomic_load(p, __ATOMIC_RELAXED, __HIP_MEMORY_SCOPE_AGENT); }
DI unsigned xb_add(unsigned* p, unsigned v) { return __hip_atomic_fetch_add(p, v, __ATOMIC_RELAXED, __HIP_MEMORY_SCOPE_AGENT); }
DI unsigned xb_xcc_id() { return (unsigned)__builtin_amdgcn_s_getreg((3 << 11) | 20) & 0xFu; }
#define XB_SPIN(cond, bar) do { unsigned _sp = 0; while (cond) { __builtin_amdgcn_s_sleep(1); \
    if ((++_sp & 255u) == 0u) { if (xb_ld(&(bar)[XB_TMO])) break; if (_sp > XB_SPIN_CAP) { atomicAdd(&(bar)[XB_TMO], 1u); break; } } } } while (0)
struct XcdBarrier { unsigned* bar; unsigned x; volatile LAS unsigned* st; };
DI XcdBarrier xcd_barrier_post(unsigned* bar, volatile LAS unsigned* st) {
    XcdBarrier b; b.bar = bar; b.x = xb_xcc_id(); b.st = st;
    if (threadIdx.x == 0) (void)xb_add(&bar[XB_XCNT(b.x)], 1u);
    return b;
}
DI void xcd_barrier_complete(unsigned* bar, unsigned x, unsigned& nloc, unsigned& nx) {
    const unsigned G = gridDim.x * gridDim.y * gridDim.z;
    unsigned sum, cnt, mine, sp = 0u;
    for (;;) {
        sum = 0u; cnt = 0u; mine = 0u;
#pragma unroll
        for (unsigned j = 0; j < 16; ++j) { const unsigned c = xb_ld(&bar[XB_XCNT(j)]); sum += c; cnt += (c > 0u) ? 1u : 0u; mine = (j == x) ? c : mine; }
        if (sum == G) break;
        __builtin_amdgcn_s_sleep(1);
        if ((++sp & 255u) == 0u) { if (xb_ld(&bar[XB_TMO])) break; if (sp > XB_SPIN_CAP) { atomicAdd(&bar[XB_TMO], 1u); break; } }
    }
    nloc = mine > 0u ? mine : 1u; nx = cnt > 0u ? cnt : 1u;
}
DI void xcd_barrier(const XcdBarrier& b) {
    asm volatile("s_waitcnt vmcnt(0)" ::: "memory");
    __syncthreads();
    if (threadIdx.x == 0) {
        unsigned* bar = b.bar;
        __builtin_amdgcn_s_waitcnt(0);
        unsigned nloc = b.st[0], nx = b.st[1];
        if (nloc == 0u) { xcd_barrier_complete(bar, b.x, nloc, nx); b.st[0] = nloc; b.st[1] = nx; }
        const unsigned old = xb_add(&bar[XB_XSUB(b.x)], 1u);
        const unsigned gen = old / nloc;
        if (old + 1u == (gen + 1u) * nloc) {
            __builtin_amdgcn_fence(__ATOMIC_RELEASE, "agent");
            asm volatile("s_waitcnt vmcnt(0)" ::: "memory");
            const unsigned og = xb_add(&bar[XB_TOP], 1u);
            const unsigned tg = og / nx;
            if (og + 1u == (tg + 1u) * nx) xb_add(&bar[XB_TOPGEN], 1u);
            else XB_SPIN(xb_ld(&bar[XB_TOPGEN]) == tg, bar);
            __builtin_amdgcn_fence(__ATOMIC_ACQUIRE, "agent");
            xb_add(&bar[XB_XGEN(b.x)], 1u);
            asm volatile("s_waitcnt vmcnt(0)" ::: "memory");
        } else {
            XB_SPIN(xb_ld(&bar[XB_XGEN(b.x)]) == gen, bar);
            __builtin_amdgcn_fence(__ATOMIC_ACQUIRE, "agent");
            asm volatile("s_waitcnt vmcnt(0)" ::: "memory");
        }
    }
    __syncthreads();
}

struct Args { const float* in[31]; float* out; unsigned char* ws; int ph_lo, ph_hi, use_cg, pad; };
struct Frame {
    LAS unsigned char* lds;
    int tid, lane, wave, G, vcu, gw, ngw, bx;
    unsigned char* ws;
};
constexpr int LDS_MISC = 131072;
constexpr int LDS_BARST = LDS_BYTES - 64;

DI void transpose_item(const float* __restrict__ W, int ldw, int k0, int n0, bf16_t* __restrict__ WT, size_t dst_row0, int ldt, LAS float* scr, int lane) {
#pragma unroll 4
    for (int kk = 0; kk < 64; kk += 4) {
        const int k = kk + (lane >> 4), n = 4 * (lane & 15);
        const float4 v = *(const float4*)(W + (size_t)(k0 + k) * ldw + n0 + n);
        LAS float* s = scr + k * 65 + n; s[0] = v.x; s[1] = v.y; s[2] = v.z; s[3] = v.w;
    }
    LDS_WAIT();
#pragma unroll
    for (int j = 0; j < 8; ++j) {
        const int n = 8 * j + (lane >> 3), c = lane & 7; const LAS float* s = scr + (8 * c) * 65 + n;
        u32x4 o; o.x = cvtpk(s[0], s[65]); o.y = cvtpk(s[130], s[195]); o.z = cvtpk(s[260], s[325]); o.w = cvtpk(s[390], s[455]);
        *(u32x4*)(WT + (dst_row0 + n) * ldt + k0 + 8 * c) = o;
    }
    LDS_WAIT();
}
constexpr int IT_WIN = 16 * 42, IT_WOUT = 16 * 16, IT_SMALL = IT_WIN + IT_WOUT;
constexpr int IT_EXP = 128 * 3, IT_MOE = NE * IT_EXP;
DI void conv_small_item(const Frame& F, const float* w_in, const float* w_out, int l, int it, LAS float* scr) {
    bf16_t* WIN = (bf16_t*)(F.ws + WS_WIN + (size_t)l * WIN_LAYER);
    if (it < IT_WIN) {
        const int kt = it / 42, nt = it % 42, n0 = 64 * nt;
        size_t drow;
        if (n0 < 768) drow = n0; else if (n0 < 1152) drow = 2304 + (n0 - 768); else drow = n0 - 384;
        transpose_item(w_in + (size_t)l * D * INW, INW, 64 * kt, n0, WIN, drow, D, scr, F.lane);
    } else {
        const int r = it - IT_WIN, kt = r >> 4, nt = r & 15;
        transpose_item(w_out + (size_t)l * D * D, D, 64 * kt, 64 * nt, (bf16_t*)(F.ws + WS_WOUT) + (size_t)l * D * D, 64 * nt, D, scr, F.lane);
    }
}
DI void conv_moe_item(const Frame& F, const float* wg, const float* wu, const float* wd, int l, int it, LAS float* scr) {
    const int e = it / IT_EXP, r = it % IT_EXP, which = r >> 7, q = r & 127;
    bf16_t* WGU = (bf16_t*)(F.ws + WS_WGU) + (size_t)e * D * D;
    if (which < 2) {
        const int kt = q >> 3, nt = q & 7, n0 = 64 * nt;
        const float* src = (which ? wu : wg) + ((size_t)l * NE + e) * D * DE;
        const size_t drow = (size_t)(n0 >> 7) * 256 + (which ? 128 : 0) + (n0 & 127);
        transpose_item(src, DE, 64 * kt, n0, WGU, drow, D, scr, F.lane);
    } else {
        const int kt = q >> 4, nt = q & 15;
        transpose_item(wd + ((size_t)l * NE + e) * DE * D, D, 64 * kt, 64 * nt, (bf16_t*)(F.ws + WS_WD) + (size_t)e * D * DE, 64 * nt, DE, scr, F.lane);
    }
}
DI void p0_prologue(const Frame& F, const Args& a) {
    const float* c = a.in[1]; const float* w_mod = a.in[2]; const float* b_mod = a.in[3];
    if (F.bx < L * (MODW / 64)) {
        LAS float* sc = (LAS float*)(F.lds);
        LAS float* red = (LAS float*)(F.lds + 8192);
        for (int i = F.tid; i < NB * D; i += NTHREADS) { const float v = c[i]; sc[i] = v / (1.f + expf(-v)); }
        __syncthreads();
        const int l = F.bx / (MODW / 64), cb = F.bx % (MODW / 64), n = cb * 64 + F.lane;
        const float* w = w_mod + (size_t)l * D * MODW + n;
        float a0 = 0.f, a1 = 0.f;
#pragma unroll 8
        for (int k = F.wave * 128; k < F.wave * 128 + 128; ++k) { const float wv = w[(size_t)k * MODW]; a0 += sc[k] * wv; a1 += sc[D + k] * wv; }
        red[(F.wave * 2 + 0) * 64 + F.lane] = a0; red[(F.wave * 2 + 1) * 64 + F.lane] = a1;
        __syncthreads();
        if (F.tid < 128) { const int b = F.tid >> 6, ln = F.tid & 63; float s = 0.f;
#pragma unroll
            for (int w8 = 0; w8 < 8; ++w8) s += red[(w8 * 2 + b) * 64 + ln];
            const int nn = cb * 64 + ln;
            ((float*)(F.ws + WS_MOD))[(size_t)(l * NB + b) * MODW + nn] = s + b_mod[l * MODW + nn]; }
        __syncthreads();
    }
    { const int nzero = L * 128 * D / 8;
      for (int i = F.gw * 64 + F.lane; i < nzero; i += F.ngw * 64) { const int l = i / (128 * D / 8), r = i % (128 * D / 8);
          *(u32x4*)((bf16_t*)(F.ws + WS_WIN + (size_t)l * WIN_LAYER) + (size_t)(2304 + 384) * D + (size_t)r * 8) = (u32x4){0u, 0u, 0u, 0u}; } }
    LAS float* scr = (LAS float*)(F.lds + 16384) + F.wave * (64 * 65);
    for (int it = F.gw; it < L * IT_SMALL; it += F.ngw) conv_small_item(F, a.in[4], a.in[19], it / IT_SMALL, it % IT_SMALL, scr);
}

DI void row_ln(f32x4 (&v)[4], float& mean_out, float& rstd_out) {
    float s = 0.f;
#pragma unroll
    for (int j = 0; j < 4; ++j) s += (v[j][0] + v[j][1]) + (v[j][2] + v[j][3]);
    const float mean = wave_sum(s) * (1.f / D); float q = 0.f;
#pragma unroll
    for (int j = 0; j < 4; ++j) { v[j] = v[j] - mean; q += (v[j][0] * v[j][0] + v[j][1] * v[j][1]) + (v[j][2] * v[j][2] + v[j][3] * v[j][3]); }
    mean_out = mean; rstd_out = 1.f / sqrtf(wave_sum(q) * (1.f / D) + LN_EPS);
}
DI void row_mod_store(f32x4 (&v)[4], const float* md, int off_sh, int off_sc, bf16_t* urow, int lane) {
    float mean, rstd; row_ln(v, mean, rstd);
#pragma unroll
    for (int j = 0; j < 4; ++j) { const int col = 4 * lane + 256 * j;
        const f32x4 scv = *(const f32x4*)(md + off_sc + col), shv = *(const f32x4*)(md + off_sh + col);
        v[j] = v[j] * rstd * (1.f + scv) + shv;
        u32x2 w; w.x = cvtpk(v[j][0], v[j][1]); w.y = cvtpk(v[j][2], v[j][3]);
        *(u32x2*)(urow + col) = w; }
}
DI void p_r0(const Frame& F, const float* x) {
    const float* MOD = (const float*)(F.ws + WS_MOD);
    bf16_t* U = (bf16_t*)(F.ws + WS_U);
    for (int row = F.gw; row < T; row += F.ngw) {
        f32x4 v[4];
#pragma unroll
        for (int j = 0; j < 4; ++j) v[j] = *(const f32x4*)(x + (size_t)row * D + 4 * F.lane + 256 * j);
        row_mod_store(v, MOD + (size_t)(row / S) * MODW, 0, D, U + (size_t)row * D, F.lane);
    }
}

DI void p_rowpass1(const Frame& F, const Args& a, int l, const float* xin) {
    const float* MODl = (const float*)(F.ws + WS_MOD) + (size_t)l * NB * MODW;
    const bf16_t* MIX = (const bf16_t*)(F.ws + WS_MIX);
    float* XA = (float*)(F.ws + WS_XA); bf16_t* U = (bf16_t*)(F.ws + WS_U);
    const float* gain = a.in[20] + (size_t)l * D; const float* bias = a.in[21] + (size_t)l * D;
    const float* wg = a.in[24] + (size_t)l * D * NG; const float* bg = a.in[25] + (size_t)l * NG;
    const float* we = a.in[26] + (size_t)l * D * NE; const float* be = a.in[27] + (size_t)l * NE;
    unsigned* CNT = (unsigned*)(F.ws + WS_CTL) + CW_CNT + l * NE;
    int* ELIST = (int*)(F.ws + WS_ELIST); float* EW = (float*)(F.ws + WS_EW); int* TOKSLOT = (int*)(F.ws + WS_TOKSLOT);
    LAS float* RT = (LAS float*)F.lds;
    for (int i = F.tid; i < D * 9; i += NTHREADS) { const int k = i / 9, q = i % 9;
        const f32x4 v = q == 0 ? *(const f32x4*)(wg + (size_t)k * NG) : *(const f32x4*)(we + (size_t)k * NE + 4 * (q - 1));
        const int n0 = q == 0 ? 0 : 4 * q;
        RT[(n0 + 0) * D + k] = v[0]; RT[(n0 + 1) * D + k] = v[1]; RT[(n0 + 2) * D + k] = v[2]; RT[(n0 + 3) * D + k] = v[3]; }
    __syncthreads();
    for (int rp = F.gw; rp < T / 2; rp += F.ngw) {
        const int row0 = 2 * rp; const float* md = MODl + (size_t)(row0 / S) * MODW;
        f32x4 va[4], vb[4];
#pragma unroll
        for (int j = 0; j < 4; ++j) { const int col = 4 * F.lane + 256 * j;
            const f32x4 g = *(const f32x4*)(md + 2 * D + col);
            const f32x4 xa = *(const f32x4*)(xin + (size_t)row0 * D + col), xb = *(const f32x4*)(xin + (size_t)(row0 + 1) * D + col);
            const u32x2 ma = *(const u32x2*)(MIX + (size_t)row0 * D + col), mb = *(const u32x2*)(MIX + (size_t)(row0 + 1) * D + col);
            va[j] = xa * ALPHA + g * (f32x4){bflo(ma.x), bfhi(ma.x), bflo(ma.y), bfhi(ma.y)};
            vb[j] = xb * ALPHA + g * (f32x4){bflo(mb.x), bfhi(mb.x), bflo(mb.y), bfhi(mb.y)}; }
        float mean, rstd;
        row_ln(va, mean, rstd);
#pragma unroll
        for (int j = 0; j < 4; ++j) { const int col = 4 * F.lane + 256 * j; va[j] = va[j] * rstd * *(const f32x4*)(gain + col) + *(const f32x4*)(bias + col); *(f32x4*)(XA + (size_t)row0 * D + col) = va[j]; }
        row_ln(vb, mean, rstd);
#pragma unroll
        for (int j = 0; j < 4; ++j) { const int col = 4 * F.lane + 256 * j; vb[j] = vb[j] * rstd * *(const f32x4*)(gain + col) + *(const f32x4*)(bias + col); *(f32x4*)(XA + (size_t)(row0 + 1) * D + col) = vb[j]; }
        row_mod_store(va, md, 3 * D, 4 * D, U + (size_t)row0 * D, F.lane);
        row_mod_store(vb, md, 3 * D, 4 * D, U + (size_t)(row0 + 1) * D, F.lane);
        LAS float* lg = (LAS float*)(F.lds + 36 * D * 4) + F.wave * 72;
#pragma unroll 1
        for (int n = 0; n < 36; ++n) { float sa = 0.f, sb = 0.f;
#pragma unroll
            for (int j = 0; j < 4; ++j) { const f32x4 w = *(const LAS f32x4*)(RT + n * D + 4 * F.lane + 256 * j);
                sa += (va[j][0] * w[0] + va[j][1] * w[1]) + (va[j][2] * w[2] + va[j][3] * w[3]);
                sb += (vb[j][0] * w[0] + vb[j][1] * w[1]) + (vb[j][2] * w[2] + vb[j][3] * w[3]); }
            sa = wave_sum(sa); sb = wave_sum(sb);
            if (F.lane == 0) { lg[n] = sa; lg[36 + n] = sb; } }
        LDS_WAIT();
#pragma unroll
        for (int rr = 0; rr < 2; ++rr) {
            float gl[4], el[32];
#pragma unroll
            for (int n = 0; n < 4; ++n) gl[n] = lg[36 * rr + n] + bg[n];
#pragma unroll
            for (int n = 0; n < 32; ++n) el[n] = lg[36 * rr + 4 + n] + be[n];
            int gi = 0; float gm = gl[0];
#pragma unroll
            for (int n = 1; n < 4; ++n) if (gl[n] > gm) { gm = gl[n]; gi = n; }
            float se = 0.f;
#pragma unroll
            for (int n = 0; n < 4; ++n) se += expf(gl[n] - gm);
            const float pg = 1.f / se;
            float l1 = -3.0e38f, l2 = -3.0e38f; int i1 = 0, i2 = 0;
#pragma unroll
            for (int n = 0; n < 32; ++n) if ((n >> 3) == gi) { const float v = el[n]; const int e = n & 7;
                if (v > l1) { l2 = l1; i2 = i1; l1 = v; i1 = e; } else if (v > l2) { l2 = v; i2 = e; } }
            const float e2 = expf(l2 - l1); const float w1 = pg / (1.f + e2), w2 = pg * e2 / (1.f + e2);
            if (F.lane == 0) {
                const int tok = row0 + rr, ea = gi * EPG + i1, eb = gi * EPG + i2;
                const unsigned pa = atomicAdd(&CNT[ea], 1u), pb = atomicAdd(&CNT[eb], 1u);
                ELIST[ea * T + pa] = tok; EW[ea * T + pa] = w1; ELIST[eb * T + pb] = tok; EW[eb * T + pb] = w2;
                TOKSLOT[tok * 2] = ea * T + (int)pa; TOKSLOT[tok * 2 + 1] = eb * T + (int)pb;
            }
        }
    }
}

DI void build_tables(const Frame& F, int l, LAS int* tb) {
    if (F.tid == 0) {
        const unsigned* CNT = (const unsigned*)(F.ws + WS_CTL) + CW_CNT + l * NE;
        int cum = 0, off = 0, nt = 0;
        for (int e = 0; e < NE; ++e) { const int c = (int)__hip_atomic_load(CNT + e, __ATOMIC_RELAXED, __HIP_MEMORY_SCOPE_AGENT);
            tb[e] = cum; tb[33 + e] = off; const int tl = (c + 255) >> 8;
            for (int t2 = 0; t2 < tl; ++t2) tb[66 + nt + t2] = e;
            nt += tl; cum += c; off += tl * 256; }
        tb[32] = cum; tb[65] = nt;
    }
    __syncthreads();
}
DI void p_gather(const Frame& F, int l) {
    LAS int* tb = (LAS int*)(F.lds + LDS_MISC);
    build_tables(F, l, tb);
    const int* ELIST = (const int*)(F.ws + WS_ELIST); const float* EW = (const float*)(F.ws + WS_EW);
    const bf16_t* U = (const bf16_t*)(F.ws + WS_U); bf16_t* XS = (bf16_t*)(F.ws + WS_XS); float* SLOTW = (float*)(F.ws + WS_SLOTW);
    for (int as = F.gw; as < 2 * T; as += F.ngw) {
        int e = 0;
#pragma unroll 1
        for (int q = 1; q < NE; ++q) if (as >= tb[q]) e = q;
        const int pos = as - tb[e], slot = tb[33 + e] + pos, tok = ELIST[e * T + pos];
        const u32x4* src = (const u32x4*)(U + (size_t)tok * D); u32x4* dst = (u32x4*)(XS + (size_t)slot * D);
        dst[F.lane] = src[F.lane]; dst[64 + F.lane] = src[64 + F.lane];
        if (F.lane == 0) SLOTW[slot] = EW[e * T + pos];
    }
}
DI void p_rowpass2(const Frame& F, const Args& a, int l, float* xout) {
    LAS int* tb = (LAS int*)(F.lds + LDS_MISC);
    build_tables(F, l, tb);
    const float* MOD = (const float*)(F.ws + WS_MOD);
    const float* XA = (const float*)(F.ws + WS_XA); const bf16_t* YS = (const bf16_t*)(F.ws + WS_YS); const int* TOKSLOT = (const int*)(F.ws + WS_TOKSLOT);
    const float* gain = a.in[22] + (size_t)l * D; const float* bias = a.in[23] + (size_t)l * D;
    bf16_t* U = (bf16_t*)(F.ws + WS_U);
    for (int row = F.gw; row < T; row += F.ngw) {
        const float* md = MOD + (size_t)(l * NB + row / S) * MODW;
        const int t0 = TOKSLOT[row * 2], t1 = TOKSLOT[row * 2 + 1];
        const int s0 = tb[33 + (t0 >> 14)] + (t0 & 16383), s1 = tb[33 + (t1 >> 14)] + (t1 & 16383);
        f32x4 v[4];
#pragma unroll
        for (int j = 0; j < 4; ++j) { const int col = 4 * F.lane + 256 * j;
            const f32x4 g = *(const f32x4*)(md + 5 * D + col), xv = *(const f32x4*)(XA + (size_t)row * D + col);
            const u32x2 y0 = *(const u32x2*)(YS + (size_t)s0 * D + col), y1 = *(const u32x2*)(YS + (size_t)s1 * D + col);
            const f32x4 f = (f32x4){bflo(y0.x) + bflo(y1.x), bfhi(y0.x) + bfhi(y1.x), bflo(y0.y) + bflo(y1.y), bfhi(y0.y) + bfhi(y1.y)};
            v[j] = xv * ALPHA + g * f; }
        float mean, rstd; row_ln(v, mean, rstd);
#pragma unroll
        for (int j = 0; j < 4; ++j) { const int col = 4 * F.lane + 256 * j; v[j] = v[j] * rstd * *(const f32x4*)(gain + col) + *(const f32x4*)(bias + col); *(f32x4*)(xout + (size_t)row * D + col) = v[j]; }
        if (l + 1 < L) row_mod_store(v, MOD + (size_t)((l + 1) * NB + row / S) * MODW, 0, D, U + (size_t)row * D, F.lane);
    }
}

#define MFMA16(a, b, c) __builtin_amdgcn_mfma_f32_16x16x32_bf16((a), (b), (c), 0, 0, 0)
#define MFMA32(a, b, c) __builtin_amdgcn_mfma_f32_32x32x16_bf16((a), (b), (c), 0, 0, 0)
constexpr int RB = 9216;
#define BUF(i) ((i) * RB)
constexpr int LWOFF = BUF(12), ZAOFF = BUF(0), SEGOFF = BUF(14), SEGXOFF = BUF(14) + 2048, TOTOFF = BUF(14) + 4096, NABFOFF = BUF(15), PCOFF = 16 * RB;
struct RwP { const float *conv, *w0, *w_up, *a0, *a_up, *g_up, *k_k, *k_a, *r_k, *gn_gain, *gn_bias; };

DI bf16x8 ldfrag(const LAS unsigned char* lds, int buf, int row, int ks, int lane) { return *(const LAS bf16x8*)(lds + buf + row * 144 + (32 * ks + 8 * (lane >> 4)) * 2); }
DI f32x4 mm64(const LAS unsigned char* lds, int abuf, int arow0, int bbuf, int brow0, int lane) {
    f32x4 acc = (f32x4){0.f, 0.f, 0.f, 0.f};
#pragma unroll
    for (int ks = 0; ks < 2; ++ks) acc = MFMA16(ldfrag(lds, abuf, arow0 + (lane & 15), ks, lane), ldfrag(lds, bbuf, brow0 + (lane & 15), ks, lane), acc);
    return acc;
}
DI u32x2 pack4(const f32x4 v) { u32x2 w; w.x = cvtpk(v[0], v[1]); w.y = cvtpk(v[2], v[3]); return w; }
DI f32x4 unpack4(const u32x2 w) { return (f32x4){bflo(w.x), bfhi(w.x), bflo(w.y), bfhi(w.y)}; }
DI void st4(LAS unsigned char* lds, int buf, int row, int col, const f32x4 v) { *(LAS u32x2*)(lds + buf + row * 144 + col * 2) = pack4(v); }
DI f32x4 ld4(const LAS unsigned char* lds, int buf, int row, int col) { return unpack4(*(const LAS u32x2*)(lds + buf + row * 144 + col * 2)); }
DI void st1(LAS unsigned char* lds, int buf, int row, int col, float v) { *(LAS bf16_t*)(lds + buf + row * 144 + col * 2) = f2bf(v); }
DI float fast_tanh(float x) { const float e = __expf(2.f * x); return 1.f - 2.f / (1.f + e); }

#define OPQZ(z) int z; asm volatile("s_mov_b32 %0, 0" : "=s"(z))
DI void rwkv_local_unit(const Frame& F, const Args& a, const int l, const int unit) {
    LAS unsigned char* lds = F.lds;
    const int tid = F.tid, lane = F.lane, wave = F.wave;
    const int c = unit % NCH, hd = (unit / NCH) % BH, b = (unit / (NCH * BH)) % NB, dir = unit / (NCH * BH * NB);
    const bf16_t* HBp = (const bf16_t*)(F.ws + WS_HB);
    const int u = tid >> 3, jg = tid & 7, tau = dir ? 63 - u : u, tloc = 64 * c + u;
    const size_t tok = (size_t)b * S + tloc;
    const int tn = wave & 3, tm0 = 2 * (wave >> 2), g4 = lane >> 4, l15 = lane & 15;
    {
        const bf16_t* hrow = HBp + tok * HW;
        const u32x2 wv = *(const u32x2*)(hrow + HWL + 4 * jg), av = *(const u32x2*)(hrow + HAL + 4 * jg);
        const f32x4 wf = unpack4(wv);
        *(LAS u32x2*)(lds + BUF(8) + tau * 144 + (4 * jg) * 2) = pack4((f32x4){fast_tanh(wf[0]), fast_tanh(wf[1]), fast_tanh(wf[2]), fast_tanh(wf[3])});
        *(LAS u32x2*)(lds + BUF(8) + tau * 144 + (32 + 4 * jg) * 2) = av;
        const u32x4 gv = *(const u32x4*)(hrow + HGL + 8 * jg);
        u32x4 so; so.x = cvtpk(sigm(bflo(gv.x)), sigm(bfhi(gv.x))); so.y = cvtpk(sigm(bflo(gv.y)), sigm(bfhi(gv.y))); so.z = cvtpk(sigm(bflo(gv.z)), sigm(bfhi(gv.z))); so.w = cvtpk(sigm(bflo(gv.w)), sigm(bfhi(gv.w)));
        *(LAS u32x4*)(lds + BUF(9) + tau * 144 + 16 * jg) = so;
        OPQZ(z0);
        { const int m = tid >> 4, j4 = (tid & 15) * 4;
          const float* w_up = a.in[8 + z0] + (size_t)l * 2 * RW * BW; const float* a_up = a.in[10 + z0] + (size_t)l * 2 * RA * BW;
          const f32x4 w4 = *(const f32x4*)(w_up + (size_t)(dir * RW + m) * BW + hd * HD + j4), a4 = *(const f32x4*)(a_up + (size_t)(dir * RA + m) * BW + hd * HD + j4);
#pragma unroll
          for (int e = 0; e < 4; ++e) { st1(lds, BUF(10), j4 + e, m, w4[e]); st1(lds, BUF(10), j4 + e, 32 + m, a4[e]); } }
        { const int m = tid >> 3, i8 = (tid & 7) * 8;
          const float* g_up = a.in[11 + z0] + (size_t)l * RG * BW;
          const f32x4 g0 = *(const f32x4*)(g_up + (size_t)m * BW + hd * HD + i8), g1 = *(const f32x4*)(g_up + (size_t)m * BW + hd * HD + i8 + 4);
#pragma unroll
          for (int e = 0; e < 4; ++e) { st1(lds, BUF(11), i8 + e, m, g0[e]); st1(lds, BUF(11), i8 + 4 + e, m, g1[e]); } }
    }
    __syncthreads();
#pragma unroll
    for (int tmi = 0; tmi < 2; ++tmi) {
        const int tm = tm0 + tmi; const f32x4 z = (f32x4){0.f, 0.f, 0.f, 0.f};
        const f32x4 zw = MFMA16(ldfrag(lds, BUF(10), 16 * tm + l15, 0, lane), ldfrag(lds, BUF(8), 16 * tn + l15, 0, lane), z);
        const f32x4 za = MFMA16(ldfrag(lds, BUF(10), 16 * tm + l15, 1, lane), ldfrag(lds, BUF(8), 16 * tn + l15, 1, lane), z);
        const int trow = 16 * tn + l15, jb = 16 * tm + 4 * g4;
        *(LAS f32x4*)(lds + LWOFF + (trow * 64 + jb) * 4) = zw;
        *(LAS f32x4*)(lds + ZAOFF + (trow * 64 + jb) * 4) = za;
        if (dir == 0) {
            const f32x4 gg = mm64(lds, BUF(11), 16 * tm, BUF(9), 16 * tn, lane);
            *(u32x2*)((bf16_t*)(F.ws + WS_GB) + ((size_t)b * S + 64 * c + trow) * BW + hd * HD + jb) = pack4(gg);
        }
    }
    __syncthreads();
    const int ch0 = hd * HD + 8 * jg;
    float r[8], kd[8], kap[8], bb[8], lw[8];
    {
        OPQZ(z1);
        const float* Pconv = a.in[6 + z1] + (size_t)l * 3 * 3 * BW;
        float k[8], v[8];
#pragma unroll
        for (int e = 0; e < 8; ++e) { r[e] = 0.f; k[e] = 0.f; v[e] = 0.f; }
#pragma unroll 1
        for (int x = 0; x < 3; ++x) {
            const int tt = tloc + x - 1;
            if (tt >= 0 && tt < S) {
                const bf16_t* hp = HBp + ((size_t)b * S + tt) * HW + HR + ch0;
                const u32x4 rr = *(const u32x4*)hp, kk2 = *(const u32x4*)(hp + BW), vv = *(const u32x4*)(hp + 2 * BW);
                const float* cw = Pconv + x * 3 * BW + ch0;
                const f32x4 cr0 = *(const f32x4*)cw, cr1 = *(const f32x4*)(cw + 4), ck0 = *(const f32x4*)(cw + BW), ck1 = *(const f32x4*)(cw + BW + 4), cv0 = *(const f32x4*)(cw + 2 * BW), cv1 = *(const f32x4*)(cw + 2 * BW + 4);
                r[0] += bflo(rr.x) * cr0[0]; r[1] += bfhi(rr.x) * cr0[1]; r[2] += bflo(rr.y) * cr0[2]; r[3] += bfhi(rr.y) * cr0[3];
                r[4] += bflo(rr.z) * cr1[0]; r[5] += bfhi(rr.z) * cr1[1]; r[6] += bflo(rr.w) * cr1[2]; r[7] += bfhi(rr.w) * cr1[3];
                k[0] += bflo(kk2.x) * ck0[0]; k[1] += bfhi(kk2.x) * ck0[1]; k[2] += bflo(kk2.y) * ck0[2]; k[3] += bfhi(kk2.y) * ck0[3];
                k[4] += bflo(kk2.z) * ck1[0]; k[5] += bfhi(kk2.z) * ck1[1]; k[6] += bflo(kk2.w) * ck1[2]; k[7] += bfhi(kk2.w) * ck1[3];
                v[0] += bflo(vv.x) * cv0[0]; v[1] += bfhi(vv.x) * cv0[1]; v[2] += bflo(vv.y) * cv0[2]; v[3] += bfhi(vv.y) * cv0[3];
                v[4] += bflo(vv.z) * cv1[0]; v[5] += bfhi(vv.z) * cv1[1]; v[6] += bflo(vv.w) * cv1[2]; v[7] += bfhi(vv.w) * cv1[3];
            }
        }
        const f32x4 zw0 = *(const LAS f32x4*)(lds + LWOFF + (tau * 64 + 8 * jg) * 4), zw1 = *(const LAS f32x4*)(lds + LWOFF + (tau * 64 + 8 * jg + 4) * 4);
        const f32x4 za0 = *(const LAS f32x4*)(lds + ZAOFF + (tau * 64 + 8 * jg) * 4), za1 = *(const LAS f32x4*)(lds + ZAOFF + (tau * 64 + 8 * jg + 4) * 4);
        float ss = 0.f, bsp = 0.f, av[8];
        OPQZ(z2);
        const float* Pw0 = a.in[7 + z2] + (size_t)l * 2 * BW + dir * BW + ch0; const float* Pa0 = a.in[9 + z2] + (size_t)l * 2 * BW + dir * BW + ch0;
        const float* Pkk = a.in[12 + z2] + (size_t)l * BW + ch0; const float* Pka = a.in[13 + z2] + (size_t)l * BW + ch0; const float* Prk = a.in[14 + z2] + (size_t)l * BH * HD + ch0;
        const f32x4 w0a = *(const f32x4*)Pw0, w0b = *(const f32x4*)(Pw0 + 4), a0a = *(const f32x4*)Pa0, a0b = *(const f32x4*)(Pa0 + 4);
        const f32x4 kka = *(const f32x4*)Pkk, kkb = *(const f32x4*)(Pkk + 4), kaa = *(const f32x4*)Pka, kab = *(const f32x4*)(Pka + 4), rka = *(const f32x4*)Prk, rkb = *(const f32x4*)(Prk + 4);
#pragma unroll
        for (int e = 0; e < 8; ++e) {
            const float zw = (e < 4 ? zw0[e & 3] : zw1[e & 3]) + (e < 4 ? w0a[e & 3] : w0b[e & 3]);
            const float za = (e < 4 ? za0[e & 3] : za1[e & 3]) + (e < 4 ? a0a[e & 3] : a0b[e & 3]);
            lw[e] = -DECAY * sigm(zw); av[e] = sigm(za);
            kap[e] = k[e] * (e < 4 ? kka[e & 3] : kkb[e & 3]); ss += kap[e] * kap[e];
            kd[e] = k[e] * (1.f + (av[e] - 1.f) * (e < 4 ? kaa[e & 3] : kab[e & 3]));
            bsp += r[e] * kd[e] * (e < 4 ? rka[e & 3] : rkb[e & 3]);
        }
        ss += __shfl_xor(ss, 1); ss += __shfl_xor(ss, 2); ss += __shfl_xor(ss, 4);
        bsp += __shfl_xor(bsp, 1); bsp += __shfl_xor(bsp, 2); bsp += __shfl_xor(bsp, 4);
        const float rn = 1.f / sqrtf(fmaxf(ss, 1e-24f));
#pragma unroll
        for (int e = 0; e < 8; ++e) { kap[e] *= rn; bb[e] = kap[e] * av[e]; }
        if (jg == 0) ((float*)(F.ws + WS_BS))[((size_t)dir * T + tok) * 8 + hd] = bsp;
        *(LAS f32x4*)(lds + LWOFF + (tau * 64 + 8 * jg) * 4) = (f32x4){lw[0], lw[1], lw[2], lw[3]};
        *(LAS f32x4*)(lds + LWOFF + (tau * 64 + 8 * jg + 4) * 4) = (f32x4){lw[4], lw[5], lw[6], lw[7]};
#pragma unroll
        for (int e = 0; e < 8; ++e) st1(lds, BUF(7), 8 * jg + e, tau, v[e]);
        if (dir == 0) {
            const size_t ucidx = ((size_t)b * BH + hd) * NCH + c;
            bf16_t* vtb = (bf16_t*)(F.ws + WS_VTB) + ucidx * 4096;
#pragma unroll
            for (int e = 0; e < 8; ++e) vtb[(8 * jg + e) * 64 + u] = f2bf(v[e]);
            u32x4 vo; vo.x = cvtpk(v[0], v[1]); vo.y = cvtpk(v[2], v[3]); vo.z = cvtpk(v[4], v[5]); vo.w = cvtpk(v[6], v[7]);
            *(u32x4*)((bf16_t*)(F.ws + WS_VC) + tok * BW + ch0) = vo;
        }
    }
    __syncthreads();
    { const int seg = tid >> 6, j = tid & 63; float p = 0.f;
#pragma unroll
      for (int i = 0; i < 8; ++i) { LAS float* q = (LAS float*)(lds + LWOFF + ((8 * seg + i) * 64 + j) * 4); p += *q; *q = p; }
      *(LAS float*)(lds + SEGOFF + (seg * 64 + j) * 4) = p; }
    __syncthreads();
    if (tid < 64) { float run = 0.f;
#pragma unroll
      for (int sg = 0; sg < 8; ++sg) { *(LAS float*)(lds + SEGXOFF + (sg * 64 + tid) * 4) = run; run += *(const LAS float*)(lds + SEGOFF + (sg * 64 + tid) * 4); }
      *(LAS float*)(lds + TOTOFF + tid * 4) = run; }
    __syncthreads();
    {
        float At[8], Rt[8], Bt[8], Kt[8], Bh[8], Kh[8];
#pragma unroll
        for (int e = 0; e < 8; ++e) {
            const int j = 8 * jg + e;
            const float lwi = *(const LAS float*)(lds + LWOFF + (tau * 64 + j) * 4) + *(const LAS float*)(lds + SEGXOFF + ((tau >> 3) * 64 + j) * 4);
            const float tot = *(const LAS float*)(lds + TOTOFF + j * 4);
            const float ep = __expf(lwi - lw[e]), epl = __expf(lwi), em = __expf(-lwi), ec = __expf(tot - lwi);
            At[e] = -kap[e] * ep; Rt[e] = r[e] * epl; Bt[e] = bb[e] * em; Kt[e] = kd[e] * em; Bh[e] = bb[e] * ec; Kh[e] = kd[e] * ec;
            if (u == 0) *(LAS float*)(lds + PCOFF + j * 4) = __expf(tot);
        }
        u32x4 o;
#define PK8(X) (o.x = cvtpk(X[0], X[1]), o.y = cvtpk(X[2], X[3]), o.z = cvtpk(X[4], X[5]), o.w = cvtpk(X[6], X[7]), o)
        *(LAS u32x4*)(lds + BUF(0) + tau * 144 + 16 * jg) = PK8(At);
        *(LAS u32x4*)(lds + BUF(1) + tau * 144 + 16 * jg) = PK8(Bt);
        *(LAS u32x4*)(lds + BUF(2) + tau * 144 + 16 * jg) = PK8(Kt);
        *(LAS u32x4*)(lds + BUF(3) + tau * 144 + 16 * jg) = PK8(Rt);
#undef PK8
#pragma unroll
        for (int e = 0; e < 8; ++e) { const int j = 8 * jg + e; st1(lds, BUF(4), j, tau, At[e]); st1(lds, BUF(5), j, tau, Bh[e]); st1(lds, BUF(6), j, tau, Kh[e]); }
    }
    __syncthreads();
#pragma unroll
    for (int tmi = 0; tmi < 2; ++tmi) {
        const int tm = tm0 + tmi, mb = 16 * tm + 4 * g4, nn = 16 * tn + l15;
        { f32x4 v = mm64(lds, BUF(1), 16 * tm, BUF(0), 16 * tn, lane);
#pragma unroll
          for (int e = 0; e < 4; ++e) v[e] = (mb + e < nn) ? v[e] : 0.f;
          if (tm == tn) {
#pragma unroll
              for (int e = 0; e < 4; ++e) *(LAS float*)(lds + NABFOFF + ((mb + e) * 16 + l15) * 4) = v[e];
              v = (f32x4){0.f, 0.f, 0.f, 0.f};
          }
          st4(lds, BUF(11), nn, mb, v); }
        { f32x4 v = mm64(lds, BUF(0), 16 * tm, BUF(2), 16 * tn, lane);
#pragma unroll
          for (int e = 0; e < 4; ++e) v[e] = (nn < mb + e) ? v[e] : 0.f;
          st4(lds, BUF(8), nn, mb, v); }
        { f32x4 v = mm64(lds, BUF(1), 16 * tm, BUF(3), 16 * tn, lane);
#pragma unroll
          for (int e = 0; e < 4; ++e) v[e] = (mb + e <= nn) ? v[e] : 0.f;
          st4(lds, BUF(9), nn, mb, v); }
        { f32x4 v = mm64(lds, BUF(2), 16 * tm, BUF(3), 16 * tn, lane);
#pragma unroll
          for (int e = 0; e < 4; ++e) v[e] = (mb + e <= nn) ? v[e] : 0.f;
          st4(lds, BUF(10), nn, mb, v); }
    }
    __syncthreads();
    if (wave == 0) {
        const int blk = lane >> 4, sr = lane & 15, s = 16 * blk + sr;
        float Tr[16];
#pragma unroll
        for (int t = 0; t < 16; ++t) { float acc = (t == sr) ? 1.f : 0.f;
#pragma unroll
            for (int sp = 0; sp < t; ++sp) acc += Tr[sp] * *(const LAS float*)(lds + NABFOFF + ((16 * blk + sp) * 16 + t) * 4);
            Tr[t] = acc; }
        const u32x4 z4 = (u32x4){0u, 0u, 0u, 0u};
#pragma unroll
        for (int q = 0; q < 9; ++q) { *(LAS u32x4*)(lds + BUF(0) + s * 144 + 16 * q) = z4; *(LAS u32x4*)(lds + BUF(1) + s * 144 + 16 * q) = z4; }
        u32x4 o0, o1; o0.x = cvtpk(Tr[0], Tr[1]); o0.y = cvtpk(Tr[2], Tr[3]); o0.z = cvtpk(Tr[4], Tr[5]); o0.w = cvtpk(Tr[6], Tr[7]);
        o1.x = cvtpk(Tr[8], Tr[9]); o1.y = cvtpk(Tr[10], Tr[11]); o1.z = cvtpk(Tr[12], Tr[13]); o1.w = cvtpk(Tr[14], Tr[15]);
        LDS_WAIT();
        *(LAS u32x4*)(lds + BUF(0) + s * 144 + 32 * blk) = o0; *(LAS u32x4*)(lds + BUF(0) + s * 144 + 32 * blk + 16) = o1;
#pragma unroll
        for (int t = 0; t < 16; ++t) st1(lds, BUF(1), 16 * blk + t, s, Tr[t]);
    }
    __syncthreads();
#pragma unroll
    for (int tmi = 0; tmi < 2; ++tmi) {
        const int tm = tm0 + tmi, mb = 16 * tm + 4 * g4, nn = 16 * tn + l15;
        const f32x4 v = mm64(lds, BUF(0), 16 * tm, BUF(11), 16 * tn, lane);
        st4(lds, BUF(12), nn, mb, v);
#pragma unroll
        for (int e = 0; e < 4; ++e) st1(lds, BUF(2), mb + e, nn, v[e]);
    }
    __syncthreads();
#pragma unroll
    for (int tmi = 0; tmi < 2; ++tmi) {
        const int tm = tm0 + tmi, mb = 16 * tm + 4 * g4, nn = 16 * tn + l15;
        const f32x4 v = mm64(lds, BUF(12), 16 * tm, BUF(2), 16 * tn, lane);
        st4(lds, BUF(13), nn, mb, v);
    }
    __syncthreads();
#pragma unroll
    for (int tmi = 0; tmi < 2; ++tmi) {
        const int tm = tm0 + tmi, mb = 16 * tm + 4 * g4, nn = 16 * tn + l15;
        const f32x4 v = mm64(lds, BUF(13), 16 * tm, BUF(1), 16 * tn, lane) + ld4(lds, BUF(1), nn, mb);
        st4(lds, BUF(14), nn, mb, v);
    }
    __syncthreads();
#pragma unroll
    for (int tmi = 0; tmi < 2; ++tmi) {
        const int tm = tm0 + tmi, mb = 16 * tm + 4 * g4, nn = 16 * tn + l15;
        const f32x4 v = mm64(lds, BUF(2), 16 * tm, BUF(14), 16 * tn, lane) + ld4(lds, BUF(14), nn, mb);
        st4(lds, BUF(15), nn, mb, v);
    }
    __syncthreads();
#pragma unroll
    for (int tmi = 0; tmi < 2; ++tmi) {
        const int tm = tm0 + tmi, mb = 16 * tm + 4 * g4, nn = 16 * tn + l15;
        const f32x4 x1 = mm64(lds, BUF(15), 16 * tm, BUF(4), 16 * tn, lane);
        const f32x4 x2 = mm64(lds, BUF(15), 16 * tm, BUF(8), 16 * tn, lane);
        st4(lds, BUF(0), nn, mb, x1); st4(lds, BUF(1), nn, mb, x2);
    }
    __syncthreads();
    {
        bf16_t* QT = (bf16_t*)(F.ws + WS_QT) + (size_t)unit * 4096; bf16_t* WT = (bf16_t*)(F.ws + WS_WT) + (size_t)unit * 4096; bf16_t* MP = (bf16_t*)(F.ws + WS_MP) + (size_t)unit * 4096;
#pragma unroll
        for (int tmi = 0; tmi < 2; ++tmi) {
            const int tm = tm0 + tmi, mb = 16 * tm + 4 * g4, nn = 16 * tn + l15;
            { const f32x4 v = mm64(lds, BUF(0), 16 * tm, BUF(9), 16 * tn, lane) + ld4(lds, BUF(3), nn, mb);
              *(u32x2*)(QT + (dir ? 63 - nn : nn) * 64 + mb) = pack4(v); }
            { const f32x4 v = mm64(lds, BUF(1), 16 * tm, BUF(9), 16 * tn, lane) + ld4(lds, BUF(10), nn, mb);
              if (dir) *(u32x2*)(WT + (63 - nn) * 64 + (60 - mb)) = pack4((f32x4){v[3], v[2], v[1], v[0]});
              else *(u32x2*)(WT + nn * 64 + mb) = pack4(v); }
            { f32x4 v = mm64(lds, BUF(0), 16 * tm, BUF(5), 16 * tn, lane);
#pragma unroll
              for (int e = 0; e < 4; ++e) if (mb + e == nn) v[e] += *(const LAS float*)(lds + PCOFF + nn * 4);
              *(u32x2*)(MP + nn * 64 + swap23(mb)) = pack4(v); }
            { const f32x4 v = mm64(lds, BUF(1), 16 * tm, BUF(5), 16 * tn, lane) + ld4(lds, BUF(6), nn, mb);
              st4(lds, BUF(2), nn, mb, v); }
        }
    }
    __syncthreads();
    {
        f32x4* NBp = (f32x4*)(F.ws + WS_NB);
#pragma unroll
        for (int tmi = 0; tmi < 2; ++tmi) {
            const int tm = tm0 + tmi, mb = 16 * tm + 4 * g4, ii = 16 * tn + l15;
            const f32x4 v = mm64(lds, BUF(2), 16 * tm, BUF(7), 16 * tn, lane);
            const int jb = mb >> 5, jl = mb & 31, q = jl >> 3, hic = (jl >> 2) & 1, ih = ii >> 5, Lc = (ii & 31) + 32 * hic;
            NBp[((((size_t)unit * 2 + ih) * 2 + jb) * 4 + q) * 64 + Lc] = v;
        }
    }
    __syncthreads();
}

DI void attn_unit(const Frame& F, const LAS float* rpbl, const int au) {
    const bf16_t* HBp = (const bf16_t*)(F.ws + WS_HB); const bf16_t* VTp = (const bf16_t*)(F.ws + WS_VT); bf16_t* CONCAT = (bf16_t*)(F.ws + WS_CONCAT);
    const int hh = au % AH, r = (au / AH) % ROWS, b = au / (AH * ROWS);
    int rstart = r - KH / 2; rstart = rstart < 0 ? 0 : (rstart > ROWS - KH ? ROWS - KH : rstart);
    const int lane = F.lane, q32 = lane & 31, hi = lane >> 5;
    const float SC = 0.125f * LOG2E;
    const int krow_off = swap23(q32);
#pragma unroll 1
    for (int qb = 0; qb < 2; ++qb) {
        const int cq = 32 * qb + q32; int cs = cq - KW / 2; cs = cs < 0 ? 0 : (cs > GW - KW ? GW - KW : cs);
        const size_t tokq = (size_t)b * S + r * GW + cq;
        bf16x8 qf[4];
#pragma unroll
        for (int ds = 0; ds < 4; ++ds) qf[ds] = *(const bf16x8*)(HBp + tokq * HW + HQ + hh * HD + 16 * ds + 8 * hi);
        f32x16 o0, o1;
#pragma unroll
        for (int i = 0; i < 16; ++i) { o0[i] = 0.f; o1[i] = 0.f; }
        float mrun = -1e30f, lsum = 0.f;
#pragma unroll 1
        for (int kt = 0; kt < 2 * KH; ++kt) {
            const int kr = rstart + (kt >> 1), ckb = 32 * (kt & 1);
            const size_t ktok = (size_t)b * S + kr * GW + ckb;
            bf16x8 kf[4], vf[2][2];
#pragma unroll
            for (int ds = 0; ds < 4; ++ds) kf[ds] = *(const bf16x8*)(HBp + (ktok + krow_off) * HW + HK + hh * HD + 16 * ds + 8 * hi);
#pragma unroll
            for (int db = 0; db < 2; ++db)
#pragma unroll
                for (int s = 0; s < 2; ++s) vf[db][s] = *(const bf16x8*)(VTp + (size_t)(hh * HD + 32 * db + q32) * T + ktok + 16 * s + 8 * hi);
            f32x16 st;
#pragma unroll
            for (int i = 0; i < 16; ++i) st[i] = 0.f;
#pragma unroll
            for (int ds = 0; ds < 4; ++ds) st = MFMA32(kf[ds], qf[ds], st);
            const LAS float* rp = rpbl + (hh * (2 * KH - 1) + (kr - r + KH - 1)) * (2 * KW - 1);
            float sl[16]; float tmax = -1e30f;
#pragma unroll
            for (int i = 0; i < 16; ++i) {
                const int ck = ckb + 16 * (i >> 3) + 8 * hi + (i & 7);
                const bool inw = (ck >= cs) && (ck < cs + KW);
                int dc = ck - cq; dc = dc < -(KW - 1) ? -(KW - 1) : (dc > KW - 1 ? KW - 1 : dc); dc += KW - 1;
                sl[i] = inw ? st[i] * SC + rp[dc] : -1e30f;
                tmax = fmaxf(tmax, sl[i]);
            }
            tmax = fmaxf(tmax, __shfl_xor(tmax, 32));
            const float mn = fmaxf(mrun, tmax), corr = __builtin_amdgcn_exp2f(mrun - mn);
            float ps = 0.f;
#pragma unroll
            for (int i = 0; i < 16; ++i) { sl[i] = (sl[i] > -1e29f) ? __builtin_amdgcn_exp2f(sl[i] - mn) : 0.f; ps += sl[i]; }
            lsum = lsum * corr + ps; mrun = mn;
#pragma unroll
            for (int i = 0; i < 16; ++i) { o0[i] *= corr; o1[i] *= corr; }
            u32x4 p0, p1;
            p0.x = cvtpk(sl[0], sl[1]); p0.y = cvtpk(sl[2], sl[3]); p0.z = cvtpk(sl[4], sl[5]); p0.w = cvtpk(sl[6], sl[7]);
            p1.x = cvtpk(sl[8], sl[9]); p1.y = cvtpk(sl[10], sl[11]); p1.z = cvtpk(sl[12], sl[13]); p1.w = cvtpk(sl[14], sl[15]);
            const bf16x8 pf0 = __builtin_bit_cast(bf16x8, p0), pf1 = __builtin_bit_cast(bf16x8, p1);
            o0 = MFMA32(vf[0][0], pf0, o0); o0 = MFMA32(vf[0][1], pf1, o0);
            o1 = MFMA32(vf[1][0], pf0, o1); o1 = MFMA32(vf[1][1], pf1, o1);
        }
        const float inv = 1.f / (lsum + __shfl_xor(lsum, 32));
        bf16_t* op = CONCAT + tokq * D + hh * HD;
#pragma unroll
        for (int g = 0; g < 4; ++g) {
            *(u32x2*)(op + 8 * g + 4 * hi) = pack4((f32x4){o0[4 * g] * inv, o0[4 * g + 1] * inv, o0[4 * g + 2] * inv, o0[4 * g + 3] * inv});
            *(u32x2*)(op + 32 + 8 * g + 4 * hi) = pack4((f32x4){o1[4 * g] * inv, o1[4 * g + 1] * inv, o1[4 * g + 2] * inv, o1[4 * g + 3] * inv});
        }
    }
}

DI void pool_unit(const Frame& F, const float* pool_w, const float* pool_scale, const int pu) {
    const bf16_t* HBp = (const bf16_t*)(F.ws + WS_HB); bf16_t* CONCAT = (bf16_t*)(F.ws + WS_CONCAT);
    const int g = pu & 3, blk = pu >> 2, b = blk >> 8, t0 = (blk & 255) * 32;
    const int lane = F.lane, q32 = lane & 31, hi = lane >> 5, t = t0 + q32, win = 2 << g;
    int lo = t - win / 2; lo = lo < 0 ? 0 : lo; int hit = t + win / 2 - 1; hit = hit > S - 1 ? S - 1 : hit;
    const float inv = 1.f / (float)(hit - lo + 1);
    f32x16 out0, out1;
#pragma unroll
    for (int i = 0; i < 16; ++i) { out0[i] = 0.f; out1[i] = 0.f; }
    const float* pw = pool_w + (size_t)g * 64 * 64;
#pragma unroll 1
    for (int s = 0; s < 4; ++s) {
        const int c0 = HP + g * 64 + 16 * s + 8 * hi;
        float acc[8];
#pragma unroll
        for (int e = 0; e < 8; ++e) acc[e] = 0.f;
#pragma unroll 1
        for (int tt = lo; tt <= hit; ++tt) {
            const u32x4 pv = *(const u32x4*)(HBp + ((size_t)b * S + tt) * HW + c0);
            acc[0] += bflo(pv.x); acc[1] += bfhi(pv.x); acc[2] += bflo(pv.y); acc[3] += bfhi(pv.y); acc[4] += bflo(pv.z); acc[5] += bfhi(pv.z); acc[6] += bflo(pv.w); acc[7] += bfhi(pv.w);
        }
        const u32x4 pc = *(const u32x4*)(HBp + ((size_t)b * S + t) * HW + c0);
        u32x4 o;
        o.x = cvtpk(acc[0] * inv - bflo(pc.x), acc[1] * inv - bfhi(pc.x)); o.y = cvtpk(acc[2] * inv - bflo(pc.y), acc[3] * inv - bfhi(pc.y));
        o.z = cvtpk(acc[4] * inv - bflo(pc.z), acc[5] * inv - bfhi(pc.z)); o.w = cvtpk(acc[6] * inv - bflo(pc.w), acc[7] * inv - bfhi(pc.w));
        const bf16x8 bfr = __builtin_bit_cast(bf16x8, o);
        const float* wp = pw + (size_t)(16 * s + 8 * hi) * 64 + q32;
        u32x4 w0; w0.x = cvtpk(wp[0], wp[64]); w0.y = cvtpk(wp[128], wp[192]); w0.z = cvtpk(wp[256], wp[320]); w0.w = cvtpk(wp[384], wp[448]);
        u32x4 w1; w1.x = cvtpk(wp[32], wp[96]); w1.y = cvtpk(wp[160], wp[224]); w1.z = cvtpk(wp[288], wp[352]); w1.w = cvtpk(wp[416], wp[480]);
        out0 = MFMA32(__builtin_bit_cast(bf16x8, w0), bfr, out0);
        out1 = MFMA32(__builtin_bit_cast(bf16x8, w1), bfr, out1);
    }
    bf16_t* op = CONCAT + ((size_t)b * S + t) * D + AW + BW + g * 64;
    const float* ps = pool_scale + g * 64;
#pragma unroll
    for (int gq = 0; gq < 4; ++gq) {
        const int e0 = 8 * gq + 4 * hi;
        const f32x4 s0 = *(const f32x4*)(ps + e0), s1 = *(const f32x4*)(ps + 32 + e0);
        *(u32x2*)(op + e0) = pack4((f32x4){out0[4 * gq] * s0[0], out0[4 * gq + 1] * s0[1], out0[4 * gq + 2] * s0[2], out0[4 * gq + 3] * s0[3]});
        *(u32x2*)(op + 32 + e0) = pack4((f32x4){out1[4 * gq] * s1[0], out1[4 * gq + 1] * s1[1], out1[4 * gq + 2] * s1[2], out1[4 * gq + 3] * s1[3]});
    }
}

DI void scan_wave(const Frame& F, const int sw) {
    const int ihalf = sw & 1, sc = sw >> 1, dir = sc / (NB * BH);
    const int lane = F.lane, il = lane & 31, hi = lane >> 5;
    const bf16_t* MP = (const bf16_t*)(F.ws + WS_MP); const f32x4* NBp = (const f32x4*)(F.ws + WS_NB); bf16_t* S0 = (bf16_t*)(F.ws + WS_S0);
    f32x16 st0, st1;
#pragma unroll
    for (int i = 0; i < 16; ++i) { st0[i] = 0.f; st1[i] = 0.f; }
    bf16x8 ma[2][2][2]; f32x4 nb[2][4];
    auto load_step = [&](int step, bf16x8 (&m)[2][2][2], f32x4 (&n)[2][4]) {
        const int c = dir ? NCH - 1 - step : step; const size_t unit = (size_t)sc * NCH + c;
#pragma unroll
        for (int jpb = 0; jpb < 2; ++jpb) {
#pragma unroll
            for (int jb = 0; jb < 2; ++jb)
#pragma unroll
                for (int s = 0; s < 2; ++s) m[jpb][jb][s] = *(const bf16x8*)(MP + unit * 4096 + (32 * jpb + il) * 64 + 32 * jb + 16 * s + 8 * hi);
#pragma unroll
            for (int q = 0; q < 4; ++q) n[jpb][q] = NBp[(((unit * 2 + ihalf) * 2 + jpb) * 4 + q) * 64 + lane];
        }
    };
    load_step(0, ma, nb);
#pragma unroll 1
    for (int step = 0; step < NCH; ++step) {
        const int c = dir ? NCH - 1 - step : step; const size_t unit = (size_t)sc * NCH + c;
        bf16x8 mn_[2][2][2]; f32x4 nn_[2][4];
        load_step(step + 1 < NCH ? step + 1 : step, mn_, nn_);
        bf16_t* sp = S0 + unit * 4096 + (size_t)(32 * ihalf + il) * 64;
        u32x4 b00, b01, b10, b11;
        b00.x = cvtpk(st0[0], st0[1]); b00.y = cvtpk(st0[2], st0[3]); b00.z = cvtpk(st0[4], st0[5]); b00.w = cvtpk(st0[6], st0[7]);
        b01.x = cvtpk(st0[8], st0[9]); b01.y = cvtpk(st0[10], st0[11]); b01.z = cvtpk(st0[12], st0[13]); b01.w = cvtpk(st0[14], st0[15]);
        b10.x = cvtpk(st1[0], st1[1]); b10.y = cvtpk(st1[2], st1[3]); b10.z = cvtpk(st1[4], st1[5]); b10.w = cvtpk(st1[6], st1[7]);
        b11.x = cvtpk(st1[8], st1[9]); b11.y = cvtpk(st1[10], st1[11]); b11.z = cvtpk(st1[12], st1[13]); b11.w = cvtpk(st1[14], st1[15]);
        *(u32x2*)(sp + 0 + 4 * hi) = (u32x2){b00.x, b00.y};  *(u32x2*)(sp + 8 + 4 * hi) = (u32x2){b00.z, b00.w};
        *(u32x2*)(sp + 16 + 4 * hi) = (u32x2){b01.x, b01.y}; *(u32x2*)(sp + 24 + 4 * hi) = (u32x2){b01.z, b01.w};
        *(u32x2*)(sp + 32 + 4 * hi) = (u32x2){b10.x, b10.y}; *(u32x2*)(sp + 40 + 4 * hi) = (u32x2){b10.z, b10.w};
        *(u32x2*)(sp + 48 + 4 * hi) = (u32x2){b11.x, b11.y}; *(u32x2*)(sp + 56 + 4 * hi) = (u32x2){b11.z, b11.w};
        const bf16x8 p00 = __builtin_bit_cast(bf16x8, b00), p01 = __builtin_bit_cast(bf16x8, b01), p10 = __builtin_bit_cast(bf16x8, b10), p11 = __builtin_bit_cast(bf16x8, b11);
        f32x16 n0, n1;
#pragma unroll
        for (int q = 0; q < 4; ++q)
#pragma unroll
            for (int e = 0; e < 4; ++e) { n0[4 * q + e] = nb[0][q][e]; n1[4 * q + e] = nb[1][q][e]; }
        n0 = MFMA32(ma[0][0][0], p00, n0); n1 = MFMA32(ma[1][0][0], p00, n1);
        n0 = MFMA32(ma[0][0][1], p01, n0); n1 = MFMA32(ma[1][0][1], p01, n1);
        n0 = MFMA32(ma[0][1][0], p10, n0); n1 = MFMA32(ma[1][1][0], p10, n1);
        n0 = MFMA32(ma[0][1][1], p11, n0); n1 = MFMA32(ma[1][1][1], p11, n1);
        st0 = n0; st1 = n1;
#pragma unroll
        for (int a = 0; a < 2; ++a) {
#pragma unroll
            for (int bq = 0; bq < 2; ++bq)
#pragma unroll
                for (int s = 0; s < 2; ++s) ma[a][bq][s] = mn_[a][bq][s];
#pragma unroll
            for (int q = 0; q < 4; ++q) nb[a][q] = nn_[a][q];
        }
    }
}

DI void rwkv_out_unit(const Frame& F, const RwP& P, const int du) {
    const int qd = du & 3, cidx = du >> 2, c = cidx % NCH, hd = (cidx / NCH) % BH, b = cidx / (NCH * BH);
    const int lane = F.lane, n = lane & 15, g = lane >> 4, u = 16 * qd + n;
    const bf16_t* QT = (const bf16_t*)(F.ws + WS_QT); const bf16_t* WT = (const bf16_t*)(F.ws + WS_WT); const bf16_t* S0 = (const bf16_t*)(F.ws + WS_S0);
    const bf16_t* VTB = (const bf16_t*)(F.ws + WS_VTB) + (size_t)cidx * 4096;
    f32x4 acc[4];
#pragma unroll
    for (int tm = 0; tm < 4; ++tm) acc[tm] = (f32x4){0.f, 0.f, 0.f, 0.f};
#pragma unroll
    for (int dir = 0; dir < 2; ++dir) {
        const size_t unit = (((size_t)dir * NB + b) * BH + hd) * NCH + c;
#pragma unroll
        for (int ks = 0; ks < 2; ++ks) {
            const bf16x8 bq = *(const bf16x8*)(QT + unit * 4096 + u * 64 + 32 * ks + 8 * g);
            const bf16x8 bw = *(const bf16x8*)(WT + unit * 4096 + u * 64 + 32 * ks + 8 * g);
#pragma unroll
            for (int tm = 0; tm < 4; ++tm) {
                const bf16x8 as = *(const bf16x8*)(S0 + unit * 4096 + (16 * tm + n) * 64 + 32 * ks + 8 * g);
                const bf16x8 av = *(const bf16x8*)(VTB + (16 * tm + n) * 64 + 32 * ks + 8 * g);
                acc[tm] = MFMA16(as, bq, acc[tm]); acc[tm] = MFMA16(av, bw, acc[tm]);
            }
        }
    }
    float s = 0.f;
#pragma unroll
    for (int tm = 0; tm < 4; ++tm) s += (acc[tm][0] + acc[tm][1]) + (acc[tm][2] + acc[tm][3]);
    s += __shfl_xor(s, 16); s += __shfl_xor(s, 32);
    const float mu = s * (1.f / HD); float q = 0.f;
#pragma unroll
    for (int tm = 0; tm < 4; ++tm) { acc[tm] = acc[tm] - mu; q += (acc[tm][0] * acc[tm][0] + acc[tm][1] * acc[tm][1]) + (acc[tm][2] * acc[tm][2] + acc[tm][3] * acc[tm][3]); }
    q += __shfl_xor(q, 16); q += __shfl_xor(q, 32);
    const float rstd = 1.f / sqrtf(q * (1.f / HD) + GN_EPS);
    const size_t tok = (size_t)b * S + 64 * c + u;
    const float* BS = (const float*)(F.ws + WS_BS);
    const float bsum = BS[tok * 8 + hd] + BS[((size_t)T + tok) * 8 + hd];
    const bf16_t* VC = (const bf16_t*)(F.ws + WS_VC) + tok * BW + hd * HD; const bf16_t* GBp = (const bf16_t*)(F.ws + WS_GB) + tok * BW + hd * HD;
    bf16_t* op = (bf16_t*)(F.ws + WS_CONCAT) + tok * D + AW + hd * HD;
#pragma unroll
    for (int tm = 0; tm < 4; ++tm) {
        const int i0 = 16 * tm + 4 * g;
        const f32x4 vv = unpack4(*(const u32x2*)(VC + i0)), gg = unpack4(*(const u32x2*)(GBp + i0));
        const f32x4 gn = *(const f32x4*)(P.gn_gain + hd * HD + i0), gb = *(const f32x4*)(P.gn_bias + hd * HD + i0);
        *(u32x2*)(op + i0) = pack4((acc[tm] * rstd * gn + gb + vv * bsum) * gg);
    }
}

DI RwP make_rwp(const Args& a, int l) {
    RwP p;
    p.conv = a.in[6] + (size_t)l * 3 * 3 * BW; p.w0 = a.in[7] + (size_t)l * 2 * BW; p.w_up = a.in[8] + (size_t)l * 2 * RW * BW;
    p.a0 = a.in[9] + (size_t)l * 2 * BW; p.a_up = a.in[10] + (size_t)l * 2 * RA * BW; p.g_up = a.in[11] + (size_t)l * RG * BW;
    p.k_k = a.in[12] + (size_t)l * BW; p.k_a = a.in[13] + (size_t)l * BW; p.r_k = a.in[14] + (size_t)l * BH * HD;
    p.gn_gain = a.in[15] + (size_t)l * BW; p.gn_bias = a.in[16] + (size_t)l * BW;
    return p;
}
DI void p_gemm1(const Frame& F, int l) {
    pg8::Gemm1Order S; S.U = (const bf16_t*)(F.ws + WS_U); S.Win = (const bf16_t*)(F.ws + WS_WIN + (size_t)l * WIN_LAYER); S.Wv = S.Win + (size_t)HW * D; S.G = F.G; S.c = F.bx;
    pg8::EpiStore E{(bf16_t*)(F.ws + WS_HB), HW, (bf16_t*)(F.ws + WS_VT), T};
    pg8::gemm_phase(F.lds, F.tid, D, S, E);
}
DI void p_mixer_local(const Frame& F, const Args& a, int l) {
    for (int unit = F.bx; unit < NUNIT; unit += F.G) rwkv_local_unit(F, a, l, unit);
    LAS float* rpbl = (LAS float*)F.lds;
    const float* rpb = a.in[5] + (size_t)l * AH * (2 * KH - 1) * (2 * KW - 1);
    for (int i = F.tid; i < AH * (2 * KH - 1) * (2 * KW - 1); i += NTHREADS) rpbl[i] = rpb[i] * LOG2E;
    __syncthreads();
    for (int au = F.gw; au < NB * ROWS * AH; au += F.ngw) attn_unit(F, rpbl, au);
    for (int pu = F.gw; pu < NB * (S / 32) * 4; pu += F.ngw) pool_unit(F, a.in[17] + (size_t)l * NG * 64 * 64, a.in[18] + (size_t)l * CW, pu);
}
DI void p_scan(const Frame& F, const Args& a, int l) {
    if (F.bx < 2 * 2 * NB * BH && F.wave == 0) scan_wave(F, F.bx);
#if TESTMODE != 2
    LAS float* scr = (LAS float*)F.lds + F.wave * (64 * 65);
    for (int it = F.bx * NWAVES + F.wave; it < IT_MOE; it += F.G * NWAVES) conv_moe_item(F, a.in[28], a.in[29], a.in[30], l, it, scr);
#endif
}
DI void p_rwkv_out(const Frame& F, const Args& a, int l) {
    const RwP P = make_rwp(a, l);
    for (int du = F.gw; du < NB * BH * NCH * 4; du += F.ngw) rwkv_out_unit(F, P, du);
}
DI void p_gemm2(const Frame& F, int l) {
    pg8::PlainOrder S; S.init((const bf16_t*)(F.ws + WS_CONCAT), (const bf16_t*)(F.ws + WS_WOUT) + (size_t)l * D * D, T, D, D, F.G, F.bx);
    pg8::EpiStore E{(bf16_t*)(F.ws + WS_MIX), D, nullptr, 0};
    pg8::gemm_phase(F.lds, F.tid, D, S, E);
}
DI void p_moe_a(const Frame& F, int l) {
    LAS int* tb = (LAS int*)(F.lds + LDS_MISC);
    build_tables(F, l, tb);
    pg8::GroupedOrder S; S.A = (const bf16_t*)(F.ws + WS_XS); S.Bt = (const bf16_t*)(F.ws + WS_WGU); S.K = D; S.estride = (size_t)D * D; S.tile_e = tb + 66; S.ntiles = tb[65]; S.nwg = S.ntiles * 4; S.G = F.G; S.c = F.bx;
    pg8::EpiSwiGlu E{(bf16_t*)(F.ws + WS_HM)};
    pg8::gemm_phase(F.lds, F.tid, D, S, E);
}
DI void p_moe_b(const Frame& F, int l) {
    LAS int* tb = (LAS int*)(F.lds + LDS_MISC);
    build_tables(F, l, tb);
    pg8::GroupedOrder S; S.A = (const bf16_t*)(F.ws + WS_HM); S.Bt = (const bf16_t*)(F.ws + WS_WD); S.K = DE; S.estride = (size_t)D * DE; S.tile_e = tb + 66; S.ntiles = tb[65]; S.nwg = S.ntiles * 4; S.G = F.G; S.c = F.bx;
    pg8::EpiRowScale E{(bf16_t*)(F.ws + WS_YS), (const float*)(F.ws + WS_SLOTW)};
    pg8::gemm_phase(F.lds, F.tid, DE, S, E);
}

constexpr int PH_PER_LAYER = 10, N_PHASES = 2 + L * PH_PER_LAYER;
DI bool in_ph(int k, int lo, int hi) { lo = __builtin_amdgcn_readfirstlane(lo); hi = __builtin_amdgcn_readfirstlane(hi); asm volatile("" : "+s"(lo), "+s"(hi)); return lo <= k && k < hi; }
DI Frame fresh(const Frame& F0) {
    Frame F = F0; int t = F0.tid, b = F0.bx;
    b = __builtin_amdgcn_readfirstlane(b); asm volatile("" : "+v"(t)); asm volatile("" : "+s"(b));
    F.tid = t; F.lane = t & 63; F.wave = __builtin_amdgcn_readfirstlane(t >> 6); F.bx = b;
    F.vcu = (F.G % 8 == 0) ? (b % 8) * (F.G / 8) + b / 8 : b; F.gw = F.vcu * NWAVES + F.wave;
    return F;
}

__global__ void __launch_bounds__(NTHREADS, 2) mk_fwd(Args a) {
    extern __shared__ __attribute__((aligned(16))) unsigned char lds_raw[];
    Frame F;
    F.lds = (LAS unsigned char*)lds_raw;
    F.tid = threadIdx.x; F.lane = F.tid & 63; F.wave = __builtin_amdgcn_readfirstlane(F.tid >> 6);
    F.G = gridDim.x; F.bx = blockIdx.x; { const int bx = blockIdx.x; F.vcu = (F.G % 8 == 0) ? (bx % 8) * (F.G / 8) + bx / 8 : bx; }
    F.gw = F.vcu * NWAVES + F.wave; F.ngw = F.G * NWAVES; F.ws = a.ws;
    volatile LAS unsigned* bst = (volatile LAS unsigned*)(F.lds + LDS_BARST);
    if (F.tid < 16) bst[F.tid] = 0u;
    __syncthreads();
    cg::grid_group grid = cg::this_grid();
    XcdBarrier bar; bar.bar = (unsigned*)(a.ws + WS_CTL) + CW_BAR; bar.x = 0; bar.st = bst;
    const bool multi = (a.ph_hi - a.ph_lo) > 1;
    if (multi && !a.use_cg) bar = xcd_barrier_post((unsigned*)(a.ws + WS_CTL) + CW_BAR, bst);
    const int lo = a.ph_lo, hi = a.ph_hi;
#define IN(k) in_ph((k), lo, hi)
#define SEAM(k) do { if (IN(k) && IN((k) + 1)) { if (a.use_cg) grid.sync(); else xcd_barrier(bar); } } while (0)
    if (IN(0)) p0_prologue(fresh(F), a);
    SEAM(0);
    if (IN(1)) p_r0(fresh(F), a.in[0]);
    SEAM(1);
#define LAYER(l) do { \
        const int pb = 2 + PH_PER_LAYER * (l); \
        if (IN(pb + 0)) p_gemm1(fresh(F), (l)); \
        SEAM(pb + 0); \
        if (IN(pb + 1)) p_mixer_local(fresh(F), a, (l)); \
        SEAM(pb + 1); \
        if (IN(pb + 2)) p_scan(fresh(F), a, (l)); \
        SEAM(pb + 2); \
        if (IN(pb + 3)) p_rwkv_out(fresh(F), a, (l)); \
        SEAM(pb + 3); \
        if (IN(pb + 4)) p_gemm2(fresh(F), (l)); \
        SEAM(pb + 4); \
        if (IN(pb + 5)) p_rowpass1(fresh(F), a, (l), (l) == 0 ? a.in[0] : a.out); \
        SEAM(pb + 5); \
        if (IN(pb + 6)) p_gather(fresh(F), (l)); \
        SEAM(pb + 6); \
        if (IN(pb + 7)) p_moe_a(fresh(F), (l)); \
        SEAM(pb + 7); \
        if (IN(pb + 8)) p_moe_b(fresh(F), (l)); \
        SEAM(pb + 8); \
        if (IN(pb + 9)) p_rowpass2(fresh(F), a, (l), a.out); \
        SEAM(pb + 9); \
    } while (0)
    LAYER(0);
    LAYER(1);
#undef LAYER
#undef IN
#undef SEAM
}

#ifndef MK_MODE
#define MK_MODE 0
#endif
#ifndef TESTMODE
#define TESTMODE 0
#endif

static void fill_args(Args& a, void* const* d_in, void* d_out, void* d_ws) {
    for (int i = 0; i < 31; ++i) a.in[i] = (const float*)d_in[i];
    a.out = (float*)d_out; a.ws = (unsigned char*)d_ws; a.ph_lo = 0; a.ph_hi = N_PHASES; a.use_cg = 0; a.pad = 0;
}
static void launch_phases(Args a, int lo, int hi, hipStream_t stream) {
    for (int p = lo; p < hi; ++p) { a.ph_lo = p; a.ph_hi = p + 1; hipLaunchKernelGGL(mk_fwd, dim3(256), dim3(NTHREADS), LDS_BYTES, stream, a); }
}

#if TESTMODE == 0
extern "C" void kernel_launch(void* const* d_in, const int* in_sizes, int n_in, void* d_out, int out_size, void* d_ws, size_t ws_size, hipStream_t stream) {
    static int grid = 0;
    if (grid == 0) {
        int dev = 0, cus = 0, per_cu = 0;
        (void)hipGetDevice(&dev); (void)hipDeviceGetAttribute(&cus, hipDeviceAttributeMultiprocessorCount, dev);
        (void)hipFuncSetAttribute((const void*)mk_fwd, hipFuncAttributeMaxDynamicSharedMemorySize, LDS_BYTES);
        (void)hipOccupancyMaxActiveBlocksPerMultiprocessor(&per_cu, (const void*)mk_fwd, NTHREADS, LDS_BYTES);
        (void)hipGetLastError();
        grid = (cus > 0 ? cus : 256) * 1;
        if (ws_size < WS_END || n_in != 31) grid = -1;
    }
    if (grid < 0) return;
    (void)hipMemsetAsync((char*)d_ws + WS_CTL, 0, CTL_BYTES, stream);
    Args a{}; fill_args(a, d_in, d_out, d_ws);
#if MK_MODE == 2
    launch_phases(a, 0, N_PHASES, stream);
#else
    a.use_cg = (MK_MODE == 1) ? 1 : 0;
    void* args[] = {&a};
    (void)hipLaunchCooperativeKernel((const void*)mk_fwd, dim3(grid), dim3(NTHREADS), args, LDS_BYTES, stream);
#endif
}
#endif

#if TESTMODE > 0
constexpr int O_A = 1152, O_B = 2304, O_W = 2336, O_AL = 2368, O_G = 2432;
struct HSrc { const bf16_t* HB; const bf16_t* VT;
    DI float at(size_t tok, int n) const { if (n < 768) return bf2f(HB[tok * HW + n]); if (n < 1152) return bf2f(VT[(size_t)(n - 768) * T + tok]); return bf2f(HB[tok * HW + n - 384]); } };
DI float sigm_n(float x) { return 1.f / (1.f + expf(-x)); }

__global__ void k_mod_n(const float* __restrict__ c, const float* __restrict__ w_mod, const float* __restrict__ b_mod, float* __restrict__ mod) {
    __shared__ float sc[NB * D];
    for (int i = threadIdx.x; i < NB * D; i += blockDim.x) { float v = c[i]; sc[i] = v * sigm_n(v); }
    __syncthreads();
    int idx = blockIdx.x * blockDim.x + threadIdx.x; int l = idx / MODW, n = idx % MODW;
    const float* w = w_mod + (size_t)l * D * MODW + n; float a0 = 0.f, a1 = 0.f;
    for (int k = 0; k < D; ++k) { float wv = w[(size_t)k * MODW]; a0 += sc[k] * wv; a1 += sc[D + k] * wv; }
    float bb = b_mod[l * MODW + n];
    mod[(size_t)(l * NB + 0) * MODW + n] = a0 + bb; mod[(size_t)(l * NB + 1) * MODW + n] = a1 + bb;
}
__global__ void k_ln_mod_n(const float* __restrict__ xin, const float* __restrict__ modl, int off_sh, int off_sc, float* __restrict__ uout) {
    int row = (blockIdx.x * blockDim.x + threadIdx.x) >> 6, lane = threadIdx.x & 63; if (row >= T) return; int b = row / S;
    f32x4 v[4];
#pragma unroll
    for (int j = 0; j < 4; ++j) v[j] = *(const f32x4*)(xin + (size_t)row * D + 4 * lane + 256 * j);
    float mean, rstd; row_ln(v, mean, rstd);
    const float* md = modl + (size_t)b * MODW;
#pragma unroll
    for (int j = 0; j < 4; ++j) { int col = 4 * lane + 256 * j; *(f32x4*)(uout + (size_t)row * D + col) = v[j] * rstd * (1.f + *(const f32x4*)(md + off_sc + col)) + *(const f32x4*)(md + off_sh + col); }
}
__global__ void k_post_n(const float* xin, const float* br, const float* __restrict__ modl, int off_gate, const float* __restrict__ gain, const float* __restrict__ bias, float* xout, float* u2out, int off_sh2, int off_sc2) {
    int row = (blockIdx.x * blockDim.x + threadIdx.x) >> 6, lane = threadIdx.x & 63; if (row >= T) return; int b = row / S;
    const float* md = modl + (size_t)b * MODW; f32x4 v[4];
#pragma unroll
    for (int j = 0; j < 4; ++j) { int col = 4 * lane + 256 * j; v[j] = *(const f32x4*)(xin + (size_t)row * D + col) * ALPHA + *(const f32x4*)(md + off_gate + col) * *(const f32x4*)(br + (size_t)row * D + col); }
    float mean, rstd; row_ln(v, mean, rstd);
#pragma unroll
    for (int j = 0; j < 4; ++j) { int col = 4 * lane + 256 * j; v[j] = v[j] * rstd * *(const f32x4*)(gain + col) + *(const f32x4*)(bias + col); *(f32x4*)(xout + (size_t)row * D + col) = v[j]; }
    if (u2out == nullptr) return;
    row_ln(v, mean, rstd);
#pragma unroll
    for (int j = 0; j < 4; ++j) { int col = 4 * lane + 256 * j; *(f32x4*)(u2out + (size_t)row * D + col) = v[j] * rstd * (1.f + *(const f32x4*)(md + off_sc2 + col)) + *(const f32x4*)(md + off_sh2 + col); }
}
__global__ void __launch_bounds__(256) k_gemm_f32(const float* __restrict__ A, int lda, const float* __restrict__ B, int ldb, float* __restrict__ C, int ldc, int K) {
    __shared__ float As[16][65]; __shared__ float Bs[16][64];
    const int tx = threadIdx.x & 15, ty = threadIdx.x >> 4; const int m0 = blockIdx.y * 64, n0 = blockIdx.x * 64;
    float acc[4][4];
#pragma unroll
    for (int i = 0; i < 4; ++i)
#pragma unroll
        for (int j = 0; j < 4; ++j) acc[i][j] = 0.f;
    for (int k0 = 0; k0 < K; k0 += 16) {
#pragma unroll
        for (int i = 0; i < 4; ++i) { int e = threadIdx.x + 256 * i; int m = e >> 4, k = e & 15; As[k][m] = A[(size_t)(m0 + m) * lda + k0 + k]; }
#pragma unroll
        for (int i = 0; i < 4; ++i) { int e = threadIdx.x + 256 * i; int k = e >> 6, n = e & 63; Bs[k][n] = B[(size_t)(k0 + k) * ldb + n0 + n]; }
        __syncthreads();
#pragma unroll
        for (int k = 0; k < 16; ++k) { float a[4], b[4];
#pragma unroll
            for (int i = 0; i < 4; ++i) { a[i] = As[k][ty * 4 + i]; b[i] = Bs[k][tx * 4 + i]; }
#pragma unroll
            for (int i = 0; i < 4; ++i)
#pragma unroll
                for (int j = 0; j < 4; ++j) acc[i][j] += a[i] * b[j]; }
        __syncthreads();
    }
#pragma unroll
    for (int i = 0; i < 4; ++i) *(float4*)(C + (size_t)(m0 + ty * 4 + i) * ldc + n0 + tx * 4) = make_float4(acc[i][0], acc[i][1], acc[i][2], acc[i][3]);
}
__global__ void __launch_bounds__(64) k_attn_n(HSrc h, const float* __restrict__ rpb, float* __restrict__ concat) {
    int idx = blockIdx.x * blockDim.x + threadIdx.x; if (idx >= T * AH) return;
    int head = idx % AH, tok = idx / AH; int b = tok / S, t = tok % S, r = t / GW, cq = t % GW;
    int rstart = r - KH / 2; rstart = rstart < 0 ? 0 : (rstart > ROWS - KH ? ROWS - KH : rstart);
    int cstart = cq - KW / 2; cstart = cstart < 0 ? 0 : (cstart > GW - KW ? GW - KW : cstart);
    float q[HD], acc[HD];
#pragma unroll
    for (int d = 0; d < HD; ++d) { q[d] = h.at(tok, head * HD + d); acc[d] = 0.f; }
    float m = -1e30f, l = 0.f; const float* rp = rpb + (size_t)head * 15 * 31;
    for (int kk = 0; kk < KH; ++kk) { int kr = rstart + kk; int dr = kr - r + (KH - 1);
        for (int j = 0; j < KW; ++j) { int ck = cstart + j; int dc = ck - cq; dc = dc < -15 ? -15 : (dc > 15 ? 15 : dc); dc += 15;
            size_t kt = (size_t)b * S + kr * GW + ck; float s = 0.f;
#pragma unroll
            for (int d = 0; d < HD; ++d) s += q[d] * h.at(kt, AW + head * HD + d);
            s = s * 0.125f + rp[dr * 31 + dc];
            float mn = fmaxf(m, s); float corr = expf(m - mn); float p = expf(s - mn); l = l * corr + p;
#pragma unroll
            for (int d = 0; d < HD; ++d) acc[d] = acc[d] * corr + p * h.at(kt, 2 * AW + head * HD + d);
            m = mn; } }
    float inv = 1.f / l;
#pragma unroll
    for (int d = 0; d < HD; ++d) concat[(size_t)tok * D + head * HD + d] = acc[d] * inv;
}
__global__ void __launch_bounds__(256) k_pool_n(HSrc h, const float* __restrict__ pool_w, const float* __restrict__ pool_scale, float* __restrict__ concat) {
    __shared__ float pooled[CW];
    int tok = blockIdx.x; int b = tok / S, t = tok % S; int ch = threadIdx.x; int g = ch / 64; int win = 2 << g;
    int lo = t - win / 2; lo = lo < 0 ? 0 : lo; int hi = t + win / 2 - 1; hi = hi > S - 1 ? S - 1 : hi;
    float s = 0.f; for (int u = lo; u <= hi; ++u) s += h.at((size_t)b * S + u, O_G + ch);
    pooled[ch] = s / (float)(hi - lo + 1) - h.at(tok, O_G + ch);
    __syncthreads();
    int e = ch % 64; const float* pw = pool_w + (size_t)g * 64 * 64 + e; float a = 0.f;
    for (int c2 = 0; c2 < 64; ++c2) a += pooled[g * 64 + c2] * pw[c2 * 64];
    concat[(size_t)tok * D + AW + BW + ch] = a * pool_scale[ch];
}
__global__ void __launch_bounds__(64) k_rwkv_scan_n(HSrc h, RwP p, float* __restrict__ ys) {
    const int lane = threadIdx.x; const int dir = blockIdx.x / (NB * BH), b = (blockIdx.x / BH) % NB, hd = blockIdx.x % BH; const int ch = hd * HD + lane;
    float st[HD];
#pragma unroll
    for (int j = 0; j < HD; ++j) st[j] = 0.f;
    float wup[RW], aup[RA];
#pragma unroll
    for (int m = 0; m < RW; ++m) { wup[m] = p.w_up[(size_t)(dir * RW + m) * BW + ch]; aup[m] = p.a_up[(size_t)(dir * RA + m) * BW + ch]; }
    const float w0 = p.w0[dir * BW + ch], a0 = p.a0[dir * BW + ch], kkw = p.k_k[ch], kaw = p.k_a[ch];
    float cr[3], ck[3], cv[3];
#pragma unroll
    for (int x = 0; x < 3; ++x) { cr[x] = p.conv[x * 3 * BW + ch]; ck[x] = p.conv[x * 3 * BW + BW + ch]; cv[x] = p.conv[x * 3 * BW + 2 * BW + ch]; }
    for (int step = 0; step < S; ++step) {
        const int t = dir ? (S - 1 - step) : step; const size_t row = (size_t)b * S + t;
        float r = 0.f, k = 0.f, v = 0.f;
#pragma unroll
        for (int x = 0; x < 3; ++x) { int tt = t + x - 1; if (tt >= 0 && tt < S) { size_t rr = (size_t)b * S + tt; r += h.at(rr, O_A + ch) * cr[x]; k += h.at(rr, O_A + BW + ch) * ck[x]; v += h.at(rr, O_A + 2 * BW + ch) * cv[x]; } }
        float lv = h.at(row, O_B + lane); float lt = lane < RW ? tanhf(lv) : lv; float zw = w0, za = a0;
#pragma unroll
        for (int m = 0; m < RW; ++m) { zw += __shfl(lt, m) * wup[m]; za += __shfl(lt, RW + m) * aup[m]; }
        const float w = expf(-DECAY * sigm_n(zw)); const float a = sigm_n(za);
        float kk = k * kkw; float ss = wave_sum(kk * kk); kk = kk * (1.f / sqrtf(fmaxf(ss, 1e-24f)));
        const float kd = k * (1.f + (a - 1.f) * kaw); const float kka = kk * a;
        float sa = 0.f;
#pragma unroll
        for (int j = 0; j < HD; ++j) sa += st[j] * (-__shfl(kk, j));
        float y = 0.f;
#pragma unroll
        for (int j = 0; j < HD; ++j) { st[j] = st[j] * __shfl(w, j) + sa * __shfl(kka, j) + v * __shfl(kd, j); y += st[j] * __shfl(r, j); }
        ys[((size_t)dir * T + b * S + t) * BW + ch] = y;
    }
}
__global__ void __launch_bounds__(384) k_rwkv_finish_n(HSrc h, RwP p, const float* __restrict__ ys, float* __restrict__ concat) {
    __shared__ float lw[RW], la[RA], sg[RG];
    const int tok = blockIdx.x, b = tok / S, t = tok % S, ch = threadIdx.x, hd = ch / HD, j = ch % HD;
    if (ch < RW) lw[ch] = tanhf(h.at(tok, O_B + ch)); else if (ch < RW + RA) la[ch - RW] = h.at(tok, O_W + (ch - RW)); else if (ch < RW + RA + RG) sg[ch - RW - RA] = sigm_n(h.at(tok, O_AL + (ch - RW - RA)));
    __syncthreads();
    float r = 0.f, k = 0.f, v = 0.f;
#pragma unroll
    for (int x = 0; x < 3; ++x) { int tt = t + x - 1; if (tt >= 0 && tt < S) { size_t rr = (size_t)b * S + tt;
        r += h.at(rr, O_A + ch) * p.conv[x * 3 * BW + ch]; k += h.at(rr, O_A + BW + ch) * p.conv[x * 3 * BW + BW + ch]; v += h.at(rr, O_A + 2 * BW + ch) * p.conv[x * 3 * BW + 2 * BW + ch]; } }
    float bon = 0.f;
    for (int dir = 0; dir < 2; ++dir) { float za = p.a0[dir * BW + ch]; for (int m = 0; m < RA; ++m) za += la[m] * p.a_up[(size_t)(dir * RA + m) * BW + ch];
        float a = sigm_n(za); float kd = k * (1.f + (a - 1.f) * p.k_a[ch]); bon += wave_sum(r * kd * p.r_k[hd * HD + j]); }
    bon *= v;
    float y = ys[(size_t)tok * BW + ch] + ys[((size_t)T + tok) * BW + ch];
    float mu = wave_sum(y) * (1.f / HD); float dy = y - mu; float var = wave_sum(dy * dy) * (1.f / HD);
    float yn = dy * (1.f / sqrtf(var + GN_EPS)) * p.gn_gain[ch] + p.gn_bias[ch];
    float g = 0.f; for (int m = 0; m < RG; ++m) g += sg[m] * p.g_up[(size_t)m * BW + ch];
    concat[(size_t)tok * D + AW + ch] = (yn + bon) * g;
}
__global__ void __launch_bounds__(256) k_moe_n(const float* __restrict__ u2, const int* __restrict__ tokslot, const float* __restrict__ ew,
                                                const float* __restrict__ wgate, const float* __restrict__ wup, const float* __restrict__ wdown, float* __restrict__ f) {
    __shared__ float xs[D]; __shared__ float hb[DE];
    const int tok = blockIdx.x, tid = threadIdx.x;
    for (int i = tid; i < D; i += 256) xs[i] = u2[(size_t)tok * D + i];
    float o[4] = {0.f, 0.f, 0.f, 0.f};
    for (int kk = 0; kk < 2; ++kk) {
        const int ts = tokslot[tok * 2 + kk]; const int e = ts >> 14; const float wt = ew[ts];
        __syncthreads();
        const float* g = wgate + (size_t)e * D * DE; const float* u = wup + (size_t)e * D * DE;
        float ag0 = 0.f, ag1 = 0.f, au0 = 0.f, au1 = 0.f;
        for (int k = 0; k < D; ++k) { float x = xs[k]; ag0 += x * g[(size_t)k * DE + tid]; ag1 += x * g[(size_t)k * DE + 256 + tid]; au0 += x * u[(size_t)k * DE + tid]; au1 += x * u[(size_t)k * DE + 256 + tid]; }
        hb[tid] = ag0 * sigm_n(ag0) * au0; hb[256 + tid] = ag1 * sigm_n(ag1) * au1;
        __syncthreads();
        const float* dn = wdown + (size_t)e * DE * D; float a[4] = {0.f, 0.f, 0.f, 0.f};
        for (int k = 0; k < DE; ++k) { float x = hb[k];
#pragma unroll
            for (int j = 0; j < 4; ++j) a[j] += x * dn[(size_t)k * D + tid + 256 * j]; }
#pragma unroll
        for (int j = 0; j < 4; ++j) o[j] += a[j] * wt;
    }
#pragma unroll
    for (int j = 0; j < 4; ++j) f[(size_t)tok * D + tid + 256 * j] = o[j];
}

__global__ void k_router_n(const float* __restrict__ u2, const float* __restrict__ wg, const float* __restrict__ bg, const float* __restrict__ we, const float* __restrict__ be, int* __restrict__ tok_e) {
    int row = (blockIdx.x * blockDim.x + threadIdx.x) >> 6, lane = threadIdx.x & 63; if (row >= T) return;
    float gl[NG], el[NE];
#pragma unroll
    for (int n = 0; n < NG; ++n) gl[n] = 0.f;
#pragma unroll
    for (int n = 0; n < NE; ++n) el[n] = 0.f;
    for (int i = 0; i < 16; ++i) { int k = lane + 64 * i; float x = u2[(size_t)row * D + k];
#pragma unroll
        for (int n = 0; n < NG; ++n) gl[n] += x * wg[k * NG + n];
#pragma unroll
        for (int n = 0; n < NE; ++n) el[n] += x * we[k * NE + n]; }
#pragma unroll
    for (int n = 0; n < NG; ++n) gl[n] = wave_sum(gl[n]) + bg[n];
#pragma unroll
    for (int n = 0; n < NE; ++n) el[n] = wave_sum(el[n]) + be[n];
    int gi = 0; float gm = gl[0];
#pragma unroll
    for (int n = 1; n < NG; ++n) if (gl[n] > gm) { gm = gl[n]; gi = n; }
    float l1 = -3.0e38f, l2 = -3.0e38f; int i1 = 0, i2 = 0;
#pragma unroll
    for (int n = 0; n < NE; ++n) if ((n >> 3) == gi) { float v = el[n]; int e = n & 7; if (v > l1) { l2 = l1; i2 = i1; l1 = v; i1 = e; } else if (v > l2) { l2 = v; i2 = e; } }
    if (lane == 0) { tok_e[row * 2] = gi * EPG + i1; tok_e[row * 2 + 1] = gi * EPG + i2; }
}
__global__ void k_cmp_route(const int* __restrict__ tokslot, const int* __restrict__ tok_e, float* acc, int slot) {
    float mis = 0.f, tot = 0.f;
    for (int t = blockIdx.x * blockDim.x + threadIdx.x; t < T; t += gridDim.x * blockDim.x) { const int a0 = tokslot[2 * t] >> 14, a1 = tokslot[2 * t + 1] >> 14;
        mis += (a0 != tok_e[2 * t] || a1 != tok_e[2 * t + 1]) ? 1.f : 0.f; tot += 1.f; }
    mis = wave_sum(mis); tot = wave_sum(tot);
    if ((threadIdx.x & 63) == 0) { atomicAdd(acc + 2 * slot, mis); atomicAdd(acc + 2 * slot + 1, tot); }
}
__global__ void k_bf2f(const bf16_t* __restrict__ src, float* __restrict__ dst, size_t n) { for (size_t i = (size_t)blockIdx.x * blockDim.x + threadIdx.x; i < n; i += (size_t)gridDim.x * blockDim.x) dst[i] = bf2f(src[i]); }
template <class TA> __global__ void k_cmp(const TA* __restrict__ a, size_t lda, const float* __restrict__ b, size_t ldb, int rows, int cols, float* acc, int slot) {
    float d2 = 0.f, r2 = 0.f;
    for (size_t i = (size_t)blockIdx.x * blockDim.x + threadIdx.x; i < (size_t)rows * cols; i += (size_t)gridDim.x * blockDim.x) {
        const size_t r = i / cols, c = i % cols; float av; if constexpr (sizeof(TA) == 2) av = bf2f(a[r * lda + c]); else av = a[r * lda + c];
        const float bv = b[r * ldb + c]; d2 += (av - bv) * (av - bv); r2 += bv * bv; }
    d2 = wave_sum(d2); r2 = wave_sum(r2);
    if ((threadIdx.x & 63) == 0) { atomicAdd(acc + 2 * slot, d2); atomicAdd(acc + 2 * slot + 1, r2); }
}
__global__ void k_cmp_vt(const bf16_t* __restrict__ vt, const float* __restrict__ b, size_t ldb, float* acc, int slot) {
    float d2 = 0.f, r2 = 0.f;
    for (size_t i = (size_t)blockIdx.x * blockDim.x + threadIdx.x; i < (size_t)T * AW; i += (size_t)gridDim.x * blockDim.x) {
        const size_t r = i % T, c = i / T; const float av = bf2f(vt[c * T + r]), bv = b[r * ldb + c]; d2 += (av - bv) * (av - bv); r2 += bv * bv; }
    d2 = wave_sum(d2); r2 = wave_sum(r2);
    if ((threadIdx.x & 63) == 0) { atomicAdd(acc + 2 * slot, d2); atomicAdd(acc + 2 * slot + 1, r2); }
}
struct Tols { float t[8]; int n; };
__global__ void k_readout(float* out, const float* acc, Tols tl, int total) {
    float mx = 0.f; int am = 0; for (int k = 0; k < tl.n; ++k) { float e = sqrtf(acc[2 * k] / fmaxf(acc[2 * k + 1], 1e-30f)); if (!(e == e)) e = 1e3f; if (e / tl.t[k] > mx) { mx = e / tl.t[k]; am = k; } }
    const float cval = sqrtf(1000.f * mx);
    for (int i = blockIdx.x * blockDim.x + threadIdx.x; i < total; i += gridDim.x * blockDim.x) out[i] = (i < 8) ? 1000.f * (float)(am + 1) : cval;
}
__global__ void __launch_bounds__(256) k_moe_chk(const float* __restrict__ u2, const int* __restrict__ tokslot, const float* __restrict__ ew, const unsigned* __restrict__ cnt,
                                                  const float* __restrict__ wgate, const float* __restrict__ wup, const float* __restrict__ wdown,
                                                  const bf16_t* __restrict__ XS, const bf16_t* __restrict__ HM, const bf16_t* __restrict__ YS, float* acc) {
    __shared__ float xs[D]; __shared__ float hb[DE]; __shared__ int offp[NE];
    const int tok = blockIdx.x, tid = threadIdx.x;
    if (tid == 0) { int off = 0; for (int e = 0; e < NE; ++e) { offp[e] = off; off += (((int)cnt[e] + 255) >> 8) * 256; } }
    for (int i = tid; i < D; i += 256) xs[i] = u2[(size_t)tok * D + i];
    float d0 = 0.f, r0 = 0.f, d1 = 0.f, r1 = 0.f, d2 = 0.f, r2 = 0.f;
    for (int kk = 0; kk < 2; ++kk) {
        __syncthreads();
        const int ts = tokslot[tok * 2 + kk]; const int e = ts >> 14; const float wt = ew[ts]; const size_t slot = (size_t)offp[e] + (ts & 16383);
        for (int i = tid; i < D; i += 256) { const float a = bf2f(XS[slot * D + i]), b = xs[i]; d0 += (a - b) * (a - b); r0 += b * b; }
        const float* g = wgate + (size_t)e * D * DE; const float* u = wup + (size_t)e * D * DE;
        float ag0 = 0.f, ag1 = 0.f, au0 = 0.f, au1 = 0.f;
        for (int k = 0; k < D; ++k) { float x = xs[k]; ag0 += x * g[(size_t)k * DE + tid]; ag1 += x * g[(size_t)k * DE + 256 + tid]; au0 += x * u[(size_t)k * DE + tid]; au1 += x * u[(size_t)k * DE + 256 + tid]; }
        const float h0 = ag0 * sigm_n(ag0) * au0, h1 = ag1 * sigm_n(ag1) * au1;
        hb[tid] = h0; hb[256 + tid] = h1;
        { const float a = bf2f(HM[slot * DE + tid]), b = bf2f(HM[slot * DE + 256 + tid]); d1 += (a - h0) * (a - h0) + (b - h1) * (b - h1); r1 += h0 * h0 + h1 * h1; }
        __syncthreads();
        const float* dn = wdown + (size_t)e * DE * D; float a4[4] = {0.f, 0.f, 0.f, 0.f};
        for (int k = 0; k < DE; ++k) { float x = hb[k];
#pragma unroll
            for (int j = 0; j < 4; ++j) a4[j] += x * dn[(size_t)k * D + tid + 256 * j]; }
#pragma unroll
        for (int j = 0; j < 4; ++j) {
#ifdef MOEB_NOSCALE
            const float y = a4[j];
#else
            const float y = a4[j] * wt;
#endif
            const float a = bf2f(YS[slot * D + tid + 256 * j]); d2 += (a - y) * (a - y); r2 += y * y; }
    }
    d0 = wave_sum(d0); r0 = wave_sum(r0); d1 = wave_sum(d1); r1 = wave_sum(r1); d2 = wave_sum(d2); r2 = wave_sum(r2);
    if ((tid & 63) == 0) { atomicAdd(acc + 0, d0); atomicAdd(acc + 1, r0); atomicAdd(acc + 2, d1); atomicAdd(acc + 3, r1); atomicAdd(acc + 4, d2); atomicAdd(acc + 5, r2); }
}

extern "C" void kernel_launch(void* const* d_in, const int* in_sizes, int n_in, void* d_out, int out_size, void* d_ws, size_t ws_size, hipStream_t stream) {
    static int once = 0; if (!once) { (void)hipFuncSetAttribute((const void*)mk_fwd, hipFuncAttributeMaxDynamicSharedMemorySize, LDS_BYTES); once = 1; }
    (void)hipMemsetAsync((char*)d_ws + WS_CTL, 0, CTL_BYTES, stream);
    Args a{}; fill_args(a, d_in, d_out, d_ws);
    char* ws = (char*)d_ws; float* out = (float*)d_out;
    float* ACC = (float*)(ws + 32768 + 1024);
    const float* x = a.in[0];
    HSrc hs{(const bf16_t*)(ws + WS_HB), (const bf16_t*)(ws + WS_VT)};
    const int l = 0;
    RwP p = { a.in[6], a.in[7], a.in[8], a.in[9], a.in[10], a.in[11], a.in[12], a.in[13], a.in[14], a.in[15], a.in[16] };
    Tols tl{};
#if TESTMODE == 1
    launch_phases(a, 0, 3, stream);
    float* MODn = (float*)(ws + WS_MOD + 512 * 1024); float* Un = (float*)(ws + WS_XA); float* HF = (float*)(ws + WS_CONCAT);
    k_mod_n<<<L * MODW / 256, 256, 0, stream>>>(a.in[1], a.in[2], a.in[3], MODn);
    k_ln_mod_n<<<T / 4, 256, 0, stream>>>(x, MODn, 0, D, Un);
    k_gemm_f32<<<dim3(INW / 64, T / 64), 256, 0, stream>>>(Un, D, a.in[4], INW, HF, INW, D);
    k_cmp<float><<<256, 256, 0, stream>>>((const float*)(ws + WS_MOD), MODW, MODn, MODW, L * NB, MODW, ACC, 0);
    k_cmp<bf16_t><<<1024, 256, 0, stream>>>((const bf16_t*)(ws + WS_U), D, Un, D, T, D, ACC, 1);
    k_cmp<bf16_t><<<1024, 256, 0, stream>>>((const bf16_t*)(ws + WS_HB), HW, HF, INW, T, 768, ACC, 2);
    k_cmp<bf16_t><<<1024, 256, 0, stream>>>((const bf16_t*)(ws + WS_HB) + 768, HW, HF + 1152, INW, T, 1536, ACC, 3);
    k_cmp_vt<<<1024, 256, 0, stream>>>((const bf16_t*)(ws + WS_VT), HF + 768, INW, ACC, 4);
    tl.n = 5; tl.t[0] = 1e-5f; tl.t[1] = 4e-3f; tl.t[2] = 6e-3f; tl.t[3] = 6e-3f; tl.t[4] = 6e-3f;
#elif TESTMODE == 2
    launch_phases(a, 0, 4, stream);
    float* CCn = (float*)(ws + WS_XA); float* YSn = (float*)(ws + WS_WGU);
    k_attn_n<<<T * AH / 64, 64, 0, stream>>>(hs, a.in[5], CCn);
    k_pool_n<<<T, 256, 0, stream>>>(hs, a.in[17], a.in[18], CCn);
    k_rwkv_scan_n<<<2 * NB * BH, 64, 0, stream>>>(hs, p, YSn);
    k_rwkv_finish_n<<<T, 384, 0, stream>>>(hs, p, YSn, CCn);
    launch_phases(a, 4, 6, stream);
    k_cmp<bf16_t><<<1024, 256, 0, stream>>>((const bf16_t*)(ws + WS_CONCAT), D, CCn, D, T, AW, ACC, 0);
    k_cmp<bf16_t><<<1024, 256, 0, stream>>>((const bf16_t*)(ws + WS_CONCAT) + AW, D, CCn + AW, D, T, BW, ACC, 1);
    k_cmp<bf16_t><<<1024, 256, 0, stream>>>((const bf16_t*)(ws + WS_CONCAT) + AW + BW, D, CCn + AW + BW, D, T, CW, ACC, 2);
    tl.n = 3; tl.t[0] = TOL0; tl.t[1] = TOL1; tl.t[2] = TOL2;
#elif TESTMODE == 3
    launch_phases(a, 0, 11, stream);
    { const float* MODf = (const float*)(ws + WS_MOD);
      float* U2f = (float*)(ws + 414 * MiB); float* Fn = (float*)(ws + 213 * MiB); float* X2n = (float*)(ws + 277 * MiB);
      k_bf2f<<<2048, 256, 0, stream>>>((const bf16_t*)(ws + WS_U), U2f, (size_t)T * D);
      launch_phases(a, 11, 12, stream);
      k_moe_n<<<T, 256, 0, stream>>>(U2f, (const int*)(ws + WS_TOKSLOT), (const float*)(ws + WS_EW), a.in[28], a.in[29], a.in[30], Fn);
      k_post_n<<<T / 4, 256, 0, stream>>>((const float*)(ws + WS_XA), Fn, MODf, 5 * D, a.in[22], a.in[23], X2n, nullptr, 0, 0);
      k_cmp<float><<<1024, 256, 0, stream>>>(out, D, X2n, D, T, D, ACC, 0); }
    tl.n = 1; tl.t[0] = TOL0;
#elif TESTMODE == 4
    launch_phases(a, 0, 8, stream);
    { const float* MODf = (const float*)(ws + WS_MOD);
      float* CCn = (float*)(ws + 405 * MiB); float* MIXn = (float*)(ws + 213 * MiB); float* X1n = (float*)(ws + 21 * MiB); float* U2n = (float*)(ws + 333 * MiB); int* TEn = (int*)(ws + 490 * MiB);
      k_bf2f<<<2048, 256, 0, stream>>>((const bf16_t*)(ws + WS_CONCAT), CCn, (size_t)T * D);
      k_gemm_f32<<<dim3(D / 64, T / 64), 256, 0, stream>>>(CCn, D, a.in[19], D, MIXn, D, D);
      k_post_n<<<T / 4, 256, 0, stream>>>(x, MIXn, MODf, 2 * D, a.in[20], a.in[21], X1n, U2n, 3 * D, 4 * D);
      k_router_n<<<T / 4, 256, 0, stream>>>(U2n, a.in[24], a.in[25], a.in[26], a.in[27], TEn);
      k_cmp<float><<<1024, 256, 0, stream>>>((const float*)(ws + WS_XA), D, X1n, D, T, D, ACC, 0);
      k_cmp<bf16_t><<<1024, 256, 0, stream>>>((const bf16_t*)(ws + WS_U), D, U2n, D, T, D, ACC, 1);
      k_cmp_route<<<64, 256, 0, stream>>>((const int*)(ws + WS_TOKSLOT), TEn, ACC, 2); }
    tl.n = 3; tl.t[0] = TOL0; tl.t[1] = TOL1; tl.t[2] = TOL2;
#elif TESTMODE == 5
    launch_phases(a, 0, 11, stream);
    { float* U2f = (float*)(ws + 414 * MiB);
      k_bf2f<<<2048, 256, 0, stream>>>((const bf16_t*)(ws + WS_U), U2f, (size_t)T * D);
      k_moe_chk<<<T, 256, 0, stream>>>(U2f, (const int*)(ws + WS_TOKSLOT), (const float*)(ws + WS_EW), (const unsigned*)(ws + WS_CTL) + CW_CNT, a.in[28], a.in[29], a.in[30],
                                       (const bf16_t*)(ws + WS_XS), (const bf16_t*)(ws + WS_HM), (const bf16_t*)(ws + WS_YS), ACC); }
    tl.n = 3; tl.t[0] = 1e-6f; tl.t[1] = 1e-2f; tl.t[2] = 1e-2f;
#endif
    k_readout<<<256, 256, 0, stream>>>(out, ACC, tl, out_size);
}
#endif
```

```cpp
#define TESTMODE 0
#define MK_MODE 0
#include <hip/hip_runtime.h>
#include <hip/hip_cooperative_groups.h>
#include <stdint.h>
namespace cg = cooperative_groups;

#ifndef TESTMODE
#define TESTMODE 0
#endif
#define DI __device__ __forceinline__
#define LAS __attribute__((address_space(3)))
typedef unsigned short bf16_t;
typedef short bf16x8 __attribute__((ext_vector_type(8)));
typedef float f32x4 __attribute__((ext_vector_type(4)));
typedef float f32x16 __attribute__((ext_vector_type(16)));
typedef unsigned u32x4 __attribute__((ext_vector_type(4)));
typedef unsigned u32x2 __attribute__((ext_vector_type(2)));
typedef float f32x2_t __attribute__((ext_vector_type(2)));
typedef __bf16 bf16x2_t __attribute__((ext_vector_type(2)));

namespace cfg {
constexpr int D = 1024, NB = 2, S = 8192, T = NB * S, L = 2;
constexpr int GW = 64, ROWS = 128;
constexpr int HD = 64, AW = 384, BW = 384, CW = 256, AH = 6, BH = 6;
constexpr int KH = 8, KW = 16;
constexpr int RW = 32, RA = 32, RG = 64;
constexpr int INW = 2688;
constexpr int NG = 4, EPG = 8, NE = 32, DE = 512;
constexpr int MODW = 6 * D;
constexpr float ALPHA = 1.41421356237309515f;
constexpr float LN_EPS = 1e-5f, GN_EPS = 64e-5f;
constexpr float DECAY = 0.60653065971263342f;
constexpr float LOG2E = 1.44269504088896341f;
constexpr int HW = 2304, HQ = 0, HK = 384, HR = 768, HWL = 1920, HAL = 1952, HGL = 1984, HP = 2048;
constexpr int NCH = S / 64;
constexpr int NUNIT = 2 * NB * BH * NCH;
constexpr int XSROWS = 2 * T + NE * 256;
}
using namespace cfg;

constexpr size_t MiB = 1u << 20;
constexpr size_t WS_CTL = 0;
constexpr size_t CTL_BYTES = 65536;
constexpr int CW_BAR = 0;
constexpr int CW_CNT = 8192;
constexpr size_t WS_MOD = 1 * MiB;
constexpr size_t WS_TOKSLOT = 1 * MiB + 128 * 1024;
constexpr size_t WS_SLOTW = 1 * MiB + 256 * 1024;
constexpr size_t WS_BC = 2 * MiB;
constexpr size_t WS_TOKW = 2 * MiB + 64 * 1024;
constexpr size_t WS_TOKFIN = 2 * MiB + 256 * 1024;
constexpr size_t WS_CNTF = 2 * MiB + 512 * 1024;
constexpr size_t WS_WIN = 6 * MiB;
constexpr size_t WIN_LAYER = (size_t)2816 * 1024 * 2;
constexpr size_t WS_WOUT = 17 * MiB;
constexpr size_t WS_WGU = 21 * MiB;
constexpr size_t WS_WD = 85 * MiB;
constexpr size_t WS_XA = 117 * MiB;
constexpr size_t WS_U = 181 * MiB;
constexpr size_t WS_HB = 213 * MiB;
constexpr size_t WS_S0 = 213 * MiB;
constexpr size_t WS_VT = 285 * MiB;
constexpr size_t WS_CONCAT = 301 * MiB;
constexpr size_t WS_MP = 333 * MiB;
constexpr size_t WS_NB = 357 * MiB;
constexpr size_t WS_MIX = 333 * MiB;
constexpr size_t WS_QT = 405 * MiB;
constexpr size_t WS_WT = 429 * MiB;
constexpr size_t WS_VTB = 453 * MiB;
constexpr size_t WS_GB = 465 * MiB;
constexpr size_t WS_VC = 477 * MiB;
constexpr size_t WS_BS = 489 * MiB;
constexpr size_t WS_XS = 213 * MiB;
constexpr size_t WS_HM = 293 * MiB;
constexpr size_t WS_YS = 333 * MiB;
constexpr size_t WS_END = 490 * MiB;

constexpr int NWAVES = 8, NTHREADS = 512;
constexpr int LDS_BYTES = 152 * 1024;

DI unsigned cvtpk(float lo, float hi) { f32x2_t v = {lo, hi}; bf16x2_t b = __builtin_convertvector(v, bf16x2_t); return __builtin_bit_cast(unsigned, b); }
DI float bflo(unsigned w) { return __uint_as_float(w << 16); }
DI float bfhi(unsigned w) { return __uint_as_float(w & 0xffff0000u); }
DI float bf2f(unsigned short h) { return __uint_as_float((unsigned)h << 16); }
DI unsigned short f2bf(float f) { return (unsigned short)(cvtpk(f, 0.f) & 0xffffu); }
DI float wave_sum_shfl(float v) {
#pragma unroll
    for (int o = 32; o > 0; o >>= 1) v += __shfl_xor(v, o);
    return v;
}
template <int CTRL, int ROWMASK> DI float dpp_add(float v) { return v + __builtin_bit_cast(float, __builtin_amdgcn_update_dpp(0, __builtin_bit_cast(int, v), CTRL, ROWMASK, 0xf, false)); }
DI float wave_sum(float v) {
    v = dpp_add<0xb1, 0xf>(v);
    v = dpp_add<0x4e, 0xf>(v);
    v = dpp_add<0x124, 0xf>(v);
    v = dpp_add<0x128, 0xf>(v);
    v = dpp_add<0x142, 0xa>(v);
    v = dpp_add<0x143, 0xc>(v);
    return __builtin_bit_cast(float, __builtin_amdgcn_readlane(__builtin_bit_cast(int, v), 63));
}
DI float sigm(float x) { return 1.f / (1.f + __expf(-x)); }
#define LDS_WAIT() asm volatile("s_waitcnt lgkmcnt(0)" ::: "memory")
#define VM_WAIT() asm volatile("s_waitcnt vmcnt(0)" ::: "memory")
DI int swap23(int i) { return (i & ~12) | ((i & 4) << 1) | ((i & 8) >> 1); }

namespace pg8 {
constexpr int BM = 256, BK = 64, HALF = 128, HTB = HALF * BK * 2, STAGE_BYTES = 8 * HTB, NXCD = 8, WGM = 8;
__host__ __device__ __forceinline__ int lds_byte(int r, int c) { const int st = (r >> 4) * 2 + (c >> 5), rr = r & 15, cc = c & 31, ob = rr * 64 + cc * 2; return st * 1024 + (ob ^ (((ob >> 9) & 1) << 5)); }
__host__ __device__ __forceinline__ void stage_rc(int b, int& R, int& C) { const int st = b / 1024, sb = b % 1024, swz = sb ^ (((sb >> 9) & 1) << 5); R = (st >> 1) * 16 + swz / 64; C = (st & 1) * 32 + (swz % 64) / 2; }
__host__ __device__ __forceinline__ int perm32(int rho) { const int n = rho >> 4, i = rho & 15; return 8 * (i >> 2) + 4 * n + (i & 3); }

struct Unit { int pm, pn, aux; };

DI int xcd_remap(int L, int nwg) { const int q = nwg / NXCD, r = nwg % NXCD, xcd = L % NXCD, off = L / NXCD; return (xcd < r ? xcd * (q + 1) : r * (q + 1) + (xcd - r) * q) + off; }

struct PlainOrder {
    const bf16_t* A; const bf16_t* Bt; int K; int nM, nN, nwg, G, c;
    DI void init(const bf16_t* A_, const bf16_t* Bt_, int M, int N, int K_, int G_, int c_) { A = A_; Bt = Bt_; K = K_; nM = M / BM; nN = N / BM; nwg = nM * nN; G = G_; c = c_; }
    DI bool next(int i, Unit& u) const {
        const int Lx = i * G + c; if (Lx >= nwg) return false;
        const int wgid = xcd_remap(Lx, nwg);
        const int nig = WGM * nN, gid = wgid / nig, fm = gid * WGM, gsz = (nM - fm) < WGM ? (nM - fm) : WGM;
        u.pm = fm + ((wgid % nig) % gsz); u.pn = (wgid % nig) / gsz; u.aux = 0; return true;
    }
    DI const char* aptr(const Unit& u) const { return (const char*)A + (size_t)u.pm * (2 * HALF) * K * 2; }
    DI const char* bptr(const Unit& u) const { return (const char*)Bt + (size_t)u.pn * (2 * HALF) * K * 2; }
};
struct Gemm1Order {
    const bf16_t* U; const bf16_t* Win; const bf16_t* Wv; int G, c;
    static constexpr int nM = T / BM, nN = HW / BM, nMain = nM * nN, nV = 2 * (T / BM), nwg = nMain + nV, K = D;
    DI bool next(int i, Unit& u) const {
        const int Lx = i * G + c; if (Lx >= nwg) return false;
        if (Lx < nMain) {
            const int wgid = xcd_remap(Lx, nMain);
            const int nig = WGM * nN, gid = wgid / nig, fm = gid * WGM, gsz = (nM - fm) < WGM ? (nM - fm) : WGM;
            u.pm = fm + ((wgid % nig) % gsz); u.pn = (wgid % nig) / gsz; u.aux = 0;
        } else { const int v = Lx - nMain; u.pm = v & 1; u.pn = v >> 1; u.aux = 1; }
        return true;
    }
    DI const char* aptr(const Unit& u) const { return (const char*)(u.aux ? Wv : U) + (size_t)u.pm * BM * K * 2; }
    DI const char* bptr(const Unit& u) const { return (const char*)(u.aux ? U : Win) + (size_t)u.pn * BM * K * 2; }
};
struct GroupedOrder {
    const bf16_t* A; const bf16_t* Bt; int K; size_t estride; const LAS int* tile_e; int ntiles, nwg, G, c;
    DI bool next(int i, Unit& u) const {
        const int Lx = i * G + c; if (Lx >= nwg) return false;
        const int wgid = xcd_remap(Lx, nwg);
        u.pm = wgid >> 2; u.pn = wgid & 3; u.aux = tile_e[u.pm]; return true;
    }
    DI const char* aptr(const Unit& u) const { return (const char*)A + (size_t)u.pm * BM * K * 2; }
    DI const char* bptr(const Unit& u) const { return (const char*)Bt + ((size_t)u.aux * estride + (size_t)u.pn * BM * K) * 2; }
};

struct EpiStore {
    bf16_t* O0; int ld0; bf16_t* O1; int ld1;
    DI void operator()(const f32x4 (&acc)[2][2][4][2], const Unit& u, int wr, int wc, int fr, int fq) const {
        bf16_t* base = u.aux ? O1 : O0; const int ldc = u.aux ? ld1 : ld0;
        const int row0 = u.pm * BM + wr * 64 + fr, col0 = u.pn * BM + wc * 32 + 8 * fq;
#pragma unroll
        for (int ai = 0; ai < 2; ++ai)
#pragma unroll
            for (int m = 0; m < 4; ++m) { bf16_t* rowp = base + (size_t)(row0 + ai * HALF + m * 16) * ldc + col0;
#pragma unroll
                for (int bj = 0; bj < 2; ++bj) { const f32x4 v0 = acc[ai][bj][m][0], v1 = acc[ai][bj][m][1];
                    u32x4 w; w.x = cvtpk(v0[0], v0[1]); w.y = cvtpk(v0[2], v0[3]); w.z = cvtpk(v1[0], v1[1]); w.w = cvtpk(v1[2], v1[3]);
                    *(u32x4*)(rowp + bj * HALF) = w; } }
    }
};
struct EpiSwiGlu {
    bf16_t* O;
    DI void operator()(const f32x4 (&acc)[2][2][4][2], const Unit& u, int wr, int wc, int fr, int fq) const {
        const int row0 = u.pm * BM + wr * 64 + fr, col0 = u.pn * HALF + wc * 32 + 8 * fq;
#pragma unroll
        for (int ai = 0; ai < 2; ++ai)
#pragma unroll
            for (int m = 0; m < 4; ++m) { bf16_t* rowp = O + (size_t)(row0 + ai * HALF + m * 16) * DE + col0;
                float hv[8];
#pragma unroll
                for (int n = 0; n < 2; ++n)
#pragma unroll
                    for (int e = 0; e < 4; ++e) { const float g = acc[ai][0][m][n][e], up = acc[ai][1][m][n][e]; hv[4 * n + e] = g * sigm(g) * up; }
                u32x4 w; w.x = cvtpk(hv[0], hv[1]); w.y = cvtpk(hv[2], hv[3]); w.z = cvtpk(hv[4], hv[5]); w.w = cvtpk(hv[6], hv[7]);
                *(u32x4*)rowp = w; }
    }
};
struct EpiRowScale {
    bf16_t* O; const float* roww;
    DI void operator()(const f32x4 (&acc)[2][2][4][2], const Unit& u, int wr, int wc, int fr, int fq) const {
        const int row0 = u.pm * BM + wr * 64 + fr, col0 = u.pn * BM + wc * 32 + 8 * fq;
#pragma unroll
        for (int ai = 0; ai < 2; ++ai)
#pragma unroll
            for (int m = 0; m < 4; ++m) { const int row = row0 + ai * HALF + m * 16;
#ifdef MOEB_NOSCALE
                const float s = 1.f;
#else
                const float s = roww[row];
#endif
                bf16_t* rowp = O + (size_t)row * D + col0;
#pragma unroll
                for (int bj = 0; bj < 2; ++bj) { const f32x4 v0 = acc[ai][bj][m][0] * s, v1 = acc[ai][bj][m][1] * s;
                    u32x4 w; w.x = cvtpk(v0[0], v0[1]); w.y = cvtpk(v0[2], v0[3]); w.z = cvtpk(v1[0], v1[1]); w.w = cvtpk(v1[2], v1[3]);
                    *(u32x4*)(rowp + bj * HALF) = w; } }
    }
};

template <class Epi, class Sched>
DI void gemm_phase(LAS unsigned char* lds, const int tid, const int K, const Sched& S, const Epi& E) {
    const int wid = __builtin_amdgcn_readfirstlane(tid >> 6), lane = tid & 63, wr = wid >> 2, wc = wid & 3, fr = lane & 15, fq = lane >> 4;
    const int nt = K / BK;
    unsigned voffA[2], voffB[2];
#pragma unroll
    for (int i = 0; i < 2; ++i) { int R, C; stage_rc(tid * 16 + i * 8192, R, C); const int Rb = (R & ~31) + perm32(R & 31);
        voffA[i] = (unsigned)(R * K + C) * 2u; voffB[i] = (unsigned)(Rb * K + C) * 2u; }
    const size_t kstep = (size_t)(BK * 2);
    const size_t hstep = (size_t)HALF * K * 2;
    const unsigned ldsw = (unsigned)wid * 1024u;
    const int aoff = lds_byte(wr * 64 + fr, fq * 8), boff = lds_byte(wc * 32 + fr, fq * 8);
#define PG8_SA(b, h) (((b) * 2 + (h)) * HTB)
#define PG8_SB(b, h) ((4 + (b) * 2 + (h)) * HTB)
#define PG8_STAGE(bufoff, gbase, voff) do { _Pragma("unroll") for (int _i = 0; _i < 2; ++_i) \
        __builtin_amdgcn_global_load_lds((const unsigned*)((const char*)(gbase) + (voff)[_i]), (LAS unsigned*)(lds + (bufoff) + ldsw + _i * 8192), 16, 0, 0); } while (0)
#define PG8_LDA(dst, b, h) do { _Pragma("unroll") for (int m = 0; m < 4; ++m) _Pragma("unroll") for (int k = 0; k < 2; ++k) dst[m][k] = *(const LAS bf16x8*)(lds + PG8_SA(b, h) + aoff + m * 2048 + k * 1024); } while (0)
#define PG8_LDB(dst, b, h) do { _Pragma("unroll") for (int n = 0; n < 2; ++n) _Pragma("unroll") for (int k = 0; k < 2; ++k) dst[n][k] = *(const LAS bf16x8*)(lds + PG8_SB(b, h) + boff + n * 2048 + k * 1024); } while (0)
#define PG8_MMA(ai, bj, At, Bt) do { __builtin_amdgcn_s_setprio(1); _Pragma("unroll") for (int m = 0; m < 4; ++m) _Pragma("unroll") for (int n = 0; n < 2; ++n) _Pragma("unroll") for (int k = 0; k < 2; ++k) \
        acc[ai][bj][m][n] = __builtin_amdgcn_mfma_f32_16x16x32_bf16(Bt[n][k], At[m][k], acc[ai][bj][m][n], 0, 0, 0); __builtin_amdgcn_s_setprio(0); } while (0)
#define PG8_WAIT_V(n) asm volatile("s_waitcnt vmcnt(" #n ")" ::: "memory")
#define PG8_WAIT_L(n) asm volatile("s_waitcnt lgkmcnt(" #n ")" ::: "memory")
#define PG8_BAR __builtin_amdgcn_s_barrier()
#define PG8_SCHED __builtin_amdgcn_sched_barrier(0)
    Unit cur, nxt; int ui = 0;
    if (!S.next(0, cur)) return;
    f32x4 acc[2][2][4][2];
#pragma unroll
    for (int a = 0; a < 2; ++a)
#pragma unroll
        for (int b = 0; b < 2; ++b)
#pragma unroll
            for (int m = 0; m < 4; ++m)
#pragma unroll
                for (int n = 0; n < 2; ++n) acc[a][b][m][n] = (f32x4){0.f, 0.f, 0.f, 0.f};
    bf16x8 At[4][2], B0[2][2], B1[2][2];
    const char* cA = S.aptr(cur); const char* cB = S.bptr(cur);
    PG8_STAGE(PG8_SB(0, 0), cB, voffB); PG8_STAGE(PG8_SB(0, 1), cB + hstep, voffB); PG8_STAGE(PG8_SA(0, 0), cA, voffA); PG8_STAGE(PG8_SA(0, 1), cA + hstep, voffA);
    if (wr == 1) PG8_BAR;
    PG8_WAIT_V(2); PG8_BAR;
    PG8_STAGE(PG8_SB(1, 0), cB + kstep, voffB); PG8_STAGE(PG8_SA(1, 0), cA + kstep, voffA); PG8_STAGE(PG8_SB(1, 1), cB + hstep + kstep, voffB);
    PG8_WAIT_V(6); PG8_BAR;
    for (;;) {
        const bool has_next = S.next(ui + 1, nxt);
        const char* nA = has_next ? S.aptr(nxt) : cA; const char* nB = has_next ? S.bptr(nxt) : cB;
        for (int t = 0; t < nt; t += 2) {
            const bool last = (t == nt - 2);
            const char* a1 = cA + (size_t)(t + 1) * kstep;
            const char* a2 = last ? nA : cA + (size_t)(t + 2) * kstep; const char* b2 = last ? nB : cB + (size_t)(t + 2) * kstep;
            const char* a3 = a2 + kstep; const char* b3 = b2 + kstep;
            PG8_LDB(B0, 0, 0); PG8_LDB(B1, 0, 1); PG8_SCHED; PG8_LDA(At, 0, 0); PG8_STAGE(PG8_SA(1, 1), a1 + hstep, voffA);
            PG8_WAIT_V(8); PG8_WAIT_L(0); PG8_BAR; PG8_MMA(0, 0, At, B0); PG8_MMA(0, 1, At, B1); PG8_BAR; PG8_SCHED;
            PG8_LDA(At, 0, 1); PG8_STAGE(PG8_SB(0, 0), b2, voffB); PG8_STAGE(PG8_SB(0, 1), b2 + hstep, voffB); PG8_STAGE(PG8_SA(0, 0), a2, voffA);
            PG8_WAIT_V(8); PG8_WAIT_L(0); PG8_BAR; PG8_MMA(1, 0, At, B0); PG8_MMA(1, 1, At, B1); PG8_BAR; PG8_SCHED;
            PG8_LDB(B0, 1, 0); PG8_LDB(B1, 1, 1); PG8_SCHED; PG8_LDA(At, 1, 0); PG8_STAGE(PG8_SA(0, 1), a2 + hstep, voffA);
            PG8_WAIT_V(8); PG8_WAIT_L(0); PG8_BAR; PG8_MMA(0, 0, At, B0); PG8_MMA(0, 1, At, B1); PG8_BAR; PG8_SCHED;
            PG8_LDA(At, 1, 1); PG8_STAGE(PG8_SB(1, 0), b3, voffB); PG8_STAGE(PG8_SB(1, 1), b3 + hstep, voffB); PG8_STAGE(PG8_SA(1, 0), a3, voffA);
            PG8_WAIT_V(8); PG8_WAIT_L(0); PG8_BAR; PG8_MMA(1, 0, At, B0); PG8_MMA(1, 1, At, B1); PG8_BAR; PG8_SCHED;
        }
        if (wr == 0) PG8_BAR;
        E(acc, cur, wr, wc, fr, fq);
        if (!has_next) break;
#pragma unroll
        for (int a = 0; a < 2; ++a)
#pragma unroll
            for (int b = 0; b < 2; ++b)
#pragma unroll
                for (int m = 0; m < 4; ++m)
#pragma unroll
                    for (int n = 0; n < 2; ++n) acc[a][b][m][n] = (f32x4){0.f, 0.f, 0.f, 0.f};
        cur = nxt; cA = nA; cB = nB; ++ui;
        if (wr == 1) PG8_BAR;
    }
    PG8_WAIT_V(0);
    PG8_BAR;
#undef PG8_SA
#undef PG8_SB
#undef PG8_STAGE
#undef PG8_LDA
#undef PG8_LDB
#undef PG8_MMA
#undef PG8_WAIT_V
#undef PG8_WAIT_L
#undef PG8_BAR
#undef PG8_SCHED
}
}

#define XB_TMO      128
#define XB_XCNT(j)  (256  + 64 * (j))
#define XB_XSUB(j)  (1280 + 64 * (j))
#define XB_XGEN(j)  (2304 + 64 * (j))
#define XB_TOP      3328
#define XB_TOPGEN   3392
#define XCD_BAR_WORDS 3456
#define XB_SPIN_CAP (1u << 20)
DI unsigned xb_ld(unsigned* p)              { return __hip_atomic_load(p, __ATOMIC_RELAXED, __HIP_MEMORY_SCOPE_AGENT); }
DI unsigned xb_add(unsigned* p, unsigned v) { return __hip_atomic_fetch_add(p, v, __ATOMIC_RELAXED, __HIP_MEMORY_SCOPE_AGENT); }
DI unsigned xb_xcc_id() { return (unsigned)__builtin_amdgcn_s_getreg((3 << 11) | 20) & 0xFu; }
#define XB_SPIN(cond, bar) do { unsigned _sp = 0; while (cond) { __builtin_amdgcn_s_sleep(1); \
    if ((++_sp & 255u) == 0u) { if (xb_ld(&(bar)[XB_TMO])) break; if (_sp > XB_SPIN_CAP) { atomicAdd(&(bar)[XB_TMO], 1u); break; } } } } while (0)
struct XcdBarrier { unsigned* bar; unsigned x; volatile LAS unsigned* st; };
DI XcdBarrier xcd_barrier_post(unsigned* bar, volatile LAS unsigned* st) {
    XcdBarrier b; b.bar = bar; b.x = xb_xcc_id(); b.st = st;
    if (threadIdx.x == 0) (void)xb_add(&bar[XB_XCNT(b.x)], 1u);
    return b;
}
DI void xcd_barrier_complete(unsigned* bar, unsigned x, unsigned& nloc, unsigned& nx) {
    const unsigned G = gridDim.x * gridDim.y * gridDim.z;
    unsigned sum, cnt, mine, sp = 0u;
    for (;;) {
        sum = 0u; cnt = 0u; mine = 0u;
#pragma unroll
        for (unsigned j = 0; j < 16; ++j) { const unsigned c = xb_ld(&bar[XB_XCNT(j)]); sum += c; cnt += (c > 0u) ? 1u : 0u; mine = (j == x) ? c : mine; }
        if (sum == G) break;
        __builtin_amdgcn_s_sleep(1);
        if ((++sp & 255u) == 0u) { if (xb_ld(&bar[XB_TMO])) break; if (sp > XB_SPIN_CAP) { atomicAdd(&bar[XB_TMO], 1u); break; } }
    }
    nloc = mine > 0u ? mine : 1u; nx = cnt > 0u ? cnt : 1u;
}
DI void xcd_barrier(const XcdBarrier& b) {
    asm volatile("s_waitcnt vmcnt(0)" ::: "memory");
    __syncthreads();
    if (threadIdx.x == 0) {
        unsigned* bar = b.bar;
        __builtin_amdgcn_s_waitcnt(0);
        unsigned nloc = b.st[0], nx = b.st[1];
        if (nloc == 0u) { xcd_barrier_complete(bar, b.x, nloc, nx); b.st[0] = nloc; b.st[1] = nx; }
        const unsigned old = xb_add(&bar[XB_XSUB(b.x)], 1u);
        const unsigned gen = old / nloc;
        if (old + 1u == (gen + 1u) * nloc) {
            __builtin_amdgcn_fence(__ATOMIC_RELEASE, "agent");
            asm volatile("s_waitcnt vmcnt(0)" ::: "memory");
            const unsigned og = xb_add(&bar[XB_TOP], 1u);
            const unsigned tg = og / nx;
            if (og + 1u == (tg + 1u) * nx) xb_add(&bar[XB_TOPGEN], 1u);
            else XB_SPIN(xb_ld(&bar[XB_TOPGEN]) == tg, bar);
            __builtin_amdgcn_fence(__ATOMIC_ACQUIRE, "agent");
            xb_add(&bar[XB_XGEN(b.x)], 1u);
            asm volatile("s_waitcnt vmcnt(0)" ::: "memory");
        } else {
            XB_SPIN(xb_ld(&bar[XB_XGEN(b.x)]) == gen, bar);
            __builtin_amdgcn_fence(__ATOMIC_ACQUIRE, "agent");
            asm volatile("s_waitcnt vmcnt(0)" ::: "memory");
        }
    }
    __syncthreads();
}

struct Args { const float* in[31]; float* out; unsigned char* ws; int ph_lo, ph_hi, use_cg, pad; };
struct Frame {
    LAS unsigned char* lds;
    int tid, lane, wave, G, vcu, gw, ngw, bx;
    unsigned char* ws;
};
constexpr int LDS_MISC = 131072;
constexpr int LDS_BARST = LDS_BYTES - 64;

DI void transpose_item(const float* __restrict__ W, int ldw, int k0, int n0, bf16_t* __restrict__ WT, size_t dst_row0, int ldt, LAS float* scr, int lane) {
#pragma unroll 4
    for (int kk = 0; kk < 64; kk += 4) {
        const int k = kk + (lane >> 4), n = 4 * (lane & 15);
        const float4 v = *(const float4*)(W + (size_t)(k0 + k) * ldw + n0 + n);
        LAS float* s = scr + k * 65 + n; s[0] = v.x; s[1] = v.y; s[2] = v.z; s[3] = v.w;
    }
    LDS_WAIT();
#pragma unroll
    for (int j = 0; j < 8; ++j) {
        const int n = 8 * j + (lane >> 3), c = lane & 7; const LAS float* s = scr + (8 * c) * 65 + n;
        u32x4 o; o.x = cvtpk(s[0], s[65]); o.y = cvtpk(s[130], s[195]); o.z = cvtpk(s[260], s[325]); o.w = cvtpk(s[390], s[455]);
        *(u32x4*)(WT + (dst_row0 + n) * ldt + k0 + 8 * c) = o;
    }
    LDS_WAIT();
}
constexpr int IT_WIN = 16 * 42, IT_WOUT = 16 * 16, IT_SMALL = IT_WIN + IT_WOUT;
constexpr int IT_EXP = 128 * 3, IT_MOE = NE * IT_EXP;
DI void conv_small_item(const Frame& F, const float* w_in, const float* w_out, int l, int it, LAS float* scr) {
    bf16_t* WIN = (bf16_t*)(F.ws + WS_WIN + (size_t)l * WIN_LAYER);
    if (it < IT_WIN) {
        const int kt = it / 42, nt = it % 42, n0 = 64 * nt;
        size_t drow;
        if (n0 < 768) drow = n0; else if (n0 < 1152) drow = 2304 + (n0 - 768); else drow = n0 - 384;
        transpose_item(w_in + (size_t)l * D * INW, INW, 64 * kt, n0, WIN, drow, D, scr, F.lane);
    } else {
        const int r = it - IT_WIN, kt = r >> 4, nt = r & 15;
        transpose_item(w_out + (size_t)l * D * D, D, 64 * kt, 64 * nt, (bf16_t*)(F.ws + WS_WOUT) + (size_t)l * D * D, 64 * nt, D, scr, F.lane);
    }
}
DI void conv_moe_item(const Frame& F, const float* wg, const float* wu, const float* wd, int l, int it, LAS float* scr) {
    const int e = it / IT_EXP, r = it % IT_EXP, which = r >> 7, q = r & 127;
    bf16_t* WGU = (bf16_t*)(F.ws + WS_WGU) + (size_t)e * D * D;
    if (which < 2) {
        const int kt = q >> 3, nt = q & 7, n0 = 64 * nt;
        const float* src = (which ? wu : wg) + ((size_t)l * NE + e) * D * DE;
        const size_t drow = (size_t)(n0 >> 7) * 256 + (which ? 128 : 0) + (n0 & 127);
        transpose_item(src, DE, 64 * kt, n0, WGU, drow, D, scr, F.lane);
    } else {
        const int kt = q >> 4, nt = q & 15;
        transpose_item(wd + ((size_t)l * NE + e) * DE * D, D, 64 * kt, 64 * nt, (bf16_t*)(F.ws + WS_WD) + (size_t)e * D * DE, 64 * nt, DE, scr, F.lane);
    }
}
DI void p0_prologue(const Frame& F, const Args& a) {
    const float* c = a.in[1]; const float* w_mod = a.in[2]; const float* b_mod = a.in[3];
    if (F.bx < L * (MODW / 64)) {
        LAS float* sc = (LAS float*)(F.lds);
        LAS float* red = (LAS float*)(F.lds + 8192);
        for (int i = F.tid; i < NB * D; i += NTHREADS) { const float v = c[i]; sc[i] = v / (1.f + expf(-v)); }
        __syncthreads();
        const int l = F.bx / (MODW / 64), cb = F.bx % (MODW / 64), n = cb * 64 + F.lane;
        const float* w = w_mod + (size_t)l * D * MODW + n;
        float a0 = 0.f, a1 = 0.f;
#pragma unroll 8
        for (int k = F.wave * 128; k < F.wave * 128 + 128; ++k) { const float wv = w[(size_t)k * MODW]; a0 += sc[k] * wv; a1 += sc[D + k] * wv; }
        red[(F.wave * 2 + 0) * 64 + F.lane] = a0; red[(F.wave * 2 + 1) * 64 + F.lane] = a1;
        __syncthreads();
        if (F.tid < 128) { const int b = F.tid >> 6, ln = F.tid & 63; float s = 0.f;
#pragma unroll
            for (int w8 = 0; w8 < 8; ++w8) s += red[(w8 * 2 + b) * 64 + ln];
            const int nn = cb * 64 + ln;
            ((float*)(F.ws + WS_MOD))[(size_t)(l * NB + b) * MODW + nn] = s + b_mod[l * MODW + nn]; }
        __syncthreads();
    }
    { const int nzero = L * 128 * D / 8;
      for (int i = F.gw * 64 + F.lane; i < nzero; i += F.ngw * 64) { const int l = i / (128 * D / 8), r = i % (128 * D / 8);
          *(u32x4*)((bf16_t*)(F.ws + WS_WIN + (size_t)l * WIN_LAYER) + (size_t)(2304 + 384) * D + (size_t)r * 8) = (u32x4){0u, 0u, 0u, 0u}; } }
    LAS float* scr = (LAS float*)(F.lds + 16384) + F.wave * (64 * 65);
    for (int it = F.gw; it < L * IT_SMALL; it += F.ngw) conv_small_item(F, a.in[4], a.in[19], it / IT_SMALL, it % IT_SMALL, scr);
}

DI void row_ln(f32x4 (&v)[4], float& mean_out, float& rstd_out) {
    float s = 0.f;
#pragma unroll
    for (int j = 0; j < 4; ++j) s += (v[j][0] + v[j][1]) + (v[j][2] + v[j][3]);
    const float mean = wave_sum(s) * (1.f / D); float q = 0.f;
#pragma unroll
    for (int j = 0; j < 4; ++j) { v[j] = v[j] - mean; q += (v[j][0] * v[j][0] + v[j][1] * v[j][1]) + (v[j][2] * v[j][2] + v[j][3] * v[j][3]); }
    mean_out = mean; rstd_out = 1.f / sqrtf(wave_sum(q) * (1.f / D) + LN_EPS);
}
DI void row_mod_store(f32x4 (&v)[4], const float* md, int off_sh, int off_sc, bf16_t* urow, int lane) {
    float mean, rstd; row_ln(v, mean, rstd);
#pragma unroll
    for (int j = 0; j < 4; ++j) { const int col = 4 * lane + 256 * j;
        const f32x4 scv = *(const f32x4*)(md + off_sc + col), shv = *(const f32x4*)(md + off_sh + col);
        v[j] = v[j] * rstd * (1.f + scv) + shv;
        u32x2 w; w.x = cvtpk(v[j][0], v[j][1]); w.y = cvtpk(v[j][2], v[j][3]);
        *(u32x2*)(urow + col) = w; }
}
DI void p_r0(const Frame& F, const float* x) {
    const float* MOD = (const float*)(F.ws + WS_MOD);
    bf16_t* U = (bf16_t*)(F.ws + WS_U);
    for (int row = F.gw; row < T; row += F.ngw) {
        f32x4 v[4];
#pragma unroll
        for (int j = 0; j < 4; ++j) v[j] = *(const f32x4*)(x + (size_t)row * D + 4 * F.lane + 256 * j);
        row_mod_store(v, MOD + (size_t)(row / S) * MODW, 0, D, U + (size_t)row * D, F.lane);
    }
}

constexpr int NGRP = T / 64;
DI void p_rowpass1(const Frame& F, const Args& a, int l, const float* xin, const bool dry = false) {
    const float* MODl = (const float*)(F.ws + WS_MOD) + (size_t)l * NB * MODW;
    const bf16_t* MIX = (const bf16_t*)(F.ws + WS_MIX);
    float* XA = (float*)(F.ws + WS_XA); bf16_t* U = (bf16_t*)(F.ws + WS_U);
    const float* gain = a.in[20] + (size_t)l * D; const float* bias = a.in[21] + (size_t)l * D;
    const float* wg = a.in[24] + (size_t)l * D * NG; const float* bg = a.in[25] + (size_t)l * NG;
    const float* we = a.in[26] + (size_t)l * D * NE; const float* be = a.in[27] + (size_t)l * NE;
    const size_t dro = dry ? 490 * MiB - WS_BC : 0;
    int* BC = (int*)(F.ws + WS_BC + dro); float* TOKW = (float*)(F.ws + WS_TOKW + dro); int* TOKSLOT = (int*)(F.ws + WS_TOKSLOT + (dry ? 496 * MiB - WS_TOKSLOT : 0));
    LAS float* RT = (LAS float*)F.lds;
    LAS unsigned* cntl = (LAS unsigned*)(F.lds + 36 * D * 4 + NWAVES * 72 * 4);
    for (int i = F.tid; i < D * 9; i += NTHREADS) { const int k = i / 9, q = i % 9;
        const f32x4 v = q == 0 ? *(const f32x4*)(wg + (size_t)k * NG) : *(const f32x4*)(we + (size_t)k * NE + 4 * (q - 1));
        const int n0 = q == 0 ? 0 : 4 * q;
        RT[(n0 + 0) * D + k] = v[0]; RT[(n0 + 1) * D + k] = v[1]; RT[(n0 + 2) * D + k] = v[2]; RT[(n0 + 3) * D + k] = v[3]; }
    for (int grp = F.vcu; grp < NGRP; grp += F.G) {
    if (F.tid < NE) cntl[F.tid] = 0u;
    __syncthreads();
    for (int rp = 0; rp < 4; ++rp) {
        const int row0 = 64 * grp + 8 * F.wave + 2 * rp; const float* md = MODl + (size_t)(row0 / S) * MODW;
        f32x4 va[4], vb[4];
#pragma unroll
        for (int j = 0; j < 4; ++j) { const int col = 4 * F.lane + 256 * j;
            const f32x4 g = *(const f32x4*)(md + 2 * D + col);
            const f32x4 xa = *(const f32x4*)(xin + (size_t)row0 * D + col), xb = *(const f32x4*)(xin + (size_t)(row0 + 1) * D + col);
            const u32x2 ma = *(const u32x2*)(MIX + (size_t)row0 * D + col), mb = *(const u32x2*)(MIX + (size_t)(row0 + 1) * D + col);
            va[j] = xa * ALPHA + g * (f32x4){bflo(ma.x), bfhi(ma.x), bflo(ma.y), bfhi(ma.y)};
            vb[j] = xb * ALPHA + g * (f32x4){bflo(mb.x), bfhi(mb.x), bflo(mb.y), bfhi(mb.y)}; }
        float mean, rstd;
        row_ln(va, mean, rstd);
#pragma unroll
        for (int j = 0; j < 4; ++j) { const int col = 4 * F.lane + 256 * j; va[j] = va[j] * rstd * *(const f32x4*)(gain + col) + *(const f32x4*)(bias + col); *(f32x4*)(XA + (size_t)row0 * D + col) = va[j]; }
        row_ln(vb, mean, rstd);
#pragma unroll
        for (int j = 0; j < 4; ++j) { const int col = 4 * F.lane + 256 * j; vb[j] = vb[j] * rstd * *(const f32x4*)(gain + col) + *(const f32x4*)(bias + col); *(f32x4*)(XA + (size_t)(row0 + 1) * D + col) = vb[j]; }
        row_mod_store(va, md, 3 * D, 4 * D, U + (size_t)row0 * D, F.lane);
        row_mod_store(vb, md, 3 * D, 4 * D, U + (size_t)(row0 + 1) * D, F.lane);
        LAS float* lg = (LAS float*)(F.lds + 36 * D * 4) + F.wave * 72;
#pragma unroll 1
        for (int n = 0; n < 36; ++n) { float sa = 0.f, sb = 0.f;
#pragma unroll
            for (int j = 0; j < 4; ++j) { const f32x4 w = *(const LAS f32x4*)(RT + n * D + 4 * F.lane + 256 * j);
                sa += (va[j][0] * w[0] + va[j][1] * w[1]) + (va[j][2] * w[2] + va[j][3] * w[3]);
                sb += (vb[j][0] * w[0] + vb[j][1] * w[1]) + (vb[j][2] * w[2] + vb[j][3] * w[3]); }
            sa = wave_sum(sa); sb = wave_sum(sb);
            if (F.lane == 0) { lg[n] = sa; lg[36 + n] = sb; } }
        LDS_WAIT();
#pragma unroll
        for (int rr = 0; rr < 2; ++rr) {
            float gl[4], el[32];
#pragma unroll
            for (int n = 0; n < 4; ++n) gl[n] = lg[36 * rr + n] + bg[n];
#pragma unroll
            for (int n = 0; n < 32; ++n) el[n] = lg[36 * rr + 4 + n] + be[n];
            int gi = 0; float gm = gl[0];
#pragma unroll
            for (int n = 1; n < 4; ++n) if (gl[n] > gm) { gm = gl[n]; gi = n; }
            float se = 0.f;
#pragma unroll
            for (int n = 0; n < 4; ++n) se += expf(gl[n] - gm);
            const float pg = 1.f / se;
            float l1 = -3.0e38f, l2 = -3.0e38f; int i1 = 0, i2 = 0;
#pragma unroll
            for (int n = 0; n < 32; ++n) if ((n >> 3) == gi) { const float v = el[n]; const int e = n & 7;
                if (v > l1) { l2 = l1; i2 = i1; l1 = v; i1 = e; } else if (v > l2) { l2 = v; i2 = e; } }
            const float e2 = expf(l2 - l1); const float w1 = pg / (1.f + e2), w2 = pg * e2 / (1.f + e2);
            if (F.lane == 0) {
                const int tok = row0 + rr, ea = gi * EPG + i1, eb = gi * EPG + i2;
                const unsigned pa = __hip_atomic_fetch_add(&cntl[ea], 1u, __ATOMIC_RELAXED, __HIP_MEMORY_SCOPE_WORKGROUP), pb = __hip_atomic_fetch_add(&cntl[eb], 1u, __ATOMIC_RELAXED, __HIP_MEMORY_SCOPE_WORKGROUP);
                TOKSLOT[tok * 2] = (ea << 14) | (int)pa; TOKSLOT[tok * 2 + 1] = (eb << 14) | (int)pb;
                TOKW[tok * 2] = w1; TOKW[tok * 2 + 1] = w2;
            }
        }
    }
    __syncthreads();
    if (F.tid < NE) BC[grp * NE + F.tid] = (int)cntl[F.tid];
    __syncthreads();
    }
}

DI void build_tables(const Frame& F, int l, LAS int* tb) {
    if (F.tid == 0) {
        const int* CNTF = (const int*)(F.ws + WS_CNTF);
        int cum = 0, off = 0, nt = 0;
        for (int e = 0; e < NE; ++e) { const int c = CNTF[e];
            tb[e] = cum; tb[33 + e] = off; const int tl = (c + 255) >> 8;
            for (int t2 = 0; t2 < tl; ++t2) tb[66 + nt + t2] = e;
            nt += tl; cum += c; off += tl * 256; }
        tb[32] = cum; tb[65] = nt;
    }
    __syncthreads();
}
DI void p_gather(const Frame& F, int l) {
    LAS int* base = (LAS int*)F.lds;
    LAS int* segt = base + NGRP * NE;
    LAS int* offp = segt + 16 * NE;
    const int* BC = (const int*)(F.ws + WS_BC);
    for (int i = F.tid; i < NGRP * NE; i += NTHREADS) base[i] = BC[i];
    __syncthreads();
    { const int e = F.tid & 31, sg = F.tid >> 5; int run = 0;
      for (int g = 16 * sg; g < 16 * sg + 16; ++g) { const int c = base[g * NE + e]; base[g * NE + e] = run; run += c; }
      segt[sg * NE + e] = run; }
    __syncthreads();
    if (F.tid < NE) { int run = 0; for (int sg = 0; sg < 16; ++sg) { const int c = segt[sg * NE + F.tid]; segt[sg * NE + F.tid] = run; run += c; }
        offp[F.tid] = run;
        if (F.bx == 0) ((int*)(F.ws + WS_CNTF))[F.tid] = run; }
    __syncthreads();
    if (F.tid == 0) { int off = 0; for (int e = 0; e < NE; ++e) { const int c = offp[e]; offp[e] = off; off += ((c + 255) >> 8) * 256; } }
    __syncthreads();
    const int* TOKSLOT = (const int*)(F.ws + WS_TOKSLOT); const float* TOKW = (const float*)(F.ws + WS_TOKW); int* TOKFIN = (int*)(F.ws + WS_TOKFIN);
    const bf16_t* U = (const bf16_t*)(F.ws + WS_U); bf16_t* XS = (bf16_t*)(F.ws + WS_XS); float* SLOTW = (float*)(F.ws + WS_SLOTW);
    for (int as = F.gw; as < 2 * T; as += F.ngw) {
        const int tok = as >> 1, ts = TOKSLOT[as], e = ts >> 14, grp = tok >> 6, sg = grp >> 4;
        const int slot = offp[e] + segt[sg * NE + e] + base[grp * NE + e] + (ts & 16383);
        const u32x4* src = (const u32x4*)(U + (size_t)tok * D); u32x4* dst = (u32x4*)(XS + (size_t)slot * D);
        dst[F.lane] = src[F.lane]; dst[64 + F.lane] = src[64 + F.lane];
        if (F.lane == 0) { SLOTW[slot] = TOKW[as]; TOKFIN[as] = slot; }
    }
}
DI void p_rowpass2(const Frame& F, const Args& a, int l, float* xout) {
    const float* MOD = (const float*)(F.ws + WS_MOD);
    const float* XA = (const float*)(F.ws + WS_XA); const bf16_t* YS = (const bf16_t*)(F.ws + WS_YS); const int* TOKFIN = (const int*)(F.ws + WS_TOKFIN);
    const float* gain = a.in[22] + (size_t)l * D; const float* bias = a.in[23] + (size_t)l * D;
    bf16_t* U = (bf16_t*)(F.ws + WS_U);
    for (int row = F.gw; row < T; row += F.ngw) {
        const float* md = MOD + (size_t)(l * NB + row / S) * MODW;
        const int s0 = TOKFIN[row * 2], s1 = TOKFIN[row * 2 + 1];
        f32x4 v[4];
#pragma unroll
        for (int j = 0; j < 4; ++j) { const int col = 4 * F.lane + 256 * j;
            const f32x4 g = *(const f32x4*)(md + 5 * D + col), xv = *(const f32x4*)(XA + (size_t)row * D + col);
            const u32x2 y0 = *(const u32x2*)(YS + (size_t)s0 * D + col), y1 = *(const u32x2*)(YS + (size_t)s1 * D + col);
            const f32x4 f = (f32x4){bflo(y0.x) + bflo(y1.x), bfhi(y0.x) + bfhi(y1.x), bflo(y0.y) + bflo(y1.y), bfhi(y0.y) + bfhi(y1.y)};
            v[j] = xv * ALPHA + g * f; }
        float mean, rstd; row_ln(v, mean, rstd);
#pragma unroll
        for (int j = 0; j < 4; ++j) { const int col = 4 * F.lane + 256 * j; v[j] = v[j] * rstd * *(const f32x4*)(gain + col) + *(const f32x4*)(bias + col); *(f32x4*)(xout + (size_t)row * D + col) = v[j]; }
        if (l + 1 < L) row_mod_store(v, MOD + (size_t)((l + 1) * NB + row / S) * MODW, 0, D, U + (size_t)row * D, F.lane);
    }
}

#define MFMA16(a, b, c) __builtin_amdgcn_mfma_f32_16x16x32_bf16((a), (b), (c), 0, 0, 0)
#define MFMA32(a, b, c) __builtin_amdgcn_mfma_f32_32x32x16_bf16((a), (b), (c), 0, 0, 0)
constexpr int RB = 9216;
#define BUF(i) ((i) * RB)
constexpr int LWOFF = BUF(12), ZAOFF = BUF(0), SEGOFF = BUF(14), SEGXOFF = BUF(14) + 2048, TOTOFF = BUF(14) + 4096, NABFOFF = BUF(15), PCOFF = 16 * RB;
struct RwP { const float *conv, *w0, *w_up, *a0, *a_up, *g_up, *k_k, *k_a, *r_k, *gn_gain, *gn_bias; };

DI bf16x8 ldfrag(const LAS unsigned char* lds, int buf, int row, int ks, int lane) { return *(const LAS bf16x8*)(lds + buf + row * 144 + (32 * ks + 8 * (lane >> 4)) * 2); }
DI f32x4 mm64(const LAS unsigned char* lds, int abuf, int arow0, int bbuf, int brow0, int lane) {
    f32x4 acc = (f32x4){0.f, 0.f, 0.f, 0.f};
#pragma unroll
    for (int ks = 0; ks < 2; ++ks) acc = MFMA16(ldfrag(lds, abuf, arow0 + (lane & 15), ks, lane), ldfrag(lds, bbuf, brow0 + (lane & 15), ks, lane), acc);
    return acc;
}
DI u32x2 pack4(const f32x4 v) { u32x2 w; w.x = cvtpk(v[0], v[1]); w.y = cvtpk(v[2], v[3]); return w; }
DI f32x4 unpack4(const u32x2 w) { return (f32x4){bflo(w.x), bfhi(w.x), bflo(w.y), bfhi(w.y)}; }
DI void st4(LAS unsigned char* lds, int buf, int row, int col, const f32x4 v) { *(LAS u32x2*)(lds + buf + row * 144 + col * 2) = pack4(v); }
DI f32x4 ld4(const LAS unsigned char* lds, int buf, int row, int col) { return unpack4(*(const LAS u32x2*)(lds + buf + row * 144 + col * 2)); }
DI void st1(LAS unsigned char* lds, int buf, int row, int col, float v) { *(LAS bf16_t*)(lds + buf + row * 144 + col * 2) = f2bf(v); }
DI float fast_tanh(float x) { const float e = __expf(2.f * x); return 1.f - 2.f / (1.f + e); }

#define OPQZ(z) int z; asm volatile("s_mov_b32 %0, 0" : "=s"(z))
DI void rwkv_local_unit(const Frame& F, const Args& a, const int l, const int unit) {
    LAS unsigned char* lds = F.lds;
    const int tid = F.tid, lane = F.lane, wave = F.wave;
    const int c = unit % NCH, hd = (unit / NCH) % BH, b = (unit / (NCH * BH)) % NB, dir = unit / (NCH * BH * NB);
    const bf16_t* HBp = (const bf16_t*)(F.ws + WS_HB);
    const int u = tid >> 3, jg = tid & 7, tau = dir ? 63 - u : u, tloc = 64 * c + u;
    const size_t tok = (size_t)b * S + tloc;
    const int tn = wave & 3, tm0 = 2 * (wave >> 2), g4 = lane >> 4, l15 = lane & 15;
    {
        const bf16_t* hrow = HBp + tok * HW;
        const u32x2 wv = *(const u32x2*)(hrow + HWL + 4 * jg), av = *(const u32x2*)(hrow + HAL + 4 * jg);
        const f32x4 wf = unpack4(wv);
        *(LAS u32x2*)(lds + BUF(8) + tau * 144 + (4 * jg) * 2) = pack4((f32x4){fast_tanh(wf[0]), fast_tanh(wf[1]), fast_tanh(wf[2]), fast_tanh(wf[3])});
        *(LAS u32x2*)(lds + BUF(8) + tau * 144 + (32 + 4 * jg) * 2) = av;
        const u32x4 gv = *(const u32x4*)(hrow + HGL + 8 * jg);
        u32x4 so; so.x = cvtpk(sigm(bflo(gv.x)), sigm(bfhi(gv.x))); so.y = cvtpk(sigm(bflo(gv.y)), sigm(bfhi(gv.y))); so.z = cvtpk(sigm(bflo(gv.z)), sigm(bfhi(gv.z))); so.w = cvtpk(sigm(bflo(gv.w)), sigm(bfhi(gv.w)));
        *(LAS u32x4*)(lds + BUF(9) + tau * 144 + 16 * jg) = so;
        OPQZ(z0);
        { const int m = tid >> 4, j4 = (tid & 15) * 4;
          const float* w_up = a.in[8 + z0] + (size_t)l * 2 * RW * BW; const float* a_up = a.in[10 + z0] + (size_t)l * 2 * RA * BW;
          const f32x4 w4 = *(const f32x4*)(w_up + (size_t)(dir * RW + m) * BW + hd * HD + j4), a4 = *(const f32x4*)(a_up + (size_t)(dir * RA + m) * BW + hd * HD + j4);
#pragma unroll
          for (int e = 0; e < 4; ++e) { st1(lds, BUF(10), j4 + e, m, w4[e]); st1(lds, BUF(10), j4 + e, 32 + m, a4[e]); } }
        { const int m = tid >> 3, i8 = (tid & 7) * 8;
          const float* g_up = a.in[11 + z0] + (size_t)l * RG * BW;
          const f32x4 g0 = *(const f32x4*)(g_up + (size_t)m * BW + hd * HD + i8), g1 = *(const f32x4*)(g_up + (size_t)m * BW + hd * HD + i8 + 4);
#pragma unroll
          for (int e = 0; e < 4; ++e) { st1(lds, BUF(11), i8 + e, m, g0[e]); st1(lds, BUF(11), i8 + 4 + e, m, g1[e]); } }
    }
    __syncthreads();
#pragma unroll
    for (int tmi = 0; tmi < 2; ++tmi) {
        const int tm = tm0 + tmi; const f32x4 z = (f32x4){0.f, 0.f, 0.f, 0.f};
        const f32x4 zw = MFMA16(ldfrag(lds, BUF(10), 16 * tm + l15, 0, lane), ldfrag(lds, BUF(8), 16 * tn + l15, 0, lane), z);
        const f32x4 za = MFMA16(ldfrag(lds, BUF(10), 16 * tm + l15, 1, lane), ldfrag(lds, BUF(8), 16 * tn + l15, 1, lane), z);
        const int trow = 16 * tn + l15, jb = 16 * tm + 4 * g4;
        *(LAS f32x4*)(lds + LWOFF + (trow * 64 + jb) * 4) = zw;
        *(LAS f32x4*)(lds + ZAOFF + (trow * 64 + jb) * 4) = za;
        if (dir == 0) {
            const f32x4 gg = mm64(lds, BUF(11), 16 * tm, BUF(9), 16 * tn, lane);
            *(u32x2*)((bf16_t*)(F.ws + WS_GB) + ((size_t)b * S + 64 * c + trow) * BW + hd * HD + jb) = pack4(gg);
        }
    }
    __syncthreads();
    const int ch0 = hd * HD + 8 * jg;
    float r[8], kd[8], kap[8], bb[8], lw[8];
    {
        OPQZ(z1);
        const float* Pconv = a.in[6 + z1] + (size_t)l * 3 * 3 * BW;
        float k[8], v[8];
#pragma unroll
        for (int e = 0; e < 8; ++e) { r[e] = 0.f; k[e] = 0.f; v[e] = 0.f; }
#pragma unroll 1
        for (int x = 0; x < 3; ++x) {
            const int tt = tloc + x - 1;
            if (tt >= 0 && tt < S) {
                const bf16_t* hp = HBp + ((size_t)b * S + tt) * HW + HR + ch0;
                const u32x4 rr = *(const u32x4*)hp, kk2 = *(const u32x4*)(hp + BW), vv = *(const u32x4*)(hp + 2 * BW);
                const float* cw = Pconv + x * 3 * BW + ch0;
                const f32x4 cr0 = *(const f32x4*)cw, cr1 = *(const f32x4*)(cw + 4), ck0 = *(const f32x4*)(cw + BW), ck1 = *(const f32x4*)(cw + BW + 4), cv0 = *(const f32x4*)(cw + 2 * BW), cv1 = *(const f32x4*)(cw + 2 * BW + 4);
                r[0] += bflo(rr.x) * cr0[0]; r[1] += bfhi(rr.x) * cr0[1]; r[2] += bflo(rr.y) * cr0[2]; r[3] += bfhi(rr.y) * cr0[3];
                r[4] += bflo(rr.z) * cr1[0]; r[5] += bfhi(rr.z) * cr1[1]; r[6] += bflo(rr.w) * cr1[2]; r[7] += bfhi(rr.w) * cr1[3];
                k[0] += bflo(kk2.x) * ck0[0]; k[1] += bfhi(kk2.x) * ck0[1]; k[2] += bflo(kk2.y) * ck0[2]; k[3] += bfhi(kk2.y) * ck0[3];
                k[4] += bflo(kk2.z) * ck1[0]; k[5] += bfhi(kk2.z) * ck1[1]; k[6] += bflo(kk2.w) * ck1[2]; k[7] += bfhi(kk2.w) * ck1[3];
                v[0] += bflo(vv.x) * cv0[0]; v[1] += bfhi(vv.x) * cv0[1]; v[2] += bflo(vv.y) * cv0[2]; v[3] += bfhi(vv.y) * cv0[3];
                v[4] += bflo(vv.z) * cv1[0]; v[5] += bfhi(vv.z) * cv1[1]; v[6] += bflo(vv.w) * cv1[2]; v[7] += bfhi(vv.w) * cv1[3];
            }
        }
        const f32x4 zw0 = *(const LAS f32x4*)(lds + LWOFF + (tau * 64 + 8 * jg) * 4), zw1 = *(const LAS f32x4*)(lds + LWOFF + (tau * 64 + 8 * jg + 4) * 4);
        const f32x4 za0 = *(const LAS f32x4*)(lds + ZAOFF + (tau * 64 + 8 * jg) * 4), za1 = *(const LAS f32x4*)(lds + ZAOFF + (tau * 64 + 8 * jg + 4) * 4);
        float ss = 0.f, bsp = 0.f, av[8];
        OPQZ(z2);
        const float* Pw0 = a.in[7 + z2] + (size_t)l * 2 * BW + dir * BW + ch0; const float* Pa0 = a.in[9 + z2] + (size_t)l * 2 * BW + dir * BW + ch0;
        const float* Pkk = a.in[12 + z2] + (size_t)l * BW + ch0; const float* Pka = a.in[13 + z2] + (size_t)l * BW + ch0; const float* Prk = a.in[14 + z2] + (size_t)l * BH * HD + ch0;
        const f32x4 w0a = *(const f32x4*)Pw0, w0b = *(const f32x4*)(Pw0 + 4), a0a = *(const f32x4*)Pa0, a0b = *(const f32x4*)(Pa0 + 4);
        const f32x4 kka = *(const f32x4*)Pkk, kkb = *(const f32x4*)(Pkk + 4), kaa = *(const f32x4*)Pka, kab = *(const f32x4*)(Pka + 4), rka = *(const f32x4*)Prk, rkb = *(const f32x4*)(Prk + 4);
#pragma unroll
        for (int e = 0; e < 8; ++e) {
            const float zw = (e < 4 ? zw0[e & 3] : zw1[e & 3]) + (e < 4 ? w0a[e & 3] : w0b[e & 3]);
            const float za = (e < 4 ? za0[e & 3] : za1[e & 3]) + (e < 4 ? a0a[e & 3] : a0b[e & 3]);
            lw[e] = -DECAY * sigm(zw); av[e] = sigm(za);
            kap[e] = k[e] * (e < 4 ? kka[e & 3] : kkb[e & 3]); ss += kap[e] * kap[e];
            kd[e] = k[e] * (1.f + (av[e] - 1.f) * (e < 4 ? kaa[e & 3] : kab[e & 3]));
            bsp += r[e] * kd[e] * (e < 4 ? rka[e & 3] : rkb[e & 3]);
        }
        ss += __shfl_xor(ss, 1); ss += __shfl_xor(ss, 2); ss += __shfl_xor(ss, 4);
        bsp += __shfl_xor(bsp, 1); bsp += __shfl_xor(bsp, 2); bsp += __shfl_xor(bsp, 4);
        const float rn = 1.f / sqrtf(fmaxf(ss, 1e-24f));
#pragma unroll
        for (int e = 0; e < 8; ++e) { kap[e] *= rn; bb[e] = kap[e] * av[e]; }
        if (jg == 0) ((float*)(F.ws + WS_BS))[((size_t)dir * T + tok) * 8 + hd] = bsp;
        *(LAS f32x4*)(lds + LWOFF + (tau * 64 + 8 * jg) * 4) = (f32x4){lw[0], lw[1], lw[2], lw[3]};
        *(LAS f32x4*)(lds + LWOFF + (tau * 64 + 8 * jg + 4) * 4) = (f32x4){lw[4], lw[5], lw[6], lw[7]};
#pragma unroll
        for (int e = 0; e < 8; ++e) st1(lds, BUF(7), 8 * jg + e, tau, v[e]);
        if (dir == 0) {
            const size_t ucidx = ((size_t)b * BH + hd) * NCH + c;
            bf16_t* vtb = (bf16_t*)(F.ws + WS_VTB) + ucidx * 4096;
#pragma unroll
            for (int e = 0; e < 8; ++e) vtb[(8 * jg + e) * 64 + u] = f2bf(v[e]);
            u32x4 vo; vo.x = cvtpk(v[0], v[1]); vo.y = cvtpk(v[2], v[3]); vo.z = cvtpk(v[4], v[5]); vo.w = cvtpk(v[6], v[7]);
            *(u32x4*)((bf16_t*)(F.ws + WS_VC) + tok * BW + ch0) = vo;
        }
    }
    __syncthreads();
    { const int seg = tid >> 6, j = tid & 63; float p = 0.f;
#pragma unroll
      for (int i = 0; i < 8; ++i) { LAS float* q = (LAS float*)(lds + LWOFF + ((8 * seg + i) * 64 + j) * 4); p += *q; *q = p; }
      *(LAS float*)(lds + SEGOFF + (seg * 64 + j) * 4) = p; }
    __syncthreads();
    if (tid < 64) { float run = 0.f;
#pragma unroll
      for (int sg = 0; sg < 8; ++sg) { *(LAS float*)(lds + SEGXOFF + (sg * 64 + tid) * 4) = run; run += *(const LAS float*)(lds + SEGOFF + (sg * 64 + tid) * 4); }
      *(LAS float*)(lds + TOTOFF + tid * 4) = run; }
    __syncthreads();
    {
        float At[8], Rt[8], Bt[8], Kt[8], Bh[8], Kh[8];
#pragma unroll
        for (int e = 0; e < 8; ++e) {
            const int j = 8 * jg + e;
            const float lwi = *(const LAS float*)(lds + LWOFF + (tau * 64 + j) * 4) + *(const LAS float*)(lds + SEGXOFF + ((tau >> 3) * 64 + j) * 4);
            const float tot = *(const LAS float*)(lds + TOTOFF + j * 4);
            const float ep = __expf(lwi - lw[e]), epl = __expf(lwi), em = __expf(-lwi), ec = __expf(tot - lwi);
            At[e] = -kap[e] * ep; Rt[e] = r[e] * epl; Bt[e] = bb[e] * em; Kt[e] = kd[e] * em; Bh[e] = bb[e] * ec; Kh[e] = kd[e] * ec;
            if (u == 0) *(LAS float*)(lds + PCOFF + j * 4) = __expf(tot);
        }
        u32x4 o;
#define PK8(X) (o.x = cvtpk(X[0], X[1]), o.y = cvtpk(X[2], X[3]), o.z = cvtpk(X[4], X[5]), o.w = cvtpk(X[6], X[7]), o)
        *(LAS u32x4*)(lds + BUF(0) + tau * 144 + 16 * jg) = PK8(At);
        *(LAS u32x4*)(lds + BUF(1) + tau * 144 + 16 * jg) = PK8(Bt);
        *(LAS u32x4*)(lds + BUF(2) + tau * 144 + 16 * jg) = PK8(Kt);
        *(LAS u32x4*)(lds + BUF(3) + tau * 144 + 16 * jg) = PK8(Rt);
#undef PK8
#pragma unroll
        for (int e = 0; e < 8; ++e) { const int j = 8 * jg + e; st1(lds, BUF(4), j, tau, At[e]); st1(lds, BUF(5), j, tau, Bh[e]); st1(lds, BUF(6), j, tau, Kh[e]); }
    }
    __syncthreads();
#pragma unroll
    for (int tmi = 0; tmi < 2; ++tmi) {
        const int tm = tm0 + tmi, mb = 16 * tm + 4 * g4, nn = 16 * tn + l15;
        { f32x4 v = mm64(lds, BUF(1), 16 * tm, BUF(0), 16 * tn, lane);
#pragma unroll
          for (int e = 0; e < 4; ++e) v[e] = (mb + e < nn) ? v[e] : 0.f;
          if (tm == tn) {
#pragma unroll
              for (int e = 0; e < 4; ++e) *(LAS float*)(lds + NABFOFF + ((mb + e) * 16 + l15) * 4) = v[e];
              v = (f32x4){0.f, 0.f, 0.f, 0.f};
          }
          st4(lds, BUF(11), nn, mb, v); }
        { f32x4 v = mm64(lds, BUF(0), 16 * tm, BUF(2), 16 * tn, lane);
#pragma unroll
          for (int e = 0; e < 4; ++e) v[e] = (nn < mb + e) ? v[e] : 0.f;
          st4(lds, BUF(8), nn, mb, v); }
        { f32x4 v = mm64(lds, BUF(1), 16 * tm, BUF(3), 16 * tn, lane);
#pragma unroll
          for (int e = 0; e < 4; ++e) v[e] = (mb + e <= nn) ? v[e] : 0.f;
          st4(lds, BUF(9), nn, mb, v); }
        { f32x4 v = mm64(lds, BUF(2), 16 * tm, BUF(3), 16 * tn, lane);
#pragma unroll
          for (int e = 0; e < 4; ++e) v[e] = (mb + e <= nn) ? v[e] : 0.f;
          st4(lds, BUF(10), nn, mb, v); }
    }
    __syncthreads();
    if (wave == 0) {
        const int blk = lane >> 4, sr = lane & 15, s = 16 * blk + sr;
        float Tr[16];
#pragma unroll
        for (int t = 0; t < 16; ++t) { float acc = (t == sr) ? 1.f : 0.f;
#pragma unroll
            for (int sp = 0; sp < t; ++sp) acc += Tr[sp] * *(const LAS float*)(lds + NABFOFF + ((16 * blk + sp) * 16 + t) * 4);
            Tr[t] = acc; }
        const u32x4 z4 = (u32x4){0u, 0u, 0u, 0u};
#pragma unroll
        for (int q = 0; q < 9; ++q) { *(LAS u32x4*)(lds + BUF(0) + s * 144 + 16 * q) = z4; *(LAS u32x4*)(lds + BUF(1) + s * 144 + 16 * q) = z4; }
        u32x4 o0, o1; o0.x = cvtpk(Tr[0], Tr[1]); o0.y = cvtpk(Tr[2], Tr[3]); o0.z = cvtpk(Tr[4], Tr[5]); o0.w = cvtpk(Tr[6], Tr[7]);
        o1.x = cvtpk(Tr[8], Tr[9]); o1.y = cvtpk(Tr[10], Tr[11]); o1.z = cvtpk(Tr[12], Tr[13]); o1.w = cvtpk(Tr[14], Tr[15]);
        LDS_WAIT();
        *(LAS u32x4*)(lds + BUF(0) + s * 144 + 32 * blk) = o0; *(LAS u32x4*)(lds + BUF(0) + s * 144 + 32 * blk + 16) = o1;
#pragma unroll
        for (int t = 0; t < 16; ++t) st1(lds, BUF(1), 16 * blk + t, s, Tr[t]);
    }
    __syncthreads();
#pragma unroll
    for (int tmi = 0; tmi < 2; ++tmi) {
        const int tm = tm0 + tmi, mb = 16 * tm + 4 * g4, nn = 16 * tn + l15;
        const f32x4 v = mm64(lds, BUF(0), 16 * tm, BUF(11), 16 * tn, lane);
        st4(lds, BUF(12), nn, mb, v);
#pragma unroll
        for (int e = 0; e < 4; ++e) st1(lds, BUF(2), mb + e, nn, v[e]);
    }
    __syncthreads();
#pragma unroll
    for (int tmi = 0; tmi < 2; ++tmi) {
        const int tm = tm0 + tmi, mb = 16 * tm + 4 * g4, nn = 16 * tn + l15;
        const f32x4 v = mm64(lds, BUF(12), 16 * tm, BUF(2), 16 * tn, lane);
        st4(lds, BUF(13), nn, mb, v);
    }
    __syncthreads();
#pragma unroll
    for (int tmi = 0; tmi < 2; ++tmi) {
        const int tm = tm0 + tmi, mb = 16 * tm + 4 * g4, nn = 16 * tn + l15;
        const f32x4 v = mm64(lds, BUF(13), 16 * tm, BUF(1), 16 * tn, lane) + ld4(lds, BUF(1), nn, mb);
        st4(lds, BUF(14), nn, mb, v);
    }
    __syncthreads();
#pragma unroll
    for (int tmi = 0; tmi < 2; ++tmi) {
        const int tm = tm0 + tmi, mb = 16 * tm + 4 * g4, nn = 16 * tn + l15;
        const f32x4 v = mm64(lds, BUF(2), 16 * tm, BUF(14), 16 * tn, lane) + ld4(lds, BUF(14), nn, mb);
        st4(lds, BUF(15), nn, mb, v);
    }
    __syncthreads();
#pragma unroll
    for (int tmi = 0; tmi < 2; ++tmi) {
        const int tm = tm0 + tmi, mb = 16 * tm + 4 * g4, nn = 16 * tn + l15;
        const f32x4 x1 = mm64(lds, BUF(15), 16 * tm, BUF(4), 16 * tn, lane);
        const f32x4 x2 = mm64(lds, BUF(15), 16 * tm, BUF(8), 16 * tn, lane);
        st4(lds, BUF(0), nn, mb, x1); st4(lds, BUF(1), nn, mb, x2);
    }
    __syncthreads();
    {
        bf16_t* QT = (bf16_t*)(F.ws + WS_QT) + (size_t)unit * 4096; bf16_t* WT = (bf16_t*)(F.ws + WS_WT) + (size_t)unit * 4096; bf16_t* MP = (bf16_t*)(F.ws + WS_MP) + (size_t)unit * 4096;
#pragma unroll
        for (int tmi = 0; tmi < 2; ++tmi) {
            const int tm = tm0 + tmi, mb = 16 * tm + 4 * g4, nn = 16 * tn + l15;
            { const f32x4 v = mm64(lds, BUF(0), 16 * tm, BUF(9), 16 * tn, lane) + ld4(lds, BUF(3), nn, mb);
              *(u32x2*)(QT + (dir ? 63 - nn : nn) * 64 + mb) = pack4(v); }
            { const f32x4 v = mm64(lds, BUF(1), 16 * tm, BUF(9), 16 * tn, lane) + ld4(lds, BUF(10), nn, mb);
              if (dir) *(u32x2*)(WT + (63 - nn) * 64 + (60 - mb)) = pack4((f32x4){v[3], v[2], v[1], v[0]});
              else *(u32x2*)(WT + nn * 64 + mb) = pack4(v); }
            { f32x4 v = mm64(lds, BUF(0), 16 * tm, BUF(5), 16 * tn, lane);
#pragma unroll
              for (int e = 0; e < 4; ++e) if (mb + e == nn) v[e] += *(const LAS float*)(lds + PCOFF + nn * 4);
              *(u32x2*)(MP + nn * 64 + swap23(mb)) = pack4(v); }
            { const f32x4 v = mm64(lds, BUF(1), 16 * tm, BUF(5), 16 * tn, lane) + ld4(lds, BUF(6), nn, mb);
              st4(lds, BUF(2), nn, mb, v); }
        }
    }
    __syncthreads();
    {
        f32x4* NBp = (f32x4*)(F.ws + WS_NB);
#pragma unroll
        for (int tmi = 0; tmi < 2; ++tmi) {
            const int tm = tm0 + tmi, mb = 16 * tm + 4 * g4, ii = 16 * tn + l15;
            const f32x4 v = mm64(lds, BUF(2), 16 * tm, BUF(7), 16 * tn, lane);
            const int jb = mb >> 5, jl = mb & 31, q = jl >> 3, hic = (jl >> 2) & 1, ih = ii >> 5, Lc = (ii & 31) + 32 * hic;
            NBp[((((size_t)unit * 2 + ih) * 2 + jb) * 4 + q) * 64 + Lc] = v;
        }
    }
    __syncthreads();
}

DI void attn_unit(const Frame& F, const LAS float* rpbl, const int au) {
    const bf16_t* HBp = (const bf16_t*)(F.ws + WS_HB); const bf16_t* VTp = (const bf16_t*)(F.ws + WS_VT); bf16_t* CONCAT = (bf16_t*)(F.ws + WS_CONCAT);
    const int hh = au % AH, r = (au / AH) % ROWS, b = au / (AH * ROWS);
    int rstart = r - KH / 2; rstart = rstart < 0 ? 0 : (rstart > ROWS - KH ? ROWS - KH : rstart);
    const int lane = F.lane, q32 = lane & 31, hi = lane >> 5;
    const float SC = 0.125f * LOG2E;
    const int krow_off = swap23(q32);
#pragma unroll 1
    for (int qb = 0; qb < 2; ++qb) {
        const int cq = 32 * qb + q32; int cs = cq - KW / 2; cs = cs < 0 ? 0 : (cs > GW - KW ? GW - KW : cs);
        const size_t tokq = (size_t)b * S + r * GW + cq;
        bf16x8 qf[4];
#pragma unroll
        for (int ds = 0; ds < 4; ++ds) qf[ds] = *(const bf16x8*)(HBp + tokq * HW + HQ + hh * HD + 16 * ds + 8 * hi);
        f32x16 o0, o1;
#pragma unroll
        for (int i = 0; i < 16; ++i) { o0[i] = 0.f; o1[i] = 0.f; }
        float mrun = -1e30f, lsum = 0.f;
#pragma unroll 1
        for (int kt = 0; kt < 2 * KH; ++kt) {
            const int kr = rstart + (kt >> 1), ckb = 32 * (kt & 1);
            const size_t ktok = (size_t)b * S + kr * GW + ckb;
            bf16x8 kf[4], vf[2][2];
#pragma unroll
            for (int ds = 0; ds < 4; ++ds) kf[ds] = *(const bf16x8*)(HBp + (ktok + krow_off) * HW + HK + hh * HD + 16 * ds + 8 * hi);
#pragma unroll
            for (int db = 0; db < 2; ++db)
#pragma unroll
                for (int s = 0; s < 2; ++s) vf[db][s] = *(const bf16x8*)(VTp + (size_t)(hh * HD + 32 * db + q32) * T + ktok + 16 * s + 8 * hi);
            f32x16 st;
#pragma unroll
            for (int i = 0; i < 16; ++i) st[i] = 0.f;
#pragma unroll
            for (int ds = 0; ds < 4; ++ds) st = MFMA32(kf[ds], qf[ds], st);
            const LAS float* rp = rpbl + (hh * (2 * KH - 1) + (kr - r + KH - 1)) * (2 * KW - 1);
            float sl[16]; float tmax = -1e30f;
#pragma unroll
            for (int i = 0; i < 16; ++i) {
                const int ck = ckb + 16 * (i >> 3) + 8 * hi + (i & 7);
                const bool inw = (ck >= cs) && (ck < cs + KW);
                int dc = ck - cq; dc = dc < -(KW - 1) ? -(KW - 1) : (dc > KW - 1 ? KW - 1 : dc); dc += KW - 1;
                sl[i] = inw ? st[i] * SC + rp[dc] : -1e30f;
                tmax = fmaxf(tmax, sl[i]);
            }
            tmax = fmaxf(tmax, __shfl_xor(tmax, 32));
            const float mn = fmaxf(mrun, tmax), corr = __builtin_amdgcn_exp2f(mrun - mn);
            float ps = 0.f;
#pragma unroll
            for (int i = 0; i < 16; ++i) { sl[i] = (sl[i] > -1e29f) ? __builtin_amdgcn_exp2f(sl[i] - mn) : 0.f; ps += sl[i]; }
            lsum = lsum * corr + ps; mrun = mn;
#pragma unroll
            for (int i = 0; i < 16; ++i) { o0[i] *= corr; o1[i] *= corr; }
            u32x4 p0, p1;
            p0.x = cvtpk(sl[0], sl[1]); p0.y = cvtpk(sl[2], sl[3]); p0.z = cvtpk(sl[4], sl[5]); p0.w = cvtpk(sl[6], sl[7]);
            p1.x = cvtpk(sl[8], sl[9]); p1.y = cvtpk(sl[10], sl[11]); p1.z = cvtpk(sl[12], sl[13]); p1.w = cvtpk(sl[14], sl[15]);
            const bf16x8 pf0 = __builtin_bit_cast(bf16x8, p0), pf1 = __builtin_bit_cast(bf16x8, p1);
            o0 = MFMA32(vf[0][0], pf0, o0); o0 = MFMA32(vf[0][1], pf1, o0);
            o1 = MFMA32(vf[1][0], pf0, o1); o1 = MFMA32(vf[1][1], pf1, o1);
        }
        const float inv = 1.f / (lsum + __shfl_xor(lsum, 32));
        bf16_t* op = CONCAT + tokq * D + hh * HD;
#pragma unroll
        for (int g = 0; g < 4; ++g) {
            *(u32x2*)(op + 8 * g + 4 * hi) = pack4((f32x4){o0[4 * g] * inv, o0[4 * g + 1] * inv, o0[4 * g + 2] * inv, o0[4 * g + 3] * inv});
            *(u32x2*)(op + 32 + 8 * g + 4 * hi) = pack4((f32x4){o1[4 * g] * inv, o1[4 * g + 1] * inv, o1[4 * g + 2] * inv, o1[4 * g + 3] * inv});
        }
    }
}

DI void pool_unit(const Frame& F, const float* pool_w, const float* pool_scale, const int pu) {
    const bf16_t* HBp = (const bf16_t*)(F.ws + WS_HB); bf16_t* CONCAT = (bf16_t*)(F.ws + WS_CONCAT);
    const int g = pu & 3, blk = pu >> 2, b = blk >> 8, t0 = (blk & 255) * 32;
    const int lane = F.lane, q32 = lane & 31, hi = lane >> 5, t = t0 + q32, win = 2 << g;
    int lo = t - win / 2; lo = lo < 0 ? 0 : lo; int hit = t + win / 2 - 1; hit = hit > S - 1 ? S - 1 : hit;
    const float inv = 1.f / (float)(hit - lo + 1);
    f32x16 out0, out1;
#pragma unroll
    for (int i = 0; i < 16; ++i) { out0[i] = 0.f; out1[i] = 0.f; }
    const float* pw = pool_w + (size_t)g * 64 * 64;
#pragma unroll 1
    for (int s = 0; s < 4; ++s) {
        const int c0 = HP + g * 64 + 16 * s + 8 * hi;
        float acc[8];
#pragma unroll
        for (int e = 0; e < 8; ++e) acc[e] = 0.f;
#pragma unroll 1
        for (int tt = lo; tt <= hit; ++tt) {
            const u32x4 pv = *(const u32x4*)(HBp + ((size_t)b * S + tt) * HW + c0);
            acc[0] += bflo(pv.x); acc[1] += bfhi(pv.x); acc[2] += bflo(pv.y); acc[3] += bfhi(pv.y); acc[4] += bflo(pv.z); acc[5] += bfhi(pv.z); acc[6] += bflo(pv.w); acc[7] += bfhi(pv.w);
        }
        const u32x4 pc = *(const u32x4*)(HBp + ((size_t)b * S + t) * HW + c0);
        u32x4 o;
        o.x = cvtpk(acc[0] * inv - bflo(pc.x), acc[1] * inv - bfhi(pc.x)); o.y = cvtpk(acc[2] * inv - bflo(pc.y), acc[3] * inv - bfhi(pc.y));
        o.z = cvtpk(acc[4] * inv - bflo(pc.z), acc[5] * inv - bfhi(pc.z)); o.w = cvtpk(acc[6] * inv - bflo(pc.w), acc[7] * inv - bfhi(pc.w));
        const bf16x8 bfr = __builtin_bit_cast(bf16x8, o);
        const float* wp = pw + (size_t)(16 * s + 8 * hi) * 64 + q32;
        u32x4 w0; w0.x = cvtpk(wp[0], wp[64]); w0.y = cvtpk(wp[128], wp[192]); w0.z = cvtpk(wp[256], wp[320]); w0.w = cvtpk(wp[384], wp[448]);
        u32x4 w1; w1.x = cvtpk(wp[32], wp[96]); w1.y = cvtpk(wp[160], wp[224]); w1.z = cvtpk(wp[288], wp[352]); w1.w = cvtpk(wp[416], wp[480]);
        out0 = MFMA32(__builtin_bit_cast(bf16x8, w0), bfr, out0);
        out1 = MFMA32(__builtin_bit_cast(bf16x8, w1), bfr, out1);
    }
    bf16_t* op = CONCAT + ((size_t)b * S + t) * D + AW + BW + g * 64;
    const float* ps = pool_scale + g * 64;
#pragma unroll
    for (int gq = 0; gq < 4; ++gq) {
        const int e0 = 8 * gq + 4 * hi;
        const f32x4 s0 = *(const f32x4*)(ps + e0), s1 = *(const f32x4*)(ps + 32 + e0);
        *(u32x2*)(op + e0) = pack4((f32x4){out0[4 * gq] * s0[0], out0[4 * gq + 1] * s0[1], out0[4 * gq + 2] * s0[2], out0[4 * gq + 3] * s0[3]});
        *(u32x2*)(op + 32 + e0) = pack4((f32x4){out1[4 * gq] * s1[0], out1[4 * gq + 1] * s1[1], out1[4 * gq + 2] * s1[2], out1[4 * gq + 3] * s1[3]});
    }
}

DI void scan_wave(const Frame& F, const int sw) {
    const int ihalf = sw & 1, sc = sw >> 1, dir = sc / (NB * BH);
    const int lane = F.lane, il = lane & 31, hi = lane >> 5;
    const bf16_t* MP = (const bf16_t*)(F.ws + WS_MP); const f32x4* NBp = (const f32x4*)(F.ws + WS_NB); bf16_t* S0 = (bf16_t*)(F.ws + WS_S0);
    f32x16 st0, st1;
#pragma unroll
    for (int i = 0; i < 16; ++i) { st0[i] = 0.f; st1[i] = 0.f; }
    bf16x8 ma[2][2][2]; f32x4 nb[2][4];
    auto load_step = [&](int step, bf16x8 (&m)[2][2][2], f32x4 (&n)[2][4]) {
        const int c = dir ? NCH - 1 - step : step; const size_t unit = (size_t)sc * NCH + c;
#pragma unroll
        for (int jpb = 0; jpb < 2; ++jpb) {
#pragma unroll
            for (int jb = 0; jb < 2; ++jb)
#pragma unroll
                for (int s = 0; s < 2; ++s) m[jpb][jb][s] = *(const bf16x8*)(MP + unit * 4096 + (32 * jpb + il) * 64 + 32 * jb + 16 * s + 8 * hi);
#pragma unroll
            for (int q = 0; q < 4; ++q) n[jpb][q] = NBp[(((unit * 2 + ihalf) * 2 + jpb) * 4 + q) * 64 + lane];
        }
    };
    load_step(0, ma, nb);
#pragma unroll 1
    for (int step = 0; step < NCH; ++step) {
        const int c = dir ? NCH - 1 - step : step; const size_t unit = (size_t)sc * NCH + c;
        bf16x8 mn_[2][2][2]; f32x4 nn_[2][4];
        load_step(step + 1 < NCH ? step + 1 : step, mn_, nn_);
        bf16_t* sp = S0 + unit * 4096 + (size_t)(32 * ihalf + il) * 64;
        u32x4 b00, b01, b10, b11;
        b00.x = cvtpk(st0[0], st0[1]); b00.y = cvtpk(st0[2], st0[3]); b00.z = cvtpk(st0[4], st0[5]); b00.w = cvtpk(st0[6], st0[7]);
        b01.x = cvtpk(st0[8], st0[9]); b01.y = cvtpk(st0[10], st0[11]); b01.z = cvtpk(st0[12], st0[13]); b01.w = cvtpk(st0[14], st0[15]);
        b10.x = cvtpk(st1[0], st1[1]); b10.y = cvtpk(st1[2], st1[3]); b10.z = cvtpk(st1[4], st1[5]); b10.w = cvtpk(st1[6], st1[7]);
        b11.x = cvtpk(st1[8], st1[9]); b11.y = cvtpk(st1[10], st1[11]); b11.z = cvtpk(st1[12], st1[13]); b11.w = cvtpk(st1[14], st1[15]);
        *(u32x2*)(sp + 0 + 4 * hi) = (u32x2){b00.x, b00.y};  *(u32x2*)(sp + 8 + 4 * hi) = (u32x2){b00.z, b00.w};
        *(u32x2*)(sp + 16 + 4 * hi) = (u32x2){b01.x, b01.y}; *(u32x2*)(sp + 24 + 4 * hi) = (u32x2){b01.z, b01.w};
        *(u32x2*)(sp + 32 + 4 * hi) = (u32x2){b10.x, b10.y}; *(u32x2*)(sp + 40 + 4 * hi) = (u32x2){b10.z, b10.w};
        *(u32x2*)(sp + 48 + 4 * hi) = (u32x2){b11.x, b11.y}; *(u32x2*)(sp + 56 + 4 * hi) = (u32x2){b11.z, b11.w};
        const bf16x8 p00 = __builtin_bit_cast(bf16x8, b00), p01 = __builtin_bit_cast(bf16x8, b01), p10 = __builtin_bit_cast(bf16x8, b10), p11 = __builtin_bit_cast(bf16x8, b11);
        f32x16 n0, n1;
#pragma unroll
        for (int q = 0; q < 4; ++q)
#pragma unroll
            for (int e = 0; e < 4; ++e) { n0[4 * q + e] = nb[0][q][e]; n1[4 * q + e] = nb[1][q][e]; }
        n0 = MFMA32(ma[0][0][0], p00, n0); n1 = MFMA32(ma[1][0][0], p00, n1);
        n0 = MFMA32(ma[0][0][1], p01, n0); n1 = MFMA32(ma[1][0][1], p01, n1);
        n0 = MFMA32(ma[0][1][0], p10, n0); n1 = MFMA32(ma[1][1][0], p10, n1);
        n0 = MFMA32(ma[0][1][1], p11, n0); n1 = MFMA32(ma[1][1][1], p11, n1);
        st0 = n0; st1 = n1;
#pragma unroll
        for (int a = 0; a < 2; ++a) {
#pragma unroll
            for (int bq = 0; bq < 2; ++bq)
#pragma unroll
                for (int s = 0; s < 2; ++s) ma[a][bq][s] = mn_[a][bq][s];
#pragma unroll
            for (int q = 0; q < 4; ++q) nb[a][q] = nn_[a][q];
        }
    }
}

DI void rwkv_out_unit(const Frame& F, const RwP& P, const int du) {
    const int qd = du & 3, cidx = du >> 2, c = cidx % NCH, hd = (cidx / NCH) % BH, b = cidx / (NCH * BH);
    const int lane = F.lane, n = lane & 15, g = lane >> 4, u = 16 * qd + n;
    const bf16_t* QT = (const bf16_t*)(F.ws + WS_QT); const bf16_t* WT = (const bf16_t*)(F.ws + WS_WT); const bf16_t* S0 = (const bf16_t*)(F.ws + WS_S0);
    const bf16_t* VTB = (const bf16_t*)(F.ws + WS_VTB) + (size_t)cidx * 4096;
    f32x4 acc[4];
#pragma unroll
    for (int tm = 0; tm < 4; ++tm) acc[tm] = (f32x4){0.f, 0.f, 0.f, 0.f};
#pragma unroll
    for (int dir = 0; dir < 2; ++dir) {
        const size_t unit = (((size_t)dir * NB + b) * BH + hd) * NCH + c;
#pragma unroll
        for (int ks = 0; ks < 2; ++ks) {
            const bf16x8 bq = *(const bf16x8*)(QT + unit * 4096 + u * 64 + 32 * ks + 8 * g);
            const bf16x8 bw = *(const bf16x8*)(WT + unit * 4096 + u * 64 + 32 * ks + 8 * g);
#pragma unroll
            for (int tm = 0; tm < 4; ++tm) {
                const bf16x8 as = *(const bf16x8*)(S0 + unit * 4096 + (16 * tm + n) * 64 + 32 * ks + 8 * g);
                const bf16x8 av = *(const bf16x8*)(VTB + (16 * tm + n) * 64 + 32 * ks + 8 * g);
                acc[tm] = MFMA16(as, bq, acc[tm]); acc[tm] = MFMA16(av, bw, acc[tm]);
            }
        }
    }
    float s = 0.f;
#pragma unroll
    for (int tm = 0; tm < 4; ++tm) s += (acc[tm][0] + acc[tm][1]) + (acc[tm][2] + acc[tm][3]);
    s += __shfl_xor(s, 16); s += __shfl_xor(s, 32);
    const float mu = s * (1.f / HD); float q = 0.f;
#pragma unroll
    for (int tm = 0; tm < 4; ++tm) { acc[tm] = acc[tm] - mu; q += (acc[tm][0] * acc[tm][0] + acc[tm][1] * acc[tm][1]) + (acc[tm][2] * acc[tm][2] + acc[tm][3] * acc[tm][3]); }
    q += __shfl_xor(q, 16); q += __shfl_xor(q, 32);
    const float rstd = 1.f / sqrtf(q * (1.f / HD) + GN_EPS);
    const size_t tok = (size_t)b * S + 64 * c + u;
    const float* BS = (const float*)(F.ws + WS_BS);
    const float bsum = BS[tok * 8 + hd] + BS[((size_t)T + tok) * 8 + hd];
    const bf16_t* VC = (const bf16_t*)(F.ws + WS_VC) + tok * BW + hd * HD; const bf16_t* GBp = (const bf16_t*)(F.ws + WS_GB) + tok * BW + hd * HD;
    bf16_t* op = (bf16_t*)(F.ws + WS_CONCAT) + tok * D + AW + hd * HD;
#pragma unroll
    for (int tm = 0; tm < 4; ++tm) {
        const int i0 = 16 * tm + 4 * g;
        const f32x4 vv = unpack4(*(const u32x2*)(VC + i0)), gg = unpack4(*(const u32x2*)(GBp + i0));
        const f32x4 gn = *(const f32x4*)(P.gn_gain + hd * HD + i0), gb = *(const f32x4*)(P.gn_bias + hd * HD + i0);
        *(u32x2*)(op + i0) = pack4((acc[tm] * rstd * gn + gb + vv * bsum) * gg);
    }
}

DI RwP make_rwp(const Args& a, int l) {
    RwP p;
    p.conv = a.in[6] + (size_t)l * 3 * 3 * BW; p.w0 = a.in[7] + (size_t)l * 2 * BW; p.w_up = a.in[8] + (size_t)l * 2 * RW * BW;
    p.a0 = a.in[9] + (size_t)l * 2 * BW; p.a_up = a.in[10] + (size_t)l * 2 * RA * BW; p.g_up = a.in[11] + (size_t)l * RG * BW;
    p.k_k = a.in[12] + (size_t)l * BW; p.k_a = a.in[13] + (size_t)l * BW; p.r_k = a.in[14] + (size_t)l * BH * HD;
    p.gn_gain = a.in[15] + (size_t)l * BW; p.gn_bias = a.in[16] + (size_t)l * BW;
    return p;
}
DI void p_gemm1(const Frame& F, int l) {
    pg8::Gemm1Order S; S.U = (const bf16_t*)(F.ws + WS_U); S.Win = (const bf16_t*)(F.ws + WS_WIN + (size_t)l * WIN_LAYER); S.Wv = S.Win + (size_t)HW * D; S.G = F.G; S.c = F.bx;
    pg8::EpiStore E{(bf16_t*)(F.ws + WS_HB), HW, (bf16_t*)(F.ws + WS_VT), T};
    pg8::gemm_phase(F.lds, F.tid, D, S, E);
}
DI void p_mixer_local(const Frame& F, const Args& a, int l) {
    for (int unit = F.bx; unit < NUNIT; unit += F.G) rwkv_local_unit(F, a, l, unit);
    LAS float* rpbl = (LAS float*)F.lds;
    const float* rpb = a.in[5] + (size_t)l * AH * (2 * KH - 1) * (2 * KW - 1);
    for (int i = F.tid; i < AH * (2 * KH - 1) * (2 * KW - 1); i += NTHREADS) rpbl[i] = rpb[i] * LOG2E;
    __syncthreads();
    for (int au = F.gw; au < NB * ROWS * AH; au += F.ngw) attn_unit(F, rpbl, au);
    for (int pu = F.gw; pu < NB * (S / 32) * 4; pu += F.ngw) pool_unit(F, a.in[17] + (size_t)l * NG * 64 * 64, a.in[18] + (size_t)l * CW, pu);
}
DI void p_scan(const Frame& F, const Args& a, int l) {
    if (F.bx < 2 * 2 * NB * BH && F.wave == 0) scan_wave(F, F.bx);
#if TESTMODE != 2
    LAS float* scr = (LAS float*)F.lds + F.wave * (64 * 65);
    for (int it = F.bx * NWAVES + F.wave; it < IT_MOE; it += F.G * NWAVES) conv_moe_item(F, a.in[28], a.in[29], a.in[30], l, it, scr);
#endif
}
DI void p_rwkv_out(const Frame& F, const Args& a, int l) {
    const RwP P = make_rwp(a, l);
    for (int du = F.gw; du < NB * BH * NCH * 4; du += F.ngw) rwkv_out_unit(F, P, du);
}
DI void p_gemm2(const Frame& F, int l) {
    pg8::PlainOrder S; S.init((const bf16_t*)(F.ws + WS_CONCAT), (const bf16_t*)(F.ws + WS_WOUT) + (size_t)l * D * D, T, D, D, F.G, F.bx);
    pg8::EpiStore E{(bf16_t*)(F.ws + WS_MIX), D, nullptr, 0};
    pg8::gemm_phase(F.lds, F.tid, D, S, E);
}
DI void p_moe_a(const Frame& F, int l) {
    LAS int* tb = (LAS int*)(F.lds + LDS_MISC);
    build_tables(F, l, tb);
    pg8::GroupedOrder S; S.A = (const bf16_t*)(F.ws + WS_XS); S.Bt = (const bf16_t*)(F.ws + WS_WGU); S.K = D; S.estride = (size_t)D * D; S.tile_e = tb + 66; S.ntiles = tb[65]; S.nwg = S.ntiles * 4; S.G = F.G; S.c = F.bx;
    pg8::EpiSwiGlu E{(bf16_t*)(F.ws + WS_HM)};
    pg8::gemm_phase(F.lds, F.tid, D, S, E);
}
DI void p_moe_b(const Frame& F, int l) {
    LAS int* tb = (LAS int*)(F.lds + LDS_MISC);
    build_tables(F, l, tb);
    pg8::GroupedOrder S; S.A = (const bf16_t*)(F.ws + WS_HM); S.Bt = (const bf16_t*)(F.ws + WS_WD); S.K = DE; S.estride = (size_t)D * DE; S.tile_e = tb + 66; S.ntiles = tb[65]; S.nwg = S.ntiles * 4; S.G = F.G; S.c = F.bx;
    pg8::EpiRowScale E{(bf16_t*)(F.ws + WS_YS), (const float*)(F.ws + WS_SLOTW)};
    pg8::gemm_phase(F.lds, F.tid, DE, S, E);
}

#ifndef DBLMASK
#define DBLMASK 0
#endif
constexpr int PH_PER_LAYER = 10, N_PHASES = 2 + L * PH_PER_LAYER;
DI bool in_ph(int k, int lo, int hi) { lo = __builtin_amdgcn_readfirstlane(lo); hi = __builtin_amdgcn_readfirstlane(hi); asm volatile("" : "+s"(lo), "+s"(hi)); return lo <= k && k < hi; }
DI Frame fresh(const Frame& F0) {
    Frame F = F0; int t = F0.tid, b = F0.bx;
    b = __builtin_amdgcn_readfirstlane(b); asm volatile("" : "+v"(t)); asm volatile("" : "+s"(b));
    F.tid = t; F.lane = t & 63; F.wave = __builtin_amdgcn_readfirstlane(t >> 6); F.bx = b;
    F.vcu = (F.G % 8 == 0) ? (b % 8) * (F.G / 8) + b / 8 : b; F.gw = F.vcu * NWAVES + F.wave;
    return F;
}

__global__ void __launch_bounds__(NTHREADS, 2) mk_fwd(Args a) {
    extern __shared__ __attribute__((aligned(16))) unsigned char lds_raw[];
    Frame F;
    F.lds = (LAS unsigned char*)lds_raw;
    F.tid = threadIdx.x; F.lane = F.tid & 63; F.wave = __builtin_amdgcn_readfirstlane(F.tid >> 6);
    F.G = gridDim.x; F.bx = blockIdx.x; { const int bx = blockIdx.x; F.vcu = (F.G % 8 == 0) ? (bx % 8) * (F.G / 8) + bx / 8 : bx; }
    F.gw = F.vcu * NWAVES + F.wave; F.ngw = F.G * NWAVES; F.ws = a.ws;
    volatile LAS unsigned* bst = (volatile LAS unsigned*)(F.lds + LDS_BARST);
    if (F.tid < 16) bst[F.tid] = 0u;
    __syncthreads();
    cg::grid_group grid = cg::this_grid();
    XcdBarrier bar; bar.bar = (unsigned*)(a.ws + WS_CTL) + CW_BAR; bar.x = 0; bar.st = bst;
    const bool multi = (a.ph_hi - a.ph_lo) > 1;
    if (multi && !a.use_cg) bar = xcd_barrier_post((unsigned*)(a.ws + WS_CTL) + CW_BAR, bst);
    const int lo = a.ph_lo, hi = a.ph_hi;
#define IN(k) in_ph((k), lo, hi)
#ifndef DBLSEAM
#define DBLSEAM 0
#endif
#define SEAM(k) do { if (IN(k) && IN((k) + 1)) { if (a.use_cg) grid.sync(); else { xcd_barrier(bar); if (DBLSEAM) xcd_barrier(bar); } } } while (0)
    if (IN(0)) { p0_prologue(fresh(F), a); if ((DBLMASK >> 11) & 1) p0_prologue(fresh(F), a); }
    SEAM(0);
    if (IN(1)) { p_r0(fresh(F), a.in[0]); if ((DBLMASK >> 12) & 1) p_r0(fresh(F), a.in[0]); }
    SEAM(1);
#define RUN(k, call) do { if (IN(pb + (k))) { call; if ((DBLMASK >> (k)) & 1) { call; } } } while (0)
#define LAYER(l) do { \
        const int pb = 2 + PH_PER_LAYER * (l); \
        RUN(0, p_gemm1(fresh(F), (l))); \
        SEAM(pb + 0); \
        RUN(1, p_mixer_local(fresh(F), a, (l))); \
        SEAM(pb + 1); \
        RUN(2, p_scan(fresh(F), a, (l))); \
        SEAM(pb + 2); \
        RUN(3, p_rwkv_out(fresh(F), a, (l))); \
        SEAM(pb + 3); \
        RUN(4, p_gemm2(fresh(F), (l))); \
        SEAM(pb + 4); \
        RUN(5, p_rowpass1(fresh(F), a, (l), (l) == 0 ? a.in[0] : a.out)); \
        if (IN(pb + 5) && ((DBLMASK >> 10) & 1)) p_rowpass1(fresh(F), a, (l), (l) == 0 ? a.in[0] : a.out, true); \
        SEAM(pb + 5); \
        RUN(6, p_gather(fresh(F), (l))); \
        SEAM(pb + 6); \
        RUN(7, p_moe_a(fresh(F), (l))); \
        SEAM(pb + 7); \
        RUN(8, p_moe_b(fresh(F), (l))); \
        SEAM(pb + 8); \
        RUN(9, p_rowpass2(fresh(F), a, (l), a.out)); \
        SEAM(pb + 9); \
    } while (0)
    LAYER(0);
    LAYER(1);
#undef LAYER
#undef IN
#undef SEAM
}

#ifndef MK_MODE
#define MK_MODE 0
#endif
#ifndef TESTMODE
#define TESTMODE 0
#endif

static void fill_args(Args& a, void* const* d_in, void* d_out, void* d_ws) {
    for (int i = 0; i < 31; ++i) a.in[i] = (const float*)d_in[i];
    a.out = (float*)d_out; a.ws = (unsigned char*)d_ws; a.ph_lo = 0; a.ph_hi = N_PHASES; a.use_cg = 0; a.pad = 0;
}
static void launch_phases(Args a, int lo, int hi, hipStream_t stream) {
    for (int p = lo; p < hi; ++p) { a.ph_lo = p; a.ph_hi = p + 1; hipLaunchKernelGGL(mk_fwd, dim3(256), dim3(NTHREADS), LDS_BYTES, stream, a); }
}

#if TESTMODE == 0
extern "C" void kernel_launch(void* const* d_in, const int* in_sizes, int n_in, void* d_out, int out_size, void* d_ws, size_t ws_size, hipStream_t stream) {
    static int grid = 0;
    if (grid == 0) {
        int dev = 0, cus = 0, per_cu = 0;
        (void)hipGetDevice(&dev); (void)hipDeviceGetAttribute(&cus, hipDeviceAttributeMultiprocessorCount, dev);
        (void)hipFuncSetAttribute((const void*)mk_fwd, hipFuncAttributeMaxDynamicSharedMemorySize, LDS_BYTES);
        (void)hipOccupancyMaxActiveBlocksPerMultiprocessor(&per_cu, (const void*)mk_fwd, NTHREADS, LDS_BYTES);
        (void)hipGetLastError();
        grid = (cus > 0 ? cus : 256) * 1;
        if (ws_size < WS_END || n_in != 31) grid = -1;
    }
    if (grid < 0) return;
    (void)hipMemsetAsync((char*)d_ws + WS_CTL, 0, CTL_BYTES, stream);
    Args a{}; fill_args(a, d_in, d_out, d_ws);
#if MK_MODE == 2
    launch_phases(a, 0, N_PHASES, stream);
#else
    a.use_cg = (MK_MODE == 1) ? 1 : 0;
    void* args[] = {&a};
    (void)hipLaunchCooperativeKernel((const void*)mk_fwd, dim3(grid), dim3(NTHREADS), args, LDS_BYTES, stream);
#endif
}
#endif

#if TESTMODE > 0
constexpr int O_A = 1152, O_B = 2304, O_W = 2336, O_AL = 2368, O_G = 2432;
struct HSrc { const bf16_t* HB; const bf16_t* VT;
    DI float at(size_t tok, int n) const { if (n < 768) return bf2f(HB[tok * HW + n]); if (n < 1152) return bf2f(VT[(size_t)(n - 768) * T + tok]); return bf2f(HB[tok * HW + n - 384]); } };
DI float sigm_n(float x) { return 1.f / (1.f + expf(-x)); }

__global__ void k_mod_n(const float* __restrict__ c, const float* __restrict__ w_mod, const float* __restrict__ b_mod, float* __restrict__ mod) {
    __shared__ float sc[NB * D];
    for (int i = threadIdx.x; i < NB * D; i += blockDim.x) { float v = c[i]; sc[i] = v * sigm_n(v); }
    __syncthreads();
    int idx = blockIdx.x * blockDim.x + threadIdx.x; int l = idx / MODW, n = idx % MODW;
    const float* w = w_mod + (size_t)l * D * MODW + n; float a0 = 0.f, a1 = 0.f;
    for (int k = 0; k < D; ++k) { float wv = w[(size_t)k * MODW]; a0 += sc[k] * wv; a1 += sc[D + k] * wv; }
    float bb = b_mod[l * MODW + n];
    mod[(size_t)(l * NB + 0) * MODW + n] = a0 + bb; mod[(size_t)(l * NB + 1) * MODW + n] = a1 + bb;
}
__global__ void k_ln_mod_n(const float* __restrict__ xin, const float* __restrict__ modl, int off_sh, int off_sc, float* __restrict__ uout) {
    int row = (blockIdx.x * blockDim.x + threadIdx.x) >> 6, lane = threadIdx.x & 63; if (row >= T) return; int b = row / S;
    f32x4 v[4];
#pragma unroll
    for (int j = 0; j < 4; ++j) v[j] = *(const f32x4*)(xin + (size_t)row * D + 4 * lane + 256 * j);
    float mean, rstd; row_ln(v, mean, rstd);
    const float* md = modl + (size_t)b * MODW;
#pragma unroll
    for (int j = 0; j < 4; ++j) { int col = 4 * lane + 256 * j; *(f32x4*)(uout + (size_t)row * D + col) = v[j] * rstd * (1.f + *(const f32x4*)(md + off_sc + col)) + *(const f32x4*)(md + off_sh + col); }
}
__global__ void k_post_n(const float* xin, const float* br, const float* __restrict__ modl, int off_gate, const float* __restrict__ gain, const float* __restrict__ bias, float* xout, float* u2out, int off_sh2, int off_sc2) {
    int row = (blockIdx.x * blockDim.x + threadIdx.x) >> 6, lane = threadIdx.x & 63; if (row >= T) return; int b = row / S;
    const float* md = modl + (size_t)b * MODW; f32x4 v[4];
#pragma unroll
    for (int j = 0; j < 4; ++j) { int col = 4 * lane + 256 * j; v[j] = *(const f32x4*)(xin + (size_t)row * D + col) * ALPHA + *(const f32x4*)(md + off_gate + col) * *(const f32x4*)(br + (size_t)row * D + col); }
    float mean, rstd; row_ln(v, mean, rstd);
#pragma unroll
    for (int j = 0; j < 4; ++j) { int col = 4 * lane + 256 * j; v[j] = v[j] * rstd * *(const f32x4*)(gain + col) + *(const f32x4*)(bias + col); *(f32x4*)(xout + (size_t)row * D + col) = v[j]; }
    if (u2out == nullptr) return;
    row_ln(v, mean, rstd);
#pragma unroll
    for (int j = 0; j < 4; ++j) { int col = 4 * lane + 256 * j; *(f32x4*)(u2out + (size_t)row * D + col) = v[j] * rstd * (1.f + *(const f32x4*)(md + off_sc2 + col)) + *(const f32x4*)(md + off_sh2 + col); }
}
__global__ void __launch_bounds__(256) k_gemm_f32(const float* __restrict__ A, int lda, const float* __restrict__ B, int ldb, float* __restrict__ C, int ldc, int K) {
    __shared__ float As[16][65]; __shared__ float Bs[16][64];
    const int tx = threadIdx.x & 15, ty = threadIdx.x >> 4; const int m0 = blockIdx.y * 64, n0 = blockIdx.x * 64;
    float acc[4][4];
#pragma unroll
    for (int i = 0; i < 4; ++i)
#pragma unroll
        for (int j = 0; j < 4; ++j) acc[i][j] = 0.f;
    for (int k0 = 0; k0 < K; k0 += 16) {
#pragma unroll
        for (int i = 0; i < 4; ++i) { int e = threadIdx.x + 256 * i; int m = e >> 4, k = e & 15; As[k][m] = A[(size_t)(m0 + m) * lda + k0 + k]; }
#pragma unroll
        for (int i = 0; i < 4; ++i) { int e = threadIdx.x + 256 * i; int k = e >> 6, n = e & 63; Bs[k][n] = B[(size_t)(k0 + k) * ldb + n0 + n]; }
        __syncthreads();
#pragma unroll
        for (int k = 0; k < 16; ++k) { float a[4], b[4];
#pragma unroll
            for (int i = 0; i < 4; ++i) { a[i] = As[k][ty * 4 + i]; b[i] = Bs[k][tx * 4 + i]; }
#pragma unroll
            for (int i = 0; i < 4; ++i)
#pragma unroll
                for (int j = 0; j < 4; ++j) acc[i][j] += a[i] * b[j]; }
        __syncthreads();
    }
#pragma unroll
    for (int i = 0; i < 4; ++i) *(float4*)(C + (size_t)(m0 + ty * 4 + i) * ldc + n0 + tx * 4) = make_float4(acc[i][0], acc[i][1], acc[i][2], acc[i][3]);
}
__global__ void __launch_bounds__(64) k_attn_n(HSrc h, const float* __restrict__ rpb, float* __restrict__ concat) {
    int idx = blockIdx.x * blockDim.x + threadIdx.x; if (idx >= T * AH) return;
    int head = idx % AH, tok = idx / AH; int b = tok / S, t = tok % S, r = t / GW, cq = t % GW;
    int rstart = r - KH / 2; rstart = rstart < 0 ? 0 : (rstart > ROWS - KH ? ROWS - KH : rstart);
    int cstart = cq - KW / 2; cstart = cstart < 0 ? 0 : (cstart > GW - KW ? GW - KW : cstart);
    float q[HD], acc[HD];
#pragma unroll
    for (int d = 0; d < HD; ++d) { q[d] = h.at(tok, head * HD + d); acc[d] = 0.f; }
    float m = -1e30f, l = 0.f; const float* rp = rpb + (size_t)head * 15 * 31;
    for (int kk = 0; kk < KH; ++kk) { int kr = rstart + kk; int dr = kr - r + (KH - 1);
        for (int j = 0; j < KW; ++j) { int ck = cstart + j; int dc = ck - cq; dc = dc < -15 ? -15 : (dc > 15 ? 15 : dc); dc += 15;
            size_t kt = (size_t)b * S + kr * GW + ck; float s = 0.f;
#pragma unroll
            for (int d = 0; d < HD; ++d) s += q[d] * h.at(kt, AW + head * HD + d);
            s = s * 0.125f + rp[dr * 31 + dc];
            float mn = fmaxf(m, s); float corr = expf(m - mn); float p = expf(s - mn); l = l * corr + p;
#pragma unroll
            for (int d = 0; d < HD; ++d) acc[d] = acc[d] * corr + p * h.at(kt, 2 * AW + head * HD + d);
            m = mn; } }
    float inv = 1.f / l;
#pragma unroll
    for (int d = 0; d < HD; ++d) concat[(size_t)tok * D + head * HD + d] = acc[d] * inv;
}
__global__ void __launch_bounds__(256) k_pool_n(HSrc h, const float* __restrict__ pool_w, const float* __restrict__ pool_scale, float* __restrict__ concat) {
    __shared__ float pooled[CW];
    int tok = blockIdx.x; int b = tok / S, t = tok % S; int ch = threadIdx.x; int g = ch / 64; int win = 2 << g;
    int lo = t - win / 2; lo = lo < 0 ? 0 : lo; int hi = t + win / 2 - 1; hi = hi > S - 1 ? S - 1 : hi;
    float s = 0.f; for (int u = lo; u <= hi; ++u) s += h.at((size_t)b * S + u, O_G + ch);
    pooled[ch] = s / (float)(hi - lo + 1) - h.at(tok, O_G + ch);
    __syncthreads();
    int e = ch % 64; const float* pw = pool_w + (size_t)g * 64 * 64 + e; float a = 0.f;
    for (int c2 = 0; c2 < 64; ++c2) a += pooled[g * 64 + c2] * pw[c2 * 64];
    concat[(size_t)tok * D + AW + BW + ch] = a * pool_scale[ch];
}
__global__ void __launch_bounds__(64) k_rwkv_scan_n(HSrc h, RwP p, float* __restrict__ ys) {
    const int lane = threadIdx.x; const int dir = blockIdx.x / (NB * BH), b = (blockIdx.x / BH) % NB, hd = blockIdx.x % BH; const int ch = hd * HD + lane;
    float st[HD];
#pragma unroll
    for (int j = 0; j < HD; ++j) st[j] = 0.f;
    float wup[RW], aup[RA];
#pragma unroll
    for (int m = 0; m < RW; ++m) { wup[m] = p.w_up[(size_t)(dir * RW + m) * BW + ch]; aup[m] = p.a_up[(size_t)(dir * RA + m) * BW + ch]; }
    const float w0 = p.w0[dir * BW + ch], a0 = p.a0[dir * BW + ch], kkw = p.k_k[ch], kaw = p.k_a[ch];
    float cr[3], ck[3], cv[3];
#pragma unroll
    for (int x = 0; x < 3; ++x) { cr[x] = p.conv[x * 3 * BW + ch]; ck[x] = p.conv[x * 3 * BW + BW + ch]; cv[x] = p.conv[x * 3 * BW + 2 * BW + ch]; }
    for (int step = 0; step < S; ++step) {
        const int t = dir ? (S - 1 - step) : step; const size_t row = (size_t)b * S + t;
        float r = 0.f, k = 0.f, v = 0.f;
#pragma unroll
        for (int x = 0; x < 3; ++x) { int tt = t + x - 1; if (tt >= 0 && tt < S) { size_t rr = (size_t)b * S + tt; r += h.at(rr, O_A + ch) * cr[x]; k += h.at(rr, O_A + BW + ch) * ck[x]; v += h.at(rr, O_A + 2 * BW + ch) * cv[x]; } }
        float lv = h.at(row, O_B + lane); float lt = lane < RW ? tanhf(lv) : lv; float zw = w0, za = a0;
#pragma unroll
        for (int m = 0; m < RW; ++m) { zw += __shfl(lt, m) * wup[m]; za += __shfl(lt, RW + m) * aup[m]; }
        const float w = expf(-DECAY * sigm_n(zw)); const float a = sigm_n(za);
        float kk = k * kkw; float ss = wave_sum(kk * kk); kk = kk * (1.f / sqrtf(fmaxf(ss, 1e-24f)));
        const float kd = k * (1.f + (a - 1.f) * kaw); const float kka = kk * a;
        float sa = 0.f;
#pragma unroll
        for (int j = 0; j < HD; ++j) sa += st[j] * (-__shfl(kk, j));
        float y = 0.f;
#pragma unroll
        for (int j = 0; j < HD; ++j) { st[j] = st[j] * __shfl(w, j) + sa * __shfl(kka, j) + v * __shfl(kd, j); y += st[j] * __shfl(r, j); }
        ys[((size_t)dir * T + b * S + t) * BW + ch] = y;
    }
}
__global__ void __launch_bounds__(384) k_rwkv_finish_n(HSrc h, RwP p, const float* __restrict__ ys, float* __restrict__ concat) {
    __shared__ float lw[RW], la[RA], sg[RG];
    const int tok = blockIdx.x, b = tok / S, t = tok % S, ch = threadIdx.x, hd = ch / HD, j = ch % HD;
    if (ch < RW) lw[ch] = tanhf(h.at(tok, O_B + ch)); else if (ch < RW + RA) la[ch - RW] = h.at(tok, O_W + (ch - RW)); else if (ch < RW + RA + RG) sg[ch - RW - RA] = sigm_n(h.at(tok, O_AL + (ch - RW - RA)));
    __syncthreads();
    float r = 0.f, k = 0.f, v = 0.f;
#pragma unroll
    for (int x = 0; x < 3; ++x) { int tt = t + x - 1; if (tt >= 0 && tt < S) { size_t rr = (size_t)b * S + tt;
        r += h.at(rr, O_A + ch) * p.conv[x * 3 * BW + ch]; k += h.at(rr, O_A + BW + ch) * p.conv[x * 3 * BW + BW + ch]; v += h.at(rr, O_A + 2 * BW + ch) * p.conv[x * 3 * BW + 2 * BW + ch]; } }
    float bon = 0.f;
    for (int dir = 0; dir < 2; ++dir) { float za = p.a0[dir * BW + ch]; for (int m = 0; m < RA; ++m) za += la[m] * p.a_up[(size_t)(dir * RA + m) * BW + ch];
        float a = sigm_n(za); float kd = k * (1.f + (a - 1.f) * p.k_a[ch]); bon += wave_sum(r * kd * p.r_k[hd * HD + j]); }
    bon *= v;
    float y = ys[(size_t)tok * BW + ch] + ys[((size_t)T + tok) * BW + ch];
    float mu = wave_sum(y) * (1.f / HD); float dy = y - mu; float var = wave_sum(dy * dy) * (1.f / HD);
    float yn = dy * (1.f / sqrtf(var + GN_EPS)) * p.gn_gain[ch] + p.gn_bias[ch];
    float g = 0.f; for (int m = 0; m < RG; ++m) g += sg[m] * p.g_up[(size_t)m * BW + ch];
    concat[(size_t)tok * D + AW + ch] = (yn + bon) * g;
}
__global__ void __launch_bounds__(256) k_moe_n(const float* __restrict__ u2, const int* __restrict__ tokslot, const float* __restrict__ ew,
                                                const float* __restrict__ wgate, const float* __restrict__ wup, const float* __restrict__ wdown, float* __restrict__ f) {
    __shared__ float xs[D]; __shared__ float hb[DE];
    const int tok = blockIdx.x, tid = threadIdx.x;
    for (int i = tid; i < D; i += 256) xs[i] = u2[(size_t)tok * D + i];
    float o[4] = {0.f, 0.f, 0.f, 0.f};
    for (int kk = 0; kk < 2; ++kk) {
        const int ts = tokslot[tok * 2 + kk]; const int e = ts >> 14; const float wt = ew[ts];
        __syncthreads();
        const float* g = wgate + (size_t)e * D * DE; const float* u = wup + (size_t)e * D * DE;
        float ag0 = 0.f, ag1 = 0.f, au0 = 0.f, au1 = 0.f;
        for (int k = 0; k < D; ++k) { float x = xs[k]; ag0 += x * g[(size_t)k * DE + tid]; ag1 += x * g[(size_t)k * DE + 256 + tid]; au0 += x * u[(size_t)k * DE + tid]; au1 += x * u[(size_t)k * DE + 256 + tid]; }
        hb[tid] = ag0 * sigm_n(ag0) * au0; hb[256 + tid] = ag1 * sigm_n(ag1) * au1;
        __syncthreads();
        const float* dn = wdown + (size_t)e * DE * D; float a[4] = {0.f, 0.f, 0.f, 0.f};
        for (int k = 0; k < DE; ++k) { float x = hb[k];
#pragma unroll
            for (int j = 0; j < 4; ++j) a[j] += x * dn[(size_t)k * D + tid + 256 * j]; }
#pragma unroll
        for (int j = 0; j < 4; ++j) o[j] += a[j] * wt;
    }
#pragma unroll
    for (int j = 0; j < 4; ++j) f[(size_t)tok * D + tid + 256 * j] = o[j];
}

__global__ void k_router_n(const float* __restrict__ u2, const float* __restrict__ wg, const float* __restrict__ bg, const float* __restrict__ we, const float* __restrict__ be, int* __restrict__ tok_e) {
    int row = (blockIdx.x * blockDim.x + threadIdx.x) >> 6, lane = threadIdx.x & 63; if (row >= T) return;
    float gl[NG], el[NE];
#pragma unroll
    for (int n = 0; n < NG; ++n) gl[n] = 0.f;
#pragma unroll
    for (int n = 0; n < NE; ++n) el[n] = 0.f;
    for (int i = 0; i < 16; ++i) { int k = lane + 64 * i; float x = u2[(size_t)row * D + k];
#pragma unroll
        for (int n = 0; n < NG; ++n) gl[n] += x * wg[k * NG + n];
#pragma unroll
        for (int n = 0; n < NE; ++n) el[n] += x * we[k * NE + n]; }
#pragma unroll
    for (int n = 0; n < NG; ++n) gl[n] = wave_sum(gl[n]) + bg[n];
#pragma unroll
    for (int n = 0; n < NE; ++n) el[n] = wave_sum(el[n]) + be[n];
    int gi = 0; float gm = gl[0];
#pragma unroll
    for (int n = 1; n < NG; ++n) if (gl[n] > gm) { gm = gl[n]; gi = n; }
    float l1 = -3.0e38f, l2 = -3.0e38f; int i1 = 0, i2 = 0;
#pragma unroll
    for (int n = 0; n < NE; ++n) if ((n >> 3) == gi) { float v = el[n]; int e = n & 7; if (v > l1) { l2 = l1; i2 = i1; l1 = v; i1 = e; } else if (v > l2) { l2 = v; i2 = e; } }
    if (lane == 0) { tok_e[row * 2] = gi * EPG + i1; tok_e[row * 2 + 1] = gi * EPG + i2; }
}
__global__ void k_cmp_route(const int* __restrict__ tokslot, const int* __restrict__ tok_e, float* acc, int slot) {
    float mis = 0.f, tot = 0.f;
    for (int t = blockIdx.x * blockDim.x + threadIdx.x; t < T; t += gridDim.x * blockDim.x) { const int a0 = tokslot[2 * t] >> 14, a1 = tokslot[2 * t + 1] >> 14;
        mis += (a0 != tok_e[2 * t] || a1 != tok_e[2 * t + 1]) ? 1.f : 0.f; tot += 1.f; }
    mis = wave_sum(mis); tot = wave_sum(tot);
    if ((threadIdx.x & 63) == 0) { atomicAdd(acc + 2 * slot, mis); atomicAdd(acc + 2 * slot + 1, tot); }
}
__global__ void k_bf2f(const bf16_t* __restrict__ src, float* __restrict__ dst, size_t n) { for (size_t i = (size_t)blockIdx.x * blockDim.x + threadIdx.x; i < n; i += (size_t)gridDim.x * blockDim.x) dst[i] = bf2f(src[i]); }
template <class TA> __global__ void k_cmp(const TA* __restrict__ a, size_t lda, const float* __restrict__ b, size_t ldb, int rows, int cols, float* acc, int slot) {
    float d2 = 0.f, r2 = 0.f;
    for (size_t i = (size_t)blockIdx.x * blockDim.x + threadIdx.x; i < (size_t)rows * cols; i += (size_t)gridDim.x * blockDim.x) {
        const size_t r = i / cols, c = i % cols; float av; if constexpr (sizeof(TA) == 2) av = bf2f(a[r * lda + c]); else av = a[r * lda + c];
        const float bv = b[r * ldb + c]; d2 += (av - bv) * (av - bv); r2 += bv * bv; }
    d2 = wave_sum(d2); r2 = wave_sum(r2);
    if ((threadIdx.x & 63) == 0) { atomicAdd(acc + 2 * slot, d2); atomicAdd(acc + 2 * slot + 1, r2); }
}
__global__ void k_cmp_vt(const bf16_t* __restrict__ vt, const float* __restrict__ b, size_t ldb, float* acc, int slot) {
    float d2 = 0.f, r2 = 0.f;
    for (size_t i = (size_t)blockIdx.x * blockDim.x + threadIdx.x; i < (size_t)T * AW; i += (size_t)gridDim.x * blockDim.x) {
        const size_t r = i % T, c = i / T; const float av = bf2f(vt[c * T + r]), bv = b[r * ldb + c]; d2 += (av - bv) * (av - bv); r2 += bv * bv; }
    d2 = wave_sum(d2); r2 = wave_sum(r2);
    if ((threadIdx.x & 63) == 0) { atomicAdd(acc + 2 * slot, d2); atomicAdd(acc + 2 * slot + 1, r2); }
}
struct Tols { float t[8]; int n; };
__global__ void k_readout(float* out, const float* acc, Tols tl, int total) {
    float mx = 0.f; int am = 0; for (int k = 0; k < tl.n; ++k) { float e = sqrtf(acc[2 * k] / fmaxf(acc[2 * k + 1], 1e-30f)); if (!(e == e)) e = 1e3f; if (e / tl.t[k] > mx) { mx = e / tl.t[k]; am = k; } }
    const float cval = sqrtf(1000.f * mx);
    for (int i = blockIdx.x * blockDim.x + threadIdx.x; i < total; i += gridDim.x * blockDim.x) out[i] = (i < 8) ? 1000.f * (float)(am + 1) : cval;
}
__global__ void __launch_bounds__(256) k_moe_chk(const float* __restrict__ u2, const int* __restrict__ tokslot, const float* __restrict__ ew, const unsigned* __restrict__ cnt,
                                                  const float* __restrict__ wgate, const float* __restrict__ wup, const float* __restrict__ wdown,
                                                  const bf16_t* __restrict__ XS, const bf16_t* __restrict__ HM, const bf16_t* __restrict__ YS, float* acc) {
    __shared__ float xs[D]; __shared__ float hb[DE]; __shared__ int offp[NE];
    const int tok = blockIdx.x, tid = threadIdx.x;
    if (tid == 0) { int off = 0; for (int e = 0; e < NE; ++e) { offp[e] = off; off += (((int)cnt[e] + 255) >> 8) * 256; } }
    for (int i = tid; i < D; i += 256) xs[i] = u2[(size_t)tok * D + i];
    float d0 = 0.f, r0 = 0.f, d1 = 0.f, r1 = 0.f, d2 = 0.f, r2 = 0.f;
    for (int kk = 0; kk < 2; ++kk) {
        __syncthreads();
        const int ts = tokslot[tok * 2 + kk]; const int e = ts >> 14; const float wt = ew[ts]; const size_t slot = (size_t)offp[e] + (ts & 16383);
        for (int i = tid; i < D; i += 256) { const float a = bf2f(XS[slot * D + i]), b = xs[i]; d0 += (a - b) * (a - b); r0 += b * b; }
        const float* g = wgate + (size_t)e * D * DE; const float* u = wup + (size_t)e * D * DE;
        float ag0 = 0.f, ag1 = 0.f, au0 = 0.f, au1 = 0.f;
        for (int k = 0; k < D; ++k) { float x = xs[k]; ag0 += x * g[(size_t)k * DE + tid]; ag1 += x * g[(size_t)k * DE + 256 + tid]; au0 += x * u[(size_t)k * DE + tid]; au1 += x * u[(size_t)k * DE + 256 + tid]; }
        const float h0 = ag0 * sigm_n(ag0) * au0, h1 = ag1 * sigm_n(ag1) * au1;
        hb[tid] = h0; hb[256 + tid] = h1;
        { const float a = bf2f(HM[slot * DE + tid]), b = bf2f(HM[slot * DE + 256 + tid]); d1 += (a - h0) * (a - h0) + (b - h1) * (b - h1); r1 += h0 * h0 + h1 * h1; }
        __syncthreads();
        const float* dn = wdown + (size_t)e * DE * D; float a4[4] = {0.f, 0.f, 0.f, 0.f};
        for (int k = 0; k < DE; ++k) { float x = hb[k];
#pragma unroll
            for (int j = 0; j < 4; ++j) a4[j] += x * dn[(size_t)k * D + tid + 256 * j]; }
#pragma unroll
        for (int j = 0; j < 4; ++j) {
#ifdef MOEB_NOSCALE
            const float y = a4[j];
#else
            const float y = a4[j] * wt;
#endif
            const float a = bf2f(YS[slot * D + tid + 256 * j]); d2 += (a - y) * (a - y); r2 += y * y; }
    }
    d0 = wave_sum(d0); r0 = wave_sum(r0); d1 = wave_sum(d1); r1 = wave_sum(r1); d2 = wave_sum(d2); r2 = wave_sum(r2);
    if ((tid & 63) == 0) { atomicAdd(acc + 0, d0); atomicAdd(acc + 1, r0); atomicAdd(acc + 2, d1); atomicAdd(acc + 3, r1); atomicAdd(acc + 4, d2); atomicAdd(acc + 5, r2); }
}

extern "C" void kernel_launch(void* const* d_in, const int* in_sizes, int n_in, void* d_out, int out_size, void* d_ws, size_t ws_size, hipStream_t stream) {
    static int once = 0; if (!once) { (void)hipFuncSetAttribute((const void*)mk_fwd, hipFuncAttributeMaxDynamicSharedMemorySize, LDS_BYTES); once = 1; }
    (void)hipMemsetAsync((char*)d_ws + WS_CTL, 0, CTL_BYTES, stream);
    Args a{}; fill_args(a, d_in, d_out, d_ws);
    char* ws = (char*)d_ws; float* out = (float*)d_out;
    float* ACC = (float*)(ws + 32768 + 1024);
    const float* x = a.in[0];
    HSrc hs{(const bf16_t*)(ws + WS_HB), (const bf16_t*)(ws + WS_VT)};
    const int l = 0;
    RwP p = { a.in[6], a.in[7], a.in[8], a.in[9], a.in[10], a.in[11], a.in[12], a.in[13], a.in[14], a.in[15], a.in[16] };
    Tols tl{};
#if TESTMODE == 1
    launch_phases(a, 0, 3, stream);
    float* MODn = (float*)(ws + WS_MOD + 512 * 1024); float* Un = (float*)(ws + WS_XA); float* HF = (float*)(ws + WS_CONCAT);
    k_mod_n<<<L * MODW / 256, 256, 0, stream>>>(a.in[1], a.in[2], a.in[3], MODn);
    k_ln_mod_n<<<T / 4, 256, 0, stream>>>(x, MODn, 0, D, Un);
    k_gemm_f32<<<dim3(INW / 64, T / 64), 256, 0, stream>>>(Un, D, a.in[4], INW, HF, INW, D);
    k_cmp<float><<<256, 256, 0, stream>>>((const float*)(ws + WS_MOD), MODW, MODn, MODW, L * NB, MODW, ACC, 0);
    k_cmp<bf16_t><<<1024, 256, 0, stream>>>((const bf16_t*)(ws + WS_U), D, Un, D, T, D, ACC, 1);
    k_cmp<bf16_t><<<1024, 256, 0, stream>>>((const bf16_t*)(ws + WS_HB), HW, HF, INW, T, 768, ACC, 2);
    k_cmp<bf16_t><<<1024, 256, 0, stream>>>((const bf16_t*)(ws + WS_HB) + 768, HW, HF + 1152, INW, T, 1536, ACC, 3);
    k_cmp_vt<<<1024, 256, 0, stream>>>((const bf16_t*)(ws + WS_VT), HF + 768, INW, ACC, 4);
    tl.n = 5; tl.t[0] = 1e-5f; tl.t[1] = 4e-3f; tl.t[2] = 6e-3f; tl.t[3] = 6e-3f; tl.t[4] = 6e-3f;
#elif TESTMODE == 2
    launch_phases(a, 0, 4, stream);
    float* CCn = (float*)(ws + WS_XA); float* YSn = (float*)(ws + WS_WGU);
    k_attn_n<<<T * AH / 64, 64, 0, stream>>>(hs, a.in[5], CCn);
    k_pool_n<<<T, 256, 0, stream>>>(hs, a.in[17], a.in[18], CCn);
    k_rwkv_scan_n<<<2 * NB * BH, 64, 0, stream>>>(hs, p, YSn);
    k_rwkv_finish_n<<<T, 384, 0, stream>>>(hs, p, YSn, CCn);
    launch_phases(a, 4, 6, stream);
    k_cmp<bf16_t><<<1024, 256, 0, stream>>>((const bf16_t*)(ws + WS_CONCAT), D, CCn, D, T, AW, ACC, 0);
    k_cmp<bf16_t><<<1024, 256, 0, stream>>>((const bf16_t*)(ws + WS_CONCAT) + AW, D, CCn + AW, D, T, BW, ACC, 1);
    k_cmp<bf16_t><<<1024, 256, 0, stream>>>((const bf16_t*)(ws + WS_CONCAT) + AW + BW, D, CCn + AW + BW, D, T, CW, ACC, 2);
    tl.n = 3; tl.t[0] = TOL0; tl.t[1] = TOL1; tl.t[2] = TOL2;
#elif TESTMODE == 3
    launch_phases(a, 0, 11, stream);
    { const float* MODf = (const float*)(ws + WS_MOD);
      float* U2f = (float*)(ws + 414 * MiB); float* Fn = (float*)(ws + 213 * MiB); float* X2n = (float*)(ws + 277 * MiB);
      k_bf2f<<<2048, 256, 0, stream>>>((const bf16_t*)(ws + WS_U), U2f, (size_t)T * D);
      launch_phases(a, 11, 12, stream);
      k_moe_n<<<T, 256, 0, stream>>>(U2f, (const int*)(ws + WS_TOKSLOT), (const float*)(ws + WS_EW), a.in[28], a.in[29], a.in[30], Fn);
      k_post_n<<<T / 4, 256, 0, stream>>>((const float*)(ws + WS_XA), Fn, MODf, 5 * D, a.in[22], a.in[23], X2n, nullptr, 0, 0);
      k_cmp<float><<<1024, 256, 0, stream>>>(out, D, X2n, D, T, D, ACC, 0); }
    tl.n = 1; tl.t[0] = TOL0;
#elif TESTMODE == 4
    launch_phases(a, 0, 8, stream);
    { const float* MODf = (const float*)(ws + WS_MOD);
      float* CCn = (float*)(ws + 405 * MiB); float* MIXn = (float*)(ws + 213 * MiB); float* X1n = (float*)(ws + 21 * MiB); float* U2n = (float*)(ws + 333 * MiB); int* TEn = (int*)(ws + 490 * MiB);
      k_bf2f<<<2048, 256, 0, stream>>>((const bf16_t*)(ws + WS_CONCAT), CCn, (size_t)T * D);
      k_gemm_f32<<<dim3(D / 64, T / 64), 256, 0, stream>>>(CCn, D, a.in[19], D, MIXn, D, D);
      k_post_n<<<T / 4, 256, 0, stream>>>(x, MIXn, MODf, 2 * D, a.in[20], a.in[21], X1n, U2n, 3 * D, 4 * D);
      k_router_n<<<T / 4, 256, 0, stream>>>(U2n, a.in[24], a.in[25], a.in[26], a.in[27], TEn);
      k_cmp<float><<<1024, 256, 0, stream>>>((const float*)(ws + WS_XA), D, X1n, D, T, D, ACC, 0);
      k_cmp<bf16_t><<<1024, 256, 0, stream>>>((const bf16_t*)(ws + WS_U), D, U2n, D, T, D, ACC, 1);
      k_cmp_route<<<64, 256, 0, stream>>>((const int*)(ws + WS_TOKSLOT), TEn, ACC, 2); }
    tl.n = 3; tl.t[0] = TOL0; tl.t[1] = TOL1; tl.t[2] = TOL2;
#elif TESTMODE == 5
    launch_phases(a, 0, 11, stream);
    { float* U2f = (float*)(ws + 414 * MiB);
      k_bf2f<<<2048, 256, 0, stream>>>((const bf16_t*)(ws + WS_U), U2f, (size_t)T * D);
      k_moe_chk<<<T, 256, 0, stream>>>(U2f, (const int*)(ws + WS_TOKSLOT), (const float*)(ws + WS_EW), (const unsigned*)(ws + WS_CTL) + CW_CNT, a.in[28], a.in[29], a.in[30],
                                       (const bf16_t*)(ws + WS_XS), (const bf16_t*)(ws + WS_HM), (const bf16_t*)(ws + WS_YS), ACC); }
    tl.n = 3; tl.t[0] = 1e-6f; tl.t[1] = 1e-2f; tl.t[2] = 1e-2f;
#endif
    k_readout<<<256, 256, 0, stream>>>(out, ACC, tl, out_size);
}
#endif
```

```cpp
#define TESTMODE 0
#define MK_MODE 0
#include <hip/hip_runtime.h>
#include <hip/hip_cooperative_groups.h>
#include <stdint.h>
namespace cg = cooperative_groups;

#ifndef TESTMODE
#define TESTMODE 0
#endif
#define DI __device__ __forceinline__
#define LAS __attribute__((address_space(3)))
typedef unsigned short bf16_t;
typedef short bf16x8 __attribute__((ext_vector_type(8)));
typedef float f32x4 __attribute__((ext_vector_type(4)));
typedef float f32x16 __attribute__((ext_vector_type(16)));
typedef unsigned u32x4 __attribute__((ext_vector_type(4)));
typedef unsigned u32x2 __attribute__((ext_vector_type(2)));
typedef float f32x2_t __attribute__((ext_vector_type(2)));
typedef __bf16 bf16x2_t __attribute__((ext_vector_type(2)));

namespace cfg {
constexpr int D = 1024, NB = 2, S = 8192, T = NB * S, L = 2;
constexpr int GW = 64, ROWS = 128;
constexpr int HD = 64, AW = 384, BW = 384, CW = 256, AH = 6, BH = 6;
constexpr int KH = 8, KW = 16;
constexpr int RW = 32, RA = 32, RG = 64;
constexpr int INW = 2688;
constexpr int NG = 4, EPG = 8, NE = 32, DE = 512;
constexpr int MODW = 6 * D;
constexpr float ALPHA = 1.41421356237309515f;
constexpr float LN_EPS = 1e-5f, GN_EPS = 64e-5f;
constexpr float DECAY = 0.60653065971263342f;
constexpr float LOG2E = 1.44269504088896341f;
constexpr int HW = 2304, HQ = 0, HK = 384, HR = 768, HWL = 1920, HAL = 1952, HGL = 1984, HP = 2048;
constexpr int NCH = S / 64;
constexpr int NUNIT = 2 * NB * BH * NCH;
constexpr int XSROWS = 2 * T + NE * 256;
}
using namespace cfg;

constexpr size_t MiB = 1u << 20;
constexpr size_t WS_CTL = 0;
constexpr size_t CTL_BYTES = 65536;
constexpr int CW_BAR = 0;
constexpr int CW_CNT = 8192;
constexpr size_t WS_MOD = 1 * MiB;
constexpr size_t WS_TOKSLOT = 1 * MiB + 128 * 1024;
constexpr size_t WS_SLOTW = 1 * MiB + 256 * 1024;
constexpr size_t WS_BC = 2 * MiB;
constexpr size_t WS_TOKW = 2 * MiB + 64 * 1024;
constexpr size_t WS_TOKFIN = 2 * MiB + 256 * 1024;
constexpr size_t WS_CNTF = 2 * MiB + 512 * 1024;
constexpr size_t WS_WIN = 6 * MiB;
constexpr size_t WIN_LAYER = (size_t)2816 * 1024 * 2;
constexpr size_t WS_WOUT = 17 * MiB;
constexpr size_t WS_WGU = 21 * MiB;
constexpr size_t WS_WD = 85 * MiB;
constexpr size_t WS_XA = 117 * MiB;
constexpr size_t WS_U = 181 * MiB;
constexpr size_t WS_HB = 213 * MiB;
constexpr size_t WS_S0 = 213 * MiB;
constexpr size_t WS_VT = 285 * MiB;
constexpr size_t WS_CONCAT = 301 * MiB;
constexpr size_t WS_MP = 333 * MiB;
constexpr size_t WS_NB = 357 * MiB;
constexpr size_t WS_MIX = 333 * MiB;
constexpr size_t WS_QT = 405 * MiB;
constexpr size_t WS_WT = 429 * MiB;
constexpr size_t WS_VTB = 453 * MiB;
constexpr size_t WS_GB = 465 * MiB;
constexpr size_t WS_VC = 477 * MiB;
constexpr size_t WS_BS = 489 * MiB;
constexpr size_t WS_XS = 213 * MiB;
constexpr size_t WS_HM = 293 * MiB;
constexpr size_t WS_YS = 333 * MiB;
constexpr size_t WS_END = 490 * MiB;

constexpr int NWAVES = 8, NTHREADS = 512;
constexpr int LDS_BYTES = 156 * 1024;

DI unsigned cvtpk(float lo, float hi) { f32x2_t v = {lo, hi}; bf16x2_t b = __builtin_convertvector(v, bf16x2_t); return __builtin_bit_cast(unsigned, b); }
DI float bflo(unsigned w) { return __uint_as_float(w << 16); }
DI float bfhi(unsigned w) { return __uint_as_float(w & 0xffff0000u); }
DI float bf2f(unsigned short h) { return __uint_as_float((unsigned)h << 16); }
DI unsigned short f2bf(float f) { return (unsigned short)(cvtpk(f, 0.f) & 0xffffu); }
DI float wave_sum_shfl(float v) {
#pragma unroll
    for (int o = 32; o > 0; o >>= 1) v += __shfl_xor(v, o);
    return v;
}
template <int CTRL, int ROWMASK> DI float dpp_add(float v) { return v + __builtin_bit_cast(float, __builtin_amdgcn_update_dpp(0, __builtin_bit_cast(int, v), CTRL, ROWMASK, 0xf, false)); }
DI float wave_sum(float v) {
    v = dpp_add<0xb1, 0xf>(v);
    v = dpp_add<0x4e, 0xf>(v);
    v = dpp_add<0x124, 0xf>(v);
    v = dpp_add<0x128, 0xf>(v);
    v = dpp_add<0x142, 0xa>(v);
    v = dpp_add<0x143, 0xc>(v);
    return __builtin_bit_cast(float, __builtin_amdgcn_readlane(__builtin_bit_cast(int, v), 63));
}
DI float sigm(float x) { return 1.f / (1.f + __expf(-x)); }
#define LDS_WAIT() asm volatile("s_waitcnt lgkmcnt(0)" ::: "memory")
#define VM_WAIT() asm volatile("s_waitcnt vmcnt(0)" ::: "memory")
DI int swap23(int i) { return (i & ~12) | ((i & 4) << 1) | ((i & 8) >> 1); }

namespace pg8 {
constexpr int BM = 256, BK = 64, HALF = 128, HTB = HALF * BK * 2, STAGE_BYTES = 8 * HTB, NXCD = 8, WGM = 8;
__host__ __device__ __forceinline__ int lds_byte(int r, int c) { const int st = (r >> 4) * 2 + (c >> 5), rr = r & 15, cc = c & 31, ob = rr * 64 + cc * 2; return st * 1024 + (ob ^ (((ob >> 9) & 1) << 5)); }
__host__ __device__ __forceinline__ void stage_rc(int b, int& R, int& C) { const int st = b / 1024, sb = b % 1024, swz = sb ^ (((sb >> 9) & 1) << 5); R = (st >> 1) * 16 + swz / 64; C = (st & 1) * 32 + (swz % 64) / 2; }
__host__ __device__ __forceinline__ int perm32(int rho) { const int n = rho >> 4, i = rho & 15; return 8 * (i >> 2) + 4 * n + (i & 3); }

struct Unit { int pm, pn, aux; };

DI int xcd_remap(int L, int nwg) { const int q = nwg / NXCD, r = nwg % NXCD, xcd = L % NXCD, off = L / NXCD; return (xcd < r ? xcd * (q + 1) : r * (q + 1) + (xcd - r) * q) + off; }

struct PlainOrder {
    const bf16_t* A; const bf16_t* Bt; int K; int nM, nN, nwg, G, c;
    DI void init(const bf16_t* A_, const bf16_t* Bt_, int M, int N, int K_, int G_, int c_) { A = A_; Bt = Bt_; K = K_; nM = M / BM; nN = N / BM; nwg = nM * nN; G = G_; c = c_; }
    DI bool next(int i, Unit& u) const {
        const int Lx = i * G + c; if (Lx >= nwg) return false;
        const int wgid = xcd_remap(Lx, nwg);
        const int nig = WGM * nN, gid = wgid / nig, fm = gid * WGM, gsz = (nM - fm) < WGM ? (nM - fm) : WGM;
        u.pm = fm + ((wgid % nig) % gsz); u.pn = (wgid % nig) / gsz; u.aux = 0; return true;
    }
    DI const char* aptr(const Unit& u) const { return (const char*)A + (size_t)u.pm * (2 * HALF) * K * 2; }
    DI const char* bptr(const Unit& u) const { return (const char*)Bt + (size_t)u.pn * (2 * HALF) * K * 2; }
};
struct Gemm1Order {
    const bf16_t* U; const bf16_t* Win; const bf16_t* Wv; int G, c;
    static constexpr int nM = T / BM, nN = HW / BM, nMain = nM * nN, nV = 2 * (T / BM), nwg = nMain + nV, K = D;
    DI bool next(int i, Unit& u) const {
        const int Lx = i * G + c; if (Lx >= nwg) return false;
        if (Lx < nMain) {
            const int wgid = xcd_remap(Lx, nMain);
            const int nig = WGM * nN, gid = wgid / nig, fm = gid * WGM, gsz = (nM - fm) < WGM ? (nM - fm) : WGM;
            u.pm = fm + ((wgid % nig) % gsz); u.pn = (wgid % nig) / gsz; u.aux = 0;
        } else { const int v = Lx - nMain; u.pm = v & 1; u.pn = v >> 1; u.aux = 1; }
        return true;
    }
    DI const char* aptr(const Unit& u) const { return (const char*)(u.aux ? Wv : U) + (size_t)u.pm * BM * K * 2; }
    DI const char* bptr(const Unit& u) const { return (const char*)(u.aux ? U : Win) + (size_t)u.pn * BM * K * 2; }
};
struct GroupedOrder {
    const bf16_t* A; const bf16_t* Bt; int K; size_t estride; const LAS int* tile_e; int ntiles, nwg, G, c;
    DI bool next(int i, Unit& u) const {
        const int Lx = i * G + c; if (Lx >= nwg) return false;
        const int wgid = xcd_remap(Lx, nwg);
        u.pm = wgid >> 2; u.pn = wgid & 3; u.aux = tile_e[u.pm]; return true;
    }
    DI const char* aptr(const Unit& u) const { return (const char*)A + (size_t)u.pm * BM * K * 2; }
    DI const char* bptr(const Unit& u) const { return (const char*)Bt + ((size_t)u.aux * estride + (size_t)u.pn * BM * K) * 2; }
};

struct EpiStore {
    bf16_t* O0; int ld0; bf16_t* O1; int ld1;
    DI void operator()(const f32x4 (&acc)[2][2][4][2], const Unit& u, int wr, int wc, int fr, int fq) const {
        bf16_t* base = u.aux ? O1 : O0; const int ldc = u.aux ? ld1 : ld0;
        const int row0 = u.pm * BM + wr * 64 + fr, col0 = u.pn * BM + wc * 32 + 8 * fq;
#pragma unroll
        for (int ai = 0; ai < 2; ++ai)
#pragma unroll
            for (int m = 0; m < 4; ++m) { bf16_t* rowp = base + (size_t)(row0 + ai * HALF + m * 16) * ldc + col0;
#pragma unroll
                for (int bj = 0; bj < 2; ++bj) { const f32x4 v0 = acc[ai][bj][m][0], v1 = acc[ai][bj][m][1];
                    u32x4 w; w.x = cvtpk(v0[0], v0[1]); w.y = cvtpk(v0[2], v0[3]); w.z = cvtpk(v1[0], v1[1]); w.w = cvtpk(v1[2], v1[3]);
                    *(u32x4*)(rowp + bj * HALF) = w; } }
    }
};
struct EpiSwiGlu {
    bf16_t* O;
    DI void operator()(const f32x4 (&acc)[2][2][4][2], const Unit& u, int wr, int wc, int fr, int fq) const {
        const int row0 = u.pm * BM + wr * 64 + fr, col0 = u.pn * HALF + wc * 32 + 8 * fq;
#pragma unroll
        for (int ai = 0; ai < 2; ++ai)
#pragma unroll
            for (int m = 0; m < 4; ++m) { bf16_t* rowp = O + (size_t)(row0 + ai * HALF + m * 16) * DE + col0;
                float hv[8];
#pragma unroll
                for (int n = 0; n < 2; ++n)
#pragma unroll
                    for (int e = 0; e < 4; ++e) { const float g = acc[ai][0][m][n][e], up = acc[ai][1][m][n][e]; hv[4 * n + e] = g * sigm(g) * up; }
                u32x4 w; w.x = cvtpk(hv[0], hv[1]); w.y = cvtpk(hv[2], hv[3]); w.z = cvtpk(hv[4], hv[5]); w.w = cvtpk(hv[6], hv[7]);
                *(u32x4*)rowp = w; }
    }
};
struct EpiRowScale {
    bf16_t* O; const float* roww;
    DI void operator()(const f32x4 (&acc)[2][2][4][2], const Unit& u, int wr, int wc, int fr, int fq) const {
        const int row0 = u.pm * BM + wr * 64 + fr, col0 = u.pn * BM + wc * 32 + 8 * fq;
#pragma unroll
        for (int ai = 0; ai < 2; ++ai)
#pragma unroll
            for (int m = 0; m < 4; ++m) { const int row = row0 + ai * HALF + m * 16;
#ifdef MOEB_NOSCALE
                const float s = 1.f;
#else
                const float s = roww[row];
#endif
                bf16_t* rowp = O + (size_t)row * D + col0;
#pragma unroll
                for (int bj = 0; bj < 2; ++bj) { const f32x4 v0 = acc[ai][bj][m][0] * s, v1 = acc[ai][bj][m][1] * s;
                    u32x4 w; w.x = cvtpk(v0[0], v0[1]); w.y = cvtpk(v0[2], v0[3]); w.z = cvtpk(v1[0], v1[1]); w.w = cvtpk(v1[2], v1[3]);
                    *(u32x4*)(rowp + bj * HALF) = w; } }
    }
};

template <class Epi, class Sched>
DI void gemm_phase(LAS unsigned char* lds, const int tid, const int K, const Sched& S, const Epi& E) {
    const int wid = __builtin_amdgcn_readfirstlane(tid >> 6), lane = tid & 63, wr = wid >> 2, wc = wid & 3, fr = lane & 15, fq = lane >> 4;
    const int nt = K / BK;
    unsigned voffA[2], voffB[2];
#pragma unroll
    for (int i = 0; i < 2; ++i) { int R, C; stage_rc(tid * 16 + i * 8192, R, C); const int Rb = (R & ~31) + perm32(R & 31);
        voffA[i] = (unsigned)(R * K + C) * 2u; voffB[i] = (unsigned)(Rb * K + C) * 2u; }
    const size_t kstep = (size_t)(BK * 2);
    const size_t hstep = (size_t)HALF * K * 2;
    const unsigned ldsw = (unsigned)wid * 1024u;
    const int aoff = lds_byte(wr * 64 + fr, fq * 8), boff = lds_byte(wc * 32 + fr, fq * 8);
#define PG8_SA(b, h) (((b) * 2 + (h)) * HTB)
#define PG8_SB(b, h) ((4 + (b) * 2 + (h)) * HTB)
#define PG8_STAGE(bufoff, gbase, voff) do { _Pragma("unroll") for (int _i = 0; _i < 2; ++_i) \
        __builtin_amdgcn_global_load_lds((const unsigned*)((const char*)(gbase) + (voff)[_i]), (LAS unsigned*)(lds + (bufoff) + ldsw + _i * 8192), 16, 0, 0); } while (0)
#define PG8_LDA(dst, b, h) do { _Pragma("unroll") for (int m = 0; m < 4; ++m) _Pragma("unroll") for (int k = 0; k < 2; ++k) dst[m][k] = *(const LAS bf16x8*)(lds + PG8_SA(b, h) + aoff + m * 2048 + k * 1024); } while (0)
#define PG8_LDB(dst, b, h) do { _Pragma("unroll") for (int n = 0; n < 2; ++n) _Pragma("unroll") for (int k = 0; k < 2; ++k) dst[n][k] = *(const LAS bf16x8*)(lds + PG8_SB(b, h) + boff + n * 2048 + k * 1024); } while (0)
#define PG8_MMA(ai, bj, At, Bt) do { __builtin_amdgcn_s_setprio(1); _Pragma("unroll") for (int m = 0; m < 4; ++m) _Pragma("unroll") for (int n = 0; n < 2; ++n) _Pragma("unroll") for (int k = 0; k < 2; ++k) \
        acc[ai][bj][m][n] = __builtin_amdgcn_mfma_f32_16x16x32_bf16(Bt[n][k], At[m][k], acc[ai][bj][m][n], 0, 0, 0); __builtin_amdgcn_s_setprio(0); } while (0)
#define PG8_WAIT_V(n) asm volatile("s_waitcnt vmcnt(" #n ")" ::: "memory")
#define PG8_WAIT_L(n) asm volatile("s_waitcnt lgkmcnt(" #n ")" ::: "memory")
#define PG8_BAR __builtin_amdgcn_s_barrier()
#define PG8_SCHED __builtin_amdgcn_sched_barrier(0)
    Unit cur, nxt; int ui = 0;
    if (!S.next(0, cur)) return;
    f32x4 acc[2][2][4][2];
#pragma unroll
    for (int a = 0; a < 2; ++a)
#pragma unroll
        for (int b = 0; b < 2; ++b)
#pragma unroll
            for (int m = 0; m < 4; ++m)
#pragma unroll
                for (int n = 0; n < 2; ++n) acc[a][b][m][n] = (f32x4){0.f, 0.f, 0.f, 0.f};
    bf16x8 At[4][2], B0[2][2], B1[2][2];
    const char* cA = S.aptr(cur); const char* cB = S.bptr(cur);
    PG8_STAGE(PG8_SB(0, 0), cB, voffB); PG8_STAGE(PG8_SB(0, 1), cB + hstep, voffB); PG8_STAGE(PG8_SA(0, 0), cA, voffA); PG8_STAGE(PG8_SA(0, 1), cA + hstep, voffA);
    if (wr == 1) PG8_BAR;
    PG8_WAIT_V(2); PG8_BAR;
    PG8_STAGE(PG8_SB(1, 0), cB + kstep, voffB); PG8_STAGE(PG8_SA(1, 0), cA + kstep, voffA); PG8_STAGE(PG8_SB(1, 1), cB + hstep + kstep, voffB);
    PG8_WAIT_V(6); PG8_BAR;
    for (;;) {
        const bool has_next = S.next(ui + 1, nxt);
        const char* nA = has_next ? S.aptr(nxt) : cA; const char* nB = has_next ? S.bptr(nxt) : cB;
        for (int t = 0; t < nt; t += 2) {
            const bool last = (t == nt - 2);
            const char* a1 = cA + (size_t)(t + 1) * kstep;
            const char* a2 = last ? nA : cA + (size_t)(t + 2) * kstep; const char* b2 = last ? nB : cB + (size_t)(t + 2) * kstep;
            const char* a3 = a2 + kstep; const char* b3 = b2 + kstep;
            PG8_LDB(B0, 0, 0); PG8_LDB(B1, 0, 1); PG8_SCHED; PG8_LDA(At, 0, 0); PG8_STAGE(PG8_SA(1, 1), a1 + hstep, voffA);
            PG8_WAIT_V(8); PG8_WAIT_L(0); PG8_BAR; PG8_MMA(0, 0, At, B0); PG8_MMA(0, 1, At, B1); PG8_BAR; PG8_SCHED;
            PG8_LDA(At, 0, 1); PG8_STAGE(PG8_SB(0, 0), b2, voffB); PG8_STAGE(PG8_SB(0, 1), b2 + hstep, voffB); PG8_STAGE(PG8_SA(0, 0), a2, voffA);
            PG8_WAIT_V(8); PG8_WAIT_L(0); PG8_BAR; PG8_MMA(1, 0, At, B0); PG8_MMA(1, 1, At, B1); PG8_BAR; PG8_SCHED;
            PG8_LDB(B0, 1, 0); PG8_LDB(B1, 1, 1); PG8_SCHED; PG8_LDA(At, 1, 0); PG8_STAGE(PG8_SA(0, 1), a2 + hstep, voffA);
            PG8_WAIT_V(8); PG8_WAIT_L(0); PG8_BAR; PG8_MMA(0, 0, At, B0); PG8_MMA(0, 1, At, B1); PG8_BAR; PG8_SCHED;
            PG8_LDA(At, 1, 1); PG8_STAGE(PG8_SB(1, 0), b3, voffB); PG8_STAGE(PG8_SB(1, 1), b3 + hstep, voffB); PG8_STAGE(PG8_SA(1, 0), a3, voffA);
            PG8_WAIT_V(8); PG8_WAIT_L(0); PG8_BAR; PG8_MMA(1, 0, At, B0); PG8_MMA(1, 1, At, B1); PG8_BAR; PG8_SCHED;
        }
        if (wr == 0) PG8_BAR;
        E(acc, cur, wr, wc, fr, fq);
        if (!has_next) break;
#pragma unroll
        for (int a = 0; a < 2; ++a)
#pragma unroll
            for (int b = 0; b < 2; ++b)
#pragma unroll
                for (int m = 0; m < 4; ++m)
#pragma unroll
                    for (int n = 0; n < 2; ++n) acc[a][b][m][n] = (f32x4){0.f, 0.f, 0.f, 0.f};
        cur = nxt; cA = nA; cB = nB; ++ui;
        if (wr == 1) PG8_BAR;
    }
    PG8_WAIT_V(0);
    PG8_BAR;
#undef PG8_SA
#undef PG8_SB
#undef PG8_STAGE
#undef PG8_LDA
#undef PG8_LDB
#undef PG8_MMA
#undef PG8_WAIT_V
#undef PG8_WAIT_L
#undef PG8_BAR
#undef PG8_SCHED
}
}

#define XB_TMO      128
#define XB_XCNT(j)  (256  + 64 * (j))
#define XB_XSUB(j)  (1280 + 64 * (j))
#define XB_XGEN(j)  (2304 + 64 * (j))
#define XB_TOP      3328
#define XB_TOPGEN   3392
#define XCD_BAR_WORDS 3456
#define XB_SPIN_CAP (1u << 20)
DI unsigned xb_ld(unsigned* p)              { return __hip_atomic_load(p, __ATOMIC_RELAXED, __HIP_MEMORY_SCOPE_AGENT); }
DI unsigned xb_add(unsigned* p, unsigned v) { return __hip_atomic_fetch_add(p, v, __ATOMIC_RELAXED, __HIP_MEMORY_SCOPE_AGENT); }
DI unsigned xb_xcc_id() { return (unsigned)__builtin_amdgcn_s_getreg((3 << 11) | 20) & 0xFu; }
#define XB_SPIN(cond, bar) do { unsigned _sp = 0; while (cond) { __builtin_amdgcn_s_sleep(1); \
    if ((++_sp & 255u) == 0u) { if (xb_ld(&(bar)[XB_TMO])) break; if (_sp > XB_SPIN_CAP) { atomicAdd(&(bar)[XB_TMO], 1u); break; } } } } while (0)
struct XcdBarrier { unsigned* bar; unsigned x; volatile LAS unsigned* st; };
DI XcdBarrier xcd_barrier_post(unsigned* bar, volatile LAS unsigned* st) {
    XcdBarrier b; b.bar = bar; b.x = xb_xcc_id(); b.st = st;
    if (threadIdx.x == 0) (void)xb_add(&bar[XB_XCNT(b.x)], 1u);
    return b;
}
DI void xcd_barrier_complete(unsigned* bar, unsigned x, unsigned& nloc, unsigned& nx) {
    const unsigned G = gridDim.x * gridDim.y * gridDim.z;
    unsigned sum, cnt, mine, sp = 0u;
    for (;;) {
        sum = 0u; cnt = 0u; mine = 0u;
#pragma unroll
        for (unsigned j = 0; j < 16; ++j) { const unsigned c = xb_ld(&bar[XB_XCNT(j)]); sum += c; cnt += (c > 0u) ? 1u : 0u; mine = (j == x) ? c : mine; }
        if (sum == G) break;
        __builtin_amdgcn_s_sleep(1);
        if ((++sp & 255u) == 0u) { if (xb_ld(&bar[XB_TMO])) break; if (sp > XB_SPIN_CAP) { atomicAdd(&bar[XB_TMO], 1u); break; } }
    }
    nloc = mine > 0u ? mine : 1u; nx = cnt > 0u ? cnt : 1u;
}
DI void xcd_barrier(const XcdBarrier& b) {
    asm volatile("s_waitcnt vmcnt(0)" ::: "memory");
    __syncthreads();
    if (threadIdx.x == 0) {
        unsigned* bar = b.bar;
        __builtin_amdgcn_s_waitcnt(0);
        unsigned nloc = b.st[0], nx = b.st[1];
        if (nloc == 0u) { xcd_barrier_complete(bar, b.x, nloc, nx); b.st[0] = nloc; b.st[1] = nx; }
        const unsigned old = xb_add(&bar[XB_XSUB(b.x)], 1u);
        const unsigned gen = old / nloc;
        if (old + 1u == (gen + 1u) * nloc) {
            __builtin_amdgcn_fence(__ATOMIC_RELEASE, "agent");
            asm volatile("s_waitcnt vmcnt(0)" ::: "memory");
            const unsigned og = xb_add(&bar[XB_TOP], 1u);
            const unsigned tg = og / nx;
            if (og + 1u == (tg + 1u) * nx) xb_add(&bar[XB_TOPGEN], 1u);
            else XB_SPIN(xb_ld(&bar[XB_TOPGEN]) == tg, bar);
            __builtin_amdgcn_fence(__ATOMIC_ACQUIRE, "agent");
            xb_add(&bar[XB_XGEN(b.x)], 1u);
            asm volatile("s_waitcnt vmcnt(0)" ::: "memory");
        } else {
            XB_SPIN(xb_ld(&bar[XB_XGEN(b.x)]) == gen, bar);
            __builtin_amdgcn_fence(__ATOMIC_ACQUIRE, "agent");
            asm volatile("s_waitcnt vmcnt(0)" ::: "memory");
        }
    }
    __syncthreads();
}

struct Args { const float* in[31]; float* out; unsigned char* ws; int ph_lo, ph_hi, use_cg, pad; };
struct Frame {
    LAS unsigned char* lds;
    int tid, lane, wave, G, vcu, gw, ngw, bx;
    unsigned char* ws;
};
constexpr int LDS_MISC = 131072;
constexpr int LDS_BARST = LDS_BYTES - 64;

DI void transpose_item(const float* __restrict__ W, int ldw, int k0, int n0, bf16_t* __restrict__ WT, size_t dst_row0, int ldt, LAS float* scr, int lane) {
#pragma unroll 4
    for (int kk = 0; kk < 64; kk += 4) {
        const int k = kk + (lane >> 4), n = 4 * (lane & 15);
        const float4 v = *(const float4*)(W + (size_t)(k0 + k) * ldw + n0 + n);
        LAS float* s = scr + k * 65 + n; s[0] = v.x; s[1] = v.y; s[2] = v.z; s[3] = v.w;
    }
    LDS_WAIT();
#pragma unroll
    for (int j = 0; j < 8; ++j) {
        const int n = 8 * j + (lane >> 3), c = lane & 7; const LAS float* s = scr + (8 * c) * 65 + n;
        u32x4 o; o.x = cvtpk(s[0], s[65]); o.y = cvtpk(s[130], s[195]); o.z = cvtpk(s[260], s[325]); o.w = cvtpk(s[390], s[455]);
        *(u32x4*)(WT + (dst_row0 + n) * ldt + k0 + 8 * c) = o;
    }
    LDS_WAIT();
}
constexpr int IT_WIN = 16 * 42, IT_WOUT = 16 * 16, IT_SMALL = IT_WIN + IT_WOUT;
constexpr int IT_EXP = 128 * 3, IT_MOE = NE * IT_EXP;
DI void conv_small_item(const Frame& F, const float* w_in, const float* w_out, int l, int it, LAS float* scr) {
    bf16_t* WIN = (bf16_t*)(F.ws + WS_WIN + (size_t)l * WIN_LAYER);
    if (it < IT_WIN) {
        const int kt = it / 42, nt = it % 42, n0 = 64 * nt;
        size_t drow;
        if (n0 < 768) drow = n0; else if (n0 < 1152) drow = 2304 + (n0 - 768); else drow = n0 - 384;
        transpose_item(w_in + (size_t)l * D * INW, INW, 64 * kt, n0, WIN, drow, D, scr, F.lane);
    } else {
        const int r = it - IT_WIN, kt = r >> 4, nt = r & 15;
        transpose_item(w_out + (size_t)l * D * D, D, 64 * kt, 64 * nt, (bf16_t*)(F.ws + WS_WOUT) + (size_t)l * D * D, 64 * nt, D, scr, F.lane);
    }
}
DI void conv_moe_item(const Frame& F, const float* wg, const float* wu, const float* wd, int l, int it, LAS float* scr) {
    const int e = it / IT_EXP, r = it % IT_EXP, which = r >> 7, q = r & 127;
    bf16_t* WGU = (bf16_t*)(F.ws + WS_WGU) + (size_t)e * D * D;
    if (which < 2) {
        const int kt = q >> 3, nt = q & 7, n0 = 64 * nt;
        const float* src = (which ? wu : wg) + ((size_t)l * NE + e) * D * DE;
        const size_t drow = (size_t)(n0 >> 7) * 256 + (which ? 128 : 0) + (n0 & 127);
        transpose_item(src, DE, 64 * kt, n0, WGU, drow, D, scr, F.lane);
    } else {
        const int kt = q >> 4, nt = q & 15;
        transpose_item(wd + ((size_t)l * NE + e) * DE * D, D, 64 * kt, 64 * nt, (bf16_t*)(F.ws + WS_WD) + (size_t)e * D * DE, 64 * nt, DE, scr, F.lane);
    }
}
DI void p0_prologue(const Frame& F, const Args& a) {
    const float* c = a.in[1]; const float* w_mod = a.in[2]; const float* b_mod = a.in[3];
    if (F.bx < L * (MODW / 64)) {
        LAS float* sc = (LAS float*)(F.lds);
        LAS float* red = (LAS float*)(F.lds + 8192);
        for (int i = F.tid; i < NB * D; i += NTHREADS) { const float v = c[i]; sc[i] = v / (1.f + expf(-v)); }
        __syncthreads();
        const int l = F.bx / (MODW / 64), cb = F.bx % (MODW / 64), n = cb * 64 + F.lane;
        const float* w = w_mod + (size_t)l * D * MODW + n;
        float a0 = 0.f, a1 = 0.f;
#pragma unroll 8
        for (int k = F.wave * 128; k < F.wave * 128 + 128; ++k) { const float wv = w[(size_t)k * MODW]; a0 += sc[k] * wv; a1 += sc[D + k] * wv; }
        red[(F.wave * 2 + 0) * 64 + F.lane] = a0; red[(F.wave * 2 + 1) * 64 + F.lane] = a1;
        __syncthreads();
        if (F.tid < 128) { const int b = F.tid >> 6, ln = F.tid & 63; float s = 0.f;
#pragma unroll
            for (int w8 = 0; w8 < 8; ++w8) s += red[(w8 * 2 + b) * 64 + ln];
            const int nn = cb * 64 + ln;
            ((float*)(F.ws + WS_MOD))[(size_t)(l * NB + b) * MODW + nn] = s + b_mod[l * MODW + nn]; }
        __syncthreads();
    }
    { const int nzero = L * 128 * D / 8;
      for (int i = F.gw * 64 + F.lane; i < nzero; i += F.ngw * 64) { const int l = i / (128 * D / 8), r = i % (128 * D / 8);
          *(u32x4*)((bf16_t*)(F.ws + WS_WIN + (size_t)l * WIN_LAYER) + (size_t)(2304 + 384) * D + (size_t)r * 8) = (u32x4){0u, 0u, 0u, 0u}; } }
    LAS float* scr = (LAS float*)(F.lds + 16384) + F.wave * (64 * 65);
    for (int it = F.gw; it < L * IT_SMALL; it += F.ngw) conv_small_item(F, a.in[4], a.in[19], it / IT_SMALL, it % IT_SMALL, scr);
}

DI void row_ln(f32x4 (&v)[4], float& mean_out, float& rstd_out) {
    float s = 0.f;
#pragma unroll
    for (int j = 0; j < 4; ++j) s += (v[j][0] + v[j][1]) + (v[j][2] + v[j][3]);
    const float mean = wave_sum(s) * (1.f / D); float q = 0.f;
#pragma unroll
    for (int j = 0; j < 4; ++j) { v[j] = v[j] - mean; q += (v[j][0] * v[j][0] + v[j][1] * v[j][1]) + (v[j][2] * v[j][2] + v[j][3] * v[j][3]); }
    mean_out = mean; rstd_out = 1.f / sqrtf(wave_sum(q) * (1.f / D) + LN_EPS);
}
DI void row_mod_store(f32x4 (&v)[4], const float* md, int off_sh, int off_sc, bf16_t* urow, int lane) {
    float mean, rstd; row_ln(v, mean, rstd);
#pragma unroll
    for (int j = 0; j < 4; ++j) { const int col = 4 * lane + 256 * j;
        const f32x4 scv = *(const f32x4*)(md + off_sc + col), shv = *(const f32x4*)(md + off_sh + col);
        v[j] = v[j] * rstd * (1.f + scv) + shv;
        u32x2 w; w.x = cvtpk(v[j][0], v[j][1]); w.y = cvtpk(v[j][2], v[j][3]);
        *(u32x2*)(urow + col) = w; }
}
DI void p_r0(const Frame& F, const float* x) {
    const float* MOD = (const float*)(F.ws + WS_MOD);
    bf16_t* U = (bf16_t*)(F.ws + WS_U);
    for (int row = F.gw; row < T; row += F.ngw) {
        f32x4 v[4];
#pragma unroll
        for (int j = 0; j < 4; ++j) v[j] = *(const f32x4*)(x + (size_t)row * D + 4 * F.lane + 256 * j);
        row_mod_store(v, MOD + (size_t)(row / S) * MODW, 0, D, U + (size_t)row * D, F.lane);
    }
}

constexpr int NGRP = T / 64;
DI void p_rowpass1(const Frame& F, const Args& a, int l, const float* xin, const bool dry = false) {
    const float* MODl = (const float*)(F.ws + WS_MOD) + (size_t)l * NB * MODW;
    const bf16_t* MIX = (const bf16_t*)(F.ws + WS_MIX);
    float* XA = (float*)(F.ws + WS_XA); bf16_t* U = (bf16_t*)(F.ws + WS_U);
    const float* gain = a.in[20] + (size_t)l * D; const float* bias = a.in[21] + (size_t)l * D;
    const float* wg = a.in[24] + (size_t)l * D * NG; const float* bg = a.in[25] + (size_t)l * NG;
    const float* we = a.in[26] + (size_t)l * D * NE; const float* be = a.in[27] + (size_t)l * NE;
    const size_t dro = dry ? 490 * MiB - WS_BC : 0;
    int* BC = (int*)(F.ws + WS_BC + dro); float* TOKW = (float*)(F.ws + WS_TOKW + dro); int* TOKSLOT = (int*)(F.ws + WS_TOKSLOT + (dry ? 496 * MiB - WS_TOKSLOT : 0));
    LAS float* RT = (LAS float*)F.lds;
    LAS unsigned* cntl = (LAS unsigned*)(F.lds + 36 * D * 4 + NWAVES * 72 * 4);
    for (int i = F.tid; i < D * 9; i += NTHREADS) { const int k = i / 9, q = i % 9;
        const f32x4 v = q == 0 ? *(const f32x4*)(wg + (size_t)k * NG) : *(const f32x4*)(we + (size_t)k * NE + 4 * (q - 1));
        const int n0 = q == 0 ? 0 : 4 * q;
        RT[(n0 + 0) * D + k] = v[0]; RT[(n0 + 1) * D + k] = v[1]; RT[(n0 + 2) * D + k] = v[2]; RT[(n0 + 3) * D + k] = v[3]; }
    for (int grp = F.vcu; grp < NGRP; grp += F.G) {
    if (F.tid < NE) cntl[F.tid] = 0u;
    __syncthreads();
    for (int rp = 0; rp < 4; ++rp) {
        const int row0 = 64 * grp + 8 * F.wave + 2 * rp; const float* md = MODl + (size_t)(row0 / S) * MODW;
        f32x4 va[4], vb[4];
#pragma unroll
        for (int j = 0; j < 4; ++j) { const int col = 4 * F.lane + 256 * j;
            const f32x4 g = *(const f32x4*)(md + 2 * D + col);
            const f32x4 xa = *(const f32x4*)(xin + (size_t)row0 * D + col), xb = *(const f32x4*)(xin + (size_t)(row0 + 1) * D + col);
            const u32x2 ma = *(const u32x2*)(MIX + (size_t)row0 * D + col), mb = *(const u32x2*)(MIX + (size_t)(row0 + 1) * D + col);
            va[j] = xa * ALPHA + g * (f32x4){bflo(ma.x), bfhi(ma.x), bflo(ma.y), bfhi(ma.y)};
            vb[j] = xb * ALPHA + g * (f32x4){bflo(mb.x), bfhi(mb.x), bflo(mb.y), bfhi(mb.y)}; }
        float mean, rstd;
        row_ln(va, mean, rstd);
#pragma unroll
        for (int j = 0; j < 4; ++j) { const int col = 4 * F.lane + 256 * j; va[j] = va[j] * rstd * *(const f32x4*)(gain + col) + *(const f32x4*)(bias + col); *(f32x4*)(XA + (size_t)row0 * D + col) = va[j]; }
        row_ln(vb, mean, rstd);
#pragma unroll
        for (int j = 0; j < 4; ++j) { const int col = 4 * F.lane + 256 * j; vb[j] = vb[j] * rstd * *(const f32x4*)(gain + col) + *(const f32x4*)(bias + col); *(f32x4*)(XA + (size_t)(row0 + 1) * D + col) = vb[j]; }
        row_mod_store(va, md, 3 * D, 4 * D, U + (size_t)row0 * D, F.lane);
        row_mod_store(vb, md, 3 * D, 4 * D, U + (size_t)(row0 + 1) * D, F.lane);
        LAS float* lg = (LAS float*)(F.lds + 36 * D * 4) + F.wave * 72;
#pragma unroll 1
        for (int n = 0; n < 36; ++n) { float sa = 0.f, sb = 0.f;
#pragma unroll
            for (int j = 0; j < 4; ++j) { const f32x4 w = *(const LAS f32x4*)(RT + n * D + 4 * F.lane + 256 * j);
                sa += (va[j][0] * w[0] + va[j][1] * w[1]) + (va[j][2] * w[2] + va[j][3] * w[3]);
                sb += (vb[j][0] * w[0] + vb[j][1] * w[1]) + (vb[j][2] * w[2] + vb[j][3] * w[3]); }
            sa = wave_sum(sa); sb = wave_sum(sb);
            if (F.lane == 0) { lg[n] = sa; lg[36 + n] = sb; } }
        LDS_WAIT();
#pragma unroll
        for (int rr = 0; rr < 2; ++rr) {
            float gl[4], el[32];
#pragma unroll
            for (int n = 0; n < 4; ++n) gl[n] = lg[36 * rr + n] + bg[n];
#pragma unroll
            for (int n = 0; n < 32; ++n) el[n] = lg[36 * rr + 4 + n] + be[n];
            int gi = 0; float gm = gl[0];
#pragma unroll
            for (int n = 1; n < 4; ++n) if (gl[n] > gm) { gm = gl[n]; gi = n; }
            float se = 0.f;
#pragma unroll
            for (int n = 0; n < 4; ++n) se += expf(gl[n] - gm);
            const float pg = 1.f / se;
            float l1 = -3.0e38f, l2 = -3.0e38f; int i1 = 0, i2 = 0;
#pragma unroll
            for (int n = 0; n < 32; ++n) if ((n >> 3) == gi) { const float v = el[n]; const int e = n & 7;
                if (v > l1) { l2 = l1; i2 = i1; l1 = v; i1 = e; } else if (v > l2) { l2 = v; i2 = e; } }
            const float e2 = expf(l2 - l1); const float w1 = pg / (1.f + e2), w2 = pg * e2 / (1.f + e2);
            if (F.lane == 0) {
                const int tok = row0 + rr, ea = gi * EPG + i1, eb = gi * EPG + i2;
                const unsigned pa = __hip_atomic_fetch_add(&cntl[ea], 1u, __ATOMIC_RELAXED, __HIP_MEMORY_SCOPE_WORKGROUP), pb = __hip_atomic_fetch_add(&cntl[eb], 1u, __ATOMIC_RELAXED, __HIP_MEMORY_SCOPE_WORKGROUP);
                TOKSLOT[tok * 2] = (ea << 14) | (int)pa; TOKSLOT[tok * 2 + 1] = (eb << 14) | (int)pb;
                TOKW[tok * 2] = w1; TOKW[tok * 2 + 1] = w2;
            }
        }
    }
    __syncthreads();
    if (F.tid < NE) BC[grp * NE + F.tid] = (int)cntl[F.tid];
    __syncthreads();
    }
}

DI void build_tables(const Frame& F, int l, LAS int* tb) {
    if (F.tid == 0) {
        const int* CNTF = (const int*)(F.ws + WS_CNTF);
        int cum = 0, off = 0, nt = 0;
        for (int e = 0; e < NE; ++e) { const int c = CNTF[e];
            tb[e] = cum; tb[33 + e] = off; const int tl = (c + 255) >> 8;
            for (int t2 = 0; t2 < tl; ++t2) tb[66 + nt + t2] = e;
            nt += tl; cum += c; off += tl * 256; }
        tb[32] = cum; tb[65] = nt;
    }
    __syncthreads();
}
DI void p_gather(const Frame& F, int l) {
    LAS int* base = (LAS int*)F.lds;
    LAS int* segt = base + NGRP * NE;
    LAS int* offp = segt + 16 * NE;
    const int* BC = (const int*)(F.ws + WS_BC);
    for (int i = F.tid; i < NGRP * NE; i += NTHREADS) base[i] = BC[i];
    __syncthreads();
    { const int e = F.tid & 31, sg = F.tid >> 5; int run = 0;
      for (int g = 16 * sg; g < 16 * sg + 16; ++g) { const int c = base[g * NE + e]; base[g * NE + e] = run; run += c; }
      segt[sg * NE + e] = run; }
    __syncthreads();
    if (F.tid < NE) { int run = 0; for (int sg = 0; sg < 16; ++sg) { const int c = segt[sg * NE + F.tid]; segt[sg * NE + F.tid] = run; run += c; }
        offp[F.tid] = run;
        if (F.bx == 0) ((int*)(F.ws + WS_CNTF))[F.tid] = run; }
    __syncthreads();
    if (F.tid == 0) { int off = 0; for (int e = 0; e < NE; ++e) { const int c = offp[e]; offp[e] = off; off += ((c + 255) >> 8) * 256; } }
    __syncthreads();
    const int* TOKSLOT = (const int*)(F.ws + WS_TOKSLOT); const float* TOKW = (const float*)(F.ws + WS_TOKW); int* TOKFIN = (int*)(F.ws + WS_TOKFIN);
    const bf16_t* U = (const bf16_t*)(F.ws + WS_U); bf16_t* XS = (bf16_t*)(F.ws + WS_XS); float* SLOTW = (float*)(F.ws + WS_SLOTW);
    for (int as = F.gw; as < 2 * T; as += F.ngw) {
        const int tok = as >> 1, ts = TOKSLOT[as], e = ts >> 14, grp = tok >> 6, sg = grp >> 4;
        const int slot = offp[e] + segt[sg * NE + e] + base[grp * NE + e] + (ts & 16383);
        const u32x4* src = (const u32x4*)(U + (size_t)tok * D); u32x4* dst = (u32x4*)(XS + (size_t)slot * D);
        dst[F.lane] = src[F.lane]; dst[64 + F.lane] = src[64 + F.lane];
        if (F.lane == 0) { SLOTW[slot] = TOKW[as]; TOKFIN[as] = slot; }
    }
}
DI void p_rowpass2(const Frame& F, const Args& a, int l, float* xout) {
    const float* MOD = (const float*)(F.ws + WS_MOD);
    const float* XA = (const float*)(F.ws + WS_XA); const bf16_t* YS = (const bf16_t*)(F.ws + WS_YS); const int* TOKFIN = (const int*)(F.ws + WS_TOKFIN);
    const float* gain = a.in[22] + (size_t)l * D; const float* bias = a.in[23] + (size_t)l * D;
    bf16_t* U = (bf16_t*)(F.ws + WS_U);
    for (int row = F.gw; row < T; row += F.ngw) {
        const float* md = MOD + (size_t)(l * NB + row / S) * MODW;
        const int s0 = TOKFIN[row * 2], s1 = TOKFIN[row * 2 + 1];
        f32x4 v[4];
#pragma unroll
        for (int j = 0; j < 4; ++j) { const int col = 4 * F.lane + 256 * j;
            const f32x4 g = *(const f32x4*)(md + 5 * D + col), xv = *(const f32x4*)(XA + (size_t)row * D + col);
            const u32x2 y0 = *(const u32x2*)(YS + (size_t)s0 * D + col), y1 = *(const u32x2*)(YS + (size_t)s1 * D + col);
            const f32x4 f = (f32x4){bflo(y0.x) + bflo(y1.x), bfhi(y0.x) + bfhi(y1.x), bflo(y0.y) + bflo(y1.y), bfhi(y0.y) + bfhi(y1.y)};
            v[j] = xv * ALPHA + g * f; }
        float mean, rstd; row_ln(v, mean, rstd);
#pragma unroll
        for (int j = 0; j < 4; ++j) { const int col = 4 * F.lane + 256 * j; v[j] = v[j] * rstd * *(const f32x4*)(gain + col) + *(const f32x4*)(bias + col); *(f32x4*)(xout + (size_t)row * D + col) = v[j]; }
        if (l + 1 < L) row_mod_store(v, MOD + (size_t)((l + 1) * NB + row / S) * MODW, 0, D, U + (size_t)row * D, F.lane);
    }
}

#define MFMA16(a, b, c) __builtin_amdgcn_mfma_f32_16x16x32_bf16((a), (b), (c), 0, 0, 0)
#define MFMA32(a, b, c) __builtin_amdgcn_mfma_f32_32x32x16_bf16((a), (b), (c), 0, 0, 0)
constexpr int RB = 9216;
#define BUF(i) ((i) * RB)
constexpr int LWOFF = BUF(12), ZAOFF = BUF(0), SEGOFF = BUF(14), SEGXOFF = BUF(14) + 2048, TOTOFF = BUF(14) + 4096, NABFOFF = BUF(15), PCOFF = 16 * RB;
struct RwP { const float *conv, *w0, *w_up, *a0, *a_up, *g_up, *k_k, *k_a, *r_k, *gn_gain, *gn_bias; };

DI void lds_barrier() { asm volatile("s_waitcnt lgkmcnt(0)" ::: "memory"); __builtin_amdgcn_s_barrier(); asm volatile("" ::: "memory"); }
DI bf16x8 ldfrag(const LAS unsigned char* lds, int buf, int row, int ks, int lane) { return *(const LAS bf16x8*)(lds + buf + row * 144 + (32 * ks + 8 * (lane >> 4)) * 2); }
DI f32x4 mm64(const LAS unsigned char* lds, int abuf, int arow0, int bbuf, int brow0, int lane) {
    f32x4 acc = (f32x4){0.f, 0.f, 0.f, 0.f};
#pragma unroll
    for (int ks = 0; ks < 2; ++ks) acc = MFMA16(ldfrag(lds, abuf, arow0 + (lane & 15), ks, lane), ldfrag(lds, bbuf, brow0 + (lane & 15), ks, lane), acc);
    return acc;
}
DI u32x2 pack4(const f32x4 v) { u32x2 w; w.x = cvtpk(v[0], v[1]); w.y = cvtpk(v[2], v[3]); return w; }
DI f32x4 unpack4(const u32x2 w) { return (f32x4){bflo(w.x), bfhi(w.x), bflo(w.y), bfhi(w.y)}; }
DI void st4(LAS unsigned char* lds, int buf, int row, int col, const f32x4 v) { *(LAS u32x2*)(lds + buf + row * 144 + col * 2) = pack4(v); }
DI f32x4 ld4(const LAS unsigned char* lds, int buf, int row, int col) { return unpack4(*(const LAS u32x2*)(lds + buf + row * 144 + col * 2)); }
DI void st1(LAS unsigned char* lds, int buf, int row, int col, float v) { *(LAS bf16_t*)(lds + buf + row * 144 + col * 2) = f2bf(v); }
DI float fast_tanh(float x) { const float e = __expf(2.f * x); return 1.f - 2.f / (1.f + e); }

#define OPQZ(z) int z; asm volatile("s_mov_b32 %0, 0" : "=s"(z))
constexpr int CWLOFF = PCOFF + 256;
constexpr int PRMOFF = CWLOFF + 6912;
struct RwPre { u32x2 wv, av; u32x4 gv; f32x4 w4, a4, g0, g1; u32x4 rr[3], kk[3], vv[3]; };
DI void rwkv_prefetch(const Frame& F, const Args& a, const int l, const int unit, RwPre& P) {
    const int tid = F.tid;
    const int c = unit % NCH, hd = (unit / NCH) % BH, b = (unit / (NCH * BH)) % NB, dir = unit / (NCH * BH * NB);
    const bf16_t* HBp = (const bf16_t*)(F.ws + WS_HB);
    const int u = tid >> 3, jg = tid & 7, tloc = 64 * c + u; const size_t tok = (size_t)b * S + tloc;
    const bf16_t* hrow = HBp + tok * HW;
    P.wv = *(const u32x2*)(hrow + HWL + 4 * jg); P.av = *(const u32x2*)(hrow + HAL + 4 * jg); P.gv = *(const u32x4*)(hrow + HGL + 8 * jg);
    OPQZ(z0);
    { const int m = tid >> 4, j4 = (tid & 15) * 4;
      const float* w_up = a.in[8 + z0] + (size_t)l * 2 * RW * BW; const float* a_up = a.in[10 + z0] + (size_t)l * 2 * RA * BW;
      P.w4 = *(const f32x4*)(w_up + (size_t)(dir * RW + m) * BW + hd * HD + j4); P.a4 = *(const f32x4*)(a_up + (size_t)(dir * RA + m) * BW + hd * HD + j4); }
    { const int m = tid >> 3, i8 = (tid & 7) * 8; const float* g_up = a.in[11 + z0] + (size_t)l * RG * BW;
      P.g0 = *(const f32x4*)(g_up + (size_t)m * BW + hd * HD + i8); P.g1 = *(const f32x4*)(g_up + (size_t)m * BW + hd * HD + i8 + 4); }
    const int ch0 = hd * HD + 8 * jg;
#pragma unroll
    for (int x = 0; x < 3; ++x) {
        const int tt = tloc + x - 1; const u32x4 z4 = (u32x4){0u, 0u, 0u, 0u};
        if (tt >= 0 && tt < S) { const bf16_t* hp = HBp + ((size_t)b * S + tt) * HW + HR + ch0; P.rr[x] = *(const u32x4*)hp; P.kk[x] = *(const u32x4*)(hp + BW); P.vv[x] = *(const u32x4*)(hp + 2 * BW); }
        else { P.rr[x] = z4; P.kk[x] = z4; P.vv[x] = z4; }
    }
}
DI void rwkv_local_unit(const Frame& F, const Args& a, const int l, const int unit, RwPre& PF, const int next_unit) {
    LAS unsigned char* lds = F.lds;
    int tid_ = F.tid; asm volatile("" : "+v"(tid_));
    const int tid = tid_, lane = tid_ & 63, wave = F.wave;
    const int c = unit % NCH, hd = (unit / NCH) % BH, b = (unit / (NCH * BH)) % NB, dir = unit / (NCH * BH * NB);
    const bf16_t* HBp = (const bf16_t*)(F.ws + WS_HB);
    const int u = tid >> 3, jg = tid & 7, tau = dir ? 63 - u : u, tloc = 64 * c + u;
    const size_t tok = (size_t)b * S + tloc;
    const int tn = wave & 3, tm0 = 2 * (wave >> 2), g4 = lane >> 4, l15 = lane & 15;
    if (tid < 320) { OPQZ(z2); const int which = tid >> 6, j = tid & 63;
      const float* src = which == 0 ? a.in[7 + z2] + (size_t)l * 2 * BW + dir * BW : which == 1 ? a.in[9 + z2] + (size_t)l * 2 * BW + dir * BW : which == 2 ? a.in[12 + z2] + (size_t)l * BW : which == 3 ? a.in[13 + z2] + (size_t)l * BW : a.in[14 + z2] + (size_t)l * BH * HD;
      *(LAS float*)(lds + PRMOFF + tid * 4) = src[hd * HD + j]; }
    {
        const f32x4 wf = unpack4(PF.wv);
        *(LAS u32x2*)(lds + BUF(8) + tau * 144 + (4 * jg) * 2) = pack4((f32x4){fast_tanh(wf[0]), fast_tanh(wf[1]), fast_tanh(wf[2]), fast_tanh(wf[3])});
        *(LAS u32x2*)(lds + BUF(8) + tau * 144 + (32 + 4 * jg) * 2) = PF.av;
        const u32x4 gv = PF.gv;
        u32x4 so; so.x = cvtpk(sigm(bflo(gv.x)), sigm(bfhi(gv.x))); so.y = cvtpk(sigm(bflo(gv.y)), sigm(bfhi(gv.y))); so.z = cvtpk(sigm(bflo(gv.z)), sigm(bfhi(gv.z))); so.w = cvtpk(sigm(bflo(gv.w)), sigm(bfhi(gv.w)));
        *(LAS u32x4*)(lds + BUF(9) + tau * 144 + 16 * jg) = so;
        { const int m = tid >> 4, j4 = (tid & 15) * 4;
#pragma unroll
          for (int e = 0; e < 4; ++e) { st1(lds, BUF(10), j4 + e, m, PF.w4[e]); st1(lds, BUF(10), j4 + e, 32 + m, PF.a4[e]); } }
        { const int m = tid >> 3, i8 = (tid & 7) * 8;
#pragma unroll
          for (int e = 0; e < 4; ++e) { st1(lds, BUF(11), i8 + e, m, PF.g0[e]); st1(lds, BUF(11), i8 + 4 + e, m, PF.g1[e]); } }
    }
    lds_barrier();
#pragma unroll
    for (int tmi = 0; tmi < 2; ++tmi) {
        const int tm = tm0 + tmi; const f32x4 z = (f32x4){0.f, 0.f, 0.f, 0.f};
        const f32x4 zw = MFMA16(ldfrag(lds, BUF(10), 16 * tm + l15, 0, lane), ldfrag(lds, BUF(8), 16 * tn + l15, 0, lane), z);
        const f32x4 za = MFMA16(ldfrag(lds, BUF(10), 16 * tm + l15, 1, lane), ldfrag(lds, BUF(8), 16 * tn + l15, 1, lane), z);
        const int trow = 16 * tn + l15, jb = 16 * tm + 4 * g4;
        *(LAS f32x4*)(lds + LWOFF + (trow * 64 + jb) * 4) = zw;
        *(LAS f32x4*)(lds + ZAOFF + (trow * 64 + jb) * 4) = za;
        if (dir == 0) {
            const f32x4 gg = mm64(lds, BUF(11), 16 * tm, BUF(9), 16 * tn, lane);
            *(u32x2*)((bf16_t*)(F.ws + WS_GB) + ((size_t)b * S + 64 * c + trow) * BW + hd * HD + jb) = pack4(gg);
        }
    }
    lds_barrier();
    const int ch0 = hd * HD + 8 * jg;
    float r[8], kd[8], kap[8], bb[8], lw[8];
    {
        float k[8], v[8];
#pragma unroll
        for (int e = 0; e < 8; ++e) { r[e] = 0.f; k[e] = 0.f; v[e] = 0.f; }
#pragma unroll
        for (int x = 0; x < 3; ++x) {
            const LAS unsigned char* cwp = lds + CWLOFF + (((hd * 3 + x) * 3) * 64 + 8 * jg) * 2;
            const u32x4 cr = *(const LAS u32x4*)cwp, ck = *(const LAS u32x4*)(cwp + 128), cv = *(const LAS u32x4*)(cwp + 256);
            const u32x4 rr = PF.rr[x], kk2 = PF.kk[x], vv = PF.vv[x];
            r[0] += bflo(rr.x) * bflo(cr.x); r[1] += bfhi(rr.x) * bfhi(cr.x); r[2] += bflo(rr.y) * bflo(cr.y); r[3] += bfhi(rr.y) * bfhi(cr.y);
            r[4] += bflo(rr.z) * bflo(cr.z); r[5] += bfhi(rr.z) * bfhi(cr.z); r[6] += bflo(rr.w) * bflo(cr.w); r[7] += bfhi(rr.w) * bfhi(cr.w);
            k[0] += bflo(kk2.x) * bflo(ck.x); k[1] += bfhi(kk2.x) * bfhi(ck.x); k[2] += bflo(kk2.y) * bflo(ck.y); k[3] += bfhi(kk2.y) * bfhi(ck.y);
            k[4] += bflo(kk2.z) * bflo(ck.z); k[5] += bfhi(kk2.z) * bfhi(ck.z); k[6] += bflo(kk2.w) * bflo(ck.w); k[7] += bfhi(kk2.w) * bfhi(ck.w);
            v[0] += bflo(vv.x) * bflo(cv.x); v[1] += bfhi(vv.x) * bfhi(cv.x); v[2] += bflo(vv.y) * bflo(cv.y); v[3] += bfhi(vv.y) * bfhi(cv.y);
            v[4] += bflo(vv.z) * bflo(cv.z); v[5] += bfhi(vv.z) * bfhi(cv.z); v[6] += bflo(vv.w) * bflo(cv.w); v[7] += bfhi(vv.w) * bfhi(cv.w);
        }
        const f32x4 zw0 = *(const LAS f32x4*)(lds + LWOFF + (tau * 64 + 8 * jg) * 4), zw1 = *(const LAS f32x4*)(lds + LWOFF + (tau * 64 + 8 * jg + 4) * 4);
        const f32x4 za0 = *(const LAS f32x4*)(lds + ZAOFF + (tau * 64 + 8 * jg) * 4), za1 = *(const LAS f32x4*)(lds + ZAOFF + (tau * 64 + 8 * jg + 4) * 4);
        float ss = 0.f, bsp = 0.f, av[8];
        const LAS f32x4* prm = (const LAS f32x4*)(lds + PRMOFF) + 2 * jg;
        const f32x4 w0a = prm[0], w0b = prm[1], a0a = prm[16], a0b = prm[17], kka = prm[32], kkb = prm[33], kaa = prm[48], kab = prm[49], rka = prm[64], rkb = prm[65];
#pragma unroll
        for (int e = 0; e < 8; ++e) {
            const float zw = (e < 4 ? zw0[e & 3] : zw1[e & 3]) + (e < 4 ? w0a[e & 3] : w0b[e & 3]);
            const float za = (e < 4 ? za0[e & 3] : za1[e & 3]) + (e < 4 ? a0a[e & 3] : a0b[e & 3]);
            lw[e] = -DECAY * sigm(zw); av[e] = sigm(za);
            kap[e] = k[e] * (e < 4 ? kka[e & 3] : kkb[e & 3]); ss += kap[e] * kap[e];
            kd[e] = k[e] * (1.f + (av[e] - 1.f) * (e < 4 ? kaa[e & 3] : kab[e & 3]));
            bsp += r[e] * kd[e] * (e < 4 ? rka[e & 3] : rkb[e & 3]);
        }
        ss += __shfl_xor(ss, 1); ss += __shfl_xor(ss, 2); ss += __shfl_xor(ss, 4);
        bsp += __shfl_xor(bsp, 1); bsp += __shfl_xor(bsp, 2); bsp += __shfl_xor(bsp, 4);
        const float rn = 1.f / sqrtf(fmaxf(ss, 1e-24f));
#pragma unroll
        for (int e = 0; e < 8; ++e) { kap[e] *= rn; bb[e] = kap[e] * av[e]; }
        if (jg == 0) ((float*)(F.ws + WS_BS))[((size_t)dir * T + tok) * 8 + hd] = bsp;
        *(LAS f32x4*)(lds + LWOFF + (tau * 64 + 8 * jg) * 4) = (f32x4){lw[0], lw[1], lw[2], lw[3]};
        *(LAS f32x4*)(lds + LWOFF + (tau * 64 + 8 * jg + 4) * 4) = (f32x4){lw[4], lw[5], lw[6], lw[7]};
#pragma unroll
        for (int e = 0; e < 8; ++e) st1(lds, BUF(7), 8 * jg + e, tau, v[e]);
        if (dir == 0) {
            const size_t ucidx = ((size_t)b * BH + hd) * NCH + c;
            bf16_t* vtb = (bf16_t*)(F.ws + WS_VTB) + ucidx * 4096;
#pragma unroll
            for (int e = 0; e < 8; ++e) vtb[(8 * jg + e) * 64 + u] = f2bf(v[e]);
            u32x4 vo; vo.x = cvtpk(v[0], v[1]); vo.y = cvtpk(v[2], v[3]); vo.z = cvtpk(v[4], v[5]); vo.w = cvtpk(v[6], v[7]);
            *(u32x4*)((bf16_t*)(F.ws + WS_VC) + tok * BW + ch0) = vo;
        }
    }
    lds_barrier();
    { const int seg = tid >> 6, j = tid & 63; float p = 0.f;
#pragma unroll
      for (int i = 0; i < 8; ++i) { LAS float* q = (LAS float*)(lds + LWOFF + ((8 * seg + i) * 64 + j) * 4); p += *q; *q = p; }
      *(LAS float*)(lds + SEGOFF + (seg * 64 + j) * 4) = p; }
    lds_barrier();
    if (tid < 64) { float run = 0.f;
#pragma unroll
      for (int sg = 0; sg < 8; ++sg) { *(LAS float*)(lds + SEGXOFF + (sg * 64 + tid) * 4) = run; run += *(const LAS float*)(lds + SEGOFF + (sg * 64 + tid) * 4); }
      *(LAS float*)(lds + TOTOFF + tid * 4) = run; }
    lds_barrier();
    {
        float At[8], Rt[8], Bt[8], Kt[8], Bh[8], Kh[8];
#pragma unroll
        for (int e = 0; e < 8; ++e) {
            const int j = 8 * jg + e;
            const float lwi = *(const LAS float*)(lds + LWOFF + (tau * 64 + j) * 4) + *(const LAS float*)(lds + SEGXOFF + ((tau >> 3) * 64 + j) * 4);
            const float tot = *(const LAS float*)(lds + TOTOFF + j * 4);
            const float ep = __expf(lwi - lw[e]), epl = __expf(lwi), em = __expf(-lwi), ec = __expf(tot - lwi);
            At[e] = -kap[e] * ep; Rt[e] = r[e] * epl; Bt[e] = bb[e] * em; Kt[e] = kd[e] * em; Bh[e] = bb[e] * ec; Kh[e] = kd[e] * ec;
            if (u == 0) *(LAS float*)(lds + PCOFF + j * 4) = __expf(tot);
        }
        u32x4 o;
#define PK8(X) (o.x = cvtpk(X[0], X[1]), o.y = cvtpk(X[2], X[3]), o.z = cvtpk(X[4], X[5]), o.w = cvtpk(X[6], X[7]), o)
        *(LAS u32x4*)(lds + BUF(0) + tau * 144 + 16 * jg) = PK8(At);
        *(LAS u32x4*)(lds + BUF(1) + tau * 144 + 16 * jg) = PK8(Bt);
        *(LAS u32x4*)(lds + BUF(2) + tau * 144 + 16 * jg) = PK8(Kt);
        *(LAS u32x4*)(lds + BUF(3) + tau * 144 + 16 * jg) = PK8(Rt);
#undef PK8
#pragma unroll
        for (int e = 0; e < 8; ++e) { const int j = 8 * jg + e; st1(lds, BUF(4), j, tau, At[e]); st1(lds, BUF(5), j, tau, Bh[e]); st1(lds, BUF(6), j, tau, Kh[e]); }
    }
    if (next_unit >= 0) rwkv_prefetch(F, a, l, next_unit, PF);
    lds_barrier();
#pragma unroll
    for (int tmi = 0; tmi < 2; ++tmi) {
        const int tm = tm0 + tmi, mb = 16 * tm + 4 * g4, nn = 16 * tn + l15;
        { f32x4 v = mm64(lds, BUF(1), 16 * tm, BUF(0), 16 * tn, lane);
#pragma unroll
          for (int e = 0; e < 4; ++e) v[e] = (mb + e < nn) ? v[e] : 0.f;
          if (tm == tn) {
#pragma unroll
              for (int e = 0; e < 4; ++e) *(LAS float*)(lds + NABFOFF + ((16 * tm + l15) * 16 + ((mb + e) & 15)) * 4) = v[e];
              v = (f32x4){0.f, 0.f, 0.f, 0.f};
          }
          st4(lds, BUF(11), nn, mb, v); }
        { f32x4 v = mm64(lds, BUF(0), 16 * tm, BUF(2), 16 * tn, lane);
#pragma unroll
          for (int e = 0; e < 4; ++e) v[e] = (nn < mb + e) ? v[e] : 0.f;
          st4(lds, BUF(8), nn, mb, v); }
        { f32x4 v = mm64(lds, BUF(1), 16 * tm, BUF(3), 16 * tn, lane);
#pragma unroll
          for (int e = 0; e < 4; ++e) v[e] = (mb + e <= nn) ? v[e] : 0.f;
          st4(lds, BUF(9), nn, mb, v); }
        { f32x4 v = mm64(lds, BUF(2), 16 * tm, BUF(3), 16 * tn, lane);
#pragma unroll
          for (int e = 0; e < 4; ++e) v[e] = (mb + e <= nn) ? v[e] : 0.f;
          st4(lds, BUF(10), nn, mb, v); }
    }
    lds_barrier();
    if (wave == 0) {
        const int blk = lane >> 4, sr = lane & 15, s = 16 * blk + sr;
        float Tr[16];
#pragma unroll
        for (int t = 0; t < 16; ++t) { float acc = (t == sr) ? 1.f : 0.f;
            const LAS f32x4* col = (const LAS f32x4*)(lds + NABFOFF + ((16 * blk + t) * 16) * 4);
#pragma unroll
            for (int q = 0; q < (t + 3) / 4; ++q) { const f32x4 nv = col[q];
#pragma unroll
                for (int e = 0; e < 4; ++e) if (4 * q + e < t) acc += Tr[4 * q + e] * nv[e]; }
            Tr[t] = acc; __builtin_amdgcn_sched_barrier(0); }
        const u32x4 z4 = (u32x4){0u, 0u, 0u, 0u};
#pragma unroll
        for (int q = 0; q < 9; ++q) { *(LAS u32x4*)(lds + BUF(0) + s * 144 + 16 * q) = z4; *(LAS u32x4*)(lds + BUF(1) + s * 144 + 16 * q) = z4; }
        u32x4 o0, o1; o0.x = cvtpk(Tr[0], Tr[1]); o0.y = cvtpk(Tr[2], Tr[3]); o0.z = cvtpk(Tr[4], Tr[5]); o0.w = cvtpk(Tr[6], Tr[7]);
        o1.x = cvtpk(Tr[8], Tr[9]); o1.y = cvtpk(Tr[10], Tr[11]); o1.z = cvtpk(Tr[12], Tr[13]); o1.w = cvtpk(Tr[14], Tr[15]);
        LDS_WAIT();
        *(LAS u32x4*)(lds + BUF(0) + s * 144 + 32 * blk) = o0; *(LAS u32x4*)(lds + BUF(0) + s * 144 + 32 * blk + 16) = o1;
#pragma unroll
        for (int t = 0; t < 16; ++t) st1(lds, BUF(1), 16 * blk + t, s, Tr[t]);
    }
    lds_barrier();
#pragma unroll
    for (int tmi = 0; tmi < 2; ++tmi) {
        const int tm = tm0 + tmi, mb = 16 * tm + 4 * g4, nn = 16 * tn + l15;
        const f32x4 v = mm64(lds, BUF(0), 16 * tm, BUF(11), 16 * tn, lane);
        st4(lds, BUF(12), nn, mb, v);
#pragma unroll
        for (int e = 0; e < 4; ++e) st1(lds, BUF(2), mb + e, nn, v[e]);
    }
    lds_barrier();
#pragma unroll
    for (int tmi = 0; tmi < 2; ++tmi) {
        const int tm = tm0 + tmi, mb = 16 * tm + 4 * g4, nn = 16 * tn + l15;
        const f32x4 v = mm64(lds, BUF(12), 16 * tm, BUF(2), 16 * tn, lane);
        st4(lds, BUF(13), nn, mb, v);
    }
    lds_barrier();
#pragma unroll
    for (int tmi = 0; tmi < 2; ++tmi) {
        const int tm = tm0 + tmi, mb = 16 * tm + 4 * g4, nn = 16 * tn + l15;
        const f32x4 v = mm64(lds, BUF(13), 16 * tm, BUF(1), 16 * tn, lane) + ld4(lds, BUF(1), nn, mb);
        st4(lds, BUF(14), nn, mb, v);
    }
    lds_barrier();
#pragma unroll
    for (int tmi = 0; tmi < 2; ++tmi) {
        const int tm = tm0 + tmi, mb = 16 * tm + 4 * g4, nn = 16 * tn + l15;
        const f32x4 v = mm64(lds, BUF(2), 16 * tm, BUF(14), 16 * tn, lane) + ld4(lds, BUF(14), nn, mb);
        st4(lds, BUF(15), nn, mb, v);
    }
    lds_barrier();
#pragma unroll
    for (int tmi = 0; tmi < 2; ++tmi) {
        const int tm = tm0 + tmi, mb = 16 * tm + 4 * g4, nn = 16 * tn + l15;
        const f32x4 x1 = mm64(lds, BUF(15), 16 * tm, BUF(4), 16 * tn, lane);
        const f32x4 x2 = mm64(lds, BUF(15), 16 * tm, BUF(8), 16 * tn, lane);
        st4(lds, BUF(0), nn, mb, x1); st4(lds, BUF(1), nn, mb, x2);
    }
    lds_barrier();
    {
        bf16_t* QT = (bf16_t*)(F.ws + WS_QT) + (size_t)unit * 4096; bf16_t* WT = (bf16_t*)(F.ws + WS_WT) + (size_t)unit * 4096; bf16_t* MP = (bf16_t*)(F.ws + WS_MP) + (size_t)unit * 4096;
#pragma unroll
        for (int tmi = 0; tmi < 2; ++tmi) {
            const int tm = tm0 + tmi, mb = 16 * tm + 4 * g4, nn = 16 * tn + l15;
            { const f32x4 v = mm64(lds, BUF(0), 16 * tm, BUF(9), 16 * tn, lane) + ld4(lds, BUF(3), nn, mb);
              *(u32x2*)(QT + (dir ? 63 - nn : nn) * 64 + mb) = pack4(v); }
            { const f32x4 v = mm64(lds, BUF(1), 16 * tm, BUF(9), 16 * tn, lane) + ld4(lds, BUF(10), nn, mb);
              if (dir) *(u32x2*)(WT + (63 - nn) * 64 + (60 - mb)) = pack4((f32x4){v[3], v[2], v[1], v[0]});
              else *(u32x2*)(WT + nn * 64 + mb) = pack4(v); }
            { f32x4 v = mm64(lds, BUF(0), 16 * tm, BUF(5), 16 * tn, lane);
#pragma unroll
              for (int e = 0; e < 4; ++e) if (mb + e == nn) v[e] += *(const LAS float*)(lds + PCOFF + nn * 4);
              *(u32x2*)(MP + nn * 64 + swap23(mb)) = pack4(v); }
            { const f32x4 v = mm64(lds, BUF(1), 16 * tm, BUF(5), 16 * tn, lane) + ld4(lds, BUF(6), nn, mb);
              st4(lds, BUF(2), nn, mb, v); }
        }
    }
    lds_barrier();
    {
        bf16_t* NBp = (bf16_t*)(F.ws + WS_NB);
#pragma unroll
        for (int tmi = 0; tmi < 2; ++tmi) {
            const int tm = tm0 + tmi, mb = 16 * tm + 4 * g4, ii = 16 * tn + l15;
            const f32x4 v = mm64(lds, BUF(2), 16 * tm, BUF(7), 16 * tn, lane);
            const int jb = mb >> 5, jl = mb & 31, q = jl >> 3, hic = (jl >> 2) & 1, ih = ii >> 5, Lc = (ii & 31) + 32 * hic;
            *(u32x2*)(NBp + ((((size_t)unit * 2 + ih) * 2 + jb) * 2 + (q >> 1)) * 512 + Lc * 8 + 4 * (q & 1)) = pack4(v);
        }
    }
    lds_barrier();
}

DI void attn_unit(const Frame& F, const LAS float* rpbl, const int au) {
    const bf16_t* HBp = (const bf16_t*)(F.ws + WS_HB); const bf16_t* VTp = (const bf16_t*)(F.ws + WS_VT); bf16_t* CONCAT = (bf16_t*)(F.ws + WS_CONCAT);
    const int hh = au % AH, r = (au / AH) % ROWS, b = au / (AH * ROWS);
    int rstart = r - KH / 2; rstart = rstart < 0 ? 0 : (rstart > ROWS - KH ? ROWS - KH : rstart);
    const int lane = F.lane, q32 = lane & 31, hi = lane >> 5;
    const float SC = 0.125f * LOG2E;
    const int krow_off = swap23(q32);
#pragma unroll 1
    for (int qb = 0; qb < 2; ++qb) {
        const int cq = 32 * qb + q32; int cs = cq - KW / 2; cs = cs < 0 ? 0 : (cs > GW - KW ? GW - KW : cs);
        const size_t tokq = (size_t)b * S + r * GW + cq;
        bf16x8 qf[4];
#pragma unroll
        for (int ds = 0; ds < 4; ++ds) qf[ds] = *(const bf16x8*)(HBp + tokq * HW + HQ + hh * HD + 16 * ds + 8 * hi);
        f32x16 o0, o1;
#pragma unroll
        for (int i = 0; i < 16; ++i) { o0[i] = 0.f; o1[i] = 0.f; }
        float mrun = -1e30f, lsum = 0.f;
#pragma unroll 1
        for (int kt = 0; kt < 2 * KH; ++kt) {
            const int kr = rstart + (kt >> 1), ckb = 32 * (kt & 1);
            const size_t ktok = (size_t)b * S + kr * GW + ckb;
            bf16x8 kf[4], vf[2][2];
#pragma unroll
            for (int ds = 0; ds < 4; ++ds) kf[ds] = *(const bf16x8*)(HBp + (ktok + krow_off) * HW + HK + hh * HD + 16 * ds + 8 * hi);
#pragma unroll
            for (int db = 0; db < 2; ++db)
#pragma unroll
                for (int s = 0; s < 2; ++s) vf[db][s] = *(const bf16x8*)(VTp + (size_t)(hh * HD + 32 * db + q32) * T + ktok + 16 * s + 8 * hi);
            f32x16 st;
#pragma unroll
            for (int i = 0; i < 16; ++i) st[i] = 0.f;
#pragma unroll
            for (int ds = 0; ds < 4; ++ds) st = MFMA32(kf[ds], qf[ds], st);
            const LAS float* rp = rpbl + (hh * (2 * KH - 1) + (kr - r + KH - 1)) * (2 * KW - 1);
            float sl[16]; float tmax = -1e30f;
#pragma unroll
            for (int i = 0; i < 16; ++i) {
                const int ck = ckb + 16 * (i >> 3) + 8 * hi + (i & 7);
                const bool inw = (ck >= cs) && (ck < cs + KW);
                int dc = ck - cq; dc = dc < -(KW - 1) ? -(KW - 1) : (dc > KW - 1 ? KW - 1 : dc); dc += KW - 1;
                sl[i] = inw ? st[i] * SC + rp[dc] : -1e30f;
                tmax = fmaxf(tmax, sl[i]);
            }
            tmax = fmaxf(tmax, __shfl_xor(tmax, 32));
            const float mn = fmaxf(mrun, tmax), corr = __builtin_amdgcn_exp2f(mrun - mn);
            float ps = 0.f;
#pragma unroll
            for (int i = 0; i < 16; ++i) { sl[i] = (sl[i] > -1e29f) ? __builtin_amdgcn_exp2f(sl[i] - mn) : 0.f; ps += sl[i]; }
            lsum = lsum * corr + ps; mrun = mn;
#pragma unroll
            for (int i = 0; i < 16; ++i) { o0[i] *= corr; o1[i] *= corr; }
            u32x4 p0, p1;
            p0.x = cvtpk(sl[0], sl[1]); p0.y = cvtpk(sl[2], sl[3]); p0.z = cvtpk(sl[4], sl[5]); p0.w = cvtpk(sl[6], sl[7]);
            p1.x = cvtpk(sl[8], sl[9]); p1.y = cvtpk(sl[10], sl[11]); p1.z = cvtpk(sl[12], sl[13]); p1.w = cvtpk(sl[14], sl[15]);
            const bf16x8 pf0 = __builtin_bit_cast(bf16x8, p0), pf1 = __builtin_bit_cast(bf16x8, p1);
            o0 = MFMA32(vf[0][0], pf0, o0); o0 = MFMA32(vf[0][1], pf1, o0);
            o1 = MFMA32(vf[1][0], pf0, o1); o1 = MFMA32(vf[1][1], pf1, o1);
        }
        const float inv = 1.f / (lsum + __shfl_xor(lsum, 32));
        bf16_t* op = CONCAT + tokq * D + hh * HD;
#pragma unroll
        for (int g = 0; g < 4; ++g) {
            *(u32x2*)(op + 8 * g + 4 * hi) = pack4((f32x4){o0[4 * g] * inv, o0[4 * g + 1] * inv, o0[4 * g + 2] * inv, o0[4 * g + 3] * inv});
            *(u32x2*)(op + 32 + 8 * g + 4 * hi) = pack4((f32x4){o1[4 * g] * inv, o1[4 * g + 1] * inv, o1[4 * g + 2] * inv, o1[4 * g + 3] * inv});
        }
    }
}

DI void pool_unit(const Frame& F, const float* pool_w, const float* pool_scale, const int pu) {
    const bf16_t* HBp = (const bf16_t*)(F.ws + WS_HB); bf16_t* CONCAT = (bf16_t*)(F.ws + WS_CONCAT);
    const int g = pu & 3, blk = pu >> 2, b = blk >> 8, t0 = (blk & 255) * 32;
    const int lane = F.lane, q32 = lane & 31, hi = lane >> 5, t = t0 + q32, win = 2 << g;
    int lo = t - win / 2; lo = lo < 0 ? 0 : lo; int hit = t + win / 2 - 1; hit = hit > S - 1 ? S - 1 : hit;
    const float inv = 1.f / (float)(hit - lo + 1);
    f32x16 out0, out1;
#pragma unroll
    for (int i = 0; i < 16; ++i) { out0[i] = 0.f; out1[i] = 0.f; }
    const float* pw = pool_w + (size_t)g * 64 * 64;
#pragma unroll 1
    for (int s = 0; s < 4; ++s) {
        const int c0 = HP + g * 64 + 16 * s + 8 * hi;
        float acc[8];
#pragma unroll
        for (int e = 0; e < 8; ++e) acc[e] = 0.f;
#pragma unroll 1
        for (int tt = lo; tt <= hit; ++tt) {
            const u32x4 pv = *(const u32x4*)(HBp + ((size_t)b * S + tt) * HW + c0);
            acc[0] += bflo(pv.x); acc[1] += bfhi(pv.x); acc[2] += bflo(pv.y); acc[3] += bfhi(pv.y); acc[4] += bflo(pv.z); acc[5] += bfhi(pv.z); acc[6] += bflo(pv.w); acc[7] += bfhi(pv.w);
        }
        const u32x4 pc = *(const u32x4*)(HBp + ((size_t)b * S + t) * HW + c0);
        u32x4 o;
        o.x = cvtpk(acc[0] * inv - bflo(pc.x), acc[1] * inv - bfhi(pc.x)); o.y = cvtpk(acc[2] * inv - bflo(pc.y), acc[3] * inv - bfhi(pc.y));
        o.z = cvtpk(acc[4] * inv - bflo(pc.z), acc[5] * inv - bfhi(pc.z)); o.w = cvtpk(acc[6] * inv - bflo(pc.w), acc[7] * inv - bfhi(pc.w));
        const bf16x8 bfr = __builtin_bit_cast(bf16x8, o);
        const float* wp = pw + (size_t)(16 * s + 8 * hi) * 64 + q32;
        u32x4 w0; w0.x = cvtpk(wp[0], wp[64]); w0.y = cvtpk(wp[128], wp[192]); w0.z = cvtpk(wp[256], wp[320]); w0.w = cvtpk(wp[384], wp[448]);
        u32x4 w1; w1.x = cvtpk(wp[32], wp[96]); w1.y = cvtpk(wp[160], wp[224]); w1.z = cvtpk(wp[288], wp[352]); w1.w = cvtpk(wp[416], wp[480]);
        out0 = MFMA32(__builtin_bit_cast(bf16x8, w0), bfr, out0);
        out1 = MFMA32(__builtin_bit_cast(bf16x8, w1), bfr, out1);
    }
    bf16_t* op = CONCAT + ((size_t)b * S + t) * D + AW + BW + g * 64;
    const float* ps = pool_scale + g * 64;
#pragma unroll
    for (int gq = 0; gq < 4; ++gq) {
        const int e0 = 8 * gq + 4 * hi;
        const f32x4 s0 = *(const f32x4*)(ps + e0), s1 = *(const f32x4*)(ps + 32 + e0);
        *(u32x2*)(op + e0) = pack4((f32x4){out0[4 * gq] * s0[0], out0[4 * gq + 1] * s0[1], out0[4 * gq + 2] * s0[2], out0[4 * gq + 3] * s0[3]});
        *(u32x2*)(op + 32 + e0) = pack4((f32x4){out1[4 * gq] * s1[0], out1[4 * gq + 1] * s1[1], out1[4 * gq + 2] * s1[2], out1[4 * gq + 3] * s1[3]});
    }
}

constexpr int SCAN_SLOT = 12288, SCAN_DEPTH = 4;
DI void scan_issue(const Frame& F, const int sc, const int ihalf, const int dir, const int step, const int lane) {
    const int c = dir ? NCH - 1 - step : step; const size_t unit = (size_t)sc * NCH + c;
    const int il = lane & 31, hi = lane >> 5;
    LAS unsigned char* slot = F.lds + (step % SCAN_DEPTH) * SCAN_SLOT;
    const bf16_t* MP = (const bf16_t*)(F.ws + WS_MP) + unit * 4096; const bf16_t* NBp = (const bf16_t*)(F.ws + WS_NB) + (unit * 2 + ihalf) * 2048;
#pragma unroll
    for (int p = 0; p < 8; ++p) { const int jpb = p >> 2, jb = (p >> 1) & 1, s = p & 1;
        __builtin_amdgcn_global_load_lds((const unsigned*)(MP + (32 * jpb + il) * 64 + 32 * jb + 16 * s + 8 * hi), (LAS unsigned*)(slot + p * 1024), 16, 0, 0); }
#pragma unroll
    for (int p = 0; p < 4; ++p)
        __builtin_amdgcn_global_load_lds((const unsigned*)(NBp + p * 512 + lane * 8), (LAS unsigned*)(slot + 8192 + p * 1024), 16, 0, 0);
}
DI void scan_wave(const Frame& F, const int sw) {
    const int ihalf = sw & 1, sc = sw >> 1, dir = sc / (NB * BH);
    const int lane = F.lane, il = lane & 31, hi = lane >> 5;
    bf16_t* S0 = (bf16_t*)(F.ws + WS_S0);
    f32x16 st0, st1;
#pragma unroll
    for (int i = 0; i < 16; ++i) { st0[i] = 0.f; st1[i] = 0.f; }
    scan_issue(F, sc, ihalf, dir, 0, lane); scan_issue(F, sc, ihalf, dir, 1, lane); scan_issue(F, sc, ihalf, dir, 2, lane);
#pragma unroll 1
    for (int step = 0; step < NCH; ++step) {
        const int c = dir ? NCH - 1 - step : step; const size_t unit = (size_t)sc * NCH + c;
        asm volatile("s_waitcnt lgkmcnt(0)" ::: "memory"); __builtin_amdgcn_sched_barrier(0);
        scan_issue(F, sc, ihalf, dir, step + 3 < NCH ? step + 3 : NCH - 1 - ((step + 3 - NCH) & 1) * 0, lane);
        bf16_t* sp = S0 + unit * 4096 + (size_t)(32 * ihalf + il) * 64;
        u32x4 b00, b01, b10, b11;
        b00.x = cvtpk(st0[0], st0[1]); b00.y = cvtpk(st0[2], st0[3]); b00.z = cvtpk(st0[4], st0[5]); b00.w = cvtpk(st0[6], st0[7]);
        b01.x = cvtpk(st0[8], st0[9]); b01.y = cvtpk(st0[10], st0[11]); b01.z = cvtpk(st0[12], st0[13]); b01.w = cvtpk(st0[14], st0[15]);
        b10.x = cvtpk(st1[0], st1[1]); b10.y = cvtpk(st1[2], st1[3]); b10.z = cvtpk(st1[4], st1[5]); b10.w = cvtpk(st1[6], st1[7]);
        b11.x = cvtpk(st1[8], st1[9]); b11.y = cvtpk(st1[10], st1[11]); b11.z = cvtpk(st1[12], st1[13]); b11.w = cvtpk(st1[14], st1[15]);
        *(u32x2*)(sp + 0 + 4 * hi) = (u32x2){b00.x, b00.y};  *(u32x2*)(sp + 8 + 4 * hi) = (u32x2){b00.z, b00.w};
        *(u32x2*)(sp + 16 + 4 * hi) = (u32x2){b01.x, b01.y}; *(u32x2*)(sp + 24 + 4 * hi) = (u32x2){b01.z, b01.w};
        *(u32x2*)(sp + 32 + 4 * hi) = (u32x2){b10.x, b10.y}; *(u32x2*)(sp + 40 + 4 * hi) = (u32x2){b10.z, b10.w};
        *(u32x2*)(sp + 48 + 4 * hi) = (u32x2){b11.x, b11.y}; *(u32x2*)(sp + 56 + 4 * hi) = (u32x2){b11.z, b11.w};
        const bf16x8 p00 = __builtin_bit_cast(bf16x8, b00), p01 = __builtin_bit_cast(bf16x8, b01), p10 = __builtin_bit_cast(bf16x8, b10), p11 = __builtin_bit_cast(bf16x8, b11);
        asm volatile("s_waitcnt vmcnt(36)" ::: "memory"); __builtin_amdgcn_sched_barrier(0);
        const LAS unsigned char* slot = F.lds + (step % SCAN_DEPTH) * SCAN_SLOT;
        bf16x8 ma[8]; u32x4 nbv[4];
#pragma unroll
        for (int p = 0; p < 8; ++p) ma[p] = *(const LAS bf16x8*)(slot + p * 1024 + lane * 16);
#pragma unroll
        for (int p = 0; p < 4; ++p) nbv[p] = *(const LAS u32x4*)(slot + 8192 + p * 1024 + lane * 16);
        f32x16 n0, n1;
#pragma unroll
        for (int h2 = 0; h2 < 2; ++h2) {
            n0[8 * h2 + 0] = bflo(nbv[h2].x); n0[8 * h2 + 1] = bfhi(nbv[h2].x); n0[8 * h2 + 2] = bflo(nbv[h2].y); n0[8 * h2 + 3] = bfhi(nbv[h2].y);
            n0[8 * h2 + 4] = bflo(nbv[h2].z); n0[8 * h2 + 5] = bfhi(nbv[h2].z); n0[8 * h2 + 6] = bflo(nbv[h2].w); n0[8 * h2 + 7] = bfhi(nbv[h2].w);
            n1[8 * h2 + 0] = bflo(nbv[2 + h2].x); n1[8 * h2 + 1] = bfhi(nbv[2 + h2].x); n1[8 * h2 + 2] = bflo(nbv[2 + h2].y); n1[8 * h2 + 3] = bfhi(nbv[2 + h2].y);
            n1[8 * h2 + 4] = bflo(nbv[2 + h2].z); n1[8 * h2 + 5] = bfhi(nbv[2 + h2].z); n1[8 * h2 + 6] = bflo(nbv[2 + h2].w); n1[8 * h2 + 7] = bfhi(nbv[2 + h2].w);
        }
        n0 = MFMA32(ma[0], p00, n0); n1 = MFMA32(ma[4], p00, n1);
        n0 = MFMA32(ma[1], p01, n0); n1 = MFMA32(ma[5], p01, n1);
        n0 = MFMA32(ma[2], p10, n0); n1 = MFMA32(ma[6], p10, n1);
        n0 = MFMA32(ma[3], p11, n0); n1 = MFMA32(ma[7], p11, n1);
        st0 = n0; st1 = n1;
    }
    asm volatile("s_waitcnt vmcnt(0)" ::: "memory");
}

DI void rwkv_out_unit(const Frame& F, const RwP& P, const int du) {
    const int qd = du & 3, cidx = du >> 2, c = cidx % NCH, hd = (cidx / NCH) % BH, b = cidx / (NCH * BH);
    const int lane = F.lane, n = lane & 15, g = lane >> 4, u = 16 * qd + n;
    const bf16_t* QT = (const bf16_t*)(F.ws + WS_QT); const bf16_t* WT = (const bf16_t*)(F.ws + WS_WT); const bf16_t* S0 = (const bf16_t*)(F.ws + WS_S0);
    const bf16_t* VTB = (const bf16_t*)(F.ws + WS_VTB) + (size_t)cidx * 4096;
    f32x4 acc[4];
#pragma unroll
    for (int tm = 0; tm < 4; ++tm) acc[tm] = (f32x4){0.f, 0.f, 0.f, 0.f};
#pragma unroll
    for (int dir = 0; dir < 2; ++dir) {
        const size_t unit = (((size_t)dir * NB + b) * BH + hd) * NCH + c;
#pragma unroll
        for (int ks = 0; ks < 2; ++ks) {
            const bf16x8 bq = *(const bf16x8*)(QT + unit * 4096 + u * 64 + 32 * ks + 8 * g);
            const bf16x8 bw = *(const bf16x8*)(WT + unit * 4096 + u * 64 + 32 * ks + 8 * g);
#pragma unroll
            for (int tm = 0; tm < 4; ++tm) {
                const bf16x8 as = *(const bf16x8*)(S0 + unit * 4096 + (16 * tm + n) * 64 + 32 * ks + 8 * g);
                const bf16x8 av = *(const bf16x8*)(VTB + (16 * tm + n) * 64 + 32 * ks + 8 * g);
                acc[tm] = MFMA16(as, bq, acc[tm]); acc[tm] = MFMA16(av, bw, acc[tm]);
            }
        }
    }
    float s = 0.f;
#pragma unroll
    for (int tm = 0; tm < 4; ++tm) s += (acc[tm][0] + acc[tm][1]) + (acc[tm][2] + acc[tm][3]);
    s += __shfl_xor(s, 16); s += __shfl_xor(s, 32);
    const float mu = s * (1.f / HD); float q = 0.f;
#pragma unroll
    for (int tm = 0; tm < 4; ++tm) { acc[tm] = acc[tm] - mu; q += (acc[tm][0] * acc[tm][0] + acc[tm][1] * acc[tm][1]) + (acc[tm][2] * acc[tm][2] + acc[tm][3] * acc[tm][3]); }
    q += __shfl_xor(q, 16); q += __shfl_xor(q, 32);
    const float rstd = 1.f / sqrtf(q * (1.f / HD) + GN_EPS);
    const size_t tok = (size_t)b * S + 64 * c + u;
    const float* BS = (const float*)(F.ws + WS_BS);
    const float bsum = BS[tok * 8 + hd] + BS[((size_t)T + tok) * 8 + hd];
    const bf16_t* VC = (const bf16_t*)(F.ws + WS_VC) + tok * BW + hd * HD; const bf16_t* GBp = (const bf16_t*)(F.ws + WS_GB) + tok * BW + hd * HD;
    bf16_t* op = (bf16_t*)(F.ws + WS_CONCAT) + tok * D + AW + hd * HD;
#pragma unroll
    for (int tm = 0; tm < 4; ++tm) {
        const int i0 = 16 * tm + 4 * g;
        const f32x4 vv = unpack4(*(const u32x2*)(VC + i0)), gg = unpack4(*(const u32x2*)(GBp + i0));
        const f32x4 gn = *(const f32x4*)(P.gn_gain + hd * HD + i0), gb = *(const f32x4*)(P.gn_bias + hd * HD + i0);
        *(u32x2*)(op + i0) = pack4((acc[tm] * rstd * gn + gb + vv * bsum) * gg);
    }
}

DI RwP make_rwp(const Args& a, int l) {
    RwP p;
    p.conv = a.in[6] + (size_t)l * 3 * 3 * BW; p.w0 = a.in[7] + (size_t)l * 2 * BW; p.w_up = a.in[8] + (size_t)l * 2 * RW * BW;
    p.a0 = a.in[9] + (size_t)l * 2 * BW; p.a_up = a.in[10] + (size_t)l * 2 * RA * BW; p.g_up = a.in[11] + (size_t)l * RG * BW;
    p.k_k = a.in[12] + (size_t)l * BW; p.k_a = a.in[13] + (size_t)l * BW; p.r_k = a.in[14] + (size_t)l * BH * HD;
    p.gn_gain = a.in[15] + (size_t)l * BW; p.gn_bias = a.in[16] + (size_t)l * BW;
    return p;
}
DI void p_gemm1(const Frame& F, int l) {
    pg8::Gemm1Order S; S.U = (const bf16_t*)(F.ws + WS_U); S.Win = (const bf16_t*)(F.ws + WS_WIN + (size_t)l * WIN_LAYER); S.Wv = S.Win + (size_t)HW * D; S.G = F.G; S.c = F.bx;
    pg8::EpiStore E{(bf16_t*)(F.ws + WS_HB), HW, (bf16_t*)(F.ws + WS_VT), T};
    pg8::gemm_phase(F.lds, F.tid, D, S, E);
}
DI void p_mixer_local(const Frame& F, const Args& a, int l) {
    {
      const float* conv = a.in[6] + (size_t)l * 3 * 3 * BW;
      for (int i = F.tid; i < BH * 9 * 64; i += NTHREADS) { const int j = i & 63, q = i >> 6, which = q % 3, x = (q / 3) % 3, hd = q / 9;
          *(LAS bf16_t*)(F.lds + CWLOFF + i * 2) = f2bf(conv[x * 3 * BW + which * BW + hd * HD + j]); }
      RwPre PF;
      if (F.bx < NUNIT) rwkv_prefetch(F, a, l, F.bx, PF);
      __syncthreads();
      for (int unit = F.bx; unit < NUNIT; unit += F.G) rwkv_local_unit(F, a, l, unit, PF, unit + F.G < NUNIT ? unit + F.G : -1);
    }
    LAS float* rpbl = (LAS float*)F.lds;
    const float* rpb = a.in[5] + (size_t)l * AH * (2 * KH - 1) * (2 * KW - 1);
    for (int i = F.tid; i < AH * (2 * KH - 1) * (2 * KW - 1); i += NTHREADS) rpbl[i] = rpb[i] * LOG2E;
    __syncthreads();
    for (int au = F.gw; au < NB * ROWS * AH; au += F.ngw) attn_unit(F, rpbl, au);
#ifdef DBL_ATTN
    for (int au = F.gw; au < NB * ROWS * AH; au += F.ngw) attn_unit(F, rpbl, au);
#endif
    for (int pu = F.gw; pu < NB * (S / 32) * 4; pu += F.ngw) pool_unit(F, a.in[17] + (size_t)l * NG * 64 * 64, a.in[18] + (size_t)l * CW, pu);
}
DI void p_scan(const Frame& F, const Args& a, int l) {
    constexpr int NSCAN = 2 * 2 * NB * BH;
    if (F.bx < NSCAN) { if (F.wave == 0) scan_wave(F, F.bx); return; }
#if TESTMODE != 2
    LAS float* scr = (LAS float*)F.lds + F.wave * (64 * 65);
    for (int it = (F.bx - NSCAN) * NWAVES + F.wave; it < IT_MOE; it += (F.G - NSCAN) * NWAVES) conv_moe_item(F, a.in[28], a.in[29], a.in[30], l, it, scr);
#endif
}
DI void p_rwkv_out(const Frame& F, const Args& a, int l) {
    const RwP P = make_rwp(a, l);
    for (int du = F.gw; du < NB * BH * NCH * 4; du += F.ngw) rwkv_out_unit(F, P, du);
}
DI void p_gemm2(const Frame& F, int l) {
    pg8::PlainOrder S; S.init((const bf16_t*)(F.ws + WS_CONCAT), (const bf16_t*)(F.ws + WS_WOUT) + (size_t)l * D * D, T, D, D, F.G, F.bx);
    pg8::EpiStore E{(bf16_t*)(F.ws + WS_MIX), D, nullptr, 0};
    pg8::gemm_phase(F.lds, F.tid, D, S, E);
}
DI void p_moe_a(const Frame& F, int l) {
    LAS int* tb = (LAS int*)(F.lds + LDS_MISC);
    build_tables(F, l, tb);
    pg8::GroupedOrder S; S.A = (const bf16_t*)(F.ws + WS_XS); S.Bt = (const bf16_t*)(F.ws + WS_WGU); S.K = D; S.estride = (size_t)D * D; S.tile_e = tb + 66; S.ntiles = tb[65]; S.nwg = S.ntiles * 4; S.G = F.G; S.c = F.bx;
    pg8::EpiSwiGlu E{(bf16_t*)(F.ws + WS_HM)};
    pg8::gemm_phase(F.lds, F.tid, D, S, E);
}
DI void p_moe_b(const Frame& F, int l) {
    LAS int* tb = (LAS int*)(F.lds + LDS_MISC);
    build_tables(F, l, tb);
    pg8::GroupedOrder S; S.A = (const bf16_t*)(F.ws + WS_HM); S.Bt = (const bf16_t*)(F.ws + WS_WD); S.K = DE; S.estride = (size_t)D * DE; S.tile_e = tb + 66; S.ntiles = tb[65]; S.nwg = S.ntiles * 4; S.G = F.G; S.c = F.bx;
    pg8::EpiRowScale E{(bf16_t*)(F.ws + WS_YS), (const float*)(F.ws + WS_SLOTW)};
    pg8::gemm_phase(F.lds, F.tid, DE, S, E);
}

#ifndef DBLMASK
#define DBLMASK 0
#endif
constexpr int PH_PER_LAYER = 10, N_PHASES = 2 + L * PH_PER_LAYER;
DI bool in_ph(int k, int lo, int hi) { lo = __builtin_amdgcn_readfirstlane(lo); hi = __builtin_amdgcn_readfirstlane(hi); asm volatile("" : "+s"(lo), "+s"(hi)); return lo <= k && k < hi; }
DI Frame fresh(const Frame& F0) {
    Frame F = F0; int t = F0.tid, b = F0.bx;
    b = __builtin_amdgcn_readfirstlane(b); asm volatile("" : "+v"(t)); asm volatile("" : "+s"(b));
    F.tid = t; F.lane = t & 63; F.wave = __builtin_amdgcn_readfirstlane(t >> 6); F.bx = b;
    F.vcu = (F.G % 8 == 0) ? (b % 8) * (F.G / 8) + b / 8 : b; F.gw = F.vcu * NWAVES + F.wave;
    return F;
}

__global__ void __launch_bounds__(NTHREADS, 2) mk_fwd(Args a) {
    extern __shared__ __attribute__((aligned(16))) unsigned char lds_raw[];
    Frame F;
    F.lds = (LAS unsigned char*)lds_raw;
    F.tid = threadIdx.x; F.lane = F.tid & 63; F.wave = __builtin_amdgcn_readfirstlane(F.tid >> 6);
    F.G = gridDim.x; F.bx = blockIdx.x; { const int bx = blockIdx.x; F.vcu = (F.G % 8 == 0) ? (bx % 8) * (F.G / 8) + bx / 8 : bx; }
    F.gw = F.vcu * NWAVES + F.wave; F.ngw = F.G * NWAVES; F.ws = a.ws;
    volatile LAS unsigned* bst = (volatile LAS unsigned*)(F.lds + LDS_BARST);
    if (F.tid < 16) bst[F.tid] = 0u;
    __syncthreads();
    cg::grid_group grid = cg::this_grid();
    XcdBarrier bar; bar.bar = (unsigned*)(a.ws + WS_CTL) + CW_BAR; bar.x = 0; bar.st = bst;
    const bool multi = (a.ph_hi - a.ph_lo) > 1;
    if (multi && !a.use_cg) bar = xcd_barrier_post((unsigned*)(a.ws + WS_CTL) + CW_BAR, bst);
    const int lo = a.ph_lo, hi = a.ph_hi;
#define IN(k) in_ph((k), lo, hi)
#ifndef DBLSEAM
#define DBLSEAM 0
#endif
#define SEAM(k) do { if (IN(k) && IN((k) + 1)) { if (a.use_cg) grid.sync(); else { xcd_barrier(bar); if (DBLSEAM) xcd_barrier(bar); } } } while (0)
    if (IN(0)) { p0_prologue(fresh(F), a); if ((DBLMASK >> 11) & 1) p0_prologue(fresh(F), a); }
    SEAM(0);
    if (IN(1)) { p_r0(fresh(F), a.in[0]); if ((DBLMASK >> 12) & 1) p_r0(fresh(F), a.in[0]); }
    SEAM(1);
#define RUN(k, call) do { if (IN(pb + (k))) { call; if ((DBLMASK >> (k)) & 1) { call; } } } while (0)
#define LAYER(l) do { \
        const int pb = 2 + PH_PER_LAYER * (l); \
        RUN(0, p_gemm1(fresh(F), (l))); \
        SEAM(pb + 0); \
        RUN(1, p_mixer_local(fresh(F), a, (l))); \
        SEAM(pb + 1); \
        RUN(2, p_scan(fresh(F), a, (l))); \
        SEAM(pb + 2); \
        RUN(3, p_rwkv_out(fresh(F), a, (l))); \
        SEAM(pb + 3); \
        RUN(4, p_gemm2(fresh(F), (l))); \
        SEAM(pb + 4); \
        RUN(5, p_rowpass1(fresh(F), a, (l), (l) == 0 ? a.in[0] : a.out)); \
        if (IN(pb + 5) && ((DBLMASK >> 10) & 1)) p_rowpass1(fresh(F), a, (l), (l) == 0 ? a.in[0] : a.out, true); \
        SEAM(pb + 5); \
        RUN(6, p_gather(fresh(F), (l))); \
        SEAM(pb + 6); \
        RUN(7, p_moe_a(fresh(F), (l))); \
        SEAM(pb + 7); \
        RUN(8, p_moe_b(fresh(F), (l))); \
        SEAM(pb + 8); \
        RUN(9, p_rowpass2(fresh(F), a, (l), a.out)); \
        SEAM(pb + 9); \
    } while (0)
    LAYER(0);
    LAYER(1);
#undef LAYER
#undef IN
#undef SEAM
}

#ifndef MK_MODE
#define MK_MODE 0
#endif
#ifndef TESTMODE
#define TESTMODE 0
#endif

static void fill_args(Args& a, void* const* d_in, void* d_out, void* d_ws) {
    for (int i = 0; i < 31; ++i) a.in[i] = (const float*)d_in[i];
    a.out = (float*)d_out; a.ws = (unsigned char*)d_ws; a.ph_lo = 0; a.ph_hi = N_PHASES; a.use_cg = 0; a.pad = 0;
}
static void launch_phases(Args a, int lo, int hi, hipStream_t stream) {
    for (int p = lo; p < hi; ++p) { a.ph_lo = p; a.ph_hi = p + 1; hipLaunchKernelGGL(mk_fwd, dim3(256), dim3(NTHREADS), LDS_BYTES, stream, a); }
}

#if TESTMODE == 0
extern "C" void kernel_launch(void* const* d_in, const int* in_sizes, int n_in, void* d_out, int out_size, void* d_ws, size_t ws_size, hipStream_t stream) {
    static int grid = 0;
    if (grid == 0) {
        int dev = 0, cus = 0, per_cu = 0;
        (void)hipGetDevice(&dev); (void)hipDeviceGetAttribute(&cus, hipDeviceAttributeMultiprocessorCount, dev);
        (void)hipFuncSetAttribute((const void*)mk_fwd, hipFuncAttributeMaxDynamicSharedMemorySize, LDS_BYTES);
        (void)hipOccupancyMaxActiveBlocksPerMultiprocessor(&per_cu, (const void*)mk_fwd, NTHREADS, LDS_BYTES);
        (void)hipGetLastError();
        grid = (cus > 0 ? cus : 256) * 1;
        if (ws_size < WS_END || n_in != 31) grid = -1;
    }
    if (grid < 0) return;
    (void)hipMemsetAsync((char*)d_ws + WS_CTL, 0, CTL_BYTES, stream);
    Args a{}; fill_args(a, d_in, d_out, d_ws);
#if MK_MODE == 2
    launch_phases(a, 0, N_PHASES, stream);
#else
    a.use_cg = (MK_MODE == 1) ? 1 : 0;
    void* args[] = {&a};
    (void)hipLaunchCooperativeKernel((const void*)mk_fwd, dim3(grid), dim3(NTHREADS), args, LDS_BYTES, stream);
#endif
}
#endif

#if TESTMODE > 0
constexpr int O_A = 1152, O_B = 2304, O_W = 2336, O_AL = 2368, O_G = 2432;
struct HSrc { const bf16_t* HB; const bf16_t* VT;
    DI float at(size_t tok, int n) const { if (n < 768) return bf2f(HB[tok * HW + n]); if (n < 1152) return bf2f(VT[(size_t)(n - 768) * T + tok]); return bf2f(HB[tok * HW + n - 384]); } };
DI float sigm_n(float x) { return 1.f / (1.f + expf(-x)); }

__global__ void k_mod_n(const float* __restrict__ c, const float* __restrict__ w_mod, const float* __restrict__ b_mod, float* __restrict__ mod) {
    __shared__ float sc[NB * D];
    for (int i = threadIdx.x; i < NB * D; i += blockDim.x) { float v = c[i]; sc[i] = v * sigm_n(v); }
    __syncthreads();
    int idx = blockIdx.x * blockDim.x + threadIdx.x; int l = idx / MODW, n = idx % MODW;
    const float* w = w_mod + (size_t)l * D * MODW + n; float a0 = 0.f, a1 = 0.f;
    for (int k = 0; k < D; ++k) { float wv = w[(size_t)k * MODW]; a0 += sc[k] * wv; a1 += sc[D + k] * wv; }
    float bb = b_mod[l * MODW + n];
    mod[(size_t)(l * NB + 0) * MODW + n] = a0 + bb; mod[(size_t)(l * NB + 1) * MODW + n] = a1 + bb;
}
__global__ void k_ln_mod_n(const float* __restrict__ xin, const float* __restrict__ modl, int off_sh, int off_sc, float* __restrict__ uout) {
    int row = (blockIdx.x * blockDim.x + threadIdx.x) >> 6, lane = threadIdx.x & 63; if (row >= T) return; int b = row / S;
    f32x4 v[4];
#pragma unroll
    for (int j = 0; j < 4; ++j) v[j] = *(const f32x4*)(xin + (size_t)row * D + 4 * lane + 256 * j);
    float mean, rstd; row_ln(v, mean, rstd);
    const float* md = modl + (size_t)b * MODW;
#pragma unroll
    for (int j = 0; j < 4; ++j) { int col = 4 * lane + 256 * j; *(f32x4*)(uout + (size_t)row * D + col) = v[j] * rstd * (1.f + *(const f32x4*)(md + off_sc + col)) + *(const f32x4*)(md + off_sh + col); }
}
__global__ void k_post_n(const float* xin, const float* br, const float* __restrict__ modl, int off_gate, const float* __restrict__ gain, const float* __restrict__ bias, float* xout, float* u2out, int off_sh2, int off_sc2) {
    int row = (blockIdx.x * blockDim.x + threadIdx.x) >> 6, lane = threadIdx.x & 63; if (row >= T) return; int b = row / S;
    const float* md = modl + (size_t)b * MODW; f32x4 v[4];
#pragma unroll
    for (int j = 0; j < 4; ++j) { int col = 4 * lane + 256 * j; v[j] = *(const f32x4*)(xin + (size_t)row * D + col) * ALPHA + *(const f32x4*)(md + off_gate + col) * *(const f32x4*)(br + (size_t)row * D + col); }
    float mean, rstd; row_ln(v, mean, rstd);
#pragma unroll
    for (int j = 0; j < 4; ++j) { int col = 4 * lane + 256 * j; v[j] = v[j] * rstd * *(const f32x4*)(gain + col) + *(const f32x4*)(bias + col); *(f32x4*)(xout + (size_t)row * D + col) = v[j]; }
    if (u2out == nullptr) return;
    row_ln(v, mean, rstd);
#pragma unroll
    for (int j = 0; j < 4; ++j) { int col = 4 * lane + 256 * j; *(f32x4*)(u2out + (size_t)row * D + col) = v[j] * rstd * (1.f + *(const f32x4*)(md + off_sc2 + col)) + *(const f32x4*)(md + off_sh2 + col); }
}
__global__ void __launch_bounds__(256) k_gemm_f32(const float* __restrict__ A, int lda, const float* __restrict__ B, int ldb, float* __restrict__ C, int ldc, int K) {
    __shared__ float As[16][65]; __shared__ float Bs[16][64];
    const int tx = threadIdx.x & 15, ty = threadIdx.x >> 4; const int m0 = blockIdx.y * 64, n0 = blockIdx.x * 64;
    float acc[4][4];
#pragma unroll
    for (int i = 0; i < 4; ++i)
#pragma unroll
        for (int j = 0; j < 4; ++j) acc[i][j] = 0.f;
    for (int k0 = 0; k0 < K; k0 += 16) {
#pragma unroll
        for (int i = 0; i < 4; ++i) { int e = threadIdx.x + 256 * i; int m = e >> 4, k = e & 15; As[k][m] = A[(size_t)(m0 + m) * lda + k0 + k]; }
#pragma unroll
        for (int i = 0; i < 4; ++i) { int e = threadIdx.x + 256 * i; int k = e >> 6, n = e & 63; Bs[k][n] = B[(size_t)(k0 + k) * ldb + n0 + n]; }
        __syncthreads();
#pragma unroll
        for (int k = 0; k < 16; ++k) { float a[4], b[4];
#pragma unroll
            for (int i = 0; i < 4; ++i) { a[i] = As[k][ty * 4 + i]; b[i] = Bs[k][tx * 4 + i]; }
#pragma unroll
            for (int i = 0; i < 4; ++i)
#pragma unroll
                for (int j = 0; j < 4; ++j) acc[i][j] += a[i] * b[j]; }
        __syncthreads();
    }
#pragma unroll
    for (int i = 0; i < 4; ++i) *(float4*)(C + (size_t)(m0 + ty * 4 + i) * ldc + n0 + tx * 4) = make_float4(acc[i][0], acc[i][1], acc[i][2], acc[i][3]);
}
__global__ void __launch_bounds__(64) k_attn_n(HSrc h, const float* __restrict__ rpb, float* __restrict__ concat) {
    int idx = blockIdx.x * blockDim.x + threadIdx.x; if (idx >= T * AH) return;
    int head = idx % AH, tok = idx / AH; int b = tok / S, t = tok % S, r = t / GW, cq = t % GW;
    int rstart = r - KH / 2; rstart = rstart < 0 ? 0 : (rstart > ROWS - KH ? ROWS - KH : rstart);
    int cstart = cq - KW / 2; cstart = cstart < 0 ? 0 : (cstart > GW - KW ? GW - KW : cstart);
    float q[HD], acc[HD];
#pragma unroll
    for (int d = 0; d < HD; ++d) { q[d] = h.at(tok, head * HD + d); acc[d] = 0.f; }
    float m = -1e30f, l = 0.f; const float* rp = rpb + (size_t)head * 15 * 31;
    for (int kk = 0; kk < KH; ++kk) { int kr = rstart + kk; int dr = kr - r + (KH - 1);
        for (int j = 0; j < KW; ++j) { int ck = cstart + j; int dc = ck - cq; dc = dc < -15 ? -15 : (dc > 15 ? 15 : dc); dc += 15;
            size_t kt = (size_t)b * S + kr * GW + ck; float s = 0.f;
#pragma unroll
            for (int d = 0; d < HD; ++d) s += q[d] * h.at(kt, AW + head * HD + d);
            s = s * 0.125f + rp[dr * 31 + dc];
            float mn = fmaxf(m, s); float corr = expf(m - mn); float p = expf(s - mn); l = l * corr + p;
#pragma unroll
            for (int d = 0; d < HD; ++d) acc[d] = acc[d] * corr + p * h.at(kt, 2 * AW + head * HD + d);
            m = mn; } }
    float inv = 1.f / l;
#pragma unroll
    for (int d = 0; d < HD; ++d) concat[(size_t)tok * D + head * HD + d] = acc[d] * inv;
}
__global__ void __launch_bounds__(256) k_pool_n(HSrc h, const float* __restrict__ pool_w, const float* __restrict__ pool_scale, float* __restrict__ concat) {
    __shared__ float pooled[CW];
    int tok = blockIdx.x; int b = tok / S, t = tok % S; int ch = threadIdx.x; int g = ch / 64; int win = 2 << g;
    int lo = t - win / 2; lo = lo < 0 ? 0 : lo; int hi = t + win / 2 - 1; hi = hi > S - 1 ? S - 1 : hi;
    float s = 0.f; for (int u = lo; u <= hi; ++u) s += h.at((size_t)b * S + u, O_G + ch);
    pooled[ch] = s / (float)(hi - lo + 1) - h.at(tok, O_G + ch);
    __syncthreads();
    int e = ch % 64; const float* pw = pool_w + (size_t)g * 64 * 64 + e; float a = 0.f;
    for (int c2 = 0; c2 < 64; ++c2) a += pooled[g * 64 + c2] * pw[c2 * 64];
    concat[(size_t)tok * D + AW + BW + ch] = a * pool_scale[ch];
}
__global__ void __launch_bounds__(64) k_rwkv_scan_n(HSrc h, RwP p, float* __restrict__ ys) {
    const int lane = threadIdx.x; const int dir = blockIdx.x / (NB * BH), b = (blockIdx.x / BH) % NB, hd = blockIdx.x % BH; const int ch = hd * HD + lane;
    float st[HD];
#pragma unroll
    for (int j = 0; j < HD; ++j) st[j] = 0.f;
    float wup[RW], aup[RA];
#pragma unroll
    for (int m = 0; m < RW; ++m) { wup[m] = p.w_up[(size_t)(dir * RW + m) * BW + ch]; aup[m] = p.a_up[(size_t)(dir * RA + m) * BW + ch]; }
    const float w0 = p.w0[dir * BW + ch], a0 = p.a0[dir * BW + ch], kkw = p.k_k[ch], kaw = p.k_a[ch];
    float cr[3], ck[3], cv[3];
#pragma unroll
    for (int x = 0; x < 3; ++x) { cr[x] = p.conv[x * 3 * BW + ch]; ck[x] = p.conv[x * 3 * BW + BW + ch]; cv[x] = p.conv[x * 3 * BW + 2 * BW + ch]; }
    for (int step = 0; step < S; ++step) {
        const int t = dir ? (S - 1 - step) : step; const size_t row = (size_t)b * S + t;
        float r = 0.f, k = 0.f, v = 0.f;
#pragma unroll
        for (int x = 0; x < 3; ++x) { int tt = t + x - 1; if (tt >= 0 && tt < S) { size_t rr = (size_t)b * S + tt; r += h.at(rr, O_A + ch) * cr[x]; k += h.at(rr, O_A + BW + ch) * ck[x]; v += h.at(rr, O_A + 2 * BW + ch) * cv[x]; } }
        float lv = h.at(row, O_B + lane); float lt = lane < RW ? tanhf(lv) : lv; float zw = w0, za = a0;
#pragma unroll
        for (int m = 0; m < RW; ++m) { zw += __shfl(lt, m) * wup[m]; za += __shfl(lt, RW + m) * aup[m]; }
        const float w = expf(-DECAY * sigm_n(zw)); const float a = sigm_n(za);
        float kk = k * kkw; float ss = wave_sum(kk * kk); kk = kk * (1.f / sqrtf(fmaxf(ss, 1e-24f)));
        const float kd = k * (1.f + (a - 1.f) * kaw); const float kka = kk * a;
        float sa = 0.f;
#pragma unroll
        for (int j = 0; j < HD; ++j) sa += st[j] * (-__shfl(kk, j));
        float y = 0.f;
#pragma unroll
        for (int j = 0; j < HD; ++j) { st[j] = st[j] * __shfl(w, j) + sa * __shfl(kka, j) + v * __shfl(kd, j); y += st[j] * __shfl(r, j); }
        ys[((size_t)dir * T + b * S + t) * BW + ch] = y;
    }
}
__global__ void __launch_bounds__(384) k_rwkv_finish_n(HSrc h, RwP p, const float* __restrict__ ys, float* __restrict__ concat) {
    __shared__ float lw[RW], la[RA], sg[RG];
    const int tok = blockIdx.x, b = tok / S, t = tok % S, ch = threadIdx.x, hd = ch / HD, j = ch % HD;
    if (ch < RW) lw[ch] = tanhf(h.at(tok, O_B + ch)); else if (ch < RW + RA) la[ch - RW] = h.at(tok, O_W + (ch - RW)); else if (ch < RW + RA + RG) sg[ch - RW - RA] = sigm_n(h.at(tok, O_AL + (ch - RW - RA)));
    __syncthreads();
    float r = 0.f, k = 0.f, v = 0.f;
#pragma unroll
    for (int x = 0; x < 3; ++x) { int tt = t + x - 1; if (tt >= 0 && tt < S) { size_t rr = (size_t)b * S + tt;
        r += h.at(rr, O_A + ch) * p.conv[x * 3 * BW + ch]; k += h.at(rr, O_A + BW + ch) * p.conv[x * 3 * BW + BW + ch]; v += h.at(rr, O_A + 2 * BW + ch) * p.conv[x * 3 * BW + 2 * BW + ch]; } }
    float bon = 0.f;
    for (int dir = 0; dir < 2; ++dir) { float za = p.a0[dir * BW + ch]; for (int m = 0; m < RA; ++m) za += la[m] * p.a_up[(size_t)(dir * RA + m) * BW + ch];
        float a = sigm_n(za); float kd = k * (1.f + (a - 1.f) * p.k_a[ch]); bon += wave_sum(r * kd * p.r_k[hd * HD + j]); }
    bon *= v;
    float y = ys[(size_t)tok * BW + ch] + ys[((size_t)T + tok) * BW + ch];
    float mu = wave_sum(y) * (1.f / HD); float dy = y - mu; float var = wave_sum(dy * dy) * (1.f / HD);
    float yn = dy * (1.f / sqrtf(var + GN_EPS)) * p.gn_gain[ch] + p.gn_bias[ch];
    float g = 0.f; for (int m = 0; m < RG; ++m) g += sg[m] * p.g_up[(size_t)m * BW + ch];
    concat[(size_t)tok * D + AW + ch] = (yn + bon) * g;
}
__global__ void __launch_bounds__(256) k_moe_n(const float* __restrict__ u2, const int* __restrict__ tokslot, const float* __restrict__ ew,
                                                const float* __restrict__ wgate, const float* __restrict__ wup, const float* __restrict__ wdown, float* __restrict__ f) {
    __shared__ float xs[D]; __shared__ float hb[DE];
    const int tok = blockIdx.x, tid = threadIdx.x;
    for (int i = tid; i < D; i += 256) xs[i] = u2[(size_t)tok * D + i];
    float o[4] = {0.f, 0.f, 0.f, 0.f};
    for (int kk = 0; kk < 2; ++kk) {
        const int ts = tokslot[tok * 2 + kk]; const int e = ts >> 14; const float wt = ew[ts];
        __syncthreads();
        const float* g = wgate + (size_t)e * D * DE; const float* u = wup + (size_t)e * D * DE;
        float ag0 = 0.f, ag1 = 0.f, au0 = 0.f, au1 = 0.f;
        for (int k = 0; k < D; ++k) { float x = xs[k]; ag0 += x * g[(size_t)k * DE + tid]; ag1 += x * g[(size_t)k * DE + 256 + tid]; au0 += x * u[(size_t)k * DE + tid]; au1 += x * u[(size_t)k * DE + 256 + tid]; }
        hb[tid] = ag0 * sigm_n(ag0) * au0; hb[256 + tid] = ag1 * sigm_n(ag1) * au1;
        __syncthreads();
        const float* dn = wdown + (size_t)e * DE * D; float a[4] = {0.f, 0.f, 0.f, 0.f};
        for (int k = 0; k < DE; ++k) { float x = hb[k];
#pragma unroll
            for (int j = 0; j < 4; ++j) a[j] += x * dn[(size_t)k * D + tid + 256 * j]; }
#pragma unroll
        for (int j = 0; j < 4; ++j) o[j] += a[j] * wt;
    }
#pragma unroll
    for (int j = 0; j < 4; ++j) f[(size_t)tok * D + tid + 256 * j] = o[j];
}

__global__ void k_router_n(const float* __restrict__ u2, const float* __restrict__ wg, const float* __restrict__ bg, const float* __restrict__ we, const float* __restrict__ be, int* __restrict__ tok_e) {
    int row = (blockIdx.x * blockDim.x + threadIdx.x) >> 6, lane = threadIdx.x & 63; if (row >= T) return;
    float gl[NG], el[NE];
#pragma unroll
    for (int n = 0; n < NG; ++n) gl[n] = 0.f;
#pragma unroll
    for (int n = 0; n < NE; ++n) el[n] = 0.f;
    for (int i = 0; i < 16; ++i) { int k = lane + 64 * i; float x = u2[(size_t)row * D + k];
#pragma unroll
        for (int n = 0; n < NG; ++n) gl[n] += x * wg[k * NG + n];
#pragma unroll
        for (int n = 0; n < NE; ++n) el[n] += x * we[k * NE + n]; }
#pragma unroll
    for (int n = 0; n < NG; ++n) gl[n] = wave_sum(gl[n]) + bg[n];
#pragma unroll
    for (int n = 0; n < NE; ++n) el[n] = wave_sum(el[n]) + be[n];
    int gi = 0; float gm = gl[0];
#pragma unroll
    for (int n = 1; n < NG; ++n) if (gl[n] > gm) { gm = gl[n]; gi = n; }
    float l1 = -3.0e38f, l2 = -3.0e38f; int i1 = 0, i2 = 0;
#pragma unroll
    for (int n = 0; n < NE; ++n) if ((n >> 3) == gi) { float v = el[n]; int e = n & 7; if (v > l1) { l2 = l1; i2 = i1; l1 = v; i1 = e; } else if (v > l2) { l2 = v; i2 = e; } }
    if (lane == 0) { tok_e[row * 2] = gi * EPG + i1; tok_e[row * 2 + 1] = gi * EPG + i2; }
}
__global__ void k_cmp_route(const int* __restrict__ tokslot, const int* __restrict__ tok_e, float* acc, int slot) {
    float mis = 0.f, tot = 0.f;
    for (int t = blockIdx.x * blockDim.x + threadIdx.x; t < T; t += gridDim.x * blockDim.x) { const int a0 = tokslot[2 * t] >> 14, a1 = tokslot[2 * t + 1] >> 14;
        mis += (a0 != tok_e[2 * t] || a1 != tok_e[2 * t + 1]) ? 1.f : 0.f; tot += 1.f; }
    mis = wave_sum(mis); tot = wave_sum(tot);
    if ((threadIdx.x & 63) == 0) { atomicAdd(acc + 2 * slot, mis); atomicAdd(acc + 2 * slot + 1, tot); }
}
__global__ void k_bf2f(const bf16_t* __restrict__ src, float* __restrict__ dst, size_t n) { for (size_t i = (size_t)blockIdx.x * blockDim.x + threadIdx.x; i < n; i += (size_t)gridDim.x * blockDim.x) dst[i] = bf2f(src[i]); }
template <class TA> __global__ void k_cmp(const TA* __restrict__ a, size_t lda, const float* __restrict__ b, size_t ldb, int rows, int cols, float* acc, int slot) {
    float d2 = 0.f, r2 = 0.f;
    for (size_t i = (size_t)blockIdx.x * blockDim.x + threadIdx.x; i < (size_t)rows * cols; i += (size_t)gridDim.x * blockDim.x) {
        const size_t r = i / cols, c = i % cols; float av; if constexpr (sizeof(TA) == 2) av = bf2f(a[r * lda + c]); else av = a[r * lda + c];
        const float bv = b[r * ldb + c]; d2 += (av - bv) * (av - bv); r2 += bv * bv; }
    d2 = wave_sum(d2); r2 = wave_sum(r2);
    if ((threadIdx.x & 63) == 0) { atomicAdd(acc + 2 * slot, d2); atomicAdd(acc + 2 * slot + 1, r2); }
}
__global__ void k_cmp_vt(const bf16_t* __restrict__ vt, const float* __restrict__ b, size_t ldb, float* acc, int slot) {
    float d2 = 0.f, r2 = 0.f;
    for (size_t i = (size_t)blockIdx.x * blockDim.x + threadIdx.x; i < (size_t)T * AW; i += (size_t)gridDim.x * blockDim.x) {
        const size_t r = i % T, c = i / T; const float av = bf2f(vt[c * T + r]), bv = b[r * ldb + c]; d2 += (av - bv) * (av - bv); r2 += bv * bv; }
    d2 = wave_sum(d2); r2 = wave_sum(r2);
    if ((threadIdx.x & 63) == 0) { atomicAdd(acc + 2 * slot, d2); atomicAdd(acc + 2 * slot + 1, r2); }
}
struct Tols { float t[8]; int n; };
__global__ void k_readout(float* out, const float* acc, Tols tl, int total) {
    float mx = 0.f; int am = 0; for (int k = 0; k < tl.n; ++k) { float e = sqrtf(acc[2 * k] / fmaxf(acc[2 * k + 1], 1e-30f)); if (!(e == e)) e = 1e3f; if (e / tl.t[k] > mx) { mx = e / tl.t[k]; am = k; } }
    const float cval = sqrtf(1000.f * mx);
    for (int i = blockIdx.x * blockDim.x + threadIdx.x; i < total; i += gridDim.x * blockDim.x) out[i] = (i < 8) ? 1000.f * (float)(am + 1) : cval;
}
__global__ void __launch_bounds__(256) k_moe_chk(const float* __restrict__ u2, const int* __restrict__ tokslot, const float* __restrict__ ew, const unsigned* __restrict__ cnt,
                                                  const float* __restrict__ wgate, const float* __restrict__ wup, const float* __restrict__ wdown,
                                                  const bf16_t* __restrict__ XS, const bf16_t* __restrict__ HM, const bf16_t* __restrict__ YS, float* acc) {
    __shared__ float xs[D]; __shared__ float hb[DE]; __shared__ int offp[NE];
    const int tok = blockIdx.x, tid = threadIdx.x;
    if (tid == 0) { int off = 0; for (int e = 0; e < NE; ++e) { offp[e] = off; off += (((int)cnt[e] + 255) >> 8) * 256; } }
    for (int i = tid; i < D; i += 256) xs[i] = u2[(size_t)tok * D + i];
    float d0 = 0.f, r0 = 0.f, d1 = 0.f, r1 = 0.f, d2 = 0.f, r2 = 0.f;
    for (int kk = 0; kk < 2; ++kk) {
        __syncthreads();
        const int ts = tokslot[tok * 2 + kk]; const int e = ts >> 14; const float wt = ew[ts]; const size_t slot = (size_t)offp[e] + (ts & 16383);
        for (int i = tid; i < D; i += 256) { const float a = bf2f(XS[slot * D + i]), b = xs[i]; d0 += (a - b) * (a - b); r0 += b * b; }
        const float* g = wgate + (size_t)e * D * DE; const float* u = wup + (size_t)e * D * DE;
        float ag0 = 0.f, ag1 = 0.f, au0 = 0.f, au1 = 0.f;
        for (int k = 0; k < D; ++k) { float x = xs[k]; ag0 += x * g[(size_t)k * DE + tid]; ag1 += x * g[(size_t)k * DE + 256 + tid]; au0 += x * u[(size_t)k * DE + tid]; au1 += x * u[(size_t)k * DE + 256 + tid]; }
        const float h0 = ag0 * sigm_n(ag0) * au0, h1 = ag1 * sigm_n(ag1) * au1;
        hb[tid] = h0; hb[256 + tid] = h1;
        { const float a = bf2f(HM[slot * DE + tid]), b = bf2f(HM[slot * DE + 256 + tid]); d1 += (a - h0) * (a - h0) + (b - h1) * (b - h1); r1 += h0 * h0 + h1 * h1; }
        __syncthreads();
        const float* dn = wdown + (size_t)e * DE * D; float a4[4] = {0.f, 0.f, 0.f, 0.f};
        for (int k = 0; k < DE; ++k) { float x = hb[k];
#pragma unroll
            for (int j = 0; j < 4; ++j) a4[j] += x * dn[(size_t)k * D + tid + 256 * j]; }
#pragma unroll
        for (int j = 0; j < 4; ++j) {
#ifdef MOEB_NOSCALE
            const float y = a4[j];
#else
            const float y = a4[j] * wt;
#endif
            const float a = bf2f(YS[slot * D + tid + 256 * j]); d2 += (a - y) * (a - y); r2 += y * y; }
    }
    d0 = wave_sum(d0); r0 = wave_sum(r0); d1 = wave_sum(d1); r1 = wave_sum(r1); d2 = wave_sum(d2); r2 = wave_sum(r2);
    if ((tid & 63) == 0) { atomicAdd(acc + 0, d0); atomicAdd(acc + 1, r0); atomicAdd(acc + 2, d1); atomicAdd(acc + 3, r1); atomicAdd(acc + 4, d2); atomicAdd(acc + 5, r2); }
}

extern "C" void kernel_launch(void* const* d_in, const int* in_sizes, int n_in, void* d_out, int out_size, void* d_ws, size_t ws_size, hipStream_t stream) {
    static int once = 0; if (!once) { (void)hipFuncSetAttribute((const void*)mk_fwd, hipFuncAttributeMaxDynamicSharedMemorySize, LDS_BYTES); once = 1; }
    (void)hipMemsetAsync((char*)d_ws + WS_CTL, 0, CTL_BYTES, stream);
    Args a{}; fill_args(a, d_in, d_out, d_ws);
    char* ws = (char*)d_ws; float* out = (float*)d_out;
    float* ACC = (float*)(ws + 32768 + 1024);
    const float* x = a.in[0];
    HSrc hs{(const bf16_t*)(ws + WS_HB), (const bf16_t*)(ws + WS_VT)};
    const int l = 0;
    RwP p = { a.in[6], a.in[7], a.in[8], a.in[9], a.in[10], a.in[11], a.in[12], a.in[13], a.in[14], a.in[15], a.in[16] };
    Tols tl{};
#if TESTMODE == 1
    launch_phases(a, 0, 3, stream);
    float* MODn = (float*)(ws + WS_MOD + 512 * 1024); float* Un = (float*)(ws + WS_XA); float* HF = (float*)(ws + WS_CONCAT);
    k_mod_n<<<L * MODW / 256, 256, 0, stream>>>(a.in[1], a.in[2], a.in[3], MODn);
    k_ln_mod_n<<<T / 4, 256, 0, stream>>>(x, MODn, 0, D, Un);
    k_gemm_f32<<<dim3(INW / 64, T / 64), 256, 0, stream>>>(Un, D, a.in[4], INW, HF, INW, D);
    k_cmp<float><<<256, 256, 0, stream>>>((const float*)(ws + WS_MOD), MODW, MODn, MODW, L * NB, MODW, ACC, 0);
    k_cmp<bf16_t><<<1024, 256, 0, stream>>>((const bf16_t*)(ws + WS_U), D, Un, D, T, D, ACC, 1);
    k_cmp<bf16_t><<<1024, 256, 0, stream>>>((const bf16_t*)(ws + WS_HB), HW, HF, INW, T, 768, ACC, 2);
    k_cmp<bf16_t><<<1024, 256, 0, stream>>>((const bf16_t*)(ws + WS_HB) + 768, HW, HF + 1152, INW, T, 1536, ACC, 3);
    k_cmp_vt<<<1024, 256, 0, stream>>>((const bf16_t*)(ws + WS_VT), HF + 768, INW, ACC, 4);
    tl.n = 5; tl.t[0] = 1e-5f; tl.t[1] = 4e-3f; tl.t[2] = 6e-3f; tl.t[3] = 6e-3f; tl.t[4] = 6e-3f;
#elif TESTMODE == 2
    launch_phases(a, 0, 4, stream);
    float* CCn = (float*)(ws + WS_XA); float* YSn = (float*)(ws + WS_WGU);
    k_attn_n<<<T * AH / 64, 64, 0, stream>>>(hs, a.in[5], CCn);
    k_pool_n<<<T, 256, 0, stream>>>(hs, a.in[17], a.in[18], CCn);
    k_rwkv_scan_n<<<2 * NB * BH, 64, 0, stream>>>(hs, p, YSn);
    k_rwkv_finish_n<<<T, 384, 0, stream>>>(hs, p, YSn, CCn);
    launch_phases(a, 4, 6, stream);
    k_cmp<bf16_t><<<1024, 256, 0, stream>>>((const bf16_t*)(ws + WS_CONCAT), D, CCn, D, T, AW, ACC, 0);
    k_cmp<bf16_t><<<1024, 256, 0, stream>>>((const bf16_t*)(ws + WS_CONCAT) + AW, D, CCn + AW, D, T, BW, ACC, 1);
    k_cmp<bf16_t><<<1024, 256, 0, stream>>>((const bf16_t*)(ws + WS_CONCAT) + AW + BW, D, CCn + AW + BW, D, T, CW, ACC, 2);
    tl.n = 3; tl.t[0] = TOL0; tl.t[1] = TOL1; tl.t[2] = TOL2;
#elif TESTMODE == 3
    launch_phases(a, 0, 11, stream);
    { const float* MODf = (const float*)(ws + WS_MOD);
      float* U2f = (float*)(ws + 414 * MiB); float* Fn = (float*)(ws + 213 * MiB); float* X2n = (float*)(ws + 277 * MiB);
      k_bf2f<<<2048, 256, 0, stream>>>((const bf16_t*)(ws + WS_U), U2f, (size_t)T * D);
      launch_phases(a, 11, 12, stream);
      k_moe_n<<<T, 256, 0, stream>>>(U2f, (const int*)(ws + WS_TOKSLOT), (const float*)(ws + WS_EW), a.in[28], a.in[29], a.in[30], Fn);
      k_post_n<<<T / 4, 256, 0, stream>>>((const float*)(ws + WS_XA), Fn, MODf, 5 * D, a.in[22], a.in[23], X2n, nullptr, 0, 0);
      k_cmp<float><<<1024, 256, 0, stream>>>(out, D, X2n, D, T, D, ACC, 0); }
    tl.n = 1; tl.t[0] = TOL0;
#elif TESTMODE == 4
    launch_phases(a, 0, 8, stream);
    { const float* MODf = (const float*)(ws + WS_MOD);
      float* CCn = (float*)(ws + 405 * MiB); float* MIXn = (float*)(ws + 213 * MiB); float* X1n = (float*)(ws + 21 * MiB); float* U2n = (float*)(ws + 333 * MiB); int* TEn = (int*)(ws + 490 * MiB);
      k_bf2f<<<2048, 256, 0, stream>>>((const bf16_t*)(ws + WS_CONCAT), CCn, (size_t)T * D);
      k_gemm_f32<<<dim3(D / 64, T / 64), 256, 0, stream>>>(CCn, D, a.in[19], D, MIXn, D, D);
      k_post_n<<<T / 4, 256, 0, stream>>>(x, MIXn, MODf, 2 * D, a.in[20], a.in[21], X1n, U2n, 3 * D, 4 * D);
      k_router_n<<<T / 4, 256, 0, stream>>>(U2n, a.in[24], a.in[25], a.in[26], a.in[27], TEn);
      k_cmp<float><<<1024, 256, 0, stream>>>((const float*)(ws + WS_XA), D, X1n, D, T, D, ACC, 0);
      k_cmp<bf16_t><<<1024, 256, 0, stream>>>((const bf16_t*)(ws + WS_U), D, U2n, D, T, D, ACC, 1);
      k_cmp_route<<<64, 256, 0, stream>>>((const int*)(ws + WS_TOKSLOT), TEn, ACC, 2); }
    tl.n = 3; tl.t[0] = TOL0; tl.t[1] = TOL1; tl.t[2] = TOL2;
#elif TESTMODE == 5
    launch_phases(a, 0, 11, stream);
    { float* U2f = (float*)(ws + 414 * MiB);
      k_bf2f<<<2048, 256, 0, stream>>>((const bf16_t*)(ws + WS_U), U2f, (size_t)T * D);
      k_moe_chk<<<T, 256, 0, stream>>>(U2f, (const int*)(ws + WS_TOKSLOT), (const float*)(ws + WS_EW), (const unsigned*)(ws + WS_CTL) + CW_CNT, a.in[28], a.in[29], a.in[30],
                                       (const bf16_t*)(ws + WS_XS), (const bf16_t*)(ws + WS_HM), (const bf16_t*)(ws + WS_YS), ACC); }
    tl.n = 3; tl.t[0] = 1e-6f; tl.t[1] = 1e-2f; tl.t[2] = 1e-2f;
#endif
    k_readout<<<256, 256, 0, stream>>>(out, ACC, tl, out_size);
}
#endif
```

```cpp
#define TESTMODE 0
#define MK_MODE 0
#include <hip/hip_runtime.h>
#include <hip/hip_cooperative_groups.h>
#include <stdint.h>
namespace cg = cooperative_groups;

#ifndef TESTMODE
#define TESTMODE 0
#endif
#define DI __device__ __forceinline__
#define LAS __attribute__((address_space(3)))
typedef unsigned short bf16_t;
typedef short bf16x8 __attribute__((ext_vector_type(8)));
typedef float f32x4 __attribute__((ext_vector_type(4)));
typedef float f32x16 __attribute__((ext_vector_type(16)));
typedef unsigned u32x4 __attribute__((ext_vector_type(4)));
typedef unsigned u32x2 __attribute__((ext_vector_type(2)));
typedef float f32x2_t __attribute__((ext_vector_type(2)));
typedef __bf16 bf16x2_t __attribute__((ext_vector_type(2)));

namespace cfg {
constexpr int D = 1024, NB = 2, S = 8192, T = NB * S, L = 2;
constexpr int GW = 64, ROWS = 128;
constexpr int HD = 64, AW = 384, BW = 384, CW = 256, AH = 6, BH = 6;
constexpr int KH = 8, KW = 16;
constexpr int RW = 32, RA = 32, RG = 64;
constexpr int INW = 2688;
constexpr int NG = 4, EPG = 8, NE = 32, DE = 512;
constexpr int MODW = 6 * D;
constexpr float ALPHA = 1.41421356237309515f;
constexpr float LN_EPS = 1e-5f, GN_EPS = 64e-5f;
constexpr float DECAY = 0.60653065971263342f;
constexpr float LOG2E = 1.44269504088896341f;
constexpr int HW = 2304, HQ = 0, HK = 384, HR = 768, HWL = 1920, HAL = 1952, HGL = 1984, HP = 2048;
constexpr int NCH = S / 64;
constexpr int NUNIT = 2 * NB * BH * NCH;
constexpr int XSROWS = 2 * T + NE * 256;
}
using namespace cfg;

constexpr size_t MiB = 1u << 20;
constexpr size_t WS_CTL = 0;
constexpr size_t CTL_BYTES = 65536;
constexpr int CW_BAR = 0;
constexpr int CW_CNT = 8192;
constexpr size_t WS_MOD = 1 * MiB;
constexpr size_t WS_TOKSLOT = 1 * MiB + 128 * 1024;
constexpr size_t WS_SLOTW = 1 * MiB + 256 * 1024;
constexpr size_t WS_BC = 2 * MiB;
constexpr size_t WS_TOKW = 2 * MiB + 64 * 1024;
constexpr size_t WS_TOKFIN = 2 * MiB + 256 * 1024;
constexpr size_t WS_CNTF = 2 * MiB + 512 * 1024;
constexpr size_t WS_WIN = 6 * MiB;
constexpr size_t WIN_LAYER = (size_t)2816 * 1024 * 2;
constexpr size_t WS_WOUT = 17 * MiB;
constexpr size_t WS_WGU = 21 * MiB;
constexpr size_t WS_WD = 85 * MiB;
constexpr size_t WS_XA = 117 * MiB;
constexpr size_t WS_U = 181 * MiB;
constexpr size_t WS_HB = 213 * MiB;
constexpr size_t WS_S0 = 213 * MiB;
constexpr size_t WS_VT = 285 * MiB;
constexpr size_t WS_CONCAT = 301 * MiB;
constexpr size_t WS_MP = 333 * MiB;
constexpr size_t WS_NB = 357 * MiB;
constexpr size_t WS_MIX = 333 * MiB;
constexpr size_t WS_QT = 405 * MiB;
constexpr size_t WS_WT = 429 * MiB;
constexpr size_t WS_VTB = 453 * MiB;
constexpr size_t WS_GB = 465 * MiB;
constexpr size_t WS_VC = 477 * MiB;
constexpr size_t WS_BS = 489 * MiB;
constexpr size_t WS_XS = 213 * MiB;
constexpr size_t WS_HM = 293 * MiB;
constexpr size_t WS_YS = 333 * MiB;
constexpr size_t WS_END = 490 * MiB;

constexpr int NWAVES = 8, NTHREADS = 512;
constexpr int LDS_BYTES = 156 * 1024;

DI unsigned cvtpk(float lo, float hi) { f32x2_t v = {lo, hi}; bf16x2_t b = __builtin_convertvector(v, bf16x2_t); return __builtin_bit_cast(unsigned, b); }
DI float bflo(unsigned w) { return __uint_as_float(w << 16); }
DI float bfhi(unsigned w) { return __uint_as_float(w & 0xffff0000u); }
DI float bf2f(unsigned short h) { return __uint_as_float((unsigned)h << 16); }
DI unsigned short f2bf(float f) { return (unsigned short)(cvtpk(f, 0.f) & 0xffffu); }
DI float wave_sum_shfl(float v) {
#pragma unroll
    for (int o = 32; o > 0; o >>= 1) v += __shfl_xor(v, o);
    return v;
}
template <int CTRL, int ROWMASK> DI float dpp_add(float v) { return v + __builtin_bit_cast(float, __builtin_amdgcn_update_dpp(0, __builtin_bit_cast(int, v), CTRL, ROWMASK, 0xf, false)); }
DI float wave_sum(float v) {
    v = dpp_add<0xb1, 0xf>(v);
    v = dpp_add<0x4e, 0xf>(v);
    v = dpp_add<0x124, 0xf>(v);
    v = dpp_add<0x128, 0xf>(v);
    v = dpp_add<0x142, 0xa>(v);
    v = dpp_add<0x143, 0xc>(v);
    return __builtin_bit_cast(float, __builtin_amdgcn_readlane(__builtin_bit_cast(int, v), 63));
}
DI float fexp2(float x) { return __builtin_amdgcn_exp2f(x); }
DI float frcp(float x) { return __builtin_amdgcn_rcpf(x); }
DI float sigm(float x) { return frcp(1.f + fexp2(x * -LOG2E)); }
#define LDS_WAIT() asm volatile("s_waitcnt lgkmcnt(0)" ::: "memory")
#define VM_WAIT() asm volatile("s_waitcnt vmcnt(0)" ::: "memory")
DI int swap23(int i) { return (i & ~12) | ((i & 4) << 1) | ((i & 8) >> 1); }

namespace pg8 {
constexpr int BM = 256, BK = 64, HALF = 128, HTB = HALF * BK * 2, STAGE_BYTES = 8 * HTB, NXCD = 8, WGM = 8;
__host__ __device__ __forceinline__ int lds_byte(int r, int c) { const int st = (r >> 4) * 2 + (c >> 5), rr = r & 15, cc = c & 31, ob = rr * 64 + cc * 2; return st * 1024 + (ob ^ (((ob >> 9) & 1) << 5)); }
__host__ __device__ __forceinline__ void stage_rc(int b, int& R, int& C) { const int st = b / 1024, sb = b % 1024, swz = sb ^ (((sb >> 9) & 1) << 5); R = (st >> 1) * 16 + swz / 64; C = (st & 1) * 32 + (swz % 64) / 2; }
__host__ __device__ __forceinline__ int perm32(int rho) { const int n = rho >> 4, i = rho & 15; return 8 * (i >> 2) + 4 * n + (i & 3); }

struct Unit { int pm, pn, aux; };

DI int xcd_remap(int L, int nwg) { const int q = nwg / NXCD, r = nwg % NXCD, xcd = L % NXCD, off = L / NXCD; return (xcd < r ? xcd * (q + 1) : r * (q + 1) + (xcd - r) * q) + off; }

struct PlainOrder {
    const bf16_t* A; const bf16_t* Bt; int K; int nM, nN, nwg, G, c;
    DI void init(const bf16_t* A_, const bf16_t* Bt_, int M, int N, int K_, int G_, int c_) { A = A_; Bt = Bt_; K = K_; nM = M / BM; nN = N / BM; nwg = nM * nN; G = G_; c = c_; }
    DI bool next(int i, Unit& u) const {
        const int Lx = i * G + c; if (Lx >= nwg) return false;
        const int wgid = xcd_remap(Lx, nwg);
        const int nig = WGM * nN, gid = wgid / nig, fm = gid * WGM, gsz = (nM - fm) < WGM ? (nM - fm) : WGM;
        u.pm = fm + ((wgid % nig) % gsz); u.pn = (wgid % nig) / gsz; u.aux = 0; return true;
    }
    DI const char* aptr(const Unit& u) const { return (const char*)A + (size_t)u.pm * (2 * HALF) * K * 2; }
    DI const char* bptr(const Unit& u) const { return (const char*)Bt + (size_t)u.pn * (2 * HALF) * K * 2; }
};
struct Gemm1Order {
    const bf16_t* U; const bf16_t* Win; const bf16_t* Wv; int G, c;
    static constexpr int nM = T / BM, nN = HW / BM, nMain = nM * nN, nV = 2 * (T / BM), nwg = nMain + nV, K = D;
    DI bool next(int i, Unit& u) const {
        const int Lx = i * G + c; if (Lx >= nwg) return false;
        if (Lx < nMain) {
            const int wgid = xcd_remap(Lx, nMain);
            const int nig = WGM * nN, gid = wgid / nig, fm = gid * WGM, gsz = (nM - fm) < WGM ? (nM - fm) : WGM;
            u.pm = fm + ((wgid % nig) % gsz); u.pn = (wgid % nig) / gsz; u.aux = 0;
        } else { const int v = Lx - nMain; u.pm = v & 1; u.pn = v >> 1; u.aux = 1; }
        return true;
    }
    DI const char* aptr(const Unit& u) const { return (const char*)(u.aux ? Wv : U) + (size_t)u.pm * BM * K * 2; }
    DI const char* bptr(const Unit& u) const { return (const char*)(u.aux ? U : Win) + (size_t)u.pn * BM * K * 2; }
};
struct GroupedOrder {
    const bf16_t* A; const bf16_t* Bt; int K; size_t estride; const LAS int* tile_e; int ntiles, nwg, G, c;
    DI bool next(int i, Unit& u) const {
        const int Lx = i * G + c; if (Lx >= nwg) return false;
        const int wgid = xcd_remap(Lx, nwg);
        u.pm = wgid >> 2; u.pn = wgid & 3; u.aux = tile_e[u.pm]; return true;
    }
    DI const char* aptr(const Unit& u) const { return (const char*)A + (size_t)u.pm * BM * K * 2; }
    DI const char* bptr(const Unit& u) const { return (const char*)Bt + ((size_t)u.aux * estride + (size_t)u.pn * BM * K) * 2; }
};

struct EpiStore {
    bf16_t* O0; int ld0; bf16_t* O1; int ld1;
    DI void operator()(const f32x4 (&acc)[2][2][4][2], const Unit& u, int wr, int wc, int fr, int fq) const {
        bf16_t* base = u.aux ? O1 : O0; const int ldc = u.aux ? ld1 : ld0;
        const int row0 = u.pm * BM + wr * 64 + fr, col0 = u.pn * BM + wc * 32 + 8 * fq;
#pragma unroll
        for (int ai = 0; ai < 2; ++ai)
#pragma unroll
            for (int m = 0; m < 4; ++m) { bf16_t* rowp = base + (size_t)(row0 + ai * HALF + m * 16) * ldc + col0;
#pragma unroll
                for (int bj = 0; bj < 2; ++bj) { const f32x4 v0 = acc[ai][bj][m][0], v1 = acc[ai][bj][m][1];
                    u32x4 w; w.x = cvtpk(v0[0], v0[1]); w.y = cvtpk(v0[2], v0[3]); w.z = cvtpk(v1[0], v1[1]); w.w = cvtpk(v1[2], v1[3]);
                    *(u32x4*)(rowp + bj * HALF) = w; } }
    }
};
struct EpiSwiGlu {
    bf16_t* O;
    DI void operator()(const f32x4 (&acc)[2][2][4][2], const Unit& u, int wr, int wc, int fr, int fq) const {
        const int row0 = u.pm * BM + wr * 64 + fr, col0 = u.pn * HALF + wc * 32 + 8 * fq;
#pragma unroll
        for (int ai = 0; ai < 2; ++ai)
#pragma unroll
            for (int m = 0; m < 4; ++m) { bf16_t* rowp = O + (size_t)(row0 + ai * HALF + m * 16) * DE + col0;
                float hv[8];
#pragma unroll
                for (int n = 0; n < 2; ++n)
#pragma unroll
                    for (int e = 0; e < 4; ++e) { const float g = acc[ai][0][m][n][e], up = acc[ai][1][m][n][e]; hv[4 * n + e] = g * sigm(g) * up; }
                u32x4 w; w.x = cvtpk(hv[0], hv[1]); w.y = cvtpk(hv[2], hv[3]); w.z = cvtpk(hv[4], hv[5]); w.w = cvtpk(hv[6], hv[7]);
                *(u32x4*)rowp = w; }
    }
};
struct EpiRowScale {
    bf16_t* O; const float* roww;
    DI void operator()(const f32x4 (&acc)[2][2][4][2], const Unit& u, int wr, int wc, int fr, int fq) const {
        const int row0 = u.pm * BM + wr * 64 + fr, col0 = u.pn * BM + wc * 32 + 8 * fq;
#pragma unroll
        for (int ai = 0; ai < 2; ++ai)
#pragma unroll
            for (int m = 0; m < 4; ++m) { const int row = row0 + ai * HALF + m * 16;
#ifdef MOEB_NOSCALE
                const float s = 1.f;
#else
                const float s = roww[row];
#endif
                bf16_t* rowp = O + (size_t)row * D + col0;
#pragma unroll
                for (int bj = 0; bj < 2; ++bj) { const f32x4 v0 = acc[ai][bj][m][0] * s, v1 = acc[ai][bj][m][1] * s;
                    u32x4 w; w.x = cvtpk(v0[0], v0[1]); w.y = cvtpk(v0[2], v0[3]); w.z = cvtpk(v1[0], v1[1]); w.w = cvtpk(v1[2], v1[3]);
                    *(u32x4*)(rowp + bj * HALF) = w; } }
    }
};

template <class Epi, class Sched>
DI void gemm_phase(LAS unsigned char* lds, const int tid, const int K, const Sched& S, const Epi& E) {
    const int wid = __builtin_amdgcn_readfirstlane(tid >> 6), lane = tid & 63, wr = wid >> 2, wc = wid & 3, fr = lane & 15, fq = lane >> 4;
    const int nt = K / BK;
    unsigned voffA[2], voffB[2];
#pragma unroll
    for (int i = 0; i < 2; ++i) { int R, C; stage_rc(tid * 16 + i * 8192, R, C); const int Rb = (R & ~31) + perm32(R & 31);
        voffA[i] = (unsigned)(R * K + C) * 2u; voffB[i] = (unsigned)(Rb * K + C) * 2u; }
    const size_t kstep = (size_t)(BK * 2);
    const size_t hstep = (size_t)HALF * K * 2;
    const unsigned ldsw = (unsigned)wid * 1024u;
    const int aoff = lds_byte(wr * 64 + fr, fq * 8), boff = lds_byte(wc * 32 + fr, fq * 8);
#define PG8_SA(b, h) (((b) * 2 + (h)) * HTB)
#define PG8_SB(b, h) ((4 + (b) * 2 + (h)) * HTB)
#define PG8_STAGE(bufoff, gbase, voff) do { _Pragma("unroll") for (int _i = 0; _i < 2; ++_i) \
        __builtin_amdgcn_global_load_lds((const unsigned*)((const char*)(gbase) + (voff)[_i]), (LAS unsigned*)(lds + (bufoff) + ldsw + _i * 8192), 16, 0, 0); } while (0)
#define PG8_LDA(dst, b, h) do { _Pragma("unroll") for (int m = 0; m < 4; ++m) _Pragma("unroll") for (int k = 0; k < 2; ++k) dst[m][k] = *(const LAS bf16x8*)(lds + PG8_SA(b, h) + aoff + m * 2048 + k * 1024); } while (0)
#define PG8_LDB(dst, b, h) do { _Pragma("unroll") for (int n = 0; n < 2; ++n) _Pragma("unroll") for (int k = 0; k < 2; ++k) dst[n][k] = *(const LAS bf16x8*)(lds + PG8_SB(b, h) + boff + n * 2048 + k * 1024); } while (0)
#define PG8_MMA(ai, bj, At, Bt) do { __builtin_amdgcn_s_setprio(1); _Pragma("unroll") for (int m = 0; m < 4; ++m) _Pragma("unroll") for (int n = 0; n < 2; ++n) _Pragma("unroll") for (int k = 0; k < 2; ++k) \
        acc[ai][bj][m][n] = __builtin_amdgcn_mfma_f32_16x16x32_bf16(Bt[n][k], At[m][k], acc[ai][bj][m][n], 0, 0, 0); __builtin_amdgcn_s_setprio(0); } while (0)
#define PG8_WAIT_V(n) asm volatile("s_waitcnt vmcnt(" #n ")" ::: "memory")
#define PG8_WAIT_L(n) asm volatile("s_waitcnt lgkmcnt(" #n ")" ::: "memory")
#define PG8_BAR __builtin_amdgcn_s_barrier()
#define PG8_SCHED __builtin_amdgcn_sched_barrier(0)
    Unit cur, nxt; int ui = 0;
    if (!S.next(0, cur)) return;
    f32x4 acc[2][2][4][2];
#pragma unroll
    for (int a = 0; a < 2; ++a)
#pragma unroll
        for (int b = 0; b < 2; ++b)
#pragma unroll
            for (int m = 0; m < 4; ++m)
#pragma unroll
                for (int n = 0; n < 2; ++n) acc[a][b][m][n] = (f32x4){0.f, 0.f, 0.f, 0.f};
    bf16x8 At[4][2], B0[2][2], B1[2][2];
    const char* cA = S.aptr(cur); const char* cB = S.bptr(cur);
    PG8_STAGE(PG8_SB(0, 0), cB, voffB); PG8_STAGE(PG8_SB(0, 1), cB + hstep, voffB); PG8_STAGE(PG8_SA(0, 0), cA, voffA); PG8_STAGE(PG8_SA(0, 1), cA + hstep, voffA);
    if (wr == 1) PG8_BAR;
    PG8_WAIT_V(2); PG8_BAR;
    PG8_STAGE(PG8_SB(1, 0), cB + kstep, voffB); PG8_STAGE(PG8_SA(1, 0), cA + kstep, voffA); PG8_STAGE(PG8_SB(1, 1), cB + hstep + kstep, voffB);
    PG8_WAIT_V(6); PG8_BAR;
    for (;;) {
        const bool has_next = S.next(ui + 1, nxt);
        const char* nA = has_next ? S.aptr(nxt) : cA; const char* nB = has_next ? S.bptr(nxt) : cB;
        for (int t = 0; t < nt; t += 2) {
            const bool last = (t == nt - 2);
            const char* a1 = cA + (size_t)(t + 1) * kstep;
            const char* a2 = last ? nA : cA + (size_t)(t + 2) * kstep; const char* b2 = last ? nB : cB + (size_t)(t + 2) * kstep;
            const char* a3 = a2 + kstep; const char* b3 = b2 + kstep;
            PG8_LDB(B0, 0, 0); PG8_LDB(B1, 0, 1); PG8_SCHED; PG8_LDA(At, 0, 0); PG8_STAGE(PG8_SA(1, 1), a1 + hstep, voffA);
            PG8_WAIT_V(8); PG8_WAIT_L(0); PG8_BAR; PG8_MMA(0, 0, At, B0); PG8_MMA(0, 1, At, B1); PG8_BAR; PG8_SCHED;
            PG8_LDA(At, 0, 1); PG8_STAGE(PG8_SB(0, 0), b2, voffB); PG8_STAGE(PG8_SB(0, 1), b2 + hstep, voffB); PG8_STAGE(PG8_SA(0, 0), a2, voffA);
            PG8_WAIT_V(8); PG8_WAIT_L(0); PG8_BAR; PG8_MMA(1, 0, At, B0); PG8_MMA(1, 1, At, B1); PG8_BAR; PG8_SCHED;
            PG8_LDB(B0, 1, 0); PG8_LDB(B1, 1, 1); PG8_SCHED; PG8_LDA(At, 1, 0); PG8_STAGE(PG8_SA(0, 1), a2 + hstep, voffA);
            PG8_WAIT_V(8); PG8_WAIT_L(0); PG8_BAR; PG8_MMA(0, 0, At, B0); PG8_MMA(0, 1, At, B1); PG8_BAR; PG8_SCHED;
            PG8_LDA(At, 1, 1); PG8_STAGE(PG8_SB(1, 0), b3, voffB); PG8_STAGE(PG8_SB(1, 1), b3 + hstep, voffB); PG8_STAGE(PG8_SA(1, 0), a3, voffA);
            PG8_WAIT_V(8); PG8_WAIT_L(0); PG8_BAR; PG8_MMA(1, 0, At, B0); PG8_MMA(1, 1, At, B1); PG8_BAR; PG8_SCHED;
        }
        if (wr == 0) PG8_BAR;
        E(acc, cur, wr, wc, fr, fq);
        if (!has_next) break;
#pragma unroll
        for (int a = 0; a < 2; ++a)
#pragma unroll
            for (int b = 0; b < 2; ++b)
#pragma unroll
                for (int m = 0; m < 4; ++m)
#pragma unroll
                    for (int n = 0; n < 2; ++n) acc[a][b][m][n] = (f32x4){0.f, 0.f, 0.f, 0.f};
        cur = nxt; cA = nA; cB = nB; ++ui;
        if (wr == 1) PG8_BAR;
    }
    PG8_WAIT_V(0);
    PG8_BAR;
#undef PG8_SA
#undef PG8_SB
#undef PG8_STAGE
#undef PG8_LDA
#undef PG8_LDB
#undef PG8_MMA
#undef PG8_WAIT_V
#undef PG8_WAIT_L
#undef PG8_BAR
#undef PG8_SCHED
}
}

#define XB_TMO      128
#define XB_XCNT(j)  (256  + 64 * (j))
#define XB_XSUB(j)  (1280 + 64 * (j))
#define XB_XGEN(j)  (2304 + 64 * (j))
#define XB_TOP      3328
#define XB_TOPGEN   3392
#define XCD_BAR_WORDS 3456
#define XB_SPIN_CAP (1u << 20)
DI unsigned xb_ld(unsigned* p)              { return __hip_atomic_load(p, __ATOMIC_RELAXED, __HIP_MEMORY_SCOPE_AGENT); }
DI unsigned xb_add(unsigned* p, unsigned v) { return __hip_atomic_fetch_add(p, v, __ATOMIC_RELAXED, __HIP_MEMORY_SCOPE_AGENT); }
DI unsigned xb_xcc_id() { return (unsigned)__builtin_amdgcn_s_getreg((3 << 11) | 20) & 0xFu; }
#define XB_SPIN(cond, bar) do { unsigned _sp = 0; while (cond) { __builtin_amdgcn_s_sleep(1); \
    if ((++_sp & 255u) == 0u) { if (xb_ld(&(bar)[XB_TMO])) break; if (_sp > XB_SPIN_CAP) { atomicAdd(&(bar)[XB_TMO], 1u); break; } } } } while (0)
struct XcdBarrier { unsigned* bar; unsigned x; volatile LAS unsigned* st; };
DI XcdBarrier xcd_barrier_post(unsigned* bar, volatile LAS unsigned* st) {
    XcdBarrier b; b.bar = bar; b.x = xb_xcc_id(); b.st = st;
    if (threadIdx.x == 0) (void)xb_add(&bar[XB_XCNT(b.x)], 1u);
    return b;
}
DI void xcd_barrier_complete(unsigned* bar, unsigned x, unsigned& nloc, unsigned& nx) {
    const unsigned G = gridDim.x * gridDim.y * gridDim.z;
    unsigned sum, cnt, mine, sp = 0u;
    for (;;) {
        sum = 0u; cnt = 0u; mine = 0u;
#pragma unroll
        for (unsigned j = 0; j < 16; ++j) { const unsigned c = xb_ld(&bar[XB_XCNT(j)]); sum += c; cnt += (c > 0u) ? 1u : 0u; mine = (j == x) ? c : mine; }
        if (sum == G) break;
        __builtin_amdgcn_s_sleep(1);
        if ((++sp & 255u) == 0u) { if (xb_ld(&bar[XB_TMO])) break; if (sp > XB_SPIN_CAP) { atomicAdd(&bar[XB_TMO], 1u); break; } }
    }
    nloc = mine > 0u ? mine : 1u; nx = cnt > 0u ? cnt : 1u;
}
DI void xcd_barrier(const XcdBarrier& b) {
    asm volatile("s_waitcnt vmcnt(0)" ::: "memory");
    __syncthreads();
    if (threadIdx.x == 0) {
        unsigned* bar = b.bar;
        __builtin_amdgcn_s_waitcnt(0);
        unsigned nloc = b.st[0], nx = b.st[1];
        if (nloc == 0u) { xcd_barrier_complete(bar, b.x, nloc, nx); b.st[0] = nloc; b.st[1] = nx; }
        const unsigned old = xb_add(&bar[XB_XSUB(b.x)], 1u);
        const unsigned gen = old / nloc;
        if (old + 1u == (gen + 1u) * nloc) {
            __builtin_amdgcn_fence(__ATOMIC_RELEASE, "agent");
            asm volatile("s_waitcnt vmcnt(0)" ::: "memory");
            const unsigned og = xb_add(&bar[XB_TOP], 1u);
            const unsigned tg = og / nx;
            if (og + 1u == (tg + 1u) * nx) xb_add(&bar[XB_TOPGEN], 1u);
            else XB_SPIN(xb_ld(&bar[XB_TOPGEN]) == tg, bar);
            __builtin_amdgcn_fence(__ATOMIC_ACQUIRE, "agent");
            xb_add(&bar[XB_XGEN(b.x)], 1u);
            asm volatile("s_waitcnt vmcnt(0)" ::: "memory");
        } else {
            XB_SPIN(xb_ld(&bar[XB_XGEN(b.x)]) == gen, bar);
            __builtin_amdgcn_fence(__ATOMIC_ACQUIRE, "agent");
            asm volatile("s_waitcnt vmcnt(0)" ::: "memory");
        }
    }
    __syncthreads();
}

struct Args { const float* in[31]; float* out; unsigned char* ws; int ph_lo, ph_hi, use_cg, pad; };
struct Frame {
    LAS unsigned char* lds;
    int tid, lane, wave, G, vcu, gw, ngw, bx;
    unsigned char* ws;
};
constexpr int LDS_MISC = 131072;
constexpr int LDS_BARST = LDS_BYTES - 64;

struct TItem { const float* src; bf16_t* dst; int ldw, ldt; };
DI void titem_load(const TItem& t, f32x4 (&v)[16], int lane) {
#pragma unroll
    for (int i = 0; i < 16; ++i) v[i] = *(const f32x4*)(t.src + (size_t)(4 * i + (lane >> 4)) * t.ldw + 4 * (lane & 15));
}
DI void titem_store(const TItem& t, const f32x4 (&v)[16], LAS float* scr, int lane) {
#pragma unroll
    for (int i = 0; i < 16; ++i) { LAS float* s = scr + (4 * i + (lane >> 4)) * 65 + 4 * (lane & 15); s[0] = v[i][0]; s[1] = v[i][1]; s[2] = v[i][2]; s[3] = v[i][3]; }
    LDS_WAIT();
#pragma unroll
    for (int j = 0; j < 8; ++j) {
        const int n = 8 * j + (lane >> 3), c = lane & 7; const LAS float* s = scr + (8 * c) * 65 + n;
        u32x4 o; o.x = cvtpk(s[0], s[65]); o.y = cvtpk(s[130], s[195]); o.z = cvtpk(s[260], s[325]); o.w = cvtpk(s[390], s[455]);
        *(u32x4*)(t.dst + (size_t)n * t.ldt + 8 * c) = o;
    }
    LDS_WAIT();
}
constexpr int IT_WIN = 16 * 42, IT_WOUT = 16 * 16, IT_SMALL = IT_WIN + IT_WOUT;
constexpr int IT_EXP = 128 * 3, IT_MOE = NE * IT_EXP;
DI TItem small_item(const Frame& F, const float* w_in, const float* w_out, int git) {
    const int l = git / IT_SMALL, it = git % IT_SMALL; TItem t;
    if (it < IT_WIN) {
        const int kt = it / 42, nt = it % 42, n0 = 64 * nt;
        size_t drow; if (n0 < 768) drow = n0; else if (n0 < 1152) drow = 2304 + (n0 - 768); else drow = n0 - 384;
        t.src = w_in + (size_t)l * D * INW + (size_t)(64 * kt) * INW + n0; t.ldw = INW;
        t.dst = (bf16_t*)(F.ws + WS_WIN + (size_t)l * WIN_LAYER) + drow * D + 64 * kt; t.ldt = D;
    } else {
        const int r = it - IT_WIN, kt = r >> 4, nt = r & 15;
        t.src = w_out + (size_t)l * D * D + (size_t)(64 * kt) * D + 64 * nt; t.ldw = D;
        t.dst = (bf16_t*)(F.ws + WS_WOUT) + (size_t)l * D * D + (size_t)(64 * nt) * D + 64 * kt; t.ldt = D;
    }
    return t;
}
DI TItem moe_item(const Frame& F, const float* wg, const float* wu, const float* wd, int l, int it) {
    const int e = it / IT_EXP, r = it % IT_EXP, which = r >> 7, q = r & 127; TItem t;
    if (which < 2) {
        const int kt = q >> 3, nt = q & 7, n0 = 64 * nt;
        t.src = (which ? wu : wg) + ((size_t)l * NE + e) * D * DE + (size_t)(64 * kt) * DE + n0; t.ldw = DE;
        const size_t drow = (size_t)(n0 >> 7) * 256 + (which ? 128 : 0) + (n0 & 127);
        t.dst = (bf16_t*)(F.ws + WS_WGU) + (size_t)e * D * D + drow * D + 64 * kt; t.ldt = D;
    } else {
        const int kt = q >> 4, nt = q & 15;
        t.src = wd + ((size_t)l * NE + e) * DE * D + (size_t)(64 * kt) * D + 64 * nt; t.ldw = D;
        t.dst = (bf16_t*)(F.ws + WS_WD) + (size_t)e * D * DE + (size_t)(64 * nt) * DE + 64 * kt; t.ldt = DE;
    }
    return t;
}
DI void p0_prologue(const Frame& F, const Args& a) {
    const float* c = a.in[1]; const float* w_mod = a.in[2]; const float* b_mod = a.in[3];
    if (F.bx < L * (MODW / 64)) {
        LAS float* sc = (LAS float*)(F.lds);
        LAS float* red = (LAS float*)(F.lds + 8192);
        for (int i = F.tid; i < NB * D; i += NTHREADS) { const float v = c[i]; sc[i] = v / (1.f + expf(-v)); }
        __syncthreads();
        const int l = F.bx / (MODW / 64), cb = F.bx % (MODW / 64), n = cb * 64 + F.lane;
        const float* w = w_mod + (size_t)l * D * MODW + n;
        float a0 = 0.f, a1 = 0.f;
#pragma unroll 8
        for (int k = F.wave * 128; k < F.wave * 128 + 128; ++k) { const float wv = w[(size_t)k * MODW]; a0 += sc[k] * wv; a1 += sc[D + k] * wv; }
        red[(F.wave * 2 + 0) * 64 + F.lane] = a0; red[(F.wave * 2 + 1) * 64 + F.lane] = a1;
        __syncthreads();
        if (F.tid < 128) { const int b = F.tid >> 6, ln = F.tid & 63; float s = 0.f;
#pragma unroll
            for (int w8 = 0; w8 < 8; ++w8) s += red[(w8 * 2 + b) * 64 + ln];
            const int nn = cb * 64 + ln;
            ((float*)(F.ws + WS_MOD))[(size_t)(l * NB + b) * MODW + nn] = s + b_mod[l * MODW + nn]; }
        __syncthreads();
    }
    { const int nzero = L * 128 * D / 8;
      for (int i = F.gw * 64 + F.lane; i < nzero; i += F.ngw * 64) { const int l = i / (128 * D / 8), r = i % (128 * D / 8);
          *(u32x4*)((bf16_t*)(F.ws + WS_WIN + (size_t)l * WIN_LAYER) + (size_t)(2304 + 384) * D + (size_t)r * 8) = (u32x4){0u, 0u, 0u, 0u}; } }
    LAS float* scr = (LAS float*)(F.lds + 16384) + F.wave * (64 * 65);
    { f32x4 cur[16], nxt[16]; int it = F.gw; TItem tc{}, tn{};
      if (it < L * IT_SMALL) { tc = small_item(F, a.in[4], a.in[19], it); titem_load(tc, cur, F.lane); }
      for (; it < L * IT_SMALL; it += F.ngw) {
          const bool more = it + F.ngw < L * IT_SMALL;
          if (more) { tn = small_item(F, a.in[4], a.in[19], it + F.ngw); titem_load(tn, nxt, F.lane); }
          titem_store(tc, cur, scr, F.lane);
          if (more) { tc = tn;
#pragma unroll
              for (int i = 0; i < 16; ++i) cur[i] = nxt[i]; }
      } }
}

DI void row_ln(f32x4 (&v)[4], float& mean_out, float& rstd_out) {
    float s = 0.f;
#pragma unroll
    for (int j = 0; j < 4; ++j) s += (v[j][0] + v[j][1]) + (v[j][2] + v[j][3]);
    const float mean = wave_sum(s) * (1.f / D); float q = 0.f;
#pragma unroll
    for (int j = 0; j < 4; ++j) { v[j] = v[j] - mean; q += (v[j][0] * v[j][0] + v[j][1] * v[j][1]) + (v[j][2] * v[j][2] + v[j][3] * v[j][3]); }
    mean_out = mean; rstd_out = 1.f / sqrtf(wave_sum(q) * (1.f / D) + LN_EPS);
}
DI void row_mod_store(f32x4 (&v)[4], const float* md, int off_sh, int off_sc, bf16_t* urow, int lane) {
    float mean, rstd; row_ln(v, mean, rstd);
#pragma unroll
    for (int j = 0; j < 4; ++j) { const int col = 4 * lane + 256 * j;
        const f32x4 scv = *(const f32x4*)(md + off_sc + col), shv = *(const f32x4*)(md + off_sh + col);
        v[j] = v[j] * rstd * (1.f + scv) + shv;
        u32x2 w; w.x = cvtpk(v[j][0], v[j][1]); w.y = cvtpk(v[j][2], v[j][3]);
        *(u32x2*)(urow + col) = w; }
}
DI void p_r0(const Frame& F, const float* x) {
    const float* MOD = (const float*)(F.ws + WS_MOD);
    bf16_t* U = (bf16_t*)(F.ws + WS_U);
    for (int row = F.gw; row < T; row += F.ngw) {
        f32x4 v[4];
#pragma unroll
        for (int j = 0; j < 4; ++j) v[j] = *(const f32x4*)(x + (size_t)row * D + 4 * F.lane + 256 * j);
        row_mod_store(v, MOD + (size_t)(row / S) * MODW, 0, D, U + (size_t)row * D, F.lane);
    }
}

constexpr int NGRP = T / 64;
DI void p_rowpass1(const Frame& F, const Args& a, int l, const float* xin, const bool dry = false) {
    const float* MODl = (const float*)(F.ws + WS_MOD) + (size_t)l * NB * MODW;
    const bf16_t* MIX = (const bf16_t*)(F.ws + WS_MIX);
    float* XA = (float*)(F.ws + WS_XA); bf16_t* U = (bf16_t*)(F.ws + WS_U);
    const float* gain = a.in[20] + (size_t)l * D; const float* bias = a.in[21] + (size_t)l * D;
    const float* wg = a.in[24] + (size_t)l * D * NG; const float* bg = a.in[25] + (size_t)l * NG;
    const float* we = a.in[26] + (size_t)l * D * NE; const float* be = a.in[27] + (size_t)l * NE;
    const size_t dro = dry ? 490 * MiB - WS_BC : 0;
    int* BC = (int*)(F.ws + WS_BC + dro); float* TOKW = (float*)(F.ws + WS_TOKW + dro); int* TOKSLOT = (int*)(F.ws + WS_TOKSLOT + (dry ? 496 * MiB - WS_TOKSLOT : 0));
    LAS float* RT = (LAS float*)F.lds;
    LAS unsigned* cntl = (LAS unsigned*)(F.lds + 36 * D * 4 + NWAVES * 72 * 4);
#pragma unroll
    for (int kk = 0; kk < 2; ++kk) { const int k = F.tid + kk * NTHREADS;
        f32x4 v[9]; v[0] = *(const f32x4*)(wg + (size_t)k * NG);
#pragma unroll
        for (int q = 0; q < 8; ++q) v[1 + q] = *(const f32x4*)(we + (size_t)k * NE + 4 * q);
#pragma unroll
        for (int q = 0; q < 9; ++q)
#pragma unroll
            for (int e = 0; e < 4; ++e) RT[(4 * q + e) * D + k] = v[q][e]; }
    for (int grp = F.vcu; grp < NGRP; grp += F.G) {
    if (F.tid < NE) cntl[F.tid] = 0u;
    __syncthreads();
    f32x4 pxa[4], pxb[4]; u32x2 pma[4], pmb[4];
    { const int r0 = 64 * grp + 8 * F.wave;
#pragma unroll
      for (int j = 0; j < 4; ++j) { const int col = 4 * F.lane + 256 * j; pxa[j] = *(const f32x4*)(xin + (size_t)r0 * D + col); pxb[j] = *(const f32x4*)(xin + (size_t)(r0 + 1) * D + col);
          pma[j] = *(const u32x2*)(MIX + (size_t)r0 * D + col); pmb[j] = *(const u32x2*)(MIX + (size_t)(r0 + 1) * D + col); } }
    for (int rp = 0; rp < 4; ++rp) {
        const int row0 = 64 * grp + 8 * F.wave + 2 * rp; const float* md = MODl + (size_t)(row0 / S) * MODW;
        f32x4 va[4], vb[4];
#pragma unroll
        for (int j = 0; j < 4; ++j) { const int col = 4 * F.lane + 256 * j;
            const f32x4 g = *(const f32x4*)(md + 2 * D + col);
            va[j] = pxa[j] * ALPHA + g * (f32x4){bflo(pma[j].x), bfhi(pma[j].x), bflo(pma[j].y), bfhi(pma[j].y)};
            vb[j] = pxb[j] * ALPHA + g * (f32x4){bflo(pmb[j].x), bfhi(pmb[j].x), bflo(pmb[j].y), bfhi(pmb[j].y)}; }
        if (rp < 3) { const int r0 = row0 + 2;
#pragma unroll
          for (int j = 0; j < 4; ++j) { const int col = 4 * F.lane + 256 * j; pxa[j] = *(const f32x4*)(xin + (size_t)r0 * D + col); pxb[j] = *(const f32x4*)(xin + (size_t)(r0 + 1) * D + col);
              pma[j] = *(const u32x2*)(MIX + (size_t)r0 * D + col); pmb[j] = *(const u32x2*)(MIX + (size_t)(r0 + 1) * D + col); } }
        float mean, rstd;
        row_ln(va, mean, rstd);
#pragma unroll
        for (int j = 0; j < 4; ++j) { const int col = 4 * F.lane + 256 * j; va[j] = va[j] * rstd * *(const f32x4*)(gain + col) + *(const f32x4*)(bias + col); *(f32x4*)(XA + (size_t)row0 * D + col) = va[j]; }
        row_ln(vb, mean, rstd);
#pragma unroll
        for (int j = 0; j < 4; ++j) { const int col = 4 * F.lane + 256 * j; vb[j] = vb[j] * rstd * *(const f32x4*)(gain + col) + *(const f32x4*)(bias + col); *(f32x4*)(XA + (size_t)(row0 + 1) * D + col) = vb[j]; }
        row_mod_store(va, md, 3 * D, 4 * D, U + (size_t)row0 * D, F.lane);
        row_mod_store(vb, md, 3 * D, 4 * D, U + (size_t)(row0 + 1) * D, F.lane);
#ifdef DRY_NOROUTER
        if (dry) continue;
#endif
        LAS float* lg = (LAS float*)(F.lds + 36 * D * 4) + F.wave * 72;
#pragma unroll 1
        for (int n = 0; n < 36; n += 3) { float sa[3], sb[3];
#pragma unroll
            for (int q = 0; q < 3; ++q) { sa[q] = 0.f; sb[q] = 0.f;
#pragma unroll
                for (int j = 0; j < 4; ++j) { const f32x4 w = *(const LAS f32x4*)(RT + (n + q) * D + 4 * F.lane + 256 * j);
                    sa[q] += (va[j][0] * w[0] + va[j][1] * w[1]) + (va[j][2] * w[2] + va[j][3] * w[3]);
                    sb[q] += (vb[j][0] * w[0] + vb[j][1] * w[1]) + (vb[j][2] * w[2] + vb[j][3] * w[3]); } }
#pragma unroll
            for (int q = 0; q < 3; ++q) { sa[q] = wave_sum(sa[q]); sb[q] = wave_sum(sb[q]); }
            if (F.lane == 0) {
#pragma unroll
                for (int q = 0; q < 3; ++q) { lg[n + q] = sa[q]; lg[36 + n + q] = sb[q]; } } }
        LDS_WAIT();
#pragma unroll
        for (int rr = 0; rr < 2; ++rr) {
            float gl[4], el[32];
#pragma unroll
            for (int n = 0; n < 4; ++n) gl[n] = lg[36 * rr + n] + bg[n];
#pragma unroll
            for (int n = 0; n < 32; ++n) el[n] = lg[36 * rr + 4 + n] + be[n];
            int gi = 0; float gm = gl[0];
#pragma unroll
            for (int n = 1; n < 4; ++n) if (gl[n] > gm) { gm = gl[n]; gi = n; }
            float se = 0.f;
#pragma unroll
            for (int n = 0; n < 4; ++n) se += expf(gl[n] - gm);
            const float pg = 1.f / se;
            float l1 = -3.0e38f, l2 = -3.0e38f; int i1 = 0, i2 = 0;
#pragma unroll
            for (int n = 0; n < 32; ++n) if ((n >> 3) == gi) { const float v = el[n]; const int e = n & 7;
                if (v > l1) { l2 = l1; i2 = i1; l1 = v; i1 = e; } else if (v > l2) { l2 = v; i2 = e; } }
            const float e2 = expf(l2 - l1); const float w1 = pg / (1.f + e2), w2 = pg * e2 / (1.f + e2);
            if (F.lane == 0) {
                const int tok = row0 + rr, ea = gi * EPG + i1, eb = gi * EPG + i2;
                const unsigned pa = __hip_atomic_fetch_add(&cntl[ea], 1u, __ATOMIC_RELAXED, __HIP_MEMORY_SCOPE_WORKGROUP), pb = __hip_atomic_fetch_add(&cntl[eb], 1u, __ATOMIC_RELAXED, __HIP_MEMORY_SCOPE_WORKGROUP);
                TOKSLOT[tok * 2] = (ea << 14) | (int)pa; TOKSLOT[tok * 2 + 1] = (eb << 14) | (int)pb;
                TOKW[tok * 2] = w1; TOKW[tok * 2 + 1] = w2;
            }
        }
    }
    __syncthreads();
    if (F.tid < NE) BC[grp * NE + F.tid] = (int)cntl[F.tid];
    __syncthreads();
    }
}

DI void build_tables(const Frame& F, int l, LAS int* tb) {
    if (F.tid < 64) {
        const int e = F.lane; const int c = e < NE ? ((const int*)(F.ws + WS_CNTF))[e] : 0; const int tl = (c + 255) >> 8;
        int cum = c, tin = tl;
#pragma unroll
        for (int o = 1; o < 32; o <<= 1) { const int a1 = __shfl_up(cum, o), a2 = __shfl_up(tin, o); if (e >= o) { cum += a1; tin += a2; } }
        if (e < NE) { tb[e] = cum - c; tb[33 + e] = (tin - tl) * 256; for (int t2 = 0; t2 < tl; ++t2) tb[66 + (tin - tl) + t2] = e; }
        if (e == NE - 1) { tb[32] = cum; tb[65] = tin; }
    }
    __syncthreads();
}
DI void p_gather(const Frame& F, int l) {
    LAS int* base = (LAS int*)F.lds;
    LAS int* segt = base + NGRP * NE;
    LAS int* offp = segt + 16 * NE;
    const int* BC = (const int*)(F.ws + WS_BC);
    { int tmp[NGRP * NE / NTHREADS];
#pragma unroll
      for (int q = 0; q < NGRP * NE / NTHREADS; ++q) tmp[q] = BC[F.tid + q * NTHREADS];
#pragma unroll
      for (int q = 0; q < NGRP * NE / NTHREADS; ++q) base[F.tid + q * NTHREADS] = tmp[q]; }
    __syncthreads();
    { const int e = F.tid & 31, sg = F.tid >> 5; int run = 0;
      for (int g = 16 * sg; g < 16 * sg + 16; ++g) { const int c = base[g * NE + e]; base[g * NE + e] = run; run += c; }
      segt[sg * NE + e] = run; }
    __syncthreads();
    if (F.tid < NE) { int run = 0; for (int sg = 0; sg < 16; ++sg) { const int c = segt[sg * NE + F.tid]; segt[sg * NE + F.tid] = run; run += c; }
        offp[F.tid] = run;
        if (F.bx == 0) ((int*)(F.ws + WS_CNTF))[F.tid] = run; }
    __syncthreads();
    if (F.tid == 0) { int off = 0; for (int e = 0; e < NE; ++e) { const int c = offp[e]; offp[e] = off; off += ((c + 255) >> 8) * 256; } }
    __syncthreads();
    const int* TOKSLOT = (const int*)(F.ws + WS_TOKSLOT); const float* TOKW = (const float*)(F.ws + WS_TOKW); int* TOKFIN = (int*)(F.ws + WS_TOKFIN);
    const bf16_t* U = (const bf16_t*)(F.ws + WS_U); bf16_t* XS = (bf16_t*)(F.ws + WS_XS); float* SLOTW = (float*)(F.ws + WS_SLOTW);
    const int nas = (2 * T - F.gw + F.ngw - 1) / F.ngw;
    int my_slot = 0, my_tok = 0;
    if (F.lane < nas) { const int as = F.gw + F.lane * F.ngw; const int tok = as >> 1, ts = TOKSLOT[as], e = ts >> 14, grp = tok >> 6, sg = grp >> 4;
        my_slot = offp[e] + segt[sg * NE + e] + base[grp * NE + e] + (ts & 16383); my_tok = tok;
        SLOTW[my_slot] = TOKW[as]; TOKFIN[as] = my_slot; }
    for (int i0 = 0; i0 < nas; i0 += 4) {
        u32x4 r0[4], r1[4];
#pragma unroll
        for (int q = 0; q < 4; ++q) if (i0 + q < nas) { const u32x4* src = (const u32x4*)(U + (size_t)__shfl(my_tok, i0 + q) * D); r0[q] = src[F.lane]; r1[q] = src[64 + F.lane]; }
#pragma unroll
        for (int q = 0; q < 4; ++q) if (i0 + q < nas) { u32x4* dst = (u32x4*)(XS + (size_t)__shfl(my_slot, i0 + q) * D); dst[F.lane] = r0[q]; dst[64 + F.lane] = r1[q]; }
    }
}
struct Rp2In { f32x4 x[4]; u32x2 y0[4], y1[4]; };
DI void rp2_load(Rp2In& r, const float* XA, const bf16_t* YS, int row, int s0, int s1, int lane) {
#pragma unroll
    for (int j = 0; j < 4; ++j) { const int col = 4 * lane + 256 * j;
        r.x[j] = *(const f32x4*)(XA + (size_t)row * D + col); r.y0[j] = *(const u32x2*)(YS + (size_t)s0 * D + col); r.y1[j] = *(const u32x2*)(YS + (size_t)s1 * D + col); }
}
DI void p_rowpass2(const Frame& F, const Args& a, int l, float* xout) {
    const float* MOD = (const float*)(F.ws + WS_MOD);
    const float* XA = (const float*)(F.ws + WS_XA); const bf16_t* YS = (const bf16_t*)(F.ws + WS_YS); const int* TOKFIN = (const int*)(F.ws + WS_TOKFIN);
    const float* gain = a.in[22] + (size_t)l * D; const float* bias = a.in[23] + (size_t)l * D;
    bf16_t* U = (bf16_t*)(F.ws + WS_U);
    const int nrows = (T - F.gw + F.ngw - 1) / F.ngw;
    int tf = 0; { const int i = F.lane >> 1; if (i < nrows) tf = TOKFIN[(F.gw + i * F.ngw) * 2 + (F.lane & 1)]; }
    Rp2In cur, nxt;
    if (nrows > 0) rp2_load(cur, XA, YS, F.gw, __shfl(tf, 0), __shfl(tf, 1), F.lane);
    for (int i = 0; i < nrows; ++i) {
        const int row = F.gw + i * F.ngw;
        if (i + 1 < nrows) rp2_load(nxt, XA, YS, row + F.ngw, __shfl(tf, 2 * i + 2), __shfl(tf, 2 * i + 3), F.lane);
        const float* md = MOD + (size_t)(l * NB + row / S) * MODW;
        f32x4 v[4];
#pragma unroll
        for (int j = 0; j < 4; ++j) { const int col = 4 * F.lane + 256 * j;
            const f32x4 g = *(const f32x4*)(md + 5 * D + col);
            const u32x2 y0 = cur.y0[j], y1 = cur.y1[j];
            const f32x4 f = (f32x4){bflo(y0.x) + bflo(y1.x), bfhi(y0.x) + bfhi(y1.x), bflo(y0.y) + bflo(y1.y), bfhi(y0.y) + bfhi(y1.y)};
            v[j] = cur.x[j] * ALPHA + g * f; }
        float mean, rstd; row_ln(v, mean, rstd);
#pragma unroll
        for (int j = 0; j < 4; ++j) { const int col = 4 * F.lane + 256 * j; v[j] = v[j] * rstd * *(const f32x4*)(gain + col) + *(const f32x4*)(bias + col); *(f32x4*)(xout + (size_t)row * D + col) = v[j]; }
        if (l + 1 < L) row_mod_store(v, MOD + (size_t)((l + 1) * NB + row / S) * MODW, 0, D, U + (size_t)row * D, F.lane);
        if (i + 1 < nrows) {
#pragma unroll
            for (int j = 0; j < 4; ++j) { cur.x[j] = nxt.x[j]; cur.y0[j] = nxt.y0[j]; cur.y1[j] = nxt.y1[j]; } }
    }
}

#define MFMA16(a, b, c) __builtin_amdgcn_mfma_f32_16x16x32_bf16((a), (b), (c), 0, 0, 0)
#define MFMA32(a, b, c) __builtin_amdgcn_mfma_f32_32x32x16_bf16((a), (b), (c), 0, 0, 0)
constexpr int RB = 9216;
#define BUF(i) ((i) * RB)
constexpr int LWOFF = BUF(12), ZAOFF = BUF(0), SEGOFF = BUF(14), SEGXOFF = BUF(14) + 2048, TOTOFF = BUF(14) + 4096, NABFOFF = BUF(15), PCOFF = 16 * RB;
struct RwP { const float *conv, *w0, *w_up, *a0, *a_up, *g_up, *k_k, *k_a, *r_k, *gn_gain, *gn_bias; };

DI void lds_barrier() { asm volatile("s_waitcnt lgkmcnt(0)" ::: "memory"); __builtin_amdgcn_s_barrier(); asm volatile("" ::: "memory"); }
DI bf16x8 ldfrag(const LAS unsigned char* lds, int buf, int row, int ks, int lane) { return *(const LAS bf16x8*)(lds + buf + row * 144 + (32 * ks + 8 * (lane >> 4)) * 2); }
DI f32x4 mm64(const LAS unsigned char* lds, int abuf, int arow0, int bbuf, int brow0, int lane) {
    f32x4 acc = (f32x4){0.f, 0.f, 0.f, 0.f};
#pragma unroll
    for (int ks = 0; ks < 2; ++ks) acc = MFMA16(ldfrag(lds, abuf, arow0 + (lane & 15), ks, lane), ldfrag(lds, bbuf, brow0 + (lane & 15), ks, lane), acc);
    return acc;
}
DI u32x2 pack4(const f32x4 v) { u32x2 w; w.x = cvtpk(v[0], v[1]); w.y = cvtpk(v[2], v[3]); return w; }
DI f32x4 unpack4(const u32x2 w) { return (f32x4){bflo(w.x), bfhi(w.x), bflo(w.y), bfhi(w.y)}; }
DI void st4(LAS unsigned char* lds, int buf, int row, int col, const f32x4 v) { *(LAS u32x2*)(lds + buf + row * 144 + col * 2) = pack4(v); }
DI f32x4 ld4(const LAS unsigned char* lds, int buf, int row, int col) { return unpack4(*(const LAS u32x2*)(lds + buf + row * 144 + col * 2)); }
DI void st1(LAS unsigned char* lds, int buf, int row, int col, float v) { *(LAS bf16_t*)(lds + buf + row * 144 + col * 2) = f2bf(v); }
DI float fast_tanh(float x) { const float e = fexp2(x * (2.f * LOG2E)); return 1.f - 2.f * frcp(1.f + e); }

#define OPQZ(z) int z; asm volatile("s_mov_b32 %0, 0" : "=s"(z))
constexpr int CWLOFF = PCOFF + 256;
constexpr int PRMOFF = CWLOFF + 6912;
struct RwPre { u32x2 wv, av; u32x4 gv; f32x4 w4, a4, g0, g1; u32x4 rr[3], kk[3], vv[3]; };
DI void rwkv_prefetch(const Frame& F, const Args& a, const int l, const int unit, RwPre& P) {
    const int tid = F.tid;
    const int c = unit % NCH, hd = (unit / NCH) % BH, b = (unit / (NCH * BH)) % NB, dir = unit / (NCH * BH * NB);
    const bf16_t* HBp = (const bf16_t*)(F.ws + WS_HB);
    const int u = tid >> 3, jg = tid & 7, tloc = 64 * c + u; const size_t tok = (size_t)b * S + tloc;
    const bf16_t* hrow = HBp + tok * HW;
    P.wv = *(const u32x2*)(hrow + HWL + 4 * jg); P.av = *(const u32x2*)(hrow + HAL + 4 * jg); P.gv = *(const u32x4*)(hrow + HGL + 8 * jg);
    OPQZ(z0);
    { const int m = tid >> 4, j4 = (tid & 15) * 4;
      const float* w_up = a.in[8 + z0] + (size_t)l * 2 * RW * BW; const float* a_up = a.in[10 + z0] + (size_t)l * 2 * RA * BW;
      P.w4 = *(const f32x4*)(w_up + (size_t)(dir * RW + m) * BW + hd * HD + j4); P.a4 = *(const f32x4*)(a_up + (size_t)(dir * RA + m) * BW + hd * HD + j4); }
    { const int m = tid >> 3, i8 = (tid & 7) * 8; const float* g_up = a.in[11 + z0] + (size_t)l * RG * BW;
      P.g0 = *(const f32x4*)(g_up + (size_t)m * BW + hd * HD + i8); P.g1 = *(const f32x4*)(g_up + (size_t)m * BW + hd * HD + i8 + 4); }
    const int ch0 = hd * HD + 8 * jg;
#pragma unroll
    for (int x = 0; x < 3; ++x) {
        const int tt = tloc + x - 1; const u32x4 z4 = (u32x4){0u, 0u, 0u, 0u};
        if (tt >= 0 && tt < S) { const bf16_t* hp = HBp + ((size_t)b * S + tt) * HW + HR + ch0; P.rr[x] = *(const u32x4*)hp; P.kk[x] = *(const u32x4*)(hp + BW); P.vv[x] = *(const u32x4*)(hp + 2 * BW); }
        else { P.rr[x] = z4; P.kk[x] = z4; P.vv[x] = z4; }
    }
}
DI void rwkv_local_unit(const Frame& F, const Args& a, const int l, const int unit, RwPre& PF, const int next_unit) {
    LAS unsigned char* lds = F.lds;
    int tid_ = F.tid; asm volatile("" : "+v"(tid_));
    const int tid = tid_, lane = tid_ & 63, wave = F.wave;
    const int c = unit % NCH, hd = (unit / NCH) % BH, b = (unit / (NCH * BH)) % NB, dir = unit / (NCH * BH * NB);
    const bf16_t* HBp = (const bf16_t*)(F.ws + WS_HB);
    const int u = tid >> 3, jg = tid & 7, tau = dir ? 63 - u : u, tloc = 64 * c + u;
    const size_t tok = (size_t)b * S + tloc;
    const int tn = wave & 3, tm0 = 2 * (wave >> 2), g4 = lane >> 4, l15 = lane & 15;
    if (tid < 320) { OPQZ(z2); const int which = tid >> 6, j = tid & 63;
      const float* src = which == 0 ? a.in[7 + z2] + (size_t)l * 2 * BW + dir * BW : which == 1 ? a.in[9 + z2] + (size_t)l * 2 * BW + dir * BW : which == 2 ? a.in[12 + z2] + (size_t)l * BW : which == 3 ? a.in[13 + z2] + (size_t)l * BW : a.in[14 + z2] + (size_t)l * BH * HD;
      *(LAS float*)(lds + PRMOFF + tid * 4) = src[hd * HD + j]; }
    {
        const f32x4 wf = unpack4(PF.wv);
        *(LAS u32x2*)(lds + BUF(8) + tau * 144 + (4 * jg) * 2) = pack4((f32x4){fast_tanh(wf[0]), fast_tanh(wf[1]), fast_tanh(wf[2]), fast_tanh(wf[3])});
        *(LAS u32x2*)(lds + BUF(8) + tau * 144 + (32 + 4 * jg) * 2) = PF.av;
        const u32x4 gv = PF.gv;
        u32x4 so; so.x = cvtpk(sigm(bflo(gv.x)), sigm(bfhi(gv.x))); so.y = cvtpk(sigm(bflo(gv.y)), sigm(bfhi(gv.y))); so.z = cvtpk(sigm(bflo(gv.z)), sigm(bfhi(gv.z))); so.w = cvtpk(sigm(bflo(gv.w)), sigm(bfhi(gv.w)));
        *(LAS u32x4*)(lds + BUF(9) + tau * 144 + 16 * jg) = so;
        { const int m = tid >> 4, j4 = (tid & 15) * 4;
#pragma unroll
          for (int e = 0; e < 4; ++e) { st1(lds, BUF(10), j4 + e, m, PF.w4[e]); st1(lds, BUF(10), j4 + e, 32 + m, PF.a4[e]); } }
        { const int m = tid >> 3, i8 = (tid & 7) * 8;
#pragma unroll
          for (int e = 0; e < 4; ++e) { st1(lds, BUF(11), i8 + e, m, PF.g0[e]); st1(lds, BUF(11), i8 + 4 + e, m, PF.g1[e]); } }
    }
    lds_barrier();
#pragma unroll
    for (int tmi = 0; tmi < 2; ++tmi) {
        const int tm = tm0 + tmi; const f32x4 z = (f32x4){0.f, 0.f, 0.f, 0.f};
        const f32x4 zw = MFMA16(ldfrag(lds, BUF(10), 16 * tm + l15, 0, lane), ldfrag(lds, BUF(8), 16 * tn + l15, 0, lane), z);
        const f32x4 za = MFMA16(ldfrag(lds, BUF(10), 16 * tm + l15, 1, lane), ldfrag(lds, BUF(8), 16 * tn + l15, 1, lane), z);
        const int trow = 16 * tn + l15, jb = 16 * tm + 4 * g4;
        *(LAS f32x4*)(lds + LWOFF + (trow * 64 + jb) * 4) = zw;
        *(LAS f32x4*)(lds + ZAOFF + (trow * 64 + jb) * 4) = za;
        if (dir == 0) {
            const f32x4 gg = mm64(lds, BUF(11), 16 * tm, BUF(9), 16 * tn, lane);
            *(u32x2*)((bf16_t*)(F.ws + WS_GB) + ((size_t)b * S + 64 * c + trow) * BW + hd * HD + jb) = pack4(gg);
        }
    }
    lds_barrier();
    const int ch0 = hd * HD + 8 * jg;
    float r[8], kd[8], kap[8], bb[8], lw[8];
    {
        float k[8], v[8];
#pragma unroll
        for (int e = 0; e < 8; ++e) { r[e] = 0.f; k[e] = 0.f; v[e] = 0.f; }
#pragma unroll
        for (int x = 0; x < 3; ++x) {
            const LAS unsigned char* cwp = lds + CWLOFF + (((hd * 3 + x) * 3) * 64 + 8 * jg) * 2;
            const u32x4 cr = *(const LAS u32x4*)cwp, ck = *(const LAS u32x4*)(cwp + 128), cv = *(const LAS u32x4*)(cwp + 256);
            const u32x4 rr = PF.rr[x], kk2 = PF.kk[x], vv = PF.vv[x];
            r[0] += bflo(rr.x) * bflo(cr.x); r[1] += bfhi(rr.x) * bfhi(cr.x); r[2] += bflo(rr.y) * bflo(cr.y); r[3] += bfhi(rr.y) * bfhi(cr.y);
            r[4] += bflo(rr.z) * bflo(cr.z); r[5] += bfhi(rr.z) * bfhi(cr.z); r[6] += bflo(rr.w) * bflo(cr.w); r[7] += bfhi(rr.w) * bfhi(cr.w);
            k[0] += bflo(kk2.x) * bflo(ck.x); k[1] += bfhi(kk2.x) * bfhi(ck.x); k[2] += bflo(kk2.y) * bflo(ck.y); k[3] += bfhi(kk2.y) * bfhi(ck.y);
            k[4] += bflo(kk2.z) * bflo(ck.z); k[5] += bfhi(kk2.z) * bfhi(ck.z); k[6] += bflo(kk2.w) * bflo(ck.w); k[7] += bfhi(kk2.w) * bfhi(ck.w);
            v[0] += bflo(vv.x) * bflo(cv.x); v[1] += bfhi(vv.x) * bfhi(cv.x); v[2] += bflo(vv.y) * bflo(cv.y); v[3] += bfhi(vv.y) * bfhi(cv.y);
            v[4] += bflo(vv.z) * bflo(cv.z); v[5] += bfhi(vv.z) * bfhi(cv.z); v[6] += bflo(vv.w) * bflo(cv.w); v[7] += bfhi(vv.w) * bfhi(cv.w);
        }
        const f32x4 zw0 = *(const LAS f32x4*)(lds + LWOFF + (tau * 64 + 8 * jg) * 4), zw1 = *(const LAS f32x4*)(lds + LWOFF + (tau * 64 + 8 * jg + 4) * 4);
        const f32x4 za0 = *(const LAS f32x4*)(lds + ZAOFF + (tau * 64 + 8 * jg) * 4), za1 = *(const LAS f32x4*)(lds + ZAOFF + (tau * 64 + 8 * jg + 4) * 4);
        float ss = 0.f, bsp = 0.f, av[8];
        const LAS f32x4* prm = (const LAS f32x4*)(lds + PRMOFF) + 2 * jg;
        const f32x4 w0a = prm[0], w0b = prm[1], a0a = prm[16], a0b = prm[17], kka = prm[32], kkb = prm[33], kaa = prm[48], kab = prm[49], rka = prm[64], rkb = prm[65];
#pragma unroll
        for (int e = 0; e < 8; ++e) {
            const float zw = (e < 4 ? zw0[e & 3] : zw1[e & 3]) + (e < 4 ? w0a[e & 3] : w0b[e & 3]);
            const float za = (e < 4 ? za0[e & 3] : za1[e & 3]) + (e < 4 ? a0a[e & 3] : a0b[e & 3]);
            lw[e] = (-DECAY * LOG2E) * sigm(zw); av[e] = sigm(za);
            kap[e] = k[e] * (e < 4 ? kka[e & 3] : kkb[e & 3]); ss += kap[e] * kap[e];
            kd[e] = k[e] * (1.f + (av[e] - 1.f) * (e < 4 ? kaa[e & 3] : kab[e & 3]));
            bsp += r[e] * kd[e] * (e < 4 ? rka[e & 3] : rkb[e & 3]);
        }
        ss += __shfl_xor(ss, 1); ss += __shfl_xor(ss, 2); ss += __shfl_xor(ss, 4);
        bsp += __shfl_xor(bsp, 1); bsp += __shfl_xor(bsp, 2); bsp += __shfl_xor(bsp, 4);
        const float rn = __builtin_amdgcn_rsqf(fmaxf(ss, 1e-24f));
#pragma unroll
        for (int e = 0; e < 8; ++e) { kap[e] *= rn; bb[e] = kap[e] * av[e]; }
        if (jg == 0) ((float*)(F.ws + WS_BS))[((size_t)dir * T + tok) * 8 + hd] = bsp;
        *(LAS f32x4*)(lds + LWOFF + (tau * 64 + 8 * jg) * 4) = (f32x4){lw[0], lw[1], lw[2], lw[3]};
        *(LAS f32x4*)(lds + LWOFF + (tau * 64 + 8 * jg + 4) * 4) = (f32x4){lw[4], lw[5], lw[6], lw[7]};
#pragma unroll
        for (int e = 0; e < 8; ++e) st1(lds, BUF(7), 8 * jg + e, tau, v[e]);
        if (dir == 0) {
            u32x4 vo; vo.x = cvtpk(v[0], v[1]); vo.y = cvtpk(v[2], v[3]); vo.z = cvtpk(v[4], v[5]); vo.w = cvtpk(v[6], v[7]);
            *(u32x4*)((bf16_t*)(F.ws + WS_VC) + tok * BW + ch0) = vo;
        }
    }
    lds_barrier();
    if (dir == 0) {
        const size_t ucidx = ((size_t)b * BH + hd) * NCH + c; const int vi = tid >> 3, vc = tid & 7;
        *(u32x4*)((bf16_t*)(F.ws + WS_VTB) + ucidx * 4096 + vi * 64 + vc * 8) = *(const LAS u32x4*)(lds + BUF(7) + vi * 144 + vc * 16);
    }
    { const int seg = tid >> 6, j = tid & 63; float p = 0.f;
#pragma unroll
      for (int i = 0; i < 8; ++i) { LAS float* q = (LAS float*)(lds + LWOFF + ((8 * seg + i) * 64 + j) * 4); p += *q; *q = p; }
      *(LAS float*)(lds + SEGOFF + (seg * 64 + j) * 4) = p; }
    lds_barrier();
    if (tid < 64) { float run = 0.f;
#pragma unroll
      for (int sg = 0; sg < 8; ++sg) { *(LAS float*)(lds + SEGXOFF + (sg * 64 + tid) * 4) = run; run += *(const LAS float*)(lds + SEGOFF + (sg * 64 + tid) * 4); }
      *(LAS float*)(lds + TOTOFF + tid * 4) = run; }
    lds_barrier();
    {
        float At[8], Rt[8], Bt[8], Kt[8], Bh[8], Kh[8];
#pragma unroll
        for (int e = 0; e < 8; ++e) {
            const int j = 8 * jg + e;
            const float lwi = *(const LAS float*)(lds + LWOFF + (tau * 64 + j) * 4) + *(const LAS float*)(lds + SEGXOFF + ((tau >> 3) * 64 + j) * 4);
            const float tot = *(const LAS float*)(lds + TOTOFF + j * 4);
            const float ep = fexp2(lwi - lw[e]), epl = fexp2(lwi), em = fexp2(-lwi), ec = fexp2(tot - lwi);
            At[e] = -kap[e] * ep; Rt[e] = r[e] * epl; Bt[e] = bb[e] * em; Kt[e] = kd[e] * em; Bh[e] = bb[e] * ec; Kh[e] = kd[e] * ec;
            if (u == 0) *(LAS float*)(lds + PCOFF + j * 4) = fexp2(tot);
        }
        u32x4 o;
#define PK8(X) (o.x = cvtpk(X[0], X[1]), o.y = cvtpk(X[2], X[3]), o.z = cvtpk(X[4], X[5]), o.w = cvtpk(X[6], X[7]), o)
        *(LAS u32x4*)(lds + BUF(0) + tau * 144 + 16 * jg) = PK8(At);
        *(LAS u32x4*)(lds + BUF(1) + tau * 144 + 16 * jg) = PK8(Bt);
        *(LAS u32x4*)(lds + BUF(2) + tau * 144 + 16 * jg) = PK8(Kt);
        *(LAS u32x4*)(lds + BUF(3) + tau * 144 + 16 * jg) = PK8(Rt);
#undef PK8
#pragma unroll
        for (int e = 0; e < 8; ++e) { const int j = 8 * jg + e; st1(lds, BUF(4), j, tau, At[e]); st1(lds, BUF(5), j, tau, Bh[e]); st1(lds, BUF(6), j, tau, Kh[e]); }
    }
    if (next_unit >= 0) rwkv_prefetch(F, a, l, next_unit, PF);
    lds_barrier();
#pragma unroll
    for (int tmi = 0; tmi < 2; ++tmi) {
        const int tm = tm0 + tmi, mb = 16 * tm + 4 * g4, nn = 16 * tn + l15;
        { f32x4 v = mm64(lds, BUF(1), 16 * tm, BUF(0), 16 * tn, lane);
#pragma unroll
          for (int e = 0; e < 4; ++e) v[e] = (mb + e < nn) ? v[e] : 0.f;
          if (tm == tn) {
#pragma unroll
              for (int e = 0; e < 4; ++e) *(LAS float*)(lds + NABFOFF + ((16 * tm + l15) * 16 + ((mb + e) & 15)) * 4) = v[e];
              v = (f32x4){0.f, 0.f, 0.f, 0.f};
          }
          st4(lds, BUF(11), nn, mb, v); }
        { f32x4 v = mm64(lds, BUF(0), 16 * tm, BUF(2), 16 * tn, lane);
#pragma unroll
          for (int e = 0; e < 4; ++e) v[e] = (nn < mb + e) ? v[e] : 0.f;
          st4(lds, BUF(8), nn, mb, v); }
        { f32x4 v = mm64(lds, BUF(1), 16 * tm, BUF(3), 16 * tn, lane);
#pragma unroll
          for (int e = 0; e < 4; ++e) v[e] = (mb + e <= nn) ? v[e] : 0.f;
          st4(lds, BUF(9), nn, mb, v); }
        { f32x4 v = mm64(lds, BUF(2), 16 * tm, BUF(3), 16 * tn, lane);
#pragma unroll
          for (int e = 0; e < 4; ++e) v[e] = (mb + e <= nn) ? v[e] : 0.f;
          st4(lds, BUF(10), nn, mb, v); }
    }
    lds_barrier();
    if (wave == 0) {
        const int blk = lane >> 4, sr = lane & 15, s = 16 * blk + sr;
        float Tr[16];
#pragma unroll
        for (int t = 0; t < 16; ++t) { float acc = (t == sr) ? 1.f : 0.f;
            const LAS f32x4* col = (const LAS f32x4*)(lds + NABFOFF + ((16 * blk + t) * 16) * 4);
#pragma unroll
            for (int q = 0; q < (t + 3) / 4; ++q) { const f32x4 nv = col[q];
#pragma unroll
                for (int e = 0; e < 4; ++e) if (4 * q + e < t) acc += Tr[4 * q + e] * nv[e]; }
            Tr[t] = acc; __builtin_amdgcn_sched_barrier(0); }
        const u32x4 z4 = (u32x4){0u, 0u, 0u, 0u};
#pragma unroll
        for (int q = 0; q < 9; ++q) { *(LAS u32x4*)(lds + BUF(0) + s * 144 + 16 * q) = z4; *(LAS u32x4*)(lds + BUF(1) + s * 144 + 16 * q) = z4; }
        u32x4 o0, o1; o0.x = cvtpk(Tr[0], Tr[1]); o0.y = cvtpk(Tr[2], Tr[3]); o0.z = cvtpk(Tr[4], Tr[5]); o0.w = cvtpk(Tr[6], Tr[7]);
        o1.x = cvtpk(Tr[8], Tr[9]); o1.y = cvtpk(Tr[10], Tr[11]); o1.z = cvtpk(Tr[12], Tr[13]); o1.w = cvtpk(Tr[14], Tr[15]);
        LDS_WAIT();
        *(LAS u32x4*)(lds + BUF(0) + s * 144 + 32 * blk) = o0; *(LAS u32x4*)(lds + BUF(0) + s * 144 + 32 * blk + 16) = o1;
#pragma unroll
        for (int t = 0; t < 16; ++t) st1(lds, BUF(1), 16 * blk + t, s, Tr[t]);
    }
    lds_barrier();
#pragma unroll
    for (int tmi = 0; tmi < 2; ++tmi) {
        const int tm = tm0 + tmi, mb = 16 * tm + 4 * g4, nn = 16 * tn + l15;
        const f32x4 v = mm64(lds, BUF(0), 16 * tm, BUF(11), 16 * tn, lane);
        st4(lds, BUF(12), nn, mb, v);
#pragma unroll
        for (int e = 0; e < 4; ++e) st1(lds, BUF(2), mb + e, nn, v[e]);
    }
    lds_barrier();
#pragma unroll
    for (int tmi = 0; tmi < 2; ++tmi) {
        const int tm = tm0 + tmi, mb = 16 * tm + 4 * g4, nn = 16 * tn + l15;
        const f32x4 v = mm64(lds, BUF(12), 16 * tm, BUF(2), 16 * tn, lane);
        st4(lds, BUF(13), nn, mb, v);
    }
    lds_barrier();
#pragma unroll
    for (int tmi = 0; tmi < 2; ++tmi) {
        const int tm = tm0 + tmi, mb = 16 * tm + 4 * g4, nn = 16 * tn + l15;
        const f32x4 v = mm64(lds, BUF(13), 16 * tm, BUF(1), 16 * tn, lane) + ld4(lds, BUF(1), nn, mb);
        st4(lds, BUF(14), nn, mb, v);
    }
    lds_barrier();
#pragma unroll
    for (int tmi = 0; tmi < 2; ++tmi) {
        const int tm = tm0 + tmi, mb = 16 * tm + 4 * g4, nn = 16 * tn + l15;
        const f32x4 v = mm64(lds, BUF(2), 16 * tm, BUF(14), 16 * tn, lane) + ld4(lds, BUF(14), nn, mb);
        st4(lds, BUF(15), nn, mb, v);
    }
    lds_barrier();
#pragma unroll
    for (int tmi = 0; tmi < 2; ++tmi) {
        const int tm = tm0 + tmi, mb = 16 * tm + 4 * g4, nn = 16 * tn + l15;
        const f32x4 x1 = mm64(lds, BUF(15), 16 * tm, BUF(4), 16 * tn, lane);
        const f32x4 x2 = mm64(lds, BUF(15), 16 * tm, BUF(8), 16 * tn, lane);
        st4(lds, BUF(0), nn, mb, x1); st4(lds, BUF(1), nn, mb, x2);
    }
    lds_barrier();
    {
        bf16_t* QT = (bf16_t*)(F.ws + WS_QT) + (size_t)unit * 4096; bf16_t* WT = (bf16_t*)(F.ws + WS_WT) + (size_t)unit * 4096; bf16_t* MP = (bf16_t*)(F.ws + WS_MP) + (size_t)unit * 4096;
#pragma unroll
        for (int tmi = 0; tmi < 2; ++tmi) {
            const int tm = tm0 + tmi, mb = 16 * tm + 4 * g4, nn = 16 * tn + l15;
            { const f32x4 v = mm64(lds, BUF(0), 16 * tm, BUF(9), 16 * tn, lane) + ld4(lds, BUF(3), nn, mb);
              *(u32x2*)(QT + (dir ? 63 - nn : nn) * 64 + mb) = pack4(v); }
            { const f32x4 v = mm64(lds, BUF(1), 16 * tm, BUF(9), 16 * tn, lane) + ld4(lds, BUF(10), nn, mb);
              if (dir) *(u32x2*)(WT + (63 - nn) * 64 + (60 - mb)) = pack4((f32x4){v[3], v[2], v[1], v[0]});
              else *(u32x2*)(WT + nn * 64 + mb) = pack4(v); }
            { f32x4 v = mm64(lds, BUF(0), 16 * tm, BUF(5), 16 * tn, lane);
#pragma unroll
              for (int e = 0; e < 4; ++e) if (mb + e == nn) v[e] += *(const LAS float*)(lds + PCOFF + nn * 4);
              *(u32x2*)(MP + nn * 64 + swap23(mb)) = pack4(v); }
            { const f32x4 v = mm64(lds, BUF(1), 16 * tm, BUF(5), 16 * tn, lane) + ld4(lds, BUF(6), nn, mb);
              st4(lds, BUF(2), nn, mb, v); }
        }
    }
    lds_barrier();
    {
        bf16_t* NBp = (bf16_t*)(F.ws + WS_NB);
#pragma unroll
        for (int tmi = 0; tmi < 2; ++tmi) {
            const int tm = tm0 + tmi, mb = 16 * tm + 4 * g4, ii = 16 * tn + l15;
            const f32x4 v = mm64(lds, BUF(2), 16 * tm, BUF(7), 16 * tn, lane);
            const int jb = mb >> 5, jl = mb & 31, q = jl >> 3, hic = (jl >> 2) & 1, ih = ii >> 5, Lc = (ii & 31) + 32 * hic;
            *(u32x2*)(NBp + ((((size_t)unit * 2 + ih) * 2 + jb) * 2 + (q >> 1)) * 512 + Lc * 8 + 4 * (q & 1)) = pack4(v);
        }
    }
    lds_barrier();
}

DI void attn_unit(const Frame& F, const LAS float* rpbl, const int au) {
    const bf16_t* HBp = (const bf16_t*)(F.ws + WS_HB); const bf16_t* VTp = (const bf16_t*)(F.ws + WS_VT); bf16_t* CONCAT = (bf16_t*)(F.ws + WS_CONCAT);
    const int hh = au % AH, r = (au / AH) % ROWS, b = au / (AH * ROWS);
    int rstart = r - KH / 2; rstart = rstart < 0 ? 0 : (rstart > ROWS - KH ? ROWS - KH : rstart);
    const int lane = F.lane, q32 = lane & 31, hi = lane >> 5;
    const float SC = 0.125f * LOG2E;
    const int krow_off = swap23(q32);
#pragma unroll 1
    for (int qb = 0; qb < 2; ++qb) {
        const int cq = 32 * qb + q32; int cs = cq - KW / 2; cs = cs < 0 ? 0 : (cs > GW - KW ? GW - KW : cs);
        const size_t tokq = (size_t)b * S + r * GW + cq;
        bf16x8 qf[4];
#pragma unroll
        for (int ds = 0; ds < 4; ++ds) qf[ds] = *(const bf16x8*)(HBp + tokq * HW + HQ + hh * HD + 16 * ds + 8 * hi);
        f32x16 o0, o1;
#pragma unroll
        for (int i = 0; i < 16; ++i) { o0[i] = 0.f; o1[i] = 0.f; }
        float mrun = -1e30f, lsum = 0.f;
#pragma unroll 1
        for (int kt = 0; kt < 2 * KH; ++kt) {
            const int kr = rstart + (kt >> 1), ckb = 32 * (kt & 1);
            const size_t ktok = (size_t)b * S + kr * GW + ckb;
            bf16x8 kf[4], vf[2][2];
#pragma unroll
            for (int ds = 0; ds < 4; ++ds) kf[ds] = *(const bf16x8*)(HBp + (ktok + krow_off) * HW + HK + hh * HD + 16 * ds + 8 * hi);
#pragma unroll
            for (int db = 0; db < 2; ++db)
#pragma unroll
                for (int s = 0; s < 2; ++s) vf[db][s] = *(const bf16x8*)(VTp + (size_t)(hh * HD + 32 * db + q32) * T + ktok + 16 * s + 8 * hi);
            f32x16 st;
#pragma unroll
            for (int i = 0; i < 16; ++i) st[i] = 0.f;
#pragma unroll
            for (int ds = 0; ds < 4; ++ds) st = MFMA32(kf[ds], qf[ds], st);
            const LAS float* rp = rpbl + (hh * (2 * KH - 1) + (kr - r + KH - 1)) * (2 * KW - 1);
            float sl[16]; float tmax = -1e30f;
#pragma unroll
            for (int i = 0; i < 16; ++i) {
                const int ck = ckb + 16 * (i >> 3) + 8 * hi + (i & 7);
                const bool inw = (ck >= cs) && (ck < cs + KW);
                int dc = ck - cq; dc = dc < -(KW - 1) ? -(KW - 1) : (dc > KW - 1 ? KW - 1 : dc); dc += KW - 1;
                sl[i] = inw ? st[i] * SC + rp[dc] : -1e30f;
                tmax = fmaxf(tmax, sl[i]);
            }
            tmax = fmaxf(tmax, __shfl_xor(tmax, 32));
            const float mn = fmaxf(mrun, tmax), corr = __builtin_amdgcn_exp2f(mrun - mn);
            float ps = 0.f;
#pragma unroll
            for (int i = 0; i < 16; ++i) { sl[i] = (sl[i] > -1e29f) ? __builtin_amdgcn_exp2f(sl[i] - mn) : 0.f; ps += sl[i]; }
            lsum = lsum * corr + ps; mrun = mn;
#pragma unroll
            for (int i = 0; i < 16; ++i) { o0[i] *= corr; o1[i] *= corr; }
            u32x4 p0, p1;
            p0.x = cvtpk(sl[0], sl[1]); p0.y = cvtpk(sl[2], sl[3]); p0.z = cvtpk(sl[4], sl[5]); p0.w = cvtpk(sl[6], sl[7]);
            p1.x = cvtpk(sl[8], sl[9]); p1.y = cvtpk(sl[10], sl[11]); p1.z = cvtpk(sl[12], sl[13]); p1.w = cvtpk(sl[14], sl[15]);
            const bf16x8 pf0 = __builtin_bit_cast(bf16x8, p0), pf1 = __builtin_bit_cast(bf16x8, p1);
            o0 = MFMA32(vf[0][0], pf0, o0); o0 = MFMA32(vf[0][1], pf1, o0);
            o1 = MFMA32(vf[1][0], pf0, o1); o1 = MFMA32(vf[1][1], pf1, o1);
        }
        const float inv = 1.f / (lsum + __shfl_xor(lsum, 32));
        bf16_t* op = CONCAT + tokq * D + hh * HD;
#pragma unroll
        for (int g = 0; g < 4; ++g) {
            *(u32x2*)(op + 8 * g + 4 * hi) = pack4((f32x4){o0[4 * g] * inv, o0[4 * g + 1] * inv, o0[4 * g + 2] * inv, o0[4 * g + 3] * inv});
            *(u32x2*)(op + 32 + 8 * g + 4 * hi) = pack4((f32x4){o1[4 * g] * inv, o1[4 * g + 1] * inv, o1[4 * g + 2] * inv, o1[4 * g + 3] * inv});
        }
    }
}

DI void pool_unit(const Frame& F, const float* pool_w, const float* pool_scale, const int pu) {
    const bf16_t* HBp = (const bf16_t*)(F.ws + WS_HB); bf16_t* CONCAT = (bf16_t*)(F.ws + WS_CONCAT);
    const int g = pu & 3, blk = pu >> 2, b = blk >> 8, t0 = (blk & 255) * 32;
    const int lane = F.lane, q32 = lane & 31, hi = lane >> 5, t = t0 + q32, win = 2 << g;
    int lo = t - win / 2; lo = lo < 0 ? 0 : lo; int hit = t + win / 2 - 1; hit = hit > S - 1 ? S - 1 : hit;
    const float inv = 1.f / (float)(hit - lo + 1);
    f32x16 out0, out1;
#pragma unroll
    for (int i = 0; i < 16; ++i) { out0[i] = 0.f; out1[i] = 0.f; }
    const float* pw = pool_w + (size_t)g * 64 * 64;
#pragma unroll 1
    for (int s = 0; s < 4; ++s) {
        const int c0 = HP + g * 64 + 16 * s + 8 * hi;
        float acc[8];
#pragma unroll
        for (int e = 0; e < 8; ++e) acc[e] = 0.f;
        u32x4 pv[16];
#pragma unroll
        for (int d = 0; d < 16; ++d) { int tt = t - win / 2 + d; const bool ok = d < win && tt >= 0 && tt < S; tt = ok ? tt : t;
            pv[d] = *(const u32x4*)(HBp + ((size_t)b * S + tt) * HW + c0); if (!ok) pv[d] = (u32x4){0u, 0u, 0u, 0u}; }
#pragma unroll
        for (int d = 0; d < 16; ++d) {
            acc[0] += bflo(pv[d].x); acc[1] += bfhi(pv[d].x); acc[2] += bflo(pv[d].y); acc[3] += bfhi(pv[d].y); acc[4] += bflo(pv[d].z); acc[5] += bfhi(pv[d].z); acc[6] += bflo(pv[d].w); acc[7] += bfhi(pv[d].w);
        }
        const u32x4 pc = *(const u32x4*)(HBp + ((size_t)b * S + t) * HW + c0);
        u32x4 o;
        o.x = cvtpk(acc[0] * inv - bflo(pc.x), acc[1] * inv - bfhi(pc.x)); o.y = cvtpk(acc[2] * inv - bflo(pc.y), acc[3] * inv - bfhi(pc.y));
        o.z = cvtpk(acc[4] * inv - bflo(pc.z), acc[5] * inv - bfhi(pc.z)); o.w = cvtpk(acc[6] * inv - bflo(pc.w), acc[7] * inv - bfhi(pc.w));
        const bf16x8 bfr = __builtin_bit_cast(bf16x8, o);
        const float* wp = pw + (size_t)(16 * s + 8 * hi) * 64 + q32;
        u32x4 w0; w0.x = cvtpk(wp[0], wp[64]); w0.y = cvtpk(wp[128], wp[192]); w0.z = cvtpk(wp[256], wp[320]); w0.w = cvtpk(wp[384], wp[448]);
        u32x4 w1; w1.x = cvtpk(wp[32], wp[96]); w1.y = cvtpk(wp[160], wp[224]); w1.z = cvtpk(wp[288], wp[352]); w1.w = cvtpk(wp[416], wp[480]);
        out0 = MFMA32(__builtin_bit_cast(bf16x8, w0), bfr, out0);
        out1 = MFMA32(__builtin_bit_cast(bf16x8, w1), bfr, out1);
    }
    bf16_t* op = CONCAT + ((size_t)b * S + t) * D + AW + BW + g * 64;
    const float* ps = pool_scale + g * 64;
#pragma unroll
    for (int gq = 0; gq < 4; ++gq) {
        const int e0 = 8 * gq + 4 * hi;
        const f32x4 s0 = *(const f32x4*)(ps + e0), s1 = *(const f32x4*)(ps + 32 + e0);
        *(u32x2*)(op + e0) = pack4((f32x4){out0[4 * gq] * s0[0], out0[4 * gq + 1] * s0[1], out0[4 * gq + 2] * s0[2], out0[4 * gq + 3] * s0[3]});
        *(u32x2*)(op + 32 + e0) = pack4((f32x4){out1[4 * gq] * s1[0], out1[4 * gq + 1] * s1[1], out1[4 * gq + 2] * s1[2], out1[4 * gq + 3] * s1[3]});
    }
}

constexpr int SCAN_SLOT = 12288, SCAN_RING = 12;
constexpr int SCAN_FLAGS = SCAN_RING * SCAN_SLOT;
DI void scan_issue(const Frame& F, const int sc, const int ihalf, const int dir, const int step, const int lane) {
    const int c = dir ? NCH - 1 - step : step; const size_t unit = (size_t)sc * NCH + c;
    const int il = lane & 31, hi = lane >> 5;
    LAS unsigned char* slot = F.lds + (step % SCAN_RING) * SCAN_SLOT;
    const bf16_t* MP = (const bf16_t*)(F.ws + WS_MP) + unit * 4096; const bf16_t* NBp = (const bf16_t*)(F.ws + WS_NB) + (unit * 2 + ihalf) * 2048;
#pragma unroll
    for (int p = 0; p < 8; ++p) { const int jpb = p >> 2, jb = (p >> 1) & 1, s = p & 1;
        __builtin_amdgcn_global_load_lds((const unsigned*)(MP + (32 * jpb + il) * 64 + 32 * jb + 16 * s + 8 * hi), (LAS unsigned*)(slot + p * 1024), 16, 0, 0); }
#pragma unroll
    for (int p = 0; p < 4; ++p)
        __builtin_amdgcn_global_load_lds((const unsigned*)(NBp + p * 512 + lane * 8), (LAS unsigned*)(slot + 8192 + p * 1024), 16, 0, 0);
}
DI unsigned lds_ld_u32(const volatile LAS unsigned* p) { return __builtin_amdgcn_readfirstlane(*p); }
DI void scan_loader(const Frame& F, const int sw, const int ld) {
    const int ihalf = sw & 1, sc = sw >> 1, dir = sc / (NB * BH);
    volatile LAS unsigned* ready = (volatile LAS unsigned*)(F.lds + SCAN_FLAGS); volatile LAS unsigned* cons = ready + 16;
    const int nmine = NCH / 2;
    for (int k = 0; k < nmine + 5; ++k) {
        if (k < nmine) {
            const int s = 2 * k + ld;
            if (s >= SCAN_RING) { unsigned spins = 0; while ((int)lds_ld_u32(cons) < s - SCAN_RING + 1) { __builtin_amdgcn_s_sleep(1); if (++spins > (1u << 22)) break; } }
            asm volatile("" ::: "memory");
            scan_issue(F, sc, ihalf, dir, s, F.lane);
        }
        if (k >= 4) {
            const int kd = k - 4;
            if (kd < nmine) {
                const int rem = nmine - 1 - kd;
                if (rem >= 4) asm volatile("s_waitcnt vmcnt(48)" ::: "memory");
                else if (rem == 3) asm volatile("s_waitcnt vmcnt(36)" ::: "memory");
                else if (rem == 2) asm volatile("s_waitcnt vmcnt(24)" ::: "memory");
                else if (rem == 1) asm volatile("s_waitcnt vmcnt(12)" ::: "memory");
                else asm volatile("s_waitcnt vmcnt(0)" ::: "memory");
                const int sd = 2 * kd + ld;
                if (F.lane == 0) ready[sd % SCAN_RING] = (unsigned)(sd + 1);
                asm volatile("s_waitcnt lgkmcnt(0)" ::: "memory");
            }
        }
    }
}
DI void scan_wave(const Frame& F, const int sw) {
    const int ihalf = sw & 1, sc = sw >> 1, dir = sc / (NB * BH);
    const int lane = F.lane, il = lane & 31, hi = lane >> 5;
    bf16_t* S0 = (bf16_t*)(F.ws + WS_S0);
    volatile LAS unsigned* ready = (volatile LAS unsigned*)(F.lds + SCAN_FLAGS); volatile LAS unsigned* cons = ready + 16;
    f32x16 st0, st1;
#pragma unroll
    for (int i = 0; i < 16; ++i) { st0[i] = 0.f; st1[i] = 0.f; }
    bf16x8 ma[8], man[8]; u32x4 nbv[4], nbn[4];
    { unsigned spins = 0; while (lds_ld_u32(ready) != 1u) { __builtin_amdgcn_s_sleep(1); if (++spins > (1u << 22)) break; } }
    asm volatile("" ::: "memory");
#pragma unroll
    for (int p = 0; p < 8; ++p) ma[p] = *(const LAS bf16x8*)(F.lds + p * 1024 + lane * 16);
#pragma unroll
    for (int p = 0; p < 4; ++p) nbv[p] = *(const LAS u32x4*)(F.lds + 8192 + p * 1024 + lane * 16);
#pragma unroll 1
    for (int step = 0; step < NCH; ++step) {
        const int c = dir ? NCH - 1 - step : step; const size_t unit = (size_t)sc * NCH + c;
        const bool more = step + 1 < NCH;
        if (more) {
            { unsigned spins = 0; while (lds_ld_u32(ready + ((step + 1) % SCAN_RING)) != (unsigned)(step + 2)) { __builtin_amdgcn_s_sleep(1); if (++spins > (1u << 22)) break; } }
            asm volatile("" ::: "memory");
            const LAS unsigned char* slot = F.lds + ((step + 1) % SCAN_RING) * SCAN_SLOT;
#pragma unroll
            for (int p = 0; p < 8; ++p) man[p] = *(const LAS bf16x8*)(slot + p * 1024 + lane * 16);
#pragma unroll
            for (int p = 0; p < 4; ++p) nbn[p] = *(const LAS u32x4*)(slot + 8192 + p * 1024 + lane * 16);
        }
        bf16_t* sp = S0 + unit * 4096 + (size_t)(32 * ihalf + il) * 64;
        u32x4 b00, b01, b10, b11;
        b00.x = cvtpk(st0[0], st0[1]); b00.y = cvtpk(st0[2], st0[3]); b00.z = cvtpk(st0[4], st0[5]); b00.w = cvtpk(st0[6], st0[7]);
        b01.x = cvtpk(st0[8], st0[9]); b01.y = cvtpk(st0[10], st0[11]); b01.z = cvtpk(st0[12], st0[13]); b01.w = cvtpk(st0[14], st0[15]);
        b10.x = cvtpk(st1[0], st1[1]); b10.y = cvtpk(st1[2], st1[3]); b10.z = cvtpk(st1[4], st1[5]); b10.w = cvtpk(st1[6], st1[7]);
        b11.x = cvtpk(st1[8], st1[9]); b11.y = cvtpk(st1[10], st1[11]); b11.z = cvtpk(st1[12], st1[13]); b11.w = cvtpk(st1[14], st1[15]);
        *(u32x2*)(sp + 0 + 4 * hi) = (u32x2){b00.x, b00.y};  *(u32x2*)(sp + 8 + 4 * hi) = (u32x2){b00.z, b00.w};
        *(u32x2*)(sp + 16 + 4 * hi) = (u32x2){b01.x, b01.y}; *(u32x2*)(sp + 24 + 4 * hi) = (u32x2){b01.z, b01.w};
        *(u32x2*)(sp + 32 + 4 * hi) = (u32x2){b10.x, b10.y}; *(u32x2*)(sp + 40 + 4 * hi) = (u32x2){b10.z, b10.w};
        *(u32x2*)(sp + 48 + 4 * hi) = (u32x2){b11.x, b11.y}; *(u32x2*)(sp + 56 + 4 * hi) = (u32x2){b11.z, b11.w};
        const bf16x8 p00 = __builtin_bit_cast(bf16x8, b00), p01 = __builtin_bit_cast(bf16x8, b01), p10 = __builtin_bit_cast(bf16x8, b10), p11 = __builtin_bit_cast(bf16x8, b11);
        f32x16 n0, n1;
#pragma unroll
        for (int h2 = 0; h2 < 2; ++h2) {
            n0[8 * h2 + 0] = bflo(nbv[h2].x); n0[8 * h2 + 1] = bfhi(nbv[h2].x); n0[8 * h2 + 2] = bflo(nbv[h2].y); n0[8 * h2 + 3] = bfhi(nbv[h2].y);
            n0[8 * h2 + 4] = bflo(nbv[h2].z); n0[8 * h2 + 5] = bfhi(nbv[h2].z); n0[8 * h2 + 6] = bflo(nbv[h2].w); n0[8 * h2 + 7] = bfhi(nbv[h2].w);
            n1[8 * h2 + 0] = bflo(nbv[2 + h2].x); n1[8 * h2 + 1] = bfhi(nbv[2 + h2].x); n1[8 * h2 + 2] = bflo(nbv[2 + h2].y); n1[8 * h2 + 3] = bfhi(nbv[2 + h2].y);
            n1[8 * h2 + 4] = bflo(nbv[2 + h2].z); n1[8 * h2 + 5] = bfhi(nbv[2 + h2].z); n1[8 * h2 + 6] = bflo(nbv[2 + h2].w); n1[8 * h2 + 7] = bfhi(nbv[2 + h2].w);
        }
        n0 = MFMA32(ma[0], p00, n0); n1 = MFMA32(ma[4], p00, n1);
        n0 = MFMA32(ma[1], p01, n0); n1 = MFMA32(ma[5], p01, n1);
        n0 = MFMA32(ma[2], p10, n0); n1 = MFMA32(ma[6], p10, n1);
        n0 = MFMA32(ma[3], p11, n0); n1 = MFMA32(ma[7], p11, n1);
        st0 = n0; st1 = n1;
        if (more) {
            asm volatile("s_waitcnt lgkmcnt(0)" ::: "memory");
            if (lane == 0) *cons = (unsigned)(step + 2);
#pragma unroll
            for (int p = 0; p < 8; ++p) ma[p] = man[p];
#pragma unroll
            for (int p = 0; p < 4; ++p) nbv[p] = nbn[p];
        }
    }
}

DI void rwkv_out_unit(const Frame& F, const RwP& P, const int du) {
    const int qd = du & 3, cidx = du >> 2, c = cidx % NCH, hd = (cidx / NCH) % BH, b = cidx / (NCH * BH);
    const int lane = F.lane, n = lane & 15, g = lane >> 4, u = 16 * qd + n;
    const bf16_t* QT = (const bf16_t*)(F.ws + WS_QT); const bf16_t* WT = (const bf16_t*)(F.ws + WS_WT); const bf16_t* S0 = (const bf16_t*)(F.ws + WS_S0);
    const bf16_t* VTB = (const bf16_t*)(F.ws + WS_VTB) + (size_t)cidx * 4096;
    f32x4 acc[4];
#pragma unroll
    for (int tm = 0; tm < 4; ++tm) acc[tm] = (f32x4){0.f, 0.f, 0.f, 0.f};
#pragma unroll
    for (int dir = 0; dir < 2; ++dir) {
        const size_t unit = (((size_t)dir * NB + b) * BH + hd) * NCH + c;
#pragma unroll
        for (int ks = 0; ks < 2; ++ks) {
            const bf16x8 bq = *(const bf16x8*)(QT + unit * 4096 + u * 64 + 32 * ks + 8 * g);
            const bf16x8 bw = *(const bf16x8*)(WT + unit * 4096 + u * 64 + 32 * ks + 8 * g);
#pragma unroll
            for (int tm = 0; tm < 4; ++tm) {
                const bf16x8 as = *(const bf16x8*)(S0 + unit * 4096 + (16 * tm + n) * 64 + 32 * ks + 8 * g);
                const bf16x8 av = *(const bf16x8*)(VTB + (16 * tm + n) * 64 + 32 * ks + 8 * g);
                acc[tm] = MFMA16(as, bq, acc[tm]); acc[tm] = MFMA16(av, bw, acc[tm]);
            }
        }
    }
    float s = 0.f;
#pragma unroll
    for (int tm = 0; tm < 4; ++tm) s += (acc[tm][0] + acc[tm][1]) + (acc[tm][2] + acc[tm][3]);
    s += __shfl_xor(s, 16); s += __shfl_xor(s, 32);
    const float mu = s * (1.f / HD); float q = 0.f;
#pragma unroll
    for (int tm = 0; tm < 4; ++tm) { acc[tm] = acc[tm] - mu; q += (acc[tm][0] * acc[tm][0] + acc[tm][1] * acc[tm][1]) + (acc[tm][2] * acc[tm][2] + acc[tm][3] * acc[tm][3]); }
    q += __shfl_xor(q, 16); q += __shfl_xor(q, 32);
    const float rstd = 1.f / sqrtf(q * (1.f / HD) + GN_EPS);
    const size_t tok = (size_t)b * S + 64 * c + u;
    const float* BS = (const float*)(F.ws + WS_BS);
    const float bsum = BS[tok * 8 + hd] + BS[((size_t)T + tok) * 8 + hd];
    const bf16_t* VC = (const bf16_t*)(F.ws + WS_VC) + tok * BW + hd * HD; const bf16_t* GBp = (const bf16_t*)(F.ws + WS_GB) + tok * BW + hd * HD;
    bf16_t* op = (bf16_t*)(F.ws + WS_CONCAT) + tok * D + AW + hd * HD;
#pragma unroll
    for (int tm = 0; tm < 4; ++tm) {
        const int i0 = 16 * tm + 4 * g;
        const f32x4 vv = unpack4(*(const u32x2*)(VC + i0)), gg = unpack4(*(const u32x2*)(GBp + i0));
        const f32x4 gn = *(const f32x4*)(P.gn_gain + hd * HD + i0), gb = *(const f32x4*)(P.gn_bias + hd * HD + i0);
        *(u32x2*)(op + i0) = pack4((acc[tm] * rstd * gn + gb + vv * bsum) * gg);
    }
}

DI RwP make_rwp(const Args& a, int l) {
    RwP p;
    p.conv = a.in[6] + (size_t)l * 3 * 3 * BW; p.w0 = a.in[7] + (size_t)l * 2 * BW; p.w_up = a.in[8] + (size_t)l * 2 * RW * BW;
    p.a0 = a.in[9] + (size_t)l * 2 * BW; p.a_up = a.in[10] + (size_t)l * 2 * RA * BW; p.g_up = a.in[11] + (size_t)l * RG * BW;
    p.k_k = a.in[12] + (size_t)l * BW; p.k_a = a.in[13] + (size_t)l * BW; p.r_k = a.in[14] + (size_t)l * BH * HD;
    p.gn_gain = a.in[15] + (size_t)l * BW; p.gn_bias = a.in[16] + (size_t)l * BW;
    return p;
}
DI void p_gemm1(const Frame& F, int l) {
    pg8::Gemm1Order S; S.U = (const bf16_t*)(F.ws + WS_U); S.Win = (const bf16_t*)(F.ws + WS_WIN + (size_t)l * WIN_LAYER); S.Wv = S.Win + (size_t)HW * D; S.G = F.G; S.c = F.bx;
    pg8::EpiStore E{(bf16_t*)(F.ws + WS_HB), HW, (bf16_t*)(F.ws + WS_VT), T};
    pg8::gemm_phase(F.lds, F.tid, D, S, E);
}
DI void p_mixer_local(const Frame& F, const Args& a, int l) {
    {
      const float* conv = a.in[6] + (size_t)l * 3 * 3 * BW;
#pragma unroll 7
      for (int i = F.tid; i < BH * 9 * 64; i += NTHREADS) { const int j = i & 63, q = i >> 6, which = q % 3, x = (q / 3) % 3, hd = q / 9;
          *(LAS bf16_t*)(F.lds + CWLOFF + i * 2) = f2bf(conv[x * 3 * BW + which * BW + hd * HD + j]); }
      RwPre PF;
      if (F.bx < NUNIT) rwkv_prefetch(F, a, l, F.bx, PF);
      __syncthreads();
      for (int unit = F.bx; unit < NUNIT; unit += F.G) rwkv_local_unit(F, a, l, unit, PF, unit + F.G < NUNIT ? unit + F.G : -1);
    }
    LAS float* rpbl = (LAS float*)F.lds;
    const float* rpb = a.in[5] + (size_t)l * AH * (2 * KH - 1) * (2 * KW - 1);
#pragma unroll 6
    for (int i = F.tid; i < AH * (2 * KH - 1) * (2 * KW - 1); i += NTHREADS) rpbl[i] = rpb[i] * LOG2E;
    __syncthreads();
    for (int au = F.gw; au < NB * ROWS * AH; au += F.ngw) attn_unit(F, rpbl, au);
#ifdef DBL_ATTN
    for (int au = F.gw; au < NB * ROWS * AH; au += F.ngw) attn_unit(F, rpbl, au);
#endif
    for (int pu = F.gw; pu < NB * (S / 32) * 4; pu += F.ngw) pool_unit(F, a.in[17] + (size_t)l * NG * 64 * 64, a.in[18] + (size_t)l * CW, pu);
}
DI void p_scan(const Frame& F, const Args& a, int l) {
    constexpr int NSCAN = 2 * 2 * NB * BH;
    if (F.bx < NSCAN) {
        volatile LAS unsigned* fl = (volatile LAS unsigned*)(F.lds + SCAN_FLAGS);
        if (F.tid < 32) fl[F.tid] = 0u;
        __syncthreads();
        if (F.wave == 0) scan_wave(F, F.bx); else if (F.wave <= 2) scan_loader(F, F.bx, F.wave - 1);
        return;
    }
#if TESTMODE != 2
    LAS float* scr = (LAS float*)F.lds + F.wave * (64 * 65);
#ifdef DBL_CONV
    for (int rep = 0; rep < 2; ++rep)
#endif
    { f32x4 cur[16], nxt[16]; const int st = (F.G - NSCAN) * NWAVES; int it = (F.bx - NSCAN) * NWAVES + F.wave; TItem tc{}, tn{};
      if (it < IT_MOE) { tc = moe_item(F, a.in[28], a.in[29], a.in[30], l, it); titem_load(tc, cur, F.lane); }
      for (; it < IT_MOE; it += st) {
          const bool more = it + st < IT_MOE;
          if (more) { tn = moe_item(F, a.in[28], a.in[29], a.in[30], l, it + st); titem_load(tn, nxt, F.lane); }
          titem_store(tc, cur, scr, F.lane);
          if (more) { tc = tn;
#pragma unroll
              for (int i = 0; i < 16; ++i) cur[i] = nxt[i]; }
      } }
#endif
}
DI void p_rwkv_out(const Frame& F, const Args& a, int l) {
    const RwP P = make_rwp(a, l);
    for (int du = F.gw; du < NB * BH * NCH * 4; du += F.ngw) rwkv_out_unit(F, P, du);
}
DI void p_gemm2(const Frame& F, int l) {
    pg8::PlainOrder S; S.init((const bf16_t*)(F.ws + WS_CONCAT), (const bf16_t*)(F.ws + WS_WOUT) + (size_t)l * D * D, T, D, D, F.G, F.bx);
    pg8::EpiStore E{(bf16_t*)(F.ws + WS_MIX), D, nullptr, 0};
    pg8::gemm_phase(F.lds, F.tid, D, S, E);
}
DI void p_moe_a(const Frame& F, int l) {
    LAS int* tb = (LAS int*)(F.lds + LDS_MISC);
    build_tables(F, l, tb);
    pg8::GroupedOrder S; S.A = (const bf16_t*)(F.ws + WS_XS); S.Bt = (const bf16_t*)(F.ws + WS_WGU); S.K = D; S.estride = (size_t)D * D; S.tile_e = tb + 66; S.ntiles = tb[65]; S.nwg = S.ntiles * 4; S.G = F.G; S.c = F.bx;
    pg8::EpiSwiGlu E{(bf16_t*)(F.ws + WS_HM)};
    pg8::gemm_phase(F.lds, F.tid, D, S, E);
}
DI void p_moe_b(const Frame& F, int l) {
    LAS int* tb = (LAS int*)(F.lds + LDS_MISC);
    build_tables(F, l, tb);
    pg8::GroupedOrder S; S.A = (const bf16_t*)(F.ws + WS_HM); S.Bt = (const bf16_t*)(F.ws + WS_WD); S.K = DE; S.estride = (size_t)D * DE; S.tile_e = tb + 66; S.ntiles = tb[65]; S.nwg = S.ntiles * 4; S.G = F.G; S.c = F.bx;
    pg8::EpiRowScale E{(bf16_t*)(F.ws + WS_YS), (const float*)(F.ws + WS_SLOTW)};
    pg8::gemm_phase(F.lds, F.tid, DE, S, E);
}

#ifndef DBLMASK
#define DBLMASK 0
#endif
constexpr int PH_PER_LAYER = 10, N_PHASES = 2 + L * PH_PER_LAYER;
DI bool in_ph(int k, int lo, int hi) { lo = __builtin_amdgcn_readfirstlane(lo); hi = __builtin_amdgcn_readfirstlane(hi); asm volatile("" : "+s"(lo), "+s"(hi)); return lo <= k && k < hi; }
DI Frame fresh(const Frame& F0) {
    Frame F = F0; int t = F0.tid, b = F0.bx;
    b = __builtin_amdgcn_readfirstlane(b); asm volatile("" : "+v"(t)); asm volatile("" : "+s"(b));
    F.tid = t; F.lane = t & 63; F.wave = __builtin_amdgcn_readfirstlane(t >> 6); F.bx = b;
    F.vcu = (F.G % 8 == 0) ? (b % 8) * (F.G / 8) + b / 8 : b; F.gw = F.vcu * NWAVES + F.wave;
    return F;
}

__global__ void __launch_bounds__(NTHREADS, 2) mk_fwd(Args a) {
    extern __shared__ __attribute__((aligned(16))) unsigned char lds_raw[];
    Frame F;
    F.lds = (LAS unsigned char*)lds_raw;
    F.tid = threadIdx.x; F.lane = F.tid & 63; F.wave = __builtin_amdgcn_readfirstlane(F.tid >> 6);
    F.G = gridDim.x; F.bx = blockIdx.x; { const int bx = blockIdx.x; F.vcu = (F.G % 8 == 0) ? (bx % 8) * (F.G / 8) + bx / 8 : bx; }
    F.gw = F.vcu * NWAVES + F.wave; F.ngw = F.G * NWAVES; F.ws = a.ws;
    volatile LAS unsigned* bst = (volatile LAS unsigned*)(F.lds + LDS_BARST);
    if (F.tid < 16) bst[F.tid] = 0u;
    __syncthreads();
    cg::grid_group grid = cg::this_grid();
    XcdBarrier bar; bar.bar = (unsigned*)(a.ws + WS_CTL) + CW_BAR; bar.x = 0; bar.st = bst;
    const bool multi = (a.ph_hi - a.ph_lo) > 1;
    if (multi && !a.use_cg) bar = xcd_barrier_post((unsigned*)(a.ws + WS_CTL) + CW_BAR, bst);
    const int lo = a.ph_lo, hi = a.ph_hi;
#define IN(k) in_ph((k), lo, hi)
#ifndef DBLSEAM
#define DBLSEAM 0
#endif
#define SEAM(k) do { if (IN(k) && IN((k) + 1)) { if (a.use_cg) grid.sync(); else { xcd_barrier(bar); if (DBLSEAM) xcd_barrier(bar); } } } while (0)
    if (IN(0)) { p0_prologue(fresh(F), a); if ((DBLMASK >> 11) & 1) p0_prologue(fresh(F), a); }
    SEAM(0);
    if (IN(1)) { p_r0(fresh(F), a.in[0]); if ((DBLMASK >> 12) & 1) p_r0(fresh(F), a.in[0]); }
    SEAM(1);
#define RUN(k, call) do { if (IN(pb + (k))) { call; if ((DBLMASK >> (k)) & 1) { call; } } } while (0)
#define LAYER(l) do { \
        const int pb = 2 + PH_PER_LAYER * (l); \
        RUN(0, p_gemm1(fresh(F), (l))); \
        SEAM(pb + 0); \
        RUN(1, p_mixer_local(fresh(F), a, (l))); \
        SEAM(pb + 1); \
        RUN(2, p_scan(fresh(F), a, (l))); \
        SEAM(pb + 2); \
        RUN(3, p_rwkv_out(fresh(F), a, (l))); \
        SEAM(pb + 3); \
        RUN(4, p_gemm2(fresh(F), (l))); \
        SEAM(pb + 4); \
        RUN(5, p_rowpass1(fresh(F), a, (l), (l) == 0 ? a.in[0] : a.out)); \
        if (IN(pb + 5) && ((DBLMASK >> 10) & 1)) p_rowpass1(fresh(F), a, (l), (l) == 0 ? a.in[0] : a.out, true); \
        SEAM(pb + 5); \
        RUN(6, p_gather(fresh(F), (l))); \
        SEAM(pb + 6); \
        RUN(7, p_moe_a(fresh(F), (l))); \
        SEAM(pb + 7); \
        RUN(8, p_moe_b(fresh(F), (l))); \
        SEAM(pb + 8); \
        RUN(9, p_rowpass2(fresh(F), a, (l), a.out)); \
        SEAM(pb + 9); \
    } while (0)
    LAYER(0);
    LAYER(1);
#undef LAYER
#undef IN
#undef SEAM
}

#ifndef MK_MODE
#define MK_MODE 0
#endif
#ifndef TESTMODE
#define TESTMODE 0
#endif

static void fill_args(Args& a, void* const* d_in, void* d_out, void* d_ws) {
    for (int i = 0; i < 31; ++i) a.in[i] = (const float*)d_in[i];
    a.out = (float*)d_out; a.ws = (unsigned char*)d_ws; a.ph_lo = 0; a.ph_hi = N_PHASES; a.use_cg = 0; a.pad = 0;
}
static void launch_phases(Args a, int lo, int hi, hipStream_t stream) {
    for (int p = lo; p < hi; ++p) { a.ph_lo = p; a.ph_hi = p + 1; hipLaunchKernelGGL(mk_fwd, dim3(256), dim3(NTHREADS), LDS_BYTES, stream, a); }
}

#if TESTMODE == 0
extern "C" void kernel_launch(void* const* d_in, const int* in_sizes, int n_in, void* d_out, int out_size, void* d_ws, size_t ws_size, hipStream_t stream) {
    static int grid = 0;
    if (grid == 0) {
        int dev = 0, cus = 0, per_cu = 0;
        (void)hipGetDevice(&dev); (void)hipDeviceGetAttribute(&cus, hipDeviceAttributeMultiprocessorCount, dev);
        (void)hipFuncSetAttribute((const void*)mk_fwd, hipFuncAttributeMaxDynamicSharedMemorySize, LDS_BYTES);
        (void)hipOccupancyMaxActiveBlocksPerMultiprocessor(&per_cu, (const void*)mk_fwd, NTHREADS, LDS_BYTES);
        (void)hipGetLastError();
        grid = (cus > 0 ? cus : 256) * 1;
        if (ws_size < WS_END || n_in != 31) grid = -1;
    }
    if (grid < 0) return;
    (void)hipMemsetAsync((char*)d_ws + WS_CTL, 0, CTL_BYTES, stream);
    Args a{}; fill_args(a, d_in, d_out, d_ws);
#if MK_MODE == 2
    launch_phases(a, 0, N_PHASES, stream);
#else
    a.use_cg = (MK_MODE == 1) ? 1 : 0;
    void* args[] = {&a};
    (void)hipLaunchCooperativeKernel((const void*)mk_fwd, dim3(grid), dim3(NTHREADS), args, LDS_BYTES, stream);
#endif
}
#endif

#if TESTMODE > 0
constexpr int O_A = 1152, O_B = 2304, O_W = 2336, O_AL = 2368, O_G = 2432;
struct HSrc { const bf16_t* HB; const bf16_t* VT;
    DI float at(size_t tok, int n) const { if (n < 768) return bf2f(HB[tok * HW + n]); if (n < 1152) return bf2f(VT[(size_t)(n - 768) * T + tok]); return bf2f(HB[tok * HW + n - 384]); } };
DI float sigm_n(float x) { return 1.f / (1.f + expf(-x)); }

__global__ void k_mod_n(const float* __restrict__ c, const float* __restrict__ w_mod, const float* __restrict__ b_mod, float* __restrict__ mod) {
    __shared__ float sc[NB * D];
    for (int i = threadIdx.x; i < NB * D; i += blockDim.x) { float v = c[i]; sc[i] = v * sigm_n(v); }
    __syncthreads();
    int idx = blockIdx.x * blockDim.x + threadIdx.x; int l = idx / MODW, n = idx % MODW;
    const float* w = w_mod + (size_t)l * D * MODW + n; float a0 = 0.f, a1 = 0.f;
    for (int k = 0; k < D; ++k) { float wv = w[(size_t)k * MODW]; a0 += sc[k] * wv; a1 += sc[D + k] * wv; }
    float bb = b_mod[l * MODW + n];
    mod[(size_t)(l * NB + 0) * MODW + n] = a0 + bb; mod[(size_t)(l * NB + 1) * MODW + n] = a1 + bb;
}
__global__ void k_ln_mod_n(const float* __restrict__ xin, const float* __restrict__ modl, int off_sh, int off_sc, float* __restrict__ uout) {
    int row = (blockIdx.x * blockDim.x + threadIdx.x) >> 6, lane = threadIdx.x & 63; if (row >= T) return; int b = row / S;
    f32x4 v[4];
#pragma unroll
    for (int j = 0; j < 4; ++j) v[j] = *(const f32x4*)(xin + (size_t)row * D + 4 * lane + 256 * j);
    float mean, rstd; row_ln(v, mean, rstd);
    const float* md = modl + (size_t)b * MODW;
#pragma unroll
    for (int j = 0; j < 4; ++j) { int col = 4 * lane + 256 * j; *(f32x4*)(uout + (size_t)row * D + col) = v[j] * rstd * (1.f + *(const f32x4*)(md + off_sc + col)) + *(const f32x4*)(md + off_sh + col); }
}
__global__ void k_post_n(const float* xin, const float* br, const float* __restrict__ modl, int off_gate, const float* __restrict__ gain, const float* __restrict__ bias, float* xout, float* u2out, int off_sh2, int off_sc2) {
    int row = (blockIdx.x * blockDim.x + threadIdx.x) >> 6, lane = threadIdx.x & 63; if (row >= T) return; int b = row / S;
    const float* md = modl + (size_t)b * MODW; f32x4 v[4];
#pragma unroll
    for (int j = 0; j < 4; ++j) { int col = 4 * lane + 256 * j; v[j] = *(const f32x4*)(xin + (size_t)row * D + col) * ALPHA + *(const f32x4*)(md + off_gate + col) * *(const f32x4*)(br + (size_t)row * D + col); }
    float mean, rstd; row_ln(v, mean, rstd);
#pragma unroll
    for (int j = 0; j < 4; ++j) { int col = 4 * lane + 256 * j; v[j] = v[j] * rstd * *(const f32x4*)(gain + col) + *(const f32x4*)(bias + col); *(f32x4*)(xout + (size_t)row * D + col) = v[j]; }
    if (u2out == nullptr) return;
    row_ln(v, mean, rstd);
#pragma unroll
    for (int j = 0; j < 4; ++j) { int col = 4 * lane + 256 * j; *(f32x4*)(u2out + (size_t)row * D + col) = v[j] * rstd * (1.f + *(const f32x4*)(md + off_sc2 + col)) + *(const f32x4*)(md + off_sh2 + col); }
}
__global__ void __launch_bounds__(256) k_gemm_f32(const float* __restrict__ A, int lda, const float* __restrict__ B, int ldb, float* __restrict__ C, int ldc, int K) {
    __shared__ float As[16][65]; __shared__ float Bs[16][64];
    const int tx = threadIdx.x & 15, ty = threadIdx.x >> 4; const int m0 = blockIdx.y * 64, n0 = blockIdx.x * 64;
    float acc[4][4];
#pragma unroll
    for (int i = 0; i < 4; ++i)
#pragma unroll
        for (int j = 0; j < 4; ++j) acc[i][j] = 0.f;
    for (int k0 = 0; k0 < K; k0 += 16) {
#pragma unroll
        for (int i = 0; i < 4; ++i) { int e = threadIdx.x + 256 * i; int m = e >> 4, k = e & 15; As[k][m] = A[(size_t)(m0 + m) * lda + k0 + k]; }
#pragma unroll
        for (int i = 0; i < 4; ++i) { int e = threadIdx.x + 256 * i; int k = e >> 6, n = e & 63; Bs[k][n] = B[(size_t)(k0 + k) * ldb + n0 + n]; }
        __syncthreads();
#pragma unroll
        for (int k = 0; k < 16; ++k) { float a[4], b[4];
#pragma unroll
            for (int i = 0; i < 4; ++i) { a[i] = As[k][ty * 4 + i]; b[i] = Bs[k][tx * 4 + i]; }
#pragma unroll
            for (int i = 0; i < 4; ++i)
#pragma unroll
                for (int j = 0; j < 4; ++j) acc[i][j] += a[i] * b[j]; }
        __syncthreads();
    }
#pragma unroll
    for (int i = 0; i < 4; ++i) *(float4*)(C + (size_t)(m0 + ty * 4 + i) * ldc + n0 + tx * 4) = make_float4(acc[i][0], acc[i][1], acc[i][2], acc[i][3]);
}
__global__ void __launch_bounds__(64) k_attn_n(HSrc h, const float* __restrict__ rpb, float* __restrict__ concat) {
    int idx = blockIdx.x * blockDim.x + threadIdx.x; if (idx >= T * AH) return;
    int head = idx % AH, tok = idx / AH; int b = tok / S, t = tok % S, r = t / GW, cq = t % GW;
    int rstart = r - KH / 2; rstart = rstart < 0 ? 0 : (rstart > ROWS - KH ? ROWS - KH : rstart);
    int cstart = cq - KW / 2; cstart = cstart < 0 ? 0 : (cstart > GW - KW ? GW - KW : cstart);
    float q[HD], acc[HD];
#pragma unroll
    for (int d = 0; d < HD; ++d) { q[d] = h.at(tok, head * HD + d); acc[d] = 0.f; }
    float m = -1e30f, l = 0.f; const float* rp = rpb + (size_t)head * 15 * 31;
    for (int kk = 0; kk < KH; ++kk) { int kr = rstart + kk; int dr = kr - r + (KH - 1);
        for (int j = 0; j < KW; ++j) { int ck = cstart + j; int dc = ck - cq; dc = dc < -15 ? -15 : (dc > 15 ? 15 : dc); dc += 15;
            size_t kt = (size_t)b * S + kr * GW + ck; float s = 0.f;
#pragma unroll
            for (int d = 0; d < HD; ++d) s += q[d] * h.at(kt, AW + head * HD + d);
            s = s * 0.125f + rp[dr * 31 + dc];
            float mn = fmaxf(m, s); float corr = expf(m - mn); float p = expf(s - mn); l = l * corr + p;
#pragma unroll
            for (int d = 0; d < HD; ++d) acc[d] = acc[d] * corr + p * h.at(kt, 2 * AW + head * HD + d);
            m = mn; } }
    float inv = 1.f / l;
#pragma unroll
    for (int d = 0; d < HD; ++d) concat[(size_t)tok * D + head * HD + d] = acc[d] * inv;
}
__global__ void __launch_bounds__(256) k_pool_n(HSrc h, const float* __restrict__ pool_w, const float* __restrict__ pool_scale, float* __restrict__ concat) {
    __shared__ float pooled[CW];
    int tok = blockIdx.x; int b = tok / S, t = tok % S; int ch = threadIdx.x; int g = ch / 64; int win = 2 << g;
    int lo = t - win / 2; lo = lo < 0 ? 0 : lo; int hi = t + win / 2 - 1; hi = hi > S - 1 ? S - 1 : hi;
    float s = 0.f; for (int u = lo; u <= hi; ++u) s += h.at((size_t)b * S + u, O_G + ch);
    pooled[ch] = s / (float)(hi - lo + 1) - h.at(tok, O_G + ch);
    __syncthreads();
    int e = ch % 64; const float* pw = pool_w + (size_t)g * 64 * 64 + e; float a = 0.f;
    for (int c2 = 0; c2 < 64; ++c2) a += pooled[g * 64 + c2] * pw[c2 * 64];
    concat[(size_t)tok * D + AW + BW + ch] = a * pool_scale[ch];
}
__global__ void __launch_bounds__(64) k_rwkv_scan_n(HSrc h, RwP p, float* __restrict__ ys) {
    const int lane = threadIdx.x; const int dir = blockIdx.x / (NB * BH), b = (blockIdx.x / BH) % NB, hd = blockIdx.x % BH; const int ch = hd * HD + lane;
    float st[HD];
#pragma unroll
    for (int j = 0; j < HD; ++j) st[j] = 0.f;
    float wup[RW], aup[RA];
#pragma unroll
    for (int m = 0; m < RW; ++m) { wup[m] = p.w_up[(size_t)(dir * RW + m) * BW + ch]; aup[m] = p.a_up[(size_t)(dir * RA + m) * BW + ch]; }
    const float w0 = p.w0[dir * BW + ch], a0 = p.a0[dir * BW + ch], kkw = p.k_k[ch], kaw = p.k_a[ch];
    float cr[3], ck[3], cv[3];
#pragma unroll
    for (int x = 0; x < 3; ++x) { cr[x] = p.conv[x * 3 * BW + ch]; ck[x] = p.conv[x * 3 * BW + BW + ch]; cv[x] = p.conv[x * 3 * BW + 2 * BW + ch]; }
    for (int step = 0; step < S; ++step) {
        const int t = dir ? (S - 1 - step) : step; const size_t row = (size_t)b * S + t;
        float r = 0.f, k = 0.f, v = 0.f;
#pragma unroll
        for (int x = 0; x < 3; ++x) { int tt = t + x - 1; if (tt >= 0 && tt < S) { size_t rr = (size_t)b * S + tt; r += h.at(rr, O_A + ch) * cr[x]; k += h.at(rr, O_A + BW + ch) * ck[x]; v += h.at(rr, O_A + 2 * BW + ch) * cv[x]; } }
        float lv = h.at(row, O_B + lane); float lt = lane < RW ? tanhf(lv) : lv; float zw = w0, za = a0;
#pragma unroll
        for (int m = 0; m < RW; ++m) { zw += __shfl(lt, m) * wup[m]; za += __shfl(lt, RW + m) * aup[m]; }
        const float w = expf(-DECAY * sigm_n(zw)); const float a = sigm_n(za);
        float kk = k * kkw; float ss = wave_sum(kk * kk); kk = kk * (1.f / sqrtf(fmaxf(ss, 1e-24f)));
        const float kd = k * (1.f + (a - 1.f) * kaw); const float kka = kk * a;
        float sa = 0.f;
#pragma unroll
        for (int j = 0; j < HD; ++j) sa += st[j] * (-__shfl(kk, j));
        float y = 0.f;
#pragma unroll
        for (int j = 0; j < HD; ++j) { st[j] = st[j] * __shfl(w, j) + sa * __shfl(kka, j) + v * __shfl(kd, j); y += st[j] * __shfl(r, j); }
        ys[((size_t)dir * T + b * S + t) * BW + ch] = y;
    }
}
__global__ void __launch_bounds__(384) k_rwkv_finish_n(HSrc h, RwP p, const float* __restrict__ ys, float* __restrict__ concat) {
    __shared__ float lw[RW], la[RA], sg[RG];
    const int tok = blockIdx.x, b = tok / S, t = tok % S, ch = threadIdx.x, hd = ch / HD, j = ch % HD;
    if (ch < RW) lw[ch] = tanhf(h.at(tok, O_B + ch)); else if (ch < RW + RA) la[ch - RW] = h.at(tok, O_W + (ch - RW)); else if (ch < RW + RA + RG) sg[ch - RW - RA] = sigm_n(h.at(tok, O_AL + (ch - RW - RA)));
    __syncthreads();
    float r = 0.f, k = 0.f, v = 0.f;
#pragma unroll
    for (int x = 0; x < 3; ++x) { int tt = t + x - 1; if (tt >= 0 && tt < S) { size_t rr = (size_t)b * S + tt;
        r += h.at(rr, O_A + ch) * p.conv[x * 3 * BW + ch]; k += h.at(rr, O_A + BW + ch) * p.conv[x * 3 * BW + BW + ch]; v += h.at(rr, O_A + 2 * BW + ch) * p.conv[x * 3 * BW + 2 * BW + ch]; } }
    float bon = 0.f;
    for (int dir = 0; dir < 2; ++dir) { float za = p.a0[dir * BW + ch]; for (int m = 0; m < RA; ++m) za += la[m] * p.a_up[(size_t)(dir * RA + m) * BW + ch];
        float a = sigm_n(za); float kd = k * (1.f + (a - 1.f) * p.k_a[ch]); bon += wave_sum(r * kd * p.r_k[hd * HD + j]); }
    bon *= v;
    float y = ys[(size_t)tok * BW + ch] + ys[((size_t)T + tok) * BW + ch];
    float mu = wave_sum(y) * (1.f / HD); float dy = y - mu; float var = wave_sum(dy * dy) * (1.f / HD);
    float yn = dy * (1.f / sqrtf(var + GN_EPS)) * p.gn_gain[ch] + p.gn_bias[ch];
    float g = 0.f; for (int m = 0; m < RG; ++m) g += sg[m] * p.g_up[(size_t)m * BW + ch];
    concat[(size_t)tok * D + AW + ch] = (yn + bon) * g;
}
__global__ void __launch_bounds__(256) k_moe_n(const float* __restrict__ u2, const int* __restrict__ tokslot, const float* __restrict__ ew,
                                                const float* __restrict__ wgate, const float* __restrict__ wup, const float* __restrict__ wdown, float* __restrict__ f) {
    __shared__ float xs[D]; __shared__ float hb[DE];
    const int tok = blockIdx.x, tid = threadIdx.x;
    for (int i = tid; i < D; i += 256) xs[i] = u2[(size_t)tok * D + i];
    float o[4] = {0.f, 0.f, 0.f, 0.f};
    for (int kk = 0; kk < 2; ++kk) {
        const int ts = tokslot[tok * 2 + kk]; const int e = ts >> 14; const float wt = ew[ts];
        __syncthreads();
        const float* g = wgate + (size_t)e * D * DE; const float* u = wup + (size_t)e * D * DE;
        float ag0 = 0.f, ag1 = 0.f, au0 = 0.f, au1 = 0.f;
        for (int k = 0; k < D; ++k) { float x = xs[k]; ag0 += x * g[(size_t)k * DE + tid]; ag1 += x * g[(size_t)k * DE + 256 + tid]; au0 += x * u[(size_t)k * DE + tid]; au1 += x * u[(size_t)k * DE + 256 + tid]; }
        hb[tid] = ag0 * sigm_n(ag0) * au0; hb[256 + tid] = ag1 * sigm_n(ag1) * au1;
        __syncthreads();
        const float* dn = wdown + (size_t)e * DE * D; float a[4] = {0.f, 0.f, 0.f, 0.f};
        for (int k = 0; k < DE; ++k) { float x = hb[k];
#pragma unroll
            for (int j = 0; j < 4; ++j) a[j] += x * dn[(size_t)k * D + tid + 256 * j]; }
#pragma unroll
        for (int j = 0; j < 4; ++j) o[j] += a[j] * wt;
    }
#pragma unroll
    for (int j = 0; j < 4; ++j) f[(size_t)tok * D + tid + 256 * j] = o[j];
}

__global__ void k_router_n(const float* __restrict__ u2, const float* __restrict__ wg, const float* __restrict__ bg, const float* __restrict__ we, const float* __restrict__ be, int* __restrict__ tok_e) {
    int row = (blockIdx.x * blockDim.x + threadIdx.x) >> 6, lane = threadIdx.x & 63; if (row >= T) return;
    float gl[NG], el[NE];
#pragma unroll
    for (int n = 0; n < NG; ++n) gl[n] = 0.f;
#pragma unroll
    for (int n = 0; n < NE; ++n) el[n] = 0.f;
    for (int i = 0; i < 16; ++i) { int k = lane + 64 * i; float x = u2[(size_t)row * D + k];
#pragma unroll
        for (int n = 0; n < NG; ++n) gl[n] += x * wg[k * NG + n];
#pragma unroll
        for (int n = 0; n < NE; ++n) el[n] += x * we[k * NE + n]; }
#pragma unroll
    for (int n = 0; n < NG; ++n) gl[n] = wave_sum(gl[n]) + bg[n];
#pragma unroll
    for (int n = 0; n < NE; ++n) el[n] = wave_sum(el[n]) + be[n];
    int gi = 0; float gm = gl[0];
#pragma unroll
    for (int n = 1; n < NG; ++n) if (gl[n] > gm) { gm = gl[n]; gi = n; }
    float l1 = -3.0e38f, l2 = -3.0e38f; int i1 = 0, i2 = 0;
#pragma unroll
    for (int n = 0; n < NE; ++n) if ((n >> 3) == gi) { float v = el[n]; int e = n & 7; if (v > l1) { l2 = l1; i2 = i1; l1 = v; i1 = e; } else if (v > l2) { l2 = v; i2 = e; } }
    if (lane == 0) { tok_e[row * 2] = gi * EPG + i1; tok_e[row * 2 + 1] = gi * EPG + i2; }
}
__global__ void k_cmp_route(const int* __restrict__ tokslot, const int* __restrict__ tok_e, float* acc, int slot) {
    float mis = 0.f, tot = 0.f;
    for (int t = blockIdx.x * blockDim.x + threadIdx.x; t < T; t += gridDim.x * blockDim.x) { const int a0 = tokslot[2 * t] >> 14, a1 = tokslot[2 * t + 1] >> 14;
        mis += (a0 != tok_e[2 * t] || a1 != tok_e[2 * t + 1]) ? 1.f : 0.f; tot += 1.f; }
    mis = wave_sum(mis); tot = wave_sum(tot);
    if ((threadIdx.x & 63) == 0) { atomicAdd(acc + 2 * slot, mis); atomicAdd(acc + 2 * slot + 1, tot); }
}
__global__ void k_bf2f(const bf16_t* __restrict__ src, float* __restrict__ dst, size_t n) { for (size_t i = (size_t)blockIdx.x * blockDim.x + threadIdx.x; i < n; i += (size_t)gridDim.x * blockDim.x) dst[i] = bf2f(src[i]); }
template <class TA> __global__ void k_cmp(const TA* __restrict__ a, size_t lda, const float* __restrict__ b, size_t ldb, int rows, int cols, float* acc, int slot) {
    float d2 = 0.f, r2 = 0.f;
    for (size_t i = (size_t)blockIdx.x * blockDim.x + threadIdx.x; i < (size_t)rows * cols; i += (size_t)gridDim.x * blockDim.x) {
        const size_t r = i / cols, c = i % cols; float av; if constexpr (sizeof(TA) == 2) av = bf2f(a[r * lda + c]); else av = a[r * lda + c];
        const float bv = b[r * ldb + c]; d2 += (av - bv) * (av - bv); r2 += bv * bv; }
    d2 = wave_sum(d2); r2 = wave_sum(r2);
    if ((threadIdx.x & 63) == 0) { atomicAdd(acc + 2 * slot, d2); atomicAdd(acc + 2 * slot + 1, r2); }
}
__global__ void k_cmp_vt(const bf16_t* __restrict__ vt, const float* __restrict__ b, size_t ldb, float* acc, int slot) {
    float d2 = 0.f, r2 = 0.f;
    for (size_t i = (size_t)blockIdx.x * blockDim.x + threadIdx.x; i < (size_t)T * AW; i += (size_t)gridDim.x * blockDim.x) {
        const size_t r = i % T, c = i / T; const float av = bf2f(vt[c * T + r]), bv = b[r * ldb + c]; d2 += (av - bv) * (av - bv); r2 += bv * bv; }
    d2 = wave_sum(d2); r2 = wave_sum(r2);
    if ((threadIdx.x & 63) == 0) { atomicAdd(acc + 2 * slot, d2); atomicAdd(acc + 2 * slot + 1, r2); }
}
struct Tols { float t[8]; int n; };
__global__ void k_readout(float* out, const float* acc, Tols tl, int total) {
    float mx = 0.f; int am = 0; for (int k = 0; k < tl.n; ++k) { float e = sqrtf(acc[2 * k] / fmaxf(acc[2 * k + 1], 1e-30f)); if (!(e == e)) e = 1e3f; if (e / tl.t[k] > mx) { mx = e / tl.t[k]; am = k; } }
    const float cval = sqrtf(1000.f * mx);
    for (int i = blockIdx.x * blockDim.x + threadIdx.x; i < total; i += gridDim.x * blockDim.x) out[i] = (i < 8) ? 1000.f * (float)(am + 1) : cval;
}
__global__ void __launch_bounds__(256) k_moe_chk(const float* __restrict__ u2, const int* __restrict__ tokslot, const float* __restrict__ ew, const unsigned* __restrict__ cnt,
                                                  const float* __restrict__ wgate, const float* __restrict__ wup, const float* __restrict__ wdown,
                                                  const bf16_t* __restrict__ XS, const bf16_t* __restrict__ HM, const bf16_t* __restrict__ YS, float* acc) {
    __shared__ float xs[D]; __shared__ float hb[DE]; __shared__ int offp[NE];
    const int tok = blockIdx.x, tid = threadIdx.x;
    if (tid == 0) { int off = 0; for (int e = 0; e < NE; ++e) { offp[e] = off; off += (((int)cnt[e] + 255) >> 8) * 256; } }
    for (int i = tid; i < D; i += 256) xs[i] = u2[(size_t)tok * D + i];
    float d0 = 0.f, r0 = 0.f, d1 = 0.f, r1 = 0.f, d2 = 0.f, r2 = 0.f;
    for (int kk = 0; kk < 2; ++kk) {
        __syncthreads();
        const int ts = tokslot[tok * 2 + kk]; const int e = ts >> 14; const float wt = ew[ts]; const size_t slot = (size_t)offp[e] + (ts & 16383);
        for (int i = tid; i < D; i += 256) { const float a = bf2f(XS[slot * D + i]), b = xs[i]; d0 += (a - b) * (a - b); r0 += b * b; }
        const float* g = wgate + (size_t)e * D * DE; const float* u = wup + (size_t)e * D * DE;
        float ag0 = 0.f, ag1 = 0.f, au0 = 0.f, au1 = 0.f;
        for (int k = 0; k < D; ++k) { float x = xs[k]; ag0 += x * g[(size_t)k * DE + tid]; ag1 += x * g[(size_t)k * DE + 256 + tid]; au0 += x * u[(size_t)k * DE + tid]; au1 += x * u[(size_t)k * DE + 256 + tid]; }
        const float h0 = ag0 * sigm_n(ag0) * au0, h1 = ag1 * sigm_n(ag1) * au1;
        hb[tid] = h0; hb[256 + tid] = h1;
        { const float a = bf2f(HM[slot * DE + tid]), b = bf2f(HM[slot * DE + 256 + tid]); d1 += (a - h0) * (a - h0) + (b - h1) * (b - h1); r1 += h0 * h0 + h1 * h1; }
        __syncthreads();
        const float* dn = wdown + (size_t)e * DE * D; float a4[4] = {0.f, 0.f, 0.f, 0.f};
        for (int k = 0; k < DE; ++k) { float x = hb[k];
#pragma unroll
            for (int j = 0; j < 4; ++j) a4[j] += x * dn[(size_t)k * D + tid + 256 * j]; }
#pragma unroll
        for (int j = 0; j < 4; ++j) {
#ifdef MOEB_NOSCALE
            const float y = a4[j];
#else
            const float y = a4[j] * wt;
#endif
            const float a = bf2f(YS[slot * D + tid + 256 * j]); d2 += (a - y) * (a - y); r2 += y * y; }
    }
    d0 = wave_sum(d0); r0 = wave_sum(r0); d1 = wave_sum(d1); r1 = wave_sum(r1); d2 = wave_sum(d2); r2 = wave_sum(r2);
    if ((tid & 63) == 0) { atomicAdd(acc + 0, d0); atomicAdd(acc + 1, r0); atomicAdd(acc + 2, d1); atomicAdd(acc + 3, r1); atomicAdd(acc + 4, d2); atomicAdd(acc + 5, r2); }
}

extern "C" void kernel_launch(void* const* d_in, const int* in_sizes, int n_in, void* d_out, int out_size, void* d_ws, size_t ws_size, hipStream_t stream) {
    static int once = 0; if (!once) { (void)hipFuncSetAttribute((const void*)mk_fwd, hipFuncAttributeMaxDynamicSharedMemorySize, LDS_BYTES); once = 1; }
    (void)hipMemsetAsync((char*)d_ws + WS_CTL, 0, CTL_BYTES, stream);
    Args a{}; fill_args(a, d_in, d_out, d_ws);
    char* ws = (char*)d_ws; float* out = (float*)d_out;
    float* ACC = (float*)(ws + 32768 + 1024);
    const float* x = a.in[0];
    HSrc hs{(const bf16_t*)(ws + WS_HB), (const bf16_t*)(ws + WS_VT)};
    const int l = 0;
    RwP p = { a.in[6], a.in[7], a.in[8], a.in[9], a.in[10], a.in[11], a.in[12], a.in[13], a.in[14], a.in[15], a.in[16] };
    Tols tl{};
#if TESTMODE == 1
    launch_phases(a, 0, 3, stream);
    float* MODn = (float*)(ws + WS_MOD + 512 * 1024); float* Un = (float*)(ws + WS_XA); float* HF = (float*)(ws + WS_CONCAT);
    k_mod_n<<<L * MODW / 256, 256, 0, stream>>>(a.in[1], a.in[2], a.in[3], MODn);
    k_ln_mod_n<<<T / 4, 256, 0, stream>>>(x, MODn, 0, D, Un);
    k_gemm_f32<<<dim3(INW / 64, T / 64), 256, 0, stream>>>(Un, D, a.in[4], INW, HF, INW, D);
    k_cmp<float><<<256, 256, 0, stream>>>((const float*)(ws + WS_MOD), MODW, MODn, MODW, L * NB, MODW, ACC, 0);
    k_cmp<bf16_t><<<1024, 256, 0, stream>>>((const bf16_t*)(ws + WS_U), D, Un, D, T, D, ACC, 1);
    k_cmp<bf16_t><<<1024, 256, 0, stream>>>((const bf16_t*)(ws + WS_HB), HW, HF, INW, T, 768, ACC, 2);
    k_cmp<bf16_t><<<1024, 256, 0, stream>>>((const bf16_t*)(ws + WS_HB) + 768, HW, HF + 1152, INW, T, 1536, ACC, 3);
    k_cmp_vt<<<1024, 256, 0, stream>>>((const bf16_t*)(ws + WS_VT), HF + 768, INW, ACC, 4);
    tl.n = 5; tl.t[0] = 1e-5f; tl.t[1] = 4e-3f; tl.t[2] = 6e-3f; tl.t[3] = 6e-3f; tl.t[4] = 6e-3f;
#elif TESTMODE == 2
    launch_phases(a, 0, 4, stream);
    float* CCn = (float*)(ws + WS_XA); float* YSn = (float*)(ws + WS_WGU);
    k_attn_n<<<T * AH / 64, 64, 0, stream>>>(hs, a.in[5], CCn);
    k_pool_n<<<T, 256, 0, stream>>>(hs, a.in[17], a.in[18], CCn);
    k_rwkv_scan_n<<<2 * NB * BH, 64, 0, stream>>>(hs, p, YSn);
    k_rwkv_finish_n<<<T, 384, 0, stream>>>(hs, p, YSn, CCn);
    launch_phases(a, 4, 6, stream);
    k_cmp<bf16_t><<<1024, 256, 0, stream>>>((const bf16_t*)(ws + WS_CONCAT), D, CCn, D, T, AW, ACC, 0);
    k_cmp<bf16_t><<<1024, 256, 0, stream>>>((const bf16_t*)(ws + WS_CONCAT) + AW, D, CCn + AW, D, T, BW, ACC, 1);
    k_cmp<bf16_t><<<1024, 256, 0, stream>>>((const bf16_t*)(ws + WS_CONCAT) + AW + BW, D, CCn + AW + BW, D, T, CW, ACC, 2);
    tl.n = 3; tl.t[0] = TOL0; tl.t[1] = TOL1; tl.t[2] = TOL2;
#elif TESTMODE == 3
    launch_phases(a, 0, 11, stream);
    { const float* MODf = (const float*)(ws + WS_MOD);
      float* U2f = (float*)(ws + 414 * MiB); float* Fn = (float*)(ws + 213 * MiB); float* X2n = (float*)(ws + 277 * MiB);
      k_bf2f<<<2048, 256, 0, stream>>>((const bf16_t*)(ws + WS_U), U2f, (size_t)T * D);
      launch_phases(a, 11, 12, stream);
      k_moe_n<<<T, 256, 0, stream>>>(U2f, (const int*)(ws + WS_TOKSLOT), (const float*)(ws + WS_EW), a.in[28], a.in[29], a.in[30], Fn);
      k_post_n<<<T / 4, 256, 0, stream>>>((const float*)(ws + WS_XA), Fn, MODf, 5 * D, a.in[22], a.in[23], X2n, nullptr, 0, 0);
      k_cmp<float><<<1024, 256, 0, stream>>>(out, D, X2n, D, T, D, ACC, 0); }
    tl.n = 1; tl.t[0] = TOL0;
#elif TESTMODE == 4
    launch_phases(a, 0, 8, stream);
    { const float* MODf = (const float*)(ws + WS_MOD);
      float* CCn = (float*)(ws + 405 * MiB); float* MIXn = (float*)(ws + 213 * MiB); float* X1n = (float*)(ws + 21 * MiB); float* U2n = (float*)(ws + 333 * MiB); int* TEn = (int*)(ws + 490 * MiB);
      k_bf2f<<<2048, 256, 0, stream>>>((const bf16_t*)(ws + WS_CONCAT), CCn, (size_t)T * D);
      k_gemm_f32<<<dim3(D / 64, T / 64), 256, 0, stream>>>(CCn, D, a.in[19], D, MIXn, D, D);
      k_post_n<<<T / 4, 256, 0, stream>>>(x, MIXn, MODf, 2 * D, a.in[20], a.in[21], X1n, U2n, 3 * D, 4 * D);
      k_router_n<<<T / 4, 256, 0, stream>>>(U2n, a.in[24], a.in[25], a.in[26], a.in[27], TEn);
      k_cmp<float><<<1024, 256, 0, stream>>>((const float*)(ws + WS_XA), D, X1n, D, T, D, ACC, 0);
      k_cmp<bf16_t><<<1024, 256, 0, stream>>>((const bf16_t*)(ws + WS_U), D, U2n, D, T, D, ACC, 1);
      k_cmp_route<<<64, 256, 0, stream>>>((const int*)(ws + WS_TOKSLOT), TEn, ACC, 2); }
    tl.n = 3; tl.t[0] = TOL0; tl.t[1] = TOL1; tl.t[2] = TOL2;
#elif TESTMODE == 5
    launch_phases(a, 0, 11, stream);
    { float* U2f = (float*)(ws + 414 * MiB);
      k_bf2f<<<2048, 256, 0, stream>>>((const bf16_t*)(ws + WS_U), U2f, (size_t)T * D);
      k_moe_chk<<<T, 256, 0, stream>>>(U2f, (const int*)(ws + WS_TOKSLOT), (const float*)(ws + WS_EW), (const unsigned*)(ws + WS_CTL) + CW_CNT, a.in[28], a.in[29], a.in[30],
                                       (const bf16_t*)(ws + WS_XS), (const bf16_t*)(ws + WS_HM), (const bf16_t*)(ws + WS_YS), ACC); }
    tl.n = 3; tl.t[0] = 1e-6f; tl.t[1] = 1e-2f; tl.t[2] = 1e-2f;
#endif
    k_readout<<<256, 256, 0, stream>>>(out, ACC, tl, out_size);
}
#endif
```

```cpp
#define TESTMODE 0
#define MK_MODE 0
#include <hip/hip_runtime.h>
#include <hip/hip_cooperative_groups.h>
#include <stdint.h>
namespace cg = cooperative_groups;

#ifndef TESTMODE
#define TESTMODE 0
#endif
#define DI __device__ __forceinline__
#define LAS __attribute__((address_space(3)))
typedef unsigned short bf16_t;
typedef short bf16x8 __attribute__((ext_vector_type(8)));
typedef float f32x4 __attribute__((ext_vector_type(4)));
typedef float f32x16 __attribute__((ext_vector_type(16)));
typedef unsigned u32x4 __attribute__((ext_vector_type(4)));
typedef unsigned u32x2 __attribute__((ext_vector_type(2)));
typedef float f32x2_t __attribute__((ext_vector_type(2)));
typedef __bf16 bf16x2_t __attribute__((ext_vector_type(2)));

namespace cfg {
constexpr int D = 1024, NB = 2, S = 8192, T = NB * S, L = 2;
constexpr int GW = 64, ROWS = 128;
constexpr int HD = 64, AW = 384, BW = 384, CW = 256, AH = 6, BH = 6;
constexpr int KH = 8, KW = 16;
constexpr int RW = 32, RA = 32, RG = 64;
constexpr int INW = 2688;
constexpr int NG = 4, EPG = 8, NE = 32, DE = 512;
constexpr int MODW = 6 * D;
constexpr float ALPHA = 1.41421356237309515f;
constexpr float LN_EPS = 1e-5f, GN_EPS = 64e-5f;
constexpr float DECAY = 0.60653065971263342f;
constexpr float LOG2E = 1.44269504088896341f;
constexpr int HW = 2304, HQ = 0, HK = 384, HR = 768, HWL = 1920, HAL = 1952, HGL = 1984, HP = 2048;
constexpr int NCH = S / 64;
constexpr int NUNIT = 2 * NB * BH * NCH;
constexpr int XSROWS = 2 * T + NE * 256;
}
using namespace cfg;

constexpr size_t MiB = 1u << 20;
constexpr size_t WS_CTL = 0;
constexpr size_t CTL_BYTES = 262144;
constexpr size_t WS_SLOTTOK = 65536;
constexpr int CW_BAR = 0;
constexpr int CW_CNT = 8192;
constexpr size_t WS_MOD = 1 * MiB;
constexpr size_t WS_TOKSLOT = 1 * MiB + 128 * 1024;
constexpr size_t WS_SLOTW = 1 * MiB + 256 * 1024;
constexpr size_t WS_BC = 2 * MiB;
constexpr size_t WS_TOKW = 2 * MiB + 64 * 1024;
constexpr size_t WS_TOKFIN = 2 * MiB + 256 * 1024;
constexpr size_t WS_CNTF = 2 * MiB + 512 * 1024;
constexpr size_t WS_WIN = 6 * MiB;
constexpr size_t WIN_LAYER = (size_t)2816 * 1024 * 2;
constexpr size_t WS_WOUT = 17 * MiB;
constexpr size_t WS_WGU = 21 * MiB;
constexpr size_t WS_WD = 85 * MiB;
constexpr size_t WS_XA = 117 * MiB;
constexpr size_t WS_U = 181 * MiB;
constexpr size_t WS_HB = 213 * MiB;
constexpr size_t WS_S0 = 213 * MiB;
constexpr size_t WS_VT = 285 * MiB;
constexpr size_t WS_CONCAT = 301 * MiB;
constexpr size_t WS_MP = 333 * MiB;
constexpr size_t WS_NB = 357 * MiB;
constexpr size_t WS_MIX = 333 * MiB;
constexpr size_t WS_QT = 405 * MiB;
constexpr size_t WS_WT = 429 * MiB;
constexpr size_t WS_VTB = 453 * MiB;
constexpr size_t WS_GB = 465 * MiB;
constexpr size_t WS_VC = 477 * MiB;
constexpr size_t WS_BS = 489 * MiB;
constexpr size_t WS_XS = 213 * MiB;
constexpr size_t WS_HM = 293 * MiB;
constexpr size_t WS_YS = 333 * MiB;
constexpr size_t WS_END = 490 * MiB;

constexpr int NWAVES = 8, NTHREADS = 512;
constexpr int LDS_BYTES = 156 * 1024;

DI unsigned cvtpk(float lo, float hi) { f32x2_t v = {lo, hi}; bf16x2_t b = __builtin_convertvector(v, bf16x2_t); return __builtin_bit_cast(unsigned, b); }
DI float bflo(unsigned w) { return __uint_as_float(w << 16); }
DI float bfhi(unsigned w) { return __uint_as_float(w & 0xffff0000u); }
DI float bf2f(unsigned short h) { return __uint_as_float((unsigned)h << 16); }
DI unsigned short f2bf(float f) { return (unsigned short)(cvtpk(f, 0.f) & 0xffffu); }
DI float wave_sum_shfl(float v) {
#pragma unroll
    for (int o = 32; o > 0; o >>= 1) v += __shfl_xor(v, o);
    return v;
}
template <int CTRL, int ROWMASK> DI float dpp_add(float v) { return v + __builtin_bit_cast(float, __builtin_amdgcn_update_dpp(0, __builtin_bit_cast(int, v), CTRL, ROWMASK, 0xf, false)); }
DI float wave_sum(float v) {
    v = dpp_add<0xb1, 0xf>(v);
    v = dpp_add<0x4e, 0xf>(v);
    v = dpp_add<0x124, 0xf>(v);
    v = dpp_add<0x128, 0xf>(v);
    v = dpp_add<0x142, 0xa>(v);
    v = dpp_add<0x143, 0xc>(v);
    return __builtin_bit_cast(float, __builtin_amdgcn_readlane(__builtin_bit_cast(int, v), 63));
}
DI float fexp2(float x) { return __builtin_amdgcn_exp2f(x); }
DI float frcp(float x) { return __builtin_amdgcn_rcpf(x); }
DI float sigm(float x) { return frcp(1.f + fexp2(x * -LOG2E)); }
#define LDS_WAIT() asm volatile("s_waitcnt lgkmcnt(0)" ::: "memory")
#define VM_WAIT() asm volatile("s_waitcnt vmcnt(0)" ::: "memory")
DI int swap23(int i) { return (i & ~12) | ((i & 4) << 1) | ((i & 8) >> 1); }

namespace pg8 {
constexpr int BM = 256, BK = 64, HALF = 128, HTB = HALF * BK * 2, STAGE_BYTES = 8 * HTB, NXCD = 8, WGM = 8;
__host__ __device__ __forceinline__ int lds_byte(int r, int c) { const int st = (r >> 4) * 2 + (c >> 5), rr = r & 15, cc = c & 31, ob = rr * 64 + cc * 2; return st * 1024 + (ob ^ (((ob >> 9) & 1) << 5)); }
__host__ __device__ __forceinline__ void stage_rc(int b, int& R, int& C) { const int st = b / 1024, sb = b % 1024, swz = sb ^ (((sb >> 9) & 1) << 5); R = (st >> 1) * 16 + swz / 64; C = (st & 1) * 32 + (swz % 64) / 2; }
__host__ __device__ __forceinline__ int perm32(int rho) { const int n = rho >> 4, i = rho & 15; return 8 * (i >> 2) + 4 * n + (i & 3); }

struct Unit { int pm, pn, aux; };

DI int xcd_remap(int L, int nwg) { const int q = nwg / NXCD, r = nwg % NXCD, xcd = L % NXCD, off = L / NXCD; return (xcd < r ? xcd * (q + 1) : r * (q + 1) + (xcd - r) * q) + off; }

struct PlainOrder {
    static constexpr bool GATHER = false;
    const bf16_t* A; const bf16_t* Bt; int K; int nM, nN, nwg, G, c;
    DI void init(const bf16_t* A_, const bf16_t* Bt_, int M, int N, int K_, int G_, int c_) { A = A_; Bt = Bt_; K = K_; nM = M / BM; nN = N / BM; nwg = nM * nN; G = G_; c = c_; }
    DI bool next(int i, Unit& u) const {
        const int Lx = i * G + c; if (Lx >= nwg) return false;
        const int wgid = xcd_remap(Lx, nwg);
        const int nig = WGM * nN, gid = wgid / nig, fm = gid * WGM, gsz = (nM - fm) < WGM ? (nM - fm) : WGM;
        u.pm = fm + ((wgid % nig) % gsz); u.pn = (wgid % nig) / gsz; u.aux = 0; return true;
    }
    DI const char* aptr(const Unit& u) const { return (const char*)A + (size_t)u.pm * (2 * HALF) * K * 2; }
    DI const char* bptr(const Unit& u) const { return (const char*)Bt + (size_t)u.pn * (2 * HALF) * K * 2; }
};
struct Gemm1Order {
    static constexpr bool GATHER = false;
    const bf16_t* U; const bf16_t* Win; const bf16_t* Wv; int G, c;
    static constexpr int nM = T / BM, nN = HW / BM, nMain = nM * nN, nV = 2 * (T / BM), nwg = nMain + nV, K = D;
    DI bool next(int i, Unit& u) const {
        const int Lx = i * G + c; if (Lx >= nwg) return false;
        if (Lx < nMain) {
            const int wgid = xcd_remap(Lx, nMain);
            const int nig = WGM * nN, gid = wgid / nig, fm = gid * WGM, gsz = (nM - fm) < WGM ? (nM - fm) : WGM;
            u.pm = fm + ((wgid % nig) % gsz); u.pn = (wgid % nig) / gsz; u.aux = 0;
        } else { const int v = Lx - nMain; u.pm = v & 1; u.pn = v >> 1; u.aux = 1; }
        return true;
    }
    DI const char* aptr(const Unit& u) const { return (const char*)(u.aux ? Wv : U) + (size_t)u.pm * BM * K * 2; }
    DI const char* bptr(const Unit& u) const { return (const char*)(u.aux ? U : Win) + (size_t)u.pn * BM * K * 2; }
};
template <bool G_> struct GroupedOrderT {
    static constexpr bool GATHER = G_;
    const bf16_t* A; const bf16_t* Bt; int K; size_t estride; const LAS int* tile_e; int ntiles, nwg, G, c; const int* rowtok;
    DI bool next(int i, Unit& u) const {
        const int Lx = i * G + c; if (Lx >= nwg) return false;
        const int wgid = xcd_remap(Lx, nwg);
        u.pm = wgid >> 2; u.pn = wgid & 3; u.aux = tile_e[u.pm]; return true;
    }
    DI const char* aptr(const Unit& u) const { return GATHER ? (const char*)A : (const char*)A + (size_t)u.pm * BM * K * 2; }
    DI const char* bptr(const Unit& u) const { return (const char*)Bt + ((size_t)u.aux * estride + (size_t)u.pn * BM * K) * 2; }
};

struct EpiStore {
    bf16_t* O0; int ld0; bf16_t* O1; int ld1;
    DI void operator()(const f32x4 (&acc)[2][2][4][2], const Unit& u, int wr, int wc, int fr, int fq) const {
        bf16_t* base = u.aux ? O1 : O0; const int ldc = u.aux ? ld1 : ld0;
        const int row0 = u.pm * BM + wr * 64 + fr, col0 = u.pn * BM + wc * 32 + 8 * fq;
#pragma unroll
        for (int ai = 0; ai < 2; ++ai)
#pragma unroll
            for (int m = 0; m < 4; ++m) { bf16_t* rowp = base + (size_t)(row0 + ai * HALF + m * 16) * ldc + col0;
#pragma unroll
                for (int bj = 0; bj < 2; ++bj) { const f32x4 v0 = acc[ai][bj][m][0], v1 = acc[ai][bj][m][1];
                    u32x4 w; w.x = cvtpk(v0[0], v0[1]); w.y = cvtpk(v0[2], v0[3]); w.z = cvtpk(v1[0], v1[1]); w.w = cvtpk(v1[2], v1[3]);
                    *(u32x4*)(rowp + bj * HALF) = w; } }
    }
};
struct EpiSwiGlu {
    bf16_t* O;
    DI void operator()(const f32x4 (&acc)[2][2][4][2], const Unit& u, int wr, int wc, int fr, int fq) const {
        const int row0 = u.pm * BM + wr * 64 + fr, col0 = u.pn * HALF + wc * 32 + 8 * fq;
#pragma unroll
        for (int ai = 0; ai < 2; ++ai)
#pragma unroll
            for (int m = 0; m < 4; ++m) { bf16_t* rowp = O + (size_t)(row0 + ai * HALF + m * 16) * DE + col0;
                float hv[8];
#pragma unroll
                for (int n = 0; n < 2; ++n)
#pragma unroll
                    for (int e = 0; e < 4; ++e) { const float g = acc[ai][0][m][n][e], up = acc[ai][1][m][n][e]; hv[4 * n + e] = g * sigm(g) * up; }
                u32x4 w; w.x = cvtpk(hv[0], hv[1]); w.y = cvtpk(hv[2], hv[3]); w.z = cvtpk(hv[4], hv[5]); w.w = cvtpk(hv[6], hv[7]);
                *(u32x4*)rowp = w; }
    }
};
struct EpiRowScale {
    bf16_t* O; const float* roww;
    DI void operator()(const f32x4 (&acc)[2][2][4][2], const Unit& u, int wr, int wc, int fr, int fq) const {
        const int row0 = u.pm * BM + wr * 64 + fr, col0 = u.pn * BM + wc * 32 + 8 * fq;
#pragma unroll
        for (int ai = 0; ai < 2; ++ai)
#pragma unroll
            for (int m = 0; m < 4; ++m) { const int row = row0 + ai * HALF + m * 16;
#ifdef MOEB_NOSCALE
                const float s = 1.f;
#else
                const float s = roww[row];
#endif
                bf16_t* rowp = O + (size_t)row * D + col0;
#pragma unroll
                for (int bj = 0; bj < 2; ++bj) { const f32x4 v0 = acc[ai][bj][m][0] * s, v1 = acc[ai][bj][m][1] * s;
                    u32x4 w; w.x = cvtpk(v0[0], v0[1]); w.y = cvtpk(v0[2], v0[3]); w.z = cvtpk(v1[0], v1[1]); w.w = cvtpk(v1[2], v1[3]);
                    *(u32x4*)(rowp + bj * HALF) = w; } }
    }
};

template <class Epi, class Sched>
DI void gemm_phase(LAS unsigned char* lds, const int tid, const int K, const Sched& S, const Epi& E) {
    const int wid = __builtin_amdgcn_readfirstlane(tid >> 6), lane = tid & 63, wr = wid >> 2, wc = wid & 3, fr = lane & 15, fq = lane >> 4;
    const int nt = K / BK;
    unsigned voffA[2], voffB[2];
#pragma unroll
    for (int i = 0; i < 2; ++i) { int R, C; stage_rc(tid * 16 + i * 8192, R, C); const int Rb = (R & ~31) + perm32(R & 31);
        voffA[i] = (unsigned)(R * K + C) * 2u; voffB[i] = (unsigned)(Rb * K + C) * 2u; }
    const size_t kstep = (size_t)(BK * 2);
    const size_t hstep = (size_t)HALF * K * 2;
    const size_t hstepA = Sched::GATHER ? 0 : hstep;
    int RA_[2], CA_[2];
#pragma unroll
    for (int i = 0; i < 2; ++i) stage_rc(tid * 16 + i * 8192, RA_[i], CA_[i]);
    unsigned vgc[2][2], vgn[2][2], vgnn[2][2];
#define PG8_GLOAD(dst, u_) do { if constexpr (Sched::GATHER) { _Pragma("unroll") for (int h_ = 0; h_ < 2; ++h_) _Pragma("unroll") for (int i_ = 0; i_ < 2; ++i_) \
        dst[h_][i_] = ((unsigned)S.rowtok[(u_).pm * BM + h_ * HALF + RA_[i_]] * (unsigned)K + (unsigned)CA_[i_]) * 2u; } } while (0)
    const unsigned ldsw = (unsigned)wid * 1024u;
    const int aoff = lds_byte(wr * 64 + fr, fq * 8), boff = lds_byte(wc * 32 + fr, fq * 8);
#define PG8_SA(b, h) (((b) * 2 + (h)) * HTB)
#define PG8_SB(b, h) ((4 + (b) * 2 + (h)) * HTB)
#define PG8_STAGE(bufoff, gbase, voff) do { _Pragma("unroll") for (int _i = 0; _i < 2; ++_i) \
        __builtin_amdgcn_global_load_lds((const unsigned*)((const char*)(gbase) + (voff)[_i]), (LAS unsigned*)(lds + (bufoff) + ldsw + _i * 8192), 16, 0, 0); } while (0)
#define PG8_STAGE_A(b, h, gbase, cur_) do { if constexpr (Sched::GATHER) { unsigned vo_[2]; vo_[0] = (cur_) ? vgc[h][0] : vgn[h][0]; vo_[1] = (cur_) ? vgc[h][1] : vgn[h][1]; PG8_STAGE(PG8_SA(b, h), gbase, vo_); } else PG8_STAGE(PG8_SA(b, h), (gbase) + (h) * hstepA, voffA); } while (0)
#define PG8_LDA(dst, b, h) do { _Pragma("unroll") for (int m = 0; m < 4; ++m) _Pragma("unroll") for (int k = 0; k < 2; ++k) dst[m][k] = *(const LAS bf16x8*)(lds + PG8_SA(b, h) + aoff + m * 2048 + k * 1024); } while (0)
#define PG8_LDB(dst, b, h) do { _Pragma("unroll") for (int n = 0; n < 2; ++n) _Pragma("unroll") for (int k = 0; k < 2; ++k) dst[n][k] = *(const LAS bf16x8*)(lds + PG8_SB(b, h) + boff + n * 2048 + k * 1024); } while (0)
#define PG8_MMA(ai, bj, At, Bt) do { __builtin_amdgcn_s_setprio(1); _Pragma("unroll") for (int m = 0; m < 4; ++m) _Pragma("unroll") for (int n = 0; n < 2; ++n) _Pragma("unroll") for (int k = 0; k < 2; ++k) \
        acc[ai][bj][m][n] = __builtin_amdgcn_mfma_f32_16x16x32_bf16(Bt[n][k], At[m][k], acc[ai][bj][m][n], 0, 0, 0); __builtin_amdgcn_s_setprio(0); } while (0)
#define PG8_WAIT_V(n) asm volatile("s_waitcnt vmcnt(" #n ")" ::: "memory")
#define PG8_WAIT_L(n) asm volatile("s_waitcnt lgkmcnt(" #n ")" ::: "memory")
#define PG8_BAR __builtin_amdgcn_s_barrier()
#define PG8_SCHED __builtin_amdgcn_sched_barrier(0)
    Unit cur, nxt; int ui = 0;
    if (!S.next(0, cur)) return;
    f32x4 acc[2][2][4][2];
#pragma unroll
    for (int a = 0; a < 2; ++a)
#pragma unroll
        for (int b = 0; b < 2; ++b)
#pragma unroll
            for (int m = 0; m < 4; ++m)
#pragma unroll
                for (int n = 0; n < 2; ++n) acc[a][b][m][n] = (f32x4){0.f, 0.f, 0.f, 0.f};
    bf16x8 At[4][2], B0[2][2], B1[2][2];
    const char* cA = S.aptr(cur); const char* cB = S.bptr(cur);
    if constexpr (Sched::GATHER) { Unit u1_ = cur, u2_ = cur; const bool h1_ = S.next(1, u1_); if (!h1_) u1_ = cur; const bool h2_ = h1_ && S.next(2, u2_); if (!h2_) u2_ = u1_;
        PG8_GLOAD(vgc, cur); PG8_GLOAD(vgn, u1_); PG8_GLOAD(vgnn, u2_); }
    PG8_STAGE(PG8_SB(0, 0), cB, voffB); PG8_STAGE(PG8_SB(0, 1), cB + hstep, voffB); PG8_STAGE_A(0, 0, cA, true); PG8_STAGE_A(0, 1, cA, true);
    if (wr == 1) PG8_BAR;
    PG8_WAIT_V(2); PG8_BAR;
    PG8_STAGE(PG8_SB(1, 0), cB + kstep, voffB); PG8_STAGE_A(1, 0, cA + kstep, true); PG8_STAGE(PG8_SB(1, 1), cB + hstep + kstep, voffB);
    PG8_WAIT_V(6); PG8_BAR;
    for (;;) {
        const bool has_next = S.next(ui + 1, nxt);
        const char* nA = has_next ? S.aptr(nxt) : cA; const char* nB = has_next ? S.bptr(nxt) : cB;

        for (int t = 0; t < nt; t += 2) {
            const bool last = (t == nt - 2);
            const char* a1 = cA + (size_t)(t + 1) * kstep;
            const char* a2 = last ? nA : cA + (size_t)(t + 2) * kstep; const char* b2 = last ? nB : cB + (size_t)(t + 2) * kstep;
            const char* a3 = a2 + kstep; const char* b3 = b2 + kstep;
            PG8_LDB(B0, 0, 0); PG8_LDB(B1, 0, 1); PG8_SCHED; PG8_LDA(At, 0, 0); PG8_STAGE_A(1, 1, a1, true);
            PG8_WAIT_V(8); PG8_WAIT_L(0); PG8_BAR; PG8_MMA(0, 0, At, B0); PG8_MMA(0, 1, At, B1); PG8_BAR; PG8_SCHED;
            PG8_LDA(At, 0, 1); PG8_STAGE(PG8_SB(0, 0), b2, voffB); PG8_STAGE(PG8_SB(0, 1), b2 + hstep, voffB); PG8_STAGE_A(0, 0, a2, !last);
            PG8_WAIT_V(8); PG8_WAIT_L(0); PG8_BAR; PG8_MMA(1, 0, At, B0); PG8_MMA(1, 1, At, B1); PG8_BAR; PG8_SCHED;
            PG8_LDB(B0, 1, 0); PG8_LDB(B1, 1, 1); PG8_SCHED; PG8_LDA(At, 1, 0); PG8_STAGE_A(0, 1, a2, !last);
            PG8_WAIT_V(8); PG8_WAIT_L(0); PG8_BAR; PG8_MMA(0, 0, At, B0); PG8_MMA(0, 1, At, B1); PG8_BAR; PG8_SCHED;
            PG8_LDA(At, 1, 1); PG8_STAGE(PG8_SB(1, 0), b3, voffB); PG8_STAGE(PG8_SB(1, 1), b3 + hstep, voffB); PG8_STAGE_A(1, 0, a3, !last);
            PG8_WAIT_V(8); PG8_WAIT_L(0); PG8_BAR; PG8_MMA(1, 0, At, B0); PG8_MMA(1, 1, At, B1); PG8_BAR; PG8_SCHED;
        }
        if (wr == 0) PG8_BAR;
        E(acc, cur, wr, wc, fr, fq);
        if (!has_next) break;
#pragma unroll
        for (int a = 0; a < 2; ++a)
#pragma unroll
            for (int b = 0; b < 2; ++b)
#pragma unroll
                for (int m = 0; m < 4; ++m)
#pragma unroll
                    for (int n = 0; n < 2; ++n) acc[a][b][m][n] = (f32x4){0.f, 0.f, 0.f, 0.f};
        cur = nxt; cA = nA; cB = nB; ++ui;
        if constexpr (Sched::GATHER) { _Pragma("unroll") for (int h_ = 0; h_ < 2; ++h_) _Pragma("unroll") for (int i_ = 0; i_ < 2; ++i_) { vgc[h_][i_] = vgn[h_][i_]; vgn[h_][i_] = vgnn[h_][i_]; } }
        if (wr == 1) PG8_BAR;
    }
    PG8_WAIT_V(0);
    PG8_BAR;
#undef PG8_SA
#undef PG8_SB
#undef PG8_STAGE
#undef PG8_STAGE_A
#undef PG8_GLOAD
#undef PG8_LDA
#undef PG8_LDB
#undef PG8_MMA
#undef PG8_WAIT_V
#undef PG8_WAIT_L
#undef PG8_BAR
#undef PG8_SCHED
}
}

#define XB_TMO      128
#define XB_XCNT(j)  (256  + 64 * (j))
#define XB_XSUB(j)  (1280 + 64 * (j))
#define XB_XGEN(j)  (2304 + 64 * (j))
#define XB_TOP      3328
#define XB_TOPGEN   3392
#define XCD_BAR_WORDS 3456
#define XB_SPIN_CAP (1u << 20)
DI unsigned xb_ld(unsigned* p)              { return __hip_atomic_load(p, __ATOMIC_RELAXED, __HIP_MEMORY_SCOPE_AGENT); }
DI unsigned xb_add(unsigned* p, unsigned v) { return __hip_atomic_fetch_add(p, v, __ATOMIC_RELAXED, __HIP_MEMORY_SCOPE_AGENT); }
DI unsigned xb_xcc_id() { return (unsigned)__builtin_amdgcn_s_getreg((3 << 11) | 20) & 0xFu; }
#define XB_SPIN(cond, bar) do { unsigned _sp = 0; while (cond) { __builtin_amdgcn_s_sleep(1); \
    if ((++_sp & 255u) == 0u) { if (xb_ld(&(bar)[XB_TMO])) break; if (_sp > XB_SPIN_CAP) { atomicAdd(&(bar)[XB_TMO], 1u); break; } } } } while (0)
struct XcdBarrier { unsigned* bar; unsigned x; volatile LAS unsigned* st; };
DI XcdBarrier xcd_barrier_post(unsigned* bar, volatile LAS unsigned* st) {
    XcdBarrier b; b.bar = bar; b.x = xb_xcc_id(); b.st = st;
    if (threadIdx.x == 0) (void)xb_add(&bar[XB_XCNT(b.x)], 1u);
    return b;
}
DI void xcd_barrier_complete(unsigned* bar, unsigned x, unsigned& nloc, unsigned& nx) {
    const unsigned G = gridDim.x * gridDim.y * gridDim.z;
    unsigned sum, cnt, mine, sp = 0u;
    for (;;) {
        sum = 0u; cnt = 0u; mine = 0u;
#pragma unroll
        for (unsigned j = 0; j < 16; ++j) { const unsigned c = xb_ld(&bar[XB_XCNT(j)]); sum += c; cnt += (c > 0u) ? 1u : 0u; mine = (j == x) ? c : mine; }
        if (sum == G) break;
        __builtin_amdgcn_s_sleep(1);
        if ((++sp & 255u) == 0u) { if (xb_ld(&bar[XB_TMO])) break; if (sp > XB_SPIN_CAP) { atomicAdd(&bar[XB_TMO], 1u); break; } }
    }
    nloc = mine > 0u ? mine : 1u; nx = cnt > 0u ? cnt : 1u;
}
DI void xcd_barrier(const XcdBarrier& b) {
    asm volatile("s_waitcnt vmcnt(0)" ::: "memory");
    __syncthreads();
    if (threadIdx.x == 0) {
        unsigned* bar = b.bar;
        __builtin_amdgcn_s_waitcnt(0);
        unsigned nloc = b.st[0], nx = b.st[1];
        if (nloc == 0u) { xcd_barrier_complete(bar, b.x, nloc, nx); b.st[0] = nloc; b.st[1] = nx; }
        const unsigned old = xb_add(&bar[XB_XSUB(b.x)], 1u);
        const unsigned gen = old / nloc;
        if (old + 1u == (gen + 1u) * nloc) {
            __builtin_amdgcn_fence(__ATOMIC_RELEASE, "agent");
            asm volatile("s_waitcnt vmcnt(0)" ::: "memory");
            const unsigned og = xb_add(&bar[XB_TOP], 1u);
            const unsigned tg = og / nx;
            if (og + 1u == (tg + 1u) * nx) xb_add(&bar[XB_TOPGEN], 1u);
            else XB_SPIN(xb_ld(&bar[XB_TOPGEN]) == tg, bar);
            __builtin_amdgcn_fence(__ATOMIC_ACQUIRE, "agent");
            xb_add(&bar[XB_XGEN(b.x)], 1u);
            asm volatile("s_waitcnt vmcnt(0)" ::: "memory");
        } else {
            XB_SPIN(xb_ld(&bar[XB_XGEN(b.x)]) == gen, bar);
            __builtin_amdgcn_fence(__ATOMIC_ACQUIRE, "agent");
            asm volatile("s_waitcnt vmcnt(0)" ::: "memory");
        }
    }
    __syncthreads();
}

struct Args { const float* in[31]; float* out; unsigned char* ws; int ph_lo, ph_hi, use_cg, pad; };
struct Frame {
    LAS unsigned char* lds;
    int tid, lane, wave, G, vcu, gw, ngw, bx;
    unsigned char* ws;
};
constexpr int LDS_MISC = 131072;
constexpr int LDS_BARST = LDS_BYTES - 64;

struct TItem { const float* src; bf16_t* dst; int ldw, ldt; };
DI void titem_load(const TItem& t, f32x4 (&v)[16], int lane) {
#pragma unroll
    for (int i = 0; i < 16; ++i) v[i] = *(const f32x4*)(t.src + (size_t)(4 * i + (lane >> 4)) * t.ldw + 4 * (lane & 15));
}
DI void titem_store(const TItem& t, const f32x4 (&v)[16], LAS float* scr, int lane) {
#pragma unroll
    for (int i = 0; i < 16; ++i) { LAS float* s = scr + (4 * i + (lane >> 4)) * 65 + 4 * (lane & 15); s[0] = v[i][0]; s[1] = v[i][1]; s[2] = v[i][2]; s[3] = v[i][3]; }
    LDS_WAIT();
#pragma unroll
    for (int j = 0; j < 8; ++j) {
        const int n = 8 * j + (lane >> 3), c = lane & 7; const LAS float* s = scr + (8 * c) * 65 + n;
        u32x4 o; o.x = cvtpk(s[0], s[65]); o.y = cvtpk(s[130], s[195]); o.z = cvtpk(s[260], s[325]); o.w = cvtpk(s[390], s[455]);
        *(u32x4*)(t.dst + (size_t)n * t.ldt + 8 * c) = o;
    }
    LDS_WAIT();
}
constexpr int IT_WIN = 16 * 42, IT_WOUT = 16 * 16, IT_SMALL = IT_WIN + IT_WOUT;
constexpr int IT_EXP = 128 * 3, IT_MOE = NE * IT_EXP;
DI TItem small_item(const Frame& F, const float* w_in, const float* w_out, int git) {
    const int l = git / IT_SMALL, it = git % IT_SMALL; TItem t;
    if (it < IT_WIN) {
        const int kt = it / 42, nt = it % 42, n0 = 64 * nt;
        size_t drow; if (n0 < 768) drow = n0; else if (n0 < 1152) drow = 2304 + (n0 - 768); else drow = n0 - 384;
        t.src = w_in + (size_t)l * D * INW + (size_t)(64 * kt) * INW + n0; t.ldw = INW;
        t.dst = (bf16_t*)(F.ws + WS_WIN + (size_t)l * WIN_LAYER) + drow * D + 64 * kt; t.ldt = D;
    } else {
        const int r = it - IT_WIN, kt = r >> 4, nt = r & 15;
        t.src = w_out + (size_t)l * D * D + (size_t)(64 * kt) * D + 64 * nt; t.ldw = D;
        t.dst = (bf16_t*)(F.ws + WS_WOUT) + (size_t)l * D * D + (size_t)(64 * nt) * D + 64 * kt; t.ldt = D;
    }
    return t;
}
DI TItem moe_item(const Frame& F, const float* wg, const float* wu, const float* wd, int l, int it) {
    const int e = it / IT_EXP, r = it % IT_EXP, which = r >> 7, q = r & 127; TItem t;
    if (which < 2) {
        const int kt = q >> 3, nt = q & 7, n0 = 64 * nt;
        t.src = (which ? wu : wg) + ((size_t)l * NE + e) * D * DE + (size_t)(64 * kt) * DE + n0; t.ldw = DE;
        const size_t drow = (size_t)(n0 >> 7) * 256 + (which ? 128 : 0) + (n0 & 127);
        t.dst = (bf16_t*)(F.ws + WS_WGU) + (size_t)e * D * D + drow * D + 64 * kt; t.ldt = D;
    } else {
        const int kt = q >> 4, nt = q & 15;
        t.src = wd + ((size_t)l * NE + e) * DE * D + (size_t)(64 * kt) * D + 64 * nt; t.ldw = D;
        t.dst = (bf16_t*)(F.ws + WS_WD) + (size_t)e * D * DE + (size_t)(64 * nt) * DE + 64 * kt; t.ldt = DE;
    }
    return t;
}
DI void p0_prologue(const Frame& F, const Args& a) {
    const float* c = a.in[1]; const float* w_mod = a.in[2]; const float* b_mod = a.in[3];
    if (F.bx < L * (MODW / 64)) {
        LAS float* sc = (LAS float*)(F.lds);
        LAS float* red = (LAS float*)(F.lds + 8192);
        for (int i = F.tid; i < NB * D; i += NTHREADS) { const float v = c[i]; sc[i] = v / (1.f + expf(-v)); }
        __syncthreads();
        const int l = F.bx / (MODW / 64), cb = F.bx % (MODW / 64), n = cb * 64 + F.lane;
        const float* w = w_mod + (size_t)l * D * MODW + n;
        float a0 = 0.f, a1 = 0.f;
#pragma unroll 8
        for (int k = F.wave * 128; k < F.wave * 128 + 128; ++k) { const float wv = w[(size_t)k * MODW]; a0 += sc[k] * wv; a1 += sc[D + k] * wv; }
        red[(F.wave * 2 + 0) * 64 + F.lane] = a0; red[(F.wave * 2 + 1) * 64 + F.lane] = a1;
        __syncthreads();
        if (F.tid < 128) { const int b = F.tid >> 6, ln = F.tid & 63; float s = 0.f;
#pragma unroll
            for (int w8 = 0; w8 < 8; ++w8) s += red[(w8 * 2 + b) * 64 + ln];
            const int nn = cb * 64 + ln;
            ((float*)(F.ws + WS_MOD))[(size_t)(l * NB + b) * MODW + nn] = s + b_mod[l * MODW + nn]; }
        __syncthreads();
    }
    { const int nzero = L * 128 * D / 8;
      for (int i = F.gw * 64 + F.lane; i < nzero; i += F.ngw * 64) { const int l = i / (128 * D / 8), r = i % (128 * D / 8);
          *(u32x4*)((bf16_t*)(F.ws + WS_WIN + (size_t)l * WIN_LAYER) + (size_t)(2304 + 384) * D + (size_t)r * 8) = (u32x4){0u, 0u, 0u, 0u}; } }
    LAS float* scr = (LAS float*)(F.lds + 16384) + F.wave * (64 * 65);
    { f32x4 cur[16], nxt[16]; int it = F.gw; TItem tc{}, tn{};
      if (it < L * IT_SMALL) { tc = small_item(F, a.in[4], a.in[19], it); titem_load(tc, cur, F.lane); }
      for (; it < L * IT_SMALL; it += F.ngw) {
          const bool more = it + F.ngw < L * IT_SMALL;
          if (more) { tn = small_item(F, a.in[4], a.in[19], it + F.ngw); titem_load(tn, nxt, F.lane); }
          titem_store(tc, cur, scr, F.lane);
          if (more) { tc = tn;
#pragma unroll
              for (int i = 0; i < 16; ++i) cur[i] = nxt[i]; }
      } }
}

DI void row_ln(f32x4 (&v)[4], float& mean_out, float& rstd_out) {
    float s = 0.f;
#pragma unroll
    for (int j = 0; j < 4; ++j) s += (v[j][0] + v[j][1]) + (v[j][2] + v[j][3]);
    const float mean = wave_sum(s) * (1.f / D); float q = 0.f;
#pragma unroll
    for (int j = 0; j < 4; ++j) { v[j] = v[j] - mean; q += (v[j][0] * v[j][0] + v[j][1] * v[j][1]) + (v[j][2] * v[j][2] + v[j][3] * v[j][3]); }
    mean_out = mean; rstd_out = 1.f / sqrtf(wave_sum(q) * (1.f / D) + LN_EPS);
}
DI void row_mod_store(f32x4 (&v)[4], const float* md, int off_sh, int off_sc, bf16_t* urow, int lane) {
    float mean, rstd; row_ln(v, mean, rstd);
#pragma unroll
    for (int j = 0; j < 4; ++j) { const int col = 4 * lane + 256 * j;
        const f32x4 scv = *(const f32x4*)(md + off_sc + col), shv = *(const f32x4*)(md + off_sh + col);
        v[j] = v[j] * rstd * (1.f + scv) + shv;
        u32x2 w; w.x = cvtpk(v[j][0], v[j][1]); w.y = cvtpk(v[j][2], v[j][3]);
        *(u32x2*)(urow + col) = w; }
}
DI void p_r0(const Frame& F, const float* x) {
    const float* MOD = (const float*)(F.ws + WS_MOD);
    bf16_t* U = (bf16_t*)(F.ws + WS_U);
    for (int row = F.gw; row < T; row += F.ngw) {
        f32x4 v[4];
#pragma unroll
        for (int j = 0; j < 4; ++j) v[j] = *(const f32x4*)(x + (size_t)row * D + 4 * F.lane + 256 * j);
        row_mod_store(v, MOD + (size_t)(row / S) * MODW, 0, D, U + (size_t)row * D, F.lane);
    }
}

constexpr int NGRP = T / 64;
DI void p_rowpass1(const Frame& F, const Args& a, int l, const float* xin, const bool dry = false) {
    const float* MODl = (const float*)(F.ws + WS_MOD) + (size_t)l * NB * MODW;
    const bf16_t* MIX = (const bf16_t*)(F.ws + WS_MIX);
    float* XA = (float*)(F.ws + WS_XA); bf16_t* U = (bf16_t*)(F.ws + WS_U);
    const float* gain = a.in[20] + (size_t)l * D; const float* bias = a.in[21] + (size_t)l * D;
    const float* wg = a.in[24] + (size_t)l * D * NG; const float* bg = a.in[25] + (size_t)l * NG;
    const float* we = a.in[26] + (size_t)l * D * NE; const float* be = a.in[27] + (size_t)l * NE;
    const size_t dro = dry ? 490 * MiB - WS_BC : 0;
    int* BC = (int*)(F.ws + WS_BC + dro); float* TOKW = (float*)(F.ws + WS_TOKW + dro); int* TOKSLOT = (int*)(F.ws + WS_TOKSLOT + (dry ? 496 * MiB - WS_TOKSLOT : 0));
    LAS float* RT = (LAS float*)F.lds;
    LAS unsigned* cntl = (LAS unsigned*)(F.lds + 36 * D * 4 + NWAVES * 72 * 4);
#pragma unroll
    for (int kk = 0; kk < 2; ++kk) { const int k = F.tid + kk * NTHREADS;
        f32x4 v[9]; v[0] = *(const f32x4*)(wg + (size_t)k * NG);
#pragma unroll
        for (int q = 0; q < 8; ++q) v[1 + q] = *(const f32x4*)(we + (size_t)k * NE + 4 * q);
#pragma unroll
        for (int q = 0; q < 9; ++q)
#pragma unroll
            for (int e = 0; e < 4; ++e) RT[(4 * q + e) * D + k] = v[q][e]; }
    for (int grp = F.vcu; grp < NGRP; grp += F.G) {
    if (F.tid < NE) cntl[F.tid] = 0u;
    __syncthreads();
    f32x4 pxa[4], pxb[4]; u32x2 pma[4], pmb[4];
    { const int r0 = 64 * grp + 8 * F.wave;
#pragma unroll
      for (int j = 0; j < 4; ++j) { const int col = 4 * F.lane + 256 * j; pxa[j] = *(const f32x4*)(xin + (size_t)r0 * D + col); pxb[j] = *(const f32x4*)(xin + (size_t)(r0 + 1) * D + col);
          pma[j] = *(const u32x2*)(MIX + (size_t)r0 * D + col); pmb[j] = *(const u32x2*)(MIX + (size_t)(r0 + 1) * D + col); } }
    for (int rp = 0; rp < 4; ++rp) {
        const int row0 = 64 * grp + 8 * F.wave + 2 * rp; const float* md = MODl + (size_t)(row0 / S) * MODW;
        f32x4 va[4], vb[4];
#pragma unroll
        for (int j = 0; j < 4; ++j) { const int col = 4 * F.lane + 256 * j;
            const f32x4 g = *(const f32x4*)(md + 2 * D + col);
            va[j] = pxa[j] * ALPHA + g * (f32x4){bflo(pma[j].x), bfhi(pma[j].x), bflo(pma[j].y), bfhi(pma[j].y)};
            vb[j] = pxb[j] * ALPHA + g * (f32x4){bflo(pmb[j].x), bfhi(pmb[j].x), bflo(pmb[j].y), bfhi(pmb[j].y)}; }
        if (rp < 3) { const int r0 = row0 + 2;
#pragma unroll
          for (int j = 0; j < 4; ++j) { const int col = 4 * F.lane + 256 * j; pxa[j] = *(const f32x4*)(xin + (size_t)r0 * D + col); pxb[j] = *(const f32x4*)(xin + (size_t)(r0 + 1) * D + col);
              pma[j] = *(const u32x2*)(MIX + (size_t)r0 * D + col); pmb[j] = *(const u32x2*)(MIX + (size_t)(r0 + 1) * D + col); } }
        float mean, rstd;
        row_ln(va, mean, rstd);
#pragma unroll
        for (int j = 0; j < 4; ++j) { const int col = 4 * F.lane + 256 * j; va[j] = va[j] * rstd * *(const f32x4*)(gain + col) + *(const f32x4*)(bias + col); *(f32x4*)(XA + (size_t)row0 * D + col) = va[j]; }
        row_ln(vb, mean, rstd);
#pragma unroll
        for (int j = 0; j < 4; ++j) { const int col = 4 * F.lane + 256 * j; vb[j] = vb[j] * rstd * *(const f32x4*)(gain + col) + *(const f32x4*)(bias + col); *(f32x4*)(XA + (size_t)(row0 + 1) * D + col) = vb[j]; }
        row_mod_store(va, md, 3 * D, 4 * D, U + (size_t)row0 * D, F.lane);
        row_mod_store(vb, md, 3 * D, 4 * D, U + (size_t)(row0 + 1) * D, F.lane);
#ifdef DRY_NOROUTER
        if (dry) continue;
#endif
        LAS float* lg = (LAS float*)(F.lds + 36 * D * 4) + F.wave * 72;
#pragma unroll 1
        for (int n = 0; n < 36; n += 3) { float sa[3], sb[3];
#pragma unroll
            for (int q = 0; q < 3; ++q) { sa[q] = 0.f; sb[q] = 0.f;
#pragma unroll
                for (int j = 0; j < 4; ++j) { const f32x4 w = *(const LAS f32x4*)(RT + (n + q) * D + 4 * F.lane + 256 * j);
                    sa[q] += (va[j][0] * w[0] + va[j][1] * w[1]) + (va[j][2] * w[2] + va[j][3] * w[3]);
                    sb[q] += (vb[j][0] * w[0] + vb[j][1] * w[1]) + (vb[j][2] * w[2] + vb[j][3] * w[3]); } }
#pragma unroll
            for (int q = 0; q < 3; ++q) { sa[q] = wave_sum(sa[q]); sb[q] = wave_sum(sb[q]); }
            if (F.lane == 0) {
#pragma unroll
                for (int q = 0; q < 3; ++q) { lg[n + q] = sa[q]; lg[36 + n + q] = sb[q]; } } }
        LDS_WAIT();
#pragma unroll
        for (int rr = 0; rr < 2; ++rr) {
            float gl[4], el[32];
#pragma unroll
            for (int n = 0; n < 4; ++n) gl[n] = lg[36 * rr + n] + bg[n];
#pragma unroll
            for (int n = 0; n < 32; ++n) el[n] = lg[36 * rr + 4 + n] + be[n];
            int gi = 0; float gm = gl[0];
#pragma unroll
            for (int n = 1; n < 4; ++n) if (gl[n] > gm) { gm = gl[n]; gi = n; }
            float se = 0.f;
#pragma unroll
            for (int n = 0; n < 4; ++n) se += expf(gl[n] - gm);
            const float pg = 1.f / se;
            float l1 = -3.0e38f, l2 = -3.0e38f; int i1 = 0, i2 = 0;
#pragma unroll
            for (int n = 0; n < 32; ++n) if ((n >> 3) == gi) { const float v = el[n]; const int e = n & 7;
                if (v > l1) { l2 = l1; i2 = i1; l1 = v; i1 = e; } else if (v > l2) { l2 = v; i2 = e; } }
            const float e2 = expf(l2 - l1); const float w1 = pg / (1.f + e2), w2 = pg * e2 / (1.f + e2);
            if (F.lane == 0) {
                const int tok = row0 + rr, ea = gi * EPG + i1, eb = gi * EPG + i2;
                const unsigned pa = __hip_atomic_fetch_add(&cntl[ea], 1u, __ATOMIC_RELAXED, __HIP_MEMORY_SCOPE_WORKGROUP), pb = __hip_atomic_fetch_add(&cntl[eb], 1u, __ATOMIC_RELAXED, __HIP_MEMORY_SCOPE_WORKGROUP);
                TOKSLOT[tok * 2] = (ea << 14) | (int)pa; TOKSLOT[tok * 2 + 1] = (eb << 14) | (int)pb;
                TOKW[tok * 2] = w1; TOKW[tok * 2 + 1] = w2;
            }
        }
    }
    __syncthreads();
    if (F.tid < NE) BC[grp * NE + F.tid] = (int)cntl[F.tid];
    __syncthreads();
    }
}

DI void build_tables(const Frame& F, int l, LAS int* tb) {
    if (F.tid < 64) {
        const int e = F.lane; const int c = e < NE ? ((const int*)(F.ws + WS_CNTF))[e] : 0; const int tl = (c + 255) >> 8;
        int cum = c, tin = tl;
#pragma unroll
        for (int o = 1; o < 32; o <<= 1) { const int a1 = __shfl_up(cum, o), a2 = __shfl_up(tin, o); if (e >= o) { cum += a1; tin += a2; } }
        if (e < NE) { tb[e] = cum - c; tb[33 + e] = (tin - tl) * 256; for (int t2 = 0; t2 < tl; ++t2) tb[66 + (tin - tl) + t2] = e; }
        if (e == NE - 1) { tb[32] = cum; tb[65] = tin; }
    }
    __syncthreads();
}
DI void p_gather(const Frame& F, int l) {
    LAS int* base = (LAS int*)F.lds;
    LAS int* segt = base + NGRP * NE;
    LAS int* offp = segt + 16 * NE;
    const int* BC = (const int*)(F.ws + WS_BC);
    { int tmp[NGRP * NE / NTHREADS];
#pragma unroll
      for (int q = 0; q < NGRP * NE / NTHREADS; ++q) tmp[q] = BC[F.tid + q * NTHREADS];
#pragma unroll
      for (int q = 0; q < NGRP * NE / NTHREADS; ++q) base[F.tid + q * NTHREADS] = tmp[q]; }
    __syncthreads();
    { const int e = F.tid & 31, sg = F.tid >> 5; int run = 0;
      for (int g = 16 * sg; g < 16 * sg + 16; ++g) { const int c = base[g * NE + e]; base[g * NE + e] = run; run += c; }
      segt[sg * NE + e] = run; }
    __syncthreads();
    if (F.tid < NE) { int run = 0; for (int sg = 0; sg < 16; ++sg) { const int c = segt[sg * NE + F.tid]; segt[sg * NE + F.tid] = run; run += c; }
        offp[F.tid] = run;
        if (F.bx == 0) ((int*)(F.ws + WS_CNTF))[F.tid] = run; }
    __syncthreads();
    if (F.tid == 0) { int off = 0; for (int e = 0; e < NE; ++e) { const int c = offp[e]; offp[e] = off; off += ((c + 255) >> 8) * 256; } }
    __syncthreads();
    const int* TOKSLOT = (const int*)(F.ws + WS_TOKSLOT); const float* TOKW = (const float*)(F.ws + WS_TOKW); int* TOKFIN = (int*)(F.ws + WS_TOKFIN);
    float* SLOTW = (float*)(F.ws + WS_SLOTW);
    const int nas = (2 * T - F.gw + F.ngw - 1) / F.ngw;
    int my_slot = 0, my_tok = 0;
    if (F.lane < nas) { const int as = F.gw + F.lane * F.ngw; const int tok = as >> 1, ts = TOKSLOT[as], e = ts >> 14, grp = tok >> 6, sg = grp >> 4;
        my_slot = offp[e] + segt[sg * NE + e] + base[grp * NE + e] + (ts & 16383); my_tok = tok;
        SLOTW[my_slot] = TOKW[as]; TOKFIN[as] = my_slot; ((int*)(F.ws + WS_CTL + WS_SLOTTOK))[my_slot] = tok; }
}
struct Rp2In { f32x4 x[4]; u32x2 y0[4], y1[4]; };
DI void rp2_load(Rp2In& r, const float* XA, const bf16_t* YS, int row, int s0, int s1, int lane) {
#pragma unroll
    for (int j = 0; j < 4; ++j) { const int col = 4 * lane + 256 * j;
        r.x[j] = *(const f32x4*)(XA + (size_t)row * D + col); r.y0[j] = *(const u32x2*)(YS + (size_t)s0 * D + col); r.y1[j] = *(const u32x2*)(YS + (size_t)s1 * D + col); }
}
DI void p_rowpass2(const Frame& F, const Args& a, int l, float* xout) {
    const float* MOD = (const float*)(F.ws + WS_MOD);
    const float* XA = (const float*)(F.ws + WS_XA); const bf16_t* YS = (const bf16_t*)(F.ws + WS_YS); const int* TOKFIN = (const int*)(F.ws + WS_TOKFIN);
    const float* gain = a.in[22] + (size_t)l * D; const float* bias = a.in[23] + (size_t)l * D;
    bf16_t* U = (bf16_t*)(F.ws + WS_U);
    const int nrows = (T - F.gw + F.ngw - 1) / F.ngw;
    int tf = 0; { const int i = F.lane >> 1; if (i < nrows) tf = TOKFIN[(F.gw + i * F.ngw) * 2 + (F.lane & 1)]; }
    Rp2In cur, nxt;
    if (nrows > 0) rp2_load(cur, XA, YS, F.gw, __shfl(tf, 0), __shfl(tf, 1), F.lane);
    for (int i = 0; i < nrows; ++i) {
        const int row = F.gw + i * F.ngw;
        if (i + 1 < nrows) rp2_load(nxt, XA, YS, row + F.ngw, __shfl(tf, 2 * i + 2), __shfl(tf, 2 * i + 3), F.lane);
        const float* md = MOD + (size_t)(l * NB + row / S) * MODW;
        f32x4 v[4];
#pragma unroll
        for (int j = 0; j < 4; ++j) { const int col = 4 * F.lane + 256 * j;
            const f32x4 g = *(const f32x4*)(md + 5 * D + col);
            const u32x2 y0 = cur.y0[j], y1 = cur.y1[j];
            const f32x4 f = (f32x4){bflo(y0.x) + bflo(y1.x), bfhi(y0.x) + bfhi(y1.x), bflo(y0.y) + bflo(y1.y), bfhi(y0.y) + bfhi(y1.y)};
            v[j] = cur.x[j] * ALPHA + g * f; }
        float mean, rstd; row_ln(v, mean, rstd);
#pragma unroll
        for (int j = 0; j < 4; ++j) { const int col = 4 * F.lane + 256 * j; v[j] = v[j] * rstd * *(const f32x4*)(gain + col) + *(const f32x4*)(bias + col); *(f32x4*)(xout + (size_t)row * D + col) = v[j]; }
        if (l + 1 < L) row_mod_store(v, MOD + (size_t)((l + 1) * NB + row / S) * MODW, 0, D, U + (size_t)row * D, F.lane);
        if (i + 1 < nrows) {
#pragma unroll
            for (int j = 0; j < 4; ++j) { cur.x[j] = nxt.x[j]; cur.y0[j] = nxt.y0[j]; cur.y1[j] = nxt.y1[j]; } }
    }
}

#define MFMA16(a, b, c) __builtin_amdgcn_mfma_f32_16x16x32_bf16((a), (b), (c), 0, 0, 0)
#define MFMA32(a, b, c) __builtin_amdgcn_mfma_f32_32x32x16_bf16((a), (b), (c), 0, 0, 0)
constexpr int RB = 9216;
#define BUF(i) ((i) * RB)
constexpr int LWOFF = BUF(12), ZAOFF = BUF(0), SEGOFF = BUF(14), SEGXOFF = BUF(14) + 2048, TOTOFF = BUF(14) + 4096, NABFOFF = BUF(15), PCOFF = 16 * RB;
struct RwP { const float *conv, *w0, *w_up, *a0, *a_up, *g_up, *k_k, *k_a, *r_k, *gn_gain, *gn_bias; };

DI void lds_barrier() { asm volatile("s_waitcnt lgkmcnt(0)" ::: "memory"); __builtin_amdgcn_s_barrier(); asm volatile("" ::: "memory"); }
DI bf16x8 ldfrag(const LAS unsigned char* lds, int buf, int row, int ks, int lane) { return *(const LAS bf16x8*)(lds + buf + row * 144 + (32 * ks + 8 * (lane >> 4)) * 2); }
DI f32x4 mm64(const LAS unsigned char* lds, int abuf, int arow0, int bbuf, int brow0, int lane) {
    f32x4 acc = (f32x4){0.f, 0.f, 0.f, 0.f};
#pragma unroll
    for (int ks = 0; ks < 2; ++ks) acc = MFMA16(ldfrag(lds, abuf, arow0 + (lane & 15), ks, lane), ldfrag(lds, bbuf, brow0 + (lane & 15), ks, lane), acc);
    return acc;
}
DI u32x2 pack4(const f32x4 v) { u32x2 w; w.x = cvtpk(v[0], v[1]); w.y = cvtpk(v[2], v[3]); return w; }
DI f32x4 unpack4(const u32x2 w) { return (f32x4){bflo(w.x), bfhi(w.x), bflo(w.y), bfhi(w.y)}; }
DI void st4(LAS unsigned char* lds, int buf, int row, int col, const f32x4 v) { *(LAS u32x2*)(lds + buf + row * 144 + col * 2) = pack4(v); }
DI f32x4 ld4(const LAS unsigned char* lds, int buf, int row, int col) { return unpack4(*(const LAS u32x2*)(lds + buf + row * 144 + col * 2)); }
DI void st1(LAS unsigned char* lds, int buf, int row, int col, float v) { *(LAS bf16_t*)(lds + buf + row * 144 + col * 2) = f2bf(v); }
DI float fast_tanh(float x) { const float e = fexp2(x * (2.f * LOG2E)); return 1.f - 2.f * frcp(1.f + e); }

#define OPQZ(z) int z; asm volatile("s_mov_b32 %0, 0" : "=s"(z))
constexpr int CWLOFF = PCOFF + 256;
constexpr int PRMOFF = CWLOFF + 6912;
struct RwPre { u32x2 wv, av; u32x4 gv; f32x4 w4, a4, g0, g1; u32x4 rr[3], kk[3], vv[3]; };
DI void rwkv_prefetch(const Frame& F, const Args& a, const int l, const int unit, RwPre& P) {
    const int tid = F.tid;
    const int c = unit % NCH, hd = (unit / NCH) % BH, b = (unit / (NCH * BH)) % NB, dir = unit / (NCH * BH * NB);
    const bf16_t* HBp = (const bf16_t*)(F.ws + WS_HB);
    const int u = tid >> 3, jg = tid & 7, tloc = 64 * c + u; const size_t tok = (size_t)b * S + tloc;
    const bf16_t* hrow = HBp + tok * HW;
    P.wv = *(const u32x2*)(hrow + HWL + 4 * jg); P.av = *(const u32x2*)(hrow + HAL + 4 * jg); P.gv = *(const u32x4*)(hrow + HGL + 8 * jg);
    OPQZ(z0);
    { const int m = tid >> 4, j4 = (tid & 15) * 4;
      const float* w_up = a.in[8 + z0] + (size_t)l * 2 * RW * BW; const float* a_up = a.in[10 + z0] + (size_t)l * 2 * RA * BW;
      P.w4 = *(const f32x4*)(w_up + (size_t)(dir * RW + m) * BW + hd * HD + j4); P.a4 = *(const f32x4*)(a_up + (size_t)(dir * RA + m) * BW + hd * HD + j4); }
    { const int m = tid >> 3, i8 = (tid & 7) * 8; const float* g_up = a.in[11 + z0] + (size_t)l * RG * BW;
      P.g0 = *(const f32x4*)(g_up + (size_t)m * BW + hd * HD + i8); P.g1 = *(const f32x4*)(g_up + (size_t)m * BW + hd * HD + i8 + 4); }
    const int ch0 = hd * HD + 8 * jg;
#pragma unroll
    for (int x = 0; x < 3; ++x) {
        const int tt = tloc + x - 1; const u32x4 z4 = (u32x4){0u, 0u, 0u, 0u};
        if (tt >= 0 && tt < S) { const bf16_t* hp = HBp + ((size_t)b * S + tt) * HW + HR + ch0; P.rr[x] = *(const u32x4*)hp; P.kk[x] = *(const u32x4*)(hp + BW); P.vv[x] = *(const u32x4*)(hp + 2 * BW); }
        else { P.rr[x] = z4; P.kk[x] = z4; P.vv[x] = z4; }
    }
}
DI void rwkv_local_unit(const Frame& F, const Args& a, const int l, const int unit, RwPre& PF, const int next_unit) {
    LAS unsigned char* lds = F.lds;
    int tid_ = F.tid; asm volatile("" : "+v"(tid_));
    const int tid = tid_, lane = tid_ & 63, wave = F.wave;
    const int c = unit % NCH, hd = (unit / NCH) % BH, b = (unit / (NCH * BH)) % NB, dir = unit / (NCH * BH * NB);
    const bf16_t* HBp = (const bf16_t*)(F.ws + WS_HB);
    const int u = tid >> 3, jg = tid & 7, tau = dir ? 63 - u : u, tloc = 64 * c + u;
    const size_t tok = (size_t)b * S + tloc;
    const int tn = wave & 3, tm0 = 2 * (wave >> 2), g4 = lane >> 4, l15 = lane & 15;
    if (tid < 320) { OPQZ(z2); const int which = tid >> 6, j = tid & 63;
      const float* src = which == 0 ? a.in[7 + z2] + (size_t)l * 2 * BW + dir * BW : which == 1 ? a.in[9 + z2] + (size_t)l * 2 * BW + dir * BW : which == 2 ? a.in[12 + z2] + (size_t)l * BW : which == 3 ? a.in[13 + z2] + (size_t)l * BW : a.in[14 + z2] + (size_t)l * BH * HD;
      *(LAS float*)(lds + PRMOFF + tid * 4) = src[hd * HD + j]; }
    {
        const f32x4 wf = unpack4(PF.wv);
        *(LAS u32x2*)(lds + BUF(8) + tau * 144 + (4 * jg) * 2) = pack4((f32x4){fast_tanh(wf[0]), fast_tanh(wf[1]), fast_tanh(wf[2]), fast_tanh(wf[3])});
        *(LAS u32x2*)(lds + BUF(8) + tau * 144 + (32 + 4 * jg) * 2) = PF.av;
        const u32x4 gv = PF.gv;
        u32x4 so; so.x = cvtpk(sigm(bflo(gv.x)), sigm(bfhi(gv.x))); so.y = cvtpk(sigm(bflo(gv.y)), sigm(bfhi(gv.y))); so.z = cvtpk(sigm(bflo(gv.z)), sigm(bfhi(gv.z))); so.w = cvtpk(sigm(bflo(gv.w)), sigm(bfhi(gv.w)));
        *(LAS u32x4*)(lds + BUF(9) + tau * 144 + 16 * jg) = so;
        { const int m = tid >> 4, j4 = (tid & 15) * 4;
#pragma unroll
          for (int e = 0; e < 4; ++e) { st1(lds, BUF(10), j4 + e, m, PF.w4[e]); st1(lds, BUF(10), j4 + e, 32 + m, PF.a4[e]); } }
        { const int m = tid >> 3, i8 = (tid & 7) * 8;
#pragma unroll
          for (int e = 0; e < 4; ++e) { st1(lds, BUF(11), i8 + e, m, PF.g0[e]); st1(lds, BUF(11), i8 + 4 + e, m, PF.g1[e]); } }
    }
    lds_barrier();
#pragma unroll
    for (int tmi = 0; tmi < 2; ++tmi) {
        const int tm = tm0 + tmi; const f32x4 z = (f32x4){0.f, 0.f, 0.f, 0.f};
        const f32x4 zw = MFMA16(ldfrag(lds, BUF(10), 16 * tm + l15, 0, lane), ldfrag(lds, BUF(8), 16 * tn + l15, 0, lane), z);
        const f32x4 za = MFMA16(ldfrag(lds, BUF(10), 16 * tm + l15, 1, lane), ldfrag(lds, BUF(8), 16 * tn + l15, 1, lane), z);
        const int trow = 16 * tn + l15, jb = 16 * tm + 4 * g4;
        *(LAS f32x4*)(lds + LWOFF + (trow * 64 + jb) * 4) = zw;
        *(LAS f32x4*)(lds + ZAOFF + (trow * 64 + jb) * 4) = za;
        if (dir == 0) {
            const f32x4 gg = mm64(lds, BUF(11), 16 * tm, BUF(9), 16 * tn, lane);
            *(u32x2*)((bf16_t*)(F.ws + WS_GB) + ((size_t)b * S + 64 * c + trow) * BW + hd * HD + jb) = pack4(gg);
        }
    }
    lds_barrier();
    const int ch0 = hd * HD + 8 * jg;
    float r[8], kd[8], kap[8], bb[8], lw[8];
    {
        float k[8], v[8];
#pragma unroll
        for (int e = 0; e < 8; ++e) { r[e] = 0.f; k[e] = 0.f; v[e] = 0.f; }
#pragma unroll
        for (int x = 0; x < 3; ++x) {
            const LAS unsigned char* cwp = lds + CWLOFF + (((hd * 3 + x) * 3) * 64 + 8 * jg) * 2;
            const u32x4 cr = *(const LAS u32x4*)cwp, ck = *(const LAS u32x4*)(cwp + 128), cv = *(const LAS u32x4*)(cwp + 256);
            const u32x4 rr = PF.rr[x], kk2 = PF.kk[x], vv = PF.vv[x];
            r[0] += bflo(rr.x) * bflo(cr.x); r[1] += bfhi(rr.x) * bfhi(cr.x); r[2] += bflo(rr.y) * bflo(cr.y); r[3] += bfhi(rr.y) * bfhi(cr.y);
            r[4] += bflo(rr.z) * bflo(cr.z); r[5] += bfhi(rr.z) * bfhi(cr.z); r[6] += bflo(rr.w) * bflo(cr.w); r[7] += bfhi(rr.w) * bfhi(cr.w);
            k[0] += bflo(kk2.x) * bflo(ck.x); k[1] += bfhi(kk2.x) * bfhi(ck.x); k[2] += bflo(kk2.y) * bflo(ck.y); k[3] += bfhi(kk2.y) * bfhi(ck.y);
            k[4] += bflo(kk2.z) * bflo(ck.z); k[5] += bfhi(kk2.z) * bfhi(ck.z); k[6] += bflo(kk2.w) * bflo(ck.w); k[7] += bfhi(kk2.w) * bfhi(ck.w);
            v[0] += bflo(vv.x) * bflo(cv.x); v[1] += bfhi(vv.x) * bfhi(cv.x); v[2] += bflo(vv.y) * bflo(cv.y); v[3] += bfhi(vv.y) * bfhi(cv.y);
            v[4] += bflo(vv.z) * bflo(cv.z); v[5] += bfhi(vv.z) * bfhi(cv.z); v[6] += bflo(vv.w) * bflo(cv.w); v[7] += bfhi(vv.w) * bfhi(cv.w);
        }
        const f32x4 zw0 = *(const LAS f32x4*)(lds + LWOFF + (tau * 64 + 8 * jg) * 4), zw1 = *(const LAS f32x4*)(lds + LWOFF + (tau * 64 + 8 * jg + 4) * 4);
        const f32x4 za0 = *(const LAS f32x4*)(lds + ZAOFF + (tau * 64 + 8 * jg) * 4), za1 = *(const LAS f32x4*)(lds + ZAOFF + (tau * 64 + 8 * jg + 4) * 4);
        float ss = 0.f, bsp = 0.f, av[8];
        const LAS f32x4* prm = (const LAS f32x4*)(lds + PRMOFF) + 2 * jg;
        const f32x4 w0a = prm[0], w0b = prm[1], a0a = prm[16], a0b = prm[17], kka = prm[32], kkb = prm[33], kaa = prm[48], kab = prm[49], rka = prm[64], rkb = prm[65];
#pragma unroll
        for (int e = 0; e < 8; ++e) {
            const float zw = (e < 4 ? zw0[e & 3] : zw1[e & 3]) + (e < 4 ? w0a[e & 3] : w0b[e & 3]);
            const float za = (e < 4 ? za0[e & 3] : za1[e & 3]) + (e < 4 ? a0a[e & 3] : a0b[e & 3]);
            lw[e] = (-DECAY * LOG2E) * sigm(zw); av[e] = sigm(za);
            kap[e] = k[e] * (e < 4 ? kka[e & 3] : kkb[e & 3]); ss += kap[e] * kap[e];
            kd[e] = k[e] * (1.f + (av[e] - 1.f) * (e < 4 ? kaa[e & 3] : kab[e & 3]));
            bsp += r[e] * kd[e] * (e < 4 ? rka[e & 3] : rkb[e & 3]);
        }
        ss += __shfl_xor(ss, 1); ss += __shfl_xor(ss, 2); ss += __shfl_xor(ss, 4);
        bsp += __shfl_xor(bsp, 1); bsp += __shfl_xor(bsp, 2); bsp += __shfl_xor(bsp, 4);
        const float rn = __builtin_amdgcn_rsqf(fmaxf(ss, 1e-24f));
#pragma unroll
        for (int e = 0; e < 8; ++e) { kap[e] *= rn; bb[e] = kap[e] * av[e]; }
        if (jg == 0) ((float*)(F.ws + WS_BS))[((size_t)dir * T + tok) * 8 + hd] = bsp;
        *(LAS f32x4*)(lds + LWOFF + (tau * 64 + 8 * jg) * 4) = (f32x4){lw[0], lw[1], lw[2], lw[3]};
        *(LAS f32x4*)(lds + LWOFF + (tau * 64 + 8 * jg + 4) * 4) = (f32x4){lw[4], lw[5], lw[6], lw[7]};
#pragma unroll
        for (int e = 0; e < 8; ++e) st1(lds, BUF(7), 8 * jg + e, tau, v[e]);
        if (dir == 0) {
            u32x4 vo; vo.x = cvtpk(v[0], v[1]); vo.y = cvtpk(v[2], v[3]); vo.z = cvtpk(v[4], v[5]); vo.w = cvtpk(v[6], v[7]);
            *(u32x4*)((bf16_t*)(F.ws + WS_VC) + tok * BW + ch0) = vo;
        }
    }
    lds_barrier();
    if (dir == 0) {
        const size_t ucidx = ((size_t)b * BH + hd) * NCH + c; const int vi = tid >> 3, vc = tid & 7;
        *(u32x4*)((bf16_t*)(F.ws + WS_VTB) + ucidx * 4096 + vi * 64 + vc * 8) = *(const LAS u32x4*)(lds + BUF(7) + vi * 144 + vc * 16);
    }
    { const int seg = tid >> 6, j = tid & 63; float p = 0.f;
#pragma unroll
      for (int i = 0; i < 8; ++i) { LAS float* q = (LAS float*)(lds + LWOFF + ((8 * seg + i) * 64 + j) * 4); p += *q; *q = p; }
      *(LAS float*)(lds + SEGOFF + (seg * 64 + j) * 4) = p; }
    lds_barrier();
    if (tid < 64) { float run = 0.f;
#pragma unroll
      for (int sg = 0; sg < 8; ++sg) { *(LAS float*)(lds + SEGXOFF + (sg * 64 + tid) * 4) = run; run += *(const LAS float*)(lds + SEGOFF + (sg * 64 + tid) * 4); }
      *(LAS float*)(lds + TOTOFF + tid * 4) = run; }
    lds_barrier();
    {
        float At[8], Rt[8], Bt[8], Kt[8], Bh[8], Kh[8];
#pragma unroll
        for (int e = 0; e < 8; ++e) {
            const int j = 8 * jg + e;
            const float lwi = *(const LAS float*)(lds + LWOFF + (tau * 64 + j) * 4) + *(const LAS float*)(lds + SEGXOFF + ((tau >> 3) * 64 + j) * 4);
            const float tot = *(const LAS float*)(lds + TOTOFF + j * 4);
            const float ep = fexp2(lwi - lw[e]), epl = fexp2(lwi), em = fexp2(-lwi), ec = fexp2(tot - lwi);
            At[e] = -kap[e] * ep; Rt[e] = r[e] * epl; Bt[e] = bb[e] * em; Kt[e] = kd[e] * em; Bh[e] = bb[e] * ec; Kh[e] = kd[e] * ec;
            if (u == 0) *(LAS float*)(lds + PCOFF + j * 4) = fexp2(tot);
        }
        u32x4 o;
#define PK8(X) (o.x = cvtpk(X[0], X[1]), o.y = cvtpk(X[2], X[3]), o.z = cvtpk(X[4], X[5]), o.w = cvtpk(X[6], X[7]), o)
        *(LAS u32x4*)(lds + BUF(0) + tau * 144 + 16 * jg) = PK8(At);
        *(LAS u32x4*)(lds + BUF(1) + tau * 144 + 16 * jg) = PK8(Bt);
        *(LAS u32x4*)(lds + BUF(2) + tau * 144 + 16 * jg) = PK8(Kt);
        *(LAS u32x4*)(lds + BUF(3) + tau * 144 + 16 * jg) = PK8(Rt);
#undef PK8
#pragma unroll
        for (int e = 0; e < 8; ++e) { const int j = 8 * jg + e; st1(lds, BUF(4), j, tau, At[e]); st1(lds, BUF(5), j, tau, Bh[e]); st1(lds, BUF(6), j, tau, Kh[e]); }
    }
    if (next_unit >= 0) rwkv_prefetch(F, a, l, next_unit, PF);
    lds_barrier();
#pragma unroll
    for (int tmi = 0; tmi < 2; ++tmi) {
        const int tm = tm0 + tmi, mb = 16 * tm + 4 * g4, nn = 16 * tn + l15;
        { f32x4 v = mm64(lds, BUF(1), 16 * tm, BUF(0), 16 * tn, lane);
#pragma unroll
          for (int e = 0; e < 4; ++e) v[e] = (mb + e < nn) ? v[e] : 0.f;
          if (tm == tn) {
#pragma unroll
              for (int e = 0; e < 4; ++e) *(LAS float*)(lds + NABFOFF + ((16 * tm + l15) * 16 + ((mb + e) & 15)) * 4) = v[e];
              v = (f32x4){0.f, 0.f, 0.f, 0.f};
          }
          st4(lds, BUF(11), nn, mb, v); }
        { f32x4 v = mm64(lds, BUF(0), 16 * tm, BUF(2), 16 * tn, lane);
#pragma unroll
          for (int e = 0; e < 4; ++e) v[e] = (nn < mb + e) ? v[e] : 0.f;
          st4(lds, BUF(8), nn, mb, v); }
        { f32x4 v = mm64(lds, BUF(1), 16 * tm, BUF(3), 16 * tn, lane);
#pragma unroll
          for (int e = 0; e < 4; ++e) v[e] = (mb + e <= nn) ? v[e] : 0.f;
          st4(lds, BUF(9), nn, mb, v); }
        { f32x4 v = mm64(lds, BUF(2), 16 * tm, BUF(3), 16 * tn, lane);
#pragma unroll
          for (int e = 0; e < 4; ++e) v[e] = (mb + e <= nn) ? v[e] : 0.f;
          st4(lds, BUF(10), nn, mb, v); }
    }
    lds_barrier();
    if (wave == 0) {
        const int blk = lane >> 4, sr = lane & 15, s = 16 * blk + sr;
        float Tr[16];
#pragma unroll
        for (int t = 0; t < 16; ++t) { float acc = (t == sr) ? 1.f : 0.f;
            const LAS f32x4* col = (const LAS f32x4*)(lds + NABFOFF + ((16 * blk + t) * 16) * 4);
#pragma unroll
            for (int q = 0; q < (t + 3) / 4; ++q) { const f32x4 nv = col[q];
#pragma unroll
                for (int e = 0; e < 4; ++e) if (4 * q + e < t) acc += Tr[4 * q + e] * nv[e]; }
            Tr[t] = acc; __builtin_amdgcn_sched_barrier(0); }
        const u32x4 z4 = (u32x4){0u, 0u, 0u, 0u};
#pragma unroll
        for (int q = 0; q < 9; ++q) { *(LAS u32x4*)(lds + BUF(0) + s * 144 + 16 * q) = z4; *(LAS u32x4*)(lds + BUF(1) + s * 144 + 16 * q) = z4; }
        u32x4 o0, o1; o0.x = cvtpk(Tr[0], Tr[1]); o0.y = cvtpk(Tr[2], Tr[3]); o0.z = cvtpk(Tr[4], Tr[5]); o0.w = cvtpk(Tr[6], Tr[7]);
        o1.x = cvtpk(Tr[8], Tr[9]); o1.y = cvtpk(Tr[10], Tr[11]); o1.z = cvtpk(Tr[12], Tr[13]); o1.w = cvtpk(Tr[14], Tr[15]);
        LDS_WAIT();
        *(LAS u32x4*)(lds + BUF(0) + s * 144 + 32 * blk) = o0; *(LAS u32x4*)(lds + BUF(0) + s * 144 + 32 * blk + 16) = o1;
#pragma unroll
        for (int t = 0; t < 16; ++t) st1(lds, BUF(1), 16 * blk + t, s, Tr[t]);
    }
    lds_barrier();
#pragma unroll
    for (int tmi = 0; tmi < 2; ++tmi) {
        const int tm = tm0 + tmi, mb = 16 * tm + 4 * g4, nn = 16 * tn + l15;
        const f32x4 v = mm64(lds, BUF(0), 16 * tm, BUF(11), 16 * tn, lane);
        st4(lds, BUF(12), nn, mb, v);
#pragma unroll
        for (int e = 0; e < 4; ++e) st1(lds, BUF(2), mb + e, nn, v[e]);
    }
    lds_barrier();
#pragma unroll
    for (int tmi = 0; tmi < 2; ++tmi) {
        const int tm = tm0 + tmi, mb = 16 * tm + 4 * g4, nn = 16 * tn + l15;
        const f32x4 v = mm64(lds, BUF(12), 16 * tm, BUF(2), 16 * tn, lane);
        st4(lds, BUF(13), nn, mb, v);
    }
    lds_barrier();
#pragma unroll
    for (int tmi = 0; tmi < 2; ++tmi) {
        const int tm = tm0 + tmi, mb = 16 * tm + 4 * g4, nn = 16 * tn + l15;
        const f32x4 v = mm64(lds, BUF(13), 16 * tm, BUF(1), 16 * tn, lane) + ld4(lds, BUF(1), nn, mb);
        st4(lds, BUF(14), nn, mb, v);
    }
    lds_barrier();
#pragma unroll
    for (int tmi = 0; tmi < 2; ++tmi) {
        const int tm = tm0 + tmi, mb = 16 * tm + 4 * g4, nn = 16 * tn + l15;
        const f32x4 v = mm64(lds, BUF(2), 16 * tm, BUF(14), 16 * tn, lane) + ld4(lds, BUF(14), nn, mb);
        st4(lds, BUF(15), nn, mb, v);
    }
    lds_barrier();
#pragma unroll
    for (int tmi = 0; tmi < 2; ++tmi) {
        const int tm = tm0 + tmi, mb = 16 * tm + 4 * g4, nn = 16 * tn + l15;
        const f32x4 x1 = mm64(lds, BUF(15), 16 * tm, BUF(4), 16 * tn, lane);
        const f32x4 x2 = mm64(lds, BUF(15), 16 * tm, BUF(8), 16 * tn, lane);
        st4(lds, BUF(0), nn, mb, x1); st4(lds, BUF(1), nn, mb, x2);
    }
    lds_barrier();
    {
        bf16_t* QT = (bf16_t*)(F.ws + WS_QT) + (size_t)unit * 4096; bf16_t* WT = (bf16_t*)(F.ws + WS_WT) + (size_t)unit * 4096; bf16_t* MP = (bf16_t*)(F.ws + WS_MP) + (size_t)unit * 4096;
#pragma unroll
        for (int tmi = 0; tmi < 2; ++tmi) {
            const int tm = tm0 + tmi, mb = 16 * tm + 4 * g4, nn = 16 * tn + l15;
            { const f32x4 v = mm64(lds, BUF(0), 16 * tm, BUF(9), 16 * tn, lane) + ld4(lds, BUF(3), nn, mb);
              *(u32x2*)(QT + (dir ? 63 - nn : nn) * 64 + mb) = pack4(v); }
            { const f32x4 v = mm64(lds, BUF(1), 16 * tm, BUF(9), 16 * tn, lane) + ld4(lds, BUF(10), nn, mb);
              if (dir) *(u32x2*)(WT + (63 - nn) * 64 + (60 - mb)) = pack4((f32x4){v[3], v[2], v[1], v[0]});
              else *(u32x2*)(WT + nn * 64 + mb) = pack4(v); }
            { f32x4 v = mm64(lds, BUF(0), 16 * tm, BUF(5), 16 * tn, lane);
#pragma unroll
              for (int e = 0; e < 4; ++e) if (mb + e == nn) v[e] += *(const LAS float*)(lds + PCOFF + nn * 4);
              *(u32x2*)(MP + nn * 64 + swap23(mb)) = pack4(v); }
            { const f32x4 v = mm64(lds, BUF(1), 16 * tm, BUF(5), 16 * tn, lane) + ld4(lds, BUF(6), nn, mb);
              st4(lds, BUF(2), nn, mb, v); }
        }
    }
    lds_barrier();
    {
        bf16_t* NBp = (bf16_t*)(F.ws + WS_NB);
#pragma unroll
        for (int tmi = 0; tmi < 2; ++tmi) {
            const int tm = tm0 + tmi, mb = 16 * tm + 4 * g4, ii = 16 * tn + l15;
            const f32x4 v = mm64(lds, BUF(2), 16 * tm, BUF(7), 16 * tn, lane);
            const int jb = mb >> 5, jl = mb & 31, q = jl >> 3, hic = (jl >> 2) & 1, ih = ii >> 5, Lc = (ii & 31) + 32 * hic;
            *(u32x2*)(NBp + ((((size_t)unit * 2 + ih) * 2 + jb) * 2 + (q >> 1)) * 512 + Lc * 8 + 4 * (q & 1)) = pack4(v);
        }
    }
    lds_barrier();
}

DI void attn_unit(const Frame& F, const LAS float* rpbl, const int au) {
    const bf16_t* HBp = (const bf16_t*)(F.ws + WS_HB); const bf16_t* VTp = (const bf16_t*)(F.ws + WS_VT); bf16_t* CONCAT = (bf16_t*)(F.ws + WS_CONCAT);
    const int hh = au % AH, r = (au / AH) % ROWS, b = au / (AH * ROWS);
    int rstart = r - KH / 2; rstart = rstart < 0 ? 0 : (rstart > ROWS - KH ? ROWS - KH : rstart);
    const int lane = F.lane, q32 = lane & 31, hi = lane >> 5;
    const float SC = 0.125f * LOG2E;
    const int krow_off = swap23(q32);
#pragma unroll 1
    for (int qb = 0; qb < 2; ++qb) {
        const int cq = 32 * qb + q32; int cs = cq - KW / 2; cs = cs < 0 ? 0 : (cs > GW - KW ? GW - KW : cs);
        const size_t tokq = (size_t)b * S + r * GW + cq;
        bf16x8 qf[4];
#pragma unroll
        for (int ds = 0; ds < 4; ++ds) qf[ds] = *(const bf16x8*)(HBp + tokq * HW + HQ + hh * HD + 16 * ds + 8 * hi);
        f32x16 o0, o1;
#pragma unroll
        for (int i = 0; i < 16; ++i) { o0[i] = 0.f; o1[i] = 0.f; }
        float mrun = -1e30f, lsum = 0.f;
#pragma unroll 1
        for (int kt = 0; kt < 2 * KH; ++kt) {
            const int kr = rstart + (kt >> 1), ckb = 32 * (kt & 1);
            const size_t ktok = (size_t)b * S + kr * GW + ckb;
            bf16x8 kf[4], vf[2][2];
#pragma unroll
            for (int ds = 0; ds < 4; ++ds) kf[ds] = *(const bf16x8*)(HBp + (ktok + krow_off) * HW + HK + hh * HD + 16 * ds + 8 * hi);
#pragma unroll
            for (int db = 0; db < 2; ++db)
#pragma unroll
                for (int s = 0; s < 2; ++s) vf[db][s] = *(const bf16x8*)(VTp + (size_t)(hh * HD + 32 * db + q32) * T + ktok + 16 * s + 8 * hi);
            f32x16 st;
#pragma unroll
            for (int i = 0; i < 16; ++i) st[i] = 0.f;
#pragma unroll
            for (int ds = 0; ds < 4; ++ds) st = MFMA32(kf[ds], qf[ds], st);
            const LAS float* rp = rpbl + (hh * (2 * KH - 1) + (kr - r + KH - 1)) * (2 * KW - 1);
            float sl[16]; float tmax = -1e30f;
#pragma unroll
            for (int i = 0; i < 16; ++i) {
                const int ck = ckb + 16 * (i >> 3) + 8 * hi + (i & 7);
                const bool inw = (ck >= cs) && (ck < cs + KW);
                int dc = ck - cq; dc = dc < -(KW - 1) ? -(KW - 1) : (dc > KW - 1 ? KW - 1 : dc); dc += KW - 1;
                sl[i] = inw ? st[i] * SC + rp[dc] : -1e30f;
                tmax = fmaxf(tmax, sl[i]);
            }
            tmax = fmaxf(tmax, __shfl_xor(tmax, 32));
            const float mn = fmaxf(mrun, tmax), corr = __builtin_amdgcn_exp2f(mrun - mn);
            float ps = 0.f;
#pragma unroll
            for (int i = 0; i < 16; ++i) { sl[i] = (sl[i] > -1e29f) ? __builtin_amdgcn_exp2f(sl[i] - mn) : 0.f; ps += sl[i]; }
            lsum = lsum * corr + ps; mrun = mn;
#pragma unroll
            for (int i = 0; i < 16; ++i) { o0[i] *= corr; o1[i] *= corr; }
            u32x4 p0, p1;
            p0.x = cvtpk(sl[0], sl[1]); p0.y = cvtpk(sl[2], sl[3]); p0.z = cvtpk(sl[4], sl[5]); p0.w = cvtpk(sl[6], sl[7]);
            p1.x = cvtpk(sl[8], sl[9]); p1.y = cvtpk(sl[10], sl[11]); p1.z = cvtpk(sl[12], sl[13]); p1.w = cvtpk(sl[14], sl[15]);
            const bf16x8 pf0 = __builtin_bit_cast(bf16x8, p0), pf1 = __builtin_bit_cast(bf16x8, p1);
            o0 = MFMA32(vf[0][0], pf0, o0); o0 = MFMA32(vf[0][1], pf1, o0);
            o1 = MFMA32(vf[1][0], pf0, o1); o1 = MFMA32(vf[1][1], pf1, o1);
        }
        const float inv = 1.f / (lsum + __shfl_xor(lsum, 32));
        bf16_t* op = CONCAT + tokq * D + hh * HD;
#pragma unroll
        for (int g = 0; g < 4; ++g) {
            *(u32x2*)(op + 8 * g + 4 * hi) = pack4((f32x4){o0[4 * g] * inv, o0[4 * g + 1] * inv, o0[4 * g + 2] * inv, o0[4 * g + 3] * inv});
            *(u32x2*)(op + 32 + 8 * g + 4 * hi) = pack4((f32x4){o1[4 * g] * inv, o1[4 * g + 1] * inv, o1[4 * g + 2] * inv, o1[4 * g + 3] * inv});
        }
    }
}

DI void pool_unit(const Frame& F, const float* pool_w, const float* pool_scale, const int pu) {
    const bf16_t* HBp = (const bf16_t*)(F.ws + WS_HB); bf16_t* CONCAT = (bf16_t*)(F.ws + WS_CONCAT);
    const int g = pu & 3, blk = pu >> 2, b = blk >> 8, t0 = (blk & 255) * 32;
    const int lane = F.lane, q32 = lane & 31, hi = lane >> 5, t = t0 + q32, win = 2 << g;
    int lo = t - win / 2; lo = lo < 0 ? 0 : lo; int hit = t + win / 2 - 1; hit = hit > S - 1 ? S - 1 : hit;
    const float inv = 1.f / (float)(hit - lo + 1);
    f32x16 out0, out1;
#pragma unroll
    for (int i = 0; i < 16; ++i) { out0[i] = 0.f; out1[i] = 0.f; }
    const float* pw = pool_w + (size_t)g * 64 * 64;
#pragma unroll 1
    for (int s = 0; s < 4; ++s) {
        const int c0 = HP + g * 64 + 16 * s + 8 * hi;
        float acc[8];
#pragma unroll
        for (int e = 0; e < 8; ++e) acc[e] = 0.f;
        u32x4 pv[16];
#pragma unroll
        for (int d = 0; d < 16; ++d) { int tt = t - win / 2 + d; const bool ok = d < win && tt >= 0 && tt < S; tt = ok ? tt : t;
            pv[d] = *(const u32x4*)(HBp + ((size_t)b * S + tt) * HW + c0); if (!ok) pv[d] = (u32x4){0u, 0u, 0u, 0u}; }
#pragma unroll
        for (int d = 0; d < 16; ++d) {
            acc[0] += bflo(pv[d].x); acc[1] += bfhi(pv[d].x); acc[2] += bflo(pv[d].y); acc[3] += bfhi(pv[d].y); acc[4] += bflo(pv[d].z); acc[5] += bfhi(pv[d].z); acc[6] += bflo(pv[d].w); acc[7] += bfhi(pv[d].w);
        }
        const u32x4 pc = *(const u32x4*)(HBp + ((size_t)b * S + t) * HW + c0);
        u32x4 o;
        o.x = cvtpk(acc[0] * inv - bflo(pc.x), acc[1] * inv - bfhi(pc.x)); o.y = cvtpk(acc[2] * inv - bflo(pc.y), acc[3] * inv - bfhi(pc.y));
        o.z = cvtpk(acc[4] * inv - bflo(pc.z), acc[5] * inv - bfhi(pc.z)); o.w = cvtpk(acc[6] * inv - bflo(pc.w), acc[7] * inv - bfhi(pc.w));
        const bf16x8 bfr = __builtin_bit_cast(bf16x8, o);
        const float* wp = pw + (size_t)(16 * s + 8 * hi) * 64 + q32;
        u32x4 w0; w0.x = cvtpk(wp[0], wp[64]); w0.y = cvtpk(wp[128], wp[192]); w0.z = cvtpk(wp[256], wp[320]); w0.w = cvtpk(wp[384], wp[448]);
        u32x4 w1; w1.x = cvtpk(wp[32], wp[96]); w1.y = cvtpk(wp[160], wp[224]); w1.z = cvtpk(wp[288], wp[352]); w1.w = cvtpk(wp[416], wp[480]);
        out0 = MFMA32(__builtin_bit_cast(bf16x8, w0), bfr, out0);
        out1 = MFMA32(__builtin_bit_cast(bf16x8, w1), bfr, out1);
    }
    bf16_t* op = CONCAT + ((size_t)b * S + t) * D + AW + BW + g * 64;
    const float* ps = pool_scale + g * 64;
#pragma unroll
    for (int gq = 0; gq < 4; ++gq) {
        const int e0 = 8 * gq + 4 * hi;
        const f32x4 s0 = *(const f32x4*)(ps + e0), s1 = *(const f32x4*)(ps + 32 + e0);
        *(u32x2*)(op + e0) = pack4((f32x4){out0[4 * gq] * s0[0], out0[4 * gq + 1] * s0[1], out0[4 * gq + 2] * s0[2], out0[4 * gq + 3] * s0[3]});
        *(u32x2*)(op + 32 + e0) = pack4((f32x4){out1[4 * gq] * s1[0], out1[4 * gq + 1] * s1[1], out1[4 * gq + 2] * s1[2], out1[4 * gq + 3] * s1[3]});
    }
}

constexpr int SCAN_SLOT = 12288, SCAN_RING = 12;
constexpr int SCAN_FLAGS = SCAN_RING * SCAN_SLOT;
DI void scan_issue(const Frame& F, const int sc, const int ihalf, const int dir, const int step, const int lane) {
    const int c = dir ? NCH - 1 - step : step; const size_t unit = (size_t)sc * NCH + c;
    const int il = lane & 31, hi = lane >> 5;
    LAS unsigned char* slot = F.lds + (step % SCAN_RING) * SCAN_SLOT;
    const bf16_t* MP = (const bf16_t*)(F.ws + WS_MP) + unit * 4096; const bf16_t* NBp = (const bf16_t*)(F.ws + WS_NB) + (unit * 2 + ihalf) * 2048;
#pragma unroll
    for (int p = 0; p < 8; ++p) { const int jpb = p >> 2, jb = (p >> 1) & 1, s = p & 1;
        __builtin_amdgcn_global_load_lds((const unsigned*)(MP + (32 * jpb + il) * 64 + 32 * jb + 16 * s + 8 * hi), (LAS unsigned*)(slot + p * 1024), 16, 0, 0); }
#pragma unroll
    for (int p = 0; p < 4; ++p)
        __builtin_amdgcn_global_load_lds((const unsigned*)(NBp + p * 512 + lane * 8), (LAS unsigned*)(slot + 8192 + p * 1024), 16, 0, 0);
}
DI unsigned lds_ld_u32(const volatile LAS unsigned* p) { return __builtin_amdgcn_readfirstlane(*p); }
DI void scan_loader(const Frame& F, const int sw, const int ld) {
    const int ihalf = sw & 1, sc = sw >> 1, dir = sc / (NB * BH);
    volatile LAS unsigned* ready = (volatile LAS unsigned*)(F.lds + SCAN_FLAGS); volatile LAS unsigned* cons = ready + 16;
    const int nmine = NCH / 2;
    for (int k = 0; k < nmine + 5; ++k) {
        if (k < nmine) {
            const int s = 2 * k + ld;
            if (s >= SCAN_RING) { unsigned spins = 0; while ((int)lds_ld_u32(cons) < s - SCAN_RING + 1) { __builtin_amdgcn_s_sleep(1); if (++spins > (1u << 22)) break; } }
            asm volatile("" ::: "memory");
            scan_issue(F, sc, ihalf, dir, s, F.lane);
        }
        if (k >= 4) {
            const int kd = k - 4;
            if (kd < nmine) {
                const int rem = nmine - 1 - kd;
                if (rem >= 4) asm volatile("s_waitcnt vmcnt(48)" ::: "memory");
                else if (rem == 3) asm volatile("s_waitcnt vmcnt(36)" ::: "memory");
                else if (rem == 2) asm volatile("s_waitcnt vmcnt(24)" ::: "memory");
                else if (rem == 1) asm volatile("s_waitcnt vmcnt(12)" ::: "memory");
                else asm volatile("s_waitcnt vmcnt(0)" ::: "memory");
                const int sd = 2 * kd + ld;
                if (F.lane == 0) ready[sd % SCAN_RING] = (unsigned)(sd + 1);
                asm volatile("s_waitcnt lgkmcnt(0)" ::: "memory");
            }
        }
    }
}
DI void scan_wave(const Frame& F, const int sw) {
    const int ihalf = sw & 1, sc = sw >> 1, dir = sc / (NB * BH);
    const int lane = F.lane, il = lane & 31, hi = lane >> 5;
    bf16_t* S0 = (bf16_t*)(F.ws + WS_S0);
    volatile LAS unsigned* ready = (volatile LAS unsigned*)(F.lds + SCAN_FLAGS); volatile LAS unsigned* cons = ready + 16;
    f32x16 st0, st1;
#pragma unroll
    for (int i = 0; i < 16; ++i) { st0[i] = 0.f; st1[i] = 0.f; }
    bf16x8 ma[8], man[8]; u32x4 nbv[4], nbn[4];
    { unsigned spins = 0; while (lds_ld_u32(ready) != 1u) { __builtin_amdgcn_s_sleep(1); if (++spins > (1u << 22)) break; } }
    asm volatile("" ::: "memory");
#pragma unroll
    for (int p = 0; p < 8; ++p) ma[p] = *(const LAS bf16x8*)(F.lds + p * 1024 + lane * 16);
#pragma unroll
    for (int p = 0; p < 4; ++p) nbv[p] = *(const LAS u32x4*)(F.lds + 8192 + p * 1024 + lane * 16);
#pragma unroll 1
    for (int step = 0; step < NCH; ++step) {
        const int c = dir ? NCH - 1 - step : step; const size_t unit = (size_t)sc * NCH + c;
        const bool more = step + 1 < NCH;
        if (more) {
            { unsigned spins = 0; while (lds_ld_u32(ready + ((step + 1) % SCAN_RING)) != (unsigned)(step + 2)) { __builtin_amdgcn_s_sleep(1); if (++spins > (1u << 22)) break; } }
            asm volatile("" ::: "memory");
            const LAS unsigned char* slot = F.lds + ((step + 1) % SCAN_RING) * SCAN_SLOT;
#pragma unroll
            for (int p = 0; p < 8; ++p) man[p] = *(const LAS bf16x8*)(slot + p * 1024 + lane * 16);
#pragma unroll
            for (int p = 0; p < 4; ++p) nbn[p] = *(const LAS u32x4*)(slot + 8192 + p * 1024 + lane * 16);
        }
        bf16_t* sp = S0 + unit * 4096 + (size_t)(32 * ihalf + il) * 64;
        u32x4 b00, b01, b10, b11;
        b00.x = cvtpk(st0[0], st0[1]); b00.y = cvtpk(st0[2], st0[3]); b00.z = cvtpk(st0[4], st0[5]); b00.w = cvtpk(st0[6], st0[7]);
        b01.x = cvtpk(st0[8], st0[9]); b01.y = cvtpk(st0[10], st0[11]); b01.z = cvtpk(st0[12], st0[13]); b01.w = cvtpk(st0[14], st0[15]);
        b10.x = cvtpk(st1[0], st1[1]); b10.y = cvtpk(st1[2], st1[3]); b10.z = cvtpk(st1[4], st1[5]); b10.w = cvtpk(st1[6], st1[7]);
        b11.x = cvtpk(st1[8], st1[9]); b11.y = cvtpk(st1[10], st1[11]); b11.z = cvtpk(st1[12], st1[13]); b11.w = cvtpk(st1[14], st1[15]);
        *(u32x2*)(sp + 0 + 4 * hi) = (u32x2){b00.x, b00.y};  *(u32x2*)(sp + 8 + 4 * hi) = (u32x2){b00.z, b00.w};
        *(u32x2*)(sp + 16 + 4 * hi) = (u32x2){b01.x, b01.y}; *(u32x2*)(sp + 24 + 4 * hi) = (u32x2){b01.z, b01.w};
        *(u32x2*)(sp + 32 + 4 * hi) = (u32x2){b10.x, b10.y}; *(u32x2*)(sp + 40 + 4 * hi) = (u32x2){b10.z, b10.w};
        *(u32x2*)(sp + 48 + 4 * hi) = (u32x2){b11.x, b11.y}; *(u32x2*)(sp + 56 + 4 * hi) = (u32x2){b11.z, b11.w};
        const bf16x8 p00 = __builtin_bit_cast(bf16x8, b00), p01 = __builtin_bit_cast(bf16x8, b01), p10 = __builtin_bit_cast(bf16x8, b10), p11 = __builtin_bit_cast(bf16x8, b11);
        f32x16 n0, n1;
#pragma unroll
        for (int h2 = 0; h2 < 2; ++h2) {
            n0[8 * h2 + 0] = bflo(nbv[h2].x); n0[8 * h2 + 1] = bfhi(nbv[h2].x); n0[8 * h2 + 2] = bflo(nbv[h2].y); n0[8 * h2 + 3] = bfhi(nbv[h2].y);
            n0[8 * h2 + 4] = bflo(nbv[h2].z); n0[8 * h2 + 5] = bfhi(nbv[h2].z); n0[8 * h2 + 6] = bflo(nbv[h2].w); n0[8 * h2 + 7] = bfhi(nbv[h2].w);
            n1[8 * h2 + 0] = bflo(nbv[2 + h2].x); n1[8 * h2 + 1] = bfhi(nbv[2 + h2].x); n1[8 * h2 + 2] = bflo(nbv[2 + h2].y); n1[8 * h2 + 3] = bfhi(nbv[2 + h2].y);
            n1[8 * h2 + 4] = bflo(nbv[2 + h2].z); n1[8 * h2 + 5] = bfhi(nbv[2 + h2].z); n1[8 * h2 + 6] = bflo(nbv[2 + h2].w); n1[8 * h2 + 7] = bfhi(nbv[2 + h2].w);
        }
        n0 = MFMA32(ma[0], p00, n0); n1 = MFMA32(ma[4], p00, n1);
        n0 = MFMA32(ma[1], p01, n0); n1 = MFMA32(ma[5], p01, n1);
        n0 = MFMA32(ma[2], p10, n0); n1 = MFMA32(ma[6], p10, n1);
        n0 = MFMA32(ma[3], p11, n0); n1 = MFMA32(ma[7], p11, n1);
        st0 = n0; st1 = n1;
        if (more) {
            asm volatile("s_waitcnt lgkmcnt(0)" ::: "memory");
            if (lane == 0) *cons = (unsigned)(step + 2);
#pragma unroll
            for (int p = 0; p < 8; ++p) ma[p] = man[p];
#pragma unroll
            for (int p = 0; p < 4; ++p) nbv[p] = nbn[p];
        }
    }
}

DI void rwkv_out_unit(const Frame& F, const RwP& P, const int du) {
    const int qd = du & 3, cidx = du >> 2, c = cidx % NCH, hd = (cidx / NCH) % BH, b = cidx / (NCH * BH);
    const int lane = F.lane, n = lane & 15, g = lane >> 4, u = 16 * qd + n;
    const bf16_t* QT = (const bf16_t*)(F.ws + WS_QT); const bf16_t* WT = (const bf16_t*)(F.ws + WS_WT); const bf16_t* S0 = (const bf16_t*)(F.ws + WS_S0);
    const bf16_t* VTB = (const bf16_t*)(F.ws + WS_VTB) + (size_t)cidx * 4096;
    f32x4 acc[4];
#pragma unroll
    for (int tm = 0; tm < 4; ++tm) acc[tm] = (f32x4){0.f, 0.f, 0.f, 0.f};
#pragma unroll
    for (int dir = 0; dir < 2; ++dir) {
        const size_t unit = (((size_t)dir * NB + b) * BH + hd) * NCH + c;
#pragma unroll
        for (int ks = 0; ks < 2; ++ks) {
            const bf16x8 bq = *(const bf16x8*)(QT + unit * 4096 + u * 64 + 32 * ks + 8 * g);
            const bf16x8 bw = *(const bf16x8*)(WT + unit * 4096 + u * 64 + 32 * ks + 8 * g);
#pragma unroll
            for (int tm = 0; tm < 4; ++tm) {
                const bf16x8 as = *(const bf16x8*)(S0 + unit * 4096 + (16 * tm + n) * 64 + 32 * ks + 8 * g);
                const bf16x8 av = *(const bf16x8*)(VTB + (16 * tm + n) * 64 + 32 * ks + 8 * g);
                acc[tm] = MFMA16(as, bq, acc[tm]); acc[tm] = MFMA16(av, bw, acc[tm]);
            }
        }
    }
    float s = 0.f;
#pragma unroll
    for (int tm = 0; tm < 4; ++tm) s += (acc[tm][0] + acc[tm][1]) + (acc[tm][2] + acc[tm][3]);
    s += __shfl_xor(s, 16); s += __shfl_xor(s, 32);
    const float mu = s * (1.f / HD); float q = 0.f;
#pragma unroll
    for (int tm = 0; tm < 4; ++tm) { acc[tm] = acc[tm] - mu; q += (acc[tm][0] * acc[tm][0] + acc[tm][1] * acc[tm][1]) + (acc[tm][2] * acc[tm][2] + acc[tm][3] * acc[tm][3]); }
    q += __shfl_xor(q, 16); q += __shfl_xor(q, 32);
    const float rstd = 1.f / sqrtf(q * (1.f / HD) + GN_EPS);
    const size_t tok = (size_t)b * S + 64 * c + u;
    const float* BS = (const float*)(F.ws + WS_BS);
    const float bsum = BS[tok * 8 + hd] + BS[((size_t)T + tok) * 8 + hd];
    const bf16_t* VC = (const bf16_t*)(F.ws + WS_VC) + tok * BW + hd * HD; const bf16_t* GBp = (const bf16_t*)(F.ws + WS_GB) + tok * BW + hd * HD;
    bf16_t* op = (bf16_t*)(F.ws + WS_CONCAT) + tok * D + AW + hd * HD;
#pragma unroll
    for (int tm = 0; tm < 4; ++tm) {
        const int i0 = 16 * tm + 4 * g;
        const f32x4 vv = unpack4(*(const u32x2*)(VC + i0)), gg = unpack4(*(const u32x2*)(GBp + i0));
        const f32x4 gn = *(const f32x4*)(P.gn_gain + hd * HD + i0), gb = *(const f32x4*)(P.gn_bias + hd * HD + i0);
        *(u32x2*)(op + i0) = pack4((acc[tm] * rstd * gn + gb + vv * bsum) * gg);
    }
}

DI RwP make_rwp(const Args& a, int l) {
    RwP p;
    p.conv = a.in[6] + (size_t)l * 3 * 3 * BW; p.w0 = a.in[7] + (size_t)l * 2 * BW; p.w_up = a.in[8] + (size_t)l * 2 * RW * BW;
    p.a0 = a.in[9] + (size_t)l * 2 * BW; p.a_up = a.in[10] + (size_t)l * 2 * RA * BW; p.g_up = a.in[11] + (size_t)l * RG * BW;
    p.k_k = a.in[12] + (size_t)l * BW; p.k_a = a.in[13] + (size_t)l * BW; p.r_k = a.in[14] + (size_t)l * BH * HD;
    p.gn_gain = a.in[15] + (size_t)l * BW; p.gn_bias = a.in[16] + (size_t)l * BW;
    return p;
}
DI void p_gemm1(const Frame& F, int l) {
    pg8::Gemm1Order S; S.U = (const bf16_t*)(F.ws + WS_U); S.Win = (const bf16_t*)(F.ws + WS_WIN + (size_t)l * WIN_LAYER); S.Wv = S.Win + (size_t)HW * D; S.G = F.G; S.c = F.bx;
    pg8::EpiStore E{(bf16_t*)(F.ws + WS_HB), HW, (bf16_t*)(F.ws + WS_VT), T};
    pg8::gemm_phase(F.lds, F.tid, D, S, E);
}
DI void p_mixer_local(const Frame& F, const Args& a, int l) {
    {
      const float* conv = a.in[6] + (size_t)l * 3 * 3 * BW;
#pragma unroll 7
      for (int i = F.tid; i < BH * 9 * 64; i += NTHREADS) { const int j = i & 63, q = i >> 6, which = q % 3, x = (q / 3) % 3, hd = q / 9;
          *(LAS bf16_t*)(F.lds + CWLOFF + i * 2) = f2bf(conv[x * 3 * BW + which * BW + hd * HD + j]); }
      RwPre PF;
      if (F.bx < NUNIT) rwkv_prefetch(F, a, l, F.bx, PF);
      __syncthreads();
      for (int unit = F.bx; unit < NUNIT; unit += F.G) rwkv_local_unit(F, a, l, unit, PF, unit + F.G < NUNIT ? unit + F.G : -1);
    }
    LAS float* rpbl = (LAS float*)F.lds;
    const float* rpb = a.in[5] + (size_t)l * AH * (2 * KH - 1) * (2 * KW - 1);
#pragma unroll 6
    for (int i = F.tid; i < AH * (2 * KH - 1) * (2 * KW - 1); i += NTHREADS) rpbl[i] = rpb[i] * LOG2E;
    __syncthreads();
    for (int au = F.gw; au < NB * ROWS * AH; au += F.ngw) attn_unit(F, rpbl, au);
#ifdef DBL_ATTN
    for (int au = F.gw; au < NB * ROWS * AH; au += F.ngw) attn_unit(F, rpbl, au);
#endif
    for (int pu = F.gw; pu < NB * (S / 32) * 4; pu += F.ngw) pool_unit(F, a.in[17] + (size_t)l * NG * 64 * 64, a.in[18] + (size_t)l * CW, pu);
}
DI void p_scan(const Frame& F, const Args& a, int l) {
    constexpr int NSCAN = 2 * 2 * NB * BH;
    if (F.bx < NSCAN) {
        volatile LAS unsigned* fl = (volatile LAS unsigned*)(F.lds + SCAN_FLAGS);
        if (F.tid < 32) fl[F.tid] = 0u;
        __syncthreads();
        if (F.wave == 0) scan_wave(F, F.bx); else if (F.wave <= 2) scan_loader(F, F.bx, F.wave - 1);
        return;
    }
#if TESTMODE != 2
    LAS float* scr = (LAS float*)F.lds + F.wave * (64 * 65);
#ifdef DBL_CONV
    for (int rep = 0; rep < 2; ++rep)
#endif
    { f32x4 cur[16], nxt[16]; const int st = (F.G - NSCAN) * NWAVES; int it = (F.bx - NSCAN) * NWAVES + F.wave; TItem tc{}, tn{};
      if (it < IT_MOE) { tc = moe_item(F, a.in[28], a.in[29], a.in[30], l, it); titem_load(tc, cur, F.lane); }
      for (; it < IT_MOE; it += st) {
          const bool more = it + st < IT_MOE;
          if (more) { tn = moe_item(F, a.in[28], a.in[29], a.in[30], l, it + st); titem_load(tn, nxt, F.lane); }
          titem_store(tc, cur, scr, F.lane);
          if (more) { tc = tn;
#pragma unroll
              for (int i = 0; i < 16; ++i) cur[i] = nxt[i]; }
      } }
#endif
}
DI void p_rwkv_out(const Frame& F, const Args& a, int l) {
    const RwP P = make_rwp(a, l);
    for (int du = F.gw; du < NB * BH * NCH * 4; du += F.ngw) rwkv_out_unit(F, P, du);
}
DI void p_gemm2(const Frame& F, int l) {
    pg8::PlainOrder S; S.init((const bf16_t*)(F.ws + WS_CONCAT), (const bf16_t*)(F.ws + WS_WOUT) + (size_t)l * D * D, T, D, D, F.G, F.bx);
    pg8::EpiStore E{(bf16_t*)(F.ws + WS_MIX), D, nullptr, 0};
    pg8::gemm_phase(F.lds, F.tid, D, S, E);
}
DI void p_moe_a(const Frame& F, int l) {
    LAS int* tb = (LAS int*)(F.lds + LDS_MISC);
    build_tables(F, l, tb);
    pg8::GroupedOrderT<true> S; S.rowtok = (const int*)(F.ws + WS_CTL + WS_SLOTTOK); S.A = (const bf16_t*)(F.ws + WS_U); S.Bt = (const bf16_t*)(F.ws + WS_WGU); S.K = D; S.estride = (size_t)D * D; S.tile_e = tb + 66; S.ntiles = tb[65]; S.nwg = S.ntiles * 4; S.G = F.G; S.c = F.bx;
    pg8::EpiSwiGlu E{(bf16_t*)(F.ws + WS_HM)};
    pg8::gemm_phase(F.lds, F.tid, D, S, E);
}
DI void p_moe_b(const Frame& F, int l) {
    LAS int* tb = (LAS int*)(F.lds + LDS_MISC);
    build_tables(F, l, tb);
    pg8::GroupedOrderT<false> S; S.rowtok = nullptr; S.A = (const bf16_t*)(F.ws + WS_HM); S.Bt = (const bf16_t*)(F.ws + WS_WD); S.K = DE; S.estride = (size_t)D * DE; S.tile_e = tb + 66; S.ntiles = tb[65]; S.nwg = S.ntiles * 4; S.G = F.G; S.c = F.bx;
    pg8::EpiRowScale E{(bf16_t*)(F.ws + WS_YS), (const float*)(F.ws + WS_SLOTW)};
    pg8::gemm_phase(F.lds, F.tid, DE, S, E);
}

#ifndef DBLMASK
#define DBLMASK 0
#endif
constexpr int PH_PER_LAYER = 10, N_PHASES = 2 + L * PH_PER_LAYER;
DI bool in_ph(int k, int lo, int hi) { lo = __builtin_amdgcn_readfirstlane(lo); hi = __builtin_amdgcn_readfirstlane(hi); asm volatile("" : "+s"(lo), "+s"(hi)); return lo <= k && k < hi; }
DI Frame fresh(const Frame& F0) {
    Frame F = F0; int t = F0.tid, b = F0.bx;
    b = __builtin_amdgcn_readfirstlane(b); asm volatile("" : "+v"(t)); asm volatile("" : "+s"(b));
    F.tid = t; F.lane = t & 63; F.wave = __builtin_amdgcn_readfirstlane(t >> 6); F.bx = b;
    F.vcu = (F.G % 8 == 0) ? (b % 8) * (F.G / 8) + b / 8 : b; F.gw = F.vcu * NWAVES + F.wave;
    return F;
}

__global__ void __launch_bounds__(NTHREADS, 2) mk_fwd(Args a) {
    extern __shared__ __attribute__((aligned(16))) unsigned char lds_raw[];
    Frame F;
    F.lds = (LAS unsigned char*)lds_raw;
    F.tid = threadIdx.x; F.lane = F.tid & 63; F.wave = __builtin_amdgcn_readfirstlane(F.tid >> 6);
    F.G = gridDim.x; F.bx = blockIdx.x; { const int bx = blockIdx.x; F.vcu = (F.G % 8 == 0) ? (bx % 8) * (F.G / 8) + bx / 8 : bx; }
    F.gw = F.vcu * NWAVES + F.wave; F.ngw = F.G * NWAVES; F.ws = a.ws;
    volatile LAS unsigned* bst = (volatile LAS unsigned*)(F.lds + LDS_BARST);
    if (F.tid < 16) bst[F.tid] = 0u;
    __syncthreads();
    cg::grid_group grid = cg::this_grid();
    XcdBarrier bar; bar.bar = (unsigned*)(a.ws + WS_CTL) + CW_BAR; bar.x = 0; bar.st = bst;
    const bool multi = (a.ph_hi - a.ph_lo) > 1;
    if (multi && !a.use_cg) bar = xcd_barrier_post((unsigned*)(a.ws + WS_CTL) + CW_BAR, bst);
    const int lo = a.ph_lo, hi = a.ph_hi;
#define IN(k) in_ph((k), lo, hi)
#ifndef DBLSEAM
#define DBLSEAM 0
#endif
#define SEAM(k) do { if (IN(k) && IN((k) + 1)) { if (a.use_cg) grid.sync(); else { xcd_barrier(bar); if (DBLSEAM) xcd_barrier(bar); } } } while (0)
    if (IN(0)) { p0_prologue(fresh(F), a); if ((DBLMASK >> 11) & 1) p0_prologue(fresh(F), a); }
    SEAM(0);
    if (IN(1)) { p_r0(fresh(F), a.in[0]); if ((DBLMASK >> 12) & 1) p_r0(fresh(F), a.in[0]); }
    SEAM(1);
#define RUN(k, call) do { if (IN(pb + (k))) { call; if ((DBLMASK >> (k)) & 1) { call; } } } while (0)
#define LAYER(l) do { \
        const int pb = 2 + PH_PER_LAYER * (l); \
        RUN(0, p_gemm1(fresh(F), (l))); \
        SEAM(pb + 0); \
        RUN(1, p_mixer_local(fresh(F), a, (l))); \
        SEAM(pb + 1); \
        RUN(2, p_scan(fresh(F), a, (l))); \
        SEAM(pb + 2); \
        RUN(3, p_rwkv_out(fresh(F), a, (l))); \
        SEAM(pb + 3); \
        RUN(4, p_gemm2(fresh(F), (l))); \
        SEAM(pb + 4); \
        RUN(5, p_rowpass1(fresh(F), a, (l), (l) == 0 ? a.in[0] : a.out)); \
        if (IN(pb + 5) && ((DBLMASK >> 10) & 1)) p_rowpass1(fresh(F), a, (l), (l) == 0 ? a.in[0] : a.out, true); \
        SEAM(pb + 5); \
        RUN(6, p_gather(fresh(F), (l))); \
        SEAM(pb + 6); \
        RUN(7, p_moe_a(fresh(F), (l))); \
        SEAM(pb + 7); \
        RUN(8, p_moe_b(fresh(F), (l))); \
        SEAM(pb + 8); \
        RUN(9, p_rowpass2(fresh(F), a, (l), a.out)); \
        SEAM(pb + 9); \
    } while (0)
    LAYER(0);
    LAYER(1);
#undef LAYER
#undef IN
#undef SEAM
}

#ifndef MK_MODE
#define MK_MODE 0
#endif
#ifndef TESTMODE
#define TESTMODE 0
#endif

static void fill_args(Args& a, void* const* d_in, void* d_out, void* d_ws) {
    for (int i = 0; i < 31; ++i) a.in[i] = (const float*)d_in[i];
    a.out = (float*)d_out; a.ws = (unsigned char*)d_ws; a.ph_lo = 0; a.ph_hi = N_PHASES; a.use_cg = 0; a.pad = 0;
}
static void launch_phases(Args a, int lo, int hi, hipStream_t stream) {
    for (int p = lo; p < hi; ++p) { a.ph_lo = p; a.ph_hi = p + 1; hipLaunchKernelGGL(mk_fwd, dim3(256), dim3(NTHREADS), LDS_BYTES, stream, a); }
}

#if TESTMODE == 0
extern "C" void kernel_launch(void* const* d_in, const int* in_sizes, int n_in, void* d_out, int out_size, void* d_ws, size_t ws_size, hipStream_t stream) {
    static int grid = 0;
    if (grid == 0) {
        int dev = 0, cus = 0, per_cu = 0;
        (void)hipGetDevice(&dev); (void)hipDeviceGetAttribute(&cus, hipDeviceAttributeMultiprocessorCount, dev);
        (void)hipFuncSetAttribute((const void*)mk_fwd, hipFuncAttributeMaxDynamicSharedMemorySize, LDS_BYTES);
        (void)hipOccupancyMaxActiveBlocksPerMultiprocessor(&per_cu, (const void*)mk_fwd, NTHREADS, LDS_BYTES);
        (void)hipGetLastError();
        grid = (cus > 0 ? cus : 256) * 1;
        if (ws_size < WS_END || n_in != 31) grid = -1;
    }
    if (grid < 0) return;
    (void)hipMemsetAsync((char*)d_ws + WS_CTL, 0, CTL_BYTES, stream);
    Args a{}; fill_args(a, d_in, d_out, d_ws);
#if MK_MODE == 2
    launch_phases(a, 0, N_PHASES, stream);
#else
    a.use_cg = (MK_MODE == 1) ? 1 : 0;
    void* args[] = {&a};
    (void)hipLaunchCooperativeKernel((const void*)mk_fwd, dim3(grid), dim3(NTHREADS), args, LDS_BYTES, stream);
#endif
}
#endif

#if TESTMODE > 0
constexpr int O_A = 1152, O_B = 2304, O_W = 2336, O_AL = 2368, O_G = 2432;
struct HSrc { const bf16_t* HB; const bf16_t* VT;
    DI float at(size_t tok, int n) const { if (n < 768) return bf2f(HB[tok * HW + n]); if (n < 1152) return bf2f(VT[(size_t)(n - 768) * T + tok]); return bf2f(HB[tok * HW + n - 384]); } };
DI float sigm_n(float x) { return 1.f / (1.f + expf(-x)); }

__global__ void k_mod_n(const float* __restrict__ c, const float* __restrict__ w_mod, const float* __restrict__ b_mod, float* __restrict__ mod) {
    __shared__ float sc[NB * D];
    for (int i = threadIdx.x; i < NB * D; i += blockDim.x) { float v = c[i]; sc[i] = v * sigm_n(v); }
    __syncthreads();
    int idx = blockIdx.x * blockDim.x + threadIdx.x; int l = idx / MODW, n = idx % MODW;
    const float* w = w_mod + (size_t)l * D * MODW + n; float a0 = 0.f, a1 = 0.f;
    for (int k = 0; k < D; ++k) { float wv = w[(size_t)k * MODW]; a0 += sc[k] * wv; a1 += sc[D + k] * wv; }
    float bb = b_mod[l * MODW + n];
    mod[(size_t)(l * NB + 0) * MODW + n] = a0 + bb; mod[(size_t)(l * NB + 1) * MODW + n] = a1 + bb;
}
__global__ void k_ln_mod_n(const float* __restrict__ xin, const float* __restrict__ modl, int off_sh, int off_sc, float* __restrict__ uout) {
    int row = (blockIdx.x * blockDim.x + threadIdx.x) >> 6, lane = threadIdx.x & 63; if (row >= T) return; int b = row / S;
    f32x4 v[4];
#pragma unroll
    for (int j = 0; j < 4; ++j) v[j] = *(const f32x4*)(xin + (size_t)row * D + 4 * lane + 256 * j);
    float mean, rstd; row_ln(v, mean, rstd);
    const float* md = modl + (size_t)b * MODW;
#pragma unroll
    for (int j = 0; j < 4; ++j) { int col = 4 * lane + 256 * j; *(f32x4*)(uout + (size_t)row * D + col) = v[j] * rstd * (1.f + *(const f32x4*)(md + off_sc + col)) + *(const f32x4*)(md + off_sh + col); }
}
__global__ void k_post_n(const float* xin, const float* br, const float* __restrict__ modl, int off_gate, const float* __restrict__ gain, const float* __restrict__ bias, float* xout, float* u2out, int off_sh2, int off_sc2) {
    int row = (blockIdx.x * blockDim.x + threadIdx.x) >> 6, lane = threadIdx.x & 63; if (row >= T) return; int b = row / S;
    const float* md = modl + (size_t)b * MODW; f32x4 v[4];
#pragma unroll
    for (int j = 0; j < 4; ++j) { int col = 4 * lane + 256 * j; v[j] = *(const f32x4*)(xin + (size_t)row * D + col) * ALPHA + *(const f32x4*)(md + off_gate + col) * *(const f32x4*)(br + (size_t)row * D + col); }
    float mean, rstd; row_ln(v, mean, rstd);
#pragma unroll
    for (int j = 0; j < 4; ++j) { int col = 4 * lane + 256 * j; v[j] = v[j] * rstd * *(const f32x4*)(gain + col) + *(const f32x4*)(bias + col); *(f32x4*)(xout + (size_t)row * D + col) = v[j]; }
    if (u2out == nullptr) return;
    row_ln(v, mean, rstd);
#pragma unroll
    for (int j = 0; j < 4; ++j) { int col = 4 * lane + 256 * j; *(f32x4*)(u2out + (size_t)row * D + col) = v[j] * rstd * (1.f + *(const f32x4*)(md + off_sc2 + col)) + *(const f32x4*)(md + off_sh2 + col); }
}
__global__ void __launch_bounds__(256) k_gemm_f32(const float* __restrict__ A, int lda, const float* __restrict__ B, int ldb, float* __restrict__ C, int ldc, int K) {
    __shared__ float As[16][65]; __shared__ float Bs[16][64];
    const int tx = threadIdx.x & 15, ty = threadIdx.x >> 4; const int m0 = blockIdx.y * 64, n0 = blockIdx.x * 64;
    float acc[4][4];
#pragma unroll
    for (int i = 0; i < 4; ++i)
#pragma unroll
        for (int j = 0; j < 4; ++j) acc[i][j] = 0.f;
    for (int k0 = 0; k0 < K; k0 += 16) {
#pragma unroll
        for (int i = 0; i < 4; ++i) { int e = threadIdx.x + 256 * i; int m = e >> 4, k = e & 15; As[k][m] = A[(size_t)(m0 + m) * lda + k0 + k]; }
#pragma unroll
        for (int i = 0; i < 4; ++i) { int e = threadIdx.x + 256 * i; int k = e >> 6, n = e & 63; Bs[k][n] = B[(size_t)(k0 + k) * ldb + n0 + n]; }
        __syncthreads();
#pragma unroll
        for (int k = 0; k < 16; ++k) { float a[4], b[4];
#pragma unroll
            for (int i = 0; i < 4; ++i) { a[i] = As[k][ty * 4 + i]; b[i] = Bs[k][tx * 4 + i]; }
#pragma unroll
            for (int i = 0; i < 4; ++i)
#pragma unroll
                for (int j = 0; j < 4; ++j) acc[i][j] += a[i] * b[j]; }
        __syncthreads();
    }
#pragma unroll
    for (int i = 0; i < 4; ++i) *(float4*)(C + (size_t)(m0 + ty * 4 + i) * ldc + n0 + tx * 4) = make_float4(acc[i][0], acc[i][1], acc[i][2], acc[i][3]);
}
__global__ void __launch_bounds__(64) k_attn_n(HSrc h, const float* __restrict__ rpb, float* __restrict__ concat) {
    int idx = blockIdx.x * blockDim.x + threadIdx.x; if (idx >= T * AH) return;
    int head = idx % AH, tok = idx / AH; int b = tok / S, t = tok % S, r = t / GW, cq = t % GW;
    int rstart = r - KH / 2; rstart = rstart < 0 ? 0 : (rstart > ROWS - KH ? ROWS - KH : rstart);
    int cstart = cq - KW / 2; cstart = cstart < 0 ? 0 : (cstart > GW - KW ? GW - KW : cstart);
    float q[HD], acc[HD];
#pragma unroll
    for (int d = 0; d < HD; ++d) { q[d] = h.at(tok, head * HD + d); acc[d] = 0.f; }
    float m = -1e30f, l = 0.f; const float* rp = rpb + (size_t)head * 15 * 31;
    for (int kk = 0; kk < KH; ++kk) { int kr = rstart + kk; int dr = kr - r + (KH - 1);
        for (int j = 0; j < KW; ++j) { int ck = cstart + j; int dc = ck - cq; dc = dc < -15 ? -15 : (dc > 15 ? 15 : dc); dc += 15;
            size_t kt = (size_t)b * S + kr * GW + ck; float s = 0.f;
#pragma unroll
            for (int d = 0; d < HD; ++d) s += q[d] * h.at(kt, AW + head * HD + d);
            s = s * 0.125f + rp[dr * 31 + dc];
            float mn = fmaxf(m, s); float corr = expf(m - mn); float p = expf(s - mn); l = l * corr + p;
#pragma unroll
            for (int d = 0; d < HD; ++d) acc[d] = acc[d] * corr + p * h.at(kt, 2 * AW + head * HD + d);
            m = mn; } }
    float inv = 1.f / l;
#pragma unroll
    for (int d = 0; d < HD; ++d) concat[(size_t)tok * D + head * HD + d] = acc[d] * inv;
}
__global__ void __launch_bounds__(256) k_pool_n(HSrc h, const float* __restrict__ pool_w, const float* __restrict__ pool_scale, float* __restrict__ concat) {
    __shared__ float pooled[CW];
    int tok = blockIdx.x; int b = tok / S, t = tok % S; int ch = threadIdx.x; int g = ch / 64; int win = 2 << g;
    int lo = t - win / 2; lo = lo < 0 ? 0 : lo; int hi = t + win / 2 - 1; hi = hi > S - 1 ? S - 1 : hi;
    float s = 0.f; for (int u = lo; u <= hi; ++u) s += h.at((size_t)b * S + u, O_G + ch);
    pooled[ch] = s / (float)(hi - lo + 1) - h.at(tok, O_G + ch);
    __syncthreads();
    int e = ch % 64; const float* pw = pool_w + (size_t)g * 64 * 64 + e; float a = 0.f;
    for (int c2 = 0; c2 < 64; ++c2) a += pooled[g * 64 + c2] * pw[c2 * 64];
    concat[(size_t)tok * D + AW + BW + ch] = a * pool_scale[ch];
}
__global__ void __launch_bounds__(64) k_rwkv_scan_n(HSrc h, RwP p, float* __restrict__ ys) {
    const int lane = threadIdx.x; const int dir = blockIdx.x / (NB * BH), b = (blockIdx.x / BH) % NB, hd = blockIdx.x % BH; const int ch = hd * HD + lane;
    float st[HD];
#pragma unroll
    for (int j = 0; j < HD; ++j) st[j] = 0.f;
    float wup[RW], aup[RA];
#pragma unroll
    for (int m = 0; m < RW; ++m) { wup[m] = p.w_up[(size_t)(dir * RW + m) * BW + ch]; aup[m] = p.a_up[(size_t)(dir * RA + m) * BW + ch]; }
    const float w0 = p.w0[dir * BW + ch], a0 = p.a0[dir * BW + ch], kkw = p.k_k[ch], kaw = p.k_a[ch];
    float cr[3], ck[3], cv[3];
#pragma unroll
    for (int x = 0; x < 3; ++x) { cr[x] = p.conv[x * 3 * BW + ch]; ck[x] = p.conv[x * 3 * BW + BW + ch]; cv[x] = p.conv[x * 3 * BW + 2 * BW + ch]; }
    for (int step = 0; step < S; ++step) {
        const int t = dir ? (S - 1 - step) : step; const size_t row = (size_t)b * S + t;
        float r = 0.f, k = 0.f, v = 0.f;
#pragma unroll
        for (int x = 0; x < 3; ++x) { int tt = t + x - 1; if (tt >= 0 && tt < S) { size_t rr = (size_t)b * S + tt; r += h.at(rr, O_A + ch) * cr[x]; k += h.at(rr, O_A + BW + ch) * ck[x]; v += h.at(rr, O_A + 2 * BW + ch) * cv[x]; } }
        float lv = h.at(row, O_B + lane); float lt = lane < RW ? tanhf(lv) : lv; float zw = w0, za = a0;
#pragma unroll
        for (int m = 0; m < RW; ++m) { zw += __shfl(lt, m) * wup[m]; za += __shfl(lt, RW + m) * aup[m]; }
        const float w = expf(-DECAY * sigm_n(zw)); const float a = sigm_n(za);
        float kk = k * kkw; float ss = wave_sum(kk * kk); kk = kk * (1.f / sqrtf(fmaxf(ss, 1e-24f)));
        const float kd = k * (1.f + (a - 1.f) * kaw); const float kka = kk * a;
        float sa = 0.f;
#pragma unroll
        for (int j = 0; j < HD; ++j) sa += st[j] * (-__shfl(kk, j));
        float y = 0.f;
#pragma unroll
        for (int j = 0; j < HD; ++j) { st[j] = st[j] * __shfl(w, j) + sa * __shfl(kka, j) + v * __shfl(kd, j); y += st[j] * __shfl(r, j); }
        ys[((size_t)dir * T + b * S + t) * BW + ch] = y;
    }
}
__global__ void __launch_bounds__(384) k_rwkv_finish_n(HSrc h, RwP p, const float* __restrict__ ys, float* __restrict__ concat) {
    __shared__ float lw[RW], la[RA], sg[RG];
    const int tok = blockIdx.x, b = tok / S, t = tok % S, ch = threadIdx.x, hd = ch / HD, j = ch % HD;
    if (ch < RW) lw[ch] = tanhf(h.at(tok, O_B + ch)); else if (ch < RW + RA) la[ch - RW] = h.at(tok, O_W + (ch - RW)); else if (ch < RW + RA + RG) sg[ch - RW - RA] = sigm_n(h.at(tok, O_AL + (ch - RW - RA)));
    __syncthreads();
    float r = 0.f, k = 0.f, v = 0.f;
#pragma unroll
    for (int x = 0; x < 3; ++x) { int tt = t + x - 1; if (tt >= 0 && tt < S) { size_t rr = (size_t)b * S + tt;
        r += h.at(rr, O_A + ch) * p.conv[x * 3 * BW + ch]; k += h.at(rr, O_A + BW + ch) * p.conv[x * 3 * BW + BW + ch]; v += h.at(rr, O_A + 2 * BW + ch) * p.conv[x * 3 * BW + 2 * BW + ch]; } }
    float bon = 0.f;
    for (int dir = 0; dir < 2; ++dir) { float za = p.a0[dir * BW + ch]; for (int m = 0; m < RA; ++m) za += la[m] * p.a_up[(size_t)(dir * RA + m) * BW + ch];
        float a = sigm_n(za); float kd = k * (1.f + (a - 1.f) * p.k_a[ch]); bon += wave_sum(r * kd * p.r_k[hd * HD + j]); }
    bon *= v;
    float y = ys[(size_t)tok * BW + ch] + ys[((size_t)T + tok) * BW + ch];
    float mu = wave_sum(y) * (1.f / HD); float dy = y - mu; float var = wave_sum(dy * dy) * (1.f / HD);
    float yn = dy * (1.f / sqrtf(var + GN_EPS)) * p.gn_gain[ch] + p.gn_bias[ch];
    float g = 0.f; for (int m = 0; m < RG; ++m) g += sg[m] * p.g_up[(size_t)m * BW + ch];
    concat[(size_t)tok * D + AW + ch] = (yn + bon) * g;
}
__global__ void __launch_bounds__(256) k_moe_n(const float* __restrict__ u2, const int* __restrict__ tokslot, const float* __restrict__ ew,
                                                const float* __restrict__ wgate, const float* __restrict__ wup, const float* __restrict__ wdown, float* __restrict__ f) {
    __shared__ float xs[D]; __shared__ float hb[DE];
    const int tok = blockIdx.x, tid = threadIdx.x;
    for (int i = tid; i < D; i += 256) xs[i] = u2[(size_t)tok * D + i];
    float o[4] = {0.f, 0.f, 0.f, 0.f};
    for (int kk = 0; kk < 2; ++kk) {
        const int ts = tokslot[tok * 2 + kk]; const int e = ts >> 14; const float wt = ew[ts];
        __syncthreads();
        const float* g = wgate + (size_t)e * D * DE; const float* u = wup + (size_t)e * D * DE;
        float ag0 = 0.f, ag1 = 0.f, au0 = 0.f, au1 = 0.f;
        for (int k = 0; k < D; ++k) { float x = xs[k]; ag0 += x * g[(size_t)k * DE + tid]; ag1 += x * g[(size_t)k * DE + 256 + tid]; au0 += x * u[(size_t)k * DE + tid]; au1 += x * u[(size_t)k * DE + 256 + tid]; }
        hb[tid] = ag0 * sigm_n(ag0) * au0; hb[256 + tid] = ag1 * sigm_n(ag1) * au1;
        __syncthreads();
        const float* dn = wdown + (size_t)e * DE * D; float a[4] = {0.f, 0.f, 0.f, 0.f};
        for (int k = 0; k < DE; ++k) { float x = hb[k];
#pragma unroll
            for (int j = 0; j < 4; ++j) a[j] += x * dn[(size_t)k * D + tid + 256 * j]; }
#pragma unroll
        for (int j = 0; j < 4; ++j) o[j] += a[j] * wt;
    }
#pragma unroll
    for (int j = 0; j < 4; ++j) f[(size_t)tok * D + tid + 256 * j] = o[j];
}

__global__ void k_router_n(const float* __restrict__ u2, const float* __restrict__ wg, const float* __restrict__ bg, const float* __restrict__ we, const float* __restrict__ be, int* __restrict__ tok_e) {
    int row = (blockIdx.x * blockDim.x + threadIdx.x) >> 6, lane = threadIdx.x & 63; if (row >= T) return;
    float gl[NG], el[NE];
#pragma unroll
    for (int n = 0; n < NG; ++n) gl[n] = 0.f;
#pragma unroll
    for (int n = 0; n < NE; ++n) el[n] = 0.f;
    for (int i = 0; i < 16; ++i) { int k = lane + 64 * i; float x = u2[(size_t)row * D + k];
#pragma unroll
        for (int n = 0; n < NG; ++n) gl[n] += x * wg[k * NG + n];
#pragma unroll
        for (int n = 0; n < NE; ++n) el[n] += x * we[k * NE + n]; }
#pragma unroll
    for (int n = 0; n < NG; ++n) gl[n] = wave_sum(gl[n]) + bg[n];
#pragma unroll
    for (int n = 0; n < NE; ++n) el[n] = wave_sum(el[n]) + be[n];
    int gi = 0; float gm = gl[0];
#pragma unroll
    for (int n = 1; n < NG; ++n) if (gl[n] > gm) { gm = gl[n]; gi = n; }
    float l1 = -3.0e38f, l2 = -3.0e38f; int i1 = 0, i2 = 0;
#pragma unroll
    for (int n = 0; n < NE; ++n) if ((n >> 3) == gi) { float v = el[n]; int e = n & 7; if (v > l1) { l2 = l1; i2 = i1; l1 = v; i1 = e; } else if (v > l2) { l2 = v; i2 = e; } }
    if (lane == 0) { tok_e[row * 2] = gi * EPG + i1; tok_e[row * 2 + 1] = gi * EPG + i2; }
}
__global__ void k_cmp_route(const int* __restrict__ tokslot, const int* __restrict__ tok_e, float* acc, int slot) {
    float mis = 0.f, tot = 0.f;
    for (int t = blockIdx.x * blockDim.x + threadIdx.x; t < T; t += gridDim.x * blockDim.x) { const int a0 = tokslot[2 * t] >> 14, a1 = tokslot[2 * t + 1] >> 14;
        mis += (a0 != tok_e[2 * t] || a1 != tok_e[2 * t + 1]) ? 1.f : 0.f; tot += 1.f; }
    mis = wave_sum(mis); tot = wave_sum(tot);
    if ((threadIdx.x & 63) == 0) { atomicAdd(acc + 2 * slot, mis); atomicAdd(acc + 2 * slot + 1, tot); }
}
__global__ void k_bf2f(const bf16_t* __restrict__ src, float* __restrict__ dst, size_t n) { for (size_t i = (size_t)blockIdx.x * blockDim.x + threadIdx.x; i < n; i += (size_t)gridDim.x * blockDim.x) dst[i] = bf2f(src[i]); }
template <class TA> __global__ void k_cmp(const TA* __restrict__ a, size_t lda, const float* __restrict__ b, size_t ldb, int rows, int cols, float* acc, int slot) {
    float d2 = 0.f, r2 = 0.f;
    for (size_t i = (size_t)blockIdx.x * blockDim.x + threadIdx.x; i < (size_t)rows * cols; i += (size_t)gridDim.x * blockDim.x) {
        const size_t r = i / cols, c = i % cols; float av; if constexpr (sizeof(TA) == 2) av = bf2f(a[r * lda + c]); else av = a[r * lda + c];
        const float bv = b[r * ldb + c]; d2 += (av - bv) * (av - bv); r2 += bv * bv; }
    d2 = wave_sum(d2); r2 = wave_sum(r2);
    if ((threadIdx.x & 63) == 0) { atomicAdd(acc + 2 * slot, d2); atomicAdd(acc + 2 * slot + 1, r2); }
}
__global__ void k_cmp_vt(const bf16_t* __restrict__ vt, const float* __restrict__ b, size_t ldb, float* acc, int slot) {
    float d2 = 0.f, r2 = 0.f;
    for (size_t i = (size_t)blockIdx.x * blockDim.x + threadIdx.x; i < (size_t)T * AW; i += (size_t)gridDim.x * blockDim.x) {
        const size_t r = i % T, c = i / T; const float av = bf2f(vt[c * T + r]), bv = b[r * ldb + c]; d2 += (av - bv) * (av - bv); r2 += bv * bv; }
    d2 = wave_sum(d2); r2 = wave_sum(r2);
    if ((threadIdx.x & 63) == 0) { atomicAdd(acc + 2 * slot, d2); atomicAdd(acc + 2 * slot + 1, r2); }
}
struct Tols { float t[8]; int n; };
__global__ void k_readout(float* out, const float* acc, Tols tl, int total) {
    float mx = 0.f; int am = 0; for (int k = 0; k < tl.n; ++k) { float e = sqrtf(acc[2 * k] / fmaxf(acc[2 * k + 1], 1e-30f)); if (!(e == e)) e = 1e3f; if (e / tl.t[k] > mx) { mx = e / tl.t[k]; am = k; } }
    const float cval = sqrtf(1000.f * mx);
    for (int i = blockIdx.x * blockDim.x + threadIdx.x; i < total; i += gridDim.x * blockDim.x) out[i] = (i < 8) ? 1000.f * (float)(am + 1) : cval;
}
__global__ void __launch_bounds__(256) k_moe_chk(const float* __restrict__ u2, const int* __restrict__ tokslot, const float* __restrict__ ew, const unsigned* __restrict__ cnt,
                                                  const float* __restrict__ wgate, const float* __restrict__ wup, const float* __restrict__ wdown,
                                                  const bf16_t* __restrict__ XS, const bf16_t* __restrict__ HM, const bf16_t* __restrict__ YS, float* acc) {
    __shared__ float xs[D]; __shared__ float hb[DE]; __shared__ int offp[NE];
    const int tok = blockIdx.x, tid = threadIdx.x;
    if (tid == 0) { int off = 0; for (int e = 0; e < NE; ++e) { offp[e] = off; off += (((int)cnt[e] + 255) >> 8) * 256; } }
    for (int i = tid; i < D; i += 256) xs[i] = u2[(size_t)tok * D + i];
    float d0 = 0.f, r0 = 0.f, d1 = 0.f, r1 = 0.f, d2 = 0.f, r2 = 0.f;
    for (int kk = 0; kk < 2; ++kk) {
        __syncthreads();
        const int ts = tokslot[tok * 2 + kk]; const int e = ts >> 14; const float wt = ew[ts]; const size_t slot = (size_t)offp[e] + (ts & 16383);
        for (int i = tid; i < D; i += 256) { const float a = bf2f(XS[slot * D + i]), b = xs[i]; d0 += (a - b) * (a - b); r0 += b * b; }
        const float* g = wgate + (size_t)e * D * DE; const float* u = wup + (size_t)e * D * DE;
        float ag0 = 0.f, ag1 = 0.f, au0 = 0.f, au1 = 0.f;
        for (int k = 0; k < D; ++k) { float x = xs[k]; ag0 += x * g[(size_t)k * DE + tid]; ag1 += x * g[(size_t)k * DE + 256 + tid]; au0 += x * u[(size_t)k * DE + tid]; au1 += x * u[(size_t)k * DE + 256 + tid]; }
        const float h0 = ag0 * sigm_n(ag0) * au0, h1 = ag1 * sigm_n(ag1) * au1;
        hb[tid] = h0; hb[256 + tid] = h1;
        { const float a = bf2f(HM[slot * DE + tid]), b = bf2f(HM[slot * DE + 256 + tid]); d1 += (a - h0) * (a - h0) + (b - h1) * (b - h1); r1 += h0 * h0 + h1 * h1; }
        __syncthreads();
        const float* dn = wdown + (size_t)e * DE * D; float a4[4] = {0.f, 0.f, 0.f, 0.f};
        for (int k = 0; k < DE; ++k) { float x = hb[k];
#pragma unroll
            for (int j = 0; j < 4; ++j) a4[j] += x * dn[(size_t)k * D + tid + 256 * j]; }
#pragma unroll
        for (int j = 0; j < 4; ++j) {
#ifdef MOEB_NOSCALE
            const float y = a4[j];
#else
            const float y = a4[j] * wt;
#endif
            const float a = bf2f(YS[slot * D + tid + 256 * j]); d2 += (a - y) * (a - y); r2 += y * y; }
    }
    d0 = wave_sum(d0); r0 = wave_sum(r0); d1 = wave_sum(d1); r1 = wave_sum(r1); d2 = wave_sum(d2); r2 = wave_sum(r2);
    if ((tid & 63) == 0) { atomicAdd(acc + 0, d0); atomicAdd(acc + 1, r0); atomicAdd(acc + 2, d1); atomicAdd(acc + 3, r1); atomicAdd(acc + 4, d2); atomicAdd(acc + 5, r2); }
}

extern "C" void kernel_launch(void* const* d_in, const int* in_sizes, int n_in, void* d_out, int out_size, void* d_ws, size_t ws_size, hipStream_t stream) {
    static int once = 0; if (!once) { (void)hipFuncSetAttribute((const void*)mk_fwd, hipFuncAttributeMaxDynamicSharedMemorySize, LDS_BYTES); once = 1; }
    (void)hipMemsetAsync((char*)d_ws + WS_CTL, 0, CTL_BYTES, stream);
    Args a{}; fill_args(a, d_in, d_out, d_ws);
    char* ws = (char*)d_ws; float* out = (float*)d_out;
    float* ACC = (float*)(ws + 32768 + 1024);
    const float* x = a.in[0];
    HSrc hs{(const bf16_t*)(ws + WS_HB), (const bf16_t*)(ws + WS_VT)};
    const int l = 0;
    RwP p = { a.in[6], a.in[7], a.in[8], a.in[9], a.in[10], a.in[11], a.in[12], a.in[13], a.in[14], a.in[15], a.in[16] };
    Tols tl{};
#if TESTMODE == 1
    launch_phases(a, 0, 3, stream);
    float* MODn = (float*)(ws + WS_MOD + 512 * 1024); float* Un = (float*)(ws + WS_XA); float* HF = (float*)(ws + WS_CONCAT);
    k_mod_n<<<L * MODW / 256, 256, 0, stream>>>(a.in[1], a.in[2], a.in[3], MODn);
    k_ln_mod_n<<<T / 4, 256, 0, stream>>>(x, MODn, 0, D, Un);
    k_gemm_f32<<<dim3(INW / 64, T / 64), 256, 0, stream>>>(Un, D, a.in[4], INW, HF, INW, D);
    k_cmp<float><<<256, 256, 0, stream>>>((const float*)(ws + WS_MOD), MODW, MODn, MODW, L * NB, MODW, ACC, 0);
    k_cmp<bf16_t><<<1024, 256, 0, stream>>>((const bf16_t*)(ws + WS_U), D, Un, D, T, D, ACC, 1);
    k_cmp<bf16_t><<<1024, 256, 0, stream>>>((const bf16_t*)(ws + WS_HB), HW, HF, INW, T, 768, ACC, 2);
    k_cmp<bf16_t><<<1024, 256, 0, stream>>>((const bf16_t*)(ws + WS_HB) + 768, HW, HF + 1152, INW, T, 1536, ACC, 3);
    k_cmp_vt<<<1024, 256, 0, stream>>>((const bf16_t*)(ws + WS_VT), HF + 768, INW, ACC, 4);
    tl.n = 5; tl.t[0] = 1e-5f; tl.t[1] = 4e-3f; tl.t[2] = 6e-3f; tl.t[3] = 6e-3f; tl.t[4] = 6e-3f;
#elif TESTMODE == 2
    launch_phases(a, 0, 4, stream);
    float* CCn = (float*)(ws + WS_XA); float* YSn = (float*)(ws + WS_WGU);
    k_attn_n<<<T * AH / 64, 64, 0, stream>>>(hs, a.in[5], CCn);
    k_pool_n<<<T, 256, 0, stream>>>(hs, a.in[17], a.in[18], CCn);
    k_rwkv_scan_n<<<2 * NB * BH, 64, 0, stream>>>(hs, p, YSn);
    k_rwkv_finish_n<<<T, 384, 0, stream>>>(hs, p, YSn, CCn);
    launch_phases(a, 4, 6, stream);
    k_cmp<bf16_t><<<1024, 256, 0, stream>>>((const bf16_t*)(ws + WS_CONCAT), D, CCn, D, T, AW, ACC, 0);
    k_cmp<bf16_t><<<1024, 256, 0, stream>>>((const bf16_t*)(ws + WS_CONCAT) + AW, D, CCn + AW, D, T, BW, ACC, 1);
    k_cmp<bf16_t><<<1024, 256, 0, stream>>>((const bf16_t*)(ws + WS_CONCAT) + AW + BW, D, CCn + AW + BW, D, T, CW, ACC, 2);
    tl.n = 3; tl.t[0] = TOL0; tl.t[1] = TOL1; tl.t[2] = TOL2;
#elif TESTMODE == 3
    launch_phases(a, 0, 11, stream);
    { const float* MODf = (const float*)(ws + WS_MOD);
      float* U2f = (float*)(ws + 414 * MiB); float* Fn = (float*)(ws + 213 * MiB); float* X2n = (float*)(ws + 277 * MiB);
      k_bf2f<<<2048, 256, 0, stream>>>((const bf16_t*)(ws + WS_U), U2f, (size_t)T * D);
      launch_phases(a, 11, 12, stream);
      k_moe_n<<<T, 256, 0, stream>>>(U2f, (const int*)(ws + WS_TOKSLOT), (const float*)(ws + WS_EW), a.in[28], a.in[29], a.in[30], Fn);
      k_post_n<<<T / 4, 256, 0, stream>>>((const float*)(ws + WS_XA), Fn, MODf, 5 * D, a.in[22], a.in[23], X2n, nullptr, 0, 0);
      k_cmp<float><<<1024, 256, 0, stream>>>(out, D, X2n, D, T, D, ACC, 0); }
    tl.n = 1; tl.t[0] = TOL0;
#elif TESTMODE == 4
    launch_phases(a, 0, 8, stream);
    { const float* MODf = (const float*)(ws + WS_MOD);
      float* CCn = (float*)(ws + 405 * MiB); float* MIXn = (float*)(ws + 213 * MiB); float* X1n = (float*)(ws + 21 * MiB); float* U2n = (float*)(ws + 333 * MiB); int* TEn = (int*)(ws + 490 * MiB);
      k_bf2f<<<2048, 256, 0, stream>>>((const bf16_t*)(ws + WS_CONCAT), CCn, (size_t)T * D);
      k_gemm_f32<<<dim3(D / 64, T / 64), 256, 0, stream>>>(CCn, D, a.in[19], D, MIXn, D, D);
      k_post_n<<<T / 4, 256, 0, stream>>>(x, MIXn, MODf, 2 * D, a.in[20], a.in[21], X1n, U2n, 3 * D, 4 * D);
      k_router_n<<<T / 4, 256, 0, stream>>>(U2n, a.in[24], a.in[25], a.in[26], a.in[27], TEn);
      k_cmp<float><<<1024, 256, 0, stream>>>((const float*)(ws + WS_XA), D, X1n, D, T, D, ACC, 0);
      k_cmp<bf16_t><<<1024, 256, 0, stream>>>((const bf16_t*)(ws + WS_U), D, U2n, D, T, D, ACC, 1);
      k_cmp_route<<<64, 256, 0, stream>>>((const int*)(ws + WS_TOKSLOT), TEn, ACC, 2); }
    tl.n = 3; tl.t[0] = TOL0; tl.t[1] = TOL1; tl.t[2] = TOL2;
#elif TESTMODE == 5
    launch_phases(a, 0, 11, stream);
    { float* U2f = (float*)(ws + 414 * MiB);
      k_bf2f<<<2048, 256, 0, stream>>>((const bf16_t*)(ws + WS_U), U2f, (size_t)T * D);
      k_moe_chk<<<T, 256, 0, stream>>>(U2f, (const int*)(ws + WS_TOKSLOT), (const float*)(ws + WS_EW), (const unsigned*)(ws + WS_CTL) + CW_CNT, a.in[28], a.in[29], a.in[30],
                                       (const bf16_t*)(ws + WS_XS), (const bf16_t*)(ws + WS_HM), (const bf16_t*)(ws + WS_YS), ACC); }
    tl.n = 3; tl.t[0] = 1e-6f; tl.t[1] = 1e-2f; tl.t[2] = 1e-2f;
#endif
    k_readout<<<256, 256, 0, stream>>>(out, ACC, tl, out_size);
}
#endif
```

```cpp
#define TESTMODE 0
#define MK_MODE 0
#include <hip/hip_runtime.h>
#include <hip/hip_cooperative_groups.h>
#include <stdint.h>
namespace cg = cooperative_groups;

#ifndef TESTMODE
#define TESTMODE 0
#endif
#define DI __device__ __forceinline__
#define LAS __attribute__((address_space(3)))
typedef unsigned short bf16_t;
typedef short bf16x8 __attribute__((ext_vector_type(8)));
typedef float f32x4 __attribute__((ext_vector_type(4)));
typedef float f32x16 __attribute__((ext_vector_type(16)));
typedef unsigned u32x4 __attribute__((ext_vector_type(4)));
typedef unsigned u32x2 __attribute__((ext_vector_type(2)));
typedef float f32x2_t __attribute__((ext_vector_type(2)));
typedef __bf16 bf16x2_t __attribute__((ext_vector_type(2)));

namespace cfg {
constexpr int D = 1024, NB = 2, S = 8192, T = NB * S, L = 2;
constexpr int GW = 64, ROWS = 128;
constexpr int HD = 64, AW = 384, BW = 384, CW = 256, AH = 6, BH = 6;
constexpr int KH = 8, KW = 16;
constexpr int RW = 32, RA = 32, RG = 64;
constexpr int INW = 2688;
constexpr int NG = 4, EPG = 8, NE = 32, DE = 512;
constexpr int MODW = 6 * D;
constexpr float ALPHA = 1.41421356237309515f;
constexpr float LN_EPS = 1e-5f, GN_EPS = 64e-5f;
constexpr float DECAY = 0.60653065971263342f;
constexpr float LOG2E = 1.44269504088896341f;
constexpr int HW = 2304, HQ = 0, HK = 384, HR = 768, HWL = 1920, HAL = 1952, HGL = 1984, HP = 2048;
constexpr int NCH = S / 64;
constexpr int NUNIT = 2 * NB * BH * NCH;
constexpr int XSROWS = 2 * T + NE * 256;
}
using namespace cfg;

constexpr size_t MiB = 1u << 20;
constexpr size_t WS_CTL = 0;
constexpr size_t CTL_BYTES = 262144;
constexpr size_t WS_SLOTTOK = 65536;
constexpr int CW_BAR = 0;
constexpr int CW_CNT = 8192;
constexpr size_t WS_MOD = 1 * MiB;
constexpr size_t WS_TOKSLOT = 1 * MiB + 128 * 1024;
constexpr size_t WS_SLOTW = 1 * MiB + 256 * 1024;
constexpr size_t WS_BC = 2 * MiB;
constexpr size_t WS_TOKW = 2 * MiB + 64 * 1024;
constexpr size_t WS_TOKFIN = 2 * MiB + 256 * 1024;
constexpr size_t WS_CNTF = 2 * MiB + 512 * 1024;
constexpr size_t WS_WIN = 6 * MiB;
constexpr size_t WIN_LAYER = (size_t)2816 * 1024 * 2;
constexpr size_t WS_WOUT = 17 * MiB;
constexpr size_t WS_WGU = 21 * MiB;
constexpr size_t WS_WD = 85 * MiB;
constexpr size_t WS_XA = 117 * MiB;
constexpr size_t WS_U = 181 * MiB;
constexpr size_t WS_HB = 213 * MiB;
constexpr size_t WS_S0 = 213 * MiB;
constexpr size_t WS_VT = 285 * MiB;
constexpr size_t WS_CONCAT = 301 * MiB;
constexpr size_t WS_MP = 333 * MiB;
constexpr size_t WS_NB = 357 * MiB;
constexpr size_t WS_MIX = 333 * MiB;
constexpr size_t WS_QT = 405 * MiB;
constexpr size_t WS_WT = 429 * MiB;
constexpr size_t WS_VTB = 453 * MiB;
constexpr size_t WS_GB = 465 * MiB;
constexpr size_t WS_VC = 477 * MiB;
constexpr size_t WS_BS = 489 * MiB;
constexpr size_t WS_XS = 213 * MiB;
constexpr size_t WS_HM = 293 * MiB;
constexpr size_t WS_YS = 333 * MiB;
constexpr size_t WS_END = 490 * MiB;

constexpr int NWAVES = 8, NTHREADS = 512;
constexpr int LDS_BYTES = 156 * 1024;

DI unsigned cvtpk(float lo, float hi) { f32x2_t v = {lo, hi}; bf16x2_t b = __builtin_convertvector(v, bf16x2_t); return __builtin_bit_cast(unsigned, b); }
DI float bflo(unsigned w) { return __uint_as_float(w << 16); }
DI float bfhi(unsigned w) { return __uint_as_float(w & 0xffff0000u); }
DI float bf2f(unsigned short h) { return __uint_as_float((unsigned)h << 16); }
DI unsigned short f2bf(float f) { return (unsigned short)(cvtpk(f, 0.f) & 0xffffu); }
DI float wave_sum_shfl(float v) {
#pragma unroll
    for (int o = 32; o > 0; o >>= 1) v += __shfl_xor(v, o);
    return v;
}
template <int CTRL, int ROWMASK> DI float dpp_add(float v) { return v + __builtin_bit_cast(float, __builtin_amdgcn_update_dpp(0, __builtin_bit_cast(int, v), CTRL, ROWMASK, 0xf, false)); }
DI float wave_sum(float v) {
    v = dpp_add<0xb1, 0xf>(v);
    v = dpp_add<0x4e, 0xf>(v);
    v = dpp_add<0x124, 0xf>(v);
    v = dpp_add<0x128, 0xf>(v);
    v = dpp_add<0x142, 0xa>(v);
    v = dpp_add<0x143, 0xc>(v);
    return __builtin_bit_cast(float, __builtin_amdgcn_readlane(__builtin_bit_cast(int, v), 63));
}
DI float fexp2(float x) { return __builtin_amdgcn_exp2f(x); }
DI float frcp(float x) { return __builtin_amdgcn_rcpf(x); }
DI float sigm(float x) { return frcp(1.f + fexp2(x * -LOG2E)); }
#define LDS_WAIT() asm volatile("s_waitcnt lgkmcnt(0)" ::: "memory")
#define VM_WAIT() asm volatile("s_waitcnt vmcnt(0)" ::: "memory")
DI int swap23(int i) { return (i & ~12) | ((i & 4) << 1) | ((i & 8) >> 1); }

namespace pg8 {
constexpr int BM = 256, BK = 64, HALF = 128, HTB = HALF * BK * 2, STAGE_BYTES = 8 * HTB, NXCD = 8, WGM = 8;
__host__ __device__ __forceinline__ int lds_byte(int r, int c) { const int st = (r >> 4) * 2 + (c >> 5), rr = r & 15, cc = c & 31, ob = rr * 64 + cc * 2; return st * 1024 + (ob ^ (((ob >> 9) & 1) << 5)); }
__host__ __device__ __forceinline__ void stage_rc(int b, int& R, int& C) { const int st = b / 1024, sb = b % 1024, swz = sb ^ (((sb >> 9) & 1) << 5); R = (st >> 1) * 16 + swz / 64; C = (st & 1) * 32 + (swz % 64) / 2; }
__host__ __device__ __forceinline__ int perm32(int rho) { const int n = rho >> 4, i = rho & 15; return 8 * (i >> 2) + 4 * n + (i & 3); }

struct Unit { int pm, pn, aux; };

DI int xcd_remap(int L, int nwg) { const int q = nwg / NXCD, r = nwg % NXCD, xcd = L % NXCD, off = L / NXCD; return (xcd < r ? xcd * (q + 1) : r * (q + 1) + (xcd - r) * q) + off; }

struct PlainOrder {
    static constexpr bool GATHER = false;
    const bf16_t* A; const bf16_t* Bt; int K; int nM, nN, nwg, G, c;
    DI void init(const bf16_t* A_, const bf16_t* Bt_, int M, int N, int K_, int G_, int c_) { A = A_; Bt = Bt_; K = K_; nM = M / BM; nN = N / BM; nwg = nM * nN; G = G_; c = c_; }
    DI bool next(int i, Unit& u) const {
        const int Lx = i * G + c; if (Lx >= nwg) return false;
        const int wgid = xcd_remap(Lx, nwg);
        const int nig = WGM * nN, gid = wgid / nig, fm = gid * WGM, gsz = (nM - fm) < WGM ? (nM - fm) : WGM;
        u.pm = fm + ((wgid % nig) % gsz); u.pn = (wgid % nig) / gsz; u.aux = 0; return true;
    }
    DI const char* aptr(const Unit& u) const { return (const char*)A + (size_t)u.pm * (2 * HALF) * K * 2; }
    DI const char* bptr(const Unit& u) const { return (const char*)Bt + (size_t)u.pn * (2 * HALF) * K * 2; }
};
struct Gemm1Order {
    static constexpr bool GATHER = false;
    const bf16_t* U; const bf16_t* Win; const bf16_t* Wv; int G, c;
    static constexpr int nM = T / BM, nN = HW / BM, nMain = nM * nN, nV = 2 * (T / BM), nwg = nMain + nV, K = D;
    DI bool next(int i, Unit& u) const {
        const int Lx = i * G + c; if (Lx >= nwg) return false;
        if (Lx < nMain) {
            const int wgid = xcd_remap(Lx, nMain);
            const int nig = WGM * nN, gid = wgid / nig, fm = gid * WGM, gsz = (nM - fm) < WGM ? (nM - fm) : WGM;
            u.pm = fm + ((wgid % nig) % gsz); u.pn = (wgid % nig) / gsz; u.aux = 0;
        } else { const int v = Lx - nMain; u.pm = v & 1; u.pn = v >> 1; u.aux = 1; }
        return true;
    }
    DI const char* aptr(const Unit& u) const { return (const char*)(u.aux ? Wv : U) + (size_t)u.pm * BM * K * 2; }
    DI const char* bptr(const Unit& u) const { return (const char*)(u.aux ? U : Win) + (size_t)u.pn * BM * K * 2; }
};
template <bool G_> struct GroupedOrderT {
    static constexpr bool GATHER = G_;
    const bf16_t* A; const bf16_t* Bt; int K; size_t estride; const LAS int* tile_e; int ntiles, nwg, G, c; const int* rowtok;
    DI bool next(int i, Unit& u) const {
        const int Lx = i * G + c; if (Lx >= nwg) return false;
        const int wgid = xcd_remap(Lx, nwg);
        u.pm = wgid >> 2; u.pn = wgid & 3; u.aux = tile_e[u.pm]; return true;
    }
    DI const char* aptr(const Unit& u) const { return GATHER ? (const char*)A : (const char*)A + (size_t)u.pm * BM * K * 2; }
    DI const char* bptr(const Unit& u) const { return (const char*)Bt + ((size_t)u.aux * estride + (size_t)u.pn * BM * K) * 2; }
};

struct EpiStore {
    bf16_t* O0; int ld0; bf16_t* O1; int ld1;
    DI void operator()(const f32x4 (&acc)[2][2][4][2], const Unit& u, int wr, int wc, int fr, int fq) const {
        bf16_t* base = u.aux ? O1 : O0; const int ldc = u.aux ? ld1 : ld0;
        const int row0 = u.pm * BM + wr * 64 + fr, col0 = u.pn * BM + wc * 32 + 8 * fq;
#pragma unroll
        for (int ai = 0; ai < 2; ++ai)
#pragma unroll
            for (int m = 0; m < 4; ++m) { bf16_t* rowp = base + (size_t)(row0 + ai * HALF + m * 16) * ldc + col0;
#pragma unroll
                for (int bj = 0; bj < 2; ++bj) { const f32x4 v0 = acc[ai][bj][m][0], v1 = acc[ai][bj][m][1];
                    u32x4 w; w.x = cvtpk(v0[0], v0[1]); w.y = cvtpk(v0[2], v0[3]); w.z = cvtpk(v1[0], v1[1]); w.w = cvtpk(v1[2], v1[3]);
                    *(u32x4*)(rowp + bj * HALF) = w; } }
    }
};
struct EpiSwiGlu {
    bf16_t* O;
    DI void operator()(const f32x4 (&acc)[2][2][4][2], const Unit& u, int wr, int wc, int fr, int fq) const {
        const int row0 = u.pm * BM + wr * 64 + fr, col0 = u.pn * HALF + wc * 32 + 8 * fq;
#pragma unroll
        for (int ai = 0; ai < 2; ++ai)
#pragma unroll
            for (int m = 0; m < 4; ++m) { bf16_t* rowp = O + (size_t)(row0 + ai * HALF + m * 16) * DE + col0;
                float hv[8];
#pragma unroll
                for (int n = 0; n < 2; ++n)
#pragma unroll
                    for (int e = 0; e < 4; ++e) { const float g = acc[ai][0][m][n][e], up = acc[ai][1][m][n][e]; hv[4 * n + e] = g * sigm(g) * up; }
                u32x4 w; w.x = cvtpk(hv[0], hv[1]); w.y = cvtpk(hv[2], hv[3]); w.z = cvtpk(hv[4], hv[5]); w.w = cvtpk(hv[6], hv[7]);
                *(u32x4*)rowp = w; }
    }
};
struct EpiRowScale {
    bf16_t* O; const float* roww;
    DI void operator()(const f32x4 (&acc)[2][2][4][2], const Unit& u, int wr, int wc, int fr, int fq) const {
        const int row0 = u.pm * BM + wr * 64 + fr, col0 = u.pn * BM + wc * 32 + 8 * fq;
#pragma unroll
        for (int ai = 0; ai < 2; ++ai)
#pragma unroll
            for (int m = 0; m < 4; ++m) { const int row = row0 + ai * HALF + m * 16;
#ifdef MOEB_NOSCALE
                const float s = 1.f;
#else
                const float s = roww[row];
#endif
                bf16_t* rowp = O + (size_t)row * D + col0;
#pragma unroll
                for (int bj = 0; bj < 2; ++bj) { const f32x4 v0 = acc[ai][bj][m][0] * s, v1 = acc[ai][bj][m][1] * s;
                    u32x4 w; w.x = cvtpk(v0[0], v0[1]); w.y = cvtpk(v0[2], v0[3]); w.z = cvtpk(v1[0], v1[1]); w.w = cvtpk(v1[2], v1[3]);
                    *(u32x4*)(rowp + bj * HALF) = w; } }
    }
};

template <class Epi, class Sched>
DI void gemm_phase(LAS unsigned char* lds, const int tid, const int K, const Sched& S, const Epi& E) {
    const int wid = __builtin_amdgcn_readfirstlane(tid >> 6), lane = tid & 63, wr = wid >> 2, wc = wid & 3, fr = lane & 15, fq = lane >> 4;
    const int nt = K / BK;
    unsigned voffA[2], voffB[2];
#pragma unroll
    for (int i = 0; i < 2; ++i) { int R, C; stage_rc(tid * 16 + i * 8192, R, C); const int Rb = (R & ~31) + perm32(R & 31);
        voffA[i] = (unsigned)(R * K + C) * 2u; voffB[i] = (unsigned)(Rb * K + C) * 2u; }
    const size_t kstep = (size_t)(BK * 2);
    const size_t hstep = (size_t)HALF * K * 2;
    const size_t hstepA = Sched::GATHER ? 0 : hstep;
    int RA_[2], CA_[2];
#pragma unroll
    for (int i = 0; i < 2; ++i) stage_rc(tid * 16 + i * 8192, RA_[i], CA_[i]);
    unsigned vgc[2][2], vgn[2][2], vgnn[2][2];
#define PG8_GLOAD(dst, u_) do { if constexpr (Sched::GATHER) { _Pragma("unroll") for (int h_ = 0; h_ < 2; ++h_) _Pragma("unroll") for (int i_ = 0; i_ < 2; ++i_) \
        dst[h_][i_] = ((unsigned)S.rowtok[(u_).pm * BM + h_ * HALF + RA_[i_]] * (unsigned)K + (unsigned)CA_[i_]) * 2u; } } while (0)
    const unsigned ldsw = (unsigned)wid * 1024u;
    const int aoff = lds_byte(wr * 64 + fr, fq * 8), boff = lds_byte(wc * 32 + fr, fq * 8);
#define PG8_SA(b, h) (((b) * 2 + (h)) * HTB)
#define PG8_SB(b, h) ((4 + (b) * 2 + (h)) * HTB)
#define PG8_STAGE(bufoff, gbase, voff) do { _Pragma("unroll") for (int _i = 0; _i < 2; ++_i) \
        __builtin_amdgcn_global_load_lds((const unsigned*)((const char*)(gbase) + (voff)[_i]), (LAS unsigned*)(lds + (bufoff) + ldsw + _i * 8192), 16, 0, 0); } while (0)
#define PG8_STAGE_A(b, h, gbase, cur_) do { if constexpr (Sched::GATHER) { unsigned vo_[2]; vo_[0] = (cur_) ? vgc[h][0] : vgn[h][0]; vo_[1] = (cur_) ? vgc[h][1] : vgn[h][1]; PG8_STAGE(PG8_SA(b, h), gbase, vo_); } else PG8_STAGE(PG8_SA(b, h), (gbase) + (h) * hstepA, voffA); } while (0)
#define PG8_LDA(dst, b, h) do { _Pragma("unroll") for (int m = 0; m < 4; ++m) _Pragma("unroll") for (int k = 0; k < 2; ++k) dst[m][k] = *(const LAS bf16x8*)(lds + PG8_SA(b, h) + aoff + m * 2048 + k * 1024); } while (0)
#define PG8_LDB(dst, b, h) do { _Pragma("unroll") for (int n = 0; n < 2; ++n) _Pragma("unroll") for (int k = 0; k < 2; ++k) dst[n][k] = *(const LAS bf16x8*)(lds + PG8_SB(b, h) + boff + n * 2048 + k * 1024); } while (0)
#define PG8_MMA(ai, bj, At, Bt) do { __builtin_amdgcn_s_setprio(1); _Pragma("unroll") for (int m = 0; m < 4; ++m) _Pragma("unroll") for (int n = 0; n < 2; ++n) _Pragma("unroll") for (int k = 0; k < 2; ++k) \
        acc[ai][bj][m][n] = __builtin_amdgcn_mfma_f32_16x16x32_bf16(Bt[n][k], At[m][k], acc[ai][bj][m][n], 0, 0, 0); __builtin_amdgcn_s_setprio(0); } while (0)
#define PG8_WAIT_V(n) asm volatile("s_waitcnt vmcnt(" #n ")" ::: "memory")
#define PG8_WAIT_L(n) asm volatile("s_waitcnt lgkmcnt(" #n ")" ::: "memory")
#define PG8_BAR __builtin_amdgcn_s_barrier()
#define PG8_SCHED __builtin_amdgcn_sched_barrier(0)
    Unit cur, nxt; int ui = 0;
    if (!S.next(0, cur)) return;
    f32x4 acc[2][2][4][2];
#pragma unroll
    for (int a = 0; a < 2; ++a)
#pragma unroll
        for (int b = 0; b < 2; ++b)
#pragma unroll
            for (int m = 0; m < 4; ++m)
#pragma unroll
                for (int n = 0; n < 2; ++n) acc[a][b][m][n] = (f32x4){0.f, 0.f, 0.f, 0.f};
    bf16x8 At[4][2], B0[2][2], B1[2][2];
    const char* cA = S.aptr(cur); const char* cB = S.bptr(cur);
    if constexpr (Sched::GATHER) { Unit u1_ = cur, u2_ = cur; const bool h1_ = S.next(1, u1_); if (!h1_) u1_ = cur; const bool h2_ = h1_ && S.next(2, u2_); if (!h2_) u2_ = u1_;
        PG8_GLOAD(vgc, cur); PG8_GLOAD(vgn, u1_); PG8_GLOAD(vgnn, u2_); }
    PG8_STAGE(PG8_SB(0, 0), cB, voffB); PG8_STAGE(PG8_SB(0, 1), cB + hstep, voffB); PG8_STAGE_A(0, 0, cA, true); PG8_STAGE_A(0, 1, cA, true);
    if (wr == 1) PG8_BAR;
    PG8_WAIT_V(2); PG8_BAR;
    PG8_STAGE(PG8_SB(1, 0), cB + kstep, voffB); PG8_STAGE_A(1, 0, cA + kstep, true); PG8_STAGE(PG8_SB(1, 1), cB + hstep + kstep, voffB);
    PG8_WAIT_V(6); PG8_BAR;
    for (;;) {
        const bool has_next = S.next(ui + 1, nxt);
        const char* nA = has_next ? S.aptr(nxt) : cA; const char* nB = has_next ? S.bptr(nxt) : cB;

        for (int t = 0; t < nt; t += 2) {
            const bool last = (t == nt - 2);
            const char* a1 = cA + (size_t)(t + 1) * kstep;
            const char* a2 = last ? nA : cA + (size_t)(t + 2) * kstep; const char* b2 = last ? nB : cB + (size_t)(t + 2) * kstep;
            const char* a3 = a2 + kstep; const char* b3 = b2 + kstep;
            PG8_LDB(B0, 0, 0); PG8_LDB(B1, 0, 1); PG8_SCHED; PG8_LDA(At, 0, 0); PG8_STAGE_A(1, 1, a1, true);
            PG8_WAIT_V(8); PG8_WAIT_L(0); PG8_BAR; PG8_MMA(0, 0, At, B0); PG8_MMA(0, 1, At, B1); PG8_BAR; PG8_SCHED;
            PG8_LDA(At, 0, 1); PG8_STAGE(PG8_SB(0, 0), b2, voffB); PG8_STAGE(PG8_SB(0, 1), b2 + hstep, voffB); PG8_STAGE_A(0, 0, a2, !last);
            PG8_WAIT_V(8); PG8_WAIT_L(0); PG8_BAR; PG8_MMA(1, 0, At, B0); PG8_MMA(1, 1, At, B1); PG8_BAR; PG8_SCHED;
            PG8_LDB(B0, 1, 0); PG8_LDB(B1, 1, 1); PG8_SCHED; PG8_LDA(At, 1, 0); PG8_STAGE_A(0, 1, a2, !last);
            PG8_WAIT_V(8); PG8_WAIT_L(0); PG8_BAR; PG8_MMA(0, 0, At, B0); PG8_MMA(0, 1, At, B1); PG8_BAR; PG8_SCHED;
            PG8_LDA(At, 1, 1); PG8_STAGE(PG8_SB(1, 0), b3, voffB); PG8_STAGE(PG8_SB(1, 1), b3 + hstep, voffB); PG8_STAGE_A(1, 0, a3, !last);
            PG8_WAIT_V(8); PG8_WAIT_L(0); PG8_BAR; PG8_MMA(1, 0, At, B0); PG8_MMA(1, 1, At, B1); PG8_BAR; PG8_SCHED;
        }
        if (wr == 0) PG8_BAR;
        E(acc, cur, wr, wc, fr, fq);
        if (!has_next) break;
#pragma unroll
        for (int a = 0; a < 2; ++a)
#pragma unroll
            for (int b = 0; b < 2; ++b)
#pragma unroll
                for (int m = 0; m < 4; ++m)
#pragma unroll
                    for (int n = 0; n < 2; ++n) acc[a][b][m][n] = (f32x4){0.f, 0.f, 0.f, 0.f};
        cur = nxt; cA = nA; cB = nB; ++ui;
        if constexpr (Sched::GATHER) { _Pragma("unroll") for (int h_ = 0; h_ < 2; ++h_) _Pragma("unroll") for (int i_ = 0; i_ < 2; ++i_) { vgc[h_][i_] = vgn[h_][i_]; vgn[h_][i_] = vgnn[h_][i_]; } }
        if (wr == 1) PG8_BAR;
    }
    PG8_WAIT_V(0);
    PG8_BAR;
#undef PG8_SA
#undef PG8_SB
#undef PG8_STAGE
#undef PG8_STAGE_A
#undef PG8_GLOAD
#undef PG8_LDA
#undef PG8_LDB
#undef PG8_MMA
#undef PG8_WAIT_V
#undef PG8_WAIT_L
#undef PG8_BAR
#undef PG8_SCHED
}
}

#define XB_TMO      128
#define XB_XCNT(j)  (256  + 64 * (j))
#define XB_XSUB(j)  (1280 + 64 * (j))
#define XB_XGEN(j)  (2304 + 64 * (j))
#define XB_TOP      3328
#define XB_TOPGEN   3392
#define XCD_BAR_WORDS 3456
#define XB_SPIN_CAP (1u << 20)
DI unsigned xb_ld(unsigned* p)              { return __hip_atomic_load(p, __ATOMIC_RELAXED, __HIP_MEMORY_SCOPE_AGENT); }
DI unsigned xb_add(unsigned* p, unsigned v) { return __hip_atomic_fetch_add(p, v, __ATOMIC_RELAXED, __HIP_MEMORY_SCOPE_AGENT); }
DI unsigned xb_xcc_id() { return (unsigned)__builtin_amdgcn_s_getreg((3 << 11) | 20) & 0xFu; }
#define XB_SPIN(cond, bar) do { unsigned _sp = 0; while (cond) { __builtin_amdgcn_s_sleep(1); \
    if ((++_sp & 255u) == 0u) { if (xb_ld(&(bar)[XB_TMO])) break; if (_sp > XB_SPIN_CAP) { atomicAdd(&(bar)[XB_TMO], 1u); break; } } } } while (0)
struct XcdBarrier { unsigned* bar; unsigned x; volatile LAS unsigned* st; };
DI XcdBarrier xcd_barrier_post(unsigned* bar, volatile LAS unsigned* st) {
    XcdBarrier b; b.bar = bar; b.x = xb_xcc_id(); b.st = st;
    if (threadIdx.x == 0) (void)xb_add(&bar[XB_XCNT(b.x)], 1u);
    return b;
}
DI void xcd_barrier_complete(unsigned* bar, unsigned x, unsigned& nloc, unsigned& nx) {
    const unsigned G = gridDim.x * gridDim.y * gridDim.z;
    unsigned sum, cnt, mine, sp = 0u;
    for (;;) {
        sum = 0u; cnt = 0u; mine = 0u;
#pragma unroll
        for (unsigned j = 0; j < 16; ++j) { const unsigned c = xb_ld(&bar[XB_XCNT(j)]); sum += c; cnt += (c > 0u) ? 1u : 0u; mine = (j == x) ? c : mine; }
        if (sum == G) break;
        __builtin_amdgcn_s_sleep(1);
        if ((++sp & 255u) == 0u) { if (xb_ld(&bar[XB_TMO])) break; if (sp > XB_SPIN_CAP) { atomicAdd(&bar[XB_TMO], 1u); break; } }
    }
    nloc = mine > 0u ? mine : 1u; nx = cnt > 0u ? cnt : 1u;
}
DI void xcd_barrier(const XcdBarrier& b) {
    asm volatile("s_waitcnt vmcnt(0)" ::: "memory");
    __syncthreads();
    if (threadIdx.x == 0) {
        unsigned* bar = b.bar;
        __builtin_amdgcn_s_waitcnt(0);
        unsigned nloc = b.st[0], nx = b.st[1];
        if (nloc == 0u) { xcd_barrier_complete(bar, b.x, nloc, nx); b.st[0] = nloc; b.st[1] = nx; }
        const unsigned old = xb_add(&bar[XB_XSUB(b.x)], 1u);
        const unsigned gen = old / nloc;
        if (old + 1u == (gen + 1u) * nloc) {
            __builtin_amdgcn_fence(__ATOMIC_RELEASE, "agent");
            asm volatile("s_waitcnt vmcnt(0)" ::: "memory");
            const unsigned og = xb_add(&bar[XB_TOP], 1u);
            const unsigned tg = og / nx;
            if (og + 1u == (tg + 1u) * nx) xb_add(&bar[XB_TOPGEN], 1u);
            else XB_SPIN(xb_ld(&bar[XB_TOPGEN]) == tg, bar);
            __builtin_amdgcn_fence(__ATOMIC_ACQUIRE, "agent");
            xb_add(&bar[XB_XGEN(b.x)], 1u);
            asm volatile("s_waitcnt vmcnt(0)" ::: "memory");
        } else {
            XB_SPIN(xb_ld(&bar[XB_XGEN(b.x)]) == gen, bar);
            __builtin_amdgcn_fence(__ATOMIC_ACQUIRE, "agent");
            asm volatile("s_waitcnt vmcnt(0)" ::: "memory");
        }
    }
    __syncthreads();
}

struct Args { const float* in[31]; float* out; unsigned char* ws; int ph_lo, ph_hi, use_cg, pad; };
struct Frame {
    LAS unsigned char* lds;
    int tid, lane, wave, G, vcu, gw, ngw, bx;
    unsigned char* ws;
};
constexpr int LDS_MISC = 131072;
constexpr int LDS_BARST = LDS_BYTES - 64;

struct TItem { const float* src; bf16_t* dst; int ldw, ldt; };
DI void titem_load(const TItem& t, f32x4 (&v)[16], int lane) {
#pragma unroll
    for (int i = 0; i < 16; ++i) v[i] = *(const f32x4*)(t.src + (size_t)(4 * i + (lane >> 4)) * t.ldw + 4 * (lane & 15));
}
DI void titem_store(const TItem& t, const f32x4 (&v)[16], LAS float* scr, int lane) {
#pragma unroll
    for (int i = 0; i < 16; ++i) { LAS float* s = scr + (4 * i + (lane >> 4)) * 65 + 4 * (lane & 15); s[0] = v[i][0]; s[1] = v[i][1]; s[2] = v[i][2]; s[3] = v[i][3]; }
    LDS_WAIT();
#pragma unroll
    for (int j = 0; j < 8; ++j) {
        const int n = 8 * j + (lane >> 3), c = lane & 7; const LAS float* s = scr + (8 * c) * 65 + n;
        u32x4 o; o.x = cvtpk(s[0], s[65]); o.y = cvtpk(s[130], s[195]); o.z = cvtpk(s[260], s[325]); o.w = cvtpk(s[390], s[455]);
        *(u32x4*)(t.dst + (size_t)n * t.ldt + 8 * c) = o;
    }
    LDS_WAIT();
}
constexpr int IT_WIN = 16 * 42, IT_WOUT = 16 * 16, IT_SMALL = IT_WIN + IT_WOUT;
constexpr int IT_EXP = 128 * 3, IT_MOE = NE * IT_EXP;
DI TItem small_item(const Frame& F, const float* w_in, const float* w_out, int git) {
    const int l = git / IT_SMALL, it = git % IT_SMALL; TItem t;
    if (it < IT_WIN) {
        const int kt = it / 42, nt = it % 42, n0 = 64 * nt;
        size_t drow; if (n0 < 768) drow = n0; else if (n0 < 1152) drow = 2304 + (n0 - 768); else drow = n0 - 384;
        t.src = w_in + (size_t)l * D * INW + (size_t)(64 * kt) * INW + n0; t.ldw = INW;
        t.dst = (bf16_t*)(F.ws + WS_WIN + (size_t)l * WIN_LAYER) + drow * D + 64 * kt; t.ldt = D;
    } else {
        const int r = it - IT_WIN, kt = r >> 4, nt = r & 15;
        t.src = w_out + (size_t)l * D * D + (size_t)(64 * kt) * D + 64 * nt; t.ldw = D;
        t.dst = (bf16_t*)(F.ws + WS_WOUT) + (size_t)l * D * D + (size_t)(64 * nt) * D + 64 * kt; t.ldt = D;
    }
    return t;
}
DI TItem moe_item(const Frame& F, const float* wg, const float* wu, const float* wd, int l, int it) {
    const int e = it / IT_EXP, r = it % IT_EXP, which = r >> 7, q = r & 127; TItem t;
    if (which < 2) {
        const int kt = q >> 3, nt = q & 7, n0 = 64 * nt;
        t.src = (which ? wu : wg) + ((size_t)l * NE + e) * D * DE + (size_t)(64 * kt) * DE + n0; t.ldw = DE;
        const size_t drow = (size_t)(n0 >> 7) * 256 + (which ? 128 : 0) + (n0 & 127);
        t.dst = (bf16_t*)(F.ws + WS_WGU) + (size_t)e * D * D + drow * D + 64 * kt; t.ldt = D;
    } else {
        const int kt = q >> 4, nt = q & 15;
        t.src = wd + ((size_t)l * NE + e) * DE * D + (size_t)(64 * kt) * D + 64 * nt; t.ldw = D;
        t.dst = (bf16_t*)(F.ws + WS_WD) + (size_t)e * D * DE + (size_t)(64 * nt) * DE + 64 * kt; t.ldt = DE;
    }
    return t;
}
DI void p0_prologue(const Frame& F, const Args& a) {
    const float* c = a.in[1]; const float* w_mod = a.in[2]; const float* b_mod = a.in[3];
    if (F.bx < L * (MODW / 64)) {
        LAS float* sc = (LAS float*)(F.lds);
        LAS float* red = (LAS float*)(F.lds + 8192);
        for (int i = F.tid; i < NB * D; i += NTHREADS) { const float v = c[i]; sc[i] = v / (1.f + expf(-v)); }
        __syncthreads();
        const int l = F.bx / (MODW / 64), cb = F.bx % (MODW / 64), n = cb * 64 + F.lane;
        const float* w = w_mod + (size_t)l * D * MODW + n;
        float a0 = 0.f, a1 = 0.f;
#pragma unroll 8
        for (int k = F.wave * 128; k < F.wave * 128 + 128; ++k) { const float wv = w[(size_t)k * MODW]; a0 += sc[k] * wv; a1 += sc[D + k] * wv; }
        red[(F.wave * 2 + 0) * 64 + F.lane] = a0; red[(F.wave * 2 + 1) * 64 + F.lane] = a1;
        __syncthreads();
        if (F.tid < 128) { const int b = F.tid >> 6, ln = F.tid & 63; float s = 0.f;
#pragma unroll
            for (int w8 = 0; w8 < 8; ++w8) s += red[(w8 * 2 + b) * 64 + ln];
            const int nn = cb * 64 + ln;
            ((float*)(F.ws + WS_MOD))[(size_t)(l * NB + b) * MODW + nn] = s + b_mod[l * MODW + nn]; }
        __syncthreads();
    }
    { const int nzero = L * 128 * D / 8;
      for (int i = F.gw * 64 + F.lane; i < nzero; i += F.ngw * 64) { const int l = i / (128 * D / 8), r = i % (128 * D / 8);
          *(u32x4*)((bf16_t*)(F.ws + WS_WIN + (size_t)l * WIN_LAYER) + (size_t)(2304 + 384) * D + (size_t)r * 8) = (u32x4){0u, 0u, 0u, 0u}; } }
    LAS float* scr = (LAS float*)(F.lds + 16384) + F.wave * (64 * 65);
    { f32x4 cur[16], nxt[16]; int it = F.gw; TItem tc{}, tn{};
      if (it < L * IT_SMALL) { tc = small_item(F, a.in[4], a.in[19], it); titem_load(tc, cur, F.lane); }
      for (; it < L * IT_SMALL; it += F.ngw) {
          const bool more = it + F.ngw < L * IT_SMALL;
          if (more) { tn = small_item(F, a.in[4], a.in[19], it + F.ngw); titem_load(tn, nxt, F.lane); }
          titem_store(tc, cur, scr, F.lane);
          if (more) { tc = tn;
#pragma unroll
              for (int i = 0; i < 16; ++i) cur[i] = nxt[i]; }
      } }
}

DI void row_ln(f32x4 (&v)[4], float& mean_out, float& rstd_out) {
    float s = 0.f;
#pragma unroll
    for (int j = 0; j < 4; ++j) s += (v[j][0] + v[j][1]) + (v[j][2] + v[j][3]);
    const float mean = wave_sum(s) * (1.f / D); float q = 0.f;
#pragma unroll
    for (int j = 0; j < 4; ++j) { v[j] = v[j] - mean; q += (v[j][0] * v[j][0] + v[j][1] * v[j][1]) + (v[j][2] * v[j][2] + v[j][3] * v[j][3]); }
    mean_out = mean; rstd_out = 1.f / sqrtf(wave_sum(q) * (1.f / D) + LN_EPS);
}
DI void row_mod_store(f32x4 (&v)[4], const float* md, int off_sh, int off_sc, bf16_t* urow, int lane) {
    float mean, rstd; row_ln(v, mean, rstd);
#pragma unroll
    for (int j = 0; j < 4; ++j) { const int col = 4 * lane + 256 * j;
        const f32x4 scv = *(const f32x4*)(md + off_sc + col), shv = *(const f32x4*)(md + off_sh + col);
        v[j] = v[j] * rstd * (1.f + scv) + shv;
        u32x2 w; w.x = cvtpk(v[j][0], v[j][1]); w.y = cvtpk(v[j][2], v[j][3]);
        *(u32x2*)(urow + col) = w; }
}
DI void p_r0(const Frame& F, const float* x) {
    const float* MOD = (const float*)(F.ws + WS_MOD);
    bf16_t* U = (bf16_t*)(F.ws + WS_U);
    for (int row = F.gw; row < T; row += F.ngw) {
        f32x4 v[4];
#pragma unroll
        for (int j = 0; j < 4; ++j) v[j] = *(const f32x4*)(x + (size_t)row * D + 4 * F.lane + 256 * j);
        row_mod_store(v, MOD + (size_t)(row / S) * MODW, 0, D, U + (size_t)row * D, F.lane);
    }
}

constexpr int NGRP = T / 64;
DI void p_rowpass1(const Frame& F, const Args& a, int l, const float* xin, const bool dry = false) {
    const float* MODl = (const float*)(F.ws + WS_MOD) + (size_t)l * NB * MODW;
    const bf16_t* MIX = (const bf16_t*)(F.ws + WS_MIX);
    float* XA = (float*)(F.ws + WS_XA); bf16_t* U = (bf16_t*)(F.ws + WS_U);
    const float* gain = a.in[20] + (size_t)l * D; const float* bias = a.in[21] + (size_t)l * D;
    const float* wg = a.in[24] + (size_t)l * D * NG; const float* bg = a.in[25] + (size_t)l * NG;
    const float* we = a.in[26] + (size_t)l * D * NE; const float* be = a.in[27] + (size_t)l * NE;
    const size_t dro = dry ? 490 * MiB - WS_BC : 0;
    int* BC = (int*)(F.ws + WS_BC + dro); float* TOKW = (float*)(F.ws + WS_TOKW + dro); int* TOKSLOT = (int*)(F.ws + WS_TOKSLOT + (dry ? 496 * MiB - WS_TOKSLOT : 0));
    LAS float* RT = (LAS float*)F.lds;
    LAS unsigned* cntl = (LAS unsigned*)(F.lds + 36 * D * 4 + NWAVES * 72 * 4);
#pragma unroll
    for (int kk = 0; kk < 2; ++kk) { const int k = F.tid + kk * NTHREADS;
        f32x4 v[9]; v[0] = *(const f32x4*)(wg + (size_t)k * NG);
#pragma unroll
        for (int q = 0; q < 8; ++q) v[1 + q] = *(const f32x4*)(we + (size_t)k * NE + 4 * q);
#pragma unroll
        for (int q = 0; q < 9; ++q)
#pragma unroll
            for (int e = 0; e < 4; ++e) RT[(4 * q + e) * D + k] = v[q][e]; }
    for (int grp = F.vcu; grp < NGRP; grp += F.G) {
    if (F.tid < NE) cntl[F.tid] = 0u;
    __syncthreads();
    f32x4 pxa[4], pxb[4]; u32x2 pma[4], pmb[4];
    { const int r0 = 64 * grp + 8 * F.wave;
#pragma unroll
      for (int j = 0; j < 4; ++j) { const int col = 4 * F.lane + 256 * j; pxa[j] = *(const f32x4*)(xin + (size_t)r0 * D + col); pxb[j] = *(const f32x4*)(xin + (size_t)(r0 + 1) * D + col);
          pma[j] = *(const u32x2*)(MIX + (size_t)r0 * D + col); pmb[j] = *(const u32x2*)(MIX + (size_t)(r0 + 1) * D + col); } }
    for (int rp = 0; rp < 4; ++rp) {
        const int row0 = 64 * grp + 8 * F.wave + 2 * rp; const float* md = MODl + (size_t)(row0 / S) * MODW;
        f32x4 va[4], vb[4];
#pragma unroll
        for (int j = 0; j < 4; ++j) { const int col = 4 * F.lane + 256 * j;
            const f32x4 g = *(const f32x4*)(md + 2 * D + col);
            va[j] = pxa[j] * ALPHA + g * (f32x4){bflo(pma[j].x), bfhi(pma[j].x), bflo(pma[j].y), bfhi(pma[j].y)};
            vb[j] = pxb[j] * ALPHA + g * (f32x4){bflo(pmb[j].x), bfhi(pmb[j].x), bflo(pmb[j].y), bfhi(pmb[j].y)}; }
        if (rp < 3) { const int r0 = row0 + 2;
#pragma unroll
          for (int j = 0; j < 4; ++j) { const int col = 4 * F.lane + 256 * j; pxa[j] = *(const f32x4*)(xin + (size_t)r0 * D + col); pxb[j] = *(const f32x4*)(xin + (size_t)(r0 + 1) * D + col);
              pma[j] = *(const u32x2*)(MIX + (size_t)r0 * D + col); pmb[j] = *(const u32x2*)(MIX + (size_t)(r0 + 1) * D + col); } }
        float mean, rstd;
        row_ln(va, mean, rstd);
#pragma unroll
        for (int j = 0; j < 4; ++j) { const int col = 4 * F.lane + 256 * j; va[j] = va[j] * rstd * *(const f32x4*)(gain + col) + *(const f32x4*)(bias + col); *(f32x4*)(XA + (size_t)row0 * D + col) = va[j]; }
        row_ln(vb, mean, rstd);
#pragma unroll
        for (int j = 0; j < 4; ++j) { const int col = 4 * F.lane + 256 * j; vb[j] = vb[j] * rstd * *(const f32x4*)(gain + col) + *(const f32x4*)(bias + col); *(f32x4*)(XA + (size_t)(row0 + 1) * D + col) = vb[j]; }
        row_mod_store(va, md, 3 * D, 4 * D, U + (size_t)row0 * D, F.lane);
        row_mod_store(vb, md, 3 * D, 4 * D, U + (size_t)(row0 + 1) * D, F.lane);
#ifdef DRY_NOROUTER
        if (dry) continue;
#endif
        LAS float* lg = (LAS float*)(F.lds + 36 * D * 4) + F.wave * 72;
#pragma unroll 1
        for (int n = 0; n < 36; n += 3) { float sa[3], sb[3];
#pragma unroll
            for (int q = 0; q < 3; ++q) { sa[q] = 0.f; sb[q] = 0.f;
#pragma unroll
                for (int j = 0; j < 4; ++j) { const f32x4 w = *(const LAS f32x4*)(RT + (n + q) * D + 4 * F.lane + 256 * j);
                    sa[q] += (va[j][0] * w[0] + va[j][1] * w[1]) + (va[j][2] * w[2] + va[j][3] * w[3]);
                    sb[q] += (vb[j][0] * w[0] + vb[j][1] * w[1]) + (vb[j][2] * w[2] + vb[j][3] * w[3]); } }
#pragma unroll
            for (int q = 0; q < 3; ++q) { sa[q] = wave_sum(sa[q]); sb[q] = wave_sum(sb[q]); }
            if (F.lane == 0) {
#pragma unroll
                for (int q = 0; q < 3; ++q) { lg[n + q] = sa[q]; lg[36 + n + q] = sb[q]; } } }
        LDS_WAIT();
#pragma unroll
        for (int rr = 0; rr < 2; ++rr) {
            float gl[4], el[32];
#pragma unroll
            for (int n = 0; n < 4; ++n) gl[n] = lg[36 * rr + n] + bg[n];
#pragma unroll
            for (int n = 0; n < 32; ++n) el[n] = lg[36 * rr + 4 + n] + be[n];
            int gi = 0; float gm = gl[0];
#pragma unroll
            for (int n = 1; n < 4; ++n) if (gl[n] > gm) { gm = gl[n]; gi = n; }
            float se = 0.f;
#pragma unroll
            for (int n = 0; n < 4; ++n) se += expf(gl[n] - gm);
            const float pg = 1.f / se;
            float l1 = -3.0e38f, l2 = -3.0e38f; int i1 = 0, i2 = 0;
#pragma unroll
            for (int n = 0; n < 32; ++n) if ((n >> 3) == gi) { const float v = el[n]; const int e = n & 7;
                if (v > l1) { l2 = l1; i2 = i1; l1 = v; i1 = e; } else if (v > l2) { l2 = v; i2 = e; } }
            const float e2 = expf(l2 - l1); const float w1 = pg / (1.f + e2), w2 = pg * e2 / (1.f + e2);
            if (F.lane == 0) {
                const int tok = row0 + rr, ea = gi * EPG + i1, eb = gi * EPG + i2;
                const unsigned pa = __hip_atomic_fetch_add(&cntl[ea], 1u, __ATOMIC_RELAXED, __HIP_MEMORY_SCOPE_WORKGROUP), pb = __hip_atomic_fetch_add(&cntl[eb], 1u, __ATOMIC_RELAXED, __HIP_MEMORY_SCOPE_WORKGROUP);
                TOKSLOT[tok * 2] = (ea << 14) | (int)pa; TOKSLOT[tok * 2 + 1] = (eb << 14) | (int)pb;
                TOKW[tok * 2] = w1; TOKW[tok * 2 + 1] = w2;
            }
        }
    }
    __syncthreads();
    if (F.tid < NE) BC[grp * NE + F.tid] = (int)cntl[F.tid];
    __syncthreads();
    }
}

DI void build_tables(const Frame& F, int l, LAS int* tb) {
    if (F.tid < 64) {
        const int e = F.lane; const int c = e < NE ? ((const int*)(F.ws + WS_CNTF))[e] : 0; const int tl = (c + 255) >> 8;
        int cum = c, tin = tl;
#pragma unroll
        for (int o = 1; o < 32; o <<= 1) { const int a1 = __shfl_up(cum, o), a2 = __shfl_up(tin, o); if (e >= o) { cum += a1; tin += a2; } }
        if (e < NE) { tb[e] = cum - c; tb[33 + e] = (tin - tl) * 256; for (int t2 = 0; t2 < tl; ++t2) tb[66 + (tin - tl) + t2] = e; }
        if (e == NE - 1) { tb[32] = cum; tb[65] = tin; }
    }
    __syncthreads();
}
DI void p_gather(const Frame& F, int l) {
    LAS int* base = (LAS int*)F.lds;
    LAS int* segt = base + NGRP * NE;
    LAS int* offp = segt + 16 * NE;
    const int* BC = (const int*)(F.ws + WS_BC);
    { int tmp[NGRP * NE / NTHREADS];
#pragma unroll
      for (int q = 0; q < NGRP * NE / NTHREADS; ++q) tmp[q] = BC[F.tid + q * NTHREADS];
#pragma unroll
      for (int q = 0; q < NGRP * NE / NTHREADS; ++q) base[F.tid + q * NTHREADS] = tmp[q]; }
    __syncthreads();
    { const int e = F.tid & 31, sg = F.tid >> 5; int run = 0;
      for (int g = 16 * sg; g < 16 * sg + 16; ++g) { const int c = base[g * NE + e]; base[g * NE + e] = run; run += c; }
      segt[sg * NE + e] = run; }
    __syncthreads();
    if (F.tid < NE) { int run = 0; for (int sg = 0; sg < 16; ++sg) { const int c = segt[sg * NE + F.tid]; segt[sg * NE + F.tid] = run; run += c; }
        offp[F.tid] = run;
        if (F.bx == 0) ((int*)(F.ws + WS_CNTF))[F.tid] = run; }
    __syncthreads();
    if (F.tid == 0) { int off = 0; for (int e = 0; e < NE; ++e) { const int c = offp[e]; offp[e] = off; off += ((c + 255) >> 8) * 256; } }
    __syncthreads();
    const int* TOKSLOT = (const int*)(F.ws + WS_TOKSLOT); const float* TOKW = (const float*)(F.ws + WS_TOKW); int* TOKFIN = (int*)(F.ws + WS_TOKFIN);
    float* SLOTW = (float*)(F.ws + WS_SLOTW);
    const int nas = (2 * T - F.gw + F.ngw - 1) / F.ngw;
    int my_slot = 0, my_tok = 0;
    if (F.lane < nas) { const int as = F.gw + F.lane * F.ngw; const int tok = as >> 1, ts = TOKSLOT[as], e = ts >> 14, grp = tok >> 6, sg = grp >> 4;
        my_slot = offp[e] + segt[sg * NE + e] + base[grp * NE + e] + (ts & 16383); my_tok = tok;
        SLOTW[my_slot] = TOKW[as]; TOKFIN[as] = my_slot; ((int*)(F.ws + WS_CTL + WS_SLOTTOK))[my_slot] = tok; }
}
struct Rp2In { f32x4 x[4]; u32x2 y0[4], y1[4]; };
DI void rp2_load(Rp2In& r, const float* XA, const bf16_t* YS, int row, int s0, int s1, int lane) {
#pragma unroll
    for (int j = 0; j < 4; ++j) { const int col = 4 * lane + 256 * j;
        r.x[j] = *(const f32x4*)(XA + (size_t)row * D + col); r.y0[j] = *(const u32x2*)(YS + (size_t)s0 * D + col); r.y1[j] = *(const u32x2*)(YS + (size_t)s1 * D + col); }
}
DI void p_rowpass2(const Frame& F, const Args& a, int l, float* xout) {
    const float* MOD = (const float*)(F.ws + WS_MOD);
    const float* XA = (const float*)(F.ws + WS_XA); const bf16_t* YS = (const bf16_t*)(F.ws + WS_YS); const int* TOKFIN = (const int*)(F.ws + WS_TOKFIN);
    const float* gain = a.in[22] + (size_t)l * D; const float* bias = a.in[23] + (size_t)l * D;
    bf16_t* U = (bf16_t*)(F.ws + WS_U);
    const int nrows = (T - F.gw + F.ngw - 1) / F.ngw;
    int tf = 0; { const int i = F.lane >> 1; if (i < nrows) tf = TOKFIN[(F.gw + i * F.ngw) * 2 + (F.lane & 1)]; }
    Rp2In cur, nxt;
    if (nrows > 0) rp2_load(cur, XA, YS, F.gw, __shfl(tf, 0), __shfl(tf, 1), F.lane);
    for (int i = 0; i < nrows; ++i) {
        const int row = F.gw + i * F.ngw;
        if (i + 1 < nrows) rp2_load(nxt, XA, YS, row + F.ngw, __shfl(tf, 2 * i + 2), __shfl(tf, 2 * i + 3), F.lane);
        const float* md = MOD + (size_t)(l * NB + row / S) * MODW;
        f32x4 v[4];
#pragma unroll
        for (int j = 0; j < 4; ++j) { const int col = 4 * F.lane + 256 * j;
            const f32x4 g = *(const f32x4*)(md + 5 * D + col);
            const u32x2 y0 = cur.y0[j], y1 = cur.y1[j];
            const f32x4 f = (f32x4){bflo(y0.x) + bflo(y1.x), bfhi(y0.x) + bfhi(y1.x), bflo(y0.y) + bflo(y1.y), bfhi(y0.y) + bfhi(y1.y)};
            v[j] = cur.x[j] * ALPHA + g * f; }
        float mean, rstd; row_ln(v, mean, rstd);
#pragma unroll
        for (int j = 0; j < 4; ++j) { const int col = 4 * F.lane + 256 * j; v[j] = v[j] * rstd * *(const f32x4*)(gain + col) + *(const f32x4*)(bias + col); *(f32x4*)(xout + (size_t)row * D + col) = v[j]; }
        if (l + 1 < L) row_mod_store(v, MOD + (size_t)((l + 1) * NB + row / S) * MODW, 0, D, U + (size_t)row * D, F.lane);
        if (i + 1 < nrows) {
#pragma unroll
            for (int j = 0; j < 4; ++j) { cur.x[j] = nxt.x[j]; cur.y0[j] = nxt.y0[j]; cur.y1[j] = nxt.y1[j]; } }
    }
}

#define MFMA16(a, b, c) __builtin_amdgcn_mfma_f32_16x16x32_bf16((a), (b), (c), 0, 0, 0)
#define MFMA32(a, b, c) __builtin_amdgcn_mfma_f32_32x32x16_bf16((a), (b), (c), 0, 0, 0)
constexpr int RB = 9216;
#define BUF(i) ((i) * RB)
constexpr int LWOFF = BUF(12), ZAOFF = BUF(0), SEGOFF = BUF(14), SEGXOFF = BUF(14) + 2048, TOTOFF = BUF(14) + 4096, NABFOFF = BUF(15), PCOFF = 16 * RB;
struct RwP { const float *conv, *w0, *w_up, *a0, *a_up, *g_up, *k_k, *k_a, *r_k, *gn_gain, *gn_bias; };

DI void lds_barrier() { asm volatile("s_waitcnt lgkmcnt(0)" ::: "memory"); __builtin_amdgcn_s_barrier(); asm volatile("" ::: "memory"); }
DI bf16x8 ldfrag(const LAS unsigned char* lds, int buf, int row, int ks, int lane) { return *(const LAS bf16x8*)(lds + buf + row * 144 + (32 * ks + 8 * (lane >> 4)) * 2); }
DI f32x4 mm64(const LAS unsigned char* lds, int abuf, int arow0, int bbuf, int brow0, int lane) {
    f32x4 acc = (f32x4){0.f, 0.f, 0.f, 0.f};
#pragma unroll
    for (int ks = 0; ks < 2; ++ks) acc = MFMA16(ldfrag(lds, abuf, arow0 + (lane & 15), ks, lane), ldfrag(lds, bbuf, brow0 + (lane & 15), ks, lane), acc);
    return acc;
}
DI u32x2 pack4(const f32x4 v) { u32x2 w; w.x = cvtpk(v[0], v[1]); w.y = cvtpk(v[2], v[3]); return w; }
DI f32x4 unpack4(const u32x2 w) { return (f32x4){bflo(w.x), bfhi(w.x), bflo(w.y), bfhi(w.y)}; }
DI void st4(LAS unsigned char* lds, int buf, int row, int col, const f32x4 v) { *(LAS u32x2*)(lds + buf + row * 144 + col * 2) = pack4(v); }
DI f32x4 ld4(const LAS unsigned char* lds, int buf, int row, int col) { return unpack4(*(const LAS u32x2*)(lds + buf + row * 144 + col * 2)); }
DI void st1(LAS unsigned char* lds, int buf, int row, int col, float v) { *(LAS bf16_t*)(lds + buf + row * 144 + col * 2) = f2bf(v); }
DI float fast_tanh(float x) { const float e = fexp2(x * (2.f * LOG2E)); return 1.f - 2.f * frcp(1.f + e); }

#define OPQZ(z) int z; asm volatile("s_mov_b32 %0, 0" : "=s"(z))
constexpr int CWLOFF = PCOFF + 256;
constexpr int PRMOFF = CWLOFF + 6912;
struct RwPre { u32x2 wv, av; u32x4 gv; f32x4 w4, a4, g0, g1; u32x4 rr[3], kk[3], vv[3]; };
DI void rwkv_prefetch(const Frame& F, const Args& a, const int l, const int unit, RwPre& P) {
    const int tid = F.tid;
    const int c = unit % NCH, hd = (unit / NCH) % BH, b = (unit / (NCH * BH)) % NB, dir = unit / (NCH * BH * NB);
    const bf16_t* HBp = (const bf16_t*)(F.ws + WS_HB);
    const int u = tid >> 3, jg = tid & 7, tloc = 64 * c + u; const size_t tok = (size_t)b * S + tloc;
    const bf16_t* hrow = HBp + tok * HW;
    P.wv = *(const u32x2*)(hrow + HWL + 4 * jg); P.av = *(const u32x2*)(hrow + HAL + 4 * jg); P.gv = *(const u32x4*)(hrow + HGL + 8 * jg);
    OPQZ(z0);
    { const int m = tid >> 4, j4 = (tid & 15) * 4;
      const float* w_up = a.in[8 + z0] + (size_t)l * 2 * RW * BW; const float* a_up = a.in[10 + z0] + (size_t)l * 2 * RA * BW;
      P.w4 = *(const f32x4*)(w_up + (size_t)(dir * RW + m) * BW + hd * HD + j4); P.a4 = *(const f32x4*)(a_up + (size_t)(dir * RA + m) * BW + hd * HD + j4); }
    { const int m = tid >> 3, i8 = (tid & 7) * 8; const float* g_up = a.in[11 + z0] + (size_t)l * RG * BW;
      P.g0 = *(const f32x4*)(g_up + (size_t)m * BW + hd * HD + i8); P.g1 = *(const f32x4*)(g_up + (size_t)m * BW + hd * HD + i8 + 4); }
    const int ch0 = hd * HD + 8 * jg;
#pragma unroll
    for (int x = 0; x < 3; ++x) {
        const int tt = tloc + x - 1; const u32x4 z4 = (u32x4){0u, 0u, 0u, 0u};
        if (tt >= 0 && tt < S) { const bf16_t* hp = HBp + ((size_t)b * S + tt) * HW + HR + ch0; P.rr[x] = *(const u32x4*)hp; P.kk[x] = *(const u32x4*)(hp + BW); P.vv[x] = *(const u32x4*)(hp + 2 * BW); }
        else { P.rr[x] = z4; P.kk[x] = z4; P.vv[x] = z4; }
    }
}
DI void rwkv_local_unit(const Frame& F, const Args& a, const int l, const int unit, RwPre& PF, const int next_unit) {
    LAS unsigned char* lds = F.lds;
    int tid_ = F.tid; asm volatile("" : "+v"(tid_));
    const int tid = tid_, lane = tid_ & 63, wave = F.wave;
    const int c = unit % NCH, hd = (unit / NCH) % BH, b = (unit / (NCH * BH)) % NB, dir = unit / (NCH * BH * NB);
    const bf16_t* HBp = (const bf16_t*)(F.ws + WS_HB);
    const int u = tid >> 3, jg = tid & 7, tau = dir ? 63 - u : u, tloc = 64 * c + u;
    const size_t tok = (size_t)b * S + tloc;
    const int tn = wave & 3, tm0 = 2 * (wave >> 2), g4 = lane >> 4, l15 = lane & 15;
    if (tid < 320) { OPQZ(z2); const int which = tid >> 6, j = tid & 63;
      const float* src = which == 0 ? a.in[7 + z2] + (size_t)l * 2 * BW + dir * BW : which == 1 ? a.in[9 + z2] + (size_t)l * 2 * BW + dir * BW : which == 2 ? a.in[12 + z2] + (size_t)l * BW : which == 3 ? a.in[13 + z2] + (size_t)l * BW : a.in[14 + z2] + (size_t)l * BH * HD;
      *(LAS float*)(lds + PRMOFF + tid * 4) = src[hd * HD + j]; }
    {
        const f32x4 wf = unpack4(PF.wv);
        *(LAS u32x2*)(lds + BUF(8) + tau * 144 + (4 * jg) * 2) = pack4((f32x4){fast_tanh(wf[0]), fast_tanh(wf[1]), fast_tanh(wf[2]), fast_tanh(wf[3])});
        *(LAS u32x2*)(lds + BUF(8) + tau * 144 + (32 + 4 * jg) * 2) = PF.av;
        const u32x4 gv = PF.gv;
        u32x4 so; so.x = cvtpk(sigm(bflo(gv.x)), sigm(bfhi(gv.x))); so.y = cvtpk(sigm(bflo(gv.y)), sigm(bfhi(gv.y))); so.z = cvtpk(sigm(bflo(gv.z)), sigm(bfhi(gv.z))); so.w = cvtpk(sigm(bflo(gv.w)), sigm(bfhi(gv.w)));
        *(LAS u32x4*)(lds + BUF(9) + tau * 144 + 16 * jg) = so;
        { const int m = tid >> 4, j4 = (tid & 15) * 4;
#pragma unroll
          for (int e = 0; e < 4; ++e) { st1(lds, BUF(10), j4 + e, m, PF.w4[e]); st1(lds, BUF(10), j4 + e, 32 + m, PF.a4[e]); } }
        { const int m = tid >> 3, i8 = (tid & 7) * 8;
#pragma unroll
          for (int e = 0; e < 4; ++e) { st1(lds, BUF(11), i8 + e, m, PF.g0[e]); st1(lds, BUF(11), i8 + 4 + e, m, PF.g1[e]); } }
    }
    lds_barrier();
#pragma unroll
    for (int tmi = 0; tmi < 2; ++tmi) {
        const int tm = tm0 + tmi; const f32x4 z = (f32x4){0.f, 0.f, 0.f, 0.f};
        const f32x4 zw = MFMA16(ldfrag(lds, BUF(10), 16 * tm + l15, 0, lane), ldfrag(lds, BUF(8), 16 * tn + l15, 0, lane), z);
        const f32x4 za = MFMA16(ldfrag(lds, BUF(10), 16 * tm + l15, 1, lane), ldfrag(lds, BUF(8), 16 * tn + l15, 1, lane), z);
        const int trow = 16 * tn + l15, jb = 16 * tm + 4 * g4;
        *(LAS f32x4*)(lds + LWOFF + (trow * 64 + jb) * 4) = zw;
        *(LAS f32x4*)(lds + ZAOFF + (trow * 64 + jb) * 4) = za;
        if (dir == 0) {
            const f32x4 gg = mm64(lds, BUF(11), 16 * tm, BUF(9), 16 * tn, lane);
            *(u32x2*)((bf16_t*)(F.ws + WS_GB) + ((size_t)b * S + 64 * c + trow) * BW + hd * HD + jb) = pack4(gg);
        }
    }
    lds_barrier();
    const int ch0 = hd * HD + 8 * jg;
    float r[8], kd[8], kap[8], bb[8], lw[8];
    {
        float k[8], v[8];
#pragma unroll
        for (int e = 0; e < 8; ++e) { r[e] = 0.f; k[e] = 0.f; v[e] = 0.f; }
#pragma unroll
        for (int x = 0; x < 3; ++x) {
            const LAS unsigned char* cwp = lds + CWLOFF + (((hd * 3 + x) * 3) * 64 + 8 * jg) * 2;
            const u32x4 cr = *(const LAS u32x4*)cwp, ck = *(const LAS u32x4*)(cwp + 128), cv = *(const LAS u32x4*)(cwp + 256);
            const u32x4 rr = PF.rr[x], kk2 = PF.kk[x], vv = PF.vv[x];
            r[0] += bflo(rr.x) * bflo(cr.x); r[1] += bfhi(rr.x) * bfhi(cr.x); r[2] += bflo(rr.y) * bflo(cr.y); r[3] += bfhi(rr.y) * bfhi(cr.y);
            r[4] += bflo(rr.z) * bflo(cr.z); r[5] += bfhi(rr.z) * bfhi(cr.z); r[6] += bflo(rr.w) * bflo(cr.w); r[7] += bfhi(rr.w) * bfhi(cr.w);
            k[0] += bflo(kk2.x) * bflo(ck.x); k[1] += bfhi(kk2.x) * bfhi(ck.x); k[2] += bflo(kk2.y) * bflo(ck.y); k[3] += bfhi(kk2.y) * bfhi(ck.y);
            k[4] += bflo(kk2.z) * bflo(ck.z); k[5] += bfhi(kk2.z) * bfhi(ck.z); k[6] += bflo(kk2.w) * bflo(ck.w); k[7] += bfhi(kk2.w) * bfhi(ck.w);
            v[0] += bflo(vv.x) * bflo(cv.x); v[1] += bfhi(vv.x) * bfhi(cv.x); v[2] += bflo(vv.y) * bflo(cv.y); v[3] += bfhi(vv.y) * bfhi(cv.y);
            v[4] += bflo(vv.z) * bflo(cv.z); v[5] += bfhi(vv.z) * bfhi(cv.z); v[6] += bflo(vv.w) * bflo(cv.w); v[7] += bfhi(vv.w) * bfhi(cv.w);
        }
        const f32x4 zw0 = *(const LAS f32x4*)(lds + LWOFF + (tau * 64 + 8 * jg) * 4), zw1 = *(const LAS f32x4*)(lds + LWOFF + (tau * 64 + 8 * jg + 4) * 4);
        const f32x4 za0 = *(const LAS f32x4*)(lds + ZAOFF + (tau * 64 + 8 * jg) * 4), za1 = *(const LAS f32x4*)(lds + ZAOFF + (tau * 64 + 8 * jg + 4) * 4);
        float ss = 0.f, bsp = 0.f, av[8];
        const LAS f32x4* prm = (const LAS f32x4*)(lds + PRMOFF) + 2 * jg;
        const f32x4 w0a = prm[0], w0b = prm[1], a0a = prm[16], a0b = prm[17], kka = prm[32], kkb = prm[33], kaa = prm[48], kab = prm[49], rka = prm[64], rkb = prm[65];
#pragma unroll
        for (int e = 0; e < 8; ++e) {
            const float zw = (e < 4 ? zw0[e & 3] : zw1[e & 3]) + (e < 4 ? w0a[e & 3] : w0b[e & 3]);
            const float za = (e < 4 ? za0[e & 3] : za1[e & 3]) + (e < 4 ? a0a[e & 3] : a0b[e & 3]);
            lw[e] = (-DECAY * LOG2E) * sigm(zw); av[e] = sigm(za);
            kap[e] = k[e] * (e < 4 ? kka[e & 3] : kkb[e & 3]); ss += kap[e] * kap[e];
            kd[e] = k[e] * (1.f + (av[e] - 1.f) * (e < 4 ? kaa[e & 3] : kab[e & 3]));
            bsp += r[e] * kd[e] * (e < 4 ? rka[e & 3] : rkb[e & 3]);
        }
        ss += __shfl_xor(ss, 1); ss += __shfl_xor(ss, 2); ss += __shfl_xor(ss, 4);
        bsp += __shfl_xor(bsp, 1); bsp += __shfl_xor(bsp, 2); bsp += __shfl_xor(bsp, 4);
        const float rn = __builtin_amdgcn_rsqf(fmaxf(ss, 1e-24f));
#pragma unroll
        for (int e = 0; e < 8; ++e) { kap[e] *= rn; bb[e] = kap[e] * av[e]; }
        if (jg == 0) ((float*)(F.ws + WS_BS))[((size_t)dir * T + tok) * 8 + hd] = bsp;
        *(LAS f32x4*)(lds + LWOFF + (tau * 64 + 8 * jg) * 4) = (f32x4){lw[0], lw[1], lw[2], lw[3]};
        *(LAS f32x4*)(lds + LWOFF + (tau * 64 + 8 * jg + 4) * 4) = (f32x4){lw[4], lw[5], lw[6], lw[7]};
#pragma unroll
        for (int e = 0; e < 8; ++e) st1(lds, BUF(7), 8 * jg + e, tau, v[e]);
        if (dir == 0) {
            u32x4 vo; vo.x = cvtpk(v[0], v[1]); vo.y = cvtpk(v[2], v[3]); vo.z = cvtpk(v[4], v[5]); vo.w = cvtpk(v[6], v[7]);
            *(u32x4*)((bf16_t*)(F.ws + WS_VC) + tok * BW + ch0) = vo;
        }
    }
    lds_barrier();
    if (dir == 0) {
        const size_t ucidx = ((size_t)b * BH + hd) * NCH + c; const int vi = tid >> 3, vc = tid & 7;
        *(u32x4*)((bf16_t*)(F.ws + WS_VTB) + ucidx * 4096 + vi * 64 + vc * 8) = *(const LAS u32x4*)(lds + BUF(7) + vi * 144 + vc * 16);
    }
    { const int seg = tid >> 6, j = tid & 63; float p = 0.f;
#pragma unroll
      for (int i = 0; i < 8; ++i) { LAS float* q = (LAS float*)(lds + LWOFF + ((8 * seg + i) * 64 + j) * 4); p += *q; *q = p; }
      *(LAS float*)(lds + SEGOFF + (seg * 64 + j) * 4) = p; }
    lds_barrier();
    if (tid < 64) { float run = 0.f;
#pragma unroll
      for (int sg = 0; sg < 8; ++sg) { *(LAS float*)(lds + SEGXOFF + (sg * 64 + tid) * 4) = run; run += *(const LAS float*)(lds + SEGOFF + (sg * 64 + tid) * 4); }
      *(LAS float*)(lds + TOTOFF + tid * 4) = run; }
    lds_barrier();
    {
        float At[8], Rt[8], Bt[8], Kt[8], Bh[8], Kh[8];
#pragma unroll
        for (int e = 0; e < 8; ++e) {
            const int j = 8 * jg + e;
            const float lwi = *(const LAS float*)(lds + LWOFF + (tau * 64 + j) * 4) + *(const LAS float*)(lds + SEGXOFF + ((tau >> 3) * 64 + j) * 4);
            const float tot = *(const LAS float*)(lds + TOTOFF + j * 4);
            const float ep = fexp2(lwi - lw[e]), epl = fexp2(lwi), em = fexp2(-lwi), ec = fexp2(tot - lwi);
            At[e] = -kap[e] * ep; Rt[e] = r[e] * epl; Bt[e] = bb[e] * em; Kt[e] = kd[e] * em; Bh[e] = bb[e] * ec; Kh[e] = kd[e] * ec;
            if (u == 0) *(LAS float*)(lds + PCOFF + j * 4) = fexp2(tot);
        }
        u32x4 o;
#define PK8(X) (o.x = cvtpk(X[0], X[1]), o.y = cvtpk(X[2], X[3]), o.z = cvtpk(X[4], X[5]), o.w = cvtpk(X[6], X[7]), o)
        *(LAS u32x4*)(lds + BUF(0) + tau * 144 + 16 * jg) = PK8(At);
        *(LAS u32x4*)(lds + BUF(1) + tau * 144 + 16 * jg) = PK8(Bt);
        *(LAS u32x4*)(lds + BUF(2) + tau * 144 + 16 * jg) = PK8(Kt);
        *(LAS u32x4*)(lds + BUF(3) + tau * 144 + 16 * jg) = PK8(Rt);
#undef PK8
#pragma unroll
        for (int e = 0; e < 8; ++e) { const int j = 8 * jg + e; st1(lds, BUF(4), j, tau, At[e]); st1(lds, BUF(5), j, tau, Bh[e]); st1(lds, BUF(6), j, tau, Kh[e]); }
    }
    if (next_unit >= 0) rwkv_prefetch(F, a, l, next_unit, PF);
    lds_barrier();
#pragma unroll
    for (int tmi = 0; tmi < 2; ++tmi) {
        const int tm = tm0 + tmi, mb = 16 * tm + 4 * g4, nn = 16 * tn + l15;
        { f32x4 v = mm64(lds, BUF(1), 16 * tm, BUF(0), 16 * tn, lane);
#pragma unroll
          for (int e = 0; e < 4; ++e) v[e] = (mb + e < nn) ? v[e] : 0.f;
          if (tm == tn) {
#pragma unroll
              for (int e = 0; e < 4; ++e) *(LAS float*)(lds + NABFOFF + ((16 * tm + l15) * 16 + ((mb + e) & 15)) * 4) = v[e];
              v = (f32x4){0.f, 0.f, 0.f, 0.f};
          }
          st4(lds, BUF(11), nn, mb, v); }
        { f32x4 v = mm64(lds, BUF(0), 16 * tm, BUF(2), 16 * tn, lane);
#pragma unroll
          for (int e = 0; e < 4; ++e) v[e] = (nn < mb + e) ? v[e] : 0.f;
          st4(lds, BUF(8), nn, mb, v); }
        { f32x4 v = mm64(lds, BUF(1), 16 * tm, BUF(3), 16 * tn, lane);
#pragma unroll
          for (int e = 0; e < 4; ++e) v[e] = (mb + e <= nn) ? v[e] : 0.f;
          st4(lds, BUF(9), nn, mb, v); }
        { f32x4 v = mm64(lds, BUF(2), 16 * tm, BUF(3), 16 * tn, lane);
#pragma unroll
          for (int e = 0; e < 4; ++e) v[e] = (mb + e <= nn) ? v[e] : 0.f;
          st4(lds, BUF(10), nn, mb, v); }
    }
    lds_barrier();
    if (wave == 0) {
        const int blk = lane >> 4, sr = lane & 15, s = 16 * blk + sr;
        float Tr[16];
#pragma unroll
        for (int t = 0; t < 16; ++t) { float acc = (t == sr) ? 1.f : 0.f;
            const LAS f32x4* col = (const LAS f32x4*)(lds + NABFOFF + ((16 * blk + t) * 16) * 4);
#pragma unroll
            for (int q = 0; q < (t + 3) / 4; ++q) { const f32x4 nv = col[q];
#pragma unroll
                for (int e = 0; e < 4; ++e) if (4 * q + e < t) acc += Tr[4 * q + e] * nv[e]; }
            Tr[t] = acc; __builtin_amdgcn_sched_barrier(0); }
        const u32x4 z4 = (u32x4){0u, 0u, 0u, 0u};
#pragma unroll
        for (int q = 0; q < 9; ++q) { *(LAS u32x4*)(lds + BUF(0) + s * 144 + 16 * q) = z4; *(LAS u32x4*)(lds + BUF(1) + s * 144 + 16 * q) = z4; }
        u32x4 o0, o1; o0.x = cvtpk(Tr[0], Tr[1]); o0.y = cvtpk(Tr[2], Tr[3]); o0.z = cvtpk(Tr[4], Tr[5]); o0.w = cvtpk(Tr[6], Tr[7]);
        o1.x = cvtpk(Tr[8], Tr[9]); o1.y = cvtpk(Tr[10], Tr[11]); o1.z = cvtpk(Tr[12], Tr[13]); o1.w = cvtpk(Tr[14], Tr[15]);
        LDS_WAIT();
        *(LAS u32x4*)(lds + BUF(0) + s * 144 + 32 * blk) = o0; *(LAS u32x4*)(lds + BUF(0) + s * 144 + 32 * blk + 16) = o1;
#pragma unroll
        for (int t = 0; t < 16; ++t) st1(lds, BUF(1), 16 * blk + t, s, Tr[t]);
    }
    lds_barrier();
#pragma unroll
    for (int tmi = 0; tmi < 2; ++tmi) {
        const int tm = tm0 + tmi, mb = 16 * tm + 4 * g4, nn = 16 * tn + l15;
        const f32x4 v = mm64(lds, BUF(0), 16 * tm, BUF(11), 16 * tn, lane);
        st4(lds, BUF(12), nn, mb, v);
#pragma unroll
        for (int e = 0; e < 4; ++e) st1(lds, BUF(2), mb + e, nn, v[e]);
    }
    lds_barrier();
#pragma unroll
    for (int tmi = 0; tmi < 2; ++tmi) {
        const int tm = tm0 + tmi, mb = 16 * tm + 4 * g4, nn = 16 * tn + l15;
        const f32x4 v = mm64(lds, BUF(12), 16 * tm, BUF(2), 16 * tn, lane);
        st4(lds, BUF(13), nn, mb, v);
    }
    lds_barrier();
#pragma unroll
    for (int tmi = 0; tmi < 2; ++tmi) {
        const int tm = tm0 + tmi, mb = 16 * tm + 4 * g4, nn = 16 * tn + l15;
        const f32x4 v = mm64(lds, BUF(13), 16 * tm, BUF(1), 16 * tn, lane) + ld4(lds, BUF(1), nn, mb);
        st4(lds, BUF(14), nn, mb, v);
    }
    lds_barrier();
#pragma unroll
    for (int tmi = 0; tmi < 2; ++tmi) {
        const int tm = tm0 + tmi, mb = 16 * tm + 4 * g4, nn = 16 * tn + l15;
        const f32x4 v = mm64(lds, BUF(2), 16 * tm, BUF(14), 16 * tn, lane) + ld4(lds, BUF(14), nn, mb);
        st4(lds, BUF(15), nn, mb, v);
    }
    lds_barrier();
#pragma unroll
    for (int tmi = 0; tmi < 2; ++tmi) {
        const int tm = tm0 + tmi, mb = 16 * tm + 4 * g4, nn = 16 * tn + l15;
        const f32x4 x1 = mm64(lds, BUF(15), 16 * tm, BUF(4), 16 * tn, lane);
        const f32x4 x2 = mm64(lds, BUF(15), 16 * tm, BUF(8), 16 * tn, lane);
        st4(lds, BUF(0), nn, mb, x1); st4(lds, BUF(1), nn, mb, x2);
    }
    lds_barrier();
    {
        bf16_t* QT = (bf16_t*)(F.ws + WS_QT) + (size_t)unit * 4096; bf16_t* WT = (bf16_t*)(F.ws + WS_WT) + (size_t)unit * 4096; bf16_t* MP = (bf16_t*)(F.ws + WS_MP) + (size_t)unit * 4096;
#pragma unroll
        for (int tmi = 0; tmi < 2; ++tmi) {
            const int tm = tm0 + tmi, mb = 16 * tm + 4 * g4, nn = 16 * tn + l15;
            { const f32x4 v = mm64(lds, BUF(0), 16 * tm, BUF(9), 16 * tn, lane) + ld4(lds, BUF(3), nn, mb);
              *(u32x2*)(QT + (dir ? 63 - nn : nn) * 64 + mb) = pack4(v); }
            { const f32x4 v = mm64(lds, BUF(1), 16 * tm, BUF(9), 16 * tn, lane) + ld4(lds, BUF(10), nn, mb);
              if (dir) *(u32x2*)(WT + (63 - nn) * 64 + (60 - mb)) = pack4((f32x4){v[3], v[2], v[1], v[0]});
              else *(u32x2*)(WT + nn * 64 + mb) = pack4(v); }
            { f32x4 v = mm64(lds, BUF(0), 16 * tm, BUF(5), 16 * tn, lane);
#pragma unroll
              for (int e = 0; e < 4; ++e) if (mb + e == nn) v[e] += *(const LAS float*)(lds + PCOFF + nn * 4);
              *(u32x2*)(MP + nn * 64 + swap23(mb)) = pack4(v); }
            { const f32x4 v = mm64(lds, BUF(1), 16 * tm, BUF(5), 16 * tn, lane) + ld4(lds, BUF(6), nn, mb);
              st4(lds, BUF(2), nn, mb, v); }
        }
    }
    lds_barrier();
    {
        bf16_t* NBp = (bf16_t*)(F.ws + WS_NB);
#pragma unroll
        for (int tmi = 0; tmi < 2; ++tmi) {
            const int tm = tm0 + tmi, mb = 16 * tm + 4 * g4, ii = 16 * tn + l15;
            const f32x4 v = mm64(lds, BUF(2), 16 * tm, BUF(7), 16 * tn, lane);
            const int jb = mb >> 5, jl = mb & 31, q = jl >> 3, hic = (jl >> 2) & 1, ih = ii >> 5, Lc = (ii & 31) + 32 * hic;
            *(u32x2*)(NBp + ((((size_t)unit * 2 + ih) * 2 + jb) * 2 + (q >> 1)) * 512 + Lc * 8 + 4 * (q & 1)) = pack4(v);
        }
    }
    lds_barrier();
}

DI void attn_unit(const Frame& F, const LAS float* rpbl, const int au) {
    const bf16_t* HBp = (const bf16_t*)(F.ws + WS_HB); const bf16_t* VTp = (const bf16_t*)(F.ws + WS_VT); bf16_t* CONCAT = (bf16_t*)(F.ws + WS_CONCAT);
    const int hh = au % AH, r = (au / AH) % ROWS, b = au / (AH * ROWS);
    int rstart = r - KH / 2; rstart = rstart < 0 ? 0 : (rstart > ROWS - KH ? ROWS - KH : rstart);
    const int lane = F.lane, q32 = lane & 31, hi = lane >> 5;
    const float SC = 0.125f * LOG2E;
    const int krow_off = swap23(q32);
    const int cqA = q32, cqB = 32 + q32;
    int csA = cqA - KW / 2; csA = csA < 0 ? 0 : csA; int csB = cqB - KW / 2; csB = csB > GW - KW ? GW - KW : csB;
    const size_t tokA = (size_t)b * S + r * GW + cqA, tokB = tokA + 32;
    bf16x8 qfA[4], qfB[4];
#pragma unroll
    for (int ds = 0; ds < 4; ++ds) { qfA[ds] = *(const bf16x8*)(HBp + tokA * HW + HQ + hh * HD + 16 * ds + 8 * hi); qfB[ds] = *(const bf16x8*)(HBp + tokB * HW + HQ + hh * HD + 16 * ds + 8 * hi); }
    f32x16 oA0, oA1, oB0, oB1;
#pragma unroll
    for (int i = 0; i < 16; ++i) { oA0[i] = 0.f; oA1[i] = 0.f; oB0[i] = 0.f; oB1[i] = 0.f; }
    float mA = -1e30f, lA = 0.f, mB = -1e30f, lB = 0.f;
#pragma unroll 1
    for (int kt = 0; kt < 2 * KH; ++kt) {
        const int kr = rstart + (kt >> 1), ckb = 32 * (kt & 1);
        const size_t ktok = (size_t)b * S + kr * GW + ckb;
        bf16x8 kf[4], vf[2][2];
#pragma unroll
        for (int ds = 0; ds < 4; ++ds) kf[ds] = *(const bf16x8*)(HBp + (ktok + krow_off) * HW + HK + hh * HD + 16 * ds + 8 * hi);
#pragma unroll
        for (int db = 0; db < 2; ++db)
#pragma unroll
            for (int s = 0; s < 2; ++s) vf[db][s] = *(const bf16x8*)(VTp + (size_t)(hh * HD + 32 * db + q32) * T + ktok + 16 * s + 8 * hi);
        const LAS float* rp = rpbl + (hh * (2 * KH - 1) + (kr - r + KH - 1)) * (2 * KW - 1);
#pragma unroll
        for (int qb = 0; qb < 2; ++qb) {
            const int cq = qb ? cqB : cqA, cs = qb ? csB : csA;
            f32x16 st;
#pragma unroll
            for (int i = 0; i < 16; ++i) st[i] = 0.f;
#pragma unroll
            for (int ds = 0; ds < 4; ++ds) st = MFMA32(kf[ds], qb ? qfB[ds] : qfA[ds], st);
            float sl[16]; float tmax = -1e30f;
#pragma unroll
            for (int i = 0; i < 16; ++i) {
                const int ck = ckb + 16 * (i >> 3) + 8 * hi + (i & 7);
                const bool inw = (ck >= cs) && (ck < cs + KW);
                int dc = ck - cq; dc = dc < -(KW - 1) ? -(KW - 1) : (dc > KW - 1 ? KW - 1 : dc); dc += KW - 1;
                sl[i] = inw ? st[i] * SC + rp[dc] : -1e30f;
                tmax = fmaxf(tmax, sl[i]);
            }
            tmax = fmaxf(tmax, __shfl_xor(tmax, 32));
            const float mrun = qb ? mB : mA;
            const float mn = fmaxf(mrun, tmax), corr = __builtin_amdgcn_exp2f(mrun - mn);
            float ps = 0.f;
#pragma unroll
            for (int i = 0; i < 16; ++i) { sl[i] = (sl[i] > -1e29f) ? __builtin_amdgcn_exp2f(sl[i] - mn) : 0.f; ps += sl[i]; }
            u32x4 p0, p1;
            p0.x = cvtpk(sl[0], sl[1]); p0.y = cvtpk(sl[2], sl[3]); p0.z = cvtpk(sl[4], sl[5]); p0.w = cvtpk(sl[6], sl[7]);
            p1.x = cvtpk(sl[8], sl[9]); p1.y = cvtpk(sl[10], sl[11]); p1.z = cvtpk(sl[12], sl[13]); p1.w = cvtpk(sl[14], sl[15]);
            const bf16x8 pf0 = __builtin_bit_cast(bf16x8, p0), pf1 = __builtin_bit_cast(bf16x8, p1);
            if (qb == 0) { lA = lA * corr + ps; mA = mn;
#pragma unroll
                for (int i = 0; i < 16; ++i) { oA0[i] *= corr; oA1[i] *= corr; }
                oA0 = MFMA32(vf[0][0], pf0, oA0); oA0 = MFMA32(vf[0][1], pf1, oA0); oA1 = MFMA32(vf[1][0], pf0, oA1); oA1 = MFMA32(vf[1][1], pf1, oA1);
            } else { lB = lB * corr + ps; mB = mn;
#pragma unroll
                for (int i = 0; i < 16; ++i) { oB0[i] *= corr; oB1[i] *= corr; }
                oB0 = MFMA32(vf[0][0], pf0, oB0); oB0 = MFMA32(vf[0][1], pf1, oB0); oB1 = MFMA32(vf[1][0], pf0, oB1); oB1 = MFMA32(vf[1][1], pf1, oB1);
            }
        }
    }
    { const float inv = 1.f / (lA + __shfl_xor(lA, 32)); bf16_t* op = CONCAT + tokA * D + hh * HD;
#pragma unroll
      for (int g = 0; g < 4; ++g) {
          *(u32x2*)(op + 8 * g + 4 * hi) = pack4((f32x4){oA0[4 * g] * inv, oA0[4 * g + 1] * inv, oA0[4 * g + 2] * inv, oA0[4 * g + 3] * inv});
          *(u32x2*)(op + 32 + 8 * g + 4 * hi) = pack4((f32x4){oA1[4 * g] * inv, oA1[4 * g + 1] * inv, oA1[4 * g + 2] * inv, oA1[4 * g + 3] * inv}); } }
    { const float inv = 1.f / (lB + __shfl_xor(lB, 32)); bf16_t* op = CONCAT + tokB * D + hh * HD;
#pragma unroll
      for (int g = 0; g < 4; ++g) {
          *(u32x2*)(op + 8 * g + 4 * hi) = pack4((f32x4){oB0[4 * g] * inv, oB0[4 * g + 1] * inv, oB0[4 * g + 2] * inv, oB0[4 * g + 3] * inv});
          *(u32x2*)(op + 32 + 8 * g + 4 * hi) = pack4((f32x4){oB1[4 * g] * inv, oB1[4 * g + 1] * inv, oB1[4 * g + 2] * inv, oB1[4 * g + 3] * inv}); } }
}

DI void pool_unit(const Frame& F, const float* pool_w, const float* pool_scale, const int pu) {
    const bf16_t* HBp = (const bf16_t*)(F.ws + WS_HB); bf16_t* CONCAT = (bf16_t*)(F.ws + WS_CONCAT);
    const int g = pu & 3, blk = pu >> 2, b = blk >> 8, t0 = (blk & 255) * 32;
    const int lane = F.lane, q32 = lane & 31, hi = lane >> 5, t = t0 + q32, win = 2 << g;
    int lo = t - win / 2; lo = lo < 0 ? 0 : lo; int hit = t + win / 2 - 1; hit = hit > S - 1 ? S - 1 : hit;
    const float inv = 1.f / (float)(hit - lo + 1);
    f32x16 out0, out1;
#pragma unroll
    for (int i = 0; i < 16; ++i) { out0[i] = 0.f; out1[i] = 0.f; }
    const float* pw = pool_w + (size_t)g * 64 * 64;
#pragma unroll 1
    for (int s = 0; s < 4; ++s) {
        const int c0 = HP + g * 64 + 16 * s + 8 * hi;
        float acc[8];
#pragma unroll
        for (int e = 0; e < 8; ++e) acc[e] = 0.f;
        u32x4 pv[16];
#pragma unroll
        for (int d = 0; d < 16; ++d) { int tt = t - win / 2 + d; const bool ok = d < win && tt >= 0 && tt < S; tt = ok ? tt : t;
            pv[d] = *(const u32x4*)(HBp + ((size_t)b * S + tt) * HW + c0); if (!ok) pv[d] = (u32x4){0u, 0u, 0u, 0u}; }
#pragma unroll
        for (int d = 0; d < 16; ++d) {
            acc[0] += bflo(pv[d].x); acc[1] += bfhi(pv[d].x); acc[2] += bflo(pv[d].y); acc[3] += bfhi(pv[d].y); acc[4] += bflo(pv[d].z); acc[5] += bfhi(pv[d].z); acc[6] += bflo(pv[d].w); acc[7] += bfhi(pv[d].w);
        }
        const u32x4 pc = *(const u32x4*)(HBp + ((size_t)b * S + t) * HW + c0);
        u32x4 o;
        o.x = cvtpk(acc[0] * inv - bflo(pc.x), acc[1] * inv - bfhi(pc.x)); o.y = cvtpk(acc[2] * inv - bflo(pc.y), acc[3] * inv - bfhi(pc.y));
        o.z = cvtpk(acc[4] * inv - bflo(pc.z), acc[5] * inv - bfhi(pc.z)); o.w = cvtpk(acc[6] * inv - bflo(pc.w), acc[7] * inv - bfhi(pc.w));
        const bf16x8 bfr = __builtin_bit_cast(bf16x8, o);
        const float* wp = pw + (size_t)(16 * s + 8 * hi) * 64 + q32;
        u32x4 w0; w0.x = cvtpk(wp[0], wp[64]); w0.y = cvtpk(wp[128], wp[192]); w0.z = cvtpk(wp[256], wp[320]); w0.w = cvtpk(wp[384], wp[448]);
        u32x4 w1; w1.x = cvtpk(wp[32], wp[96]); w1.y = cvtpk(wp[160], wp[224]); w1.z = cvtpk(wp[288], wp[352]); w1.w = cvtpk(wp[416], wp[480]);
        out0 = MFMA32(__builtin_bit_cast(bf16x8, w0), bfr, out0);
        out1 = MFMA32(__builtin_bit_cast(bf16x8, w1), bfr, out1);
    }
    bf16_t* op = CONCAT + ((size_t)b * S + t) * D + AW + BW + g * 64;
    const float* ps = pool_scale + g * 64;
#pragma unroll
    for (int gq = 0; gq < 4; ++gq) {
        const int e0 = 8 * gq + 4 * hi;
        const f32x4 s0 = *(const f32x4*)(ps + e0), s1 = *(const f32x4*)(ps + 32 + e0);
        *(u32x2*)(op + e0) = pack4((f32x4){out0[4 * gq] * s0[0], out0[4 * gq + 1] * s0[1], out0[4 * gq + 2] * s0[2], out0[4 * gq + 3] * s0[3]});
        *(u32x2*)(op + 32 + e0) = pack4((f32x4){out1[4 * gq] * s1[0], out1[4 * gq + 1] * s1[1], out1[4 * gq + 2] * s1[2], out1[4 * gq + 3] * s1[3]});
    }
}

constexpr int SCAN_SLOT = 12288, SCAN_RING = 12;
constexpr int SCAN_FLAGS = SCAN_RING * SCAN_SLOT;
DI void scan_issue(const Frame& F, const int sc, const int ihalf, const int dir, const int step, const int lane) {
    const int c = dir ? NCH - 1 - step : step; const size_t unit = (size_t)sc * NCH + c;
    const int il = lane & 31, hi = lane >> 5;
    LAS unsigned char* slot = F.lds + (step % SCAN_RING) * SCAN_SLOT;
    const bf16_t* MP = (const bf16_t*)(F.ws + WS_MP) + unit * 4096; const bf16_t* NBp = (const bf16_t*)(F.ws + WS_NB) + (unit * 2 + ihalf) * 2048;
#pragma unroll
    for (int p = 0; p < 8; ++p) { const int jpb = p >> 2, jb = (p >> 1) & 1, s = p & 1;
        __builtin_amdgcn_global_load_lds((const unsigned*)(MP + (32 * jpb + il) * 64 + 32 * jb + 16 * s + 8 * hi), (LAS unsigned*)(slot + p * 1024), 16, 0, 0); }
#pragma unroll
    for (int p = 0; p < 4; ++p)
        __builtin_amdgcn_global_load_lds((const unsigned*)(NBp + p * 512 + lane * 8), (LAS unsigned*)(slot + 8192 + p * 1024), 16, 0, 0);
}
DI unsigned lds_ld_u32(const volatile LAS unsigned* p) { return __builtin_amdgcn_readfirstlane(*p); }
DI void scan_loader(const Frame& F, const int sw, const int ld) {
    const int ihalf = sw & 1, sc = sw >> 1, dir = sc / (NB * BH);
    volatile LAS unsigned* ready = (volatile LAS unsigned*)(F.lds + SCAN_FLAGS); volatile LAS unsigned* cons = ready + 16;
    const int nmine = NCH / 2;
    for (int k = 0; k < nmine + 5; ++k) {
        if (k < nmine) {
            const int s = 2 * k + ld;
            if (s >= SCAN_RING) { unsigned spins = 0; while ((int)lds_ld_u32(cons) < s - SCAN_RING + 1) { __builtin_amdgcn_s_sleep(1); if (++spins > (1u << 22)) break; } }
            asm volatile("" ::: "memory");
            scan_issue(F, sc, ihalf, dir, s, F.lane);
        }
        if (k >= 4) {
            const int kd = k - 4;
            if (kd < nmine) {
                const int rem = nmine - 1 - kd;
                if (rem >= 4) asm volatile("s_waitcnt vmcnt(48)" ::: "memory");
                else if (rem == 3) asm volatile("s_waitcnt vmcnt(36)" ::: "memory");
                else if (rem == 2) asm volatile("s_waitcnt vmcnt(24)" ::: "memory");
                else if (rem == 1) asm volatile("s_waitcnt vmcnt(12)" ::: "memory");
                else asm volatile("s_waitcnt vmcnt(0)" ::: "memory");
                const int sd = 2 * kd + ld;
                if (F.lane == 0) ready[sd % SCAN_RING] = (unsigned)(sd + 1);
                asm volatile("s_waitcnt lgkmcnt(0)" ::: "memory");
            }
        }
    }
}
DI void scan_wave(const Frame& F, const int sw) {
    const int ihalf = sw & 1, sc = sw >> 1, dir = sc / (NB * BH);
    const int lane = F.lane, il = lane & 31, hi = lane >> 5;
    bf16_t* S0 = (bf16_t*)(F.ws + WS_S0);
    volatile LAS unsigned* ready = (volatile LAS unsigned*)(F.lds + SCAN_FLAGS); volatile LAS unsigned* cons = ready + 16;
    f32x16 st0, st1;
#pragma unroll
    for (int i = 0; i < 16; ++i) { st0[i] = 0.f; st1[i] = 0.f; }
    bf16x8 ma[8], man[8]; u32x4 nbv[4], nbn[4];
    { unsigned spins = 0; while (lds_ld_u32(ready) != 1u) { __builtin_amdgcn_s_sleep(1); if (++spins > (1u << 22)) break; } }
    asm volatile("" ::: "memory");
#pragma unroll
    for (int p = 0; p < 8; ++p) ma[p] = *(const LAS bf16x8*)(F.lds + p * 1024 + lane * 16);
#pragma unroll
    for (int p = 0; p < 4; ++p) nbv[p] = *(const LAS u32x4*)(F.lds + 8192 + p * 1024 + lane * 16);
#pragma unroll 1
    for (int step = 0; step < NCH; ++step) {
        const int c = dir ? NCH - 1 - step : step; const size_t unit = (size_t)sc * NCH + c;
        const bool more = step + 1 < NCH;
        if (more) {
            { unsigned spins = 0; while (lds_ld_u32(ready + ((step + 1) % SCAN_RING)) != (unsigned)(step + 2)) { __builtin_amdgcn_s_sleep(1); if (++spins > (1u << 22)) break; } }
            asm volatile("" ::: "memory");
            const LAS unsigned char* slot = F.lds + ((step + 1) % SCAN_RING) * SCAN_SLOT;
#pragma unroll
            for (int p = 0; p < 8; ++p) man[p] = *(const LAS bf16x8*)(slot + p * 1024 + lane * 16);
#pragma unroll
            for (int p = 0; p < 4; ++p) nbn[p] = *(const LAS u32x4*)(slot + 8192 + p * 1024 + lane * 16);
        }
        bf16_t* sp = S0 + unit * 4096 + (size_t)(32 * ihalf + il) * 64;
        u32x4 b00, b01, b10, b11;
        b00.x = cvtpk(st0[0], st0[1]); b00.y = cvtpk(st0[2], st0[3]); b00.z = cvtpk(st0[4], st0[5]); b00.w = cvtpk(st0[6], st0[7]);
        b01.x = cvtpk(st0[8], st0[9]); b01.y = cvtpk(st0[10], st0[11]); b01.z = cvtpk(st0[12], st0[13]); b01.w = cvtpk(st0[14], st0[15]);
        b10.x = cvtpk(st1[0], st1[1]); b10.y = cvtpk(st1[2], st1[3]); b10.z = cvtpk(st1[4], st1[5]); b10.w = cvtpk(st1[6], st1[7]);
        b11.x = cvtpk(st1[8], st1[9]); b11.y = cvtpk(st1[10], st1[11]); b11.z = cvtpk(st1[12], st1[13]); b11.w = cvtpk(st1[14], st1[15]);
        *(u32x2*)(sp + 0 + 4 * hi) = (u32x2){b00.x, b00.y};  *(u32x2*)(sp + 8 + 4 * hi) = (u32x2){b00.z, b00.w};
        *(u32x2*)(sp + 16 + 4 * hi) = (u32x2){b01.x, b01.y}; *(u32x2*)(sp + 24 + 4 * hi) = (u32x2){b01.z, b01.w};
        *(u32x2*)(sp + 32 + 4 * hi) = (u32x2){b10.x, b10.y}; *(u32x2*)(sp + 40 + 4 * hi) = (u32x2){b10.z, b10.w};
        *(u32x2*)(sp + 48 + 4 * hi) = (u32x2){b11.x, b11.y}; *(u32x2*)(sp + 56 + 4 * hi) = (u32x2){b11.z, b11.w};
        const bf16x8 p00 = __builtin_bit_cast(bf16x8, b00), p01 = __builtin_bit_cast(bf16x8, b01), p10 = __builtin_bit_cast(bf16x8, b10), p11 = __builtin_bit_cast(bf16x8, b11);
        f32x16 n0, n1;
#pragma unroll
        for (int h2 = 0; h2 < 2; ++h2) {
            n0[8 * h2 + 0] = bflo(nbv[h2].x); n0[8 * h2 + 1] = bfhi(nbv[h2].x); n0[8 * h2 + 2] = bflo(nbv[h2].y); n0[8 * h2 + 3] = bfhi(nbv[h2].y);
            n0[8 * h2 + 4] = bflo(nbv[h2].z); n0[8 * h2 + 5] = bfhi(nbv[h2].z); n0[8 * h2 + 6] = bflo(nbv[h2].w); n0[8 * h2 + 7] = bfhi(nbv[h2].w);
            n1[8 * h2 + 0] = bflo(nbv[2 + h2].x); n1[8 * h2 + 1] = bfhi(nbv[2 + h2].x); n1[8 * h2 + 2] = bflo(nbv[2 + h2].y); n1[8 * h2 + 3] = bfhi(nbv[2 + h2].y);
            n1[8 * h2 + 4] = bflo(nbv[2 + h2].z); n1[8 * h2 + 5] = bfhi(nbv[2 + h2].z); n1[8 * h2 + 6] = bflo(nbv[2 + h2].w); n1[8 * h2 + 7] = bfhi(nbv[2 + h2].w);
        }
        n0 = MFMA32(ma[0], p00, n0); n1 = MFMA32(ma[4], p00, n1);
        n0 = MFMA32(ma[1], p01, n0); n1 = MFMA32(ma[5], p01, n1);
        n0 = MFMA32(ma[2], p10, n0); n1 = MFMA32(ma[6], p10, n1);
        n0 = MFMA32(ma[3], p11, n0); n1 = MFMA32(ma[7], p11, n1);
        st0 = n0; st1 = n1;
        if (more) {
            asm volatile("s_waitcnt lgkmcnt(0)" ::: "memory");
            if (lane == 0) *cons = (unsigned)(step + 2);
#pragma unroll
            for (int p = 0; p < 8; ++p) ma[p] = man[p];
#pragma unroll
            for (int p = 0; p < 4; ++p) nbv[p] = nbn[p];
        }
    }
}

DI void rwkv_out_unit(const Frame& F, const RwP& P, const int du) {
    const int qd = du & 3, cidx = du >> 2, c = cidx % NCH, hd = (cidx / NCH) % BH, b = cidx / (NCH * BH);
    const int lane = F.lane, n = lane & 15, g = lane >> 4, u = 16 * qd + n;
    const bf16_t* QT = (const bf16_t*)(F.ws + WS_QT); const bf16_t* WT = (const bf16_t*)(F.ws + WS_WT); const bf16_t* S0 = (const bf16_t*)(F.ws + WS_S0);
    const bf16_t* VTB = (const bf16_t*)(F.ws + WS_VTB) + (size_t)cidx * 4096;
    f32x4 acc[4];
#pragma unroll
    for (int tm = 0; tm < 4; ++tm) acc[tm] = (f32x4){0.f, 0.f, 0.f, 0.f};
#pragma unroll
    for (int dir = 0; dir < 2; ++dir) {
        const size_t unit = (((size_t)dir * NB + b) * BH + hd) * NCH + c;
#pragma unroll
        for (int ks = 0; ks < 2; ++ks) {
            const bf16x8 bq = *(const bf16x8*)(QT + unit * 4096 + u * 64 + 32 * ks + 8 * g);
            const bf16x8 bw = *(const bf16x8*)(WT + unit * 4096 + u * 64 + 32 * ks + 8 * g);
#pragma unroll
            for (int tm = 0; tm < 4; ++tm) {
                const bf16x8 as = *(const bf16x8*)(S0 + unit * 4096 + (16 * tm + n) * 64 + 32 * ks + 8 * g);
                const bf16x8 av = *(const bf16x8*)(VTB + (16 * tm + n) * 64 + 32 * ks + 8 * g);
                acc[tm] = MFMA16(as, bq, acc[tm]); acc[tm] = MFMA16(av, bw, acc[tm]);
            }
        }
    }
    float s = 0.f;
#pragma unroll
    for (int tm = 0; tm < 4; ++tm) s += (acc[tm][0] + acc[tm][1]) + (acc[tm][2] + acc[tm][3]);
    s += __shfl_xor(s, 16); s += __shfl_xor(s, 32);
    const float mu = s * (1.f / HD); float q = 0.f;
#pragma unroll
    for (int tm = 0; tm < 4; ++tm) { acc[tm] = acc[tm] - mu; q += (acc[tm][0] * acc[tm][0] + acc[tm][1] * acc[tm][1]) + (acc[tm][2] * acc[tm][2] + acc[tm][3] * acc[tm][3]); }
    q += __shfl_xor(q, 16); q += __shfl_xor(q, 32);
    const float rstd = 1.f / sqrtf(q * (1.f / HD) + GN_EPS);
    const size_t tok = (size_t)b * S + 64 * c + u;
    const float* BS = (const float*)(F.ws + WS_BS);
    const float bsum = BS[tok * 8 + hd] + BS[((size_t)T + tok) * 8 + hd];
    const bf16_t* VC = (const bf16_t*)(F.ws + WS_VC) + tok * BW + hd * HD; const bf16_t* GBp = (const bf16_t*)(F.ws + WS_GB) + tok * BW + hd * HD;
    bf16_t* op = (bf16_t*)(F.ws + WS_CONCAT) + tok * D + AW + hd * HD;
#pragma unroll
    for (int tm = 0; tm < 4; ++tm) {
        const int i0 = 16 * tm + 4 * g;
        const f32x4 vv = unpack4(*(const u32x2*)(VC + i0)), gg = unpack4(*(const u32x2*)(GBp + i0));
        const f32x4 gn = *(const f32x4*)(P.gn_gain + hd * HD + i0), gb = *(const f32x4*)(P.gn_bias + hd * HD + i0);
        *(u32x2*)(op + i0) = pack4((acc[tm] * rstd * gn + gb + vv * bsum) * gg);
    }
}

DI RwP make_rwp(const Args& a, int l) {
    RwP p;
    p.conv = a.in[6] + (size_t)l * 3 * 3 * BW; p.w0 = a.in[7] + (size_t)l * 2 * BW; p.w_up = a.in[8] + (size_t)l * 2 * RW * BW;
    p.a0 = a.in[9] + (size_t)l * 2 * BW; p.a_up = a.in[10] + (size_t)l * 2 * RA * BW; p.g_up = a.in[11] + (size_t)l * RG * BW;
    p.k_k = a.in[12] + (size_t)l * BW; p.k_a = a.in[13] + (size_t)l * BW; p.r_k = a.in[14] + (size_t)l * BH * HD;
    p.gn_gain = a.in[15] + (size_t)l * BW; p.gn_bias = a.in[16] + (size_t)l * BW;
    return p;
}
DI void p_gemm1(const Frame& F, int l) {
    pg8::Gemm1Order S; S.U = (const bf16_t*)(F.ws + WS_U); S.Win = (const bf16_t*)(F.ws + WS_WIN + (size_t)l * WIN_LAYER); S.Wv = S.Win + (size_t)HW * D; S.G = F.G; S.c = F.bx;
    pg8::EpiStore E{(bf16_t*)(F.ws + WS_HB), HW, (bf16_t*)(F.ws + WS_VT), T};
    pg8::gemm_phase(F.lds, F.tid, D, S, E);
}
DI void p_mixer_local(const Frame& F, const Args& a, int l) {
    {
      const float* conv = a.in[6] + (size_t)l * 3 * 3 * BW;
#pragma unroll 7
      for (int i = F.tid; i < BH * 9 * 64; i += NTHREADS) { const int j = i & 63, q = i >> 6, which = q % 3, x = (q / 3) % 3, hd = q / 9;
          *(LAS bf16_t*)(F.lds + CWLOFF + i * 2) = f2bf(conv[x * 3 * BW + which * BW + hd * HD + j]); }
      RwPre PF;
      if (F.bx < NUNIT) rwkv_prefetch(F, a, l, F.bx, PF);
      __syncthreads();
      for (int unit = F.bx; unit < NUNIT; unit += F.G) rwkv_local_unit(F, a, l, unit, PF, unit + F.G < NUNIT ? unit + F.G : -1);
    }
    LAS float* rpbl = (LAS float*)F.lds;
    const float* rpb = a.in[5] + (size_t)l * AH * (2 * KH - 1) * (2 * KW - 1);
#pragma unroll 6
    for (int i = F.tid; i < AH * (2 * KH - 1) * (2 * KW - 1); i += NTHREADS) rpbl[i] = rpb[i] * LOG2E;
    __syncthreads();
    for (int au = F.gw; au < NB * ROWS * AH; au += F.ngw) attn_unit(F, rpbl, au);
#ifdef DBL_ATTN
    for (int au = F.gw; au < NB * ROWS * AH; au += F.ngw) attn_unit(F, rpbl, au);
#endif
    for (int pu = F.gw; pu < NB * (S / 32) * 4; pu += F.ngw) pool_unit(F, a.in[17] + (size_t)l * NG * 64 * 64, a.in[18] + (size_t)l * CW, pu);
}
DI void p_scan(const Frame& F, const Args& a, int l) {
    constexpr int NSCAN = 2 * 2 * NB * BH;
    if (F.bx < NSCAN) {
        volatile LAS unsigned* fl = (volatile LAS unsigned*)(F.lds + SCAN_FLAGS);
        if (F.tid < 32) fl[F.tid] = 0u;
        __syncthreads();
        if (F.wave == 0) scan_wave(F, F.bx); else if (F.wave <= 2) scan_loader(F, F.bx, F.wave - 1);
        return;
    }
#if TESTMODE != 2
    LAS float* scr = (LAS float*)F.lds + F.wave * (64 * 65);
#ifdef DBL_CONV
    for (int rep = 0; rep < 2; ++rep)
#endif
    { f32x4 cur[16], nxt[16]; const int st = (F.G - NSCAN) * NWAVES; int it = (F.bx - NSCAN) * NWAVES + F.wave; TItem tc{}, tn{};
      if (it < IT_MOE) { tc = moe_item(F, a.in[28], a.in[29], a.in[30], l, it); titem_load(tc, cur, F.lane); }
      for (; it < IT_MOE; it += st) {
          const bool more = it + st < IT_MOE;
          if (more) { tn = moe_item(F, a.in[28], a.in[29], a.in[30], l, it + st); titem_load(tn, nxt, F.lane); }
          titem_store(tc, cur, scr, F.lane);
          if (more) { tc = tn;
#pragma unroll
              for (int i = 0; i < 16; ++i) cur[i] = nxt[i]; }
      } }
#endif
}
DI void p_rwkv_out(const Frame& F, const Args& a, int l) {
    const RwP P = make_rwp(a, l);
    for (int du = F.gw; du < NB * BH * NCH * 4; du += F.ngw) rwkv_out_unit(F, P, du);
}
DI void p_gemm2(const Frame& F, int l) {
    pg8::PlainOrder S; S.init((const bf16_t*)(F.ws + WS_CONCAT), (const bf16_t*)(F.ws + WS_WOUT) + (size_t)l * D * D, T, D, D, F.G, F.bx);
    pg8::EpiStore E{(bf16_t*)(F.ws + WS_MIX), D, nullptr, 0};
    pg8::gemm_phase(F.lds, F.tid, D, S, E);
}
DI void p_moe_a(const Frame& F, int l) {
    LAS int* tb = (LAS int*)(F.lds + LDS_MISC);
    build_tables(F, l, tb);
    pg8::GroupedOrderT<true> S; S.rowtok = (const int*)(F.ws + WS_CTL + WS_SLOTTOK); S.A = (const bf16_t*)(F.ws + WS_U); S.Bt = (const bf16_t*)(F.ws + WS_WGU); S.K = D; S.estride = (size_t)D * D; S.tile_e = tb + 66; S.ntiles = tb[65]; S.nwg = S.ntiles * 4; S.G = F.G; S.c = F.bx;
    pg8::EpiSwiGlu E{(bf16_t*)(F.ws + WS_HM)};
    pg8::gemm_phase(F.lds, F.tid, D, S, E);
}
DI void p_moe_b(const Frame& F, int l) {
    LAS int* tb = (LAS int*)(F.lds + LDS_MISC);
    build_tables(F, l, tb);
    pg8::GroupedOrderT<false> S; S.rowtok = nullptr; S.A = (const bf16_t*)(F.ws + WS_HM); S.Bt = (const bf16_t*)(F.ws + WS_WD); S.K = DE; S.estride = (size_t)D * DE; S.tile_e = tb + 66; S.ntiles = tb[65]; S.nwg = S.ntiles * 4; S.G = F.G; S.c = F.bx;
    pg8::EpiRowScale E{(bf16_t*)(F.ws + WS_YS), (const float*)(F.ws + WS_SLOTW)};
    pg8::gemm_phase(F.lds, F.tid, DE, S, E);
}

#ifndef DBLMASK
#define DBLMASK 0
#endif
constexpr int PH_PER_LAYER = 10, N_PHASES = 2 + L * PH_PER_LAYER;
DI bool in_ph(int k, int lo, int hi) { lo = __builtin_amdgcn_readfirstlane(lo); hi = __builtin_amdgcn_readfirstlane(hi); asm volatile("" : "+s"(lo), "+s"(hi)); return lo <= k && k < hi; }
DI Frame fresh(const Frame& F0) {
    Frame F = F0; int t = F0.tid, b = F0.bx;
    b = __builtin_amdgcn_readfirstlane(b); asm volatile("" : "+v"(t)); asm volatile("" : "+s"(b));
    F.tid = t; F.lane = t & 63; F.wave = __builtin_amdgcn_readfirstlane(t >> 6); F.bx = b;
    F.vcu = (F.G % 8 == 0) ? (b % 8) * (F.G / 8) + b / 8 : b; F.gw = F.vcu * NWAVES + F.wave;
    return F;
}

__global__ void __launch_bounds__(NTHREADS, 2) mk_fwd(Args a) {
    extern __shared__ __attribute__((aligned(16))) unsigned char lds_raw[];
    Frame F;
    F.lds = (LAS unsigned char*)lds_raw;
    F.tid = threadIdx.x; F.lane = F.tid & 63; F.wave = __builtin_amdgcn_readfirstlane(F.tid >> 6);
    F.G = gridDim.x; F.bx = blockIdx.x; { const int bx = blockIdx.x; F.vcu = (F.G % 8 == 0) ? (bx % 8) * (F.G / 8) + bx / 8 : bx; }
    F.gw = F.vcu * NWAVES + F.wave; F.ngw = F.G * NWAVES; F.ws = a.ws;
    volatile LAS unsigned* bst = (volatile LAS unsigned*)(F.lds + LDS_BARST);
    if (F.tid < 16) bst[F.tid] = 0u;
    __syncthreads();
    cg::grid_group grid = cg::this_grid();
    XcdBarrier bar; bar.bar = (unsigned*)(a.ws + WS_CTL) + CW_BAR; bar.x = 0; bar.st = bst;
    const bool multi = (a.ph_hi - a.ph_lo) > 1;
    if (multi && !a.use_cg) bar = xcd_barrier_post((unsigned*)(a.ws + WS_CTL) + CW_BAR, bst);
    const int lo = a.ph_lo, hi = a.ph_hi;
#define IN(k) in_ph((k), lo, hi)
#ifndef DBLSEAM
#define DBLSEAM 0
#endif
#define SEAM(k) do { if (IN(k) && IN((k) + 1)) { if (a.use_cg) grid.sync(); else { xcd_barrier(bar); if (DBLSEAM) xcd_barrier(bar); } } } while (0)
    if (IN(0)) { p0_prologue(fresh(F), a); if ((DBLMASK >> 11) & 1) p0_prologue(fresh(F), a); }
    SEAM(0);
    if (IN(1)) { p_r0(fresh(F), a.in[0]); if ((DBLMASK >> 12) & 1) p_r0(fresh(F), a.in[0]); }
    SEAM(1);
#define RUN(k, call) do { if (IN(pb + (k))) { call; if ((DBLMASK >> (k)) & 1) { call; } } } while (0)
#define LAYER(l) do { \
        const int pb = 2 + PH_PER_LAYER * (l); \
        RUN(0, p_gemm1(fresh(F), (l))); \
        SEAM(pb + 0); \
        RUN(1, p_mixer_local(fresh(F), a, (l))); \
        SEAM(pb + 1); \
        RUN(2, p_scan(fresh(F), a, (l))); \
        SEAM(pb + 2); \
        RUN(3, p_rwkv_out(fresh(F), a, (l))); \
        SEAM(pb + 3); \
        RUN(4, p_gemm2(fresh(F), (l))); \
        SEAM(pb + 4); \
        RUN(5, p_rowpass1(fresh(F), a, (l), (l) == 0 ? a.in[0] : a.out)); \
        if (IN(pb + 5) && ((DBLMASK >> 10) & 1)) p_rowpass1(fresh(F), a, (l), (l) == 0 ? a.in[0] : a.out, true); \
        SEAM(pb + 5); \
        RUN(6, p_gather(fresh(F), (l))); \
        SEAM(pb + 6); \
        RUN(7, p_moe_a(fresh(F), (l))); \
        SEAM(pb + 7); \
        RUN(8, p_moe_b(fresh(F), (l))); \
        SEAM(pb + 8); \
        RUN(9, p_rowpass2(fresh(F), a, (l), a.out)); \
        SEAM(pb + 9); \
    } while (0)
    LAYER(0);
    LAYER(1);
#undef LAYER
#undef IN
#undef SEAM
}

#ifndef MK_MODE
#define MK_MODE 0
#endif
#ifndef TESTMODE
#define TESTMODE 0
#endif

static void fill_args(Args& a, void* const* d_in, void* d_out, void* d_ws) {
    for (int i = 0; i < 31; ++i) a.in[i] = (const float*)d_in[i];
    a.out = (float*)d_out; a.ws = (unsigned char*)d_ws; a.ph_lo = 0; a.ph_hi = N_PHASES; a.use_cg = 0; a.pad = 0;
}
static void launch_phases(Args a, int lo, int hi, hipStream_t stream) {
    for (int p = lo; p < hi; ++p) { a.ph_lo = p; a.ph_hi = p + 1; hipLaunchKernelGGL(mk_fwd, dim3(256), dim3(NTHREADS), LDS_BYTES, stream, a); }
}

#if TESTMODE == 0
extern "C" void kernel_launch(void* const* d_in, const int* in_sizes, int n_in, void* d_out, int out_size, void* d_ws, size_t ws_size, hipStream_t stream) {
    static int grid = 0;
    if (grid == 0) {
        int dev = 0, cus = 0, per_cu = 0;
        (void)hipGetDevice(&dev); (void)hipDeviceGetAttribute(&cus, hipDeviceAttributeMultiprocessorCount, dev);
        (void)hipFuncSetAttribute((const void*)mk_fwd, hipFuncAttributeMaxDynamicSharedMemorySize, LDS_BYTES);
        (void)hipOccupancyMaxActiveBlocksPerMultiprocessor(&per_cu, (const void*)mk_fwd, NTHREADS, LDS_BYTES);
        (void)hipGetLastError();
        grid = (cus > 0 ? cus : 256) * 1;
        if (ws_size < WS_END || n_in != 31) grid = -1;
    }
    if (grid < 0) return;
    (void)hipMemsetAsync((char*)d_ws + WS_CTL, 0, CTL_BYTES, stream);
    Args a{}; fill_args(a, d_in, d_out, d_ws);
#if MK_MODE == 2
    launch_phases(a, 0, N_PHASES, stream);
#else
    a.use_cg = (MK_MODE == 1) ? 1 : 0;
    void* args[] = {&a};
    (void)hipLaunchCooperativeKernel((const void*)mk_fwd, dim3(grid), dim3(NTHREADS), args, LDS_BYTES, stream);
#endif
}
#endif

#if TESTMODE > 0
constexpr int O_A = 1152, O_B = 2304, O_W = 2336, O_AL = 2368, O_G = 2432;
struct HSrc { const bf16_t* HB; const bf16_t* VT;
    DI float at(size_t tok, int n) const { if (n < 768) return bf2f(HB[tok * HW + n]); if (n < 1152) return bf2f(VT[(size_t)(n - 768) * T + tok]); return bf2f(HB[tok * HW + n - 384]); } };
DI float sigm_n(float x) { return 1.f / (1.f + expf(-x)); }

__global__ void k_mod_n(const float* __restrict__ c, const float* __restrict__ w_mod, const float* __restrict__ b_mod, float* __restrict__ mod) {
    __shared__ float sc[NB * D];
    for (int i = threadIdx.x; i < NB * D; i += blockDim.x) { float v = c[i]; sc[i] = v * sigm_n(v); }
    __syncthreads();
    int idx = blockIdx.x * blockDim.x + threadIdx.x; int l = idx / MODW, n = idx % MODW;
    const float* w = w_mod + (size_t)l * D * MODW + n; float a0 = 0.f, a1 = 0.f;
    for (int k = 0; k < D; ++k) { float wv = w[(size_t)k * MODW]; a0 += sc[k] * wv; a1 += sc[D + k] * wv; }
    float bb = b_mod[l * MODW + n];
    mod[(size_t)(l * NB + 0) * MODW + n] = a0 + bb; mod[(size_t)(l * NB + 1) * MODW + n] = a1 + bb;
}
__global__ void k_ln_mod_n(const float* __restrict__ xin, const float* __restrict__ modl, int off_sh, int off_sc, float* __restrict__ uout) {
    int row = (blockIdx.x * blockDim.x + threadIdx.x) >> 6, lane = threadIdx.x & 63; if (row >= T) return; int b = row / S;
    f32x4 v[4];
#pragma unroll
    for (int j = 0; j < 4; ++j) v[j] = *(const f32x4*)(xin + (size_t)row * D + 4 * lane + 256 * j);
    float mean, rstd; row_ln(v, mean, rstd);
    const float* md = modl + (size_t)b * MODW;
#pragma unroll
    for (int j = 0; j < 4; ++j) { int col = 4 * lane + 256 * j; *(f32x4*)(uout + (size_t)row * D + col) = v[j] * rstd * (1.f + *(const f32x4*)(md + off_sc + col)) + *(const f32x4*)(md + off_sh + col); }
}
__global__ void k_post_n(const float* xin, const float* br, const float* __restrict__ modl, int off_gate, const float* __restrict__ gain, const float* __restrict__ bias, float* xout, float* u2out, int off_sh2, int off_sc2) {
    int row = (blockIdx.x * blockDim.x + threadIdx.x) >> 6, lane = threadIdx.x & 63; if (row >= T) return; int b = row / S;
    const float* md = modl + (size_t)b * MODW; f32x4 v[4];
#pragma unroll
    for (int j = 0; j < 4; ++j) { int col = 4 * lane + 256 * j; v[j] = *(const f32x4*)(xin + (size_t)row * D + col) * ALPHA + *(const f32x4*)(md + off_gate + col) * *(const f32x4*)(br + (size_t)row * D + col); }
    float mean, rstd; row_ln(v, mean, rstd);
#pragma unroll
    for (int j = 0; j < 4; ++j) { int col = 4 * lane + 256 * j; v[j] = v[j] * rstd * *(const f32x4*)(gain + col) + *(const f32x4*)(bias + col); *(f32x4*)(xout + (size_t)row * D + col) = v[j]; }
    if (u2out == nullptr) return;
    row_ln(v, mean, rstd);
#pragma unroll
    for (int j = 0; j < 4; ++j) { int col = 4 * lane + 256 * j; *(f32x4*)(u2out + (size_t)row * D + col) = v[j] * rstd * (1.f + *(const f32x4*)(md + off_sc2 + col)) + *(const f32x4*)(md + off_sh2 + col); }
}
__global__ void __launch_bounds__(256) k_gemm_f32(const float* __restrict__ A, int lda, const float* __restrict__ B, int ldb, float* __restrict__ C, int ldc, int K) {
    __shared__ float As[16][65]; __shared__ float Bs[16][64];
    const int tx = threadIdx.x & 15, ty = threadIdx.x >> 4; const int m0 = blockIdx.y * 64, n0 = blockIdx.x * 64;
    float acc[4][4];
#pragma unroll
    for (int i = 0; i < 4; ++i)
#pragma unroll
        for (int j = 0; j < 4; ++j) acc[i][j] = 0.f;
    for (int k0 = 0; k0 < K; k0 += 16) {
#pragma unroll
        for (int i = 0; i < 4; ++i) { int e = threadIdx.x + 256 * i; int m = e >> 4, k = e & 15; As[k][m] = A[(size_t)(m0 + m) * lda + k0 + k]; }
#pragma unroll
        for (int i = 0; i < 4; ++i) { int e = threadIdx.x + 256 * i; int k = e >> 6, n = e & 63; Bs[k][n] = B[(size_t)(k0 + k) * ldb + n0 + n]; }
        __syncthreads();
#pragma unroll
        for (int k = 0; k < 16; ++k) { float a[4], b[4];
#pragma unroll
            for (int i = 0; i < 4; ++i) { a[i] = As[k][ty * 4 + i]; b[i] = Bs[k][tx * 4 + i]; }
#pragma unroll
            for (int i = 0; i < 4; ++i)
#pragma unroll
                for (int j = 0; j < 4; ++j) acc[i][j] += a[i] * b[j]; }
        __syncthreads();
    }
#pragma unroll
    for (int i = 0; i < 4; ++i) *(float4*)(C + (size_t)(m0 + ty * 4 + i) * ldc + n0 + tx * 4) = make_float4(acc[i][0], acc[i][1], acc[i][2], acc[i][3]);
}
__global__ void __launch_bounds__(64) k_attn_n(HSrc h, const float* __restrict__ rpb, float* __restrict__ concat) {
    int idx = blockIdx.x * blockDim.x + threadIdx.x; if (idx >= T * AH) return;
    int head = idx % AH, tok = idx / AH; int b = tok / S, t = tok % S, r = t / GW, cq = t % GW;
    int rstart = r - KH / 2; rstart = rstart < 0 ? 0 : (rstart > ROWS - KH ? ROWS - KH : rstart);
    int cstart = cq - KW / 2; cstart = cstart < 0 ? 0 : (cstart > GW - KW ? GW - KW : cstart);
    float q[HD], acc[HD];
#pragma unroll
    for (int d = 0; d < HD; ++d) { q[d] = h.at(tok, head * HD + d); acc[d] = 0.f; }
    float m = -1e30f, l = 0.f; const float* rp = rpb + (size_t)head * 15 * 31;
    for (int kk = 0; kk < KH; ++kk) { int kr = rstart + kk; int dr = kr - r + (KH - 1);
        for (int j = 0; j < KW; ++j) { int ck = cstart + j; int dc = ck - cq; dc = dc < -15 ? -15 : (dc > 15 ? 15 : dc); dc += 15;
            size_t kt = (size_t)b * S + kr * GW + ck; float s = 0.f;
#pragma unroll
            for (int d = 0; d < HD; ++d) s += q[d] * h.at(kt, AW + head * HD + d);
            s = s * 0.125f + rp[dr * 31 + dc];
            float mn = fmaxf(m, s); float corr = expf(m - mn); float p = expf(s - mn); l = l * corr + p;
#pragma unroll
            for (int d = 0; d < HD; ++d) acc[d] = acc[d] * corr + p * h.at(kt, 2 * AW + head * HD + d);
            m = mn; } }
    float inv = 1.f / l;
#pragma unroll
    for (int d = 0; d < HD; ++d) concat[(size_t)tok * D + head * HD + d] = acc[d] * inv;
}
__global__ void __launch_bounds__(256) k_pool_n(HSrc h, const float* __restrict__ pool_w, const float* __restrict__ pool_scale, float* __restrict__ concat) {
    __shared__ float pooled[CW];
    int tok = blockIdx.x; int b = tok / S, t = tok % S; int ch = threadIdx.x; int g = ch / 64; int win = 2 << g;
    int lo = t - win / 2; lo = lo < 0 ? 0 : lo; int hi = t + win / 2 - 1; hi = hi > S - 1 ? S - 1 : hi;
    float s = 0.f; for (int u = lo; u <= hi; ++u) s += h.at((size_t)b * S + u, O_G + ch);
    pooled[ch] = s / (float)(hi - lo + 1) - h.at(tok, O_G + ch);
    __syncthreads();
    int e = ch % 64; const float* pw = pool_w + (size_t)g * 64 * 64 + e; float a = 0.f;
    for (int c2 = 0; c2 < 64; ++c2) a += pooled[g * 64 + c2] * pw[c2 * 64];
    concat[(size_t)tok * D + AW + BW + ch] = a * pool_scale[ch];
}
__global__ void __launch_bounds__(64) k_rwkv_scan_n(HSrc h, RwP p, float* __restrict__ ys) {
    const int lane = threadIdx.x; const int dir = blockIdx.x / (NB * BH), b = (blockIdx.x / BH) % NB, hd = blockIdx.x % BH; const int ch = hd * HD + lane;
    float st[HD];
#pragma unroll
    for (int j = 0; j < HD; ++j) st[j] = 0.f;
    float wup[RW], aup[RA];
#pragma unroll
    for (int m = 0; m < RW; ++m) { wup[m] = p.w_up[(size_t)(dir * RW + m) * BW + ch]; aup[m] = p.a_up[(size_t)(dir * RA + m) * BW + ch]; }
    const float w0 = p.w0[dir * BW + ch], a0 = p.a0[dir * BW + ch], kkw = p.k_k[ch], kaw = p.k_a[ch];
    float cr[3], ck[3], cv[3];
#pragma unroll
    for (int x = 0; x < 3; ++x) { cr[x] = p.conv[x * 3 * BW + ch]; ck[x] = p.conv[x * 3 * BW + BW + ch]; cv[x] = p.conv[x * 3 * BW + 2 * BW + ch]; }
    for (int step = 0; step < S; ++step) {
        const int t = dir ? (S - 1 - step) : step; const size_t row = (size_t)b * S + t;
        float r = 0.f, k = 0.f, v = 0.f;
#pragma unroll
        for (int x = 0; x < 3; ++x) { int tt = t + x - 1; if (tt >= 0 && tt < S) { size_t rr = (size_t)b * S + tt; r += h.at(rr, O_A + ch) * cr[x]; k += h.at(rr, O_A + BW + ch) * ck[x]; v += h.at(rr, O_A + 2 * BW + ch) * cv[x]; } }
        float lv = h.at(row, O_B + lane); float lt = lane < RW ? tanhf(lv) : lv; float zw = w0, za = a0;
#pragma unroll
        for (int m = 0; m < RW; ++m) { zw += __shfl(lt, m) * wup[m]; za += __shfl(lt, RW + m) * aup[m]; }
        const float w = expf(-DECAY * sigm_n(zw)); const float a = sigm_n(za);
        float kk = k * kkw; float ss = wave_sum(kk * kk); kk = kk * (1.f / sqrtf(fmaxf(ss, 1e-24f)));
        const float kd = k * (1.f + (a - 1.f) * kaw); const float kka = kk * a;
        float sa = 0.f;
#pragma unroll
        for (int j = 0; j < HD; ++j) sa += st[j] * (-__shfl(kk, j));
        float y = 0.f;
#pragma unroll
        for (int j = 0; j < HD; ++j) { st[j] = st[j] * __shfl(w, j) + sa * __shfl(kka, j) + v * __shfl(kd, j); y += st[j] * __shfl(r, j); }
        ys[((size_t)dir * T + b * S + t) * BW + ch] = y;
    }
}
__global__ void __launch_bounds__(384) k_rwkv_finish_n(HSrc h, RwP p, const float* __restrict__ ys, float* __restrict__ concat) {
    __shared__ float lw[RW], la[RA], sg[RG];
    const int tok = blockIdx.x, b = tok / S, t = tok % S, ch = threadIdx.x, hd = ch / HD, j = ch % HD;
    if (ch < RW) lw[ch] = tanhf(h.at(tok, O_B + ch)); else if (ch < RW + RA) la[ch - RW] = h.at(tok, O_W + (ch - RW)); else if (ch < RW + RA + RG) sg[ch - RW - RA] = sigm_n(h.at(tok, O_AL + (ch - RW - RA)));
    __syncthreads();
    float r = 0.f, k = 0.f, v = 0.f;
#pragma unroll
    for (int x = 0; x < 3; ++x) { int tt = t + x - 1; if (tt >= 0 && tt < S) { size_t rr = (size_t)b * S + tt;
        r += h.at(rr, O_A + ch) * p.conv[x * 3 * BW + ch]; k += h.at(rr, O_A + BW + ch) * p.conv[x * 3 * BW + BW + ch]; v += h.at(rr, O_A + 2 * BW + ch) * p.conv[x * 3 * BW + 2 * BW + ch]; } }
    float bon = 0.f;
    for (int dir = 0; dir < 2; ++dir) { float za = p.a0[dir * BW + ch]; for (int m = 0; m < RA; ++m) za += la[m] * p.a_up[(size_t)(dir * RA + m) * BW + ch];
        float a = sigm_n(za); float kd = k * (1.f + (a - 1.f) * p.k_a[ch]); bon += wave_sum(r * kd * p.r_k[hd * HD + j]); }
    bon *= v;
    float y = ys[(size_t)tok * BW + ch] + ys[((size_t)T + tok) * BW + ch];
    float mu = wave_sum(y) * (1.f / HD); float dy = y - mu; float var = wave_sum(dy * dy) * (1.f / HD);
    float yn = dy * (1.f / sqrtf(var + GN_EPS)) * p.gn_gain[ch] + p.gn_bias[ch];
    float g = 0.f; for (int m = 0; m < RG; ++m) g += sg[m] * p.g_up[(size_t)m * BW + ch];
    concat[(size_t)tok * D + AW + ch] = (yn + bon) * g;
}
__global__ void __launch_bounds__(256) k_moe_n(const float* __restrict__ u2, const int* __restrict__ tokslot, const float* __restrict__ ew,
                                                const float* __restrict__ wgate, const float* __restrict__ wup, const float* __restrict__ wdown, float* __restrict__ f) {
    __shared__ float xs[D]; __shared__ float hb[DE];
    const int tok = blockIdx.x, tid = threadIdx.x;
    for (int i = tid; i < D; i += 256) xs[i] = u2[(size_t)tok * D + i];
    float o[4] = {0.f, 0.f, 0.f, 0.f};
    for (int kk = 0; kk < 2; ++kk) {
        const int ts = tokslot[tok * 2 + kk]; const int e = ts >> 14; const float wt = ew[ts];
        __syncthreads();
        const float* g = wgate + (size_t)e * D * DE; const float* u = wup + (size_t)e * D * DE;
        float ag0 = 0.f, ag1 = 0.f, au0 = 0.f, au1 = 0.f;
        for (int k = 0; k < D; ++k) { float x = xs[k]; ag0 += x * g[(size_t)k * DE + tid]; ag1 += x * g[(size_t)k * DE + 256 + tid]; au0 += x * u[(size_t)k * DE + tid]; au1 += x * u[(size_t)k * DE + 256 + tid]; }
        hb[tid] = ag0 * sigm_n(ag0) * au0; hb[256 + tid] = ag1 * sigm_n(ag1) * au1;
        __syncthreads();
        const float* dn = wdown + (size_t)e * DE * D; float a[4] = {0.f, 0.f, 0.f, 0.f};
        for (int k = 0; k < DE; ++k) { float x = hb[k];
#pragma unroll
            for (int j = 0; j < 4; ++j) a[j] += x * dn[(size_t)k * D + tid + 256 * j]; }
#pragma unroll
        for (int j = 0; j < 4; ++j) o[j] += a[j] * wt;
    }
#pragma unroll
    for (int j = 0; j < 4; ++j) f[(size_t)tok * D + tid + 256 * j] = o[j];
}

__global__ void k_router_n(const float* __restrict__ u2, const float* __restrict__ wg, const float* __restrict__ bg, const float* __restrict__ we, const float* __restrict__ be, int* __restrict__ tok_e) {
    int row = (blockIdx.x * blockDim.x + threadIdx.x) >> 6, lane = threadIdx.x & 63; if (row >= T) return;
    float gl[NG], el[NE];
#pragma unroll
    for (int n = 0; n < NG; ++n) gl[n] = 0.f;
#pragma unroll
    for (int n = 0; n < NE; ++n) el[n] = 0.f;
    for (int i = 0; i < 16; ++i) { int k = lane + 64 * i; float x = u2[(size_t)row * D + k];
#pragma unroll
        for (int n = 0; n < NG; ++n) gl[n] += x * wg[k * NG + n];
#pragma unroll
        for (int n = 0; n < NE; ++n) el[n] += x * we[k * NE + n]; }
#pragma unroll
    for (int n = 0; n < NG; ++n) gl[n] = wave_sum(gl[n]) + bg[n];
#pragma unroll
    for (int n = 0; n < NE; ++n) el[n] = wave_sum(el[n]) + be[n];
    int gi = 0; float gm = gl[0];
#pragma unroll
    for (int n = 1; n < NG; ++n) if (gl[n] > gm) { gm = gl[n]; gi = n; }
    float l1 = -3.0e38f, l2 = -3.0e38f; int i1 = 0, i2 = 0;
#pragma unroll
    for (int n = 0; n < NE; ++n) if ((n >> 3) == gi) { float v = el[n]; int e = n & 7; if (v > l1) { l2 = l1; i2 = i1; l1 = v; i1 = e; } else if (v > l2) { l2 = v; i2 = e; } }
    if (lane == 0) { tok_e[row * 2] = gi * EPG + i1; tok_e[row * 2 + 1] = gi * EPG + i2; }
}
__global__ void k_cmp_route(const int* __restrict__ tokslot, const int* __restrict__ tok_e, float* acc, int slot) {
    float mis = 0.f, tot = 0.f;
    for (int t = blockIdx.x * blockDim.x + threadIdx.x; t < T; t += gridDim.x * blockDim.x) { const int a0 = tokslot[2 * t] >> 14, a1 = tokslot[2 * t + 1] >> 14;
        mis += (a0 != tok_e[2 * t] || a1 != tok_e[2 * t + 1]) ? 1.f : 0.f; tot += 1.f; }
    mis = wave_sum(mis); tot = wave_sum(tot);
    if ((threadIdx.x & 63) == 0) { atomicAdd(acc + 2 * slot, mis); atomicAdd(acc + 2 * slot + 1, tot); }
}
__global__ void k_bf2f(const bf16_t* __restrict__ src, float* __restrict__ dst, size_t n) { for (size_t i = (size_t)blockIdx.x * blockDim.x + threadIdx.x; i < n; i += (size_t)gridDim.x * blockDim.x) dst[i] = bf2f(src[i]); }
template <class TA> __global__ void k_cmp(const TA* __restrict__ a, size_t lda, const float* __restrict__ b, size_t ldb, int rows, int cols, float* acc, int slot) {
    float d2 = 0.f, r2 = 0.f;
    for (size_t i = (size_t)blockIdx.x * blockDim.x + threadIdx.x; i < (size_t)rows * cols; i += (size_t)gridDim.x * blockDim.x) {
        const size_t r = i / cols, c = i % cols; float av; if constexpr (sizeof(TA) == 2) av = bf2f(a[r * lda + c]); else av = a[r * lda + c];
        const float bv = b[r * ldb + c]; d2 += (av - bv) * (av - bv); r2 += bv * bv; }
    d2 = wave_sum(d2); r2 = wave_sum(r2);
    if ((threadIdx.x & 63) == 0) { atomicAdd(acc + 2 * slot, d2); atomicAdd(acc + 2 * slot + 1, r2); }
}
__global__ void k_cmp_vt(const bf16_t* __restrict__ vt, const float* __restrict__ b, size_t ldb, float* acc, int slot) {
    float d2 = 0.f, r2 = 0.f;
    for (size_t i = (size_t)blockIdx.x * blockDim.x + threadIdx.x; i < (size_t)T * AW; i += (size_t)gridDim.x * blockDim.x) {
        const size_t r = i % T, c = i / T; const float av = bf2f(vt[c * T + r]), bv = b[r * ldb + c]; d2 += (av - bv) * (av - bv); r2 += bv * bv; }
    d2 = wave_sum(d2); r2 = wave_sum(r2);
    if ((threadIdx.x & 63) == 0) { atomicAdd(acc + 2 * slot, d2); atomicAdd(acc + 2 * slot + 1, r2); }
}
struct Tols { float t[8]; int n; };
__global__ void k_readout(float* out, const float* acc, Tols tl, int total) {
    float mx = 0.f; int am = 0; for (int k = 0; k < tl.n; ++k) { float e = sqrtf(acc[2 * k] / fmaxf(acc[2 * k + 1], 1e-30f)); if (!(e == e)) e = 1e3f; if (e / tl.t[k] > mx) { mx = e / tl.t[k]; am = k; } }
    const float cval = sqrtf(1000.f * mx);
    for (int i = blockIdx.x * blockDim.x + threadIdx.x; i < total; i += gridDim.x * blockDim.x) out[i] = (i < 8) ? 1000.f * (float)(am + 1) : cval;
}
__global__ void __launch_bounds__(256) k_moe_chk(const float* __restrict__ u2, const int* __restrict__ tokslot, const float* __restrict__ ew, const unsigned* __restrict__ cnt,
                                                  const float* __restrict__ wgate, const float* __restrict__ wup, const float* __restrict__ wdown,
                                                  const bf16_t* __restrict__ XS, const bf16_t* __restrict__ HM, const bf16_t* __restrict__ YS, float* acc) {
    __shared__ float xs[D]; __shared__ float hb[DE]; __shared__ int offp[NE];
    const int tok = blockIdx.x, tid = threadIdx.x;
    if (tid == 0) { int off = 0; for (int e = 0; e < NE; ++e) { offp[e] = off; off += (((int)cnt[e] + 255) >> 8) * 256; } }
    for (int i = tid; i < D; i += 256) xs[i] = u2[(size_t)tok * D + i];
    float d0 = 0.f, r0 = 0.f, d1 = 0.f, r1 = 0.f, d2 = 0.f, r2 = 0.f;
    for (int kk = 0; kk < 2; ++kk) {
        __syncthreads();
        const int ts = tokslot[tok * 2 + kk]; const int e = ts >> 14; const float wt = ew[ts]; const size_t slot = (size_t)offp[e] + (ts & 16383);
        for (int i = tid; i < D; i += 256) { const float a = bf2f(XS[slot * D + i]), b = xs[i]; d0 += (a - b) * (a - b); r0 += b * b; }
        const float* g = wgate + (size_t)e * D * DE; const float* u = wup + (size_t)e * D * DE;
        float ag0 = 0.f, ag1 = 0.f, au0 = 0.f, au1 = 0.f;
        for (int k = 0; k < D; ++k) { float x = xs[k]; ag0 += x * g[(size_t)k * DE + tid]; ag1 += x * g[(size_t)k * DE + 256 + tid]; au0 += x * u[(size_t)k * DE + tid]; au1 += x * u[(size_t)k * DE + 256 + tid]; }
        const float h0 = ag0 * sigm_n(ag0) * au0, h1 = ag1 * sigm_n(ag1) * au1;
        hb[tid] = h0; hb[256 + tid] = h1;
        { const float a = bf2f(HM[slot * DE + tid]), b = bf2f(HM[slot * DE + 256 + tid]); d1 += (a - h0) * (a - h0) + (b - h1) * (b - h1); r1 += h0 * h0 + h1 * h1; }
        __syncthreads();
        const float* dn = wdown + (size_t)e * DE * D; float a4[4] = {0.f, 0.f, 0.f, 0.f};
        for (int k = 0; k < DE; ++k) { float x = hb[k];
#pragma unroll
            for (int j = 0; j < 4; ++j) a4[j] += x * dn[(size_t)k * D + tid + 256 * j]; }
#pragma unroll
        for (int j = 0; j < 4; ++j) {
#ifdef MOEB_NOSCALE
            const float y = a4[j];
#else
            const float y = a4[j] * wt;
#endif
            const float a = bf2f(YS[slot * D + tid + 256 * j]); d2 += (a - y) * (a - y); r2 += y * y; }
    }
    d0 = wave_sum(d0); r0 = wave_sum(r0); d1 = wave_sum(d1); r1 = wave_sum(r1); d2 = wave_sum(d2); r2 = wave_sum(r2);
    if ((tid & 63) == 0) { atomicAdd(acc + 0, d0); atomicAdd(acc + 1, r0); atomicAdd(acc + 2, d1); atomicAdd(acc + 3, r1); atomicAdd(acc + 4, d2); atomicAdd(acc + 5, r2); }
}

extern "C" void kernel_launch(void* const* d_in, const int* in_sizes, int n_in, void* d_out, int out_size, void* d_ws, size_t ws_size, hipStream_t stream) {
    static int once = 0; if (!once) { (void)hipFuncSetAttribute((const void*)mk_fwd, hipFuncAttributeMaxDynamicSharedMemorySize, LDS_BYTES); once = 1; }
    (void)hipMemsetAsync((char*)d_ws + WS_CTL, 0, CTL_BYTES, stream);
    Args a{}; fill_args(a, d_in, d_out, d_ws);
    char* ws = (char*)d_ws; float* out = (float*)d_out;
    float* ACC = (float*)(ws + 32768 + 1024);
    const float* x = a.in[0];
    HSrc hs{(const bf16_t*)(ws + WS_HB), (const bf16_t*)(ws + WS_VT)};
    const int l = 0;
    RwP p = { a.in[6], a.in[7], a.in[8], a.in[9], a.in[10], a.in[11], a.in[12], a.in[13], a.in[14], a.in[15], a.in[16] };
    Tols tl{};
#if TESTMODE == 1
    launch_phases(a, 0, 3, stream);
    float* MODn = (float*)(ws + WS_MOD + 512 * 1024); float* Un = (float*)(ws + WS_XA); float* HF = (float*)(ws + WS_CONCAT);
    k_mod_n<<<L * MODW / 256, 256, 0, stream>>>(a.in[1], a.in[2], a.in[3], MODn);
    k_ln_mod_n<<<T / 4, 256, 0, stream>>>(x, MODn, 0, D, Un);
    k_gemm_f32<<<dim3(INW / 64, T / 64), 256, 0, stream>>>(Un, D, a.in[4], INW, HF, INW, D);
    k_cmp<float><<<256, 256, 0, stream>>>((const float*)(ws + WS_MOD), MODW, MODn, MODW, L * NB, MODW, ACC, 0);
    k_cmp<bf16_t><<<1024, 256, 0, stream>>>((const bf16_t*)(ws + WS_U), D, Un, D, T, D, ACC, 1);
    k_cmp<bf16_t><<<1024, 256, 0, stream>>>((const bf16_t*)(ws + WS_HB), HW, HF, INW, T, 768, ACC, 2);
    k_cmp<bf16_t><<<1024, 256, 0, stream>>>((const bf16_t*)(ws + WS_HB) + 768, HW, HF + 1152, INW, T, 1536, ACC, 3);
    k_cmp_vt<<<1024, 256, 0, stream>>>((const bf16_t*)(ws + WS_VT), HF + 768, INW, ACC, 4);
    tl.n = 5; tl.t[0] = 1e-5f; tl.t[1] = 4e-3f; tl.t[2] = 6e-3f; tl.t[3] = 6e-3f; tl.t[4] = 6e-3f;
#elif TESTMODE == 2
    launch_phases(a, 0, 4, stream);
    float* CCn = (float*)(ws + WS_XA); float* YSn = (float*)(ws + WS_WGU);
    k_attn_n<<<T * AH / 64, 64, 0, stream>>>(hs, a.in[5], CCn);
    k_pool_n<<<T, 256, 0, stream>>>(hs, a.in[17], a.in[18], CCn);
    k_rwkv_scan_n<<<2 * NB * BH, 64, 0, stream>>>(hs, p, YSn);
    k_rwkv_finish_n<<<T, 384, 0, stream>>>(hs, p, YSn, CCn);
    launch_phases(a, 4, 6, stream);
    k_cmp<bf16_t><<<1024, 256, 0, stream>>>((const bf16_t*)(ws + WS_CONCAT), D, CCn, D, T, AW, ACC, 0);
    k_cmp<bf16_t><<<1024, 256, 0, stream>>>((const bf16_t*)(ws + WS_CONCAT) + AW, D, CCn + AW, D, T, BW, ACC, 1);
    k_cmp<bf16_t><<<1024, 256, 0, stream>>>((const bf16_t*)(ws + WS_CONCAT) + AW + BW, D, CCn + AW + BW, D, T, CW, ACC, 2);
    tl.n = 3; tl.t[0] = TOL0; tl.t[1] = TOL1; tl.t[2] = TOL2;
#elif TESTMODE == 3
    launch_phases(a, 0, 11, stream);
    { const float* MODf = (const float*)(ws + WS_MOD);
      float* U2f = (float*)(ws + 414 * MiB); float* Fn = (float*)(ws + 213 * MiB); float* X2n = (float*)(ws + 277 * MiB);
      k_bf2f<<<2048, 256, 0, stream>>>((const bf16_t*)(ws + WS_U), U2f, (size_t)T * D);
      launch_phases(a, 11, 12, stream);
      k_moe_n<<<T, 256, 0, stream>>>(U2f, (const int*)(ws + WS_TOKSLOT), (const float*)(ws + WS_EW), a.in[28], a.in[29], a.in[30], Fn);
      k_post_n<<<T / 4, 256, 0, stream>>>((const float*)(ws + WS_XA), Fn, MODf, 5 * D, a.in[22], a.in[23], X2n, nullptr, 0, 0);
      k_cmp<float><<<1024, 256, 0, stream>>>(out, D, X2n, D, T, D, ACC, 0); }
    tl.n = 1; tl.t[0] = TOL0;
#elif TESTMODE == 4
    launch_phases(a, 0, 8, stream);
    { const float* MODf = (const float*)(ws + WS_MOD);
      float* CCn = (float*)(ws + 405 * MiB); float* MIXn = (float*)(ws + 213 * MiB); float* X1n = (float*)(ws + 21 * MiB); float* U2n = (float*)(ws + 333 * MiB); int* TEn = (int*)(ws + 490 * MiB);
      k_bf2f<<<2048, 256, 0, stream>>>((const bf16_t*)(ws + WS_CONCAT), CCn, (size_t)T * D);
      k_gemm_f32<<<dim3(D / 64, T / 64), 256, 0, stream>>>(CCn, D, a.in[19], D, MIXn, D, D);
      k_post_n<<<T / 4, 256, 0, stream>>>(x, MIXn, MODf, 2 * D, a.in[20], a.in[21], X1n, U2n, 3 * D, 4 * D);
      k_router_n<<<T / 4, 256, 0, stream>>>(U2n, a.in[24], a.in[25], a.in[26], a.in[27], TEn);
      k_cmp<float><<<1024, 256, 0, stream>>>((const float*)(ws + WS_XA), D, X1n, D, T, D, ACC, 0);
      k_cmp<bf16_t><<<1024, 256, 0, stream>>>((const bf16_t*)(ws + WS_U), D, U2n, D, T, D, ACC, 1);
      k_cmp_route<<<64, 256, 0, stream>>>((const int*)(ws + WS_TOKSLOT), TEn, ACC, 2); }
    tl.n = 3; tl.t[0] = TOL0; tl.t[1] = TOL1; tl.t[2] = TOL2;
#elif TESTMODE == 5
    launch_phases(a, 0, 11, stream);
    { float* U2f = (float*)(ws + 414 * MiB);
      k_bf2f<<<2048, 256, 0, stream>>>((const bf16_t*)(ws + WS_U), U2f, (size_t)T * D);
      k_moe_chk<<<T, 256, 0, stream>>>(U2f, (const int*)(ws + WS_TOKSLOT), (const float*)(ws + WS_EW), (const unsigned*)(ws + WS_CTL) + CW_CNT, a.in[28], a.in[29], a.in[30],
                                       (const bf16_t*)(ws + WS_XS), (const bf16_t*)(ws + WS_HM), (const bf16_t*)(ws + WS_YS), ACC); }
    tl.n = 3; tl.t[0] = 1e-6f; tl.t[1] = 1e-2f; tl.t[2] = 1e-2f;
#endif
    k_readout<<<256, 256, 0, stream>>>(out, ACC, tl, out_size);
}
#endif
```

```cpp
#define TESTMODE 0
#define MK_MODE 0
#include <hip/hip_runtime.h>
#include <hip/hip_cooperative_groups.h>
#include <stdint.h>
namespace cg = cooperative_groups;

#ifndef TESTMODE
#define TESTMODE 0
#endif
#define DI __device__ __forceinline__
#define LAS __attribute__((address_space(3)))
typedef unsigned short bf16_t;
typedef short bf16x8 __attribute__((ext_vector_type(8)));
typedef float f32x4 __attribute__((ext_vector_type(4)));
typedef float f32x16 __attribute__((ext_vector_type(16)));
typedef unsigned u32x4 __attribute__((ext_vector_type(4)));
typedef unsigned u32x2 __attribute__((ext_vector_type(2)));
typedef float f32x2_t __attribute__((ext_vector_type(2)));
typedef __bf16 bf16x2_t __attribute__((ext_vector_type(2)));

namespace cfg {
constexpr int D = 1024, NB = 2, S = 8192, T = NB * S, L = 2;
constexpr int GW = 64, ROWS = 128;
constexpr int HD = 64, AW = 384, BW = 384, CW = 256, AH = 6, BH = 6;
constexpr int KH = 8, KW = 16;
constexpr int RW = 32, RA = 32, RG = 64;
constexpr int INW = 2688;
constexpr int NG = 4, EPG = 8, NE = 32, DE = 512;
constexpr int MODW = 6 * D;
constexpr float ALPHA = 1.41421356237309515f;
constexpr float LN_EPS = 1e-5f, GN_EPS = 64e-5f;
constexpr float DECAY = 0.60653065971263342f;
constexpr float LOG2E = 1.44269504088896341f;
constexpr int HW = 2304, HQ = 0, HK = 384, HR = 768, HWL = 1920, HAL = 1952, HGL = 1984, HP = 2048;
constexpr int NCH = S / 64;
constexpr int NUNIT = 2 * NB * BH * NCH;
constexpr int XSROWS = 2 * T + NE * 256;
}
using namespace cfg;

constexpr size_t MiB = 1u << 20;
constexpr size_t WS_CTL = 0;
constexpr size_t CTL_BYTES = 262144;
constexpr size_t WS_SLOTTOK = 65536;
constexpr int CW_BAR = 0;
constexpr int CW_CNT = 8192;
constexpr size_t WS_MOD = 1 * MiB;
constexpr size_t WS_TOKSLOT = 1 * MiB + 128 * 1024;
constexpr size_t WS_SLOTW = 1 * MiB + 256 * 1024;
constexpr size_t WS_BC = 2 * MiB;
constexpr size_t WS_TOKW = 2 * MiB + 64 * 1024;
constexpr size_t WS_TOKFIN = 2 * MiB + 256 * 1024;
constexpr size_t WS_CNTF = 2 * MiB + 512 * 1024;
constexpr size_t WS_WIN = 6 * MiB;
constexpr size_t WIN_LAYER = (size_t)2816 * 1024 * 2;
constexpr size_t WS_WOUT = 17 * MiB;
constexpr size_t WS_WGU = 21 * MiB;
constexpr size_t WS_WD = 85 * MiB;
constexpr size_t WS_XA = 117 * MiB;
constexpr size_t WS_U = 181 * MiB;
constexpr size_t WS_HB = 213 * MiB;
constexpr size_t WS_S0 = 117 * MiB;
constexpr size_t WS_VT = 285 * MiB;
constexpr size_t WS_CONCAT = 301 * MiB;
constexpr size_t WS_MP = 333 * MiB;
constexpr size_t WS_NB = 357 * MiB;
constexpr size_t WS_MIX = 333 * MiB;
constexpr size_t WS_QT = 405 * MiB;
constexpr size_t WS_WT = 429 * MiB;
constexpr size_t WS_VTB = 453 * MiB;
constexpr size_t WS_GB = 465 * MiB;
constexpr size_t WS_VC = 477 * MiB;
constexpr size_t WS_BS = 489 * MiB;
constexpr size_t WS_XS = 213 * MiB;
constexpr size_t WS_HM = 293 * MiB;
constexpr size_t WS_YS = 333 * MiB;
constexpr size_t WS_END = 490 * MiB;

constexpr int NWAVES = 8, NTHREADS = 512;
constexpr int LDS_BYTES = 156 * 1024;

DI unsigned cvtpk(float lo, float hi) { f32x2_t v = {lo, hi}; bf16x2_t b = __builtin_convertvector(v, bf16x2_t); return __builtin_bit_cast(unsigned, b); }
DI float bflo(unsigned w) { return __uint_as_float(w << 16); }
DI float bfhi(unsigned w) { return __uint_as_float(w & 0xffff0000u); }
DI float bf2f(unsigned short h) { return __uint_as_float((unsigned)h << 16); }
DI unsigned short f2bf(float f) { return (unsigned short)(cvtpk(f, 0.f) & 0xffffu); }
DI float wave_sum_shfl(float v) {
#pragma unroll
    for (int o = 32; o > 0; o >>= 1) v += __shfl_xor(v, o);
    return v;
}
template <int CTRL, int ROWMASK> DI float dpp_add(float v) { return v + __builtin_bit_cast(float, __builtin_amdgcn_update_dpp(0, __builtin_bit_cast(int, v), CTRL, ROWMASK, 0xf, false)); }
DI float wave_sum(float v) {
    v = dpp_add<0xb1, 0xf>(v);
    v = dpp_add<0x4e, 0xf>(v);
    v = dpp_add<0x124, 0xf>(v);
    v = dpp_add<0x128, 0xf>(v);
    v = dpp_add<0x142, 0xa>(v);
    v = dpp_add<0x143, 0xc>(v);
    return __builtin_bit_cast(float, __builtin_amdgcn_readlane(__builtin_bit_cast(int, v), 63));
}
DI float fexp2(float x) { return __builtin_amdgcn_exp2f(x); }
DI float frcp(float x) { return __builtin_amdgcn_rcpf(x); }
DI float sigm(float x) { return frcp(1.f + fexp2(x * -LOG2E)); }
#define LDS_WAIT() asm volatile("s_waitcnt lgkmcnt(0)" ::: "memory")
#define VM_WAIT() asm volatile("s_waitcnt vmcnt(0)" ::: "memory")
DI int swap23(int i) { return (i & ~12) | ((i & 4) << 1) | ((i & 8) >> 1); }

namespace pg8 {
constexpr int BM = 256, BK = 64, HALF = 128, HTB = HALF * BK * 2, STAGE_BYTES = 8 * HTB, NXCD = 8, WGM = 8;
__host__ __device__ __forceinline__ int lds_byte(int r, int c) { const int st = (r >> 4) * 2 + (c >> 5), rr = r & 15, cc = c & 31, ob = rr * 64 + cc * 2; return st * 1024 + (ob ^ (((ob >> 9) & 1) << 5)); }
__host__ __device__ __forceinline__ void stage_rc(int b, int& R, int& C) { const int st = b / 1024, sb = b % 1024, swz = sb ^ (((sb >> 9) & 1) << 5); R = (st >> 1) * 16 + swz / 64; C = (st & 1) * 32 + (swz % 64) / 2; }
__host__ __device__ __forceinline__ int perm32(int rho) { const int n = rho >> 4, i = rho & 15; return 8 * (i >> 2) + 4 * n + (i & 3); }

struct Unit { int pm, pn, aux; };

DI int xcd_remap(int L, int nwg) { const int q = nwg / NXCD, r = nwg % NXCD, xcd = L % NXCD, off = L / NXCD; return (xcd < r ? xcd * (q + 1) : r * (q + 1) + (xcd - r) * q) + off; }

struct PlainOrder {
    static constexpr bool GATHER = false;
    const bf16_t* A; const bf16_t* Bt; int K; int nM, nN, nwg, G, c;
    DI void init(const bf16_t* A_, const bf16_t* Bt_, int M, int N, int K_, int G_, int c_) { A = A_; Bt = Bt_; K = K_; nM = M / BM; nN = N / BM; nwg = nM * nN; G = G_; c = c_; }
    DI bool next(int i, Unit& u) const {
        const int Lx = i * G + c; if (Lx >= nwg) return false;
        const int wgid = xcd_remap(Lx, nwg);
        const int nig = WGM * nN, gid = wgid / nig, fm = gid * WGM, gsz = (nM - fm) < WGM ? (nM - fm) : WGM;
        u.pm = fm + ((wgid % nig) % gsz); u.pn = (wgid % nig) / gsz; u.aux = 0; return true;
    }
    DI const char* aptr(const Unit& u) const { return (const char*)A + (size_t)u.pm * (2 * HALF) * K * 2; }
    DI const char* bptr(const Unit& u) const { return (const char*)Bt + (size_t)u.pn * (2 * HALF) * K * 2; }
};
struct Gemm1Order {
    static constexpr bool GATHER = false;
    const bf16_t* U; const bf16_t* Win; const bf16_t* Wv; int G, c;
    static constexpr int nM = T / BM, nN = HW / BM, nMain = nM * nN, nV = 2 * (T / BM), nwg = nMain + nV, K = D;
    DI bool next(int i, Unit& u) const {
        const int Lx = i * G + c; if (Lx >= nwg) return false;
        if (Lx < nMain) {
            const int wgid = xcd_remap(Lx, nMain);
            const int nig = WGM * nN, gid = wgid / nig, fm = gid * WGM, gsz = (nM - fm) < WGM ? (nM - fm) : WGM;
            u.pm = fm + ((wgid % nig) % gsz); u.pn = (wgid % nig) / gsz; u.aux = 0;
        } else { const int v = Lx - nMain; u.pm = v & 1; u.pn = v >> 1; u.aux = 1; }
        return true;
    }
    DI const char* aptr(const Unit& u) const { return (const char*)(u.aux ? Wv : U) + (size_t)u.pm * BM * K * 2; }
    DI const char* bptr(const Unit& u) const { return (const char*)(u.aux ? U : Win) + (size_t)u.pn * BM * K * 2; }
};
template <bool G_> struct GroupedOrderT {
    static constexpr bool GATHER = G_;
    const bf16_t* A; const bf16_t* Bt; int K; size_t estride; const LAS int* tile_e; int ntiles, nwg, G, c; const int* rowtok;
    DI bool next(int i, Unit& u) const {
        const int Lx = i * G + c; if (Lx >= nwg) return false;
        const int wgid = xcd_remap(Lx, nwg);
        u.pm = wgid >> 2; u.pn = wgid & 3; u.aux = tile_e[u.pm]; return true;
    }
    DI const char* aptr(const Unit& u) const { return GATHER ? (const char*)A : (const char*)A + (size_t)u.pm * BM * K * 2; }
    DI const char* bptr(const Unit& u) const { return (const char*)Bt + ((size_t)u.aux * estride + (size_t)u.pn * BM * K) * 2; }
};

struct EpiStore {
    bf16_t* O0; int ld0; bf16_t* O1; int ld1;
    DI void operator()(const f32x4 (&acc)[2][2][4][2], const Unit& u, int wr, int wc, int fr, int fq) const {
        bf16_t* base = u.aux ? O1 : O0; const int ldc = u.aux ? ld1 : ld0;
        const int row0 = u.pm * BM + wr * 64 + fr, col0 = u.pn * BM + wc * 32 + 8 * fq;
#pragma unroll
        for (int ai = 0; ai < 2; ++ai)
#pragma unroll
            for (int m = 0; m < 4; ++m) { bf16_t* rowp = base + (size_t)(row0 + ai * HALF + m * 16) * ldc + col0;
#pragma unroll
                for (int bj = 0; bj < 2; ++bj) { const f32x4 v0 = acc[ai][bj][m][0], v1 = acc[ai][bj][m][1];
                    u32x4 w; w.x = cvtpk(v0[0], v0[1]); w.y = cvtpk(v0[2], v0[3]); w.z = cvtpk(v1[0], v1[1]); w.w = cvtpk(v1[2], v1[3]);
                    *(u32x4*)(rowp + bj * HALF) = w; } }
    }
};
struct EpiSwiGlu {
    bf16_t* O;
    DI void operator()(const f32x4 (&acc)[2][2][4][2], const Unit& u, int wr, int wc, int fr, int fq) const {
        const int row0 = u.pm * BM + wr * 64 + fr, col0 = u.pn * HALF + wc * 32 + 8 * fq;
#pragma unroll
        for (int ai = 0; ai < 2; ++ai)
#pragma unroll
            for (int m = 0; m < 4; ++m) { bf16_t* rowp = O + (size_t)(row0 + ai * HALF + m * 16) * DE + col0;
                float hv[8];
#pragma unroll
                for (int n = 0; n < 2; ++n)
#pragma unroll
                    for (int e = 0; e < 4; ++e) { const float g = acc[ai][0][m][n][e], up = acc[ai][1][m][n][e]; hv[4 * n + e] = g * sigm(g) * up; }
                u32x4 w; w.x = cvtpk(hv[0], hv[1]); w.y = cvtpk(hv[2], hv[3]); w.z = cvtpk(hv[4], hv[5]); w.w = cvtpk(hv[6], hv[7]);
                *(u32x4*)rowp = w; }
    }
};
struct EpiRowScale {
    bf16_t* O; const float* roww;
    DI void operator()(const f32x4 (&acc)[2][2][4][2], const Unit& u, int wr, int wc, int fr, int fq) const {
        const int row0 = u.pm * BM + wr * 64 + fr, col0 = u.pn * BM + wc * 32 + 8 * fq;
#pragma unroll
        for (int ai = 0; ai < 2; ++ai)
#pragma unroll
            for (int m = 0; m < 4; ++m) { const int row = row0 + ai * HALF + m * 16;
#ifdef MOEB_NOSCALE
                const float s = 1.f;
#else
                const float s = roww[row];
#endif
                bf16_t* rowp = O + (size_t)row * D + col0;
#pragma unroll
                for (int bj = 0; bj < 2; ++bj) { const f32x4 v0 = acc[ai][bj][m][0] * s, v1 = acc[ai][bj][m][1] * s;
                    u32x4 w; w.x = cvtpk(v0[0], v0[1]); w.y = cvtpk(v0[2], v0[3]); w.z = cvtpk(v1[0], v1[1]); w.w = cvtpk(v1[2], v1[3]);
                    *(u32x4*)(rowp + bj * HALF) = w; } }
    }
};

template <class Epi, class Sched>
DI void gemm_phase(LAS unsigned char* lds, const int tid, const int K, const Sched& S, const Epi& E) {
    const int wid = __builtin_amdgcn_readfirstlane(tid >> 6), lane = tid & 63, wr = wid >> 2, wc = wid & 3, fr = lane & 15, fq = lane >> 4;
    const int nt = K / BK;
    unsigned voffA[2], voffB[2];
#pragma unroll
    for (int i = 0; i < 2; ++i) { int R, C; stage_rc(tid * 16 + i * 8192, R, C); const int Rb = (R & ~31) + perm32(R & 31);
        voffA[i] = (unsigned)(R * K + C) * 2u; voffB[i] = (unsigned)(Rb * K + C) * 2u; }
    const size_t kstep = (size_t)(BK * 2);
    const size_t hstep = (size_t)HALF * K * 2;
    const size_t hstepA = Sched::GATHER ? 0 : hstep;
    int RA_[2], CA_[2];
#pragma unroll
    for (int i = 0; i < 2; ++i) stage_rc(tid * 16 + i * 8192, RA_[i], CA_[i]);
    unsigned vgc[2][2], vgn[2][2], vgnn[2][2];
#define PG8_GLOAD(dst, u_) do { if constexpr (Sched::GATHER) { _Pragma("unroll") for (int h_ = 0; h_ < 2; ++h_) _Pragma("unroll") for (int i_ = 0; i_ < 2; ++i_) \
        dst[h_][i_] = ((unsigned)S.rowtok[(u_).pm * BM + h_ * HALF + RA_[i_]] * (unsigned)K + (unsigned)CA_[i_]) * 2u; } } while (0)
    const unsigned ldsw = (unsigned)wid * 1024u;
    const int aoff = lds_byte(wr * 64 + fr, fq * 8), boff = lds_byte(wc * 32 + fr, fq * 8);
#define PG8_SA(b, h) (((b) * 2 + (h)) * HTB)
#define PG8_SB(b, h) ((4 + (b) * 2 + (h)) * HTB)
#define PG8_STAGE(bufoff, gbase, voff) do { _Pragma("unroll") for (int _i = 0; _i < 2; ++_i) \
        __builtin_amdgcn_global_load_lds((const unsigned*)((const char*)(gbase) + (voff)[_i]), (LAS unsigned*)(lds + (bufoff) + ldsw + _i * 8192), 16, 0, 0); } while (0)
#define PG8_STAGE_A(b, h, gbase, cur_) do { if constexpr (Sched::GATHER) { unsigned vo_[2]; vo_[0] = (cur_) ? vgc[h][0] : vgn[h][0]; vo_[1] = (cur_) ? vgc[h][1] : vgn[h][1]; PG8_STAGE(PG8_SA(b, h), gbase, vo_); } else PG8_STAGE(PG8_SA(b, h), (gbase) + (h) * hstepA, voffA); } while (0)
#define PG8_LDA(dst, b, h) do { _Pragma("unroll") for (int m = 0; m < 4; ++m) _Pragma("unroll") for (int k = 0; k < 2; ++k) dst[m][k] = *(const LAS bf16x8*)(lds + PG8_SA(b, h) + aoff + m * 2048 + k * 1024); } while (0)
#define PG8_LDB(dst, b, h) do { _Pragma("unroll") for (int n = 0; n < 2; ++n) _Pragma("unroll") for (int k = 0; k < 2; ++k) dst[n][k] = *(const LAS bf16x8*)(lds + PG8_SB(b, h) + boff + n * 2048 + k * 1024); } while (0)
#define PG8_MMA(ai, bj, At, Bt) do { __builtin_amdgcn_s_setprio(1); _Pragma("unroll") for (int m = 0; m < 4; ++m) _Pragma("unroll") for (int n = 0; n < 2; ++n) _Pragma("unroll") for (int k = 0; k < 2; ++k) \
        acc[ai][bj][m][n] = __builtin_amdgcn_mfma_f32_16x16x32_bf16(Bt[n][k], At[m][k], acc[ai][bj][m][n], 0, 0, 0); __builtin_amdgcn_s_setprio(0); } while (0)
#define PG8_WAIT_V(n) asm volatile("s_waitcnt vmcnt(" #n ")" ::: "memory")
#define PG8_WAIT_L(n) asm volatile("s_waitcnt lgkmcnt(" #n ")" ::: "memory")
#define PG8_BAR __builtin_amdgcn_s_barrier()
#define PG8_SCHED __builtin_amdgcn_sched_barrier(0)
    Unit cur, nxt; int ui = 0;
    if (!S.next(0, cur)) return;
    f32x4 acc[2][2][4][2];
#pragma unroll
    for (int a = 0; a < 2; ++a)
#pragma unroll
        for (int b = 0; b < 2; ++b)
#pragma unroll
            for (int m = 0; m < 4; ++m)
#pragma unroll
                for (int n = 0; n < 2; ++n) acc[a][b][m][n] = (f32x4){0.f, 0.f, 0.f, 0.f};
    bf16x8 At[4][2], B0[2][2], B1[2][2];
    const char* cA = S.aptr(cur); const char* cB = S.bptr(cur);
    if constexpr (Sched::GATHER) { Unit u1_ = cur, u2_ = cur; const bool h1_ = S.next(1, u1_); if (!h1_) u1_ = cur; const bool h2_ = h1_ && S.next(2, u2_); if (!h2_) u2_ = u1_;
        PG8_GLOAD(vgc, cur); PG8_GLOAD(vgn, u1_); PG8_GLOAD(vgnn, u2_); }
    PG8_STAGE(PG8_SB(0, 0), cB, voffB); PG8_STAGE(PG8_SB(0, 1), cB + hstep, voffB); PG8_STAGE_A(0, 0, cA, true); PG8_STAGE_A(0, 1, cA, true);
    if (wr == 1) PG8_BAR;
    PG8_WAIT_V(2); PG8_BAR;
    PG8_STAGE(PG8_SB(1, 0), cB + kstep, voffB); PG8_STAGE_A(1, 0, cA + kstep, true); PG8_STAGE(PG8_SB(1, 1), cB + hstep + kstep, voffB);
    PG8_WAIT_V(6); PG8_BAR;
    for (;;) {
        const bool has_next = S.next(ui + 1, nxt);
        const char* nA = has_next ? S.aptr(nxt) : cA; const char* nB = has_next ? S.bptr(nxt) : cB;

        for (int t = 0; t < nt; t += 2) {
            const bool last = (t == nt - 2);
            const char* a1 = cA + (size_t)(t + 1) * kstep;
            const char* a2 = last ? nA : cA + (size_t)(t + 2) * kstep; const char* b2 = last ? nB : cB + (size_t)(t + 2) * kstep;
            const char* a3 = a2 + kstep; const char* b3 = b2 + kstep;
            PG8_LDB(B0, 0, 0); PG8_LDB(B1, 0, 1); PG8_SCHED; PG8_LDA(At, 0, 0); PG8_STAGE_A(1, 1, a1, true);
            PG8_WAIT_V(8); PG8_WAIT_L(0); PG8_BAR; PG8_MMA(0, 0, At, B0); PG8_MMA(0, 1, At, B1); PG8_BAR; PG8_SCHED;
            PG8_LDA(At, 0, 1); PG8_STAGE(PG8_SB(0, 0), b2, voffB); PG8_STAGE(PG8_SB(0, 1), b2 + hstep, voffB); PG8_STAGE_A(0, 0, a2, !last);
            PG8_WAIT_V(8); PG8_WAIT_L(0); PG8_BAR; PG8_MMA(1, 0, At, B0); PG8_MMA(1, 1, At, B1); PG8_BAR; PG8_SCHED;
            PG8_LDB(B0, 1, 0); PG8_LDB(B1, 1, 1); PG8_SCHED; PG8_LDA(At, 1, 0); PG8_STAGE_A(0, 1, a2, !last);
            PG8_WAIT_V(8); PG8_WAIT_L(0); PG8_BAR; PG8_MMA(0, 0, At, B0); PG8_MMA(0, 1, At, B1); PG8_BAR; PG8_SCHED;
            PG8_LDA(At, 1, 1); PG8_STAGE(PG8_SB(1, 0), b3, voffB); PG8_STAGE(PG8_SB(1, 1), b3 + hstep, voffB); PG8_STAGE_A(1, 0, a3, !last);
            PG8_WAIT_V(8); PG8_WAIT_L(0); PG8_BAR; PG8_MMA(1, 0, At, B0); PG8_MMA(1, 1, At, B1); PG8_BAR; PG8_SCHED;
        }
        if (wr == 0) PG8_BAR;
        E(acc, cur, wr, wc, fr, fq);
        if (!has_next) break;
#pragma unroll
        for (int a = 0; a < 2; ++a)
#pragma unroll
            for (int b = 0; b < 2; ++b)
#pragma unroll
                for (int m = 0; m < 4; ++m)
#pragma unroll
                    for (int n = 0; n < 2; ++n) acc[a][b][m][n] = (f32x4){0.f, 0.f, 0.f, 0.f};
        cur = nxt; cA = nA; cB = nB; ++ui;
        if constexpr (Sched::GATHER) { _Pragma("unroll") for (int h_ = 0; h_ < 2; ++h_) _Pragma("unroll") for (int i_ = 0; i_ < 2; ++i_) { vgc[h_][i_] = vgn[h_][i_]; vgn[h_][i_] = vgnn[h_][i_]; } }
        if (wr == 1) PG8_BAR;
    }
    PG8_WAIT_V(0);
    PG8_BAR;
#undef PG8_SA
#undef PG8_SB
#undef PG8_STAGE
#undef PG8_STAGE_A
#undef PG8_GLOAD
#undef PG8_LDA
#undef PG8_LDB
#undef PG8_MMA
#undef PG8_WAIT_V
#undef PG8_WAIT_L
#undef PG8_BAR
#undef PG8_SCHED
}
}

#define XB_TMO      128
#define XB_XCNT(j)  (256  + 64 * (j))
#define XB_XSUB(j)  (1280 + 64 * (j))
#define XB_XGEN(j)  (2304 + 64 * (j))
#define XB_TOP      3328
#define XB_TOPGEN   3392
#define XCD_BAR_WORDS 3456
#define XB_SPIN_CAP (1u << 20)
DI unsigned xb_ld(unsigned* p)              { return __hip_atomic_load(p, __ATOMIC_RELAXED, __HIP_MEMORY_SCOPE_AGENT); }
DI unsigned xb_add(unsigned* p, unsigned v) { return __hip_atomic_fetch_add(p, v, __ATOMIC_RELAXED, __HIP_MEMORY_SCOPE_AGENT); }
DI unsigned xb_xcc_id() { return (unsigned)__builtin_amdgcn_s_getreg((3 << 11) | 20) & 0xFu; }
#define XB_SPIN(cond, bar) do { unsigned _sp = 0; while (cond) { __builtin_amdgcn_s_sleep(1); \
    if ((++_sp & 255u) == 0u) { if (xb_ld(&(bar)[XB_TMO])) break; if (_sp > XB_SPIN_CAP) { atomicAdd(&(bar)[XB_TMO], 1u); break; } } } } while (0)
struct XcdBarrier { unsigned* bar; unsigned x; volatile LAS unsigned* st; };
DI XcdBarrier xcd_barrier_post(unsigned* bar, volatile LAS unsigned* st) {
    XcdBarrier b; b.bar = bar; b.x = xb_xcc_id(); b.st = st;
    if (threadIdx.x == 0) (void)xb_add(&bar[XB_XCNT(b.x)], 1u);
    return b;
}
DI void xcd_barrier_complete(unsigned* bar, unsigned x, unsigned& nloc, unsigned& nx) {
    const unsigned G = gridDim.x * gridDim.y * gridDim.z;
    unsigned sum, cnt, mine, sp = 0u;
    for (;;) {
        sum = 0u; cnt = 0u; mine = 0u;
#pragma unroll
        for (unsigned j = 0; j < 16; ++j) { const unsigned c = xb_ld(&bar[XB_XCNT(j)]); sum += c; cnt += (c > 0u) ? 1u : 0u; mine = (j == x) ? c : mine; }
        if (sum == G) break;
        __builtin_amdgcn_s_sleep(1);
        if ((++sp & 255u) == 0u) { if (xb_ld(&bar[XB_TMO])) break; if (sp > XB_SPIN_CAP) { atomicAdd(&bar[XB_TMO], 1u); break; } }
    }
    nloc = mine > 0u ? mine : 1u; nx = cnt > 0u ? cnt : 1u;
}
DI void xcd_barrier(const XcdBarrier& b) {
    asm volatile("s_waitcnt vmcnt(0)" ::: "memory");
    __syncthreads();
    if (threadIdx.x == 0) {
        unsigned* bar = b.bar;
        __builtin_amdgcn_s_waitcnt(0);
        unsigned nloc = b.st[0], nx = b.st[1];
        if (nloc == 0u) { xcd_barrier_complete(bar, b.x, nloc, nx); b.st[0] = nloc; b.st[1] = nx; }
        const unsigned old = xb_add(&bar[XB_XSUB(b.x)], 1u);
        const unsigned gen = old / nloc;
        if (old + 1u == (gen + 1u) * nloc) {
            __builtin_amdgcn_fence(__ATOMIC_RELEASE, "agent");
            asm volatile("s_waitcnt vmcnt(0)" ::: "memory");
            const unsigned og = xb_add(&bar[XB_TOP], 1u);
            const unsigned tg = og / nx;
            if (og + 1u == (tg + 1u) * nx) xb_add(&bar[XB_TOPGEN], 1u);
            else XB_SPIN(xb_ld(&bar[XB_TOPGEN]) == tg, bar);
            __builtin_amdgcn_fence(__ATOMIC_ACQUIRE, "agent");
            xb_add(&bar[XB_XGEN(b.x)], 1u);
            asm volatile("s_waitcnt vmcnt(0)" ::: "memory");
        } else {
            XB_SPIN(xb_ld(&bar[XB_XGEN(b.x)]) == gen, bar);
            __builtin_amdgcn_fence(__ATOMIC_ACQUIRE, "agent");
            asm volatile("s_waitcnt vmcnt(0)" ::: "memory");
        }
    }
    __syncthreads();
}

struct Args { const float* in[31]; float* out; unsigned char* ws; int ph_lo, ph_hi, use_cg, pad; };
struct Frame {
    LAS unsigned char* lds;
    int tid, lane, wave, G, vcu, gw, ngw, bx;
    unsigned char* ws;
};
constexpr int LDS_MISC = 131072;
constexpr int LDS_BARST = LDS_BYTES - 64;

struct TItem { const float* src; bf16_t* dst; int ldw, ldt; };
DI void titem_load(const TItem& t, f32x4 (&v)[16], int lane) {
#pragma unroll
    for (int i = 0; i < 16; ++i) v[i] = *(const f32x4*)(t.src + (size_t)(4 * i + (lane >> 4)) * t.ldw + 4 * (lane & 15));
}
DI void titem_store(const TItem& t, const f32x4 (&v)[16], LAS float* scr, int lane) {
#pragma unroll
    for (int i = 0; i < 16; ++i) { LAS float* s = scr + (4 * i + (lane >> 4)) * 65 + 4 * (lane & 15); s[0] = v[i][0]; s[1] = v[i][1]; s[2] = v[i][2]; s[3] = v[i][3]; }
    LDS_WAIT();
#pragma unroll
    for (int j = 0; j < 8; ++j) {
        const int n = 8 * j + (lane >> 3), c = lane & 7; const LAS float* s = scr + (8 * c) * 65 + n;
        u32x4 o; o.x = cvtpk(s[0], s[65]); o.y = cvtpk(s[130], s[195]); o.z = cvtpk(s[260], s[325]); o.w = cvtpk(s[390], s[455]);
        *(u32x4*)(t.dst + (size_t)n * t.ldt + 8 * c) = o;
    }
    LDS_WAIT();
}
constexpr int IT_WIN = 16 * 42, IT_WOUT = 16 * 16, IT_SMALL = IT_WIN + IT_WOUT;
constexpr int IT_EXP = 128 * 3, IT_MOE = NE * IT_EXP;
DI TItem small_item(const Frame& F, const float* w_in, const float* w_out, int git) {
    const int l = git / IT_SMALL, it = git % IT_SMALL; TItem t;
    if (it < IT_WIN) {
        const int kt = it / 42, nt = it % 42, n0 = 64 * nt;
        size_t drow; if (n0 < 768) drow = n0; else if (n0 < 1152) drow = 2304 + (n0 - 768); else drow = n0 - 384;
        t.src = w_in + (size_t)l * D * INW + (size_t)(64 * kt) * INW + n0; t.ldw = INW;
        t.dst = (bf16_t*)(F.ws + WS_WIN + (size_t)l * WIN_LAYER) + drow * D + 64 * kt; t.ldt = D;
    } else {
        const int r = it - IT_WIN, kt = r >> 4, nt = r & 15;
        t.src = w_out + (size_t)l * D * D + (size_t)(64 * kt) * D + 64 * nt; t.ldw = D;
        t.dst = (bf16_t*)(F.ws + WS_WOUT) + (size_t)l * D * D + (size_t)(64 * nt) * D + 64 * kt; t.ldt = D;
    }
    return t;
}
DI TItem moe_item(const Frame& F, const float* wg, const float* wu, const float* wd, int l, int it) {
    const int e = it / IT_EXP, r = it % IT_EXP, which = r >> 7, q = r & 127; TItem t;
    if (which < 2) {
        const int kt = q >> 3, nt = q & 7, n0 = 64 * nt;
        t.src = (which ? wu : wg) + ((size_t)l * NE + e) * D * DE + (size_t)(64 * kt) * DE + n0; t.ldw = DE;
        const size_t drow = (size_t)(n0 >> 7) * 256 + (which ? 128 : 0) + (n0 & 127);
        t.dst = (bf16_t*)(F.ws + WS_WGU) + (size_t)e * D * D + drow * D + 64 * kt; t.ldt = D;
    } else {
        const int kt = q >> 4, nt = q & 15;
        t.src = wd + ((size_t)l * NE + e) * DE * D + (size_t)(64 * kt) * D + 64 * nt; t.ldw = D;
        t.dst = (bf16_t*)(F.ws + WS_WD) + (size_t)e * D * DE + (size_t)(64 * nt) * DE + 64 * kt; t.ldt = DE;
    }
    return t;
}
DI void p0_prologue(const Frame& F, const Args& a) {
    const float* c = a.in[1]; const float* w_mod = a.in[2]; const float* b_mod = a.in[3];
    if (F.bx < L * (MODW / 64)) {
        LAS float* sc = (LAS float*)(F.lds);
        LAS float* red = (LAS float*)(F.lds + 8192);
        for (int i = F.tid; i < NB * D; i += NTHREADS) { const float v = c[i]; sc[i] = v / (1.f + expf(-v)); }
        __syncthreads();
        const int l = F.bx / (MODW / 64), cb = F.bx % (MODW / 64), n = cb * 64 + F.lane;
        const float* w = w_mod + (size_t)l * D * MODW + n;
        float a0 = 0.f, a1 = 0.f;
#pragma unroll 8
        for (int k = F.wave * 128; k < F.wave * 128 + 128; ++k) { const float wv = w[(size_t)k * MODW]; a0 += sc[k] * wv; a1 += sc[D + k] * wv; }
        red[(F.wave * 2 + 0) * 64 + F.lane] = a0; red[(F.wave * 2 + 1) * 64 + F.lane] = a1;
        __syncthreads();
        if (F.tid < 128) { const int b = F.tid >> 6, ln = F.tid & 63; float s = 0.f;
#pragma unroll
            for (int w8 = 0; w8 < 8; ++w8) s += red[(w8 * 2 + b) * 64 + ln];
            const int nn = cb * 64 + ln;
            ((float*)(F.ws + WS_MOD))[(size_t)(l * NB + b) * MODW + nn] = s + b_mod[l * MODW + nn]; }
        __syncthreads();
    }
    { const int nzero = L * 128 * D / 8;
      for (int i = F.gw * 64 + F.lane; i < nzero; i += F.ngw * 64) { const int l = i / (128 * D / 8), r = i % (128 * D / 8);
          *(u32x4*)((bf16_t*)(F.ws + WS_WIN + (size_t)l * WIN_LAYER) + (size_t)(2304 + 384) * D + (size_t)r * 8) = (u32x4){0u, 0u, 0u, 0u}; } }
    LAS float* scr = (LAS float*)(F.lds + 16384) + F.wave * (64 * 65);
    { f32x4 cur[16], nxt[16]; int it = F.gw; TItem tc{}, tn{};
      if (it < L * IT_SMALL) { tc = small_item(F, a.in[4], a.in[19], it); titem_load(tc, cur, F.lane); }
      for (; it < L * IT_SMALL; it += F.ngw) {
          const bool more = it + F.ngw < L * IT_SMALL;
          if (more) { tn = small_item(F, a.in[4], a.in[19], it + F.ngw); titem_load(tn, nxt, F.lane); }
          titem_store(tc, cur, scr, F.lane);
          if (more) { tc = tn;
#pragma unroll
              for (int i = 0; i < 16; ++i) cur[i] = nxt[i]; }
      } }
}

DI void row_ln(f32x4 (&v)[4], float& mean_out, float& rstd_out) {
    float s = 0.f;
#pragma unroll
    for (int j = 0; j < 4; ++j) s += (v[j][0] + v[j][1]) + (v[j][2] + v[j][3]);
    const float mean = wave_sum(s) * (1.f / D); float q = 0.f;
#pragma unroll
    for (int j = 0; j < 4; ++j) { v[j] = v[j] - mean; q += (v[j][0] * v[j][0] + v[j][1] * v[j][1]) + (v[j][2] * v[j][2] + v[j][3] * v[j][3]); }
    mean_out = mean; rstd_out = 1.f / sqrtf(wave_sum(q) * (1.f / D) + LN_EPS);
}
DI void row_mod_store(f32x4 (&v)[4], const float* md, int off_sh, int off_sc, bf16_t* urow, int lane) {
    float mean, rstd; row_ln(v, mean, rstd);
#pragma unroll
    for (int j = 0; j < 4; ++j) { const int col = 4 * lane + 256 * j;
        const f32x4 scv = *(const f32x4*)(md + off_sc + col), shv = *(const f32x4*)(md + off_sh + col);
        v[j] = v[j] * rstd * (1.f + scv) + shv;
        u32x2 w; w.x = cvtpk(v[j][0], v[j][1]); w.y = cvtpk(v[j][2], v[j][3]);
        *(u32x2*)(urow + col) = w; }
}
DI void p_r0(const Frame& F, const float* x) {
    const float* MOD = (const float*)(F.ws + WS_MOD);
    bf16_t* U = (bf16_t*)(F.ws + WS_U);
    for (int row = F.gw; row < T; row += F.ngw) {
        f32x4 v[4];
#pragma unroll
        for (int j = 0; j < 4; ++j) v[j] = *(const f32x4*)(x + (size_t)row * D + 4 * F.lane + 256 * j);
        row_mod_store(v, MOD + (size_t)(row / S) * MODW, 0, D, U + (size_t)row * D, F.lane);
    }
}

constexpr int NGRP = T / 64;
DI void p_rowpass1(const Frame& F, const Args& a, int l, const float* xin, const bool dry = false) {
    const float* MODl = (const float*)(F.ws + WS_MOD) + (size_t)l * NB * MODW;
    const bf16_t* MIX = (const bf16_t*)(F.ws + WS_MIX);
    float* XA = (float*)(F.ws + WS_XA); bf16_t* U = (bf16_t*)(F.ws + WS_U);
    const float* gain = a.in[20] + (size_t)l * D; const float* bias = a.in[21] + (size_t)l * D;
    const float* wg = a.in[24] + (size_t)l * D * NG; const float* bg = a.in[25] + (size_t)l * NG;
    const float* we = a.in[26] + (size_t)l * D * NE; const float* be = a.in[27] + (size_t)l * NE;
    const size_t dro = dry ? 490 * MiB - WS_BC : 0;
    int* BC = (int*)(F.ws + WS_BC + dro); float* TOKW = (float*)(F.ws + WS_TOKW + dro); int* TOKSLOT = (int*)(F.ws + WS_TOKSLOT + (dry ? 496 * MiB - WS_TOKSLOT : 0));
    LAS float* RT = (LAS float*)F.lds;
    LAS unsigned* cntl = (LAS unsigned*)(F.lds + 36 * D * 4 + NWAVES * 72 * 4);
#pragma unroll
    for (int kk = 0; kk < 2; ++kk) { const int k = F.tid + kk * NTHREADS;
        f32x4 v[9]; v[0] = *(const f32x4*)(wg + (size_t)k * NG);
#pragma unroll
        for (int q = 0; q < 8; ++q) v[1 + q] = *(const f32x4*)(we + (size_t)k * NE + 4 * q);
#pragma unroll
        for (int q = 0; q < 9; ++q)
#pragma unroll
            for (int e = 0; e < 4; ++e) RT[(4 * q + e) * D + k] = v[q][e]; }
    for (int grp = F.vcu; grp < NGRP; grp += F.G) {
    if (F.tid < NE) cntl[F.tid] = 0u;
    __syncthreads();
    f32x4 pxa[4], pxb[4]; u32x2 pma[4], pmb[4];
    { const int r0 = 64 * grp + 8 * F.wave;
#pragma unroll
      for (int j = 0; j < 4; ++j) { const int col = 4 * F.lane + 256 * j; pxa[j] = *(const f32x4*)(xin + (size_t)r0 * D + col); pxb[j] = *(const f32x4*)(xin + (size_t)(r0 + 1) * D + col);
          pma[j] = *(const u32x2*)(MIX + (size_t)r0 * D + col); pmb[j] = *(const u32x2*)(MIX + (size_t)(r0 + 1) * D + col); } }
    for (int rp = 0; rp < 4; ++rp) {
        const int row0 = 64 * grp + 8 * F.wave + 2 * rp; const float* md = MODl + (size_t)(row0 / S) * MODW;
        f32x4 va[4], vb[4];
#pragma unroll
        for (int j = 0; j < 4; ++j) { const int col = 4 * F.lane + 256 * j;
            const f32x4 g = *(const f32x4*)(md + 2 * D + col);
            va[j] = pxa[j] * ALPHA + g * (f32x4){bflo(pma[j].x), bfhi(pma[j].x), bflo(pma[j].y), bfhi(pma[j].y)};
            vb[j] = pxb[j] * ALPHA + g * (f32x4){bflo(pmb[j].x), bfhi(pmb[j].x), bflo(pmb[j].y), bfhi(pmb[j].y)}; }
        if (rp < 3) { const int r0 = row0 + 2;
#pragma unroll
          for (int j = 0; j < 4; ++j) { const int col = 4 * F.lane + 256 * j; pxa[j] = *(const f32x4*)(xin + (size_t)r0 * D + col); pxb[j] = *(const f32x4*)(xin + (size_t)(r0 + 1) * D + col);
              pma[j] = *(const u32x2*)(MIX + (size_t)r0 * D + col); pmb[j] = *(const u32x2*)(MIX + (size_t)(r0 + 1) * D + col); } }
        float mean, rstd;
        row_ln(va, mean, rstd);
#pragma unroll
        for (int j = 0; j < 4; ++j) { const int col = 4 * F.lane + 256 * j; va[j] = va[j] * rstd * *(const f32x4*)(gain + col) + *(const f32x4*)(bias + col); *(f32x4*)(XA + (size_t)row0 * D + col) = va[j]; }
        row_ln(vb, mean, rstd);
#pragma unroll
        for (int j = 0; j < 4; ++j) { const int col = 4 * F.lane + 256 * j; vb[j] = vb[j] * rstd * *(const f32x4*)(gain + col) + *(const f32x4*)(bias + col); *(f32x4*)(XA + (size_t)(row0 + 1) * D + col) = vb[j]; }
        row_mod_store(va, md, 3 * D, 4 * D, U + (size_t)row0 * D, F.lane);
        row_mod_store(vb, md, 3 * D, 4 * D, U + (size_t)(row0 + 1) * D, F.lane);
#ifdef DRY_NOROUTER
        if (dry) continue;
#endif
        LAS float* lg = (LAS float*)(F.lds + 36 * D * 4) + F.wave * 72;
#pragma unroll 1
        for (int n = 0; n < 36; n += 3) { float sa[3], sb[3];
#pragma unroll
            for (int q = 0; q < 3; ++q) { sa[q] = 0.f; sb[q] = 0.f;
#pragma unroll
                for (int j = 0; j < 4; ++j) { const f32x4 w = *(const LAS f32x4*)(RT + (n + q) * D + 4 * F.lane + 256 * j);
                    sa[q] += (va[j][0] * w[0] + va[j][1] * w[1]) + (va[j][2] * w[2] + va[j][3] * w[3]);
                    sb[q] += (vb[j][0] * w[0] + vb[j][1] * w[1]) + (vb[j][2] * w[2] + vb[j][3] * w[3]); } }
#pragma unroll
            for (int q = 0; q < 3; ++q) { sa[q] = wave_sum(sa[q]); sb[q] = wave_sum(sb[q]); }
            if (F.lane == 0) {
#pragma unroll
                for (int q = 0; q < 3; ++q) { lg[n + q] = sa[q]; lg[36 + n + q] = sb[q]; } } }
        LDS_WAIT();
#pragma unroll
        for (int rr = 0; rr < 2; ++rr) {
            float gl[4], el[32];
#pragma unroll
            for (int n = 0; n < 4; ++n) gl[n] = lg[36 * rr + n] + bg[n];
#pragma unroll
            for (int n = 0; n < 32; ++n) el[n] = lg[36 * rr + 4 + n] + be[n];
            int gi = 0; float gm = gl[0];
#pragma unroll
            for (int n = 1; n < 4; ++n) if (gl[n] > gm) { gm = gl[n]; gi = n; }
            float se = 0.f;
#pragma unroll
            for (int n = 0; n < 4; ++n) se += expf(gl[n] - gm);
            const float pg = 1.f / se;
            float l1 = -3.0e38f, l2 = -3.0e38f; int i1 = 0, i2 = 0;
#pragma unroll
            for (int n = 0; n < 32; ++n) if ((n >> 3) == gi) { const float v = el[n]; const int e = n & 7;
                if (v > l1) { l2 = l1; i2 = i1; l1 = v; i1 = e; } else if (v > l2) { l2 = v; i2 = e; } }
            const float e2 = expf(l2 - l1); const float w1 = pg / (1.f + e2), w2 = pg * e2 / (1.f + e2);
            if (F.lane == 0) {
                const int tok = row0 + rr, ea = gi * EPG + i1, eb = gi * EPG + i2;
                const unsigned pa = __hip_atomic_fetch_add(&cntl[ea], 1u, __ATOMIC_RELAXED, __HIP_MEMORY_SCOPE_WORKGROUP), pb = __hip_atomic_fetch_add(&cntl[eb], 1u, __ATOMIC_RELAXED, __HIP_MEMORY_SCOPE_WORKGROUP);
                TOKSLOT[tok * 2] = (ea << 14) | (int)pa; TOKSLOT[tok * 2 + 1] = (eb << 14) | (int)pb;
                TOKW[tok * 2] = w1; TOKW[tok * 2 + 1] = w2;
            }
        }
    }
    __syncthreads();
    if (F.tid < NE) BC[grp * NE + F.tid] = (int)cntl[F.tid];
    __syncthreads();
    }
}

DI void build_tables(const Frame& F, int l, LAS int* tb) {
    if (F.tid < 64) {
        const int e = F.lane; const int c = e < NE ? ((const int*)(F.ws + WS_CNTF))[e] : 0; const int tl = (c + 255) >> 8;
        int cum = c, tin = tl;
#pragma unroll
        for (int o = 1; o < 32; o <<= 1) { const int a1 = __shfl_up(cum, o), a2 = __shfl_up(tin, o); if (e >= o) { cum += a1; tin += a2; } }
        if (e < NE) { tb[e] = cum - c; tb[33 + e] = (tin - tl) * 256; for (int t2 = 0; t2 < tl; ++t2) tb[66 + (tin - tl) + t2] = e; }
        if (e == NE - 1) { tb[32] = cum; tb[65] = tin; }
    }
    __syncthreads();
}
DI void p_gather(const Frame& F, int l) {
    LAS int* base = (LAS int*)F.lds;
    LAS int* segt = base + NGRP * NE;
    LAS int* offp = segt + 16 * NE;
    const int* BC = (const int*)(F.ws + WS_BC);
    { int tmp[NGRP * NE / NTHREADS];
#pragma unroll
      for (int q = 0; q < NGRP * NE / NTHREADS; ++q) tmp[q] = BC[F.tid + q * NTHREADS];
#pragma unroll
      for (int q = 0; q < NGRP * NE / NTHREADS; ++q) base[F.tid + q * NTHREADS] = tmp[q]; }
    __syncthreads();
    { const int e = F.tid & 31, sg = F.tid >> 5; int run = 0;
      for (int g = 16 * sg; g < 16 * sg + 16; ++g) { const int c = base[g * NE + e]; base[g * NE + e] = run; run += c; }
      segt[sg * NE + e] = run; }
    __syncthreads();
    if (F.tid < NE) { int run = 0; for (int sg = 0; sg < 16; ++sg) { const int c = segt[sg * NE + F.tid]; segt[sg * NE + F.tid] = run; run += c; }
        offp[F.tid] = run;
        if (F.bx == 0) ((int*)(F.ws + WS_CNTF))[F.tid] = run; }
    __syncthreads();
    if (F.tid == 0) { int off = 0; for (int e = 0; e < NE; ++e) { const int c = offp[e]; offp[e] = off; off += ((c + 255) >> 8) * 256; } }
    __syncthreads();
    const int* TOKSLOT = (const int*)(F.ws + WS_TOKSLOT); const float* TOKW = (const float*)(F.ws + WS_TOKW); int* TOKFIN = (int*)(F.ws + WS_TOKFIN);
    float* SLOTW = (float*)(F.ws + WS_SLOTW);
    const int nas = (2 * T - F.gw + F.ngw - 1) / F.ngw;
    int my_slot = 0, my_tok = 0;
    if (F.lane < nas) { const int as = F.gw + F.lane * F.ngw; const int tok = as >> 1, ts = TOKSLOT[as], e = ts >> 14, grp = tok >> 6, sg = grp >> 4;
        my_slot = offp[e] + segt[sg * NE + e] + base[grp * NE + e] + (ts & 16383); my_tok = tok;
        SLOTW[my_slot] = TOKW[as]; TOKFIN[as] = my_slot; ((int*)(F.ws + WS_CTL + WS_SLOTTOK))[my_slot] = tok; }
}
struct Rp2In { f32x4 x[4]; u32x2 y0[4], y1[4]; };
DI void rp2_load(Rp2In& r, const float* XA, const bf16_t* YS, int row, int s0, int s1, int lane) {
#pragma unroll
    for (int j = 0; j < 4; ++j) { const int col = 4 * lane + 256 * j;
        r.x[j] = *(const f32x4*)(XA + (size_t)row * D + col); r.y0[j] = *(const u32x2*)(YS + (size_t)s0 * D + col); r.y1[j] = *(const u32x2*)(YS + (size_t)s1 * D + col); }
}
DI void p_rowpass2(const Frame& F, const Args& a, int l, float* xout) {
    const float* MOD = (const float*)(F.ws + WS_MOD);
    const float* XA = (const float*)(F.ws + WS_XA); const bf16_t* YS = (const bf16_t*)(F.ws + WS_YS); const int* TOKFIN = (const int*)(F.ws + WS_TOKFIN);
    const float* gain = a.in[22] + (size_t)l * D; const float* bias = a.in[23] + (size_t)l * D;
    bf16_t* U = (bf16_t*)(F.ws + WS_U);
    const int nrows = (T - F.gw + F.ngw - 1) / F.ngw;
    int tf = 0; { const int i = F.lane >> 1; if (i < nrows) tf = TOKFIN[(F.gw + i * F.ngw) * 2 + (F.lane & 1)]; }
    Rp2In cur, nxt;
    if (nrows > 0) rp2_load(cur, XA, YS, F.gw, __shfl(tf, 0), __shfl(tf, 1), F.lane);
    for (int i = 0; i < nrows; ++i) {
        const int row = F.gw + i * F.ngw;
        if (i + 1 < nrows) rp2_load(nxt, XA, YS, row + F.ngw, __shfl(tf, 2 * i + 2), __shfl(tf, 2 * i + 3), F.lane);
        const float* md = MOD + (size_t)(l * NB + row / S) * MODW;
        f32x4 v[4];
#pragma unroll
        for (int j = 0; j < 4; ++j) { const int col = 4 * F.lane + 256 * j;
            const f32x4 g = *(const f32x4*)(md + 5 * D + col);
            const u32x2 y0 = cur.y0[j], y1 = cur.y1[j];
            const f32x4 f = (f32x4){bflo(y0.x) + bflo(y1.x), bfhi(y0.x) + bfhi(y1.x), bflo(y0.y) + bflo(y1.y), bfhi(y0.y) + bfhi(y1.y)};
            v[j] = cur.x[j] * ALPHA + g * f; }
        float mean, rstd; row_ln(v, mean, rstd);
#pragma unroll
        for (int j = 0; j < 4; ++j) { const int col = 4 * F.lane + 256 * j; v[j] = v[j] * rstd * *(const f32x4*)(gain + col) + *(const f32x4*)(bias + col); *(f32x4*)(xout + (size_t)row * D + col) = v[j]; }
        if (l + 1 < L) row_mod_store(v, MOD + (size_t)((l + 1) * NB + row / S) * MODW, 0, D, U + (size_t)row * D, F.lane);
        if (i + 1 < nrows) {
#pragma unroll
            for (int j = 0; j < 4; ++j) { cur.x[j] = nxt.x[j]; cur.y0[j] = nxt.y0[j]; cur.y1[j] = nxt.y1[j]; } }
    }
}

#define MFMA16(a, b, c) __builtin_amdgcn_mfma_f32_16x16x32_bf16((a), (b), (c), 0, 0, 0)
#define MFMA32(a, b, c) __builtin_amdgcn_mfma_f32_32x32x16_bf16((a), (b), (c), 0, 0, 0)
constexpr int RB = 9216;
#define BUF(i) ((i) * RB)
constexpr int LWOFF = BUF(12), ZAOFF = BUF(0), SEGOFF = BUF(14), SEGXOFF = BUF(14) + 2048, TOTOFF = BUF(14) + 4096, NABFOFF = BUF(15), PCOFF = 16 * RB;
struct RwP { const float *conv, *w0, *w_up, *a0, *a_up, *g_up, *k_k, *k_a, *r_k, *gn_gain, *gn_bias; };

DI void lds_barrier() { asm volatile("s_waitcnt lgkmcnt(0)" ::: "memory"); __builtin_amdgcn_s_barrier(); asm volatile("" ::: "memory"); }
DI bf16x8 ldfrag(const LAS unsigned char* lds, int buf, int row, int ks, int lane) { return *(const LAS bf16x8*)(lds + buf + row * 144 + (32 * ks + 8 * (lane >> 4)) * 2); }
DI f32x4 mm64(const LAS unsigned char* lds, int abuf, int arow0, int bbuf, int brow0, int lane) {
    f32x4 acc = (f32x4){0.f, 0.f, 0.f, 0.f};
#pragma unroll
    for (int ks = 0; ks < 2; ++ks) acc = MFMA16(ldfrag(lds, abuf, arow0 + (lane & 15), ks, lane), ldfrag(lds, bbuf, brow0 + (lane & 15), ks, lane), acc);
    return acc;
}
DI u32x2 pack4(const f32x4 v) { u32x2 w; w.x = cvtpk(v[0], v[1]); w.y = cvtpk(v[2], v[3]); return w; }
DI f32x4 unpack4(const u32x2 w) { return (f32x4){bflo(w.x), bfhi(w.x), bflo(w.y), bfhi(w.y)}; }
DI void st4(LAS unsigned char* lds, int buf, int row, int col, const f32x4 v) { *(LAS u32x2*)(lds + buf + row * 144 + col * 2) = pack4(v); }
DI f32x4 ld4(const LAS unsigned char* lds, int buf, int row, int col) { return unpack4(*(const LAS u32x2*)(lds + buf + row * 144 + col * 2)); }
DI void st1(LAS unsigned char* lds, int buf, int row, int col, float v) { *(LAS bf16_t*)(lds + buf + row * 144 + col * 2) = f2bf(v); }
DI float fast_tanh(float x) { const float e = fexp2(x * (2.f * LOG2E)); return 1.f - 2.f * frcp(1.f + e); }

#define OPQZ(z) int z; asm volatile("s_mov_b32 %0, 0" : "=s"(z))
constexpr int CWLOFF = PCOFF + 256;
constexpr int PRMOFF = CWLOFF + 6912;
struct RwPre { u32x2 wv, av; u32x4 gv; f32x4 w4, a4, g0, g1; u32x4 rr[3], kk[3], vv[3]; };
DI void rwkv_prefetch(const Frame& F, const Args& a, const int l, const int unit, RwPre& P) {
    const int tid = F.tid;
    const int c = unit % NCH, hd = (unit / NCH) % BH, b = (unit / (NCH * BH)) % NB, dir = unit / (NCH * BH * NB);
    const bf16_t* HBp = (const bf16_t*)(F.ws + WS_HB);
    const int u = tid >> 3, jg = tid & 7, tloc = 64 * c + u; const size_t tok = (size_t)b * S + tloc;
    const bf16_t* hrow = HBp + tok * HW;
    P.wv = *(const u32x2*)(hrow + HWL + 4 * jg); P.av = *(const u32x2*)(hrow + HAL + 4 * jg); P.gv = *(const u32x4*)(hrow + HGL + 8 * jg);
    OPQZ(z0);
    { const int m = tid >> 4, j4 = (tid & 15) * 4;
      const float* w_up = a.in[8 + z0] + (size_t)l * 2 * RW * BW; const float* a_up = a.in[10 + z0] + (size_t)l * 2 * RA * BW;
      P.w4 = *(const f32x4*)(w_up + (size_t)(dir * RW + m) * BW + hd * HD + j4); P.a4 = *(const f32x4*)(a_up + (size_t)(dir * RA + m) * BW + hd * HD + j4); }
    { const int m = tid >> 3, i8 = (tid & 7) * 8; const float* g_up = a.in[11 + z0] + (size_t)l * RG * BW;
      P.g0 = *(const f32x4*)(g_up + (size_t)m * BW + hd * HD + i8); P.g1 = *(const f32x4*)(g_up + (size_t)m * BW + hd * HD + i8 + 4); }
    const int ch0 = hd * HD + 8 * jg;
#pragma unroll
    for (int x = 0; x < 3; ++x) {
        const int tt = tloc + x - 1; const u32x4 z4 = (u32x4){0u, 0u, 0u, 0u};
        if (tt >= 0 && tt < S) { const bf16_t* hp = HBp + ((size_t)b * S + tt) * HW + HR + ch0; P.rr[x] = *(const u32x4*)hp; P.kk[x] = *(const u32x4*)(hp + BW); P.vv[x] = *(const u32x4*)(hp + 2 * BW); }
        else { P.rr[x] = z4; P.kk[x] = z4; P.vv[x] = z4; }
    }
}
DI void rwkv_local_unit(const Frame& F, const Args& a, const int l, const int unit, RwPre& PF, const int next_unit) {
    LAS unsigned char* lds = F.lds;
    int tid_ = F.tid; asm volatile("" : "+v"(tid_));
    const int tid = tid_, lane = tid_ & 63, wave = F.wave;
    const int c = unit % NCH, hd = (unit / NCH) % BH, b = (unit / (NCH * BH)) % NB, dir = unit / (NCH * BH * NB);
    const bf16_t* HBp = (const bf16_t*)(F.ws + WS_HB);
    const int u = tid >> 3, jg = tid & 7, tau = dir ? 63 - u : u, tloc = 64 * c + u;
    const size_t tok = (size_t)b * S + tloc;
    const int tn = wave & 3, tm0 = 2 * (wave >> 2), g4 = lane >> 4, l15 = lane & 15;
    if (tid < 320) { OPQZ(z2); const int which = tid >> 6, j = tid & 63;
      const float* src = which == 0 ? a.in[7 + z2] + (size_t)l * 2 * BW + dir * BW : which == 1 ? a.in[9 + z2] + (size_t)l * 2 * BW + dir * BW : which == 2 ? a.in[12 + z2] + (size_t)l * BW : which == 3 ? a.in[13 + z2] + (size_t)l * BW : a.in[14 + z2] + (size_t)l * BH * HD;
      *(LAS float*)(lds + PRMOFF + tid * 4) = src[hd * HD + j]; }
    {
        const f32x4 wf = unpack4(PF.wv);
        *(LAS u32x2*)(lds + BUF(8) + tau * 144 + (4 * jg) * 2) = pack4((f32x4){fast_tanh(wf[0]), fast_tanh(wf[1]), fast_tanh(wf[2]), fast_tanh(wf[3])});
        *(LAS u32x2*)(lds + BUF(8) + tau * 144 + (32 + 4 * jg) * 2) = PF.av;
        const u32x4 gv = PF.gv;
        u32x4 so; so.x = cvtpk(sigm(bflo(gv.x)), sigm(bfhi(gv.x))); so.y = cvtpk(sigm(bflo(gv.y)), sigm(bfhi(gv.y))); so.z = cvtpk(sigm(bflo(gv.z)), sigm(bfhi(gv.z))); so.w = cvtpk(sigm(bflo(gv.w)), sigm(bfhi(gv.w)));
        *(LAS u32x4*)(lds + BUF(9) + tau * 144 + 16 * jg) = so;
        { const int m = tid >> 4, j4 = (tid & 15) * 4;
#pragma unroll
          for (int e = 0; e < 4; ++e) { st1(lds, BUF(10), j4 + e, m, PF.w4[e]); st1(lds, BUF(10), j4 + e, 32 + m, PF.a4[e]); } }
        { const int m = tid >> 3, i8 = (tid & 7) * 8;
#pragma unroll
          for (int e = 0; e < 4; ++e) { st1(lds, BUF(11), i8 + e, m, PF.g0[e]); st1(lds, BUF(11), i8 + 4 + e, m, PF.g1[e]); } }
    }
    lds_barrier();
#pragma unroll
    for (int tmi = 0; tmi < 2; ++tmi) {
        const int tm = tm0 + tmi; const f32x4 z = (f32x4){0.f, 0.f, 0.f, 0.f};
        const f32x4 zw = MFMA16(ldfrag(lds, BUF(10), 16 * tm + l15, 0, lane), ldfrag(lds, BUF(8), 16 * tn + l15, 0, lane), z);
        const f32x4 za = MFMA16(ldfrag(lds, BUF(10), 16 * tm + l15, 1, lane), ldfrag(lds, BUF(8), 16 * tn + l15, 1, lane), z);
        const int trow = 16 * tn + l15, jb = 16 * tm + 4 * g4;
        *(LAS f32x4*)(lds + LWOFF + (trow * 64 + jb) * 4) = zw;
        *(LAS f32x4*)(lds + ZAOFF + (trow * 64 + jb) * 4) = za;
        if (dir == 0) {
            const f32x4 gg = mm64(lds, BUF(11), 16 * tm, BUF(9), 16 * tn, lane);
            *(u32x2*)((bf16_t*)(F.ws + WS_GB) + ((size_t)b * S + 64 * c + trow) * BW + hd * HD + jb) = pack4(gg);
        }
    }
    lds_barrier();
    const int ch0 = hd * HD + 8 * jg;
    float r[8], kd[8], kap[8], bb[8], lw[8];
    {
        float k[8], v[8];
#pragma unroll
        for (int e = 0; e < 8; ++e) { r[e] = 0.f; k[e] = 0.f; v[e] = 0.f; }
#pragma unroll
        for (int x = 0; x < 3; ++x) {
            const LAS unsigned char* cwp = lds + CWLOFF + (((hd * 3 + x) * 3) * 64 + 8 * jg) * 2;
            const u32x4 cr = *(const LAS u32x4*)cwp, ck = *(const LAS u32x4*)(cwp + 128), cv = *(const LAS u32x4*)(cwp + 256);
            const u32x4 rr = PF.rr[x], kk2 = PF.kk[x], vv = PF.vv[x];
            r[0] += bflo(rr.x) * bflo(cr.x); r[1] += bfhi(rr.x) * bfhi(cr.x); r[2] += bflo(rr.y) * bflo(cr.y); r[3] += bfhi(rr.y) * bfhi(cr.y);
            r[4] += bflo(rr.z) * bflo(cr.z); r[5] += bfhi(rr.z) * bfhi(cr.z); r[6] += bflo(rr.w) * bflo(cr.w); r[7] += bfhi(rr.w) * bfhi(cr.w);
            k[0] += bflo(kk2.x) * bflo(ck.x); k[1] += bfhi(kk2.x) * bfhi(ck.x); k[2] += bflo(kk2.y) * bflo(ck.y); k[3] += bfhi(kk2.y) * bfhi(ck.y);
            k[4] += bflo(kk2.z) * bflo(ck.z); k[5] += bfhi(kk2.z) * bfhi(ck.z); k[6] += bflo(kk2.w) * bflo(ck.w); k[7] += bfhi(kk2.w) * bfhi(ck.w);
            v[0] += bflo(vv.x) * bflo(cv.x); v[1] += bfhi(vv.x) * bfhi(cv.x); v[2] += bflo(vv.y) * bflo(cv.y); v[3] += bfhi(vv.y) * bfhi(cv.y);
            v[4] += bflo(vv.z) * bflo(cv.z); v[5] += bfhi(vv.z) * bfhi(cv.z); v[6] += bflo(vv.w) * bflo(cv.w); v[7] += bfhi(vv.w) * bfhi(cv.w);
        }
        const f32x4 zw0 = *(const LAS f32x4*)(lds + LWOFF + (tau * 64 + 8 * jg) * 4), zw1 = *(const LAS f32x4*)(lds + LWOFF + (tau * 64 + 8 * jg + 4) * 4);
        const f32x4 za0 = *(const LAS f32x4*)(lds + ZAOFF + (tau * 64 + 8 * jg) * 4), za1 = *(const LAS f32x4*)(lds + ZAOFF + (tau * 64 + 8 * jg + 4) * 4);
        float ss = 0.f, bsp = 0.f, av[8];
        const LAS f32x4* prm = (const LAS f32x4*)(lds + PRMOFF) + 2 * jg;
        const f32x4 w0a = prm[0], w0b = prm[1], a0a = prm[16], a0b = prm[17], kka = prm[32], kkb = prm[33], kaa = prm[48], kab = prm[49], rka = prm[64], rkb = prm[65];
#pragma unroll
        for (int e = 0; e < 8; ++e) {
            const float zw = (e < 4 ? zw0[e & 3] : zw1[e & 3]) + (e < 4 ? w0a[e & 3] : w0b[e & 3]);
            const float za = (e < 4 ? za0[e & 3] : za1[e & 3]) + (e < 4 ? a0a[e & 3] : a0b[e & 3]);
            lw[e] = (-DECAY * LOG2E) * sigm(zw); av[e] = sigm(za);
            kap[e] = k[e] * (e < 4 ? kka[e & 3] : kkb[e & 3]); ss += kap[e] * kap[e];
            kd[e] = k[e] * (1.f + (av[e] - 1.f) * (e < 4 ? kaa[e & 3] : kab[e & 3]));
            bsp += r[e] * kd[e] * (e < 4 ? rka[e & 3] : rkb[e & 3]);
        }
        ss += __shfl_xor(ss, 1); ss += __shfl_xor(ss, 2); ss += __shfl_xor(ss, 4);
        bsp += __shfl_xor(bsp, 1); bsp += __shfl_xor(bsp, 2); bsp += __shfl_xor(bsp, 4);
        const float rn = __builtin_amdgcn_rsqf(fmaxf(ss, 1e-24f));
#pragma unroll
        for (int e = 0; e < 8; ++e) { kap[e] *= rn; bb[e] = kap[e] * av[e]; }
        if (jg == 0) ((float*)(F.ws + WS_BS))[((size_t)dir * T + tok) * 8 + hd] = bsp;
        *(LAS f32x4*)(lds + LWOFF + (tau * 64 + 8 * jg) * 4) = (f32x4){lw[0], lw[1], lw[2], lw[3]};
        *(LAS f32x4*)(lds + LWOFF + (tau * 64 + 8 * jg + 4) * 4) = (f32x4){lw[4], lw[5], lw[6], lw[7]};
#pragma unroll
        for (int e = 0; e < 8; ++e) st1(lds, BUF(7), 8 * jg + e, tau, v[e]);
        if (dir == 0) {
            u32x4 vo; vo.x = cvtpk(v[0], v[1]); vo.y = cvtpk(v[2], v[3]); vo.z = cvtpk(v[4], v[5]); vo.w = cvtpk(v[6], v[7]);
            *(u32x4*)((bf16_t*)(F.ws + WS_VC) + tok * BW + ch0) = vo;
        }
    }
    lds_barrier();
    if (dir == 0) {
        const size_t ucidx = ((size_t)b * BH + hd) * NCH + c; const int vi = tid >> 3, vc = tid & 7;
        *(u32x4*)((bf16_t*)(F.ws + WS_VTB) + ucidx * 4096 + vi * 64 + vc * 8) = *(const LAS u32x4*)(lds + BUF(7) + vi * 144 + vc * 16);
    }
    { const int seg = tid >> 6, j = tid & 63; float p = 0.f;
#pragma unroll
      for (int i = 0; i < 8; ++i) { LAS float* q = (LAS float*)(lds + LWOFF + ((8 * seg + i) * 64 + j) * 4); p += *q; *q = p; }
      *(LAS float*)(lds + SEGOFF + (seg * 64 + j) * 4) = p; }
    lds_barrier();
    if (tid < 64) { float run = 0.f;
#pragma unroll
      for (int sg = 0; sg < 8; ++sg) { *(LAS float*)(lds + SEGXOFF + (sg * 64 + tid) * 4) = run; run += *(const LAS float*)(lds + SEGOFF + (sg * 64 + tid) * 4); }
      *(LAS float*)(lds + TOTOFF + tid * 4) = run; }
    lds_barrier();
    {
        float At[8], Rt[8], Bt[8], Kt[8], Bh[8], Kh[8];
#pragma unroll
        for (int e = 0; e < 8; ++e) {
            const int j = 8 * jg + e;
            const float lwi = *(const LAS float*)(lds + LWOFF + (tau * 64 + j) * 4) + *(const LAS float*)(lds + SEGXOFF + ((tau >> 3) * 64 + j) * 4);
            const float tot = *(const LAS float*)(lds + TOTOFF + j * 4);
            const float ep = fexp2(lwi - lw[e]), epl = fexp2(lwi), em = fexp2(-lwi), ec = fexp2(tot - lwi);
            At[e] = -kap[e] * ep; Rt[e] = r[e] * epl; Bt[e] = bb[e] * em; Kt[e] = kd[e] * em; Bh[e] = bb[e] * ec; Kh[e] = kd[e] * ec;
            if (u == 0) *(LAS float*)(lds + PCOFF + j * 4) = fexp2(tot);
        }
        u32x4 o;
#define PK8(X) (o.x = cvtpk(X[0], X[1]), o.y = cvtpk(X[2], X[3]), o.z = cvtpk(X[4], X[5]), o.w = cvtpk(X[6], X[7]), o)
        *(LAS u32x4*)(lds + BUF(0) + tau * 144 + 16 * jg) = PK8(At);
        *(LAS u32x4*)(lds + BUF(1) + tau * 144 + 16 * jg) = PK8(Bt);
        *(LAS u32x4*)(lds + BUF(2) + tau * 144 + 16 * jg) = PK8(Kt);
        *(LAS u32x4*)(lds + BUF(3) + tau * 144 + 16 * jg) = PK8(Rt);
#undef PK8
#pragma unroll
        for (int e = 0; e < 8; ++e) { const int j = 8 * jg + e; st1(lds, BUF(4), j, tau, At[e]); st1(lds, BUF(5), j, tau, Bh[e]); st1(lds, BUF(6), j, tau, Kh[e]); }
    }
    if (next_unit >= 0) rwkv_prefetch(F, a, l, next_unit, PF);
    lds_barrier();
#pragma unroll
    for (int tmi = 0; tmi < 2; ++tmi) {
        const int tm = tm0 + tmi, mb = 16 * tm + 4 * g4, nn = 16 * tn + l15;
        { f32x4 v = mm64(lds, BUF(1), 16 * tm, BUF(0), 16 * tn, lane);
#pragma unroll
          for (int e = 0; e < 4; ++e) v[e] = (mb + e < nn) ? v[e] : 0.f;
          if (tm == tn) {
#pragma unroll
              for (int e = 0; e < 4; ++e) *(LAS float*)(lds + NABFOFF + ((16 * tm + l15) * 16 + ((mb + e) & 15)) * 4) = v[e];
              v = (f32x4){0.f, 0.f, 0.f, 0.f};
          }
          st4(lds, BUF(11), nn, mb, v); }
        { f32x4 v = mm64(lds, BUF(0), 16 * tm, BUF(2), 16 * tn, lane);
#pragma unroll
          for (int e = 0; e < 4; ++e) v[e] = (nn < mb + e) ? v[e] : 0.f;
          st4(lds, BUF(8), nn, mb, v); }
        { f32x4 v = mm64(lds, BUF(1), 16 * tm, BUF(3), 16 * tn, lane);
#pragma unroll
          for (int e = 0; e < 4; ++e) v[e] = (mb + e <= nn) ? v[e] : 0.f;
          st4(lds, BUF(9), nn, mb, v); }
        { f32x4 v = mm64(lds, BUF(2), 16 * tm, BUF(3), 16 * tn, lane);
#pragma unroll
          for (int e = 0; e < 4; ++e) v[e] = (mb + e <= nn) ? v[e] : 0.f;
          st4(lds, BUF(10), nn, mb, v); }
    }
    lds_barrier();
    if (wave == 0) {
        const int blk = lane >> 4, sr = lane & 15, s = 16 * blk + sr;
        float Tr[16];
#pragma unroll
        for (int t = 0; t < 16; ++t) { float acc = (t == sr) ? 1.f : 0.f;
            const LAS f32x4* col = (const LAS f32x4*)(lds + NABFOFF + ((16 * blk + t) * 16) * 4);
#pragma unroll
            for (int q = 0; q < (t + 3) / 4; ++q) { const f32x4 nv = col[q];
#pragma unroll
                for (int e = 0; e < 4; ++e) if (4 * q + e < t) acc += Tr[4 * q + e] * nv[e]; }
            Tr[t] = acc; __builtin_amdgcn_sched_barrier(0); }
        const u32x4 z4 = (u32x4){0u, 0u, 0u, 0u};
#pragma unroll
        for (int q = 0; q < 9; ++q) { *(LAS u32x4*)(lds + BUF(0) + s * 144 + 16 * q) = z4; *(LAS u32x4*)(lds + BUF(1) + s * 144 + 16 * q) = z4; }
        u32x4 o0, o1; o0.x = cvtpk(Tr[0], Tr[1]); o0.y = cvtpk(Tr[2], Tr[3]); o0.z = cvtpk(Tr[4], Tr[5]); o0.w = cvtpk(Tr[6], Tr[7]);
        o1.x = cvtpk(Tr[8], Tr[9]); o1.y = cvtpk(Tr[10], Tr[11]); o1.z = cvtpk(Tr[12], Tr[13]); o1.w = cvtpk(Tr[14], Tr[15]);
        LDS_WAIT();
        *(LAS u32x4*)(lds + BUF(0) + s * 144 + 32 * blk) = o0; *(LAS u32x4*)(lds + BUF(0) + s * 144 + 32 * blk + 16) = o1;
#pragma unroll
        for (int t = 0; t < 16; ++t) st1(lds, BUF(1), 16 * blk + t, s, Tr[t]);
    }
    lds_barrier();
#pragma unroll
    for (int tmi = 0; tmi < 2; ++tmi) {
        const int tm = tm0 + tmi, mb = 16 * tm + 4 * g4, nn = 16 * tn + l15;
        const f32x4 v = mm64(lds, BUF(0), 16 * tm, BUF(11), 16 * tn, lane);
        st4(lds, BUF(12), nn, mb, v);
#pragma unroll
        for (int e = 0; e < 4; ++e) st1(lds, BUF(2), mb + e, nn, v[e]);
    }
    lds_barrier();
#pragma unroll
    for (int tmi = 0; tmi < 2; ++tmi) {
        const int tm = tm0 + tmi, mb = 16 * tm + 4 * g4, nn = 16 * tn + l15;
        const f32x4 v = mm64(lds, BUF(12), 16 * tm, BUF(2), 16 * tn, lane);
        st4(lds, BUF(13), nn, mb, v);
    }
    lds_barrier();
#pragma unroll
    for (int tmi = 0; tmi < 2; ++tmi) {
        const int tm = tm0 + tmi, mb = 16 * tm + 4 * g4, nn = 16 * tn + l15;
        const f32x4 v = mm64(lds, BUF(13), 16 * tm, BUF(1), 16 * tn, lane) + ld4(lds, BUF(1), nn, mb);
        st4(lds, BUF(14), nn, mb, v);
    }
    lds_barrier();
#pragma unroll
    for (int tmi = 0; tmi < 2; ++tmi) {
        const int tm = tm0 + tmi, mb = 16 * tm + 4 * g4, nn = 16 * tn + l15;
        const f32x4 v = mm64(lds, BUF(2), 16 * tm, BUF(14), 16 * tn, lane) + ld4(lds, BUF(14), nn, mb);
        st4(lds, BUF(15), nn, mb, v);
    }
    lds_barrier();
#pragma unroll
    for (int tmi = 0; tmi < 2; ++tmi) {
        const int tm = tm0 + tmi, mb = 16 * tm + 4 * g4, nn = 16 * tn + l15;
        const f32x4 x1 = mm64(lds, BUF(15), 16 * tm, BUF(4), 16 * tn, lane);
        const f32x4 x2 = mm64(lds, BUF(15), 16 * tm, BUF(8), 16 * tn, lane);
        st4(lds, BUF(0), nn, mb, x1); st4(lds, BUF(1), nn, mb, x2);
    }
    lds_barrier();
    {
        bf16_t* QT = (bf16_t*)(F.ws + WS_QT) + (size_t)unit * 4096; bf16_t* WT = (bf16_t*)(F.ws + WS_WT) + (size_t)unit * 4096; bf16_t* MP = (bf16_t*)(F.ws + WS_MP) + (size_t)unit * 4096;
#pragma unroll
        for (int tmi = 0; tmi < 2; ++tmi) {
            const int tm = tm0 + tmi, mb = 16 * tm + 4 * g4, nn = 16 * tn + l15;
            { const f32x4 v = mm64(lds, BUF(0), 16 * tm, BUF(9), 16 * tn, lane) + ld4(lds, BUF(3), nn, mb);
              *(u32x2*)(QT + (dir ? 63 - nn : nn) * 64 + mb) = pack4(v); }
            { const f32x4 v = mm64(lds, BUF(1), 16 * tm, BUF(9), 16 * tn, lane) + ld4(lds, BUF(10), nn, mb);
              if (dir) *(u32x2*)(WT + (63 - nn) * 64 + (60 - mb)) = pack4((f32x4){v[3], v[2], v[1], v[0]});
              else *(u32x2*)(WT + nn * 64 + mb) = pack4(v); }
            { f32x4 v = mm64(lds, BUF(0), 16 * tm, BUF(5), 16 * tn, lane);
#pragma unroll
              for (int e = 0; e < 4; ++e) if (mb + e == nn) v[e] += *(const LAS float*)(lds + PCOFF + nn * 4);
              *(u32x2*)(MP + nn * 64 + swap23(mb)) = pack4(v); }
            { const f32x4 v = mm64(lds, BUF(1), 16 * tm, BUF(5), 16 * tn, lane) + ld4(lds, BUF(6), nn, mb);
              st4(lds, BUF(2), nn, mb, v); }
        }
    }
    lds_barrier();
    {
        bf16_t* NBp = (bf16_t*)(F.ws + WS_NB);
#pragma unroll
        for (int tmi = 0; tmi < 2; ++tmi) {
            const int tm = tm0 + tmi, mb = 16 * tm + 4 * g4, ii = 16 * tn + l15;
            const f32x4 v = mm64(lds, BUF(2), 16 * tm, BUF(7), 16 * tn, lane);
            const int jb = mb >> 5, jl = mb & 31, q = jl >> 3, hic = (jl >> 2) & 1, ih = ii >> 5, Lc = (ii & 31) + 32 * hic;
            *(u32x2*)(NBp + ((((size_t)unit * 2 + ih) * 2 + jb) * 2 + (q >> 1)) * 512 + Lc * 8 + 4 * (q & 1)) = pack4(v);
        }
    }
    lds_barrier();
}

DI void attn_unit(const Frame& F, const LAS float* rpbl, const int au) {
    const bf16_t* HBp = (const bf16_t*)(F.ws + WS_HB); const bf16_t* VTp = (const bf16_t*)(F.ws + WS_VT); bf16_t* CONCAT = (bf16_t*)(F.ws + WS_CONCAT);
    const int hh = au % AH, r = (au / AH) % ROWS, b = au / (AH * ROWS);
    int rstart = r - KH / 2; rstart = rstart < 0 ? 0 : (rstart > ROWS - KH ? ROWS - KH : rstart);
    const int lane = F.lane, q32 = lane & 31, hi = lane >> 5;
    const float SC = 0.125f * LOG2E;
    const int krow_off = swap23(q32);
    const int cqA = q32, cqB = 32 + q32;
    int csA = cqA - KW / 2; csA = csA < 0 ? 0 : csA; int csB = cqB - KW / 2; csB = csB > GW - KW ? GW - KW : csB;
    const size_t tokA = (size_t)b * S + r * GW + cqA, tokB = tokA + 32;
    bf16x8 qfA[4], qfB[4];
#pragma unroll
    for (int ds = 0; ds < 4; ++ds) { qfA[ds] = *(const bf16x8*)(HBp + tokA * HW + HQ + hh * HD + 16 * ds + 8 * hi); qfB[ds] = *(const bf16x8*)(HBp + tokB * HW + HQ + hh * HD + 16 * ds + 8 * hi); }
    f32x16 oA0, oA1, oB0, oB1;
#pragma unroll
    for (int i = 0; i < 16; ++i) { oA0[i] = 0.f; oA1[i] = 0.f; oB0[i] = 0.f; oB1[i] = 0.f; }
    float mA = -1e30f, lA = 0.f, mB = -1e30f, lB = 0.f;
#pragma unroll 1
    for (int kt = 0; kt < 2 * KH; ++kt) {
        const int kr = rstart + (kt >> 1), ckb = 32 * (kt & 1);
        const size_t ktok = (size_t)b * S + kr * GW + ckb;
        bf16x8 kf[4], vf[2][2];
#pragma unroll
        for (int ds = 0; ds < 4; ++ds) kf[ds] = *(const bf16x8*)(HBp + (ktok + krow_off) * HW + HK + hh * HD + 16 * ds + 8 * hi);
#pragma unroll
        for (int db = 0; db < 2; ++db)
#pragma unroll
            for (int s = 0; s < 2; ++s) vf[db][s] = *(const bf16x8*)(VTp + (size_t)(hh * HD + 32 * db + q32) * T + ktok + 16 * s + 8 * hi);
        const LAS float* rp = rpbl + (hh * (2 * KH - 1) + (kr - r + KH - 1)) * (2 * KW - 1);
#pragma unroll
        for (int qb = 0; qb < 2; ++qb) {
            const int cq = qb ? cqB : cqA, cs = qb ? csB : csA;
            f32x16 st;
#pragma unroll
            for (int i = 0; i < 16; ++i) st[i] = 0.f;
#pragma unroll
            for (int ds = 0; ds < 4; ++ds) st = MFMA32(kf[ds], qb ? qfB[ds] : qfA[ds], st);
            float sl[16]; float tmax = -1e30f;
#pragma unroll
            for (int i = 0; i < 16; ++i) {
                const int ck = ckb + 16 * (i >> 3) + 8 * hi + (i & 7);
                const bool inw = (ck >= cs) && (ck < cs + KW);
                int dc = ck - cq; dc = dc < -(KW - 1) ? -(KW - 1) : (dc > KW - 1 ? KW - 1 : dc); dc += KW - 1;
                sl[i] = inw ? st[i] * SC + rp[dc] : -1e30f;
                tmax = fmaxf(tmax, sl[i]);
            }
            tmax = fmaxf(tmax, __shfl_xor(tmax, 32));
            const float mrun = qb ? mB : mA;
            const float mn = fmaxf(mrun, tmax), corr = __builtin_amdgcn_exp2f(mrun - mn);
            float ps = 0.f;
#pragma unroll
            for (int i = 0; i < 16; ++i) { sl[i] = (sl[i] > -1e29f) ? __builtin_amdgcn_exp2f(sl[i] - mn) : 0.f; ps += sl[i]; }
            u32x4 p0, p1;
            p0.x = cvtpk(sl[0], sl[1]); p0.y = cvtpk(sl[2], sl[3]); p0.z = cvtpk(sl[4], sl[5]); p0.w = cvtpk(sl[6], sl[7]);
            p1.x = cvtpk(sl[8], sl[9]); p1.y = cvtpk(sl[10], sl[11]); p1.z = cvtpk(sl[12], sl[13]); p1.w = cvtpk(sl[14], sl[15]);
            const bf16x8 pf0 = __builtin_bit_cast(bf16x8, p0), pf1 = __builtin_bit_cast(bf16x8, p1);
            if (qb == 0) { lA = lA * corr + ps; mA = mn;
#pragma unroll
                for (int i = 0; i < 16; ++i) { oA0[i] *= corr; oA1[i] *= corr; }
                oA0 = MFMA32(vf[0][0], pf0, oA0); oA0 = MFMA32(vf[0][1], pf1, oA0); oA1 = MFMA32(vf[1][0], pf0, oA1); oA1 = MFMA32(vf[1][1], pf1, oA1);
            } else { lB = lB * corr + ps; mB = mn;
#pragma unroll
                for (int i = 0; i < 16; ++i) { oB0[i] *= corr; oB1[i] *= corr; }
                oB0 = MFMA32(vf[0][0], pf0, oB0); oB0 = MFMA32(vf[0][1], pf1, oB0); oB1 = MFMA32(vf[1][0], pf0, oB1); oB1 = MFMA32(vf[1][1], pf1, oB1);
            }
        }
    }
    { const float inv = 1.f / (lA + __shfl_xor(lA, 32)); bf16_t* op = CONCAT + tokA * D + hh * HD;
#pragma unroll
      for (int g = 0; g < 4; ++g) {
          *(u32x2*)(op + 8 * g + 4 * hi) = pack4((f32x4){oA0[4 * g] * inv, oA0[4 * g + 1] * inv, oA0[4 * g + 2] * inv, oA0[4 * g + 3] * inv});
          *(u32x2*)(op + 32 + 8 * g + 4 * hi) = pack4((f32x4){oA1[4 * g] * inv, oA1[4 * g + 1] * inv, oA1[4 * g + 2] * inv, oA1[4 * g + 3] * inv}); } }
    { const float inv = 1.f / (lB + __shfl_xor(lB, 32)); bf16_t* op = CONCAT + tokB * D + hh * HD;
#pragma unroll
      for (int g = 0; g < 4; ++g) {
          *(u32x2*)(op + 8 * g + 4 * hi) = pack4((f32x4){oB0[4 * g] * inv, oB0[4 * g + 1] * inv, oB0[4 * g + 2] * inv, oB0[4 * g + 3] * inv});
          *(u32x2*)(op + 32 + 8 * g + 4 * hi) = pack4((f32x4){oB1[4 * g] * inv, oB1[4 * g + 1] * inv, oB1[4 * g + 2] * inv, oB1[4 * g + 3] * inv}); } }
}

DI void pool_unit(const Frame& F, const float* pool_w, const float* pool_scale, const int pu) {
    const bf16_t* HBp = (const bf16_t*)(F.ws + WS_HB); bf16_t* CONCAT = (bf16_t*)(F.ws + WS_CONCAT);
    const int g = pu & 3, blk = pu >> 2, b = blk >> 8, t0 = (blk & 255) * 32;
    const int lane = F.lane, q32 = lane & 31, hi = lane >> 5, t = t0 + q32, win = 2 << g;
    int lo = t - win / 2; lo = lo < 0 ? 0 : lo; int hit = t + win / 2 - 1; hit = hit > S - 1 ? S - 1 : hit;
    const float inv = 1.f / (float)(hit - lo + 1);
    f32x16 out0, out1;
#pragma unroll
    for (int i = 0; i < 16; ++i) { out0[i] = 0.f; out1[i] = 0.f; }
    const float* pw = pool_w + (size_t)g * 64 * 64;
#pragma unroll 1
    for (int s = 0; s < 4; ++s) {
        const int c0 = HP + g * 64 + 16 * s + 8 * hi;
        float acc[8];
#pragma unroll
        for (int e = 0; e < 8; ++e) acc[e] = 0.f;
        u32x4 pv[16];
#pragma unroll
        for (int d = 0; d < 16; ++d) { int tt = t - win / 2 + d; const bool ok = d < win && tt >= 0 && tt < S; tt = ok ? tt : t;
            pv[d] = *(const u32x4*)(HBp + ((size_t)b * S + tt) * HW + c0); if (!ok) pv[d] = (u32x4){0u, 0u, 0u, 0u}; }
#pragma unroll
        for (int d = 0; d < 16; ++d) {
            acc[0] += bflo(pv[d].x); acc[1] += bfhi(pv[d].x); acc[2] += bflo(pv[d].y); acc[3] += bfhi(pv[d].y); acc[4] += bflo(pv[d].z); acc[5] += bfhi(pv[d].z); acc[6] += bflo(pv[d].w); acc[7] += bfhi(pv[d].w);
        }
        const u32x4 pc = *(const u32x4*)(HBp + ((size_t)b * S + t) * HW + c0);
        u32x4 o;
        o.x = cvtpk(acc[0] * inv - bflo(pc.x), acc[1] * inv - bfhi(pc.x)); o.y = cvtpk(acc[2] * inv - bflo(pc.y), acc[3] * inv - bfhi(pc.y));
        o.z = cvtpk(acc[4] * inv - bflo(pc.z), acc[5] * inv - bfhi(pc.z)); o.w = cvtpk(acc[6] * inv - bflo(pc.w), acc[7] * inv - bfhi(pc.w));
        const bf16x8 bfr = __builtin_bit_cast(bf16x8, o);
        const float* wp = pw + (size_t)(16 * s + 8 * hi) * 64 + q32;
        u32x4 w0; w0.x = cvtpk(wp[0], wp[64]); w0.y = cvtpk(wp[128], wp[192]); w0.z = cvtpk(wp[256], wp[320]); w0.w = cvtpk(wp[384], wp[448]);
        u32x4 w1; w1.x = cvtpk(wp[32], wp[96]); w1.y = cvtpk(wp[160], wp[224]); w1.z = cvtpk(wp[288], wp[352]); w1.w = cvtpk(wp[416], wp[480]);
        out0 = MFMA32(__builtin_bit_cast(bf16x8, w0), bfr, out0);
        out1 = MFMA32(__builtin_bit_cast(bf16x8, w1), bfr, out1);
    }
    bf16_t* op = CONCAT + ((size_t)b * S + t) * D + AW + BW + g * 64;
    const float* ps = pool_scale + g * 64;
#pragma unroll
    for (int gq = 0; gq < 4; ++gq) {
        const int e0 = 8 * gq + 4 * hi;
        const f32x4 s0 = *(const f32x4*)(ps + e0), s1 = *(const f32x4*)(ps + 32 + e0);
        *(u32x2*)(op + e0) = pack4((f32x4){out0[4 * gq] * s0[0], out0[4 * gq + 1] * s0[1], out0[4 * gq + 2] * s0[2], out0[4 * gq + 3] * s0[3]});
        *(u32x2*)(op + 32 + e0) = pack4((f32x4){out1[4 * gq] * s1[0], out1[4 * gq + 1] * s1[1], out1[4 * gq + 2] * s1[2], out1[4 * gq + 3] * s1[3]});
    }
}

constexpr int SCAN_SLOT = 12288, SCAN_RING = 12;
constexpr int SCAN_FLAGS = SCAN_RING * SCAN_SLOT;
DI void scan_issue(const Frame& F, const int sc, const int ihalf, const int dir, const int step, const int lane) {
    const int c = dir ? NCH - 1 - step : step; const size_t unit = (size_t)sc * NCH + c;
    const int il = lane & 31, hi = lane >> 5;
    LAS unsigned char* slot = F.lds + (step % SCAN_RING) * SCAN_SLOT;
    const bf16_t* MP = (const bf16_t*)(F.ws + WS_MP) + unit * 4096; const bf16_t* NBp = (const bf16_t*)(F.ws + WS_NB) + (unit * 2 + ihalf) * 2048;
#pragma unroll
    for (int p = 0; p < 8; ++p) { const int jpb = p >> 2, jb = (p >> 1) & 1, s = p & 1;
        __builtin_amdgcn_global_load_lds((const unsigned*)(MP + (32 * jpb + il) * 64 + 32 * jb + 16 * s + 8 * hi), (LAS unsigned*)(slot + p * 1024), 16, 0, 0); }
#pragma unroll
    for (int p = 0; p < 4; ++p)
        __builtin_amdgcn_global_load_lds((const unsigned*)(NBp + p * 512 + lane * 8), (LAS unsigned*)(slot + 8192 + p * 1024), 16, 0, 0);
}
DI unsigned lds_ld_u32(const volatile LAS unsigned* p) { return __builtin_amdgcn_readfirstlane(*p); }
DI void scan_loader(const Frame& F, const int sw, const int ld) {
    const int ihalf = sw & 1, sc = sw >> 1, dir = sc / (NB * BH);
    volatile LAS unsigned* ready = (volatile LAS unsigned*)(F.lds + SCAN_FLAGS); volatile LAS unsigned* cons = ready + 16;
    const int nmine = NCH / 2;
    for (int k = 0; k < nmine + 5; ++k) {
        if (k < nmine) {
            const int s = 2 * k + ld;
            if (s >= SCAN_RING) { unsigned spins = 0; while ((int)lds_ld_u32(cons) < s - SCAN_RING + 1) { __builtin_amdgcn_s_sleep(1); if (++spins > (1u << 22)) break; } }
            asm volatile("" ::: "memory");
            scan_issue(F, sc, ihalf, dir, s, F.lane);
        }
        if (k >= 4) {
            const int kd = k - 4;
            if (kd < nmine) {
                const int rem = nmine - 1 - kd;
                if (rem >= 4) asm volatile("s_waitcnt vmcnt(48)" ::: "memory");
                else if (rem == 3) asm volatile("s_waitcnt vmcnt(36)" ::: "memory");
                else if (rem == 2) asm volatile("s_waitcnt vmcnt(24)" ::: "memory");
                else if (rem == 1) asm volatile("s_waitcnt vmcnt(12)" ::: "memory");
                else asm volatile("s_waitcnt vmcnt(0)" ::: "memory");
                const int sd = 2 * kd + ld;
                if (F.lane == 0) ready[sd % SCAN_RING] = (unsigned)(sd + 1);
                asm volatile("s_waitcnt lgkmcnt(0)" ::: "memory");
            }
        }
    }
}
DI void scan_wave(const Frame& F, const int sw) {
    const int ihalf = sw & 1, sc = sw >> 1, dir = sc / (NB * BH);
    const int lane = F.lane, il = lane & 31, hi = lane >> 5;
    bf16_t* S0 = (bf16_t*)(F.ws + WS_S0);
    volatile LAS unsigned* ready = (volatile LAS unsigned*)(F.lds + SCAN_FLAGS); volatile LAS unsigned* cons = ready + 16;
    f32x16 st0, st1;
#pragma unroll
    for (int i = 0; i < 16; ++i) { st0[i] = 0.f; st1[i] = 0.f; }
    bf16x8 ma[8], man[8]; u32x4 nbv[4], nbn[4];
    { unsigned spins = 0; while (lds_ld_u32(ready) != 1u) { __builtin_amdgcn_s_sleep(1); if (++spins > (1u << 22)) break; } }
    asm volatile("" ::: "memory");
#pragma unroll
    for (int p = 0; p < 8; ++p) ma[p] = *(const LAS bf16x8*)(F.lds + p * 1024 + lane * 16);
#pragma unroll
    for (int p = 0; p < 4; ++p) nbv[p] = *(const LAS u32x4*)(F.lds + 8192 + p * 1024 + lane * 16);
#pragma unroll 1
    for (int step = 0; step < NCH; ++step) {
        const int c = dir ? NCH - 1 - step : step; const size_t unit = (size_t)sc * NCH + c;
        const bool more = step + 1 < NCH;
        if (more) {
            { unsigned spins = 0; while (lds_ld_u32(ready + ((step + 1) % SCAN_RING)) != (unsigned)(step + 2)) { __builtin_amdgcn_s_sleep(1); if (++spins > (1u << 22)) break; } }
            asm volatile("" ::: "memory");
            const LAS unsigned char* slot = F.lds + ((step + 1) % SCAN_RING) * SCAN_SLOT;
#pragma unroll
            for (int p = 0; p < 8; ++p) man[p] = *(const LAS bf16x8*)(slot + p * 1024 + lane * 16);
#pragma unroll
            for (int p = 0; p < 4; ++p) nbn[p] = *(const LAS u32x4*)(slot + 8192 + p * 1024 + lane * 16);
        }
        bf16_t* sp = S0 + unit * 4096 + (size_t)(32 * ihalf + il) * 64;
        u32x4 b00, b01, b10, b11;
        b00.x = cvtpk(st0[0], st0[1]); b00.y = cvtpk(st0[2], st0[3]); b00.z = cvtpk(st0[4], st0[5]); b00.w = cvtpk(st0[6], st0[7]);
        b01.x = cvtpk(st0[8], st0[9]); b01.y = cvtpk(st0[10], st0[11]); b01.z = cvtpk(st0[12], st0[13]); b01.w = cvtpk(st0[14], st0[15]);
        b10.x = cvtpk(st1[0], st1[1]); b10.y = cvtpk(st1[2], st1[3]); b10.z = cvtpk(st1[4], st1[5]); b10.w = cvtpk(st1[6], st1[7]);
        b11.x = cvtpk(st1[8], st1[9]); b11.y = cvtpk(st1[10], st1[11]); b11.z = cvtpk(st1[12], st1[13]); b11.w = cvtpk(st1[14], st1[15]);
        *(u32x2*)(sp + 0 + 4 * hi) = (u32x2){b00.x, b00.y};  *(u32x2*)(sp + 8 + 4 * hi) = (u32x2){b00.z, b00.w};
        *(u32x2*)(sp + 16 + 4 * hi) = (u32x2){b01.x, b01.y}; *(u32x2*)(sp + 24 + 4 * hi) = (u32x2){b01.z, b01.w};
        *(u32x2*)(sp + 32 + 4 * hi) = (u32x2){b10.x, b10.y}; *(u32x2*)(sp + 40 + 4 * hi) = (u32x2){b10.z, b10.w};
        *(u32x2*)(sp + 48 + 4 * hi) = (u32x2){b11.x, b11.y}; *(u32x2*)(sp + 56 + 4 * hi) = (u32x2){b11.z, b11.w};
        const bf16x8 p00 = __builtin_bit_cast(bf16x8, b00), p01 = __builtin_bit_cast(bf16x8, b01), p10 = __builtin_bit_cast(bf16x8, b10), p11 = __builtin_bit_cast(bf16x8, b11);
        f32x16 n0, n1;
#pragma unroll
        for (int h2 = 0; h2 < 2; ++h2) {
            n0[8 * h2 + 0] = bflo(nbv[h2].x); n0[8 * h2 + 1] = bfhi(nbv[h2].x); n0[8 * h2 + 2] = bflo(nbv[h2].y); n0[8 * h2 + 3] = bfhi(nbv[h2].y);
            n0[8 * h2 + 4] = bflo(nbv[h2].z); n0[8 * h2 + 5] = bfhi(nbv[h2].z); n0[8 * h2 + 6] = bflo(nbv[h2].w); n0[8 * h2 + 7] = bfhi(nbv[h2].w);
            n1[8 * h2 + 0] = bflo(nbv[2 + h2].x); n1[8 * h2 + 1] = bfhi(nbv[2 + h2].x); n1[8 * h2 + 2] = bflo(nbv[2 + h2].y); n1[8 * h2 + 3] = bfhi(nbv[2 + h2].y);
            n1[8 * h2 + 4] = bflo(nbv[2 + h2].z); n1[8 * h2 + 5] = bfhi(nbv[2 + h2].z); n1[8 * h2 + 6] = bflo(nbv[2 + h2].w); n1[8 * h2 + 7] = bfhi(nbv[2 + h2].w);
        }
        n0 = MFMA32(ma[0], p00, n0); n1 = MFMA32(ma[4], p00, n1);
        n0 = MFMA32(ma[1], p01, n0); n1 = MFMA32(ma[5], p01, n1);
        n0 = MFMA32(ma[2], p10, n0); n1 = MFMA32(ma[6], p10, n1);
        n0 = MFMA32(ma[3], p11, n0); n1 = MFMA32(ma[7], p11, n1);
        st0 = n0; st1 = n1;
        if (more) {
            asm volatile("s_waitcnt lgkmcnt(0)" ::: "memory");
            if (lane == 0) *cons = (unsigned)(step + 2);
#pragma unroll
            for (int p = 0; p < 8; ++p) ma[p] = man[p];
#pragma unroll
            for (int p = 0; p < 4; ++p) nbv[p] = nbn[p];
        }
    }
}

DI void rwkv_out_unit(const Frame& F, const RwP& P, const int du) {
    const int qd = du & 3, cidx = du >> 2, c = cidx % NCH, hd = (cidx / NCH) % BH, b = cidx / (NCH * BH);
    const int lane = F.lane, n = lane & 15, g = lane >> 4, u = 16 * qd + n;
    const bf16_t* QT = (const bf16_t*)(F.ws + WS_QT); const bf16_t* WT = (const bf16_t*)(F.ws + WS_WT); const bf16_t* S0 = (const bf16_t*)(F.ws + WS_S0);
    const bf16_t* VTB = (const bf16_t*)(F.ws + WS_VTB) + (size_t)cidx * 4096;
    f32x4 acc[4];
#pragma unroll
    for (int tm = 0; tm < 4; ++tm) acc[tm] = (f32x4){0.f, 0.f, 0.f, 0.f};
#pragma unroll
    for (int dir = 0; dir < 2; ++dir) {
        const size_t unit = (((size_t)dir * NB + b) * BH + hd) * NCH + c;
#pragma unroll
        for (int ks = 0; ks < 2; ++ks) {
            const bf16x8 bq = *(const bf16x8*)(QT + unit * 4096 + u * 64 + 32 * ks + 8 * g);
            const bf16x8 bw = *(const bf16x8*)(WT + unit * 4096 + u * 64 + 32 * ks + 8 * g);
#pragma unroll
            for (int tm = 0; tm < 4; ++tm) {
                const bf16x8 as = *(const bf16x8*)(S0 + unit * 4096 + (16 * tm + n) * 64 + 32 * ks + 8 * g);
                const bf16x8 av = *(const bf16x8*)(VTB + (16 * tm + n) * 64 + 32 * ks + 8 * g);
                acc[tm] = MFMA16(as, bq, acc[tm]); acc[tm] = MFMA16(av, bw, acc[tm]);
            }
        }
    }
    float s = 0.f;
#pragma unroll
    for (int tm = 0; tm < 4; ++tm) s += (acc[tm][0] + acc[tm][1]) + (acc[tm][2] + acc[tm][3]);
    s += __shfl_xor(s, 16); s += __shfl_xor(s, 32);
    const float mu = s * (1.f / HD); float q = 0.f;
#pragma unroll
    for (int tm = 0; tm < 4; ++tm) { acc[tm] = acc[tm] - mu; q += (acc[tm][0] * acc[tm][0] + acc[tm][1] * acc[tm][1]) + (acc[tm][2] * acc[tm][2] + acc[tm][3] * acc[tm][3]); }
    q += __shfl_xor(q, 16); q += __shfl_xor(q, 32);
    const float rstd = 1.f / sqrtf(q * (1.f / HD) + GN_EPS);
    const size_t tok = (size_t)b * S + 64 * c + u;
    const float* BS = (const float*)(F.ws + WS_BS);
    const float bsum = BS[tok * 8 + hd] + BS[((size_t)T + tok) * 8 + hd];
    const bf16_t* VC = (const bf16_t*)(F.ws + WS_VC) + tok * BW + hd * HD; const bf16_t* GBp = (const bf16_t*)(F.ws + WS_GB) + tok * BW + hd * HD;
    bf16_t* op = (bf16_t*)(F.ws + WS_CONCAT) + tok * D + AW + hd * HD;
#pragma unroll
    for (int tm = 0; tm < 4; ++tm) {
        const int i0 = 16 * tm + 4 * g;
        const f32x4 vv = unpack4(*(const u32x2*)(VC + i0)), gg = unpack4(*(const u32x2*)(GBp + i0));
        const f32x4 gn = *(const f32x4*)(P.gn_gain + hd * HD + i0), gb = *(const f32x4*)(P.gn_bias + hd * HD + i0);
        *(u32x2*)(op + i0) = pack4((acc[tm] * rstd * gn + gb + vv * bsum) * gg);
    }
}

DI RwP make_rwp(const Args& a, int l) {
    RwP p;
    p.conv = a.in[6] + (size_t)l * 3 * 3 * BW; p.w0 = a.in[7] + (size_t)l * 2 * BW; p.w_up = a.in[8] + (size_t)l * 2 * RW * BW;
    p.a0 = a.in[9] + (size_t)l * 2 * BW; p.a_up = a.in[10] + (size_t)l * 2 * RA * BW; p.g_up = a.in[11] + (size_t)l * RG * BW;
    p.k_k = a.in[12] + (size_t)l * BW; p.k_a = a.in[13] + (size_t)l * BW; p.r_k = a.in[14] + (size_t)l * BH * HD;
    p.gn_gain = a.in[15] + (size_t)l * BW; p.gn_bias = a.in[16] + (size_t)l * BW;
    return p;
}
DI void p_gemm1(const Frame& F, int l) {
    pg8::Gemm1Order S; S.U = (const bf16_t*)(F.ws + WS_U); S.Win = (const bf16_t*)(F.ws + WS_WIN + (size_t)l * WIN_LAYER); S.Wv = S.Win + (size_t)HW * D; S.G = F.G; S.c = F.bx;
    pg8::EpiStore E{(bf16_t*)(F.ws + WS_HB), HW, (bf16_t*)(F.ws + WS_VT), T};
    pg8::gemm_phase(F.lds, F.tid, D, S, E);
}
DI void p_mixer_local(const Frame& F, const Args& a, int l) {
    {
      const float* conv = a.in[6] + (size_t)l * 3 * 3 * BW;
#pragma unroll 7
      for (int i = F.tid; i < BH * 9 * 64; i += NTHREADS) { const int j = i & 63, q = i >> 6, which = q % 3, x = (q / 3) % 3, hd = q / 9;
          *(LAS bf16_t*)(F.lds + CWLOFF + i * 2) = f2bf(conv[x * 3 * BW + which * BW + hd * HD + j]); }
      RwPre PF;
      if (F.bx < NUNIT) rwkv_prefetch(F, a, l, F.bx, PF);
      __syncthreads();
      for (int unit = F.bx; unit < NUNIT; unit += F.G) rwkv_local_unit(F, a, l, unit, PF, unit + F.G < NUNIT ? unit + F.G : -1);
    }
}
DI void p_scan(const Frame& F, const Args& a, int l) {
    constexpr int NSCAN = 2 * 2 * NB * BH;
    if (F.bx < NSCAN) {
        volatile LAS unsigned* fl = (volatile LAS unsigned*)(F.lds + SCAN_FLAGS);
        if (F.tid < 32) fl[F.tid] = 0u;
        __syncthreads();
        if (F.wave == 0) scan_wave(F, F.bx); else if (F.wave <= 2) scan_loader(F, F.bx, F.wave - 1);
        return;
    }
    constexpr int CVW = 4;
    LAS float* rpbl = (LAS float*)(F.lds + CVW * 64 * 65 * 4);
    { const float* rpb = a.in[5] + (size_t)l * AH * (2 * KH - 1) * (2 * KW - 1);
#pragma unroll 6
      for (int i = F.tid; i < AH * (2 * KH - 1) * (2 * KW - 1); i += NTHREADS) rpbl[i] = rpb[i] * LOG2E; }
    __syncthreads();
    if (F.wave < CVW) {
        LAS float* scr = (LAS float*)F.lds + F.wave * (64 * 65);
        f32x4 cur[16], nxt[16]; const int st = (F.G - NSCAN) * CVW; int it = (F.bx - NSCAN) * CVW + F.wave; TItem tc{}, tn{};
        if (it < IT_MOE) { tc = moe_item(F, a.in[28], a.in[29], a.in[30], l, it); titem_load(tc, cur, F.lane); }
        for (; it < IT_MOE; it += st) {
            const bool more = it + st < IT_MOE;
            if (more) { tn = moe_item(F, a.in[28], a.in[29], a.in[30], l, it + st); titem_load(tn, nxt, F.lane); }
            titem_store(tc, cur, scr, F.lane);
            if (more) { tc = tn;
#pragma unroll
                for (int i = 0; i < 16; ++i) cur[i] = nxt[i]; }
        }
    } else {
        const int aw = (F.bx - NSCAN) * (NWAVES - CVW) + (F.wave - CVW), naw = (F.G - NSCAN) * (NWAVES - CVW);
        for (int au = aw; au < NB * ROWS * AH; au += naw) attn_unit(F, rpbl, au);
        for (int pu = aw; pu < NB * (S / 32) * 4; pu += naw) pool_unit(F, a.in[17] + (size_t)l * NG * 64 * 64, a.in[18] + (size_t)l * CW, pu);
    }
}
DI void p_rwkv_out(const Frame& F, const Args& a, int l) {
    const RwP P = make_rwp(a, l);
    for (int du = F.gw; du < NB * BH * NCH * 4; du += F.ngw) rwkv_out_unit(F, P, du);
}
DI void p_gemm2(const Frame& F, int l) {
    pg8::PlainOrder S; S.init((const bf16_t*)(F.ws + WS_CONCAT), (const bf16_t*)(F.ws + WS_WOUT) + (size_t)l * D * D, T, D, D, F.G, F.bx);
    pg8::EpiStore E{(bf16_t*)(F.ws + WS_MIX), D, nullptr, 0};
    pg8::gemm_phase(F.lds, F.tid, D, S, E);
}
DI void p_moe_a(const Frame& F, int l) {
    LAS int* tb = (LAS int*)(F.lds + LDS_MISC);
    build_tables(F, l, tb);
    pg8::GroupedOrderT<true> S; S.rowtok = (const int*)(F.ws + WS_CTL + WS_SLOTTOK); S.A = (const bf16_t*)(F.ws + WS_U); S.Bt = (const bf16_t*)(F.ws + WS_WGU); S.K = D; S.estride = (size_t)D * D; S.tile_e = tb + 66; S.ntiles = tb[65]; S.nwg = S.ntiles * 4; S.G = F.G; S.c = F.bx;
    pg8::EpiSwiGlu E{(bf16_t*)(F.ws + WS_HM)};
    pg8::gemm_phase(F.lds, F.tid, D, S, E);
}
DI void p_moe_b(const Frame& F, int l) {
    LAS int* tb = (LAS int*)(F.lds + LDS_MISC);
    build_tables(F, l, tb);
    pg8::GroupedOrderT<false> S; S.rowtok = nullptr; S.A = (const bf16_t*)(F.ws + WS_HM); S.Bt = (const bf16_t*)(F.ws + WS_WD); S.K = DE; S.estride = (size_t)D * DE; S.tile_e = tb + 66; S.ntiles = tb[65]; S.nwg = S.ntiles * 4; S.G = F.G; S.c = F.bx;
    pg8::EpiRowScale E{(bf16_t*)(F.ws + WS_YS), (const float*)(F.ws + WS_SLOTW)};
    pg8::gemm_phase(F.lds, F.tid, DE, S, E);
}

#ifndef DBLMASK
#define DBLMASK 0
#endif
constexpr int PH_PER_LAYER = 10, N_PHASES = 2 + L * PH_PER_LAYER;
DI bool in_ph(int k, int lo, int hi) { lo = __builtin_amdgcn_readfirstlane(lo); hi = __builtin_amdgcn_readfirstlane(hi); asm volatile("" : "+s"(lo), "+s"(hi)); return lo <= k && k < hi; }
DI Frame fresh(const Frame& F0) {
    Frame F = F0; int t = F0.tid, b = F0.bx;
    b = __builtin_amdgcn_readfirstlane(b); asm volatile("" : "+v"(t)); asm volatile("" : "+s"(b));
    F.tid = t; F.lane = t & 63; F.wave = __builtin_amdgcn_readfirstlane(t >> 6); F.bx = b;
    F.vcu = (F.G % 8 == 0) ? (b % 8) * (F.G / 8) + b / 8 : b; F.gw = F.vcu * NWAVES + F.wave;
    return F;
}

__global__ void __launch_bounds__(NTHREADS, 2) mk_fwd(Args a) {
    extern __shared__ __attribute__((aligned(16))) unsigned char lds_raw[];
    Frame F;
    F.lds = (LAS unsigned char*)lds_raw;
    F.tid = threadIdx.x; F.lane = F.tid & 63; F.wave = __builtin_amdgcn_readfirstlane(F.tid >> 6);
    F.G = gridDim.x; F.bx = blockIdx.x; { const int bx = blockIdx.x; F.vcu = (F.G % 8 == 0) ? (bx % 8) * (F.G / 8) + bx / 8 : bx; }
    F.gw = F.vcu * NWAVES + F.wave; F.ngw = F.G * NWAVES; F.ws = a.ws;
    volatile LAS unsigned* bst = (volatile LAS unsigned*)(F.lds + LDS_BARST);
    if (F.tid < 16) bst[F.tid] = 0u;
    __syncthreads();
    cg::grid_group grid = cg::this_grid();
    XcdBarrier bar; bar.bar = (unsigned*)(a.ws + WS_CTL) + CW_BAR; bar.x = 0; bar.st = bst;
    const bool multi = (a.ph_hi - a.ph_lo) > 1;
    if (multi && !a.use_cg) bar = xcd_barrier_post((unsigned*)(a.ws + WS_CTL) + CW_BAR, bst);
    const int lo = a.ph_lo, hi = a.ph_hi;
#define IN(k) in_ph((k), lo, hi)
#ifndef DBLSEAM
#define DBLSEAM 0
#endif
#define SEAM(k) do { if (IN(k) && IN((k) + 1)) { if (a.use_cg) grid.sync(); else { xcd_barrier(bar); if (DBLSEAM) xcd_barrier(bar); } } } while (0)
    if (IN(0)) { p0_prologue(fresh(F), a); if ((DBLMASK >> 11) & 1) p0_prologue(fresh(F), a); }
    SEAM(0);
    if (IN(1)) { p_r0(fresh(F), a.in[0]); if ((DBLMASK >> 12) & 1) p_r0(fresh(F), a.in[0]); }
    SEAM(1);
#define RUN(k, call) do { if (IN(pb + (k))) { call; if ((DBLMASK >> (k)) & 1) { call; } } } while (0)
#define LAYER(l) do { \
        const int pb = 2 + PH_PER_LAYER * (l); \
        RUN(0, p_gemm1(fresh(F), (l))); \
        SEAM(pb + 0); \
        RUN(1, p_mixer_local(fresh(F), a, (l))); \
        SEAM(pb + 1); \
        RUN(2, p_scan(fresh(F), a, (l))); \
        SEAM(pb + 2); \
        RUN(3, p_rwkv_out(fresh(F), a, (l))); \
        SEAM(pb + 3); \
        RUN(4, p_gemm2(fresh(F), (l))); \
        SEAM(pb + 4); \
        RUN(5, p_rowpass1(fresh(F), a, (l), (l) == 0 ? a.in[0] : a.out)); \
        if (IN(pb + 5) && ((DBLMASK >> 10) & 1)) p_rowpass1(fresh(F), a, (l), (l) == 0 ? a.in[0] : a.out, true); \
        SEAM(pb + 5); \
        RUN(6, p_gather(fresh(F), (l))); \
        SEAM(pb + 6); \
        RUN(7, p_moe_a(fresh(F), (l))); \
        SEAM(pb + 7); \
        RUN(8, p_moe_b(fresh(F), (l))); \
        SEAM(pb + 8); \
        RUN(9, p_rowpass2(fresh(F), a, (l), a.out)); \
        SEAM(pb + 9); \
    } while (0)
    LAYER(0);
    LAYER(1);
#undef LAYER
#undef IN
#undef SEAM
}

#ifndef MK_MODE
#define MK_MODE 0
#endif
#ifndef TESTMODE
#define TESTMODE 0
#endif

static void fill_args(Args& a, void* const* d_in, void* d_out, void* d_ws) {
    for (int i = 0; i < 31; ++i) a.in[i] = (const float*)d_in[i];
    a.out = (float*)d_out; a.ws = (unsigned char*)d_ws; a.ph_lo = 0; a.ph_hi = N_PHASES; a.use_cg = 0; a.pad = 0;
}
static void launch_phases(Args a, int lo, int hi, hipStream_t stream) {
    for (int p = lo; p < hi; ++p) { a.ph_lo = p; a.ph_hi = p + 1; hipLaunchKernelGGL(mk_fwd, dim3(256), dim3(NTHREADS), LDS_BYTES, stream, a); }
}

#if TESTMODE == 0
extern "C" void kernel_launch(void* const* d_in, const int* in_sizes, int n_in, void* d_out, int out_size, void* d_ws, size_t ws_size, hipStream_t stream) {
    static int grid = 0;
    if (grid == 0) {
        int dev = 0, cus = 0, per_cu = 0;
        (void)hipGetDevice(&dev); (void)hipDeviceGetAttribute(&cus, hipDeviceAttributeMultiprocessorCount, dev);
        (void)hipFuncSetAttribute((const void*)mk_fwd, hipFuncAttributeMaxDynamicSharedMemorySize, LDS_BYTES);
        (void)hipOccupancyMaxActiveBlocksPerMultiprocessor(&per_cu, (const void*)mk_fwd, NTHREADS, LDS_BYTES);
        (void)hipGetLastError();
        grid = (cus > 0 ? cus : 256) * 1;
        if (ws_size < WS_END || n_in != 31) grid = -1;
    }
    if (grid < 0) return;
    (void)hipMemsetAsync((char*)d_ws + WS_CTL, 0, CTL_BYTES, stream);
    Args a{}; fill_args(a, d_in, d_out, d_ws);
#if MK_MODE == 2
    launch_phases(a, 0, N_PHASES, stream);
#else
    a.use_cg = (MK_MODE == 1) ? 1 : 0;
    void* args[] = {&a};
    (void)hipLaunchCooperativeKernel((const void*)mk_fwd, dim3(grid), dim3(NTHREADS), args, LDS_BYTES, stream);
#endif
}
#endif

#if TESTMODE > 0
constexpr int O_A = 1152, O_B = 2304, O_W = 2336, O_AL = 2368, O_G = 2432;
struct HSrc { const bf16_t* HB; const bf16_t* VT;
    DI float at(size_t tok, int n) const { if (n < 768) return bf2f(HB[tok * HW + n]); if (n < 1152) return bf2f(VT[(size_t)(n - 768) * T + tok]); return bf2f(HB[tok * HW + n - 384]); } };
DI float sigm_n(float x) { return 1.f / (1.f + expf(-x)); }

__global__ void k_mod_n(const float* __restrict__ c, const float* __restrict__ w_mod, const float* __restrict__ b_mod, float* __restrict__ mod) {
    __shared__ float sc[NB * D];
    for (int i = threadIdx.x; i < NB * D; i += blockDim.x) { float v = c[i]; sc[i] = v * sigm_n(v); }
    __syncthreads();
    int idx = blockIdx.x * blockDim.x + threadIdx.x; int l = idx / MODW, n = idx % MODW;
    const float* w = w_mod + (size_t)l * D * MODW + n; float a0 = 0.f, a1 = 0.f;
    for (int k = 0; k < D; ++k) { float wv = w[(size_t)k * MODW]; a0 += sc[k] * wv; a1 += sc[D + k] * wv; }
    float bb = b_mod[l * MODW + n];
    mod[(size_t)(l * NB + 0) * MODW + n] = a0 + bb; mod[(size_t)(l * NB + 1) * MODW + n] = a1 + bb;
}
__global__ void k_ln_mod_n(const float* __restrict__ xin, const float* __restrict__ modl, int off_sh, int off_sc, float* __restrict__ uout) {
    int row = (blockIdx.x * blockDim.x + threadIdx.x) >> 6, lane = threadIdx.x & 63; if (row >= T) return; int b = row / S;
    f32x4 v[4];
#pragma unroll
    for (int j = 0; j < 4; ++j) v[j] = *(const f32x4*)(xin + (size_t)row * D + 4 * lane + 256 * j);
    float mean, rstd; row_ln(v, mean, rstd);
    const float* md = modl + (size_t)b * MODW;
#pragma unroll
    for (int j = 0; j < 4; ++j) { int col = 4 * lane + 256 * j; *(f32x4*)(uout + (size_t)row * D + col) = v[j] * rstd * (1.f + *(const f32x4*)(md + off_sc + col)) + *(const f32x4*)(md + off_sh + col); }
}
__global__ void k_post_n(const float* xin, const float* br, const float* __restrict__ modl, int off_gate, const float* __restrict__ gain, const float* __restrict__ bias, float* xout, float* u2out, int off_sh2, int off_sc2) {
    int row = (blockIdx.x * blockDim.x + threadIdx.x) >> 6, lane = threadIdx.x & 63; if (row >= T) return; int b = row / S;
    const float* md = modl + (size_t)b * MODW; f32x4 v[4];
#pragma unroll
    for (int j = 0; j < 4; ++j) { int col = 4 * lane + 256 * j; v[j] = *(const f32x4*)(xin + (size_t)row * D + col) * ALPHA + *(const f32x4*)(md + off_gate + col) * *(const f32x4*)(br + (size_t)row * D + col); }
    float mean, rstd; row_ln(v, mean, rstd);
#pragma unroll
    for (int j = 0; j < 4; ++j) { int col = 4 * lane + 256 * j; v[j] = v[j] * rstd * *(const f32x4*)(gain + col) + *(const f32x4*)(bias + col); *(f32x4*)(xout + (size_t)row * D + col) = v[j]; }
    if (u2out == nullptr) return;
    row_ln(v, mean, rstd);
#pragma unroll
    for (int j = 0; j < 4; ++j) { int col = 4 * lane + 256 * j; *(f32x4*)(u2out + (size_t)row * D + col) = v[j] * rstd * (1.f + *(const f32x4*)(md + off_sc2 + col)) + *(const f32x4*)(md + off_sh2 + col); }
}
__global__ void __launch_bounds__(256) k_gemm_f32(const float* __restrict__ A, int lda, const float* __restrict__ B, int ldb, float* __restrict__ C, int ldc, int K) {
    __shared__ float As[16][65]; __shared__ float Bs[16][64];
    const int tx = threadIdx.x & 15, ty = threadIdx.x >> 4; const int m0 = blockIdx.y * 64, n0 = blockIdx.x * 64;
    float acc[4][4];
#pragma unroll
    for (int i = 0; i < 4; ++i)
#pragma unroll
        for (int j = 0; j < 4; ++j) acc[i][j] = 0.f;
    for (int k0 = 0; k0 < K; k0 += 16) {
#pragma unroll
        for (int i = 0; i < 4; ++i) { int e = threadIdx.x + 256 * i; int m = e >> 4, k = e & 15; As[k][m] = A[(size_t)(m0 + m) * lda + k0 + k]; }
#pragma unroll
        for (int i = 0; i < 4; ++i) { int e = threadIdx.x + 256 * i; int k = e >> 6, n = e & 63; Bs[k][n] = B[(size_t)(k0 + k) * ldb + n0 + n]; }
        __syncthreads();
#pragma unroll
        for (int k = 0; k < 16; ++k) { float a[4], b[4];
#pragma unroll
            for (int i = 0; i < 4; ++i) { a[i] = As[k][ty * 4 + i]; b[i] = Bs[k][tx * 4 + i]; }
#pragma unroll
            for (int i = 0; i < 4; ++i)
#pragma unroll
                for (int j = 0; j < 4; ++j) acc[i][j] += a[i] * b[j]; }
        __syncthreads();
    }
#pragma unroll
    for (int i = 0; i < 4; ++i) *(float4*)(C + (size_t)(m0 + ty * 4 + i) * ldc + n0 + tx * 4) = make_float4(acc[i][0], acc[i][1], acc[i][2], acc[i][3]);
}
__global__ void __launch_bounds__(64) k_attn_n(HSrc h, const float* __restrict__ rpb, float* __restrict__ concat) {
    int idx = blockIdx.x * blockDim.x + threadIdx.x; if (idx >= T * AH) return;
    int head = idx % AH, tok = idx / AH; int b = tok / S, t = tok % S, r = t / GW, cq = t % GW;
    int rstart = r - KH / 2; rstart = rstart < 0 ? 0 : (rstart > ROWS - KH ? ROWS - KH : rstart);
    int cstart = cq - KW / 2; cstart = cstart < 0 ? 0 : (cstart > GW - KW ? GW - KW : cstart);
    float q[HD], acc[HD];
#pragma unroll
    for (int d = 0; d < HD; ++d) { q[d] = h.at(tok, head * HD + d); acc[d] = 0.f; }
    float m = -1e30f, l = 0.f; const float* rp = rpb + (size_t)head * 15 * 31;
    for (int kk = 0; kk < KH; ++kk) { int kr = rstart + kk; int dr = kr - r + (KH - 1);
        for (int j = 0; j < KW; ++j) { int ck = cstart + j; int dc = ck - cq; dc = dc < -15 ? -15 : (dc > 15 ? 15 : dc); dc += 15;
            size_t kt = (size_t)b * S + kr * GW + ck; float s = 0.f;
#pragma unroll
            for (int d = 0; d < HD; ++d) s += q[d] * h.at(kt, AW + head * HD + d);
            s = s * 0.125f + rp[dr * 31 + dc];
            float mn = fmaxf(m, s); float corr = expf(m - mn); float p = expf(s - mn); l = l * corr + p;
#pragma unroll
            for (int d = 0; d < HD; ++d) acc[d] = acc[d] * corr + p * h.at(kt, 2 * AW + head * HD + d);
            m = mn; } }
    float inv = 1.f / l;
#pragma unroll
    for (int d = 0; d < HD; ++d) concat[(size_t)tok * D + head * HD + d] = acc[d] * inv;
}
__global__ void __launch_bounds__(256) k_pool_n(HSrc h, const float* __restrict__ pool_w, const float* __restrict__ pool_scale, float* __restrict__ concat) {
    __shared__ float pooled[CW];
    int tok = blockIdx.x; int b = tok / S, t = tok % S; int ch = threadIdx.x; int g = ch / 64; int win = 2 << g;
    int lo = t - win / 2; lo = lo < 0 ? 0 : lo; int hi = t + win / 2 - 1; hi = hi > S - 1 ? S - 1 : hi;
    float s = 0.f; for (int u = lo; u <= hi; ++u) s += h.at((size_t)b * S + u, O_G + ch);
    pooled[ch] = s / (float)(hi - lo + 1) - h.at(tok, O_G + ch);
    __syncthreads();
    int e = ch % 64; const float* pw = pool_w + (size_t)g * 64 * 64 + e; float a = 0.f;
    for (int c2 = 0; c2 < 64; ++c2) a += pooled[g * 64 + c2] * pw[c2 * 64];
    concat[(size_t)tok * D + AW + BW + ch] = a * pool_scale[ch];
}
__global__ void __launch_bounds__(64) k_rwkv_scan_n(HSrc h, RwP p, float* __restrict__ ys) {
    const int lane = threadIdx.x; const int dir = blockIdx.x / (NB * BH), b = (blockIdx.x / BH) % NB, hd = blockIdx.x % BH; const int ch = hd * HD + lane;
    float st[HD];
#pragma unroll
    for (int j = 0; j < HD; ++j) st[j] = 0.f;
    float wup[RW], aup[RA];
#pragma unroll
    for (int m = 0; m < RW; ++m) { wup[m] = p.w_up[(size_t)(dir * RW + m) * BW + ch]; aup[m] = p.a_up[(size_t)(dir * RA + m) * BW + ch]; }
    const float w0 = p.w0[dir * BW + ch], a0 = p.a0[dir * BW + ch], kkw = p.k_k[ch], kaw = p.k_a[ch];
    float cr[3], ck[3], cv[3];
#pragma unroll
    for (int x = 0; x < 3; ++x) { cr[x] = p.conv[x * 3 * BW + ch]; ck[x] = p.conv[x * 3 * BW + BW + ch]; cv[x] = p.conv[x * 3 * BW + 2 * BW + ch]; }
    for (int step = 0; step < S; ++step) {
        const int t = dir ? (S - 1 - step) : step; const size_t row = (size_t)b * S + t;
        float r = 0.f, k = 0.f, v = 0.f;
#pragma unroll
        for (int x = 0; x < 3; ++x) { int tt = t + x - 1; if (tt >= 0 && tt < S) { size_t rr = (size_t)b * S + tt; r += h.at(rr, O_A + ch) * cr[x]; k += h.at(rr, O_A + BW + ch) * ck[x]; v += h.at(rr, O_A + 2 * BW + ch) * cv[x]; } }
        float lv = h.at(row, O_B + lane); float lt = lane < RW ? tanhf(lv) : lv; float zw = w0, za = a0;
#pragma unroll
        for (int m = 0; m < RW; ++m) { zw += __shfl(lt, m) * wup[m]; za += __shfl(lt, RW + m) * aup[m]; }
        const float w = expf(-DECAY * sigm_n(zw)); const float a = sigm_n(za);
        float kk = k * kkw; float ss = wave_sum(kk * kk); kk = kk * (1.f / sqrtf(fmaxf(ss, 1e-24f)));
        const float kd = k * (1.f + (a - 1.f) * kaw); const float kka = kk * a;
        float sa = 0.f;
#pragma unroll
        for (int j = 0; j < HD; ++j) sa += st[j] * (-__shfl(kk, j));
        float y = 0.f;
#pragma unroll
        for (int j = 0; j < HD; ++j) { st[j] = st[j] * __shfl(w, j) + sa * __shfl(kka, j) + v * __shfl(kd, j); y += st[j] * __shfl(r, j); }
        ys[((size_t)dir * T + b * S + t) * BW + ch] = y;
    }
}
__global__ void __launch_bounds__(384) k_rwkv_finish_n(HSrc h, RwP p, const float* __restrict__ ys, float* __restrict__ concat) {
    __shared__ float lw[RW], la[RA], sg[RG];
    const int tok = blockIdx.x, b = tok / S, t = tok % S, ch = threadIdx.x, hd = ch / HD, j = ch % HD;
    if (ch < RW) lw[ch] = tanhf(h.at(tok, O_B + ch)); else if (ch < RW + RA) la[ch - RW] = h.at(tok, O_W + (ch - RW)); else if (ch < RW + RA + RG) sg[ch - RW - RA] = sigm_n(h.at(tok, O_AL + (ch - RW - RA)));
    __syncthreads();
    float r = 0.f, k = 0.f, v = 0.f;
#pragma unroll
    for (int x = 0; x < 3; ++x) { int tt = t + x - 1; if (tt >= 0 && tt < S) { size_t rr = (size_t)b * S + tt;
        r += h.at(rr, O_A + ch) * p.conv[x * 3 * BW + ch]; k += h.at(rr, O_A + BW + ch) * p.conv[x * 3 * BW + BW + ch]; v += h.at(rr, O_A + 2 * BW + ch) * p.conv[x * 3 * BW + 2 * BW + ch]; } }
    float bon = 0.f;
    for (int dir = 0; dir < 2; ++dir) { float za = p.a0[dir * BW + ch]; for (int m = 0; m < RA; ++m) za += la[m] * p.a_up[(size_t)(dir * RA + m) * BW + ch];
        float a = sigm_n(za); float kd = k * (1.f + (a - 1.f) * p.k_a[ch]); bon += wave_sum(r * kd * p.r_k[hd * HD + j]); }
    bon *= v;
    float y = ys[(size_t)tok * BW + ch] + ys[((size_t)T + tok) * BW + ch];
    float mu = wave_sum(y) * (1.f / HD); float dy = y - mu; float var = wave_sum(dy * dy) * (1.f / HD);
    float yn = dy * (1.f / sqrtf(var + GN_EPS)) * p.gn_gain[ch] + p.gn_bias[ch];
    float g = 0.f; for (int m = 0; m < RG; ++m) g += sg[m] * p.g_up[(size_t)m * BW + ch];
    concat[(size_t)tok * D + AW + ch] = (yn + bon) * g;
}
__global__ void __launch_bounds__(256) k_moe_n(const float* __restrict__ u2, const int* __restrict__ tokslot, const float* __restrict__ ew,
                                                const float* __restrict__ wgate, const float* __restrict__ wup, const float* __restrict__ wdown, float* __restrict__ f) {
    __shared__ float xs[D]; __shared__ float hb[DE];
    const int tok = blockIdx.x, tid = threadIdx.x;
    for (int i = tid; i < D; i += 256) xs[i] = u2[(size_t)tok * D + i];
    float o[4] = {0.f, 0.f, 0.f, 0.f};
    for (int kk = 0; kk < 2; ++kk) {
        const int ts = tokslot[tok * 2 + kk]; const int e = ts >> 14; const float wt = ew[ts];
        __syncthreads();
        const float* g = wgate + (size_t)e * D * DE; const float* u = wup + (size_t)e * D * DE;
        float ag0 = 0.f, ag1 = 0.f, au0 = 0.f, au1 = 0.f;
        for (int k = 0; k < D; ++k) { float x = xs[k]; ag0 += x * g[(size_t)k * DE + tid]; ag1 += x * g[(size_t)k * DE + 256 + tid]; au0 += x * u[(size_t)k * DE + tid]; au1 += x * u[(size_t)k * DE + 256 + tid]; }
        hb[tid] = ag0 * sigm_n(ag0) * au0; hb[256 + tid] = ag1 * sigm_n(ag1) * au1;
        __syncthreads();
        const float* dn = wdown + (size_t)e * DE * D; float a[4] = {0.f, 0.f, 0.f, 0.f};
        for (int k = 0; k < DE; ++k) { float x = hb[k];
#pragma unroll
            for (int j = 0; j < 4; ++j) a[j] += x * dn[(size_t)k * D + tid + 256 * j]; }
#pragma unroll
        for (int j = 0; j < 4; ++j) o[j] += a[j] * wt;
    }
#pragma unroll
    for (int j = 0; j < 4; ++j) f[(size_t)tok * D + tid + 256 * j] = o[j];
}

__global__ void k_router_n(const float* __restrict__ u2, const float* __restrict__ wg, const float* __restrict__ bg, const float* __restrict__ we, const float* __restrict__ be, int* __restrict__ tok_e) {
    int row = (blockIdx.x * blockDim.x + threadIdx.x) >> 6, lane = threadIdx.x & 63; if (row >= T) return;
    float gl[NG], el[NE];
#pragma unroll
    for (int n = 0; n < NG; ++n) gl[n] = 0.f;
#pragma unroll
    for (int n = 0; n < NE; ++n) el[n] = 0.f;
    for (int i = 0; i < 16; ++i) { int k = lane + 64 * i; float x = u2[(size_t)row * D + k];
#pragma unroll
        for (int n = 0; n < NG; ++n) gl[n] += x * wg[k * NG + n];
#pragma unroll
        for (int n = 0; n < NE; ++n) el[n] += x * we[k * NE + n]; }
#pragma unroll
    for (int n = 0; n < NG; ++n) gl[n] = wave_sum(gl[n]) + bg[n];
#pragma unroll
    for (int n = 0; n < NE; ++n) el[n] = wave_sum(el[n]) + be[n];
    int gi = 0; float gm = gl[0];
#pragma unroll
    for (int n = 1; n < NG; ++n) if (gl[n] > gm) { gm = gl[n]; gi = n; }
    float l1 = -3.0e38f, l2 = -3.0e38f; int i1 = 0, i2 = 0;
#pragma unroll
    for (int n = 0; n < NE; ++n) if ((n >> 3) == gi) { float v = el[n]; int e = n & 7; if (v > l1) { l2 = l1; i2 = i1; l1 = v; i1 = e; } else if (v > l2) { l2 = v; i2 = e; } }
    if (lane == 0) { tok_e[row * 2] = gi * EPG + i1; tok_e[row * 2 + 1] = gi * EPG + i2; }
}
__global__ void k_cmp_route(const int* __restrict__ tokslot, const int* __restrict__ tok_e, float* acc, int slot) {
    float mis = 0.f, tot = 0.f;
    for (int t = blockIdx.x * blockDim.x + threadIdx.x; t < T; t += gridDim.x * blockDim.x) { const int a0 = tokslot[2 * t] >> 14, a1 = tokslot[2 * t + 1] >> 14;
        mis += (a0 != tok_e[2 * t] || a1 != tok_e[2 * t + 1]) ? 1.f : 0.f; tot += 1.f; }
    mis = wave_sum(mis); tot = wave_sum(tot);
    if ((threadIdx.x & 63) == 0) { atomicAdd(acc + 2 * slot, mis); atomicAdd(acc + 2 * slot + 1, tot); }
}
__global__ void k_bf2f(const bf16_t* __restrict__ src, float* __restrict__ dst, size_t n) { for (size_t i = (size_t)blockIdx.x * blockDim.x + threadIdx.x; i < n; i += (size_t)gridDim.x * blockDim.x) dst[i] = bf2f(src[i]); }
template <class TA> __global__ void k_cmp(const TA* __restrict__ a, size_t lda, const float* __restrict__ b, size_t ldb, int rows, int cols, float* acc, int slot) {
    float d2 = 0.f, r2 = 0.f;
    for (size_t i = (size_t)blockIdx.x * blockDim.x + threadIdx.x; i < (size_t)rows * cols; i += (size_t)gridDim.x * blockDim.x) {
        const size_t r = i / cols, c = i % cols; float av; if constexpr (sizeof(TA) == 2) av = bf2f(a[r * lda + c]); else av = a[r * lda + c];
        const float bv = b[r * ldb + c]; d2 += (av - bv) * (av - bv); r2 += bv * bv; }
    d2 = wave_sum(d2); r2 = wave_sum(r2);
    if ((threadIdx.x & 63) == 0) { atomicAdd(acc + 2 * slot, d2); atomicAdd(acc + 2 * slot + 1, r2); }
}
__global__ void k_cmp_vt(const bf16_t* __restrict__ vt, const float* __restrict__ b, size_t ldb, float* acc, int slot) {
    float d2 = 0.f, r2 = 0.f;
    for (size_t i = (size_t)blockIdx.x * blockDim.x + threadIdx.x; i < (size_t)T * AW; i += (size_t)gridDim.x * blockDim.x) {
        const size_t r = i % T, c = i / T; const float av = bf2f(vt[c * T + r]), bv = b[r * ldb + c]; d2 += (av - bv) * (av - bv); r2 += bv * bv; }
    d2 = wave_sum(d2); r2 = wave_sum(r2);
    if ((threadIdx.x & 63) == 0) { atomicAdd(acc + 2 * slot, d2); atomicAdd(acc + 2 * slot + 1, r2); }
}
struct Tols { float t[8]; int n; };
__global__ void k_readout(float* out, const float* acc, Tols tl, int total) {
    float mx = 0.f; int am = 0; for (int k = 0; k < tl.n; ++k) { float e = sqrtf(acc[2 * k] / fmaxf(acc[2 * k + 1], 1e-30f)); if (!(e == e)) e = 1e3f; if (e / tl.t[k] > mx) { mx = e / tl.t[k]; am = k; } }
    const float cval = sqrtf(1000.f * mx);
    for (int i = blockIdx.x * blockDim.x + threadIdx.x; i < total; i += gridDim.x * blockDim.x) out[i] = (i < 8) ? 1000.f * (float)(am + 1) : cval;
}
__global__ void __launch_bounds__(256) k_moe_chk(const float* __restrict__ u2, const int* __restrict__ tokslot, const float* __restrict__ ew, const unsigned* __restrict__ cnt,
                                                  const float* __restrict__ wgate, const float* __restrict__ wup, const float* __restrict__ wdown,
                                                  const bf16_t* __restrict__ XS, const bf16_t* __restrict__ HM, const bf16_t* __restrict__ YS, float* acc) {
    __shared__ float xs[D]; __shared__ float hb[DE]; __shared__ int offp[NE];
    const int tok = blockIdx.x, tid = threadIdx.x;
    if (tid == 0) { int off = 0; for (int e = 0; e < NE; ++e) { offp[e] = off; off += (((int)cnt[e] + 255) >> 8) * 256; } }
    for (int i = tid; i < D; i += 256) xs[i] = u2[(size_t)tok * D + i];
    float d0 = 0.f, r0 = 0.f, d1 = 0.f, r1 = 0.f, d2 = 0.f, r2 = 0.f;
    for (int kk = 0; kk < 2; ++kk) {
        __syncthreads();
        const int ts = tokslot[tok * 2 + kk]; const int e = ts >> 14; const float wt = ew[ts]; const size_t slot = (size_t)offp[e] + (ts & 16383);
        for (int i = tid; i < D; i += 256) { const float a = bf2f(XS[slot * D + i]), b = xs[i]; d0 += (a - b) * (a - b); r0 += b * b; }
        const float* g = wgate + (size_t)e * D * DE; const float* u = wup + (size_t)e * D * DE;
        float ag0 = 0.f, ag1 = 0.f, au0 = 0.f, au1 = 0.f;
        for (int k = 0; k < D; ++k) { float x = xs[k]; ag0 += x * g[(size_t)k * DE + tid]; ag1 += x * g[(size_t)k * DE + 256 + tid]; au0 += x * u[(size_t)k * DE + tid]; au1 += x * u[(size_t)k * DE + 256 + tid]; }
        const float h0 = ag0 * sigm_n(ag0) * au0, h1 = ag1 * sigm_n(ag1) * au1;
        hb[tid] = h0; hb[256 + tid] = h1;
        { const float a = bf2f(HM[slot * DE + tid]), b = bf2f(HM[slot * DE + 256 + tid]); d1 += (a - h0) * (a - h0) + (b - h1) * (b - h1); r1 += h0 * h0 + h1 * h1; }
        __syncthreads();
        const float* dn = wdown + (size_t)e * DE * D; float a4[4] = {0.f, 0.f, 0.f, 0.f};
        for (int k = 0; k < DE; ++k) { float x = hb[k];
#pragma unroll
            for (int j = 0; j < 4; ++j) a4[j] += x * dn[(size_t)k * D + tid + 256 * j]; }
#pragma unroll
        for (int j = 0; j < 4; ++j) {
#ifdef MOEB_NOSCALE
            const float y = a4[j];
#else
            const float y = a4[j] * wt;
#endif
            const float a = bf2f(YS[slot * D + tid + 256 * j]); d2 += (a - y) * (a - y); r2 += y * y; }
    }
    d0 = wave_sum(d0); r0 = wave_sum(r0); d1 = wave_sum(d1); r1 = wave_sum(r1); d2 = wave_sum(d2); r2 = wave_sum(r2);
    if ((tid & 63) == 0) { atomicAdd(acc + 0, d0); atomicAdd(acc + 1, r0); atomicAdd(acc + 2, d1); atomicAdd(acc + 3, r1); atomicAdd(acc + 4, d2); atomicAdd(acc + 5, r2); }
}

extern "C" void kernel_launch(void* const* d_in, const int* in_sizes, int n_in, void* d_out, int out_size, void* d_ws, size_t ws_size, hipStream_t stream) {
    static int once = 0; if (!once) { (void)hipFuncSetAttribute((const void*)mk_fwd, hipFuncAttributeMaxDynamicSharedMemorySize, LDS_BYTES); once = 1; }
    (void)hipMemsetAsync((char*)d_ws + WS_CTL, 0, CTL_BYTES, stream);
    Args a{}; fill_args(a, d_in, d_out, d_ws);
    char* ws = (char*)d_ws; float* out = (float*)d_out;
    float* ACC = (float*)(ws + 32768 + 1024);
    const float* x = a.in[0];
    HSrc hs{(const bf16_t*)(ws + WS_HB), (const bf16_t*)(ws + WS_VT)};
    const int l = 0;
    RwP p = { a.in[6], a.in[7], a.in[8], a.in[9], a.in[10], a.in[11], a.in[12], a.in[13], a.in[14], a.in[15], a.in[16] };
    Tols tl{};
#if TESTMODE == 1
    launch_phases(a, 0, 3, stream);
    float* MODn = (float*)(ws + WS_MOD + 512 * 1024); float* Un = (float*)(ws + WS_XA); float* HF = (float*)(ws + WS_CONCAT);
    k_mod_n<<<L * MODW / 256, 256, 0, stream>>>(a.in[1], a.in[2], a.in[3], MODn);
    k_ln_mod_n<<<T / 4, 256, 0, stream>>>(x, MODn, 0, D, Un);
    k_gemm_f32<<<dim3(INW / 64, T / 64), 256, 0, stream>>>(Un, D, a.in[4], INW, HF, INW, D);
    k_cmp<float><<<256, 256, 0, stream>>>((const float*)(ws + WS_MOD), MODW, MODn, MODW, L * NB, MODW, ACC, 0);
    k_cmp<bf16_t><<<1024, 256, 0, stream>>>((const bf16_t*)(ws + WS_U), D, Un, D, T, D, ACC, 1);
    k_cmp<bf16_t><<<1024, 256, 0, stream>>>((const bf16_t*)(ws + WS_HB), HW, HF, INW, T, 768, ACC, 2);
    k_cmp<bf16_t><<<1024, 256, 0, stream>>>((const bf16_t*)(ws + WS_HB) + 768, HW, HF + 1152, INW, T, 1536, ACC, 3);
    k_cmp_vt<<<1024, 256, 0, stream>>>((const bf16_t*)(ws + WS_VT), HF + 768, INW, ACC, 4);
    tl.n = 5; tl.t[0] = 1e-5f; tl.t[1] = 4e-3f; tl.t[2] = 6e-3f; tl.t[3] = 6e-3f; tl.t[4] = 6e-3f;
#elif TESTMODE == 2
    launch_phases(a, 0, 4, stream);
    float* CCn = (float*)(ws + WS_XA); float* YSn = (float*)(ws + WS_WGU);
    k_attn_n<<<T * AH / 64, 64, 0, stream>>>(hs, a.in[5], CCn);
    k_pool_n<<<T, 256, 0, stream>>>(hs, a.in[17], a.in[18], CCn);
    k_rwkv_scan_n<<<2 * NB * BH, 64, 0, stream>>>(hs, p, YSn);
    k_rwkv_finish_n<<<T, 384, 0, stream>>>(hs, p, YSn, CCn);
    launch_phases(a, 4, 6, stream);
    k_cmp<bf16_t><<<1024, 256, 0, stream>>>((const bf16_t*)(ws + WS_CONCAT), D, CCn, D, T, AW, ACC, 0);
    k_cmp<bf16_t><<<1024, 256, 0, stream>>>((const bf16_t*)(ws + WS_CONCAT) + AW, D, CCn + AW, D, T, BW, ACC, 1);
    k_cmp<bf16_t><<<1024, 256, 0, stream>>>((const bf16_t*)(ws + WS_CONCAT) + AW + BW, D, CCn + AW + BW, D, T, CW, ACC, 2);
    tl.n = 3; tl.t[0] = TOL0; tl.t[1] = TOL1; tl.t[2] = TOL2;
#elif TESTMODE == 3
    launch_phases(a, 0, 11, stream);
    { const float* MODf = (const float*)(ws + WS_MOD);
      float* U2f = (float*)(ws + 414 * MiB); float* Fn = (float*)(ws + 213 * MiB); float* X2n = (float*)(ws + 277 * MiB);
      k_bf2f<<<2048, 256, 0, stream>>>((const bf16_t*)(ws + WS_U), U2f, (size_t)T * D);
      launch_phases(a, 11, 12, stream);
      k_moe_n<<<T, 256, 0, stream>>>(U2f, (const int*)(ws + WS_TOKSLOT), (const float*)(ws + WS_EW), a.in[28], a.in[29], a.in[30], Fn);
      k_post_n<<<T / 4, 256, 0, stream>>>((const float*)(ws + WS_XA), Fn, MODf, 5 * D, a.in[22], a.in[23], X2n, nullptr, 0, 0);
      k_cmp<float><<<1024, 256, 0, stream>>>(out, D, X2n, D, T, D, ACC, 0); }
    tl.n = 1; tl.t[0] = TOL0;
#elif TESTMODE == 4
    launch_phases(a, 0, 8, stream);
    { const float* MODf = (const float*)(ws + WS_MOD);
      float* CCn = (float*)(ws + 405 * MiB); float* MIXn = (float*)(ws + 213 * MiB); float* X1n = (float*)(ws + 21 * MiB); float* U2n = (float*)(ws + 333 * MiB); int* TEn = (int*)(ws + 490 * MiB);
      k_bf2f<<<2048, 256, 0, stream>>>((const bf16_t*)(ws + WS_CONCAT), CCn, (size_t)T * D);
      k_gemm_f32<<<dim3(D / 64, T / 64), 256, 0, stream>>>(CCn, D, a.in[19], D, MIXn, D, D);
      k_post_n<<<T / 4, 256, 0, stream>>>(x, MIXn, MODf, 2 * D, a.in[20], a.in[21], X1n, U2n, 3 * D, 4 * D);
      k_router_n<<<T / 4, 256, 0, stream>>>(U2n, a.in[24], a.in[25], a.in[26], a.in[27], TEn);
      k_cmp<float><<<1024, 256, 0, stream>>>((const float*)(ws + WS_XA), D, X1n, D, T, D, ACC, 0);
      k_cmp<bf16_t><<<1024, 256, 0, stream>>>((const bf16_t*)(ws + WS_U), D, U2n, D, T, D, ACC, 1);
      k_cmp_route<<<64, 256, 0, stream>>>((const int*)(ws + WS_TOKSLOT), TEn, ACC, 2); }
    tl.n = 3; tl.t[0] = TOL0; tl.t[1] = TOL1; tl.t[2] = TOL2;
#elif TESTMODE == 5
    launch_phases(a, 0, 11, stream);
    { float* U2f = (float*)(ws + 414 * MiB);
      k_bf2f<<<2048, 256, 0, stream>>>((const bf16_t*)(ws + WS_U), U2f, (size_t)T * D);
      k_moe_chk<<<T, 256, 0, stream>>>(U2f, (const int*)(ws + WS_TOKSLOT), (const float*)(ws + WS_EW), (const unsigned*)(ws + WS_CTL) + CW_CNT, a.in[28], a.in[29], a.in[30],
                                       (const bf16_t*)(ws + WS_XS), (const bf16_t*)(ws + WS_HM), (const bf16_t*)(ws + WS_YS), ACC); }
    tl.n = 3; tl.t[0] = 1e-6f; tl.t[1] = 1e-2f; tl.t[2] = 1e-2f;
#endif
    k_readout<<<256, 256, 0, stream>>>(out, ACC, tl, out_size);
}
#endif
```

```cpp
#define TESTMODE 0
#define MK_MODE 0
#define CVW 3
#include <hip/hip_runtime.h>
#include <hip/hip_cooperative_groups.h>
#include <stdint.h>
namespace cg = cooperative_groups;

#ifndef TESTMODE
#define TESTMODE 0
#endif
#define DI __device__ __forceinline__
#define LAS __attribute__((address_space(3)))
typedef unsigned short bf16_t;
typedef short bf16x8 __attribute__((ext_vector_type(8)));
typedef float f32x4 __attribute__((ext_vector_type(4)));
typedef float f32x16 __attribute__((ext_vector_type(16)));
typedef unsigned u32x4 __attribute__((ext_vector_type(4)));
typedef unsigned u32x2 __attribute__((ext_vector_type(2)));
typedef float f32x2_t __attribute__((ext_vector_type(2)));
typedef __bf16 bf16x2_t __attribute__((ext_vector_type(2)));

namespace cfg {
constexpr int D = 1024, NB = 2, S = 8192, T = NB * S, L = 2;
constexpr int GW = 64, ROWS = 128;
constexpr int HD = 64, AW = 384, BW = 384, CW = 256, AH = 6, BH = 6;
constexpr int KH = 8, KW = 16;
constexpr int RW = 32, RA = 32, RG = 64;
constexpr int INW = 2688;
constexpr int NG = 4, EPG = 8, NE = 32, DE = 512;
constexpr int MODW = 6 * D;
constexpr float ALPHA = 1.41421356237309515f;
constexpr float LN_EPS = 1e-5f, GN_EPS = 64e-5f;
constexpr float DECAY = 0.60653065971263342f;
constexpr float LOG2E = 1.44269504088896341f;
constexpr int HW = 2304, HQ = 0, HK = 384, HR = 768, HWL = 1920, HAL = 1952, HGL = 1984, HP = 2048;
constexpr int NCH = S / 64;
constexpr int NUNIT = 2 * NB * BH * NCH;
constexpr int XSROWS = 2 * T + NE * 256;
}
using namespace cfg;

constexpr size_t MiB = 1u << 20;
constexpr size_t WS_CTL = 0;
constexpr size_t CTL_BYTES = 262144;
constexpr size_t WS_SLOTTOK = 65536;
constexpr int CW_BAR = 0;
constexpr int CW_CNT = 8192;
constexpr size_t WS_MOD = 1 * MiB;
constexpr size_t WS_TOKSLOT = 1 * MiB + 128 * 1024;
constexpr size_t WS_SLOTW = 1 * MiB + 256 * 1024;
constexpr size_t WS_BC = 2 * MiB;
constexpr size_t WS_TOKW = 2 * MiB + 64 * 1024;
constexpr size_t WS_TOKFIN = 2 * MiB + 256 * 1024;
constexpr size_t WS_CNTF = 2 * MiB + 512 * 1024;
constexpr size_t WS_WIN = 6 * MiB;
constexpr size_t WIN_LAYER = (size_t)2816 * 1024 * 2;
constexpr size_t WS_WOUT = 17 * MiB;
constexpr size_t WS_WGU = 21 * MiB;
constexpr size_t WS_WD = 85 * MiB;
constexpr size_t WS_XA = 117 * MiB;
constexpr size_t WS_U = 181 * MiB;
constexpr size_t WS_HB = 213 * MiB;
constexpr size_t WS_S0 = 117 * MiB;
constexpr size_t WS_VT = 285 * MiB;
constexpr size_t WS_CONCAT = 301 * MiB;
constexpr size_t WS_MP = 333 * MiB;
constexpr size_t WS_NB = 357 * MiB;
constexpr size_t WS_MIX = 333 * MiB;
constexpr size_t WS_QT = 405 * MiB;
constexpr size_t WS_WT = 429 * MiB;
constexpr size_t WS_VTB = 453 * MiB;
constexpr size_t WS_GB = 465 * MiB;
constexpr size_t WS_VC = 477 * MiB;
constexpr size_t WS_BS = 489 * MiB;
constexpr size_t WS_XS = 213 * MiB;
constexpr size_t WS_HM = 293 * MiB;
constexpr size_t WS_YS = 333 * MiB;
constexpr size_t WS_END = 490 * MiB;

constexpr int NWAVES = 8, NTHREADS = 512;
constexpr int LDS_BYTES = 156 * 1024;

DI unsigned cvtpk(float lo, float hi) { f32x2_t v = {lo, hi}; bf16x2_t b = __builtin_convertvector(v, bf16x2_t); return __builtin_bit_cast(unsigned, b); }
DI float bflo(unsigned w) { return __uint_as_float(w << 16); }
DI float bfhi(unsigned w) { return __uint_as_float(w & 0xffff0000u); }
DI float bf2f(unsigned short h) { return __uint_as_float((unsigned)h << 16); }
DI unsigned short f2bf(float f) { return (unsigned short)(cvtpk(f, 0.f) & 0xffffu); }
DI float wave_sum_shfl(float v) {
#pragma unroll
    for (int o = 32; o > 0; o >>= 1) v += __shfl_xor(v, o);
    return v;
}
template <int CTRL, int ROWMASK> DI float dpp_add(float v) { return v + __builtin_bit_cast(float, __builtin_amdgcn_update_dpp(0, __builtin_bit_cast(int, v), CTRL, ROWMASK, 0xf, false)); }
DI float wave_sum(float v) {
    v = dpp_add<0xb1, 0xf>(v);
    v = dpp_add<0x4e, 0xf>(v);
    v = dpp_add<0x124, 0xf>(v);
    v = dpp_add<0x128, 0xf>(v);
    v = dpp_add<0x142, 0xa>(v);
    v = dpp_add<0x143, 0xc>(v);
    return __builtin_bit_cast(float, __builtin_amdgcn_readlane(__builtin_bit_cast(int, v), 63));
}
DI float fexp2(float x) { return __builtin_amdgcn_exp2f(x); }
DI float frcp(float x) { return __builtin_amdgcn_rcpf(x); }
DI float sigm(float x) { return frcp(1.f + fexp2(x * -LOG2E)); }
#define LDS_WAIT() asm volatile("s_waitcnt lgkmcnt(0)" ::: "memory")
#define VM_WAIT() asm volatile("s_waitcnt vmcnt(0)" ::: "memory")
DI int swap23(int i) { return (i & ~12) | ((i & 4) << 1) | ((i & 8) >> 1); }

namespace pg8 {
constexpr int BM = 256, BK = 64, HALF = 128, HTB = HALF * BK * 2, STAGE_BYTES = 8 * HTB, NXCD = 8, WGM = 8;
__host__ __device__ __forceinline__ int lds_byte(int r, int c) { const int st = (r >> 4) * 2 + (c >> 5), rr = r & 15, cc = c & 31, ob = rr * 64 + cc * 2; return st * 1024 + (ob ^ (((ob >> 9) & 1) << 5)); }
__host__ __device__ __forceinline__ void stage_rc(int b, int& R, int& C) { const int st = b / 1024, sb = b % 1024, swz = sb ^ (((sb >> 9) & 1) << 5); R = (st >> 1) * 16 + swz / 64; C = (st & 1) * 32 + (swz % 64) / 2; }
__host__ __device__ __forceinline__ int perm32(int rho) { const int n = rho >> 4, i = rho & 15; return 8 * (i >> 2) + 4 * n + (i & 3); }

struct Unit { int pm, pn, aux; };

DI int xcd_remap(int L, int nwg) { const int q = nwg / NXCD, r = nwg % NXCD, xcd = L % NXCD, off = L / NXCD; return (xcd < r ? xcd * (q + 1) : r * (q + 1) + (xcd - r) * q) + off; }

struct PlainOrder {
    static constexpr bool GATHER = false;
    const bf16_t* A; const bf16_t* Bt; int K; int nM, nN, nwg, G, c;
    DI void init(const bf16_t* A_, const bf16_t* Bt_, int M, int N, int K_, int G_, int c_) { A = A_; Bt = Bt_; K = K_; nM = M / BM; nN = N / BM; nwg = nM * nN; G = G_; c = c_; }
    DI bool next(int i, Unit& u) const {
        const int Lx = i * G + c; if (Lx >= nwg) return false;
        const int wgid = xcd_remap(Lx, nwg);
        const int nig = WGM * nN, gid = wgid / nig, fm = gid * WGM, gsz = (nM - fm) < WGM ? (nM - fm) : WGM;
        u.pm = fm + ((wgid % nig) % gsz); u.pn = (wgid % nig) / gsz; u.aux = 0; return true;
    }
    DI const char* aptr(const Unit& u) const { return (const char*)A + (size_t)u.pm * (2 * HALF) * K * 2; }
    DI const char* bptr(const Unit& u) const { return (const char*)Bt + (size_t)u.pn * (2 * HALF) * K * 2; }
};
struct Gemm1Order {
    static constexpr bool GATHER = false;
    const bf16_t* U; const bf16_t* Win; const bf16_t* Wv; int G, c;
    static constexpr int nM = T / BM, nN = HW / BM, nMain = nM * nN, nV = 2 * (T / BM), nwg = nMain + nV, K = D;
    DI bool next(int i, Unit& u) const {
        const int Lx = i * G + c; if (Lx >= nwg) return false;
        if (Lx < nMain) {
            const int wgid = xcd_remap(Lx, nMain);
            const int nig = WGM * nN, gid = wgid / nig, fm = gid * WGM, gsz = (nM - fm) < WGM ? (nM - fm) : WGM;
            u.pm = fm + ((wgid % nig) % gsz); u.pn = (wgid % nig) / gsz; u.aux = 0;
        } else { const int v = Lx - nMain; u.pm = v & 1; u.pn = v >> 1; u.aux = 1; }
        return true;
    }
    DI const char* aptr(const Unit& u) const { return (const char*)(u.aux ? Wv : U) + (size_t)u.pm * BM * K * 2; }
    DI const char* bptr(const Unit& u) const { return (const char*)(u.aux ? U : Win) + (size_t)u.pn * BM * K * 2; }
};
template <bool G_> struct GroupedOrderT {
    static constexpr bool GATHER = G_;
    const bf16_t* A; const bf16_t* Bt; int K; size_t estride; const LAS int* tile_e; int ntiles, nwg, G, c; const int* rowtok;
    DI bool next(int i, Unit& u) const {
        const int Lx = i * G + c; if (Lx >= nwg) return false;
        const int wgid = xcd_remap(Lx, nwg);
        u.pm = wgid >> 2; u.pn = wgid & 3; u.aux = tile_e[u.pm]; return true;
    }
    DI const char* aptr(const Unit& u) const { return GATHER ? (const char*)A : (const char*)A + (size_t)u.pm * BM * K * 2; }
    DI const char* bptr(const Unit& u) const { return (const char*)Bt + ((size_t)u.aux * estride + (size_t)u.pn * BM * K) * 2; }
};

struct EpiStore {
    bf16_t* O0; int ld0; bf16_t* O1; int ld1;
    DI void operator()(const f32x4 (&acc)[2][2][4][2], const Unit& u, int wr, int wc, int fr, int fq) const {
        bf16_t* base = u.aux ? O1 : O0; const int ldc = u.aux ? ld1 : ld0;
        const int row0 = u.pm * BM + wr * 64 + fr, col0 = u.pn * BM + wc * 32 + 8 * fq;
#pragma unroll
        for (int ai = 0; ai < 2; ++ai)
#pragma unroll
            for (int m = 0; m < 4; ++m) { bf16_t* rowp = base + (size_t)(row0 + ai * HALF + m * 16) * ldc + col0;
#pragma unroll
                for (int bj = 0; bj < 2; ++bj) { const f32x4 v0 = acc[ai][bj][m][0], v1 = acc[ai][bj][m][1];
                    u32x4 w; w.x = cvtpk(v0[0], v0[1]); w.y = cvtpk(v0[2], v0[3]); w.z = cvtpk(v1[0], v1[1]); w.w = cvtpk(v1[2], v1[3]);
                    *(u32x4*)(rowp + bj * HALF) = w; } }
    }
};
struct EpiSwiGlu {
    bf16_t* O;
    DI void operator()(const f32x4 (&acc)[2][2][4][2], const Unit& u, int wr, int wc, int fr, int fq) const {
        const int row0 = u.pm * BM + wr * 64 + fr, col0 = u.pn * HALF + wc * 32 + 8 * fq;
#pragma unroll
        for (int ai = 0; ai < 2; ++ai)
#pragma unroll
            for (int m = 0; m < 4; ++m) { bf16_t* rowp = O + (size_t)(row0 + ai * HALF + m * 16) * DE + col0;
                float hv[8];
#pragma unroll
                for (int n = 0; n < 2; ++n)
#pragma unroll
                    for (int e = 0; e < 4; ++e) { const float g = acc[ai][0][m][n][e], up = acc[ai][1][m][n][e]; hv[4 * n + e] = g * sigm(g) * up; }
                u32x4 w; w.x = cvtpk(hv[0], hv[1]); w.y = cvtpk(hv[2], hv[3]); w.z = cvtpk(hv[4], hv[5]); w.w = cvtpk(hv[6], hv[7]);
                *(u32x4*)rowp = w; }
    }
};
struct EpiRowScale {
    bf16_t* O; const float* roww;
    DI void operator()(const f32x4 (&acc)[2][2][4][2], const Unit& u, int wr, int wc, int fr, int fq) const {
        const int row0 = u.pm * BM + wr * 64 + fr, col0 = u.pn * BM + wc * 32 + 8 * fq;
#pragma unroll
        for (int ai = 0; ai < 2; ++ai)
#pragma unroll
            for (int m = 0; m < 4; ++m) { const int row = row0 + ai * HALF + m * 16;
#ifdef MOEB_NOSCALE
                const float s = 1.f;
#else
                const float s = roww[row];
#endif
                bf16_t* rowp = O + (size_t)row * D + col0;
#pragma unroll
                for (int bj = 0; bj < 2; ++bj) { const f32x4 v0 = acc[ai][bj][m][0] * s, v1 = acc[ai][bj][m][1] * s;
                    u32x4 w; w.x = cvtpk(v0[0], v0[1]); w.y = cvtpk(v0[2], v0[3]); w.z = cvtpk(v1[0], v1[1]); w.w = cvtpk(v1[2], v1[3]);
                    *(u32x4*)(rowp + bj * HALF) = w; } }
    }
};

template <class Epi, class Sched>
DI void gemm_phase(LAS unsigned char* lds, const int tid, const int K, const Sched& S, const Epi& E) {
    const int wid = __builtin_amdgcn_readfirstlane(tid >> 6), lane = tid & 63, wr = wid >> 2, wc = wid & 3, fr = lane & 15, fq = lane >> 4;
    const int nt = K / BK;
    unsigned voffA[2], voffB[2];
#pragma unroll
    for (int i = 0; i < 2; ++i) { int R, C; stage_rc(tid * 16 + i * 8192, R, C); const int Rb = (R & ~31) + perm32(R & 31);
        voffA[i] = (unsigned)(R * K + C) * 2u; voffB[i] = (unsigned)(Rb * K + C) * 2u; }
    const size_t kstep = (size_t)(BK * 2);
    const size_t hstep = (size_t)HALF * K * 2;
    const size_t hstepA = Sched::GATHER ? 0 : hstep;
    int RA_[2], CA_[2];
#pragma unroll
    for (int i = 0; i < 2; ++i) stage_rc(tid * 16 + i * 8192, RA_[i], CA_[i]);
    unsigned vgc[2][2], vgn[2][2], vgnn[2][2];
#define PG8_GLOAD(dst, u_) do { if constexpr (Sched::GATHER) { _Pragma("unroll") for (int h_ = 0; h_ < 2; ++h_) _Pragma("unroll") for (int i_ = 0; i_ < 2; ++i_) \
        dst[h_][i_] = ((unsigned)S.rowtok[(u_).pm * BM + h_ * HALF + RA_[i_]] * (unsigned)K + (unsigned)CA_[i_]) * 2u; } } while (0)
    const unsigned ldsw = (unsigned)wid * 1024u;
    const int aoff = lds_byte(wr * 64 + fr, fq * 8), boff = lds_byte(wc * 32 + fr, fq * 8);
#define PG8_SA(b, h) (((b) * 2 + (h)) * HTB)
#define PG8_SB(b, h) ((4 + (b) * 2 + (h)) * HTB)
#define PG8_STAGE(bufoff, gbase, voff) do { _Pragma("unroll") for (int _i = 0; _i < 2; ++_i) \
        __builtin_amdgcn_global_load_lds((const unsigned*)((const char*)(gbase) + (voff)[_i]), (LAS unsigned*)(lds + (bufoff) + ldsw + _i * 8192), 16, 0, 0); } while (0)
#define PG8_STAGE_A(b, h, gbase, cur_) do { if constexpr (Sched::GATHER) { unsigned vo_[2]; vo_[0] = (cur_) ? vgc[h][0] : vgn[h][0]; vo_[1] = (cur_) ? vgc[h][1] : vgn[h][1]; PG8_STAGE(PG8_SA(b, h), gbase, vo_); } else PG8_STAGE(PG8_SA(b, h), (gbase) + (h) * hstepA, voffA); } while (0)
#define PG8_LDA(dst, b, h) do { _Pragma("unroll") for (int m = 0; m < 4; ++m) _Pragma("unroll") for (int k = 0; k < 2; ++k) dst[m][k] = *(const LAS bf16x8*)(lds + PG8_SA(b, h) + aoff + m * 2048 + k * 1024); } while (0)
#define PG8_LDB(dst, b, h) do { _Pragma("unroll") for (int n = 0; n < 2; ++n) _Pragma("unroll") for (int k = 0; k < 2; ++k) dst[n][k] = *(const LAS bf16x8*)(lds + PG8_SB(b, h) + boff + n * 2048 + k * 1024); } while (0)
#define PG8_MMA(ai, bj, At, Bt) do { __builtin_amdgcn_s_setprio(1); _Pragma("unroll") for (int m = 0; m < 4; ++m) _Pragma("unroll") for (int n = 0; n < 2; ++n) _Pragma("unroll") for (int k = 0; k < 2; ++k) \
        acc[ai][bj][m][n] = __builtin_amdgcn_mfma_f32_16x16x32_bf16(Bt[n][k], At[m][k], acc[ai][bj][m][n], 0, 0, 0); __builtin_amdgcn_s_setprio(0); } while (0)
#define PG8_WAIT_V(n) asm volatile("s_waitcnt vmcnt(" #n ")" ::: "memory")
#define PG8_WAIT_L(n) asm volatile("s_waitcnt lgkmcnt(" #n ")" ::: "memory")
#define PG8_BAR __builtin_amdgcn_s_barrier()
#define PG8_SCHED __builtin_amdgcn_sched_barrier(0)
    Unit cur, nxt; int ui = 0;
    if (!S.next(0, cur)) return;
    f32x4 acc[2][2][4][2];
#pragma unroll
    for (int a = 0; a < 2; ++a)
#pragma unroll
        for (int b = 0; b < 2; ++b)
#pragma unroll
            for (int m = 0; m < 4; ++m)
#pragma unroll
                for (int n = 0; n < 2; ++n) acc[a][b][m][n] = (f32x4){0.f, 0.f, 0.f, 0.f};
    bf16x8 At[4][2], B0[2][2], B1[2][2];
    const char* cA = S.aptr(cur); const char* cB = S.bptr(cur);
    if constexpr (Sched::GATHER) { Unit u1_ = cur, u2_ = cur; const bool h1_ = S.next(1, u1_); if (!h1_) u1_ = cur; const bool h2_ = h1_ && S.next(2, u2_); if (!h2_) u2_ = u1_;
        PG8_GLOAD(vgc, cur); PG8_GLOAD(vgn, u1_); PG8_GLOAD(vgnn, u2_); }
    PG8_STAGE(PG8_SB(0, 0), cB, voffB); PG8_STAGE(PG8_SB(0, 1), cB + hstep, voffB); PG8_STAGE_A(0, 0, cA, true); PG8_STAGE_A(0, 1, cA, true);
    if (wr == 1) PG8_BAR;
    PG8_WAIT_V(2); PG8_BAR;
    PG8_STAGE(PG8_SB(1, 0), cB + kstep, voffB); PG8_STAGE_A(1, 0, cA + kstep, true); PG8_STAGE(PG8_SB(1, 1), cB + hstep + kstep, voffB);
    PG8_WAIT_V(6); PG8_BAR;
    for (;;) {
        const bool has_next = S.next(ui + 1, nxt);
        const char* nA = has_next ? S.aptr(nxt) : cA; const char* nB = has_next ? S.bptr(nxt) : cB;

        for (int t = 0; t < nt; t += 2) {
            const bool last = (t == nt - 2);
            const char* a1 = cA + (size_t)(t + 1) * kstep;
            const char* a2 = last ? nA : cA + (size_t)(t + 2) * kstep; const char* b2 = last ? nB : cB + (size_t)(t + 2) * kstep;
            const char* a3 = a2 + kstep; const char* b3 = b2 + kstep;
            PG8_LDB(B0, 0, 0); PG8_LDB(B1, 0, 1); PG8_SCHED; PG8_LDA(At, 0, 0); PG8_STAGE_A(1, 1, a1, true);
            PG8_WAIT_V(8); PG8_WAIT_L(0); PG8_BAR; PG8_MMA(0, 0, At, B0); PG8_MMA(0, 1, At, B1); PG8_BAR; PG8_SCHED;
            PG8_LDA(At, 0, 1); PG8_STAGE(PG8_SB(0, 0), b2, voffB); PG8_STAGE(PG8_SB(0, 1), b2 + hstep, voffB); PG8_STAGE_A(0, 0, a2, !last);
            PG8_WAIT_V(8); PG8_WAIT_L(0); PG8_BAR; PG8_MMA(1, 0, At, B0); PG8_MMA(1, 1, At, B1); PG8_BAR; PG8_SCHED;
            PG8_LDB(B0, 1, 0); PG8_LDB(B1, 1, 1); PG8_SCHED; PG8_LDA(At, 1, 0); PG8_STAGE_A(0, 1, a2, !last);
            PG8_WAIT_V(8); PG8_WAIT_L(0); PG8_BAR; PG8_MMA(0, 0, At, B0); PG8_MMA(0, 1, At, B1); PG8_BAR; PG8_SCHED;
            PG8_LDA(At, 1, 1); PG8_STAGE(PG8_SB(1, 0), b3, voffB); PG8_STAGE(PG8_SB(1, 1), b3 + hstep, voffB); PG8_STAGE_A(1, 0, a3, !last);
            PG8_WAIT_V(8); PG8_WAIT_L(0); PG8_BAR; PG8_MMA(1, 0, At, B0); PG8_MMA(1, 1, At, B1); PG8_BAR; PG8_SCHED;
        }
        if (wr == 0) PG8_BAR;
        E(acc, cur, wr, wc, fr, fq);
        if (!has_next) break;
#pragma unroll
        for (int a = 0; a < 2; ++a)
#pragma unroll
            for (int b = 0; b < 2; ++b)
#pragma unroll
                for (int m = 0; m < 4; ++m)
#pragma unroll
                    for (int n = 0; n < 2; ++n) acc[a][b][m][n] = (f32x4){0.f, 0.f, 0.f, 0.f};
        cur = nxt; cA = nA; cB = nB; ++ui;
        if constexpr (Sched::GATHER) { _Pragma("unroll") for (int h_ = 0; h_ < 2; ++h_) _Pragma("unroll") for (int i_ = 0; i_ < 2; ++i_) { vgc[h_][i_] = vgn[h_][i_]; vgn[h_][i_] = vgnn[h_][i_]; } }
        if (wr == 1) PG8_BAR;
    }
    PG8_WAIT_V(0);
    PG8_BAR;
#undef PG8_SA
#undef PG8_SB
#undef PG8_STAGE
#undef PG8_STAGE_A
#undef PG8_GLOAD
#undef PG8_LDA
#undef PG8_LDB
#undef PG8_MMA
#undef PG8_WAIT_V
#undef PG8_WAIT_L
#undef PG8_BAR
#undef PG8_SCHED
}
}

#define XB_TMO      128
#define XB_XCNT(j)  (256  + 64 * (j))
#define XB_XSUB(j)  (1280 + 64 * (j))
#define XB_XGEN(j)  (2304 + 64 * (j))
#define XB_TOP      3328
#define XB_TOPGEN   3392
#define XCD_BAR_WORDS 3456
#define XB_SPIN_CAP (1u << 20)
DI unsigned xb_ld(unsigned* p)              { return __hip_atomic_load(p, __ATOMIC_RELAXED, __HIP_MEMORY_SCOPE_AGENT); }
DI unsigned xb_add(unsigned* p, unsigned v) { return __hip_atomic_fetch_add(p, v, __ATOMIC_RELAXED, __HIP_MEMORY_SCOPE_AGENT); }
DI unsigned xb_xcc_id() { return (unsigned)__builtin_amdgcn_s_getreg((3 << 11) | 20) & 0xFu; }
#define XB_SPIN(cond, bar) do { unsigned _sp = 0; while (cond) { __builtin_amdgcn_s_sleep(1); \
    if ((++_sp & 255u) == 0u) { if (xb_ld(&(bar)[XB_TMO])) break; if (_sp > XB_SPIN_CAP) { atomicAdd(&(bar)[XB_TMO], 1u); break; } } } } while (0)
struct XcdBarrier { unsigned* bar; unsigned x; volatile LAS unsigned* st; };
DI XcdBarrier xcd_barrier_post(unsigned* bar, volatile LAS unsigned* st) {
    XcdBarrier b; b.bar = bar; b.x = xb_xcc_id(); b.st = st;
    if (threadIdx.x == 0) (void)xb_add(&bar[XB_XCNT(b.x)], 1u);
    return b;
}
DI void xcd_barrier_complete(unsigned* bar, unsigned x, unsigned& nloc, unsigned& nx) {
    const unsigned G = gridDim.x * gridDim.y * gridDim.z;
    unsigned sum, cnt, mine, sp = 0u;
    for (;;) {
        sum = 0u; cnt = 0u; mine = 0u;
#pragma unroll
        for (unsigned j = 0; j < 16; ++j) { const unsigned c = xb_ld(&bar[XB_XCNT(j)]); sum += c; cnt += (c > 0u) ? 1u : 0u; mine = (j == x) ? c : mine; }
        if (sum == G) break;
        __builtin_amdgcn_s_sleep(1);
        if ((++sp & 255u) == 0u) { if (xb_ld(&bar[XB_TMO])) break; if (sp > XB_SPIN_CAP) { atomicAdd(&bar[XB_TMO], 1u); break; } }
    }
    nloc = mine > 0u ? mine : 1u; nx = cnt > 0u ? cnt : 1u;
}
DI void xcd_barrier(const XcdBarrier& b) {
    asm volatile("s_waitcnt vmcnt(0)" ::: "memory");
    __syncthreads();
    if (threadIdx.x == 0) {
        unsigned* bar = b.bar;
        __builtin_amdgcn_s_waitcnt(0);
        unsigned nloc = b.st[0], nx = b.st[1];
        if (nloc == 0u) { xcd_barrier_complete(bar, b.x, nloc, nx); b.st[0] = nloc; b.st[1] = nx; }
        const unsigned old = xb_add(&bar[XB_XSUB(b.x)], 1u);
        const unsigned gen = old / nloc;
        if (old + 1u == (gen + 1u) * nloc) {
            __builtin_amdgcn_fence(__ATOMIC_RELEASE, "agent");
            asm volatile("s_waitcnt vmcnt(0)" ::: "memory");
            const unsigned og = xb_add(&bar[XB_TOP], 1u);
            const unsigned tg = og / nx;
            if (og + 1u == (tg + 1u) * nx) xb_add(&bar[XB_TOPGEN], 1u);
            else XB_SPIN(xb_ld(&bar[XB_TOPGEN]) == tg, bar);
            __builtin_amdgcn_fence(__ATOMIC_ACQUIRE, "agent");
            xb_add(&bar[XB_XGEN(b.x)], 1u);
            asm volatile("s_waitcnt vmcnt(0)" ::: "memory");
        } else {
            XB_SPIN(xb_ld(&bar[XB_XGEN(b.x)]) == gen, bar);
            __builtin_amdgcn_fence(__ATOMIC_ACQUIRE, "agent");
            asm volatile("s_waitcnt vmcnt(0)" ::: "memory");
        }
    }
    __syncthreads();
}

struct Args { const float* in[31]; float* out; unsigned char* ws; int ph_lo, ph_hi, use_cg, pad; };
struct Frame {
    LAS unsigned char* lds;
    int tid, lane, wave, G, vcu, gw, ngw, bx;
    unsigned char* ws;
};
constexpr int LDS_MISC = 131072;
constexpr int LDS_BARST = LDS_BYTES - 64;

struct TItem { const float* src; bf16_t* dst; int ldw, ldt; };
DI void titem_load(const TItem& t, f32x4 (&v)[16], int lane) {
#pragma unroll
    for (int i = 0; i < 16; ++i) v[i] = *(const f32x4*)(t.src + (size_t)(4 * i + (lane >> 4)) * t.ldw + 4 * (lane & 15));
}
DI void titem_store(const TItem& t, const f32x4 (&v)[16], LAS float* scr, int lane) {
#pragma unroll
    for (int i = 0; i < 16; ++i) { LAS float* s = scr + (4 * i + (lane >> 4)) * 65 + 4 * (lane & 15); s[0] = v[i][0]; s[1] = v[i][1]; s[2] = v[i][2]; s[3] = v[i][3]; }
    LDS_WAIT();
#pragma unroll
    for (int j = 0; j < 8; ++j) {
        const int n = 8 * j + (lane >> 3), c = lane & 7; const LAS float* s = scr + (8 * c) * 65 + n;
        u32x4 o; o.x = cvtpk(s[0], s[65]); o.y = cvtpk(s[130], s[195]); o.z = cvtpk(s[260], s[325]); o.w = cvtpk(s[390], s[455]);
        *(u32x4*)(t.dst + (size_t)n * t.ldt + 8 * c) = o;
    }
    LDS_WAIT();
}
constexpr int IT_WIN = 16 * 42, IT_WOUT = 16 * 16, IT_SMALL = IT_WIN + IT_WOUT;
constexpr int IT_EXP = 128 * 3, IT_MOE = NE * IT_EXP;
DI TItem small_item(const Frame& F, const float* w_in, const float* w_out, int git) {
    const int l = git / IT_SMALL, it = git % IT_SMALL; TItem t;
    if (it < IT_WIN) {
        const int kt = it / 42, nt = it % 42, n0 = 64 * nt;
        size_t drow; if (n0 < 768) drow = n0; else if (n0 < 1152) drow = 2304 + (n0 - 768); else drow = n0 - 384;
        t.src = w_in + (size_t)l * D * INW + (size_t)(64 * kt) * INW + n0; t.ldw = INW;
        t.dst = (bf16_t*)(F.ws + WS_WIN + (size_t)l * WIN_LAYER) + drow * D + 64 * kt; t.ldt = D;
    } else {
        const int r = it - IT_WIN, kt = r >> 4, nt = r & 15;
        t.src = w_out + (size_t)l * D * D + (size_t)(64 * kt) * D + 64 * nt; t.ldw = D;
        t.dst = (bf16_t*)(F.ws + WS_WOUT) + (size_t)l * D * D + (size_t)(64 * nt) * D + 64 * kt; t.ldt = D;
    }
    return t;
}
DI TItem moe_item(const Frame& F, const float* wg, const float* wu, const float* wd, int l, int it) {
    const int e = it / IT_EXP, r = it % IT_EXP, which = r >> 7, q = r & 127; TItem t;
    if (which < 2) {
        const int kt = q >> 3, nt = q & 7, n0 = 64 * nt;
        t.src = (which ? wu : wg) + ((size_t)l * NE + e) * D * DE + (size_t)(64 * kt) * DE + n0; t.ldw = DE;
        const size_t drow = (size_t)(n0 >> 7) * 256 + (which ? 128 : 0) + (n0 & 127);
        t.dst = (bf16_t*)(F.ws + WS_WGU) + (size_t)e * D * D + drow * D + 64 * kt; t.ldt = D;
    } else {
        const int kt = q >> 4, nt = q & 15;
        t.src = wd + ((size_t)l * NE + e) * DE * D + (size_t)(64 * kt) * D + 64 * nt; t.ldw = D;
        t.dst = (bf16_t*)(F.ws + WS_WD) + (size_t)e * D * DE + (size_t)(64 * nt) * DE + 64 * kt; t.ldt = DE;
    }
    return t;
}
DI void p0_prologue(const Frame& F, const Args& a) {
    const float* c = a.in[1]; const float* w_mod = a.in[2]; const float* b_mod = a.in[3];
    if (F.bx < L * (MODW / 64)) {
        LAS float* sc = (LAS float*)(F.lds);
        LAS float* red = (LAS float*)(F.lds + 8192);
        for (int i = F.tid; i < NB * D; i += NTHREADS) { const float v = c[i]; sc[i] = v / (1.f + expf(-v)); }
        __syncthreads();
        const int l = F.bx / (MODW / 64), cb = F.bx % (MODW / 64), n = cb * 64 + F.lane;
        const float* w = w_mod + (size_t)l * D * MODW + n;
        float a0 = 0.f, a1 = 0.f;
#pragma unroll 8
        for (int k = F.wave * 128; k < F.wave * 128 + 128; ++k) { const float wv = w[(size_t)k * MODW]; a0 += sc[k] * wv; a1 += sc[D + k] * wv; }
        red[(F.wave * 2 + 0) * 64 + F.lane] = a0; red[(F.wave * 2 + 1) * 64 + F.lane] = a1;
        __syncthreads();
        if (F.tid < 128) { const int b = F.tid >> 6, ln = F.tid & 63; float s = 0.f;
#pragma unroll
            for (int w8 = 0; w8 < 8; ++w8) s += red[(w8 * 2 + b) * 64 + ln];
            const int nn = cb * 64 + ln;
            ((float*)(F.ws + WS_MOD))[(size_t)(l * NB + b) * MODW + nn] = s + b_mod[l * MODW + nn]; }
        __syncthreads();
    }
    { const int nzero = L * 128 * D / 8;
      for (int i = F.gw * 64 + F.lane; i < nzero; i += F.ngw * 64) { const int l = i / (128 * D / 8), r = i % (128 * D / 8);
          *(u32x4*)((bf16_t*)(F.ws + WS_WIN + (size_t)l * WIN_LAYER) + (size_t)(2304 + 384) * D + (size_t)r * 8) = (u32x4){0u, 0u, 0u, 0u}; } }
    LAS float* scr = (LAS float*)(F.lds + 16384) + F.wave * (64 * 65);
    { f32x4 cur[16], nxt[16]; int it = F.gw; TItem tc{}, tn{};
      if (it < L * IT_SMALL) { tc = small_item(F, a.in[4], a.in[19], it); titem_load(tc, cur, F.lane); }
      for (; it < L * IT_SMALL; it += F.ngw) {
          const bool more = it + F.ngw < L * IT_SMALL;
          if (more) { tn = small_item(F, a.in[4], a.in[19], it + F.ngw); titem_load(tn, nxt, F.lane); }
          titem_store(tc, cur, scr, F.lane);
          if (more) { tc = tn;
#pragma unroll
              for (int i = 0; i < 16; ++i) cur[i] = nxt[i]; }
      } }
}

DI void row_ln(f32x4 (&v)[4], float& mean_out, float& rstd_out) {
    float s = 0.f;
#pragma unroll
    for (int j = 0; j < 4; ++j) s += (v[j][0] + v[j][1]) + (v[j][2] + v[j][3]);
    const float mean = wave_sum(s) * (1.f / D); float q = 0.f;
#pragma unroll
    for (int j = 0; j < 4; ++j) { v[j] = v[j] - mean; q += (v[j][0] * v[j][0] + v[j][1] * v[j][1]) + (v[j][2] * v[j][2] + v[j][3] * v[j][3]); }
    mean_out = mean; rstd_out = 1.f / sqrtf(wave_sum(q) * (1.f / D) + LN_EPS);
}
DI void row_mod_store(f32x4 (&v)[4], const float* md, int off_sh, int off_sc, bf16_t* urow, int lane) {
    float mean, rstd; row_ln(v, mean, rstd);
#pragma unroll
    for (int j = 0; j < 4; ++j) { const int col = 4 * lane + 256 * j;
        const f32x4 scv = *(const f32x4*)(md + off_sc + col), shv = *(const f32x4*)(md + off_sh + col);
        v[j] = v[j] * rstd * (1.f + scv) + shv;
        u32x2 w; w.x = cvtpk(v[j][0], v[j][1]); w.y = cvtpk(v[j][2], v[j][3]);
        *(u32x2*)(urow + col) = w; }
}
DI void p_r0(const Frame& F, const float* x) {
    const float* MOD = (const float*)(F.ws + WS_MOD);
    bf16_t* U = (bf16_t*)(F.ws + WS_U);
    for (int row = F.gw; row < T; row += F.ngw) {
        f32x4 v[4];
#pragma unroll
        for (int j = 0; j < 4; ++j) v[j] = *(const f32x4*)(x + (size_t)row * D + 4 * F.lane + 256 * j);
        row_mod_store(v, MOD + (size_t)(row / S) * MODW, 0, D, U + (size_t)row * D, F.lane);
    }
}

constexpr int NGRP = T / 64;
DI void p_rowpass1(const Frame& F, const Args& a, int l, const float* xin, const bool dry = false) {
    const float* MODl = (const float*)(F.ws + WS_MOD) + (size_t)l * NB * MODW;
    const bf16_t* MIX = (const bf16_t*)(F.ws + WS_MIX);
    float* XA = (float*)(F.ws + WS_XA); bf16_t* U = (bf16_t*)(F.ws + WS_U);
    const float* gain = a.in[20] + (size_t)l * D; const float* bias = a.in[21] + (size_t)l * D;
    const float* wg = a.in[24] + (size_t)l * D * NG; const float* bg = a.in[25] + (size_t)l * NG;
    const float* we = a.in[26] + (size_t)l * D * NE; const float* be = a.in[27] + (size_t)l * NE;
    const size_t dro = dry ? 490 * MiB - WS_BC : 0;
    int* BC = (int*)(F.ws + WS_BC + dro); float* TOKW = (float*)(F.ws + WS_TOKW + dro); int* TOKSLOT = (int*)(F.ws + WS_TOKSLOT + (dry ? 496 * MiB - WS_TOKSLOT : 0));
    LAS float* RT = (LAS float*)F.lds;
    LAS unsigned* cntl = (LAS unsigned*)(F.lds + 36 * D * 4 + NWAVES * 72 * 4);
#pragma unroll
    for (int kk = 0; kk < 2; ++kk) { const int k = F.tid + kk * NTHREADS;
        f32x4 v[9]; v[0] = *(const f32x4*)(wg + (size_t)k * NG);
#pragma unroll
        for (int q = 0; q < 8; ++q) v[1 + q] = *(const f32x4*)(we + (size_t)k * NE + 4 * q);
#pragma unroll
        for (int q = 0; q < 9; ++q)
#pragma unroll
            for (int e = 0; e < 4; ++e) RT[(4 * q + e) * D + k] = v[q][e]; }
    for (int grp = F.vcu; grp < NGRP; grp += F.G) {
    if (F.tid < NE) cntl[F.tid] = 0u;
    __syncthreads();
    f32x4 pxa[4], pxb[4]; u32x2 pma[4], pmb[4];
    { const int r0 = 64 * grp + 8 * F.wave;
#pragma unroll
      for (int j = 0; j < 4; ++j) { const int col = 4 * F.lane + 256 * j; pxa[j] = *(const f32x4*)(xin + (size_t)r0 * D + col); pxb[j] = *(const f32x4*)(xin + (size_t)(r0 + 1) * D + col);
          pma[j] = *(const u32x2*)(MIX + (size_t)r0 * D + col); pmb[j] = *(const u32x2*)(MIX + (size_t)(r0 + 1) * D + col); } }
    for (int rp = 0; rp < 4; ++rp) {
        const int row0 = 64 * grp + 8 * F.wave + 2 * rp; const float* md = MODl + (size_t)(row0 / S) * MODW;
        f32x4 va[4], vb[4];
#pragma unroll
        for (int j = 0; j < 4; ++j) { const int col = 4 * F.lane + 256 * j;
            const f32x4 g = *(const f32x4*)(md + 2 * D + col);
            va[j] = pxa[j] * ALPHA + g * (f32x4){bflo(pma[j].x), bfhi(pma[j].x), bflo(pma[j].y), bfhi(pma[j].y)};
            vb[j] = pxb[j] * ALPHA + g * (f32x4){bflo(pmb[j].x), bfhi(pmb[j].x), bflo(pmb[j].y), bfhi(pmb[j].y)}; }
        if (rp < 3) { const int r0 = row0 + 2;
#pragma unroll
          for (int j = 0; j < 4; ++j) { const int col = 4 * F.lane + 256 * j; pxa[j] = *(const f32x4*)(xin + (size_t)r0 * D + col); pxb[j] = *(const f32x4*)(xin + (size_t)(r0 + 1) * D + col);
              pma[j] = *(const u32x2*)(MIX + (size_t)r0 * D + col); pmb[j] = *(const u32x2*)(MIX + (size_t)(r0 + 1) * D + col); } }
        float mean, rstd;
        row_ln(va, mean, rstd);
#pragma unroll
        for (int j = 0; j < 4; ++j) { const int col = 4 * F.lane + 256 * j; va[j] = va[j] * rstd * *(const f32x4*)(gain + col) + *(const f32x4*)(bias + col); *(f32x4*)(XA + (size_t)row0 * D + col) = va[j]; }
        row_ln(vb, mean, rstd);
#pragma unroll
        for (int j = 0; j < 4; ++j) { const int col = 4 * F.lane + 256 * j; vb[j] = vb[j] * rstd * *(const f32x4*)(gain + col) + *(const f32x4*)(bias + col); *(f32x4*)(XA + (size_t)(row0 + 1) * D + col) = vb[j]; }
        row_mod_store(va, md, 3 * D, 4 * D, U + (size_t)row0 * D, F.lane);
        row_mod_store(vb, md, 3 * D, 4 * D, U + (size_t)(row0 + 1) * D, F.lane);
#ifdef DRY_NOROUTER
        if (dry) continue;
#endif
        LAS float* lg = (LAS float*)(F.lds + 36 * D * 4) + F.wave * 72;
#pragma unroll 1
        for (int n = 0; n < 36; n += 3) { float sa[3], sb[3];
#pragma unroll
            for (int q = 0; q < 3; ++q) { sa[q] = 0.f; sb[q] = 0.f;
#pragma unroll
                for (int j = 0; j < 4; ++j) { const f32x4 w = *(const LAS f32x4*)(RT + (n + q) * D + 4 * F.lane + 256 * j);
                    sa[q] += (va[j][0] * w[0] + va[j][1] * w[1]) + (va[j][2] * w[2] + va[j][3] * w[3]);
                    sb[q] += (vb[j][0] * w[0] + vb[j][1] * w[1]) + (vb[j][2] * w[2] + vb[j][3] * w[3]); } }
#pragma unroll
            for (int q = 0; q < 3; ++q) { sa[q] = wave_sum(sa[q]); sb[q] = wave_sum(sb[q]); }
            if (F.lane == 0) {
#pragma unroll
                for (int q = 0; q < 3; ++q) { lg[n + q] = sa[q]; lg[36 + n + q] = sb[q]; } } }
        LDS_WAIT();
#pragma unroll
        for (int rr = 0; rr < 2; ++rr) {
            float gl[4];
#pragma unroll
            for (int n = 0; n < 4; ++n) gl[n] = lg[36 * rr + n] + bg[n];
            int gi = 0; float gm = gl[0];
#pragma unroll
            for (int n = 1; n < 4; ++n) { const bool c = gl[n] > gm; gm = c ? gl[n] : gm; gi = c ? n : gi; }
            float se = 0.f;
#pragma unroll
            for (int n = 0; n < 4; ++n) se += expf(gl[n] - gm);
            const float pg = 1.f / se;
            float l1 = -3.0e38f, l2 = -3.0e38f; int i1 = 0, i2 = 0;
#pragma unroll
            for (int e = 0; e < 8; ++e) { const float v = lg[36 * rr + 4 + gi * EPG + e] + be[gi * EPG + e];
                const bool c1 = v > l1, c2 = v > l2;
                l2 = c1 ? l1 : (c2 ? v : l2); i2 = c1 ? i1 : (c2 ? e : i2); l1 = c1 ? v : l1; i1 = c1 ? e : i1; }
            const float e2 = expf(l2 - l1); const float w1 = pg / (1.f + e2), w2 = pg * e2 / (1.f + e2);
            if (F.lane == 0) {
                const int tok = row0 + rr, ea = gi * EPG + i1, eb = gi * EPG + i2;
                const unsigned pa = __hip_atomic_fetch_add(&cntl[ea], 1u, __ATOMIC_RELAXED, __HIP_MEMORY_SCOPE_WORKGROUP), pb = __hip_atomic_fetch_add(&cntl[eb], 1u, __ATOMIC_RELAXED, __HIP_MEMORY_SCOPE_WORKGROUP);
                TOKSLOT[tok * 2] = (ea << 14) | (int)pa; TOKSLOT[tok * 2 + 1] = (eb << 14) | (int)pb;
                TOKW[tok * 2] = w1; TOKW[tok * 2 + 1] = w2;
            }
        }
    }
    __syncthreads();
    if (F.tid < NE) BC[grp * NE + F.tid] = (int)cntl[F.tid];
    __syncthreads();
    }
}

DI void build_tables(const Frame& F, int l, LAS int* tb) {
    if (F.tid < 64) {
        const int e = F.lane; const int c = e < NE ? ((const int*)(F.ws + WS_CNTF))[e] : 0; const int tl = (c + 255) >> 8;
        int cum = c, tin = tl;
#pragma unroll
        for (int o = 1; o < 32; o <<= 1) { const int a1 = __shfl_up(cum, o), a2 = __shfl_up(tin, o); if (e >= o) { cum += a1; tin += a2; } }
        if (e < NE) { tb[e] = cum - c; tb[33 + e] = (tin - tl) * 256; for (int t2 = 0; t2 < tl; ++t2) tb[66 + (tin - tl) + t2] = e; }
        if (e == NE - 1) { tb[32] = cum; tb[65] = tin; }
    }
    __syncthreads();
}
DI void p_gather(const Frame& F, int l) {
    LAS int* base = (LAS int*)F.lds;
    LAS int* segt = base + NGRP * NE;
    LAS int* offp = segt + 16 * NE;
    const int* BC = (const int*)(F.ws + WS_BC);
    { int tmp[NGRP * NE / NTHREADS];
#pragma unroll
      for (int q = 0; q < NGRP * NE / NTHREADS; ++q) tmp[q] = BC[F.tid + q * NTHREADS];
#pragma unroll
      for (int q = 0; q < NGRP * NE / NTHREADS; ++q) base[F.tid + q * NTHREADS] = tmp[q]; }
    __syncthreads();
    { const int e = F.tid & 31, sg = F.tid >> 5; int run = 0;
      for (int g = 16 * sg; g < 16 * sg + 16; ++g) { const int c = base[g * NE + e]; base[g * NE + e] = run; run += c; }
      segt[sg * NE + e] = run; }
    __syncthreads();
    if (F.tid < NE) { int run = 0; for (int sg = 0; sg < 16; ++sg) { const int c = segt[sg * NE + F.tid]; segt[sg * NE + F.tid] = run; run += c; }
        offp[F.tid] = run;
        if (F.bx == 0) ((int*)(F.ws + WS_CNTF))[F.tid] = run; }
    __syncthreads();
    if (F.tid == 0) { int off = 0; for (int e = 0; e < NE; ++e) { const int c = offp[e]; offp[e] = off; off += ((c + 255) >> 8) * 256; } }
    __syncthreads();
    const int* TOKSLOT = (const int*)(F.ws + WS_TOKSLOT); const float* TOKW = (const float*)(F.ws + WS_TOKW); int* TOKFIN = (int*)(F.ws + WS_TOKFIN);
    float* SLOTW = (float*)(F.ws + WS_SLOTW);
    const int nas = (2 * T - F.gw + F.ngw - 1) / F.ngw;
    int my_slot = 0, my_tok = 0;
    if (F.lane < nas) { const int as = F.gw + F.lane * F.ngw; const int tok = as >> 1, ts = TOKSLOT[as], e = ts >> 14, grp = tok >> 6, sg = grp >> 4;
        my_slot = offp[e] + segt[sg * NE + e] + base[grp * NE + e] + (ts & 16383); my_tok = tok;
        SLOTW[my_slot] = TOKW[as]; TOKFIN[as] = my_slot; ((int*)(F.ws + WS_CTL + WS_SLOTTOK))[my_slot] = tok; }
}
struct Rp2In { f32x4 x[4]; u32x2 y0[4], y1[4]; };
DI void rp2_load(Rp2In& r, const float* XA, const bf16_t* YS, int row, int s0, int s1, int lane) {
#pragma unroll
    for (int j = 0; j < 4; ++j) { const int col = 4 * lane + 256 * j;
        r.x[j] = *(const f32x4*)(XA + (size_t)row * D + col); r.y0[j] = *(const u32x2*)(YS + (size_t)s0 * D + col); r.y1[j] = *(const u32x2*)(YS + (size_t)s1 * D + col); }
}
DI void p_rowpass2(const Frame& F, const Args& a, int l, float* xout) {
    const float* MOD = (const float*)(F.ws + WS_MOD);
    const float* XA = (const float*)(F.ws + WS_XA); const bf16_t* YS = (const bf16_t*)(F.ws + WS_YS); const int* TOKFIN = (const int*)(F.ws + WS_TOKFIN);
    const float* gain = a.in[22] + (size_t)l * D; const float* bias = a.in[23] + (size_t)l * D;
    bf16_t* U = (bf16_t*)(F.ws + WS_U);
    const int nrows = (T - F.gw + F.ngw - 1) / F.ngw;
    int tf = 0; { const int i = F.lane >> 1; if (i < nrows) tf = TOKFIN[(F.gw + i * F.ngw) * 2 + (F.lane & 1)]; }
    Rp2In cur, nxt;
    if (nrows > 0) rp2_load(cur, XA, YS, F.gw, __shfl(tf, 0), __shfl(tf, 1), F.lane);
    for (int i = 0; i < nrows; ++i) {
        const int row = F.gw + i * F.ngw;
        if (i + 1 < nrows) rp2_load(nxt, XA, YS, row + F.ngw, __shfl(tf, 2 * i + 2), __shfl(tf, 2 * i + 3), F.lane);
        const float* md = MOD + (size_t)(l * NB + row / S) * MODW;
        f32x4 v[4];
#pragma unroll
        for (int j = 0; j < 4; ++j) { const int col = 4 * F.lane + 256 * j;
            const f32x4 g = *(const f32x4*)(md + 5 * D + col);
            const u32x2 y0 = cur.y0[j], y1 = cur.y1[j];
            const f32x4 f = (f32x4){bflo(y0.x) + bflo(y1.x), bfhi(y0.x) + bfhi(y1.x), bflo(y0.y) + bflo(y1.y), bfhi(y0.y) + bfhi(y1.y)};
            v[j] = cur.x[j] * ALPHA + g * f; }
        float mean, rstd; row_ln(v, mean, rstd);
#pragma unroll
        for (int j = 0; j < 4; ++j) { const int col = 4 * F.lane + 256 * j; v[j] = v[j] * rstd * *(const f32x4*)(gain + col) + *(const f32x4*)(bias + col); *(f32x4*)(xout + (size_t)row * D + col) = v[j]; }
        if (l + 1 < L) row_mod_store(v, MOD + (size_t)((l + 1) * NB + row / S) * MODW, 0, D, U + (size_t)row * D, F.lane);
        if (i + 1 < nrows) {
#pragma unroll
            for (int j = 0; j < 4; ++j) { cur.x[j] = nxt.x[j]; cur.y0[j] = nxt.y0[j]; cur.y1[j] = nxt.y1[j]; } }
    }
}

#define MFMA16(a, b, c) __builtin_amdgcn_mfma_f32_16x16x32_bf16((a), (b), (c), 0, 0, 0)
#define MFMA32(a, b, c) __builtin_amdgcn_mfma_f32_32x32x16_bf16((a), (b), (c), 0, 0, 0)
constexpr int RB = 9216;
#define BUF(i) ((i) * RB)
constexpr int LWOFF = BUF(12), ZAOFF = BUF(0), SEGOFF = BUF(14), SEGXOFF = BUF(14) + 2048, TOTOFF = BUF(14) + 4096, NABFOFF = BUF(15), PCOFF = 16 * RB;
struct RwP { const float *conv, *w0, *w_up, *a0, *a_up, *g_up, *k_k, *k_a, *r_k, *gn_gain, *gn_bias; };

DI void lds_barrier() { asm volatile("s_waitcnt lgkmcnt(0)" ::: "memory"); __builtin_amdgcn_s_barrier(); asm volatile("" ::: "memory"); }
DI int swo(int row, int col) { return row * 144 + (((((col >> 3) ^ (row >> 3)) & 7) << 3) + (col & 7)) * 2; }
DI bf16x8 ldfrag(const LAS unsigned char* lds, int buf, int row, int ks, int lane) { return *(const LAS bf16x8*)(lds + buf + swo(row, 32 * ks + 8 * (lane >> 4))); }
DI f32x4 mm64(const LAS unsigned char* lds, int abuf, int arow0, int bbuf, int brow0, int lane) {
    f32x4 acc = (f32x4){0.f, 0.f, 0.f, 0.f};
#pragma unroll
    for (int ks = 0; ks < 2; ++ks) acc = MFMA16(ldfrag(lds, abuf, arow0 + (lane & 15), ks, lane), ldfrag(lds, bbuf, brow0 + (lane & 15), ks, lane), acc);
    return acc;
}
DI u32x2 pack4(const f32x4 v) { u32x2 w; w.x = cvtpk(v[0], v[1]); w.y = cvtpk(v[2], v[3]); return w; }
DI f32x4 unpack4(const u32x2 w) { return (f32x4){bflo(w.x), bfhi(w.x), bflo(w.y), bfhi(w.y)}; }
DI void st4(LAS unsigned char* lds, int buf, int row, int col, const f32x4 v) { *(LAS u32x2*)(lds + buf + swo(row, col)) = pack4(v); }
DI f32x4 ld4(const LAS unsigned char* lds, int buf, int row, int col) { return unpack4(*(const LAS u32x2*)(lds + buf + swo(row, col))); }
DI void st1(LAS unsigned char* lds, int buf, int row, int col, float v) { *(LAS bf16_t*)(lds + buf + swo(row, col)) = f2bf(v); }
DI float fast_tanh(float x) { const float e = fexp2(x * (2.f * LOG2E)); return 1.f - 2.f * frcp(1.f + e); }

#define OPQZ(z) int z; asm volatile("s_mov_b32 %0, 0" : "=s"(z))
constexpr int CWLOFF = PCOFF + 256;
constexpr int PRMOFF = CWLOFF + 6912;
struct RwPre { u32x2 wv, av; u32x4 gv; f32x4 w4, a4, g0, g1; u32x4 rr[3], kk[3], vv[3]; };
DI void rwkv_prefetch(const Frame& F, const Args& a, const int l, const int unit, RwPre& P) {
    const int tid = F.tid;
    const int c = unit % NCH, hd = (unit / NCH) % BH, b = (unit / (NCH * BH)) % NB, dir = unit / (NCH * BH * NB);
    const bf16_t* HBp = (const bf16_t*)(F.ws + WS_HB);
    const int u = tid >> 3, jg = tid & 7, tloc = 64 * c + u; const size_t tok = (size_t)b * S + tloc;
    const bf16_t* hrow = HBp + tok * HW;
    P.wv = *(const u32x2*)(hrow + HWL + 4 * jg); P.av = *(const u32x2*)(hrow + HAL + 4 * jg); P.gv = *(const u32x4*)(hrow + HGL + 8 * jg);
    OPQZ(z0);
    { const int m = tid >> 4, j4 = (tid & 15) * 4;
      const float* w_up = a.in[8 + z0] + (size_t)l * 2 * RW * BW; const float* a_up = a.in[10 + z0] + (size_t)l * 2 * RA * BW;
      P.w4 = *(const f32x4*)(w_up + (size_t)(dir * RW + m) * BW + hd * HD + j4); P.a4 = *(const f32x4*)(a_up + (size_t)(dir * RA + m) * BW + hd * HD + j4); }
    { const int m = tid >> 3, i8 = (tid & 7) * 8; const float* g_up = a.in[11 + z0] + (size_t)l * RG * BW;
      P.g0 = *(const f32x4*)(g_up + (size_t)m * BW + hd * HD + i8); P.g1 = *(const f32x4*)(g_up + (size_t)m * BW + hd * HD + i8 + 4); }
    const int ch0 = hd * HD + 8 * jg;
#pragma unroll
    for (int x = 0; x < 3; ++x) {
        const int tt = tloc + x - 1; const u32x4 z4 = (u32x4){0u, 0u, 0u, 0u};
        if (tt >= 0 && tt < S) { const bf16_t* hp = HBp + ((size_t)b * S + tt) * HW + HR + ch0; P.rr[x] = *(const u32x4*)hp; P.kk[x] = *(const u32x4*)(hp + BW); P.vv[x] = *(const u32x4*)(hp + 2 * BW); }
        else { P.rr[x] = z4; P.kk[x] = z4; P.vv[x] = z4; }
    }
}
DI void rwkv_local_unit(const Frame& F, const Args& a, const int l, const int unit, RwPre& PF, const int next_unit) {
    LAS unsigned char* lds = F.lds;
    int tid_ = F.tid; asm volatile("" : "+v"(tid_));
    const int tid = tid_, lane = tid_ & 63, wave = F.wave;
    const int c = unit % NCH, hd = (unit / NCH) % BH, b = (unit / (NCH * BH)) % NB, dir = unit / (NCH * BH * NB);
    const bf16_t* HBp = (const bf16_t*)(F.ws + WS_HB);
    const int u = tid >> 3, jg = tid & 7, tau = dir ? 63 - u : u, tloc = 64 * c + u;
    const size_t tok = (size_t)b * S + tloc;
    const int tn = wave & 3, tm0 = 2 * (wave >> 2), g4 = lane >> 4, l15 = lane & 15;
    if (tid < 320) { OPQZ(z2); const int which = tid >> 6, j = tid & 63;
      const float* src = which == 0 ? a.in[7 + z2] + (size_t)l * 2 * BW + dir * BW : which == 1 ? a.in[9 + z2] + (size_t)l * 2 * BW + dir * BW : which == 2 ? a.in[12 + z2] + (size_t)l * BW : which == 3 ? a.in[13 + z2] + (size_t)l * BW : a.in[14 + z2] + (size_t)l * BH * HD;
      *(LAS float*)(lds + PRMOFF + tid * 4) = src[hd * HD + j]; }
    {
        const f32x4 wf = unpack4(PF.wv);
        *(LAS u32x2*)(lds + BUF(8) + swo(tau, 4 * jg)) = pack4((f32x4){fast_tanh(wf[0]), fast_tanh(wf[1]), fast_tanh(wf[2]), fast_tanh(wf[3])});
        *(LAS u32x2*)(lds + BUF(8) + swo(tau, 32 + 4 * jg)) = PF.av;
        const u32x4 gv = PF.gv;
        u32x4 so; so.x = cvtpk(sigm(bflo(gv.x)), sigm(bfhi(gv.x))); so.y = cvtpk(sigm(bflo(gv.y)), sigm(bfhi(gv.y))); so.z = cvtpk(sigm(bflo(gv.z)), sigm(bfhi(gv.z))); so.w = cvtpk(sigm(bflo(gv.w)), sigm(bfhi(gv.w)));
        *(LAS u32x4*)(lds + BUF(9) + swo(tau, 8 * jg)) = so;
        { const int m = tid >> 4, j4 = (tid & 15) * 4;
#pragma unroll
          for (int e = 0; e < 4; ++e) { st1(lds, BUF(10), j4 + e, m, PF.w4[e]); st1(lds, BUF(10), j4 + e, 32 + m, PF.a4[e]); } }
        { const int m = tid >> 3, i8 = (tid & 7) * 8;
#pragma unroll
          for (int e = 0; e < 4; ++e) { st1(lds, BUF(11), i8 + e, m, PF.g0[e]); st1(lds, BUF(11), i8 + 4 + e, m, PF.g1[e]); } }
    }
    lds_barrier();
#pragma unroll
    for (int tmi = 0; tmi < 2; ++tmi) {
        const int tm = tm0 + tmi; const f32x4 z = (f32x4){0.f, 0.f, 0.f, 0.f};
        const f32x4 zw = MFMA16(ldfrag(lds, BUF(10), 16 * tm + l15, 0, lane), ldfrag(lds, BUF(8), 16 * tn + l15, 0, lane), z);
        const f32x4 za = MFMA16(ldfrag(lds, BUF(10), 16 * tm + l15, 1, lane), ldfrag(lds, BUF(8), 16 * tn + l15, 1, lane), z);
        const int trow = 16 * tn + l15, jb = 16 * tm + 4 * g4;
        *(LAS f32x4*)(lds + LWOFF + (trow * 64 + jb) * 4) = zw;
        *(LAS f32x4*)(lds + ZAOFF + (trow * 64 + jb) * 4) = za;
        if (dir == 0) {
            const f32x4 gg = mm64(lds, BUF(11), 16 * tm, BUF(9), 16 * tn, lane);
            *(u32x2*)((bf16_t*)(F.ws + WS_GB) + ((size_t)b * S + 64 * c + trow) * BW + hd * HD + jb) = pack4(gg);
        }
    }
    lds_barrier();
    const int ch0 = hd * HD + 8 * jg;
    float r[8], kd[8], kap[8], bb[8], lw[8];
    {
        float k[8], v[8];
#pragma unroll
        for (int e = 0; e < 8; ++e) { r[e] = 0.f; k[e] = 0.f; v[e] = 0.f; }
#pragma unroll
        for (int x = 0; x < 3; ++x) {
            const LAS unsigned char* cwp = lds + CWLOFF + (((hd * 3 + x) * 3) * 64 + 8 * jg) * 2;
            const u32x4 cr = *(const LAS u32x4*)cwp, ck = *(const LAS u32x4*)(cwp + 128), cv = *(const LAS u32x4*)(cwp + 256);
            const u32x4 rr = PF.rr[x], kk2 = PF.kk[x], vv = PF.vv[x];
            r[0] += bflo(rr.x) * bflo(cr.x); r[1] += bfhi(rr.x) * bfhi(cr.x); r[2] += bflo(rr.y) * bflo(cr.y); r[3] += bfhi(rr.y) * bfhi(cr.y);
            r[4] += bflo(rr.z) * bflo(cr.z); r[5] += bfhi(rr.z) * bfhi(cr.z); r[6] += bflo(rr.w) * bflo(cr.w); r[7] += bfhi(rr.w) * bfhi(cr.w);
            k[0] += bflo(kk2.x) * bflo(ck.x); k[1] += bfhi(kk2.x) * bfhi(ck.x); k[2] += bflo(kk2.y) * bflo(ck.y); k[3] += bfhi(kk2.y) * bfhi(ck.y);
            k[4] += bflo(kk2.z) * bflo(ck.z); k[5] += bfhi(kk2.z) * bfhi(ck.z); k[6] += bflo(kk2.w) * bflo(ck.w); k[7] += bfhi(kk2.w) * bfhi(ck.w);
            v[0] += bflo(vv.x) * bflo(cv.x); v[1] += bfhi(vv.x) * bfhi(cv.x); v[2] += bflo(vv.y) * bflo(cv.y); v[3] += bfhi(vv.y) * bfhi(cv.y);
            v[4] += bflo(vv.z) * bflo(cv.z); v[5] += bfhi(vv.z) * bfhi(cv.z); v[6] += bflo(vv.w) * bflo(cv.w); v[7] += bfhi(vv.w) * bfhi(cv.w);
        }
        const f32x4 zw0 = *(const LAS f32x4*)(lds + LWOFF + (tau * 64 + 8 * jg) * 4), zw1 = *(const LAS f32x4*)(lds + LWOFF + (tau * 64 + 8 * jg + 4) * 4);
        const f32x4 za0 = *(const LAS f32x4*)(lds + ZAOFF + (tau * 64 + 8 * jg) * 4), za1 = *(const LAS f32x4*)(lds + ZAOFF + (tau * 64 + 8 * jg + 4) * 4);
        float ss = 0.f, bsp = 0.f, av[8];
        const LAS f32x4* prm = (const LAS f32x4*)(lds + PRMOFF) + 2 * jg;
        const f32x4 w0a = prm[0], w0b = prm[1], a0a = prm[16], a0b = prm[17], kka = prm[32], kkb = prm[33], kaa = prm[48], kab = prm[49], rka = prm[64], rkb = prm[65];
#pragma unroll
        for (int e = 0; e < 8; ++e) {
            const float zw = (e < 4 ? zw0[e & 3] : zw1[e & 3]) + (e < 4 ? w0a[e & 3] : w0b[e & 3]);
            const float za = (e < 4 ? za0[e & 3] : za1[e & 3]) + (e < 4 ? a0a[e & 3] : a0b[e & 3]);
            lw[e] = (-DECAY * LOG2E) * sigm(zw); av[e] = sigm(za);
            kap[e] = k[e] * (e < 4 ? kka[e & 3] : kkb[e & 3]); ss += kap[e] * kap[e];
            kd[e] = k[e] * (1.f + (av[e] - 1.f) * (e < 4 ? kaa[e & 3] : kab[e & 3]));
            bsp += r[e] * kd[e] * (e < 4 ? rka[e & 3] : rkb[e & 3]);
        }
        ss += __shfl_xor(ss, 1); ss += __shfl_xor(ss, 2); ss += __shfl_xor(ss, 4);
        bsp += __shfl_xor(bsp, 1); bsp += __shfl_xor(bsp, 2); bsp += __shfl_xor(bsp, 4);
        const float rn = __builtin_amdgcn_rsqf(fmaxf(ss, 1e-24f));
#pragma unroll
        for (int e = 0; e < 8; ++e) { kap[e] *= rn; bb[e] = kap[e] * av[e]; }
        if (jg == 0) ((float*)(F.ws + WS_BS))[((size_t)dir * T + tok) * 8 + hd] = bsp;
        *(LAS f32x4*)(lds + LWOFF + (tau * 64 + 8 * jg) * 4) = (f32x4){lw[0], lw[1], lw[2], lw[3]};
        *(LAS f32x4*)(lds + LWOFF + (tau * 64 + 8 * jg + 4) * 4) = (f32x4){lw[4], lw[5], lw[6], lw[7]};
#pragma unroll
        for (int e = 0; e < 8; ++e) st1(lds, BUF(7), 8 * jg + e, tau, v[e]);
        if (dir == 0) {
            u32x4 vo; vo.x = cvtpk(v[0], v[1]); vo.y = cvtpk(v[2], v[3]); vo.z = cvtpk(v[4], v[5]); vo.w = cvtpk(v[6], v[7]);
            *(u32x4*)((bf16_t*)(F.ws + WS_VC) + tok * BW + ch0) = vo;
        }
    }
    lds_barrier();
    if (dir == 0) {
        const size_t ucidx = ((size_t)b * BH + hd) * NCH + c; const int vi = tid >> 3, vc = tid & 7;
        *(u32x4*)((bf16_t*)(F.ws + WS_VTB) + ucidx * 4096 + vi * 64 + vc * 8) = *(const LAS u32x4*)(lds + BUF(7) + swo(vi, 8 * vc));
    }
    { const int seg = tid >> 6, j = tid & 63; float p = 0.f;
#pragma unroll
      for (int i = 0; i < 8; ++i) { LAS float* q = (LAS float*)(lds + LWOFF + ((8 * seg + i) * 64 + j) * 4); p += *q; *q = p; }
      *(LAS float*)(lds + SEGOFF + (seg * 64 + j) * 4) = p; }
    lds_barrier();
    if (tid < 64) { float run = 0.f;
#pragma unroll
      for (int sg = 0; sg < 8; ++sg) { *(LAS float*)(lds + SEGXOFF + (sg * 64 + tid) * 4) = run; run += *(const LAS float*)(lds + SEGOFF + (sg * 64 + tid) * 4); }
      *(LAS float*)(lds + TOTOFF + tid * 4) = run; }
    lds_barrier();
    {
        float At[8], Rt[8], Bt[8], Kt[8], Bh[8], Kh[8], pcs[8];
#pragma unroll
        for (int e = 0; e < 8; ++e) {
            const int j = 8 * jg + e;
            const float lwi = *(const LAS float*)(lds + LWOFF + (tau * 64 + j) * 4) + *(const LAS float*)(lds + SEGXOFF + ((tau >> 3) * 64 + j) * 4);
            const float tot = *(const LAS float*)(lds + TOTOFF + j * 4);
            const float ep = fexp2(lwi - lw[e]), epl = fexp2(lwi), em = fexp2(-lwi), ec = fexp2(tot - lwi);
            At[e] = -kap[e] * ep; Rt[e] = r[e] * epl; Bt[e] = bb[e] * em; Kt[e] = kd[e] * em; Bh[e] = bb[e] * ec; Kh[e] = kd[e] * ec;
            pcs[e] = tot;
        }
        if (u == 0) {
            *(LAS f32x4*)(lds + PCOFF + (8 * jg) * 4) = (f32x4){fexp2(pcs[0]), fexp2(pcs[1]), fexp2(pcs[2]), fexp2(pcs[3])};
            *(LAS f32x4*)(lds + PCOFF + (8 * jg + 4) * 4) = (f32x4){fexp2(pcs[4]), fexp2(pcs[5]), fexp2(pcs[6]), fexp2(pcs[7])}; }
        u32x4 o;
#define PK8(X) (o.x = cvtpk(X[0], X[1]), o.y = cvtpk(X[2], X[3]), o.z = cvtpk(X[4], X[5]), o.w = cvtpk(X[6], X[7]), o)
        *(LAS u32x4*)(lds + BUF(0) + swo(tau, 8 * jg)) = PK8(At);
        *(LAS u32x4*)(lds + BUF(1) + swo(tau, 8 * jg)) = PK8(Bt);
        *(LAS u32x4*)(lds + BUF(2) + swo(tau, 8 * jg)) = PK8(Kt);
        *(LAS u32x4*)(lds + BUF(3) + swo(tau, 8 * jg)) = PK8(Rt);
#undef PK8
#pragma unroll
        for (int e = 0; e < 8; ++e) { const int j = 8 * jg + e; st1(lds, BUF(4), j, tau, At[e]); st1(lds, BUF(5), j, tau, Bh[e]); st1(lds, BUF(6), j, tau, Kh[e]); }
    }
    if (next_unit >= 0) rwkv_prefetch(F, a, l, next_unit, PF);
    lds_barrier();
#pragma unroll
    for (int tmi = 0; tmi < 2; ++tmi) {
        const int tm = tm0 + tmi, mb = 16 * tm + 4 * g4, nn = 16 * tn + l15;
        { f32x4 v = mm64(lds, BUF(1), 16 * tm, BUF(0), 16 * tn, lane);
#pragma unroll
          for (int e = 0; e < 4; ++e) v[e] = (mb + e < nn) ? v[e] : 0.f;
          if (tm == tn) {
#pragma unroll
              for (int e = 0; e < 4; ++e) *(LAS float*)(lds + NABFOFF + ((16 * tm + l15) * 16 + ((mb + e) & 15)) * 4) = v[e];
              v = (f32x4){0.f, 0.f, 0.f, 0.f};
          }
          st4(lds, BUF(11), nn, mb, v); }
        { f32x4 v = mm64(lds, BUF(0), 16 * tm, BUF(2), 16 * tn, lane);
#pragma unroll
          for (int e = 0; e < 4; ++e) v[e] = (nn < mb + e) ? v[e] : 0.f;
          st4(lds, BUF(8), nn, mb, v); }
        { f32x4 v = mm64(lds, BUF(1), 16 * tm, BUF(3), 16 * tn, lane);
#pragma unroll
          for (int e = 0; e < 4; ++e) v[e] = (mb + e <= nn) ? v[e] : 0.f;
          st4(lds, BUF(9), nn, mb, v); }
        { f32x4 v = mm64(lds, BUF(2), 16 * tm, BUF(3), 16 * tn, lane);
#pragma unroll
          for (int e = 0; e < 4; ++e) v[e] = (mb + e <= nn) ? v[e] : 0.f;
          st4(lds, BUF(10), nn, mb, v); }
    }
    lds_barrier();
    if (wave == 0) {
        const int blk = lane >> 4, sr = lane & 15, s = 16 * blk + sr;
        float Tr[16];
#pragma unroll
        for (int t = 0; t < 16; ++t) { float acc = (t == sr) ? 1.f : 0.f;
            const LAS f32x4* col = (const LAS f32x4*)(lds + NABFOFF + ((16 * blk + t) * 16) * 4);
#pragma unroll
            for (int q = 0; q < (t + 3) / 4; ++q) { const f32x4 nv = col[q];
#pragma unroll
                for (int e = 0; e < 4; ++e) if (4 * q + e < t) acc += Tr[4 * q + e] * nv[e]; }
            Tr[t] = acc; __builtin_amdgcn_sched_barrier(0); }
        const u32x4 z4 = (u32x4){0u, 0u, 0u, 0u};
#pragma unroll
        for (int q = 0; q < 9; ++q) { *(LAS u32x4*)(lds + BUF(0) + s * 144 + 16 * q) = z4; *(LAS u32x4*)(lds + BUF(1) + s * 144 + 16 * q) = z4; }
        u32x4 o0, o1; o0.x = cvtpk(Tr[0], Tr[1]); o0.y = cvtpk(Tr[2], Tr[3]); o0.z = cvtpk(Tr[4], Tr[5]); o0.w = cvtpk(Tr[6], Tr[7]);
        o1.x = cvtpk(Tr[8], Tr[9]); o1.y = cvtpk(Tr[10], Tr[11]); o1.z = cvtpk(Tr[12], Tr[13]); o1.w = cvtpk(Tr[14], Tr[15]);
        LDS_WAIT();
        *(LAS u32x4*)(lds + BUF(0) + swo(s, 16 * blk)) = o0; *(LAS u32x4*)(lds + BUF(0) + swo(s, 16 * blk + 8)) = o1;
#pragma unroll
        for (int t = 0; t < 16; ++t) st1(lds, BUF(1), 16 * blk + t, s, Tr[t]);
    }
    lds_barrier();
#pragma unroll
    for (int tmi = 0; tmi < 2; ++tmi) {
        const int tm = tm0 + tmi, mb = 16 * tm + 4 * g4, nn = 16 * tn + l15;
        const f32x4 v = mm64(lds, BUF(0), 16 * tm, BUF(11), 16 * tn, lane);
        st4(lds, BUF(12), nn, mb, v);
#pragma unroll
        for (int e = 0; e < 4; ++e) st1(lds, BUF(2), mb + e, nn, v[e]);
    }
    lds_barrier();
#pragma unroll
    for (int tmi = 0; tmi < 2; ++tmi) {
        const int tm = tm0 + tmi, mb = 16 * tm + 4 * g4, nn = 16 * tn + l15;
        const f32x4 v = mm64(lds, BUF(12), 16 * tm, BUF(2), 16 * tn, lane);
        st4(lds, BUF(13), nn, mb, v);
    }
    lds_barrier();
#pragma unroll
    for (int tmi = 0; tmi < 2; ++tmi) {
        const int tm = tm0 + tmi, mb = 16 * tm + 4 * g4, nn = 16 * tn + l15;
        const f32x4 v = mm64(lds, BUF(13), 16 * tm, BUF(1), 16 * tn, lane) + ld4(lds, BUF(1), nn, mb);
        st4(lds, BUF(14), nn, mb, v);
    }
    lds_barrier();
#pragma unroll
    for (int tmi = 0; tmi < 2; ++tmi) {
        const int tm = tm0 + tmi, mb = 16 * tm + 4 * g4, nn = 16 * tn + l15;
        const f32x4 v = mm64(lds, BUF(2), 16 * tm, BUF(14), 16 * tn, lane) + ld4(lds, BUF(14), nn, mb);
        st4(lds, BUF(15), nn, mb, v);
    }
    lds_barrier();
#pragma unroll
    for (int tmi = 0; tmi < 2; ++tmi) {
        const int tm = tm0 + tmi, mb = 16 * tm + 4 * g4, nn = 16 * tn + l15;
        const f32x4 x1 = mm64(lds, BUF(15), 16 * tm, BUF(4), 16 * tn, lane);
        const f32x4 x2 = mm64(lds, BUF(15), 16 * tm, BUF(8), 16 * tn, lane);
        st4(lds, BUF(0), nn, mb, x1); st4(lds, BUF(1), nn, mb, x2);
    }
    lds_barrier();
    {
        bf16_t* QT = (bf16_t*)(F.ws + WS_QT) + (size_t)unit * 4096; bf16_t* WT = (bf16_t*)(F.ws + WS_WT) + (size_t)unit * 4096; bf16_t* MP = (bf16_t*)(F.ws + WS_MP) + (size_t)unit * 4096;
#pragma unroll
        for (int tmi = 0; tmi < 2; ++tmi) {
            const int tm = tm0 + tmi, mb = 16 * tm + 4 * g4, nn = 16 * tn + l15;
            { const f32x4 v = mm64(lds, BUF(0), 16 * tm, BUF(9), 16 * tn, lane) + ld4(lds, BUF(3), nn, mb);
              *(u32x2*)(QT + (dir ? 63 - nn : nn) * 64 + mb) = pack4(v); }
            { const f32x4 v = mm64(lds, BUF(1), 16 * tm, BUF(9), 16 * tn, lane) + ld4(lds, BUF(10), nn, mb);
              if (dir) *(u32x2*)(WT + (63 - nn) * 64 + (60 - mb)) = pack4((f32x4){v[3], v[2], v[1], v[0]});
              else *(u32x2*)(WT + nn * 64 + mb) = pack4(v); }
            { const float pcv = *(const volatile LAS float*)(lds + PCOFF + nn * 4);
              f32x4 v = mm64(lds, BUF(0), 16 * tm, BUF(5), 16 * tn, lane);
#pragma unroll
              for (int e = 0; e < 4; ++e) v[e] += (mb + e == nn) ? pcv : 0.f;
              *(u32x2*)(MP + nn * 64 + swap23(mb)) = pack4(v); }
            { const f32x4 v = mm64(lds, BUF(1), 16 * tm, BUF(5), 16 * tn, lane) + ld4(lds, BUF(6), nn, mb);
              st4(lds, BUF(2), nn, mb, v); }
        }
    }
    lds_barrier();
    {
        bf16_t* NBp = (bf16_t*)(F.ws + WS_NB);
#pragma unroll
        for (int tmi = 0; tmi < 2; ++tmi) {
            const int tm = tm0 + tmi, mb = 16 * tm + 4 * g4, ii = 16 * tn + l15;
            const f32x4 v = mm64(lds, BUF(2), 16 * tm, BUF(7), 16 * tn, lane);
            const int jb = mb >> 5, jl = mb & 31, q = jl >> 3, hic = (jl >> 2) & 1, ih = ii >> 5, Lc = (ii & 31) + 32 * hic;
            *(u32x2*)(NBp + ((((size_t)unit * 2 + ih) * 2 + jb) * 2 + (q >> 1)) * 512 + Lc * 8 + 4 * (q & 1)) = pack4(v);
        }
    }
    lds_barrier();
}

DI void attn_unit(const Frame& F, const LAS float* rpbl, const int au) {
    const bf16_t* HBp = (const bf16_t*)(F.ws + WS_HB); const bf16_t* VTp = (const bf16_t*)(F.ws + WS_VT); bf16_t* CONCAT = (bf16_t*)(F.ws + WS_CONCAT);
    const int hh = au % AH, r = (au / AH) % ROWS, b = au / (AH * ROWS);
    int rstart = r - KH / 2; rstart = rstart < 0 ? 0 : (rstart > ROWS - KH ? ROWS - KH : rstart);
    const int lane = F.lane, q32 = lane & 31, hi = lane >> 5;
    const float SC = 0.125f * LOG2E;
    const int krow_off = swap23(q32);
    const int cqA = q32, cqB = 32 + q32;
    int csA = cqA - KW / 2; csA = csA < 0 ? 0 : csA; int csB = cqB - KW / 2; csB = csB > GW - KW ? GW - KW : csB;
    const size_t tokA = (size_t)b * S + r * GW + cqA, tokB = tokA + 32;
    bf16x8 qfA[4], qfB[4];
#pragma unroll
    for (int ds = 0; ds < 4; ++ds) { qfA[ds] = *(const bf16x8*)(HBp + tokA * HW + HQ + hh * HD + 16 * ds + 8 * hi); qfB[ds] = *(const bf16x8*)(HBp + tokB * HW + HQ + hh * HD + 16 * ds + 8 * hi); }
    f32x16 oA0, oA1, oB0, oB1;
#pragma unroll
    for (int i = 0; i < 16; ++i) { oA0[i] = 0.f; oA1[i] = 0.f; oB0[i] = 0.f; oB1[i] = 0.f; }
    float mA = -1e30f, lA = 0.f, mB = -1e30f, lB = 0.f;
#pragma unroll 1
    for (int kt = 0; kt < 2 * KH; ++kt) {
        const int kr = rstart + (kt >> 1), ckb = 32 * (kt & 1);
        const size_t ktok = (size_t)b * S + kr * GW + ckb;
        bf16x8 kf[4], vf[2][2];
#pragma unroll
        for (int ds = 0; ds < 4; ++ds) kf[ds] = *(const bf16x8*)(HBp + (ktok + krow_off) * HW + HK + hh * HD + 16 * ds + 8 * hi);
#pragma unroll
        for (int db = 0; db < 2; ++db)
#pragma unroll
            for (int s = 0; s < 2; ++s) vf[db][s] = *(const bf16x8*)(VTp + (size_t)(hh * HD + 32 * db + q32) * T + ktok + 16 * s + 8 * hi);
        const LAS float* rp = rpbl + (hh * (2 * KH - 1) + (kr - r + KH - 1)) * (2 * KW - 1);
#pragma unroll
        for (int qb = 0; qb < 2; ++qb) {
            const int cq = qb ? cqB : cqA, cs = qb ? csB : csA;
            f32x16 st;
#pragma unroll
            for (int i = 0; i < 16; ++i) st[i] = 0.f;
#pragma unroll
            for (int ds = 0; ds < 4; ++ds) st = MFMA32(kf[ds], qb ? qfB[ds] : qfA[ds], st);
            float sl[16]; float tmax = -1e30f;
            float bia[16];
#pragma unroll
            for (int i = 0; i < 16; ++i) {
                const int ck = ckb + 16 * (i >> 3) + 8 * hi + (i & 7);
                int dc = ck - cq; dc = dc < -(KW - 1) ? -(KW - 1) : (dc > KW - 1 ? KW - 1 : dc); dc += KW - 1;
                bia[i] = *(const volatile LAS float*)(rp + dc);
            }
#pragma unroll
            for (int i = 0; i < 16; ++i) {
                const int ck = ckb + 16 * (i >> 3) + 8 * hi + (i & 7);
                const bool inw = (ck >= cs) && (ck < cs + KW);
                const float sv = st[i] * SC + bia[i];
                sl[i] = inw ? sv : -1e30f;
                tmax = fmaxf(tmax, sl[i]);
            }
            tmax = fmaxf(tmax, __shfl_xor(tmax, 32));
            const float mrun = qb ? mB : mA;
            const float mn = fmaxf(mrun, tmax), corr = __builtin_amdgcn_exp2f(mrun - mn);
            float ps = 0.f;
#pragma unroll
            for (int i = 0; i < 16; ++i) { sl[i] = (sl[i] > -1e29f) ? __builtin_amdgcn_exp2f(sl[i] - mn) : 0.f; ps += sl[i]; }
            u32x4 p0, p1;
            p0.x = cvtpk(sl[0], sl[1]); p0.y = cvtpk(sl[2], sl[3]); p0.z = cvtpk(sl[4], sl[5]); p0.w = cvtpk(sl[6], sl[7]);
            p1.x = cvtpk(sl[8], sl[9]); p1.y = cvtpk(sl[10], sl[11]); p1.z = cvtpk(sl[12], sl[13]); p1.w = cvtpk(sl[14], sl[15]);
            const bf16x8 pf0 = __builtin_bit_cast(bf16x8, p0), pf1 = __builtin_bit_cast(bf16x8, p1);
            if (qb == 0) { lA = lA * corr + ps; mA = mn;
#pragma unroll
                for (int i = 0; i < 16; ++i) { oA0[i] *= corr; oA1[i] *= corr; }
                oA0 = MFMA32(vf[0][0], pf0, oA0); oA0 = MFMA32(vf[0][1], pf1, oA0); oA1 = MFMA32(vf[1][0], pf0, oA1); oA1 = MFMA32(vf[1][1], pf1, oA1);
            } else { lB = lB * corr + ps; mB = mn;
#pragma unroll
                for (int i = 0; i < 16; ++i) { oB0[i] *= corr; oB1[i] *= corr; }
                oB0 = MFMA32(vf[0][0], pf0, oB0); oB0 = MFMA32(vf[0][1], pf1, oB0); oB1 = MFMA32(vf[1][0], pf0, oB1); oB1 = MFMA32(vf[1][1], pf1, oB1);
            }
        }
    }
    { const float inv = 1.f / (lA + __shfl_xor(lA, 32)); bf16_t* op = CONCAT + tokA * D + hh * HD;
#pragma unroll
      for (int g = 0; g < 4; ++g) {
          *(u32x2*)(op + 8 * g + 4 * hi) = pack4((f32x4){oA0[4 * g] * inv, oA0[4 * g + 1] * inv, oA0[4 * g + 2] * inv, oA0[4 * g + 3] * inv});
          *(u32x2*)(op + 32 + 8 * g + 4 * hi) = pack4((f32x4){oA1[4 * g] * inv, oA1[4 * g + 1] * inv, oA1[4 * g + 2] * inv, oA1[4 * g + 3] * inv}); } }
    { const float inv = 1.f / (lB + __shfl_xor(lB, 32)); bf16_t* op = CONCAT + tokB * D + hh * HD;
#pragma unroll
      for (int g = 0; g < 4; ++g) {
          *(u32x2*)(op + 8 * g + 4 * hi) = pack4((f32x4){oB0[4 * g] * inv, oB0[4 * g + 1] * inv, oB0[4 * g + 2] * inv, oB0[4 * g + 3] * inv});
          *(u32x2*)(op + 32 + 8 * g + 4 * hi) = pack4((f32x4){oB1[4 * g] * inv, oB1[4 * g + 1] * inv, oB1[4 * g + 2] * inv, oB1[4 * g + 3] * inv}); } }
}

DI void pool_unit(const Frame& F, const float* pool_w, const float* pool_scale, const int pu) {
    const bf16_t* HBp = (const bf16_t*)(F.ws + WS_HB); bf16_t* CONCAT = (bf16_t*)(F.ws + WS_CONCAT);
    const int g = pu & 3, blk = pu >> 2, b = blk >> 8, t0 = (blk & 255) * 32;
    const int lane = F.lane, q32 = lane & 31, hi = lane >> 5, t = t0 + q32, win = 2 << g;
    int lo = t - win / 2; lo = lo < 0 ? 0 : lo; int hit = t + win / 2 - 1; hit = hit > S - 1 ? S - 1 : hit;
    const float inv = 1.f / (float)(hit - lo + 1);
    f32x16 out0, out1;
#pragma unroll
    for (int i = 0; i < 16; ++i) { out0[i] = 0.f; out1[i] = 0.f; }
    const float* pw = pool_w + (size_t)g * 64 * 64;
#pragma unroll 1
    for (int s = 0; s < 4; ++s) {
        const int c0 = HP + g * 64 + 16 * s + 8 * hi;
        float acc[8];
#pragma unroll
        for (int e = 0; e < 8; ++e) acc[e] = 0.f;
        u32x4 pv[16];
#pragma unroll
        for (int d = 0; d < 16; ++d) { int tt = t - win / 2 + d; const bool ok = d < win && tt >= 0 && tt < S; tt = ok ? tt : t;
            pv[d] = *(const u32x4*)(HBp + ((size_t)b * S + tt) * HW + c0); if (!ok) pv[d] = (u32x4){0u, 0u, 0u, 0u}; }
#pragma unroll
        for (int d = 0; d < 16; ++d) {
            acc[0] += bflo(pv[d].x); acc[1] += bfhi(pv[d].x); acc[2] += bflo(pv[d].y); acc[3] += bfhi(pv[d].y); acc[4] += bflo(pv[d].z); acc[5] += bfhi(pv[d].z); acc[6] += bflo(pv[d].w); acc[7] += bfhi(pv[d].w);
        }
        const u32x4 pc = *(const u32x4*)(HBp + ((size_t)b * S + t) * HW + c0);
        u32x4 o;
        o.x = cvtpk(acc[0] * inv - bflo(pc.x), acc[1] * inv - bfhi(pc.x)); o.y = cvtpk(acc[2] * inv - bflo(pc.y), acc[3] * inv - bfhi(pc.y));
        o.z = cvtpk(acc[4] * inv - bflo(pc.z), acc[5] * inv - bfhi(pc.z)); o.w = cvtpk(acc[6] * inv - bflo(pc.w), acc[7] * inv - bfhi(pc.w));
        const bf16x8 bfr = __builtin_bit_cast(bf16x8, o);
        const float* wp = pw + (size_t)(16 * s + 8 * hi) * 64 + q32;
        u32x4 w0; w0.x = cvtpk(wp[0], wp[64]); w0.y = cvtpk(wp[128], wp[192]); w0.z = cvtpk(wp[256], wp[320]); w0.w = cvtpk(wp[384], wp[448]);
        u32x4 w1; w1.x = cvtpk(wp[32], wp[96]); w1.y = cvtpk(wp[160], wp[224]); w1.z = cvtpk(wp[288], wp[352]); w1.w = cvtpk(wp[416], wp[480]);
        out0 = MFMA32(__builtin_bit_cast(bf16x8, w0), bfr, out0);
        out1 = MFMA32(__builtin_bit_cast(bf16x8, w1), bfr, out1);
    }
    bf16_t* op = CONCAT + ((size_t)b * S + t) * D + AW + BW + g * 64;
    const float* ps = pool_scale + g * 64;
#pragma unroll
    for (int gq = 0; gq < 4; ++gq) {
        const int e0 = 8 * gq + 4 * hi;
        const f32x4 s0 = *(const f32x4*)(ps + e0), s1 = *(const f32x4*)(ps + 32 + e0);
        *(u32x2*)(op + e0) = pack4((f32x4){out0[4 * gq] * s0[0], out0[4 * gq + 1] * s0[1], out0[4 * gq + 2] * s0[2], out0[4 * gq + 3] * s0[3]});
        *(u32x2*)(op + 32 + e0) = pack4((f32x4){out1[4 * gq] * s1[0], out1[4 * gq + 1] * s1[1], out1[4 * gq + 2] * s1[2], out1[4 * gq + 3] * s1[3]});
    }
}

constexpr int SCAN_SLOT = 12288, SCAN_RING = 12;
constexpr int SCAN_FLAGS = SCAN_RING * SCAN_SLOT;
DI void scan_issue(const Frame& F, const int sc, const int ihalf, const int dir, const int step, const int lane) {
    const int c = dir ? NCH - 1 - step : step; const size_t unit = (size_t)sc * NCH + c;
    const int il = lane & 31, hi = lane >> 5;
    LAS unsigned char* slot = F.lds + (step % SCAN_RING) * SCAN_SLOT;
    const bf16_t* MP = (const bf16_t*)(F.ws + WS_MP) + unit * 4096; const bf16_t* NBp = (const bf16_t*)(F.ws + WS_NB) + (unit * 2 + ihalf) * 2048;
#pragma unroll
    for (int p = 0; p < 8; ++p) { const int jpb = p >> 2, jb = (p >> 1) & 1, s = p & 1;
        __builtin_amdgcn_global_load_lds((const unsigned*)(MP + (32 * jpb + il) * 64 + 32 * jb + 16 * s + 8 * hi), (LAS unsigned*)(slot + p * 1024), 16, 0, 0); }
#pragma unroll
    for (int p = 0; p < 4; ++p)
        __builtin_amdgcn_global_load_lds((const unsigned*)(NBp + p * 512 + lane * 8), (LAS unsigned*)(slot + 8192 + p * 1024), 16, 0, 0);
}
DI unsigned lds_ld_u32(const volatile LAS unsigned* p) { return __builtin_amdgcn_readfirstlane(*p); }
DI void scan_loader(const Frame& F, const int sw, const int ld) {
    const int ihalf = sw & 1, sc = sw >> 1, dir = sc / (NB * BH);
    volatile LAS unsigned* ready = (volatile LAS unsigned*)(F.lds + SCAN_FLAGS); volatile LAS unsigned* cons = ready + 16;
    const int nmine = NCH / 2;
    for (int k = 0; k < nmine + 5; ++k) {
        if (k < nmine) {
            const int s = 2 * k + ld;
            if (s >= SCAN_RING) { unsigned spins = 0; while ((int)lds_ld_u32(cons) < s - SCAN_RING + 1) { __builtin_amdgcn_s_sleep(1); if (++spins > (1u << 22)) break; } }
            asm volatile("" ::: "memory");
            scan_issue(F, sc, ihalf, dir, s, F.lane);
        }
        if (k >= 4) {
            const int kd = k - 4;
            if (kd < nmine) {
                const int rem = nmine - 1 - kd;
                if (rem >= 4) asm volatile("s_waitcnt vmcnt(48)" ::: "memory");
                else if (rem == 3) asm volatile("s_waitcnt vmcnt(36)" ::: "memory");
                else if (rem == 2) asm volatile("s_waitcnt vmcnt(24)" ::: "memory");
                else if (rem == 1) asm volatile("s_waitcnt vmcnt(12)" ::: "memory");
                else asm volatile("s_waitcnt vmcnt(0)" ::: "memory");
                const int sd = 2 * kd + ld;
                if (F.lane == 0) ready[sd % SCAN_RING] = (unsigned)(sd + 1);
                asm volatile("s_waitcnt lgkmcnt(0)" ::: "memory");
            }
        }
    }
}
DI void scan_wave(const Frame& F, const int sw) {
    const int ihalf = sw & 1, sc = sw >> 1, dir = sc / (NB * BH);
    const int lane = F.lane, il = lane & 31, hi = lane >> 5;
    bf16_t* S0 = (bf16_t*)(F.ws + WS_S0);
    volatile LAS unsigned* ready = (volatile LAS unsigned*)(F.lds + SCAN_FLAGS); volatile LAS unsigned* cons = ready + 16;
    f32x16 st0, st1;
#pragma unroll
    for (int i = 0; i < 16; ++i) { st0[i] = 0.f; st1[i] = 0.f; }
    bf16x8 ma[8], man[8]; u32x4 nbv[4], nbn[4];
    { unsigned spins = 0; while (lds_ld_u32(ready) != 1u) { __builtin_amdgcn_s_sleep(1); if (++spins > (1u << 22)) break; } }
    asm volatile("" ::: "memory");
#pragma unroll
    for (int p = 0; p < 8; ++p) ma[p] = *(const LAS bf16x8*)(F.lds + p * 1024 + lane * 16);
#pragma unroll
    for (int p = 0; p < 4; ++p) nbv[p] = *(const LAS u32x4*)(F.lds + 8192 + p * 1024 + lane * 16);
#pragma unroll 1
    for (int step = 0; step < NCH; ++step) {
        const int c = dir ? NCH - 1 - step : step; const size_t unit = (size_t)sc * NCH + c;
        const bool more = step + 1 < NCH;
        if (more) {
            { unsigned spins = 0; while (lds_ld_u32(ready + ((step + 1) % SCAN_RING)) != (unsigned)(step + 2)) { __builtin_amdgcn_s_sleep(1); if (++spins > (1u << 22)) break; } }
            asm volatile("" ::: "memory");
            const LAS unsigned char* slot = F.lds + ((step + 1) % SCAN_RING) * SCAN_SLOT;
#pragma unroll
            for (int p = 0; p < 8; ++p) man[p] = *(const LAS bf16x8*)(slot + p * 1024 + lane * 16);
#pragma unroll
            for (int p = 0; p < 4; ++p) nbn[p] = *(const LAS u32x4*)(slot + 8192 + p * 1024 + lane * 16);
        }
        bf16_t* sp = S0 + unit * 4096 + (size_t)(32 * ihalf + il) * 64;
        u32x4 b00, b01, b10, b11;
        b00.x = cvtpk(st0[0], st0[1]); b00.y = cvtpk(st0[2], st0[3]); b00.z = cvtpk(st0[4], st0[5]); b00.w = cvtpk(st0[6], st0[7]);
        b01.x = cvtpk(st0[8], st0[9]); b01.y = cvtpk(st0[10], st0[11]); b01.z = cvtpk(st0[12], st0[13]); b01.w = cvtpk(st0[14], st0[15]);
        b10.x = cvtpk(st1[0], st1[1]); b10.y = cvtpk(st1[2], st1[3]); b10.z = cvtpk(st1[4], st1[5]); b10.w = cvtpk(st1[6], st1[7]);
        b11.x = cvtpk(st1[8], st1[9]); b11.y = cvtpk(st1[10], st1[11]); b11.z = cvtpk(st1[12], st1[13]); b11.w = cvtpk(st1[14], st1[15]);
        *(u32x2*)(sp + 0 + 4 * hi) = (u32x2){b00.x, b00.y};  *(u32x2*)(sp + 8 + 4 * hi) = (u32x2){b00.z, b00.w};
        *(u32x2*)(sp + 16 + 4 * hi) = (u32x2){b01.x, b01.y}; *(u32x2*)(sp + 24 + 4 * hi) = (u32x2){b01.z, b01.w};
        *(u32x2*)(sp + 32 + 4 * hi) = (u32x2){b10.x, b10.y}; *(u32x2*)(sp + 40 + 4 * hi) = (u32x2){b10.z, b10.w};
        *(u32x2*)(sp + 48 + 4 * hi) = (u32x2){b11.x, b11.y}; *(u32x2*)(sp + 56 + 4 * hi) = (u32x2){b11.z, b11.w};
        const bf16x8 p00 = __builtin_bit_cast(bf16x8, b00), p01 = __builtin_bit_cast(bf16x8, b01), p10 = __builtin_bit_cast(bf16x8, b10), p11 = __builtin_bit_cast(bf16x8, b11);
        f32x16 n0, n1;
#pragma unroll
        for (int h2 = 0; h2 < 2; ++h2) {
            n0[8 * h2 + 0] = bflo(nbv[h2].x); n0[8 * h2 + 1] = bfhi(nbv[h2].x); n0[8 * h2 + 2] = bflo(nbv[h2].y); n0[8 * h2 + 3] = bfhi(nbv[h2].y);
            n0[8 * h2 + 4] = bflo(nbv[h2].z); n0[8 * h2 + 5] = bfhi(nbv[h2].z); n0[8 * h2 + 6] = bflo(nbv[h2].w); n0[8 * h2 + 7] = bfhi(nbv[h2].w);
            n1[8 * h2 + 0] = bflo(nbv[2 + h2].x); n1[8 * h2 + 1] = bfhi(nbv[2 + h2].x); n1[8 * h2 + 2] = bflo(nbv[2 + h2].y); n1[8 * h2 + 3] = bfhi(nbv[2 + h2].y);
            n1[8 * h2 + 4] = bflo(nbv[2 + h2].z); n1[8 * h2 + 5] = bfhi(nbv[2 + h2].z); n1[8 * h2 + 6] = bflo(nbv[2 + h2].w); n1[8 * h2 + 7] = bfhi(nbv[2 + h2].w);
        }
        n0 = MFMA32(ma[0], p00, n0); n1 = MFMA32(ma[4], p00, n1);
        n0 = MFMA32(ma[1], p01, n0); n1 = MFMA32(ma[5], p01, n1);
        n0 = MFMA32(ma[2], p10, n0); n1 = MFMA32(ma[6], p10, n1);
        n0 = MFMA32(ma[3], p11, n0); n1 = MFMA32(ma[7], p11, n1);
        st0 = n0; st1 = n1;
        if (more) {
            asm volatile("s_waitcnt lgkmcnt(0)" ::: "memory");
            if (lane == 0) *cons = (unsigned)(step + 2);
#pragma unroll
            for (int p = 0; p < 8; ++p) ma[p] = man[p];
#pragma unroll
            for (int p = 0; p < 4; ++p) nbv[p] = nbn[p];
        }
    }
}

DI void rwkv_out_unit(const Frame& F, const RwP& P, const int du) {
    const int qd = du & 3, cidx = du >> 2, c = cidx % NCH, hd = (cidx / NCH) % BH, b = cidx / (NCH * BH);
    const int lane = F.lane, n = lane & 15, g = lane >> 4, u = 16 * qd + n;
    const bf16_t* QT = (const bf16_t*)(F.ws + WS_QT); const bf16_t* WT = (const bf16_t*)(F.ws + WS_WT); const bf16_t* S0 = (const bf16_t*)(F.ws + WS_S0);
    const bf16_t* VTB = (const bf16_t*)(F.ws + WS_VTB) + (size_t)cidx * 4096;
    f32x4 acc[4];
#pragma unroll
    for (int tm = 0; tm < 4; ++tm) acc[tm] = (f32x4){0.f, 0.f, 0.f, 0.f};
#pragma unroll
    for (int dir = 0; dir < 2; ++dir) {
        const size_t unit = (((size_t)dir * NB + b) * BH + hd) * NCH + c;
#pragma unroll
        for (int ks = 0; ks < 2; ++ks) {
            const bf16x8 bq = *(const bf16x8*)(QT + unit * 4096 + u * 64 + 32 * ks + 8 * g);
            const bf16x8 bw = *(const bf16x8*)(WT + unit * 4096 + u * 64 + 32 * ks + 8 * g);
#pragma unroll
            for (int tm = 0; tm < 4; ++tm) {
                const bf16x8 as = *(const bf16x8*)(S0 + unit * 4096 + (16 * tm + n) * 64 + 32 * ks + 8 * g);
                const bf16x8 av = *(const bf16x8*)(VTB + (16 * tm + n) * 64 + 32 * ks + 8 * g);
                acc[tm] = MFMA16(as, bq, acc[tm]); acc[tm] = MFMA16(av, bw, acc[tm]);
            }
        }
    }
    float s = 0.f;
#pragma unroll
    for (int tm = 0; tm < 4; ++tm) s += (acc[tm][0] + acc[tm][1]) + (acc[tm][2] + acc[tm][3]);
    s += __shfl_xor(s, 16); s += __shfl_xor(s, 32);
    const float mu = s * (1.f / HD); float q = 0.f;
#pragma unroll
    for (int tm = 0; tm < 4; ++tm) { acc[tm] = acc[tm] - mu; q += (acc[tm][0] * acc[tm][0] + acc[tm][1] * acc[tm][1]) + (acc[tm][2] * acc[tm][2] + acc[tm][3] * acc[tm][3]); }
    q += __shfl_xor(q, 16); q += __shfl_xor(q, 32);
    const float rstd = 1.f / sqrtf(q * (1.f / HD) + GN_EPS);
    const size_t tok = (size_t)b * S + 64 * c + u;
    const float* BS = (const float*)(F.ws + WS_BS);
    const float bsum = BS[tok * 8 + hd] + BS[((size_t)T + tok) * 8 + hd];
    const bf16_t* VC = (const bf16_t*)(F.ws + WS_VC) + tok * BW + hd * HD; const bf16_t* GBp = (const bf16_t*)(F.ws + WS_GB) + tok * BW + hd * HD;
    bf16_t* op = (bf16_t*)(F.ws + WS_CONCAT) + tok * D + AW + hd * HD;
#pragma unroll
    for (int tm = 0; tm < 4; ++tm) {
        const int i0 = 16 * tm + 4 * g;
        const f32x4 vv = unpack4(*(const u32x2*)(VC + i0)), gg = unpack4(*(const u32x2*)(GBp + i0));
        const f32x4 gn = *(const f32x4*)(P.gn_gain + hd * HD + i0), gb = *(const f32x4*)(P.gn_bias + hd * HD + i0);
        *(u32x2*)(op + i0) = pack4((acc[tm] * rstd * gn + gb + vv * bsum) * gg);
    }
}

DI RwP make_rwp(const Args& a, int l) {
    RwP p;
    p.conv = a.in[6] + (size_t)l * 3 * 3 * BW; p.w0 = a.in[7] + (size_t)l * 2 * BW; p.w_up = a.in[8] + (size_t)l * 2 * RW * BW;
    p.a0 = a.in[9] + (size_t)l * 2 * BW; p.a_up = a.in[10] + (size_t)l * 2 * RA * BW; p.g_up = a.in[11] + (size_t)l * RG * BW;
    p.k_k = a.in[12] + (size_t)l * BW; p.k_a = a.in[13] + (size_t)l * BW; p.r_k = a.in[14] + (size_t)l * BH * HD;
    p.gn_gain = a.in[15] + (size_t)l * BW; p.gn_bias = a.in[16] + (size_t)l * BW;
    return p;
}
DI void p_gemm1(const Frame& F, int l) {
    pg8::Gemm1Order S; S.U = (const bf16_t*)(F.ws + WS_U); S.Win = (const bf16_t*)(F.ws + WS_WIN + (size_t)l * WIN_LAYER); S.Wv = S.Win + (size_t)HW * D; S.G = F.G; S.c = F.bx;
    pg8::EpiStore E{(bf16_t*)(F.ws + WS_HB), HW, (bf16_t*)(F.ws + WS_VT), T};
    pg8::gemm_phase(F.lds, F.tid, D, S, E);
}
DI void p_mixer_local(const Frame& F, const Args& a, int l) {
    {
      const float* conv = a.in[6] + (size_t)l * 3 * 3 * BW;
#pragma unroll 7
      for (int i = F.tid; i < BH * 9 * 64; i += NTHREADS) { const int j = i & 63, q = i >> 6, which = q % 3, x = (q / 3) % 3, hd = q / 9;
          *(LAS bf16_t*)(F.lds + CWLOFF + i * 2) = f2bf(conv[x * 3 * BW + which * BW + hd * HD + j]); }
      RwPre PF;
      if (F.bx < NUNIT) rwkv_prefetch(F, a, l, F.bx, PF);
      __syncthreads();
      for (int unit = F.bx; unit < NUNIT; unit += F.G) rwkv_local_unit(F, a, l, unit, PF, unit + F.G < NUNIT ? unit + F.G : -1);
    }
}
DI void p_scan(const Frame& F, const Args& a, int l) {
#ifndef CVW
#define CVW 2
#endif
    constexpr int NSCAN = 2 * 2 * NB * BH;
    const int NATTW = (F.G - NSCAN) * (NWAVES - CVW);
    if (F.bx < NSCAN) {
        volatile LAS unsigned* fl = (volatile LAS unsigned*)(F.lds + SCAN_FLAGS);
        if (F.tid < 32) fl[F.tid] = 0u;
        __syncthreads();
        if (F.wave == 0) scan_wave(F, F.bx); else if (F.wave <= 2) scan_loader(F, F.bx, F.wave - 1);
        return;
    }
    LAS float* rpbl = (LAS float*)(F.lds + CVW * 64 * 65 * 4);
    { const float* rpb = a.in[5] + (size_t)l * AH * (2 * KH - 1) * (2 * KW - 1);
#pragma unroll 6
      for (int i = F.tid; i < AH * (2 * KH - 1) * (2 * KW - 1); i += NTHREADS) rpbl[i] = rpb[i] * LOG2E; }
    __syncthreads();
    if (F.wave < CVW) {
        LAS float* scr = (LAS float*)F.lds + F.wave * (64 * 65);
        f32x4 cur[16], nxt[16]; const int st = (F.G - NSCAN) * CVW; int it = (F.bx - NSCAN) * CVW + F.wave; TItem tc{}, tn{};
        if (it < IT_MOE) { tc = moe_item(F, a.in[28], a.in[29], a.in[30], l, it); titem_load(tc, cur, F.lane); }
        for (; it < IT_MOE; it += st) {
            const bool more = it + st < IT_MOE;
            if (more) { tn = moe_item(F, a.in[28], a.in[29], a.in[30], l, it + st); titem_load(tn, nxt, F.lane); }
            titem_store(tc, cur, scr, F.lane);
            if (more) { tc = tn;
#pragma unroll
                for (int i = 0; i < 16; ++i) cur[i] = nxt[i]; }
        }
    } else {
        const int aw = (F.bx - NSCAN) * (NWAVES - CVW) + (F.wave - CVW), naw = NATTW;
        for (int au = aw; au < NB * ROWS * AH; au += naw) attn_unit(F, rpbl, au);
        for (int pu = aw; pu < NB * (S / 32) * 4; pu += naw) pool_unit(F, a.in[17] + (size_t)l * NG * 64 * 64, a.in[18] + (size_t)l * CW, pu);
    }
}
DI void p_rwkv_out(const Frame& F, const Args& a, int l) {
    const RwP P = make_rwp(a, l);
    for (int du = F.gw; du < NB * BH * NCH * 4; du += F.ngw) rwkv_out_unit(F, P, du);
}
DI void p_gemm2(const Frame& F, int l) {
    pg8::PlainOrder S; S.init((const bf16_t*)(F.ws + WS_CONCAT), (const bf16_t*)(F.ws + WS_WOUT) + (size_t)l * D * D, T, D, D, F.G, F.bx);
    pg8::EpiStore E{(bf16_t*)(F.ws + WS_MIX), D, nullptr, 0};
    pg8::gemm_phase(F.lds, F.tid, D, S, E);
}
DI void p_moe_a(const Frame& F, int l) {
    LAS int* tb = (LAS int*)(F.lds + LDS_MISC);
    build_tables(F, l, tb);
    pg8::GroupedOrderT<true> S; S.rowtok = (const int*)(F.ws + WS_CTL + WS_SLOTTOK); S.A = (const bf16_t*)(F.ws + WS_U); S.Bt = (const bf16_t*)(F.ws + WS_WGU); S.K = D; S.estride = (size_t)D * D; S.tile_e = tb + 66; S.ntiles = tb[65]; S.nwg = S.ntiles * 4; S.G = F.G; S.c = F.bx;
    pg8::EpiSwiGlu E{(bf16_t*)(F.ws + WS_HM)};
    pg8::gemm_phase(F.lds, F.tid, D, S, E);
}
DI void p_moe_b(const Frame& F, int l) {
    LAS int* tb = (LAS int*)(F.lds + LDS_MISC);
    build_tables(F, l, tb);
    pg8::GroupedOrderT<false> S; S.rowtok = nullptr; S.A = (const bf16_t*)(F.ws + WS_HM); S.Bt = (const bf16_t*)(F.ws + WS_WD); S.K = DE; S.estride = (size_t)D * DE; S.tile_e = tb + 66; S.ntiles = tb[65]; S.nwg = S.ntiles * 4; S.G = F.G; S.c = F.bx;
    pg8::EpiRowScale E{(bf16_t*)(F.ws + WS_YS), (const float*)(F.ws + WS_SLOTW)};
    pg8::gemm_phase(F.lds, F.tid, DE, S, E);
}

#ifndef DBLMASK
#define DBLMASK 0
#endif
constexpr int PH_PER_LAYER = 10, N_PHASES = 2 + L * PH_PER_LAYER;
DI bool in_ph(int k, int lo, int hi) { lo = __builtin_amdgcn_readfirstlane(lo); hi = __builtin_amdgcn_readfirstlane(hi); asm volatile("" : "+s"(lo), "+s"(hi)); return lo <= k && k < hi; }
DI Frame fresh(const Frame& F0) {
    Frame F = F0; int t = F0.tid, b = F0.bx;
    b = __builtin_amdgcn_readfirstlane(b); asm volatile("" : "+v"(t)); asm volatile("" : "+s"(b));
    F.tid = t; F.lane = t & 63; F.wave = __builtin_amdgcn_readfirstlane(t >> 6); F.bx = b;
    F.vcu = (F.G % 8 == 0) ? (b % 8) * (F.G / 8) + b / 8 : b; F.gw = F.vcu * NWAVES + F.wave;
    return F;
}

__global__ void __launch_bounds__(NTHREADS, 2) mk_fwd(Args a) {
    extern __shared__ __attribute__((aligned(16))) unsigned char lds_raw[];
    Frame F;
    F.lds = (LAS unsigned char*)lds_raw;
    F.tid = threadIdx.x; F.lane = F.tid & 63; F.wave = __builtin_amdgcn_readfirstlane(F.tid >> 6);
    F.G = gridDim.x; F.bx = blockIdx.x; { const int bx = blockIdx.x; F.vcu = (F.G % 8 == 0) ? (bx % 8) * (F.G / 8) + bx / 8 : bx; }
    F.gw = F.vcu * NWAVES + F.wave; F.ngw = F.G * NWAVES; F.ws = a.ws;
    volatile LAS unsigned* bst = (volatile LAS unsigned*)(F.lds + LDS_BARST);
    if (F.tid < 16) bst[F.tid] = 0u;
    __syncthreads();
    cg::grid_group grid = cg::this_grid();
    XcdBarrier bar; bar.bar = (unsigned*)(a.ws + WS_CTL) + CW_BAR; bar.x = 0; bar.st = bst;
    const bool multi = (a.ph_hi - a.ph_lo) > 1;
    if (multi && !a.use_cg) bar = xcd_barrier_post((unsigned*)(a.ws + WS_CTL) + CW_BAR, bst);
    const int lo = a.ph_lo, hi = a.ph_hi;
#define IN(k) in_ph((k), lo, hi)
#ifndef DBLSEAM
#define DBLSEAM 0
#endif
#define SEAM(k) do { if (IN(k) && IN((k) + 1)) { if (a.use_cg) grid.sync(); else { xcd_barrier(bar); if (DBLSEAM) xcd_barrier(bar); } } } while (0)
    if (IN(0)) { p0_prologue(fresh(F), a); if ((DBLMASK >> 11) & 1) p0_prologue(fresh(F), a); }
    SEAM(0);
    if (IN(1)) { p_r0(fresh(F), a.in[0]); if ((DBLMASK >> 12) & 1) p_r0(fresh(F), a.in[0]); }
    SEAM(1);
#define RUN(k, call) do { if (IN(pb + (k))) { call; if ((DBLMASK >> (k)) & 1) { call; } } } while (0)
#define LAYER(l) do { \
        const int pb = 2 + PH_PER_LAYER * (l); \
        RUN(0, p_gemm1(fresh(F), (l))); \
        SEAM(pb + 0); \
        RUN(1, p_mixer_local(fresh(F), a, (l))); \
        SEAM(pb + 1); \
        RUN(2, p_scan(fresh(F), a, (l))); \
        SEAM(pb + 2); \
        RUN(3, p_rwkv_out(fresh(F), a, (l))); \
        SEAM(pb + 3); \
        RUN(4, p_gemm2(fresh(F), (l))); \
        SEAM(pb + 4); \
        RUN(5, p_rowpass1(fresh(F), a, (l), (l) == 0 ? a.in[0] : a.out)); \
        if (IN(pb + 5) && ((DBLMASK >> 10) & 1)) p_rowpass1(fresh(F), a, (l), (l) == 0 ? a.in[0] : a.out, true); \
        SEAM(pb + 5); \
        RUN(6, p_gather(fresh(F), (l))); \
        SEAM(pb + 6); \
        RUN(7, p_moe_a(fresh(F), (l))); \
        SEAM(pb + 7); \
        RUN(8, p_moe_b(fresh(F), (l))); \
        SEAM(pb + 8); \
        RUN(9, p_rowpass2(fresh(F), a, (l), a.out)); \
        SEAM(pb + 9); \
    } while (0)
    LAYER(0);
    LAYER(1);
#undef LAYER
#undef IN
#undef SEAM
}

#ifndef MK_MODE
#define MK_MODE 0
#endif
#ifndef TESTMODE
#define TESTMODE 0
#endif

static void fill_args(Args& a, void* const* d_in, void* d_out, void* d_ws) {
    for (int i = 0; i < 31; ++i) a.in[i] = (const float*)d_in[i];
    a.out = (float*)d_out; a.ws = (unsigned char*)d_ws; a.ph_lo = 0; a.ph_hi = N_PHASES; a.use_cg = 0; a.pad = 0;
}
static void launch_phases(Args a, int lo, int hi, hipStream_t stream) {
    for (int p = lo; p < hi; ++p) { a.ph_lo = p; a.ph_hi = p + 1; hipLaunchKernelGGL(mk_fwd, dim3(256), dim3(NTHREADS), LDS_BYTES, stream, a); }
}

#if TESTMODE == 0
extern "C" void kernel_launch(void* const* d_in, const int* in_sizes, int n_in, void* d_out, int out_size, void* d_ws, size_t ws_size, hipStream_t stream) {
    static int grid = 0;
    if (grid == 0) {
        int dev = 0, cus = 0, per_cu = 0;
        (void)hipGetDevice(&dev); (void)hipDeviceGetAttribute(&cus, hipDeviceAttributeMultiprocessorCount, dev);
        (void)hipFuncSetAttribute((const void*)mk_fwd, hipFuncAttributeMaxDynamicSharedMemorySize, LDS_BYTES);
        (void)hipOccupancyMaxActiveBlocksPerMultiprocessor(&per_cu, (const void*)mk_fwd, NTHREADS, LDS_BYTES);
        (void)hipGetLastError();
        grid = (cus > 0 ? cus : 256) * 1;
        if (ws_size < WS_END || n_in != 31) grid = -1;
    }
    if (grid < 0) return;
    (void)hipMemsetAsync((char*)d_ws + WS_CTL, 0, CTL_BYTES, stream);
    Args a{}; fill_args(a, d_in, d_out, d_ws);
#if MK_MODE == 2
    launch_phases(a, 0, N_PHASES, stream);
#else
    a.use_cg = (MK_MODE == 1) ? 1 : 0;
    void* args[] = {&a};
    (void)hipLaunchCooperativeKernel((const void*)mk_fwd, dim3(grid), dim3(NTHREADS), args, LDS_BYTES, stream);
#endif
}
#endif

#if TESTMODE > 0
constexpr int O_A = 1152, O_B = 2304, O_W = 2336, O_AL = 2368, O_G = 2432;
struct HSrc { const bf16_t* HB; const bf16_t* VT;
    DI float at(size_t tok, int n) const { if (n < 768) return bf2f(HB[tok * HW + n]); if (n < 1152) return bf2f(VT[(size_t)(n - 768) * T + tok]); return bf2f(HB[tok * HW + n - 384]); } };
DI float sigm_n(float x) { return 1.f / (1.f + expf(-x)); }

__global__ void k_mod_n(const float* __restrict__ c, const float* __restrict__ w_mod, const float* __restrict__ b_mod, float* __restrict__ mod) {
    __shared__ float sc[NB * D];
    for (int i = threadIdx.x; i < NB * D; i += blockDim.x) { float v = c[i]; sc[i] = v * sigm_n(v); }
    __syncthreads();
    int idx = blockIdx.x * blockDim.x + threadIdx.x; int l = idx / MODW, n = idx % MODW;
    const float* w = w_mod + (size_t)l * D * MODW + n; float a0 = 0.f, a1 = 0.f;
    for (int k = 0; k < D; ++k) { float wv = w[(size_t)k * MODW]; a0 += sc[k] * wv; a1 += sc[D + k] * wv; }
    float bb = b_mod[l * MODW + n];
    mod[(size_t)(l * NB + 0) * MODW + n] = a0 + bb; mod[(size_t)(l * NB + 1) * MODW + n] = a1 + bb;
}
__global__ void k_ln_mod_n(const float* __restrict__ xin, const float* __restrict__ modl, int off_sh, int off_sc, float* __restrict__ uout) {
    int row = (blockIdx.x * blockDim.x + threadIdx.x) >> 6, lane = threadIdx.x & 63; if (row >= T) return; int b = row / S;
    f32x4 v[4];
#pragma unroll
    for (int j = 0; j < 4; ++j) v[j] = *(const f32x4*)(xin + (size_t)row * D + 4 * lane + 256 * j);
    float mean, rstd; row_ln(v, mean, rstd);
    const float* md = modl + (size_t)b * MODW;
#pragma unroll
    for (int j = 0; j < 4; ++j) { int col = 4 * lane + 256 * j; *(f32x4*)(uout + (size_t)row * D + col) = v[j] * rstd * (1.f + *(const f32x4*)(md + off_sc + col)) + *(const f32x4*)(md + off_sh + col); }
}
__global__ void k_post_n(const float* xin, const float* br, const float* __restrict__ modl, int off_gate, const float* __restrict__ gain, const float* __restrict__ bias, float* xout, float* u2out, int off_sh2, int off_sc2) {
    int row = (blockIdx.x * blockDim.x + threadIdx.x) >> 6, lane = threadIdx.x & 63; if (row >= T) return; int b = row / S;
    const float* md = modl + (size_t)b * MODW; f32x4 v[4];
#pragma unroll
    for (int j = 0; j < 4; ++j) { int col = 4 * lane + 256 * j; v[j] = *(const f32x4*)(xin + (size_t)row * D + col) * ALPHA + *(const f32x4*)(md + off_gate + col) * *(const f32x4*)(br + (size_t)row * D + col); }
    float mean, rstd; row_ln(v, mean, rstd);
#pragma unroll
    for (int j = 0; j < 4; ++j) { int col = 4 * lane + 256 * j; v[j] = v[j] * rstd * *(const f32x4*)(gain + col) + *(const f32x4*)(bias + col); *(f32x4*)(xout + (size_t)row * D + col) = v[j]; }
    if (u2out == nullptr) return;
    row_ln(v, mean, rstd);
#pragma unroll
    for (int j = 0; j < 4; ++j) { int col = 4 * lane + 256 * j; *(f32x4*)(u2out + (size_t)row * D + col) = v[j] * rstd * (1.f + *(const f32x4*)(md + off_sc2 + col)) + *(const f32x4*)(md + off_sh2 + col); }
}
__global__ void __launch_bounds__(256) k_gemm_f32(const float* __restrict__ A, int lda, const float* __restrict__ B, int ldb, float* __restrict__ C, int ldc, int K) {
    __shared__ float As[16][65]; __shared__ float Bs[16][64];
    const int tx = threadIdx.x & 15, ty = threadIdx.x >> 4; const int m0 = blockIdx.y * 64, n0 = blockIdx.x * 64;
    float acc[4][4];
#pragma unroll
    for (int i = 0; i < 4; ++i)
#pragma unroll
        for (int j = 0; j < 4; ++j) acc[i][j] = 0.f;
    for (int k0 = 0; k0 < K; k0 += 16) {
#pragma unroll
        for (int i = 0; i < 4; ++i) { int e = threadIdx.x + 256 * i; int m = e >> 4, k = e & 15; As[k][m] = A[(size_t)(m0 + m) * lda + k0 + k]; }
#pragma unroll
        for (int i = 0; i < 4; ++i) { int e = threadIdx.x + 256 * i; int k = e >> 6, n = e & 63; Bs[k][n] = B[(size_t)(k0 + k) * ldb + n0 + n]; }
        __syncthreads();
#pragma unroll
        for (int k = 0; k < 16; ++k) { float a[4], b[4];
#pragma unroll
            for (int i = 0; i < 4; ++i) { a[i] = As[k][ty * 4 + i]; b[i] = Bs[k][tx * 4 + i]; }
#pragma unroll
            for (int i = 0; i < 4; ++i)
#pragma unroll
                for (int j = 0; j < 4; ++j) acc[i][j] += a[i] * b[j]; }
        __syncthreads();
    }
#pragma unroll
    for (int i = 0; i < 4; ++i) *(float4*)(C + (size_t)(m0 + ty * 4 + i) * ldc + n0 + tx * 4) = make_float4(acc[i][0], acc[i][1], acc[i][2], acc[i][3]);
}
__global__ void __launch_bounds__(64) k_attn_n(HSrc h, const float* __restrict__ rpb, float* __restrict__ concat) {
    int idx = blockIdx.x * blockDim.x + threadIdx.x; if (idx >= T * AH) return;
    int head = idx % AH, tok = idx / AH; int b = tok / S, t = tok % S, r = t / GW, cq = t % GW;
    int rstart = r - KH / 2; rstart = rstart < 0 ? 0 : (rstart > ROWS - KH ? ROWS - KH : rstart);
    int cstart = cq - KW / 2; cstart = cstart < 0 ? 0 : (cstart > GW - KW ? GW - KW : cstart);
    float q[HD], acc[HD];
#pragma unroll
    for (int d = 0; d < HD; ++d) { q[d] = h.at(tok, head * HD + d); acc[d] = 0.f; }
    float m = -1e30f, l = 0.f; const float* rp = rpb + (size_t)head * 15 * 31;
    for (int kk = 0; kk < KH; ++kk) { int kr = rstart + kk; int dr = kr - r + (KH - 1);
        for (int j = 0; j < KW; ++j) { int ck = cstart + j; int dc = ck - cq; dc = dc < -15 ? -15 : (dc > 15 ? 15 : dc); dc += 15;
            size_t kt = (size_t)b * S + kr * GW + ck; float s = 0.f;
#pragma unroll
            for (int d = 0; d < HD; ++d) s += q[d] * h.at(kt, AW + head * HD + d);
            s = s * 0.125f + rp[dr * 31 + dc];
            float mn = fmaxf(m, s); float corr = expf(m - mn); float p = expf(s - mn); l = l * corr + p;
#pragma unroll
            for (int d = 0; d < HD; ++d) acc[d] = acc[d] * corr + p * h.at(kt, 2 * AW + head * HD + d);
            m = mn; } }
    float inv = 1.f / l;
#pragma unroll
    for (int d = 0; d < HD; ++d) concat[(size_t)tok * D + head * HD + d] = acc[d] * inv;
}
__global__ void __launch_bounds__(256) k_pool_n(HSrc h, const float* __restrict__ pool_w, const float* __restrict__ pool_scale, float* __restrict__ concat) {
    __shared__ float pooled[CW];
    int tok = blockIdx.x; int b = tok / S, t = tok % S; int ch = threadIdx.x; int g = ch / 64; int win = 2 << g;
    int lo = t - win / 2; lo = lo < 0 ? 0 : lo; int hi = t + win / 2 - 1; hi = hi > S - 1 ? S - 1 : hi;
    float s = 0.f; for (int u = lo; u <= hi; ++u) s += h.at((size_t)b * S + u, O_G + ch);
    pooled[ch] = s / (float)(hi - lo + 1) - h.at(tok, O_G + ch);
    __syncthreads();
    int e = ch % 64; const float* pw = pool_w + (size_t)g * 64 * 64 + e; float a = 0.f;
    for (int c2 = 0; c2 < 64; ++c2) a += pooled[g * 64 + c2] * pw[c2 * 64];
    concat[(size_t)tok * D + AW + BW + ch] = a * pool_scale[ch];
}
__global__ void __launch_bounds__(64) k_rwkv_scan_n(HSrc h, RwP p, float* __restrict__ ys) {
    const int lane = threadIdx.x; const int dir = blockIdx.x / (NB * BH), b = (blockIdx.x / BH) % NB, hd = blockIdx.x % BH; const int ch = hd * HD + lane;
    float st[HD];
#pragma unroll
    for (int j = 0; j < HD; ++j) st[j] = 0.f;
    float wup[RW], aup[RA];
#pragma unroll
    for (int m = 0; m < RW; ++m) { wup[m] = p.w_up[(size_t)(dir * RW + m) * BW + ch]; aup[m] = p.a_up[(size_t)(dir * RA + m) * BW + ch]; }
    const float w0 = p.w0[dir * BW + ch], a0 = p.a0[dir * BW + ch], kkw = p.k_k[ch], kaw = p.k_a[ch];
    float cr[3], ck[3], cv[3];
#pragma unroll
    for (int x = 0; x < 3; ++x) { cr[x] = p.conv[x * 3 * BW + ch]; ck[x] = p.conv[x * 3 * BW + BW + ch]; cv[x] = p.conv[x * 3 * BW + 2 * BW + ch]; }
    for (int step = 0; step < S; ++step) {
        const int t = dir ? (S - 1 - step) : step; const size_t row = (size_t)b * S + t;
        float r = 0.f, k = 0.f, v = 0.f;
#pragma unroll
        for (int x = 0; x < 3; ++x) { int tt = t + x - 1; if (tt >= 0 && tt < S) { size_t rr = (size_t)b * S + tt; r += h.at(rr, O_A + ch) * cr[x]; k += h.at(rr, O_A + BW + ch) * ck[x]; v += h.at(rr, O_A + 2 * BW + ch) * cv[x]; } }
        float lv = h.at(row, O_B + lane); float lt = lane < RW ? tanhf(lv) : lv; float zw = w0, za = a0;
#pragma unroll
        for (int m = 0; m < RW; ++m) { zw += __shfl(lt, m) * wup[m]; za += __shfl(lt, RW + m) * aup[m]; }
        const float w = expf(-DECAY * sigm_n(zw)); const float a = sigm_n(za);
        float kk = k * kkw; float ss = wave_sum(kk * kk); kk = kk * (1.f / sqrtf(fmaxf(ss, 1e-24f)));
        const float kd = k * (1.f + (a - 1.f) * kaw); const float kka = kk * a;
        float sa = 0.f;
#pragma unroll
        for (int j = 0; j < HD; ++j) sa += st[j] * (-__shfl(kk, j));
        float y = 0.f;
#pragma unroll
        for (int j = 0; j < HD; ++j) { st[j] = st[j] * __shfl(w, j) + sa * __shfl(kka, j) + v * __shfl(kd, j); y += st[j] * __shfl(r, j); }
        ys[((size_t)dir * T + b * S + t) * BW + ch] = y;
    }
}
__global__ void __launch_bounds__(384) k_rwkv_finish_n(HSrc h, RwP p, const float* __restrict__ ys, float* __restrict__ concat) {
    __shared__ float lw[RW], la[RA], sg[RG];
    const int tok = blockIdx.x, b = tok / S, t = tok % S, ch = threadIdx.x, hd = ch / HD, j = ch % HD;
    if (ch < RW) lw[ch] = tanhf(h.at(tok, O_B + ch)); else if (ch < RW + RA) la[ch - RW] = h.at(tok, O_W + (ch - RW)); else if (ch < RW + RA + RG) sg[ch - RW - RA] = sigm_n(h.at(tok, O_AL + (ch - RW - RA)));
    __syncthreads();
    float r = 0.f, k = 0.f, v = 0.f;
#pragma unroll
    for (int x = 0; x < 3; ++x) { int tt = t + x - 1; if (tt >= 0 && tt < S) { size_t rr = (size_t)b * S + tt;
        r += h.at(rr, O_A + ch) * p.conv[x * 3 * BW + ch]; k += h.at(rr, O_A + BW + ch) * p.conv[x * 3 * BW + BW + ch]; v += h.at(rr, O_A + 2 * BW + ch) * p.conv[x * 3 * BW + 2 * BW + ch]; } }
    float bon = 0.f;
    for (int dir = 0; dir < 2; ++dir) { float za = p.a0[dir * BW + ch]; for (int m = 0; m < RA; ++m) za += la[m] * p.a_up[(size_t)(dir * RA + m) * BW + ch];
        float a = sigm_n(za); float kd = k * (1.f + (a - 1.f) * p.k_a[ch]); bon += wave_sum(r * kd * p.r_k[hd * HD + j]); }
    bon *= v;
    float y = ys[(size_t)tok * BW + ch] + ys[((size_t)T + tok) * BW + ch];
    float mu = wave_sum(y) * (1.f / HD); float dy = y - mu; float var = wave_sum(dy * dy) * (1.f / HD);
    float yn = dy * (1.f / sqrtf(var + GN_EPS)) * p.gn_gain[ch] + p.gn_bias[ch];
    float g = 0.f; for (int m = 0; m < RG; ++m) g += sg[m] * p.g_up[(size_t)m * BW + ch];
    concat[(size_t)tok * D + AW + ch] = (yn + bon) * g;
}
__global__ void __launch_bounds__(256) k_moe_n(const float* __restrict__ u2, const int* __restrict__ tokslot, const float* __restrict__ ew,
                                                const float* __restrict__ wgate, const float* __restrict__ wup, const float* __restrict__ wdown, float* __restrict__ f) {
    __shared__ float xs[D]; __shared__ float hb[DE];
    const int tok = blockIdx.x, tid = threadIdx.x;
    for (int i = tid; i < D; i += 256) xs[i] = u2[(size_t)tok * D + i];
    float o[4] = {0.f, 0.f, 0.f, 0.f};
    for (int kk = 0; kk < 2; ++kk) {
        const int ts = tokslot[tok * 2 + kk]; const int e = ts >> 14; const float wt = ew[ts];
        __syncthreads();
        const float* g = wgate + (size_t)e * D * DE; const float* u = wup + (size_t)e * D * DE;
        float ag0 = 0.f, ag1 = 0.f, au0 = 0.f, au1 = 0.f;
        for (int k = 0; k < D; ++k) { float x = xs[k]; ag0 += x * g[(size_t)k * DE + tid]; ag1 += x * g[(size_t)k * DE + 256 + tid]; au0 += x * u[(size_t)k * DE + tid]; au1 += x * u[(size_t)k * DE + 256 + tid]; }
        hb[tid] = ag0 * sigm_n(ag0) * au0; hb[256 + tid] = ag1 * sigm_n(ag1) * au1;
        __syncthreads();
        const float* dn = wdown + (size_t)e * DE * D; float a[4] = {0.f, 0.f, 0.f, 0.f};
        for (int k = 0; k < DE; ++k) { float x = hb[k];
#pragma unroll
            for (int j = 0; j < 4; ++j) a[j] += x * dn[(size_t)k * D + tid + 256 * j]; }
#pragma unroll
        for (int j = 0; j < 4; ++j) o[j] += a[j] * wt;
    }
#pragma unroll
    for (int j = 0; j < 4; ++j) f[(size_t)tok * D + tid + 256 * j] = o[j];
}

__global__ void k_router_n(const float* __restrict__ u2, const float* __restrict__ wg, const float* __restrict__ bg, const float* __restrict__ we, const float* __restrict__ be, int* __restrict__ tok_e) {
    int row = (blockIdx.x * blockDim.x + threadIdx.x) >> 6, lane = threadIdx.x & 63; if (row >= T) return;
    float gl[NG], el[NE];
#pragma unroll
    for (int n = 0; n < NG; ++n) gl[n] = 0.f;
#pragma unroll
    for (int n = 0; n < NE; ++n) el[n] = 0.f;
    for (int i = 0; i < 16; ++i) { int k = lane + 64 * i; float x = u2[(size_t)row * D + k];
#pragma unroll
        for (int n = 0; n < NG; ++n) gl[n] += x * wg[k * NG + n];
#pragma unroll
        for (int n = 0; n < NE; ++n) el[n] += x * we[k * NE + n]; }
#pragma unroll
    for (int n = 0; n < NG; ++n) gl[n] = wave_sum(gl[n]) + bg[n];
#pragma unroll
    for (int n = 0; n < NE; ++n) el[n] = wave_sum(el[n]) + be[n];
    int gi = 0; float gm = gl[0];
#pragma unroll
    for (int n = 1; n < NG; ++n) if (gl[n] > gm) { gm = gl[n]; gi = n; }
    float l1 = -3.0e38f, l2 = -3.0e38f; int i1 = 0, i2 = 0;
#pragma unroll
    for (int n = 0; n < NE; ++n) if ((n >> 3) == gi) { float v = el[n]; int e = n & 7; if (v > l1) { l2 = l1; i2 = i1; l1 = v; i1 = e; } else if (v > l2) { l2 = v; i2 = e; } }
    if (lane == 0) { tok_e[row * 2] = gi * EPG + i1; tok_e[row * 2 + 1] = gi * EPG + i2; }
}
__global__ void k_cmp_route(const int* __restrict__ tokslot, const int* __restrict__ tok_e, float* acc, int slot) {
    float mis = 0.f, tot = 0.f;
    for (int t = blockIdx.x * blockDim.x + threadIdx.x; t < T; t += gridDim.x * blockDim.x) { const int a0 = tokslot[2 * t] >> 14, a1 = tokslot[2 * t + 1] >> 14;
        mis += (a0 != tok_e[2 * t] || a1 != tok_e[2 * t + 1]) ? 1.f : 0.f; tot += 1.f; }
    mis = wave_sum(mis); tot = wave_sum(tot);
    if ((threadIdx.x & 63) == 0) { atomicAdd(acc + 2 * slot, mis); atomicAdd(acc + 2 * slot + 1, tot); }
}
__global__ void k_bf2f(const bf16_t* __restrict__ src, float* __restrict__ dst, size_t n) { for (size_t i = (size_t)blockIdx.x * blockDim.x + threadIdx.x; i < n; i += (size_t)gridDim.x * blockDim.x) dst[i] = bf2f(src[i]); }
template <class TA> __global__ void k_cmp(const TA* __restrict__ a, size_t lda, const float* __restrict__ b, size_t ldb, int rows, int cols, float* acc, int slot) {
    float d2 = 0.f, r2 = 0.f;
    for (size_t i = (size_t)blockIdx.x * blockDim.x + threadIdx.x; i < (size_t)rows * cols; i += (size_t)gridDim.x * blockDim.x) {
        const size_t r = i / cols, c = i % cols; float av; if constexpr (sizeof(TA) == 2) av = bf2f(a[r * lda + c]); else av = a[r * lda + c];
        const float bv = b[r * ldb + c]; d2 += (av - bv) * (av - bv); r2 += bv * bv; }
    d2 = wave_sum(d2); r2 = wave_sum(r2);
    if ((threadIdx.x & 63) == 0) { atomicAdd(acc + 2 * slot, d2); atomicAdd(acc + 2 * slot + 1, r2); }
}
__global__ void k_cmp_vt(const bf16_t* __restrict__ vt, const float* __restrict__ b, size_t ldb, float* acc, int slot) {
    float d2 = 0.f, r2 = 0.f;
    for (size_t i = (size_t)blockIdx.x * blockDim.x + threadIdx.x; i < (size_t)T * AW; i += (size_t)gridDim.x * blockDim.x) {
        const size_t r = i % T, c = i / T; const float av = bf2f(vt[c * T + r]), bv = b[r * ldb + c]; d2 += (av - bv) * (av - bv); r2 += bv * bv; }
    d2 = wave_sum(d2); r2 = wave_sum(r2);
    if ((threadIdx.x & 63) == 0) { atomicAdd(acc + 2 * slot, d2); atomicAdd(acc + 2 * slot + 1, r2); }
}
struct Tols { float t[8]; int n; };
__global__ void k_readout(float* out, const float* acc, Tols tl, int total) {
    float mx = 0.f; int am = 0; for (int k = 0; k < tl.n; ++k) { float e = sqrtf(acc[2 * k] / fmaxf(acc[2 * k + 1], 1e-30f)); if (!(e == e)) e = 1e3f; if (e / tl.t[k] > mx) { mx = e / tl.t[k]; am = k; } }
    const float cval = sqrtf(1000.f * mx);
    for (int i = blockIdx.x * blockDim.x + threadIdx.x; i < total; i += gridDim.x * blockDim.x) out[i] = (i < 8) ? 1000.f * (float)(am + 1) : cval;
}
__global__ void __launch_bounds__(256) k_moe_chk(const float* __restrict__ u2, const int* __restrict__ tokslot, const float* __restrict__ ew, const unsigned* __restrict__ cnt,
                                                  const float* __restrict__ wgate, const float* __restrict__ wup, const float* __restrict__ wdown,
                                                  const bf16_t* __restrict__ XS, const bf16_t* __restrict__ HM, const bf16_t* __restrict__ YS, float* acc) {
    __shared__ float xs[D]; __shared__ float hb[DE]; __shared__ int offp[NE];
    const int tok = blockIdx.x, tid = threadIdx.x;
    if (tid == 0) { int off = 0; for (int e = 0; e < NE; ++e) { offp[e] = off; off += (((int)cnt[e] + 255) >> 8) * 256; } }
    for (int i = tid; i < D; i += 256) xs[i] = u2[(size_t)tok * D + i];
    float d0 = 0.f, r0 = 0.f, d1 = 0.f, r1 = 0.f, d2 = 0.f, r2 = 0.f;
    for (int kk = 0; kk < 2; ++kk) {
        __syncthreads();
        const int ts = tokslot[tok * 2 + kk]; const int e = ts >> 14; const float wt = ew[ts]; const size_t slot = (size_t)offp[e] + (ts & 16383);
        for (int i = tid; i < D; i += 256) { const float a = bf2f(XS[slot * D + i]), b = xs[i]; d0 += (a - b) * (a - b); r0 += b * b; }
        const float* g = wgate + (size_t)e * D * DE; const float* u = wup + (size_t)e * D * DE;
        float ag0 = 0.f, ag1 = 0.f, au0 = 0.f, au1 = 0.f;
        for (int k = 0; k < D; ++k) { float x = xs[k]; ag0 += x * g[(size_t)k * DE + tid]; ag1 += x * g[(size_t)k * DE + 256 + tid]; au0 += x * u[(size_t)k * DE + tid]; au1 += x * u[(size_t)k * DE + 256 + tid]; }
        const float h0 = ag0 * sigm_n(ag0) * au0, h1 = ag1 * sigm_n(ag1) * au1;
        hb[tid] = h0; hb[256 + tid] = h1;
        { const float a = bf2f(HM[slot * DE + tid]), b = bf2f(HM[slot * DE + 256 + tid]); d1 += (a - h0) * (a - h0) + (b - h1) * (b - h1); r1 += h0 * h0 + h1 * h1; }
        __syncthreads();
        const float* dn = wdown + (size_t)e * DE * D; float a4[4] = {0.f, 0.f, 0.f, 0.f};
        for (int k = 0; k < DE; ++k) { float x = hb[k];
#pragma unroll
            for (int j = 0; j < 4; ++j) a4[j] += x * dn[(size_t)k * D + tid + 256 * j]; }
#pragma unroll
        for (int j = 0; j < 4; ++j) {
#ifdef MOEB_NOSCALE
            const float y = a4[j];
#else
            const float y = a4[j] * wt;
#endif
            const float a = bf2f(YS[slot * D + tid + 256 * j]); d2 += (a - y) * (a - y); r2 += y * y; }
    }
    d0 = wave_sum(d0); r0 = wave_sum(r0); d1 = wave_sum(d1); r1 = wave_sum(r1); d2 = wave_sum(d2); r2 = wave_sum(r2);
    if ((tid & 63) == 0) { atomicAdd(acc + 0, d0); atomicAdd(acc + 1, r0); atomicAdd(acc + 2, d1); atomicAdd(acc + 3, r1); atomicAdd(acc + 4, d2); atomicAdd(acc + 5, r2); }
}

extern "C" void kernel_launch(void* const* d_in, const int* in_sizes, int n_in, void* d_out, int out_size, void* d_ws, size_t ws_size, hipStream_t stream) {
    static int once = 0; if (!once) { (void)hipFuncSetAttribute((const void*)mk_fwd, hipFuncAttributeMaxDynamicSharedMemorySize, LDS_BYTES); once = 1; }
    (void)hipMemsetAsync((char*)d_ws + WS_CTL, 0, CTL_BYTES, stream);
    Args a{}; fill_args(a, d_in, d_out, d_ws);
    char* ws = (char*)d_ws; float* out = (float*)d_out;
    float* ACC = (float*)(ws + 32768 + 1024);
    const float* x = a.in[0];
    HSrc hs{(const bf16_t*)(ws + WS_HB), (const bf16_t*)(ws + WS_VT)};
    const int l = 0;
    RwP p = { a.in[6], a.in[7], a.in[8], a.in[9], a.in[10], a.in[11], a.in[12], a.in[13], a.in[14], a.in[15], a.in[16] };
    Tols tl{};
#if TESTMODE == 1
    launch_phases(a, 0, 3, stream);
    float* MODn = (float*)(ws + WS_MOD + 512 * 1024); float* Un = (float*)(ws + WS_XA); float* HF = (float*)(ws + WS_CONCAT);
    k_mod_n<<<L * MODW / 256, 256, 0, stream>>>(a.in[1], a.in[2], a.in[3], MODn);
    k_ln_mod_n<<<T / 4, 256, 0, stream>>>(x, MODn, 0, D, Un);
    k_gemm_f32<<<dim3(INW / 64, T / 64), 256, 0, stream>>>(Un, D, a.in[4], INW, HF, INW, D);
    k_cmp<float><<<256, 256, 0, stream>>>((const float*)(ws + WS_MOD), MODW, MODn, MODW, L * NB, MODW, ACC, 0);
    k_cmp<bf16_t><<<1024, 256, 0, stream>>>((const bf16_t*)(ws + WS_U), D, Un, D, T, D, ACC, 1);
    k_cmp<bf16_t><<<1024, 256, 0, stream>>>((const bf16_t*)(ws + WS_HB), HW, HF, INW, T, 768, ACC, 2);
    k_cmp<bf16_t><<<1024, 256, 0, stream>>>((const bf16_t*)(ws + WS_HB) + 768, HW, HF + 1152, INW, T, 1536, ACC, 3);
    k_cmp_vt<<<1024, 256, 0, stream>>>((const bf16_t*)(ws + WS_VT), HF + 768, INW, ACC, 4);
    tl.n = 5; tl.t[0] = 1e-5f; tl.t[1] = 4e-3f; tl.t[2] = 6e-3f; tl.t[3] = 6e-3f; tl.t[4] = 6e-3f;
#elif TESTMODE == 2
    launch_phases(a, 0, 4, stream);
    float* CCn = (float*)(ws + WS_XA); float* YSn = (float*)(ws + WS_WGU);
    k_attn_n<<<T * AH / 64, 64, 0, stream>>>(hs, a.in[5], CCn);
    k_pool_n<<<T, 256, 0, stream>>>(hs, a.in[17], a.in[18], CCn);
    k_rwkv_scan_n<<<2 * NB * BH, 64, 0, stream>>>(hs, p, YSn);
    k_rwkv_finish_n<<<T, 384, 0, stream>>>(hs, p, YSn, CCn);
    launch_phases(a, 4, 6, stream);
    k_cmp<bf16_t><<<1024, 256, 0, stream>>>((const bf16_t*)(ws + WS_CONCAT), D, CCn, D, T, AW, ACC, 0);
    k_cmp<bf16_t><<<1024, 256, 0, stream>>>((const bf16_t*)(ws + WS_CONCAT) + AW, D, CCn + AW, D, T, BW, ACC, 1);
    k_cmp<bf16_t><<<1024, 256, 0, stream>>>((const bf16_t*)(ws + WS_CONCAT) + AW + BW, D, CCn + AW + BW, D, T, CW, ACC, 2);
    tl.n = 3; tl.t[0] = TOL0; tl.t[1] = TOL1; tl.t[2] = TOL2;
#elif TESTMODE == 3
    launch_phases(a, 0, 11, stream);
    { const float* MODf = (const float*)(ws + WS_MOD);
      float* U2f = (float*)(ws + 414 * MiB); float* Fn = (float*)(ws + 213 * MiB); float* X2n = (float*)(ws + 277 * MiB);
      k_bf2f<<<2048, 256, 0, stream>>>((const bf16_t*)(ws + WS_U), U2f, (size_t)T * D);
      launch_phases(a, 11, 12, stream);
      k_moe_n<<<T, 256, 0, stream>>>(U2f, (const int*)(ws + WS_TOKSLOT), (const float*)(ws + WS_EW), a.in[28], a.in[29], a.in[30], Fn);
      k_post_n<<<T / 4, 256, 0, stream>>>((const float*)(ws + WS_XA), Fn, MODf, 5 * D, a.in[22], a.in[23], X2n, nullptr, 0, 0);
      k_cmp<float><<<1024, 256, 0, stream>>>(out, D, X2n, D, T, D, ACC, 0); }
    tl.n = 1; tl.t[0] = TOL0;
#elif TESTMODE == 4
    launch_phases(a, 0, 8, stream);
    { const float* MODf = (const float*)(ws + WS_MOD);
      float* CCn = (float*)(ws + 405 * MiB); float* MIXn = (float*)(ws + 213 * MiB); float* X1n = (float*)(ws + 21 * MiB); float* U2n = (float*)(ws + 333 * MiB); int* TEn = (int*)(ws + 490 * MiB);
      k_bf2f<<<2048, 256, 0, stream>>>((const bf16_t*)(ws + WS_CONCAT), CCn, (size_t)T * D);
      k_gemm_f32<<<dim3(D / 64, T / 64), 256, 0, stream>>>(CCn, D, a.in[19], D, MIXn, D, D);
      k_post_n<<<T / 4, 256, 0, stream>>>(x, MIXn, MODf, 2 * D, a.in[20], a.in[21], X1n, U2n, 3 * D, 4 * D);
      k_router_n<<<T / 4, 256, 0, stream>>>(U2n, a.in[24], a.in[25], a.in[26], a.in[27], TEn);
      k_cmp<float><<<1024, 256, 0, stream>>>((const float*)(ws + WS_XA), D, X1n, D, T, D, ACC, 0);
      k_cmp<bf16_t><<<1024, 256, 0, stream>>>((const bf16_t*)(ws + WS_U), D, U2n, D, T, D, ACC, 1);
      k_cmp_route<<<64, 256, 0, stream>>>((const int*)(ws + WS_TOKSLOT), TEn, ACC, 2); }
    tl.n = 3; tl.t[0] = TOL0; tl.t[1] = TOL1; tl.t[2] = TOL2;
#elif TESTMODE == 5
    launch_phases(a, 0, 11, stream);
    { float* U2f = (float*)(ws + 414 * MiB);
      k_bf2f<<<2048, 256, 0, stream>>>((const bf16_t*)(ws + WS_U), U2f, (size_t)T * D);
      k_moe_chk<<<T, 256, 0, stream>>>(U2f, (const int*)(ws + WS_TOKSLOT), (const float*)(ws + WS_EW), (const unsigned*)(ws + WS_CTL) + CW_CNT, a.in[28], a.in[29], a.in[30],
                                       (const bf16_t*)(ws + WS_XS), (const bf16_t*)(ws + WS_HM), (const bf16_t*)(ws + WS_YS), ACC); }
    tl.n = 3; tl.t[0] = 1e-6f; tl.t[1] = 1e-2f; tl.t[2] = 1e-2f;
#endif
    k_readout<<<256, 256, 0, stream>>>(out, ACC, tl, out_size);
}
#endif
```

```cpp
#define TESTMODE 0
#define MK_MODE 0
#define S0_WRITER 1
#define ATT_XCD 1
#include <hip/hip_runtime.h>
#include <hip/hip_cooperative_groups.h>
#include <stdint.h>
namespace cg = cooperative_groups;

#ifndef TESTMODE
#define TESTMODE 0
#endif
#define DI __device__ __forceinline__
#define LAS __attribute__((address_space(3)))
typedef unsigned short bf16_t;
typedef short bf16x8 __attribute__((ext_vector_type(8)));
typedef float f32x4 __attribute__((ext_vector_type(4)));
typedef float f32x16 __attribute__((ext_vector_type(16)));
typedef unsigned u32x4 __attribute__((ext_vector_type(4)));
typedef unsigned u32x2 __attribute__((ext_vector_type(2)));
typedef float f32x2_t __attribute__((ext_vector_type(2)));
typedef __bf16 bf16x2_t __attribute__((ext_vector_type(2)));

namespace cfg {
constexpr int D = 1024, NB = 2, S = 8192, T = NB * S, L = 2;
constexpr int GW = 64, ROWS = 128;
constexpr int HD = 64, AW = 384, BW = 384, CW = 256, AH = 6, BH = 6;
constexpr int KH = 8, KW = 16;
constexpr int RW = 32, RA = 32, RG = 64;
constexpr int INW = 2688;
constexpr int NG = 4, EPG = 8, NE = 32, DE = 512;
constexpr int MODW = 6 * D;
constexpr float ALPHA = 1.41421356237309515f;
constexpr float LN_EPS = 1e-5f, GN_EPS = 64e-5f;
constexpr float DECAY = 0.60653065971263342f;
constexpr float LOG2E = 1.44269504088896341f;
constexpr int HW = 2304, HQ = 0, HK = 384, HR = 768, HWL = 1920, HAL = 1952, HGL = 1984, HP = 2048;
constexpr int NCH = S / 64;
constexpr int NUNIT = 2 * NB * BH * NCH;
constexpr int XSROWS = 2 * T + NE * 256;
}
using namespace cfg;

constexpr size_t MiB = 1u << 20;
constexpr size_t WS_CTL = 0;
constexpr size_t CTL_BYTES = 262144;
constexpr size_t WS_SLOTTOK = 65536;
constexpr int CW_BAR = 0;
constexpr int CW_CNT = 8192;
constexpr size_t WS_MOD = 1 * MiB;
constexpr size_t WS_TOKSLOT = 1 * MiB + 128 * 1024;
constexpr size_t WS_SLOTW = 1 * MiB + 256 * 1024;
constexpr size_t WS_BC = 2 * MiB;
constexpr size_t WS_TOKW = 2 * MiB + 64 * 1024;
constexpr size_t WS_TOKFIN = 2 * MiB + 256 * 1024;
constexpr size_t WS_CNTF = 2 * MiB + 512 * 1024;
constexpr size_t WS_WIN = 6 * MiB;
constexpr size_t WIN_LAYER = (size_t)2816 * 1024 * 2;
constexpr size_t WS_WOUT = 17 * MiB;
constexpr size_t WS_WGU = 21 * MiB;
constexpr size_t WS_WD = 85 * MiB;
constexpr size_t WS_XA = 117 * MiB;
constexpr size_t WS_U = 181 * MiB;
constexpr size_t WS_HB = 213 * MiB;
constexpr size_t WS_S0 = 117 * MiB;
constexpr size_t WS_VT = 285 * MiB;
constexpr size_t WS_CONCAT = 301 * MiB;
constexpr size_t WS_MP = 333 * MiB;
constexpr size_t WS_NB = 358 * MiB;
constexpr size_t WS_MIX = 333 * MiB;
constexpr size_t WS_QT = 405 * MiB;
constexpr size_t WS_WT = 429 * MiB;
constexpr size_t WS_VTB = 453 * MiB;
constexpr size_t WS_GB = 465 * MiB;
constexpr size_t WS_VC = 477 * MiB;
constexpr size_t WS_BS = 489 * MiB;
constexpr size_t WS_XS = 213 * MiB;
constexpr size_t WS_HM = 293 * MiB;
constexpr size_t WS_YS = 333 * MiB;
constexpr size_t WS_END = 490 * MiB;
#ifndef NOSKEW
#define USK(u) ((size_t)(u) + ((size_t)(u) >> 7))
#else
#define USK(u) ((size_t)(u))
#endif

constexpr int NWAVES = 8, NTHREADS = 512;
constexpr int LDS_BYTES = 156 * 1024;

DI unsigned cvtpk(float lo, float hi) { f32x2_t v = {lo, hi}; bf16x2_t b = __builtin_convertvector(v, bf16x2_t); return __builtin_bit_cast(unsigned, b); }
DI float bflo(unsigned w) { return __uint_as_float(w << 16); }
DI float bfhi(unsigned w) { return __uint_as_float(w & 0xffff0000u); }
DI float bf2f(unsigned short h) { return __uint_as_float((unsigned)h << 16); }
DI unsigned short f2bf(float f) { return (unsigned short)(cvtpk(f, 0.f) & 0xffffu); }
DI float wave_sum_shfl(float v) {
#pragma unroll
    for (int o = 32; o > 0; o >>= 1) v += __shfl_xor(v, o);
    return v;
}
template <int CTRL, int ROWMASK> DI float dpp_add(float v) { return v + __builtin_bit_cast(float, __builtin_amdgcn_update_dpp(0, __builtin_bit_cast(int, v), CTRL, ROWMASK, 0xf, false)); }
DI float wave_sum(float v) {
    v = dpp_add<0xb1, 0xf>(v);
    v = dpp_add<0x4e, 0xf>(v);
    v = dpp_add<0x124, 0xf>(v);
    v = dpp_add<0x128, 0xf>(v);
    v = dpp_add<0x142, 0xa>(v);
    v = dpp_add<0x143, 0xc>(v);
    return __builtin_bit_cast(float, __builtin_amdgcn_readlane(__builtin_bit_cast(int, v), 63));
}
DI float fexp2(float x) { return __builtin_amdgcn_exp2f(x); }
DI float frcp(float x) { return __builtin_amdgcn_rcpf(x); }
DI float sigm(float x) { return frcp(1.f + fexp2(x * -LOG2E)); }
#define LDS_WAIT() asm volatile("s_waitcnt lgkmcnt(0)" ::: "memory")
#define VM_WAIT() asm volatile("s_waitcnt vmcnt(0)" ::: "memory")
DI int swap23(int i) { return (i & ~12) | ((i & 4) << 1) | ((i & 8) >> 1); }

namespace pg8 {
constexpr int BM = 256, BK = 64, HALF = 128, HTB = HALF * BK * 2, STAGE_BYTES = 8 * HTB, NXCD = 8, WGM = 8;
__host__ __device__ __forceinline__ int lds_byte(int r, int c) { const int st = (r >> 4) * 2 + (c >> 5), rr = r & 15, cc = c & 31, ob = rr * 64 + cc * 2; return st * 1024 + (ob ^ (((ob >> 9) & 1) << 5)); }
__host__ __device__ __forceinline__ void stage_rc(int b, int& R, int& C) { const int st = b / 1024, sb = b % 1024, swz = sb ^ (((sb >> 9) & 1) << 5); R = (st >> 1) * 16 + swz / 64; C = (st & 1) * 32 + (swz % 64) / 2; }
__host__ __device__ __forceinline__ int perm32(int rho) { const int n = rho >> 4, i = rho & 15; return 8 * (i >> 2) + 4 * n + (i & 3); }

struct Unit { int pm, pn, aux; };

DI int xcd_remap(int L, int nwg) { const int q = nwg / NXCD, r = nwg % NXCD, xcd = L % NXCD, off = L / NXCD; return (xcd < r ? xcd * (q + 1) : r * (q + 1) + (xcd - r) * q) + off; }

struct PlainOrder {
    static constexpr bool GATHER = false;
    const bf16_t* A; const bf16_t* Bt; int K; int nM, nN, nwg, G, c;
    DI void init(const bf16_t* A_, const bf16_t* Bt_, int M, int N, int K_, int G_, int c_) { A = A_; Bt = Bt_; K = K_; nM = M / BM; nN = N / BM; nwg = nM * nN; G = G_; c = c_; }
    DI bool next(int i, Unit& u) const {
        const int Lx = i * G + c; if (Lx >= nwg) return false;
        const int wgid = xcd_remap(Lx, nwg);
        const int nig = WGM * nN, gid = wgid / nig, fm = gid * WGM, gsz = (nM - fm) < WGM ? (nM - fm) : WGM;
        u.pm = fm + ((wgid % nig) % gsz); u.pn = (wgid % nig) / gsz; u.aux = 0; return true;
    }
    DI const char* aptr(const Unit& u) const { return (const char*)A + (size_t)u.pm * (2 * HALF) * K * 2; }
    DI const char* bptr(const Unit& u) const { return (const char*)Bt + (size_t)u.pn * (2 * HALF) * K * 2; }
};
struct Gemm1Order {
    static constexpr bool GATHER = false;
    const bf16_t* U; const bf16_t* Win; const bf16_t* Wv; int G, c;
    static constexpr int nM = T / BM, nN = HW / BM, nMain = nM * nN, nV = 2 * (T / BM), nwg = nMain + nV, K = D;
    DI bool next(int i, Unit& u) const {
        const int Lx = i * G + c; if (Lx >= nwg) return false;
        if (Lx < nMain) {
            const int wgid = xcd_remap(Lx, nMain);
            const int nig = WGM * nN, gid = wgid / nig, fm = gid * WGM, gsz = (nM - fm) < WGM ? (nM - fm) : WGM;
            u.pm = fm + ((wgid % nig) % gsz); u.pn = (wgid % nig) / gsz; u.aux = 0;
        } else { const int v = Lx - nMain; u.pm = v & 1; u.pn = v >> 1; u.aux = 1; }
        return true;
    }
    DI const char* aptr(const Unit& u) const { return (const char*)(u.aux ? Wv : U) + (size_t)u.pm * BM * K * 2; }
    DI const char* bptr(const Unit& u) const { return (const char*)(u.aux ? U : Win) + (size_t)u.pn * BM * K * 2; }
};
template <bool G_> struct GroupedOrderT {
    static constexpr bool GATHER = G_;
    const bf16_t* A; const bf16_t* Bt; int K; size_t estride; const LAS int* tile_e; int ntiles, nwg, G, c; const int* rowtok;
    DI bool next(int i, Unit& u) const {
        const int Lx = i * G + c; if (Lx >= nwg) return false;
        const int wgid = xcd_remap(Lx, nwg);
        u.pm = wgid >> 2; u.pn = wgid & 3; u.aux = tile_e[u.pm]; return true;
    }
    DI const char* aptr(const Unit& u) const { return GATHER ? (const char*)A : (const char*)A + (size_t)u.pm * BM * K * 2; }
    DI const char* bptr(const Unit& u) const { return (const char*)Bt + ((size_t)u.aux * estride + (size_t)u.pn * BM * K) * 2; }
};

struct EpiStore {
    bf16_t* O0; int ld0; bf16_t* O1; int ld1;
    DI void operator()(const f32x4 (&acc)[2][2][4][2], const Unit& u, int wr, int wc, int fr, int fq) const {
        bf16_t* base = u.aux ? O1 : O0; const int ldc = u.aux ? ld1 : ld0;
        const int row0 = u.pm * BM + wr * 64 + fr, col0 = u.pn * BM + wc * 32 + 8 * fq;
#pragma unroll
        for (int ai = 0; ai < 2; ++ai)
#pragma unroll
            for (int m = 0; m < 4; ++m) { bf16_t* rowp = base + (size_t)(row0 + ai * HALF + m * 16) * ldc + col0;
#pragma unroll
                for (int bj = 0; bj < 2; ++bj) { const f32x4 v0 = acc[ai][bj][m][0], v1 = acc[ai][bj][m][1];
                    u32x4 w; w.x = cvtpk(v0[0], v0[1]); w.y = cvtpk(v0[2], v0[3]); w.z = cvtpk(v1[0], v1[1]); w.w = cvtpk(v1[2], v1[3]);
                    *(u32x4*)(rowp + bj * HALF) = w; } }
    }
};
struct EpiSwiGlu {
    bf16_t* O;
    DI void operator()(const f32x4 (&acc)[2][2][4][2], const Unit& u, int wr, int wc, int fr, int fq) const {
        const int row0 = u.pm * BM + wr * 64 + fr, col0 = u.pn * HALF + wc * 32 + 8 * fq;
#pragma unroll
        for (int ai = 0; ai < 2; ++ai)
#pragma unroll
            for (int m = 0; m < 4; ++m) { bf16_t* rowp = O + (size_t)(row0 + ai * HALF + m * 16) * DE + col0;
                float hv[8];
#pragma unroll
                for (int n = 0; n < 2; ++n)
#pragma unroll
                    for (int e = 0; e < 4; ++e) { const float g = acc[ai][0][m][n][e], up = acc[ai][1][m][n][e]; hv[4 * n + e] = g * sigm(g) * up; }
                u32x4 w; w.x = cvtpk(hv[0], hv[1]); w.y = cvtpk(hv[2], hv[3]); w.z = cvtpk(hv[4], hv[5]); w.w = cvtpk(hv[6], hv[7]);
                *(u32x4*)rowp = w; }
    }
};
struct EpiRowScale {
    bf16_t* O; const float* roww;
    DI void operator()(const f32x4 (&acc)[2][2][4][2], const Unit& u, int wr, int wc, int fr, int fq) const {
        const int row0 = u.pm * BM + wr * 64 + fr, col0 = u.pn * BM + wc * 32 + 8 * fq;
#pragma unroll
        for (int ai = 0; ai < 2; ++ai)
#pragma unroll
            for (int m = 0; m < 4; ++m) { const int row = row0 + ai * HALF + m * 16;
#ifdef MOEB_NOSCALE
                const float s = 1.f;
#else
                const float s = roww[row];
#endif
                bf16_t* rowp = O + (size_t)row * D + col0;
#pragma unroll
                for (int bj = 0; bj < 2; ++bj) { const f32x4 v0 = acc[ai][bj][m][0] * s, v1 = acc[ai][bj][m][1] * s;
                    u32x4 w; w.x = cvtpk(v0[0], v0[1]); w.y = cvtpk(v0[2], v0[3]); w.z = cvtpk(v1[0], v1[1]); w.w = cvtpk(v1[2], v1[3]);
                    *(u32x4*)(rowp + bj * HALF) = w; } }
    }
};

template <class Epi, class Sched>
DI void gemm_phase(LAS unsigned char* lds, const int tid, const int K, const Sched& S, const Epi& E) {
    const int wid = __builtin_amdgcn_readfirstlane(tid >> 6), lane = tid & 63, wr = wid >> 2, wc = wid & 3, fr = lane & 15, fq = lane >> 4;
    const int nt = K / BK;
    unsigned voffA[2], voffB[2];
#pragma unroll
    for (int i = 0; i < 2; ++i) { int R, C; stage_rc(tid * 16 + i * 8192, R, C); const int Rb = (R & ~31) + perm32(R & 31);
        voffA[i] = (unsigned)(R * K + C) * 2u; voffB[i] = (unsigned)(Rb * K + C) * 2u; }
    const size_t kstep = (size_t)(BK * 2);
    const size_t hstep = (size_t)HALF * K * 2;
    const size_t hstepA = Sched::GATHER ? 0 : hstep;
    int RA_[2], CA_[2];
#pragma unroll
    for (int i = 0; i < 2; ++i) stage_rc(tid * 16 + i * 8192, RA_[i], CA_[i]);
    unsigned vgc[2][2], vgn[2][2], vgnn[2][2];
#define PG8_GLOAD(dst, u_) do { if constexpr (Sched::GATHER) { _Pragma("unroll") for (int h_ = 0; h_ < 2; ++h_) _Pragma("unroll") for (int i_ = 0; i_ < 2; ++i_) \
        dst[h_][i_] = ((unsigned)S.rowtok[(u_).pm * BM + h_ * HALF + RA_[i_]] * (unsigned)K + (unsigned)CA_[i_]) * 2u; } } while (0)
    const unsigned ldsw = (unsigned)wid * 1024u;
    const int aoff = lds_byte(wr * 64 + fr, fq * 8), boff = lds_byte(wc * 32 + fr, fq * 8);
#define PG8_SA(b, h) (((b) * 2 + (h)) * HTB)
#define PG8_SB(b, h) ((4 + (b) * 2 + (h)) * HTB)
#define PG8_STAGE(bufoff, gbase, voff) do { _Pragma("unroll") for (int _i = 0; _i < 2; ++_i) \
        __builtin_amdgcn_global_load_lds((const unsigned*)((const char*)(gbase) + (voff)[_i]), (LAS unsigned*)(lds + (bufoff) + ldsw + _i * 8192), 16, 0, 0); } while (0)
#define PG8_STAGE_A(b, h, gbase, cur_) do { if constexpr (Sched::GATHER) { unsigned vo_[2]; vo_[0] = (cur_) ? vgc[h][0] : vgn[h][0]; vo_[1] = (cur_) ? vgc[h][1] : vgn[h][1]; PG8_STAGE(PG8_SA(b, h), gbase, vo_); } else PG8_STAGE(PG8_SA(b, h), (gbase) + (h) * hstepA, voffA); } while (0)
#define PG8_LDA(dst, b, h) do { _Pragma("unroll") for (int m = 0; m < 4; ++m) _Pragma("unroll") for (int k = 0; k < 2; ++k) dst[m][k] = *(const LAS bf16x8*)(lds + PG8_SA(b, h) + aoff + m * 2048 + k * 1024); } while (0)
#define PG8_LDB(dst, b, h) do { _Pragma("unroll") for (int n = 0; n < 2; ++n) _Pragma("unroll") for (int k = 0; k < 2; ++k) dst[n][k] = *(const LAS bf16x8*)(lds + PG8_SB(b, h) + boff + n * 2048 + k * 1024); } while (0)
#define PG8_MMA(ai, bj, At, Bt) do { __builtin_amdgcn_s_setprio(1); _Pragma("unroll") for (int m = 0; m < 4; ++m) _Pragma("unroll") for (int n = 0; n < 2; ++n) _Pragma("unroll") for (int k = 0; k < 2; ++k) \
        acc[ai][bj][m][n] = __builtin_amdgcn_mfma_f32_16x16x32_bf16(Bt[n][k], At[m][k], acc[ai][bj][m][n], 0, 0, 0); __builtin_amdgcn_s_setprio(0); } while (0)
#define PG8_WAIT_V(n) asm volatile("s_waitcnt vmcnt(" #n ")" ::: "memory")
#define PG8_WAIT_L(n) asm volatile("s_waitcnt lgkmcnt(" #n ")" ::: "memory")
#define PG8_BAR __builtin_amdgcn_s_barrier()
#define PG8_SCHED __builtin_amdgcn_sched_barrier(0)
    Unit cur, nxt; int ui = 0;
    if (!S.next(0, cur)) return;
    f32x4 acc[2][2][4][2];
#pragma unroll
    for (int a = 0; a < 2; ++a)
#pragma unroll
        for (int b = 0; b < 2; ++b)
#pragma unroll
            for (int m = 0; m < 4; ++m)
#pragma unroll
                for (int n = 0; n < 2; ++n) acc[a][b][m][n] = (f32x4){0.f, 0.f, 0.f, 0.f};
    bf16x8 At[4][2], B0[2][2], B1[2][2];
    const char* cA = S.aptr(cur); const char* cB = S.bptr(cur);
    if constexpr (Sched::GATHER) { Unit u1_ = cur, u2_ = cur; const bool h1_ = S.next(1, u1_); if (!h1_) u1_ = cur; const bool h2_ = h1_ && S.next(2, u2_); if (!h2_) u2_ = u1_;
        PG8_GLOAD(vgc, cur); PG8_GLOAD(vgn, u1_); PG8_GLOAD(vgnn, u2_); }
    PG8_STAGE(PG8_SB(0, 0), cB, voffB); PG8_STAGE(PG8_SB(0, 1), cB + hstep, voffB); PG8_STAGE_A(0, 0, cA, true); PG8_STAGE_A(0, 1, cA, true);
    if (wr == 1) PG8_BAR;
    PG8_WAIT_V(2); PG8_BAR;
    PG8_STAGE(PG8_SB(1, 0), cB + kstep, voffB); PG8_STAGE_A(1, 0, cA + kstep, true); PG8_STAGE(PG8_SB(1, 1), cB + hstep + kstep, voffB);
    PG8_WAIT_V(6); PG8_BAR;
    for (;;) {
        const bool has_next = S.next(ui + 1, nxt);
        const char* nA = has_next ? S.aptr(nxt) : cA; const char* nB = has_next ? S.bptr(nxt) : cB;

        for (int t = 0; t < nt; t += 2) {
            const bool last = (t == nt - 2);
            const char* a1 = cA + (size_t)(t + 1) * kstep;
            const char* a2 = last ? nA : cA + (size_t)(t + 2) * kstep; const char* b2 = last ? nB : cB + (size_t)(t + 2) * kstep;
            const char* a3 = a2 + kstep; const char* b3 = b2 + kstep;
            PG8_LDB(B0, 0, 0); PG8_LDB(B1, 0, 1); PG8_SCHED; PG8_LDA(At, 0, 0); PG8_STAGE_A(1, 1, a1, true);
            PG8_WAIT_V(8); PG8_WAIT_L(0); PG8_BAR; PG8_MMA(0, 0, At, B0); PG8_MMA(0, 1, At, B1); PG8_BAR; PG8_SCHED;
            PG8_LDA(At, 0, 1); PG8_STAGE(PG8_SB(0, 0), b2, voffB); PG8_STAGE(PG8_SB(0, 1), b2 + hstep, voffB); PG8_STAGE_A(0, 0, a2, !last);
            PG8_WAIT_V(8); PG8_WAIT_L(0); PG8_BAR; PG8_MMA(1, 0, At, B0); PG8_MMA(1, 1, At, B1); PG8_BAR; PG8_SCHED;
            PG8_LDB(B0, 1, 0); PG8_LDB(B1, 1, 1); PG8_SCHED; PG8_LDA(At, 1, 0); PG8_STAGE_A(0, 1, a2, !last);
            PG8_WAIT_V(8); PG8_WAIT_L(0); PG8_BAR; PG8_MMA(0, 0, At, B0); PG8_MMA(0, 1, At, B1); PG8_BAR; PG8_SCHED;
            PG8_LDA(At, 1, 1); PG8_STAGE(PG8_SB(1, 0), b3, voffB); PG8_STAGE(PG8_SB(1, 1), b3 + hstep, voffB); PG8_STAGE_A(1, 0, a3, !last);
            PG8_WAIT_V(8); PG8_WAIT_L(0); PG8_BAR; PG8_MMA(1, 0, At, B0); PG8_MMA(1, 1, At, B1); PG8_BAR; PG8_SCHED;
        }
        if (wr == 0) PG8_BAR;
        E(acc, cur, wr, wc, fr, fq);
        if (!has_next) break;
#pragma unroll
        for (int a = 0; a < 2; ++a)
#pragma unroll
            for (int b = 0; b < 2; ++b)
#pragma unroll
                for (int m = 0; m < 4; ++m)
#pragma unroll
                    for (int n = 0; n < 2; ++n) acc[a][b][m][n] = (f32x4){0.f, 0.f, 0.f, 0.f};
        cur = nxt; cA = nA; cB = nB; ++ui;
        if constexpr (Sched::GATHER) { _Pragma("unroll") for (int h_ = 0; h_ < 2; ++h_) _Pragma("unroll") for (int i_ = 0; i_ < 2; ++i_) { vgc[h_][i_] = vgn[h_][i_]; vgn[h_][i_] = vgnn[h_][i_]; } }
        if (wr == 1) PG8_BAR;
    }
    PG8_WAIT_V(0);
    PG8_BAR;
#undef PG8_SA
#undef PG8_SB
#undef PG8_STAGE
#undef PG8_STAGE_A
#undef PG8_GLOAD
#undef PG8_LDA
#undef PG8_LDB
#undef PG8_MMA
#undef PG8_WAIT_V
#undef PG8_WAIT_L
#undef PG8_BAR
#undef PG8_SCHED
}
}

#define XB_TMO      128
#define XB_XCNT(j)  (256  + 64 * (j))
#define XB_XSUB(j)  (1280 + 64 * (j))
#define XB_XGEN(j)  (2304 + 64 * (j))
#define XB_TOP      3328
#define XB_TOPGEN   3392
#define XCD_BAR_WORDS 3456
#define XB_SPIN_CAP (1u << 20)
DI unsigned xb_ld(unsigned* p)              { return __hip_atomic_load(p, __ATOMIC_RELAXED, __HIP_MEMORY_SCOPE_AGENT); }
DI unsigned xb_add(unsigned* p, unsigned v) { return __hip_atomic_fetch_add(p, v, __ATOMIC_RELAXED, __HIP_MEMORY_SCOPE_AGENT); }
DI unsigned xb_xcc_id() { return (unsigned)__builtin_amdgcn_s_getreg((3 << 11) | 20) & 0xFu; }
#define XB_SPIN(cond, bar) do { unsigned _sp = 0; while (cond) { __builtin_amdgcn_s_sleep(1); \
    if ((++_sp & 255u) == 0u) { if (xb_ld(&(bar)[XB_TMO])) break; if (_sp > XB_SPIN_CAP) { atomicAdd(&(bar)[XB_TMO], 1u); break; } } } } while (0)
struct XcdBarrier { unsigned* bar; unsigned x; volatile LAS unsigned* st; };
DI XcdBarrier xcd_barrier_post(unsigned* bar, volatile LAS unsigned* st) {
    XcdBarrier b; b.bar = bar; b.x = xb_xcc_id(); b.st = st;
    if (threadIdx.x == 0) (void)xb_add(&bar[XB_XCNT(b.x)], 1u);
    return b;
}
DI void xcd_barrier_complete(unsigned* bar, unsigned x, unsigned& nloc, unsigned& nx) {
    const unsigned G = gridDim.x * gridDim.y * gridDim.z;
    unsigned sum, cnt, mine, sp = 0u;
    for (;;) {
        sum = 0u; cnt = 0u; mine = 0u;
#pragma unroll
        for (unsigned j = 0; j < 16; ++j) { const unsigned c = xb_ld(&bar[XB_XCNT(j)]); sum += c; cnt += (c > 0u) ? 1u : 0u; mine = (j == x) ? c : mine; }
        if (sum == G) break;
        __builtin_amdgcn_s_sleep(1);
        if ((++sp & 255u) == 0u) { if (xb_ld(&bar[XB_TMO])) break; if (sp > XB_SPIN_CAP) { atomicAdd(&bar[XB_TMO], 1u); break; } }
    }
    nloc = mine > 0u ? mine : 1u; nx = cnt > 0u ? cnt : 1u;
}
DI void xcd_barrier(const XcdBarrier& b) {
    asm volatile("s_waitcnt vmcnt(0)" ::: "memory");
    __syncthreads();
    if (threadIdx.x == 0) {
        unsigned* bar = b.bar;
        __builtin_amdgcn_s_waitcnt(0);
        unsigned nloc = b.st[0], nx = b.st[1];
        if (nloc == 0u) { xcd_barrier_complete(bar, b.x, nloc, nx); b.st[0] = nloc; b.st[1] = nx; }
        const unsigned old = xb_add(&bar[XB_XSUB(b.x)], 1u);
        const unsigned gen = old / nloc;
        if (old + 1u == (gen + 1u) * nloc) {
            __builtin_amdgcn_fence(__ATOMIC_RELEASE, "agent");
            asm volatile("s_waitcnt vmcnt(0)" ::: "memory");
            const unsigned og = xb_add(&bar[XB_TOP], 1u);
            const unsigned tg = og / nx;
            if (og + 1u == (tg + 1u) * nx) xb_add(&bar[XB_TOPGEN], 1u);
            else XB_SPIN(xb_ld(&bar[XB_TOPGEN]) == tg, bar);
            __builtin_amdgcn_fence(__ATOMIC_ACQUIRE, "agent");
            xb_add(&bar[XB_XGEN(b.x)], 1u);
            asm volatile("s_waitcnt vmcnt(0)" ::: "memory");
        } else {
            XB_SPIN(xb_ld(&bar[XB_XGEN(b.x)]) == gen, bar);
            __builtin_amdgcn_fence(__ATOMIC_ACQUIRE, "agent");
            asm volatile("s_waitcnt vmcnt(0)" ::: "memory");
        }
    }
    __syncthreads();
}

struct Args { const float* in[31]; float* out; unsigned char* ws; int ph_lo, ph_hi, use_cg, pad; };
struct Frame {
    LAS unsigned char* lds;
    int tid, lane, wave, G, vcu, gw, ngw, bx;
    unsigned char* ws;
};
constexpr int LDS_MISC = 131072;
constexpr int LDS_BARST = LDS_BYTES - 64;

struct TItem { const float* src; bf16_t* dst; int ldw, ldt; };
DI void titem_load(const TItem& t, f32x4 (&v)[16], int lane) {
#pragma unroll
    for (int i = 0; i < 16; ++i) v[i] = *(const f32x4*)(t.src + (size_t)(4 * i + (lane >> 4)) * t.ldw + 4 * (lane & 15));
}
DI void titem_store(const TItem& t, const f32x4 (&v)[16], LAS float* scr, int lane) {
#pragma unroll
    for (int i = 0; i < 16; ++i) { LAS float* s = scr + (4 * i + (lane >> 4)) * 65 + 4 * (lane & 15); s[0] = v[i][0]; s[1] = v[i][1]; s[2] = v[i][2]; s[3] = v[i][3]; }
    LDS_WAIT();
#pragma unroll
    for (int j = 0; j < 8; ++j) {
        const int n = 8 * j + (lane >> 3), c = lane & 7; const LAS float* s = scr + (8 * c) * 65 + n;
        u32x4 o; o.x = cvtpk(s[0], s[65]); o.y = cvtpk(s[130], s[195]); o.z = cvtpk(s[260], s[325]); o.w = cvtpk(s[390], s[455]);
        *(u32x4*)(t.dst + (size_t)n * t.ldt + 8 * c) = o;
    }
    LDS_WAIT();
}
constexpr int IT_WIN = 16 * 42, IT_WOUT = 16 * 16, IT_SMALL = IT_WIN + IT_WOUT;
constexpr int IT_EXP = 128 * 3, IT_MOE = NE * IT_EXP;
DI TItem small_item(const Frame& F, const float* w_in, const float* w_out, int git) {
    const int l = git / IT_SMALL, it = git % IT_SMALL; TItem t;
    if (it < IT_WIN) {
        const int kt = it / 42, nt = it % 42, n0 = 64 * nt;
        size_t drow; if (n0 < 768) drow = n0; else if (n0 < 1152) drow = 2304 + (n0 - 768); else drow = n0 - 384;
        t.src = w_in + (size_t)l * D * INW + (size_t)(64 * kt) * INW + n0; t.ldw = INW;
        t.dst = (bf16_t*)(F.ws + WS_WIN + (size_t)l * WIN_LAYER) + drow * D + 64 * kt; t.ldt = D;
    } else {
        const int r = it - IT_WIN, kt = r >> 4, nt = r & 15;
        t.src = w_out + (size_t)l * D * D + (size_t)(64 * kt) * D + 64 * nt; t.ldw = D;
        t.dst = (bf16_t*)(F.ws + WS_WOUT) + (size_t)l * D * D + (size_t)(64 * nt) * D + 64 * kt; t.ldt = D;
    }
    return t;
}
DI TItem moe_item(const Frame& F, const float* wg, const float* wu, const float* wd, int l, int it) {
    const int e = it / IT_EXP, r = it % IT_EXP, which = r >> 7, q = r & 127; TItem t;
    if (which < 2) {
        const int kt = q >> 3, nt = q & 7, n0 = 64 * nt;
        t.src = (which ? wu : wg) + ((size_t)l * NE + e) * D * DE + (size_t)(64 * kt) * DE + n0; t.ldw = DE;
        const size_t drow = (size_t)(n0 >> 7) * 256 + (which ? 128 : 0) + (n0 & 127);
        t.dst = (bf16_t*)(F.ws + WS_WGU) + (size_t)e * D * D + drow * D + 64 * kt; t.ldt = D;
    } else {
        const int kt = q >> 4, nt = q & 15;
        t.src = wd + ((size_t)l * NE + e) * DE * D + (size_t)(64 * kt) * D + 64 * nt; t.ldw = D;
        t.dst = (bf16_t*)(F.ws + WS_WD) + (size_t)e * D * DE + (size_t)(64 * nt) * DE + 64 * kt; t.ldt = DE;
    }
    return t;
}
DI void p0_prologue(const Frame& F, const Args& a) {
    const float* c = a.in[1]; const float* w_mod = a.in[2]; const float* b_mod = a.in[3];
    if (F.bx < L * (MODW / 64)) {
        LAS float* sc = (LAS float*)(F.lds);
        LAS float* red = (LAS float*)(F.lds + 8192);
        for (int i = F.tid; i < NB * D; i += NTHREADS) { const float v = c[i]; sc[i] = v / (1.f + expf(-v)); }
        __syncthreads();
        const int l = F.bx / (MODW / 64), cb = F.bx % (MODW / 64), n = cb * 64 + F.lane;
        const float* w = w_mod + (size_t)l * D * MODW + n;
        float a0 = 0.f, a1 = 0.f;
#pragma unroll 8
        for (int k = F.wave * 128; k < F.wave * 128 + 128; ++k) { const float wv = w[(size_t)k * MODW]; a0 += sc[k] * wv; a1 += sc[D + k] * wv; }
        red[(F.wave * 2 + 0) * 64 + F.lane] = a0; red[(F.wave * 2 + 1) * 64 + F.lane] = a1;
        __syncthreads();
        if (F.tid < 128) { const int b = F.tid >> 6, ln = F.tid & 63; float s = 0.f;
#pragma unroll
            for (int w8 = 0; w8 < 8; ++w8) s += red[(w8 * 2 + b) * 64 + ln];
            const int nn = cb * 64 + ln;
            ((float*)(F.ws + WS_MOD))[(size_t)(l * NB + b) * MODW + nn] = s + b_mod[l * MODW + nn]; }
        __syncthreads();
    }
    { const int nzero = L * 128 * D / 8;
      for (int i = F.gw * 64 + F.lane; i < nzero; i += F.ngw * 64) { const int l = i / (128 * D / 8), r = i % (128 * D / 8);
          *(u32x4*)((bf16_t*)(F.ws + WS_WIN + (size_t)l * WIN_LAYER) + (size_t)(2304 + 384) * D + (size_t)r * 8) = (u32x4){0u, 0u, 0u, 0u}; } }
    LAS float* scr = (LAS float*)(F.lds + 16384) + F.wave * (64 * 65);
    { f32x4 cur[16], nxt[16]; int it = F.gw; TItem tc{}, tn{};
      if (it < L * IT_SMALL) { tc = small_item(F, a.in[4], a.in[19], it); titem_load(tc, cur, F.lane); }
      for (; it < L * IT_SMALL; it += F.ngw) {
          const bool more = it + F.ngw < L * IT_SMALL;
          if (more) { tn = small_item(F, a.in[4], a.in[19], it + F.ngw); titem_load(tn, nxt, F.lane); }
          titem_store(tc, cur, scr, F.lane);
          if (more) { tc = tn;
#pragma unroll
              for (int i = 0; i < 16; ++i) cur[i] = nxt[i]; }
      } }
}

DI void row_ln(f32x4 (&v)[4], float& mean_out, float& rstd_out) {
    float s = 0.f;
#pragma unroll
    for (int j = 0; j < 4; ++j) s += (v[j][0] + v[j][1]) + (v[j][2] + v[j][3]);
    const float mean = wave_sum(s) * (1.f / D); float q = 0.f;
#pragma unroll
    for (int j = 0; j < 4; ++j) { v[j] = v[j] - mean; q += (v[j][0] * v[j][0] + v[j][1] * v[j][1]) + (v[j][2] * v[j][2] + v[j][3] * v[j][3]); }
    mean_out = mean; rstd_out = 1.f / sqrtf(wave_sum(q) * (1.f / D) + LN_EPS);
}
DI void row_mod_store(f32x4 (&v)[4], const float* md, int off_sh, int off_sc, bf16_t* urow, int lane) {
    float mean, rstd; row_ln(v, mean, rstd);
#pragma unroll
    for (int j = 0; j < 4; ++j) { const int col = 4 * lane + 256 * j;
        const f32x4 scv = *(const f32x4*)(md + off_sc + col), shv = *(const f32x4*)(md + off_sh + col);
        v[j] = v[j] * rstd * (1.f + scv) + shv;
        u32x2 w; w.x = cvtpk(v[j][0], v[j][1]); w.y = cvtpk(v[j][2], v[j][3]);
        *(u32x2*)(urow + col) = w; }
}
DI void p_r0(const Frame& F, const float* x) {
    const float* MOD = (const float*)(F.ws + WS_MOD);
    bf16_t* U = (bf16_t*)(F.ws + WS_U);
    for (int row = F.gw; row < T; row += F.ngw) {
        f32x4 v[4];
#pragma unroll
        for (int j = 0; j < 4; ++j) v[j] = *(const f32x4*)(x + (size_t)row * D + 4 * F.lane + 256 * j);
        row_mod_store(v, MOD + (size_t)(row / S) * MODW, 0, D, U + (size_t)row * D, F.lane);
    }
}

constexpr int NGRP = T / 64;
DI void p_rowpass1(const Frame& F, const Args& a, int l, const float* xin, const bool dry = false) {
    const float* MODl = (const float*)(F.ws + WS_MOD) + (size_t)l * NB * MODW;
    const bf16_t* MIX = (const bf16_t*)(F.ws + WS_MIX);
    float* XA = (float*)(F.ws + WS_XA); bf16_t* U = (bf16_t*)(F.ws + WS_U);
    const float* gain = a.in[20] + (size_t)l * D; const float* bias = a.in[21] + (size_t)l * D;
    const float* wg = a.in[24] + (size_t)l * D * NG; const float* bg = a.in[25] + (size_t)l * NG;
    const float* we = a.in[26] + (size_t)l * D * NE; const float* be = a.in[27] + (size_t)l * NE;
    const size_t dro = dry ? 490 * MiB - WS_BC : 0;
    int* BC = (int*)(F.ws + WS_BC + dro); float* TOKW = (float*)(F.ws + WS_TOKW + dro); int* TOKSLOT = (int*)(F.ws + WS_TOKSLOT + (dry ? 496 * MiB - WS_TOKSLOT : 0));
    LAS float* RT = (LAS float*)F.lds;
    LAS unsigned* cntl = (LAS unsigned*)(F.lds + 36 * D * 4 + NWAVES * 72 * 4);
#pragma unroll
    for (int kk = 0; kk < 2; ++kk) { const int k = F.tid + kk * NTHREADS;
        f32x4 v[9]; v[0] = *(const f32x4*)(wg + (size_t)k * NG);
#pragma unroll
        for (int q = 0; q < 8; ++q) v[1 + q] = *(const f32x4*)(we + (size_t)k * NE + 4 * q);
#pragma unroll
        for (int q = 0; q < 9; ++q)
#pragma unroll
            for (int e = 0; e < 4; ++e) RT[(4 * q + e) * D + k] = v[q][e]; }
    for (int grp = F.vcu; grp < NGRP; grp += F.G) {
    if (F.tid < NE) cntl[F.tid] = 0u;
    __syncthreads();
    f32x4 pxa[4], pxb[4]; u32x2 pma[4], pmb[4];
    { const int r0 = 64 * grp + 8 * F.wave;
#pragma unroll
      for (int j = 0; j < 4; ++j) { const int col = 4 * F.lane + 256 * j; pxa[j] = *(const f32x4*)(xin + (size_t)r0 * D + col); pxb[j] = *(const f32x4*)(xin + (size_t)(r0 + 1) * D + col);
          pma[j] = *(const u32x2*)(MIX + (size_t)r0 * D + col); pmb[j] = *(const u32x2*)(MIX + (size_t)(r0 + 1) * D + col); } }
    for (int rp = 0; rp < 4; ++rp) {
        const int row0 = 64 * grp + 8 * F.wave + 2 * rp; const float* md = MODl + (size_t)(row0 / S) * MODW;
        f32x4 va[4], vb[4];
#pragma unroll
        for (int j = 0; j < 4; ++j) { const int col = 4 * F.lane + 256 * j;
            const f32x4 g = *(const f32x4*)(md + 2 * D + col);
            va[j] = pxa[j] * ALPHA + g * (f32x4){bflo(pma[j].x), bfhi(pma[j].x), bflo(pma[j].y), bfhi(pma[j].y)};
            vb[j] = pxb[j] * ALPHA + g * (f32x4){bflo(pmb[j].x), bfhi(pmb[j].x), bflo(pmb[j].y), bfhi(pmb[j].y)}; }
        if (rp < 3) { const int r0 = row0 + 2;
#pragma unroll
          for (int j = 0; j < 4; ++j) { const int col = 4 * F.lane + 256 * j; pxa[j] = *(const f32x4*)(xin + (size_t)r0 * D + col); pxb[j] = *(const f32x4*)(xin + (size_t)(r0 + 1) * D + col);
              pma[j] = *(const u32x2*)(MIX + (size_t)r0 * D + col); pmb[j] = *(const u32x2*)(MIX + (size_t)(r0 + 1) * D + col); } }
        float mean, rstd;
        row_ln(va, mean, rstd);
#pragma unroll
        for (int j = 0; j < 4; ++j) { const int col = 4 * F.lane + 256 * j; va[j] = va[j] * rstd * *(const f32x4*)(gain + col) + *(const f32x4*)(bias + col); *(f32x4*)(XA + (size_t)row0 * D + col) = va[j]; }
        row_ln(vb, mean, rstd);
#pragma unroll
        for (int j = 0; j < 4; ++j) { const int col = 4 * F.lane + 256 * j; vb[j] = vb[j] * rstd * *(const f32x4*)(gain + col) + *(const f32x4*)(bias + col); *(f32x4*)(XA + (size_t)(row0 + 1) * D + col) = vb[j]; }
        row_mod_store(va, md, 3 * D, 4 * D, U + (size_t)row0 * D, F.lane);
        row_mod_store(vb, md, 3 * D, 4 * D, U + (size_t)(row0 + 1) * D, F.lane);
#ifdef DRY_NOROUTER
        if (dry) continue;
#endif
        LAS float* lg = (LAS float*)(F.lds + 36 * D * 4) + F.wave * 72;
#pragma unroll 1
        for (int n = 0; n < 36; n += 3) { float sa[3], sb[3];
#pragma unroll
            for (int q = 0; q < 3; ++q) { sa[q] = 0.f; sb[q] = 0.f;
#pragma unroll
                for (int j = 0; j < 4; ++j) { const f32x4 w = *(const LAS f32x4*)(RT + (n + q) * D + 4 * F.lane + 256 * j);
                    sa[q] += (va[j][0] * w[0] + va[j][1] * w[1]) + (va[j][2] * w[2] + va[j][3] * w[3]);
                    sb[q] += (vb[j][0] * w[0] + vb[j][1] * w[1]) + (vb[j][2] * w[2] + vb[j][3] * w[3]); } }
#pragma unroll
            for (int q = 0; q < 3; ++q) { sa[q] = wave_sum(sa[q]); sb[q] = wave_sum(sb[q]); }
            if (F.lane == 0) {
#pragma unroll
                for (int q = 0; q < 3; ++q) { lg[n + q] = sa[q]; lg[36 + n + q] = sb[q]; } } }
        LDS_WAIT();
#pragma unroll
        for (int rr = 0; rr < 2; ++rr) {
            float gl[4];
#pragma unroll
            for (int n = 0; n < 4; ++n) gl[n] = lg[36 * rr + n] + bg[n];
            int gi = 0; float gm = gl[0];
#pragma unroll
            for (int n = 1; n < 4; ++n) { const bool c = gl[n] > gm; gm = c ? gl[n] : gm; gi = c ? n : gi; }
            float se = 0.f;
#pragma unroll
            for (int n = 0; n < 4; ++n) se += expf(gl[n] - gm);
            const float pg = 1.f / se;
            float l1 = -3.0e38f, l2 = -3.0e38f; int i1 = 0, i2 = 0;
#pragma unroll
            for (int e = 0; e < 8; ++e) { const float v = lg[36 * rr + 4 + gi * EPG + e] + be[gi * EPG + e];
                const bool c1 = v > l1, c2 = v > l2;
                l2 = c1 ? l1 : (c2 ? v : l2); i2 = c1 ? i1 : (c2 ? e : i2); l1 = c1 ? v : l1; i1 = c1 ? e : i1; }
            const float e2 = expf(l2 - l1); const float w1 = pg / (1.f + e2), w2 = pg * e2 / (1.f + e2);
            if (F.lane == 0) {
                const int tok = row0 + rr, ea = gi * EPG + i1, eb = gi * EPG + i2;
                const unsigned pa = __hip_atomic_fetch_add(&cntl[ea], 1u, __ATOMIC_RELAXED, __HIP_MEMORY_SCOPE_WORKGROUP), pb = __hip_atomic_fetch_add(&cntl[eb], 1u, __ATOMIC_RELAXED, __HIP_MEMORY_SCOPE_WORKGROUP);
                TOKSLOT[tok * 2] = (ea << 14) | (int)pa; TOKSLOT[tok * 2 + 1] = (eb << 14) | (int)pb;
                TOKW[tok * 2] = w1; TOKW[tok * 2 + 1] = w2;
            }
        }
    }
    __syncthreads();
    if (F.tid < NE) BC[grp * NE + F.tid] = (int)cntl[F.tid];
    __syncthreads();
    }
}

DI void build_tables(const Frame& F, int l, LAS int* tb) {
    if (F.tid < 64) {
        const int e = F.lane; const int c = e < NE ? ((const int*)(F.ws + WS_CNTF))[e] : 0; const int tl = (c + 255) >> 8;
        int cum = c, tin = tl;
#pragma unroll
        for (int o = 1; o < 32; o <<= 1) { const int a1 = __shfl_up(cum, o), a2 = __shfl_up(tin, o); if (e >= o) { cum += a1; tin += a2; } }
        if (e < NE) { tb[e] = cum - c; tb[33 + e] = (tin - tl) * 256; for (int t2 = 0; t2 < tl; ++t2) tb[66 + (tin - tl) + t2] = e; }
        if (e == NE - 1) { tb[32] = cum; tb[65] = tin; }
    }
    __syncthreads();
}
DI void p_gather(const Frame& F, int l) {
    LAS int* base = (LAS int*)F.lds;
    LAS int* segt = base + NGRP * NE;
    LAS int* offp = segt + 16 * NE;
    const int* BC = (const int*)(F.ws + WS_BC);
    { int tmp[NGRP * NE / NTHREADS];
#pragma unroll
      for (int q = 0; q < NGRP * NE / NTHREADS; ++q) tmp[q] = BC[F.tid + q * NTHREADS];
#pragma unroll
      for (int q = 0; q < NGRP * NE / NTHREADS; ++q) base[F.tid + q * NTHREADS] = tmp[q]; }
    __syncthreads();
    { const int e = F.tid & 31, sg = F.tid >> 5; int run = 0;
      for (int g = 16 * sg; g < 16 * sg + 16; ++g) { const int c = base[g * NE + e]; base[g * NE + e] = run; run += c; }
      segt[sg * NE + e] = run; }
    __syncthreads();
    if (F.tid < NE) { int run = 0; for (int sg = 0; sg < 16; ++sg) { const int c = segt[sg * NE + F.tid]; segt[sg * NE + F.tid] = run; run += c; }
        offp[F.tid] = run;
        if (F.bx == 0) ((int*)(F.ws + WS_CNTF))[F.tid] = run; }
    __syncthreads();
    if (F.tid == 0) { int off = 0; for (int e = 0; e < NE; ++e) { const int c = offp[e]; offp[e] = off; off += ((c + 255) >> 8) * 256; } }
    __syncthreads();
    const int* TOKSLOT = (const int*)(F.ws + WS_TOKSLOT); const float* TOKW = (const float*)(F.ws + WS_TOKW); int* TOKFIN = (int*)(F.ws + WS_TOKFIN);
    float* SLOTW = (float*)(F.ws + WS_SLOTW);
    const int nas = (2 * T - F.gw + F.ngw - 1) / F.ngw;
    int my_slot = 0, my_tok = 0;
    if (F.lane < nas) { const int as = F.gw + F.lane * F.ngw; const int tok = as >> 1, ts = TOKSLOT[as], e = ts >> 14, grp = tok >> 6, sg = grp >> 4;
        my_slot = offp[e] + segt[sg * NE + e] + base[grp * NE + e] + (ts & 16383); my_tok = tok;
        SLOTW[my_slot] = TOKW[as]; TOKFIN[as] = my_slot; ((int*)(F.ws + WS_CTL + WS_SLOTTOK))[my_slot] = tok; }
}
struct Rp2In { f32x4 x[4]; u32x2 y0[4], y1[4]; };
DI void rp2_load(Rp2In& r, const float* XA, const bf16_t* YS, int row, int s0, int s1, int lane) {
#pragma unroll
    for (int j = 0; j < 4; ++j) { const int col = 4 * lane + 256 * j;
        r.x[j] = *(const f32x4*)(XA + (size_t)row * D + col); r.y0[j] = *(const u32x2*)(YS + (size_t)s0 * D + col); r.y1[j] = *(const u32x2*)(YS + (size_t)s1 * D + col); }
}
DI void p_rowpass2(const Frame& F, const Args& a, int l, float* xout) {
    const float* MOD = (const float*)(F.ws + WS_MOD);
    const float* XA = (const float*)(F.ws + WS_XA); const bf16_t* YS = (const bf16_t*)(F.ws + WS_YS); const int* TOKFIN = (const int*)(F.ws + WS_TOKFIN);
    const float* gain = a.in[22] + (size_t)l * D; const float* bias = a.in[23] + (size_t)l * D;
    bf16_t* U = (bf16_t*)(F.ws + WS_U);
    const int nrows = (T - F.gw + F.ngw - 1) / F.ngw;
    int tf = 0; { const int i = F.lane >> 1; if (i < nrows) tf = TOKFIN[(F.gw + i * F.ngw) * 2 + (F.lane & 1)]; }
    Rp2In cur, nxt;
    if (nrows > 0) rp2_load(cur, XA, YS, F.gw, __shfl(tf, 0), __shfl(tf, 1), F.lane);
    for (int i = 0; i < nrows; ++i) {
        const int row = F.gw + i * F.ngw;
        if (i + 1 < nrows) rp2_load(nxt, XA, YS, row + F.ngw, __shfl(tf, 2 * i + 2), __shfl(tf, 2 * i + 3), F.lane);
        const float* md = MOD + (size_t)(l * NB + row / S) * MODW;
        f32x4 v[4];
#pragma unroll
        for (int j = 0; j < 4; ++j) { const int col = 4 * F.lane + 256 * j;
            const f32x4 g = *(const f32x4*)(md + 5 * D + col);
            const u32x2 y0 = cur.y0[j], y1 = cur.y1[j];
            const f32x4 f = (f32x4){bflo(y0.x) + bflo(y1.x), bfhi(y0.x) + bfhi(y1.x), bflo(y0.y) + bflo(y1.y), bfhi(y0.y) + bfhi(y1.y)};
            v[j] = cur.x[j] * ALPHA + g * f; }
        float mean, rstd; row_ln(v, mean, rstd);
#pragma unroll
        for (int j = 0; j < 4; ++j) { const int col = 4 * F.lane + 256 * j; v[j] = v[j] * rstd * *(const f32x4*)(gain + col) + *(const f32x4*)(bias + col); *(f32x4*)(xout + (size_t)row * D + col) = v[j]; }
        if (l + 1 < L) row_mod_store(v, MOD + (size_t)((l + 1) * NB + row / S) * MODW, 0, D, U + (size_t)row * D, F.lane);
        if (i + 1 < nrows) {
#pragma unroll
            for (int j = 0; j < 4; ++j) { cur.x[j] = nxt.x[j]; cur.y0[j] = nxt.y0[j]; cur.y1[j] = nxt.y1[j]; } }
    }
}

#define MFMA16(a, b, c) __builtin_amdgcn_mfma_f32_16x16x32_bf16((a), (b), (c), 0, 0, 0)
#define MFMA32(a, b, c) __builtin_amdgcn_mfma_f32_32x32x16_bf16((a), (b), (c), 0, 0, 0)
constexpr int RB = 9216;
#define BUF(i) ((i) * RB)
constexpr int LWOFF = BUF(12), ZAOFF = BUF(0), SEGOFF = BUF(14), SEGXOFF = BUF(14) + 2048, TOTOFF = BUF(14) + 4096, NABFOFF = BUF(15), PCOFF = 16 * RB;
struct RwP { const float *conv, *w0, *w_up, *a0, *a_up, *g_up, *k_k, *k_a, *r_k, *gn_gain, *gn_bias; };

DI void lds_barrier() { asm volatile("s_waitcnt lgkmcnt(0)" ::: "memory"); __builtin_amdgcn_s_barrier(); asm volatile("" ::: "memory"); }
DI int swo(int row, int col) { return row * 144 + (((((col >> 3) ^ (row >> 3)) & 7) << 3) + (col & 7)) * 2; }
DI bf16x8 ldfrag(const LAS unsigned char* lds, int buf, int row, int ks, int lane) { return *(const LAS bf16x8*)(lds + buf + swo(row, 32 * ks + 8 * (lane >> 4))); }
DI f32x4 mm64(const LAS unsigned char* lds, int abuf, int arow0, int bbuf, int brow0, int lane) {
    f32x4 acc = (f32x4){0.f, 0.f, 0.f, 0.f};
#pragma unroll
    for (int ks = 0; ks < 2; ++ks) acc = MFMA16(ldfrag(lds, abuf, arow0 + (lane & 15), ks, lane), ldfrag(lds, bbuf, brow0 + (lane & 15), ks, lane), acc);
    return acc;
}
DI u32x2 pack4(const f32x4 v) { u32x2 w; w.x = cvtpk(v[0], v[1]); w.y = cvtpk(v[2], v[3]); return w; }
DI f32x4 unpack4(const u32x2 w) { return (f32x4){bflo(w.x), bfhi(w.x), bflo(w.y), bfhi(w.y)}; }
DI void st4(LAS unsigned char* lds, int buf, int row, int col, const f32x4 v) { *(LAS u32x2*)(lds + buf + swo(row, col)) = pack4(v); }
DI f32x4 ld4(const LAS unsigned char* lds, int buf, int row, int col) { return unpack4(*(const LAS u32x2*)(lds + buf + swo(row, col))); }
DI void st1(LAS unsigned char* lds, int buf, int row, int col, float v) { *(LAS bf16_t*)(lds + buf + swo(row, col)) = f2bf(v); }
DI float fast_tanh(float x) { const float e = fexp2(x * (2.f * LOG2E)); return 1.f - 2.f * frcp(1.f + e); }

#define OPQZ(z) int z; asm volatile("s_mov_b32 %0, 0" : "=s"(z))
constexpr int CWLOFF = PCOFF + 256;
constexpr int PRMOFF = CWLOFF + 6912;
struct RwPre { u32x2 wv, av; u32x4 gv; f32x4 w4, a4, g0, g1; u32x4 rr[3], kk[3], vv[3]; };
DI void rwkv_prefetch(const Frame& F, const Args& a, const int l, const int unit, RwPre& P) {
    const int tid = F.tid;
    const int c = unit % NCH, hd = (unit / NCH) % BH, b = (unit / (NCH * BH)) % NB, dir = unit / (NCH * BH * NB);
    const bf16_t* HBp = (const bf16_t*)(F.ws + WS_HB);
    const int u = tid >> 3, jg = tid & 7, tloc = 64 * c + u; const size_t tok = (size_t)b * S + tloc;
    const bf16_t* hrow = HBp + tok * HW;
    P.wv = *(const u32x2*)(hrow + HWL + 4 * jg); P.av = *(const u32x2*)(hrow + HAL + 4 * jg); P.gv = *(const u32x4*)(hrow + HGL + 8 * jg);
    OPQZ(z0);
    { const int m = tid >> 4, j4 = (tid & 15) * 4;
      const float* w_up = a.in[8 + z0] + (size_t)l * 2 * RW * BW; const float* a_up = a.in[10 + z0] + (size_t)l * 2 * RA * BW;
      P.w4 = *(const f32x4*)(w_up + (size_t)(dir * RW + m) * BW + hd * HD + j4); P.a4 = *(const f32x4*)(a_up + (size_t)(dir * RA + m) * BW + hd * HD + j4); }
    { const int m = tid >> 3, i8 = (tid & 7) * 8; const float* g_up = a.in[11 + z0] + (size_t)l * RG * BW;
      P.g0 = *(const f32x4*)(g_up + (size_t)m * BW + hd * HD + i8); P.g1 = *(const f32x4*)(g_up + (size_t)m * BW + hd * HD + i8 + 4); }
    const int ch0 = hd * HD + 8 * jg;
#pragma unroll
    for (int x = 0; x < 3; ++x) {
        const int tt = tloc + x - 1; const u32x4 z4 = (u32x4){0u, 0u, 0u, 0u};
        if (tt >= 0 && tt < S) { const bf16_t* hp = HBp + ((size_t)b * S + tt) * HW + HR + ch0; P.rr[x] = *(const u32x4*)hp; P.kk[x] = *(const u32x4*)(hp + BW); P.vv[x] = *(const u32x4*)(hp + 2 * BW); }
        else { P.rr[x] = z4; P.kk[x] = z4; P.vv[x] = z4; }
    }
}
DI void rwkv_local_unit(const Frame& F, const Args& a, const int l, const int unit, RwPre& PF, const int next_unit) {
    LAS unsigned char* lds = F.lds;
    int tid_ = F.tid; asm volatile("" : "+v"(tid_));
    const int tid = tid_, lane = tid_ & 63, wave = F.wave;
    const int c = unit % NCH, hd = (unit / NCH) % BH, b = (unit / (NCH * BH)) % NB, dir = unit / (NCH * BH * NB);
    const bf16_t* HBp = (const bf16_t*)(F.ws + WS_HB);
    const int u = tid >> 3, jg = tid & 7, tau = dir ? 63 - u : u, tloc = 64 * c + u;
    const size_t tok = (size_t)b * S + tloc;
    const int tn = wave & 3, tm0 = 2 * (wave >> 2), g4 = lane >> 4, l15 = lane & 15;
    if (tid < 320) { OPQZ(z2); const int which = tid >> 6, j = tid & 63;
      const float* src = which == 0 ? a.in[7 + z2] + (size_t)l * 2 * BW + dir * BW : which == 1 ? a.in[9 + z2] + (size_t)l * 2 * BW + dir * BW : which == 2 ? a.in[12 + z2] + (size_t)l * BW : which == 3 ? a.in[13 + z2] + (size_t)l * BW : a.in[14 + z2] + (size_t)l * BH * HD;
      *(LAS float*)(lds + PRMOFF + tid * 4) = src[hd * HD + j]; }
    {
        const f32x4 wf = unpack4(PF.wv);
        *(LAS u32x2*)(lds + BUF(8) + swo(tau, 4 * jg)) = pack4((f32x4){fast_tanh(wf[0]), fast_tanh(wf[1]), fast_tanh(wf[2]), fast_tanh(wf[3])});
        *(LAS u32x2*)(lds + BUF(8) + swo(tau, 32 + 4 * jg)) = PF.av;
        const u32x4 gv = PF.gv;
        u32x4 so; so.x = cvtpk(sigm(bflo(gv.x)), sigm(bfhi(gv.x))); so.y = cvtpk(sigm(bflo(gv.y)), sigm(bfhi(gv.y))); so.z = cvtpk(sigm(bflo(gv.z)), sigm(bfhi(gv.z))); so.w = cvtpk(sigm(bflo(gv.w)), sigm(bfhi(gv.w)));
        *(LAS u32x4*)(lds + BUF(9) + swo(tau, 8 * jg)) = so;
        { const int m = tid >> 4, j4 = (tid & 15) * 4;
#pragma unroll
          for (int e = 0; e < 4; ++e) { st1(lds, BUF(10), j4 + e, m, PF.w4[e]); st1(lds, BUF(10), j4 + e, 32 + m, PF.a4[e]); } }
        { const int m = tid >> 3, i8 = (tid & 7) * 8;
#pragma unroll
          for (int e = 0; e < 4; ++e) { st1(lds, BUF(11), i8 + e, m, PF.g0[e]); st1(lds, BUF(11), i8 + 4 + e, m, PF.g1[e]); } }
    }
    lds_barrier();
#pragma unroll
    for (int tmi = 0; tmi < 2; ++tmi) {
        const int tm = tm0 + tmi; const f32x4 z = (f32x4){0.f, 0.f, 0.f, 0.f};
        const f32x4 zw = MFMA16(ldfrag(lds, BUF(10), 16 * tm + l15, 0, lane), ldfrag(lds, BUF(8), 16 * tn + l15, 0, lane), z);
        const f32x4 za = MFMA16(ldfrag(lds, BUF(10), 16 * tm + l15, 1, lane), ldfrag(lds, BUF(8), 16 * tn + l15, 1, lane), z);
        const int trow = 16 * tn + l15, jb = 16 * tm + 4 * g4;
        *(LAS f32x4*)(lds + LWOFF + (trow * 64 + jb) * 4) = zw;
        *(LAS f32x4*)(lds + ZAOFF + (trow * 64 + jb) * 4) = za;
        if (dir == 0) {
            const f32x4 gg = mm64(lds, BUF(11), 16 * tm, BUF(9), 16 * tn, lane);
            *(u32x2*)((bf16_t*)(F.ws + WS_GB) + ((size_t)b * S + 64 * c + trow) * BW + hd * HD + jb) = pack4(gg);
        }
    }
    lds_barrier();
    const int ch0 = hd * HD + 8 * jg;
    float r[8], kd[8], kap[8], bb[8], lw[8];
    {
        float k[8], v[8];
#pragma unroll
        for (int e = 0; e < 8; ++e) { r[e] = 0.f; k[e] = 0.f; v[e] = 0.f; }
#pragma unroll
        for (int x = 0; x < 3; ++x) {
            const LAS unsigned char* cwp = lds + CWLOFF + (((hd * 3 + x) * 3) * 64 + 8 * jg) * 2;
            const u32x4 cr = *(const LAS u32x4*)cwp, ck = *(const LAS u32x4*)(cwp + 128), cv = *(const LAS u32x4*)(cwp + 256);
            const u32x4 rr = PF.rr[x], kk2 = PF.kk[x], vv = PF.vv[x];
            r[0] += bflo(rr.x) * bflo(cr.x); r[1] += bfhi(rr.x) * bfhi(cr.x); r[2] += bflo(rr.y) * bflo(cr.y); r[3] += bfhi(rr.y) * bfhi(cr.y);
            r[4] += bflo(rr.z) * bflo(cr.z); r[5] += bfhi(rr.z) * bfhi(cr.z); r[6] += bflo(rr.w) * bflo(cr.w); r[7] += bfhi(rr.w) * bfhi(cr.w);
            k[0] += bflo(kk2.x) * bflo(ck.x); k[1] += bfhi(kk2.x) * bfhi(ck.x); k[2] += bflo(kk2.y) * bflo(ck.y); k[3] += bfhi(kk2.y) * bfhi(ck.y);
            k[4] += bflo(kk2.z) * bflo(ck.z); k[5] += bfhi(kk2.z) * bfhi(ck.z); k[6] += bflo(kk2.w) * bflo(ck.w); k[7] += bfhi(kk2.w) * bfhi(ck.w);
            v[0] += bflo(vv.x) * bflo(cv.x); v[1] += bfhi(vv.x) * bfhi(cv.x); v[2] += bflo(vv.y) * bflo(cv.y); v[3] += bfhi(vv.y) * bfhi(cv.y);
            v[4] += bflo(vv.z) * bflo(cv.z); v[5] += bfhi(vv.z) * bfhi(cv.z); v[6] += bflo(vv.w) * bflo(cv.w); v[7] += bfhi(vv.w) * bfhi(cv.w);
        }
        const f32x4 zw0 = *(const LAS f32x4*)(lds + LWOFF + (tau * 64 + 8 * jg) * 4), zw1 = *(const LAS f32x4*)(lds + LWOFF + (tau * 64 + 8 * jg + 4) * 4);
        const f32x4 za0 = *(const LAS f32x4*)(lds + ZAOFF + (tau * 64 + 8 * jg) * 4), za1 = *(const LAS f32x4*)(lds + ZAOFF + (tau * 64 + 8 * jg + 4) * 4);
        float ss = 0.f, bsp = 0.f, av[8];
        const LAS f32x4* prm = (const LAS f32x4*)(lds + PRMOFF) + 2 * jg;
        const f32x4 w0a = prm[0], w0b = prm[1], a0a = prm[16], a0b = prm[17], kka = prm[32], kkb = prm[33], kaa = prm[48], kab = prm[49], rka = prm[64], rkb = prm[65];
#pragma unroll
        for (int e = 0; e < 8; ++e) {
            const float zw = (e < 4 ? zw0[e & 3] : zw1[e & 3]) + (e < 4 ? w0a[e & 3] : w0b[e & 3]);
            const float za = (e < 4 ? za0[e & 3] : za1[e & 3]) + (e < 4 ? a0a[e & 3] : a0b[e & 3]);
            lw[e] = (-DECAY * LOG2E) * sigm(zw); av[e] = sigm(za);
            kap[e] = k[e] * (e < 4 ? kka[e & 3] : kkb[e & 3]); ss += kap[e] * kap[e];
            kd[e] = k[e] * (1.f + (av[e] - 1.f) * (e < 4 ? kaa[e & 3] : kab[e & 3]));
            bsp += r[e] * kd[e] * (e < 4 ? rka[e & 3] : rkb[e & 3]);
        }
        ss += __shfl_xor(ss, 1); ss += __shfl_xor(ss, 2); ss += __shfl_xor(ss, 4);
        bsp += __shfl_xor(bsp, 1); bsp += __shfl_xor(bsp, 2); bsp += __shfl_xor(bsp, 4);
        const float rn = __builtin_amdgcn_rsqf(fmaxf(ss, 1e-24f));
#pragma unroll
        for (int e = 0; e < 8; ++e) { kap[e] *= rn; bb[e] = kap[e] * av[e]; }
        if (jg == 0) ((float*)(F.ws + WS_BS))[((size_t)dir * T + tok) * 8 + hd] = bsp;
        *(LAS f32x4*)(lds + LWOFF + (tau * 64 + 8 * jg) * 4) = (f32x4){lw[0], lw[1], lw[2], lw[3]};
        *(LAS f32x4*)(lds + LWOFF + (tau * 64 + 8 * jg + 4) * 4) = (f32x4){lw[4], lw[5], lw[6], lw[7]};
#pragma unroll
        for (int e = 0; e < 8; ++e) st1(lds, BUF(7), 8 * jg + e, tau, v[e]);
        if (dir == 0) {
            u32x4 vo; vo.x = cvtpk(v[0], v[1]); vo.y = cvtpk(v[2], v[3]); vo.z = cvtpk(v[4], v[5]); vo.w = cvtpk(v[6], v[7]);
            *(u32x4*)((bf16_t*)(F.ws + WS_VC) + tok * BW + ch0) = vo;
        }
    }
    lds_barrier();
    if (dir == 0) {
        const size_t ucidx = ((size_t)b * BH + hd) * NCH + c; const int vi = tid >> 3, vc = tid & 7;
        *(u32x4*)((bf16_t*)(F.ws + WS_VTB) + ucidx * 4096 + vi * 64 + vc * 8) = *(const LAS u32x4*)(lds + BUF(7) + swo(vi, 8 * vc));
    }
    { const int seg = tid >> 6, j = tid & 63; float p = 0.f;
#pragma unroll
      for (int i = 0; i < 8; ++i) { LAS float* q = (LAS float*)(lds + LWOFF + ((8 * seg + i) * 64 + j) * 4); p += *q; *q = p; }
      *(LAS float*)(lds + SEGOFF + (seg * 64 + j) * 4) = p; }
    lds_barrier();
    if (tid < 64) { float run = 0.f;
#pragma unroll
      for (int sg = 0; sg < 8; ++sg) { *(LAS float*)(lds + SEGXOFF + (sg * 64 + tid) * 4) = run; run += *(const LAS float*)(lds + SEGOFF + (sg * 64 + tid) * 4); }
      *(LAS float*)(lds + TOTOFF + tid * 4) = run; }
    lds_barrier();
    {
        float At[8], Rt[8], Bt[8], Kt[8], Bh[8], Kh[8], pcs[8];
#pragma unroll
        for (int e = 0; e < 8; ++e) {
            const int j = 8 * jg + e;
            const float lwi = *(const LAS float*)(lds + LWOFF + (tau * 64 + j) * 4) + *(const LAS float*)(lds + SEGXOFF + ((tau >> 3) * 64 + j) * 4);
            const float tot = *(const LAS float*)(lds + TOTOFF + j * 4);
            const float ep = fexp2(lwi - lw[e]), epl = fexp2(lwi), em = fexp2(-lwi), ec = fexp2(tot - lwi);
            At[e] = -kap[e] * ep; Rt[e] = r[e] * epl; Bt[e] = bb[e] * em; Kt[e] = kd[e] * em; Bh[e] = bb[e] * ec; Kh[e] = kd[e] * ec;
            pcs[e] = tot;
        }
        if (u == 0) {
            *(LAS f32x4*)(lds + PCOFF + (8 * jg) * 4) = (f32x4){fexp2(pcs[0]), fexp2(pcs[1]), fexp2(pcs[2]), fexp2(pcs[3])};
            *(LAS f32x4*)(lds + PCOFF + (8 * jg + 4) * 4) = (f32x4){fexp2(pcs[4]), fexp2(pcs[5]), fexp2(pcs[6]), fexp2(pcs[7])}; }
        u32x4 o;
#define PK8(X) (o.x = cvtpk(X[0], X[1]), o.y = cvtpk(X[2], X[3]), o.z = cvtpk(X[4], X[5]), o.w = cvtpk(X[6], X[7]), o)
        *(LAS u32x4*)(lds + BUF(0) + swo(tau, 8 * jg)) = PK8(At);
        *(LAS u32x4*)(lds + BUF(1) + swo(tau, 8 * jg)) = PK8(Bt);
        *(LAS u32x4*)(lds + BUF(2) + swo(tau, 8 * jg)) = PK8(Kt);
        *(LAS u32x4*)(lds + BUF(3) + swo(tau, 8 * jg)) = PK8(Rt);
#undef PK8
#pragma unroll
        for (int e = 0; e < 8; ++e) { const int j = 8 * jg + e; st1(lds, BUF(4), j, tau, At[e]); st1(lds, BUF(5), j, tau, Bh[e]); st1(lds, BUF(6), j, tau, Kh[e]); }
    }
    if (next_unit >= 0) rwkv_prefetch(F, a, l, next_unit, PF);
    lds_barrier();
#pragma unroll
    for (int tmi = 0; tmi < 2; ++tmi) {
        const int tm = tm0 + tmi, mb = 16 * tm + 4 * g4, nn = 16 * tn + l15;
        { f32x4 v = mm64(lds, BUF(1), 16 * tm, BUF(0), 16 * tn, lane);
#pragma unroll
          for (int e = 0; e < 4; ++e) v[e] = (mb + e < nn) ? v[e] : 0.f;
          if (tm == tn) {
#pragma unroll
              for (int e = 0; e < 4; ++e) *(LAS float*)(lds + NABFOFF + ((16 * tm + l15) * 16 + ((mb + e) & 15)) * 4) = v[e];
              v = (f32x4){0.f, 0.f, 0.f, 0.f};
          }
          st4(lds, BUF(11), nn, mb, v); }
        { f32x4 v = mm64(lds, BUF(0), 16 * tm, BUF(2), 16 * tn, lane);
#pragma unroll
          for (int e = 0; e < 4; ++e) v[e] = (nn < mb + e) ? v[e] : 0.f;
          st4(lds, BUF(8), nn, mb, v); }
        { f32x4 v = mm64(lds, BUF(1), 16 * tm, BUF(3), 16 * tn, lane);
#pragma unroll
          for (int e = 0; e < 4; ++e) v[e] = (mb + e <= nn) ? v[e] : 0.f;
          st4(lds, BUF(9), nn, mb, v); }
        { f32x4 v = mm64(lds, BUF(2), 16 * tm, BUF(3), 16 * tn, lane);
#pragma unroll
          for (int e = 0; e < 4; ++e) v[e] = (mb + e <= nn) ? v[e] : 0.f;
          st4(lds, BUF(10), nn, mb, v); }
    }
    lds_barrier();
    if (wave == 0) {
        const int blk = lane >> 4, sr = lane & 15, s = 16 * blk + sr;
        float Tr[16];
#pragma unroll
        for (int t = 0; t < 16; ++t) { float acc = (t == sr) ? 1.f : 0.f;
            const LAS f32x4* col = (const LAS f32x4*)(lds + NABFOFF + ((16 * blk + t) * 16) * 4);
#pragma unroll
            for (int q = 0; q < (t + 3) / 4; ++q) { const f32x4 nv = col[q];
#pragma unroll
                for (int e = 0; e < 4; ++e) if (4 * q + e < t) acc += Tr[4 * q + e] * nv[e]; }
            Tr[t] = acc; __builtin_amdgcn_sched_barrier(0); }
        const u32x4 z4 = (u32x4){0u, 0u, 0u, 0u};
#pragma unroll
        for (int q = 0; q < 9; ++q) { *(LAS u32x4*)(lds + BUF(0) + s * 144 + 16 * q) = z4; *(LAS u32x4*)(lds + BUF(1) + s * 144 + 16 * q) = z4; }
        u32x4 o0, o1; o0.x = cvtpk(Tr[0], Tr[1]); o0.y = cvtpk(Tr[2], Tr[3]); o0.z = cvtpk(Tr[4], Tr[5]); o0.w = cvtpk(Tr[6], Tr[7]);
        o1.x = cvtpk(Tr[8], Tr[9]); o1.y = cvtpk(Tr[10], Tr[11]); o1.z = cvtpk(Tr[12], Tr[13]); o1.w = cvtpk(Tr[14], Tr[15]);
        LDS_WAIT();
        *(LAS u32x4*)(lds + BUF(0) + swo(s, 16 * blk)) = o0; *(LAS u32x4*)(lds + BUF(0) + swo(s, 16 * blk + 8)) = o1;
#pragma unroll
        for (int t = 0; t < 16; ++t) st1(lds, BUF(1), 16 * blk + t, s, Tr[t]);
    }
    lds_barrier();
#pragma unroll
    for (int tmi = 0; tmi < 2; ++tmi) {
        const int tm = tm0 + tmi, mb = 16 * tm + 4 * g4, nn = 16 * tn + l15;
        const f32x4 v = mm64(lds, BUF(0), 16 * tm, BUF(11), 16 * tn, lane);
        st4(lds, BUF(12), nn, mb, v);
#pragma unroll
        for (int e = 0; e < 4; ++e) st1(lds, BUF(2), mb + e, nn, v[e]);
    }
    lds_barrier();
#pragma unroll
    for (int tmi = 0; tmi < 2; ++tmi) {
        const int tm = tm0 + tmi, mb = 16 * tm + 4 * g4, nn = 16 * tn + l15;
        const f32x4 v = mm64(lds, BUF(12), 16 * tm, BUF(2), 16 * tn, lane);
        st4(lds, BUF(13), nn, mb, v);
    }
    lds_barrier();
#pragma unroll
    for (int tmi = 0; tmi < 2; ++tmi) {
        const int tm = tm0 + tmi, mb = 16 * tm + 4 * g4, nn = 16 * tn + l15;
        const f32x4 v = mm64(lds, BUF(13), 16 * tm, BUF(1), 16 * tn, lane) + ld4(lds, BUF(1), nn, mb);
        st4(lds, BUF(14), nn, mb, v);
    }
    lds_barrier();
#pragma unroll
    for (int tmi = 0; tmi < 2; ++tmi) {
        const int tm = tm0 + tmi, mb = 16 * tm + 4 * g4, nn = 16 * tn + l15;
        const f32x4 v = mm64(lds, BUF(2), 16 * tm, BUF(14), 16 * tn, lane) + ld4(lds, BUF(14), nn, mb);
        st4(lds, BUF(15), nn, mb, v);
    }
    lds_barrier();
#pragma unroll
    for (int tmi = 0; tmi < 2; ++tmi) {
        const int tm = tm0 + tmi, mb = 16 * tm + 4 * g4, nn = 16 * tn + l15;
        const f32x4 x1 = mm64(lds, BUF(15), 16 * tm, BUF(4), 16 * tn, lane);
        const f32x4 x2 = mm64(lds, BUF(15), 16 * tm, BUF(8), 16 * tn, lane);
        st4(lds, BUF(0), nn, mb, x1); st4(lds, BUF(1), nn, mb, x2);
    }
    lds_barrier();
    {
        bf16_t* QT = (bf16_t*)(F.ws + WS_QT) + (size_t)unit * 4096; bf16_t* WT = (bf16_t*)(F.ws + WS_WT) + (size_t)unit * 4096; bf16_t* MP = (bf16_t*)(F.ws + WS_MP) + USK(unit) * 4096;
#pragma unroll
        for (int tmi = 0; tmi < 2; ++tmi) {
            const int tm = tm0 + tmi, mb = 16 * tm + 4 * g4, nn = 16 * tn + l15;
            { const f32x4 v = mm64(lds, BUF(0), 16 * tm, BUF(9), 16 * tn, lane) + ld4(lds, BUF(3), nn, mb);
              *(u32x2*)(QT + (dir ? 63 - nn : nn) * 64 + mb) = pack4(v); }
            { const f32x4 v = mm64(lds, BUF(1), 16 * tm, BUF(9), 16 * tn, lane) + ld4(lds, BUF(10), nn, mb);
              if (dir) *(u32x2*)(WT + (63 - nn) * 64 + (60 - mb)) = pack4((f32x4){v[3], v[2], v[1], v[0]});
              else *(u32x2*)(WT + nn * 64 + mb) = pack4(v); }
            { const float pcv = *(const volatile LAS float*)(lds + PCOFF + nn * 4);
              f32x4 v = mm64(lds, BUF(0), 16 * tm, BUF(5), 16 * tn, lane);
#pragma unroll
              for (int e = 0; e < 4; ++e) v[e] += (mb + e == nn) ? pcv : 0.f;
              *(u32x2*)(MP + nn * 64 + swap23(mb)) = pack4(v); }
            { const f32x4 v = mm64(lds, BUF(1), 16 * tm, BUF(5), 16 * tn, lane) + ld4(lds, BUF(6), nn, mb);
              st4(lds, BUF(2), nn, mb, v); }
        }
    }
    lds_barrier();
    {
        bf16_t* NBp = (bf16_t*)(F.ws + WS_NB);
#pragma unroll
        for (int tmi = 0; tmi < 2; ++tmi) {
            const int tm = tm0 + tmi, mb = 16 * tm + 4 * g4, ii = 16 * tn + l15;
            const f32x4 v = mm64(lds, BUF(2), 16 * tm, BUF(7), 16 * tn, lane);
            const int jb = mb >> 5, jl = mb & 31, q = jl >> 3, hic = (jl >> 2) & 1, ih = ii >> 5, Lc = (ii & 31) + 32 * hic;
            *(u32x2*)(NBp + (((USK(unit) * 2 + ih) * 2 + jb) * 2 + (q >> 1)) * 512 + Lc * 8 + 4 * (q & 1)) = pack4(v);
        }
    }
    lds_barrier();
}

DI void attn_unit(const Frame& F, const LAS float* rpbl, const int au) {
    const bf16_t* HBp = (const bf16_t*)(F.ws + WS_HB); const bf16_t* VTp = (const bf16_t*)(F.ws + WS_VT); bf16_t* CONCAT = (bf16_t*)(F.ws + WS_CONCAT);
    const int hh = au % AH, r = (au / AH) % ROWS, b = au / (AH * ROWS);
    int rstart = r - KH / 2; rstart = rstart < 0 ? 0 : (rstart > ROWS - KH ? ROWS - KH : rstart);
    const int lane = F.lane, q32 = lane & 31, hi = lane >> 5;
    const float SC = 0.125f * LOG2E;
    const int krow_off = swap23(q32);
    const int cqA = q32, cqB = 32 + q32;
    int csA = cqA - KW / 2; csA = csA < 0 ? 0 : csA; int csB = cqB - KW / 2; csB = csB > GW - KW ? GW - KW : csB;
    const size_t tokA = (size_t)b * S + r * GW + cqA, tokB = tokA + 32;
    bf16x8 qfA[4], qfB[4];
#pragma unroll
    for (int ds = 0; ds < 4; ++ds) { qfA[ds] = *(const bf16x8*)(HBp + tokA * HW + HQ + hh * HD + 16 * ds + 8 * hi); qfB[ds] = *(const bf16x8*)(HBp + tokB * HW + HQ + hh * HD + 16 * ds + 8 * hi); }
    f32x16 oA0, oA1, oB0, oB1;
#pragma unroll
    for (int i = 0; i < 16; ++i) { oA0[i] = 0.f; oA1[i] = 0.f; oB0[i] = 0.f; oB1[i] = 0.f; }
    float mA = -1e30f, lA = 0.f, mB = -1e30f, lB = 0.f;
#pragma unroll 1
    for (int kt = 0; kt < 2 * KH; ++kt) {
        const int kr = rstart + (kt >> 1), ckb = 32 * (kt & 1);
        const size_t ktok = (size_t)b * S + kr * GW + ckb;
        bf16x8 kf[4], vf[2][2];
#pragma unroll
        for (int ds = 0; ds < 4; ++ds) kf[ds] = *(const bf16x8*)(HBp + (ktok + krow_off) * HW + HK + hh * HD + 16 * ds + 8 * hi);
#pragma unroll
        for (int db = 0; db < 2; ++db)
#pragma unroll
            for (int s = 0; s < 2; ++s) vf[db][s] = *(const bf16x8*)(VTp + (size_t)(hh * HD + 32 * db + q32) * T + ktok + 16 * s + 8 * hi);
        const LAS float* rp = rpbl + (hh * (2 * KH - 1) + (kr - r + KH - 1)) * (2 * KW - 1);
#pragma unroll
        for (int qb = 0; qb < 2; ++qb) {
            const int cq = qb ? cqB : cqA, cs = qb ? csB : csA;
            f32x16 st;
#pragma unroll
            for (int i = 0; i < 16; ++i) st[i] = 0.f;
#pragma unroll
            for (int ds = 0; ds < 4; ++ds) st = MFMA32(kf[ds], qb ? qfB[ds] : qfA[ds], st);
            float sl[16]; float tmax = -1e30f;
            float bia[16];
#pragma unroll
            for (int i = 0; i < 16; ++i) {
                const int ck = ckb + 16 * (i >> 3) + 8 * hi + (i & 7);
                int dc = ck - cq; dc = dc < -(KW - 1) ? -(KW - 1) : (dc > KW - 1 ? KW - 1 : dc); dc += KW - 1;
                bia[i] = *(const volatile LAS float*)(rp + dc);
            }
#pragma unroll
            for (int i = 0; i < 16; ++i) {
                const int ck = ckb + 16 * (i >> 3) + 8 * hi + (i & 7);
                const bool inw = (ck >= cs) && (ck < cs + KW);
                const float sv = st[i] * SC + bia[i];
                sl[i] = inw ? sv : -1e30f;
                tmax = fmaxf(tmax, sl[i]);
            }
            tmax = fmaxf(tmax, __shfl_xor(tmax, 32));
            const float mrun = qb ? mB : mA;
            const float mn = fmaxf(mrun, tmax), corr = __builtin_amdgcn_exp2f(mrun - mn);
            float ps = 0.f;
#pragma unroll
            for (int i = 0; i < 16; ++i) { sl[i] = (sl[i] > -1e29f) ? __builtin_amdgcn_exp2f(sl[i] - mn) : 0.f; ps += sl[i]; }
            u32x4 p0, p1;
            p0.x = cvtpk(sl[0], sl[1]); p0.y = cvtpk(sl[2], sl[3]); p0.z = cvtpk(sl[4], sl[5]); p0.w = cvtpk(sl[6], sl[7]);
            p1.x = cvtpk(sl[8], sl[9]); p1.y = cvtpk(sl[10], sl[11]); p1.z = cvtpk(sl[12], sl[13]); p1.w = cvtpk(sl[14], sl[15]);
            const bf16x8 pf0 = __builtin_bit_cast(bf16x8, p0), pf1 = __builtin_bit_cast(bf16x8, p1);
            if (qb == 0) { lA = lA * corr + ps; mA = mn;
#pragma unroll
                for (int i = 0; i < 16; ++i) { oA0[i] *= corr; oA1[i] *= corr; }
                oA0 = MFMA32(vf[0][0], pf0, oA0); oA0 = MFMA32(vf[0][1], pf1, oA0); oA1 = MFMA32(vf[1][0], pf0, oA1); oA1 = MFMA32(vf[1][1], pf1, oA1);
            } else { lB = lB * corr + ps; mB = mn;
#pragma unroll
                for (int i = 0; i < 16; ++i) { oB0[i] *= corr; oB1[i] *= corr; }
                oB0 = MFMA32(vf[0][0], pf0, oB0); oB0 = MFMA32(vf[0][1], pf1, oB0); oB1 = MFMA32(vf[1][0], pf0, oB1); oB1 = MFMA32(vf[1][1], pf1, oB1);
            }
        }
    }
    { const float inv = 1.f / (lA + __shfl_xor(lA, 32)); bf16_t* op = CONCAT + tokA * D + hh * HD;
#pragma unroll
      for (int g = 0; g < 4; ++g) {
          *(u32x2*)(op + 8 * g + 4 * hi) = pack4((f32x4){oA0[4 * g] * inv, oA0[4 * g + 1] * inv, oA0[4 * g + 2] * inv, oA0[4 * g + 3] * inv});
          *(u32x2*)(op + 32 + 8 * g + 4 * hi) = pack4((f32x4){oA1[4 * g] * inv, oA1[4 * g + 1] * inv, oA1[4 * g + 2] * inv, oA1[4 * g + 3] * inv}); } }
    { const float inv = 1.f / (lB + __shfl_xor(lB, 32)); bf16_t* op = CONCAT + tokB * D + hh * HD;
#pragma unroll
      for (int g = 0; g < 4; ++g) {
          *(u32x2*)(op + 8 * g + 4 * hi) = pack4((f32x4){oB0[4 * g] * inv, oB0[4 * g + 1] * inv, oB0[4 * g + 2] * inv, oB0[4 * g + 3] * inv});
          *(u32x2*)(op + 32 + 8 * g + 4 * hi) = pack4((f32x4){oB1[4 * g] * inv, oB1[4 * g + 1] * inv, oB1[4 * g + 2] * inv, oB1[4 * g + 3] * inv}); } }
}

DI void pool_unit(const Frame& F, const float* pool_w, const float* pool_scale, const int pu) {
    const bf16_t* HBp = (const bf16_t*)(F.ws + WS_HB); bf16_t* CONCAT = (bf16_t*)(F.ws + WS_CONCAT);
    const int g = pu & 3, blk = pu >> 2, b = blk >> 8, t0 = (blk & 255) * 32;
    const int lane = F.lane, q32 = lane & 31, hi = lane >> 5, t = t0 + q32, win = 2 << g;
    int lo = t - win / 2; lo = lo < 0 ? 0 : lo; int hit = t + win / 2 - 1; hit = hit > S - 1 ? S - 1 : hit;
    const float inv = 1.f / (float)(hit - lo + 1);
    f32x16 out0, out1;
#pragma unroll
    for (int i = 0; i < 16; ++i) { out0[i] = 0.f; out1[i] = 0.f; }
    const float* pw = pool_w + (size_t)g * 64 * 64;
#pragma unroll 1
    for (int s = 0; s < 4; ++s) {
        const int c0 = HP + g * 64 + 16 * s + 8 * hi;
        float acc[8];
#pragma unroll
        for (int e = 0; e < 8; ++e) acc[e] = 0.f;
        u32x4 pv[16];
#pragma unroll
        for (int d = 0; d < 16; ++d) { int tt = t - win / 2 + d; const bool ok = d < win && tt >= 0 && tt < S; tt = ok ? tt : t;
            pv[d] = *(const u32x4*)(HBp + ((size_t)b * S + tt) * HW + c0); if (!ok) pv[d] = (u32x4){0u, 0u, 0u, 0u}; }
#pragma unroll
        for (int d = 0; d < 16; ++d) {
            acc[0] += bflo(pv[d].x); acc[1] += bfhi(pv[d].x); acc[2] += bflo(pv[d].y); acc[3] += bfhi(pv[d].y); acc[4] += bflo(pv[d].z); acc[5] += bfhi(pv[d].z); acc[6] += bflo(pv[d].w); acc[7] += bfhi(pv[d].w);
        }
        const u32x4 pc = *(const u32x4*)(HBp + ((size_t)b * S + t) * HW + c0);
        u32x4 o;
        o.x = cvtpk(acc[0] * inv - bflo(pc.x), acc[1] * inv - bfhi(pc.x)); o.y = cvtpk(acc[2] * inv - bflo(pc.y), acc[3] * inv - bfhi(pc.y));
        o.z = cvtpk(acc[4] * inv - bflo(pc.z), acc[5] * inv - bfhi(pc.z)); o.w = cvtpk(acc[6] * inv - bflo(pc.w), acc[7] * inv - bfhi(pc.w));
        const bf16x8 bfr = __builtin_bit_cast(bf16x8, o);
        const float* wp = pw + (size_t)(16 * s + 8 * hi) * 64 + q32;
        u32x4 w0; w0.x = cvtpk(wp[0], wp[64]); w0.y = cvtpk(wp[128], wp[192]); w0.z = cvtpk(wp[256], wp[320]); w0.w = cvtpk(wp[384], wp[448]);
        u32x4 w1; w1.x = cvtpk(wp[32], wp[96]); w1.y = cvtpk(wp[160], wp[224]); w1.z = cvtpk(wp[288], wp[352]); w1.w = cvtpk(wp[416], wp[480]);
        out0 = MFMA32(__builtin_bit_cast(bf16x8, w0), bfr, out0);
        out1 = MFMA32(__builtin_bit_cast(bf16x8, w1), bfr, out1);
    }
    bf16_t* op = CONCAT + ((size_t)b * S + t) * D + AW + BW + g * 64;
    const float* ps = pool_scale + g * 64;
#pragma unroll
    for (int gq = 0; gq < 4; ++gq) {
        const int e0 = 8 * gq + 4 * hi;
        const f32x4 s0 = *(const f32x4*)(ps + e0), s1 = *(const f32x4*)(ps + 32 + e0);
        *(u32x2*)(op + e0) = pack4((f32x4){out0[4 * gq] * s0[0], out0[4 * gq + 1] * s0[1], out0[4 * gq + 2] * s0[2], out0[4 * gq + 3] * s0[3]});
        *(u32x2*)(op + 32 + e0) = pack4((f32x4){out1[4 * gq] * s1[0], out1[4 * gq + 1] * s1[1], out1[4 * gq + 2] * s1[2], out1[4 * gq + 3] * s1[3]});
    }
}

constexpr int SCAN_SLOT = 12288, SCAN_RING = 12;
constexpr int SCAN_FLAGS = SCAN_RING * SCAN_SLOT;
DI void scan_issue(const Frame& F, const int sc, const int ihalf, const int dir, const int step, const int lane) {
    const int c = dir ? NCH - 1 - step : step; const size_t unit = (size_t)sc * NCH + c;
    const int il = lane & 31, hi = lane >> 5;
    LAS unsigned char* slot = F.lds + (step % SCAN_RING) * SCAN_SLOT;
    const bf16_t* MP = (const bf16_t*)(F.ws + WS_MP) + USK(unit) * 4096; const bf16_t* NBp = (const bf16_t*)(F.ws + WS_NB) + (USK(unit) * 2 + ihalf) * 2048;
#pragma unroll
    for (int p = 0; p < 8; ++p) { const int jpb = p >> 2, jb = (p >> 1) & 1, s = p & 1;
        __builtin_amdgcn_global_load_lds((const unsigned*)(MP + (32 * jpb + il) * 64 + 32 * jb + 16 * s + 8 * hi), (LAS unsigned*)(slot + p * 1024), 16, 0, 0); }
#pragma unroll
    for (int p = 0; p < 4; ++p)
        __builtin_amdgcn_global_load_lds((const unsigned*)(NBp + p * 512 + lane * 8), (LAS unsigned*)(slot + 8192 + p * 1024), 16, 0, 0);
}
DI unsigned lds_ld_u32(const volatile LAS unsigned* p) { return __builtin_amdgcn_readfirstlane(*p); }
DI void scan_loader(const Frame& F, const int sw, const int ld) {
    const int ihalf = sw & 1, sc = sw >> 1, dir = sc / (NB * BH);
    volatile LAS unsigned* ready = (volatile LAS unsigned*)(F.lds + SCAN_FLAGS); volatile LAS unsigned* cons = ready + 16;
    const int nmine = NCH / 2;
    for (int k = 0; k < nmine + 5; ++k) {
        if (k < nmine) {
            const int s = 2 * k + ld;
            if (s >= SCAN_RING) { unsigned spins = 0; while ((int)lds_ld_u32(cons) < s - SCAN_RING + 1) { __builtin_amdgcn_s_sleep(1); if (++spins > (1u << 22)) break; } }
            asm volatile("" ::: "memory");
            scan_issue(F, sc, ihalf, dir, s, F.lane);
        }
        if (k >= 4) {
            const int kd = k - 4;
            if (kd < nmine) {
                const int rem = nmine - 1 - kd;
                if (rem >= 4) asm volatile("s_waitcnt vmcnt(48)" ::: "memory");
                else if (rem == 3) asm volatile("s_waitcnt vmcnt(36)" ::: "memory");
                else if (rem == 2) asm volatile("s_waitcnt vmcnt(24)" ::: "memory");
                else if (rem == 1) asm volatile("s_waitcnt vmcnt(12)" ::: "memory");
                else asm volatile("s_waitcnt vmcnt(0)" ::: "memory");
                const int sd = 2 * kd + ld;
                if (F.lane == 0) ready[sd % SCAN_RING] = (unsigned)(sd + 1);
                asm volatile("s_waitcnt lgkmcnt(0)" ::: "memory");
            }
        }
    }
}
constexpr int S0_STAGE = SCAN_FLAGS + 256;
DI void scan_writer(const Frame& F, const int sw) {
    const int ihalf = sw & 1, sc = sw >> 1, dir = sc / (NB * BH);
    volatile LAS unsigned* ready = (volatile LAS unsigned*)(F.lds + SCAN_FLAGS);
    volatile LAS unsigned* s0rdy = ready + 17; volatile LAS unsigned* s0done = ready + 18;
    bf16_t* S0 = (bf16_t*)(F.ws + WS_S0);
    const int lane = F.lane;
#pragma unroll 1
    for (int step = 0; step < NCH; ++step) {
        const int c = dir ? NCH - 1 - step : step; const size_t unit = (size_t)sc * NCH + c;
        { unsigned spins = 0; while ((int)lds_ld_u32(s0rdy) < step + 1) { __builtin_amdgcn_s_sleep(1); if (++spins > (1u << 22)) break; } }
        asm volatile("" ::: "memory");
        const LAS unsigned char* sl = F.lds + S0_STAGE + (step & 1) * (32 * 144);
        u32x4 v[4];
#pragma unroll
        for (int p = 0; p < 4; ++p) { const int idx = p * 64 + lane; v[p] = *(const LAS u32x4*)(sl + (idx >> 3) * 144 + (idx & 7) * 16); }
        asm volatile("s_waitcnt lgkmcnt(0)" ::: "memory");
        if (lane == 0) *s0done = (unsigned)(step + 1);
        bf16_t* dst = S0 + USK(unit) * 4096 + ihalf * 2048;
#pragma unroll
        for (int p = 0; p < 4; ++p) *(u32x4*)(dst + (p * 64 + lane) * 8) = v[p];
    }
}
DI void scan_wave(const Frame& F, const int sw) {
    const int ihalf = sw & 1, sc = sw >> 1, dir = sc / (NB * BH);
    const int lane = F.lane, il = lane & 31, hi = lane >> 5;
    bf16_t* S0 = (bf16_t*)(F.ws + WS_S0);
    volatile LAS unsigned* ready = (volatile LAS unsigned*)(F.lds + SCAN_FLAGS); volatile LAS unsigned* cons = ready + 16;
    volatile LAS unsigned* s0rdy = ready + 17; volatile LAS unsigned* s0done = ready + 18; (void)s0rdy; (void)s0done;
    f32x16 st0, st1;
#pragma unroll
    for (int i = 0; i < 16; ++i) { st0[i] = 0.f; st1[i] = 0.f; }
    bf16x8 ma[8], man[8]; u32x4 nbv[4], nbn[4];
    { unsigned spins = 0; while (lds_ld_u32(ready) != 1u) { __builtin_amdgcn_s_sleep(1); if (++spins > (1u << 22)) break; } }
    asm volatile("" ::: "memory");
#pragma unroll
    for (int p = 0; p < 8; ++p) ma[p] = *(const LAS bf16x8*)(F.lds + p * 1024 + lane * 16);
#pragma unroll
    for (int p = 0; p < 4; ++p) nbv[p] = *(const LAS u32x4*)(F.lds + 8192 + p * 1024 + lane * 16);
#pragma unroll 1
    for (int step = 0; step < NCH; ++step) {
        const int c = dir ? NCH - 1 - step : step; const size_t unit = (size_t)sc * NCH + c;
        const bool more = step + 1 < NCH;
#ifdef S0_WRITER
        if (step >= 2) { unsigned spins = 0; while ((int)lds_ld_u32(s0done) < step - 1) { __builtin_amdgcn_s_sleep(1); if (++spins > (1u << 22)) break; } }
        asm volatile("" ::: "memory");
#endif
        if (more) {
            { unsigned spins = 0; while (lds_ld_u32(ready + ((step + 1) % SCAN_RING)) != (unsigned)(step + 2)) { __builtin_amdgcn_s_sleep(1); if (++spins > (1u << 22)) break; } }
            asm volatile("" ::: "memory");

            const LAS unsigned char* slot = F.lds + ((step + 1) % SCAN_RING) * SCAN_SLOT;
#pragma unroll
            for (int p = 0; p < 8; ++p) man[p] = *(const LAS bf16x8*)(slot + p * 1024 + lane * 16);
#pragma unroll
            for (int p = 0; p < 4; ++p) nbn[p] = *(const LAS u32x4*)(slot + 8192 + p * 1024 + lane * 16);
        }
        bf16_t* sp = S0 + USK(unit) * 4096 + (size_t)(32 * ihalf + il) * 64;
        u32x4 b00, b01, b10, b11;
        b00.x = cvtpk(st0[0], st0[1]); b00.y = cvtpk(st0[2], st0[3]); b00.z = cvtpk(st0[4], st0[5]); b00.w = cvtpk(st0[6], st0[7]);
        b01.x = cvtpk(st0[8], st0[9]); b01.y = cvtpk(st0[10], st0[11]); b01.z = cvtpk(st0[12], st0[13]); b01.w = cvtpk(st0[14], st0[15]);
        b10.x = cvtpk(st1[0], st1[1]); b10.y = cvtpk(st1[2], st1[3]); b10.z = cvtpk(st1[4], st1[5]); b10.w = cvtpk(st1[6], st1[7]);
        b11.x = cvtpk(st1[8], st1[9]); b11.y = cvtpk(st1[10], st1[11]); b11.z = cvtpk(st1[12], st1[13]); b11.w = cvtpk(st1[14], st1[15]);
#ifdef S0_WRITER
        { LAS unsigned char* sl = F.lds + S0_STAGE + (step & 1) * (32 * 144) + il * 144 + 8 * hi;
          {
          *(LAS u32x2*)(sl + 0) = (u32x2){b00.x, b00.y};  *(LAS u32x2*)(sl + 16) = (u32x2){b00.z, b00.w};
          *(LAS u32x2*)(sl + 32) = (u32x2){b01.x, b01.y}; *(LAS u32x2*)(sl + 48) = (u32x2){b01.z, b01.w};
          *(LAS u32x2*)(sl + 64) = (u32x2){b10.x, b10.y}; *(LAS u32x2*)(sl + 80) = (u32x2){b10.z, b10.w};
          *(LAS u32x2*)(sl + 96) = (u32x2){b11.x, b11.y}; *(LAS u32x2*)(sl + 112) = (u32x2){b11.z, b11.w}; }
          asm volatile("" ::: "memory");
          if (lane == 0) *s0rdy = (unsigned)(step + 1); }
        (void)sp;
#else
        *(u32x2*)(sp + 0 + 4 * hi) = (u32x2){b00.x, b00.y};  *(u32x2*)(sp + 8 + 4 * hi) = (u32x2){b00.z, b00.w};
        *(u32x2*)(sp + 16 + 4 * hi) = (u32x2){b01.x, b01.y}; *(u32x2*)(sp + 24 + 4 * hi) = (u32x2){b01.z, b01.w};
        *(u32x2*)(sp + 32 + 4 * hi) = (u32x2){b10.x, b10.y}; *(u32x2*)(sp + 40 + 4 * hi) = (u32x2){b10.z, b10.w};
        *(u32x2*)(sp + 48 + 4 * hi) = (u32x2){b11.x, b11.y}; *(u32x2*)(sp + 56 + 4 * hi) = (u32x2){b11.z, b11.w};
#endif
        const bf16x8 p00 = __builtin_bit_cast(bf16x8, b00), p01 = __builtin_bit_cast(bf16x8, b01), p10 = __builtin_bit_cast(bf16x8, b10), p11 = __builtin_bit_cast(bf16x8, b11);
        f32x16 n0, n1;
#pragma unroll
        for (int h2 = 0; h2 < 2; ++h2) {
            n0[8 * h2 + 0] = bflo(nbv[h2].x); n0[8 * h2 + 1] = bfhi(nbv[h2].x); n0[8 * h2 + 2] = bflo(nbv[h2].y); n0[8 * h2 + 3] = bfhi(nbv[h2].y);
            n0[8 * h2 + 4] = bflo(nbv[h2].z); n0[8 * h2 + 5] = bfhi(nbv[h2].z); n0[8 * h2 + 6] = bflo(nbv[h2].w); n0[8 * h2 + 7] = bfhi(nbv[h2].w);
            n1[8 * h2 + 0] = bflo(nbv[2 + h2].x); n1[8 * h2 + 1] = bfhi(nbv[2 + h2].x); n1[8 * h2 + 2] = bflo(nbv[2 + h2].y); n1[8 * h2 + 3] = bfhi(nbv[2 + h2].y);
            n1[8 * h2 + 4] = bflo(nbv[2 + h2].z); n1[8 * h2 + 5] = bfhi(nbv[2 + h2].z); n1[8 * h2 + 6] = bflo(nbv[2 + h2].w); n1[8 * h2 + 7] = bfhi(nbv[2 + h2].w);
        }
        n0 = MFMA32(ma[0], p00, n0); n1 = MFMA32(ma[4], p00, n1);
        n0 = MFMA32(ma[1], p01, n0); n1 = MFMA32(ma[5], p01, n1);
        n0 = MFMA32(ma[2], p10, n0); n1 = MFMA32(ma[6], p10, n1);
        n0 = MFMA32(ma[3], p11, n0); n1 = MFMA32(ma[7], p11, n1);
        st0 = n0; st1 = n1;
        if (more) {
            asm volatile("s_waitcnt lgkmcnt(0)" ::: "memory");
            if (lane == 0) *cons = (unsigned)(step + 2);
#pragma unroll
            for (int p = 0; p < 8; ++p) ma[p] = man[p];
#pragma unroll
            for (int p = 0; p < 4; ++p) nbv[p] = nbn[p];
        }
    }
}

DI void rwkv_out_unit(const Frame& F, const RwP& P, const int du) {
    const int qd = du & 3, cidx = du >> 2, c = cidx % NCH, hd = (cidx / NCH) % BH, b = cidx / (NCH * BH);
    const int lane = F.lane, n = lane & 15, g = lane >> 4, u = 16 * qd + n;
    const bf16_t* QT = (const bf16_t*)(F.ws + WS_QT); const bf16_t* WT = (const bf16_t*)(F.ws + WS_WT); const bf16_t* S0 = (const bf16_t*)(F.ws + WS_S0);
    const bf16_t* VTB = (const bf16_t*)(F.ws + WS_VTB) + (size_t)cidx * 4096;
    f32x4 acc[4];
#pragma unroll
    for (int tm = 0; tm < 4; ++tm) acc[tm] = (f32x4){0.f, 0.f, 0.f, 0.f};
#pragma unroll
    for (int dir = 0; dir < 2; ++dir) {
        const size_t unit = (((size_t)dir * NB + b) * BH + hd) * NCH + c;
#pragma unroll
        for (int ks = 0; ks < 2; ++ks) {
            const bf16x8 bq = *(const bf16x8*)(QT + unit * 4096 + u * 64 + 32 * ks + 8 * g);
            const bf16x8 bw = *(const bf16x8*)(WT + unit * 4096 + u * 64 + 32 * ks + 8 * g);
#pragma unroll
            for (int tm = 0; tm < 4; ++tm) {
                const bf16x8 as = *(const bf16x8*)(S0 + USK(unit) * 4096 + (16 * tm + n) * 64 + 32 * ks + 8 * g);
                const bf16x8 av = *(const bf16x8*)(VTB + (16 * tm + n) * 64 + 32 * ks + 8 * g);
                acc[tm] = MFMA16(as, bq, acc[tm]); acc[tm] = MFMA16(av, bw, acc[tm]);
            }
        }
    }
    float s = 0.f;
#pragma unroll
    for (int tm = 0; tm < 4; ++tm) s += (acc[tm][0] + acc[tm][1]) + (acc[tm][2] + acc[tm][3]);
    s += __shfl_xor(s, 16); s += __shfl_xor(s, 32);
    const float mu = s * (1.f / HD); float q = 0.f;
#pragma unroll
    for (int tm = 0; tm < 4; ++tm) { acc[tm] = acc[tm] - mu; q += (acc[tm][0] * acc[tm][0] + acc[tm][1] * acc[tm][1]) + (acc[tm][2] * acc[tm][2] + acc[tm][3] * acc[tm][3]); }
    q += __shfl_xor(q, 16); q += __shfl_xor(q, 32);
    const float rstd = 1.f / sqrtf(q * (1.f / HD) + GN_EPS);
    const size_t tok = (size_t)b * S + 64 * c + u;
    const float* BS = (const float*)(F.ws + WS_BS);
    const float bsum = BS[tok * 8 + hd] + BS[((size_t)T + tok) * 8 + hd];
    const bf16_t* VC = (const bf16_t*)(F.ws + WS_VC) + tok * BW + hd * HD; const bf16_t* GBp = (const bf16_t*)(F.ws + WS_GB) + tok * BW + hd * HD;
    bf16_t* op = (bf16_t*)(F.ws + WS_CONCAT) + tok * D + AW + hd * HD;
#pragma unroll
    for (int tm = 0; tm < 4; ++tm) {
        const int i0 = 16 * tm + 4 * g;
        const f32x4 vv = unpack4(*(const u32x2*)(VC + i0)), gg = unpack4(*(const u32x2*)(GBp + i0));
        const f32x4 gn = *(const f32x4*)(P.gn_gain + hd * HD + i0), gb = *(const f32x4*)(P.gn_bias + hd * HD + i0);
        *(u32x2*)(op + i0) = pack4((acc[tm] * rstd * gn + gb + vv * bsum) * gg);
    }
}

DI RwP make_rwp(const Args& a, int l) {
    RwP p;
    p.conv = a.in[6] + (size_t)l * 3 * 3 * BW; p.w0 = a.in[7] + (size_t)l * 2 * BW; p.w_up = a.in[8] + (size_t)l * 2 * RW * BW;
    p.a0 = a.in[9] + (size_t)l * 2 * BW; p.a_up = a.in[10] + (size_t)l * 2 * RA * BW; p.g_up = a.in[11] + (size_t)l * RG * BW;
    p.k_k = a.in[12] + (size_t)l * BW; p.k_a = a.in[13] + (size_t)l * BW; p.r_k = a.in[14] + (size_t)l * BH * HD;
    p.gn_gain = a.in[15] + (size_t)l * BW; p.gn_bias = a.in[16] + (size_t)l * BW;
    return p;
}
DI void p_gemm1(const Frame& F, int l) {
    pg8::Gemm1Order S; S.U = (const bf16_t*)(F.ws + WS_U); S.Win = (const bf16_t*)(F.ws + WS_WIN + (size_t)l * WIN_LAYER); S.Wv = S.Win + (size_t)HW * D; S.G = F.G; S.c = F.bx;
    pg8::EpiStore E{(bf16_t*)(F.ws + WS_HB), HW, (bf16_t*)(F.ws + WS_VT), T};
    pg8::gemm_phase(F.lds, F.tid, D, S, E);
}
DI void p_mixer_local(const Frame& F, const Args& a, int l) {
    {
      const float* conv = a.in[6] + (size_t)l * 3 * 3 * BW;
#pragma unroll 7
      for (int i = F.tid; i < BH * 9 * 64; i += NTHREADS) { const int j = i & 63, q = i >> 6, which = q % 3, x = (q / 3) % 3, hd = q / 9;
          *(LAS bf16_t*)(F.lds + CWLOFF + i * 2) = f2bf(conv[x * 3 * BW + which * BW + hd * HD + j]); }
      RwPre PF;
      if (F.bx < NUNIT) rwkv_prefetch(F, a, l, F.bx, PF);
      __syncthreads();
      for (int unit = F.bx; unit < NUNIT; unit += F.G) rwkv_local_unit(F, a, l, unit, PF, unit + F.G < NUNIT ? unit + F.G : -1);
    }
}
DI void p_scan(const Frame& F, const Args& a, int l) {
#ifndef CVW
#define CVW 3
#endif
    constexpr int NSCAN = 2 * 2 * NB * BH;
    const int NATTW = (F.G - NSCAN) * (NWAVES - CVW);
    if (F.bx < NSCAN) {
        volatile LAS unsigned* fl = (volatile LAS unsigned*)(F.lds + SCAN_FLAGS);
        if (F.tid < 32) fl[F.tid] = 0u;
        __syncthreads();
#ifdef S0_WRITER
        if (F.wave == 0) scan_wave(F, F.bx); else if (F.wave <= 2) scan_loader(F, F.bx, F.wave - 1); else if (F.wave == 3) scan_writer(F, F.bx);
#else
        if (F.wave == 0) scan_wave(F, F.bx); else if (F.wave <= 2) scan_loader(F, F.bx, F.wave - 1);
#endif
#ifdef DBL_SCAN
        __syncthreads();
        if (F.tid < 32) fl[F.tid] = 0u;
        __syncthreads();
        if (F.wave == 0) scan_wave(F, F.bx); else if (F.wave <= 2) scan_loader(F, F.bx, F.wave - 1);
#endif
        return;
    }
    LAS float* rpbl = (LAS float*)(F.lds + CVW * 64 * 65 * 4);
    { const float* rpb = a.in[5] + (size_t)l * AH * (2 * KH - 1) * (2 * KW - 1);
#pragma unroll 6
      for (int i = F.tid; i < AH * (2 * KH - 1) * (2 * KW - 1); i += NTHREADS) rpbl[i] = rpb[i] * LOG2E; }
    __syncthreads();
    if (F.wave < CVW) {
        LAS float* scr = (LAS float*)F.lds + F.wave * (64 * 65);
        f32x4 cur[16], nxt[16]; const int st = (F.G - NSCAN) * CVW; int it = (F.bx - NSCAN) * CVW + F.wave; TItem tc{}, tn{};
        if (it < IT_MOE) { tc = moe_item(F, a.in[28], a.in[29], a.in[30], l, it); titem_load(tc, cur, F.lane); }
#ifdef DBL_CONV
        for (int rep = 0; rep < 2; ++rep) { it = (F.bx - NSCAN) * CVW + F.wave; if (it < IT_MOE) { tc = moe_item(F, a.in[28], a.in[29], a.in[30], l, it); titem_load(tc, cur, F.lane); }
#endif
        for (; it < IT_MOE; it += st) {
            const bool more = it + st < IT_MOE;
#ifdef CONV_SINGLE
            titem_store(tc, cur, scr, F.lane);
            if (more) { tc = moe_item(F, a.in[28], a.in[29], a.in[30], l, it + st); titem_load(tc, cur, F.lane); }
            continue;
#endif
            if (more) { tn = moe_item(F, a.in[28], a.in[29], a.in[30], l, it + st); titem_load(tn, nxt, F.lane); }
            titem_store(tc, cur, scr, F.lane);
            if (more) { tc = tn;
#pragma unroll
                for (int i = 0; i < 16; ++i) cur[i] = nxt[i]; }
        }
#ifdef DBL_CONV
        }
#endif
    } else {
        const int aw = (F.bx - NSCAN) * (NWAVES - CVW) + (F.wave - CVW), naw = NATTW;
#ifdef ATT_XCD
        if (F.G == 256) {
            constexpr int NW5 = NWAVES - CVW, NBX = (256 - NSCAN) / 8, NWX = NBX * NW5, UPX = NB * ROWS * AH / 8, REM = UPX - NWX, PER = (REM + NBX - 1) / NBX;
            const int x = F.bx & 7, k = (F.bx - NSCAN) >> 3, w5 = F.wave - CVW;
            { const int v = (x & 3) * UPX + k * NW5 + w5; attn_unit(F, rpbl, (((x >> 2) * ROWS) + (v & (ROWS - 1))) * AH + (v >> 7)); }
            if (w5 < PER && k * PER + w5 < REM) { const int v = (x & 3) * UPX + NWX + k * PER + w5; attn_unit(F, rpbl, (((x >> 2) * ROWS) + (v & (ROWS - 1))) * AH + (v >> 7)); }
        } else
#endif
        for (int au = aw; au < NB * ROWS * AH; au += naw) attn_unit(F, rpbl, au);
#ifdef DBL_ATTN
        for (int au = aw; au < NB * ROWS * AH; au += naw) attn_unit(F, rpbl, au);
#endif
        for (int pu = aw; pu < NB * (S / 32) * 4; pu += naw) pool_unit(F, a.in[17] + (size_t)l * NG * 64 * 64, a.in[18] + (size_t)l * CW, pu);
    }
}
DI void p_rwkv_out(const Frame& F, const Args& a, int l) {
    const RwP P = make_rwp(a, l);
    for (int du = F.gw; du < NB * BH * NCH * 4; du += F.ngw) rwkv_out_unit(F, P, du);
}
DI void p_gemm2(const Frame& F, int l) {
    pg8::PlainOrder S; S.init((const bf16_t*)(F.ws + WS_CONCAT), (const bf16_t*)(F.ws + WS_WOUT) + (size_t)l * D * D, T, D, D, F.G, F.bx);
    pg8::EpiStore E{(bf16_t*)(F.ws + WS_MIX), D, nullptr, 0};
    pg8::gemm_phase(F.lds, F.tid, D, S, E);
}
DI void p_moe_a(const Frame& F, int l) {
    LAS int* tb = (LAS int*)(F.lds + LDS_MISC);
    build_tables(F, l, tb);
    pg8::GroupedOrderT<true> S; S.rowtok = (const int*)(F.ws + WS_CTL + WS_SLOTTOK); S.A = (const bf16_t*)(F.ws + WS_U); S.Bt = (const bf16_t*)(F.ws + WS_WGU); S.K = D; S.estride = (size_t)D * D; S.tile_e = tb + 66; S.ntiles = tb[65]; S.nwg = S.ntiles * 4; S.G = F.G; S.c = F.bx;
    pg8::EpiSwiGlu E{(bf16_t*)(F.ws + WS_HM)};
    pg8::gemm_phase(F.lds, F.tid, D, S, E);
}
DI void p_moe_b(const Frame& F, int l) {
    LAS int* tb = (LAS int*)(F.lds + LDS_MISC);
    build_tables(F, l, tb);
    pg8::GroupedOrderT<false> S; S.rowtok = nullptr; S.A = (const bf16_t*)(F.ws + WS_HM); S.Bt = (const bf16_t*)(F.ws + WS_WD); S.K = DE; S.estride = (size_t)D * DE; S.tile_e = tb + 66; S.ntiles = tb[65]; S.nwg = S.ntiles * 4; S.G = F.G; S.c = F.bx;
    pg8::EpiRowScale E{(bf16_t*)(F.ws + WS_YS), (const float*)(F.ws + WS_SLOTW)};
    pg8::gemm_phase(F.lds, F.tid, DE, S, E);
}

#ifndef DBLMASK
#define DBLMASK 0
#endif
constexpr int PH_PER_LAYER = 10, N_PHASES = 2 + L * PH_PER_LAYER;
DI bool in_ph(int k, int lo, int hi) { lo = __builtin_amdgcn_readfirstlane(lo); hi = __builtin_amdgcn_readfirstlane(hi); asm volatile("" : "+s"(lo), "+s"(hi)); return lo <= k && k < hi; }
DI Frame fresh(const Frame& F0) {
    Frame F = F0; int t = F0.tid, b = F0.bx;
    b = __builtin_amdgcn_readfirstlane(b); asm volatile("" : "+v"(t)); asm volatile("" : "+s"(b));
    F.tid = t; F.lane = t & 63; F.wave = __builtin_amdgcn_readfirstlane(t >> 6); F.bx = b;
    F.vcu = (F.G % 8 == 0) ? (b % 8) * (F.G / 8) + b / 8 : b; F.gw = F.vcu * NWAVES + F.wave;
    return F;
}

__global__ void __launch_bounds__(NTHREADS, 2) mk_fwd(Args a) {
    extern __shared__ __attribute__((aligned(16))) unsigned char lds_raw[];
    Frame F;
    F.lds = (LAS unsigned char*)lds_raw;
    F.tid = threadIdx.x; F.lane = F.tid & 63; F.wave = __builtin_amdgcn_readfirstlane(F.tid >> 6);
    F.G = gridDim.x; F.bx = blockIdx.x; { const int bx = blockIdx.x; F.vcu = (F.G % 8 == 0) ? (bx % 8) * (F.G / 8) + bx / 8 : bx; }
    F.gw = F.vcu * NWAVES + F.wave; F.ngw = F.G * NWAVES; F.ws = a.ws;
    volatile LAS unsigned* bst = (volatile LAS unsigned*)(F.lds + LDS_BARST);
    if (F.tid < 16) bst[F.tid] = 0u;
    __syncthreads();
    cg::grid_group grid = cg::this_grid();
    XcdBarrier bar; bar.bar = (unsigned*)(a.ws + WS_CTL) + CW_BAR; bar.x = 0; bar.st = bst;
    const bool multi = (a.ph_hi - a.ph_lo) > 1;
    if (multi && !a.use_cg) bar = xcd_barrier_post((unsigned*)(a.ws + WS_CTL) + CW_BAR, bst);
    const int lo = a.ph_lo, hi = a.ph_hi;
#define IN(k) in_ph((k), lo, hi)
#ifndef DBLSEAM
#define DBLSEAM 0
#endif
#define SEAM(k) do { if (IN(k) && IN((k) + 1)) { if (a.use_cg) grid.sync(); else { xcd_barrier(bar); if (DBLSEAM) xcd_barrier(bar); } } } while (0)
    if (IN(0)) { p0_prologue(fresh(F), a); if ((DBLMASK >> 11) & 1) p0_prologue(fresh(F), a); }
    SEAM(0);
    if (IN(1)) { p_r0(fresh(F), a.in[0]); if ((DBLMASK >> 12) & 1) p_r0(fresh(F), a.in[0]); }
    SEAM(1);
#define RUN(k, call) do { if (IN(pb + (k))) { call; if ((DBLMASK >> (k)) & 1) { call; } } } while (0)
#define LAYER(l) do { \
        const int pb = 2 + PH_PER_LAYER * (l); \
        RUN(0, p_gemm1(fresh(F), (l))); \
        SEAM(pb + 0); \
        RUN(1, p_mixer_local(fresh(F), a, (l))); \
        SEAM(pb + 1); \
        RUN(2, p_scan(fresh(F), a, (l))); \
        SEAM(pb + 2); \
        RUN(3, p_rwkv_out(fresh(F), a, (l))); \
        SEAM(pb + 3); \
        RUN(4, p_gemm2(fresh(F), (l))); \
        SEAM(pb + 4); \
        RUN(5, p_rowpass1(fresh(F), a, (l), (l) == 0 ? a.in[0] : a.out)); \
        if (IN(pb + 5) && ((DBLMASK >> 10) & 1)) p_rowpass1(fresh(F), a, (l), (l) == 0 ? a.in[0] : a.out, true); \
        SEAM(pb + 5); \
        RUN(6, p_gather(fresh(F), (l))); \
        SEAM(pb + 6); \
        RUN(7, p_moe_a(fresh(F), (l))); \
        SEAM(pb + 7); \
        RUN(8, p_moe_b(fresh(F), (l))); \
        SEAM(pb + 8); \
        RUN(9, p_rowpass2(fresh(F), a, (l), a.out)); \
        SEAM(pb + 9); \
    } while (0)
    LAYER(0);
    LAYER(1);
#undef LAYER
#undef IN
#undef SEAM
}

#ifndef MK_MODE
#define MK_MODE 0
#endif
#ifndef TESTMODE
#define TESTMODE 0
#endif

static void fill_args(Args& a, void* const* d_in, void* d_out, void* d_ws) {
    for (int i = 0; i < 31; ++i) a.in[i] = (const float*)d_in[i];
    a.out = (float*)d_out; a.ws = (unsigned char*)d_ws; a.ph_lo = 0; a.ph_hi = N_PHASES; a.use_cg = 0; a.pad = 0;
}
static void launch_phases(Args a, int lo, int hi, hipStream_t stream) {
    for (int p = lo; p < hi; ++p) { a.ph_lo = p; a.ph_hi = p + 1; hipLaunchKernelGGL(mk_fwd, dim3(256), dim3(NTHREADS), LDS_BYTES, stream, a); }
}

#if TESTMODE == 0
extern "C" void kernel_launch(void* const* d_in, const int* in_sizes, int n_in, void* d_out, int out_size, void* d_ws, size_t ws_size, hipStream_t stream) {
    static int grid = 0;
    if (grid == 0) {
        int dev = 0, cus = 0, per_cu = 0;
        (void)hipGetDevice(&dev); (void)hipDeviceGetAttribute(&cus, hipDeviceAttributeMultiprocessorCount, dev);
        (void)hipFuncSetAttribute((const void*)mk_fwd, hipFuncAttributeMaxDynamicSharedMemorySize, LDS_BYTES);
        (void)hipOccupancyMaxActiveBlocksPerMultiprocessor(&per_cu, (const void*)mk_fwd, NTHREADS, LDS_BYTES);
        (void)hipGetLastError();
        grid = (cus > 0 ? cus : 256) * 1;
        if (ws_size < WS_END || n_in != 31) grid = -1;
    }
    if (grid < 0) return;
    (void)hipMemsetAsync((char*)d_ws + WS_CTL, 0, CTL_BYTES, stream);
    Args a{}; fill_args(a, d_in, d_out, d_ws);
#if MK_MODE == 2
    launch_phases(a, 0, N_PHASES, stream);
#else
    a.use_cg = (MK_MODE == 1) ? 1 : 0;
    void* args[] = {&a};
    (void)hipLaunchCooperativeKernel((const void*)mk_fwd, dim3(grid), dim3(NTHREADS), args, LDS_BYTES, stream);
#endif
}
#endif

#if TESTMODE > 0
constexpr int O_A = 1152, O_B = 2304, O_W = 2336, O_AL = 2368, O_G = 2432;
struct HSrc { const bf16_t* HB; const bf16_t* VT;
    DI float at(size_t tok, int n) const { if (n < 768) return bf2f(HB[tok * HW + n]); if (n < 1152) return bf2f(VT[(size_t)(n - 768) * T + tok]); return bf2f(HB[tok * HW + n - 384]); } };
DI float sigm_n(float x) { return 1.f / (1.f + expf(-x)); }

__global__ void k_mod_n(const float* __restrict__ c, const float* __restrict__ w_mod, const float* __restrict__ b_mod, float* __restrict__ mod) {
    __shared__ float sc[NB * D];
    for (int i = threadIdx.x; i < NB * D; i += blockDim.x) { float v = c[i]; sc[i] = v * sigm_n(v); }
    __syncthreads();
    int idx = blockIdx.x * blockDim.x + threadIdx.x; int l = idx / MODW, n = idx % MODW;
    const float* w = w_mod + (size_t)l * D * MODW + n; float a0 = 0.f, a1 = 0.f;
    for (int k = 0; k < D; ++k) { float wv = w[(size_t)k * MODW]; a0 += sc[k] * wv; a1 += sc[D + k] * wv; }
    float bb = b_mod[l * MODW + n];
    mod[(size_t)(l * NB + 0) * MODW + n] = a0 + bb; mod[(size_t)(l * NB + 1) * MODW + n] = a1 + bb;
}
__global__ void k_ln_mod_n(const float* __restrict__ xin, const float* __restrict__ modl, int off_sh, int off_sc, float* __restrict__ uout) {
    int row = (blockIdx.x * blockDim.x + threadIdx.x) >> 6, lane = threadIdx.x & 63; if (row >= T) return; int b = row / S;
    f32x4 v[4];
#pragma unroll
    for (int j = 0; j < 4; ++j) v[j] = *(const f32x4*)(xin + (size_t)row * D + 4 * lane + 256 * j);
    float mean, rstd; row_ln(v, mean, rstd);
    const float* md = modl + (size_t)b * MODW;
#pragma unroll
    for (int j = 0; j < 4; ++j) { int col = 4 * lane + 256 * j; *(f32x4*)(uout + (size_t)row * D + col) = v[j] * rstd * (1.f + *(const f32x4*)(md + off_sc + col)) + *(const f32x4*)(md + off_sh + col); }
}
__global__ void k_post_n(const float* xin, const float* br, const float* __restrict__ modl, int off_gate, const float* __restrict__ gain, const float* __restrict__ bias, float* xout, float* u2out, int off_sh2, int off_sc2) {
    int row = (blockIdx.x * blockDim.x + threadIdx.x) >> 6, lane = threadIdx.x & 63; if (row >= T) return; int b = row / S;
    const float* md = modl + (size_t)b * MODW; f32x4 v[4];
#pragma unroll
    for (int j = 0; j < 4; ++j) { int col = 4 * lane + 256 * j; v[j] = *(const f32x4*)(xin + (size_t)row * D + col) * ALPHA + *(const f32x4*)(md + off_gate + col) * *(const f32x4*)(br + (size_t)row * D + col); }
    float mean, rstd; row_ln(v, mean, rstd);
#pragma unroll
    for (int j = 0; j < 4; ++j) { int col = 4 * lane + 256 * j; v[j] = v[j] * rstd * *(const f32x4*)(gain + col) + *(const f32x4*)(bias + col); *(f32x4*)(xout + (size_t)row * D + col) = v[j]; }
    if (u2out == nullptr) return;
    row_ln(v, mean, rstd);
#pragma unroll
    for (int j = 0; j < 4; ++j) { int col = 4 * lane + 256 * j; *(f32x4*)(u2out + (size_t)row * D + col) = v[j] * rstd * (1.f + *(const f32x4*)(md + off_sc2 + col)) + *(const f32x4*)(md + off_sh2 + col); }
}
__global__ void __launch_bounds__(256) k_gemm_f32(const float* __restrict__ A, int lda, const float* __restrict__ B, int ldb, float* __restrict__ C, int ldc, int K) {
    __shared__ float As[16][65]; __shared__ float Bs[16][64];
    const int tx = threadIdx.x & 15, ty = threadIdx.x >> 4; const int m0 = blockIdx.y * 64, n0 = blockIdx.x * 64;
    float acc[4][4];
#pragma unroll
    for (int i = 0; i < 4; ++i)
#pragma unroll
        for (int j = 0; j < 4; ++j) acc[i][j] = 0.f;
    for (int k0 = 0; k0 < K; k0 += 16) {
#pragma unroll
        for (int i = 0; i < 4; ++i) { int e = threadIdx.x + 256 * i; int m = e >> 4, k = e & 15; As[k][m] = A[(size_t)(m0 + m) * lda + k0 + k]; }
#pragma unroll
        for (int i = 0; i < 4; ++i) { int e = threadIdx.x + 256 * i; int k = e >> 6, n = e & 63; Bs[k][n] = B[(size_t)(k0 + k) * ldb + n0 + n]; }
        __syncthreads();
#pragma unroll
        for (int k = 0; k < 16; ++k) { float a[4], b[4];
#pragma unroll
            for (int i = 0; i < 4; ++i) { a[i] = As[k][ty * 4 + i]; b[i] = Bs[k][tx * 4 + i]; }
#pragma unroll
            for (int i = 0; i < 4; ++i)
#pragma unroll
                for (int j = 0; j < 4; ++j) acc[i][j] += a[i] * b[j]; }
        __syncthreads();
    }
#pragma unroll
    for (int i = 0; i < 4; ++i) *(float4*)(C + (size_t)(m0 + ty * 4 + i) * ldc + n0 + tx * 4) = make_float4(acc[i][0], acc[i][1], acc[i][2], acc[i][3]);
}
__global__ void __launch_bounds__(64) k_attn_n(HSrc h, const float* __restrict__ rpb, float* __restrict__ concat) {
    int idx = blockIdx.x * blockDim.x + threadIdx.x; if (idx >= T * AH) return;
    int head = idx % AH, tok = idx / AH; int b = tok / S, t = tok % S, r = t / GW, cq = t % GW;
    int rstart = r - KH / 2; rstart = rstart < 0 ? 0 : (rstart > ROWS - KH ? ROWS - KH : rstart);
    int cstart = cq - KW / 2; cstart = cstart < 0 ? 0 : (cstart > GW - KW ? GW - KW : cstart);
    float q[HD], acc[HD];
#pragma unroll
    for (int d = 0; d < HD; ++d) { q[d] = h.at(tok, head * HD + d); acc[d] = 0.f; }
    float m = -1e30f, l = 0.f; const float* rp = rpb + (size_t)head * 15 * 31;
    for (int kk = 0; kk < KH; ++kk) { int kr = rstart + kk; int dr = kr - r + (KH - 1);
        for (int j = 0; j < KW; ++j) { int ck = cstart + j; int dc = ck - cq; dc = dc < -15 ? -15 : (dc > 15 ? 15 : dc); dc += 15;
            size_t kt = (size_t)b * S + kr * GW + ck; float s = 0.f;
#pragma unroll
            for (int d = 0; d < HD; ++d) s += q[d] * h.at(kt, AW + head * HD + d);
            s = s * 0.125f + rp[dr * 31 + dc];
            float mn = fmaxf(m, s); float corr = expf(m - mn); float p = expf(s - mn); l = l * corr + p;
#pragma unroll
            for (int d = 0; d < HD; ++d) acc[d] = acc[d] * corr + p * h.at(kt, 2 * AW + head * HD + d);
            m = mn; } }
    float inv = 1.f / l;
#pragma unroll
    for (int d = 0; d < HD; ++d) concat[(size_t)tok * D + head * HD + d] = acc[d] * inv;
}
__global__ void __launch_bounds__(256) k_pool_n(HSrc h, const float* __restrict__ pool_w, const float* __restrict__ pool_scale, float* __restrict__ concat) {
    __shared__ float pooled[CW];
    int tok = blockIdx.x; int b = tok / S, t = tok % S; int ch = threadIdx.x; int g = ch / 64; int win = 2 << g;
    int lo = t - win / 2; lo = lo < 0 ? 0 : lo; int hi = t + win / 2 - 1; hi = hi > S - 1 ? S - 1 : hi;
    float s = 0.f; for (int u = lo; u <= hi; ++u) s += h.at((size_t)b * S + u, O_G + ch);
    pooled[ch] = s / (float)(hi - lo + 1) - h.at(tok, O_G + ch);
    __syncthreads();
    int e = ch % 64; const float* pw = pool_w + (size_t)g * 64 * 64 + e; float a = 0.f;
    for (int c2 = 0; c2 < 64; ++c2) a += pooled[g * 64 + c2] * pw[c2 * 64];
    concat[(size_t)tok * D + AW + BW + ch] = a * pool_scale[ch];
}
__global__ void __launch_bounds__(64) k_rwkv_scan_n(HSrc h, RwP p, float* __restrict__ ys) {
    const int lane = threadIdx.x; const int dir = blockIdx.x / (NB * BH), b = (blockIdx.x / BH) % NB, hd = blockIdx.x % BH; const int ch = hd * HD + lane;
    float st[HD];
#pragma unroll
    for (int j = 0; j < HD; ++j) st[j] = 0.f;
    float wup[RW], aup[RA];
#pragma unroll
    for (int m = 0; m < RW; ++m) { wup[m] = p.w_up[(size_t)(dir * RW + m) * BW + ch]; aup[m] = p.a_up[(size_t)(dir * RA + m) * BW + ch]; }
    const float w0 = p.w0[dir * BW + ch], a0 = p.a0[dir * BW + ch], kkw = p.k_k[ch], kaw = p.k_a[ch];
    float cr[3], ck[3], cv[3];
#pragma unroll
    for (int x = 0; x < 3; ++x) { cr[x] = p.conv[x * 3 * BW + ch]; ck[x] = p.conv[x * 3 * BW + BW + ch]; cv[x] = p.conv[x * 3 * BW + 2 * BW + ch]; }
    for (int step = 0; step < S; ++step) {
        const int t = dir ? (S - 1 - step) : step; const size_t row = (size_t)b * S + t;
        float r = 0.f, k = 0.f, v = 0.f;
#pragma unroll
        for (int x = 0; x < 3; ++x) { int tt = t + x - 1; if (tt >= 0 && tt < S) { size_t rr = (size_t)b * S + tt; r += h.at(rr, O_A + ch) * cr[x]; k += h.at(rr, O_A + BW + ch) * ck[x]; v += h.at(rr, O_A + 2 * BW + ch) * cv[x]; } }
        float lv = h.at(row, O_B + lane); float lt = lane < RW ? tanhf(lv) : lv; float zw = w0, za = a0;
#pragma unroll
        for (int m = 0; m < RW; ++m) { zw += __shfl(lt, m) * wup[m]; za += __shfl(lt, RW + m) * aup[m]; }
        const float w = expf(-DECAY * sigm_n(zw)); const float a = sigm_n(za);
        float kk = k * kkw; float ss = wave_sum(kk * kk); kk = kk * (1.f / sqrtf(fmaxf(ss, 1e-24f)));
        const float kd = k * (1.f + (a - 1.f) * kaw); const float kka = kk * a;
        float sa = 0.f;
#pragma unroll
        for (int j = 0; j < HD; ++j) sa += st[j] * (-__shfl(kk, j));
        float y = 0.f;
#pragma unroll
        for (int j = 0; j < HD; ++j) { st[j] = st[j] * __shfl(w, j) + sa * __shfl(kka, j) + v * __shfl(kd, j); y += st[j] * __shfl(r, j); }
        ys[((size_t)dir * T + b * S + t) * BW + ch] = y;
    }
}
__global__ void __launch_bounds__(384) k_rwkv_finish_n(HSrc h, RwP p, const float* __restrict__ ys, float* __restrict__ concat) {
    __shared__ float lw[RW], la[RA], sg[RG];
    const int tok = blockIdx.x, b = tok / S, t = tok % S, ch = threadIdx.x, hd = ch / HD, j = ch % HD;
    if (ch < RW) lw[ch] = tanhf(h.at(tok, O_B + ch)); else if (ch < RW + RA) la[ch - RW] = h.at(tok, O_W + (ch - RW)); else if (ch < RW + RA + RG) sg[ch - RW - RA] = sigm_n(h.at(tok, O_AL + (ch - RW - RA)));
    __syncthreads();
    float r = 0.f, k = 0.f, v = 0.f;
#pragma unroll
    for (int x = 0; x < 3; ++x) { int tt = t + x - 1; if (tt >= 0 && tt < S) { size_t rr = (size_t)b * S + tt;
        r += h.at(rr, O_A + ch) * p.conv[x * 3 * BW + ch]; k += h.at(rr, O_A + BW + ch) * p.conv[x * 3 * BW + BW + ch]; v += h.at(rr, O_A + 2 * BW + ch) * p.conv[x * 3 * BW + 2 * BW + ch]; } }
    float bon = 0.f;
    for (int dir = 0; dir < 2; ++dir) { float za = p.a0[dir * BW + ch]; for (int m = 0; m < RA; ++m) za += la[m] * p.a_up[(size_t)(dir * RA + m) * BW + ch];
        float a = sigm_n(za); float kd = k * (1.f + (a - 1.f) * p.k_a[ch]); bon += wave_sum(r * kd * p.r_k[hd * HD + j]); }
    bon *= v;
    float y = ys[(size_t)tok * BW + ch] + ys[((size_t)T + tok) * BW + ch];
    float mu = wave_sum(y) * (1.f / HD); float dy = y - mu; float var = wave_sum(dy * dy) * (1.f / HD);
    float yn = dy * (1.f / sqrtf(var + GN_EPS)) * p.gn_gain[ch] + p.gn_bias[ch];
    float g = 0.f; for (int m = 0; m < RG; ++m) g += sg[m] * p.g_up[(size_t)m * BW + ch];
    concat[(size_t)tok * D + AW + ch] = (yn + bon) * g;
}
__global__ void __launch_bounds__(256) k_moe_n(const float* __restrict__ u2, const int* __restrict__ tokslot, const float* __restrict__ ew,
                                                const float* __restrict__ wgate, const float* __restrict__ wup, const float* __restrict__ wdown, float* __restrict__ f) {
    __shared__ float xs[D]; __shared__ float hb[DE];
    const int tok = blockIdx.x, tid = threadIdx.x;
    for (int i = tid; i < D; i += 256) xs[i] = u2[(size_t)tok * D + i];
    float o[4] = {0.f, 0.f, 0.f, 0.f};
    for (int kk = 0; kk < 2; ++kk) {
        const int ts = tokslot[tok * 2 + kk]; const int e = ts >> 14; const float wt = ew[ts];
        __syncthreads();
        const float* g = wgate + (size_t)e * D * DE; const float* u = wup + (size_t)e * D * DE;
        float ag0 = 0.f, ag1 = 0.f, au0 = 0.f, au1 = 0.f;
        for (int k = 0; k < D; ++k) { float x = xs[k]; ag0 += x * g[(size_t)k * DE + tid]; ag1 += x * g[(size_t)k * DE + 256 + tid]; au0 += x * u[(size_t)k * DE + tid]; au1 += x * u[(size_t)k * DE + 256 + tid]; }
        hb[tid] = ag0 * sigm_n(ag0) * au0; hb[256 + tid] = ag1 * sigm_n(ag1) * au1;
        __syncthreads();
        const float* dn = wdown + (size_t)e * DE * D; float a[4] = {0.f, 0.f, 0.f, 0.f};
        for (int k = 0; k < DE; ++k) { float x = hb[k];
#pragma unroll
            for (int j = 0; j < 4; ++j) a[j] += x * dn[(size_t)k * D + tid + 256 * j]; }
#pragma unroll
        for (int j = 0; j < 4; ++j) o[j] += a[j] * wt;
    }
#pragma unroll
    for (int j = 0; j < 4; ++j) f[(size_t)tok * D + tid + 256 * j] = o[j];
}

__global__ void k_router_n(const float* __restrict__ u2, const float* __restrict__ wg, const float* __restrict__ bg, const float* __restrict__ we, const float* __restrict__ be, int* __restrict__ tok_e) {
    int row = (blockIdx.x * blockDim.x + threadIdx.x) >> 6, lane = threadIdx.x & 63; if (row >= T) return;
    float gl[NG], el[NE];
#pragma unroll
    for (int n = 0; n < NG; ++n) gl[n] = 0.f;
#pragma unroll
    for (int n = 0; n < NE; ++n) el[n] = 0.f;
    for (int i = 0; i < 16; ++i) { int k = lane + 64 * i; float x = u2[(size_t)row * D + k];
#pragma unroll
        for (int n = 0; n < NG; ++n) gl[n] += x * wg[k * NG + n];
#pragma unroll
        for (int n = 0; n < NE; ++n) el[n] += x * we[k * NE + n]; }
#pragma unroll
    for (int n = 0; n < NG; ++n) gl[n] = wave_sum(gl[n]) + bg[n];
#pragma unroll
    for (int n = 0; n < NE; ++n) el[n] = wave_sum(el[n]) + be[n];
    int gi = 0; float gm = gl[0];
#pragma unroll
    for (int n = 1; n < NG; ++n) if (gl[n] > gm) { gm = gl[n]; gi = n; }
    float l1 = -3.0e38f, l2 = -3.0e38f; int i1 = 0, i2 = 0;
#pragma unroll
    for (int n = 0; n < NE; ++n) if ((n >> 3) == gi) { float v = el[n]; int e = n & 7; if (v > l1) { l2 = l1; i2 = i1; l1 = v; i1 = e; } else if (v > l2) { l2 = v; i2 = e; } }
    if (lane == 0) { tok_e[row * 2] = gi * EPG + i1; tok_e[row * 2 + 1] = gi * EPG + i2; }
}
__global__ void k_cmp_route(const int* __restrict__ tokslot, const int* __restrict__ tok_e, float* acc, int slot) {
    float mis = 0.f, tot = 0.f;
    for (int t = blockIdx.x * blockDim.x + threadIdx.x; t < T; t += gridDim.x * blockDim.x) { const int a0 = tokslot[2 * t] >> 14, a1 = tokslot[2 * t + 1] >> 14;
        mis += (a0 != tok_e[2 * t] || a1 != tok_e[2 * t + 1]) ? 1.f : 0.f; tot += 1.f; }
    mis = wave_sum(mis); tot = wave_sum(tot);
    if ((threadIdx.x & 63) == 0) { atomicAdd(acc + 2 * slot, mis); atomicAdd(acc + 2 * slot + 1, tot); }
}
__global__ void k_bf2f(const bf16_t* __restrict__ src, float* __restrict__ dst, size_t n) { for (size_t i = (size_t)blockIdx.x * blockDim.x + threadIdx.x; i < n; i += (size_t)gridDim.x * blockDim.x) dst[i] = bf2f(src[i]); }
template <class TA> __global__ void k_cmp(const TA* __restrict__ a, size_t lda, const float* __restrict__ b, size_t ldb, int rows, int cols, float* acc, int slot) {
    float d2 = 0.f, r2 = 0.f;
    for (size_t i = (size_t)blockIdx.x * blockDim.x + threadIdx.x; i < (size_t)rows * cols; i += (size_t)gridDim.x * blockDim.x) {
        const size_t r = i / cols, c = i % cols; float av; if constexpr (sizeof(TA) == 2) av = bf2f(a[r * lda + c]); else av = a[r * lda + c];
        const float bv = b[r * ldb + c]; d2 += (av - bv) * (av - bv); r2 += bv * bv; }
    d2 = wave_sum(d2); r2 = wave_sum(r2);
    if ((threadIdx.x & 63) == 0) { atomicAdd(acc + 2 * slot, d2); atomicAdd(acc + 2 * slot + 1, r2); }
}
__global__ void k_cmp_vt(const bf16_t* __restrict__ vt, const float* __restrict__ b, size_t ldb, float* acc, int slot) {
    float d2 = 0.f, r2 = 0.f;
    for (size_t i = (size_t)blockIdx.x * blockDim.x + threadIdx.x; i < (size_t)T * AW; i += (size_t)gridDim.x * blockDim.x) {
        const size_t r = i % T, c = i / T; const float av = bf2f(vt[c * T + r]), bv = b[r * ldb + c]; d2 += (av - bv) * (av - bv); r2 += bv * bv; }
    d2 = wave_sum(d2); r2 = wave_sum(r2);
    if ((threadIdx.x & 63) == 0) { atomicAdd(acc + 2 * slot, d2); atomicAdd(acc + 2 * slot + 1, r2); }
}
struct Tols { float t[8]; int n; };
__global__ void k_readout(float* out, const float* acc, Tols tl, int total) {
    float mx = 0.f; int am = 0; for (int k = 0; k < tl.n; ++k) { float e = sqrtf(acc[2 * k] / fmaxf(acc[2 * k + 1], 1e-30f)); if (!(e == e)) e = 1e3f; if (e / tl.t[k] > mx) { mx = e / tl.t[k]; am = k; } }
    const float cval = sqrtf(1000.f * mx);
    for (int i = blockIdx.x * blockDim.x + threadIdx.x; i < total; i += gridDim.x * blockDim.x) out[i] = (i < 8) ? 1000.f * (float)(am + 1) : cval;
}
__global__ void __launch_bounds__(256) k_moe_chk(const float* __restrict__ u2, const int* __restrict__ tokslot, const float* __restrict__ ew, const unsigned* __restrict__ cnt,
                                                  const float* __restrict__ wgate, const float* __restrict__ wup, const float* __restrict__ wdown,
                                                  const bf16_t* __restrict__ XS, const bf16_t* __restrict__ HM, const bf16_t* __restrict__ YS, float* acc) {
    __shared__ float xs[D]; __shared__ float hb[DE]; __shared__ int offp[NE];
    const int tok = blockIdx.x, tid = threadIdx.x;
    if (tid == 0) { int off = 0; for (int e = 0; e < NE; ++e) { offp[e] = off; off += (((int)cnt[e] + 255) >> 8) * 256; } }
    for (int i = tid; i < D; i += 256) xs[i] = u2[(size_t)tok * D + i];
    float d0 = 0.f, r0 = 0.f, d1 = 0.f, r1 = 0.f, d2 = 0.f, r2 = 0.f;
    for (int kk = 0; kk < 2; ++kk) {
        __syncthreads();
        const int ts = tokslot[tok * 2 + kk]; const int e = ts >> 14; const float wt = ew[ts]; const size_t slot = (size_t)offp[e] + (ts & 16383);
        for (int i = tid; i < D; i += 256) { const float a = bf2f(XS[slot * D + i]), b = xs[i]; d0 += (a - b) * (a - b); r0 += b * b; }
        const float* g = wgate + (size_t)e * D * DE; const float* u = wup + (size_t)e * D * DE;
        float ag0 = 0.f, ag1 = 0.f, au0 = 0.f, au1 = 0.f;
        for (int k = 0; k < D; ++k) { float x = xs[k]; ag0 += x * g[(size_t)k * DE + tid]; ag1 += x * g[(size_t)k * DE + 256 + tid]; au0 += x * u[(size_t)k * DE + tid]; au1 += x * u[(size_t)k * DE + 256 + tid]; }
        const float h0 = ag0 * sigm_n(ag0) * au0, h1 = ag1 * sigm_n(ag1) * au1;
        hb[tid] = h0; hb[256 + tid] = h1;
        { const float a = bf2f(HM[slot * DE + tid]), b = bf2f(HM[slot * DE + 256 + tid]); d1 += (a - h0) * (a - h0) + (b - h1) * (b - h1); r1 += h0 * h0 + h1 * h1; }
        __syncthreads();
        const float* dn = wdown + (size_t)e * DE * D; float a4[4] = {0.f, 0.f, 0.f, 0.f};
        for (int k = 0; k < DE; ++k) { float x = hb[k];
#pragma unroll
            for (int j = 0; j < 4; ++j) a4[j] += x * dn[(size_t)k * D + tid + 256 * j]; }
#pragma unroll
        for (int j = 0; j < 4; ++j) {
#ifdef MOEB_NOSCALE
            const float y = a4[j];
#else
            const float y = a4[j] * wt;
#endif
            const float a = bf2f(YS[slot * D + tid + 256 * j]); d2 += (a - y) * (a - y); r2 += y * y; }
    }
    d0 = wave_sum(d0); r0 = wave_sum(r0); d1 = wave_sum(d1); r1 = wave_sum(r1); d2 = wave_sum(d2); r2 = wave_sum(r2);
    if ((tid & 63) == 0) { atomicAdd(acc + 0, d0); atomicAdd(acc + 1, r0); atomicAdd(acc + 2, d1); atomicAdd(acc + 3, r1); atomicAdd(acc + 4, d2); atomicAdd(acc + 5, r2); }
}

extern "C" void kernel_launch(void* const* d_in, const int* in_sizes, int n_in, void* d_out, int out_size, void* d_ws, size_t ws_size, hipStream_t stream) {
    static int once = 0; if (!once) { (void)hipFuncSetAttribute((const void*)mk_fwd, hipFuncAttributeMaxDynamicSharedMemorySize, LDS_BYTES); once = 1; }
    (void)hipMemsetAsync((char*)d_ws + WS_CTL, 0, CTL_BYTES, stream);
    Args a{}; fill_args(a, d_in, d_out, d_ws);
    char* ws = (char*)d_ws; float* out = (float*)d_out;
    float* ACC = (float*)(ws + 32768 + 1024);
    const float* x = a.in[0];
    HSrc hs{(const bf16_t*)(ws + WS_HB), (const bf16_t*)(ws + WS_VT)};
    const int l = 0;
    RwP p = { a.in[6], a.in[7], a.in[8], a.in[9], a.in[10], a.in[11], a.in[12], a.in[13], a.in[14], a.in[15], a.in[16] };
    Tols tl{};
#if TESTMODE == 1
    launch_phases(a, 0, 3, stream);
    float* MODn = (float*)(ws + WS_MOD + 512 * 1024); float* Un = (float*)(ws + WS_XA); float* HF = (float*)(ws + WS_CONCAT);
    k_mod_n<<<L * MODW / 256, 256, 0, stream>>>(a.in[1], a.in[2], a.in[3], MODn);
    k_ln_mod_n<<<T / 4, 256, 0, stream>>>(x, MODn, 0, D, Un);
    k_gemm_f32<<<dim3(INW / 64, T / 64), 256, 0, stream>>>(Un, D, a.in[4], INW, HF, INW, D);
    k_cmp<float><<<256, 256, 0, stream>>>((const float*)(ws + WS_MOD), MODW, MODn, MODW, L * NB, MODW, ACC, 0);
    k_cmp<bf16_t><<<1024, 256, 0, stream>>>((const bf16_t*)(ws + WS_U), D, Un, D, T, D, ACC, 1);
    k_cmp<bf16_t><<<1024, 256, 0, stream>>>((const bf16_t*)(ws + WS_HB), HW, HF, INW, T, 768, ACC, 2);
    k_cmp<bf16_t><<<1024, 256, 0, stream>>>((const bf16_t*)(ws + WS_HB) + 768, HW, HF + 1152, INW, T, 1536, ACC, 3);
    k_cmp_vt<<<1024, 256, 0, stream>>>((const bf16_t*)(ws + WS_VT), HF + 768, INW, ACC, 4);
    tl.n = 5; tl.t[0] = 1e-5f; tl.t[1] = 4e-3f; tl.t[2] = 6e-3f; tl.t[3] = 6e-3f; tl.t[4] = 6e-3f;
#elif TESTMODE == 2
    launch_phases(a, 0, 4, stream);
    float* CCn = (float*)(ws + WS_XA); float* YSn = (float*)(ws + WS_WGU);
    k_attn_n<<<T * AH / 64, 64, 0, stream>>>(hs, a.in[5], CCn);
    k_pool_n<<<T, 256, 0, stream>>>(hs, a.in[17], a.in[18], CCn);
    k_rwkv_scan_n<<<2 * NB * BH, 64, 0, stream>>>(hs, p, YSn);
    k_rwkv_finish_n<<<T, 384, 0, stream>>>(hs, p, YSn, CCn);
    launch_phases(a, 4, 6, stream);
    k_cmp<bf16_t><<<1024, 256, 0, stream>>>((const bf16_t*)(ws + WS_CONCAT), D, CCn, D, T, AW, ACC, 0);
    k_cmp<bf16_t><<<1024, 256, 0, stream>>>((const bf16_t*)(ws + WS_CONCAT) + AW, D, CCn + AW, D, T, BW, ACC, 1);
    k_cmp<bf16_t><<<1024, 256, 0, stream>>>((const bf16_t*)(ws + WS_CONCAT) + AW + BW, D, CCn + AW + BW, D, T, CW, ACC, 2);
    tl.n = 3; tl.t[0] = TOL0; tl.t[1] = TOL1; tl.t[2] = TOL2;
#elif TESTMODE == 3
    launch_phases(a, 0, 11, stream);
    { const float* MODf = (const float*)(ws + WS_MOD);
      float* U2f = (float*)(ws + 414 * MiB); float* Fn = (float*)(ws + 213 * MiB); float* X2n = (float*)(ws + 277 * MiB);
      k_bf2f<<<2048, 256, 0, stream>>>((const bf16_t*)(ws + WS_U), U2f, (size_t)T * D);
      launch_phases(a, 11, 12, stream);
      k_moe_n<<<T, 256, 0, stream>>>(U2f, (const int*)(ws + WS_TOKSLOT), (const float*)(ws + WS_EW), a.in[28], a.in[29], a.in[30], Fn);
      k_post_n<<<T / 4, 256, 0, stream>>>((const float*)(ws + WS_XA), Fn, MODf, 5 * D, a.in[22], a.in[23], X2n, nullptr, 0, 0);
      k_cmp<float><<<1024, 256, 0, stream>>>(out, D, X2n, D, T, D, ACC, 0); }
    tl.n = 1; tl.t[0] = TOL0;
#elif TESTMODE == 4
    launch_phases(a, 0, 8, stream);
    { const float* MODf = (const float*)(ws + WS_MOD);
      float* CCn = (float*)(ws + 405 * MiB); float* MIXn = (float*)(ws + 213 * MiB); float* X1n = (float*)(ws + 21 * MiB); float* U2n = (float*)(ws + 333 * MiB); int* TEn = (int*)(ws + 490 * MiB);
      k_bf2f<<<2048, 256, 0, stream>>>((const bf16_t*)(ws + WS_CONCAT), CCn, (size_t)T * D);
      k_gemm_f32<<<dim3(D / 64, T / 64), 256, 0, stream>>>(CCn, D, a.in[19], D, MIXn, D, D);
      k_post_n<<<T / 4, 256, 0, stream>>>(x, MIXn, MODf, 2 * D, a.in[20], a.in[21], X1n, U2n, 3 * D, 4 * D);
      k_router_n<<<T / 4, 256, 0, stream>>>(U2n, a.in[24], a.in[25], a.in[26], a.in[27], TEn);
      k_cmp<float><<<1024, 256, 0, stream>>>((const float*)(ws + WS_XA), D, X1n, D, T, D, ACC, 0);
      k_cmp<bf16_t><<<1024, 256, 0, stream>>>((const bf16_t*)(ws + WS_U), D, U2n, D, T, D, ACC, 1);
      k_cmp_route<<<64, 256, 0, stream>>>((const int*)(ws + WS_TOKSLOT), TEn, ACC, 2); }
    tl.n = 3; tl.t[0] = TOL0; tl.t[1] = TOL1; tl.t[2] = TOL2;
#elif TESTMODE == 5
    launch_phases(a, 0, 11, stream);
    { float* U2f = (float*)(ws + 414 * MiB);
      k_bf2f<<<2048, 256, 0, stream>>>((const bf16_t*)(ws + WS_U), U2f, (size_t)T * D);
      k_moe_chk<<<T, 256, 0, stream>>>(U2f, (const int*)(ws + WS_TOKSLOT), (const float*)(ws + WS_EW), (const unsigned*)(ws + WS_CTL) + CW_CNT, a.in[28], a.in[29], a.in[30],
                                       (const bf16_t*)(ws + WS_XS), (const bf16_t*)(ws + WS_HM), (const bf16_t*)(ws + WS_YS), ACC); }
    tl.n = 3; tl.t[0] = 1e-6f; tl.t[1] = 1e-2f; tl.t[2] = 1e-2f;
#endif
    k_readout<<<256, 256, 0, stream>>>(out, ACC, tl, out_size);
}
#endif
```

```cpp
#define TESTMODE 0
#define MK_MODE 0
#define S0_WRITER 1
#define ATT_XCD 1
#define FUSE_MOE 1
#include <hip/hip_runtime.h>
#include <hip/hip_cooperative_groups.h>
#include <stdint.h>
namespace cg = cooperative_groups;

#ifndef TESTMODE
#define TESTMODE 0
#endif
#define DI __device__ __forceinline__
#define LAS __attribute__((address_space(3)))
typedef unsigned short bf16_t;
typedef short bf16x8 __attribute__((ext_vector_type(8)));
typedef float f32x4 __attribute__((ext_vector_type(4)));
typedef float f32x16 __attribute__((ext_vector_type(16)));
typedef unsigned u32x4 __attribute__((ext_vector_type(4)));
typedef unsigned u32x2 __attribute__((ext_vector_type(2)));
typedef float f32x2_t __attribute__((ext_vector_type(2)));
typedef __bf16 bf16x2_t __attribute__((ext_vector_type(2)));

namespace cfg {
constexpr int D = 1024, NB = 2, S = 8192, T = NB * S, L = 2;
constexpr int GW = 64, ROWS = 128;
constexpr int HD = 64, AW = 384, BW = 384, CW = 256, AH = 6, BH = 6;
constexpr int KH = 8, KW = 16;
constexpr int RW = 32, RA = 32, RG = 64;
constexpr int INW = 2688;
constexpr int NG = 4, EPG = 8, NE = 32, DE = 512;
constexpr int MODW = 6 * D;
constexpr float ALPHA = 1.41421356237309515f;
constexpr float LN_EPS = 1e-5f, GN_EPS = 64e-5f;
constexpr float DECAY = 0.60653065971263342f;
constexpr float LOG2E = 1.44269504088896341f;
constexpr int HW = 2304, HQ = 0, HK = 384, HR = 768, HWL = 1920, HAL = 1952, HGL = 1984, HP = 2048;
constexpr int NCH = S / 64;
constexpr int NUNIT = 2 * NB * BH * NCH;
constexpr int XSROWS = 2 * T + NE * 256;
}
using namespace cfg;

constexpr size_t MiB = 1u << 20;
constexpr size_t WS_CTL = 0;
constexpr size_t CTL_BYTES = 262144;
constexpr size_t WS_SLOTTOK = 65536;
constexpr int CW_BAR = 0;
constexpr int CW_MFL = 9216;
constexpr int CW_CNT = 8192;
constexpr size_t WS_MOD = 1 * MiB;
constexpr size_t WS_TOKSLOT = 1 * MiB + 128 * 1024;
constexpr size_t WS_SLOTW = 1 * MiB + 256 * 1024;
constexpr size_t WS_BC = 2 * MiB;
constexpr size_t WS_TOKW = 2 * MiB + 64 * 1024;
constexpr size_t WS_TOKFIN = 2 * MiB + 256 * 1024;
constexpr size_t WS_CNTF = 2 * MiB + 512 * 1024;
constexpr size_t WS_WIN = 6 * MiB;
constexpr size_t WIN_LAYER = (size_t)2816 * 1024 * 2;
constexpr size_t WS_WOUT = 17 * MiB;
constexpr size_t WS_WGU = 21 * MiB;
constexpr size_t WS_WD = 85 * MiB;
constexpr size_t WS_XA = 117 * MiB;
constexpr size_t WS_U = 181 * MiB;
constexpr size_t WS_HB = 213 * MiB;
constexpr size_t WS_S0 = 117 * MiB;
constexpr size_t WS_VT = 285 * MiB;
constexpr size_t WS_CONCAT = 301 * MiB;
constexpr size_t WS_MP = 333 * MiB;
constexpr size_t WS_NB = 358 * MiB;
constexpr size_t WS_MIX = 333 * MiB;
constexpr size_t WS_QT = 405 * MiB;
constexpr size_t WS_WT = 429 * MiB;
constexpr size_t WS_VTB = 453 * MiB;
constexpr size_t WS_GB = 465 * MiB;
constexpr size_t WS_VC = 477 * MiB;
constexpr size_t WS_BS = 489 * MiB;
constexpr size_t WS_XS = 213 * MiB;
constexpr size_t WS_HM = 293 * MiB;
constexpr size_t WS_YS = 333 * MiB;
constexpr size_t WS_END = 490 * MiB;
#ifndef NOSKEW
#define USK(u) ((size_t)(u) + ((size_t)(u) >> 7))
#else
#define USK(u) ((size_t)(u))
#endif

constexpr int NWAVES = 8, NTHREADS = 512;
constexpr int LDS_BYTES = 156 * 1024;

DI unsigned cvtpk(float lo, float hi) { f32x2_t v = {lo, hi}; bf16x2_t b = __builtin_convertvector(v, bf16x2_t); return __builtin_bit_cast(unsigned, b); }
DI float bflo(unsigned w) { return __uint_as_float(w << 16); }
DI float bfhi(unsigned w) { return __uint_as_float(w & 0xffff0000u); }
DI float bf2f(unsigned short h) { return __uint_as_float((unsigned)h << 16); }
DI unsigned short f2bf(float f) { return (unsigned short)(cvtpk(f, 0.f) & 0xffffu); }
DI float wave_sum_shfl(float v) {
#pragma unroll
    for (int o = 32; o > 0; o >>= 1) v += __shfl_xor(v, o);
    return v;
}
template <int CTRL, int ROWMASK> DI float dpp_add(float v) { return v + __builtin_bit_cast(float, __builtin_amdgcn_update_dpp(0, __builtin_bit_cast(int, v), CTRL, ROWMASK, 0xf, false)); }
DI float wave_sum(float v) {
    v = dpp_add<0xb1, 0xf>(v);
    v = dpp_add<0x4e, 0xf>(v);
    v = dpp_add<0x124, 0xf>(v);
    v = dpp_add<0x128, 0xf>(v);
    v = dpp_add<0x142, 0xa>(v);
    v = dpp_add<0x143, 0xc>(v);
    return __builtin_bit_cast(float, __builtin_amdgcn_readlane(__builtin_bit_cast(int, v), 63));
}
DI float fexp2(float x) { return __builtin_amdgcn_exp2f(x); }
DI float frcp(float x) { return __builtin_amdgcn_rcpf(x); }
DI float sigm(float x) { return frcp(1.f + fexp2(x * -LOG2E)); }
#define LDS_WAIT() asm volatile("s_waitcnt lgkmcnt(0)" ::: "memory")
#define VM_WAIT() asm volatile("s_waitcnt vmcnt(0)" ::: "memory")
DI int swap23(int i) { return (i & ~12) | ((i & 4) << 1) | ((i & 8) >> 1); }

namespace pg8 {
constexpr int BM = 256, BK = 64, HALF = 128, HTB = HALF * BK * 2, STAGE_BYTES = 8 * HTB, NXCD = 8, WGM = 8;
__host__ __device__ __forceinline__ int lds_byte(int r, int c) { const int st = (r >> 4) * 2 + (c >> 5), rr = r & 15, cc = c & 31, ob = rr * 64 + cc * 2; return st * 1024 + (ob ^ (((ob >> 9) & 1) << 5)); }
__host__ __device__ __forceinline__ void stage_rc(int b, int& R, int& C) { const int st = b / 1024, sb = b % 1024, swz = sb ^ (((sb >> 9) & 1) << 5); R = (st >> 1) * 16 + swz / 64; C = (st & 1) * 32 + (swz % 64) / 2; }
__host__ __device__ __forceinline__ int perm32(int rho) { const int n = rho >> 4, i = rho & 15; return 8 * (i >> 2) + 4 * n + (i & 3); }

struct Unit { int pm, pn, aux; };

DI int xcd_remap(int L, int nwg) { const int q = nwg / NXCD, r = nwg % NXCD, xcd = L % NXCD, off = L / NXCD; return (xcd < r ? xcd * (q + 1) : r * (q + 1) + (xcd - r) * q) + off; }

struct PlainOrder {
    static constexpr bool GATHER = false, SIGNAL = false, WAIT = false;
    DI void signal(const Unit&) const {} DI void wait(const Unit&) const {}
    const bf16_t* A; const bf16_t* Bt; int K; int nM, nN, nwg, G, c;
    DI void init(const bf16_t* A_, const bf16_t* Bt_, int M, int N, int K_, int G_, int c_) { A = A_; Bt = Bt_; K = K_; nM = M / BM; nN = N / BM; nwg = nM * nN; G = G_; c = c_; }
    DI bool next(int i, Unit& u) const {
        const int Lx = i * G + c; if (Lx >= nwg) return false;
        const int wgid = xcd_remap(Lx, nwg);
        const int nig = WGM * nN, gid = wgid / nig, fm = gid * WGM, gsz = (nM - fm) < WGM ? (nM - fm) : WGM;
        u.pm = fm + ((wgid % nig) % gsz); u.pn = (wgid % nig) / gsz; u.aux = 0; return true;
    }
    DI const char* aptr(const Unit& u) const { return (const char*)A + (size_t)u.pm * (2 * HALF) * K * 2; }
    DI const char* bptr(const Unit& u) const { return (const char*)Bt + (size_t)u.pn * (2 * HALF) * K * 2; }
};
struct Gemm1Order {
    static constexpr bool GATHER = false, SIGNAL = false, WAIT = false;
    DI void signal(const Unit&) const {} DI void wait(const Unit&) const {}
    const bf16_t* U; const bf16_t* Win; const bf16_t* Wv; int G, c;
    static constexpr int nM = T / BM, nN = HW / BM, nMain = nM * nN, nV = 2 * (T / BM), nwg = nMain + nV, K = D;
    DI bool next(int i, Unit& u) const {
        const int Lx = i * G + c; if (Lx >= nwg) return false;
        if (Lx < nMain) {
            const int wgid = xcd_remap(Lx, nMain);
            const int nig = WGM * nN, gid = wgid / nig, fm = gid * WGM, gsz = (nM - fm) < WGM ? (nM - fm) : WGM;
            u.pm = fm + ((wgid % nig) % gsz); u.pn = (wgid % nig) / gsz; u.aux = 0;
        } else { const int v = Lx - nMain; u.pm = v & 1; u.pn = v >> 1; u.aux = 1; }
        return true;
    }
    DI const char* aptr(const Unit& u) const { return (const char*)(u.aux ? Wv : U) + (size_t)u.pm * BM * K * 2; }
    DI const char* bptr(const Unit& u) const { return (const char*)(u.aux ? U : Win) + (size_t)u.pn * BM * K * 2; }
};
template <bool G_> struct GroupedOrderT {
    static constexpr bool GATHER = G_;
#ifdef FUSE_MOE
    static constexpr bool SIGNAL = G_, WAIT = false;
    unsigned* flags;
    DI void signal(const Unit& u) const { (void)__hip_atomic_fetch_add(flags + u.pm, 1u, __ATOMIC_RELAXED, __HIP_MEMORY_SCOPE_AGENT); }
    DI void wait(const Unit&) const {}
#else
    static constexpr bool SIGNAL = false, WAIT = false;
    DI void signal(const Unit&) const {} DI void wait(const Unit&) const {}
#endif
    const bf16_t* A; const bf16_t* Bt; int K; size_t estride; const LAS int* tile_e; int ntiles, nwg, G, c; const int* rowtok;
    DI bool next(int i, Unit& u) const {
        const int Lx = i * G + c; if (Lx >= nwg) return false;
        const int wgid = xcd_remap(Lx, nwg);
        u.pm = wgid >> 2; u.pn = wgid & 3; u.aux = tile_e[u.pm]; return true;
    }
    DI const char* aptr(const Unit& u) const { return GATHER ? (const char*)A : (const char*)A + (size_t)u.pm * BM * K * 2; }
    DI const char* bptr(const Unit& u) const { return (const char*)Bt + ((size_t)u.aux * estride + (size_t)u.pn * BM * K) * 2; }
};

#ifdef FUSE_MOE
struct GroupedOrderB {
    static constexpr bool GATHER = false, SIGNAL = false, WAIT = true;
    const bf16_t* A; const bf16_t* Bt; int K; size_t estride; const LAS int* tile_e; int ntiles, nwg, G, c; const int* rowtok; unsigned* flags;
    DI bool next(int i, Unit& u) const {
        int wgid;
        if (G % NXCD == 0) {
            const int P = G / NXCD, x = c % NXCD, k = c / NXCD, q = nwg / NXCD, r8 = nwg % NXCD;
            const int qx = q + (x < r8 ? 1 : 0), startx = x < r8 ? x * (q + 1) : r8 * (q + 1) + (x - r8) * q;
            const int remA = qx % P, nL = P - remA, seg1 = remA > 0 ? (2 * nL < qx ? 2 * nL : qx) : 0;
            int n1 = 0;
            if (remA > 0 && k >= remA) { n1 = (k - remA) < seg1 ? 1 : 0; n1 += (k - remA) + nL < seg1 ? 1 : 0; }
            const int ob = i < n1 ? (k - remA) + i * nL : seg1 + k + (i - n1) * P;
            if (ob >= qx) return false;
            wgid = startx + ob;
        } else { const int Lx = i * G + c; if (Lx >= nwg) return false; wgid = Lx; }
        u.pm = wgid >> 2; u.pn = wgid & 3; u.aux = tile_e[u.pm]; return true;
    }
    DI const char* aptr(const Unit& u) const { return (const char*)A + (size_t)u.pm * BM * K * 2; }
    DI const char* bptr(const Unit& u) const { return (const char*)Bt + ((size_t)u.aux * estride + (size_t)u.pn * BM * K) * 2; }
    DI void signal(const Unit&) const {}
    DI void wait(const Unit& u) const {
        unsigned sp = 0;
        while (__hip_atomic_load(flags + u.pm, __ATOMIC_RELAXED, __HIP_MEMORY_SCOPE_AGENT) < 4u) { __builtin_amdgcn_s_sleep(4); if (++sp > (1u << 22)) break; }
        asm volatile("" ::: "memory");
    }
};
#endif

struct EpiStore {
    bf16_t* O0; int ld0; bf16_t* O1; int ld1;
    DI void operator()(const f32x4 (&acc)[2][2][4][2], const Unit& u, int wr, int wc, int fr, int fq) const {
        bf16_t* base = u.aux ? O1 : O0; const int ldc = u.aux ? ld1 : ld0;
        const int row0 = u.pm * BM + wr * 64 + fr, col0 = u.pn * BM + wc * 32 + 8 * fq;
#pragma unroll
        for (int ai = 0; ai < 2; ++ai)
#pragma unroll
            for (int m = 0; m < 4; ++m) { bf16_t* rowp = base + (size_t)(row0 + ai * HALF + m * 16) * ldc + col0;
#pragma unroll
                for (int bj = 0; bj < 2; ++bj) { const f32x4 v0 = acc[ai][bj][m][0], v1 = acc[ai][bj][m][1];
                    u32x4 w; w.x = cvtpk(v0[0], v0[1]); w.y = cvtpk(v0[2], v0[3]); w.z = cvtpk(v1[0], v1[1]); w.w = cvtpk(v1[2], v1[3]);
                    *(u32x4*)(rowp + bj * HALF) = w; } }
    }
};
struct EpiSwiGlu {
    bf16_t* O;
    DI void operator()(const f32x4 (&acc)[2][2][4][2], const Unit& u, int wr, int wc, int fr, int fq) const {
        const int row0 = u.pm * BM + wr * 64 + fr, col0 = u.pn * HALF + wc * 32 + 8 * fq;
#pragma unroll
        for (int ai = 0; ai < 2; ++ai)
#pragma unroll
            for (int m = 0; m < 4; ++m) { bf16_t* rowp = O + (size_t)(row0 + ai * HALF + m * 16) * DE + col0;
                float hv[8];
#pragma unroll
                for (int n = 0; n < 2; ++n)
#pragma unroll
                    for (int e = 0; e < 4; ++e) { const float g = acc[ai][0][m][n][e], up = acc[ai][1][m][n][e]; hv[4 * n + e] = g * sigm(g) * up; }
                u32x4 w; w.x = cvtpk(hv[0], hv[1]); w.y = cvtpk(hv[2], hv[3]); w.z = cvtpk(hv[4], hv[5]); w.w = cvtpk(hv[6], hv[7]);
#ifdef FUSE_MOE
                asm volatile("global_store_dwordx4 %0, %1, off sc1\n\ts_nop 1" :: "v"(rowp), "v"(w) : "memory");
#else
                *(u32x4*)rowp = w;
#endif
            }
    }
};
struct EpiRowScale {
    bf16_t* O; const float* roww;
    DI void operator()(const f32x4 (&acc)[2][2][4][2], const Unit& u, int wr, int wc, int fr, int fq) const {
        const int row0 = u.pm * BM + wr * 64 + fr, col0 = u.pn * BM + wc * 32 + 8 * fq;
#pragma unroll
        for (int ai = 0; ai < 2; ++ai)
#pragma unroll
            for (int m = 0; m < 4; ++m) { const int row = row0 + ai * HALF + m * 16;
#ifdef MOEB_NOSCALE
                const float s = 1.f;
#else
                const float s = roww[row];
#endif
                bf16_t* rowp = O + (size_t)row * D + col0;
#pragma unroll
                for (int bj = 0; bj < 2; ++bj) { const f32x4 v0 = acc[ai][bj][m][0] * s, v1 = acc[ai][bj][m][1] * s;
                    u32x4 w; w.x = cvtpk(v0[0], v0[1]); w.y = cvtpk(v0[2], v0[3]); w.z = cvtpk(v1[0], v1[1]); w.w = cvtpk(v1[2], v1[3]);
                    *(u32x4*)(rowp + bj * HALF) = w; } }
    }
};

template <class Epi, class Sched>
DI void gemm_phase(LAS unsigned char* lds, const int tid, const int K, const Sched& S, const Epi& E) {
    const int wid = __builtin_amdgcn_readfirstlane(tid >> 6), lane = tid & 63, wr = wid >> 2, wc = wid & 3, fr = lane & 15, fq = lane >> 4;
    const int nt = K / BK;
    unsigned voffA[2], voffB[2];
#pragma unroll
    for (int i = 0; i < 2; ++i) { int R, C; stage_rc(tid * 16 + i * 8192, R, C); const int Rb = (R & ~31) + perm32(R & 31);
        voffA[i] = (unsigned)(R * K + C) * 2u; voffB[i] = (unsigned)(Rb * K + C) * 2u; }
    const size_t kstep = (size_t)(BK * 2);
    const size_t hstep = (size_t)HALF * K * 2;
    const size_t hstepA = Sched::GATHER ? 0 : hstep;
    int RA_[2], CA_[2];
#pragma unroll
    for (int i = 0; i < 2; ++i) stage_rc(tid * 16 + i * 8192, RA_[i], CA_[i]);
    unsigned vgc[2][2], vgn[2][2], vgnn[2][2];
#define PG8_GLOAD(dst, u_) do { if constexpr (Sched::GATHER) { _Pragma("unroll") for (int h_ = 0; h_ < 2; ++h_) _Pragma("unroll") for (int i_ = 0; i_ < 2; ++i_) \
        dst[h_][i_] = ((unsigned)S.rowtok[(u_).pm * BM + h_ * HALF + RA_[i_]] * (unsigned)K + (unsigned)CA_[i_]) * 2u; } } while (0)
    const unsigned ldsw = (unsigned)wid * 1024u;
    const int aoff = lds_byte(wr * 64 + fr, fq * 8), boff = lds_byte(wc * 32 + fr, fq * 8);
#define PG8_SA(b, h) (((b) * 2 + (h)) * HTB)
#define PG8_SB(b, h) ((4 + (b) * 2 + (h)) * HTB)
#define PG8_STAGE(bufoff, gbase, voff) do { _Pragma("unroll") for (int _i = 0; _i < 2; ++_i) \
        __builtin_amdgcn_global_load_lds((const unsigned*)((const char*)(gbase) + (voff)[_i]), (LAS unsigned*)(lds + (bufoff) + ldsw + _i * 8192), 16, 0, 0); } while (0)
#define PG8_STAGE_C(bufoff, gbase, voff) do { _Pragma("unroll") for (int _i = 0; _i < 2; ++_i) \
        __builtin_amdgcn_global_load_lds((const unsigned*)((const char*)(gbase) + (voff)[_i]), (LAS unsigned*)(lds + (bufoff) + ldsw + _i * 8192), 16, 0, 16); } while (0)
#define PG8_STAGE_A(b, h, gbase, cur_) do { if constexpr (Sched::GATHER) { unsigned vo_[2]; vo_[0] = (cur_) ? vgc[h][0] : vgn[h][0]; vo_[1] = (cur_) ? vgc[h][1] : vgn[h][1]; PG8_STAGE(PG8_SA(b, h), gbase, vo_); } else if constexpr (Sched::WAIT) PG8_STAGE_C(PG8_SA(b, h), (gbase) + (h) * hstepA, voffA); else PG8_STAGE(PG8_SA(b, h), (gbase) + (h) * hstepA, voffA); } while (0)
#define PG8_LDA(dst, b, h) do { _Pragma("unroll") for (int m = 0; m < 4; ++m) _Pragma("unroll") for (int k = 0; k < 2; ++k) dst[m][k] = *(const LAS bf16x8*)(lds + PG8_SA(b, h) + aoff + m * 2048 + k * 1024); } while (0)
#define PG8_LDB(dst, b, h) do { _Pragma("unroll") for (int n = 0; n < 2; ++n) _Pragma("unroll") for (int k = 0; k < 2; ++k) dst[n][k] = *(const LAS bf16x8*)(lds + PG8_SB(b, h) + boff + n * 2048 + k * 1024); } while (0)
#define PG8_MMA(ai, bj, At, Bt) do { __builtin_amdgcn_s_setprio(1); _Pragma("unroll") for (int m = 0; m < 4; ++m) _Pragma("unroll") for (int n = 0; n < 2; ++n) _Pragma("unroll") for (int k = 0; k < 2; ++k) \
        acc[ai][bj][m][n] = __builtin_amdgcn_mfma_f32_16x16x32_bf16(Bt[n][k], At[m][k], acc[ai][bj][m][n], 0, 0, 0); __builtin_amdgcn_s_setprio(0); } while (0)
#define PG8_WAIT_V(n) asm volatile("s_waitcnt vmcnt(" #n ")" ::: "memory")
#define PG8_WAIT_L(n) asm volatile("s_waitcnt lgkmcnt(" #n ")" ::: "memory")
#define PG8_BAR __builtin_amdgcn_s_barrier()
#define PG8_SCHED __builtin_amdgcn_sched_barrier(0)
    Unit cur, nxt; int ui = 0;
    if (!S.next(0, cur)) return;
    f32x4 acc[2][2][4][2];
#pragma unroll
    for (int a = 0; a < 2; ++a)
#pragma unroll
        for (int b = 0; b < 2; ++b)
#pragma unroll
            for (int m = 0; m < 4; ++m)
#pragma unroll
                for (int n = 0; n < 2; ++n) acc[a][b][m][n] = (f32x4){0.f, 0.f, 0.f, 0.f};
    bf16x8 At[4][2], B0[2][2], B1[2][2];
    const char* cA = S.aptr(cur); const char* cB = S.bptr(cur);
    if constexpr (Sched::WAIT) S.wait(cur);
    if constexpr (Sched::GATHER) { Unit u1_ = cur, u2_ = cur; const bool h1_ = S.next(1, u1_); if (!h1_) u1_ = cur; const bool h2_ = h1_ && S.next(2, u2_); if (!h2_) u2_ = u1_;
        PG8_GLOAD(vgc, cur); PG8_GLOAD(vgn, u1_); PG8_GLOAD(vgnn, u2_); }
    PG8_STAGE(PG8_SB(0, 0), cB, voffB); PG8_STAGE(PG8_SB(0, 1), cB + hstep, voffB); PG8_STAGE_A(0, 0, cA, true); PG8_STAGE_A(0, 1, cA, true);
    if (wr == 1) PG8_BAR;
    PG8_WAIT_V(2); PG8_BAR;
    PG8_STAGE(PG8_SB(1, 0), cB + kstep, voffB); PG8_STAGE_A(1, 0, cA + kstep, true); PG8_STAGE(PG8_SB(1, 1), cB + hstep + kstep, voffB);
    PG8_WAIT_V(6); PG8_BAR;
    for (;;) {
        const bool has_next = S.next(ui + 1, nxt);
        const char* nA = has_next ? S.aptr(nxt) : cA; const char* nB = has_next ? S.bptr(nxt) : cB;

        for (int t = 0; t < nt; t += 2) {
            const bool last = (t == nt - 2);
            if constexpr (Sched::WAIT) { if (last && has_next) S.wait(nxt); }
            const char* a1 = cA + (size_t)(t + 1) * kstep;
            const char* a2 = last ? nA : cA + (size_t)(t + 2) * kstep; const char* b2 = last ? nB : cB + (size_t)(t + 2) * kstep;
            const char* a3 = a2 + kstep; const char* b3 = b2 + kstep;
            PG8_LDB(B0, 0, 0); PG8_LDB(B1, 0, 1); PG8_SCHED; PG8_LDA(At, 0, 0); PG8_STAGE_A(1, 1, a1, true);
            PG8_WAIT_V(8); PG8_WAIT_L(0); PG8_BAR; PG8_MMA(0, 0, At, B0); PG8_MMA(0, 1, At, B1); PG8_BAR; PG8_SCHED;
            PG8_LDA(At, 0, 1); PG8_STAGE(PG8_SB(0, 0), b2, voffB); PG8_STAGE(PG8_SB(0, 1), b2 + hstep, voffB); PG8_STAGE_A(0, 0, a2, !last);
            PG8_WAIT_V(8); PG8_WAIT_L(0); PG8_BAR; PG8_MMA(1, 0, At, B0); PG8_MMA(1, 1, At, B1); PG8_BAR; PG8_SCHED;
            PG8_LDB(B0, 1, 0); PG8_LDB(B1, 1, 1); PG8_SCHED; PG8_LDA(At, 1, 0); PG8_STAGE_A(0, 1, a2, !last);
            PG8_WAIT_V(8); PG8_WAIT_L(0); PG8_BAR; PG8_MMA(0, 0, At, B0); PG8_MMA(0, 1, At, B1); PG8_BAR; PG8_SCHED;
            PG8_LDA(At, 1, 1); PG8_STAGE(PG8_SB(1, 0), b3, voffB); PG8_STAGE(PG8_SB(1, 1), b3 + hstep, voffB); PG8_STAGE_A(1, 0, a3, !last);
            PG8_WAIT_V(8); PG8_WAIT_L(0); PG8_BAR; PG8_MMA(1, 0, At, B0); PG8_MMA(1, 1, At, B1); PG8_BAR; PG8_SCHED;
        }
        if (wr == 0) PG8_BAR;
        E(acc, cur, wr, wc, fr, fq);
        if constexpr (Sched::SIGNAL) { PG8_WAIT_V(0); PG8_BAR; if (tid == 0) S.signal(cur); }
        if (!has_next) break;
#pragma unroll
        for (int a = 0; a < 2; ++a)
#pragma unroll
            for (int b = 0; b < 2; ++b)
#pragma unroll
                for (int m = 0; m < 4; ++m)
#pragma unroll
                    for (int n = 0; n < 2; ++n) acc[a][b][m][n] = (f32x4){0.f, 0.f, 0.f, 0.f};
        cur = nxt; cA = nA; cB = nB; ++ui;
        if constexpr (Sched::GATHER) { _Pragma("unroll") for (int h_ = 0; h_ < 2; ++h_) _Pragma("unroll") for (int i_ = 0; i_ < 2; ++i_) { vgc[h_][i_] = vgn[h_][i_]; vgn[h_][i_] = vgnn[h_][i_]; } }
        if (wr == 1) PG8_BAR;
    }
    PG8_WAIT_V(0);
    PG8_BAR;
#undef PG8_SA
#undef PG8_SB
#undef PG8_STAGE
#undef PG8_STAGE_C
#undef PG8_STAGE_A
#undef PG8_GLOAD
#undef PG8_LDA
#undef PG8_LDB
#undef PG8_MMA
#undef PG8_WAIT_V
#undef PG8_WAIT_L
#undef PG8_BAR
#undef PG8_SCHED
}
}

#define XB_TMO      128
#define XB_XCNT(j)  (256  + 64 * (j))
#define XB_XSUB(j)  (1280 + 64 * (j))
#define XB_XGEN(j)  (2304 + 64 * (j))
#define XB_TOP      3328
#define XB_TOPGEN   3392
#define XCD_BAR_WORDS 3456
#define XB_SPIN_CAP (1u << 20)
DI unsigned xb_ld(unsigned* p)              { return __hip_atomic_load(p, __ATOMIC_RELAXED, __HIP_MEMORY_SCOPE_AGENT); }
DI unsigned xb_add(unsigned* p, unsigned v) { return __hip_atomic_fetch_add(p, v, __ATOMIC_RELAXED, __HIP_MEMORY_SCOPE_AGENT); }
DI unsigned xb_xcc_id() { return (unsigned)__builtin_amdgcn_s_getreg((3 << 11) | 20) & 0xFu; }
#define XB_SPIN(cond, bar) do { unsigned _sp = 0; while (cond) { __builtin_amdgcn_s_sleep(1); \
    if ((++_sp & 255u) == 0u) { if (xb_ld(&(bar)[XB_TMO])) break; if (_sp > XB_SPIN_CAP) { atomicAdd(&(bar)[XB_TMO], 1u); break; } } } } while (0)
struct XcdBarrier { unsigned* bar; unsigned x; volatile LAS unsigned* st; };
DI XcdBarrier xcd_barrier_post(unsigned* bar, volatile LAS unsigned* st) {
    XcdBarrier b; b.bar = bar; b.x = xb_xcc_id(); b.st = st;
    if (threadIdx.x == 0) (void)xb_add(&bar[XB_XCNT(b.x)], 1u);
    return b;
}
DI void xcd_barrier_complete(unsigned* bar, unsigned x, unsigned& nloc, unsigned& nx) {
    const unsigned G = gridDim.x * gridDim.y * gridDim.z;
    unsigned sum, cnt, mine, sp = 0u;
    for (;;) {
        sum = 0u; cnt = 0u; mine = 0u;
#pragma unroll
        for (unsigned j = 0; j < 16; ++j) { const unsigned c = xb_ld(&bar[XB_XCNT(j)]); sum += c; cnt += (c > 0u) ? 1u : 0u; mine = (j == x) ? c : mine; }
        if (sum == G) break;
        __builtin_amdgcn_s_sleep(1);
        if ((++sp & 255u) == 0u) { if (xb_ld(&bar[XB_TMO])) break; if (sp > XB_SPIN_CAP) { atomicAdd(&bar[XB_TMO], 1u); break; } }
    }
    nloc = mine > 0u ? mine : 1u; nx = cnt > 0u ? cnt : 1u;
}
DI void xcd_barrier(const XcdBarrier& b) {
    asm volatile("s_waitcnt vmcnt(0)" ::: "memory");
    __syncthreads();
    if (threadIdx.x == 0) {
        unsigned* bar = b.bar;
        __builtin_amdgcn_s_waitcnt(0);
        unsigned nloc = b.st[0], nx = b.st[1];
        if (nloc == 0u) { xcd_barrier_complete(bar, b.x, nloc, nx); b.st[0] = nloc; b.st[1] = nx; }
        const unsigned old = xb_add(&bar[XB_XSUB(b.x)], 1u);
        const unsigned gen = old / nloc;
        if (old + 1u == (gen + 1u) * nloc) {
            __builtin_amdgcn_fence(__ATOMIC_RELEASE, "agent");
            asm volatile("s_waitcnt vmcnt(0)" ::: "memory");
            const unsigned og = xb_add(&bar[XB_TOP], 1u);
            const unsigned tg = og / nx;
            if (og + 1u == (tg + 1u) * nx) xb_add(&bar[XB_TOPGEN], 1u);
            else XB_SPIN(xb_ld(&bar[XB_TOPGEN]) == tg, bar);
            __builtin_amdgcn_fence(__ATOMIC_ACQUIRE, "agent");
            xb_add(&bar[XB_XGEN(b.x)], 1u);
            asm volatile("s_waitcnt vmcnt(0)" ::: "memory");
        } else {
            XB_SPIN(xb_ld(&bar[XB_XGEN(b.x)]) == gen, bar);
            __builtin_amdgcn_fence(__ATOMIC_ACQUIRE, "agent");
            asm volatile("s_waitcnt vmcnt(0)" ::: "memory");
        }
    }
    __syncthreads();
}

struct Args { const float* in[31]; float* out; unsigned char* ws; int ph_lo, ph_hi, use_cg, pad; };
struct Frame {
    LAS unsigned char* lds;
    int tid, lane, wave, G, vcu, gw, ngw, bx;
    unsigned char* ws;
};
constexpr int LDS_MISC = 131072;
constexpr int LDS_BARST = LDS_BYTES - 64;

struct TItem { const float* src; bf16_t* dst; int ldw, ldt; };
DI void titem_load(const TItem& t, f32x4 (&v)[16], int lane) {
#pragma unroll
    for (int i = 0; i < 16; ++i) v[i] = *(const f32x4*)(t.src + (size_t)(4 * i + (lane >> 4)) * t.ldw + 4 * (lane & 15));
}
DI void titem_store(const TItem& t, const f32x4 (&v)[16], LAS float* scr, int lane) {
#pragma unroll
    for (int i = 0; i < 16; ++i) { LAS float* s = scr + (4 * i + (lane >> 4)) * 65 + 4 * (lane & 15); s[0] = v[i][0]; s[1] = v[i][1]; s[2] = v[i][2]; s[3] = v[i][3]; }
    LDS_WAIT();
#pragma unroll
    for (int j = 0; j < 8; ++j) {
        const int n = 8 * j + (lane >> 3), c = lane & 7; const LAS float* s = scr + (8 * c) * 65 + n;
        u32x4 o; o.x = cvtpk(s[0], s[65]); o.y = cvtpk(s[130], s[195]); o.z = cvtpk(s[260], s[325]); o.w = cvtpk(s[390], s[455]);
        *(u32x4*)(t.dst + (size_t)n * t.ldt + 8 * c) = o;
    }
    LDS_WAIT();
}
constexpr int IT_WIN = 16 * 42, IT_WOUT = 16 * 16, IT_SMALL = IT_WIN + IT_WOUT;
constexpr int IT_EXP = 128 * 3, IT_MOE = NE * IT_EXP;
DI TItem small_item(const Frame& F, const float* w_in, const float* w_out, int git) {
    const int l = git / IT_SMALL, it = git % IT_SMALL; TItem t;
    if (it < IT_WIN) {
        const int kt = it / 42, nt = it % 42, n0 = 64 * nt;
        size_t drow; if (n0 < 768) drow = n0; else if (n0 < 1152) drow = 2304 + (n0 - 768); else drow = n0 - 384;
        t.src = w_in + (size_t)l * D * INW + (size_t)(64 * kt) * INW + n0; t.ldw = INW;
        t.dst = (bf16_t*)(F.ws + WS_WIN + (size_t)l * WIN_LAYER) + drow * D + 64 * kt; t.ldt = D;
    } else {
        const int r = it - IT_WIN, kt = r >> 4, nt = r & 15;
        t.src = w_out + (size_t)l * D * D + (size_t)(64 * kt) * D + 64 * nt; t.ldw = D;
        t.dst = (bf16_t*)(F.ws + WS_WOUT) + (size_t)l * D * D + (size_t)(64 * nt) * D + 64 * kt; t.ldt = D;
    }
    return t;
}
DI TItem moe_item(const Frame& F, const float* wg, const float* wu, const float* wd, int l, int it) {
    const int e = it / IT_EXP, r = it % IT_EXP, which = r >> 7, q = r & 127; TItem t;
    if (which < 2) {
        const int kt = q >> 3, nt = q & 7, n0 = 64 * nt;
        t.src = (which ? wu : wg) + ((size_t)l * NE + e) * D * DE + (size_t)(64 * kt) * DE + n0; t.ldw = DE;
        const size_t drow = (size_t)(n0 >> 7) * 256 + (which ? 128 : 0) + (n0 & 127);
        t.dst = (bf16_t*)(F.ws + WS_WGU) + (size_t)e * D * D + drow * D + 64 * kt; t.ldt = D;
    } else {
        const int kt = q >> 4, nt = q & 15;
        t.src = wd + ((size_t)l * NE + e) * DE * D + (size_t)(64 * kt) * D + 64 * nt; t.ldw = D;
        t.dst = (bf16_t*)(F.ws + WS_WD) + (size_t)e * D * DE + (size_t)(64 * nt) * DE + 64 * kt; t.ldt = DE;
    }
    return t;
}
DI void p0_prologue(const Frame& F, const Args& a) {
    const float* c = a.in[1]; const float* w_mod = a.in[2]; const float* b_mod = a.in[3];
    if (F.bx < L * (MODW / 64)) {
        LAS float* sc = (LAS float*)(F.lds);
        LAS float* red = (LAS float*)(F.lds + 8192);
        for (int i = F.tid; i < NB * D; i += NTHREADS) { const float v = c[i]; sc[i] = v / (1.f + expf(-v)); }
        __syncthreads();
        const int l = F.bx / (MODW / 64), cb = F.bx % (MODW / 64), n = cb * 64 + F.lane;
        const float* w = w_mod + (size_t)l * D * MODW + n;
        float a0 = 0.f, a1 = 0.f;
#pragma unroll 8
        for (int k = F.wave * 128; k < F.wave * 128 + 128; ++k) { const float wv = w[(size_t)k * MODW]; a0 += sc[k] * wv; a1 += sc[D + k] * wv; }
        red[(F.wave * 2 + 0) * 64 + F.lane] = a0; red[(F.wave * 2 + 1) * 64 + F.lane] = a1;
        __syncthreads();
        if (F.tid < 128) { const int b = F.tid >> 6, ln = F.tid & 63; float s = 0.f;
#pragma unroll
            for (int w8 = 0; w8 < 8; ++w8) s += red[(w8 * 2 + b) * 64 + ln];
            const int nn = cb * 64 + ln;
            ((float*)(F.ws + WS_MOD))[(size_t)(l * NB + b) * MODW + nn] = s + b_mod[l * MODW + nn]; }
        __syncthreads();
    }
    { const int nzero = L * 128 * D / 8;
      for (int i = F.gw * 64 + F.lane; i < nzero; i += F.ngw * 64) { const int l = i / (128 * D / 8), r = i % (128 * D / 8);
          *(u32x4*)((bf16_t*)(F.ws + WS_WIN + (size_t)l * WIN_LAYER) + (size_t)(2304 + 384) * D + (size_t)r * 8) = (u32x4){0u, 0u, 0u, 0u}; } }
    LAS float* scr = (LAS float*)(F.lds + 16384) + F.wave * (64 * 65);
    { f32x4 cur[16], nxt[16]; int it = F.gw; TItem tc{}, tn{};
      if (it < L * IT_SMALL) { tc = small_item(F, a.in[4], a.in[19], it); titem_load(tc, cur, F.lane); }
      for (; it < L * IT_SMALL; it += F.ngw) {
          const bool more = it + F.ngw < L * IT_SMALL;
          if (more) { tn = small_item(F, a.in[4], a.in[19], it + F.ngw); titem_load(tn, nxt, F.lane); }
          titem_store(tc, cur, scr, F.lane);
          if (more) { tc = tn;
#pragma unroll
              for (int i = 0; i < 16; ++i) cur[i] = nxt[i]; }
      } }
}

DI void row_ln(f32x4 (&v)[4], float& mean_out, float& rstd_out) {
    float s = 0.f;
#pragma unroll
    for (int j = 0; j < 4; ++j) s += (v[j][0] + v[j][1]) + (v[j][2] + v[j][3]);
    const float mean = wave_sum(s) * (1.f / D); float q = 0.f;
#pragma unroll
    for (int j = 0; j < 4; ++j) { v[j] = v[j] - mean; q += (v[j][0] * v[j][0] + v[j][1] * v[j][1]) + (v[j][2] * v[j][2] + v[j][3] * v[j][3]); }
    mean_out = mean; rstd_out = 1.f / sqrtf(wave_sum(q) * (1.f / D) + LN_EPS);
}
DI void row_mod_store(f32x4 (&v)[4], const float* md, int off_sh, int off_sc, bf16_t* urow, int lane) {
    float mean, rstd; row_ln(v, mean, rstd);
#pragma unroll
    for (int j = 0; j < 4; ++j) { const int col = 4 * lane + 256 * j;
        const f32x4 scv = *(const f32x4*)(md + off_sc + col), shv = *(const f32x4*)(md + off_sh + col);
        v[j] = v[j] * rstd * (1.f + scv) + shv;
        u32x2 w; w.x = cvtpk(v[j][0], v[j][1]); w.y = cvtpk(v[j][2], v[j][3]);
        *(u32x2*)(urow + col) = w; }
}
DI void p_r0(const Frame& F, const float* x) {
    const float* MOD = (const float*)(F.ws + WS_MOD);
    bf16_t* U = (bf16_t*)(F.ws + WS_U);
    for (int row = F.gw; row < T; row += F.ngw) {
        f32x4 v[4];
#pragma unroll
        for (int j = 0; j < 4; ++j) v[j] = *(const f32x4*)(x + (size_t)row * D + 4 * F.lane + 256 * j);
        row_mod_store(v, MOD + (size_t)(row / S) * MODW, 0, D, U + (size_t)row * D, F.lane);
    }
}

constexpr int NGRP = T / 64;
DI void p_rowpass1(const Frame& F, const Args& a, int l, const float* xin, const bool dry = false) {
    const float* MODl = (const float*)(F.ws + WS_MOD) + (size_t)l * NB * MODW;
    const bf16_t* MIX = (const bf16_t*)(F.ws + WS_MIX);
    float* XA = (float*)(F.ws + WS_XA); bf16_t* U = (bf16_t*)(F.ws + WS_U);
    const float* gain = a.in[20] + (size_t)l * D; const float* bias = a.in[21] + (size_t)l * D;
    const float* wg = a.in[24] + (size_t)l * D * NG; const float* bg = a.in[25] + (size_t)l * NG;
    const float* we = a.in[26] + (size_t)l * D * NE; const float* be = a.in[27] + (size_t)l * NE;
    const size_t dro = dry ? 490 * MiB - WS_BC : 0;
    int* BC = (int*)(F.ws + WS_BC + dro); float* TOKW = (float*)(F.ws + WS_TOKW + dro); int* TOKSLOT = (int*)(F.ws + WS_TOKSLOT + (dry ? 496 * MiB - WS_TOKSLOT : 0));
    LAS float* RT = (LAS float*)F.lds;
    LAS unsigned* cntl = (LAS unsigned*)(F.lds + 36 * D * 4 + NWAVES * 72 * 4);
#pragma unroll
    for (int kk = 0; kk < 2; ++kk) { const int k = F.tid + kk * NTHREADS;
        f32x4 v[9]; v[0] = *(const f32x4*)(wg + (size_t)k * NG);
#pragma unroll
        for (int q = 0; q < 8; ++q) v[1 + q] = *(const f32x4*)(we + (size_t)k * NE + 4 * q);
#pragma unroll
        for (int q = 0; q < 9; ++q)
#pragma unroll
            for (int e = 0; e < 4; ++e) RT[(4 * q + e) * D + k] = v[q][e]; }
    for (int grp = F.vcu; grp < NGRP; grp += F.G) {
    if (F.tid < NE) cntl[F.tid] = 0u;
    __syncthreads();
    f32x4 pxa[4], pxb[4]; u32x2 pma[4], pmb[4];
    { const int r0 = 64 * grp + 8 * F.wave;
#pragma unroll
      for (int j = 0; j < 4; ++j) { const int col = 4 * F.lane + 256 * j; pxa[j] = *(const f32x4*)(xin + (size_t)r0 * D + col); pxb[j] = *(const f32x4*)(xin + (size_t)(r0 + 1) * D + col);
          pma[j] = *(const u32x2*)(MIX + (size_t)r0 * D + col); pmb[j] = *(const u32x2*)(MIX + (size_t)(r0 + 1) * D + col); } }
    for (int rp = 0; rp < 4; ++rp) {
        const int row0 = 64 * grp + 8 * F.wave + 2 * rp; const float* md = MODl + (size_t)(row0 / S) * MODW;
        f32x4 va[4], vb[4];
#pragma unroll
        for (int j = 0; j < 4; ++j) { const int col = 4 * F.lane + 256 * j;
            const f32x4 g = *(const f32x4*)(md + 2 * D + col);
            va[j] = pxa[j] * ALPHA + g * (f32x4){bflo(pma[j].x), bfhi(pma[j].x), bflo(pma[j].y), bfhi(pma[j].y)};
            vb[j] = pxb[j] * ALPHA + g * (f32x4){bflo(pmb[j].x), bfhi(pmb[j].x), bflo(pmb[j].y), bfhi(pmb[j].y)}; }
        if (rp < 3) { const int r0 = row0 + 2;
#pragma unroll
          for (int j = 0; j < 4; ++j) { const int col = 4 * F.lane + 256 * j; pxa[j] = *(const f32x4*)(xin + (size_t)r0 * D + col); pxb[j] = *(const f32x4*)(xin + (size_t)(r0 + 1) * D + col);
              pma[j] = *(const u32x2*)(MIX + (size_t)r0 * D + col); pmb[j] = *(const u32x2*)(MIX + (size_t)(r0 + 1) * D + col); } }
        float mean, rstd;
        row_ln(va, mean, rstd);
#pragma unroll
        for (int j = 0; j < 4; ++j) { const int col = 4 * F.lane + 256 * j; va[j] = va[j] * rstd * *(const f32x4*)(gain + col) + *(const f32x4*)(bias + col); *(f32x4*)(XA + (size_t)row0 * D + col) = va[j]; }
        row_ln(vb, mean, rstd);
#pragma unroll
        for (int j = 0; j < 4; ++j) { const int col = 4 * F.lane + 256 * j; vb[j] = vb[j] * rstd * *(const f32x4*)(gain + col) + *(const f32x4*)(bias + col); *(f32x4*)(XA + (size_t)(row0 + 1) * D + col) = vb[j]; }
        row_mod_store(va, md, 3 * D, 4 * D, U + (size_t)row0 * D, F.lane);
        row_mod_store(vb, md, 3 * D, 4 * D, U + (size_t)(row0 + 1) * D, F.lane);
#ifdef DRY_NOROUTER
        if (dry) continue;
#endif
        LAS float* lg = (LAS float*)(F.lds + 36 * D * 4) + F.wave * 72;
#pragma unroll 1
        for (int n = 0; n < 36; n += 3) { float sa[3], sb[3];
#pragma unroll
            for (int q = 0; q < 3; ++q) { sa[q] = 0.f; sb[q] = 0.f;
#pragma unroll
                for (int j = 0; j < 4; ++j) { const f32x4 w = *(const LAS f32x4*)(RT + (n + q) * D + 4 * F.lane + 256 * j);
                    sa[q] += (va[j][0] * w[0] + va[j][1] * w[1]) + (va[j][2] * w[2] + va[j][3] * w[3]);
                    sb[q] += (vb[j][0] * w[0] + vb[j][1] * w[1]) + (vb[j][2] * w[2] + vb[j][3] * w[3]); } }
#pragma unroll
            for (int q = 0; q < 3; ++q) { sa[q] = wave_sum(sa[q]); sb[q] = wave_sum(sb[q]); }
            if (F.lane == 0) {
#pragma unroll
                for (int q = 0; q < 3; ++q) { lg[n + q] = sa[q]; lg[36 + n + q] = sb[q]; } } }
        LDS_WAIT();
#pragma unroll
        for (int rr = 0; rr < 2; ++rr) {
            float gl[4];
#pragma unroll
            for (int n = 0; n < 4; ++n) gl[n] = lg[36 * rr + n] + bg[n];
            int gi = 0; float gm = gl[0];
#pragma unroll
            for (int n = 1; n < 4; ++n) { const bool c = gl[n] > gm; gm = c ? gl[n] : gm; gi = c ? n : gi; }
            float se = 0.f;
#pragma unroll
            for (int n = 0; n < 4; ++n) se += expf(gl[n] - gm);
            const float pg = 1.f / se;
            float l1 = -3.0e38f, l2 = -3.0e38f; int i1 = 0, i2 = 0;
#pragma unroll
            for (int e = 0; e < 8; ++e) { const float v = lg[36 * rr + 4 + gi * EPG + e] + be[gi * EPG + e];
                const bool c1 = v > l1, c2 = v > l2;
                l2 = c1 ? l1 : (c2 ? v : l2); i2 = c1 ? i1 : (c2 ? e : i2); l1 = c1 ? v : l1; i1 = c1 ? e : i1; }
            const float e2 = expf(l2 - l1); const float w1 = pg / (1.f + e2), w2 = pg * e2 / (1.f + e2);
            if (F.lane == 0) {
                const int tok = row0 + rr, ea = gi * EPG + i1, eb = gi * EPG + i2;
                const unsigned pa = __hip_atomic_fetch_add(&cntl[ea], 1u, __ATOMIC_RELAXED, __HIP_MEMORY_SCOPE_WORKGROUP), pb = __hip_atomic_fetch_add(&cntl[eb], 1u, __ATOMIC_RELAXED, __HIP_MEMORY_SCOPE_WORKGROUP);
                TOKSLOT[tok * 2] = (ea << 14) | (int)pa; TOKSLOT[tok * 2 + 1] = (eb << 14) | (int)pb;
                TOKW[tok * 2] = w1; TOKW[tok * 2 + 1] = w2;
            }
        }
    }
    __syncthreads();
    if (F.tid < NE) BC[grp * NE + F.tid] = (int)cntl[F.tid];
    __syncthreads();
    }
}

DI void build_tables(const Frame& F, int l, LAS int* tb) {
    if (F.tid < 64) {
        const int e = F.lane; const int c = e < NE ? ((const int*)(F.ws + WS_CNTF))[e] : 0; const int tl = (c + 255) >> 8;
        int cum = c, tin = tl;
#pragma unroll
        for (int o = 1; o < 32; o <<= 1) { const int a1 = __shfl_up(cum, o), a2 = __shfl_up(tin, o); if (e >= o) { cum += a1; tin += a2; } }
        if (e < NE) { tb[e] = cum - c; tb[33 + e] = (tin - tl) * 256; for (int t2 = 0; t2 < tl; ++t2) tb[66 + (tin - tl) + t2] = e; }
        if (e == NE - 1) { tb[32] = cum; tb[65] = tin; }
    }
    __syncthreads();
}
DI void p_gather(const Frame& F, int l) {
    LAS int* base = (LAS int*)F.lds;
    LAS int* segt = base + NGRP * NE;
    LAS int* offp = segt + 16 * NE;
    const int* BC = (const int*)(F.ws + WS_BC);
    { int tmp[NGRP * NE / NTHREADS];
#pragma unroll
      for (int q = 0; q < NGRP * NE / NTHREADS; ++q) tmp[q] = BC[F.tid + q * NTHREADS];
#pragma unroll
      for (int q = 0; q < NGRP * NE / NTHREADS; ++q) base[F.tid + q * NTHREADS] = tmp[q]; }
    __syncthreads();
    { const int e = F.tid & 31, sg = F.tid >> 5; int run = 0;
      for (int g = 16 * sg; g < 16 * sg + 16; ++g) { const int c = base[g * NE + e]; base[g * NE + e] = run; run += c; }
      segt[sg * NE + e] = run; }
    __syncthreads();
    if (F.tid < NE) { int run = 0; for (int sg = 0; sg < 16; ++sg) { const int c = segt[sg * NE + F.tid]; segt[sg * NE + F.tid] = run; run += c; }
        offp[F.tid] = run;
        if (F.bx == 0) ((int*)(F.ws + WS_CNTF))[F.tid] = run; }
    __syncthreads();
    if (F.tid == 0) { int off = 0; for (int e = 0; e < NE; ++e) { const int c = offp[e]; offp[e] = off; off += ((c + 255) >> 8) * 256; } }
    __syncthreads();
    const int* TOKSLOT = (const int*)(F.ws + WS_TOKSLOT); const float* TOKW = (const float*)(F.ws + WS_TOKW); int* TOKFIN = (int*)(F.ws + WS_TOKFIN);
    float* SLOTW = (float*)(F.ws + WS_SLOTW);
    const int nas = (2 * T - F.gw + F.ngw - 1) / F.ngw;
    int my_slot = 0, my_tok = 0;
    if (F.lane < nas) { const int as = F.gw + F.lane * F.ngw; const int tok = as >> 1, ts = TOKSLOT[as], e = ts >> 14, grp = tok >> 6, sg = grp >> 4;
        my_slot = offp[e] + segt[sg * NE + e] + base[grp * NE + e] + (ts & 16383); my_tok = tok;
        SLOTW[my_slot] = TOKW[as]; TOKFIN[as] = my_slot; ((int*)(F.ws + WS_CTL + WS_SLOTTOK))[my_slot] = tok; }
}
struct Rp2In { f32x4 x[4]; u32x2 y0[4], y1[4]; };
DI void rp2_load(Rp2In& r, const float* XA, const bf16_t* YS, int row, int s0, int s1, int lane) {
#pragma unroll
    for (int j = 0; j < 4; ++j) { const int col = 4 * lane + 256 * j;
        r.x[j] = *(const f32x4*)(XA + (size_t)row * D + col); r.y0[j] = *(const u32x2*)(YS + (size_t)s0 * D + col); r.y1[j] = *(const u32x2*)(YS + (size_t)s1 * D + col); }
}
DI void p_rowpass2(const Frame& F, const Args& a, int l, float* xout) {
    const float* MOD = (const float*)(F.ws + WS_MOD);
    const float* XA = (const float*)(F.ws + WS_XA); const bf16_t* YS = (const bf16_t*)(F.ws + WS_YS); const int* TOKFIN = (const int*)(F.ws + WS_TOKFIN);
    const float* gain = a.in[22] + (size_t)l * D; const float* bias = a.in[23] + (size_t)l * D;
    bf16_t* U = (bf16_t*)(F.ws + WS_U);
    const int nrows = (T - F.gw + F.ngw - 1) / F.ngw;
    int tf = 0; { const int i = F.lane >> 1; if (i < nrows) tf = TOKFIN[(F.gw + i * F.ngw) * 2 + (F.lane & 1)]; }
    Rp2In cur, nxt;
    if (nrows > 0) rp2_load(cur, XA, YS, F.gw, __shfl(tf, 0), __shfl(tf, 1), F.lane);
    for (int i = 0; i < nrows; ++i) {
        const int row = F.gw + i * F.ngw;
        if (i + 1 < nrows) rp2_load(nxt, XA, YS, row + F.ngw, __shfl(tf, 2 * i + 2), __shfl(tf, 2 * i + 3), F.lane);
        const float* md = MOD + (size_t)(l * NB + row / S) * MODW;
        f32x4 v[4];
#pragma unroll
        for (int j = 0; j < 4; ++j) { const int col = 4 * F.lane + 256 * j;
            const f32x4 g = *(const f32x4*)(md + 5 * D + col);
            const u32x2 y0 = cur.y0[j], y1 = cur.y1[j];
            const f32x4 f = (f32x4){bflo(y0.x) + bflo(y1.x), bfhi(y0.x) + bfhi(y1.x), bflo(y0.y) + bflo(y1.y), bfhi(y0.y) + bfhi(y1.y)};
            v[j] = cur.x[j] * ALPHA + g * f; }
        float mean, rstd; row_ln(v, mean, rstd);
#pragma unroll
        for (int j = 0; j < 4; ++j) { const int col = 4 * F.lane + 256 * j; v[j] = v[j] * rstd * *(const f32x4*)(gain + col) + *(const f32x4*)(bias + col); *(f32x4*)(xout + (size_t)row * D + col) = v[j]; }
        if (l + 1 < L) row_mod_store(v, MOD + (size_t)((l + 1) * NB + row / S) * MODW, 0, D, U + (size_t)row * D, F.lane);
        if (i + 1 < nrows) {
#pragma unroll
            for (int j = 0; j < 4; ++j) { cur.x[j] = nxt.x[j]; cur.y0[j] = nxt.y0[j]; cur.y1[j] = nxt.y1[j]; } }
    }
}

#define MFMA16(a, b, c) __builtin_amdgcn_mfma_f32_16x16x32_bf16((a), (b), (c), 0, 0, 0)
#define MFMA32(a, b, c) __builtin_amdgcn_mfma_f32_32x32x16_bf16((a), (b), (c), 0, 0, 0)
constexpr int RB = 9216;
#define BUF(i) ((i) * RB)
constexpr int LWOFF = BUF(12), ZAOFF = BUF(0), SEGOFF = BUF(14), SEGXOFF = BUF(14) + 2048, TOTOFF = BUF(14) + 4096, NABFOFF = BUF(15), PCOFF = 16 * RB;
struct RwP { const float *conv, *w0, *w_up, *a0, *a_up, *g_up, *k_k, *k_a, *r_k, *gn_gain, *gn_bias; };

DI void lds_barrier() { asm volatile("s_waitcnt lgkmcnt(0)" ::: "memory"); __builtin_amdgcn_s_barrier(); asm volatile("" ::: "memory"); }
DI int swo(int row, int col) { return row * 144 + (((((col >> 3) ^ (row >> 3)) & 7) << 3) + (col & 7)) * 2; }
DI bf16x8 ldfrag(const LAS unsigned char* lds, int buf, int row, int ks, int lane) { return *(const LAS bf16x8*)(lds + buf + swo(row, 32 * ks + 8 * (lane >> 4))); }
DI f32x4 mm64(const LAS unsigned char* lds, int abuf, int arow0, int bbuf, int brow0, int lane) {
    f32x4 acc = (f32x4){0.f, 0.f, 0.f, 0.f};
#pragma unroll
    for (int ks = 0; ks < 2; ++ks) acc = MFMA16(ldfrag(lds, abuf, arow0 + (lane & 15), ks, lane), ldfrag(lds, bbuf, brow0 + (lane & 15), ks, lane), acc);
    return acc;
}
DI u32x2 pack4(const f32x4 v) { u32x2 w; w.x = cvtpk(v[0], v[1]); w.y = cvtpk(v[2], v[3]); return w; }
DI f32x4 unpack4(const u32x2 w) { return (f32x4){bflo(w.x), bfhi(w.x), bflo(w.y), bfhi(w.y)}; }
DI void st4(LAS unsigned char* lds, int buf, int row, int col, const f32x4 v) { *(LAS u32x2*)(lds + buf + swo(row, col)) = pack4(v); }
DI f32x4 ld4(const LAS unsigned char* lds, int buf, int row, int col) { return unpack4(*(const LAS u32x2*)(lds + buf + swo(row, col))); }
DI void st1(LAS unsigned char* lds, int buf, int row, int col, float v) { *(LAS bf16_t*)(lds + buf + swo(row, col)) = f2bf(v); }
DI float fast_tanh(float x) { const float e = fexp2(x * (2.f * LOG2E)); return 1.f - 2.f * frcp(1.f + e); }

#define OPQZ(z) int z; asm volatile("s_mov_b32 %0, 0" : "=s"(z))
constexpr int CWLOFF = PCOFF + 256;
constexpr int PRMOFF = CWLOFF + 6912;
struct RwPre { u32x2 wv, av; u32x4 gv; f32x4 w4, a4, g0, g1; u32x4 rr[3], kk[3], vv[3]; };
DI void rwkv_prefetch(const Frame& F, const Args& a, const int l, const int unit, RwPre& P) {
    const int tid = F.tid;
    const int c = unit % NCH, hd = (unit / NCH) % BH, b = (unit / (NCH * BH)) % NB, dir = unit / (NCH * BH * NB);
    const bf16_t* HBp = (const bf16_t*)(F.ws + WS_HB);
    const int u = tid >> 3, jg = tid & 7, tloc = 64 * c + u; const size_t tok = (size_t)b * S + tloc;
    const bf16_t* hrow = HBp + tok * HW;
    P.wv = *(const u32x2*)(hrow + HWL + 4 * jg); P.av = *(const u32x2*)(hrow + HAL + 4 * jg); P.gv = *(const u32x4*)(hrow + HGL + 8 * jg);
    OPQZ(z0);
    { const int m = tid >> 4, j4 = (tid & 15) * 4;
      const float* w_up = a.in[8 + z0] + (size_t)l * 2 * RW * BW; const float* a_up = a.in[10 + z0] + (size_t)l * 2 * RA * BW;
      P.w4 = *(const f32x4*)(w_up + (size_t)(dir * RW + m) * BW + hd * HD + j4); P.a4 = *(const f32x4*)(a_up + (size_t)(dir * RA + m) * BW + hd * HD + j4); }
    { const int m = tid >> 3, i8 = (tid & 7) * 8; const float* g_up = a.in[11 + z0] + (size_t)l * RG * BW;
      P.g0 = *(const f32x4*)(g_up + (size_t)m * BW + hd * HD + i8); P.g1 = *(const f32x4*)(g_up + (size_t)m * BW + hd * HD + i8 + 4); }
    const int ch0 = hd * HD + 8 * jg;
#pragma unroll
    for (int x = 0; x < 3; ++x) {
        const int tt = tloc + x - 1; const u32x4 z4 = (u32x4){0u, 0u, 0u, 0u};
        if (tt >= 0 && tt < S) { const bf16_t* hp = HBp + ((size_t)b * S + tt) * HW + HR + ch0; P.rr[x] = *(const u32x4*)hp; P.kk[x] = *(const u32x4*)(hp + BW); P.vv[x] = *(const u32x4*)(hp + 2 * BW); }
        else { P.rr[x] = z4; P.kk[x] = z4; P.vv[x] = z4; }
    }
}
DI void rwkv_local_unit(const Frame& F, const Args& a, const int l, const int unit, RwPre& PF, const int next_unit) {
    LAS unsigned char* lds = F.lds;
    int tid_ = F.tid; asm volatile("" : "+v"(tid_));
    const int tid = tid_, lane = tid_ & 63, wave = F.wave;
    const int c = unit % NCH, hd = (unit / NCH) % BH, b = (unit / (NCH * BH)) % NB, dir = unit / (NCH * BH * NB);
    const bf16_t* HBp = (const bf16_t*)(F.ws + WS_HB);
    const int u = tid >> 3, jg = tid & 7, tau = dir ? 63 - u : u, tloc = 64 * c + u;
    const size_t tok = (size_t)b * S + tloc;
    const int tn = wave & 3, tm0 = 2 * (wave >> 2), g4 = lane >> 4, l15 = lane & 15;
    if (tid < 320) { OPQZ(z2); const int which = tid >> 6, j = tid & 63;
      const float* src = which == 0 ? a.in[7 + z2] + (size_t)l * 2 * BW + dir * BW : which == 1 ? a.in[9 + z2] + (size_t)l * 2 * BW + dir * BW : which == 2 ? a.in[12 + z2] + (size_t)l * BW : which == 3 ? a.in[13 + z2] + (size_t)l * BW : a.in[14 + z2] + (size_t)l * BH * HD;
      *(LAS float*)(lds + PRMOFF + tid * 4) = src[hd * HD + j]; }
    {
        const f32x4 wf = unpack4(PF.wv);
        *(LAS u32x2*)(lds + BUF(8) + swo(tau, 4 * jg)) = pack4((f32x4){fast_tanh(wf[0]), fast_tanh(wf[1]), fast_tanh(wf[2]), fast_tanh(wf[3])});
        *(LAS u32x2*)(lds + BUF(8) + swo(tau, 32 + 4 * jg)) = PF.av;
        const u32x4 gv = PF.gv;
        u32x4 so; so.x = cvtpk(sigm(bflo(gv.x)), sigm(bfhi(gv.x))); so.y = cvtpk(sigm(bflo(gv.y)), sigm(bfhi(gv.y))); so.z = cvtpk(sigm(bflo(gv.z)), sigm(bfhi(gv.z))); so.w = cvtpk(sigm(bflo(gv.w)), sigm(bfhi(gv.w)));
        *(LAS u32x4*)(lds + BUF(9) + swo(tau, 8 * jg)) = so;
        { const int m = tid >> 4, j4 = (tid & 15) * 4;
#pragma unroll
          for (int e = 0; e < 4; ++e) { st1(lds, BUF(10), j4 + e, m, PF.w4[e]); st1(lds, BUF(10), j4 + e, 32 + m, PF.a4[e]); } }
        { const int m = tid >> 3, i8 = (tid & 7) * 8;
#pragma unroll
          for (int e = 0; e < 4; ++e) { st1(lds, BUF(11), i8 + e, m, PF.g0[e]); st1(lds, BUF(11), i8 + 4 + e, m, PF.g1[e]); } }
    }
    lds_barrier();
#pragma unroll
    for (int tmi = 0; tmi < 2; ++tmi) {
        const int tm = tm0 + tmi; const f32x4 z = (f32x4){0.f, 0.f, 0.f, 0.f};
        const f32x4 zw = MFMA16(ldfrag(lds, BUF(10), 16 * tm + l15, 0, lane), ldfrag(lds, BUF(8), 16 * tn + l15, 0, lane), z);
        const f32x4 za = MFMA16(ldfrag(lds, BUF(10), 16 * tm + l15, 1, lane), ldfrag(lds, BUF(8), 16 * tn + l15, 1, lane), z);
        const int trow = 16 * tn + l15, jb = 16 * tm + 4 * g4;
        *(LAS f32x4*)(lds + LWOFF + (trow * 64 + jb) * 4) = zw;
        *(LAS f32x4*)(lds + ZAOFF + (trow * 64 + jb) * 4) = za;
        if (dir == 0) {
            const f32x4 gg = mm64(lds, BUF(11), 16 * tm, BUF(9), 16 * tn, lane);
            *(u32x2*)((bf16_t*)(F.ws + WS_GB) + ((size_t)b * S + 64 * c + trow) * BW + hd * HD + jb) = pack4(gg);
        }
    }
    lds_barrier();
    const int ch0 = hd * HD + 8 * jg;
    float r[8], kd[8], kap[8], bb[8], lw[8];
    {
        float k[8], v[8];
#pragma unroll
        for (int e = 0; e < 8; ++e) { r[e] = 0.f; k[e] = 0.f; v[e] = 0.f; }
#pragma unroll
        for (int x = 0; x < 3; ++x) {
            const LAS unsigned char* cwp = lds + CWLOFF + (((hd * 3 + x) * 3) * 64 + 8 * jg) * 2;
            const u32x4 cr = *(const LAS u32x4*)cwp, ck = *(const LAS u32x4*)(cwp + 128), cv = *(const LAS u32x4*)(cwp + 256);
            const u32x4 rr = PF.rr[x], kk2 = PF.kk[x], vv = PF.vv[x];
            r[0] += bflo(rr.x) * bflo(cr.x); r[1] += bfhi(rr.x) * bfhi(cr.x); r[2] += bflo(rr.y) * bflo(cr.y); r[3] += bfhi(rr.y) * bfhi(cr.y);
            r[4] += bflo(rr.z) * bflo(cr.z); r[5] += bfhi(rr.z) * bfhi(cr.z); r[6] += bflo(rr.w) * bflo(cr.w); r[7] += bfhi(rr.w) * bfhi(cr.w);
            k[0] += bflo(kk2.x) * bflo(ck.x); k[1] += bfhi(kk2.x) * bfhi(ck.x); k[2] += bflo(kk2.y) * bflo(ck.y); k[3] += bfhi(kk2.y) * bfhi(ck.y);
            k[4] += bflo(kk2.z) * bflo(ck.z); k[5] += bfhi(kk2.z) * bfhi(ck.z); k[6] += bflo(kk2.w) * bflo(ck.w); k[7] += bfhi(kk2.w) * bfhi(ck.w);
            v[0] += bflo(vv.x) * bflo(cv.x); v[1] += bfhi(vv.x) * bfhi(cv.x); v[2] += bflo(vv.y) * bflo(cv.y); v[3] += bfhi(vv.y) * bfhi(cv.y);
            v[4] += bflo(vv.z) * bflo(cv.z); v[5] += bfhi(vv.z) * bfhi(cv.z); v[6] += bflo(vv.w) * bflo(cv.w); v[7] += bfhi(vv.w) * bfhi(cv.w);
        }
        const f32x4 zw0 = *(const LAS f32x4*)(lds + LWOFF + (tau * 64 + 8 * jg) * 4), zw1 = *(const LAS f32x4*)(lds + LWOFF + (tau * 64 + 8 * jg + 4) * 4);
        const f32x4 za0 = *(const LAS f32x4*)(lds + ZAOFF + (tau * 64 + 8 * jg) * 4), za1 = *(const LAS f32x4*)(lds + ZAOFF + (tau * 64 + 8 * jg + 4) * 4);
        float ss = 0.f, bsp = 0.f, av[8];
        const LAS f32x4* prm = (const LAS f32x4*)(lds + PRMOFF) + 2 * jg;
        const f32x4 w0a = prm[0], w0b = prm[1], a0a = prm[16], a0b = prm[17], kka = prm[32], kkb = prm[33], kaa = prm[48], kab = prm[49], rka = prm[64], rkb = prm[65];
#pragma unroll
        for (int e = 0; e < 8; ++e) {
            const float zw = (e < 4 ? zw0[e & 3] : zw1[e & 3]) + (e < 4 ? w0a[e & 3] : w0b[e & 3]);
            const float za = (e < 4 ? za0[e & 3] : za1[e & 3]) + (e < 4 ? a0a[e & 3] : a0b[e & 3]);
            lw[e] = (-DECAY * LOG2E) * sigm(zw); av[e] = sigm(za);
            kap[e] = k[e] * (e < 4 ? kka[e & 3] : kkb[e & 3]); ss += kap[e] * kap[e];
            kd[e] = k[e] * (1.f + (av[e] - 1.f) * (e < 4 ? kaa[e & 3] : kab[e & 3]));
            bsp += r[e] * kd[e] * (e < 4 ? rka[e & 3] : rkb[e & 3]);
        }
        ss += __shfl_xor(ss, 1); ss += __shfl_xor(ss, 2); ss += __shfl_xor(ss, 4);
        bsp += __shfl_xor(bsp, 1); bsp += __shfl_xor(bsp, 2); bsp += __shfl_xor(bsp, 4);
        const float rn = __builtin_amdgcn_rsqf(fmaxf(ss, 1e-24f));
#pragma unroll
        for (int e = 0; e < 8; ++e) { kap[e] *= rn; bb[e] = kap[e] * av[e]; }
        if (jg == 0) ((float*)(F.ws + WS_BS))[((size_t)dir * T + tok) * 8 + hd] = bsp;
        *(LAS f32x4*)(lds + LWOFF + (tau * 64 + 8 * jg) * 4) = (f32x4){lw[0], lw[1], lw[2], lw[3]};
        *(LAS f32x4*)(lds + LWOFF + (tau * 64 + 8 * jg + 4) * 4) = (f32x4){lw[4], lw[5], lw[6], lw[7]};
#pragma unroll
        for (int e = 0; e < 8; ++e) st1(lds, BUF(7), 8 * jg + e, tau, v[e]);
        if (dir == 0) {
            u32x4 vo; vo.x = cvtpk(v[0], v[1]); vo.y = cvtpk(v[2], v[3]); vo.z = cvtpk(v[4], v[5]); vo.w = cvtpk(v[6], v[7]);
            *(u32x4*)((bf16_t*)(F.ws + WS_VC) + tok * BW + ch0) = vo;
        }
    }
    lds_barrier();
    if (dir == 0) {
        const size_t ucidx = ((size_t)b * BH + hd) * NCH + c; const int vi = tid >> 3, vc = tid & 7;
        *(u32x4*)((bf16_t*)(F.ws + WS_VTB) + ucidx * 4096 + vi * 64 + vc * 8) = *(const LAS u32x4*)(lds + BUF(7) + swo(vi, 8 * vc));
    }
    { const int seg = tid >> 6, j = tid & 63; float p = 0.f;
#pragma unroll
      for (int i = 0; i < 8; ++i) { LAS float* q = (LAS float*)(lds + LWOFF + ((8 * seg + i) * 64 + j) * 4); p += *q; *q = p; }
      *(LAS float*)(lds + SEGOFF + (seg * 64 + j) * 4) = p; }
    lds_barrier();
    if (tid < 64) { float run = 0.f;
#pragma unroll
      for (int sg = 0; sg < 8; ++sg) { *(LAS float*)(lds + SEGXOFF + (sg * 64 + tid) * 4) = run; run += *(const LAS float*)(lds + SEGOFF + (sg * 64 + tid) * 4); }
      *(LAS float*)(lds + TOTOFF + tid * 4) = run; }
    lds_barrier();
    {
        float At[8], Rt[8], Bt[8], Kt[8], Bh[8], Kh[8], pcs[8];
#pragma unroll
        for (int e = 0; e < 8; ++e) {
            const int j = 8 * jg + e;
            const float lwi = *(const LAS float*)(lds + LWOFF + (tau * 64 + j) * 4) + *(const LAS float*)(lds + SEGXOFF + ((tau >> 3) * 64 + j) * 4);
            const float tot = *(const LAS float*)(lds + TOTOFF + j * 4);
            const float ep = fexp2(lwi - lw[e]), epl = fexp2(lwi), em = fexp2(-lwi), ec = fexp2(tot - lwi);
            At[e] = -kap[e] * ep; Rt[e] = r[e] * epl; Bt[e] = bb[e] * em; Kt[e] = kd[e] * em; Bh[e] = bb[e] * ec; Kh[e] = kd[e] * ec;
            pcs[e] = tot;
        }
        if (u == 0) {
            *(LAS f32x4*)(lds + PCOFF + (8 * jg) * 4) = (f32x4){fexp2(pcs[0]), fexp2(pcs[1]), fexp2(pcs[2]), fexp2(pcs[3])};
            *(LAS f32x4*)(lds + PCOFF + (8 * jg + 4) * 4) = (f32x4){fexp2(pcs[4]), fexp2(pcs[5]), fexp2(pcs[6]), fexp2(pcs[7])}; }
        u32x4 o;
#define PK8(X) (o.x = cvtpk(X[0], X[1]), o.y = cvtpk(X[2], X[3]), o.z = cvtpk(X[4], X[5]), o.w = cvtpk(X[6], X[7]), o)
        *(LAS u32x4*)(lds + BUF(0) + swo(tau, 8 * jg)) = PK8(At);
        *(LAS u32x4*)(lds + BUF(1) + swo(tau, 8 * jg)) = PK8(Bt);
        *(LAS u32x4*)(lds + BUF(2) + swo(tau, 8 * jg)) = PK8(Kt);
        *(LAS u32x4*)(lds + BUF(3) + swo(tau, 8 * jg)) = PK8(Rt);
#undef PK8
#pragma unroll
        for (int e = 0; e < 8; ++e) { const int j = 8 * jg + e; st1(lds, BUF(4), j, tau, At[e]); st1(lds, BUF(5), j, tau, Bh[e]); st1(lds, BUF(6), j, tau, Kh[e]); }
    }
    if (next_unit >= 0) rwkv_prefetch(F, a, l, next_unit, PF);
    lds_barrier();
#pragma unroll
    for (int tmi = 0; tmi < 2; ++tmi) {
        const int tm = tm0 + tmi, mb = 16 * tm + 4 * g4, nn = 16 * tn + l15;
        { f32x4 v = mm64(lds, BUF(1), 16 * tm, BUF(0), 16 * tn, lane);
#pragma unroll
          for (int e = 0; e < 4; ++e) v[e] = (mb + e < nn) ? v[e] : 0.f;
          if (tm == tn) {
#pragma unroll
              for (int e = 0; e < 4; ++e) *(LAS float*)(lds + NABFOFF + ((16 * tm + l15) * 16 + ((mb + e) & 15)) * 4) = v[e];
              v = (f32x4){0.f, 0.f, 0.f, 0.f};
          }
          st4(lds, BUF(11), nn, mb, v); }
        { f32x4 v = mm64(lds, BUF(0), 16 * tm, BUF(2), 16 * tn, lane);
#pragma unroll
          for (int e = 0; e < 4; ++e) v[e] = (nn < mb + e) ? v[e] : 0.f;
          st4(lds, BUF(8), nn, mb, v); }
        { f32x4 v = mm64(lds, BUF(1), 16 * tm, BUF(3), 16 * tn, lane);
#pragma unroll
          for (int e = 0; e < 4; ++e) v[e] = (mb + e <= nn) ? v[e] : 0.f;
          st4(lds, BUF(9), nn, mb, v); }
        { f32x4 v = mm64(lds, BUF(2), 16 * tm, BUF(3), 16 * tn, lane);
#pragma unroll
          for (int e = 0; e < 4; ++e) v[e] = (mb + e <= nn) ? v[e] : 0.f;
          st4(lds, BUF(10), nn, mb, v); }
    }
    lds_barrier();
    if (wave == 0) {
        const int blk = lane >> 4, sr = lane & 15, s = 16 * blk + sr;
        float Tr[16];
#pragma unroll
        for (int t = 0; t < 16; ++t) { float acc = (t == sr) ? 1.f : 0.f;
            const LAS f32x4* col = (const LAS f32x4*)(lds + NABFOFF + ((16 * blk + t) * 16) * 4);
#pragma unroll
            for (int q = 0; q < (t + 3) / 4; ++q) { const f32x4 nv = col[q];
#pragma unroll
                for (int e = 0; e < 4; ++e) if (4 * q + e < t) acc += Tr[4 * q + e] * nv[e]; }
            Tr[t] = acc; __builtin_amdgcn_sched_barrier(0); }
        const u32x4 z4 = (u32x4){0u, 0u, 0u, 0u};
#pragma unroll
        for (int q = 0; q < 9; ++q) { *(LAS u32x4*)(lds + BUF(0) + s * 144 + 16 * q) = z4; *(LAS u32x4*)(lds + BUF(1) + s * 144 + 16 * q) = z4; }
        u32x4 o0, o1; o0.x = cvtpk(Tr[0], Tr[1]); o0.y = cvtpk(Tr[2], Tr[3]); o0.z = cvtpk(Tr[4], Tr[5]); o0.w = cvtpk(Tr[6], Tr[7]);
        o1.x = cvtpk(Tr[8], Tr[9]); o1.y = cvtpk(Tr[10], Tr[11]); o1.z = cvtpk(Tr[12], Tr[13]); o1.w = cvtpk(Tr[14], Tr[15]);
        LDS_WAIT();
        *(LAS u32x4*)(lds + BUF(0) + swo(s, 16 * blk)) = o0; *(LAS u32x4*)(lds + BUF(0) + swo(s, 16 * blk + 8)) = o1;
#pragma unroll
        for (int t = 0; t < 16; ++t) st1(lds, BUF(1), 16 * blk + t, s, Tr[t]);
    }
    lds_barrier();
#pragma unroll
    for (int tmi = 0; tmi < 2; ++tmi) {
        const int tm = tm0 + tmi, mb = 16 * tm + 4 * g4, nn = 16 * tn + l15;
        const f32x4 v = mm64(lds, BUF(0), 16 * tm, BUF(11), 16 * tn, lane);
        st4(lds, BUF(12), nn, mb, v);
#pragma unroll
        for (int e = 0; e < 4; ++e) st1(lds, BUF(2), mb + e, nn, v[e]);
    }
    lds_barrier();
#pragma unroll
    for (int tmi = 0; tmi < 2; ++tmi) {
        const int tm = tm0 + tmi, mb = 16 * tm + 4 * g4, nn = 16 * tn + l15;
        const f32x4 v = mm64(lds, BUF(12), 16 * tm, BUF(2), 16 * tn, lane);
        st4(lds, BUF(13), nn, mb, v);
    }
    lds_barrier();
#pragma unroll
    for (int tmi = 0; tmi < 2; ++tmi) {
        const int tm = tm0 + tmi, mb = 16 * tm + 4 * g4, nn = 16 * tn + l15;
        const f32x4 v = mm64(lds, BUF(13), 16 * tm, BUF(1), 16 * tn, lane) + ld4(lds, BUF(1), nn, mb);
        st4(lds, BUF(14), nn, mb, v);
    }
    lds_barrier();
#pragma unroll
    for (int tmi = 0; tmi < 2; ++tmi) {
        const int tm = tm0 + tmi, mb = 16 * tm + 4 * g4, nn = 16 * tn + l15;
        const f32x4 v = mm64(lds, BUF(2), 16 * tm, BUF(14), 16 * tn, lane) + ld4(lds, BUF(14), nn, mb);
        st4(lds, BUF(15), nn, mb, v);
    }
    lds_barrier();
#pragma unroll
    for (int tmi = 0; tmi < 2; ++tmi) {
        const int tm = tm0 + tmi, mb = 16 * tm + 4 * g4, nn = 16 * tn + l15;
        const f32x4 x1 = mm64(lds, BUF(15), 16 * tm, BUF(4), 16 * tn, lane);
        const f32x4 x2 = mm64(lds, BUF(15), 16 * tm, BUF(8), 16 * tn, lane);
        st4(lds, BUF(0), nn, mb, x1); st4(lds, BUF(1), nn, mb, x2);
    }
    lds_barrier();
    {
        bf16_t* QT = (bf16_t*)(F.ws + WS_QT) + (size_t)unit * 4096; bf16_t* WT = (bf16_t*)(F.ws + WS_WT) + (size_t)unit * 4096; bf16_t* MP = (bf16_t*)(F.ws + WS_MP) + USK(unit) * 4096;
#pragma unroll
        for (int tmi = 0; tmi < 2; ++tmi) {
            const int tm = tm0 + tmi, mb = 16 * tm + 4 * g4, nn = 16 * tn + l15;
            { const f32x4 v = mm64(lds, BUF(0), 16 * tm, BUF(9), 16 * tn, lane) + ld4(lds, BUF(3), nn, mb);
              *(u32x2*)(QT + (dir ? 63 - nn : nn) * 64 + mb) = pack4(v); }
            { const f32x4 v = mm64(lds, BUF(1), 16 * tm, BUF(9), 16 * tn, lane) + ld4(lds, BUF(10), nn, mb);
              if (dir) *(u32x2*)(WT + (63 - nn) * 64 + (60 - mb)) = pack4((f32x4){v[3], v[2], v[1], v[0]});
              else *(u32x2*)(WT + nn * 64 + mb) = pack4(v); }
            { const float pcv = *(const volatile LAS float*)(lds + PCOFF + nn * 4);
              f32x4 v = mm64(lds, BUF(0), 16 * tm, BUF(5), 16 * tn, lane);
#pragma unroll
              for (int e = 0; e < 4; ++e) v[e] += (mb + e == nn) ? pcv : 0.f;
              *(u32x2*)(MP + nn * 64 + swap23(mb)) = pack4(v); }
            { const f32x4 v = mm64(lds, BUF(1), 16 * tm, BUF(5), 16 * tn, lane) + ld4(lds, BUF(6), nn, mb);
              st4(lds, BUF(2), nn, mb, v); }
        }
    }
    lds_barrier();
    {
        bf16_t* NBp = (bf16_t*)(F.ws + WS_NB);
#pragma unroll
        for (int tmi = 0; tmi < 2; ++tmi) {
            const int tm = tm0 + tmi, mb = 16 * tm + 4 * g4, ii = 16 * tn + l15;
            const f32x4 v = mm64(lds, BUF(2), 16 * tm, BUF(7), 16 * tn, lane);
            const int jb = mb >> 5, jl = mb & 31, q = jl >> 3, hic = (jl >> 2) & 1, ih = ii >> 5, Lc = (ii & 31) + 32 * hic;
            *(u32x2*)(NBp + (((USK(unit) * 2 + ih) * 2 + jb) * 2 + (q >> 1)) * 512 + Lc * 8 + 4 * (q & 1)) = pack4(v);
        }
    }
    lds_barrier();
}

DI void attn_unit(const Frame& F, const LAS float* rpbl, const int au) {
    const bf16_t* HBp = (const bf16_t*)(F.ws + WS_HB); const bf16_t* VTp = (const bf16_t*)(F.ws + WS_VT); bf16_t* CONCAT = (bf16_t*)(F.ws + WS_CONCAT);
    const int hh = au % AH, r = (au / AH) % ROWS, b = au / (AH * ROWS);
    int rstart = r - KH / 2; rstart = rstart < 0 ? 0 : (rstart > ROWS - KH ? ROWS - KH : rstart);
    const int lane = F.lane, q32 = lane & 31, hi = lane >> 5;
    const float SC = 0.125f * LOG2E;
    const int krow_off = swap23(q32);
    const int cqA = q32, cqB = 32 + q32;
    int csA = cqA - KW / 2; csA = csA < 0 ? 0 : csA; int csB = cqB - KW / 2; csB = csB > GW - KW ? GW - KW : csB;
    const size_t tokA = (size_t)b * S + r * GW + cqA, tokB = tokA + 32;
    bf16x8 qfA[4], qfB[4];
#pragma unroll
    for (int ds = 0; ds < 4; ++ds) { qfA[ds] = *(const bf16x8*)(HBp + tokA * HW + HQ + hh * HD + 16 * ds + 8 * hi); qfB[ds] = *(const bf16x8*)(HBp + tokB * HW + HQ + hh * HD + 16 * ds + 8 * hi); }
    f32x16 oA0, oA1, oB0, oB1;
#pragma unroll
    for (int i = 0; i < 16; ++i) { oA0[i] = 0.f; oA1[i] = 0.f; oB0[i] = 0.f; oB1[i] = 0.f; }
    float mA = -1e30f, lA = 0.f, mB = -1e30f, lB = 0.f;
#pragma unroll 1
    for (int kt = 0; kt < 2 * KH; ++kt) {
        const int kr = rstart + (kt >> 1), ckb = 32 * (kt & 1);
        const size_t ktok = (size_t)b * S + kr * GW + ckb;
        bf16x8 kf[4], vf[2][2];
#pragma unroll
        for (int ds = 0; ds < 4; ++ds) kf[ds] = *(const bf16x8*)(HBp + (ktok + krow_off) * HW + HK + hh * HD + 16 * ds + 8 * hi);
#pragma unroll
        for (int db = 0; db < 2; ++db)
#pragma unroll
            for (int s = 0; s < 2; ++s) vf[db][s] = *(const bf16x8*)(VTp + (size_t)(hh * HD + 32 * db + q32) * T + ktok + 16 * s + 8 * hi);
        const LAS float* rp = rpbl + (hh * (2 * KH - 1) + (kr - r + KH - 1)) * (2 * KW - 1);
#pragma unroll
        for (int qb = 0; qb < 2; ++qb) {
            const int cq = qb ? cqB : cqA, cs = qb ? csB : csA;
            f32x16 st;
#pragma unroll
            for (int i = 0; i < 16; ++i) st[i] = 0.f;
#pragma unroll
            for (int ds = 0; ds < 4; ++ds) st = MFMA32(kf[ds], qb ? qfB[ds] : qfA[ds], st);
            float sl[16]; float tmax = -1e30f;
            float bia[16];
#pragma unroll
            for (int i = 0; i < 16; ++i) {
                const int ck = ckb + 16 * (i >> 3) + 8 * hi + (i & 7);
                int dc = ck - cq; dc = dc < -(KW - 1) ? -(KW - 1) : (dc > KW - 1 ? KW - 1 : dc); dc += KW - 1;
                bia[i] = *(const volatile LAS float*)(rp + dc);
            }
#pragma unroll
            for (int i = 0; i < 16; ++i) {
                const int ck = ckb + 16 * (i >> 3) + 8 * hi + (i & 7);
                const bool inw = (ck >= cs) && (ck < cs + KW);
                const float sv = st[i] * SC + bia[i];
                sl[i] = inw ? sv : -1e30f;
                tmax = fmaxf(tmax, sl[i]);
            }
            tmax = fmaxf(tmax, __shfl_xor(tmax, 32));
            const float mrun = qb ? mB : mA;
            const float mn = fmaxf(mrun, tmax), corr = __builtin_amdgcn_exp2f(mrun - mn);
            float ps = 0.f;
#pragma unroll
            for (int i = 0; i < 16; ++i) { sl[i] = (sl[i] > -1e29f) ? __builtin_amdgcn_exp2f(sl[i] - mn) : 0.f; ps += sl[i]; }
            u32x4 p0, p1;
            p0.x = cvtpk(sl[0], sl[1]); p0.y = cvtpk(sl[2], sl[3]); p0.z = cvtpk(sl[4], sl[5]); p0.w = cvtpk(sl[6], sl[7]);
            p1.x = cvtpk(sl[8], sl[9]); p1.y = cvtpk(sl[10], sl[11]); p1.z = cvtpk(sl[12], sl[13]); p1.w = cvtpk(sl[14], sl[15]);
            const bf16x8 pf0 = __builtin_bit_cast(bf16x8, p0), pf1 = __builtin_bit_cast(bf16x8, p1);
            if (qb == 0) { lA = lA * corr + ps; mA = mn;
#pragma unroll
                for (int i = 0; i < 16; ++i) { oA0[i] *= corr; oA1[i] *= corr; }
                oA0 = MFMA32(vf[0][0], pf0, oA0); oA0 = MFMA32(vf[0][1], pf1, oA0); oA1 = MFMA32(vf[1][0], pf0, oA1); oA1 = MFMA32(vf[1][1], pf1, oA1);
            } else { lB = lB * corr + ps; mB = mn;
#pragma unroll
                for (int i = 0; i < 16; ++i) { oB0[i] *= corr; oB1[i] *= corr; }
                oB0 = MFMA32(vf[0][0], pf0, oB0); oB0 = MFMA32(vf[0][1], pf1, oB0); oB1 = MFMA32(vf[1][0], pf0, oB1); oB1 = MFMA32(vf[1][1], pf1, oB1);
            }
        }
    }
    { const float inv = 1.f / (lA + __shfl_xor(lA, 32)); bf16_t* op = CONCAT + tokA * D + hh * HD;
#pragma unroll
      for (int g = 0; g < 4; ++g) {
          *(u32x2*)(op + 8 * g + 4 * hi) = pack4((f32x4){oA0[4 * g] * inv, oA0[4 * g + 1] * inv, oA0[4 * g + 2] * inv, oA0[4 * g + 3] * inv});
          *(u32x2*)(op + 32 + 8 * g + 4 * hi) = pack4((f32x4){oA1[4 * g] * inv, oA1[4 * g + 1] * inv, oA1[4 * g + 2] * inv, oA1[4 * g + 3] * inv}); } }
    { const float inv = 1.f / (lB + __shfl_xor(lB, 32)); bf16_t* op = CONCAT + tokB * D + hh * HD;
#pragma unroll
      for (int g = 0; g < 4; ++g) {
          *(u32x2*)(op + 8 * g + 4 * hi) = pack4((f32x4){oB0[4 * g] * inv, oB0[4 * g + 1] * inv, oB0[4 * g + 2] * inv, oB0[4 * g + 3] * inv});
          *(u32x2*)(op + 32 + 8 * g + 4 * hi) = pack4((f32x4){oB1[4 * g] * inv, oB1[4 * g + 1] * inv, oB1[4 * g + 2] * inv, oB1[4 * g + 3] * inv}); } }
}

DI void pool_unit(const Frame& F, const float* pool_w, const float* pool_scale, const int pu) {
    const bf16_t* HBp = (const bf16_t*)(F.ws + WS_HB); bf16_t* CONCAT = (bf16_t*)(F.ws + WS_CONCAT);
    const int g = pu & 3, blk = pu >> 2, b = blk >> 8, t0 = (blk & 255) * 32;
    const int lane = F.lane, q32 = lane & 31, hi = lane >> 5, t = t0 + q32, win = 2 << g;
    int lo = t - win / 2; lo = lo < 0 ? 0 : lo; int hit = t + win / 2 - 1; hit = hit > S - 1 ? S - 1 : hit;
    const float inv = 1.f / (float)(hit - lo + 1);
    f32x16 out0, out1;
#pragma unroll
    for (int i = 0; i < 16; ++i) { out0[i] = 0.f; out1[i] = 0.f; }
    const float* pw = pool_w + (size_t)g * 64 * 64;
#pragma unroll 1
    for (int s = 0; s < 4; ++s) {
        const int c0 = HP + g * 64 + 16 * s + 8 * hi;
        float acc[8];
#pragma unroll
        for (int e = 0; e < 8; ++e) acc[e] = 0.f;
        u32x4 pv[16];
#pragma unroll
        for (int d = 0; d < 16; ++d) { int tt = t - win / 2 + d; const bool ok = d < win && tt >= 0 && tt < S; tt = ok ? tt : t;
            pv[d] = *(const u32x4*)(HBp + ((size_t)b * S + tt) * HW + c0); if (!ok) pv[d] = (u32x4){0u, 0u, 0u, 0u}; }
#pragma unroll
        for (int d = 0; d < 16; ++d) {
            acc[0] += bflo(pv[d].x); acc[1] += bfhi(pv[d].x); acc[2] += bflo(pv[d].y); acc[3] += bfhi(pv[d].y); acc[4] += bflo(pv[d].z); acc[5] += bfhi(pv[d].z); acc[6] += bflo(pv[d].w); acc[7] += bfhi(pv[d].w);
        }
        const u32x4 pc = *(const u32x4*)(HBp + ((size_t)b * S + t) * HW + c0);
        u32x4 o;
        o.x = cvtpk(acc[0] * inv - bflo(pc.x), acc[1] * inv - bfhi(pc.x)); o.y = cvtpk(acc[2] * inv - bflo(pc.y), acc[3] * inv - bfhi(pc.y));
        o.z = cvtpk(acc[4] * inv - bflo(pc.z), acc[5] * inv - bfhi(pc.z)); o.w = cvtpk(acc[6] * inv - bflo(pc.w), acc[7] * inv - bfhi(pc.w));
        const bf16x8 bfr = __builtin_bit_cast(bf16x8, o);
        const float* wp = pw + (size_t)(16 * s + 8 * hi) * 64 + q32;
        u32x4 w0; w0.x = cvtpk(wp[0], wp[64]); w0.y = cvtpk(wp[128], wp[192]); w0.z = cvtpk(wp[256], wp[320]); w0.w = cvtpk(wp[384], wp[448]);
        u32x4 w1; w1.x = cvtpk(wp[32], wp[96]); w1.y = cvtpk(wp[160], wp[224]); w1.z = cvtpk(wp[288], wp[352]); w1.w = cvtpk(wp[416], wp[480]);
        out0 = MFMA32(__builtin_bit_cast(bf16x8, w0), bfr, out0);
        out1 = MFMA32(__builtin_bit_cast(bf16x8, w1), bfr, out1);
    }
    bf16_t* op = CONCAT + ((size_t)b * S + t) * D + AW + BW + g * 64;
    const float* ps = pool_scale + g * 64;
#pragma unroll
    for (int gq = 0; gq < 4; ++gq) {
        const int e0 = 8 * gq + 4 * hi;
        const f32x4 s0 = *(const f32x4*)(ps + e0), s1 = *(const f32x4*)(ps + 32 + e0);
        *(u32x2*)(op + e0) = pack4((f32x4){out0[4 * gq] * s0[0], out0[4 * gq + 1] * s0[1], out0[4 * gq + 2] * s0[2], out0[4 * gq + 3] * s0[3]});
        *(u32x2*)(op + 32 + e0) = pack4((f32x4){out1[4 * gq] * s1[0], out1[4 * gq + 1] * s1[1], out1[4 * gq + 2] * s1[2], out1[4 * gq + 3] * s1[3]});
    }
}

constexpr int SCAN_SLOT = 12288, SCAN_RING = 12;
constexpr int SCAN_FLAGS = SCAN_RING * SCAN_SLOT;
DI void scan_issue(const Frame& F, const int sc, const int ihalf, const int dir, const int step, const int lane) {
    const int c = dir ? NCH - 1 - step : step; const size_t unit = (size_t)sc * NCH + c;
    const int il = lane & 31, hi = lane >> 5;
    LAS unsigned char* slot = F.lds + (step % SCAN_RING) * SCAN_SLOT;
    const bf16_t* MP = (const bf16_t*)(F.ws + WS_MP) + USK(unit) * 4096; const bf16_t* NBp = (const bf16_t*)(F.ws + WS_NB) + (USK(unit) * 2 + ihalf) * 2048;
#pragma unroll
    for (int p = 0; p < 8; ++p) { const int jpb = p >> 2, jb = (p >> 1) & 1, s = p & 1;
        __builtin_amdgcn_global_load_lds((const unsigned*)(MP + (32 * jpb + il) * 64 + 32 * jb + 16 * s + 8 * hi), (LAS unsigned*)(slot + p * 1024), 16, 0, 0); }
#pragma unroll
    for (int p = 0; p < 4; ++p)
        __builtin_amdgcn_global_load_lds((const unsigned*)(NBp + p * 512 + lane * 8), (LAS unsigned*)(slot + 8192 + p * 1024), 16, 0, 0);
}
DI unsigned lds_ld_u32(const volatile LAS unsigned* p) { return __builtin_amdgcn_readfirstlane(*p); }
DI void scan_loader(const Frame& F, const int sw, const int ld) {
    const int ihalf = sw & 1, sc = sw >> 1, dir = sc / (NB * BH);
    volatile LAS unsigned* ready = (volatile LAS unsigned*)(F.lds + SCAN_FLAGS); volatile LAS unsigned* cons = ready + 16;
    const int nmine = NCH / 2;
    for (int k = 0; k < nmine + 5; ++k) {
        if (k < nmine) {
            const int s = 2 * k + ld;
            if (s >= SCAN_RING) { unsigned spins = 0; while ((int)lds_ld_u32(cons) < s - SCAN_RING + 1) { __builtin_amdgcn_s_sleep(1); if (++spins > (1u << 22)) break; } }
            asm volatile("" ::: "memory");
            scan_issue(F, sc, ihalf, dir, s, F.lane);
        }
        if (k >= 4) {
            const int kd = k - 4;
            if (kd < nmine) {
                const int rem = nmine - 1 - kd;
                if (rem >= 4) asm volatile("s_waitcnt vmcnt(48)" ::: "memory");
                else if (rem == 3) asm volatile("s_waitcnt vmcnt(36)" ::: "memory");
                else if (rem == 2) asm volatile("s_waitcnt vmcnt(24)" ::: "memory");
                else if (rem == 1) asm volatile("s_waitcnt vmcnt(12)" ::: "memory");
                else asm volatile("s_waitcnt vmcnt(0)" ::: "memory");
                const int sd = 2 * kd + ld;
                if (F.lane == 0) ready[sd % SCAN_RING] = (unsigned)(sd + 1);
                asm volatile("s_waitcnt lgkmcnt(0)" ::: "memory");
            }
        }
    }
}
constexpr int S0_STAGE = SCAN_FLAGS + 256;
DI void scan_writer(const Frame& F, const int sw) {
    const int ihalf = sw & 1, sc = sw >> 1, dir = sc / (NB * BH);
    volatile LAS unsigned* ready = (volatile LAS unsigned*)(F.lds + SCAN_FLAGS);
    volatile LAS unsigned* s0rdy = ready + 17; volatile LAS unsigned* s0done = ready + 18;
    bf16_t* S0 = (bf16_t*)(F.ws + WS_S0);
    const int lane = F.lane;
#pragma unroll 1
    for (int step = 0; step < NCH; ++step) {
        const int c = dir ? NCH - 1 - step : step; const size_t unit = (size_t)sc * NCH + c;
        { unsigned spins = 0; while ((int)lds_ld_u32(s0rdy) < step + 1) { __builtin_amdgcn_s_sleep(1); if (++spins > (1u << 22)) break; } }
        asm volatile("" ::: "memory");
        const LAS unsigned char* sl = F.lds + S0_STAGE + (step & 1) * (32 * 144);
        u32x4 v[4];
#pragma unroll
        for (int p = 0; p < 4; ++p) { const int idx = p * 64 + lane; v[p] = *(const LAS u32x4*)(sl + (idx >> 3) * 144 + (idx & 7) * 16); }
        asm volatile("s_waitcnt lgkmcnt(0)" ::: "memory");
        if (lane == 0) *s0done = (unsigned)(step + 1);
        bf16_t* dst = S0 + USK(unit) * 4096 + ihalf * 2048;
#pragma unroll
        for (int p = 0; p < 4; ++p) *(u32x4*)(dst + (p * 64 + lane) * 8) = v[p];
    }
}
DI void scan_wave(const Frame& F, const int sw) {
    const int ihalf = sw & 1, sc = sw >> 1, dir = sc / (NB * BH);
    const int lane = F.lane, il = lane & 31, hi = lane >> 5;
    bf16_t* S0 = (bf16_t*)(F.ws + WS_S0);
    volatile LAS unsigned* ready = (volatile LAS unsigned*)(F.lds + SCAN_FLAGS); volatile LAS unsigned* cons = ready + 16;
    volatile LAS unsigned* s0rdy = ready + 17; volatile LAS unsigned* s0done = ready + 18; (void)s0rdy; (void)s0done;
    f32x16 st0, st1;
#pragma unroll
    for (int i = 0; i < 16; ++i) { st0[i] = 0.f; st1[i] = 0.f; }
    bf16x8 ma[8], man[8]; u32x4 nbv[4], nbn[4];
    { unsigned spins = 0; while (lds_ld_u32(ready) != 1u) { __builtin_amdgcn_s_sleep(1); if (++spins > (1u << 22)) break; } }
    asm volatile("" ::: "memory");
#pragma unroll
    for (int p = 0; p < 8; ++p) ma[p] = *(const LAS bf16x8*)(F.lds + p * 1024 + lane * 16);
#pragma unroll
    for (int p = 0; p < 4; ++p) nbv[p] = *(const LAS u32x4*)(F.lds + 8192 + p * 1024 + lane * 16);
#pragma unroll 1
    for (int step = 0; step < NCH; ++step) {
        const int c = dir ? NCH - 1 - step : step; const size_t unit = (size_t)sc * NCH + c;
        const bool more = step + 1 < NCH;
#ifdef S0_WRITER
        if (step >= 2) { unsigned spins = 0; while ((int)lds_ld_u32(s0done) < step - 1) { __builtin_amdgcn_s_sleep(1); if (++spins > (1u << 22)) break; } }
        asm volatile("" ::: "memory");
#endif
        if (more) {
            { unsigned spins = 0; while (lds_ld_u32(ready + ((step + 1) % SCAN_RING)) != (unsigned)(step + 2)) { __builtin_amdgcn_s_sleep(1); if (++spins > (1u << 22)) break; } }
            asm volatile("" ::: "memory");

            const LAS unsigned char* slot = F.lds + ((step + 1) % SCAN_RING) * SCAN_SLOT;
#pragma unroll
            for (int p = 0; p < 8; ++p) man[p] = *(const LAS bf16x8*)(slot + p * 1024 + lane * 16);
#pragma unroll
            for (int p = 0; p < 4; ++p) nbn[p] = *(const LAS u32x4*)(slot + 8192 + p * 1024 + lane * 16);
        }
        bf16_t* sp = S0 + USK(unit) * 4096 + (size_t)(32 * ihalf + il) * 64;
        u32x4 b00, b01, b10, b11;
        b00.x = cvtpk(st0[0], st0[1]); b00.y = cvtpk(st0[2], st0[3]); b00.z = cvtpk(st0[4], st0[5]); b00.w = cvtpk(st0[6], st0[7]);
        b01.x = cvtpk(st0[8], st0[9]); b01.y = cvtpk(st0[10], st0[11]); b01.z = cvtpk(st0[12], st0[13]); b01.w = cvtpk(st0[14], st0[15]);
        b10.x = cvtpk(st1[0], st1[1]); b10.y = cvtpk(st1[2], st1[3]); b10.z = cvtpk(st1[4], st1[5]); b10.w = cvtpk(st1[6], st1[7]);
        b11.x = cvtpk(st1[8], st1[9]); b11.y = cvtpk(st1[10], st1[11]); b11.z = cvtpk(st1[12], st1[13]); b11.w = cvtpk(st1[14], st1[15]);
#ifdef S0_WRITER
        { LAS unsigned char* sl = F.lds + S0_STAGE + (step & 1) * (32 * 144) + il * 144 + 8 * hi;
          {
          *(LAS u32x2*)(sl + 0) = (u32x2){b00.x, b00.y};  *(LAS u32x2*)(sl + 16) = (u32x2){b00.z, b00.w};
          *(LAS u32x2*)(sl + 32) = (u32x2){b01.x, b01.y}; *(LAS u32x2*)(sl + 48) = (u32x2){b01.z, b01.w};
          *(LAS u32x2*)(sl + 64) = (u32x2){b10.x, b10.y}; *(LAS u32x2*)(sl + 80) = (u32x2){b10.z, b10.w};
          *(LAS u32x2*)(sl + 96) = (u32x2){b11.x, b11.y}; *(LAS u32x2*)(sl + 112) = (u32x2){b11.z, b11.w}; }
          asm volatile("" ::: "memory");
          if (lane == 0) *s0rdy = (unsigned)(step + 1); }
        (void)sp;
#else
        *(u32x2*)(sp + 0 + 4 * hi) = (u32x2){b00.x, b00.y};  *(u32x2*)(sp + 8 + 4 * hi) = (u32x2){b00.z, b00.w};
        *(u32x2*)(sp + 16 + 4 * hi) = (u32x2){b01.x, b01.y}; *(u32x2*)(sp + 24 + 4 * hi) = (u32x2){b01.z, b01.w};
        *(u32x2*)(sp + 32 + 4 * hi) = (u32x2){b10.x, b10.y}; *(u32x2*)(sp + 40 + 4 * hi) = (u32x2){b10.z, b10.w};
        *(u32x2*)(sp + 48 + 4 * hi) = (u32x2){b11.x, b11.y}; *(u32x2*)(sp + 56 + 4 * hi) = (u32x2){b11.z, b11.w};
#endif
        const bf16x8 p00 = __builtin_bit_cast(bf16x8, b00), p01 = __builtin_bit_cast(bf16x8, b01), p10 = __builtin_bit_cast(bf16x8, b10), p11 = __builtin_bit_cast(bf16x8, b11);
        f32x16 n0, n1;
#pragma unroll
        for (int h2 = 0; h2 < 2; ++h2) {
            n0[8 * h2 + 0] = bflo(nbv[h2].x); n0[8 * h2 + 1] = bfhi(nbv[h2].x); n0[8 * h2 + 2] = bflo(nbv[h2].y); n0[8 * h2 + 3] = bfhi(nbv[h2].y);
            n0[8 * h2 + 4] = bflo(nbv[h2].z); n0[8 * h2 + 5] = bfhi(nbv[h2].z); n0[8 * h2 + 6] = bflo(nbv[h2].w); n0[8 * h2 + 7] = bfhi(nbv[h2].w);
            n1[8 * h2 + 0] = bflo(nbv[2 + h2].x); n1[8 * h2 + 1] = bfhi(nbv[2 + h2].x); n1[8 * h2 + 2] = bflo(nbv[2 + h2].y); n1[8 * h2 + 3] = bfhi(nbv[2 + h2].y);
            n1[8 * h2 + 4] = bflo(nbv[2 + h2].z); n1[8 * h2 + 5] = bfhi(nbv[2 + h2].z); n1[8 * h2 + 6] = bflo(nbv[2 + h2].w); n1[8 * h2 + 7] = bfhi(nbv[2 + h2].w);
        }
        n0 = MFMA32(ma[0], p00, n0); n1 = MFMA32(ma[4], p00, n1);
        n0 = MFMA32(ma[1], p01, n0); n1 = MFMA32(ma[5], p01, n1);
        n0 = MFMA32(ma[2], p10, n0); n1 = MFMA32(ma[6], p10, n1);
        n0 = MFMA32(ma[3], p11, n0); n1 = MFMA32(ma[7], p11, n1);
        st0 = n0; st1 = n1;
        if (more) {
            asm volatile("s_waitcnt lgkmcnt(0)" ::: "memory");
            if (lane == 0) *cons = (unsigned)(step + 2);
#pragma unroll
            for (int p = 0; p < 8; ++p) ma[p] = man[p];
#pragma unroll
            for (int p = 0; p < 4; ++p) nbv[p] = nbn[p];
        }
    }
}

DI void rwkv_out_unit(const Frame& F, const RwP& P, const int du) {
    const int qd = du & 3, cidx = du >> 2, c = cidx % NCH, hd = (cidx / NCH) % BH, b = cidx / (NCH * BH);
    const int lane = F.lane, n = lane & 15, g = lane >> 4, u = 16 * qd + n;
    const bf16_t* QT = (const bf16_t*)(F.ws + WS_QT); const bf16_t* WT = (const bf16_t*)(F.ws + WS_WT); const bf16_t* S0 = (const bf16_t*)(F.ws + WS_S0);
    const bf16_t* VTB = (const bf16_t*)(F.ws + WS_VTB) + (size_t)cidx * 4096;
    f32x4 acc[4];
#pragma unroll
    for (int tm = 0; tm < 4; ++tm) acc[tm] = (f32x4){0.f, 0.f, 0.f, 0.f};
#pragma unroll
    for (int dir = 0; dir < 2; ++dir) {
        const size_t unit = (((size_t)dir * NB + b) * BH + hd) * NCH + c;
#pragma unroll
        for (int ks = 0; ks < 2; ++ks) {
            const bf16x8 bq = *(const bf16x8*)(QT + unit * 4096 + u * 64 + 32 * ks + 8 * g);
            const bf16x8 bw = *(const bf16x8*)(WT + unit * 4096 + u * 64 + 32 * ks + 8 * g);
#pragma unroll
            for (int tm = 0; tm < 4; ++tm) {
                const bf16x8 as = *(const bf16x8*)(S0 + USK(unit) * 4096 + (16 * tm + n) * 64 + 32 * ks + 8 * g);
                const bf16x8 av = *(const bf16x8*)(VTB + (16 * tm + n) * 64 + 32 * ks + 8 * g);
                acc[tm] = MFMA16(as, bq, acc[tm]); acc[tm] = MFMA16(av, bw, acc[tm]);
            }
        }
    }
    float s = 0.f;
#pragma unroll
    for (int tm = 0; tm < 4; ++tm) s += (acc[tm][0] + acc[tm][1]) + (acc[tm][2] + acc[tm][3]);
    s += __shfl_xor(s, 16); s += __shfl_xor(s, 32);
    const float mu = s * (1.f / HD); float q = 0.f;
#pragma unroll
    for (int tm = 0; tm < 4; ++tm) { acc[tm] = acc[tm] - mu; q += (acc[tm][0] * acc[tm][0] + acc[tm][1] * acc[tm][1]) + (acc[tm][2] * acc[tm][2] + acc[tm][3] * acc[tm][3]); }
    q += __shfl_xor(q, 16); q += __shfl_xor(q, 32);
    const float rstd = 1.f / sqrtf(q * (1.f / HD) + GN_EPS);
    const size_t tok = (size_t)b * S + 64 * c + u;
    const float* BS = (const float*)(F.ws + WS_BS);
    const float bsum = BS[tok * 8 + hd] + BS[((size_t)T + tok) * 8 + hd];
    const bf16_t* VC = (const bf16_t*)(F.ws + WS_VC) + tok * BW + hd * HD; const bf16_t* GBp = (const bf16_t*)(F.ws + WS_GB) + tok * BW + hd * HD;
    bf16_t* op = (bf16_t*)(F.ws + WS_CONCAT) + tok * D + AW + hd * HD;
#pragma unroll
    for (int tm = 0; tm < 4; ++tm) {
        const int i0 = 16 * tm + 4 * g;
        const f32x4 vv = unpack4(*(const u32x2*)(VC + i0)), gg = unpack4(*(const u32x2*)(GBp + i0));
        const f32x4 gn = *(const f32x4*)(P.gn_gain + hd * HD + i0), gb = *(const f32x4*)(P.gn_bias + hd * HD + i0);
        *(u32x2*)(op + i0) = pack4((acc[tm] * rstd * gn + gb + vv * bsum) * gg);
    }
}

DI RwP make_rwp(const Args& a, int l) {
    RwP p;
    p.conv = a.in[6] + (size_t)l * 3 * 3 * BW; p.w0 = a.in[7] + (size_t)l * 2 * BW; p.w_up = a.in[8] + (size_t)l * 2 * RW * BW;
    p.a0 = a.in[9] + (size_t)l * 2 * BW; p.a_up = a.in[10] + (size_t)l * 2 * RA * BW; p.g_up = a.in[11] + (size_t)l * RG * BW;
    p.k_k = a.in[12] + (size_t)l * BW; p.k_a = a.in[13] + (size_t)l * BW; p.r_k = a.in[14] + (size_t)l * BH * HD;
    p.gn_gain = a.in[15] + (size_t)l * BW; p.gn_bias = a.in[16] + (size_t)l * BW;
    return p;
}
DI void p_gemm1(const Frame& F, int l) {
    pg8::Gemm1Order S; S.U = (const bf16_t*)(F.ws + WS_U); S.Win = (const bf16_t*)(F.ws + WS_WIN + (size_t)l * WIN_LAYER); S.Wv = S.Win + (size_t)HW * D; S.G = F.G; S.c = F.bx;
    pg8::EpiStore E{(bf16_t*)(F.ws + WS_HB), HW, (bf16_t*)(F.ws + WS_VT), T};
    pg8::gemm_phase(F.lds, F.tid, D, S, E);
}
DI void p_mixer_local(const Frame& F, const Args& a, int l) {
    {
      const float* conv = a.in[6] + (size_t)l * 3 * 3 * BW;
#pragma unroll 7
      for (int i = F.tid; i < BH * 9 * 64; i += NTHREADS) { const int j = i & 63, q = i >> 6, which = q % 3, x = (q / 3) % 3, hd = q / 9;
          *(LAS bf16_t*)(F.lds + CWLOFF + i * 2) = f2bf(conv[x * 3 * BW + which * BW + hd * HD + j]); }
      RwPre PF;
      if (F.bx < NUNIT) rwkv_prefetch(F, a, l, F.bx, PF);
      __syncthreads();
      for (int unit = F.bx; unit < NUNIT; unit += F.G) rwkv_local_unit(F, a, l, unit, PF, unit + F.G < NUNIT ? unit + F.G : -1);
    }
}
DI void p_scan(const Frame& F, const Args& a, int l) {
#ifndef CVW
#define CVW 3
#endif
    constexpr int NSCAN = 2 * 2 * NB * BH;
    const int NATTW = (F.G - NSCAN) * (NWAVES - CVW);
    if (F.bx < NSCAN) {
        volatile LAS unsigned* fl = (volatile LAS unsigned*)(F.lds + SCAN_FLAGS);
        if (F.tid < 32) fl[F.tid] = 0u;
        __syncthreads();
#ifdef S0_WRITER
        if (F.wave == 0) scan_wave(F, F.bx); else if (F.wave <= 2) scan_loader(F, F.bx, F.wave - 1); else if (F.wave == 3) scan_writer(F, F.bx);
#else
        if (F.wave == 0) scan_wave(F, F.bx); else if (F.wave <= 2) scan_loader(F, F.bx, F.wave - 1);
#endif
#ifdef DBL_SCAN
        __syncthreads();
        if (F.tid < 32) fl[F.tid] = 0u;
        __syncthreads();
        if (F.wave == 0) scan_wave(F, F.bx); else if (F.wave <= 2) scan_loader(F, F.bx, F.wave - 1);
#endif
        return;
    }
#ifdef SERIAL_C
    {
        LAS float* rpbl8 = (LAS float*)(F.lds + NWAVES * 64 * 65 * 4);
        { const float* rpb = a.in[5] + (size_t)l * AH * (2 * KH - 1) * (2 * KW - 1);
#pragma unroll 6
          for (int i = F.tid; i < AH * (2 * KH - 1) * (2 * KW - 1); i += NTHREADS) rpbl8[i] = rpb[i] * LOG2E; }
        __syncthreads();
        const int aw8 = (F.bx - NSCAN) * NWAVES + F.wave, naw8 = (F.G - NSCAN) * NWAVES;
        if (F.G == 256) {
            constexpr int UPX = NB * ROWS * AH / 8;
            const int x = F.bx & 7, k = (F.bx - NSCAN) >> 3, j = k * NWAVES + F.wave;
            if (j < UPX) { const int v = (x & 3) * UPX + j; attn_unit(F, rpbl8, (((x >> 2) * ROWS) + (v & (ROWS - 1))) * AH + (v >> 7)); }
        } else
            for (int au = aw8; au < NB * ROWS * AH; au += naw8) attn_unit(F, rpbl8, au);
        for (int pu = aw8; pu < NB * (S / 32) * 4; pu += naw8) pool_unit(F, a.in[17] + (size_t)l * NG * 64 * 64, a.in[18] + (size_t)l * CW, pu);
        LAS float* scr = (LAS float*)F.lds + F.wave * (64 * 65);
        f32x4 cur[16], nxt[16]; const int st = naw8; int it = aw8; TItem tc{}, tn{};
#ifdef DBL_CONV
        for (int rep = 0; rep < 2; ++rep) { it = aw8;
#endif
        if (it < IT_MOE) { tc = moe_item(F, a.in[28], a.in[29], a.in[30], l, it); titem_load(tc, cur, F.lane); }
        for (; it < IT_MOE; it += st) {
            const bool more = it + st < IT_MOE;
            if (more) { tn = moe_item(F, a.in[28], a.in[29], a.in[30], l, it + st); titem_load(tn, nxt, F.lane); }
            titem_store(tc, cur, scr, F.lane);
            if (more) { tc = tn;
#pragma unroll
                for (int i = 0; i < 16; ++i) cur[i] = nxt[i]; }
        }
#ifdef DBL_CONV
        }
#endif
        return;
    }
#endif
    LAS float* rpbl = (LAS float*)(F.lds + CVW * 64 * 65 * 4);
    { const float* rpb = a.in[5] + (size_t)l * AH * (2 * KH - 1) * (2 * KW - 1);
#pragma unroll 6
      for (int i = F.tid; i < AH * (2 * KH - 1) * (2 * KW - 1); i += NTHREADS) rpbl[i] = rpb[i] * LOG2E; }
    __syncthreads();
    if (F.wave < CVW) {
        LAS float* scr = (LAS float*)F.lds + F.wave * (64 * 65);
        f32x4 cur[16], nxt[16]; const int st = (F.G - NSCAN) * CVW; int it = (F.bx - NSCAN) * CVW + F.wave; TItem tc{}, tn{};
        if (it < IT_MOE) { tc = moe_item(F, a.in[28], a.in[29], a.in[30], l, it); titem_load(tc, cur, F.lane); }
#ifdef DBL_CONV
        for (int rep = 0; rep < 2; ++rep) { it = (F.bx - NSCAN) * CVW + F.wave; if (it < IT_MOE) { tc = moe_item(F, a.in[28], a.in[29], a.in[30], l, it); titem_load(tc, cur, F.lane); }
#endif
        for (; it < IT_MOE; it += st) {
            const bool more = it + st < IT_MOE;
#ifdef CONV_SINGLE
            titem_store(tc, cur, scr, F.lane);
            if (more) { tc = moe_item(F, a.in[28], a.in[29], a.in[30], l, it + st); titem_load(tc, cur, F.lane); }
            continue;
#endif
            if (more) { tn = moe_item(F, a.in[28], a.in[29], a.in[30], l, it + st); titem_load(tn, nxt, F.lane); }
            titem_store(tc, cur, scr, F.lane);
            if (more) { tc = tn;
#pragma unroll
                for (int i = 0; i < 16; ++i) cur[i] = nxt[i]; }
        }
#ifdef DBL_CONV
        }
#endif
    } else {
        const int aw = (F.bx - NSCAN) * (NWAVES - CVW) + (F.wave - CVW), naw = NATTW;
#ifdef ATT_XCD
        if (F.G == 256) {
            constexpr int NW5 = NWAVES - CVW, NBX = (256 - NSCAN) / 8, NWX = NBX * NW5, UPX = NB * ROWS * AH / 8, REM = UPX - NWX, PER = (REM + NBX - 1) / NBX;
            const int x = F.bx & 7, k = (F.bx - NSCAN) >> 3, w5 = F.wave - CVW;
            { const int v = (x & 3) * UPX + k * NW5 + w5; attn_unit(F, rpbl, (((x >> 2) * ROWS) + (v & (ROWS - 1))) * AH + (v >> 7)); }
            if (w5 < PER && k * PER + w5 < REM) { const int v = (x & 3) * UPX + NWX + k * PER + w5; attn_unit(F, rpbl, (((x >> 2) * ROWS) + (v & (ROWS - 1))) * AH + (v >> 7)); }
        } else
#endif
        for (int au = aw; au < NB * ROWS * AH; au += naw) attn_unit(F, rpbl, au);
#ifdef DBL_ATTN
        for (int au = aw; au < NB * ROWS * AH; au += naw) attn_unit(F, rpbl, au);
#endif
        for (int pu = aw; pu < NB * (S / 32) * 4; pu += naw) pool_unit(F, a.in[17] + (size_t)l * NG * 64 * 64, a.in[18] + (size_t)l * CW, pu);
    }
}
DI void p_rwkv_out(const Frame& F, const Args& a, int l) {
    const RwP P = make_rwp(a, l);
    for (int du = F.gw; du < NB * BH * NCH * 4; du += F.ngw) rwkv_out_unit(F, P, du);
}
DI void p_gemm2(const Frame& F, int l) {
    pg8::PlainOrder S; S.init((const bf16_t*)(F.ws + WS_CONCAT), (const bf16_t*)(F.ws + WS_WOUT) + (size_t)l * D * D, T, D, D, F.G, F.bx);
    pg8::EpiStore E{(bf16_t*)(F.ws + WS_MIX), D, nullptr, 0};
    pg8::gemm_phase(F.lds, F.tid, D, S, E);
}
DI void p_moe_a(const Frame& F, int l) {
    LAS int* tb = (LAS int*)(F.lds + LDS_MISC);
    build_tables(F, l, tb);
    pg8::GroupedOrderT<true> S; S.rowtok = (const int*)(F.ws + WS_CTL + WS_SLOTTOK); S.A = (const bf16_t*)(F.ws + WS_U); S.Bt = (const bf16_t*)(F.ws + WS_WGU); S.K = D; S.estride = (size_t)D * D; S.tile_e = tb + 66; S.ntiles = tb[65]; S.nwg = S.ntiles * 4; S.G = F.G; S.c = F.bx;
#ifdef FUSE_MOE
    S.flags = (unsigned*)(F.ws + WS_CTL) + CW_MFL + l * 256;
#endif
    pg8::EpiSwiGlu E{(bf16_t*)(F.ws + WS_HM)};
    pg8::gemm_phase(F.lds, F.tid, D, S, E);
}
DI void p_moe_b(const Frame& F, int l) {
    LAS int* tb = (LAS int*)(F.lds + LDS_MISC);
    build_tables(F, l, tb);
#ifdef FUSE_MOE
    pg8::GroupedOrderB S; S.flags = (unsigned*)(F.ws + WS_CTL) + CW_MFL + l * 256;
#else
    pg8::GroupedOrderT<false> S;
#endif
    S.rowtok = nullptr; S.A = (const bf16_t*)(F.ws + WS_HM); S.Bt = (const bf16_t*)(F.ws + WS_WD); S.K = DE; S.estride = (size_t)D * DE; S.tile_e = tb + 66; S.ntiles = tb[65]; S.nwg = S.ntiles * 4; S.G = F.G; S.c = F.bx;
    pg8::EpiRowScale E{(bf16_t*)(F.ws + WS_YS), (const float*)(F.ws + WS_SLOTW)};
    pg8::gemm_phase(F.lds, F.tid, DE, S, E);
}

#ifndef DBLMASK
#define DBLMASK 0
#endif
constexpr int PH_PER_LAYER = 10, N_PHASES = 2 + L * PH_PER_LAYER;
DI bool in_ph(int k, int lo, int hi) { lo = __builtin_amdgcn_readfirstlane(lo); hi = __builtin_amdgcn_readfirstlane(hi); asm volatile("" : "+s"(lo), "+s"(hi)); return lo <= k && k < hi; }
DI Frame fresh(const Frame& F0) {
    Frame F = F0; int t = F0.tid, b = F0.bx;
    b = __builtin_amdgcn_readfirstlane(b); asm volatile("" : "+v"(t)); asm volatile("" : "+s"(b));
    F.tid = t; F.lane = t & 63; F.wave = __builtin_amdgcn_readfirstlane(t >> 6); F.bx = b;
    F.vcu = (F.G % 8 == 0) ? (b % 8) * (F.G / 8) + b / 8 : b; F.gw = F.vcu * NWAVES + F.wave;
    return F;
}

__global__ void __launch_bounds__(NTHREADS, 2) mk_fwd(Args a) {
    extern __shared__ __attribute__((aligned(16))) unsigned char lds_raw[];
    Frame F;
    F.lds = (LAS unsigned char*)lds_raw;
    F.tid = threadIdx.x; F.lane = F.tid & 63; F.wave = __builtin_amdgcn_readfirstlane(F.tid >> 6);
    F.G = gridDim.x; F.bx = blockIdx.x; { const int bx = blockIdx.x; F.vcu = (F.G % 8 == 0) ? (bx % 8) * (F.G / 8) + bx / 8 : bx; }
    F.gw = F.vcu * NWAVES + F.wave; F.ngw = F.G * NWAVES; F.ws = a.ws;
    volatile LAS unsigned* bst = (volatile LAS unsigned*)(F.lds + LDS_BARST);
    if (F.tid < 16) bst[F.tid] = 0u;
    __syncthreads();
    cg::grid_group grid = cg::this_grid();
    XcdBarrier bar; bar.bar = (unsigned*)(a.ws + WS_CTL) + CW_BAR; bar.x = 0; bar.st = bst;
    const bool multi = (a.ph_hi - a.ph_lo) > 1;
    if (multi && !a.use_cg) bar = xcd_barrier_post((unsigned*)(a.ws + WS_CTL) + CW_BAR, bst);
    const int lo = a.ph_lo, hi = a.ph_hi;
#define IN(k) in_ph((k), lo, hi)
#ifndef DBLSEAM
#define DBLSEAM 0
#endif
#define SEAM(k) do { if (IN(k) && IN((k) + 1)) { if (a.use_cg) grid.sync(); else { xcd_barrier(bar); if (DBLSEAM) xcd_barrier(bar); } } } while (0)
    if (IN(0)) { p0_prologue(fresh(F), a); if ((DBLMASK >> 11) & 1) p0_prologue(fresh(F), a); }
    SEAM(0);
    if (IN(1)) { p_r0(fresh(F), a.in[0]); if ((DBLMASK >> 12) & 1) p_r0(fresh(F), a.in[0]); }
    SEAM(1);
#ifdef FUSE_MOE
#define SEAM_MOE(k) do { } while (0)
#else
#define SEAM_MOE(k) SEAM(k)
#endif
#define RUN(k, call) do { if (IN(pb + (k))) { call; if ((DBLMASK >> (k)) & 1) { call; } } } while (0)
#define LAYER(l) do { \
        const int pb = 2 + PH_PER_LAYER * (l); \
        RUN(0, p_gemm1(fresh(F), (l))); \
        SEAM(pb + 0); \
        RUN(1, p_mixer_local(fresh(F), a, (l))); \
        SEAM(pb + 1); \
        RUN(2, p_scan(fresh(F), a, (l))); \
        SEAM(pb + 2); \
        RUN(3, p_rwkv_out(fresh(F), a, (l))); \
        SEAM(pb + 3); \
        RUN(4, p_gemm2(fresh(F), (l))); \
        SEAM(pb + 4); \
        RUN(5, p_rowpass1(fresh(F), a, (l), (l) == 0 ? a.in[0] : a.out)); \
        if (IN(pb + 5) && ((DBLMASK >> 10) & 1)) p_rowpass1(fresh(F), a, (l), (l) == 0 ? a.in[0] : a.out, true); \
        SEAM(pb + 5); \
        RUN(6, p_gather(fresh(F), (l))); \
        SEAM(pb + 6); \
        RUN(7, p_moe_a(fresh(F), (l))); \
        SEAM_MOE(pb + 7); \
        RUN(8, p_moe_b(fresh(F), (l))); \
        SEAM(pb + 8); \
        RUN(9, p_rowpass2(fresh(F), a, (l), a.out)); \
        SEAM(pb + 9); \
    } while (0)
    LAYER(0);
    LAYER(1);
#undef LAYER
#undef IN
#undef SEAM
}

#ifndef MK_MODE
#define MK_MODE 0
#endif
#ifndef TESTMODE
#define TESTMODE 0
#endif

static void fill_args(Args& a, void* const* d_in, void* d_out, void* d_ws) {
    for (int i = 0; i < 31; ++i) a.in[i] = (const float*)d_in[i];
    a.out = (float*)d_out; a.ws = (unsigned char*)d_ws; a.ph_lo = 0; a.ph_hi = N_PHASES; a.use_cg = 0; a.pad = 0;
}
static void launch_phases(Args a, int lo, int hi, hipStream_t stream) {
    for (int p = lo; p < hi; ++p) { a.ph_lo = p; a.ph_hi = p + 1; hipLaunchKernelGGL(mk_fwd, dim3(256), dim3(NTHREADS), LDS_BYTES, stream, a); }
}

#if TESTMODE == 0
extern "C" void kernel_launch(void* const* d_in, const int* in_sizes, int n_in, void* d_out, int out_size, void* d_ws, size_t ws_size, hipStream_t stream) {
    static int grid = 0;
    if (grid == 0) {
        int dev = 0, cus = 0, per_cu = 0;
        (void)hipGetDevice(&dev); (void)hipDeviceGetAttribute(&cus, hipDeviceAttributeMultiprocessorCount, dev);
        (void)hipFuncSetAttribute((const void*)mk_fwd, hipFuncAttributeMaxDynamicSharedMemorySize, LDS_BYTES);
        (void)hipOccupancyMaxActiveBlocksPerMultiprocessor(&per_cu, (const void*)mk_fwd, NTHREADS, LDS_BYTES);
        (void)hipGetLastError();
        grid = (cus > 0 ? cus : 256) * 1;
        if (ws_size < WS_END || n_in != 31) grid = -1;
    }
    if (grid < 0) return;
    (void)hipMemsetAsync((char*)d_ws + WS_CTL, 0, CTL_BYTES, stream);
    Args a{}; fill_args(a, d_in, d_out, d_ws);
#if MK_MODE == 2
    launch_phases(a, 0, N_PHASES, stream);
#else
    a.use_cg = (MK_MODE == 1) ? 1 : 0;
    void* args[] = {&a};
    (void)hipLaunchCooperativeKernel((const void*)mk_fwd, dim3(grid), dim3(NTHREADS), args, LDS_BYTES, stream);
#endif
}
#endif

#if TESTMODE > 0
constexpr int O_A = 1152, O_B = 2304, O_W = 2336, O_AL = 2368, O_G = 2432;
struct HSrc { const bf16_t* HB; const bf16_t* VT;
    DI float at(size_t tok, int n) const { if (n < 768) return bf2f(HB[tok * HW + n]); if (n < 1152) return bf2f(VT[(size_t)(n - 768) * T + tok]); return bf2f(HB[tok * HW + n - 384]); } };
DI float sigm_n(float x) { return 1.f / (1.f + expf(-x)); }

__global__ void k_mod_n(const float* __restrict__ c, const float* __restrict__ w_mod, const float* __restrict__ b_mod, float* __restrict__ mod) {
    __shared__ float sc[NB * D];
    for (int i = threadIdx.x; i < NB * D; i += blockDim.x) { float v = c[i]; sc[i] = v * sigm_n(v); }
    __syncthreads();
    int idx = blockIdx.x * blockDim.x + threadIdx.x; int l = idx / MODW, n = idx % MODW;
    const float* w = w_mod + (size_t)l * D * MODW + n; float a0 = 0.f, a1 = 0.f;
    for (int k = 0; k < D; ++k) { float wv = w[(size_t)k * MODW]; a0 += sc[k] * wv; a1 += sc[D + k] * wv; }
    float bb = b_mod[l * MODW + n];
    mod[(size_t)(l * NB + 0) * MODW + n] = a0 + bb; mod[(size_t)(l * NB + 1) * MODW + n] = a1 + bb;
}
__global__ void k_ln_mod_n(const float* __restrict__ xin, const float* __restrict__ modl, int off_sh, int off_sc, float* __restrict__ uout) {
    int row = (blockIdx.x * blockDim.x + threadIdx.x) >> 6, lane = threadIdx.x & 63; if (row >= T) return; int b = row / S;
    f32x4 v[4];
#pragma unroll
    for (int j = 0; j < 4; ++j) v[j] = *(const f32x4*)(xin + (size_t)row * D + 4 * lane + 256 * j);
    float mean, rstd; row_ln(v, mean, rstd);
    const float* md = modl + (size_t)b * MODW;
#pragma unroll
    for (int j = 0; j < 4; ++j) { int col = 4 * lane + 256 * j; *(f32x4*)(uout + (size_t)row * D + col) = v[j] * rstd * (1.f + *(const f32x4*)(md + off_sc + col)) + *(const f32x4*)(md + off_sh + col); }
}
__global__ void k_post_n(const float* xin, const float* br, const float* __restrict__ modl, int off_gate, const float* __restrict__ gain, const float* __restrict__ bias, float* xout, float* u2out, int off_sh2, int off_sc2) {
    int row = (blockIdx.x * blockDim.x + threadIdx.x) >> 6, lane = threadIdx.x & 63; if (row >= T) return; int b = row / S;
    const float* md = modl + (size_t)b * MODW; f32x4 v[4];
#pragma unroll
    for (int j = 0; j < 4; ++j) { int col = 4 * lane + 256 * j; v[j] = *(const f32x4*)(xin + (size_t)row * D + col) * ALPHA + *(const f32x4*)(md + off_gate + col) * *(const f32x4*)(br + (size_t)row * D + col); }
    float mean, rstd; row_ln(v, mean, rstd);
#pragma unroll
    for (int j = 0; j < 4; ++j) { int col = 4 * lane + 256 * j; v[j] = v[j] * rstd * *(const f32x4*)(gain + col) + *(const f32x4*)(bias + col); *(f32x4*)(xout + (size_t)row * D + col) = v[j]; }
    if (u2out == nullptr) return;
    row_ln(v, mean, rstd);
#pragma unroll
    for (int j = 0; j < 4; ++j) { int col = 4 * lane + 256 * j; *(f32x4*)(u2out + (size_t)row * D + col) = v[j] * rstd * (1.f + *(const f32x4*)(md + off_sc2 + col)) + *(const f32x4*)(md + off_sh2 + col); }
}
__global__ void __launch_bounds__(256) k_gemm_f32(const float* __restrict__ A, int lda, const float* __restrict__ B, int ldb, float* __restrict__ C, int ldc, int K) {
    __shared__ float As[16][65]; __shared__ float Bs[16][64];
    const int tx = threadIdx.x & 15, ty = threadIdx.x >> 4; const int m0 = blockIdx.y * 64, n0 = blockIdx.x * 64;
    float acc[4][4];
#pragma unroll
    for (int i = 0; i < 4; ++i)
#pragma unroll
        for (int j = 0; j < 4; ++j) acc[i][j] = 0.f;
    for (int k0 = 0; k0 < K; k0 += 16) {
#pragma unroll
        for (int i = 0; i < 4; ++i) { int e = threadIdx.x + 256 * i; int m = e >> 4, k = e & 15; As[k][m] = A[(size_t)(m0 + m) * lda + k0 + k]; }
#pragma unroll
        for (int i = 0; i < 4; ++i) { int e = threadIdx.x + 256 * i; int k = e >> 6, n = e & 63; Bs[k][n] = B[(size_t)(k0 + k) * ldb + n0 + n]; }
        __syncthreads();
#pragma unroll
        for (int k = 0; k < 16; ++k) { float a[4], b[4];
#pragma unroll
            for (int i = 0; i < 4; ++i) { a[i] = As[k][ty * 4 + i]; b[i] = Bs[k][tx * 4 + i]; }
#pragma unroll
            for (int i = 0; i < 4; ++i)
#pragma unroll
                for (int j = 0; j < 4; ++j) acc[i][j] += a[i] * b[j]; }
        __syncthreads();
    }
#pragma unroll
    for (int i = 0; i < 4; ++i) *(float4*)(C + (size_t)(m0 + ty * 4 + i) * ldc + n0 + tx * 4) = make_float4(acc[i][0], acc[i][1], acc[i][2], acc[i][3]);
}
__global__ void __launch_bounds__(64) k_attn_n(HSrc h, const float* __restrict__ rpb, float* __restrict__ concat) {
    int idx = blockIdx.x * blockDim.x + threadIdx.x; if (idx >= T * AH) return;
    int head = idx % AH, tok = idx / AH; int b = tok / S, t = tok % S, r = t / GW, cq = t % GW;
    int rstart = r - KH / 2; rstart = rstart < 0 ? 0 : (rstart > ROWS - KH ? ROWS - KH : rstart);
    int cstart = cq - KW / 2; cstart = cstart < 0 ? 0 : (cstart > GW - KW ? GW - KW : cstart);
    float q[HD], acc[HD];
#pragma unroll
    for (int d = 0; d < HD; ++d) { q[d] = h.at(tok, head * HD + d); acc[d] = 0.f; }
    float m = -1e30f, l = 0.f; const float* rp = rpb + (size_t)head * 15 * 31;
    for (int kk = 0; kk < KH; ++kk) { int kr = rstart + kk; int dr = kr - r + (KH - 1);
        for (int j = 0; j < KW; ++j) { int ck = cstart + j; int dc = ck - cq; dc = dc < -15 ? -15 : (dc > 15 ? 15 : dc); dc += 15;
            size_t kt = (size_t)b * S + kr * GW + ck; float s = 0.f;
#pragma unroll
            for (int d = 0; d < HD; ++d) s += q[d] * h.at(kt, AW + head * HD + d);
            s = s * 0.125f + rp[dr * 31 + dc];
            float mn = fmaxf(m, s); float corr = expf(m - mn); float p = expf(s - mn); l = l * corr + p;
#pragma unroll
            for (int d = 0; d < HD; ++d) acc[d] = acc[d] * corr + p * h.at(kt, 2 * AW + head * HD + d);
            m = mn; } }
    float inv = 1.f / l;
#pragma unroll
    for (int d = 0; d < HD; ++d) concat[(size_t)tok * D + head * HD + d] = acc[d] * inv;
}
__global__ void __launch_bounds__(256) k_pool_n(HSrc h, const float* __restrict__ pool_w, const float* __restrict__ pool_scale, float* __restrict__ concat) {
    __shared__ float pooled[CW];
    int tok = blockIdx.x; int b = tok / S, t = tok % S; int ch = threadIdx.x; int g = ch / 64; int win = 2 << g;
    int lo = t - win / 2; lo = lo < 0 ? 0 : lo; int hi = t + win / 2 - 1; hi = hi > S - 1 ? S - 1 : hi;
    float s = 0.f; for (int u = lo; u <= hi; ++u) s += h.at((size_t)b * S + u, O_G + ch);
    pooled[ch] = s / (float)(hi - lo + 1) - h.at(tok, O_G + ch);
    __syncthreads();
    int e = ch % 64; const float* pw = pool_w + (size_t)g * 64 * 64 + e; float a = 0.f;
    for (int c2 = 0; c2 < 64; ++c2) a += pooled[g * 64 + c2] * pw[c2 * 64];
    concat[(size_t)tok * D + AW + BW + ch] = a * pool_scale[ch];
}
__global__ void __launch_bounds__(64) k_rwkv_scan_n(HSrc h, RwP p, float* __restrict__ ys) {
    const int lane = threadIdx.x; const int dir = blockIdx.x / (NB * BH), b = (blockIdx.x / BH) % NB, hd = blockIdx.x % BH; const int ch = hd * HD + lane;
    float st[HD];
#pragma unroll
    for (int j = 0; j < HD; ++j) st[j] = 0.f;
    float wup[RW], aup[RA];
#pragma unroll
    for (int m = 0; m < RW; ++m) { wup[m] = p.w_up[(size_t)(dir * RW + m) * BW + ch]; aup[m] = p.a_up[(size_t)(dir * RA + m) * BW + ch]; }
    const float w0 = p.w0[dir * BW + ch], a0 = p.a0[dir * BW + ch], kkw = p.k_k[ch], kaw = p.k_a[ch];
    float cr[3], ck[3], cv[3];
#pragma unroll
    for (int x = 0; x < 3; ++x) { cr[x] = p.conv[x * 3 * BW + ch]; ck[x] = p.conv[x * 3 * BW + BW + ch]; cv[x] = p.conv[x * 3 * BW + 2 * BW + ch]; }
    for (int step = 0; step < S; ++step) {
        const int t = dir ? (S - 1 - step) : step; const size_t row = (size_t)b * S + t;
        float r = 0.f, k = 0.f, v = 0.f;
#pragma unroll
        for (int x = 0; x < 3; ++x) { int tt = t + x - 1; if (tt >= 0 && tt < S) { size_t rr = (size_t)b * S + tt; r += h.at(rr, O_A + ch) * cr[x]; k += h.at(rr, O_A + BW + ch) * ck[x]; v += h.at(rr, O_A + 2 * BW + ch) * cv[x]; } }
        float lv = h.at(row, O_B + lane); float lt = lane < RW ? tanhf(lv) : lv; float zw = w0, za = a0;
#pragma unroll
        for (int m = 0; m < RW; ++m) { zw += __shfl(lt, m) * wup[m]; za += __shfl(lt, RW + m) * aup[m]; }
        const float w = expf(-DECAY * sigm_n(zw)); const float a = sigm_n(za);
        float kk = k * kkw; float ss = wave_sum(kk * kk); kk = kk * (1.f / sqrtf(fmaxf(ss, 1e-24f)));
        const float kd = k * (1.f + (a - 1.f) * kaw); const float kka = kk * a;
        float sa = 0.f;
#pragma unroll
        for (int j = 0; j < HD; ++j) sa += st[j] * (-__shfl(kk, j));
        float y = 0.f;
#pragma unroll
        for (int j = 0; j < HD; ++j) { st[j] = st[j] * __shfl(w, j) + sa * __shfl(kka, j) + v * __shfl(kd, j); y += st[j] * __shfl(r, j); }
        ys[((size_t)dir * T + b * S + t) * BW + ch] = y;
    }
}
__global__ void __launch_bounds__(384) k_rwkv_finish_n(HSrc h, RwP p, const float* __restrict__ ys, float* __restrict__ concat) {
    __shared__ float lw[RW], la[RA], sg[RG];
    const int tok = blockIdx.x, b = tok / S, t = tok % S, ch = threadIdx.x, hd = ch / HD, j = ch % HD;
    if (ch < RW) lw[ch] = tanhf(h.at(tok, O_B + ch)); else if (ch < RW + RA) la[ch - RW] = h.at(tok, O_W + (ch - RW)); else if (ch < RW + RA + RG) sg[ch - RW - RA] = sigm_n(h.at(tok, O_AL + (ch - RW - RA)));
    __syncthreads();
    float r = 0.f, k = 0.f, v = 0.f;
#pragma unroll
    for (int x = 0; x < 3; ++x) { int tt = t + x - 1; if (tt >= 0 && tt < S) { size_t rr = (size_t)b * S + tt;
        r += h.at(rr, O_A + ch) * p.conv[x * 3 * BW + ch]; k += h.at(rr, O_A + BW + ch) * p.conv[x * 3 * BW + BW + ch]; v += h.at(rr, O_A + 2 * BW + ch) * p.conv[x * 3 * BW + 2 * BW + ch]; } }
    float bon = 0.f;
    for (int dir = 0; dir < 2; ++dir) { float za = p.a0[dir * BW + ch]; for (int m = 0; m < RA; ++m) za += la[m] * p.a_up[(size_t)(dir * RA + m) * BW + ch];
        float a = sigm_n(za); float kd = k * (1.f + (a - 1.f) * p.k_a[ch]); bon += wave_sum(r * kd * p.r_k[hd * HD + j]); }
    bon *= v;
    float y = ys[(size_t)tok * BW + ch] + ys[((size_t)T + tok) * BW + ch];
    float mu = wave_sum(y) * (1.f / HD); float dy = y - mu; float var = wave_sum(dy * dy) * (1.f / HD);
    float yn = dy * (1.f / sqrtf(var + GN_EPS)) * p.gn_gain[ch] + p.gn_bias[ch];
    float g = 0.f; for (int m = 0; m < RG; ++m) g += sg[m] * p.g_up[(size_t)m * BW + ch];
    concat[(size_t)tok * D + AW + ch] = (yn + bon) * g;
}
__global__ void __launch_bounds__(256) k_moe_n(const float* __restrict__ u2, const int* __restrict__ tokslot, const float* __restrict__ ew,
                                                const float* __restrict__ wgate, const float* __restrict__ wup, const float* __restrict__ wdown, float* __restrict__ f) {
    __shared__ float xs[D]; __shared__ float hb[DE];
    const int tok = blockIdx.x, tid = threadIdx.x;
    for (int i = tid; i < D; i += 256) xs[i] = u2[(size_t)tok * D + i];
    float o[4] = {0.f, 0.f, 0.f, 0.f};
    for (int kk = 0; kk < 2; ++kk) {
        const int ts = tokslot[tok * 2 + kk]; const int e = ts >> 14; const float wt = ew[ts];
        __syncthreads();
        const float* g = wgate + (size_t)e * D * DE; const float* u = wup + (size_t)e * D * DE;
        float ag0 = 0.f, ag1 = 0.f, au0 = 0.f, au1 = 0.f;
        for (int k = 0; k < D; ++k) { float x = xs[k]; ag0 += x * g[(size_t)k * DE + tid]; ag1 += x * g[(size_t)k * DE + 256 + tid]; au0 += x * u[(size_t)k * DE + tid]; au1 += x * u[(size_t)k * DE + 256 + tid]; }
        hb[tid] = ag0 * sigm_n(ag0) * au0; hb[256 + tid] = ag1 * sigm_n(ag1) * au1;
        __syncthreads();
        const float* dn = wdown + (size_t)e * DE * D; float a[4] = {0.f, 0.f, 0.f, 0.f};
        for (int k = 0; k < DE; ++k) { float x = hb[k];
#pragma unroll
            for (int j = 0; j < 4; ++j) a[j] += x * dn[(size_t)k * D + tid + 256 * j]; }
#pragma unroll
        for (int j = 0; j < 4; ++j) o[j] += a[j] * wt;
    }
#pragma unroll
    for (int j = 0; j < 4; ++j) f[(size_t)tok * D + tid + 256 * j] = o[j];
}

__global__ void k_router_n(const float* __restrict__ u2, const float* __restrict__ wg, const float* __restrict__ bg, const float* __restrict__ we, const float* __restrict__ be, int* __restrict__ tok_e) {
    int row = (blockIdx.x * blockDim.x + threadIdx.x) >> 6, lane = threadIdx.x & 63; if (row >= T) return;
    float gl[NG], el[NE];
#pragma unroll
    for (int n = 0; n < NG; ++n) gl[n] = 0.f;
#pragma unroll
    for (int n = 0; n < NE; ++n) el[n] = 0.f;
    for (int i = 0; i < 16; ++i) { int k = lane + 64 * i; float x = u2[(size_t)row * D + k];
#pragma unroll
        for (int n = 0; n < NG; ++n) gl[n] += x * wg[k * NG + n];
#pragma unroll
        for (int n = 0; n < NE; ++n) el[n] += x * we[k * NE + n]; }
#pragma unroll
    for (int n = 0; n < NG; ++n) gl[n] = wave_sum(gl[n]) + bg[n];
#pragma unroll
    for (int n = 0; n < NE; ++n) el[n] = wave_sum(el[n]) + be[n];
    int gi = 0; float gm = gl[0];
#pragma unroll
    for (int n = 1; n < NG; ++n) if (gl[n] > gm) { gm = gl[n]; gi = n; }
    float l1 = -3.0e38f, l2 = -3.0e38f; int i1 = 0, i2 = 0;
#pragma unroll
    for (int n = 0; n < NE; ++n) if ((n >> 3) == gi) { float v = el[n]; int e = n & 7; if (v > l1) { l2 = l1; i2 = i1; l1 = v; i1 = e; } else if (v > l2) { l2 = v; i2 = e; } }
    if (lane == 0) { tok_e[row * 2] = gi * EPG + i1; tok_e[row * 2 + 1] = gi * EPG + i2; }
}
__global__ void k_cmp_route(const int* __restrict__ tokslot, const int* __restrict__ tok_e, float* acc, int slot) {
    float mis = 0.f, tot = 0.f;
    for (int t = blockIdx.x * blockDim.x + threadIdx.x; t < T; t += gridDim.x * blockDim.x) { const int a0 = tokslot[2 * t] >> 14, a1 = tokslot[2 * t + 1] >> 14;
        mis += (a0 != tok_e[2 * t] || a1 != tok_e[2 * t + 1]) ? 1.f : 0.f; tot += 1.f; }
    mis = wave_sum(mis); tot = wave_sum(tot);
    if ((threadIdx.x & 63) == 0) { atomicAdd(acc + 2 * slot, mis); atomicAdd(acc + 2 * slot + 1, tot); }
}
__global__ void k_bf2f(const bf16_t* __restrict__ src, float* __restrict__ dst, size_t n) { for (size_t i = (size_t)blockIdx.x * blockDim.x + threadIdx.x; i < n; i += (size_t)gridDim.x * blockDim.x) dst[i] = bf2f(src[i]); }
template <class TA> __global__ void k_cmp(const TA* __restrict__ a, size_t lda, const float* __restrict__ b, size_t ldb, int rows, int cols, float* acc, int slot) {
    float d2 = 0.f, r2 = 0.f;
    for (size_t i = (size_t)blockIdx.x * blockDim.x + threadIdx.x; i < (size_t)rows * cols; i += (size_t)gridDim.x * blockDim.x) {
        const size_t r = i / cols, c = i % cols; float av; if constexpr (sizeof(TA) == 2) av = bf2f(a[r * lda + c]); else av = a[r * lda + c];
        const float bv = b[r * ldb + c]; d2 += (av - bv) * (av - bv); r2 += bv * bv; }
    d2 = wave_sum(d2); r2 = wave_sum(r2);
    if ((threadIdx.x & 63) == 0) { atomicAdd(acc + 2 * slot, d2); atomicAdd(acc + 2 * slot + 1, r2); }
}
__global__ void k_cmp_vt(const bf16_t* __restrict__ vt, const float* __restrict__ b, size_t ldb, float* acc, int slot) {
    float d2 = 0.f, r2 = 0.f;
    for (size_t i = (size_t)blockIdx.x * blockDim.x + threadIdx.x; i < (size_t)T * AW; i += (size_t)gridDim.x * blockDim.x) {
        const size_t r = i % T, c = i / T; const float av = bf2f(vt[c * T + r]), bv = b[r * ldb + c]; d2 += (av - bv) * (av - bv); r2 += bv * bv; }
    d2 = wave_sum(d2); r2 = wave_sum(r2);
    if ((threadIdx.x & 63) == 0) { atomicAdd(acc + 2 * slot, d2); atomicAdd(acc + 2 * slot + 1, r2); }
}
struct Tols { float t[8]; int n; };
__global__ void k_readout(float* out, const float* acc, Tols tl, int total) {
    float mx = 0.f; int am = 0; for (int k = 0; k < tl.n; ++k) { float e = sqrtf(acc[2 * k] / fmaxf(acc[2 * k + 1], 1e-30f)); if (!(e == e)) e = 1e3f; if (e / tl.t[k] > mx) { mx = e / tl.t[k]; am = k; } }
    const float cval = sqrtf(1000.f * mx);
    for (int i = blockIdx.x * blockDim.x + threadIdx.x; i < total; i += gridDim.x * blockDim.x) out[i] = (i < 8) ? 1000.f * (float)(am + 1) : cval;
}
__global__ void __launch_bounds__(256) k_moe_chk(const float* __restrict__ u2, const int* __restrict__ tokslot, const float* __restrict__ ew, const unsigned* __restrict__ cnt,
                                                  const float* __restrict__ wgate, const float* __restrict__ wup, const float* __restrict__ wdown,
                                                  const bf16_t* __restrict__ XS, const bf16_t* __restrict__ HM, const bf16_t* __restrict__ YS, float* acc) {
    __shared__ float xs[D]; __shared__ float hb[DE]; __shared__ int offp[NE];
    const int tok = blockIdx.x, tid = threadIdx.x;
    if (tid == 0) { int off = 0; for (int e = 0; e < NE; ++e) { offp[e] = off; off += (((int)cnt[e] + 255) >> 8) * 256; } }
    for (int i = tid; i < D; i += 256) xs[i] = u2[(size_t)tok * D + i];
    float d0 = 0.f, r0 = 0.f, d1 = 0.f, r1 = 0.f, d2 = 0.f, r2 = 0.f;
    for (int kk = 0; kk < 2; ++kk) {
        __syncthreads();
        const int ts = tokslot[tok * 2 + kk]; const int e = ts >> 14; const float wt = ew[ts]; const size_t slot = (size_t)offp[e] + (ts & 16383);
        for (int i = tid; i < D; i += 256) { const float a = bf2f(XS[slot * D + i]), b = xs[i]; d0 += (a - b) * (a - b); r0 += b * b; }
        const float* g = wgate + (size_t)e * D * DE; const float* u = wup + (size_t)e * D * DE;
        float ag0 = 0.f, ag1 = 0.f, au0 = 0.f, au1 = 0.f;
        for (int k = 0; k < D; ++k) { float x = xs[k]; ag0 += x * g[(size_t)k * DE + tid]; ag1 += x * g[(size_t)k * DE + 256 + tid]; au0 += x * u[(size_t)k * DE + tid]; au1 += x * u[(size_t)k * DE + 256 + tid]; }
        const float h0 = ag0 * sigm_n(ag0) * au0, h1 = ag1 * sigm_n(ag1) * au1;
        hb[tid] = h0; hb[256 + tid] = h1;
        { const float a = bf2f(HM[slot * DE + tid]), b = bf2f(HM[slot * DE + 256 + tid]); d1 += (a - h0) * (a - h0) + (b - h1) * (b - h1); r1 += h0 * h0 + h1 * h1; }
        __syncthreads();
        const float* dn = wdown + (size_t)e * DE * D; float a4[4] = {0.f, 0.f, 0.f, 0.f};
        for (int k = 0; k < DE; ++k) { float x = hb[k];
#pragma unroll
            for (int j = 0; j < 4; ++j) a4[j] += x * dn[(size_t)k * D + tid + 256 * j]; }
#pragma unroll
        for (int j = 0; j < 4; ++j) {
#ifdef MOEB_NOSCALE
            const float y = a4[j];
#else
            const float y = a4[j] * wt;
#endif
            const float a = bf2f(YS[slot * D + tid + 256 * j]); d2 += (a - y) * (a - y); r2 += y * y; }
    }
    d0 = wave_sum(d0); r0 = wave_sum(r0); d1 = wave_sum(d1); r1 = wave_sum(r1); d2 = wave_sum(d2); r2 = wave_sum(r2);
    if ((tid & 63) == 0) { atomicAdd(acc + 0, d0); atomicAdd(acc + 1, r0); atomicAdd(acc + 2, d1); atomicAdd(acc + 3, r1); atomicAdd(acc + 4, d2); atomicAdd(acc + 5, r2); }
}

extern "C" void kernel_launch(void* const* d_in, const int* in_sizes, int n_in, void* d_out, int out_size, void* d_ws, size_t ws_size, hipStream_t stream) {
    static int once = 0; if (!once) { (void)hipFuncSetAttribute((const void*)mk_fwd, hipFuncAttributeMaxDynamicSharedMemorySize, LDS_BYTES); once = 1; }
    (void)hipMemsetAsync((char*)d_ws + WS_CTL, 0, CTL_BYTES, stream);
    Args a{}; fill_args(a, d_in, d_out, d_ws);
    char* ws = (char*)d_ws; float* out = (float*)d_out;
    float* ACC = (float*)(ws + 32768 + 1024);
    const float* x = a.in[0];
    HSrc hs{(const bf16_t*)(ws + WS_HB), (const bf16_t*)(ws + WS_VT)};
    const int l = 0;
    RwP p = { a.in[6], a.in[7], a.in[8], a.in[9], a.in[10], a.in[11], a.in[12], a.in[13], a.in[14], a.in[15], a.in[16] };
    Tols tl{};
#if TESTMODE == 1
    launch_phases(a, 0, 3, stream);
    float* MODn = (float*)(ws + WS_MOD + 512 * 1024); float* Un = (float*)(ws + WS_XA); float* HF = (float*)(ws + WS_CONCAT);
    k_mod_n<<<L * MODW / 256, 256, 0, stream>>>(a.in[1], a.in[2], a.in[3], MODn);
    k_ln_mod_n<<<T / 4, 256, 0, stream>>>(x, MODn, 0, D, Un);
    k_gemm_f32<<<dim3(INW / 64, T / 64), 256, 0, stream>>>(Un, D, a.in[4], INW, HF, INW, D);
    k_cmp<float><<<256, 256, 0, stream>>>((const float*)(ws + WS_MOD), MODW, MODn, MODW, L * NB, MODW, ACC, 0);
    k_cmp<bf16_t><<<1024, 256, 0, stream>>>((const bf16_t*)(ws + WS_U), D, Un, D, T, D, ACC, 1);
    k_cmp<bf16_t><<<1024, 256, 0, stream>>>((const bf16_t*)(ws + WS_HB), HW, HF, INW, T, 768, ACC, 2);
    k_cmp<bf16_t><<<1024, 256, 0, stream>>>((const bf16_t*)(ws + WS_HB) + 768, HW, HF + 1152, INW, T, 1536, ACC, 3);
    k_cmp_vt<<<1024, 256, 0, stream>>>((const bf16_t*)(ws + WS_VT), HF + 768, INW, ACC, 4);
    tl.n = 5; tl.t[0] = 1e-5f; tl.t[1] = 4e-3f; tl.t[2] = 6e-3f; tl.t[3] = 6e-3f; tl.t[4] = 6e-3f;
#elif TESTMODE == 2
    launch_phases(a, 0, 4, stream);
    float* CCn = (float*)(ws + WS_XA); float* YSn = (float*)(ws + WS_WGU);
    k_attn_n<<<T * AH / 64, 64, 0, stream>>>(hs, a.in[5], CCn);
    k_pool_n<<<T, 256, 0, stream>>>(hs, a.in[17], a.in[18], CCn);
    k_rwkv_scan_n<<<2 * NB * BH, 64, 0, stream>>>(hs, p, YSn);
    k_rwkv_finish_n<<<T, 384, 0, stream>>>(hs, p, YSn, CCn);
    launch_phases(a, 4, 6, stream);
    k_cmp<bf16_t><<<1024, 256, 0, stream>>>((const bf16_t*)(ws + WS_CONCAT), D, CCn, D, T, AW, ACC, 0);
    k_cmp<bf16_t><<<1024, 256, 0, stream>>>((const bf16_t*)(ws + WS_CONCAT) + AW, D, CCn + AW, D, T, BW, ACC, 1);
    k_cmp<bf16_t><<<1024, 256, 0, stream>>>((const bf16_t*)(ws + WS_CONCAT) + AW + BW, D, CCn + AW + BW, D, T, CW, ACC, 2);
    tl.n = 3; tl.t[0] = TOL0; tl.t[1] = TOL1; tl.t[2] = TOL2;
#elif TESTMODE == 3
    launch_phases(a, 0, 11, stream);
    { const float* MODf = (const float*)(ws + WS_MOD);
      float* U2f = (float*)(ws + 414 * MiB); float* Fn = (float*)(ws + 213 * MiB); float* X2n = (float*)(ws + 277 * MiB);
      k_bf2f<<<2048, 256, 0, stream>>>((const bf16_t*)(ws + WS_U), U2f, (size_t)T * D);
      launch_phases(a, 11, 12, stream);
      k_moe_n<<<T, 256, 0, stream>>>(U2f, (const int*)(ws + WS_TOKSLOT), (const float*)(ws + WS_EW), a.in[28], a.in[29], a.in[30], Fn);
      k_post_n<<<T / 4, 256, 0, stream>>>((const float*)(ws + WS_XA), Fn, MODf, 5 * D, a.in[22], a.in[23], X2n, nullptr, 0, 0);
      k_cmp<float><<<1024, 256, 0, stream>>>(out, D, X2n, D, T, D, ACC, 0); }
    tl.n = 1; tl.t[0] = TOL0;
#elif TESTMODE == 4
    launch_phases(a, 0, 8, stream);
    { const float* MODf = (const float*)(ws + WS_MOD);
      float* CCn = (float*)(ws + 405 * MiB); float* MIXn = (float*)(ws + 213 * MiB); float* X1n = (float*)(ws + 21 * MiB); float* U2n = (float*)(ws + 333 * MiB); int* TEn = (int*)(ws + 490 * MiB);
      k_bf2f<<<2048, 256, 0, stream>>>((const bf16_t*)(ws + WS_CONCAT), CCn, (size_t)T * D);
      k_gemm_f32<<<dim3(D / 64, T / 64), 256, 0, stream>>>(CCn, D, a.in[19], D, MIXn, D, D);
      k_post_n<<<T / 4, 256, 0, stream>>>(x, MIXn, MODf, 2 * D, a.in[20], a.in[21], X1n, U2n, 3 * D, 4 * D);
      k_router_n<<<T / 4, 256, 0, stream>>>(U2n, a.in[24], a.in[25], a.in[26], a.in[27], TEn);
      k_cmp<float><<<1024, 256, 0, stream>>>((const float*)(ws + WS_XA), D, X1n, D, T, D, ACC, 0);
      k_cmp<bf16_t><<<1024, 256, 0, stream>>>((const bf16_t*)(ws + WS_U), D, U2n, D, T, D, ACC, 1);
      k_cmp_route<<<64, 256, 0, stream>>>((const int*)(ws + WS_TOKSLOT), TEn, ACC, 2); }
    tl.n = 3; tl.t[0] = TOL0; tl.t[1] = TOL1; tl.t[2] = TOL2;
#elif TESTMODE == 5
    launch_phases(a, 0, 11, stream);
    { float* U2f = (float*)(ws + 414 * MiB);
      k_bf2f<<<2048, 256, 0, stream>>>((const bf16_t*)(ws + WS_U), U2f, (size_t)T * D);
      k_moe_chk<<<T, 256, 0, stream>>>(U2f, (const int*)(ws + WS_TOKSLOT), (const float*)(ws + WS_EW), (const unsigned*)(ws + WS_CTL) + CW_CNT, a.in[28], a.in[29], a.in[30],
                                       (const bf16_t*)(ws + WS_XS), (const bf16_t*)(ws + WS_HM), (const bf16_t*)(ws + WS_YS), ACC); }
    tl.n = 3; tl.t[0] = 1e-6f; tl.t[1] = 1e-2f; tl.t[2] = 1e-2f;
#endif
    k_readout<<<256, 256, 0, stream>>>(out, ACC, tl, out_size);
}
#endif
```

```cpp
#define TESTMODE 0
#define MK_MODE 0
#define S0_WRITER 1
#define ATT_XCD 1
#define FUSE_MOE 1
#define CONV_G1 1
#define N1 2016
#include <hip/hip_runtime.h>
#include <hip/hip_cooperative_groups.h>
#include <stdint.h>
namespace cg = cooperative_groups;

#ifndef TESTMODE
#define TESTMODE 0
#endif
#define DI __device__ __forceinline__
#define LAS __attribute__((address_space(3)))
typedef unsigned short bf16_t;
typedef short bf16x8 __attribute__((ext_vector_type(8)));
typedef float f32x4 __attribute__((ext_vector_type(4)));
typedef float f32x16 __attribute__((ext_vector_type(16)));
typedef unsigned u32x4 __attribute__((ext_vector_type(4)));
typedef unsigned u32x2 __attribute__((ext_vector_type(2)));
typedef float f32x2_t __attribute__((ext_vector_type(2)));
typedef __bf16 bf16x2_t __attribute__((ext_vector_type(2)));

namespace cfg {
constexpr int D = 1024, NB = 2, S = 8192, T = NB * S, L = 2;
constexpr int GW = 64, ROWS = 128;
constexpr int HD = 64, AW = 384, BW = 384, CW = 256, AH = 6, BH = 6;
constexpr int KH = 8, KW = 16;
constexpr int RW = 32, RA = 32, RG = 64;
constexpr int INW = 2688;
constexpr int NG = 4, EPG = 8, NE = 32, DE = 512;
constexpr int MODW = 6 * D;
constexpr float ALPHA = 1.41421356237309515f;
constexpr float LN_EPS = 1e-5f, GN_EPS = 64e-5f;
constexpr float DECAY = 0.60653065971263342f;
constexpr float LOG2E = 1.44269504088896341f;
constexpr int HW = 2304, HQ = 0, HK = 384, HR = 768, HWL = 1920, HAL = 1952, HGL = 1984, HP = 2048;
constexpr int NCH = S / 64;
constexpr int NUNIT = 2 * NB * BH * NCH;
constexpr int XSROWS = 2 * T + NE * 256;
}
using namespace cfg;

constexpr size_t MiB = 1u << 20;
constexpr size_t WS_CTL = 0;
constexpr size_t CTL_BYTES = 262144;
constexpr size_t WS_SLOTTOK = 65536;
constexpr int CW_BAR = 0;
constexpr int CW_MFL = 9216;
constexpr int CW_CNT = 8192;
constexpr size_t WS_MOD = 1 * MiB;
constexpr size_t WS_TOKSLOT = 1 * MiB + 128 * 1024;
constexpr size_t WS_SLOTW = 1 * MiB + 256 * 1024;
constexpr size_t WS_BC = 2 * MiB;
constexpr size_t WS_TOKW = 2 * MiB + 64 * 1024;
constexpr size_t WS_TOKFIN = 2 * MiB + 256 * 1024;
constexpr size_t WS_CNTF = 2 * MiB + 512 * 1024;
constexpr size_t WS_WIN = 6 * MiB;
constexpr size_t WIN_LAYER = (size_t)2816 * 1024 * 2;
constexpr size_t WS_WOUT = 17 * MiB;
constexpr size_t WS_WGU = 21 * MiB;
constexpr size_t WS_WD = 85 * MiB;
constexpr size_t WS_XA = 117 * MiB;
constexpr size_t WS_U = 181 * MiB;
constexpr size_t WS_HB = 213 * MiB;
constexpr size_t WS_S0 = 117 * MiB;
constexpr size_t WS_VT = 285 * MiB;
constexpr size_t WS_CONCAT = 301 * MiB;
constexpr size_t WS_MP = 333 * MiB;
constexpr size_t WS_NB = 358 * MiB;
constexpr size_t WS_MIX = 333 * MiB;
constexpr size_t WS_QT = 405 * MiB;
constexpr size_t WS_WT = 429 * MiB;
constexpr size_t WS_VTB = 453 * MiB;
constexpr size_t WS_GB = 465 * MiB;
constexpr size_t WS_VC = 477 * MiB;
constexpr size_t WS_BS = 489 * MiB;
constexpr size_t WS_XS = 213 * MiB;
constexpr size_t WS_HM = 293 * MiB;
constexpr size_t WS_YS = 333 * MiB;
constexpr size_t WS_END = 490 * MiB;
#ifndef NOSKEW
#define USK(u) ((size_t)(u) + ((size_t)(u) >> 7))
#else
#define USK(u) ((size_t)(u))
#endif

constexpr int NWAVES = 8, NTHREADS = 512;
constexpr int LDS_BYTES = 156 * 1024;

DI unsigned cvtpk(float lo, float hi) { f32x2_t v = {lo, hi}; bf16x2_t b = __builtin_convertvector(v, bf16x2_t); return __builtin_bit_cast(unsigned, b); }
DI float bflo(unsigned w) { return __uint_as_float(w << 16); }
DI float bfhi(unsigned w) { return __uint_as_float(w & 0xffff0000u); }
DI float bf2f(unsigned short h) { return __uint_as_float((unsigned)h << 16); }
DI unsigned short f2bf(float f) { return (unsigned short)(cvtpk(f, 0.f) & 0xffffu); }
DI float wave_sum_shfl(float v) {
#pragma unroll
    for (int o = 32; o > 0; o >>= 1) v += __shfl_xor(v, o);
    return v;
}
template <int CTRL, int ROWMASK> DI float dpp_add(float v) { return v + __builtin_bit_cast(float, __builtin_amdgcn_update_dpp(0, __builtin_bit_cast(int, v), CTRL, ROWMASK, 0xf, false)); }
DI float wave_sum(float v) {
    v = dpp_add<0xb1, 0xf>(v);
    v = dpp_add<0x4e, 0xf>(v);
    v = dpp_add<0x124, 0xf>(v);
    v = dpp_add<0x128, 0xf>(v);
    v = dpp_add<0x142, 0xa>(v);
    v = dpp_add<0x143, 0xc>(v);
    return __builtin_bit_cast(float, __builtin_amdgcn_readlane(__builtin_bit_cast(int, v), 63));
}
DI float fexp2(float x) { return __builtin_amdgcn_exp2f(x); }
DI float frcp(float x) { return __builtin_amdgcn_rcpf(x); }
DI float sigm(float x) { return frcp(1.f + fexp2(x * -LOG2E)); }
#define LDS_WAIT() asm volatile("s_waitcnt lgkmcnt(0)" ::: "memory")
#define VM_WAIT() asm volatile("s_waitcnt vmcnt(0)" ::: "memory")
DI int swap23(int i) { return (i & ~12) | ((i & 4) << 1) | ((i & 8) >> 1); }

namespace pg8 {
constexpr int BM = 256, BK = 64, HALF = 128, HTB = HALF * BK * 2, STAGE_BYTES = 8 * HTB, NXCD = 8, WGM = 8;
__host__ __device__ __forceinline__ int lds_byte(int r, int c) { const int st = (r >> 4) * 2 + (c >> 5), rr = r & 15, cc = c & 31, ob = rr * 64 + cc * 2; return st * 1024 + (ob ^ (((ob >> 9) & 1) << 5)); }
__host__ __device__ __forceinline__ void stage_rc(int b, int& R, int& C) { const int st = b / 1024, sb = b % 1024, swz = sb ^ (((sb >> 9) & 1) << 5); R = (st >> 1) * 16 + swz / 64; C = (st & 1) * 32 + (swz % 64) / 2; }
__host__ __device__ __forceinline__ int perm32(int rho) { const int n = rho >> 4, i = rho & 15; return 8 * (i >> 2) + 4 * n + (i & 3); }

struct Unit { int pm, pn, aux; };

DI int xcd_remap(int L, int nwg) { const int q = nwg / NXCD, r = nwg % NXCD, xcd = L % NXCD, off = L / NXCD; return (xcd < r ? xcd * (q + 1) : r * (q + 1) + (xcd - r) * q) + off; }

struct PlainOrder {
    static constexpr bool GATHER = false, SIGNAL = false, WAIT = false;
    DI void signal(const Unit&) const {} DI void wait(const Unit&) const {}
    const bf16_t* A; const bf16_t* Bt; int K; int nM, nN, nwg, G, c;
    DI void init(const bf16_t* A_, const bf16_t* Bt_, int M, int N, int K_, int G_, int c_) { A = A_; Bt = Bt_; K = K_; nM = M / BM; nN = N / BM; nwg = nM * nN; G = G_; c = c_; }
    DI bool next(int i, Unit& u) const {
        const int Lx = i * G + c; if (Lx >= nwg) return false;
        const int wgid = xcd_remap(Lx, nwg);
        const int nig = WGM * nN, gid = wgid / nig, fm = gid * WGM, gsz = (nM - fm) < WGM ? (nM - fm) : WGM;
        u.pm = fm + ((wgid % nig) % gsz); u.pn = (wgid % nig) / gsz; u.aux = 0; return true;
    }
    DI const char* aptr(const Unit& u) const { return (const char*)A + (size_t)u.pm * (2 * HALF) * K * 2; }
    DI const char* bptr(const Unit& u) const { return (const char*)Bt + (size_t)u.pn * (2 * HALF) * K * 2; }
};
struct Gemm1Order {
    static constexpr bool GATHER = false, SIGNAL = false, WAIT = false;
    DI void signal(const Unit&) const {} DI void wait(const Unit&) const {}
    const bf16_t* U; const bf16_t* Win; const bf16_t* Wv; int G, c;
    static constexpr int nM = T / BM, nN = HW / BM, nMain = nM * nN, nV = 2 * (T / BM), nwg = nMain + nV, K = D;
    DI bool next(int i, Unit& u) const {
        const int Lx = i * G + c; if (Lx >= nwg) return false;
        if (Lx < nMain) {
            const int wgid = xcd_remap(Lx, nMain);
            const int nig = WGM * nN, gid = wgid / nig, fm = gid * WGM, gsz = (nM - fm) < WGM ? (nM - fm) : WGM;
            u.pm = fm + ((wgid % nig) % gsz); u.pn = (wgid % nig) / gsz; u.aux = 0;
        } else { const int v = Lx - nMain; u.pm = v & 1; u.pn = v >> 1; u.aux = 1; }
        return true;
    }
    DI const char* aptr(const Unit& u) const { return (const char*)(u.aux ? Wv : U) + (size_t)u.pm * BM * K * 2; }
    DI const char* bptr(const Unit& u) const { return (const char*)(u.aux ? U : Win) + (size_t)u.pn * BM * K * 2; }
};
template <bool G_> struct GroupedOrderT {
    static constexpr bool GATHER = G_;
#ifdef FUSE_MOE
    static constexpr bool SIGNAL = G_, WAIT = false;
    unsigned* flags;
    DI void signal(const Unit& u) const { (void)__hip_atomic_fetch_add(flags + u.pm, 1u, __ATOMIC_RELAXED, __HIP_MEMORY_SCOPE_AGENT); }
    DI void wait(const Unit&) const {}
#else
    static constexpr bool SIGNAL = false, WAIT = false;
    DI void signal(const Unit&) const {} DI void wait(const Unit&) const {}
#endif
    const bf16_t* A; const bf16_t* Bt; int K; size_t estride; const LAS int* tile_e; int ntiles, nwg, G, c; const int* rowtok;
    DI bool next(int i, Unit& u) const {
        const int Lx = i * G + c; if (Lx >= nwg) return false;
        const int wgid = xcd_remap(Lx, nwg);
        u.pm = wgid >> 2; u.pn = wgid & 3; u.aux = tile_e[u.pm]; return true;
    }
    DI const char* aptr(const Unit& u) const { return GATHER ? (const char*)A : (const char*)A + (size_t)u.pm * BM * K * 2; }
    DI const char* bptr(const Unit& u) const { return (const char*)Bt + ((size_t)u.aux * estride + (size_t)u.pn * BM * K) * 2; }
};

#ifdef FUSE_MOE
struct GroupedOrderB {
    static constexpr bool GATHER = false, SIGNAL = false, WAIT = true;
    const bf16_t* A; const bf16_t* Bt; int K; size_t estride; const LAS int* tile_e; int ntiles, nwg, G, c; const int* rowtok; unsigned* flags;
    DI bool next(int i, Unit& u) const {
        int wgid;
        if (G % NXCD == 0) {
            const int P = G / NXCD, x = c % NXCD, k = c / NXCD, q = nwg / NXCD, r8 = nwg % NXCD;
            const int qx = q + (x < r8 ? 1 : 0), startx = x < r8 ? x * (q + 1) : r8 * (q + 1) + (x - r8) * q;
            const int remA = qx % P, nL = P - remA, seg1 = remA > 0 ? (2 * nL < qx ? 2 * nL : qx) : 0;
            int n1 = 0;
            if (remA > 0 && k >= remA) { n1 = (k - remA) < seg1 ? 1 : 0; n1 += (k - remA) + nL < seg1 ? 1 : 0; }
            const int ob = i < n1 ? (k - remA) + i * nL : seg1 + k + (i - n1) * P;
            if (ob >= qx) return false;
            wgid = startx + ob;
        } else { const int Lx = i * G + c; if (Lx >= nwg) return false; wgid = Lx; }
        u.pm = wgid >> 2; u.pn = wgid & 3; u.aux = tile_e[u.pm]; return true;
    }
    DI const char* aptr(const Unit& u) const { return (const char*)A + (size_t)u.pm * BM * K * 2; }
    DI const char* bptr(const Unit& u) const { return (const char*)Bt + ((size_t)u.aux * estride + (size_t)u.pn * BM * K) * 2; }
    DI void signal(const Unit&) const {}
    DI void wait(const Unit& u) const {
        unsigned sp = 0;
        while (__hip_atomic_load(flags + u.pm, __ATOMIC_RELAXED, __HIP_MEMORY_SCOPE_AGENT) < 4u) { __builtin_amdgcn_s_sleep(4); if (++sp > (1u << 22)) break; }
        asm volatile("" ::: "memory");
    }
};
#endif

struct EpiStore {
    bf16_t* O0; int ld0; bf16_t* O1; int ld1;
    DI void operator()(const f32x4 (&acc)[2][2][4][2], const Unit& u, int wr, int wc, int fr, int fq) const {
        bf16_t* base = u.aux ? O1 : O0; const int ldc = u.aux ? ld1 : ld0;
        const int row0 = u.pm * BM + wr * 64 + fr, col0 = u.pn * BM + wc * 32 + 8 * fq;
#pragma unroll
        for (int ai = 0; ai < 2; ++ai)
#pragma unroll
            for (int m = 0; m < 4; ++m) { bf16_t* rowp = base + (size_t)(row0 + ai * HALF + m * 16) * ldc + col0;
#pragma unroll
                for (int bj = 0; bj < 2; ++bj) { const f32x4 v0 = acc[ai][bj][m][0], v1 = acc[ai][bj][m][1];
                    u32x4 w; w.x = cvtpk(v0[0], v0[1]); w.y = cvtpk(v0[2], v0[3]); w.z = cvtpk(v1[0], v1[1]); w.w = cvtpk(v1[2], v1[3]);
                    *(u32x4*)(rowp + bj * HALF) = w; } }
    }
};
struct EpiSwiGlu {
    bf16_t* O;
    DI void operator()(const f32x4 (&acc)[2][2][4][2], const Unit& u, int wr, int wc, int fr, int fq) const {
        const int row0 = u.pm * BM + wr * 64 + fr, col0 = u.pn * HALF + wc * 32 + 8 * fq;
#pragma unroll
        for (int ai = 0; ai < 2; ++ai)
#pragma unroll
            for (int m = 0; m < 4; ++m) { bf16_t* rowp = O + (size_t)(row0 + ai * HALF + m * 16) * DE + col0;
                float hv[8];
#pragma unroll
                for (int n = 0; n < 2; ++n)
#pragma unroll
                    for (int e = 0; e < 4; ++e) { const float g = acc[ai][0][m][n][e], up = acc[ai][1][m][n][e]; hv[4 * n + e] = g * sigm(g) * up; }
                u32x4 w; w.x = cvtpk(hv[0], hv[1]); w.y = cvtpk(hv[2], hv[3]); w.z = cvtpk(hv[4], hv[5]); w.w = cvtpk(hv[6], hv[7]);
#ifdef FUSE_MOE
                asm volatile("global_store_dwordx4 %0, %1, off sc1\n\ts_nop 1" :: "v"(rowp), "v"(w) : "memory");
#else
                *(u32x4*)rowp = w;
#endif
            }
    }
};
struct EpiRowScale {
    bf16_t* O; const float* roww;
    DI void operator()(const f32x4 (&acc)[2][2][4][2], const Unit& u, int wr, int wc, int fr, int fq) const {
        const int row0 = u.pm * BM + wr * 64 + fr, col0 = u.pn * BM + wc * 32 + 8 * fq;
#pragma unroll
        for (int ai = 0; ai < 2; ++ai)
#pragma unroll
            for (int m = 0; m < 4; ++m) { const int row = row0 + ai * HALF + m * 16;
#ifdef MOEB_NOSCALE
                const float s = 1.f;
#else
                const float s = roww[row];
#endif
                bf16_t* rowp = O + (size_t)row * D + col0;
#pragma unroll
                for (int bj = 0; bj < 2; ++bj) { const f32x4 v0 = acc[ai][bj][m][0] * s, v1 = acc[ai][bj][m][1] * s;
                    u32x4 w; w.x = cvtpk(v0[0], v0[1]); w.y = cvtpk(v0[2], v0[3]); w.z = cvtpk(v1[0], v1[1]); w.w = cvtpk(v1[2], v1[3]);
                    *(u32x4*)(rowp + bj * HALF) = w; } }
    }
};

template <class Epi, class Sched>
DI void gemm_phase(LAS unsigned char* lds, const int tid, const int K, const Sched& S, const Epi& E) {
    const int wid = __builtin_amdgcn_readfirstlane(tid >> 6), lane = tid & 63, wr = wid >> 2, wc = wid & 3, fr = lane & 15, fq = lane >> 4;
    const int nt = K / BK;
    unsigned voffA[2], voffB[2];
#pragma unroll
    for (int i = 0; i < 2; ++i) { int R, C; stage_rc(tid * 16 + i * 8192, R, C); const int Rb = (R & ~31) + perm32(R & 31);
        voffA[i] = (unsigned)(R * K + C) * 2u; voffB[i] = (unsigned)(Rb * K + C) * 2u; }
    const size_t kstep = (size_t)(BK * 2);
    const size_t hstep = (size_t)HALF * K * 2;
    const size_t hstepA = Sched::GATHER ? 0 : hstep;
    int RA_[2], CA_[2];
#pragma unroll
    for (int i = 0; i < 2; ++i) stage_rc(tid * 16 + i * 8192, RA_[i], CA_[i]);
    unsigned vgc[2][2], vgn[2][2], vgnn[2][2];
#define PG8_GLOAD(dst, u_) do { if constexpr (Sched::GATHER) { _Pragma("unroll") for (int h_ = 0; h_ < 2; ++h_) _Pragma("unroll") for (int i_ = 0; i_ < 2; ++i_) \
        dst[h_][i_] = ((unsigned)S.rowtok[(u_).pm * BM + h_ * HALF + RA_[i_]] * (unsigned)K + (unsigned)CA_[i_]) * 2u; } } while (0)
    const unsigned ldsw = (unsigned)wid * 1024u;
    const int aoff = lds_byte(wr * 64 + fr, fq * 8), boff = lds_byte(wc * 32 + fr, fq * 8);
#define PG8_SA(b, h) (((b) * 2 + (h)) * HTB)
#define PG8_SB(b, h) ((4 + (b) * 2 + (h)) * HTB)
#define PG8_STAGE(bufoff, gbase, voff) do { _Pragma("unroll") for (int _i = 0; _i < 2; ++_i) \
        __builtin_amdgcn_global_load_lds((const unsigned*)((const char*)(gbase) + (voff)[_i]), (LAS unsigned*)(lds + (bufoff) + ldsw + _i * 8192), 16, 0, 0); } while (0)
#define PG8_STAGE_C(bufoff, gbase, voff) do { _Pragma("unroll") for (int _i = 0; _i < 2; ++_i) \
        __builtin_amdgcn_global_load_lds((const unsigned*)((const char*)(gbase) + (voff)[_i]), (LAS unsigned*)(lds + (bufoff) + ldsw + _i * 8192), 16, 0, 16); } while (0)
#define PG8_STAGE_A(b, h, gbase, cur_) do { if constexpr (Sched::GATHER) { unsigned vo_[2]; vo_[0] = (cur_) ? vgc[h][0] : vgn[h][0]; vo_[1] = (cur_) ? vgc[h][1] : vgn[h][1]; PG8_STAGE(PG8_SA(b, h), gbase, vo_); } else if constexpr (Sched::WAIT) PG8_STAGE_C(PG8_SA(b, h), (gbase) + (h) * hstepA, voffA); else PG8_STAGE(PG8_SA(b, h), (gbase) + (h) * hstepA, voffA); } while (0)
#define PG8_LDA(dst, b, h) do { _Pragma("unroll") for (int m = 0; m < 4; ++m) _Pragma("unroll") for (int k = 0; k < 2; ++k) dst[m][k] = *(const LAS bf16x8*)(lds + PG8_SA(b, h) + aoff + m * 2048 + k * 1024); } while (0)
#define PG8_LDB(dst, b, h) do { _Pragma("unroll") for (int n = 0; n < 2; ++n) _Pragma("unroll") for (int k = 0; k < 2; ++k) dst[n][k] = *(const LAS bf16x8*)(lds + PG8_SB(b, h) + boff + n * 2048 + k * 1024); } while (0)
#define PG8_MMA(ai, bj, At, Bt) do { __builtin_amdgcn_s_setprio(1); _Pragma("unroll") for (int m = 0; m < 4; ++m) _Pragma("unroll") for (int n = 0; n < 2; ++n) _Pragma("unroll") for (int k = 0; k < 2; ++k) \
        acc[ai][bj][m][n] = __builtin_amdgcn_mfma_f32_16x16x32_bf16(Bt[n][k], At[m][k], acc[ai][bj][m][n], 0, 0, 0); __builtin_amdgcn_s_setprio(0); } while (0)
#define PG8_WAIT_V(n) asm volatile("s_waitcnt vmcnt(" #n ")" ::: "memory")
#define PG8_WAIT_L(n) asm volatile("s_waitcnt lgkmcnt(" #n ")" ::: "memory")
#define PG8_BAR __builtin_amdgcn_s_barrier()
#define PG8_SCHED __builtin_amdgcn_sched_barrier(0)
    Unit cur, nxt; int ui = 0;
    if (!S.next(0, cur)) return;
    f32x4 acc[2][2][4][2];
#pragma unroll
    for (int a = 0; a < 2; ++a)
#pragma unroll
        for (int b = 0; b < 2; ++b)
#pragma unroll
            for (int m = 0; m < 4; ++m)
#pragma unroll
                for (int n = 0; n < 2; ++n) acc[a][b][m][n] = (f32x4){0.f, 0.f, 0.f, 0.f};
    bf16x8 At[4][2], B0[2][2], B1[2][2];
    const char* cA = S.aptr(cur); const char* cB = S.bptr(cur);
    if constexpr (Sched::WAIT) S.wait(cur);
    if constexpr (Sched::GATHER) { Unit u1_ = cur, u2_ = cur; const bool h1_ = S.next(1, u1_); if (!h1_) u1_ = cur; const bool h2_ = h1_ && S.next(2, u2_); if (!h2_) u2_ = u1_;
        PG8_GLOAD(vgc, cur); PG8_GLOAD(vgn, u1_); PG8_GLOAD(vgnn, u2_); }
    PG8_STAGE(PG8_SB(0, 0), cB, voffB); PG8_STAGE(PG8_SB(0, 1), cB + hstep, voffB); PG8_STAGE_A(0, 0, cA, true); PG8_STAGE_A(0, 1, cA, true);
    if (wr == 1) PG8_BAR;
    PG8_WAIT_V(2); PG8_BAR;
    PG8_STAGE(PG8_SB(1, 0), cB + kstep, voffB); PG8_STAGE_A(1, 0, cA + kstep, true); PG8_STAGE(PG8_SB(1, 1), cB + hstep + kstep, voffB);
    PG8_WAIT_V(6); PG8_BAR;
    for (;;) {
        const bool has_next = S.next(ui + 1, nxt);
        const char* nA = has_next ? S.aptr(nxt) : cA; const char* nB = has_next ? S.bptr(nxt) : cB;

        for (int t = 0; t < nt; t += 2) {
            const bool last = (t == nt - 2);
            if constexpr (Sched::WAIT) { if (last && has_next) S.wait(nxt); }
            const char* a1 = cA + (size_t)(t + 1) * kstep;
            const char* a2 = last ? nA : cA + (size_t)(t + 2) * kstep; const char* b2 = last ? nB : cB + (size_t)(t + 2) * kstep;
            const char* a3 = a2 + kstep; const char* b3 = b2 + kstep;
            PG8_LDB(B0, 0, 0); PG8_LDB(B1, 0, 1); PG8_SCHED; PG8_LDA(At, 0, 0); PG8_STAGE_A(1, 1, a1, true);
            PG8_WAIT_V(8); PG8_WAIT_L(0); PG8_BAR; PG8_MMA(0, 0, At, B0); PG8_MMA(0, 1, At, B1); PG8_BAR; PG8_SCHED;
            PG8_LDA(At, 0, 1); PG8_STAGE(PG8_SB(0, 0), b2, voffB); PG8_STAGE(PG8_SB(0, 1), b2 + hstep, voffB); PG8_STAGE_A(0, 0, a2, !last);
            PG8_WAIT_V(8); PG8_WAIT_L(0); PG8_BAR; PG8_MMA(1, 0, At, B0); PG8_MMA(1, 1, At, B1); PG8_BAR; PG8_SCHED;
            PG8_LDB(B0, 1, 0); PG8_LDB(B1, 1, 1); PG8_SCHED; PG8_LDA(At, 1, 0); PG8_STAGE_A(0, 1, a2, !last);
            PG8_WAIT_V(8); PG8_WAIT_L(0); PG8_BAR; PG8_MMA(0, 0, At, B0); PG8_MMA(0, 1, At, B1); PG8_BAR; PG8_SCHED;
            PG8_LDA(At, 1, 1); PG8_STAGE(PG8_SB(1, 0), b3, voffB); PG8_STAGE(PG8_SB(1, 1), b3 + hstep, voffB); PG8_STAGE_A(1, 0, a3, !last);
            PG8_WAIT_V(8); PG8_WAIT_L(0); PG8_BAR; PG8_MMA(1, 0, At, B0); PG8_MMA(1, 1, At, B1); PG8_BAR; PG8_SCHED;
        }
        if (wr == 0) PG8_BAR;
        E(acc, cur, wr, wc, fr, fq);
        if constexpr (Sched::SIGNAL) { PG8_WAIT_V(0); PG8_BAR; if (tid == 0) S.signal(cur); }
        if (!has_next) break;
#pragma unroll
        for (int a = 0; a < 2; ++a)
#pragma unroll
            for (int b = 0; b < 2; ++b)
#pragma unroll
                for (int m = 0; m < 4; ++m)
#pragma unroll
                    for (int n = 0; n < 2; ++n) acc[a][b][m][n] = (f32x4){0.f, 0.f, 0.f, 0.f};
        cur = nxt; cA = nA; cB = nB; ++ui;
        if constexpr (Sched::GATHER) { _Pragma("unroll") for (int h_ = 0; h_ < 2; ++h_) _Pragma("unroll") for (int i_ = 0; i_ < 2; ++i_) { vgc[h_][i_] = vgn[h_][i_]; vgn[h_][i_] = vgnn[h_][i_]; } }
        if (wr == 1) PG8_BAR;
    }
    PG8_WAIT_V(0);
    PG8_BAR;
#undef PG8_SA
#undef PG8_SB
#undef PG8_STAGE
#undef PG8_STAGE_C
#undef PG8_STAGE_A
#undef PG8_GLOAD
#undef PG8_LDA
#undef PG8_LDB
#undef PG8_MMA
#undef PG8_WAIT_V
#undef PG8_WAIT_L
#undef PG8_BAR
#undef PG8_SCHED
}
}

#define XB_TMO      128
#define XB_XCNT(j)  (256  + 64 * (j))
#define XB_XSUB(j)  (1280 + 64 * (j))
#define XB_XGEN(j)  (2304 + 64 * (j))
#define XB_TOP      3328
#define XB_TOPGEN   3392
#define XCD_BAR_WORDS 3456
#define XB_SPIN_CAP (1u << 20)
DI unsigned xb_ld(unsigned* p)              { return __hip_atomic_load(p, __ATOMIC_RELAXED, __HIP_MEMORY_SCOPE_AGENT); }
DI unsigned xb_add(unsigned* p, unsigned v) { return __hip_atomic_fetch_add(p, v, __ATOMIC_RELAXED, __HIP_MEMORY_SCOPE_AGENT); }
DI unsigned xb_xcc_id() { return (unsigned)__builtin_amdgcn_s_getreg((3 << 11) | 20) & 0xFu; }
#define XB_SPIN(cond, bar) do { unsigned _sp = 0; while (cond) { __builtin_amdgcn_s_sleep(1); \
    if ((++_sp & 255u) == 0u) { if (xb_ld(&(bar)[XB_TMO])) break; if (_sp > XB_SPIN_CAP) { atomicAdd(&(bar)[XB_TMO], 1u); break; } } } } while (0)
struct XcdBarrier { unsigned* bar; unsigned x; volatile LAS unsigned* st; };
DI XcdBarrier xcd_barrier_post(unsigned* bar, volatile LAS unsigned* st) {
    XcdBarrier b; b.bar = bar; b.x = xb_xcc_id(); b.st = st;
    if (threadIdx.x == 0) (void)xb_add(&bar[XB_XCNT(b.x)], 1u);
    return b;
}
DI void xcd_barrier_complete(unsigned* bar, unsigned x, unsigned& nloc, unsigned& nx) {
    const unsigned G = gridDim.x * gridDim.y * gridDim.z;
    unsigned sum, cnt, mine, sp = 0u;
    for (;;) {
        sum = 0u; cnt = 0u; mine = 0u;
#pragma unroll
        for (unsigned j = 0; j < 16; ++j) { const unsigned c = xb_ld(&bar[XB_XCNT(j)]); sum += c; cnt += (c > 0u) ? 1u : 0u; mine = (j == x) ? c : mine; }
        if (sum == G) break;
        __builtin_amdgcn_s_sleep(1);
        if ((++sp & 255u) == 0u) { if (xb_ld(&bar[XB_TMO])) break; if (sp > XB_SPIN_CAP) { atomicAdd(&bar[XB_TMO], 1u); break; } }
    }
    nloc = mine > 0u ? mine : 1u; nx = cnt > 0u ? cnt : 1u;
}
DI void xcd_barrier(const XcdBarrier& b) {
    asm volatile("s_waitcnt vmcnt(0)" ::: "memory");
    __syncthreads();
    if (threadIdx.x == 0) {
        unsigned* bar = b.bar;
        __builtin_amdgcn_s_waitcnt(0);
        unsigned nloc = b.st[0], nx = b.st[1];
        if (nloc == 0u) { xcd_barrier_complete(bar, b.x, nloc, nx); b.st[0] = nloc; b.st[1] = nx; }
        const unsigned old = xb_add(&bar[XB_XSUB(b.x)], 1u);
        const unsigned gen = old / nloc;
        if (old + 1u == (gen + 1u) * nloc) {
            __builtin_amdgcn_fence(__ATOMIC_RELEASE, "agent");
            asm volatile("s_waitcnt vmcnt(0)" ::: "memory");
            const unsigned og = xb_add(&bar[XB_TOP], 1u);
            const unsigned tg = og / nx;
            if (og + 1u == (tg + 1u) * nx) xb_add(&bar[XB_TOPGEN], 1u);
            else XB_SPIN(xb_ld(&bar[XB_TOPGEN]) == tg, bar);
            __builtin_amdgcn_fence(__ATOMIC_ACQUIRE, "agent");
            xb_add(&bar[XB_XGEN(b.x)], 1u);
            asm volatile("s_waitcnt vmcnt(0)" ::: "memory");
        } else {
            XB_SPIN(xb_ld(&bar[XB_XGEN(b.x)]) == gen, bar);
            __builtin_amdgcn_fence(__ATOMIC_ACQUIRE, "agent");
            asm volatile("s_waitcnt vmcnt(0)" ::: "memory");
        }
    }
    __syncthreads();
}

struct Args { const float* in[31]; float* out; unsigned char* ws; int ph_lo, ph_hi, use_cg, pad; };
struct Frame {
    LAS unsigned char* lds;
    int tid, lane, wave, G, vcu, gw, ngw, bx;
    unsigned char* ws;
};
constexpr int LDS_MISC = 131072;
constexpr int LDS_BARST = LDS_BYTES - 64;

#ifdef NO_PREWAIT
#define CONV_PREWAIT() do { } while (0)
#else
#define CONV_PREWAIT() __builtin_amdgcn_s_waitcnt(0x0F70)
#endif
struct TItem { const float* src; bf16_t* dst; int ldw, ldt; };
#ifdef TITEM2
DI void titem_load(const TItem& t, f32x4 (&v)[16], int lane) {
#pragma unroll
    for (int i = 0; i < 16; ++i) v[i] = *(const f32x4*)(t.src + (size_t)(16 * (i >> 2) + 4 * (lane >> 4) + (i & 3)) * t.ldw + 4 * (lane & 15));
}
DI void titem_store(const TItem& t, const f32x4 (&v)[16], LAS float* scr, int lane) {
    LAS unsigned char* T = (LAS unsigned char*)scr;
    const int rr = lane >> 4, cc = lane & 15;
#pragma unroll
    for (int q = 0; q < 4; ++q)
#pragma unroll
        for (int e = 0; e < 4; ++e)
            *(LAS u32x2*)(T + (4 * cc + e) * 136 + (16 * q + 4 * rr) * 2) = (u32x2){cvtpk(v[4 * q][e], v[4 * q + 1][e]), cvtpk(v[4 * q + 2][e], v[4 * q + 3][e])};
    LDS_WAIT();
#pragma unroll
    for (int j = 0; j < 8; ++j) {
        const int n = 8 * j + (lane >> 3), c = lane & 7;
        const u32x2 lo = *(const LAS u32x2*)(T + n * 136 + 16 * c), hi = *(const LAS u32x2*)(T + n * 136 + 16 * c + 8);
        *(u32x4*)(t.dst + (size_t)n * t.ldt + 8 * c) = (u32x4){lo.x, lo.y, hi.x, hi.y};
    }
    LDS_WAIT();
}
#else
DI void titem_load(const TItem& t, f32x4 (&v)[16], int lane) {
#pragma unroll
    for (int i = 0; i < 16; ++i) v[i] = *(const f32x4*)(t.src + (size_t)(4 * i + (lane >> 4)) * t.ldw + 4 * (lane & 15));
}
DI void titem_store(const TItem& t, const f32x4 (&v)[16], LAS float* scr, int lane) {
#pragma unroll
    for (int i = 0; i < 16; ++i) { LAS float* s = scr + (4 * i + (lane >> 4)) * 65 + 4 * (lane & 15); s[0] = v[i][0]; s[1] = v[i][1]; s[2] = v[i][2]; s[3] = v[i][3]; }
    LDS_WAIT();
#pragma unroll
    for (int j = 0; j < 8; ++j) {
        const int n = 8 * j + (lane >> 3), c = lane & 7; const LAS float* s = scr + (8 * c) * 65 + n;
        u32x4 o; o.x = cvtpk(s[0], s[65]); o.y = cvtpk(s[130], s[195]); o.z = cvtpk(s[260], s[325]); o.w = cvtpk(s[390], s[455]);
        *(u32x4*)(t.dst + (size_t)n * t.ldt + 8 * c) = o;
    }
    LDS_WAIT();
}
#endif
constexpr int IT_WIN = 16 * 42, IT_WOUT = 16 * 16, IT_SMALL = IT_WIN + IT_WOUT;
constexpr int IT_EXP = 128 * 3, IT_MOE = NE * IT_EXP;
DI TItem small_item(const Frame& F, const float* w_in, const float* w_out, int git) {
    const int l = git / IT_SMALL, it = git % IT_SMALL; TItem t;
    if (it < IT_WIN) {
        const int kt = it / 42, nt = it % 42, n0 = 64 * nt;
        size_t drow; if (n0 < 768) drow = n0; else if (n0 < 1152) drow = 2304 + (n0 - 768); else drow = n0 - 384;
        t.src = w_in + (size_t)l * D * INW + (size_t)(64 * kt) * INW + n0; t.ldw = INW;
        t.dst = (bf16_t*)(F.ws + WS_WIN + (size_t)l * WIN_LAYER) + drow * D + 64 * kt; t.ldt = D;
    } else {
        const int r = it - IT_WIN, kt = r >> 4, nt = r & 15;
        t.src = w_out + (size_t)l * D * D + (size_t)(64 * kt) * D + 64 * nt; t.ldw = D;
        t.dst = (bf16_t*)(F.ws + WS_WOUT) + (size_t)l * D * D + (size_t)(64 * nt) * D + 64 * kt; t.ldt = D;
    }
    return t;
}
DI TItem moe_item(const Frame& F, const float* wg, const float* wu, const float* wd, int l, int it) {
    const int e = it / IT_EXP, r = it % IT_EXP, which = r >> 7, q = r & 127; TItem t;
    if (which < 2) {
        const int kt = q >> 3, nt = q & 7, n0 = 64 * nt;
        t.src = (which ? wu : wg) + ((size_t)l * NE + e) * D * DE + (size_t)(64 * kt) * DE + n0; t.ldw = DE;
        const size_t drow = (size_t)(n0 >> 7) * 256 + (which ? 128 : 0) + (n0 & 127);
        t.dst = (bf16_t*)(F.ws + WS_WGU) + (size_t)e * D * D + drow * D + 64 * kt; t.ldt = D;
    } else {
        const int kt = q >> 4, nt = q & 15;
        t.src = wd + ((size_t)l * NE + e) * DE * D + (size_t)(64 * kt) * D + 64 * nt; t.ldw = D;
        t.dst = (bf16_t*)(F.ws + WS_WD) + (size_t)e * D * DE + (size_t)(64 * nt) * DE + 64 * kt; t.ldt = DE;
    }
    return t;
}
DI void p0_prologue(const Frame& F, const Args& a) {
    const float* c = a.in[1]; const float* w_mod = a.in[2]; const float* b_mod = a.in[3];
    if (F.bx < L * (MODW / 64)) {
        LAS float* sc = (LAS float*)(F.lds);
        LAS float* red = (LAS float*)(F.lds + 8192);
        for (int i = F.tid; i < NB * D; i += NTHREADS) { const float v = c[i]; sc[i] = v / (1.f + expf(-v)); }
        __syncthreads();
        const int l = F.bx / (MODW / 64), cb = F.bx % (MODW / 64), n = cb * 64 + F.lane;
        const float* w = w_mod + (size_t)l * D * MODW + n;
        float a0 = 0.f, a1 = 0.f;
#pragma unroll 8
        for (int k = F.wave * 128; k < F.wave * 128 + 128; ++k) { const float wv = w[(size_t)k * MODW]; a0 += sc[k] * wv; a1 += sc[D + k] * wv; }
        red[(F.wave * 2 + 0) * 64 + F.lane] = a0; red[(F.wave * 2 + 1) * 64 + F.lane] = a1;
        __syncthreads();
        if (F.tid < 128) { const int b = F.tid >> 6, ln = F.tid & 63; float s = 0.f;
#pragma unroll
            for (int w8 = 0; w8 < 8; ++w8) s += red[(w8 * 2 + b) * 64 + ln];
            const int nn = cb * 64 + ln;
            ((float*)(F.ws + WS_MOD))[(size_t)(l * NB + b) * MODW + nn] = s + b_mod[l * MODW + nn]; }
        __syncthreads();
    }
    { const int nzero = L * 128 * D / 8;
      for (int i = F.gw * 64 + F.lane; i < nzero; i += F.ngw * 64) { const int l = i / (128 * D / 8), r = i % (128 * D / 8);
          *(u32x4*)((bf16_t*)(F.ws + WS_WIN + (size_t)l * WIN_LAYER) + (size_t)(2304 + 384) * D + (size_t)r * 8) = (u32x4){0u, 0u, 0u, 0u}; } }
    LAS float* scr = (LAS float*)(F.lds + 16384) + F.wave * (64 * 65);
    { f32x4 cur[16], nxt[16]; int it = F.gw; TItem tc{}, tn{};
      if (it < L * IT_SMALL) { tc = small_item(F, a.in[4], a.in[19], it); titem_load(tc, cur, F.lane); }
      CONV_PREWAIT();
      for (; it < L * IT_SMALL; it += F.ngw) {
          const bool more = it + F.ngw < L * IT_SMALL;
          if (more) { tn = small_item(F, a.in[4], a.in[19], it + F.ngw); titem_load(tn, nxt, F.lane); }
          titem_store(tc, cur, scr, F.lane);
          if (more) { tc = tn;
#pragma unroll
              for (int i = 0; i < 16; ++i) cur[i] = nxt[i]; }
      } }
}

DI void row_ln(f32x4 (&v)[4], float& mean_out, float& rstd_out) {
    float s = 0.f;
#pragma unroll
    for (int j = 0; j < 4; ++j) s += (v[j][0] + v[j][1]) + (v[j][2] + v[j][3]);
    const float mean = wave_sum(s) * (1.f / D); float q = 0.f;
#pragma unroll
    for (int j = 0; j < 4; ++j) { v[j] = v[j] - mean; q += (v[j][0] * v[j][0] + v[j][1] * v[j][1]) + (v[j][2] * v[j][2] + v[j][3] * v[j][3]); }
    mean_out = mean; rstd_out = 1.f / sqrtf(wave_sum(q) * (1.f / D) + LN_EPS);
}
DI void row_mod_store(f32x4 (&v)[4], const float* md, int off_sh, int off_sc, bf16_t* urow, int lane) {
    float mean, rstd; row_ln(v, mean, rstd);
#pragma unroll
    for (int j = 0; j < 4; ++j) { const int col = 4 * lane + 256 * j;
        const f32x4 scv = *(const f32x4*)(md + off_sc + col), shv = *(const f32x4*)(md + off_sh + col);
        v[j] = v[j] * rstd * (1.f + scv) + shv;
        u32x2 w; w.x = cvtpk(v[j][0], v[j][1]); w.y = cvtpk(v[j][2], v[j][3]);
        *(u32x2*)(urow + col) = w; }
}
DI void p_r0(const Frame& F, const float* x) {
    const float* MOD = (const float*)(F.ws + WS_MOD);
    bf16_t* U = (bf16_t*)(F.ws + WS_U);
    for (int row = F.gw; row < T; row += F.ngw) {
        f32x4 v[4];
#pragma unroll
        for (int j = 0; j < 4; ++j) v[j] = *(const f32x4*)(x + (size_t)row * D + 4 * F.lane + 256 * j);
        row_mod_store(v, MOD + (size_t)(row / S) * MODW, 0, D, U + (size_t)row * D, F.lane);
    }
}

constexpr int NGRP = T / 64;
DI void p_rowpass1(const Frame& F, const Args& a, int l, const float* xin, const bool dry = false) {
    const float* MODl = (const float*)(F.ws + WS_MOD) + (size_t)l * NB * MODW;
    const bf16_t* MIX = (const bf16_t*)(F.ws + WS_MIX);
    float* XA = (float*)(F.ws + WS_XA); bf16_t* U = (bf16_t*)(F.ws + WS_U);
    const float* gain = a.in[20] + (size_t)l * D; const float* bias = a.in[21] + (size_t)l * D;
    const float* wg = a.in[24] + (size_t)l * D * NG; const float* bg = a.in[25] + (size_t)l * NG;
    const float* we = a.in[26] + (size_t)l * D * NE; const float* be = a.in[27] + (size_t)l * NE;
    const size_t dro = dry ? 490 * MiB - WS_BC : 0;
    int* BC = (int*)(F.ws + WS_BC + dro); float* TOKW = (float*)(F.ws + WS_TOKW + dro); int* TOKSLOT = (int*)(F.ws + WS_TOKSLOT + (dry ? 496 * MiB - WS_TOKSLOT : 0));
    LAS float* RT = (LAS float*)F.lds;
    LAS unsigned* cntl = (LAS unsigned*)(F.lds + 36 * D * 4 + NWAVES * 72 * 4);
#pragma unroll
    for (int kk = 0; kk < 2; ++kk) { const int k = F.tid + kk * NTHREADS;
        f32x4 v[9]; v[0] = *(const f32x4*)(wg + (size_t)k * NG);
#pragma unroll
        for (int q = 0; q < 8; ++q) v[1 + q] = *(const f32x4*)(we + (size_t)k * NE + 4 * q);
#pragma unroll
        for (int q = 0; q < 9; ++q)
#pragma unroll
            for (int e = 0; e < 4; ++e) RT[(4 * q + e) * D + k] = v[q][e]; }
    for (int grp = F.vcu; grp < NGRP; grp += F.G) {
    if (F.tid < NE) cntl[F.tid] = 0u;
    __syncthreads();
#ifdef RESBF
    const bool xbf = l > 0; const bf16_t* xinb = (const bf16_t*)xin; bf16_t* XAb = (bf16_t*)(F.ws + WS_XA);
    u32x4 pxa[4], pxb[4]; u32x2 pma[4], pmb[4];
#define RP1_LDX(dst, row_, col_) do { if (xbf) { const u32x2 t_ = *(const u32x2*)(xinb + (size_t)(row_) * D + (col_)); dst.x = t_.x; dst.y = t_.y; } else dst = *(const u32x4*)(xin + (size_t)(row_) * D + (col_)); } while (0)
#define RP1_XV(p_) (xbf ? (f32x4){bflo(p_.x), bfhi(p_.x), bflo(p_.y), bfhi(p_.y)} : __builtin_bit_cast(f32x4, p_))
#else
    f32x4 pxa[4], pxb[4]; u32x2 pma[4], pmb[4];
#define RP1_LDX(dst, row_, col_) dst = *(const f32x4*)(xin + (size_t)(row_) * D + (col_))
#define RP1_XV(p_) (p_)
#endif
    { const int r0 = 64 * grp + 8 * F.wave;
#pragma unroll
      for (int j = 0; j < 4; ++j) { const int col = 4 * F.lane + 256 * j; RP1_LDX(pxa[j], r0, col); RP1_LDX(pxb[j], r0 + 1, col);
          pma[j] = *(const u32x2*)(MIX + (size_t)r0 * D + col); pmb[j] = *(const u32x2*)(MIX + (size_t)(r0 + 1) * D + col); } }
    for (int rp = 0; rp < 4; ++rp) {
        const int row0 = 64 * grp + 8 * F.wave + 2 * rp; const float* md = MODl + (size_t)(row0 / S) * MODW;
        f32x4 va[4], vb[4];
#pragma unroll
        for (int j = 0; j < 4; ++j) { const int col = 4 * F.lane + 256 * j;
            const f32x4 g = *(const f32x4*)(md + 2 * D + col);
            va[j] = RP1_XV(pxa[j]) * ALPHA + g * (f32x4){bflo(pma[j].x), bfhi(pma[j].x), bflo(pma[j].y), bfhi(pma[j].y)};
            vb[j] = RP1_XV(pxb[j]) * ALPHA + g * (f32x4){bflo(pmb[j].x), bfhi(pmb[j].x), bflo(pmb[j].y), bfhi(pmb[j].y)}; }
        if (rp < 3) { const int r0 = row0 + 2;
#pragma unroll
          for (int j = 0; j < 4; ++j) { const int col = 4 * F.lane + 256 * j; RP1_LDX(pxa[j], r0, col); RP1_LDX(pxb[j], r0 + 1, col);
              pma[j] = *(const u32x2*)(MIX + (size_t)r0 * D + col); pmb[j] = *(const u32x2*)(MIX + (size_t)(r0 + 1) * D + col); } }
        float mean, rstd;
        row_ln(va, mean, rstd);
#pragma unroll
        for (int j = 0; j < 4; ++j) { const int col = 4 * F.lane + 256 * j; va[j] = va[j] * rstd * *(const f32x4*)(gain + col) + *(const f32x4*)(bias + col);
#ifdef RESBF
            *(u32x2*)(XAb + (size_t)row0 * D + col) = (u32x2){cvtpk(va[j][0], va[j][1]), cvtpk(va[j][2], va[j][3])}; }
#else
            *(f32x4*)(XA + (size_t)row0 * D + col) = va[j]; }
#endif
        row_ln(vb, mean, rstd);
#pragma unroll
        for (int j = 0; j < 4; ++j) { const int col = 4 * F.lane + 256 * j; vb[j] = vb[j] * rstd * *(const f32x4*)(gain + col) + *(const f32x4*)(bias + col);
#ifdef RESBF
            *(u32x2*)(XAb + (size_t)(row0 + 1) * D + col) = (u32x2){cvtpk(vb[j][0], vb[j][1]), cvtpk(vb[j][2], vb[j][3])}; }
#else
            *(f32x4*)(XA + (size_t)(row0 + 1) * D + col) = vb[j]; }
#endif
        row_mod_store(va, md, 3 * D, 4 * D, U + (size_t)row0 * D, F.lane);
        row_mod_store(vb, md, 3 * D, 4 * D, U + (size_t)(row0 + 1) * D, F.lane);
#ifdef DRY_NOROUTER
        if (dry) continue;
#endif
        LAS float* lg = (LAS float*)(F.lds + 36 * D * 4) + F.wave * 72;
#pragma unroll 1
        for (int n = 0; n < 36; n += 3) { float sa[3], sb[3];
#pragma unroll
            for (int q = 0; q < 3; ++q) { sa[q] = 0.f; sb[q] = 0.f;
#pragma unroll
                for (int j = 0; j < 4; ++j) { const f32x4 w = *(const LAS f32x4*)(RT + (n + q) * D + 4 * F.lane + 256 * j);
                    sa[q] += (va[j][0] * w[0] + va[j][1] * w[1]) + (va[j][2] * w[2] + va[j][3] * w[3]);
                    sb[q] += (vb[j][0] * w[0] + vb[j][1] * w[1]) + (vb[j][2] * w[2] + vb[j][3] * w[3]); } }
#pragma unroll
            for (int q = 0; q < 3; ++q) { sa[q] = wave_sum(sa[q]); sb[q] = wave_sum(sb[q]); }
            if (F.lane == 0) {
#pragma unroll
                for (int q = 0; q < 3; ++q) { lg[n + q] = sa[q]; lg[36 + n + q] = sb[q]; } } }
        LDS_WAIT();
#pragma unroll
        for (int rr = 0; rr < 2; ++rr) {
            float gl[4];
#pragma unroll
            for (int n = 0; n < 4; ++n) gl[n] = lg[36 * rr + n] + bg[n];
            int gi = 0; float gm = gl[0];
#pragma unroll
            for (int n = 1; n < 4; ++n) { const bool c = gl[n] > gm; gm = c ? gl[n] : gm; gi = c ? n : gi; }
            float se = 0.f;
#pragma unroll
            for (int n = 0; n < 4; ++n) se += expf(gl[n] - gm);
            const float pg = 1.f / se;
            float l1 = -3.0e38f, l2 = -3.0e38f; int i1 = 0, i2 = 0;
#pragma unroll
            for (int e = 0; e < 8; ++e) { const float v = lg[36 * rr + 4 + gi * EPG + e] + be[gi * EPG + e];
                const bool c1 = v > l1, c2 = v > l2;
                l2 = c1 ? l1 : (c2 ? v : l2); i2 = c1 ? i1 : (c2 ? e : i2); l1 = c1 ? v : l1; i1 = c1 ? e : i1; }
            const float e2 = expf(l2 - l1); const float w1 = pg / (1.f + e2), w2 = pg * e2 / (1.f + e2);
            if (F.lane == 0) {
                const int tok = row0 + rr, ea = gi * EPG + i1, eb = gi * EPG + i2;
                const unsigned pa = __hip_atomic_fetch_add(&cntl[ea], 1u, __ATOMIC_RELAXED, __HIP_MEMORY_SCOPE_WORKGROUP), pb = __hip_atomic_fetch_add(&cntl[eb], 1u, __ATOMIC_RELAXED, __HIP_MEMORY_SCOPE_WORKGROUP);
                TOKSLOT[tok * 2] = (ea << 14) | (int)pa; TOKSLOT[tok * 2 + 1] = (eb << 14) | (int)pb;
                TOKW[tok * 2] = w1; TOKW[tok * 2 + 1] = w2;
            }
        }
    }
    __syncthreads();
    if (F.tid < NE) BC[grp * NE + F.tid] = (int)cntl[F.tid];
    __syncthreads();
    }
}

DI void build_tables(const Frame& F, int l, LAS int* tb) {
    if (F.tid < 64) {
        const int e = F.lane; const int c = e < NE ? ((const int*)(F.ws + WS_CNTF))[e] : 0; const int tl = (c + 255) >> 8;
        int cum = c, tin = tl;
#pragma unroll
        for (int o = 1; o < 32; o <<= 1) { const int a1 = __shfl_up(cum, o), a2 = __shfl_up(tin, o); if (e >= o) { cum += a1; tin += a2; } }
        if (e < NE) { tb[e] = cum - c; tb[33 + e] = (tin - tl) * 256; for (int t2 = 0; t2 < tl; ++t2) tb[66 + (tin - tl) + t2] = e; }
        if (e == NE - 1) { tb[32] = cum; tb[65] = tin; }
    }
    __syncthreads();
}
DI void p_gather(const Frame& F, int l) {
    LAS int* base = (LAS int*)F.lds;
    LAS int* segt = base + NGRP * NE;
    LAS int* offp = segt + 16 * NE;
    const int* BC = (const int*)(F.ws + WS_BC);
    { int tmp[NGRP * NE / NTHREADS];
#pragma unroll
      for (int q = 0; q < NGRP * NE / NTHREADS; ++q) tmp[q] = BC[F.tid + q * NTHREADS];
#pragma unroll
      for (int q = 0; q < NGRP * NE / NTHREADS; ++q) base[F.tid + q * NTHREADS] = tmp[q]; }
    __syncthreads();
    { const int e = F.tid & 31, sg = F.tid >> 5; int run = 0;
      for (int g = 16 * sg; g < 16 * sg + 16; ++g) { const int c = base[g * NE + e]; base[g * NE + e] = run; run += c; }
      segt[sg * NE + e] = run; }
    __syncthreads();
    if (F.tid < NE) { int run = 0; for (int sg = 0; sg < 16; ++sg) { const int c = segt[sg * NE + F.tid]; segt[sg * NE + F.tid] = run; run += c; }
        offp[F.tid] = run;
        if (F.bx == 0) ((int*)(F.ws + WS_CNTF))[F.tid] = run; }
    __syncthreads();
    if (F.tid == 0) { int off = 0; for (int e = 0; e < NE; ++e) { const int c = offp[e]; offp[e] = off; off += ((c + 255) >> 8) * 256; } }
    __syncthreads();
    const int* TOKSLOT = (const int*)(F.ws + WS_TOKSLOT); const float* TOKW = (const float*)(F.ws + WS_TOKW); int* TOKFIN = (int*)(F.ws + WS_TOKFIN);
    float* SLOTW = (float*)(F.ws + WS_SLOTW);
    const int nas = (2 * T - F.gw + F.ngw - 1) / F.ngw;
    int my_slot = 0, my_tok = 0;
    if (F.lane < nas) { const int as = F.gw + F.lane * F.ngw; const int tok = as >> 1, ts = TOKSLOT[as], e = ts >> 14, grp = tok >> 6, sg = grp >> 4;
        my_slot = offp[e] + segt[sg * NE + e] + base[grp * NE + e] + (ts & 16383); my_tok = tok;
        SLOTW[my_slot] = TOKW[as]; TOKFIN[as] = my_slot; ((int*)(F.ws + WS_CTL + WS_SLOTTOK))[my_slot] = tok; }
}
#ifdef RESBF
struct Rp2In { u32x2 x[4]; u32x2 y0[4], y1[4]; };
DI void rp2_load(Rp2In& r, const float* XA, const bf16_t* YS, int row, int s0, int s1, int lane) {
    const bf16_t* XAb = (const bf16_t*)XA;
#pragma unroll
    for (int j = 0; j < 4; ++j) { const int col = 4 * lane + 256 * j;
        r.x[j] = *(const u32x2*)(XAb + (size_t)row * D + col); r.y0[j] = *(const u32x2*)(YS + (size_t)s0 * D + col); r.y1[j] = *(const u32x2*)(YS + (size_t)s1 * D + col); }
}
#define RP2_XV(p_) ((f32x4){bflo(p_.x), bfhi(p_.x), bflo(p_.y), bfhi(p_.y)})
#else
struct Rp2In { f32x4 x[4]; u32x2 y0[4], y1[4]; };
DI void rp2_load(Rp2In& r, const float* XA, const bf16_t* YS, int row, int s0, int s1, int lane) {
#pragma unroll
    for (int j = 0; j < 4; ++j) { const int col = 4 * lane + 256 * j;
        r.x[j] = *(const f32x4*)(XA + (size_t)row * D + col); r.y0[j] = *(const u32x2*)(YS + (size_t)s0 * D + col); r.y1[j] = *(const u32x2*)(YS + (size_t)s1 * D + col); }
}
#define RP2_XV(p_) (p_)
#endif
DI void p_rowpass2(const Frame& F, const Args& a, int l, float* xout) {
    const float* MOD = (const float*)(F.ws + WS_MOD);
    const float* XA = (const float*)(F.ws + WS_XA); const bf16_t* YS = (const bf16_t*)(F.ws + WS_YS); const int* TOKFIN = (const int*)(F.ws + WS_TOKFIN);
    const float* gain = a.in[22] + (size_t)l * D; const float* bias = a.in[23] + (size_t)l * D;
    bf16_t* U = (bf16_t*)(F.ws + WS_U);
    const int nrows = (T - F.gw + F.ngw - 1) / F.ngw;
    int tf = 0; { const int i = F.lane >> 1; if (i < nrows) tf = TOKFIN[(F.gw + i * F.ngw) * 2 + (F.lane & 1)]; }
    Rp2In cur, nxt;
    if (nrows > 0) rp2_load(cur, XA, YS, F.gw, __shfl(tf, 0), __shfl(tf, 1), F.lane);
    for (int i = 0; i < nrows; ++i) {
        const int row = F.gw + i * F.ngw;
        if (i + 1 < nrows) rp2_load(nxt, XA, YS, row + F.ngw, __shfl(tf, 2 * i + 2), __shfl(tf, 2 * i + 3), F.lane);
        const float* md = MOD + (size_t)(l * NB + row / S) * MODW;
        f32x4 v[4];
#pragma unroll
        for (int j = 0; j < 4; ++j) { const int col = 4 * F.lane + 256 * j;
            const f32x4 g = *(const f32x4*)(md + 5 * D + col);
            const u32x2 y0 = cur.y0[j], y1 = cur.y1[j];
            const f32x4 f = (f32x4){bflo(y0.x) + bflo(y1.x), bfhi(y0.x) + bfhi(y1.x), bflo(y0.y) + bflo(y1.y), bfhi(y0.y) + bfhi(y1.y)};
            v[j] = RP2_XV(cur.x[j]) * ALPHA + g * f; }
        float mean, rstd; row_ln(v, mean, rstd);
#pragma unroll
        for (int j = 0; j < 4; ++j) { const int col = 4 * F.lane + 256 * j; v[j] = v[j] * rstd * *(const f32x4*)(gain + col) + *(const f32x4*)(bias + col);
#ifdef TSTAMP
            if (l == L - 1) { const unsigned long long* st = (const unsigned long long*)(F.ws + WS_CTL + 40960); const float sc = 1.f + (float)(long long)(st[TS_B] - st[TS_A]) * 1e-5f; *(f32x4*)(xout + (size_t)row * D + col) = v[j] * sc; } else
#endif
#ifdef RESBF
            if (l + 1 < L) *(u32x2*)((bf16_t*)xout + (size_t)row * D + col) = (u32x2){cvtpk(v[j][0], v[j][1]), cvtpk(v[j][2], v[j][3])}; else
#endif
            *(f32x4*)(xout + (size_t)row * D + col) = v[j]; }
        if (l + 1 < L) row_mod_store(v, MOD + (size_t)((l + 1) * NB + row / S) * MODW, 0, D, U + (size_t)row * D, F.lane);
        if (i + 1 < nrows) {
#pragma unroll
            for (int j = 0; j < 4; ++j) { cur.x[j] = nxt.x[j]; cur.y0[j] = nxt.y0[j]; cur.y1[j] = nxt.y1[j]; } }
    }
}

#define MFMA16(a, b, c) __builtin_amdgcn_mfma_f32_16x16x32_bf16((a), (b), (c), 0, 0, 0)
#define MFMA32(a, b, c) __builtin_amdgcn_mfma_f32_32x32x16_bf16((a), (b), (c), 0, 0, 0)
constexpr int RB = 9216;
#define BUF(i) ((i) * RB)
constexpr int LWOFF = BUF(12), ZAOFF = BUF(0), SEGOFF = BUF(14), SEGXOFF = BUF(14) + 2048, TOTOFF = BUF(14) + 4096, NABFOFF = BUF(15), PCOFF = 16 * RB;
struct RwP { const float *conv, *w0, *w_up, *a0, *a_up, *g_up, *k_k, *k_a, *r_k, *gn_gain, *gn_bias; };

DI void lds_barrier() { asm volatile("s_waitcnt lgkmcnt(0)" ::: "memory"); __builtin_amdgcn_s_barrier(); asm volatile("" ::: "memory"); }
DI int swo(int row, int col) { return row * 144 + (((((col >> 3) ^ (row >> 3)) & 7) << 3) + (col & 7)) * 2; }
DI bf16x8 ldfrag(const LAS unsigned char* lds, int buf, int row, int ks, int lane) { return *(const LAS bf16x8*)(lds + buf + swo(row, 32 * ks + 8 * (lane >> 4))); }
DI f32x4 mm64(const LAS unsigned char* lds, int abuf, int arow0, int bbuf, int brow0, int lane) {
    f32x4 acc = (f32x4){0.f, 0.f, 0.f, 0.f};
#pragma unroll
    for (int ks = 0; ks < 2; ++ks) acc = MFMA16(ldfrag(lds, abuf, arow0 + (lane & 15), ks, lane), ldfrag(lds, bbuf, brow0 + (lane & 15), ks, lane), acc);
    return acc;
}
DI u32x2 pack4(const f32x4 v) { u32x2 w; w.x = cvtpk(v[0], v[1]); w.y = cvtpk(v[2], v[3]); return w; }
DI f32x4 unpack4(const u32x2 w) { return (f32x4){bflo(w.x), bfhi(w.x), bflo(w.y), bfhi(w.y)}; }
DI void st4(LAS unsigned char* lds, int buf, int row, int col, const f32x4 v) { *(LAS u32x2*)(lds + buf + swo(row, col)) = pack4(v); }
DI f32x4 ld4(const LAS unsigned char* lds, int buf, int row, int col) { return unpack4(*(const LAS u32x2*)(lds + buf + swo(row, col))); }
DI void st1(LAS unsigned char* lds, int buf, int row, int col, float v) { *(LAS bf16_t*)(lds + buf + swo(row, col)) = f2bf(v); }
DI float fast_tanh(float x) { const float e = fexp2(x * (2.f * LOG2E)); return 1.f - 2.f * frcp(1.f + e); }

#define OPQZ(z) int z; asm volatile("s_mov_b32 %0, 0" : "=s"(z))
constexpr int CWLOFF = PCOFF + 256;
constexpr int PRMOFF = CWLOFF + 6912;
struct RwPre { u32x2 wv, av; u32x4 gv; f32x4 w4, a4, g0, g1; u32x4 rr[3], kk[3], vv[3]; };
DI void rwkv_prefetch(const Frame& F, const Args& a, const int l, const int unit, RwPre& P) {
    const int tid = F.tid;
    const int c = unit % NCH, hd = (unit / NCH) % BH, b = (unit / (NCH * BH)) % NB, dir = unit / (NCH * BH * NB);
    const bf16_t* HBp = (const bf16_t*)(F.ws + WS_HB);
    const int u = tid >> 3, jg = tid & 7, tloc = 64 * c + u; const size_t tok = (size_t)b * S + tloc;
    const bf16_t* hrow = HBp + tok * HW;
    P.wv = *(const u32x2*)(hrow + HWL + 4 * jg); P.av = *(const u32x2*)(hrow + HAL + 4 * jg); P.gv = *(const u32x4*)(hrow + HGL + 8 * jg);
    OPQZ(z0);
    { const int m = tid >> 4, j4 = (tid & 15) * 4;
      const float* w_up = a.in[8 + z0] + (size_t)l * 2 * RW * BW; const float* a_up = a.in[10 + z0] + (size_t)l * 2 * RA * BW;
      P.w4 = *(const f32x4*)(w_up + (size_t)(dir * RW + m) * BW + hd * HD + j4); P.a4 = *(const f32x4*)(a_up + (size_t)(dir * RA + m) * BW + hd * HD + j4); }
    { const int m = tid >> 3, i8 = (tid & 7) * 8; const float* g_up = a.in[11 + z0] + (size_t)l * RG * BW;
      P.g0 = *(const f32x4*)(g_up + (size_t)m * BW + hd * HD + i8); P.g1 = *(const f32x4*)(g_up + (size_t)m * BW + hd * HD + i8 + 4); }
    const int ch0 = hd * HD + 8 * jg;
#pragma unroll
    for (int x = 0; x < 3; ++x) {
        const int tt = tloc + x - 1; const u32x4 z4 = (u32x4){0u, 0u, 0u, 0u};
        if (tt >= 0 && tt < S) { const bf16_t* hp = HBp + ((size_t)b * S + tt) * HW + HR + ch0; P.rr[x] = *(const u32x4*)hp; P.kk[x] = *(const u32x4*)(hp + BW); P.vv[x] = *(const u32x4*)(hp + 2 * BW); }
        else { P.rr[x] = z4; P.kk[x] = z4; P.vv[x] = z4; }
    }
}
DI void rwkv_local_unit(const Frame& F, const Args& a, const int l, const int unit, RwPre& PF, const int next_unit) {
    LAS unsigned char* lds = F.lds;
    int tid_ = F.tid; asm volatile("" : "+v"(tid_));
    const int tid = tid_, lane = tid_ & 63, wave = F.wave;
    const int c = unit % NCH, hd = (unit / NCH) % BH, b = (unit / (NCH * BH)) % NB, dir = unit / (NCH * BH * NB);
    const bf16_t* HBp = (const bf16_t*)(F.ws + WS_HB);
    const int u = tid >> 3, jg = tid & 7, tau = dir ? 63 - u : u, tloc = 64 * c + u;
    const size_t tok = (size_t)b * S + tloc;
    const int tn = wave & 3, tm0 = 2 * (wave >> 2), g4 = lane >> 4, l15 = lane & 15;
    if (tid < 320) { OPQZ(z2); const int which = tid >> 6, j = tid & 63;
      const float* src = which == 0 ? a.in[7 + z2] + (size_t)l * 2 * BW + dir * BW : which == 1 ? a.in[9 + z2] + (size_t)l * 2 * BW + dir * BW : which == 2 ? a.in[12 + z2] + (size_t)l * BW : which == 3 ? a.in[13 + z2] + (size_t)l * BW : a.in[14 + z2] + (size_t)l * BH * HD;
      *(LAS float*)(lds + PRMOFF + tid * 4) = src[hd * HD + j]; }
    {
        const f32x4 wf = unpack4(PF.wv);
        *(LAS u32x2*)(lds + BUF(8) + swo(tau, 4 * jg)) = pack4((f32x4){fast_tanh(wf[0]), fast_tanh(wf[1]), fast_tanh(wf[2]), fast_tanh(wf[3])});
        *(LAS u32x2*)(lds + BUF(8) + swo(tau, 32 + 4 * jg)) = PF.av;
        const u32x4 gv = PF.gv;
        u32x4 so; so.x = cvtpk(sigm(bflo(gv.x)), sigm(bfhi(gv.x))); so.y = cvtpk(sigm(bflo(gv.y)), sigm(bfhi(gv.y))); so.z = cvtpk(sigm(bflo(gv.z)), sigm(bfhi(gv.z))); so.w = cvtpk(sigm(bflo(gv.w)), sigm(bfhi(gv.w)));
        *(LAS u32x4*)(lds + BUF(9) + swo(tau, 8 * jg)) = so;
        { const int m = tid >> 4, j4 = (tid & 15) * 4;
#pragma unroll
          for (int e = 0; e < 4; ++e) { st1(lds, BUF(10), j4 + e, m, PF.w4[e]); st1(lds, BUF(10), j4 + e, 32 + m, PF.a4[e]); } }
        { const int m = tid >> 3, i8 = (tid & 7) * 8;
#pragma unroll
          for (int e = 0; e < 4; ++e) { st1(lds, BUF(11), i8 + e, m, PF.g0[e]); st1(lds, BUF(11), i8 + 4 + e, m, PF.g1[e]); } }
    }
    lds_barrier();
#pragma unroll
    for (int tmi = 0; tmi < 2; ++tmi) {
        const int tm = tm0 + tmi; const f32x4 z = (f32x4){0.f, 0.f, 0.f, 0.f};
        const f32x4 zw = MFMA16(ldfrag(lds, BUF(10), 16 * tm + l15, 0, lane), ldfrag(lds, BUF(8), 16 * tn + l15, 0, lane), z);
        const f32x4 za = MFMA16(ldfrag(lds, BUF(10), 16 * tm + l15, 1, lane), ldfrag(lds, BUF(8), 16 * tn + l15, 1, lane), z);
        const int trow = 16 * tn + l15, jb = 16 * tm + 4 * g4;
        *(LAS f32x4*)(lds + LWOFF + (trow * 64 + jb) * 4) = zw;
        *(LAS f32x4*)(lds + ZAOFF + (trow * 64 + jb) * 4) = za;
        if (dir == 0) {
            const f32x4 gg = mm64(lds, BUF(11), 16 * tm, BUF(9), 16 * tn, lane);
            *(u32x2*)((bf16_t*)(F.ws + WS_GB) + ((size_t)b * S + 64 * c + trow) * BW + hd * HD + jb) = pack4(gg);
        }
    }
    lds_barrier();
    const int ch0 = hd * HD + 8 * jg;
    float r[8], kd[8], kap[8], bb[8], lw[8];
    {
        float k[8], v[8];
#pragma unroll
        for (int e = 0; e < 8; ++e) { r[e] = 0.f; k[e] = 0.f; v[e] = 0.f; }
#pragma unroll
        for (int x = 0; x < 3; ++x) {
            const LAS unsigned char* cwp = lds + CWLOFF + (((hd * 3 + x) * 3) * 64 + 8 * jg) * 2;
            const u32x4 cr = *(const LAS u32x4*)cwp, ck = *(const LAS u32x4*)(cwp + 128), cv = *(const LAS u32x4*)(cwp + 256);
            const u32x4 rr = PF.rr[x], kk2 = PF.kk[x], vv = PF.vv[x];
            r[0] += bflo(rr.x) * bflo(cr.x); r[1] += bfhi(rr.x) * bfhi(cr.x); r[2] += bflo(rr.y) * bflo(cr.y); r[3] += bfhi(rr.y) * bfhi(cr.y);
            r[4] += bflo(rr.z) * bflo(cr.z); r[5] += bfhi(rr.z) * bfhi(cr.z); r[6] += bflo(rr.w) * bflo(cr.w); r[7] += bfhi(rr.w) * bfhi(cr.w);
            k[0] += bflo(kk2.x) * bflo(ck.x); k[1] += bfhi(kk2.x) * bfhi(ck.x); k[2] += bflo(kk2.y) * bflo(ck.y); k[3] += bfhi(kk2.y) * bfhi(ck.y);
            k[4] += bflo(kk2.z) * bflo(ck.z); k[5] += bfhi(kk2.z) * bfhi(ck.z); k[6] += bflo(kk2.w) * bflo(ck.w); k[7] += bfhi(kk2.w) * bfhi(ck.w);
            v[0] += bflo(vv.x) * bflo(cv.x); v[1] += bfhi(vv.x) * bfhi(cv.x); v[2] += bflo(vv.y) * bflo(cv.y); v[3] += bfhi(vv.y) * bfhi(cv.y);
            v[4] += bflo(vv.z) * bflo(cv.z); v[5] += bfhi(vv.z) * bfhi(cv.z); v[6] += bflo(vv.w) * bflo(cv.w); v[7] += bfhi(vv.w) * bfhi(cv.w);
        }
        const f32x4 zw0 = *(const LAS f32x4*)(lds + LWOFF + (tau * 64 + 8 * jg) * 4), zw1 = *(const LAS f32x4*)(lds + LWOFF + (tau * 64 + 8 * jg + 4) * 4);
        const f32x4 za0 = *(const LAS f32x4*)(lds + ZAOFF + (tau * 64 + 8 * jg) * 4), za1 = *(const LAS f32x4*)(lds + ZAOFF + (tau * 64 + 8 * jg + 4) * 4);
        float ss = 0.f, bsp = 0.f, av[8];
        const LAS f32x4* prm = (const LAS f32x4*)(lds + PRMOFF) + 2 * jg;
        const f32x4 w0a = prm[0], w0b = prm[1], a0a = prm[16], a0b = prm[17], kka = prm[32], kkb = prm[33], kaa = prm[48], kab = prm[49], rka = prm[64], rkb = prm[65];
#pragma unroll
        for (int e = 0; e < 8; ++e) {
            const float zw = (e < 4 ? zw0[e & 3] : zw1[e & 3]) + (e < 4 ? w0a[e & 3] : w0b[e & 3]);
            const float za = (e < 4 ? za0[e & 3] : za1[e & 3]) + (e < 4 ? a0a[e & 3] : a0b[e & 3]);
            lw[e] = (-DECAY * LOG2E) * sigm(zw); av[e] = sigm(za);
            kap[e] = k[e] * (e < 4 ? kka[e & 3] : kkb[e & 3]); ss += kap[e] * kap[e];
            kd[e] = k[e] * (1.f + (av[e] - 1.f) * (e < 4 ? kaa[e & 3] : kab[e & 3]));
            bsp += r[e] * kd[e] * (e < 4 ? rka[e & 3] : rkb[e & 3]);
        }
        ss += __shfl_xor(ss, 1); ss += __shfl_xor(ss, 2); ss += __shfl_xor(ss, 4);
        bsp += __shfl_xor(bsp, 1); bsp += __shfl_xor(bsp, 2); bsp += __shfl_xor(bsp, 4);
        const float rn = __builtin_amdgcn_rsqf(fmaxf(ss, 1e-24f));
#pragma unroll
        for (int e = 0; e < 8; ++e) { kap[e] *= rn; bb[e] = kap[e] * av[e]; }
        if (jg == 0) ((float*)(F.ws + WS_BS))[((size_t)dir * T + tok) * 8 + hd] = bsp;
        *(LAS f32x4*)(lds + LWOFF + (tau * 64 + 8 * jg) * 4) = (f32x4){lw[0], lw[1], lw[2], lw[3]};
        *(LAS f32x4*)(lds + LWOFF + (tau * 64 + 8 * jg + 4) * 4) = (f32x4){lw[4], lw[5], lw[6], lw[7]};
#pragma unroll
        for (int e = 0; e < 8; ++e) st1(lds, BUF(7), 8 * jg + e, tau, v[e]);
        if (dir == 0) {
            u32x4 vo; vo.x = cvtpk(v[0], v[1]); vo.y = cvtpk(v[2], v[3]); vo.z = cvtpk(v[4], v[5]); vo.w = cvtpk(v[6], v[7]);
            *(u32x4*)((bf16_t*)(F.ws + WS_VC) + tok * BW + ch0) = vo;
        }
    }
    lds_barrier();
    if (dir == 0) {
        const size_t ucidx = ((size_t)b * BH + hd) * NCH + c; const int vi = tid >> 3, vc = tid & 7;
        *(u32x4*)((bf16_t*)(F.ws + WS_VTB) + ucidx * 4096 + vi * 64 + vc * 8) = *(const LAS u32x4*)(lds + BUF(7) + swo(vi, 8 * vc));
    }
    { const int seg = tid >> 6, j = tid & 63; float p = 0.f;
#pragma unroll
      for (int i = 0; i < 8; ++i) { LAS float* q = (LAS float*)(lds + LWOFF + ((8 * seg + i) * 64 + j) * 4); p += *q; *q = p; }
      *(LAS float*)(lds + SEGOFF + (seg * 64 + j) * 4) = p; }
    lds_barrier();
    if (tid < 64) { float run = 0.f;
#pragma unroll
      for (int sg = 0; sg < 8; ++sg) { *(LAS float*)(lds + SEGXOFF + (sg * 64 + tid) * 4) = run; run += *(const LAS float*)(lds + SEGOFF + (sg * 64 + tid) * 4); }
      *(LAS float*)(lds + TOTOFF + tid * 4) = run; }
    lds_barrier();
    {
        float At[8], Rt[8], Bt[8], Kt[8], Bh[8], Kh[8], pcs[8];
#pragma unroll
        for (int e = 0; e < 8; ++e) {
            const int j = 8 * jg + e;
            const float lwi = *(const LAS float*)(lds + LWOFF + (tau * 64 + j) * 4) + *(const LAS float*)(lds + SEGXOFF + ((tau >> 3) * 64 + j) * 4);
            const float tot = *(const LAS float*)(lds + TOTOFF + j * 4);
            const float ep = fexp2(lwi - lw[e]), epl = fexp2(lwi), em = fexp2(-lwi), ec = fexp2(tot - lwi);
            At[e] = -kap[e] * ep; Rt[e] = r[e] * epl; Bt[e] = bb[e] * em; Kt[e] = kd[e] * em; Bh[e] = bb[e] * ec; Kh[e] = kd[e] * ec;
            pcs[e] = tot;
        }
        if (u == 0) {
            *(LAS f32x4*)(lds + PCOFF + (8 * jg) * 4) = (f32x4){fexp2(pcs[0]), fexp2(pcs[1]), fexp2(pcs[2]), fexp2(pcs[3])};
            *(LAS f32x4*)(lds + PCOFF + (8 * jg + 4) * 4) = (f32x4){fexp2(pcs[4]), fexp2(pcs[5]), fexp2(pcs[6]), fexp2(pcs[7])}; }
        u32x4 o;
#define PK8(X) (o.x = cvtpk(X[0], X[1]), o.y = cvtpk(X[2], X[3]), o.z = cvtpk(X[4], X[5]), o.w = cvtpk(X[6], X[7]), o)
        *(LAS u32x4*)(lds + BUF(0) + swo(tau, 8 * jg)) = PK8(At);
        *(LAS u32x4*)(lds + BUF(1) + swo(tau, 8 * jg)) = PK8(Bt);
        *(LAS u32x4*)(lds + BUF(2) + swo(tau, 8 * jg)) = PK8(Kt);
        *(LAS u32x4*)(lds + BUF(3) + swo(tau, 8 * jg)) = PK8(Rt);
#undef PK8
#pragma unroll
        for (int e = 0; e < 8; ++e) { const int j = 8 * jg + e; st1(lds, BUF(4), j, tau, At[e]); st1(lds, BUF(5), j, tau, Bh[e]); st1(lds, BUF(6), j, tau, Kh[e]); }
    }
    if (next_unit >= 0) rwkv_prefetch(F, a, l, next_unit, PF);
    lds_barrier();
#pragma unroll
    for (int tmi = 0; tmi < 2; ++tmi) {
        const int tm = tm0 + tmi, mb = 16 * tm + 4 * g4, nn = 16 * tn + l15;
        { f32x4 v = mm64(lds, BUF(1), 16 * tm, BUF(0), 16 * tn, lane);
#pragma unroll
          for (int e = 0; e < 4; ++e) v[e] = (mb + e < nn) ? v[e] : 0.f;
          if (tm == tn) {
#pragma unroll
              for (int e = 0; e < 4; ++e) *(LAS float*)(lds + NABFOFF + ((16 * tm + l15) * 16 + ((mb + e) & 15)) * 4) = v[e];
              v = (f32x4){0.f, 0.f, 0.f, 0.f};
          }
          st4(lds, BUF(11), nn, mb, v); }
        { f32x4 v = mm64(lds, BUF(0), 16 * tm, BUF(2), 16 * tn, lane);
#pragma unroll
          for (int e = 0; e < 4; ++e) v[e] = (nn < mb + e) ? v[e] : 0.f;
          st4(lds, BUF(8), nn, mb, v); }
        { f32x4 v = mm64(lds, BUF(1), 16 * tm, BUF(3), 16 * tn, lane);
#pragma unroll
          for (int e = 0; e < 4; ++e) v[e] = (mb + e <= nn) ? v[e] : 0.f;
          st4(lds, BUF(9), nn, mb, v); }
        { f32x4 v = mm64(lds, BUF(2), 16 * tm, BUF(3), 16 * tn, lane);
#pragma unroll
          for (int e = 0; e < 4; ++e) v[e] = (mb + e <= nn) ? v[e] : 0.f;
          st4(lds, BUF(10), nn, mb, v); }
    }
    lds_barrier();
    if (wave == 0) {
        const int blk = lane >> 4, sr = lane & 15, s = 16 * blk + sr;
        float Tr[16];
#pragma unroll
        for (int t = 0; t < 16; ++t) { float acc = (t == sr) ? 1.f : 0.f;
            const LAS f32x4* col = (const LAS f32x4*)(lds + NABFOFF + ((16 * blk + t) * 16) * 4);
#pragma unroll
            for (int q = 0; q < (t + 3) / 4; ++q) { const f32x4 nv = col[q];
#pragma unroll
                for (int e = 0; e < 4; ++e) if (4 * q + e < t) acc += Tr[4 * q + e] * nv[e]; }
            Tr[t] = acc; __builtin_amdgcn_sched_barrier(0); }
        const u32x4 z4 = (u32x4){0u, 0u, 0u, 0u};
#pragma unroll
        for (int q = 0; q < 9; ++q) { *(LAS u32x4*)(lds + BUF(0) + s * 144 + 16 * q) = z4; *(LAS u32x4*)(lds + BUF(1) + s * 144 + 16 * q) = z4; }
        u32x4 o0, o1; o0.x = cvtpk(Tr[0], Tr[1]); o0.y = cvtpk(Tr[2], Tr[3]); o0.z = cvtpk(Tr[4], Tr[5]); o0.w = cvtpk(Tr[6], Tr[7]);
        o1.x = cvtpk(Tr[8], Tr[9]); o1.y = cvtpk(Tr[10], Tr[11]); o1.z = cvtpk(Tr[12], Tr[13]); o1.w = cvtpk(Tr[14], Tr[15]);
        LDS_WAIT();
        *(LAS u32x4*)(lds + BUF(0) + swo(s, 16 * blk)) = o0; *(LAS u32x4*)(lds + BUF(0) + swo(s, 16 * blk + 8)) = o1;
#pragma unroll
        for (int t = 0; t < 16; ++t) st1(lds, BUF(1), 16 * blk + t, s, Tr[t]);
    }
    lds_barrier();
#pragma unroll
    for (int tmi = 0; tmi < 2; ++tmi) {
        const int tm = tm0 + tmi, mb = 16 * tm + 4 * g4, nn = 16 * tn + l15;
        const f32x4 v = mm64(lds, BUF(0), 16 * tm, BUF(11), 16 * tn, lane);
        st4(lds, BUF(12), nn, mb, v);
#pragma unroll
        for (int e = 0; e < 4; ++e) st1(lds, BUF(2), mb + e, nn, v[e]);
    }
    lds_barrier();
#pragma unroll
    for (int tmi = 0; tmi < 2; ++tmi) {
        const int tm = tm0 + tmi, mb = 16 * tm + 4 * g4, nn = 16 * tn + l15;
        const f32x4 v = mm64(lds, BUF(12), 16 * tm, BUF(2), 16 * tn, lane);
        st4(lds, BUF(13), nn, mb, v);
    }
    lds_barrier();
#pragma unroll
    for (int tmi = 0; tmi < 2; ++tmi) {
        const int tm = tm0 + tmi, mb = 16 * tm + 4 * g4, nn = 16 * tn + l15;
        const f32x4 v = mm64(lds, BUF(13), 16 * tm, BUF(1), 16 * tn, lane) + ld4(lds, BUF(1), nn, mb);
        st4(lds, BUF(14), nn, mb, v);
    }
    lds_barrier();
#pragma unroll
    for (int tmi = 0; tmi < 2; ++tmi) {
        const int tm = tm0 + tmi, mb = 16 * tm + 4 * g4, nn = 16 * tn + l15;
        const f32x4 v = mm64(lds, BUF(2), 16 * tm, BUF(14), 16 * tn, lane) + ld4(lds, BUF(14), nn, mb);
        st4(lds, BUF(15), nn, mb, v);
    }
    lds_barrier();
#pragma unroll
    for (int tmi = 0; tmi < 2; ++tmi) {
        const int tm = tm0 + tmi, mb = 16 * tm + 4 * g4, nn = 16 * tn + l15;
        const f32x4 x1 = mm64(lds, BUF(15), 16 * tm, BUF(4), 16 * tn, lane);
        const f32x4 x2 = mm64(lds, BUF(15), 16 * tm, BUF(8), 16 * tn, lane);
        st4(lds, BUF(0), nn, mb, x1); st4(lds, BUF(1), nn, mb, x2);
    }
    lds_barrier();
    {
        bf16_t* QT = (bf16_t*)(F.ws + WS_QT) + (size_t)unit * 4096; bf16_t* WT = (bf16_t*)(F.ws + WS_WT) + (size_t)unit * 4096; bf16_t* MP = (bf16_t*)(F.ws + WS_MP) + USK(unit) * 4096;
#pragma unroll
        for (int tmi = 0; tmi < 2; ++tmi) {
            const int tm = tm0 + tmi, mb = 16 * tm + 4 * g4, nn = 16 * tn + l15;
            { const f32x4 v = mm64(lds, BUF(0), 16 * tm, BUF(9), 16 * tn, lane) + ld4(lds, BUF(3), nn, mb);
              *(u32x2*)(QT + (dir ? 63 - nn : nn) * 64 + mb) = pack4(v); }
            { const f32x4 v = mm64(lds, BUF(1), 16 * tm, BUF(9), 16 * tn, lane) + ld4(lds, BUF(10), nn, mb);
              if (dir) *(u32x2*)(WT + (63 - nn) * 64 + (60 - mb)) = pack4((f32x4){v[3], v[2], v[1], v[0]});
              else *(u32x2*)(WT + nn * 64 + mb) = pack4(v); }
            { const float pcv = *(const volatile LAS float*)(lds + PCOFF + nn * 4);
              f32x4 v = mm64(lds, BUF(0), 16 * tm, BUF(5), 16 * tn, lane);
#pragma unroll
              for (int e = 0; e < 4; ++e) v[e] += (mb + e == nn) ? pcv : 0.f;
              *(u32x2*)(MP + nn * 64 + swap23(mb)) = pack4(v); }
            { const f32x4 v = mm64(lds, BUF(1), 16 * tm, BUF(5), 16 * tn, lane) + ld4(lds, BUF(6), nn, mb);
              st4(lds, BUF(2), nn, mb, v); }
        }
    }
    lds_barrier();
    {
        bf16_t* NBp = (bf16_t*)(F.ws + WS_NB);
#pragma unroll
        for (int tmi = 0; tmi < 2; ++tmi) {
            const int tm = tm0 + tmi, mb = 16 * tm + 4 * g4, ii = 16 * tn + l15;
            const f32x4 v = mm64(lds, BUF(2), 16 * tm, BUF(7), 16 * tn, lane);
            const int jb = mb >> 5, jl = mb & 31, q = jl >> 3, hic = (jl >> 2) & 1, ih = ii >> 5, Lc = (ii & 31) + 32 * hic;
            *(u32x2*)(NBp + (((USK(unit) * 2 + ih) * 2 + jb) * 2 + (q >> 1)) * 512 + Lc * 8 + 4 * (q & 1)) = pack4(v);
        }
    }
    lds_barrier();
}

DI void attn_unit(const Frame& F, const LAS float* rpbl, const int au) {
    const bf16_t* HBp = (const bf16_t*)(F.ws + WS_HB); const bf16_t* VTp = (const bf16_t*)(F.ws + WS_VT); bf16_t* CONCAT = (bf16_t*)(F.ws + WS_CONCAT);
    const int hh = au % AH, r = (au / AH) % ROWS, b = au / (AH * ROWS);
    int rstart = r - KH / 2; rstart = rstart < 0 ? 0 : (rstart > ROWS - KH ? ROWS - KH : rstart);
    const int lane = F.lane, q32 = lane & 31, hi = lane >> 5;
    const float SC = 0.125f * LOG2E;
    const int krow_off = swap23(q32);
    const int cqA = q32, cqB = 32 + q32;
    int csA = cqA - KW / 2; csA = csA < 0 ? 0 : csA; int csB = cqB - KW / 2; csB = csB > GW - KW ? GW - KW : csB;
    const size_t tokA = (size_t)b * S + r * GW + cqA, tokB = tokA + 32;
    bf16x8 qfA[4], qfB[4];
#pragma unroll
    for (int ds = 0; ds < 4; ++ds) { qfA[ds] = *(const bf16x8*)(HBp + tokA * HW + HQ + hh * HD + 16 * ds + 8 * hi); qfB[ds] = *(const bf16x8*)(HBp + tokB * HW + HQ + hh * HD + 16 * ds + 8 * hi); }
    f32x16 oA0, oA1, oB0, oB1;
#pragma unroll
    for (int i = 0; i < 16; ++i) { oA0[i] = 0.f; oA1[i] = 0.f; oB0[i] = 0.f; oB1[i] = 0.f; }
    float mA = -1e30f, lA = 0.f, mB = -1e30f, lB = 0.f;
#ifdef ATT_PF
    bf16x8 kf[4], kfn[4];
    { const size_t ktok = (size_t)b * S + rstart * GW;
#pragma unroll
      for (int ds = 0; ds < 4; ++ds) kf[ds] = *(const bf16x8*)(HBp + (ktok + krow_off) * HW + HK + hh * HD + 16 * ds + 8 * hi); }
    __builtin_amdgcn_s_waitcnt(0x0F70);
#endif
#pragma unroll 1
    for (int kt = 0; kt < 2 * KH; ++kt) {
        const int kr = rstart + (kt >> 1), ckb = 32 * (kt & 1);
        const size_t ktok = (size_t)b * S + kr * GW + ckb;
#ifdef ATT_PF
        { const int ktn = kt + 1 < 2 * KH ? kt + 1 : kt; const size_t ktokn = (size_t)b * S + (rstart + (ktn >> 1)) * GW + 32 * (ktn & 1);
#pragma unroll
          for (int ds = 0; ds < 4; ++ds) kfn[ds] = *(const bf16x8*)(HBp + (ktokn + krow_off) * HW + HK + hh * HD + 16 * ds + 8 * hi); }
        bf16x8 vf[2][2];
#pragma unroll
        for (int db = 0; db < 2; ++db)
#pragma unroll
            for (int s = 0; s < 2; ++s) vf[db][s] = *(const bf16x8*)(VTp + (size_t)(hh * HD + 32 * db + q32) * T + ktok + 16 * s + 8 * hi);
#else
        bf16x8 kf[4], vf[2][2];
#pragma unroll
        for (int ds = 0; ds < 4; ++ds) kf[ds] = *(const bf16x8*)(HBp + (ktok + krow_off) * HW + HK + hh * HD + 16 * ds + 8 * hi);
#pragma unroll
        for (int db = 0; db < 2; ++db)
#pragma unroll
            for (int s = 0; s < 2; ++s) vf[db][s] = *(const bf16x8*)(VTp + (size_t)(hh * HD + 32 * db + q32) * T + ktok + 16 * s + 8 * hi);
#endif
        const LAS float* rp = rpbl + (hh * (2 * KH - 1) + (kr - r + KH - 1)) * (2 * KW - 1);
#pragma unroll
        for (int qb = 0; qb < 2; ++qb) {
            const int cq = qb ? cqB : cqA, cs = qb ? csB : csA;
            f32x16 st;
#pragma unroll
            for (int i = 0; i < 16; ++i) st[i] = 0.f;
#pragma unroll
            for (int ds = 0; ds < 4; ++ds) st = MFMA32(kf[ds], qb ? qfB[ds] : qfA[ds], st);
            float sl[16]; float tmax = -1e30f;
            float bia[16];
#pragma unroll
            for (int i = 0; i < 16; ++i) {
                const int ck = ckb + 16 * (i >> 3) + 8 * hi + (i & 7);
                int dc = ck - cq; dc = dc < -(KW - 1) ? -(KW - 1) : (dc > KW - 1 ? KW - 1 : dc); dc += KW - 1;
                bia[i] = *(const volatile LAS float*)(rp + dc);
            }
#pragma unroll
            for (int i = 0; i < 16; ++i) {
                const int ck = ckb + 16 * (i >> 3) + 8 * hi + (i & 7);
                const bool inw = (ck >= cs) && (ck < cs + KW);
                const float sv = st[i] * SC + bia[i];
                sl[i] = inw ? sv : -1e30f;
                tmax = fmaxf(tmax, sl[i]);
            }
            tmax = fmaxf(tmax, __shfl_xor(tmax, 32));
            const float mrun = qb ? mB : mA;
            const float mn = fmaxf(mrun, tmax), corr = __builtin_amdgcn_exp2f(mrun - mn);
            float ps = 0.f;
#pragma unroll
            for (int i = 0; i < 16; ++i) { sl[i] = (sl[i] > -1e29f) ? __builtin_amdgcn_exp2f(sl[i] - mn) : 0.f; ps += sl[i]; }
            u32x4 p0, p1;
            p0.x = cvtpk(sl[0], sl[1]); p0.y = cvtpk(sl[2], sl[3]); p0.z = cvtpk(sl[4], sl[5]); p0.w = cvtpk(sl[6], sl[7]);
            p1.x = cvtpk(sl[8], sl[9]); p1.y = cvtpk(sl[10], sl[11]); p1.z = cvtpk(sl[12], sl[13]); p1.w = cvtpk(sl[14], sl[15]);
            const bf16x8 pf0 = __builtin_bit_cast(bf16x8, p0), pf1 = __builtin_bit_cast(bf16x8, p1);
            if (qb == 0) { lA = lA * corr + ps; mA = mn;
#pragma unroll
                for (int i = 0; i < 16; ++i) { oA0[i] *= corr; oA1[i] *= corr; }
                oA0 = MFMA32(vf[0][0], pf0, oA0); oA0 = MFMA32(vf[0][1], pf1, oA0); oA1 = MFMA32(vf[1][0], pf0, oA1); oA1 = MFMA32(vf[1][1], pf1, oA1);
            } else { lB = lB * corr + ps; mB = mn;
#pragma unroll
                for (int i = 0; i < 16; ++i) { oB0[i] *= corr; oB1[i] *= corr; }
                oB0 = MFMA32(vf[0][0], pf0, oB0); oB0 = MFMA32(vf[0][1], pf1, oB0); oB1 = MFMA32(vf[1][0], pf0, oB1); oB1 = MFMA32(vf[1][1], pf1, oB1);
            }
        }
#ifdef ATT_PF
#pragma unroll
        for (int ds = 0; ds < 4; ++ds) kf[ds] = kfn[ds];
#endif
    }
    { const float inv = 1.f / (lA + __shfl_xor(lA, 32)); bf16_t* op = CONCAT + tokA * D + hh * HD;
#pragma unroll
      for (int g = 0; g < 4; ++g) {
          *(u32x2*)(op + 8 * g + 4 * hi) = pack4((f32x4){oA0[4 * g] * inv, oA0[4 * g + 1] * inv, oA0[4 * g + 2] * inv, oA0[4 * g + 3] * inv});
          *(u32x2*)(op + 32 + 8 * g + 4 * hi) = pack4((f32x4){oA1[4 * g] * inv, oA1[4 * g + 1] * inv, oA1[4 * g + 2] * inv, oA1[4 * g + 3] * inv}); } }
    { const float inv = 1.f / (lB + __shfl_xor(lB, 32)); bf16_t* op = CONCAT + tokB * D + hh * HD;
#pragma unroll
      for (int g = 0; g < 4; ++g) {
          *(u32x2*)(op + 8 * g + 4 * hi) = pack4((f32x4){oB0[4 * g] * inv, oB0[4 * g + 1] * inv, oB0[4 * g + 2] * inv, oB0[4 * g + 3] * inv});
          *(u32x2*)(op + 32 + 8 * g + 4 * hi) = pack4((f32x4){oB1[4 * g] * inv, oB1[4 * g + 1] * inv, oB1[4 * g + 2] * inv, oB1[4 * g + 3] * inv}); } }
}

DI void pool_unit(const Frame& F, const float* pool_w, const float* pool_scale, const int pu) {
    const bf16_t* HBp = (const bf16_t*)(F.ws + WS_HB); bf16_t* CONCAT = (bf16_t*)(F.ws + WS_CONCAT);
    const int g = pu & 3, blk = pu >> 2, b = blk >> 8, t0 = (blk & 255) * 32;
    const int lane = F.lane, q32 = lane & 31, hi = lane >> 5, t = t0 + q32, win = 2 << g;
    int lo = t - win / 2; lo = lo < 0 ? 0 : lo; int hit = t + win / 2 - 1; hit = hit > S - 1 ? S - 1 : hit;
    const float inv = 1.f / (float)(hit - lo + 1);
    f32x16 out0, out1;
#pragma unroll
    for (int i = 0; i < 16; ++i) { out0[i] = 0.f; out1[i] = 0.f; }
    const float* pw = pool_w + (size_t)g * 64 * 64;
#pragma unroll 1
    for (int s = 0; s < 4; ++s) {
        const int c0 = HP + g * 64 + 16 * s + 8 * hi;
        float acc[8];
#pragma unroll
        for (int e = 0; e < 8; ++e) acc[e] = 0.f;
        u32x4 pv[16];
#pragma unroll
        for (int d = 0; d < 16; ++d) { int tt = t - win / 2 + d; const bool ok = d < win && tt >= 0 && tt < S; tt = ok ? tt : t;
            pv[d] = *(const u32x4*)(HBp + ((size_t)b * S + tt) * HW + c0); if (!ok) pv[d] = (u32x4){0u, 0u, 0u, 0u}; }
#pragma unroll
        for (int d = 0; d < 16; ++d) {
            acc[0] += bflo(pv[d].x); acc[1] += bfhi(pv[d].x); acc[2] += bflo(pv[d].y); acc[3] += bfhi(pv[d].y); acc[4] += bflo(pv[d].z); acc[5] += bfhi(pv[d].z); acc[6] += bflo(pv[d].w); acc[7] += bfhi(pv[d].w);
        }
        const u32x4 pc = *(const u32x4*)(HBp + ((size_t)b * S + t) * HW + c0);
        u32x4 o;
        o.x = cvtpk(acc[0] * inv - bflo(pc.x), acc[1] * inv - bfhi(pc.x)); o.y = cvtpk(acc[2] * inv - bflo(pc.y), acc[3] * inv - bfhi(pc.y));
        o.z = cvtpk(acc[4] * inv - bflo(pc.z), acc[5] * inv - bfhi(pc.z)); o.w = cvtpk(acc[6] * inv - bflo(pc.w), acc[7] * inv - bfhi(pc.w));
        const bf16x8 bfr = __builtin_bit_cast(bf16x8, o);
        const float* wp = pw + (size_t)(16 * s + 8 * hi) * 64 + q32;
        u32x4 w0; w0.x = cvtpk(wp[0], wp[64]); w0.y = cvtpk(wp[128], wp[192]); w0.z = cvtpk(wp[256], wp[320]); w0.w = cvtpk(wp[384], wp[448]);
        u32x4 w1; w1.x = cvtpk(wp[32], wp[96]); w1.y = cvtpk(wp[160], wp[224]); w1.z = cvtpk(wp[288], wp[352]); w1.w = cvtpk(wp[416], wp[480]);
        out0 = MFMA32(__builtin_bit_cast(bf16x8, w0), bfr, out0);
        out1 = MFMA32(__builtin_bit_cast(bf16x8, w1), bfr, out1);
    }
    bf16_t* op = CONCAT + ((size_t)b * S + t) * D + AW + BW + g * 64;
    const float* ps = pool_scale + g * 64;
#pragma unroll
    for (int gq = 0; gq < 4; ++gq) {
        const int e0 = 8 * gq + 4 * hi;
        const f32x4 s0 = *(const f32x4*)(ps + e0), s1 = *(const f32x4*)(ps + 32 + e0);
        *(u32x2*)(op + e0) = pack4((f32x4){out0[4 * gq] * s0[0], out0[4 * gq + 1] * s0[1], out0[4 * gq + 2] * s0[2], out0[4 * gq + 3] * s0[3]});
        *(u32x2*)(op + 32 + e0) = pack4((f32x4){out1[4 * gq] * s1[0], out1[4 * gq + 1] * s1[1], out1[4 * gq + 2] * s1[2], out1[4 * gq + 3] * s1[3]});
    }
}

constexpr int SCAN_SLOT = 12288, SCAN_RING = 12;
constexpr int SCAN_FLAGS = SCAN_RING * SCAN_SLOT;
DI void scan_issue(const Frame& F, const int sc, const int ihalf, const int dir, const int step, const int lane) {
    const int c = dir ? NCH - 1 - step : step; const size_t unit = (size_t)sc * NCH + c;
    const int il = lane & 31, hi = lane >> 5;
    LAS unsigned char* slot = F.lds + (step % SCAN_RING) * SCAN_SLOT;
    const bf16_t* MP = (const bf16_t*)(F.ws + WS_MP) + USK(unit) * 4096; const bf16_t* NBp = (const bf16_t*)(F.ws + WS_NB) + (USK(unit) * 2 + ihalf) * 2048;
#pragma unroll
    for (int p = 0; p < 8; ++p) { const int jpb = p >> 2, jb = (p >> 1) & 1, s = p & 1;
        __builtin_amdgcn_global_load_lds((const unsigned*)(MP + (32 * jpb + il) * 64 + 32 * jb + 16 * s + 8 * hi), (LAS unsigned*)(slot + p * 1024), 16, 0, 0); }
#pragma unroll
    for (int p = 0; p < 4; ++p)
        __builtin_amdgcn_global_load_lds((const unsigned*)(NBp + p * 512 + lane * 8), (LAS unsigned*)(slot + 8192 + p * 1024), 16, 0, 0);
}
DI unsigned lds_ld_u32(const volatile LAS unsigned* p) { return __builtin_amdgcn_readfirstlane(*p); }
DI void scan_loader(const Frame& F, const int sw, const int ld) {
    const int ihalf = sw & 1, sc = sw >> 1, dir = sc / (NB * BH);
    volatile LAS unsigned* ready = (volatile LAS unsigned*)(F.lds + SCAN_FLAGS); volatile LAS unsigned* cons = ready + 16;
    const int nmine = NCH / 2;
    for (int k = 0; k < nmine + 5; ++k) {
        if (k < nmine) {
            const int s = 2 * k + ld;
            if (s >= SCAN_RING) { unsigned spins = 0; while ((int)lds_ld_u32(cons) < s - SCAN_RING + 1) { __builtin_amdgcn_s_sleep(1); if (++spins > (1u << 22)) break; } }
            asm volatile("" ::: "memory");
            scan_issue(F, sc, ihalf, dir, s, F.lane);
        }
        if (k >= 4) {
            const int kd = k - 4;
            if (kd < nmine) {
                const int rem = nmine - 1 - kd;
                if (rem >= 4) asm volatile("s_waitcnt vmcnt(48)" ::: "memory");
                else if (rem == 3) asm volatile("s_waitcnt vmcnt(36)" ::: "memory");
                else if (rem == 2) asm volatile("s_waitcnt vmcnt(24)" ::: "memory");
                else if (rem == 1) asm volatile("s_waitcnt vmcnt(12)" ::: "memory");
                else asm volatile("s_waitcnt vmcnt(0)" ::: "memory");
                const int sd = 2 * kd + ld;
                if (F.lane == 0) ready[sd % SCAN_RING] = (unsigned)(sd + 1);
                asm volatile("s_waitcnt lgkmcnt(0)" ::: "memory");
            }
        }
    }
}
constexpr int S0_STAGE = SCAN_FLAGS + 256;
DI void scan_writer(const Frame& F, const int sw) {
    const int ihalf = sw & 1, sc = sw >> 1, dir = sc / (NB * BH);
    volatile LAS unsigned* ready = (volatile LAS unsigned*)(F.lds + SCAN_FLAGS);
    volatile LAS unsigned* s0rdy = ready + 17; volatile LAS unsigned* s0done = ready + 18;
    bf16_t* S0 = (bf16_t*)(F.ws + WS_S0);
    const int lane = F.lane;
#pragma unroll 1
    for (int step = 0; step < NCH; ++step) {
        const int c = dir ? NCH - 1 - step : step; const size_t unit = (size_t)sc * NCH + c;
        { unsigned spins = 0; while ((int)lds_ld_u32(s0rdy) < step + 1) { __builtin_amdgcn_s_sleep(1); if (++spins > (1u << 22)) break; } }
        asm volatile("" ::: "memory");
        const LAS unsigned char* sl = F.lds + S0_STAGE + (step & 1) * (32 * 144);
        u32x4 v[4];
#pragma unroll
        for (int p = 0; p < 4; ++p) { const int idx = p * 64 + lane; v[p] = *(const LAS u32x4*)(sl + (idx >> 3) * 144 + (idx & 7) * 16); }
        asm volatile("s_waitcnt lgkmcnt(0)" ::: "memory");
        if (lane == 0) *s0done = (unsigned)(step + 1);
        bf16_t* dst = S0 + USK(unit) * 4096 + ihalf * 2048;
#pragma unroll
        for (int p = 0; p < 4; ++p) *(u32x4*)(dst + (p * 64 + lane) * 8) = v[p];
    }
}
DI void scan_wave(const Frame& F, const int sw) {
    const int ihalf = sw & 1, sc = sw >> 1, dir = sc / (NB * BH);
    const int lane = F.lane, il = lane & 31, hi = lane >> 5;
    bf16_t* S0 = (bf16_t*)(F.ws + WS_S0);
    volatile LAS unsigned* ready = (volatile LAS unsigned*)(F.lds + SCAN_FLAGS); volatile LAS unsigned* cons = ready + 16;
    volatile LAS unsigned* s0rdy = ready + 17; volatile LAS unsigned* s0done = ready + 18; (void)s0rdy; (void)s0done;
    f32x16 st0, st1;
#pragma unroll
    for (int i = 0; i < 16; ++i) { st0[i] = 0.f; st1[i] = 0.f; }
    bf16x8 ma[8], man[8]; u32x4 nbv[4], nbn[4];
    { unsigned spins = 0; while (lds_ld_u32(ready) != 1u) { __builtin_amdgcn_s_sleep(1); if (++spins > (1u << 22)) break; } }
    asm volatile("" ::: "memory");
#pragma unroll
    for (int p = 0; p < 8; ++p) ma[p] = *(const LAS bf16x8*)(F.lds + p * 1024 + lane * 16);
#pragma unroll
    for (int p = 0; p < 4; ++p) nbv[p] = *(const LAS u32x4*)(F.lds + 8192 + p * 1024 + lane * 16);
#pragma unroll 1
    for (int step = 0; step < NCH; ++step) {
        const int c = dir ? NCH - 1 - step : step; const size_t unit = (size_t)sc * NCH + c;
        const bool more = step + 1 < NCH;
#ifdef S0_WRITER
        if (step >= 2) { unsigned spins = 0; while ((int)lds_ld_u32(s0done) < step - 1) { __builtin_amdgcn_s_sleep(1); if (++spins > (1u << 22)) break; } }
        asm volatile("" ::: "memory");
#endif
        if (more) {
            { unsigned spins = 0; while (lds_ld_u32(ready + ((step + 1) % SCAN_RING)) != (unsigned)(step + 2)) { __builtin_amdgcn_s_sleep(1); if (++spins > (1u << 22)) break; } }
            asm volatile("" ::: "memory");

            const LAS unsigned char* slot = F.lds + ((step + 1) % SCAN_RING) * SCAN_SLOT;
#pragma unroll
            for (int p = 0; p < 8; ++p) man[p] = *(const LAS bf16x8*)(slot + p * 1024 + lane * 16);
#pragma unroll
            for (int p = 0; p < 4; ++p) nbn[p] = *(const LAS u32x4*)(slot + 8192 + p * 1024 + lane * 16);
        }
        bf16_t* sp = S0 + USK(unit) * 4096 + (size_t)(32 * ihalf + il) * 64;
        u32x4 b00, b01, b10, b11;
        b00.x = cvtpk(st0[0], st0[1]); b00.y = cvtpk(st0[2], st0[3]); b00.z = cvtpk(st0[4], st0[5]); b00.w = cvtpk(st0[6], st0[7]);
        b01.x = cvtpk(st0[8], st0[9]); b01.y = cvtpk(st0[10], st0[11]); b01.z = cvtpk(st0[12], st0[13]); b01.w = cvtpk(st0[14], st0[15]);
        b10.x = cvtpk(st1[0], st1[1]); b10.y = cvtpk(st1[2], st1[3]); b10.z = cvtpk(st1[4], st1[5]); b10.w = cvtpk(st1[6], st1[7]);
        b11.x = cvtpk(st1[8], st1[9]); b11.y = cvtpk(st1[10], st1[11]); b11.z = cvtpk(st1[12], st1[13]); b11.w = cvtpk(st1[14], st1[15]);
#ifdef S0_WRITER
        { LAS unsigned char* sl = F.lds + S0_STAGE + (step & 1) * (32 * 144) + il * 144 + 8 * hi;
          {
          *(LAS u32x2*)(sl + 0) = (u32x2){b00.x, b00.y};  *(LAS u32x2*)(sl + 16) = (u32x2){b00.z, b00.w};
          *(LAS u32x2*)(sl + 32) = (u32x2){b01.x, b01.y}; *(LAS u32x2*)(sl + 48) = (u32x2){b01.z, b01.w};
          *(LAS u32x2*)(sl + 64) = (u32x2){b10.x, b10.y}; *(LAS u32x2*)(sl + 80) = (u32x2){b10.z, b10.w};
          *(LAS u32x2*)(sl + 96) = (u32x2){b11.x, b11.y}; *(LAS u32x2*)(sl + 112) = (u32x2){b11.z, b11.w}; }
          asm volatile("" ::: "memory");
          if (lane == 0) *s0rdy = (unsigned)(step + 1); }
        (void)sp;
#else
        *(u32x2*)(sp + 0 + 4 * hi) = (u32x2){b00.x, b00.y};  *(u32x2*)(sp + 8 + 4 * hi) = (u32x2){b00.z, b00.w};
        *(u32x2*)(sp + 16 + 4 * hi) = (u32x2){b01.x, b01.y}; *(u32x2*)(sp + 24 + 4 * hi) = (u32x2){b01.z, b01.w};
        *(u32x2*)(sp + 32 + 4 * hi) = (u32x2){b10.x, b10.y}; *(u32x2*)(sp + 40 + 4 * hi) = (u32x2){b10.z, b10.w};
        *(u32x2*)(sp + 48 + 4 * hi) = (u32x2){b11.x, b11.y}; *(u32x2*)(sp + 56 + 4 * hi) = (u32x2){b11.z, b11.w};
#endif
        const bf16x8 p00 = __builtin_bit_cast(bf16x8, b00), p01 = __builtin_bit_cast(bf16x8, b01), p10 = __builtin_bit_cast(bf16x8, b10), p11 = __builtin_bit_cast(bf16x8, b11);
        f32x16 n0, n1;
#pragma unroll
        for (int h2 = 0; h2 < 2; ++h2) {
            n0[8 * h2 + 0] = bflo(nbv[h2].x); n0[8 * h2 + 1] = bfhi(nbv[h2].x); n0[8 * h2 + 2] = bflo(nbv[h2].y); n0[8 * h2 + 3] = bfhi(nbv[h2].y);
            n0[8 * h2 + 4] = bflo(nbv[h2].z); n0[8 * h2 + 5] = bfhi(nbv[h2].z); n0[8 * h2 + 6] = bflo(nbv[h2].w); n0[8 * h2 + 7] = bfhi(nbv[h2].w);
            n1[8 * h2 + 0] = bflo(nbv[2 + h2].x); n1[8 * h2 + 1] = bfhi(nbv[2 + h2].x); n1[8 * h2 + 2] = bflo(nbv[2 + h2].y); n1[8 * h2 + 3] = bfhi(nbv[2 + h2].y);
            n1[8 * h2 + 4] = bflo(nbv[2 + h2].z); n1[8 * h2 + 5] = bfhi(nbv[2 + h2].z); n1[8 * h2 + 6] = bflo(nbv[2 + h2].w); n1[8 * h2 + 7] = bfhi(nbv[2 + h2].w);
        }
        n0 = MFMA32(ma[0], p00, n0); n1 = MFMA32(ma[4], p00, n1);
        n0 = MFMA32(ma[1], p01, n0); n1 = MFMA32(ma[5], p01, n1);
        n0 = MFMA32(ma[2], p10, n0); n1 = MFMA32(ma[6], p10, n1);
        n0 = MFMA32(ma[3], p11, n0); n1 = MFMA32(ma[7], p11, n1);
        st0 = n0; st1 = n1;
        if (more) {
            asm volatile("s_waitcnt lgkmcnt(0)" ::: "memory");
            if (lane == 0) *cons = (unsigned)(step + 2);
#pragma unroll
            for (int p = 0; p < 8; ++p) ma[p] = man[p];
#pragma unroll
            for (int p = 0; p < 4; ++p) nbv[p] = nbn[p];
        }
    }
}

DI void rwkv_out_unit(const Frame& F, const RwP& P, const int du) {
    const int qd = du & 3, cidx = du >> 2, c = cidx % NCH, hd = (cidx / NCH) % BH, b = cidx / (NCH * BH);
    const int lane = F.lane, n = lane & 15, g = lane >> 4, u = 16 * qd + n;
    const bf16_t* QT = (const bf16_t*)(F.ws + WS_QT); const bf16_t* WT = (const bf16_t*)(F.ws + WS_WT); const bf16_t* S0 = (const bf16_t*)(F.ws + WS_S0);
    const bf16_t* VTB = (const bf16_t*)(F.ws + WS_VTB) + (size_t)cidx * 4096;
    f32x4 acc[4];
#pragma unroll
    for (int tm = 0; tm < 4; ++tm) acc[tm] = (f32x4){0.f, 0.f, 0.f, 0.f};
#pragma unroll
    for (int dir = 0; dir < 2; ++dir) {
        const size_t unit = (((size_t)dir * NB + b) * BH + hd) * NCH + c;
#pragma unroll
        for (int ks = 0; ks < 2; ++ks) {
            const bf16x8 bq = *(const bf16x8*)(QT + unit * 4096 + u * 64 + 32 * ks + 8 * g);
            const bf16x8 bw = *(const bf16x8*)(WT + unit * 4096 + u * 64 + 32 * ks + 8 * g);
#pragma unroll
            for (int tm = 0; tm < 4; ++tm) {
                const bf16x8 as = *(const bf16x8*)(S0 + USK(unit) * 4096 + (16 * tm + n) * 64 + 32 * ks + 8 * g);
                const bf16x8 av = *(const bf16x8*)(VTB + (16 * tm + n) * 64 + 32 * ks + 8 * g);
                acc[tm] = MFMA16(as, bq, acc[tm]); acc[tm] = MFMA16(av, bw, acc[tm]);
            }
        }
    }
    float s = 0.f;
#pragma unroll
    for (int tm = 0; tm < 4; ++tm) s += (acc[tm][0] + acc[tm][1]) + (acc[tm][2] + acc[tm][3]);
    s += __shfl_xor(s, 16); s += __shfl_xor(s, 32);
    const float mu = s * (1.f / HD); float q = 0.f;
#pragma unroll
    for (int tm = 0; tm < 4; ++tm) { acc[tm] = acc[tm] - mu; q += (acc[tm][0] * acc[tm][0] + acc[tm][1] * acc[tm][1]) + (acc[tm][2] * acc[tm][2] + acc[tm][3] * acc[tm][3]); }
    q += __shfl_xor(q, 16); q += __shfl_xor(q, 32);
    const float rstd = 1.f / sqrtf(q * (1.f / HD) + GN_EPS);
    const size_t tok = (size_t)b * S + 64 * c + u;
    const float* BS = (const float*)(F.ws + WS_BS);
    const float bsum = BS[tok * 8 + hd] + BS[((size_t)T + tok) * 8 + hd];
    const bf16_t* VC = (const bf16_t*)(F.ws + WS_VC) + tok * BW + hd * HD; const bf16_t* GBp = (const bf16_t*)(F.ws + WS_GB) + tok * BW + hd * HD;
    bf16_t* op = (bf16_t*)(F.ws + WS_CONCAT) + tok * D + AW + hd * HD;
#pragma unroll
    for (int tm = 0; tm < 4; ++tm) {
        const int i0 = 16 * tm + 4 * g;
        const f32x4 vv = unpack4(*(const u32x2*)(VC + i0)), gg = unpack4(*(const u32x2*)(GBp + i0));
        const f32x4 gn = *(const f32x4*)(P.gn_gain + hd * HD + i0), gb = *(const f32x4*)(P.gn_bias + hd * HD + i0);
        *(u32x2*)(op + i0) = pack4((acc[tm] * rstd * gn + gb + vv * bsum) * gg);
    }
}

DI RwP make_rwp(const Args& a, int l) {
    RwP p;
    p.conv = a.in[6] + (size_t)l * 3 * 3 * BW; p.w0 = a.in[7] + (size_t)l * 2 * BW; p.w_up = a.in[8] + (size_t)l * 2 * RW * BW;
    p.a0 = a.in[9] + (size_t)l * 2 * BW; p.a_up = a.in[10] + (size_t)l * 2 * RA * BW; p.g_up = a.in[11] + (size_t)l * RG * BW;
    p.k_k = a.in[12] + (size_t)l * BW; p.k_a = a.in[13] + (size_t)l * BW; p.r_k = a.in[14] + (size_t)l * BH * HD;
    p.gn_gain = a.in[15] + (size_t)l * BW; p.gn_bias = a.in[16] + (size_t)l * BW;
    return p;
}
DI void conv_moe(const Frame& F, const Args& a, int l, int first, int stride, const int IT_END = IT_MOE) {
    LAS float* scr = (LAS float*)F.lds + F.wave * (64 * 65);
#ifdef CONV3
    f32x4 b0[16], b1[16], b2[16]; TItem t0{}, t1{}, t2{};
    int it = first;
    if (it < IT_MOE) { t0 = moe_item(F, a.in[28], a.in[29], a.in[30], l, it); titem_load(t0, b0, F.lane); }
    if (it + stride < IT_MOE) { t1 = moe_item(F, a.in[28], a.in[29], a.in[30], l, it + stride); titem_load(t1, b1, F.lane); }
    for (; it < IT_MOE; it += 3 * stride) {
        if (it + 2 * stride < IT_MOE) { t2 = moe_item(F, a.in[28], a.in[29], a.in[30], l, it + 2 * stride); titem_load(t2, b2, F.lane); }
        titem_store(t0, b0, scr, F.lane);
        if (it + stride >= IT_MOE) break;
        if (it + 3 * stride < IT_MOE) { t0 = moe_item(F, a.in[28], a.in[29], a.in[30], l, it + 3 * stride); titem_load(t0, b0, F.lane); }
        titem_store(t1, b1, scr, F.lane);
        if (it + 2 * stride >= IT_MOE) break;
        if (it + 4 * stride < IT_MOE) { t1 = moe_item(F, a.in[28], a.in[29], a.in[30], l, it + 4 * stride); titem_load(t1, b1, F.lane); }
        titem_store(t2, b2, scr, F.lane);
    }
#else
    f32x4 cur[16], nxt[16]; int it = first; TItem tc{}, tn{};
    if (it < IT_END) { tc = moe_item(F, a.in[28], a.in[29], a.in[30], l, it); titem_load(tc, cur, F.lane); }
    CONV_PREWAIT();
    for (; it < IT_END; it += stride) {
        const bool more = it + stride < IT_END;
        if (more) { tn = moe_item(F, a.in[28], a.in[29], a.in[30], l, it + stride); titem_load(tn, nxt, F.lane); }
        titem_store(tc, cur, scr, F.lane);
        if (more) { tc = tn;
#pragma unroll
            for (int i = 0; i < 16; ++i) cur[i] = nxt[i]; }
    }
#endif
}
#ifndef NG1
#define NG1 21
#endif
#ifndef N1
#define N1 3360
#endif
DI void p_gemm1(const Frame& F, const Args& a, int l) {
#ifdef CONV_G1
    if (F.G == 256) {
        if (F.bx >= 256 - NG1) { conv_moe(F, a, l, (F.bx - (256 - NG1)) * NWAVES + F.wave, NG1 * NWAVES, N1); return; }
        pg8::Gemm1Order S; S.U = (const bf16_t*)(F.ws + WS_U); S.Win = (const bf16_t*)(F.ws + WS_WIN + (size_t)l * WIN_LAYER); S.Wv = S.Win + (size_t)HW * D; S.G = 256 - NG1; S.c = F.bx;
        pg8::EpiStore E{(bf16_t*)(F.ws + WS_HB), HW, (bf16_t*)(F.ws + WS_VT), T};
        pg8::gemm_phase(F.lds, F.tid, D, S, E);
        return;
    }
#endif
    pg8::Gemm1Order S; S.U = (const bf16_t*)(F.ws + WS_U); S.Win = (const bf16_t*)(F.ws + WS_WIN + (size_t)l * WIN_LAYER); S.Wv = S.Win + (size_t)HW * D; S.G = F.G; S.c = F.bx;
    pg8::EpiStore E{(bf16_t*)(F.ws + WS_HB), HW, (bf16_t*)(F.ws + WS_VT), T};
    pg8::gemm_phase(F.lds, F.tid, D, S, E);
}
#ifndef NCB
#define NCB 16
#endif
DI void p_mixer_local(const Frame& F, const Args& a, int l) {
#ifdef CONV_IN_B
    const int GR = F.G - NCB;
    if (F.bx >= GR) { conv_moe(F, a, l, (F.bx - GR) * NWAVES + F.wave, NCB * NWAVES); return; }
    { const float* conv = a.in[6] + (size_t)l * 3 * 3 * BW;
#pragma unroll 7
      for (int i = F.tid; i < BH * 9 * 64; i += NTHREADS) { const int j = i & 63, q = i >> 6, which = q % 3, x = (q / 3) % 3, hd = q / 9;
          *(LAS bf16_t*)(F.lds + CWLOFF + i * 2) = f2bf(conv[x * 3 * BW + which * BW + hd * HD + j]); }
      RwPre PF;
      if (F.bx < NUNIT) rwkv_prefetch(F, a, l, F.bx, PF);
      __syncthreads();
      for (int unit = F.bx; unit < NUNIT; unit += GR) rwkv_local_unit(F, a, l, unit, PF, unit + GR < NUNIT ? unit + GR : -1);
      return;
    }
#endif
    {
      const float* conv = a.in[6] + (size_t)l * 3 * 3 * BW;
#pragma unroll 7
      for (int i = F.tid; i < BH * 9 * 64; i += NTHREADS) { const int j = i & 63, q = i >> 6, which = q % 3, x = (q / 3) % 3, hd = q / 9;
          *(LAS bf16_t*)(F.lds + CWLOFF + i * 2) = f2bf(conv[x * 3 * BW + which * BW + hd * HD + j]); }
      RwPre PF;
      if (F.bx < NUNIT) rwkv_prefetch(F, a, l, F.bx, PF);
      __syncthreads();
      for (int unit = F.bx; unit < NUNIT; unit += F.G) rwkv_local_unit(F, a, l, unit, PF, unit + F.G < NUNIT ? unit + F.G : -1);
    }
}
DI void p_scan(const Frame& F, const Args& a, int l) {
#ifndef CVW
#define CVW 3
#endif
    constexpr int NSCAN = 2 * 2 * NB * BH;
    const int NATTW = (F.G - NSCAN) * (NWAVES - CVW);
    if (F.bx < NSCAN) {
        volatile LAS unsigned* fl = (volatile LAS unsigned*)(F.lds + SCAN_FLAGS);
        if (F.tid < 32) fl[F.tid] = 0u;
        __syncthreads();
#ifdef S0_WRITER
        if (F.wave == 0) scan_wave(F, F.bx); else if (F.wave <= 2) scan_loader(F, F.bx, F.wave - 1); else if (F.wave == 3) scan_writer(F, F.bx);
#else
        if (F.wave == 0) scan_wave(F, F.bx); else if (F.wave <= 2) scan_loader(F, F.bx, F.wave - 1);
#endif
#ifdef DBL_SCAN
        __syncthreads();
        if (F.tid < 32) fl[F.tid] = 0u;
        __syncthreads();
        if (F.wave == 0) scan_wave(F, F.bx); else if (F.wave <= 2) scan_loader(F, F.bx, F.wave - 1);
#endif
        return;
    }
#ifdef SERIAL_C
    {
        LAS float* rpbl8 = (LAS float*)(F.lds + NWAVES * 64 * 65 * 4);
        { const float* rpb = a.in[5] + (size_t)l * AH * (2 * KH - 1) * (2 * KW - 1);
#pragma unroll 6
          for (int i = F.tid; i < AH * (2 * KH - 1) * (2 * KW - 1); i += NTHREADS) rpbl8[i] = rpb[i] * LOG2E; }
        __syncthreads();
        const int aw8 = (F.bx - NSCAN) * NWAVES + F.wave, naw8 = (F.G - NSCAN) * NWAVES;
        if (F.G == 256) {
            constexpr int UPX = NB * ROWS * AH / 8;
            const int x = F.bx & 7, k = (F.bx - NSCAN) >> 3, j = k * NWAVES + F.wave;
            if (j < UPX) { const int v = (x & 3) * UPX + j; attn_unit(F, rpbl8, (((x >> 2) * ROWS) + (v & (ROWS - 1))) * AH + (v >> 7)); }
        } else
            for (int au = aw8; au < NB * ROWS * AH; au += naw8) attn_unit(F, rpbl8, au);
        for (int pu = aw8; pu < NB * (S / 32) * 4; pu += naw8) pool_unit(F, a.in[17] + (size_t)l * NG * 64 * 64, a.in[18] + (size_t)l * CW, pu);
#ifdef CONV_IN_B
        return;
#endif
        LAS float* scr = (LAS float*)F.lds + F.wave * (64 * 65);
        f32x4 cur[16], nxt[16]; const int st = naw8; int it = aw8; TItem tc{}, tn{};
#ifdef DBL_CONV
        for (int rep = 0; rep < 2; ++rep) { it = aw8;
#endif
        if (it < IT_MOE) { tc = moe_item(F, a.in[28], a.in[29], a.in[30], l, it); titem_load(tc, cur, F.lane); }
        for (; it < IT_MOE; it += st) {
            const bool more = it + st < IT_MOE;
            if (more) { tn = moe_item(F, a.in[28], a.in[29], a.in[30], l, it + st); titem_load(tn, nxt, F.lane); }
            titem_store(tc, cur, scr, F.lane);
            if (more) { tc = tn;
#pragma unroll
                for (int i = 0; i < 16; ++i) cur[i] = nxt[i]; }
        }
#ifdef DBL_CONV
        }
#endif
        return;
    }
#endif
    LAS float* rpbl = (LAS float*)(F.lds + CVW * 64 * 65 * 4);
    { const float* rpb = a.in[5] + (size_t)l * AH * (2 * KH - 1) * (2 * KW - 1);
#pragma unroll 6
      for (int i = F.tid; i < AH * (2 * KH - 1) * (2 * KW - 1); i += NTHREADS) rpbl[i] = rpb[i] * LOG2E; }
    __syncthreads();
    if (F.wave < CVW) {
        LAS float* scr = (LAS float*)F.lds + F.wave * (64 * 65);
#ifdef CONV_G1
        const int it0 = F.G == 256 ? N1 : 0;
#else
        const int it0 = 0;
#endif
        f32x4 cur[16], nxt[16]; const int st = (F.G - NSCAN) * CVW; int it = it0 + (F.bx - NSCAN) * CVW + F.wave; TItem tc{}, tn{};
#ifndef CONV_PAIR
        if (it < IT_MOE) { tc = moe_item(F, a.in[28], a.in[29], a.in[30], l, it); titem_load(tc, cur, F.lane); }
        CONV_PREWAIT();
#endif
#ifdef DBL_CONV
        for (int rep = 0; rep < 2; ++rep) { it = (F.bx - NSCAN) * CVW + F.wave; if (it < IT_MOE) { tc = moe_item(F, a.in[28], a.in[29], a.in[30], l, it); titem_load(tc, cur, F.lane); }
#endif
#ifdef CONV_PAIR
        for (int pr = it; pr < IT_MOE / 2; pr += st) {
            tc = moe_item(F, a.in[28], a.in[29], a.in[30], l, 2 * pr); tn = moe_item(F, a.in[28], a.in[29], a.in[30], l, 2 * pr + 1);
#pragma unroll
            for (int i = 0; i < 16; ++i) { cur[i] = *(const f32x4*)(tc.src + (size_t)(4 * i + (F.lane >> 4)) * tc.ldw + 4 * (F.lane & 15)); nxt[i] = *(const f32x4*)(tn.src + (size_t)(4 * i + (F.lane >> 4)) * tn.ldw + 4 * (F.lane & 15)); }
            titem_store(tc, cur, scr, F.lane); titem_store(tn, nxt, scr, F.lane);
        }
        it = IT_MOE;
#endif
        for (; it < IT_MOE; it += st) {
            const bool more = it + st < IT_MOE;
#ifdef CONV_SINGLE
            titem_store(tc, cur, scr, F.lane);
            if (more) { tc = moe_item(F, a.in[28], a.in[29], a.in[30], l, it + st); titem_load(tc, cur, F.lane); }
            continue;
#endif
            if (more) { tn = moe_item(F, a.in[28], a.in[29], a.in[30], l, it + st); titem_load(tn, nxt, F.lane); }
            titem_store(tc, cur, scr, F.lane);
            if (more) { tc = tn;
#pragma unroll
                for (int i = 0; i < 16; ++i) cur[i] = nxt[i]; }
        }
#ifdef DBL_CONV
        }
#endif
    } else {
        const int aw = (F.bx - NSCAN) * (NWAVES - CVW) + (F.wave - CVW), naw = NATTW;
#ifdef ATT_XCD
        if (F.G == 256) {
            constexpr int NW5 = NWAVES - CVW, NBX = (256 - NSCAN) / 8, NWX = NBX * NW5, UPX = NB * ROWS * AH / 8, REM = UPX - NWX, PER = (REM + NBX - 1) / NBX;
            const int x = F.bx & 7, k = (F.bx - NSCAN) >> 3, w5 = F.wave - CVW;
            { const int v = (x & 3) * UPX + k * NW5 + w5; attn_unit(F, rpbl, (((x >> 2) * ROWS) + (v & (ROWS - 1))) * AH + (v >> 7)); }
            if (w5 < PER && k * PER + w5 < REM) { const int v = (x & 3) * UPX + NWX + k * PER + w5; attn_unit(F, rpbl, (((x >> 2) * ROWS) + (v & (ROWS - 1))) * AH + (v >> 7)); }
        } else
#endif
        for (int au = aw; au < NB * ROWS * AH; au += naw) attn_unit(F, rpbl, au);
#ifdef DBL_ATTN
        for (int au = aw; au < NB * ROWS * AH; au += naw) attn_unit(F, rpbl, au);
#endif
        for (int pu = aw; pu < NB * (S / 32) * 4; pu += naw) pool_unit(F, a.in[17] + (size_t)l * NG * 64 * 64, a.in[18] + (size_t)l * CW, pu);
    }
}
DI void p_rwkv_out(const Frame& F, const Args& a, int l) {
    const RwP P = make_rwp(a, l);
    for (int du = F.gw; du < NB * BH * NCH * 4; du += F.ngw) rwkv_out_unit(F, P, du);
}
DI void p_gemm2(const Frame& F, int l) {
    pg8::PlainOrder S; S.init((const bf16_t*)(F.ws + WS_CONCAT), (const bf16_t*)(F.ws + WS_WOUT) + (size_t)l * D * D, T, D, D, F.G, F.bx);
    pg8::EpiStore E{(bf16_t*)(F.ws + WS_MIX), D, nullptr, 0};
    pg8::gemm_phase(F.lds, F.tid, D, S, E);
}
DI void p_moe_a(const Frame& F, int l) {
    LAS int* tb = (LAS int*)(F.lds + LDS_MISC);
    build_tables(F, l, tb);
    pg8::GroupedOrderT<true> S; S.rowtok = (const int*)(F.ws + WS_CTL + WS_SLOTTOK); S.A = (const bf16_t*)(F.ws + WS_U); S.Bt = (const bf16_t*)(F.ws + WS_WGU); S.K = D; S.estride = (size_t)D * D; S.tile_e = tb + 66; S.ntiles = tb[65]; S.nwg = S.ntiles * 4; S.G = F.G; S.c = F.bx;
#ifdef FUSE_MOE
    S.flags = (unsigned*)(F.ws + WS_CTL) + CW_MFL + l * 256;
#endif
    pg8::EpiSwiGlu E{(bf16_t*)(F.ws + WS_HM)};
    pg8::gemm_phase(F.lds, F.tid, D, S, E);
}
DI void p_moe_b(const Frame& F, int l) {
    LAS int* tb = (LAS int*)(F.lds + LDS_MISC);
    build_tables(F, l, tb);
#ifdef FUSE_MOE
    pg8::GroupedOrderB S; S.flags = (unsigned*)(F.ws + WS_CTL) + CW_MFL + l * 256;
#else
    pg8::GroupedOrderT<false> S;
#endif
    S.rowtok = nullptr; S.A = (const bf16_t*)(F.ws + WS_HM); S.Bt = (const bf16_t*)(F.ws + WS_WD); S.K = DE; S.estride = (size_t)D * DE; S.tile_e = tb + 66; S.ntiles = tb[65]; S.nwg = S.ntiles * 4; S.G = F.G; S.c = F.bx;
    pg8::EpiRowScale E{(bf16_t*)(F.ws + WS_YS), (const float*)(F.ws + WS_SLOTW)};
    pg8::gemm_phase(F.lds, F.tid, DE, S, E);
}

#ifndef DBLMASK
#define DBLMASK 0
#endif
constexpr int PH_PER_LAYER = 10, N_PHASES = 2 + L * PH_PER_LAYER;
DI bool in_ph(int k, int lo, int hi) { lo = __builtin_amdgcn_readfirstlane(lo); hi = __builtin_amdgcn_readfirstlane(hi); asm volatile("" : "+s"(lo), "+s"(hi)); return lo <= k && k < hi; }
DI Frame fresh(const Frame& F0) {
    Frame F = F0; int t = F0.tid, b = F0.bx;
    b = __builtin_amdgcn_readfirstlane(b); asm volatile("" : "+v"(t)); asm volatile("" : "+s"(b));
    F.tid = t; F.lane = t & 63; F.wave = __builtin_amdgcn_readfirstlane(t >> 6); F.bx = b;
    F.vcu = (F.G % 8 == 0) ? (b % 8) * (F.G / 8) + b / 8 : b; F.gw = F.vcu * NWAVES + F.wave;
    return F;
}

__global__ void __launch_bounds__(NTHREADS, 2) mk_fwd(Args a) {
    extern __shared__ __attribute__((aligned(16))) unsigned char lds_raw[];
    Frame F;
    F.lds = (LAS unsigned char*)lds_raw;
    F.tid = threadIdx.x; F.lane = F.tid & 63; F.wave = __builtin_amdgcn_readfirstlane(F.tid >> 6);
    F.G = gridDim.x; F.bx = blockIdx.x; { const int bx = blockIdx.x; F.vcu = (F.G % 8 == 0) ? (bx % 8) * (F.G / 8) + bx / 8 : bx; }
    F.gw = F.vcu * NWAVES + F.wave; F.ngw = F.G * NWAVES; F.ws = a.ws;
    volatile LAS unsigned* bst = (volatile LAS unsigned*)(F.lds + LDS_BARST);
    if (F.tid < 16) bst[F.tid] = 0u;
    __syncthreads();
    cg::grid_group grid = cg::this_grid();
    XcdBarrier bar; bar.bar = (unsigned*)(a.ws + WS_CTL) + CW_BAR; bar.x = 0; bar.st = bst;
    const bool multi = (a.ph_hi - a.ph_lo) > 1;
    if (multi && !a.use_cg) bar = xcd_barrier_post((unsigned*)(a.ws + WS_CTL) + CW_BAR, bst);
    const int lo = a.ph_lo, hi = a.ph_hi;
#ifdef TSTAMP
#define STAMP(k) do { if (blockIdx.x == 0 && threadIdx.x == 0) ((unsigned long long*)(a.ws + WS_CTL + 40960))[k] = wall_clock64(); } while (0)
#else
#define STAMP(k) do { } while (0)
#endif
    STAMP(0);
#define IN(k) in_ph((k), lo, hi)
#ifndef DBLSEAM
#define DBLSEAM 0
#endif
#define SEAM(k) do { if (IN(k) && IN((k) + 1)) { if (a.use_cg) grid.sync(); else { xcd_barrier(bar); if (DBLSEAM) xcd_barrier(bar); } } STAMP((k) + 1); } while (0)
    if (IN(0)) { p0_prologue(fresh(F), a); if ((DBLMASK >> 11) & 1) p0_prologue(fresh(F), a); }
    SEAM(0);
    if (IN(1)) { p_r0(fresh(F), a.in[0]); if ((DBLMASK >> 12) & 1) p_r0(fresh(F), a.in[0]); }
    SEAM(1);
#ifdef FUSE_MOE
#define SEAM_MOE(k) do { } while (0)
#else
#define SEAM_MOE(k) SEAM(k)
#endif
#define RUN(k, call) do { if (IN(pb + (k))) { call; if ((DBLMASK >> (k)) & 1) { call; } } } while (0)
#define LAYER(l) do { \
        const int pb = 2 + PH_PER_LAYER * (l); \
        RUN(0, p_gemm1(fresh(F), a, (l))); \
        SEAM(pb + 0); \
        RUN(1, p_mixer_local(fresh(F), a, (l))); \
        SEAM(pb + 1); \
        RUN(2, p_scan(fresh(F), a, (l))); \
        SEAM(pb + 2); \
        RUN(3, p_rwkv_out(fresh(F), a, (l))); \
        SEAM(pb + 3); \
        RUN(4, p_gemm2(fresh(F), (l))); \
        SEAM(pb + 4); \
        RUN(5, p_rowpass1(fresh(F), a, (l), (l) == 0 ? a.in[0] : a.out)); \
        if (IN(pb + 5) && ((DBLMASK >> 10) & 1)) p_rowpass1(fresh(F), a, (l), (l) == 0 ? a.in[0] : a.out, true); \
        SEAM(pb + 5); \
        RUN(6, p_gather(fresh(F), (l))); \
        SEAM(pb + 6); \
        RUN(7, p_moe_a(fresh(F), (l))); \
        SEAM_MOE(pb + 7); \
        RUN(8, p_moe_b(fresh(F), (l))); \
        SEAM(pb + 8); \
        RUN(9, p_rowpass2(fresh(F), a, (l), a.out)); \
        SEAM(pb + 9); \
    } while (0)
    LAYER(0);
    LAYER(1);
#undef LAYER
#undef IN
#undef SEAM
}

#ifndef MK_MODE
#define MK_MODE 0
#endif
#ifndef TESTMODE
#define TESTMODE 0
#endif

static void fill_args(Args& a, void* const* d_in, void* d_out, void* d_ws) {
    for (int i = 0; i < 31; ++i) a.in[i] = (const float*)d_in[i];
    a.out = (float*)d_out; a.ws = (unsigned char*)d_ws; a.ph_lo = 0; a.ph_hi = N_PHASES; a.use_cg = 0; a.pad = 0;
}
static void launch_phases(Args a, int lo, int hi, hipStream_t stream) {
    for (int p = lo; p < hi; ++p) { a.ph_lo = p; a.ph_hi = p + 1; hipLaunchKernelGGL(mk_fwd, dim3(256), dim3(NTHREADS), LDS_BYTES, stream, a); }
}

#if TESTMODE == 0
extern "C" void kernel_launch(void* const* d_in, const int* in_sizes, int n_in, void* d_out, int out_size, void* d_ws, size_t ws_size, hipStream_t stream) {
    static int grid = 0;
    if (grid == 0) {
        int dev = 0, cus = 0, per_cu = 0;
        (void)hipGetDevice(&dev); (void)hipDeviceGetAttribute(&cus, hipDeviceAttributeMultiprocessorCount, dev);
        (void)hipFuncSetAttribute((const void*)mk_fwd, hipFuncAttributeMaxDynamicSharedMemorySize, LDS_BYTES);
        (void)hipOccupancyMaxActiveBlocksPerMultiprocessor(&per_cu, (const void*)mk_fwd, NTHREADS, LDS_BYTES);
        (void)hipGetLastError();
        grid = (cus > 0 ? cus : 256) * 1;
        if (ws_size < WS_END || n_in != 31) grid = -1;
    }
    if (grid < 0) return;
    (void)hipMemsetAsync((char*)d_ws + WS_CTL, 0, CTL_BYTES, stream);
    Args a{}; fill_args(a, d_in, d_out, d_ws);
#if MK_MODE == 2
    launch_phases(a, 0, N_PHASES, stream);
#else
    a.use_cg = (MK_MODE == 1) ? 1 : 0;
    void* args[] = {&a};
    (void)hipLaunchCooperativeKernel((const void*)mk_fwd, dim3(grid), dim3(NTHREADS), args, LDS_BYTES, stream);
#endif
}
#endif

#if TESTMODE > 0
constexpr int O_A = 1152, O_B = 2304, O_W = 2336, O_AL = 2368, O_G = 2432;
struct HSrc { const bf16_t* HB; const bf16_t* VT;
    DI float at(size_t tok, int n) const { if (n < 768) return bf2f(HB[tok * HW + n]); if (n < 1152) return bf2f(VT[(size_t)(n - 768) * T + tok]); return bf2f(HB[tok * HW + n - 384]); } };
DI float sigm_n(float x) { return 1.f / (1.f + expf(-x)); }

__global__ void k_mod_n(const float* __restrict__ c, const float* __restrict__ w_mod, const float* __restrict__ b_mod, float* __restrict__ mod) {
    __shared__ float sc[NB * D];
    for (int i = threadIdx.x; i < NB * D; i += blockDim.x) { float v = c[i]; sc[i] = v * sigm_n(v); }
    __syncthreads();
    int idx = blockIdx.x * blockDim.x + threadIdx.x; int l = idx / MODW, n = idx % MODW;
    const float* w = w_mod + (size_t)l * D * MODW + n; float a0 = 0.f, a1 = 0.f;
    for (int k = 0; k < D; ++k) { float wv = w[(size_t)k * MODW]; a0 += sc[k] * wv; a1 += sc[D + k] * wv; }
    float bb = b_mod[l * MODW + n];
    mod[(size_t)(l * NB + 0) * MODW + n] = a0 + bb; mod[(size_t)(l * NB + 1) * MODW + n] = a1 + bb;
}
__global__ void k_ln_mod_n(const float* __restrict__ xin, const float* __restrict__ modl, int off_sh, int off_sc, float* __restrict__ uout) {
    int row = (blockIdx.x * blockDim.x + threadIdx.x) >> 6, lane = threadIdx.x & 63; if (row >= T) return; int b = row / S;
    f32x4 v[4];
#pragma unroll
    for (int j = 0; j < 4; ++j) v[j] = *(const f32x4*)(xin + (size_t)row * D + 4 * lane + 256 * j);
    float mean, rstd; row_ln(v, mean, rstd);
    const float* md = modl + (size_t)b * MODW;
#pragma unroll
    for (int j = 0; j < 4; ++j) { int col = 4 * lane + 256 * j; *(f32x4*)(uout + (size_t)row * D + col) = v[j] * rstd * (1.f + *(const f32x4*)(md + off_sc + col)) + *(const f32x4*)(md + off_sh + col); }
}
__global__ void k_post_n(const float* xin, const float* br, const float* __restrict__ modl, int off_gate, const float* __restrict__ gain, const float* __restrict__ bias, float* xout, float* u2out, int off_sh2, int off_sc2) {
    int row = (blockIdx.x * blockDim.x + threadIdx.x) >> 6, lane = threadIdx.x & 63; if (row >= T) return; int b = row / S;
    const float* md = modl + (size_t)b * MODW; f32x4 v[4];
#pragma unroll
    for (int j = 0; j < 4; ++j) { int col = 4 * lane + 256 * j; v[j] = *(const f32x4*)(xin + (size_t)row * D + col) * ALPHA + *(const f32x4*)(md + off_gate + col) * *(const f32x4*)(br + (size_t)row * D + col); }
    float mean, rstd; row_ln(v, mean, rstd);
#pragma unroll
    for (int j = 0; j < 4; ++j) { int col = 4 * lane + 256 * j; v[j] = v[j] * rstd * *(const f32x4*)(gain + col) + *(const f32x4*)(bias + col); *(f32x4*)(xout + (size_t)row * D + col) = v[j]; }
    if (u2out == nullptr) return;
    row_ln(v, mean, rstd);
#pragma unroll
    for (int j = 0; j < 4; ++j) { int col = 4 * lane + 256 * j; *(f32x4*)(u2out + (size_t)row * D + col) = v[j] * rstd * (1.f + *(const f32x4*)(md + off_sc2 + col)) + *(const f32x4*)(md + off_sh2 + col); }
}
__global__ void __launch_bounds__(256) k_gemm_f32(const float* __restrict__ A, int lda, const float* __restrict__ B, int ldb, float* __restrict__ C, int ldc, int K) {
    __shared__ float As[16][65]; __shared__ float Bs[16][64];
    const int tx = threadIdx.x & 15, ty = threadIdx.x >> 4; const int m0 = blockIdx.y * 64, n0 = blockIdx.x * 64;
    float acc[4][4];
#pragma unroll
    for (int i = 0; i < 4; ++i)
#pragma unroll
        for (int j = 0; j < 4; ++j) acc[i][j] = 0.f;
    for (int k0 = 0; k0 < K; k0 += 16) {
#pragma unroll
        for (int i = 0; i < 4; ++i) { int e = threadIdx.x + 256 * i; int m = e >> 4, k = e & 15; As[k][m] = A[(size_t)(m0 + m) * lda + k0 + k]; }
#pragma unroll
        for (int i = 0; i < 4; ++i) { int e = threadIdx.x + 256 * i; int k = e >> 6, n = e & 63; Bs[k][n] = B[(size_t)(k0 + k) * ldb + n0 + n]; }
        __syncthreads();
#pragma unroll
        for (int k = 0; k < 16; ++k) { float a[4], b[4];
#pragma unroll
            for (int i = 0; i < 4; ++i) { a[i] = As[k][ty * 4 + i]; b[i] = Bs[k][tx * 4 + i]; }
#pragma unroll
            for (int i = 0; i < 4; ++i)
#pragma unroll
                for (int j = 0; j < 4; ++j) acc[i][j] += a[i] * b[j]; }
        __syncthreads();
    }
#pragma unroll
    for (int i = 0; i < 4; ++i) *(float4*)(C + (size_t)(m0 + ty * 4 + i) * ldc + n0 + tx * 4) = make_float4(acc[i][0], acc[i][1], acc[i][2], acc[i][3]);
}
__global__ void __launch_bounds__(64) k_attn_n(HSrc h, const float* __restrict__ rpb, float* __restrict__ concat) {
    int idx = blockIdx.x * blockDim.x + threadIdx.x; if (idx >= T * AH) return;
    int head = idx % AH, tok = idx / AH; int b = tok / S, t = tok % S, r = t / GW, cq = t % GW;
    int rstart = r - KH / 2; rstart = rstart < 0 ? 0 : (rstart > ROWS - KH ? ROWS - KH : rstart);
    int cstart = cq - KW / 2; cstart = cstart < 0 ? 0 : (cstart > GW - KW ? GW - KW : cstart);
    float q[HD], acc[HD];
#pragma unroll
    for (int d = 0; d < HD; ++d) { q[d] = h.at(tok, head * HD + d); acc[d] = 0.f; }
    float m = -1e30f, l = 0.f; const float* rp = rpb + (size_t)head * 15 * 31;
    for (int kk = 0; kk < KH; ++kk) { int kr = rstart + kk; int dr = kr - r + (KH - 1);
        for (int j = 0; j < KW; ++j) { int ck = cstart + j; int dc = ck - cq; dc = dc < -15 ? -15 : (dc > 15 ? 15 : dc); dc += 15;
            size_t kt = (size_t)b * S + kr * GW + ck; float s = 0.f;
#pragma unroll
            for (int d = 0; d < HD; ++d) s += q[d] * h.at(kt, AW + head * HD + d);
            s = s * 0.125f + rp[dr * 31 + dc];
            float mn = fmaxf(m, s); float corr = expf(m - mn); float p = expf(s - mn); l = l * corr + p;
#pragma unroll
            for (int d = 0; d < HD; ++d) acc[d] = acc[d] * corr + p * h.at(kt, 2 * AW + head * HD + d);
            m = mn; } }
    float inv = 1.f / l;
#pragma unroll
    for (int d = 0; d < HD; ++d) concat[(size_t)tok * D + head * HD + d] = acc[d] * inv;
}
__global__ void __launch_bounds__(256) k_pool_n(HSrc h, const float* __restrict__ pool_w, const float* __restrict__ pool_scale, float* __restrict__ concat) {
    __shared__ float pooled[CW];
    int tok = blockIdx.x; int b = tok / S, t = tok % S; int ch = threadIdx.x; int g = ch / 64; int win = 2 << g;
    int lo = t - win / 2; lo = lo < 0 ? 0 : lo; int hi = t + win / 2 - 1; hi = hi > S - 1 ? S - 1 : hi;
    float s = 0.f; for (int u = lo; u <= hi; ++u) s += h.at((size_t)b * S + u, O_G + ch);
    pooled[ch] = s / (float)(hi - lo + 1) - h.at(tok, O_G + ch);
    __syncthreads();
    int e = ch % 64; const float* pw = pool_w + (size_t)g * 64 * 64 + e; float a = 0.f;
    for (int c2 = 0; c2 < 64; ++c2) a += pooled[g * 64 + c2] * pw[c2 * 64];
    concat[(size_t)tok * D + AW + BW + ch] = a * pool_scale[ch];
}
__global__ void __launch_bounds__(64) k_rwkv_scan_n(HSrc h, RwP p, float* __restrict__ ys) {
    const int lane = threadIdx.x; const int dir = blockIdx.x / (NB * BH), b = (blockIdx.x / BH) % NB, hd = blockIdx.x % BH; const int ch = hd * HD + lane;
    float st[HD];
#pragma unroll
    for (int j = 0; j < HD; ++j) st[j] = 0.f;
    float wup[RW], aup[RA];
#pragma unroll
    for (int m = 0; m < RW; ++m) { wup[m] = p.w_up[(size_t)(dir * RW + m) * BW + ch]; aup[m] = p.a_up[(size_t)(dir * RA + m) * BW + ch]; }
    const float w0 = p.w0[dir * BW + ch], a0 = p.a0[dir * BW + ch], kkw = p.k_k[ch], kaw = p.k_a[ch];
    float cr[3], ck[3], cv[3];
#pragma unroll
    for (int x = 0; x < 3; ++x) { cr[x] = p.conv[x * 3 * BW + ch]; ck[x] = p.conv[x * 3 * BW + BW + ch]; cv[x] = p.conv[x * 3 * BW + 2 * BW + ch]; }
    for (int step = 0; step < S; ++step) {
        const int t = dir ? (S - 1 - step) : step; const size_t row = (size_t)b * S + t;
        float r = 0.f, k = 0.f, v = 0.f;
#pragma unroll
        for (int x = 0; x < 3; ++x) { int tt = t + x - 1; if (tt >= 0 && tt < S) { size_t rr = (size_t)b * S + tt; r += h.at(rr, O_A + ch) * cr[x]; k += h.at(rr, O_A + BW + ch) * ck[x]; v += h.at(rr, O_A + 2 * BW + ch) * cv[x]; } }
        float lv = h.at(row, O_B + lane); float lt = lane < RW ? tanhf(lv) : lv; float zw = w0, za = a0;
#pragma unroll
        for (int m = 0; m < RW; ++m) { zw += __shfl(lt, m) * wup[m]; za += __shfl(lt, RW + m) * aup[m]; }
        const float w = expf(-DECAY * sigm_n(zw)); const float a = sigm_n(za);
        float kk = k * kkw; float ss = wave_sum(kk * kk); kk = kk * (1.f / sqrtf(fmaxf(ss, 1e-24f)));
        const float kd = k * (1.f + (a - 1.f) * kaw); const float kka = kk * a;
        float sa = 0.f;
#pragma unroll
        for (int j = 0; j < HD; ++j) sa += st[j] * (-__shfl(kk, j));
        float y = 0.f;
#pragma unroll
        for (int j = 0; j < HD; ++j) { st[j] = st[j] * __shfl(w, j) + sa * __shfl(kka, j) + v * __shfl(kd, j); y += st[j] * __shfl(r, j); }
        ys[((size_t)dir * T + b * S + t) * BW + ch] = y;
    }
}
__global__ void __launch_bounds__(384) k_rwkv_finish_n(HSrc h, RwP p, const float* __restrict__ ys, float* __restrict__ concat) {
    __shared__ float lw[RW], la[RA], sg[RG];
    const int tok = blockIdx.x, b = tok / S, t = tok % S, ch = threadIdx.x, hd = ch / HD, j = ch % HD;
    if (ch < RW) lw[ch] = tanhf(h.at(tok, O_B + ch)); else if (ch < RW + RA) la[ch - RW] = h.at(tok, O_W + (ch - RW)); else if (ch < RW + RA + RG) sg[ch - RW - RA] = sigm_n(h.at(tok, O_AL + (ch - RW - RA)));
    __syncthreads();
    float r = 0.f, k = 0.f, v = 0.f;
#pragma unroll
    for (int x = 0; x < 3; ++x) { int tt = t + x - 1; if (tt >= 0 && tt < S) { size_t rr = (size_t)b * S + tt;
        r += h.at(rr, O_A + ch) * p.conv[x * 3 * BW + ch]; k += h.at(rr, O_A + BW + ch) * p.conv[x * 3 * BW + BW + ch]; v += h.at(rr, O_A + 2 * BW + ch) * p.conv[x * 3 * BW + 2 * BW + ch]; } }
    float bon = 0.f;
    for (int dir = 0; dir < 2; ++dir) { float za = p.a0[dir * BW + ch]; for (int m = 0; m < RA; ++m) za += la[m] * p.a_up[(size_t)(dir * RA + m) * BW + ch];
        float a = sigm_n(za); float kd = k * (1.f + (a - 1.f) * p.k_a[ch]); bon += wave_sum(r * kd * p.r_k[hd * HD + j]); }
    bon *= v;
    float y = ys[(size_t)tok * BW + ch] + ys[((size_t)T + tok) * BW + ch];
    float mu = wave_sum(y) * (1.f / HD); float dy = y - mu; float var = wave_sum(dy * dy) * (1.f / HD);
    float yn = dy * (1.f / sqrtf(var + GN_EPS)) * p.gn_gain[ch] + p.gn_bias[ch];
    float g = 0.f; for (int m = 0; m < RG; ++m) g += sg[m] * p.g_up[(size_t)m * BW + ch];
    concat[(size_t)tok * D + AW + ch] = (yn + bon) * g;
}
__global__ void __launch_bounds__(256) k_moe_n(const float* __restrict__ u2, const int* __restrict__ tokslot, const float* __restrict__ ew,
                                                const float* __restrict__ wgate, const float* __restrict__ wup, const float* __restrict__ wdown, float* __restrict__ f) {
    __shared__ float xs[D]; __shared__ float hb[DE];
    const int tok = blockIdx.x, tid = threadIdx.x;
    for (int i = tid; i < D; i += 256) xs[i] = u2[(size_t)tok * D + i];
    float o[4] = {0.f, 0.f, 0.f, 0.f};
    for (int kk = 0; kk < 2; ++kk) {
        const int ts = tokslot[tok * 2 + kk]; const int e = ts >> 14; const float wt = ew[ts];
        __syncthreads();
        const float* g = wgate + (size_t)e * D * DE; const float* u = wup + (size_t)e * D * DE;
        float ag0 = 0.f, ag1 = 0.f, au0 = 0.f, au1 = 0.f;
        for (int k = 0; k < D; ++k) { float x = xs[k]; ag0 += x * g[(size_t)k * DE + tid]; ag1 += x * g[(size_t)k * DE + 256 + tid]; au0 += x * u[(size_t)k * DE + tid]; au1 += x * u[(size_t)k * DE + 256 + tid]; }
        hb[tid] = ag0 * sigm_n(ag0) * au0; hb[256 + tid] = ag1 * sigm_n(ag1) * au1;
        __syncthreads();
        const float* dn = wdown + (size_t)e * DE * D; float a[4] = {0.f, 0.f, 0.f, 0.f};
        for (int k = 0; k < DE; ++k) { float x = hb[k];
#pragma unroll
            for (int j = 0; j < 4; ++j) a[j] += x * dn[(size_t)k * D + tid + 256 * j]; }
#pragma unroll
        for (int j = 0; j < 4; ++j) o[j] += a[j] * wt;
    }
#pragma unroll
    for (int j = 0; j < 4; ++j) f[(size_t)tok * D + tid + 256 * j] = o[j];
}

__global__ void k_router_n(const float* __restrict__ u2, const float* __restrict__ wg, const float* __restrict__ bg, const float* __restrict__ we, const float* __restrict__ be, int* __restrict__ tok_e) {
    int row = (blockIdx.x * blockDim.x + threadIdx.x) >> 6, lane = threadIdx.x & 63; if (row >= T) return;
    float gl[NG], el[NE];
#pragma unroll
    for (int n = 0; n < NG; ++n) gl[n] = 0.f;
#pragma unroll
    for (int n = 0; n < NE; ++n) el[n] = 0.f;
    for (int i = 0; i < 16; ++i) { int k = lane + 64 * i; float x = u2[(size_t)row * D + k];
#pragma unroll
        for (int n = 0; n < NG; ++n) gl[n] += x * wg[k * NG + n];
#pragma unroll
        for (int n = 0; n < NE; ++n) el[n] += x * we[k * NE + n]; }
#pragma unroll
    for (int n = 0; n < NG; ++n) gl[n] = wave_sum(gl[n]) + bg[n];
#pragma unroll
    for (int n = 0; n < NE; ++n) el[n] = wave_sum(el[n]) + be[n];
    int gi = 0; float gm = gl[0];
#pragma unroll
    for (int n = 1; n < NG; ++n) if (gl[n] > gm) { gm = gl[n]; gi = n; }
    float l1 = -3.0e38f, l2 = -3.0e38f; int i1 = 0, i2 = 0;
#pragma unroll
    for (int n = 0; n < NE; ++n) if ((n >> 3) == gi) { float v = el[n]; int e = n & 7; if (v > l1) { l2 = l1; i2 = i1; l1 = v; i1 = e; } else if (v > l2) { l2 = v; i2 = e; } }
    if (lane == 0) { tok_e[row * 2] = gi * EPG + i1; tok_e[row * 2 + 1] = gi * EPG + i2; }
}
__global__ void k_cmp_route(const int* __restrict__ tokslot, const int* __restrict__ tok_e, float* acc, int slot) {
    float mis = 0.f, tot = 0.f;
    for (int t = blockIdx.x * blockDim.x + threadIdx.x; t < T; t += gridDim.x * blockDim.x) { const int a0 = tokslot[2 * t] >> 14, a1 = tokslot[2 * t + 1] >> 14;
        mis += (a0 != tok_e[2 * t] || a1 != tok_e[2 * t + 1]) ? 1.f : 0.f; tot += 1.f; }
    mis = wave_sum(mis); tot = wave_sum(tot);
    if ((threadIdx.x & 63) == 0) { atomicAdd(acc + 2 * slot, mis); atomicAdd(acc + 2 * slot + 1, tot); }
}
__global__ void k_bf2f(const bf16_t* __restrict__ src, float* __restrict__ dst, size_t n) { for (size_t i = (size_t)blockIdx.x * blockDim.x + threadIdx.x; i < n; i += (size_t)gridDim.x * blockDim.x) dst[i] = bf2f(src[i]); }
template <class TA> __global__ void k_cmp(const TA* __restrict__ a, size_t lda, const float* __restrict__ b, size_t ldb, int rows, int cols, float* acc, int slot) {
    float d2 = 0.f, r2 = 0.f;
    for (size_t i = (size_t)blockIdx.x * blockDim.x + threadIdx.x; i < (size_t)rows * cols; i += (size_t)gridDim.x * blockDim.x) {
        const size_t r = i / cols, c = i % cols; float av; if constexpr (sizeof(TA) == 2) av = bf2f(a[r * lda + c]); else av = a[r * lda + c];
        const float bv = b[r * ldb + c]; d2 += (av - bv) * (av - bv); r2 += bv * bv; }
    d2 = wave_sum(d2); r2 = wave_sum(r2);
    if ((threadIdx.x & 63) == 0) { atomicAdd(acc + 2 * slot, d2); atomicAdd(acc + 2 * slot + 1, r2); }
}
__global__ void k_cmp_vt(const bf16_t* __restrict__ vt, const float* __restrict__ b, size_t ldb, float* acc, int slot) {
    float d2 = 0.f, r2 = 0.f;
    for (size_t i = (size_t)blockIdx.x * blockDim.x + threadIdx.x; i < (size_t)T * AW; i += (size_t)gridDim.x * blockDim.x) {
        const size_t r = i % T, c = i / T; const float av = bf2f(vt[c * T + r]), bv = b[r * ldb + c]; d2 += (av - bv) * (av - bv); r2 += bv * bv; }
    d2 = wave_sum(d2); r2 = wave_sum(r2);
    if ((threadIdx.x & 63) == 0) { atomicAdd(acc + 2 * slot, d2); atomicAdd(acc + 2 * slot + 1, r2); }
}
struct Tols { float t[8]; int n; };
__global__ void k_readout(float* out, const float* acc, Tols tl, int total) {
    float mx = 0.f; int am = 0; for (int k = 0; k < tl.n; ++k) { float e = sqrtf(acc[2 * k] / fmaxf(acc[2 * k + 1], 1e-30f)); if (!(e == e)) e = 1e3f; if (e / tl.t[k] > mx) { mx = e / tl.t[k]; am = k; } }
    const float cval = sqrtf(1000.f * mx);
    for (int i = blockIdx.x * blockDim.x + threadIdx.x; i < total; i += gridDim.x * blockDim.x) out[i] = (i < 8) ? 1000.f * (float)(am + 1) : cval;
}
__global__ void __launch_bounds__(256) k_moe_chk(const float* __restrict__ u2, const int* __restrict__ tokslot, const float* __restrict__ ew, const unsigned* __restrict__ cnt,
                                                  const float* __restrict__ wgate, const float* __restrict__ wup, const float* __restrict__ wdown,
                                                  const bf16_t* __restrict__ XS, const bf16_t* __restrict__ HM, const bf16_t* __restrict__ YS, float* acc) {
    __shared__ float xs[D]; __shared__ float hb[DE]; __shared__ int offp[NE];
    const int tok = blockIdx.x, tid = threadIdx.x;
    if (tid == 0) { int off = 0; for (int e = 0; e < NE; ++e) { offp[e] = off; off += (((int)cnt[e] + 255) >> 8) * 256; } }
    for (int i = tid; i < D; i += 256) xs[i] = u2[(size_t)tok * D + i];
    float d0 = 0.f, r0 = 0.f, d1 = 0.f, r1 = 0.f, d2 = 0.f, r2 = 0.f;
    for (int kk = 0; kk < 2; ++kk) {
        __syncthreads();
        const int ts = tokslot[tok * 2 + kk]; const int e = ts >> 14; const float wt = ew[ts]; const size_t slot = (size_t)offp[e] + (ts & 16383);
        for (int i = tid; i < D; i += 256) { const float a = bf2f(XS[slot * D + i]), b = xs[i]; d0 += (a - b) * (a - b); r0 += b * b; }
        const float* g = wgate + (size_t)e * D * DE; const float* u = wup + (size_t)e * D * DE;
        float ag0 = 0.f, ag1 = 0.f, au0 = 0.f, au1 = 0.f;
        for (int k = 0; k < D; ++k) { float x = xs[k]; ag0 += x * g[(size_t)k * DE + tid]; ag1 += x * g[(size_t)k * DE + 256 + tid]; au0 += x * u[(size_t)k * DE + tid]; au1 += x * u[(size_t)k * DE + 256 + tid]; }
        const float h0 = ag0 * sigm_n(ag0) * au0, h1 = ag1 * sigm_n(ag1) * au1;
        hb[tid] = h0; hb[256 + tid] = h1;
        { const float a = bf2f(HM[slot * DE + tid]), b = bf2f(HM[slot * DE + 256 + tid]); d1 += (a - h0) * (a - h0) + (b - h1) * (b - h1); r1 += h0 * h0 + h1 * h1; }
        __syncthreads();
        const float* dn = wdown + (size_t)e * DE * D; float a4[4] = {0.f, 0.f, 0.f, 0.f};
        for (int k = 0; k < DE; ++k) { float x = hb[k];
#pragma unroll
            for (int j = 0; j < 4; ++j) a4[j] += x * dn[(size_t)k * D + tid + 256 * j]; }
#pragma unroll
        for (int j = 0; j < 4; ++j) {
#ifdef MOEB_NOSCALE
            const float y = a4[j];
#else
            const float y = a4[j] * wt;
#endif
            const float a = bf2f(YS[slot * D + tid + 256 * j]); d2 += (a - y) * (a - y); r2 += y * y; }
    }
    d0 = wave_sum(d0); r0 = wave_sum(r0); d1 = wave_sum(d1); r1 = wave_sum(r1); d2 = wave_sum(d2); r2 = wave_sum(r2);
    if ((tid & 63) == 0) { atomicAdd(acc + 0, d0); atomicAdd(acc + 1, r0); atomicAdd(acc + 2, d1); atomicAdd(acc + 3, r1); atomicAdd(acc + 4, d2); atomicAdd(acc + 5, r2); }
}

extern "C" void kernel_launch(void* const* d_in, const int* in_sizes, int n_in, void* d_out, int out_size, void* d_ws, size_t ws_size, hipStream_t stream) {
    static int once = 0; if (!once) { (void)hipFuncSetAttribute((const void*)mk_fwd, hipFuncAttributeMaxDynamicSharedMemorySize, LDS_BYTES); once = 1; }
    (void)hipMemsetAsync((char*)d_ws + WS_CTL, 0, CTL_BYTES, stream);
    Args a{}; fill_args(a, d_in, d_out, d_ws);
    char* ws = (char*)d_ws; float* out = (float*)d_out;
    float* ACC = (float*)(ws + 32768 + 1024);
    const float* x = a.in[0];
    HSrc hs{(const bf16_t*)(ws + WS_HB), (const bf16_t*)(ws + WS_VT)};
    const int l = 0;
    RwP p = { a.in[6], a.in[7], a.in[8], a.in[9], a.in[10], a.in[11], a.in[12], a.in[13], a.in[14], a.in[15], a.in[16] };
    Tols tl{};
#if TESTMODE == 1
    launch_phases(a, 0, 3, stream);
    float* MODn = (float*)(ws + WS_MOD + 512 * 1024); float* Un = (float*)(ws + WS_XA); float* HF = (float*)(ws + WS_CONCAT);
    k_mod_n<<<L * MODW / 256, 256, 0, stream>>>(a.in[1], a.in[2], a.in[3], MODn);
    k_ln_mod_n<<<T / 4, 256, 0, stream>>>(x, MODn, 0, D, Un);
    k_gemm_f32<<<dim3(INW / 64, T / 64), 256, 0, stream>>>(Un, D, a.in[4], INW, HF, INW, D);
    k_cmp<float><<<256, 256, 0, stream>>>((const float*)(ws + WS_MOD), MODW, MODn, MODW, L * NB, MODW, ACC, 0);
    k_cmp<bf16_t><<<1024, 256, 0, stream>>>((const bf16_t*)(ws + WS_U), D, Un, D, T, D, ACC, 1);
    k_cmp<bf16_t><<<1024, 256, 0, stream>>>((const bf16_t*)(ws + WS_HB), HW, HF, INW, T, 768, ACC, 2);
    k_cmp<bf16_t><<<1024, 256, 0, stream>>>((const bf16_t*)(ws + WS_HB) + 768, HW, HF + 1152, INW, T, 1536, ACC, 3);
    k_cmp_vt<<<1024, 256, 0, stream>>>((const bf16_t*)(ws + WS_VT), HF + 768, INW, ACC, 4);
    tl.n = 5; tl.t[0] = 1e-5f; tl.t[1] = 4e-3f; tl.t[2] = 6e-3f; tl.t[3] = 6e-3f; tl.t[4] = 6e-3f;
#elif TESTMODE == 2
    launch_phases(a, 0, 4, stream);
    float* CCn = (float*)(ws + WS_XA); float* YSn = (float*)(ws + WS_WGU);
    k_attn_n<<<T * AH / 64, 64, 0, stream>>>(hs, a.in[5], CCn);
    k_pool_n<<<T, 256, 0, stream>>>(hs, a.in[17], a.in[18], CCn);
    k_rwkv_scan_n<<<2 * NB * BH, 64, 0, stream>>>(hs, p, YSn);
    k_rwkv_finish_n<<<T, 384, 0, stream>>>(hs, p, YSn, CCn);
    launch_phases(a, 4, 6, stream);
    k_cmp<bf16_t><<<1024, 256, 0, stream>>>((const bf16_t*)(ws + WS_CONCAT), D, CCn, D, T, AW, ACC, 0);
    k_cmp<bf16_t><<<1024, 256, 0, stream>>>((const bf16_t*)(ws + WS_CONCAT) + AW, D, CCn + AW, D, T, BW, ACC, 1);
    k_cmp<bf16_t><<<1024, 256, 0, stream>>>((const bf16_t*)(ws + WS_CONCAT) + AW + BW, D, CCn + AW + BW, D, T, CW, ACC, 2);
    tl.n = 3; tl.t[0] = TOL0; tl.t[1] = TOL1; tl.t[2] = TOL2;
#elif TESTMODE == 3
    launch_phases(a, 0, 11, stream);
    { const float* MODf = (const float*)(ws + WS_MOD);
      float* U2f = (float*)(ws + 414 * MiB); float* Fn = (float*)(ws + 213 * MiB); float* X2n = (float*)(ws + 277 * MiB);
      k_bf2f<<<2048, 256, 0, stream>>>((const bf16_t*)(ws + WS_U), U2f, (size_t)T * D);
      launch_phases(a, 11, 12, stream);
      k_moe_n<<<T, 256, 0, stream>>>(U2f, (const int*)(ws + WS_TOKSLOT), (const float*)(ws + WS_EW), a.in[28], a.in[29], a.in[30], Fn);
      k_post_n<<<T / 4, 256, 0, stream>>>((const float*)(ws + WS_XA), Fn, MODf, 5 * D, a.in[22], a.in[23], X2n, nullptr, 0, 0);
      k_cmp<float><<<1024, 256, 0, stream>>>(out, D, X2n, D, T, D, ACC, 0); }
    tl.n = 1; tl.t[0] = TOL0;
#elif TESTMODE == 4
    launch_phases(a, 0, 8, stream);
    { const float* MODf = (const float*)(ws + WS_MOD);
      float* CCn = (float*)(ws + 405 * MiB); float* MIXn = (float*)(ws + 213 * MiB); float* X1n = (float*)(ws + 21 * MiB); float* U2n = (float*)(ws + 333 * MiB); int* TEn = (int*)(ws + 490 * MiB);
      k_bf2f<<<2048, 256, 0, stream>>>((const bf16_t*)(ws + WS_CONCAT), CCn, (size_t)T * D);
      k_gemm_f32<<<dim3(D / 64, T / 64), 256, 0, stream>>>(CCn, D, a.in[19], D, MIXn, D, D);
      k_post_n<<<T / 4, 256, 0, stream>>>(x, MIXn, MODf, 2 * D, a.in[20], a.in[21], X1n, U2n, 3 * D, 4 * D);
      k_router_n<<<T / 4, 256, 0, stream>>>(U2n, a.in[24], a.in[25], a.in[26], a.in[27], TEn);
      k_cmp<float><<<1024, 256, 0, stream>>>((const float*)(ws + WS_XA), D, X1n, D, T, D, ACC, 0);
      k_cmp<bf16_t><<<1024, 256, 0, stream>>>((const bf16_t*)(ws + WS_U), D, U2n, D, T, D, ACC, 1);
      k_cmp_route<<<64, 256, 0, stream>>>((const int*)(ws + WS_TOKSLOT), TEn, ACC, 2); }
    tl.n = 3; tl.t[0] = TOL0; tl.t[1] = TOL1; tl.t[2] = TOL2;
#elif TESTMODE == 5
    launch_phases(a, 0, 11, stream);
    { float* U2f = (float*)(ws + 414 * MiB);
      k_bf2f<<<2048, 256, 0, stream>>>((const bf16_t*)(ws + WS_U), U2f, (size_t)T * D);
      k_moe_chk<<<T, 256, 0, stream>>>(U2f, (const int*)(ws + WS_TOKSLOT), (const float*)(ws + WS_EW), (const unsigned*)(ws + WS_CTL) + CW_CNT, a.in[28], a.in[29], a.in[30],
                                       (const bf16_t*)(ws + WS_XS), (const bf16_t*)(ws + WS_HM), (const bf16_t*)(ws + WS_YS), ACC); }
    tl.n = 3; tl.t[0] = 1e-6f; tl.t[1] = 1e-2f; tl.t[2] = 1e-2f;
#endif
    k_readout<<<256, 256, 0, stream>>>(out, ACC, tl, out_size);
}
#endif
```

```cpp
#define TESTMODE 0
#define MK_MODE 0
#define S0_WRITER 1
#define ATT_XCD 1
#define FUSE_MOE 1
#define MOE_ACQ1 1
#include <hip/hip_runtime.h>
#include <hip/hip_cooperative_groups.h>
#include <stdint.h>
namespace cg = cooperative_groups;

#ifndef TESTMODE
#define TESTMODE 0
#endif
#define DI __device__ __forceinline__
#define LAS __attribute__((address_space(3)))
typedef unsigned short bf16_t;
typedef short bf16x8 __attribute__((ext_vector_type(8)));
typedef float f32x4 __attribute__((ext_vector_type(4)));
typedef float f32x16 __attribute__((ext_vector_type(16)));
typedef unsigned u32x4 __attribute__((ext_vector_type(4)));
typedef unsigned u32x2 __attribute__((ext_vector_type(2)));
typedef float f32x2_t __attribute__((ext_vector_type(2)));
typedef __bf16 bf16x2_t __attribute__((ext_vector_type(2)));

namespace cfg {
constexpr int D = 1024, NB = 2, S = 8192, T = NB * S, L = 2;
constexpr int GW = 64, ROWS = 128;
constexpr int HD = 64, AW = 384, BW = 384, CW = 256, AH = 6, BH = 6;
constexpr int KH = 8, KW = 16;
constexpr int RW = 32, RA = 32, RG = 64;
constexpr int INW = 2688;
constexpr int NG = 4, EPG = 8, NE = 32, DE = 512;
constexpr int MODW = 6 * D;
constexpr float ALPHA = 1.41421356237309515f;
constexpr float LN_EPS = 1e-5f, GN_EPS = 64e-5f;
constexpr float DECAY = 0.60653065971263342f;
constexpr float LOG2E = 1.44269504088896341f;
constexpr int HW = 2304, HQ = 0, HK = 384, HR = 768, HWL = 1920, HAL = 1952, HGL = 1984, HP = 2048;
constexpr int NCH = S / 64;
constexpr int NUNIT = 2 * NB * BH * NCH;
constexpr int XSROWS = 2 * T + NE * 256;
}
using namespace cfg;

constexpr size_t MiB = 1u << 20;
constexpr size_t WS_CTL = 0;
constexpr size_t CTL_BYTES = 262144;
constexpr size_t WS_SLOTTOK = 65536;
constexpr int CW_BAR = 0;
constexpr int CW_MFL = 9216;
constexpr int CW_CNT = 8192;
constexpr size_t WS_MOD = 1 * MiB;
constexpr size_t WS_TOKSLOT = 1 * MiB + 128 * 1024;
constexpr size_t WS_SLOTW = 1 * MiB + 256 * 1024;
constexpr size_t WS_BC = 2 * MiB;
constexpr size_t WS_TOKW = 2 * MiB + 64 * 1024;
constexpr size_t WS_TOKFIN = 2 * MiB + 256 * 1024;
constexpr size_t WS_CNTF = 2 * MiB + 512 * 1024;
constexpr size_t WS_WIN = 6 * MiB;
constexpr size_t WIN_LAYER = (size_t)2816 * 1024 * 2;
constexpr size_t WS_WOUT = 17 * MiB;
constexpr size_t WS_WGU = 21 * MiB;
constexpr size_t WS_WD = 85 * MiB;
constexpr size_t WS_XA = 117 * MiB;
constexpr size_t WS_U = 181 * MiB;
constexpr size_t WS_HB = 213 * MiB;
constexpr size_t WS_S0 = 117 * MiB;
constexpr size_t WS_VT = 285 * MiB;
constexpr size_t WS_CONCAT = 301 * MiB;
constexpr size_t WS_MP = 333 * MiB;
constexpr size_t WS_NB = 358 * MiB;
constexpr size_t WS_MIX = 333 * MiB;
constexpr size_t WS_QT = 405 * MiB;
constexpr size_t WS_WT = 429 * MiB;
constexpr size_t WS_VTB = 453 * MiB;
constexpr size_t WS_GB = 465 * MiB;
constexpr size_t WS_VC = 477 * MiB;
constexpr size_t WS_BS = 489 * MiB;
constexpr size_t WS_XS = 213 * MiB;
constexpr size_t WS_HM = 293 * MiB;
constexpr size_t WS_YS = 333 * MiB;
constexpr size_t WS_END = 490 * MiB;
#ifndef NOSKEW
#define USK(u) ((size_t)(u) + ((size_t)(u) >> 7))
#else
#define USK(u) ((size_t)(u))
#endif

constexpr int NWAVES = 8, NTHREADS = 512;
constexpr int LDS_BYTES = 156 * 1024;

DI unsigned cvtpk(float lo, float hi) { f32x2_t v = {lo, hi}; bf16x2_t b = __builtin_convertvector(v, bf16x2_t); return __builtin_bit_cast(unsigned, b); }
DI float bflo(unsigned w) { return __uint_as_float(w << 16); }
DI float bfhi(unsigned w) { return __uint_as_float(w & 0xffff0000u); }
DI float bf2f(unsigned short h) { return __uint_as_float((unsigned)h << 16); }
DI unsigned short f2bf(float f) { return (unsigned short)(cvtpk(f, 0.f) & 0xffffu); }
DI float wave_sum_shfl(float v) {
#pragma unroll
    for (int o = 32; o > 0; o >>= 1) v += __shfl_xor(v, o);
    return v;
}
template <int CTRL, int ROWMASK> DI float dpp_add(float v) { return v + __builtin_bit_cast(float, __builtin_amdgcn_update_dpp(0, __builtin_bit_cast(int, v), CTRL, ROWMASK, 0xf, false)); }
DI float wave_sum(float v) {
    v = dpp_add<0xb1, 0xf>(v);
    v = dpp_add<0x4e, 0xf>(v);
    v = dpp_add<0x124, 0xf>(v);
    v = dpp_add<0x128, 0xf>(v);
    v = dpp_add<0x142, 0xa>(v);
    v = dpp_add<0x143, 0xc>(v);
    return __builtin_bit_cast(float, __builtin_amdgcn_readlane(__builtin_bit_cast(int, v), 63));
}
DI float fexp2(float x) { return __builtin_amdgcn_exp2f(x); }
DI float frcp(float x) { return __builtin_amdgcn_rcpf(x); }
DI float sigm(float x) { return frcp(1.f + fexp2(x * -LOG2E)); }
#define LDS_WAIT() asm volatile("s_waitcnt lgkmcnt(0)" ::: "memory")
#define VM_WAIT() asm volatile("s_waitcnt vmcnt(0)" ::: "memory")
DI int swap23(int i) { return (i & ~12) | ((i & 4) << 1) | ((i & 8) >> 1); }

namespace pg8 {
constexpr int BM = 256, BK = 64, HALF = 128, HTB = HALF * BK * 2, STAGE_BYTES = 8 * HTB, NXCD = 8, WGM = 8;
__host__ __device__ __forceinline__ int lds_byte(int r, int c) { const int st = (r >> 4) * 2 + (c >> 5), rr = r & 15, cc = c & 31, ob = rr * 64 + cc * 2; return st * 1024 + (ob ^ (((ob >> 9) & 1) << 5)); }
__host__ __device__ __forceinline__ void stage_rc(int b, int& R, int& C) { const int st = b / 1024, sb = b % 1024, swz = sb ^ (((sb >> 9) & 1) << 5); R = (st >> 1) * 16 + swz / 64; C = (st & 1) * 32 + (swz % 64) / 2; }
__host__ __device__ __forceinline__ int perm32(int rho) { const int n = rho >> 4, i = rho & 15; return 8 * (i >> 2) + 4 * n + (i & 3); }

struct Unit { int pm, pn, aux; };

DI int xcd_remap(int L, int nwg) { const int q = nwg / NXCD, r = nwg % NXCD, xcd = L % NXCD, off = L / NXCD; return (xcd < r ? xcd * (q + 1) : r * (q + 1) + (xcd - r) * q) + off; }

struct PlainOrder {
    static constexpr bool GATHER = false, SIGNAL = false, WAIT = false, ACQ1 = false;
    DI void signal(const Unit&) const {} DI void wait(const Unit&) const {}
    const bf16_t* A; const bf16_t* Bt; int K; int nM, nN, nwg, G, c;
    DI void init(const bf16_t* A_, const bf16_t* Bt_, int M, int N, int K_, int G_, int c_) { A = A_; Bt = Bt_; K = K_; nM = M / BM; nN = N / BM; nwg = nM * nN; G = G_; c = c_; }
    DI bool next(int i, Unit& u) const {
        const int Lx = i * G + c; if (Lx >= nwg) return false;
        const int wgid = xcd_remap(Lx, nwg);
        const int nig = WGM * nN, gid = wgid / nig, fm = gid * WGM, gsz = (nM - fm) < WGM ? (nM - fm) : WGM;
        u.pm = fm + ((wgid % nig) % gsz); u.pn = (wgid % nig) / gsz; u.aux = 0; return true;
    }
    DI const char* aptr(const Unit& u) const { return (const char*)A + (size_t)u.pm * (2 * HALF) * K * 2; }
    DI const char* bptr(const Unit& u) const { return (const char*)Bt + (size_t)u.pn * (2 * HALF) * K * 2; }
};
struct Gemm1Order {
    static constexpr bool GATHER = false, SIGNAL = false, WAIT = false, ACQ1 = false;
    DI void signal(const Unit&) const {} DI void wait(const Unit&) const {}
    const bf16_t* U; const bf16_t* Win; const bf16_t* Wv; int G, c;
    static constexpr int nM = T / BM, nN = HW / BM, nMain = nM * nN, nV = 2 * (T / BM), nwg = nMain + nV, K = D;
    DI bool next(int i, Unit& u) const {
        const int Lx = i * G + c; if (Lx >= nwg) return false;
        if (Lx < nMain) {
            const int wgid = xcd_remap(Lx, nMain);
            const int nig = WGM * nN, gid = wgid / nig, fm = gid * WGM, gsz = (nM - fm) < WGM ? (nM - fm) : WGM;
            u.pm = fm + ((wgid % nig) % gsz); u.pn = (wgid % nig) / gsz; u.aux = 0;
        } else { const int v = Lx - nMain; u.pm = v & 1; u.pn = v >> 1; u.aux = 1; }
        return true;
    }
    DI const char* aptr(const Unit& u) const { return (const char*)(u.aux ? Wv : U) + (size_t)u.pm * BM * K * 2; }
    DI const char* bptr(const Unit& u) const { return (const char*)(u.aux ? U : Win) + (size_t)u.pn * BM * K * 2; }
};
template <bool G_> struct GroupedOrderT {
    static constexpr bool GATHER = G_;
#ifdef FUSE_MOE
    static constexpr bool SIGNAL = G_, WAIT = false, ACQ1 = false;
    unsigned* flags;
    DI void signal(const Unit& u) const { (void)__hip_atomic_fetch_add(flags + u.pm, 1u, __ATOMIC_RELAXED, __HIP_MEMORY_SCOPE_AGENT); }
    DI void wait(const Unit&) const {}
#else
    static constexpr bool SIGNAL = false, WAIT = false, ACQ1 = false;
    DI void signal(const Unit&) const {} DI void wait(const Unit&) const {}
#endif
    const bf16_t* A; const bf16_t* Bt; int K; size_t estride; const LAS int* tile_e; int ntiles, nwg, G, c; const int* rowtok;
    DI bool next(int i, Unit& u) const {
        const int Lx = i * G + c; if (Lx >= nwg) return false;
        const int wgid = xcd_remap(Lx, nwg);
        u.pm = wgid >> 2; u.pn = wgid & 3; u.aux = tile_e[u.pm]; return true;
    }
    DI const char* aptr(const Unit& u) const { return GATHER ? (const char*)A : (const char*)A + (size_t)u.pm * BM * K * 2; }
    DI const char* bptr(const Unit& u) const { return (const char*)Bt + ((size_t)u.aux * estride + (size_t)u.pn * BM * K) * 2; }
};

#ifdef FUSE_MOE
struct GroupedOrderB {
    static constexpr bool GATHER = false, SIGNAL = false, WAIT = true;
#ifdef MOE_ACQ1
    static constexpr bool ACQ1 = true;
#else
    static constexpr bool ACQ1 = false;
#endif
    const bf16_t* A; const bf16_t* Bt; int K; size_t estride; const LAS int* tile_e; int ntiles, nwg, G, c; const int* rowtok; unsigned* flags;
    DI bool next(int i, Unit& u) const {
        int wgid;
        if (G % NXCD == 0) {
            const int P = G / NXCD, x = c % NXCD, k = c / NXCD, q = nwg / NXCD, r8 = nwg % NXCD;
            const int qx = q + (x < r8 ? 1 : 0), startx = x < r8 ? x * (q + 1) : r8 * (q + 1) + (x - r8) * q;
            const int remA = qx % P, nL = P - remA, seg1 = remA > 0 ? (2 * nL < qx ? 2 * nL : qx) : 0;
            int n1 = 0;
            if (remA > 0 && k >= remA) { n1 = (k - remA) < seg1 ? 1 : 0; n1 += (k - remA) + nL < seg1 ? 1 : 0; }
            const int ob = i < n1 ? (k - remA) + i * nL : seg1 + k + (i - n1) * P;
            if (ob >= qx) return false;
            wgid = startx + ob;
        } else { const int Lx = i * G + c; if (Lx >= nwg) return false; wgid = Lx; }
        u.pm = wgid >> 2; u.pn = wgid & 3; u.aux = tile_e[u.pm]; return true;
    }
    DI const char* aptr(const Unit& u) const { return (const char*)A + (size_t)u.pm * BM * K * 2; }
    DI const char* bptr(const Unit& u) const { return (const char*)Bt + ((size_t)u.aux * estride + (size_t)u.pn * BM * K) * 2; }
    DI void signal(const Unit&) const {}
    DI void wait(const Unit& u) const {
        unsigned sp = 0;
        while (__hip_atomic_load(flags + u.pm, __ATOMIC_RELAXED, __HIP_MEMORY_SCOPE_AGENT) < 4u) { __builtin_amdgcn_s_sleep(4); if (++sp > (1u << 22)) break; }
#ifdef MOE_ACQ1
        __builtin_amdgcn_fence(__ATOMIC_ACQUIRE, "agent"); asm volatile("s_waitcnt vmcnt(0)" ::: "memory");
#else
        asm volatile("" ::: "memory");
#endif
    }
};
#endif

struct EpiStore {
    bf16_t* O0; int ld0; bf16_t* O1; int ld1;
    DI void operator()(const f32x4 (&acc)[2][2][4][2], const Unit& u, int wr, int wc, int fr, int fq) const {
        bf16_t* base = u.aux ? O1 : O0; const int ldc = u.aux ? ld1 : ld0;
        const int row0 = u.pm * BM + wr * 64 + fr, col0 = u.pn * BM + wc * 32 + 8 * fq;
#pragma unroll
        for (int ai = 0; ai < 2; ++ai)
#pragma unroll
            for (int m = 0; m < 4; ++m) { bf16_t* rowp = base + (size_t)(row0 + ai * HALF + m * 16) * ldc + col0;
#pragma unroll
                for (int bj = 0; bj < 2; ++bj) { const f32x4 v0 = acc[ai][bj][m][0], v1 = acc[ai][bj][m][1];
                    u32x4 w; w.x = cvtpk(v0[0], v0[1]); w.y = cvtpk(v0[2], v0[3]); w.z = cvtpk(v1[0], v1[1]); w.w = cvtpk(v1[2], v1[3]);
                    *(u32x4*)(rowp + bj * HALF) = w; } }
    }
};
struct EpiSwiGlu {
    bf16_t* O;
    DI void operator()(const f32x4 (&acc)[2][2][4][2], const Unit& u, int wr, int wc, int fr, int fq) const {
        const int row0 = u.pm * BM + wr * 64 + fr, col0 = u.pn * HALF + wc * 32 + 8 * fq;
#pragma unroll
        for (int ai = 0; ai < 2; ++ai)
#pragma unroll
            for (int m = 0; m < 4; ++m) { bf16_t* rowp = O + (size_t)(row0 + ai * HALF + m * 16) * DE + col0;
                float hv[8];
#pragma unroll
                for (int n = 0; n < 2; ++n)
#pragma unroll
                    for (int e = 0; e < 4; ++e) { const float g = acc[ai][0][m][n][e], up = acc[ai][1][m][n][e]; hv[4 * n + e] = g * sigm(g) * up; }
                u32x4 w; w.x = cvtpk(hv[0], hv[1]); w.y = cvtpk(hv[2], hv[3]); w.z = cvtpk(hv[4], hv[5]); w.w = cvtpk(hv[6], hv[7]);
#ifdef FUSE_MOE
                asm volatile("global_store_dwordx4 %0, %1, off sc1\n\ts_nop 1" :: "v"(rowp), "v"(w) : "memory");
#else
                *(u32x4*)rowp = w;
#endif
            }
    }
};
struct EpiRowScale {
    bf16_t* O; const float* roww;
    DI void operator()(const f32x4 (&acc)[2][2][4][2], const Unit& u, int wr, int wc, int fr, int fq) const {
        const int row0 = u.pm * BM + wr * 64 + fr, col0 = u.pn * BM + wc * 32 + 8 * fq;
#pragma unroll
        for (int ai = 0; ai < 2; ++ai)
#pragma unroll
            for (int m = 0; m < 4; ++m) { const int row = row0 + ai * HALF + m * 16;
#ifdef MOEB_NOSCALE
                const float s = 1.f;
#else
                const float s = roww[row];
#endif
                bf16_t* rowp = O + (size_t)row * D + col0;
#pragma unroll
                for (int bj = 0; bj < 2; ++bj) { const f32x4 v0 = acc[ai][bj][m][0] * s, v1 = acc[ai][bj][m][1] * s;
                    u32x4 w; w.x = cvtpk(v0[0], v0[1]); w.y = cvtpk(v0[2], v0[3]); w.z = cvtpk(v1[0], v1[1]); w.w = cvtpk(v1[2], v1[3]);
                    *(u32x4*)(rowp + bj * HALF) = w; } }
    }
};

template <class Epi, class Sched>
DI void gemm_phase(LAS unsigned char* lds, const int tid, const int K, const Sched& S, const Epi& E) {
    const int wid = __builtin_amdgcn_readfirstlane(tid >> 6), lane = tid & 63, wr = wid >> 2, wc = wid & 3, fr = lane & 15, fq = lane >> 4;
    const int nt = K / BK;
    unsigned voffA[2], voffB[2];
#pragma unroll
    for (int i = 0; i < 2; ++i) { int R, C; stage_rc(tid * 16 + i * 8192, R, C); const int Rb = (R & ~31) + perm32(R & 31);
        voffA[i] = (unsigned)(R * K + C) * 2u; voffB[i] = (unsigned)(Rb * K + C) * 2u; }
    const size_t kstep = (size_t)(BK * 2);
    const size_t hstep = (size_t)HALF * K * 2;
    const size_t hstepA = Sched::GATHER ? 0 : hstep;
    int RA_[2], CA_[2];
#pragma unroll
    for (int i = 0; i < 2; ++i) stage_rc(tid * 16 + i * 8192, RA_[i], CA_[i]);
    unsigned vgc[2][2], vgn[2][2], vgnn[2][2];
#define PG8_GLOAD(dst, u_) do { if constexpr (Sched::GATHER) { _Pragma("unroll") for (int h_ = 0; h_ < 2; ++h_) _Pragma("unroll") for (int i_ = 0; i_ < 2; ++i_) \
        dst[h_][i_] = ((unsigned)S.rowtok[(u_).pm * BM + h_ * HALF + RA_[i_]] * (unsigned)K + (unsigned)CA_[i_]) * 2u; } } while (0)
    const unsigned ldsw = (unsigned)wid * 1024u;
    const int aoff = lds_byte(wr * 64 + fr, fq * 8), boff = lds_byte(wc * 32 + fr, fq * 8);
#define PG8_SA(b, h) (((b) * 2 + (h)) * HTB)
#define PG8_SB(b, h) ((4 + (b) * 2 + (h)) * HTB)
#define PG8_STAGE(bufoff, gbase, voff) do { _Pragma("unroll") for (int _i = 0; _i < 2; ++_i) \
        __builtin_amdgcn_global_load_lds((const unsigned*)((const char*)(gbase) + (voff)[_i]), (LAS unsigned*)(lds + (bufoff) + ldsw + _i * 8192), 16, 0, 0); } while (0)
#define PG8_STAGE_C(bufoff, gbase, voff) do { _Pragma("unroll") for (int _i = 0; _i < 2; ++_i) \
        __builtin_amdgcn_global_load_lds((const unsigned*)((const char*)(gbase) + (voff)[_i]), (LAS unsigned*)(lds + (bufoff) + ldsw + _i * 8192), 16, 0, 16); } while (0)
#define PG8_STAGE_A(b, h, gbase, cur_) do { if constexpr (Sched::GATHER) { unsigned vo_[2]; vo_[0] = (cur_) ? vgc[h][0] : vgn[h][0]; vo_[1] = (cur_) ? vgc[h][1] : vgn[h][1]; PG8_STAGE(PG8_SA(b, h), gbase, vo_); } else if constexpr (Sched::WAIT && !Sched::ACQ1) PG8_STAGE_C(PG8_SA(b, h), (gbase) + (h) * hstepA, voffA); else PG8_STAGE(PG8_SA(b, h), (gbase) + (h) * hstepA, voffA); } while (0)
#define PG8_LDA(dst, b, h) do { _Pragma("unroll") for (int m = 0; m < 4; ++m) _Pragma("unroll") for (int k = 0; k < 2; ++k) dst[m][k] = *(const LAS bf16x8*)(lds + PG8_SA(b, h) + aoff + m * 2048 + k * 1024); } while (0)
#define PG8_LDB(dst, b, h) do { _Pragma("unroll") for (int n = 0; n < 2; ++n) _Pragma("unroll") for (int k = 0; k < 2; ++k) dst[n][k] = *(const LAS bf16x8*)(lds + PG8_SB(b, h) + boff + n * 2048 + k * 1024); } while (0)
#define PG8_MMA(ai, bj, At, Bt) do { __builtin_amdgcn_s_setprio(1); _Pragma("unroll") for (int m = 0; m < 4; ++m) _Pragma("unroll") for (int n = 0; n < 2; ++n) _Pragma("unroll") for (int k = 0; k < 2; ++k) \
        acc[ai][bj][m][n] = __builtin_amdgcn_mfma_f32_16x16x32_bf16(Bt[n][k], At[m][k], acc[ai][bj][m][n], 0, 0, 0); __builtin_amdgcn_s_setprio(0); } while (0)
#define PG8_WAIT_V(n) asm volatile("s_waitcnt vmcnt(" #n ")" ::: "memory")
#define PG8_WAIT_L(n) asm volatile("s_waitcnt lgkmcnt(" #n ")" ::: "memory")
#define PG8_BAR __builtin_amdgcn_s_barrier()
#define PG8_SCHED __builtin_amdgcn_sched_barrier(0)
    Unit cur, nxt; int ui = 0;
    if (!S.next(0, cur)) return;
    f32x4 acc[2][2][4][2];
#pragma unroll
    for (int a = 0; a < 2; ++a)
#pragma unroll
        for (int b = 0; b < 2; ++b)
#pragma unroll
            for (int m = 0; m < 4; ++m)
#pragma unroll
                for (int n = 0; n < 2; ++n) acc[a][b][m][n] = (f32x4){0.f, 0.f, 0.f, 0.f};
    bf16x8 At[4][2], B0[2][2], B1[2][2];
    const char* cA = S.aptr(cur); const char* cB = S.bptr(cur);
    if constexpr (Sched::WAIT) { if constexpr (Sched::ACQ1) { if (wid == 0) S.wait(cur); PG8_BAR; } else S.wait(cur); }
    if constexpr (Sched::GATHER) { Unit u1_ = cur, u2_ = cur; const bool h1_ = S.next(1, u1_); if (!h1_) u1_ = cur; const bool h2_ = h1_ && S.next(2, u2_); if (!h2_) u2_ = u1_;
        PG8_GLOAD(vgc, cur); PG8_GLOAD(vgn, u1_); PG8_GLOAD(vgnn, u2_); }
    PG8_STAGE(PG8_SB(0, 0), cB, voffB); PG8_STAGE(PG8_SB(0, 1), cB + hstep, voffB); PG8_STAGE_A(0, 0, cA, true); PG8_STAGE_A(0, 1, cA, true);
    if (wr == 1) PG8_BAR;
    PG8_WAIT_V(2); PG8_BAR;
    PG8_STAGE(PG8_SB(1, 0), cB + kstep, voffB); PG8_STAGE_A(1, 0, cA + kstep, true); PG8_STAGE(PG8_SB(1, 1), cB + hstep + kstep, voffB);
    PG8_WAIT_V(6); PG8_BAR;
    for (;;) {
        const bool has_next = S.next(ui + 1, nxt);
        const char* nA = has_next ? S.aptr(nxt) : cA; const char* nB = has_next ? S.bptr(nxt) : cB;

        for (int t = 0; t < nt; t += 2) {
            const bool last = (t == nt - 2);
            if constexpr (Sched::WAIT) { if (last && has_next) { if constexpr (Sched::ACQ1) { if (wid == 0) S.wait(nxt); } else S.wait(nxt); } }
            const char* a1 = cA + (size_t)(t + 1) * kstep;
            const char* a2 = last ? nA : cA + (size_t)(t + 2) * kstep; const char* b2 = last ? nB : cB + (size_t)(t + 2) * kstep;
            const char* a3 = a2 + kstep; const char* b3 = b2 + kstep;
            PG8_LDB(B0, 0, 0); PG8_LDB(B1, 0, 1); PG8_SCHED; PG8_LDA(At, 0, 0); PG8_STAGE_A(1, 1, a1, true);
            PG8_WAIT_V(8); PG8_WAIT_L(0); PG8_BAR; PG8_MMA(0, 0, At, B0); PG8_MMA(0, 1, At, B1); PG8_BAR; PG8_SCHED;
            PG8_LDA(At, 0, 1); PG8_STAGE(PG8_SB(0, 0), b2, voffB); PG8_STAGE(PG8_SB(0, 1), b2 + hstep, voffB); PG8_STAGE_A(0, 0, a2, !last);
            PG8_WAIT_V(8); PG8_WAIT_L(0); PG8_BAR; PG8_MMA(1, 0, At, B0); PG8_MMA(1, 1, At, B1); PG8_BAR; PG8_SCHED;
            PG8_LDB(B0, 1, 0); PG8_LDB(B1, 1, 1); PG8_SCHED; PG8_LDA(At, 1, 0); PG8_STAGE_A(0, 1, a2, !last);
            PG8_WAIT_V(8); PG8_WAIT_L(0); PG8_BAR; PG8_MMA(0, 0, At, B0); PG8_MMA(0, 1, At, B1); PG8_BAR; PG8_SCHED;
            PG8_LDA(At, 1, 1); PG8_STAGE(PG8_SB(1, 0), b3, voffB); PG8_STAGE(PG8_SB(1, 1), b3 + hstep, voffB); PG8_STAGE_A(1, 0, a3, !last);
            PG8_WAIT_V(8); PG8_WAIT_L(0); PG8_BAR; PG8_MMA(1, 0, At, B0); PG8_MMA(1, 1, At, B1); PG8_BAR; PG8_SCHED;
        }
        if (wr == 0) PG8_BAR;
        E(acc, cur, wr, wc, fr, fq);
        if constexpr (Sched::SIGNAL) { PG8_WAIT_V(0); PG8_BAR; if (tid == 0) S.signal(cur); }
        if (!has_next) break;
#pragma unroll
        for (int a = 0; a < 2; ++a)
#pragma unroll
            for (int b = 0; b < 2; ++b)
#pragma unroll
                for (int m = 0; m < 4; ++m)
#pragma unroll
                    for (int n = 0; n < 2; ++n) acc[a][b][m][n] = (f32x4){0.f, 0.f, 0.f, 0.f};
        cur = nxt; cA = nA; cB = nB; ++ui;
        if constexpr (Sched::GATHER) { _Pragma("unroll") for (int h_ = 0; h_ < 2; ++h_) _Pragma("unroll") for (int i_ = 0; i_ < 2; ++i_) { vgc[h_][i_] = vgn[h_][i_]; vgn[h_][i_] = vgnn[h_][i_]; } }
        if (wr == 1) PG8_BAR;
    }
    PG8_WAIT_V(0);
    PG8_BAR;
#undef PG8_SA
#undef PG8_SB
#undef PG8_STAGE
#undef PG8_STAGE_C
#undef PG8_STAGE_A
#undef PG8_GLOAD
#undef PG8_LDA
#undef PG8_LDB
#undef PG8_MMA
#undef PG8_WAIT_V
#undef PG8_WAIT_L
#undef PG8_BAR
#undef PG8_SCHED
}
}

#define XB_TMO      128
#define XB_XCNT(j)  (256  + 64 * (j))
#define XB_XSUB(j)  (1280 + 64 * (j))
#define XB_XGEN(j)  (2304 + 64 * (j))
#define XB_TOP      3328
#define XB_TOPGEN   3392
#define XCD_BAR_WORDS 3456
#define XB_SPIN_CAP (1u << 20)
DI unsigned xb_ld(unsigned* p)              { return __hip_atomic_load(p, __ATOMIC_RELAXED, __HIP_MEMORY_SCOPE_AGENT); }
DI unsigned xb_add(unsigned* p, unsigned v) { return __hip_atomic_fetch_add(p, v, __ATOMIC_RELAXED, __HIP_MEMORY_SCOPE_AGENT); }
DI unsigned xb_xcc_id() { return (unsigned)__builtin_amdgcn_s_getreg((3 << 11) | 20) & 0xFu; }
#define XB_SPIN(cond, bar) do { unsigned _sp = 0; while (cond) { __builtin_amdgcn_s_sleep(1); \
    if ((++_sp & 255u) == 0u) { if (xb_ld(&(bar)[XB_TMO])) break; if (_sp > XB_SPIN_CAP) { atomicAdd(&(bar)[XB_TMO], 1u); break; } } } } while (0)
struct XcdBarrier { unsigned* bar; unsigned x; volatile LAS unsigned* st; };
DI XcdBarrier xcd_barrier_post(unsigned* bar, volatile LAS unsigned* st) {
    XcdBarrier b; b.bar = bar; b.x = xb_xcc_id(); b.st = st;
    if (threadIdx.x == 0) (void)xb_add(&bar[XB_XCNT(b.x)], 1u);
    return b;
}
DI void xcd_barrier_complete(unsigned* bar, unsigned x, unsigned& nloc, unsigned& nx) {
    const unsigned G = gridDim.x * gridDim.y * gridDim.z;
    unsigned sum, cnt, mine, sp = 0u;
    for (;;) {
        sum = 0u; cnt = 0u; mine = 0u;
#pragma unroll
        for (unsigned j = 0; j < 16; ++j) { const unsigned c = xb_ld(&bar[XB_XCNT(j)]); sum += c; cnt += (c > 0u) ? 1u : 0u; mine = (j == x) ? c : mine; }
        if (sum == G) break;
        __builtin_amdgcn_s_sleep(1);
        if ((++sp & 255u) == 0u) { if (xb_ld(&bar[XB_TMO])) break; if (sp > XB_SPIN_CAP) { atomicAdd(&bar[XB_TMO], 1u); break; } }
    }
    nloc = mine > 0u ? mine : 1u; nx = cnt > 0u ? cnt : 1u;
}
DI void xcd_barrier(const XcdBarrier& b) {
    asm volatile("s_waitcnt vmcnt(0)" ::: "memory");
    __syncthreads();
    if (threadIdx.x == 0) {
        unsigned* bar = b.bar;
        __builtin_amdgcn_s_waitcnt(0);
        unsigned nloc = b.st[0], nx = b.st[1];
        if (nloc == 0u) { xcd_barrier_complete(bar, b.x, nloc, nx); b.st[0] = nloc; b.st[1] = nx; }
        const unsigned old = xb_add(&bar[XB_XSUB(b.x)], 1u);
        const unsigned gen = old / nloc;
        if (old + 1u == (gen + 1u) * nloc) {
            __builtin_amdgcn_fence(__ATOMIC_RELEASE, "agent");
            asm volatile("s_waitcnt vmcnt(0)" ::: "memory");
            const unsigned og = xb_add(&bar[XB_TOP], 1u);
            const unsigned tg = og / nx;
            if (og + 1u == (tg + 1u) * nx) xb_add(&bar[XB_TOPGEN], 1u);
            else XB_SPIN(xb_ld(&bar[XB_TOPGEN]) == tg, bar);
            __builtin_amdgcn_fence(__ATOMIC_ACQUIRE, "agent");
            xb_add(&bar[XB_XGEN(b.x)], 1u);
            asm volatile("s_waitcnt vmcnt(0)" ::: "memory");
        } else {
            XB_SPIN(xb_ld(&bar[XB_XGEN(b.x)]) == gen, bar);
            __builtin_amdgcn_fence(__ATOMIC_ACQUIRE, "agent");
            asm volatile("s_waitcnt vmcnt(0)" ::: "memory");
        }
    }
    __syncthreads();
}

struct Args { const float* in[31]; float* out; unsigned char* ws; int ph_lo, ph_hi, use_cg, pad; };
struct Frame {
    LAS unsigned char* lds;
    int tid, lane, wave, G, vcu, gw, ngw, bx;
    unsigned char* ws;
};
constexpr int LDS_MISC = 131072;
constexpr int LDS_BARST = LDS_BYTES - 64;

#ifdef NO_PREWAIT
#define CONV_PREWAIT() do { } while (0)
#else
#define CONV_PREWAIT() __builtin_amdgcn_s_waitcnt(0x0F70)
#endif
struct TItem { const float* src; bf16_t* dst; int ldw, ldt; };
#ifdef TITEM2
DI void titem_load(const TItem& t, f32x4 (&v)[16], int lane) {
#pragma unroll
    for (int i = 0; i < 16; ++i) v[i] = *(const f32x4*)(t.src + (size_t)(16 * (i >> 2) + 4 * (lane >> 4) + (i & 3)) * t.ldw + 4 * (lane & 15));
}
DI void titem_store(const TItem& t, const f32x4 (&v)[16], LAS float* scr, int lane) {
    LAS unsigned char* T = (LAS unsigned char*)scr;
    const int rr = lane >> 4, cc = lane & 15;
#pragma unroll
    for (int q = 0; q < 4; ++q)
#pragma unroll
        for (int e = 0; e < 4; ++e)
            *(LAS u32x2*)(T + (4 * cc + e) * 136 + (16 * q + 4 * rr) * 2) = (u32x2){cvtpk(v[4 * q][e], v[4 * q + 1][e]), cvtpk(v[4 * q + 2][e], v[4 * q + 3][e])};
    LDS_WAIT();
#pragma unroll
    for (int j = 0; j < 8; ++j) {
        const int n = 8 * j + (lane >> 3), c = lane & 7;
        const u32x2 lo = *(const LAS u32x2*)(T + n * 136 + 16 * c), hi = *(const LAS u32x2*)(T + n * 136 + 16 * c + 8);
        *(u32x4*)(t.dst + (size_t)n * t.ldt + 8 * c) = (u32x4){lo.x, lo.y, hi.x, hi.y};
    }
    LDS_WAIT();
}
#else
DI void titem_load(const TItem& t, f32x4 (&v)[16], int lane) {
#pragma unroll
    for (int i = 0; i < 16; ++i) v[i] = *(const f32x4*)(t.src + (size_t)(4 * i + (lane >> 4)) * t.ldw + 4 * (lane & 15));
}
DI void titem_store(const TItem& t, const f32x4 (&v)[16], LAS float* scr, int lane) {
#pragma unroll
    for (int i = 0; i < 16; ++i) { LAS float* s = scr + (4 * i + (lane >> 4)) * 65 + 4 * (lane & 15); s[0] = v[i][0]; s[1] = v[i][1]; s[2] = v[i][2]; s[3] = v[i][3]; }
    LDS_WAIT();
#pragma unroll
    for (int j = 0; j < 8; ++j) {
        const int n = 8 * j + (lane >> 3), c = lane & 7; const LAS float* s = scr + (8 * c) * 65 + n;
        u32x4 o; o.x = cvtpk(s[0], s[65]); o.y = cvtpk(s[130], s[195]); o.z = cvtpk(s[260], s[325]); o.w = cvtpk(s[390], s[455]);
        *(u32x4*)(t.dst + (size_t)n * t.ldt + 8 * c) = o;
    }
    LDS_WAIT();
}
#endif
constexpr int IT_WIN = 16 * 42, IT_WOUT = 16 * 16, IT_SMALL = IT_WIN + IT_WOUT;
constexpr int IT_EXP = 128 * 3, IT_MOE = NE * IT_EXP;
DI TItem small_item(const Frame& F, const float* w_in, const float* w_out, int git) {
    const int l = git / IT_SMALL, it = git % IT_SMALL; TItem t;
    if (it < IT_WIN) {
        const int kt = it / 42, nt = it % 42, n0 = 64 * nt;
        size_t drow; if (n0 < 768) drow = n0; else if (n0 < 1152) drow = 2304 + (n0 - 768); else drow = n0 - 384;
        t.src = w_in + (size_t)l * D * INW + (size_t)(64 * kt) * INW + n0; t.ldw = INW;
        t.dst = (bf16_t*)(F.ws + WS_WIN + (size_t)l * WIN_LAYER) + drow * D + 64 * kt; t.ldt = D;
    } else {
        const int r = it - IT_WIN, kt = r >> 4, nt = r & 15;
        t.src = w_out + (size_t)l * D * D + (size_t)(64 * kt) * D + 64 * nt; t.ldw = D;
        t.dst = (bf16_t*)(F.ws + WS_WOUT) + (size_t)l * D * D + (size_t)(64 * nt) * D + 64 * kt; t.ldt = D;
    }
    return t;
}
DI TItem moe_item(const Frame& F, const float* wg, const float* wu, const float* wd, int l, int it) {
    const int e = it / IT_EXP, r = it % IT_EXP, which = r >> 7, q = r & 127; TItem t;
    if (which < 2) {
        const int kt = q >> 3, nt = q & 7, n0 = 64 * nt;
        t.src = (which ? wu : wg) + ((size_t)l * NE + e) * D * DE + (size_t)(64 * kt) * DE + n0; t.ldw = DE;
        const size_t drow = (size_t)(n0 >> 7) * 256 + (which ? 128 : 0) + (n0 & 127);
        t.dst = (bf16_t*)(F.ws + WS_WGU) + (size_t)e * D * D + drow * D + 64 * kt; t.ldt = D;
    } else {
        const int kt = q >> 4, nt = q & 15;
        t.src = wd + ((size_t)l * NE + e) * DE * D + (size_t)(64 * kt) * D + 64 * nt; t.ldw = D;
        t.dst = (bf16_t*)(F.ws + WS_WD) + (size_t)e * D * DE + (size_t)(64 * nt) * DE + 64 * kt; t.ldt = DE;
    }
    return t;
}
DI void p0_prologue(const Frame& F, const Args& a) {
    const float* c = a.in[1]; const float* w_mod = a.in[2]; const float* b_mod = a.in[3];
    if (F.bx < L * (MODW / 64)) {
        LAS float* sc = (LAS float*)(F.lds);
        LAS float* red = (LAS float*)(F.lds + 8192);
        for (int i = F.tid; i < NB * D; i += NTHREADS) { const float v = c[i]; sc[i] = v / (1.f + expf(-v)); }
        __syncthreads();
        const int l = F.bx / (MODW / 64), cb = F.bx % (MODW / 64), n = cb * 64 + F.lane;
        const float* w = w_mod + (size_t)l * D * MODW + n;
        float a0 = 0.f, a1 = 0.f;
#pragma unroll 8
        for (int k = F.wave * 128; k < F.wave * 128 + 128; ++k) { const float wv = w[(size_t)k * MODW]; a0 += sc[k] * wv; a1 += sc[D + k] * wv; }
        red[(F.wave * 2 + 0) * 64 + F.lane] = a0; red[(F.wave * 2 + 1) * 64 + F.lane] = a1;
        __syncthreads();
        if (F.tid < 128) { const int b = F.tid >> 6, ln = F.tid & 63; float s = 0.f;
#pragma unroll
            for (int w8 = 0; w8 < 8; ++w8) s += red[(w8 * 2 + b) * 64 + ln];
            const int nn = cb * 64 + ln;
            ((float*)(F.ws + WS_MOD))[(size_t)(l * NB + b) * MODW + nn] = s + b_mod[l * MODW + nn]; }
        __syncthreads();
    }
    { const int nzero = L * 128 * D / 8;
      for (int i = F.gw * 64 + F.lane; i < nzero; i += F.ngw * 64) { const int l = i / (128 * D / 8), r = i % (128 * D / 8);
          *(u32x4*)((bf16_t*)(F.ws + WS_WIN + (size_t)l * WIN_LAYER) + (size_t)(2304 + 384) * D + (size_t)r * 8) = (u32x4){0u, 0u, 0u, 0u}; } }
    LAS float* scr = (LAS float*)(F.lds + 16384) + F.wave * (64 * 65);
    { f32x4 cur[16], nxt[16]; int it = F.gw; TItem tc{}, tn{};
      if (it < L * IT_SMALL) { tc = small_item(F, a.in[4], a.in[19], it); titem_load(tc, cur, F.lane); }
      CONV_PREWAIT();
      for (; it < L * IT_SMALL; it += F.ngw) {
          const bool more = it + F.ngw < L * IT_SMALL;
          if (more) { tn = small_item(F, a.in[4], a.in[19], it + F.ngw); titem_load(tn, nxt, F.lane); }
          titem_store(tc, cur, scr, F.lane);
          if (more) { tc = tn;
#pragma unroll
              for (int i = 0; i < 16; ++i) cur[i] = nxt[i]; }
      } }
}

DI void row_ln(f32x4 (&v)[4], float& mean_out, float& rstd_out) {
    float s = 0.f;
#pragma unroll
    for (int j = 0; j < 4; ++j) s += (v[j][0] + v[j][1]) + (v[j][2] + v[j][3]);
    const float mean = wave_sum(s) * (1.f / D); float q = 0.f;
#pragma unroll
    for (int j = 0; j < 4; ++j) { v[j] = v[j] - mean; q += (v[j][0] * v[j][0] + v[j][1] * v[j][1]) + (v[j][2] * v[j][2] + v[j][3] * v[j][3]); }
    mean_out = mean; rstd_out = 1.f / sqrtf(wave_sum(q) * (1.f / D) + LN_EPS);
}
DI void row_mod_store(f32x4 (&v)[4], const float* md, int off_sh, int off_sc, bf16_t* urow, int lane) {
    float mean, rstd; row_ln(v, mean, rstd);
#pragma unroll
    for (int j = 0; j < 4; ++j) { const int col = 4 * lane + 256 * j;
        const f32x4 scv = *(const f32x4*)(md + off_sc + col), shv = *(const f32x4*)(md + off_sh + col);
        v[j] = v[j] * rstd * (1.f + scv) + shv;
        u32x2 w; w.x = cvtpk(v[j][0], v[j][1]); w.y = cvtpk(v[j][2], v[j][3]);
        *(u32x2*)(urow + col) = w; }
}
DI void p_r0(const Frame& F, const float* x) {
    const float* MOD = (const float*)(F.ws + WS_MOD);
    bf16_t* U = (bf16_t*)(F.ws + WS_U);
    for (int row = F.gw; row < T; row += F.ngw) {
        f32x4 v[4];
#pragma unroll
        for (int j = 0; j < 4; ++j) v[j] = *(const f32x4*)(x + (size_t)row * D + 4 * F.lane + 256 * j);
        row_mod_store(v, MOD + (size_t)(row / S) * MODW, 0, D, U + (size_t)row * D, F.lane);
    }
}

constexpr int NGRP = T / 64;
DI void p_rowpass1(const Frame& F, const Args& a, int l, const float* xin, const bool dry = false) {
    const float* MODl = (const float*)(F.ws + WS_MOD) + (size_t)l * NB * MODW;
    const bf16_t* MIX = (const bf16_t*)(F.ws + WS_MIX);
    float* XA = (float*)(F.ws + WS_XA); bf16_t* U = (bf16_t*)(F.ws + WS_U);
    const float* gain = a.in[20] + (size_t)l * D; const float* bias = a.in[21] + (size_t)l * D;
    const float* wg = a.in[24] + (size_t)l * D * NG; const float* bg = a.in[25] + (size_t)l * NG;
    const float* we = a.in[26] + (size_t)l * D * NE; const float* be = a.in[27] + (size_t)l * NE;
    const size_t dro = dry ? 490 * MiB - WS_BC : 0;
    int* BC = (int*)(F.ws + WS_BC + dro); float* TOKW = (float*)(F.ws + WS_TOKW + dro); int* TOKSLOT = (int*)(F.ws + WS_TOKSLOT + (dry ? 496 * MiB - WS_TOKSLOT : 0));
    LAS float* RT = (LAS float*)F.lds;
    LAS unsigned* cntl = (LAS unsigned*)(F.lds + 36 * D * 4 + NWAVES * 72 * 4);
#ifdef DRY_NOFILL
    if (!dry)
#endif
#pragma unroll
    for (int kk = 0; kk < 2; ++kk) { const int k = F.tid + kk * NTHREADS;
        f32x4 v[9]; v[0] = *(const f32x4*)(wg + (size_t)k * NG);
#pragma unroll
        for (int q = 0; q < 8; ++q) v[1 + q] = *(const f32x4*)(we + (size_t)k * NE + 4 * q);
#pragma unroll
        for (int q = 0; q < 9; ++q)
#pragma unroll
            for (int e = 0; e < 4; ++e) RT[(4 * q + e) * D + k] = v[q][e]; }
    for (int grp = F.vcu; grp < NGRP; grp += F.G) {
    if (F.tid < NE) cntl[F.tid] = 0u;
    __syncthreads();
#ifdef RESBF
    const bool xbf = l > 0; const bf16_t* xinb = (const bf16_t*)xin; bf16_t* XAb = (bf16_t*)(F.ws + WS_XA);
    u32x4 pxa[4], pxb[4]; u32x2 pma[4], pmb[4];
#define RP1_LDX(dst, row_, col_) do { if (xbf) { const u32x2 t_ = *(const u32x2*)(xinb + (size_t)(row_) * D + (col_)); dst.x = t_.x; dst.y = t_.y; } else dst = *(const u32x4*)(xin + (size_t)(row_) * D + (col_)); } while (0)
#define RP1_XV(p_) (xbf ? (f32x4){bflo(p_.x), bfhi(p_.x), bflo(p_.y), bfhi(p_.y)} : __builtin_bit_cast(f32x4, p_))
#else
    f32x4 pxa[4], pxb[4]; u32x2 pma[4], pmb[4];
#define RP1_LDX(dst, row_, col_) dst = *(const f32x4*)(xin + (size_t)(row_) * D + (col_))
#define RP1_XV(p_) (p_)
#endif
    { const int r0 = 64 * grp + 8 * F.wave;
#pragma unroll
      for (int j = 0; j < 4; ++j) { const int col = 4 * F.lane + 256 * j; RP1_LDX(pxa[j], r0, col); RP1_LDX(pxb[j], r0 + 1, col);
          pma[j] = *(const u32x2*)(MIX + (size_t)r0 * D + col); pmb[j] = *(const u32x2*)(MIX + (size_t)(r0 + 1) * D + col); } }
    for (int rp = 0; rp < 4; ++rp) {
        const int row0 = 64 * grp + 8 * F.wave + 2 * rp; const float* md = MODl + (size_t)(row0 / S) * MODW;
        f32x4 va[4], vb[4];
#pragma unroll
        for (int j = 0; j < 4; ++j) { const int col = 4 * F.lane + 256 * j;
            const f32x4 g = *(const f32x4*)(md + 2 * D + col);
            va[j] = RP1_XV(pxa[j]) * ALPHA + g * (f32x4){bflo(pma[j].x), bfhi(pma[j].x), bflo(pma[j].y), bfhi(pma[j].y)};
            vb[j] = RP1_XV(pxb[j]) * ALPHA + g * (f32x4){bflo(pmb[j].x), bfhi(pmb[j].x), bflo(pmb[j].y), bfhi(pmb[j].y)}; }
        if (rp < 3) { const int r0 = row0 + 2;
#pragma unroll
          for (int j = 0; j < 4; ++j) { const int col = 4 * F.lane + 256 * j; RP1_LDX(pxa[j], r0, col); RP1_LDX(pxb[j], r0 + 1, col);
              pma[j] = *(const u32x2*)(MIX + (size_t)r0 * D + col); pmb[j] = *(const u32x2*)(MIX + (size_t)(r0 + 1) * D + col); } }
        float mean, rstd;
        row_ln(va, mean, rstd);
#pragma unroll
        for (int j = 0; j < 4; ++j) { const int col = 4 * F.lane + 256 * j; va[j] = va[j] * rstd * *(const f32x4*)(gain + col) + *(const f32x4*)(bias + col);
#ifdef RESBF
            *(u32x2*)(XAb + (size_t)row0 * D + col) = (u32x2){cvtpk(va[j][0], va[j][1]), cvtpk(va[j][2], va[j][3])}; }
#else
            *(f32x4*)(XA + (size_t)row0 * D + col) = va[j]; }
#endif
        row_ln(vb, mean, rstd);
#pragma unroll
        for (int j = 0; j < 4; ++j) { const int col = 4 * F.lane + 256 * j; vb[j] = vb[j] * rstd * *(const f32x4*)(gain + col) + *(const f32x4*)(bias + col);
#ifdef RESBF
            *(u32x2*)(XAb + (size_t)(row0 + 1) * D + col) = (u32x2){cvtpk(vb[j][0], vb[j][1]), cvtpk(vb[j][2], vb[j][3])}; }
#else
            *(f32x4*)(XA + (size_t)(row0 + 1) * D + col) = vb[j]; }
#endif
        row_mod_store(va, md, 3 * D, 4 * D, U + (size_t)row0 * D, F.lane);
        row_mod_store(vb, md, 3 * D, 4 * D, U + (size_t)(row0 + 1) * D, F.lane);
#ifdef DRY_NOROUTER
        if (dry) continue;
#endif
        LAS float* lg = (LAS float*)(F.lds + 36 * D * 4) + F.wave * 72;
#ifdef ROUTER_FULL
#pragma unroll 1
        for (int n = 0; n < 36; n += 3) { float sa[3], sb[3];
#pragma unroll
            for (int q = 0; q < 3; ++q) { sa[q] = 0.f; sb[q] = 0.f;
#pragma unroll
                for (int j = 0; j < 4; ++j) { const f32x4 w = *(const LAS f32x4*)(RT + (n + q) * D + 4 * F.lane + 256 * j);
                    sa[q] += (va[j][0] * w[0] + va[j][1] * w[1]) + (va[j][2] * w[2] + va[j][3] * w[3]);
                    sb[q] += (vb[j][0] * w[0] + vb[j][1] * w[1]) + (vb[j][2] * w[2] + vb[j][3] * w[3]); } }
#pragma unroll
            for (int q = 0; q < 3; ++q) { sa[q] = wave_sum(sa[q]); sb[q] = wave_sum(sb[q]); }
            if (F.lane == 0) {
#pragma unroll
                for (int q = 0; q < 3; ++q) { lg[n + q] = sa[q]; lg[36 + n + q] = sb[q]; } } }
#else
        int gia, gib;
        { float sa[4], sb[4];
#pragma unroll
          for (int q = 0; q < 4; ++q) { sa[q] = 0.f; sb[q] = 0.f;
#pragma unroll
              for (int j = 0; j < 4; ++j) { const f32x4 w = *(const LAS f32x4*)(RT + q * D + 4 * F.lane + 256 * j);
                  sa[q] += (va[j][0] * w[0] + va[j][1] * w[1]) + (va[j][2] * w[2] + va[j][3] * w[3]);
                  sb[q] += (vb[j][0] * w[0] + vb[j][1] * w[1]) + (vb[j][2] * w[2] + vb[j][3] * w[3]); } }
#pragma unroll
          for (int q = 0; q < 4; ++q) { sa[q] = wave_sum(sa[q]); sb[q] = wave_sum(sb[q]); }
          if (F.lane == 0) {
#pragma unroll
              for (int q = 0; q < 4; ++q) { lg[q] = sa[q]; lg[36 + q] = sb[q]; } }
          gia = 0; gib = 0; float ma = sa[0] + bg[0], mb = sb[0] + bg[0];
#pragma unroll
          for (int q = 1; q < 4; ++q) { const float xa = sa[q] + bg[q], xb = sb[q] + bg[q]; const bool ca = xa > ma, cb = xb > mb; ma = ca ? xa : ma; gia = ca ? q : gia; mb = cb ? xb : mb; gib = cb ? q : gib; }
          gia = __builtin_amdgcn_readfirstlane(gia); gib = __builtin_amdgcn_readfirstlane(gib); }
        { const LAS float* RA = RT + (4 + gia * EPG) * D + 4 * F.lane; const LAS float* RBp = RT + (4 + gib * EPG) * D + 4 * F.lane;
#pragma unroll 1
          for (int e0 = 0; e0 < EPG; e0 += 4) { float sa[4], sb[4];
#pragma unroll
              for (int q = 0; q < 4; ++q) { sa[q] = 0.f; sb[q] = 0.f;
#pragma unroll
                  for (int j = 0; j < 4; ++j) { const f32x4 wa = *(const LAS f32x4*)(RA + (e0 + q) * D + 256 * j), wb = *(const LAS f32x4*)(RBp + (e0 + q) * D + 256 * j);
                      sa[q] += (va[j][0] * wa[0] + va[j][1] * wa[1]) + (va[j][2] * wa[2] + va[j][3] * wa[3]);
                      sb[q] += (vb[j][0] * wb[0] + vb[j][1] * wb[1]) + (vb[j][2] * wb[2] + vb[j][3] * wb[3]); } }
#pragma unroll
              for (int q = 0; q < 4; ++q) { sa[q] = wave_sum(sa[q]); sb[q] = wave_sum(sb[q]); }
              if (F.lane == 0) {
#pragma unroll
                  for (int q = 0; q < 4; ++q) { lg[4 + gia * EPG + e0 + q] = sa[q]; lg[36 + 4 + gib * EPG + e0 + q] = sb[q]; } } } }
#endif
        LDS_WAIT();
#pragma unroll
        for (int rr = 0; rr < 2; ++rr) {
            float gl[4];
#pragma unroll
            for (int n = 0; n < 4; ++n) gl[n] = lg[36 * rr + n] + bg[n];
            int gi = 0; float gm = gl[0];
#pragma unroll
            for (int n = 1; n < 4; ++n) { const bool c = gl[n] > gm; gm = c ? gl[n] : gm; gi = c ? n : gi; }
            float se = 0.f;
#pragma unroll
            for (int n = 0; n < 4; ++n) se += expf(gl[n] - gm);
            const float pg = 1.f / se;
            float l1 = -3.0e38f, l2 = -3.0e38f; int i1 = 0, i2 = 0;
#pragma unroll
            for (int e = 0; e < 8; ++e) { const float v = lg[36 * rr + 4 + gi * EPG + e] + be[gi * EPG + e];
                const bool c1 = v > l1, c2 = v > l2;
                l2 = c1 ? l1 : (c2 ? v : l2); i2 = c1 ? i1 : (c2 ? e : i2); l1 = c1 ? v : l1; i1 = c1 ? e : i1; }
            const float e2 = expf(l2 - l1); const float w1 = pg / (1.f + e2), w2 = pg * e2 / (1.f + e2);
            if (F.lane == 0) {
                const int tok = row0 + rr, ea = gi * EPG + i1, eb = gi * EPG + i2;
                const unsigned pa = __hip_atomic_fetch_add(&cntl[ea], 1u, __ATOMIC_RELAXED, __HIP_MEMORY_SCOPE_WORKGROUP), pb = __hip_atomic_fetch_add(&cntl[eb], 1u, __ATOMIC_RELAXED, __HIP_MEMORY_SCOPE_WORKGROUP);
                TOKSLOT[tok * 2] = (ea << 14) | (int)pa; TOKSLOT[tok * 2 + 1] = (eb << 14) | (int)pb;
                TOKW[tok * 2] = w1; TOKW[tok * 2 + 1] = w2;
            }
        }
    }
    __syncthreads();
    if (F.tid < NE) BC[grp * NE + F.tid] = (int)cntl[F.tid];
    __syncthreads();
    }
}

DI void build_tables(const Frame& F, int l, LAS int* tb) {
    if (F.tid < 64) {
        const int e = F.lane; const int c = e < NE ? ((const int*)(F.ws + WS_CNTF))[e] : 0; const int tl = (c + 255) >> 8;
        int cum = c, tin = tl;
#pragma unroll
        for (int o = 1; o < 32; o <<= 1) { const int a1 = __shfl_up(cum, o), a2 = __shfl_up(tin, o); if (e >= o) { cum += a1; tin += a2; } }
        if (e < NE) { tb[e] = cum - c; tb[33 + e] = (tin - tl) * 256; for (int t2 = 0; t2 < tl; ++t2) tb[66 + (tin - tl) + t2] = e; }
        if (e == NE - 1) { tb[32] = cum; tb[65] = tin; }
    }
    __syncthreads();
}
DI void p_gather(const Frame& F, int l) {
    LAS int* base = (LAS int*)F.lds;
    LAS int* segt = base + NGRP * NE;
    LAS int* offp = segt + 16 * NE;
    const int* BC = (const int*)(F.ws + WS_BC);
    { int tmp[NGRP * NE / NTHREADS];
#pragma unroll
      for (int q = 0; q < NGRP * NE / NTHREADS; ++q) tmp[q] = BC[F.tid + q * NTHREADS];
#pragma unroll
      for (int q = 0; q < NGRP * NE / NTHREADS; ++q) base[F.tid + q * NTHREADS] = tmp[q]; }
    __syncthreads();
    { const int e = F.tid & 31, sg = F.tid >> 5; int run = 0;
      for (int g = 16 * sg; g < 16 * sg + 16; ++g) { const int c = base[g * NE + e]; base[g * NE + e] = run; run += c; }
      segt[sg * NE + e] = run; }
    __syncthreads();
    if (F.tid < NE) { int run = 0; for (int sg = 0; sg < 16; ++sg) { const int c = segt[sg * NE + F.tid]; segt[sg * NE + F.tid] = run; run += c; }
        offp[F.tid] = run;
        if (F.bx == 0) ((int*)(F.ws + WS_CNTF))[F.tid] = run; }
    __syncthreads();
    if (F.tid == 0) { int off = 0; for (int e = 0; e < NE; ++e) { const int c = offp[e]; offp[e] = off; off += ((c + 255) >> 8) * 256; } }
    __syncthreads();
    const int* TOKSLOT = (const int*)(F.ws + WS_TOKSLOT); const float* TOKW = (const float*)(F.ws + WS_TOKW); int* TOKFIN = (int*)(F.ws + WS_TOKFIN);
    float* SLOTW = (float*)(F.ws + WS_SLOTW);
    const int nas = (2 * T - F.gw + F.ngw - 1) / F.ngw;
    int my_slot = 0, my_tok = 0;
    if (F.lane < nas) { const int as = F.gw + F.lane * F.ngw; const int tok = as >> 1, ts = TOKSLOT[as], e = ts >> 14, grp = tok >> 6, sg = grp >> 4;
        my_slot = offp[e] + segt[sg * NE + e] + base[grp * NE + e] + (ts & 16383); my_tok = tok;
        SLOTW[my_slot] = TOKW[as]; TOKFIN[as] = my_slot; ((int*)(F.ws + WS_CTL + WS_SLOTTOK))[my_slot] = tok; }
}
#ifdef RESBF
struct Rp2In { u32x2 x[4]; u32x2 y0[4], y1[4]; };
DI void rp2_load(Rp2In& r, const float* XA, const bf16_t* YS, int row, int s0, int s1, int lane) {
    const bf16_t* XAb = (const bf16_t*)XA;
#pragma unroll
    for (int j = 0; j < 4; ++j) { const int col = 4 * lane + 256 * j;
        r.x[j] = *(const u32x2*)(XAb + (size_t)row * D + col); r.y0[j] = *(const u32x2*)(YS + (size_t)s0 * D + col); r.y1[j] = *(const u32x2*)(YS + (size_t)s1 * D + col); }
}
#define RP2_XV(p_) ((f32x4){bflo(p_.x), bfhi(p_.x), bflo(p_.y), bfhi(p_.y)})
#else
struct Rp2In { f32x4 x[4]; u32x2 y0[4], y1[4]; };
DI void rp2_load(Rp2In& r, const float* XA, const bf16_t* YS, int row, int s0, int s1, int lane) {
#pragma unroll
    for (int j = 0; j < 4; ++j) { const int col = 4 * lane + 256 * j;
        r.x[j] = *(const f32x4*)(XA + (size_t)row * D + col); r.y0[j] = *(const u32x2*)(YS + (size_t)s0 * D + col); r.y1[j] = *(const u32x2*)(YS + (size_t)s1 * D + col); }
}
#define RP2_XV(p_) (p_)
#endif
DI void p_rowpass2(const Frame& F, const Args& a, int l, float* xout) {
    const float* MOD = (const float*)(F.ws + WS_MOD);
    const float* XA = (const float*)(F.ws + WS_XA); const bf16_t* YS = (const bf16_t*)(F.ws + WS_YS); const int* TOKFIN = (const int*)(F.ws + WS_TOKFIN);
    const float* gain = a.in[22] + (size_t)l * D; const float* bias = a.in[23] + (size_t)l * D;
    bf16_t* U = (bf16_t*)(F.ws + WS_U);
    const int nrows = (T - F.gw + F.ngw - 1) / F.ngw;
    int tf = 0; { const int i = F.lane >> 1; if (i < nrows) tf = TOKFIN[(F.gw + i * F.ngw) * 2 + (F.lane & 1)]; }
    Rp2In cur, nxt;
    if (nrows > 0) rp2_load(cur, XA, YS, F.gw, __shfl(tf, 0), __shfl(tf, 1), F.lane);
    for (int i = 0; i < nrows; ++i) {
        const int row = F.gw + i * F.ngw;
        if (i + 1 < nrows) rp2_load(nxt, XA, YS, row + F.ngw, __shfl(tf, 2 * i + 2), __shfl(tf, 2 * i + 3), F.lane);
        const float* md = MOD + (size_t)(l * NB + row / S) * MODW;
        f32x4 v[4];
#pragma unroll
        for (int j = 0; j < 4; ++j) { const int col = 4 * F.lane + 256 * j;
            const f32x4 g = *(const f32x4*)(md + 5 * D + col);
            const u32x2 y0 = cur.y0[j], y1 = cur.y1[j];
            const f32x4 f = (f32x4){bflo(y0.x) + bflo(y1.x), bfhi(y0.x) + bfhi(y1.x), bflo(y0.y) + bflo(y1.y), bfhi(y0.y) + bfhi(y1.y)};
            v[j] = RP2_XV(cur.x[j]) * ALPHA + g * f; }
        float mean, rstd; row_ln(v, mean, rstd);
#pragma unroll
        for (int j = 0; j < 4; ++j) { const int col = 4 * F.lane + 256 * j; v[j] = v[j] * rstd * *(const f32x4*)(gain + col) + *(const f32x4*)(bias + col);
#ifdef TSTAMP
            if (l == L - 1) { const unsigned long long* st = (const unsigned long long*)(F.ws + WS_CTL + 40960); const float sc = 1.f + (float)(long long)(st[TS_B] - st[TS_A]) * 1e-5f; *(f32x4*)(xout + (size_t)row * D + col) = v[j] * sc; } else
#endif
#ifdef RESBF
            if (l + 1 < L) *(u32x2*)((bf16_t*)xout + (size_t)row * D + col) = (u32x2){cvtpk(v[j][0], v[j][1]), cvtpk(v[j][2], v[j][3])}; else
#endif
            *(f32x4*)(xout + (size_t)row * D + col) = v[j]; }
        if (l + 1 < L) row_mod_store(v, MOD + (size_t)((l + 1) * NB + row / S) * MODW, 0, D, U + (size_t)row * D, F.lane);
        if (i + 1 < nrows) {
#pragma unroll
            for (int j = 0; j < 4; ++j) { cur.x[j] = nxt.x[j]; cur.y0[j] = nxt.y0[j]; cur.y1[j] = nxt.y1[j]; } }
    }
}

#define MFMA16(a, b, c) __builtin_amdgcn_mfma_f32_16x16x32_bf16((a), (b), (c), 0, 0, 0)
#define MFMA32(a, b, c) __builtin_amdgcn_mfma_f32_32x32x16_bf16((a), (b), (c), 0, 0, 0)
constexpr int RB = 9216;
#define BUF(i) ((i) * RB)
constexpr int LWOFF = BUF(12), ZAOFF = BUF(0), SEGOFF = BUF(14), SEGXOFF = BUF(14) + 2048, TOTOFF = BUF(14) + 4096, NABFOFF = BUF(15), PCOFF = 16 * RB;
struct RwP { const float *conv, *w0, *w_up, *a0, *a_up, *g_up, *k_k, *k_a, *r_k, *gn_gain, *gn_bias; };

DI void lds_barrier() { asm volatile("s_waitcnt lgkmcnt(0)" ::: "memory"); __builtin_amdgcn_s_barrier(); asm volatile("" ::: "memory"); }
DI int swo(int row, int col) { return row * 144 + (((((col >> 3) ^ (row >> 3)) & 7) << 3) + (col & 7)) * 2; }
DI bf16x8 ldfrag(const LAS unsigned char* lds, int buf, int row, int ks, int lane) { return *(const LAS bf16x8*)(lds + buf + swo(row, 32 * ks + 8 * (lane >> 4))); }
DI f32x4 mm64(const LAS unsigned char* lds, int abuf, int arow0, int bbuf, int brow0, int lane) {
    f32x4 acc = (f32x4){0.f, 0.f, 0.f, 0.f};
#pragma unroll
    for (int ks = 0; ks < 2; ++ks) acc = MFMA16(ldfrag(lds, abuf, arow0 + (lane & 15), ks, lane), ldfrag(lds, bbuf, brow0 + (lane & 15), ks, lane), acc);
    return acc;
}
DI u32x2 pack4(const f32x4 v) { u32x2 w; w.x = cvtpk(v[0], v[1]); w.y = cvtpk(v[2], v[3]); return w; }
DI f32x4 unpack4(const u32x2 w) { return (f32x4){bflo(w.x), bfhi(w.x), bflo(w.y), bfhi(w.y)}; }
DI void st4(LAS unsigned char* lds, int buf, int row, int col, const f32x4 v) { *(LAS u32x2*)(lds + buf + swo(row, col)) = pack4(v); }
DI f32x4 ld4(const LAS unsigned char* lds, int buf, int row, int col) { return unpack4(*(const LAS u32x2*)(lds + buf + swo(row, col))); }
DI void st1(LAS unsigned char* lds, int buf, int row, int col, float v) { *(LAS bf16_t*)(lds + buf + swo(row, col)) = f2bf(v); }
DI float fast_tanh(float x) { const float e = fexp2(x * (2.f * LOG2E)); return 1.f - 2.f * frcp(1.f + e); }

#define OPQZ(z) int z; asm volatile("s_mov_b32 %0, 0" : "=s"(z))
constexpr int CWLOFF = PCOFF + 256;
constexpr int PRMOFF = CWLOFF + 6912;
struct RwPre { u32x2 wv, av; u32x4 gv; f32x4 w4, a4, g0, g1; u32x4 rr[3], kk[3], vv[3]; };
DI void rwkv_prefetch(const Frame& F, const Args& a, const int l, const int unit, RwPre& P) {
    const int tid = F.tid;
    const int c = unit % NCH, hd = (unit / NCH) % BH, b = (unit / (NCH * BH)) % NB, dir = unit / (NCH * BH * NB);
    const bf16_t* HBp = (const bf16_t*)(F.ws + WS_HB);
    const int u = tid >> 3, jg = tid & 7, tloc = 64 * c + u; const size_t tok = (size_t)b * S + tloc;
    const bf16_t* hrow = HBp + tok * HW;
    P.wv = *(const u32x2*)(hrow + HWL + 4 * jg); P.av = *(const u32x2*)(hrow + HAL + 4 * jg); P.gv = *(const u32x4*)(hrow + HGL + 8 * jg);
    OPQZ(z0);
    { const int m = tid >> 4, j4 = (tid & 15) * 4;
      const float* w_up = a.in[8 + z0] + (size_t)l * 2 * RW * BW; const float* a_up = a.in[10 + z0] + (size_t)l * 2 * RA * BW;
      P.w4 = *(const f32x4*)(w_up + (size_t)(dir * RW + m) * BW + hd * HD + j4); P.a4 = *(const f32x4*)(a_up + (size_t)(dir * RA + m) * BW + hd * HD + j4); }
    { const int m = tid >> 3, i8 = (tid & 7) * 8; const float* g_up = a.in[11 + z0] + (size_t)l * RG * BW;
      P.g0 = *(const f32x4*)(g_up + (size_t)m * BW + hd * HD + i8); P.g1 = *(const f32x4*)(g_up + (size_t)m * BW + hd * HD + i8 + 4); }
    const int ch0 = hd * HD + 8 * jg;
#pragma unroll
    for (int x = 0; x < 3; ++x) {
        const int tt = tloc + x - 1; const u32x4 z4 = (u32x4){0u, 0u, 0u, 0u};
        if (tt >= 0 && tt < S) { const bf16_t* hp = HBp + ((size_t)b * S + tt) * HW + HR + ch0; P.rr[x] = *(const u32x4*)hp; P.kk[x] = *(const u32x4*)(hp + BW); P.vv[x] = *(const u32x4*)(hp + 2 * BW); }
        else { P.rr[x] = z4; P.kk[x] = z4; P.vv[x] = z4; }
    }
}
DI void rwkv_local_unit(const Frame& F, const Args& a, const int l, const int unit, RwPre& PF, const int next_unit) {
    LAS unsigned char* lds = F.lds;
    int tid_ = F.tid; asm volatile("" : "+v"(tid_));
    const int tid = tid_, lane = tid_ & 63, wave = F.wave;
    const int c = unit % NCH, hd = (unit / NCH) % BH, b = (unit / (NCH * BH)) % NB, dir = unit / (NCH * BH * NB);
    const bf16_t* HBp = (const bf16_t*)(F.ws + WS_HB);
    const int u = tid >> 3, jg = tid & 7, tau = dir ? 63 - u : u, tloc = 64 * c + u;
    const size_t tok = (size_t)b * S + tloc;
    const int tn = wave & 3, tm0 = 2 * (wave >> 2), g4 = lane >> 4, l15 = lane & 15;
    if (tid < 320) { OPQZ(z2); const int which = tid >> 6, j = tid & 63;
      const float* src = which == 0 ? a.in[7 + z2] + (size_t)l * 2 * BW + dir * BW : which == 1 ? a.in[9 + z2] + (size_t)l * 2 * BW + dir * BW : which == 2 ? a.in[12 + z2] + (size_t)l * BW : which == 3 ? a.in[13 + z2] + (size_t)l * BW : a.in[14 + z2] + (size_t)l * BH * HD;
      *(LAS float*)(lds + PRMOFF + tid * 4) = src[hd * HD + j]; }
    {
        const f32x4 wf = unpack4(PF.wv);
        *(LAS u32x2*)(lds + BUF(8) + swo(tau, 4 * jg)) = pack4((f32x4){fast_tanh(wf[0]), fast_tanh(wf[1]), fast_tanh(wf[2]), fast_tanh(wf[3])});
        *(LAS u32x2*)(lds + BUF(8) + swo(tau, 32 + 4 * jg)) = PF.av;
        const u32x4 gv = PF.gv;
        u32x4 so; so.x = cvtpk(sigm(bflo(gv.x)), sigm(bfhi(gv.x))); so.y = cvtpk(sigm(bflo(gv.y)), sigm(bfhi(gv.y))); so.z = cvtpk(sigm(bflo(gv.z)), sigm(bfhi(gv.z))); so.w = cvtpk(sigm(bflo(gv.w)), sigm(bfhi(gv.w)));
        *(LAS u32x4*)(lds + BUF(9) + swo(tau, 8 * jg)) = so;
        { const int m = tid >> 4, j4 = (tid & 15) * 4;
#pragma unroll
          for (int e = 0; e < 4; ++e) { st1(lds, BUF(10), j4 + e, m, PF.w4[e]); st1(lds, BUF(10), j4 + e, 32 + m, PF.a4[e]); } }
        { const int m = tid >> 3, i8 = (tid & 7) * 8;
#pragma unroll
          for (int e = 0; e < 4; ++e) { st1(lds, BUF(11), i8 + e, m, PF.g0[e]); st1(lds, BUF(11), i8 + 4 + e, m, PF.g1[e]); } }
    }
    lds_barrier();
#pragma unroll
    for (int tmi = 0; tmi < 2; ++tmi) {
        const int tm = tm0 + tmi; const f32x4 z = (f32x4){0.f, 0.f, 0.f, 0.f};
        const f32x4 zw = MFMA16(ldfrag(lds, BUF(10), 16 * tm + l15, 0, lane), ldfrag(lds, BUF(8), 16 * tn + l15, 0, lane), z);
        const f32x4 za = MFMA16(ldfrag(lds, BUF(10), 16 * tm + l15, 1, lane), ldfrag(lds, BUF(8), 16 * tn + l15, 1, lane), z);
        const int trow = 16 * tn + l15, jb = 16 * tm + 4 * g4;
        *(LAS f32x4*)(lds + LWOFF + (trow * 64 + jb) * 4) = zw;
        *(LAS f32x4*)(lds + ZAOFF + (trow * 64 + jb) * 4) = za;
        if (dir == 0) {
            const f32x4 gg = mm64(lds, BUF(11), 16 * tm, BUF(9), 16 * tn, lane);
            *(u32x2*)((bf16_t*)(F.ws + WS_GB) + ((size_t)b * S + 64 * c + trow) * BW + hd * HD + jb) = pack4(gg);
        }
    }
    lds_barrier();
    const int ch0 = hd * HD + 8 * jg;
    float r[8], kd[8], kap[8], bb[8], lw[8];
    {
        float k[8], v[8];
#pragma unroll
        for (int e = 0; e < 8; ++e) { r[e] = 0.f; k[e] = 0.f; v[e] = 0.f; }
#pragma unroll
        for (int x = 0; x < 3; ++x) {
            const LAS unsigned char* cwp = lds + CWLOFF + (((hd * 3 + x) * 3) * 64 + 8 * jg) * 2;
            const u32x4 cr = *(const LAS u32x4*)cwp, ck = *(const LAS u32x4*)(cwp + 128), cv = *(const LAS u32x4*)(cwp + 256);
            const u32x4 rr = PF.rr[x], kk2 = PF.kk[x], vv = PF.vv[x];
            r[0] += bflo(rr.x) * bflo(cr.x); r[1] += bfhi(rr.x) * bfhi(cr.x); r[2] += bflo(rr.y) * bflo(cr.y); r[3] += bfhi(rr.y) * bfhi(cr.y);
            r[4] += bflo(rr.z) * bflo(cr.z); r[5] += bfhi(rr.z) * bfhi(cr.z); r[6] += bflo(rr.w) * bflo(cr.w); r[7] += bfhi(rr.w) * bfhi(cr.w);
            k[0] += bflo(kk2.x) * bflo(ck.x); k[1] += bfhi(kk2.x) * bfhi(ck.x); k[2] += bflo(kk2.y) * bflo(ck.y); k[3] += bfhi(kk2.y) * bfhi(ck.y);
            k[4] += bflo(kk2.z) * bflo(ck.z); k[5] += bfhi(kk2.z) * bfhi(ck.z); k[6] += bflo(kk2.w) * bflo(ck.w); k[7] += bfhi(kk2.w) * bfhi(ck.w);
            v[0] += bflo(vv.x) * bflo(cv.x); v[1] += bfhi(vv.x) * bfhi(cv.x); v[2] += bflo(vv.y) * bflo(cv.y); v[3] += bfhi(vv.y) * bfhi(cv.y);
            v[4] += bflo(vv.z) * bflo(cv.z); v[5] += bfhi(vv.z) * bfhi(cv.z); v[6] += bflo(vv.w) * bflo(cv.w); v[7] += bfhi(vv.w) * bfhi(cv.w);
        }
        const f32x4 zw0 = *(const LAS f32x4*)(lds + LWOFF + (tau * 64 + 8 * jg) * 4), zw1 = *(const LAS f32x4*)(lds + LWOFF + (tau * 64 + 8 * jg + 4) * 4);
        const f32x4 za0 = *(const LAS f32x4*)(lds + ZAOFF + (tau * 64 + 8 * jg) * 4), za1 = *(const LAS f32x4*)(lds + ZAOFF + (tau * 64 + 8 * jg + 4) * 4);
        float ss = 0.f, bsp = 0.f, av[8];
        const LAS f32x4* prm = (const LAS f32x4*)(lds + PRMOFF) + 2 * jg;
        const f32x4 w0a = prm[0], w0b = prm[1], a0a = prm[16], a0b = prm[17], kka = prm[32], kkb = prm[33], kaa = prm[48], kab = prm[49], rka = prm[64], rkb = prm[65];
#pragma unroll
        for (int e = 0; e < 8; ++e) {
            const float zw = (e < 4 ? zw0[e & 3] : zw1[e & 3]) + (e < 4 ? w0a[e & 3] : w0b[e & 3]);
            const float za = (e < 4 ? za0[e & 3] : za1[e & 3]) + (e < 4 ? a0a[e & 3] : a0b[e & 3]);
            lw[e] = (-DECAY * LOG2E) * sigm(zw); av[e] = sigm(za);
            kap[e] = k[e] * (e < 4 ? kka[e & 3] : kkb[e & 3]); ss += kap[e] * kap[e];
            kd[e] = k[e] * (1.f + (av[e] - 1.f) * (e < 4 ? kaa[e & 3] : kab[e & 3]));
            bsp += r[e] * kd[e] * (e < 4 ? rka[e & 3] : rkb[e & 3]);
        }
        ss += __shfl_xor(ss, 1); ss += __shfl_xor(ss, 2); ss += __shfl_xor(ss, 4);
        bsp += __shfl_xor(bsp, 1); bsp += __shfl_xor(bsp, 2); bsp += __shfl_xor(bsp, 4);
        const float rn = __builtin_amdgcn_rsqf(fmaxf(ss, 1e-24f));
#pragma unroll
        for (int e = 0; e < 8; ++e) { kap[e] *= rn; bb[e] = kap[e] * av[e]; }
        if (jg == 0) ((float*)(F.ws + WS_BS))[((size_t)dir * T + tok) * 8 + hd] = bsp;
        *(LAS f32x4*)(lds + LWOFF + (tau * 64 + 8 * jg) * 4) = (f32x4){lw[0], lw[1], lw[2], lw[3]};
        *(LAS f32x4*)(lds + LWOFF + (tau * 64 + 8 * jg + 4) * 4) = (f32x4){lw[4], lw[5], lw[6], lw[7]};
#pragma unroll
        for (int e = 0; e < 8; ++e) st1(lds, BUF(7), 8 * jg + e, tau, v[e]);
        if (dir == 0) {
            u32x4 vo; vo.x = cvtpk(v[0], v[1]); vo.y = cvtpk(v[2], v[3]); vo.z = cvtpk(v[4], v[5]); vo.w = cvtpk(v[6], v[7]);
            *(u32x4*)((bf16_t*)(F.ws + WS_VC) + tok * BW + ch0) = vo;
        }
    }
    lds_barrier();
    if (dir == 0) {
        const size_t ucidx = ((size_t)b * BH + hd) * NCH + c; const int vi = tid >> 3, vc = tid & 7;
        *(u32x4*)((bf16_t*)(F.ws + WS_VTB) + ucidx * 4096 + vi * 64 + vc * 8) = *(const LAS u32x4*)(lds + BUF(7) + swo(vi, 8 * vc));
    }
    { const int seg = tid >> 6, j = tid & 63; float p = 0.f;
#pragma unroll
      for (int i = 0; i < 8; ++i) { LAS float* q = (LAS float*)(lds + LWOFF + ((8 * seg + i) * 64 + j) * 4); p += *q; *q = p; }
      *(LAS float*)(lds + SEGOFF + (seg * 64 + j) * 4) = p; }
    lds_barrier();
    if (tid < 64) { float run = 0.f;
#pragma unroll
      for (int sg = 0; sg < 8; ++sg) { *(LAS float*)(lds + SEGXOFF + (sg * 64 + tid) * 4) = run; run += *(const LAS float*)(lds + SEGOFF + (sg * 64 + tid) * 4); }
      *(LAS float*)(lds + TOTOFF + tid * 4) = run; }
    lds_barrier();
    {
        float At[8], Rt[8], Bt[8], Kt[8], Bh[8], Kh[8], pcs[8];
#pragma unroll
        for (int e = 0; e < 8; ++e) {
            const int j = 8 * jg + e;
            const float lwi = *(const LAS float*)(lds + LWOFF + (tau * 64 + j) * 4) + *(const LAS float*)(lds + SEGXOFF + ((tau >> 3) * 64 + j) * 4);
            const float tot = *(const LAS float*)(lds + TOTOFF + j * 4);
            const float ep = fexp2(lwi - lw[e]), epl = fexp2(lwi), em = fexp2(-lwi), ec = fexp2(tot - lwi);
            At[e] = -kap[e] * ep; Rt[e] = r[e] * epl; Bt[e] = bb[e] * em; Kt[e] = kd[e] * em; Bh[e] = bb[e] * ec; Kh[e] = kd[e] * ec;
            pcs[e] = tot;
        }
        if (u == 0) {
            *(LAS f32x4*)(lds + PCOFF + (8 * jg) * 4) = (f32x4){fexp2(pcs[0]), fexp2(pcs[1]), fexp2(pcs[2]), fexp2(pcs[3])};
            *(LAS f32x4*)(lds + PCOFF + (8 * jg + 4) * 4) = (f32x4){fexp2(pcs[4]), fexp2(pcs[5]), fexp2(pcs[6]), fexp2(pcs[7])}; }
        u32x4 o;
#define PK8(X) (o.x = cvtpk(X[0], X[1]), o.y = cvtpk(X[2], X[3]), o.z = cvtpk(X[4], X[5]), o.w = cvtpk(X[6], X[7]), o)
        *(LAS u32x4*)(lds + BUF(0) + swo(tau, 8 * jg)) = PK8(At);
        *(LAS u32x4*)(lds + BUF(1) + swo(tau, 8 * jg)) = PK8(Bt);
        *(LAS u32x4*)(lds + BUF(2) + swo(tau, 8 * jg)) = PK8(Kt);
        *(LAS u32x4*)(lds + BUF(3) + swo(tau, 8 * jg)) = PK8(Rt);
#undef PK8
#pragma unroll
        for (int e = 0; e < 8; ++e) { const int j = 8 * jg + e; st1(lds, BUF(4), j, tau, At[e]); st1(lds, BUF(5), j, tau, Bh[e]); st1(lds, BUF(6), j, tau, Kh[e]); }
    }
    if (next_unit >= 0) rwkv_prefetch(F, a, l, next_unit, PF);
    lds_barrier();
#pragma unroll
    for (int tmi = 0; tmi < 2; ++tmi) {
        const int tm = tm0 + tmi, mb = 16 * tm + 4 * g4, nn = 16 * tn + l15;
        { f32x4 v = mm64(lds, BUF(1), 16 * tm, BUF(0), 16 * tn, lane);
#pragma unroll
          for (int e = 0; e < 4; ++e) v[e] = (mb + e < nn) ? v[e] : 0.f;
          if (tm == tn) {
#pragma unroll
              for (int e = 0; e < 4; ++e) *(LAS float*)(lds + NABFOFF + ((16 * tm + l15) * 16 + ((mb + e) & 15)) * 4) = v[e];
              v = (f32x4){0.f, 0.f, 0.f, 0.f};
          }
          st4(lds, BUF(11), nn, mb, v); }
        { f32x4 v = mm64(lds, BUF(0), 16 * tm, BUF(2), 16 * tn, lane);
#pragma unroll
          for (int e = 0; e < 4; ++e) v[e] = (nn < mb + e) ? v[e] : 0.f;
          st4(lds, BUF(8), nn, mb, v); }
        { f32x4 v = mm64(lds, BUF(1), 16 * tm, BUF(3), 16 * tn, lane);
#pragma unroll
          for (int e = 0; e < 4; ++e) v[e] = (mb + e <= nn) ? v[e] : 0.f;
          st4(lds, BUF(9), nn, mb, v); }
        { f32x4 v = mm64(lds, BUF(2), 16 * tm, BUF(3), 16 * tn, lane);
#pragma unroll
          for (int e = 0; e < 4; ++e) v[e] = (mb + e <= nn) ? v[e] : 0.f;
          st4(lds, BUF(10), nn, mb, v); }
    }
    lds_barrier();
    if (wave == 0) {
        const int blk = lane >> 4, sr = lane & 15, s = 16 * blk + sr;
        float Tr[16];
#pragma unroll
        for (int t = 0; t < 16; ++t) { float acc = (t == sr) ? 1.f : 0.f;
            const LAS f32x4* col = (const LAS f32x4*)(lds + NABFOFF + ((16 * blk + t) * 16) * 4);
#pragma unroll
            for (int q = 0; q < (t + 3) / 4; ++q) { const f32x4 nv = col[q];
#pragma unroll
                for (int e = 0; e < 4; ++e) if (4 * q + e < t) acc += Tr[4 * q + e] * nv[e]; }
            Tr[t] = acc; __builtin_amdgcn_sched_barrier(0); }
        const u32x4 z4 = (u32x4){0u, 0u, 0u, 0u};
#pragma unroll
        for (int q = 0; q < 9; ++q) { *(LAS u32x4*)(lds + BUF(0) + s * 144 + 16 * q) = z4; *(LAS u32x4*)(lds + BUF(1) + s * 144 + 16 * q) = z4; }
        u32x4 o0, o1; o0.x = cvtpk(Tr[0], Tr[1]); o0.y = cvtpk(Tr[2], Tr[3]); o0.z = cvtpk(Tr[4], Tr[5]); o0.w = cvtpk(Tr[6], Tr[7]);
        o1.x = cvtpk(Tr[8], Tr[9]); o1.y = cvtpk(Tr[10], Tr[11]); o1.z = cvtpk(Tr[12], Tr[13]); o1.w = cvtpk(Tr[14], Tr[15]);
        LDS_WAIT();
        *(LAS u32x4*)(lds + BUF(0) + swo(s, 16 * blk)) = o0; *(LAS u32x4*)(lds + BUF(0) + swo(s, 16 * blk + 8)) = o1;
#pragma unroll
        for (int t = 0; t < 16; ++t) st1(lds, BUF(1), 16 * blk + t, s, Tr[t]);
    }
    lds_barrier();
#pragma unroll
    for (int tmi = 0; tmi < 2; ++tmi) {
        const int tm = tm0 + tmi, mb = 16 * tm + 4 * g4, nn = 16 * tn + l15;
        const f32x4 v = mm64(lds, BUF(0), 16 * tm, BUF(11), 16 * tn, lane);
        st4(lds, BUF(12), nn, mb, v);
#pragma unroll
        for (int e = 0; e < 4; ++e) st1(lds, BUF(2), mb + e, nn, v[e]);
    }
    lds_barrier();
#pragma unroll
    for (int tmi = 0; tmi < 2; ++tmi) {
        const int tm = tm0 + tmi, mb = 16 * tm + 4 * g4, nn = 16 * tn + l15;
        const f32x4 v = mm64(lds, BUF(12), 16 * tm, BUF(2), 16 * tn, lane);
        st4(lds, BUF(13), nn, mb, v);
    }
    lds_barrier();
#pragma unroll
    for (int tmi = 0; tmi < 2; ++tmi) {
        const int tm = tm0 + tmi, mb = 16 * tm + 4 * g4, nn = 16 * tn + l15;
        const f32x4 v = mm64(lds, BUF(13), 16 * tm, BUF(1), 16 * tn, lane) + ld4(lds, BUF(1), nn, mb);
        st4(lds, BUF(14), nn, mb, v);
    }
    lds_barrier();
#pragma unroll
    for (int tmi = 0; tmi < 2; ++tmi) {
        const int tm = tm0 + tmi, mb = 16 * tm + 4 * g4, nn = 16 * tn + l15;
        const f32x4 v = mm64(lds, BUF(2), 16 * tm, BUF(14), 16 * tn, lane) + ld4(lds, BUF(14), nn, mb);
        st4(lds, BUF(15), nn, mb, v);
    }
    lds_barrier();
#pragma unroll
    for (int tmi = 0; tmi < 2; ++tmi) {
        const int tm = tm0 + tmi, mb = 16 * tm + 4 * g4, nn = 16 * tn + l15;
        const f32x4 x1 = mm64(lds, BUF(15), 16 * tm, BUF(4), 16 * tn, lane);
        const f32x4 x2 = mm64(lds, BUF(15), 16 * tm, BUF(8), 16 * tn, lane);
        st4(lds, BUF(0), nn, mb, x1); st4(lds, BUF(1), nn, mb, x2);
    }
    lds_barrier();
    {
        bf16_t* QT = (bf16_t*)(F.ws + WS_QT) + (size_t)unit * 4096; bf16_t* WT = (bf16_t*)(F.ws + WS_WT) + (size_t)unit * 4096; bf16_t* MP = (bf16_t*)(F.ws + WS_MP) + USK(unit) * 4096;
#pragma unroll
        for (int tmi = 0; tmi < 2; ++tmi) {
            const int tm = tm0 + tmi, mb = 16 * tm + 4 * g4, nn = 16 * tn + l15;
            { const f32x4 v = mm64(lds, BUF(0), 16 * tm, BUF(9), 16 * tn, lane) + ld4(lds, BUF(3), nn, mb);
              *(u32x2*)(QT + (dir ? 63 - nn : nn) * 64 + mb) = pack4(v); }
            { const f32x4 v = mm64(lds, BUF(1), 16 * tm, BUF(9), 16 * tn, lane) + ld4(lds, BUF(10), nn, mb);
              if (dir) *(u32x2*)(WT + (63 - nn) * 64 + (60 - mb)) = pack4((f32x4){v[3], v[2], v[1], v[0]});
              else *(u32x2*)(WT + nn * 64 + mb) = pack4(v); }
            { const float pcv = *(const volatile LAS float*)(lds + PCOFF + nn * 4);
              f32x4 v = mm64(lds, BUF(0), 16 * tm, BUF(5), 16 * tn, lane);
#pragma unroll
              for (int e = 0; e < 4; ++e) v[e] += (mb + e == nn) ? pcv : 0.f;
              *(u32x2*)(MP + nn * 64 + swap23(mb)) = pack4(v); }
            { const f32x4 v = mm64(lds, BUF(1), 16 * tm, BUF(5), 16 * tn, lane) + ld4(lds, BUF(6), nn, mb);
              st4(lds, BUF(2), nn, mb, v); }
        }
    }
    lds_barrier();
    {
        bf16_t* NBp = (bf16_t*)(F.ws + WS_NB);
#pragma unroll
        for (int tmi = 0; tmi < 2; ++tmi) {
            const int tm = tm0 + tmi, mb = 16 * tm + 4 * g4, ii = 16 * tn + l15;
            const f32x4 v = mm64(lds, BUF(2), 16 * tm, BUF(7), 16 * tn, lane);
            const int jb = mb >> 5, jl = mb & 31, q = jl >> 3, hic = (jl >> 2) & 1, ih = ii >> 5, Lc = (ii & 31) + 32 * hic;
            *(u32x2*)(NBp + (((USK(unit) * 2 + ih) * 2 + jb) * 2 + (q >> 1)) * 512 + Lc * 8 + 4 * (q & 1)) = pack4(v);
        }
    }
    lds_barrier();
}

DI void attn_unit(const Frame& F, const LAS float* rpbl, const int au) {
    const bf16_t* HBp = (const bf16_t*)(F.ws + WS_HB); const bf16_t* VTp = (const bf16_t*)(F.ws + WS_VT); bf16_t* CONCAT = (bf16_t*)(F.ws + WS_CONCAT);
    const int hh = au % AH, r = (au / AH) % ROWS, b = au / (AH * ROWS);
    int rstart = r - KH / 2; rstart = rstart < 0 ? 0 : (rstart > ROWS - KH ? ROWS - KH : rstart);
    const int lane = F.lane, q32 = lane & 31, hi = lane >> 5;
    const float SC = 0.125f * LOG2E;
    const int krow_off = swap23(q32);
    const int cqA = q32, cqB = 32 + q32;
    int csA = cqA - KW / 2; csA = csA < 0 ? 0 : csA; int csB = cqB - KW / 2; csB = csB > GW - KW ? GW - KW : csB;
    const size_t tokA = (size_t)b * S + r * GW + cqA, tokB = tokA + 32;
    bf16x8 qfA[4], qfB[4];
#pragma unroll
    for (int ds = 0; ds < 4; ++ds) { qfA[ds] = *(const bf16x8*)(HBp + tokA * HW + HQ + hh * HD + 16 * ds + 8 * hi); qfB[ds] = *(const bf16x8*)(HBp + tokB * HW + HQ + hh * HD + 16 * ds + 8 * hi); }
    f32x16 oA0, oA1, oB0, oB1;
#pragma unroll
    for (int i = 0; i < 16; ++i) { oA0[i] = 0.f; oA1[i] = 0.f; oB0[i] = 0.f; oB1[i] = 0.f; }
    float mA = -1e30f, lA = 0.f, mB = -1e30f, lB = 0.f;
#ifdef ATT_PF
    bf16x8 kf[4], kfn[4];
    { const size_t ktok = (size_t)b * S + rstart * GW;
#pragma unroll
      for (int ds = 0; ds < 4; ++ds) kf[ds] = *(const bf16x8*)(HBp + (ktok + krow_off) * HW + HK + hh * HD + 16 * ds + 8 * hi); }
    __builtin_amdgcn_s_waitcnt(0x0F70);
#endif
#pragma unroll 1
    for (int kt = 0; kt < 2 * KH; ++kt) {
        const int kr = rstart + (kt >> 1), ckb = 32 * (kt & 1);
        const size_t ktok = (size_t)b * S + kr * GW + ckb;
#ifdef ATT_PF
        { const int ktn = kt + 1 < 2 * KH ? kt + 1 : kt; const size_t ktokn = (size_t)b * S + (rstart + (ktn >> 1)) * GW + 32 * (ktn & 1);
#pragma unroll
          for (int ds = 0; ds < 4; ++ds) kfn[ds] = *(const bf16x8*)(HBp + (ktokn + krow_off) * HW + HK + hh * HD + 16 * ds + 8 * hi); }
        bf16x8 vf[2][2];
#pragma unroll
        for (int db = 0; db < 2; ++db)
#pragma unroll
            for (int s = 0; s < 2; ++s) vf[db][s] = *(const bf16x8*)(VTp + (size_t)(hh * HD + 32 * db + q32) * T + ktok + 16 * s + 8 * hi);
#else
        bf16x8 kf[4], vf[2][2];
#pragma unroll
        for (int ds = 0; ds < 4; ++ds) kf[ds] = *(const bf16x8*)(HBp + (ktok + krow_off) * HW + HK + hh * HD + 16 * ds + 8 * hi);
#pragma unroll
        for (int db = 0; db < 2; ++db)
#pragma unroll
            for (int s = 0; s < 2; ++s) vf[db][s] = *(const bf16x8*)(VTp + (size_t)(hh * HD + 32 * db + q32) * T + ktok + 16 * s + 8 * hi);
#endif
        const LAS float* rp = rpbl + (hh * (2 * KH - 1) + (kr - r + KH - 1)) * (2 * KW - 1);
#pragma unroll
        for (int qb = 0; qb < 2; ++qb) {
            const int cq = qb ? cqB : cqA, cs = qb ? csB : csA;
            f32x16 st;
#pragma unroll
            for (int i = 0; i < 16; ++i) st[i] = 0.f;
#pragma unroll
            for (int ds = 0; ds < 4; ++ds) st = MFMA32(kf[ds], qb ? qfB[ds] : qfA[ds], st);
            float sl[16]; float tmax = -1e30f;
            float bia[16];
#pragma unroll
            for (int i = 0; i < 16; ++i) {
                const int ck = ckb + 16 * (i >> 3) + 8 * hi + (i & 7);
                int dc = ck - cq; dc = dc < -(KW - 1) ? -(KW - 1) : (dc > KW - 1 ? KW - 1 : dc); dc += KW - 1;
                bia[i] = *(const volatile LAS float*)(rp + dc);
            }
#pragma unroll
            for (int i = 0; i < 16; ++i) {
                const int ck = ckb + 16 * (i >> 3) + 8 * hi + (i & 7);
                const bool inw = (ck >= cs) && (ck < cs + KW);
                const float sv = st[i] * SC + bia[i];
                sl[i] = inw ? sv : -1e30f;
                tmax = fmaxf(tmax, sl[i]);
            }
            tmax = fmaxf(tmax, __shfl_xor(tmax, 32));
            const float mrun = qb ? mB : mA;
            const float mn = fmaxf(mrun, tmax), corr = __builtin_amdgcn_exp2f(mrun - mn);
            float ps = 0.f;
#pragma unroll
            for (int i = 0; i < 16; ++i) { sl[i] = (sl[i] > -1e29f) ? __builtin_amdgcn_exp2f(sl[i] - mn) : 0.f; ps += sl[i]; }
            u32x4 p0, p1;
            p0.x = cvtpk(sl[0], sl[1]); p0.y = cvtpk(sl[2], sl[3]); p0.z = cvtpk(sl[4], sl[5]); p0.w = cvtpk(sl[6], sl[7]);
            p1.x = cvtpk(sl[8], sl[9]); p1.y = cvtpk(sl[10], sl[11]); p1.z = cvtpk(sl[12], sl[13]); p1.w = cvtpk(sl[14], sl[15]);
            const bf16x8 pf0 = __builtin_bit_cast(bf16x8, p0), pf1 = __builtin_bit_cast(bf16x8, p1);
            if (qb == 0) { lA = lA * corr + ps; mA = mn;
#pragma unroll
                for (int i = 0; i < 16; ++i) { oA0[i] *= corr; oA1[i] *= corr; }
                oA0 = MFMA32(vf[0][0], pf0, oA0); oA0 = MFMA32(vf[0][1], pf1, oA0); oA1 = MFMA32(vf[1][0], pf0, oA1); oA1 = MFMA32(vf[1][1], pf1, oA1);
            } else { lB = lB * corr + ps; mB = mn;
#pragma unroll
                for (int i = 0; i < 16; ++i) { oB0[i] *= corr; oB1[i] *= corr; }
                oB0 = MFMA32(vf[0][0], pf0, oB0); oB0 = MFMA32(vf[0][1], pf1, oB0); oB1 = MFMA32(vf[1][0], pf0, oB1); oB1 = MFMA32(vf[1][1], pf1, oB1);
            }
        }
#ifdef ATT_PF
#pragma unroll
        for (int ds = 0; ds < 4; ++ds) kf[ds] = kfn[ds];
#endif
    }
    { const float inv = 1.f / (lA + __shfl_xor(lA, 32)); bf16_t* op = CONCAT + tokA * D + hh * HD;
#pragma unroll
      for (int g = 0; g < 4; ++g) {
          *(u32x2*)(op + 8 * g + 4 * hi) = pack4((f32x4){oA0[4 * g] * inv, oA0[4 * g + 1] * inv, oA0[4 * g + 2] * inv, oA0[4 * g + 3] * inv});
          *(u32x2*)(op + 32 + 8 * g + 4 * hi) = pack4((f32x4){oA1[4 * g] * inv, oA1[4 * g + 1] * inv, oA1[4 * g + 2] * inv, oA1[4 * g + 3] * inv}); } }
    { const float inv = 1.f / (lB + __shfl_xor(lB, 32)); bf16_t* op = CONCAT + tokB * D + hh * HD;
#pragma unroll
      for (int g = 0; g < 4; ++g) {
          *(u32x2*)(op + 8 * g + 4 * hi) = pack4((f32x4){oB0[4 * g] * inv, oB0[4 * g + 1] * inv, oB0[4 * g + 2] * inv, oB0[4 * g + 3] * inv});
          *(u32x2*)(op + 32 + 8 * g + 4 * hi) = pack4((f32x4){oB1[4 * g] * inv, oB1[4 * g + 1] * inv, oB1[4 * g + 2] * inv, oB1[4 * g + 3] * inv}); } }
}

DI void pool_unit(const Frame& F, const float* pool_w, const float* pool_scale, const int pu) {
    const bf16_t* HBp = (const bf16_t*)(F.ws + WS_HB); bf16_t* CONCAT = (bf16_t*)(F.ws + WS_CONCAT);
    const int g = pu & 3, blk = pu >> 2, b = blk >> 8, t0 = (blk & 255) * 32;
    const int lane = F.lane, q32 = lane & 31, hi = lane >> 5, t = t0 + q32, win = 2 << g;
    int lo = t - win / 2; lo = lo < 0 ? 0 : lo; int hit = t + win / 2 - 1; hit = hit > S - 1 ? S - 1 : hit;
    const float inv = 1.f / (float)(hit - lo + 1);
    f32x16 out0, out1;
#pragma unroll
    for (int i = 0; i < 16; ++i) { out0[i] = 0.f; out1[i] = 0.f; }
    const float* pw = pool_w + (size_t)g * 64 * 64;
#pragma unroll 1
    for (int s = 0; s < 4; ++s) {
        const int c0 = HP + g * 64 + 16 * s + 8 * hi;
        float acc[8];
#pragma unroll
        for (int e = 0; e < 8; ++e) acc[e] = 0.f;
        u32x4 pv[16];
#pragma unroll
        for (int d = 0; d < 16; ++d) { int tt = t - win / 2 + d; const bool ok = d < win && tt >= 0 && tt < S; tt = ok ? tt : t;
            pv[d] = *(const u32x4*)(HBp + ((size_t)b * S + tt) * HW + c0); if (!ok) pv[d] = (u32x4){0u, 0u, 0u, 0u}; }
#pragma unroll
        for (int d = 0; d < 16; ++d) {
            acc[0] += bflo(pv[d].x); acc[1] += bfhi(pv[d].x); acc[2] += bflo(pv[d].y); acc[3] += bfhi(pv[d].y); acc[4] += bflo(pv[d].z); acc[5] += bfhi(pv[d].z); acc[6] += bflo(pv[d].w); acc[7] += bfhi(pv[d].w);
        }
        const u32x4 pc = *(const u32x4*)(HBp + ((size_t)b * S + t) * HW + c0);
        u32x4 o;
        o.x = cvtpk(acc[0] * inv - bflo(pc.x), acc[1] * inv - bfhi(pc.x)); o.y = cvtpk(acc[2] * inv - bflo(pc.y), acc[3] * inv - bfhi(pc.y));
        o.z = cvtpk(acc[4] * inv - bflo(pc.z), acc[5] * inv - bfhi(pc.z)); o.w = cvtpk(acc[6] * inv - bflo(pc.w), acc[7] * inv - bfhi(pc.w));
        const bf16x8 bfr = __builtin_bit_cast(bf16x8, o);
        const float* wp = pw + (size_t)(16 * s + 8 * hi) * 64 + q32;
        u32x4 w0; w0.x = cvtpk(wp[0], wp[64]); w0.y = cvtpk(wp[128], wp[192]); w0.z = cvtpk(wp[256], wp[320]); w0.w = cvtpk(wp[384], wp[448]);
        u32x4 w1; w1.x = cvtpk(wp[32], wp[96]); w1.y = cvtpk(wp[160], wp[224]); w1.z = cvtpk(wp[288], wp[352]); w1.w = cvtpk(wp[416], wp[480]);
        out0 = MFMA32(__builtin_bit_cast(bf16x8, w0), bfr, out0);
        out1 = MFMA32(__builtin_bit_cast(bf16x8, w1), bfr, out1);
    }
    bf16_t* op = CONCAT + ((size_t)b * S + t) * D + AW + BW + g * 64;
    const float* ps = pool_scale + g * 64;
#pragma unroll
    for (int gq = 0; gq < 4; ++gq) {
        const int e0 = 8 * gq + 4 * hi;
        const f32x4 s0 = *(const f32x4*)(ps + e0), s1 = *(const f32x4*)(ps + 32 + e0);
        *(u32x2*)(op + e0) = pack4((f32x4){out0[4 * gq] * s0[0], out0[4 * gq + 1] * s0[1], out0[4 * gq + 2] * s0[2], out0[4 * gq + 3] * s0[3]});
        *(u32x2*)(op + 32 + e0) = pack4((f32x4){out1[4 * gq] * s1[0], out1[4 * gq + 1] * s1[1], out1[4 * gq + 2] * s1[2], out1[4 * gq + 3] * s1[3]});
    }
}

constexpr int SCAN_SLOT = 12288, SCAN_RING = 12;
constexpr int SCAN_FLAGS = SCAN_RING * SCAN_SLOT;
DI void scan_issue(const Frame& F, const int sc, const int ihalf, const int dir, const int step, const int lane) {
    const int c = dir ? NCH - 1 - step : step; const size_t unit = (size_t)sc * NCH + c;
    const int il = lane & 31, hi = lane >> 5;
    LAS unsigned char* slot = F.lds + (step % SCAN_RING) * SCAN_SLOT;
    const bf16_t* MP = (const bf16_t*)(F.ws + WS_MP) + USK(unit) * 4096; const bf16_t* NBp = (const bf16_t*)(F.ws + WS_NB) + (USK(unit) * 2 + ihalf) * 2048;
#pragma unroll
    for (int p = 0; p < 8; ++p) { const int jpb = p >> 2, jb = (p >> 1) & 1, s = p & 1;
        __builtin_amdgcn_global_load_lds((const unsigned*)(MP + (32 * jpb + il) * 64 + 32 * jb + 16 * s + 8 * hi), (LAS unsigned*)(slot + p * 1024), 16, 0, 0); }
#pragma unroll
    for (int p = 0; p < 4; ++p)
        __builtin_amdgcn_global_load_lds((const unsigned*)(NBp + p * 512 + lane * 8), (LAS unsigned*)(slot + 8192 + p * 1024), 16, 0, 0);
}
DI unsigned lds_ld_u32(const volatile LAS unsigned* p) { return __builtin_amdgcn_readfirstlane(*p); }
#ifndef NLD
#define NLD 2
#endif
constexpr int SC_INFL = NLD == 2 ? 5 : (NLD == 3 ? 4 : 3);
DI void scan_loader(const Frame& F, const int sw, const int ld) {
    const int ihalf = sw & 1, sc = sw >> 1, dir = sc / (NB * BH);
    volatile LAS unsigned* ready = (volatile LAS unsigned*)(F.lds + SCAN_FLAGS); volatile LAS unsigned* cons = ready + 16;
    const int nmine = (NCH - ld + NLD - 1) / NLD;
    constexpr int LAG = SC_INFL - 1;
    for (int k = 0; k < nmine + LAG; ++k) {
        if (k < nmine) {
            const int s = NLD * k + ld;
            if (s >= SCAN_RING) { unsigned spins = 0; while ((int)lds_ld_u32(cons) < s - SCAN_RING + 1) { __builtin_amdgcn_s_sleep(1); if (++spins > (1u << 22)) break; } }
            asm volatile("" ::: "memory");
            scan_issue(F, sc, ihalf, dir, s, F.lane);
        }
        if (k >= LAG) {
            const int kd = k - LAG;
            if (kd < nmine) {
                const int rem = nmine - 1 - kd;
                const int out = rem < LAG ? rem : LAG;
                if (out == 4) asm volatile("s_waitcnt vmcnt(48)" ::: "memory");
                else if (out == 3) asm volatile("s_waitcnt vmcnt(36)" ::: "memory");
                else if (out == 2) asm volatile("s_waitcnt vmcnt(24)" ::: "memory");
                else if (out == 1) asm volatile("s_waitcnt vmcnt(12)" ::: "memory");
                else asm volatile("s_waitcnt vmcnt(0)" ::: "memory");
                const int sd = NLD * kd + ld;
                if (F.lane == 0) ready[sd % SCAN_RING] = (unsigned)(sd + 1);
                asm volatile("s_waitcnt lgkmcnt(0)" ::: "memory");
            }
        }
    }
}
constexpr int S0_STAGE = SCAN_FLAGS + 256;
DI void scan_writer(const Frame& F, const int sw) {
    const int ihalf = sw & 1, sc = sw >> 1, dir = sc / (NB * BH);
    volatile LAS unsigned* ready = (volatile LAS unsigned*)(F.lds + SCAN_FLAGS);
    volatile LAS unsigned* s0rdy = ready + 17; volatile LAS unsigned* s0done = ready + 18;
    bf16_t* S0 = (bf16_t*)(F.ws + WS_S0);
    const int lane = F.lane;
#pragma unroll 1
    for (int step = 0; step < NCH; ++step) {
        const int c = dir ? NCH - 1 - step : step; const size_t unit = (size_t)sc * NCH + c;
        { unsigned spins = 0; while ((int)lds_ld_u32(s0rdy) < step + 1) { __builtin_amdgcn_s_sleep(1); if (++spins > (1u << 22)) break; } }
        asm volatile("" ::: "memory");
        const LAS unsigned char* sl = F.lds + S0_STAGE + (step & 1) * (32 * 144);
        u32x4 v[4];
#pragma unroll
        for (int p = 0; p < 4; ++p) { const int idx = p * 64 + lane; v[p] = *(const LAS u32x4*)(sl + (idx >> 3) * 144 + (idx & 7) * 16); }
        asm volatile("s_waitcnt lgkmcnt(0)" ::: "memory");
        if (lane == 0) *s0done = (unsigned)(step + 1);
        bf16_t* dst = S0 + USK(unit) * 4096 + ihalf * 2048;
#pragma unroll
        for (int p = 0; p < 4; ++p) *(u32x4*)(dst + (p * 64 + lane) * 8) = v[p];
    }
}
DI void scan_wave(const Frame& F, const int sw) {
    const int ihalf = sw & 1, sc = sw >> 1, dir = sc / (NB * BH);
    const int lane = F.lane, il = lane & 31, hi = lane >> 5;
    bf16_t* S0 = (bf16_t*)(F.ws + WS_S0);
    volatile LAS unsigned* ready = (volatile LAS unsigned*)(F.lds + SCAN_FLAGS); volatile LAS unsigned* cons = ready + 16;
    volatile LAS unsigned* s0rdy = ready + 17; volatile LAS unsigned* s0done = ready + 18; (void)s0rdy; (void)s0done;
    f32x16 st0, st1;
#pragma unroll
    for (int i = 0; i < 16; ++i) { st0[i] = 0.f; st1[i] = 0.f; }
    bf16x8 ma[8], man[8]; u32x4 nbv[4], nbn[4];
    { unsigned spins = 0; while (lds_ld_u32(ready) != 1u) { __builtin_amdgcn_s_sleep(1); if (++spins > (1u << 22)) break; } }
    asm volatile("" ::: "memory");
#pragma unroll
    for (int p = 0; p < 8; ++p) ma[p] = *(const LAS bf16x8*)(F.lds + p * 1024 + lane * 16);
#pragma unroll
    for (int p = 0; p < 4; ++p) nbv[p] = *(const LAS u32x4*)(F.lds + 8192 + p * 1024 + lane * 16);
#pragma unroll 1
    for (int step = 0; step < NCH; ++step) {
        const int c = dir ? NCH - 1 - step : step; const size_t unit = (size_t)sc * NCH + c;
        const bool more = step + 1 < NCH;
#ifdef S0_WRITER
        if (step >= 2) { unsigned spins = 0; while ((int)lds_ld_u32(s0done) < step - 1) { __builtin_amdgcn_s_sleep(1); if (++spins > (1u << 22)) break; } }
        asm volatile("" ::: "memory");
#endif
        if (more) {
            { unsigned spins = 0; while (lds_ld_u32(ready + ((step + 1) % SCAN_RING)) != (unsigned)(step + 2)) { __builtin_amdgcn_s_sleep(1); if (++spins > (1u << 22)) break; } }
            asm volatile("" ::: "memory");

            const LAS unsigned char* slot = F.lds + ((step + 1) % SCAN_RING) * SCAN_SLOT;
#pragma unroll
            for (int p = 0; p < 8; ++p) man[p] = *(const LAS bf16x8*)(slot + p * 1024 + lane * 16);
#pragma unroll
            for (int p = 0; p < 4; ++p) nbn[p] = *(const LAS u32x4*)(slot + 8192 + p * 1024 + lane * 16);
        }
        bf16_t* sp = S0 + USK(unit) * 4096 + (size_t)(32 * ihalf + il) * 64;
        u32x4 b00, b01, b10, b11;
        b00.x = cvtpk(st0[0], st0[1]); b00.y = cvtpk(st0[2], st0[3]); b00.z = cvtpk(st0[4], st0[5]); b00.w = cvtpk(st0[6], st0[7]);
        b01.x = cvtpk(st0[8], st0[9]); b01.y = cvtpk(st0[10], st0[11]); b01.z = cvtpk(st0[12], st0[13]); b01.w = cvtpk(st0[14], st0[15]);
        b10.x = cvtpk(st1[0], st1[1]); b10.y = cvtpk(st1[2], st1[3]); b10.z = cvtpk(st1[4], st1[5]); b10.w = cvtpk(st1[6], st1[7]);
        b11.x = cvtpk(st1[8], st1[9]); b11.y = cvtpk(st1[10], st1[11]); b11.z = cvtpk(st1[12], st1[13]); b11.w = cvtpk(st1[14], st1[15]);
#ifdef S0_WRITER
        { LAS unsigned char* sl = F.lds + S0_STAGE + (step & 1) * (32 * 144) + il * 144 + 8 * hi;
          {
          *(LAS u32x2*)(sl + 0) = (u32x2){b00.x, b00.y};  *(LAS u32x2*)(sl + 16) = (u32x2){b00.z, b00.w};
          *(LAS u32x2*)(sl + 32) = (u32x2){b01.x, b01.y}; *(LAS u32x2*)(sl + 48) = (u32x2){b01.z, b01.w};
          *(LAS u32x2*)(sl + 64) = (u32x2){b10.x, b10.y}; *(LAS u32x2*)(sl + 80) = (u32x2){b10.z, b10.w};
          *(LAS u32x2*)(sl + 96) = (u32x2){b11.x, b11.y}; *(LAS u32x2*)(sl + 112) = (u32x2){b11.z, b11.w}; }
          asm volatile("" ::: "memory");
          if (lane == 0) *s0rdy = (unsigned)(step + 1); }
        (void)sp;
#else
        *(u32x2*)(sp + 0 + 4 * hi) = (u32x2){b00.x, b00.y};  *(u32x2*)(sp + 8 + 4 * hi) = (u32x2){b00.z, b00.w};
        *(u32x2*)(sp + 16 + 4 * hi) = (u32x2){b01.x, b01.y}; *(u32x2*)(sp + 24 + 4 * hi) = (u32x2){b01.z, b01.w};
        *(u32x2*)(sp + 32 + 4 * hi) = (u32x2){b10.x, b10.y}; *(u32x2*)(sp + 40 + 4 * hi) = (u32x2){b10.z, b10.w};
        *(u32x2*)(sp + 48 + 4 * hi) = (u32x2){b11.x, b11.y}; *(u32x2*)(sp + 56 + 4 * hi) = (u32x2){b11.z, b11.w};
#endif
        const bf16x8 p00 = __builtin_bit_cast(bf16x8, b00), p01 = __builtin_bit_cast(bf16x8, b01), p10 = __builtin_bit_cast(bf16x8, b10), p11 = __builtin_bit_cast(bf16x8, b11);
        f32x16 n0, n1;
#pragma unroll
        for (int h2 = 0; h2 < 2; ++h2) {
            n0[8 * h2 + 0] = bflo(nbv[h2].x); n0[8 * h2 + 1] = bfhi(nbv[h2].x); n0[8 * h2 + 2] = bflo(nbv[h2].y); n0[8 * h2 + 3] = bfhi(nbv[h2].y);
            n0[8 * h2 + 4] = bflo(nbv[h2].z); n0[8 * h2 + 5] = bfhi(nbv[h2].z); n0[8 * h2 + 6] = bflo(nbv[h2].w); n0[8 * h2 + 7] = bfhi(nbv[h2].w);
            n1[8 * h2 + 0] = bflo(nbv[2 + h2].x); n1[8 * h2 + 1] = bfhi(nbv[2 + h2].x); n1[8 * h2 + 2] = bflo(nbv[2 + h2].y); n1[8 * h2 + 3] = bfhi(nbv[2 + h2].y);
            n1[8 * h2 + 4] = bflo(nbv[2 + h2].z); n1[8 * h2 + 5] = bfhi(nbv[2 + h2].z); n1[8 * h2 + 6] = bflo(nbv[2 + h2].w); n1[8 * h2 + 7] = bfhi(nbv[2 + h2].w);
        }
        n0 = MFMA32(ma[0], p00, n0); n1 = MFMA32(ma[4], p00, n1);
        n0 = MFMA32(ma[1], p01, n0); n1 = MFMA32(ma[5], p01, n1);
        n0 = MFMA32(ma[2], p10, n0); n1 = MFMA32(ma[6], p10, n1);
        n0 = MFMA32(ma[3], p11, n0); n1 = MFMA32(ma[7], p11, n1);
        st0 = n0; st1 = n1;
        if (more) {
            asm volatile("s_waitcnt lgkmcnt(0)" ::: "memory");
            if (lane == 0) *cons = (unsigned)(step + 2);
#pragma unroll
            for (int p = 0; p < 8; ++p) ma[p] = man[p];
#pragma unroll
            for (int p = 0; p < 4; ++p) nbv[p] = nbn[p];
        }
    }
}

DI void rwkv_out_unit(const Frame& F, const RwP& P, const int du) {
    const int qd = du & 3, cidx = du >> 2, c = cidx % NCH, hd = (cidx / NCH) % BH, b = cidx / (NCH * BH);
    const int lane = F.lane, n = lane & 15, g = lane >> 4, u = 16 * qd + n;
    const bf16_t* QT = (const bf16_t*)(F.ws + WS_QT); const bf16_t* WT = (const bf16_t*)(F.ws + WS_WT); const bf16_t* S0 = (const bf16_t*)(F.ws + WS_S0);
    const bf16_t* VTB = (const bf16_t*)(F.ws + WS_VTB) + (size_t)cidx * 4096;
    f32x4 acc[4];
#pragma unroll
    for (int tm = 0; tm < 4; ++tm) acc[tm] = (f32x4){0.f, 0.f, 0.f, 0.f};
#pragma unroll
    for (int dir = 0; dir < 2; ++dir) {
        const size_t unit = (((size_t)dir * NB + b) * BH + hd) * NCH + c;
#pragma unroll
        for (int ks = 0; ks < 2; ++ks) {
            const bf16x8 bq = *(const bf16x8*)(QT + unit * 4096 + u * 64 + 32 * ks + 8 * g);
            const bf16x8 bw = *(const bf16x8*)(WT + unit * 4096 + u * 64 + 32 * ks + 8 * g);
#pragma unroll
            for (int tm = 0; tm < 4; ++tm) {
                const bf16x8 as = *(const bf16x8*)(S0 + USK(unit) * 4096 + (16 * tm + n) * 64 + 32 * ks + 8 * g);
                const bf16x8 av = *(const bf16x8*)(VTB + (16 * tm + n) * 64 + 32 * ks + 8 * g);
                acc[tm] = MFMA16(as, bq, acc[tm]); acc[tm] = MFMA16(av, bw, acc[tm]);
            }
        }
    }
    float s = 0.f;
#pragma unroll
    for (int tm = 0; tm < 4; ++tm) s += (acc[tm][0] + acc[tm][1]) + (acc[tm][2] + acc[tm][3]);
    s += __shfl_xor(s, 16); s += __shfl_xor(s, 32);
    const float mu = s * (1.f / HD); float q = 0.f;
#pragma unroll
    for (int tm = 0; tm < 4; ++tm) { acc[tm] = acc[tm] - mu; q += (acc[tm][0] * acc[tm][0] + acc[tm][1] * acc[tm][1]) + (acc[tm][2] * acc[tm][2] + acc[tm][3] * acc[tm][3]); }
    q += __shfl_xor(q, 16); q += __shfl_xor(q, 32);
    const float rstd = 1.f / sqrtf(q * (1.f / HD) + GN_EPS);
    const size_t tok = (size_t)b * S + 64 * c + u;
    const float* BS = (const float*)(F.ws + WS_BS);
    const float bsum = BS[tok * 8 + hd] + BS[((size_t)T + tok) * 8 + hd];
    const bf16_t* VC = (const bf16_t*)(F.ws + WS_VC) + tok * BW + hd * HD; const bf16_t* GBp = (const bf16_t*)(F.ws + WS_GB) + tok * BW + hd * HD;
    bf16_t* op = (bf16_t*)(F.ws + WS_CONCAT) + tok * D + AW + hd * HD;
#pragma unroll
    for (int tm = 0; tm < 4; ++tm) {
        const int i0 = 16 * tm + 4 * g;
        const f32x4 vv = unpack4(*(const u32x2*)(VC + i0)), gg = unpack4(*(const u32x2*)(GBp + i0));
        const f32x4 gn = *(const f32x4*)(P.gn_gain + hd * HD + i0), gb = *(const f32x4*)(P.gn_bias + hd * HD + i0);
        *(u32x2*)(op + i0) = pack4((acc[tm] * rstd * gn + gb + vv * bsum) * gg);
    }
}

DI RwP make_rwp(const Args& a, int l) {
    RwP p;
    p.conv = a.in[6] + (size_t)l * 3 * 3 * BW; p.w0 = a.in[7] + (size_t)l * 2 * BW; p.w_up = a.in[8] + (size_t)l * 2 * RW * BW;
    p.a0 = a.in[9] + (size_t)l * 2 * BW; p.a_up = a.in[10] + (size_t)l * 2 * RA * BW; p.g_up = a.in[11] + (size_t)l * RG * BW;
    p.k_k = a.in[12] + (size_t)l * BW; p.k_a = a.in[13] + (size_t)l * BW; p.r_k = a.in[14] + (size_t)l * BH * HD;
    p.gn_gain = a.in[15] + (size_t)l * BW; p.gn_bias = a.in[16] + (size_t)l * BW;
    return p;
}
DI void conv_moe(const Frame& F, const Args& a, int l, int first, int stride, const int IT_END = IT_MOE) {
    LAS float* scr = (LAS float*)F.lds + F.wave * (64 * 65);
#ifdef CONV3
    f32x4 b0[16], b1[16], b2[16]; TItem t0{}, t1{}, t2{};
    int it = first;
    if (it < IT_MOE) { t0 = moe_item(F, a.in[28], a.in[29], a.in[30], l, it); titem_load(t0, b0, F.lane); }
    if (it + stride < IT_MOE) { t1 = moe_item(F, a.in[28], a.in[29], a.in[30], l, it + stride); titem_load(t1, b1, F.lane); }
    for (; it < IT_MOE; it += 3 * stride) {
        if (it + 2 * stride < IT_MOE) { t2 = moe_item(F, a.in[28], a.in[29], a.in[30], l, it + 2 * stride); titem_load(t2, b2, F.lane); }
        titem_store(t0, b0, scr, F.lane);
        if (it + stride >= IT_MOE) break;
        if (it + 3 * stride < IT_MOE) { t0 = moe_item(F, a.in[28], a.in[29], a.in[30], l, it + 3 * stride); titem_load(t0, b0, F.lane); }
        titem_store(t1, b1, scr, F.lane);
        if (it + 2 * stride >= IT_MOE) break;
        if (it + 4 * stride < IT_MOE) { t1 = moe_item(F, a.in[28], a.in[29], a.in[30], l, it + 4 * stride); titem_load(t1, b1, F.lane); }
        titem_store(t2, b2, scr, F.lane);
    }
#else
    f32x4 cur[16], nxt[16]; int it = first; TItem tc{}, tn{};
    if (it < IT_END) { tc = moe_item(F, a.in[28], a.in[29], a.in[30], l, it); titem_load(tc, cur, F.lane); }
    CONV_PREWAIT();
    for (; it < IT_END; it += stride) {
        const bool more = it + stride < IT_END;
        if (more) { tn = moe_item(F, a.in[28], a.in[29], a.in[30], l, it + stride); titem_load(tn, nxt, F.lane); }
        titem_store(tc, cur, scr, F.lane);
        if (more) { tc = tn;
#pragma unroll
            for (int i = 0; i < 16; ++i) cur[i] = nxt[i]; }
    }
#endif
}
#ifndef NG1
#define NG1 21
#endif
#ifndef N1
#define N1 3360
#endif
DI void p_gemm1(const Frame& F, const Args& a, int l) {
#ifdef CONV_G1
    if (F.G == 256) {
        if (F.bx >= 256 - NG1) { conv_moe(F, a, l, (F.bx - (256 - NG1)) * NWAVES + F.wave, NG1 * NWAVES, N1); return; }
        pg8::Gemm1Order S; S.U = (const bf16_t*)(F.ws + WS_U); S.Win = (const bf16_t*)(F.ws + WS_WIN + (size_t)l * WIN_LAYER); S.Wv = S.Win + (size_t)HW * D; S.G = 256 - NG1; S.c = F.bx;
        pg8::EpiStore E{(bf16_t*)(F.ws + WS_HB), HW, (bf16_t*)(F.ws + WS_VT), T};
        pg8::gemm_phase(F.lds, F.tid, D, S, E);
        return;
    }
#endif
    pg8::Gemm1Order S; S.U = (const bf16_t*)(F.ws + WS_U); S.Win = (const bf16_t*)(F.ws + WS_WIN + (size_t)l * WIN_LAYER); S.Wv = S.Win + (size_t)HW * D; S.G = F.G; S.c = F.bx;
    pg8::EpiStore E{(bf16_t*)(F.ws + WS_HB), HW, (bf16_t*)(F.ws + WS_VT), T};
    pg8::gemm_phase(F.lds, F.tid, D, S, E);
}
#ifndef NCB
#define NCB 16
#endif
DI void p_mixer_local(const Frame& F, const Args& a, int l) {
#ifdef CONV_IN_B
    const int GR = F.G - NCB;
    if (F.bx >= GR) { conv_moe(F, a, l, (F.bx - GR) * NWAVES + F.wave, NCB * NWAVES); return; }
    { const float* conv = a.in[6] + (size_t)l * 3 * 3 * BW;
#pragma unroll 7
      for (int i = F.tid; i < BH * 9 * 64; i += NTHREADS) { const int j = i & 63, q = i >> 6, which = q % 3, x = (q / 3) % 3, hd = q / 9;
          *(LAS bf16_t*)(F.lds + CWLOFF + i * 2) = f2bf(conv[x * 3 * BW + which * BW + hd * HD + j]); }
      RwPre PF;
      if (F.bx < NUNIT) rwkv_prefetch(F, a, l, F.bx, PF);
      __syncthreads();
      for (int unit = F.bx; unit < NUNIT; unit += GR) rwkv_local_unit(F, a, l, unit, PF, unit + GR < NUNIT ? unit + GR : -1);
      return;
    }
#endif
    {
      const float* conv = a.in[6] + (size_t)l * 3 * 3 * BW;
#pragma unroll 7
      for (int i = F.tid; i < BH * 9 * 64; i += NTHREADS) { const int j = i & 63, q = i >> 6, which = q % 3, x = (q / 3) % 3, hd = q / 9;
          *(LAS bf16_t*)(F.lds + CWLOFF + i * 2) = f2bf(conv[x * 3 * BW + which * BW + hd * HD + j]); }
      RwPre PF;
      if (F.bx < NUNIT) rwkv_prefetch(F, a, l, F.bx, PF);
      __syncthreads();
      for (int unit = F.bx; unit < NUNIT; unit += F.G) rwkv_local_unit(F, a, l, unit, PF, unit + F.G < NUNIT ? unit + F.G : -1);
    }
}
DI void p_scan(const Frame& F, const Args& a, int l) {
#ifndef CVW
#define CVW 3
#endif
    constexpr int NSCAN = 2 * 2 * NB * BH;
    const int NATTW = (F.G - NSCAN) * (NWAVES - CVW);
    if (F.bx < NSCAN) {
        volatile LAS unsigned* fl = (volatile LAS unsigned*)(F.lds + SCAN_FLAGS);
        if (F.tid < 32) fl[F.tid] = 0u;
        __syncthreads();
#ifdef S0_WRITER
        if (F.wave == 0) scan_wave(F, F.bx); else if (F.wave <= NLD) scan_loader(F, F.bx, F.wave - 1); else if (F.wave == NLD + 1) scan_writer(F, F.bx);
#else
        if (F.wave == 0) scan_wave(F, F.bx); else if (F.wave <= NLD) scan_loader(F, F.bx, F.wave - 1);
#endif
#ifdef DBL_SCAN
        __syncthreads();
        if (F.tid < 32) fl[F.tid] = 0u;
        __syncthreads();
        if (F.wave == 0) scan_wave(F, F.bx); else if (F.wave <= NLD) scan_loader(F, F.bx, F.wave - 1);
#endif
        return;
    }
#ifdef SERIAL_C
    {
        LAS float* rpbl8 = (LAS float*)(F.lds + NWAVES * 64 * 65 * 4);
        { const float* rpb = a.in[5] + (size_t)l * AH * (2 * KH - 1) * (2 * KW - 1);
#pragma unroll 6
          for (int i = F.tid; i < AH * (2 * KH - 1) * (2 * KW - 1); i += NTHREADS) rpbl8[i] = rpb[i] * LOG2E; }
        __syncthreads();
        const int aw8 = (F.bx - NSCAN) * NWAVES + F.wave, naw8 = (F.G - NSCAN) * NWAVES;
        if (F.G == 256) {
            constexpr int UPX = NB * ROWS * AH / 8;
            const int x = F.bx & 7, k = (F.bx - NSCAN) >> 3, j = k * NWAVES + F.wave;
            if (j < UPX) { const int v = (x & 3) * UPX + j; attn_unit(F, rpbl8, (((x >> 2) * ROWS) + (v & (ROWS - 1))) * AH + (v >> 7)); }
        } else
            for (int au = aw8; au < NB * ROWS * AH; au += naw8) attn_unit(F, rpbl8, au);
        for (int pu = aw8; pu < NB * (S / 32) * 4; pu += naw8) pool_unit(F, a.in[17] + (size_t)l * NG * 64 * 64, a.in[18] + (size_t)l * CW, pu);
#ifdef CONV_IN_B
        return;
#endif
        LAS float* scr = (LAS float*)F.lds + F.wave * (64 * 65);
        f32x4 cur[16], nxt[16]; const int st = naw8; int it = aw8; TItem tc{}, tn{};
#ifdef DBL_CONV
        for (int rep = 0; rep < 2; ++rep) { it = aw8;
#endif
        if (it < IT_MOE) { tc = moe_item(F, a.in[28], a.in[29], a.in[30], l, it); titem_load(tc, cur, F.lane); }
        for (; it < IT_MOE; it += st) {
            const bool more = it + st < IT_MOE;
            if (more) { tn = moe_item(F, a.in[28], a.in[29], a.in[30], l, it + st); titem_load(tn, nxt, F.lane); }
            titem_store(tc, cur, scr, F.lane);
            if (more) { tc = tn;
#pragma unroll
                for (int i = 0; i < 16; ++i) cur[i] = nxt[i]; }
        }
#ifdef DBL_CONV
        }
#endif
        return;
    }
#endif
    LAS float* rpbl = (LAS float*)(F.lds + CVW * 64 * 65 * 4);
    { const float* rpb = a.in[5] + (size_t)l * AH * (2 * KH - 1) * (2 * KW - 1);
#pragma unroll 6
      for (int i = F.tid; i < AH * (2 * KH - 1) * (2 * KW - 1); i += NTHREADS) rpbl[i] = rpb[i] * LOG2E; }
    __syncthreads();
    if (F.wave < CVW) {
        LAS float* scr = (LAS float*)F.lds + F.wave * (64 * 65);
#ifdef CONV_G1
        const int it0 = F.G == 256 ? N1 : 0;
#else
        const int it0 = 0;
#endif
        f32x4 cur[16], nxt[16]; const int st = (F.G - NSCAN) * CVW; int it = it0 + (F.bx - NSCAN) * CVW + F.wave; TItem tc{}, tn{};
#ifndef CONV_PAIR
        if (it < IT_MOE) { tc = moe_item(F, a.in[28], a.in[29], a.in[30], l, it); titem_load(tc, cur, F.lane); }
        CONV_PREWAIT();
#endif
#ifdef DBL_CONV
        for (int rep = 0; rep < 2; ++rep) { it = (F.bx - NSCAN) * CVW + F.wave; if (it < IT_MOE) { tc = moe_item(F, a.in[28], a.in[29], a.in[30], l, it); titem_load(tc, cur, F.lane); }
#endif
#ifdef CONV_PAIR
        for (int pr = it; pr < IT_MOE / 2; pr += st) {
            tc = moe_item(F, a.in[28], a.in[29], a.in[30], l, 2 * pr); tn = moe_item(F, a.in[28], a.in[29], a.in[30], l, 2 * pr + 1);
#pragma unroll
            for (int i = 0; i < 16; ++i) { cur[i] = *(const f32x4*)(tc.src + (size_t)(4 * i + (F.lane >> 4)) * tc.ldw + 4 * (F.lane & 15)); nxt[i] = *(const f32x4*)(tn.src + (size_t)(4 * i + (F.lane >> 4)) * tn.ldw + 4 * (F.lane & 15)); }
            titem_store(tc, cur, scr, F.lane); titem_store(tn, nxt, scr, F.lane);
        }
        it = IT_MOE;
#endif
        for (; it < IT_MOE; it += st) {
            const bool more = it + st < IT_MOE;
#ifdef CONV_SINGLE
            titem_store(tc, cur, scr, F.lane);
            if (more) { tc = moe_item(F, a.in[28], a.in[29], a.in[30], l, it + st); titem_load(tc, cur, F.lane); }
            continue;
#endif
            if (more) { tn = moe_item(F, a.in[28], a.in[29], a.in[30], l, it + st); titem_load(tn, nxt, F.lane); }
            titem_store(tc, cur, scr, F.lane);
            if (more) { tc = tn;
#pragma unroll
                for (int i = 0; i < 16; ++i) cur[i] = nxt[i]; }
        }
#ifdef DBL_CONV
        }
#endif
    } else {
        const int aw = (F.bx - NSCAN) * (NWAVES - CVW) + (F.wave - CVW), naw = NATTW;
#ifdef ATT_XCD
        if (F.G == 256) {
            constexpr int NW5 = NWAVES - CVW, NBX = (256 - NSCAN) / 8, NWX = NBX * NW5, UPX = NB * ROWS * AH / 8, REM = UPX - NWX, PER = (REM + NBX - 1) / NBX;
            const int x = F.bx & 7, k = (F.bx - NSCAN) >> 3, w5 = F.wave - CVW;
            { const int v = (x & 3) * UPX + k * NW5 + w5; attn_unit(F, rpbl, (((x >> 2) * ROWS) + (v & (ROWS - 1))) * AH + (v >> 7)); }
            if (w5 < PER && k * PER + w5 < REM) { const int v = (x & 3) * UPX + NWX + k * PER + w5; attn_unit(F, rpbl, (((x >> 2) * ROWS) + (v & (ROWS - 1))) * AH + (v >> 7)); }
        } else
#endif
        for (int au = aw; au < NB * ROWS * AH; au += naw) attn_unit(F, rpbl, au);
#ifdef DBL_ATTN
        for (int au = aw; au < NB * ROWS * AH; au += naw) attn_unit(F, rpbl, au);
#endif
        for (int pu = aw; pu < NB * (S / 32) * 4; pu += naw) pool_unit(F, a.in[17] + (size_t)l * NG * 64 * 64, a.in[18] + (size_t)l * CW, pu);
    }
}
DI void p_rwkv_out(const Frame& F, const Args& a, int l) {
    const RwP P = make_rwp(a, l);
    for (int du = F.gw; du < NB * BH * NCH * 4; du += F.ngw) rwkv_out_unit(F, P, du);
}
DI void p_gemm2(const Frame& F, int l) {
    pg8::PlainOrder S; S.init((const bf16_t*)(F.ws + WS_CONCAT), (const bf16_t*)(F.ws + WS_WOUT) + (size_t)l * D * D, T, D, D, F.G, F.bx);
    pg8::EpiStore E{(bf16_t*)(F.ws + WS_MIX), D, nullptr, 0};
    pg8::gemm_phase(F.lds, F.tid, D, S, E);
}
DI void p_gemm2k(const Frame& F, int Kx) {
    pg8::PlainOrder S; S.init((const bf16_t*)(F.ws + WS_CONCAT), (const bf16_t*)(F.ws + WS_WOUT), T, D, Kx, F.G, F.bx);
    pg8::EpiStore E{(bf16_t*)(F.ws + WS_MIX), D, nullptr, 0};
    pg8::gemm_phase(F.lds, F.tid, Kx, S, E);
}
DI void p_moe_a(const Frame& F, int l) {
    LAS int* tb = (LAS int*)(F.lds + LDS_MISC);
    build_tables(F, l, tb);
    pg8::GroupedOrderT<true> S; S.rowtok = (const int*)(F.ws + WS_CTL + WS_SLOTTOK); S.A = (const bf16_t*)(F.ws + WS_U); S.Bt = (const bf16_t*)(F.ws + WS_WGU); S.K = D; S.estride = (size_t)D * D; S.tile_e = tb + 66; S.ntiles = tb[65]; S.nwg = S.ntiles * 4; S.G = F.G; S.c = F.bx;
#ifdef FUSE_MOE
    S.flags = (unsigned*)(F.ws + WS_CTL) + CW_MFL + l * 256;
#endif
    pg8::EpiSwiGlu E{(bf16_t*)(F.ws + WS_HM)};
    pg8::gemm_phase(F.lds, F.tid, D, S, E);
}
DI void p_moe_b(const Frame& F, int l) {
    LAS int* tb = (LAS int*)(F.lds + LDS_MISC);
    build_tables(F, l, tb);
#ifdef FUSE_MOE
    pg8::GroupedOrderB S; S.flags = (unsigned*)(F.ws + WS_CTL) + CW_MFL + l * 256;
#else
    pg8::GroupedOrderT<false> S;
#endif
    S.rowtok = nullptr; S.A = (const bf16_t*)(F.ws + WS_HM); S.Bt = (const bf16_t*)(F.ws + WS_WD); S.K = DE; S.estride = (size_t)D * DE; S.tile_e = tb + 66; S.ntiles = tb[65]; S.nwg = S.ntiles * 4; S.G = F.G; S.c = F.bx;
    pg8::EpiRowScale E{(bf16_t*)(F.ws + WS_YS), (const float*)(F.ws + WS_SLOTW)};
    pg8::gemm_phase(F.lds, F.tid, DE, S, E);
}

#ifndef DBLMASK
#define DBLMASK 0
#endif
constexpr int PH_PER_LAYER = 10, N_PHASES = 2 + L * PH_PER_LAYER;
DI bool in_ph(int k, int lo, int hi) { lo = __builtin_amdgcn_readfirstlane(lo); hi = __builtin_amdgcn_readfirstlane(hi); asm volatile("" : "+s"(lo), "+s"(hi)); return lo <= k && k < hi; }
DI Frame fresh(const Frame& F0) {
    Frame F = F0; int t = F0.tid, b = F0.bx;
    b = __builtin_amdgcn_readfirstlane(b); asm volatile("" : "+v"(t)); asm volatile("" : "+s"(b));
    F.tid = t; F.lane = t & 63; F.wave = __builtin_amdgcn_readfirstlane(t >> 6); F.bx = b;
    F.vcu = (F.G % 8 == 0) ? (b % 8) * (F.G / 8) + b / 8 : b; F.gw = F.vcu * NWAVES + F.wave;
    return F;
}

__global__ void __launch_bounds__(NTHREADS, 2) mk_fwd(Args a) {
    extern __shared__ __attribute__((aligned(16))) unsigned char lds_raw[];
    Frame F;
    F.lds = (LAS unsigned char*)lds_raw;
    F.tid = threadIdx.x; F.lane = F.tid & 63; F.wave = __builtin_amdgcn_readfirstlane(F.tid >> 6);
    F.G = gridDim.x; F.bx = blockIdx.x; { const int bx = blockIdx.x; F.vcu = (F.G % 8 == 0) ? (bx % 8) * (F.G / 8) + bx / 8 : bx; }
    F.gw = F.vcu * NWAVES + F.wave; F.ngw = F.G * NWAVES; F.ws = a.ws;
    volatile LAS unsigned* bst = (volatile LAS unsigned*)(F.lds + LDS_BARST);
    if (F.tid < 16) bst[F.tid] = 0u;
    __syncthreads();
    cg::grid_group grid = cg::this_grid();
    XcdBarrier bar; bar.bar = (unsigned*)(a.ws + WS_CTL) + CW_BAR; bar.x = 0; bar.st = bst;
    const bool multi = (a.ph_hi - a.ph_lo) > 1;
    if (multi && !a.use_cg) bar = xcd_barrier_post((unsigned*)(a.ws + WS_CTL) + CW_BAR, bst);
    const int lo = a.ph_lo, hi = a.ph_hi;
#ifdef TSTAMP
#define STAMP(k) do { if (blockIdx.x == 0 && threadIdx.x == 0) ((unsigned long long*)(a.ws + WS_CTL + 40960))[k] = wall_clock64(); } while (0)
#else
#define STAMP(k) do { } while (0)
#endif
    STAMP(0);
#define IN(k) in_ph((k), lo, hi)
#ifndef DBLSEAM
#define DBLSEAM 0
#endif
#define SEAM(k) do { if (IN(k) && IN((k) + 1)) { if (a.use_cg) grid.sync(); else { xcd_barrier(bar); if (DBLSEAM) xcd_barrier(bar); } } STAMP((k) + 1); } while (0)
    if (IN(0)) { p0_prologue(fresh(F), a); if ((DBLMASK >> 11) & 1) p0_prologue(fresh(F), a); }
    SEAM(0);
    if (IN(1)) { p_r0(fresh(F), a.in[0]); if ((DBLMASK >> 12) & 1) p_r0(fresh(F), a.in[0]); }
    SEAM(1);
#ifdef FUSE_MOE
#define SEAM_MOE(k) do { } while (0)
#else
#define SEAM_MOE(k) SEAM(k)
#endif
#define RUN(k, call) do { if (IN(pb + (k))) { call; if ((DBLMASK >> (k)) & 1) { call; } } } while (0)
#define LAYER(l) do { \
        const int pb = 2 + PH_PER_LAYER * (l); \
        RUN(0, p_gemm1(fresh(F), a, (l))); \
        SEAM(pb + 0); \
        RUN(1, p_mixer_local(fresh(F), a, (l))); \
        SEAM(pb + 1); \
        RUN(2, p_scan(fresh(F), a, (l))); \
        SEAM(pb + 2); \
        RUN(3, p_rwkv_out(fresh(F), a, (l))); \
        SEAM(pb + 3); \
        RUN(4, p_gemm2(fresh(F), (l))); \
        SEAM(pb + 4); \
        RUN(5, p_rowpass1(fresh(F), a, (l), (l) == 0 ? a.in[0] : a.out)); \
        if (IN(pb + 5) && ((DBLMASK >> 10) & 1)) p_rowpass1(fresh(F), a, (l), (l) == 0 ? a.in[0] : a.out, true); \
        SEAM(pb + 5); \
        RUN(6, p_gather(fresh(F), (l))); \
        SEAM(pb + 6); \
        RUN(7, p_moe_a(fresh(F), (l))); \
        SEAM_MOE(pb + 7); \
        RUN(8, p_moe_b(fresh(F), (l))); \
        SEAM(pb + 8); \
        RUN(9, p_rowpass2(fresh(F), a, (l), a.out)); \
        SEAM(pb + 9); \
    } while (0)
    LAYER(0);
    LAYER(1);
#ifdef END_RERUN
#define RERUN(k, call) do { if ((END_RERUN >> (k)) & 1) { xcd_barrier(bar); call; } } while (0)
    if (multi && !a.use_cg) {
        RERUN(0, p_gemm1(fresh(F), a, 1));
        RERUN(1, p_mixer_local(fresh(F), a, 1));
        RERUN(2, p_scan(fresh(F), a, 1));
        RERUN(3, p_rwkv_out(fresh(F), a, 1));
        RERUN(4, p_gemm2(fresh(F), 1));
        RERUN(7, p_moe_a(fresh(F), 1); p_moe_b(fresh(F), 1));
        RERUN(12, p_gemm2k(fresh(F), 512));
        RERUN(13, p_gemm2k(fresh(F), 256));
        RERUN(5, p_moe_a(fresh(F), 1));
        RERUN(6, p_moe_b(fresh(F), 1));
        RERUN(10, p_rowpass1(fresh(F), a, 1, a.out, true));
        RERUN(11, p_gather(fresh(F), 1));
        RERUN(14, p_rowpass1(fresh(F), a, 1, a.out, false));
        RERUN(9, p_rowpass2(fresh(F), a, 1, a.out));
    }
#endif
#undef LAYER
#undef IN
#undef SEAM
}

#ifndef MK_MODE
#define MK_MODE 0
#endif
#ifndef TESTMODE
#define TESTMODE 0
#endif

static void fill_args(Args& a, void* const* d_in, void* d_out, void* d_ws) {
    for (int i = 0; i < 31; ++i) a.in[i] = (const float*)d_in[i];
    a.out = (float*)d_out; a.ws = (unsigned char*)d_ws; a.ph_lo = 0; a.ph_hi = N_PHASES; a.use_cg = 0; a.pad = 0;
}
static void launch_phases(Args a, int lo, int hi, hipStream_t stream) {
    for (int p = lo; p < hi; ++p) { a.ph_lo = p; a.ph_hi = p + 1; hipLaunchKernelGGL(mk_fwd, dim3(256), dim3(NTHREADS), LDS_BYTES, stream, a); }
}

#if TESTMODE == 0
extern "C" void kernel_launch(void* const* d_in, const int* in_sizes, int n_in, void* d_out, int out_size, void* d_ws, size_t ws_size, hipStream_t stream) {
    static int grid = 0;
    if (grid == 0) {
        int dev = 0, cus = 0, per_cu = 0;
        (void)hipGetDevice(&dev); (void)hipDeviceGetAttribute(&cus, hipDeviceAttributeMultiprocessorCount, dev);
        (void)hipFuncSetAttribute((const void*)mk_fwd, hipFuncAttributeMaxDynamicSharedMemorySize, LDS_BYTES);
        (void)hipOccupancyMaxActiveBlocksPerMultiprocessor(&per_cu, (const void*)mk_fwd, NTHREADS, LDS_BYTES);
        (void)hipGetLastError();
        grid = (cus > 0 ? cus : 256) * 1;
        if (ws_size < WS_END || n_in != 31) grid = -1;
    }
    if (grid < 0) return;
    (void)hipMemsetAsync((char*)d_ws + WS_CTL, 0, CTL_BYTES, stream);
    Args a{}; fill_args(a, d_in, d_out, d_ws);
#if MK_MODE == 2
    launch_phases(a, 0, N_PHASES, stream);
#else
    a.use_cg = (MK_MODE == 1) ? 1 : 0;
    void* args[] = {&a};
    (void)hipLaunchCooperativeKernel((const void*)mk_fwd, dim3(grid), dim3(NTHREADS), args, LDS_BYTES, stream);
#endif
}
#endif

#if TESTMODE > 0
constexpr int O_A = 1152, O_B = 2304, O_W = 2336, O_AL = 2368, O_G = 2432;
struct HSrc { const bf16_t* HB; const bf16_t* VT;
    DI float at(size_t tok, int n) const { if (n < 768) return bf2f(HB[tok * HW + n]); if (n < 1152) return bf2f(VT[(size_t)(n - 768) * T + tok]); return bf2f(HB[tok * HW + n - 384]); } };
DI float sigm_n(float x) { return 1.f / (1.f + expf(-x)); }

__global__ void k_mod_n(const float* __restrict__ c, const float* __restrict__ w_mod, const float* __restrict__ b_mod, float* __restrict__ mod) {
    __shared__ float sc[NB * D];
    for (int i = threadIdx.x; i < NB * D; i += blockDim.x) { float v = c[i]; sc[i] = v * sigm_n(v); }
    __syncthreads();
    int idx = blockIdx.x * blockDim.x + threadIdx.x; int l = idx / MODW, n = idx % MODW;
    const float* w = w_mod + (size_t)l * D * MODW + n; float a0 = 0.f, a1 = 0.f;
    for (int k = 0; k < D; ++k) { float wv = w[(size_t)k * MODW]; a0 += sc[k] * wv; a1 += sc[D + k] * wv; }
    float bb = b_mod[l * MODW + n];
    mod[(size_t)(l * NB + 0) * MODW + n] = a0 + bb; mod[(size_t)(l * NB + 1) * MODW + n] = a1 + bb;
}
__global__ void k_ln_mod_n(const float* __restrict__ xin, const float* __restrict__ modl, int off_sh, int off_sc, float* __restrict__ uout) {
    int row = (blockIdx.x * blockDim.x + threadIdx.x) >> 6, lane = threadIdx.x & 63; if (row >= T) return; int b = row / S;
    f32x4 v[4];
#pragma unroll
    for (int j = 0; j < 4; ++j) v[j] = *(const f32x4*)(xin + (size_t)row * D + 4 * lane + 256 * j);
    float mean, rstd; row_ln(v, mean, rstd);
    const float* md = modl + (size_t)b * MODW;
#pragma unroll
    for (int j = 0; j < 4; ++j) { int col = 4 * lane + 256 * j; *(f32x4*)(uout + (size_t)row * D + col) = v[j] * rstd * (1.f + *(const f32x4*)(md + off_sc + col)) + *(const f32x4*)(md + off_sh + col); }
}
__global__ void k_post_n(const float* xin, const float* br, const float* __restrict__ modl, int off_gate, const float* __restrict__ gain, const float* __restrict__ bias, float* xout, float* u2out, int off_sh2, int off_sc2) {
    int row = (blockIdx.x * blockDim.x + threadIdx.x) >> 6, lane = threadIdx.x & 63; if (row >= T) return; int b = row / S;
    const float* md = modl + (size_t)b * MODW; f32x4 v[4];
#pragma unroll
    for (int j = 0; j < 4; ++j) { int col = 4 * lane + 256 * j; v[j] = *(const f32x4*)(xin + (size_t)row * D + col) * ALPHA + *(const f32x4*)(md + off_gate + col) * *(const f32x4*)(br + (size_t)row * D + col); }
    float mean, rstd; row_ln(v, mean, rstd);
#pragma unroll
    for (int j = 0; j < 4; ++j) { int col = 4 * lane + 256 * j; v[j] = v[j] * rstd * *(const f32x4*)(gain + col) + *(const f32x4*)(bias + col); *(f32x4*)(xout + (size_t)row * D + col) = v[j]; }
    if (u2out == nullptr) return;
    row_ln(v, mean, rstd);
#pragma unroll
    for (int j = 0; j < 4; ++j) { int col = 4 * lane + 256 * j; *(f32x4*)(u2out + (size_t)row * D + col) = v[j] * rstd * (1.f + *(const f32x4*)(md + off_sc2 + col)) + *(const f32x4*)(md + off_sh2 + col); }
}
__global__ void __launch_bounds__(256) k_gemm_f32(const float* __restrict__ A, int lda, const float* __restrict__ B, int ldb, float* __restrict__ C, int ldc, int K) {
    __shared__ float As[16][65]; __shared__ float Bs[16][64];
    const int tx = threadIdx.x & 15, ty = threadIdx.x >> 4; const int m0 = blockIdx.y * 64, n0 = blockIdx.x * 64;
    float acc[4][4];
#pragma unroll
    for (int i = 0; i < 4; ++i)
#pragma unroll
        for (int j = 0; j < 4; ++j) acc[i][j] = 0.f;
    for (int k0 = 0; k0 < K; k0 += 16) {
#pragma unroll
        for (int i = 0; i < 4; ++i) { int e = threadIdx.x + 256 * i; int m = e >> 4, k = e & 15; As[k][m] = A[(size_t)(m0 + m) * lda + k0 + k]; }
#pragma unroll
        for (int i = 0; i < 4; ++i) { int e = threadIdx.x + 256 * i; int k = e >> 6, n = e & 63; Bs[k][n] = B[(size_t)(k0 + k) * ldb + n0 + n]; }
        __syncthreads();
#pragma unroll
        for (int k = 0; k < 16; ++k) { float a[4], b[4];
#pragma unroll
            for (int i = 0; i < 4; ++i) { a[i] = As[k][ty * 4 + i]; b[i] = Bs[k][tx * 4 + i]; }
#pragma unroll
            for (int i = 0; i < 4; ++i)
#pragma unroll
                for (int j = 0; j < 4; ++j) acc[i][j] += a[i] * b[j]; }
        __syncthreads();
    }
#pragma unroll
    for (int i = 0; i < 4; ++i) *(float4*)(C + (size_t)(m0 + ty * 4 + i) * ldc + n0 + tx * 4) = make_float4(acc[i][0], acc[i][1], acc[i][2], acc[i][3]);
}
__global__ void __launch_bounds__(64) k_attn_n(HSrc h, const float* __restrict__ rpb, float* __restrict__ concat) {
    int idx = blockIdx.x * blockDim.x + threadIdx.x; if (idx >= T * AH) return;
    int head = idx % AH, tok = idx / AH; int b = tok / S, t = tok % S, r = t / GW, cq = t % GW;
    int rstart = r - KH / 2; rstart = rstart < 0 ? 0 : (rstart > ROWS - KH ? ROWS - KH : rstart);
    int cstart = cq - KW / 2; cstart = cstart < 0 ? 0 : (cstart > GW - KW ? GW - KW : cstart);
    float q[HD], acc[HD];
#pragma unroll
    for (int d = 0; d < HD; ++d) { q[d] = h.at(tok, head * HD + d); acc[d] = 0.f; }
    float m = -1e30f, l = 0.f; const float* rp = rpb + (size_t)head * 15 * 31;
    for (int kk = 0; kk < KH; ++kk) { int kr = rstart + kk; int dr = kr - r + (KH - 1);
        for (int j = 0; j < KW; ++j) { int ck = cstart + j; int dc = ck - cq; dc = dc < -15 ? -15 : (dc > 15 ? 15 : dc); dc += 15;
            size_t kt = (size_t)b * S + kr * GW + ck; float s = 0.f;
#pragma unroll
            for (int d = 0; d < HD; ++d) s += q[d] * h.at(kt, AW + head * HD + d);
            s = s * 0.125f + rp[dr * 31 + dc];
            float mn = fmaxf(m, s); float corr = expf(m - mn); float p = expf(s - mn); l = l * corr + p;
#pragma unroll
            for (int d = 0; d < HD; ++d) acc[d] = acc[d] * corr + p * h.at(kt, 2 * AW + head * HD + d);
            m = mn; } }
    float inv = 1.f / l;
#pragma unroll
    for (int d = 0; d < HD; ++d) concat[(size_t)tok * D + head * HD + d] = acc[d] * inv;
}
__global__ void __launch_bounds__(256) k_pool_n(HSrc h, const float* __restrict__ pool_w, const float* __restrict__ pool_scale, float* __restrict__ concat) {
    __shared__ float pooled[CW];
    int tok = blockIdx.x; int b = tok / S, t = tok % S; int ch = threadIdx.x; int g = ch / 64; int win = 2 << g;
    int lo = t - win / 2; lo = lo < 0 ? 0 : lo; int hi = t + win / 2 - 1; hi = hi > S - 1 ? S - 1 : hi;
    float s = 0.f; for (int u = lo; u <= hi; ++u) s += h.at((size_t)b * S + u, O_G + ch);
    pooled[ch] = s / (float)(hi - lo + 1) - h.at(tok, O_G + ch);
    __syncthreads();
    int e = ch % 64; const float* pw = pool_w + (size_t)g * 64 * 64 + e; float a = 0.f;
    for (int c2 = 0; c2 < 64; ++c2) a += pooled[g * 64 + c2] * pw[c2 * 64];
    concat[(size_t)tok * D + AW + BW + ch] = a * pool_scale[ch];
}
__global__ void __launch_bounds__(64) k_rwkv_scan_n(HSrc h, RwP p, float* __restrict__ ys) {
    const int lane = threadIdx.x; const int dir = blockIdx.x / (NB * BH), b = (blockIdx.x / BH) % NB, hd = blockIdx.x % BH; const int ch = hd * HD + lane;
    float st[HD];
#pragma unroll
    for (int j = 0; j < HD; ++j) st[j] = 0.f;
    float wup[RW], aup[RA];
#pragma unroll
    for (int m = 0; m < RW; ++m) { wup[m] = p.w_up[(size_t)(dir * RW + m) * BW + ch]; aup[m] = p.a_up[(size_t)(dir * RA + m) * BW + ch]; }
    const float w0 = p.w0[dir * BW + ch], a0 = p.a0[dir * BW + ch], kkw = p.k_k[ch], kaw = p.k_a[ch];
    float cr[3], ck[3], cv[3];
#pragma unroll
    for (int x = 0; x < 3; ++x) { cr[x] = p.conv[x * 3 * BW + ch]; ck[x] = p.conv[x * 3 * BW + BW + ch]; cv[x] = p.conv[x * 3 * BW + 2 * BW + ch]; }
    for (int step = 0; step < S; ++step) {
        const int t = dir ? (S - 1 - step) : step; const size_t row = (size_t)b * S + t;
        float r = 0.f, k = 0.f, v = 0.f;
#pragma unroll
        for (int x = 0; x < 3; ++x) { int tt = t + x - 1; if (tt >= 0 && tt < S) { size_t rr = (size_t)b * S + tt; r += h.at(rr, O_A + ch) * cr[x]; k += h.at(rr, O_A + BW + ch) * ck[x]; v += h.at(rr, O_A + 2 * BW + ch) * cv[x]; } }
        float lv = h.at(row, O_B + lane); float lt = lane < RW ? tanhf(lv) : lv; float zw = w0, za = a0;
#pragma unroll
        for (int m = 0; m < RW; ++m) { zw += __shfl(lt, m) * wup[m]; za += __shfl(lt, RW + m) * aup[m]; }
        const float w = expf(-DECAY * sigm_n(zw)); const float a = sigm_n(za);
        float kk = k * kkw; float ss = wave_sum(kk * kk); kk = kk * (1.f / sqrtf(fmaxf(ss, 1e-24f)));
        const float kd = k * (1.f + (a - 1.f) * kaw); const float kka = kk * a;
        float sa = 0.f;
#pragma unroll
        for (int j = 0; j < HD; ++j) sa += st[j] * (-__shfl(kk, j));
        float y = 0.f;
#pragma unroll
        for (int j = 0; j < HD; ++j) { st[j] = st[j] * __shfl(w, j) + sa * __shfl(kka, j) + v * __shfl(kd, j); y += st[j] * __shfl(r, j); }
        ys[((size_t)dir * T + b * S + t) * BW + ch] = y;
    }
}
__global__ void __launch_bounds__(384) k_rwkv_finish_n(HSrc h, RwP p, const float* __restrict__ ys, float* __restrict__ concat) {
    __shared__ float lw[RW], la[RA], sg[RG];
    const int tok = blockIdx.x, b = tok / S, t = tok % S, ch = threadIdx.x, hd = ch / HD, j = ch % HD;
    if (ch < RW) lw[ch] = tanhf(h.at(tok, O_B + ch)); else if (ch < RW + RA) la[ch - RW] = h.at(tok, O_W + (ch - RW)); else if (ch < RW + RA + RG) sg[ch - RW - RA] = sigm_n(h.at(tok, O_AL + (ch - RW - RA)));
    __syncthreads();
    float r = 0.f, k = 0.f, v = 0.f;
#pragma unroll
    for (int x = 0; x < 3; ++x) { int tt = t + x - 1; if (tt >= 0 && tt < S) { size_t rr = (size_t)b * S + tt;
        r += h.at(rr, O_A + ch) * p.conv[x * 3 * BW + ch]; k += h.at(rr, O_A + BW + ch) * p.conv[x * 3 * BW + BW + ch]; v += h.at(rr, O_A + 2 * BW + ch) * p.conv[x * 3 * BW + 2 * BW + ch]; } }
    float bon = 0.f;
    for (int dir = 0; dir < 2; ++dir) { float za = p.a0[dir * BW + ch]; for (int m = 0; m < RA; ++m) za += la[m] * p.a_up[(size_t)(dir * RA + m) * BW + ch];
        float a = sigm_n(za); float kd = k * (1.f + (a - 1.f) * p.k_a[ch]); bon += wave_sum(r * kd * p.r_k[hd * HD + j]); }
    bon *= v;
    float y = ys[(size_t)tok * BW + ch] + ys[((size_t)T + tok) * BW + ch];
    float mu = wave_sum(y) * (1.f / HD); float dy = y - mu; float var = wave_sum(dy * dy) * (1.f / HD);
    float yn = dy * (1.f / sqrtf(var + GN_EPS)) * p.gn_gain[ch] + p.gn_bias[ch];
    float g = 0.f; for (int m = 0; m < RG; ++m) g += sg[m] * p.g_up[(size_t)m * BW + ch];
    concat[(size_t)tok * D + AW + ch] = (yn + bon) * g;
}
__global__ void __launch_bounds__(256) k_moe_n(const float* __restrict__ u2, const int* __restrict__ tokslot, const float* __restrict__ ew,
                                                const float* __restrict__ wgate, const float* __restrict__ wup, const float* __restrict__ wdown, float* __restrict__ f) {
    __shared__ float xs[D]; __shared__ float hb[DE];
    const int tok = blockIdx.x, tid = threadIdx.x;
    for (int i = tid; i < D; i += 256) xs[i] = u2[(size_t)tok * D + i];
    float o[4] = {0.f, 0.f, 0.f, 0.f};
    for (int kk = 0; kk < 2; ++kk) {
        const int ts = tokslot[tok * 2 + kk]; const int e = ts >> 14; const float wt = ew[ts];
        __syncthreads();
        const float* g = wgate + (size_t)e * D * DE; const float* u = wup + (size_t)e * D * DE;
        float ag0 = 0.f, ag1 = 0.f, au0 = 0.f, au1 = 0.f;
        for (int k = 0; k < D; ++k) { float x = xs[k]; ag0 += x * g[(size_t)k * DE + tid]; ag1 += x * g[(size_t)k * DE + 256 + tid]; au0 += x * u[(size_t)k * DE + tid]; au1 += x * u[(size_t)k * DE + 256 + tid]; }
        hb[tid] = ag0 * sigm_n(ag0) * au0; hb[256 + tid] = ag1 * sigm_n(ag1) * au1;
        __syncthreads();
        const float* dn = wdown + (size_t)e * DE * D; float a[4] = {0.f, 0.f, 0.f, 0.f};
        for (int k = 0; k < DE; ++k) { float x = hb[k];
#pragma unroll
            for (int j = 0; j < 4; ++j) a[j] += x * dn[(size_t)k * D + tid + 256 * j]; }
#pragma unroll
        for (int j = 0; j < 4; ++j) o[j] += a[j] * wt;
    }
#pragma unroll
    for (int j = 0; j < 4; ++j) f[(size_t)tok * D + tid + 256 * j] = o[j];
}

__global__ void k_router_n(const float* __restrict__ u2, const float* __restrict__ wg, const float* __restrict__ bg, const float* __restrict__ we, const float* __restrict__ be, int* __restrict__ tok_e) {
    int row = (blockIdx.x * blockDim.x + threadIdx.x) >> 6, lane = threadIdx.x & 63; if (row >= T) return;
    float gl[NG], el[NE];
#pragma unroll
    for (int n = 0; n < NG; ++n) gl[n] = 0.f;
#pragma unroll
    for (int n = 0; n < NE; ++n) el[n] = 0.f;
    for (int i = 0; i < 16; ++i) { int k = lane + 64 * i; float x = u2[(size_t)row * D + k];
#pragma unroll
        for (int n = 0; n < NG; ++n) gl[n] += x * wg[k * NG + n];
#pragma unroll
        for (int n = 0; n < NE; ++n) el[n] += x * we[k * NE + n]; }
#pragma unroll
    for (int n = 0; n < NG; ++n) gl[n] = wave_sum(gl[n]) + bg[n];
#pragma unroll
    for (int n = 0; n < NE; ++n) el[n] = wave_sum(el[n]) + be[n];
    int gi = 0; float gm = gl[0];
#pragma unroll
    for (int n = 1; n < NG; ++n) if (gl[n] > gm) { gm = gl[n]; gi = n; }
    float l1 = -3.0e38f, l2 = -3.0e38f; int i1 = 0, i2 = 0;
#pragma unroll
    for (int n = 0; n < NE; ++n) if ((n >> 3) == gi) { float v = el[n]; int e = n & 7; if (v > l1) { l2 = l1; i2 = i1; l1 = v; i1 = e; } else if (v > l2) { l2 = v; i2 = e; } }
    if (lane == 0) { tok_e[row * 2] = gi * EPG + i1; tok_e[row * 2 + 1] = gi * EPG + i2; }
}
__global__ void k_cmp_route(const int* __restrict__ tokslot, const int* __restrict__ tok_e, float* acc, int slot) {
    float mis = 0.f, tot = 0.f;
    for (int t = blockIdx.x * blockDim.x + threadIdx.x; t < T; t += gridDim.x * blockDim.x) { const int a0 = tokslot[2 * t] >> 14, a1 = tokslot[2 * t + 1] >> 14;
        mis += (a0 != tok_e[2 * t] || a1 != tok_e[2 * t + 1]) ? 1.f : 0.f; tot += 1.f; }
    mis = wave_sum(mis); tot = wave_sum(tot);
    if ((threadIdx.x & 63) == 0) { atomicAdd(acc + 2 * slot, mis); atomicAdd(acc + 2 * slot + 1, tot); }
}
__global__ void k_bf2f(const bf16_t* __restrict__ src, float* __restrict__ dst, size_t n) { for (size_t i = (size_t)blockIdx.x * blockDim.x + threadIdx.x; i < n; i += (size_t)gridDim.x * blockDim.x) dst[i] = bf2f(src[i]); }
template <class TA> __global__ void k_cmp(const TA* __restrict__ a, size_t lda, const float* __restrict__ b, size_t ldb, int rows, int cols, float* acc, int slot) {
    float d2 = 0.f, r2 = 0.f;
    for (size_t i = (size_t)blockIdx.x * blockDim.x + threadIdx.x; i < (size_t)rows * cols; i += (size_t)gridDim.x * blockDim.x) {
        const size_t r = i / cols, c = i % cols; float av; if constexpr (sizeof(TA) == 2) av = bf2f(a[r * lda + c]); else av = a[r * lda + c];
        const float bv = b[r * ldb + c]; d2 += (av - bv) * (av - bv); r2 += bv * bv; }
    d2 = wave_sum(d2); r2 = wave_sum(r2);
    if ((threadIdx.x & 63) == 0) { atomicAdd(acc + 2 * slot, d2); atomicAdd(acc + 2 * slot + 1, r2); }
}
__global__ void k_cmp_vt(const bf16_t* __restrict__ vt, const float* __restrict__ b, size_t ldb, float* acc, int slot) {
    float d2 = 0.f, r2 = 0.f;
    for (size_t i = (size_t)blockIdx.x * blockDim.x + threadIdx.x; i < (size_t)T * AW; i += (size_t)gridDim.x * blockDim.x) {
        const size_t r = i % T, c = i / T; const float av = bf2f(vt[c * T + r]), bv = b[r * ldb + c]; d2 += (av - bv) * (av - bv); r2 += bv * bv; }
    d2 = wave_sum(d2); r2 = wave_sum(r2);
    if ((threadIdx.x & 63) == 0) { atomicAdd(acc + 2 * slot, d2); atomicAdd(acc + 2 * slot + 1, r2); }
}
struct Tols { float t[8]; int n; };
__global__ void k_readout(float* out, const float* acc, Tols tl, int total) {
    float mx = 0.f; int am = 0; for (int k = 0; k < tl.n; ++k) { float e = sqrtf(acc[2 * k] / fmaxf(acc[2 * k + 1], 1e-30f)); if (!(e == e)) e = 1e3f; if (e / tl.t[k] > mx) { mx = e / tl.t[k]; am = k; } }
    const float cval = sqrtf(1000.f * mx);
    for (int i = blockIdx.x * blockDim.x + threadIdx.x; i < total; i += gridDim.x * blockDim.x) out[i] = (i < 8) ? 1000.f * (float)(am + 1) : cval;
}
__global__ void __launch_bounds__(256) k_moe_chk(const float* __restrict__ u2, const int* __restrict__ tokslot, const float* __restrict__ ew, const unsigned* __restrict__ cnt,
                                                  const float* __restrict__ wgate, const float* __restrict__ wup, const float* __restrict__ wdown,
                                                  const bf16_t* __restrict__ XS, const bf16_t* __restrict__ HM, const bf16_t* __restrict__ YS, float* acc) {
    __shared__ float xs[D]; __shared__ float hb[DE]; __shared__ int offp[NE];
    const int tok = blockIdx.x, tid = threadIdx.x;
    if (tid == 0) { int off = 0; for (int e = 0; e < NE; ++e) { offp[e] = off; off += (((int)cnt[e] + 255) >> 8) * 256; } }
    for (int i = tid; i < D; i += 256) xs[i] = u2[(size_t)tok * D + i];
    float d0 = 0.f, r0 = 0.f, d1 = 0.f, r1 = 0.f, d2 = 0.f, r2 = 0.f;
    for (int kk = 0; kk < 2; ++kk) {
        __syncthreads();
        const int ts = tokslot[tok * 2 + kk]; const int e = ts >> 14; const float wt = ew[ts]; const size_t slot = (size_t)offp[e] + (ts & 16383);
        for (int i = tid; i < D; i += 256) { const float a = bf2f(XS[slot * D + i]), b = xs[i]; d0 += (a - b) * (a - b); r0 += b * b; }
        const float* g = wgate + (size_t)e * D * DE; const float* u = wup + (size_t)e * D * DE;
        float ag0 = 0.f, ag1 = 0.f, au0 = 0.f, au1 = 0.f;
        for (int k = 0; k < D; ++k) { float x = xs[k]; ag0 += x * g[(size_t)k * DE + tid]; ag1 += x * g[(size_t)k * DE + 256 + tid]; au0 += x * u[(size_t)k * DE + tid]; au1 += x * u[(size_t)k * DE + 256 + tid]; }
        const float h0 = ag0 * sigm_n(ag0) * au0, h1 = ag1 * sigm_n(ag1) * au1;
        hb[tid] = h0; hb[256 + tid] = h1;
        { const float a = bf2f(HM[slot * DE + tid]), b = bf2f(HM[slot * DE + 256 + tid]); d1 += (a - h0) * (a - h0) + (b - h1) * (b - h1); r1 += h0 * h0 + h1 * h1; }
        __syncthreads();
        const float* dn = wdown + (size_t)e * DE * D; float a4[4] = {0.f, 0.f, 0.f, 0.f};
        for (int k = 0; k < DE; ++k) { float x = hb[k];
#pragma unroll
            for (int j = 0; j < 4; ++j) a4[j] += x * dn[(size_t)k * D + tid + 256 * j]; }
#pragma unroll
        for (int j = 0; j < 4; ++j) {
#ifdef MOEB_NOSCALE
            const float y = a4[j];
#else
            const float y = a4[j] * wt;
#endif
            const float a = bf2f(YS[slot * D + tid + 256 * j]); d2 += (a - y) * (a - y); r2 += y * y; }
    }
    d0 = wave_sum(d0); r0 = wave_sum(r0); d1 = wave_sum(d1); r1 = wave_sum(r1); d2 = wave_sum(d2); r2 = wave_sum(r2);
    if ((tid & 63) == 0) { atomicAdd(acc + 0, d0); atomicAdd(acc + 1, r0); atomicAdd(acc + 2, d1); atomicAdd(acc + 3, r1); atomicAdd(acc + 4, d2); atomicAdd(acc + 5, r2); }
}

extern "C" void kernel_launch(void* const* d_in, const int* in_sizes, int n_in, void* d_out, int out_size, void* d_ws, size_t ws_size, hipStream_t stream) {
    static int once = 0; if (!once) { (void)hipFuncSetAttribute((const void*)mk_fwd, hipFuncAttributeMaxDynamicSharedMemorySize, LDS_BYTES); once = 1; }
    (void)hipMemsetAsync((char*)d_ws + WS_CTL, 0, CTL_BYTES, stream);
    Args a{}; fill_args(a, d_in, d_out, d_ws);
    char* ws = (char*)d_ws; float* out = (float*)d_out;
    float* ACC = (float*)(ws + 32768 + 1024);
    const float* x = a.in[0];
    HSrc hs{(const bf16_t*)(ws + WS_HB), (const bf16_t*)(ws + WS_VT)};
    const int l = 0;
    RwP p = { a.in[6], a.in[7], a.in[8], a.in[9], a.in[10], a.in[11], a.in[12], a.in[13], a.in[14], a.in[15], a.in[16] };
    Tols tl{};
#if TESTMODE == 1
    launch_phases(a, 0, 3, stream);
    float* MODn = (float*)(ws + WS_MOD + 512 * 1024); float* Un = (float*)(ws + WS_XA); float* HF = (float*)(ws + WS_CONCAT);
    k_mod_n<<<L * MODW / 256, 256, 0, stream>>>(a.in[1], a.in[2], a.in[3], MODn);
    k_ln_mod_n<<<T / 4, 256, 0, stream>>>(x, MODn, 0, D, Un);
    k_gemm_f32<<<dim3(INW / 64, T / 64), 256, 0, stream>>>(Un, D, a.in[4], INW, HF, INW, D);
    k_cmp<float><<<256, 256, 0, stream>>>((const float*)(ws + WS_MOD), MODW, MODn, MODW, L * NB, MODW, ACC, 0);
    k_cmp<bf16_t><<<1024, 256, 0, stream>>>((const bf16_t*)(ws + WS_U), D, Un, D, T, D, ACC, 1);
    k_cmp<bf16_t><<<1024, 256, 0, stream>>>((const bf16_t*)(ws + WS_HB), HW, HF, INW, T, 768, ACC, 2);
    k_cmp<bf16_t><<<1024, 256, 0, stream>>>((const bf16_t*)(ws + WS_HB) + 768, HW, HF + 1152, INW, T, 1536, ACC, 3);
    k_cmp_vt<<<1024, 256, 0, stream>>>((const bf16_t*)(ws + WS_VT), HF + 768, INW, ACC, 4);
    tl.n = 5; tl.t[0] = 1e-5f; tl.t[1] = 4e-3f; tl.t[2] = 6e-3f; tl.t[3] = 6e-3f; tl.t[4] = 6e-3f;
#elif TESTMODE == 2
    launch_phases(a, 0, 4, stream);
    float* CCn = (float*)(ws + WS_XA); float* YSn = (float*)(ws + WS_WGU);
    k_attn_n<<<T * AH / 64, 64, 0, stream>>>(hs, a.in[5], CCn);
    k_pool_n<<<T, 256, 0, stream>>>(hs, a.in[17], a.in[18], CCn);
    k_rwkv_scan_n<<<2 * NB * BH, 64, 0, stream>>>(hs, p, YSn);
    k_rwkv_finish_n<<<T, 384, 0, stream>>>(hs, p, YSn, CCn);
    launch_phases(a, 4, 6, stream);
    k_cmp<bf16_t><<<1024, 256, 0, stream>>>((const bf16_t*)(ws + WS_CONCAT), D, CCn, D, T, AW, ACC, 0);
    k_cmp<bf16_t><<<1024, 256, 0, stream>>>((const bf16_t*)(ws + WS_CONCAT) + AW, D, CCn + AW, D, T, BW, ACC, 1);
    k_cmp<bf16_t><<<1024, 256, 0, stream>>>((const bf16_t*)(ws + WS_CONCAT) + AW + BW, D, CCn + AW + BW, D, T, CW, ACC, 2);
    tl.n = 3; tl.t[0] = TOL0; tl.t[1] = TOL1; tl.t[2] = TOL2;
#elif TESTMODE == 3
    launch_phases(a, 0, 11, stream);
    { const float* MODf = (const float*)(ws + WS_MOD);
      float* U2f = (float*)(ws + 414 * MiB); float* Fn = (float*)(ws + 213 * MiB); float* X2n = (float*)(ws + 277 * MiB);
      k_bf2f<<<2048, 256, 0, stream>>>((const bf16_t*)(ws + WS_U), U2f, (size_t)T * D);
      launch_phases(a, 11, 12, stream);
      k_moe_n<<<T, 256, 0, stream>>>(U2f, (const int*)(ws + WS_TOKSLOT), (const float*)(ws + WS_EW), a.in[28], a.in[29], a.in[30], Fn);
      k_post_n<<<T / 4, 256, 0, stream>>>((const float*)(ws + WS_XA), Fn, MODf, 5 * D, a.in[22], a.in[23], X2n, nullptr, 0, 0);
      k_cmp<float><<<1024, 256, 0, stream>>>(out, D, X2n, D, T, D, ACC, 0); }
    tl.n = 1; tl.t[0] = TOL0;
#elif TESTMODE == 4
    launch_phases(a, 0, 8, stream);
    { const float* MODf = (const float*)(ws + WS_MOD);
      float* CCn = (float*)(ws + 405 * MiB); float* MIXn = (float*)(ws + 213 * MiB); float* X1n = (float*)(ws + 21 * MiB); float* U2n = (float*)(ws + 333 * MiB); int* TEn = (int*)(ws + 490 * MiB);
      k_bf2f<<<2048, 256, 0, stream>>>((const bf16_t*)(ws + WS_CONCAT), CCn, (size_t)T * D);
      k_gemm_f32<<<dim3(D / 64, T / 64), 256, 0, stream>>>(CCn, D, a.in[19], D, MIXn, D, D);
      k_post_n<<<T / 4, 256, 0, stream>>>(x, MIXn, MODf, 2 * D, a.in[20], a.in[21], X1n, U2n, 3 * D, 4 * D);
      k_router_n<<<T / 4, 256, 0, stream>>>(U2n, a.in[24], a.in[25], a.in[26], a.in[27], TEn);
      k_cmp<float><<<1024, 256, 0, stream>>>((const float*)(ws + WS_XA), D, X1n, D, T, D, ACC, 0);
      k_cmp<bf16_t><<<1024, 256, 0, stream>>>((const bf16_t*)(ws + WS_U), D, U2n, D, T, D, ACC, 1);
      k_cmp_route<<<64, 256, 0, stream>>>((const int*)(ws + WS_TOKSLOT), TEn, ACC, 2); }
    tl.n = 3; tl.t[0] = TOL0; tl.t[1] = TOL1; tl.t[2] = TOL2;
#elif TESTMODE == 5
    launch_phases(a, 0, 11, stream);
    { float* U2f = (float*)(ws + 414 * MiB);
      k_bf2f<<<2048, 256, 0, stream>>>((const bf16_t*)(ws + WS_U), U2f, (size_t)T * D);
      k_moe_chk<<<T, 256, 0, stream>>>(U2f, (const int*)(ws + WS_TOKSLOT), (const float*)(ws + WS_EW), (const unsigned*)(ws + WS_CTL) + CW_CNT, a.in[28], a.in[29], a.in[30],
                                       (const bf16_t*)(ws + WS_XS), (const bf16_t*)(ws + WS_HM), (const bf16_t*)(ws + WS_YS), ACC); }
    tl.n = 3; tl.t[0] = 1e-6f; tl.t[1] = 1e-2f; tl.t[2] = 1e-2f;
#endif
    k_readout<<<256, 256, 0, stream>>>(out, ACC, tl, out_size);
}
#endif
```

```cpp
#define TESTMODE 0
#define MK_MODE 0
#define S0_WRITER 1
#define ATT_XCD 1
#define FUSE_MOE 1
#define MOE_ACQ1 1
#define KV_TILED 1
#include <hip/hip_runtime.h>
#include <hip/hip_cooperative_groups.h>
#include <stdint.h>
namespace cg = cooperative_groups;

#ifndef TESTMODE
#define TESTMODE 0
#endif
#define DI __device__ __forceinline__
#define LAS __attribute__((address_space(3)))
typedef unsigned short bf16_t;
typedef short bf16x8 __attribute__((ext_vector_type(8)));
typedef float f32x4 __attribute__((ext_vector_type(4)));
typedef float f32x16 __attribute__((ext_vector_type(16)));
typedef unsigned u32x4 __attribute__((ext_vector_type(4)));
typedef unsigned u32x2 __attribute__((ext_vector_type(2)));
typedef float f32x2_t __attribute__((ext_vector_type(2)));
typedef __bf16 bf16x2_t __attribute__((ext_vector_type(2)));

namespace cfg {
constexpr int D = 1024, NB = 2, S = 8192, T = NB * S, L = 2;
constexpr int GW = 64, ROWS = 128;
constexpr int HD = 64, AW = 384, BW = 384, CW = 256, AH = 6, BH = 6;
constexpr int KH = 8, KW = 16;
constexpr int RW = 32, RA = 32, RG = 64;
constexpr int INW = 2688;
constexpr int NG = 4, EPG = 8, NE = 32, DE = 512;
constexpr int MODW = 6 * D;
constexpr float ALPHA = 1.41421356237309515f;
constexpr float LN_EPS = 1e-5f, GN_EPS = 64e-5f;
constexpr float DECAY = 0.60653065971263342f;
constexpr float LOG2E = 1.44269504088896341f;
constexpr int HW = 2304, HQ = 0, HK = 384, HR = 768, HWL = 1920, HAL = 1952, HGL = 1984, HP = 2048;
constexpr int NCH = S / 64;
constexpr int NUNIT = 2 * NB * BH * NCH;
constexpr int XSROWS = 2 * T + NE * 256;
}
using namespace cfg;

constexpr size_t MiB = 1u << 20;
constexpr size_t WS_CTL = 0;
constexpr size_t CTL_BYTES = 262144;
constexpr size_t WS_SLOTTOK = 65536;
constexpr int CW_BAR = 0;
constexpr int CW_MFL = 9216;
constexpr int CW_CNT = 8192;
constexpr size_t WS_MOD = 1 * MiB;
constexpr size_t WS_TOKSLOT = 1 * MiB + 128 * 1024;
constexpr size_t WS_SLOTW = 1 * MiB + 256 * 1024;
constexpr size_t WS_BC = 2 * MiB;
constexpr size_t WS_TOKW = 2 * MiB + 64 * 1024;
constexpr size_t WS_TOKFIN = 2 * MiB + 256 * 1024;
constexpr size_t WS_CNTF = 2 * MiB + 512 * 1024;
constexpr size_t WS_WIN = 6 * MiB;
constexpr size_t WIN_LAYER = (size_t)2816 * 1024 * 2;
constexpr size_t WS_WOUT = 17 * MiB;
constexpr size_t WS_WGU = 21 * MiB;
constexpr size_t WS_WD = 85 * MiB;
constexpr size_t WS_XA = 117 * MiB;
constexpr size_t WS_U = 181 * MiB;
constexpr size_t WS_HB = 213 * MiB;
constexpr size_t WS_S0 = 117 * MiB;
constexpr size_t WS_VT = 285 * MiB;
constexpr size_t WS_CONCAT = 301 * MiB;
constexpr size_t WS_MP = 333 * MiB;
constexpr size_t WS_NB = 358 * MiB;
constexpr size_t WS_MIX = 333 * MiB;
constexpr size_t WS_KT = 384 * MiB;
constexpr size_t WS_QT = 405 * MiB;
constexpr size_t WS_WT = 429 * MiB;
constexpr size_t WS_VTB = 453 * MiB;
constexpr size_t WS_GB = 465 * MiB;
constexpr size_t WS_VC = 477 * MiB;
constexpr size_t WS_BS = 489 * MiB;
constexpr size_t WS_XS = 213 * MiB;
constexpr size_t WS_HM = 293 * MiB;
constexpr size_t WS_YS = 333 * MiB;
constexpr size_t WS_END = 490 * MiB;
#ifndef NOSKEW
#define USK(u) ((size_t)(u) + ((size_t)(u) >> 7))
#else
#define USK(u) ((size_t)(u))
#endif

constexpr int NWAVES = 8, NTHREADS = 512;
constexpr int LDS_BYTES = 156 * 1024;

DI unsigned cvtpk(float lo, float hi) { f32x2_t v = {lo, hi}; bf16x2_t b = __builtin_convertvector(v, bf16x2_t); return __builtin_bit_cast(unsigned, b); }
DI float bflo(unsigned w) { return __uint_as_float(w << 16); }
DI float bfhi(unsigned w) { return __uint_as_float(w & 0xffff0000u); }
DI float bf2f(unsigned short h) { return __uint_as_float((unsigned)h << 16); }
DI unsigned short f2bf(float f) { return (unsigned short)(cvtpk(f, 0.f) & 0xffffu); }
DI float wave_sum_shfl(float v) {
#pragma unroll
    for (int o = 32; o > 0; o >>= 1) v += __shfl_xor(v, o);
    return v;
}
template <int CTRL, int ROWMASK> DI float dpp_add(float v) { return v + __builtin_bit_cast(float, __builtin_amdgcn_update_dpp(0, __builtin_bit_cast(int, v), CTRL, ROWMASK, 0xf, false)); }
DI float wave_sum(float v) {
    v = dpp_add<0xb1, 0xf>(v);
    v = dpp_add<0x4e, 0xf>(v);
    v = dpp_add<0x124, 0xf>(v);
    v = dpp_add<0x128, 0xf>(v);
    v = dpp_add<0x142, 0xa>(v);
    v = dpp_add<0x143, 0xc>(v);
    return __builtin_bit_cast(float, __builtin_amdgcn_readlane(__builtin_bit_cast(int, v), 63));
}
DI float fexp2(float x) { return __builtin_amdgcn_exp2f(x); }
DI float frcp(float x) { return __builtin_amdgcn_rcpf(x); }
DI float sigm(float x) { return frcp(1.f + fexp2(x * -LOG2E)); }
#define LDS_WAIT() asm volatile("s_waitcnt lgkmcnt(0)" ::: "memory")
#define VM_WAIT() asm volatile("s_waitcnt vmcnt(0)" ::: "memory")
DI int swap23(int i) { return (i & ~12) | ((i & 4) << 1) | ((i & 8) >> 1); }

namespace pg8 {
constexpr int BM = 256, BK = 64, HALF = 128, HTB = HALF * BK * 2, STAGE_BYTES = 8 * HTB, NXCD = 8, WGM = 8;
__host__ __device__ __forceinline__ int lds_byte(int r, int c) { const int st = (r >> 4) * 2 + (c >> 5), rr = r & 15, cc = c & 31, ob = rr * 64 + cc * 2; return st * 1024 + (ob ^ (((ob >> 9) & 1) << 5)); }
__host__ __device__ __forceinline__ void stage_rc(int b, int& R, int& C) { const int st = b / 1024, sb = b % 1024, swz = sb ^ (((sb >> 9) & 1) << 5); R = (st >> 1) * 16 + swz / 64; C = (st & 1) * 32 + (swz % 64) / 2; }
__host__ __device__ __forceinline__ int perm32(int rho) { const int n = rho >> 4, i = rho & 15; return 8 * (i >> 2) + 4 * n + (i & 3); }

struct Unit { int pm, pn, aux; };

DI int xcd_remap(int L, int nwg) { const int q = nwg / NXCD, r = nwg % NXCD, xcd = L % NXCD, off = L / NXCD; return (xcd < r ? xcd * (q + 1) : r * (q + 1) + (xcd - r) * q) + off; }

struct PlainOrder {
    static constexpr bool GATHER = false, SIGNAL = false, WAIT = false, ACQ1 = false;
    DI void signal(const Unit&) const {} DI void wait(const Unit&) const {}
    const bf16_t* A; const bf16_t* Bt; int K; int nM, nN, nwg, G, c;
    DI void init(const bf16_t* A_, const bf16_t* Bt_, int M, int N, int K_, int G_, int c_) { A = A_; Bt = Bt_; K = K_; nM = M / BM; nN = N / BM; nwg = nM * nN; G = G_; c = c_; }
    DI bool next(int i, Unit& u) const {
        const int Lx = i * G + c; if (Lx >= nwg) return false;
        const int wgid = xcd_remap(Lx, nwg);
        const int nig = WGM * nN, gid = wgid / nig, fm = gid * WGM, gsz = (nM - fm) < WGM ? (nM - fm) : WGM;
        u.pm = fm + ((wgid % nig) % gsz); u.pn = (wgid % nig) / gsz; u.aux = 0; return true;
    }
    DI const char* aptr(const Unit& u) const { return (const char*)A + (size_t)u.pm * (2 * HALF) * K * 2; }
    DI const char* bptr(const Unit& u) const { return (const char*)Bt + (size_t)u.pn * (2 * HALF) * K * 2; }
};
struct Gemm1Order {
    static constexpr bool GATHER = false, SIGNAL = false, WAIT = false, ACQ1 = false;
    DI void signal(const Unit&) const {} DI void wait(const Unit&) const {}
    const bf16_t* U; const bf16_t* Win; const bf16_t* Wv; int G, c;
    static constexpr int nM = T / BM, nN = HW / BM, nMain = nM * nN, nV = 2 * (T / BM), nwg = nMain + nV, K = D;
    DI bool next(int i, Unit& u) const {
        const int Lx = i * G + c; if (Lx >= nwg) return false;
        if (Lx < nMain) {
            const int wgid = xcd_remap(Lx, nMain);
            const int nig = WGM * nN, gid = wgid / nig, fm = gid * WGM, gsz = (nM - fm) < WGM ? (nM - fm) : WGM;
            u.pm = fm + ((wgid % nig) % gsz); u.pn = (wgid % nig) / gsz; u.aux = 0;
        } else { const int v = Lx - nMain; u.pm = v & 1; u.pn = v >> 1; u.aux = 1; }
        return true;
    }
    DI const char* aptr(const Unit& u) const { return (const char*)(u.aux ? Wv : U) + (size_t)u.pm * BM * K * 2; }
    DI const char* bptr(const Unit& u) const { return (const char*)(u.aux ? U : Win) + (size_t)u.pn * BM * K * 2; }
};
template <bool G_> struct GroupedOrderT {
    static constexpr bool GATHER = G_;
#ifdef FUSE_MOE
    static constexpr bool SIGNAL = G_, WAIT = false, ACQ1 = false;
    unsigned* flags;
    DI void signal(const Unit& u) const { (void)__hip_atomic_fetch_add(flags + u.pm, 1u, __ATOMIC_RELAXED, __HIP_MEMORY_SCOPE_AGENT); }
    DI void wait(const Unit&) const {}
#else
    static constexpr bool SIGNAL = false, WAIT = false, ACQ1 = false;
    DI void signal(const Unit&) const {} DI void wait(const Unit&) const {}
#endif
    const bf16_t* A; const bf16_t* Bt; int K; size_t estride; const LAS int* tile_e; int ntiles, nwg, G, c; const int* rowtok;
    DI bool next(int i, Unit& u) const {
        const int Lx = i * G + c; if (Lx >= nwg) return false;
        const int wgid = xcd_remap(Lx, nwg);
        u.pm = wgid >> 2; u.pn = wgid & 3; u.aux = tile_e[u.pm]; return true;
    }
    DI const char* aptr(const Unit& u) const { return GATHER ? (const char*)A : (const char*)A + (size_t)u.pm * BM * K * 2; }
    DI const char* bptr(const Unit& u) const { return (const char*)Bt + ((size_t)u.aux * estride + (size_t)u.pn * BM * K) * 2; }
};

#ifdef FUSE_MOE
struct GroupedOrderB {
    static constexpr bool GATHER = false, SIGNAL = false, WAIT = true;
#ifdef MOE_ACQ1
    static constexpr bool ACQ1 = true;
#else
    static constexpr bool ACQ1 = false;
#endif
    const bf16_t* A; const bf16_t* Bt; int K; size_t estride; const LAS int* tile_e; int ntiles, nwg, G, c; const int* rowtok; unsigned* flags;
    DI bool next(int i, Unit& u) const {
        int wgid;
        if (G % NXCD == 0) {
            const int P = G / NXCD, x = c % NXCD, k = c / NXCD, q = nwg / NXCD, r8 = nwg % NXCD;
            const int qx = q + (x < r8 ? 1 : 0), startx = x < r8 ? x * (q + 1) : r8 * (q + 1) + (x - r8) * q;
            const int remA = qx % P, nL = P - remA, seg1 = remA > 0 ? (2 * nL < qx ? 2 * nL : qx) : 0;
            int n1 = 0;
            if (remA > 0 && k >= remA) { n1 = (k - remA) < seg1 ? 1 : 0; n1 += (k - remA) + nL < seg1 ? 1 : 0; }
            const int ob = i < n1 ? (k - remA) + i * nL : seg1 + k + (i - n1) * P;
            if (ob >= qx) return false;
            wgid = startx + ob;
        } else { const int Lx = i * G + c; if (Lx >= nwg) return false; wgid = Lx; }
        u.pm = wgid >> 2; u.pn = wgid & 3; u.aux = tile_e[u.pm]; return true;
    }
    DI const char* aptr(const Unit& u) const { return (const char*)A + (size_t)u.pm * BM * K * 2; }
    DI const char* bptr(const Unit& u) const { return (const char*)Bt + ((size_t)u.aux * estride + (size_t)u.pn * BM * K) * 2; }
    DI void signal(const Unit&) const {}
    DI void wait(const Unit& u) const {
        unsigned sp = 0;
        while (__hip_atomic_load(flags + u.pm, __ATOMIC_RELAXED, __HIP_MEMORY_SCOPE_AGENT) < 4u) { __builtin_amdgcn_s_sleep(4); if (++sp > (1u << 22)) break; }
#ifdef MOE_ACQ1
        __builtin_amdgcn_fence(__ATOMIC_ACQUIRE, "agent"); asm volatile("s_waitcnt vmcnt(0)" ::: "memory");
#else
        asm volatile("" ::: "memory");
#endif
    }
};
#endif

struct EpiStore {
    bf16_t* O0; int ld0; bf16_t* O1; int ld1;
    DI void operator()(const f32x4 (&acc)[2][2][4][2], const Unit& u, int wr, int wc, int fr, int fq) const {
        bf16_t* base = u.aux ? O1 : O0; const int ldc = u.aux ? ld1 : ld0;
        const int row0 = u.pm * BM + wr * 64 + fr, col0 = u.pn * BM + wc * 32 + 8 * fq;
#pragma unroll
        for (int ai = 0; ai < 2; ++ai)
#pragma unroll
            for (int m = 0; m < 4; ++m) { bf16_t* rowp = base + (size_t)(row0 + ai * HALF + m * 16) * ldc + col0;
#pragma unroll
                for (int bj = 0; bj < 2; ++bj) { const f32x4 v0 = acc[ai][bj][m][0], v1 = acc[ai][bj][m][1];
                    u32x4 w; w.x = cvtpk(v0[0], v0[1]); w.y = cvtpk(v0[2], v0[3]); w.z = cvtpk(v1[0], v1[1]); w.w = cvtpk(v1[2], v1[3]);
                    *(u32x4*)(rowp + bj * HALF) = w; } }
    }
};
#ifdef KV_TILED
struct EpiGemm1 {
    bf16_t* O0; int ld0; bf16_t* Kt; bf16_t* Vt;
    DI void operator()(const f32x4 (&acc)[2][2][4][2], const Unit& u, int wr, int wc, int fr, int fq) const {
        const int row0 = u.pm * BM + wr * 64 + fr, col0 = u.pn * BM + wc * 32 + 8 * fq;
#pragma unroll
        for (int ai = 0; ai < 2; ++ai)
#pragma unroll
            for (int m = 0; m < 4; ++m) { const int row = row0 + ai * HALF + m * 16;
#pragma unroll
                for (int bj = 0; bj < 2; ++bj) { const f32x4 v0 = acc[ai][bj][m][0], v1 = acc[ai][bj][m][1]; const int col = col0 + bj * HALF;
                    u32x4 w; w.x = cvtpk(v0[0], v0[1]); w.y = cvtpk(v0[2], v0[3]); w.z = cvtpk(v1[0], v1[1]); w.w = cvtpk(v1[2], v1[3]);
                    if (u.aux) {
                        if (row < 384) { const int head = row >> 6, dd = row & 63, tl = col >> 5, tk = col & 31;
                            *(u32x4*)(Vt + ((((size_t)head * (T / 32) + tl) * 4 + (dd >> 5) * 2 + (tk >> 4)) * 32 + (dd & 31)) * 16 + (tk & 15)) = w; }
                    } else if (col >= 384 && col < 768) {
                        const int head = (col - 384) >> 6, d = (col - 384) & 63, tl = row >> 5, tk = row & 31, pos = (tk & 19) | ((tk & 4) << 1) | ((tk & 8) >> 1);
                        *(u32x4*)(Kt + ((((size_t)head * (T / 32) + tl) * 4 + (d >> 4)) * 32 + pos) * 16 + (d & 15)) = w;
                    } else *(u32x4*)(O0 + (size_t)row * ld0 + col) = w; } }
    }
};
#endif
struct EpiSwiGlu {
    bf16_t* O;
    DI void operator()(const f32x4 (&acc)[2][2][4][2], const Unit& u, int wr, int wc, int fr, int fq) const {
        const int row0 = u.pm * BM + wr * 64 + fr, col0 = u.pn * HALF + wc * 32 + 8 * fq;
#pragma unroll
        for (int ai = 0; ai < 2; ++ai)
#pragma unroll
            for (int m = 0; m < 4; ++m) { bf16_t* rowp = O + (size_t)(row0 + ai * HALF + m * 16) * DE + col0;
                float hv[8];
#pragma unroll
                for (int n = 0; n < 2; ++n)
#pragma unroll
                    for (int e = 0; e < 4; ++e) { const float g = acc[ai][0][m][n][e], up = acc[ai][1][m][n][e]; hv[4 * n + e] = g * sigm(g) * up; }
                u32x4 w; w.x = cvtpk(hv[0], hv[1]); w.y = cvtpk(hv[2], hv[3]); w.z = cvtpk(hv[4], hv[5]); w.w = cvtpk(hv[6], hv[7]);
#ifdef FUSE_MOE
                asm volatile("global_store_dwordx4 %0, %1, off sc1\n\ts_nop 1" :: "v"(rowp), "v"(w) : "memory");
#else
                *(u32x4*)rowp = w;
#endif
            }
    }
};
struct EpiRowScale {
    bf16_t* O; const float* roww;
    DI void operator()(const f32x4 (&acc)[2][2][4][2], const Unit& u, int wr, int wc, int fr, int fq) const {
        const int row0 = u.pm * BM + wr * 64 + fr, col0 = u.pn * BM + wc * 32 + 8 * fq;
#pragma unroll
        for (int ai = 0; ai < 2; ++ai)
#pragma unroll
            for (int m = 0; m < 4; ++m) { const int row = row0 + ai * HALF + m * 16;
#ifdef MOEB_NOSCALE
                const float s = 1.f;
#else
                const float s = roww[row];
#endif
                bf16_t* rowp = O + (size_t)row * D + col0;
#pragma unroll
                for (int bj = 0; bj < 2; ++bj) { const f32x4 v0 = acc[ai][bj][m][0] * s, v1 = acc[ai][bj][m][1] * s;
                    u32x4 w; w.x = cvtpk(v0[0], v0[1]); w.y = cvtpk(v0[2], v0[3]); w.z = cvtpk(v1[0], v1[1]); w.w = cvtpk(v1[2], v1[3]);
                    *(u32x4*)(rowp + bj * HALF) = w; } }
    }
};

template <class Epi, class Sched>
DI void gemm_phase(LAS unsigned char* lds, const int tid, const int K, const Sched& S, const Epi& E) {
    const int wid = __builtin_amdgcn_readfirstlane(tid >> 6), lane = tid & 63, wr = wid >> 2, wc = wid & 3, fr = lane & 15, fq = lane >> 4;
    const int nt = K / BK;
    unsigned voffA[2], voffB[2];
#pragma unroll
    for (int i = 0; i < 2; ++i) { int R, C; stage_rc(tid * 16 + i * 8192, R, C); const int Rb = (R & ~31) + perm32(R & 31);
        voffA[i] = (unsigned)(R * K + C) * 2u; voffB[i] = (unsigned)(Rb * K + C) * 2u; }
    const size_t kstep = (size_t)(BK * 2);
    const size_t hstep = (size_t)HALF * K * 2;
    const size_t hstepA = Sched::GATHER ? 0 : hstep;
    int RA_[2], CA_[2];
#pragma unroll
    for (int i = 0; i < 2; ++i) stage_rc(tid * 16 + i * 8192, RA_[i], CA_[i]);
    unsigned vgc[2][2], vgn[2][2], vgnn[2][2];
#define PG8_GLOAD(dst, u_) do { if constexpr (Sched::GATHER) { _Pragma("unroll") for (int h_ = 0; h_ < 2; ++h_) _Pragma("unroll") for (int i_ = 0; i_ < 2; ++i_) \
        dst[h_][i_] = ((unsigned)S.rowtok[(u_).pm * BM + h_ * HALF + RA_[i_]] * (unsigned)K + (unsigned)CA_[i_]) * 2u; } } while (0)
    const unsigned ldsw = (unsigned)wid * 1024u;
    const int aoff = lds_byte(wr * 64 + fr, fq * 8), boff = lds_byte(wc * 32 + fr, fq * 8);
#define PG8_SA(b, h) (((b) * 2 + (h)) * HTB)
#define PG8_SB(b, h) ((4 + (b) * 2 + (h)) * HTB)
#define PG8_STAGE(bufoff, gbase, voff) do { _Pragma("unroll") for (int _i = 0; _i < 2; ++_i) \
        __builtin_amdgcn_global_load_lds((const unsigned*)((const char*)(gbase) + (voff)[_i]), (LAS unsigned*)(lds + (bufoff) + ldsw + _i * 8192), 16, 0, 0); } while (0)
#define PG8_STAGE_C(bufoff, gbase, voff) do { _Pragma("unroll") for (int _i = 0; _i < 2; ++_i) \
        __builtin_amdgcn_global_load_lds((const unsigned*)((const char*)(gbase) + (voff)[_i]), (LAS unsigned*)(lds + (bufoff) + ldsw + _i * 8192), 16, 0, 16); } while (0)
#define PG8_STAGE_A(b, h, gbase, cur_) do { if constexpr (Sched::GATHER) { unsigned vo_[2]; vo_[0] = (cur_) ? vgc[h][0] : vgn[h][0]; vo_[1] = (cur_) ? vgc[h][1] : vgn[h][1]; PG8_STAGE(PG8_SA(b, h), gbase, vo_); } else if constexpr (Sched::WAIT && !Sched::ACQ1) PG8_STAGE_C(PG8_SA(b, h), (gbase) + (h) * hstepA, voffA); else PG8_STAGE(PG8_SA(b, h), (gbase) + (h) * hstepA, voffA); } while (0)
#define PG8_LDA(dst, b, h) do { _Pragma("unroll") for (int m = 0; m < 4; ++m) _Pragma("unroll") for (int k = 0; k < 2; ++k) dst[m][k] = *(const LAS bf16x8*)(lds + PG8_SA(b, h) + aoff + m * 2048 + k * 1024); } while (0)
#define PG8_LDB(dst, b, h) do { _Pragma("unroll") for (int n = 0; n < 2; ++n) _Pragma("unroll") for (int k = 0; k < 2; ++k) dst[n][k] = *(const LAS bf16x8*)(lds + PG8_SB(b, h) + boff + n * 2048 + k * 1024); } while (0)
#define PG8_MMA(ai, bj, At, Bt) do { __builtin_amdgcn_s_setprio(1); _Pragma("unroll") for (int m = 0; m < 4; ++m) _Pragma("unroll") for (int n = 0; n < 2; ++n) _Pragma("unroll") for (int k = 0; k < 2; ++k) \
        acc[ai][bj][m][n] = __builtin_amdgcn_mfma_f32_16x16x32_bf16(Bt[n][k], At[m][k], acc[ai][bj][m][n], 0, 0, 0); __builtin_amdgcn_s_setprio(0); } while (0)
#define PG8_WAIT_V(n) asm volatile("s_waitcnt vmcnt(" #n ")" ::: "memory")
#define PG8_WAIT_L(n) asm volatile("s_waitcnt lgkmcnt(" #n ")" ::: "memory")
#define PG8_BAR __builtin_amdgcn_s_barrier()
#define PG8_SCHED __builtin_amdgcn_sched_barrier(0)
    Unit cur, nxt; int ui = 0;
    if (!S.next(0, cur)) return;
    f32x4 acc[2][2][4][2];
#pragma unroll
    for (int a = 0; a < 2; ++a)
#pragma unroll
        for (int b = 0; b < 2; ++b)
#pragma unroll
            for (int m = 0; m < 4; ++m)
#pragma unroll
                for (int n = 0; n < 2; ++n) acc[a][b][m][n] = (f32x4){0.f, 0.f, 0.f, 0.f};
    bf16x8 At[4][2], B0[2][2], B1[2][2];
    const char* cA = S.aptr(cur); const char* cB = S.bptr(cur);
    if constexpr (Sched::WAIT) { if constexpr (Sched::ACQ1) { if (wid == 0) S.wait(cur); PG8_BAR; } else S.wait(cur); }
    if constexpr (Sched::GATHER) { Unit u1_ = cur, u2_ = cur; const bool h1_ = S.next(1, u1_); if (!h1_) u1_ = cur; const bool h2_ = h1_ && S.next(2, u2_); if (!h2_) u2_ = u1_;
        PG8_GLOAD(vgc, cur); PG8_GLOAD(vgn, u1_); PG8_GLOAD(vgnn, u2_); }
    PG8_STAGE(PG8_SB(0, 0), cB, voffB); PG8_STAGE(PG8_SB(0, 1), cB + hstep, voffB); PG8_STAGE_A(0, 0, cA, true); PG8_STAGE_A(0, 1, cA, true);
    if (wr == 1) PG8_BAR;
    PG8_WAIT_V(2); PG8_BAR;
    PG8_STAGE(PG8_SB(1, 0), cB + kstep, voffB); PG8_STAGE_A(1, 0, cA + kstep, true); PG8_STAGE(PG8_SB(1, 1), cB + hstep + kstep, voffB);
    PG8_WAIT_V(6); PG8_BAR;
    for (;;) {
        const bool has_next = S.next(ui + 1, nxt);
        const char* nA = has_next ? S.aptr(nxt) : cA; const char* nB = has_next ? S.bptr(nxt) : cB;

        for (int t = 0; t < nt; t += 2) {
            const bool last = (t == nt - 2);
            if constexpr (Sched::WAIT) { if (last && has_next) { if constexpr (Sched::ACQ1) { if (wid == 0) S.wait(nxt); } else S.wait(nxt); } }
            const char* a1 = cA + (size_t)(t + 1) * kstep;
            const char* a2 = last ? nA : cA + (size_t)(t + 2) * kstep; const char* b2 = last ? nB : cB + (size_t)(t + 2) * kstep;
            const char* a3 = a2 + kstep; const char* b3 = b2 + kstep;
            PG8_LDB(B0, 0, 0); PG8_LDB(B1, 0, 1); PG8_SCHED; PG8_LDA(At, 0, 0); PG8_STAGE_A(1, 1, a1, true);
            PG8_WAIT_V(8); PG8_WAIT_L(0); PG8_BAR; PG8_MMA(0, 0, At, B0); PG8_MMA(0, 1, At, B1); PG8_BAR; PG8_SCHED;
            PG8_LDA(At, 0, 1); PG8_STAGE(PG8_SB(0, 0), b2, voffB); PG8_STAGE(PG8_SB(0, 1), b2 + hstep, voffB); PG8_STAGE_A(0, 0, a2, !last);
            PG8_WAIT_V(8); PG8_WAIT_L(0); PG8_BAR; PG8_MMA(1, 0, At, B0); PG8_MMA(1, 1, At, B1); PG8_BAR; PG8_SCHED;
            PG8_LDB(B0, 1, 0); PG8_LDB(B1, 1, 1); PG8_SCHED; PG8_LDA(At, 1, 0); PG8_STAGE_A(0, 1, a2, !last);
            PG8_WAIT_V(8); PG8_WAIT_L(0); PG8_BAR; PG8_MMA(0, 0, At, B0); PG8_MMA(0, 1, At, B1); PG8_BAR; PG8_SCHED;
            PG8_LDA(At, 1, 1); PG8_STAGE(PG8_SB(1, 0), b3, voffB); PG8_STAGE(PG8_SB(1, 1), b3 + hstep, voffB); PG8_STAGE_A(1, 0, a3, !last);
            PG8_WAIT_V(8); PG8_WAIT_L(0); PG8_BAR; PG8_MMA(1, 0, At, B0); PG8_MMA(1, 1, At, B1); PG8_BAR; PG8_SCHED;
        }
        if (wr == 0) PG8_BAR;
        E(acc, cur, wr, wc, fr, fq);
        if constexpr (Sched::SIGNAL) { PG8_WAIT_V(0); PG8_BAR; if (tid == 0) S.signal(cur); }
        if (!has_next) break;
#pragma unroll
        for (int a = 0; a < 2; ++a)
#pragma unroll
            for (int b = 0; b < 2; ++b)
#pragma unroll
                for (int m = 0; m < 4; ++m)
#pragma unroll
                    for (int n = 0; n < 2; ++n) acc[a][b][m][n] = (f32x4){0.f, 0.f, 0.f, 0.f};
        cur = nxt; cA = nA; cB = nB; ++ui;
        if constexpr (Sched::GATHER) { _Pragma("unroll") for (int h_ = 0; h_ < 2; ++h_) _Pragma("unroll") for (int i_ = 0; i_ < 2; ++i_) { vgc[h_][i_] = vgn[h_][i_]; vgn[h_][i_] = vgnn[h_][i_]; } }
        if (wr == 1) PG8_BAR;
    }
    PG8_WAIT_V(0);
    PG8_BAR;
#undef PG8_SA
#undef PG8_SB
#undef PG8_STAGE
#undef PG8_STAGE_C
#undef PG8_STAGE_A
#undef PG8_GLOAD
#undef PG8_LDA
#undef PG8_LDB
#undef PG8_MMA
#undef PG8_WAIT_V
#undef PG8_WAIT_L
#undef PG8_BAR
#undef PG8_SCHED
}
}

#define XB_TMO      128
#define XB_XCNT(j)  (256  + 64 * (j))
#define XB_XSUB(j)  (1280 + 64 * (j))
#define XB_XGEN(j)  (2304 + 64 * (j))
#define XB_TOP      3328
#define XB_TOPGEN   3392
#define XCD_BAR_WORDS 3456
#define XB_SPIN_CAP (1u << 20)
DI unsigned xb_ld(unsigned* p)              { return __hip_atomic_load(p, __ATOMIC_RELAXED, __HIP_MEMORY_SCOPE_AGENT); }
DI unsigned xb_add(unsigned* p, unsigned v) { return __hip_atomic_fetch_add(p, v, __ATOMIC_RELAXED, __HIP_MEMORY_SCOPE_AGENT); }
DI unsigned xb_xcc_id() { return (unsigned)__builtin_amdgcn_s_getreg((3 << 11) | 20) & 0xFu; }
#define XB_SPIN(cond, bar) do { unsigned _sp = 0; while (cond) { __builtin_amdgcn_s_sleep(1); \
    if ((++_sp & 255u) == 0u) { if (xb_ld(&(bar)[XB_TMO])) break; if (_sp > XB_SPIN_CAP) { atomicAdd(&(bar)[XB_TMO], 1u); break; } } } } while (0)
struct XcdBarrier { unsigned* bar; unsigned x; volatile LAS unsigned* st; };
DI XcdBarrier xcd_barrier_post(unsigned* bar, volatile LAS unsigned* st) {
    XcdBarrier b; b.bar = bar; b.x = xb_xcc_id(); b.st = st;
    if (threadIdx.x == 0) (void)xb_add(&bar[XB_XCNT(b.x)], 1u);
    return b;
}
DI void xcd_barrier_complete(unsigned* bar, unsigned x, unsigned& nloc, unsigned& nx) {
    const unsigned G = gridDim.x * gridDim.y * gridDim.z;
    unsigned sum, cnt, mine, sp = 0u;
    for (;;) {
        sum = 0u; cnt = 0u; mine = 0u;
#pragma unroll
        for (unsigned j = 0; j < 16; ++j) { const unsigned c = xb_ld(&bar[XB_XCNT(j)]); sum += c; cnt += (c > 0u) ? 1u : 0u; mine = (j == x) ? c : mine; }
        if (sum == G) break;
        __builtin_amdgcn_s_sleep(1);
        if ((++sp & 255u) == 0u) { if (xb_ld(&bar[XB_TMO])) break; if (sp > XB_SPIN_CAP) { atomicAdd(&bar[XB_TMO], 1u); break; } }
    }
    nloc = mine > 0u ? mine : 1u; nx = cnt > 0u ? cnt : 1u;
}
DI void xcd_barrier(const XcdBarrier& b) {
    asm volatile("s_waitcnt vmcnt(0)" ::: "memory");
    __syncthreads();
    if (threadIdx.x == 0) {
        unsigned* bar = b.bar;
        __builtin_amdgcn_s_waitcnt(0);
        unsigned nloc = b.st[0], nx = b.st[1];
        if (nloc == 0u) { xcd_barrier_complete(bar, b.x, nloc, nx); b.st[0] = nloc; b.st[1] = nx; }
        const unsigned old = xb_add(&bar[XB_XSUB(b.x)], 1u);
        const unsigned gen = old / nloc;
        if (old + 1u == (gen + 1u) * nloc) {
            __builtin_amdgcn_fence(__ATOMIC_RELEASE, "agent");
            asm volatile("s_waitcnt vmcnt(0)" ::: "memory");
            const unsigned og = xb_add(&bar[XB_TOP], 1u);
            const unsigned tg = og / nx;
            if (og + 1u == (tg + 1u) * nx) xb_add(&bar[XB_TOPGEN], 1u);
            else XB_SPIN(xb_ld(&bar[XB_TOPGEN]) == tg, bar);
            __builtin_amdgcn_fence(__ATOMIC_ACQUIRE, "agent");
            xb_add(&bar[XB_XGEN(b.x)], 1u);
            asm volatile("s_waitcnt vmcnt(0)" ::: "memory");
        } else {
            XB_SPIN(xb_ld(&bar[XB_XGEN(b.x)]) == gen, bar);
            __builtin_amdgcn_fence(__ATOMIC_ACQUIRE, "agent");
            asm volatile("s_waitcnt vmcnt(0)" ::: "memory");
        }
    }
    __syncthreads();
}

struct Args { const float* in[31]; float* out; unsigned char* ws; int ph_lo, ph_hi, use_cg, pad; };
struct Frame {
    LAS unsigned char* lds;
    int tid, lane, wave, G, vcu, gw, ngw, bx;
    unsigned char* ws;
};
constexpr int LDS_MISC = 131072;
constexpr int LDS_BARST = LDS_BYTES - 64;

#ifdef NO_PREWAIT
#define CONV_PREWAIT() do { } while (0)
#else
#define CONV_PREWAIT() __builtin_amdgcn_s_waitcnt(0x0F70)
#endif
struct TItem { const float* src; bf16_t* dst; int ldw, ldt; };
#ifdef TITEM2
DI void titem_load(const TItem& t, f32x4 (&v)[16], int lane) {
#pragma unroll
    for (int i = 0; i < 16; ++i) v[i] = *(const f32x4*)(t.src + (size_t)(16 * (i >> 2) + 4 * (lane >> 4) + (i & 3)) * t.ldw + 4 * (lane & 15));
}
DI void titem_store(const TItem& t, const f32x4 (&v)[16], LAS float* scr, int lane) {
    LAS unsigned char* T = (LAS unsigned char*)scr;
    const int rr = lane >> 4, cc = lane & 15;
#pragma unroll
    for (int q = 0; q < 4; ++q)
#pragma unroll
        for (int e = 0; e < 4; ++e)
            *(LAS u32x2*)(T + (4 * cc + e) * 136 + (16 * q + 4 * rr) * 2) = (u32x2){cvtpk(v[4 * q][e], v[4 * q + 1][e]), cvtpk(v[4 * q + 2][e], v[4 * q + 3][e])};
    LDS_WAIT();
#pragma unroll
    for (int j = 0; j < 8; ++j) {
        const int n = 8 * j + (lane >> 3), c = lane & 7;
        const u32x2 lo = *(const LAS u32x2*)(T + n * 136 + 16 * c), hi = *(const LAS u32x2*)(T + n * 136 + 16 * c + 8);
        *(u32x4*)(t.dst + (size_t)n * t.ldt + 8 * c) = (u32x4){lo.x, lo.y, hi.x, hi.y};
    }
    LDS_WAIT();
}
#else
DI void titem_load(const TItem& t, f32x4 (&v)[16], int lane) {
#pragma unroll
    for (int i = 0; i < 16; ++i) v[i] = *(const f32x4*)(t.src + (size_t)(4 * i + (lane >> 4)) * t.ldw + 4 * (lane & 15));
}
DI void titem_store(const TItem& t, const f32x4 (&v)[16], LAS float* scr, int lane) {
#pragma unroll
    for (int i = 0; i < 16; ++i) { LAS float* s = scr + (4 * i + (lane >> 4)) * 65 + 4 * (lane & 15); s[0] = v[i][0]; s[1] = v[i][1]; s[2] = v[i][2]; s[3] = v[i][3]; }
    LDS_WAIT();
#pragma unroll
    for (int j = 0; j < 8; ++j) {
        const int n = 8 * j + (lane >> 3), c = lane & 7; const LAS float* s = scr + (8 * c) * 65 + n;
        u32x4 o; o.x = cvtpk(s[0], s[65]); o.y = cvtpk(s[130], s[195]); o.z = cvtpk(s[260], s[325]); o.w = cvtpk(s[390], s[455]);
        *(u32x4*)(t.dst + (size_t)n * t.ldt + 8 * c) = o;
    }
    LDS_WAIT();
}
#endif
constexpr int IT_WIN = 16 * 42, IT_WOUT = 16 * 16, IT_SMALL = IT_WIN + IT_WOUT;
constexpr int IT_EXP = 128 * 3, IT_MOE = NE * IT_EXP;
DI TItem small_item(const Frame& F, const float* w_in, const float* w_out, int git) {
    const int l = git / IT_SMALL, it = git % IT_SMALL; TItem t;
    if (it < IT_WIN) {
        const int kt = it / 42, nt = it % 42, n0 = 64 * nt;
        size_t drow; if (n0 < 768) drow = n0; else if (n0 < 1152) drow = 2304 + (n0 - 768); else drow = n0 - 384;
        t.src = w_in + (size_t)l * D * INW + (size_t)(64 * kt) * INW + n0; t.ldw = INW;
        t.dst = (bf16_t*)(F.ws + WS_WIN + (size_t)l * WIN_LAYER) + drow * D + 64 * kt; t.ldt = D;
    } else {
        const int r = it - IT_WIN, kt = r >> 4, nt = r & 15;
        t.src = w_out + (size_t)l * D * D + (size_t)(64 * kt) * D + 64 * nt; t.ldw = D;
        t.dst = (bf16_t*)(F.ws + WS_WOUT) + (size_t)l * D * D + (size_t)(64 * nt) * D + 64 * kt; t.ldt = D;
    }
    return t;
}
DI TItem moe_item(const Frame& F, const float* wg, const float* wu, const float* wd, int l, int it) {
    const int e = it / IT_EXP, r = it % IT_EXP, which = r >> 7, q = r & 127; TItem t;
    if (which < 2) {
        const int kt = q >> 3, nt = q & 7, n0 = 64 * nt;
        t.src = (which ? wu : wg) + ((size_t)l * NE + e) * D * DE + (size_t)(64 * kt) * DE + n0; t.ldw = DE;
        const size_t drow = (size_t)(n0 >> 7) * 256 + (which ? 128 : 0) + (n0 & 127);
        t.dst = (bf16_t*)(F.ws + WS_WGU) + (size_t)e * D * D + drow * D + 64 * kt; t.ldt = D;
    } else {
        const int kt = q >> 4, nt = q & 15;
        t.src = wd + ((size_t)l * NE + e) * DE * D + (size_t)(64 * kt) * D + 64 * nt; t.ldw = D;
        t.dst = (bf16_t*)(F.ws + WS_WD) + (size_t)e * D * DE + (size_t)(64 * nt) * DE + 64 * kt; t.ldt = DE;
    }
    return t;
}
DI void p0_prologue(const Frame& F, const Args& a) {
    const float* c = a.in[1]; const float* w_mod = a.in[2]; const float* b_mod = a.in[3];
    if (F.bx < L * (MODW / 64)) {
        LAS float* sc = (LAS float*)(F.lds);
        LAS float* red = (LAS float*)(F.lds + 8192);
        for (int i = F.tid; i < NB * D; i += NTHREADS) { const float v = c[i]; sc[i] = v / (1.f + expf(-v)); }
        __syncthreads();
        const int l = F.bx / (MODW / 64), cb = F.bx % (MODW / 64), n = cb * 64 + F.lane;
        const float* w = w_mod + (size_t)l * D * MODW + n;
        float a0 = 0.f, a1 = 0.f;
#pragma unroll 8
        for (int k = F.wave * 128; k < F.wave * 128 + 128; ++k) { const float wv = w[(size_t)k * MODW]; a0 += sc[k] * wv; a1 += sc[D + k] * wv; }
        red[(F.wave * 2 + 0) * 64 + F.lane] = a0; red[(F.wave * 2 + 1) * 64 + F.lane] = a1;
        __syncthreads();
        if (F.tid < 128) { const int b = F.tid >> 6, ln = F.tid & 63; float s = 0.f;
#pragma unroll
            for (int w8 = 0; w8 < 8; ++w8) s += red[(w8 * 2 + b) * 64 + ln];
            const int nn = cb * 64 + ln;
            ((float*)(F.ws + WS_MOD))[(size_t)(l * NB + b) * MODW + nn] = s + b_mod[l * MODW + nn]; }
        __syncthreads();
    }
    { const int nzero = L * 128 * D / 8;
      for (int i = F.gw * 64 + F.lane; i < nzero; i += F.ngw * 64) { const int l = i / (128 * D / 8), r = i % (128 * D / 8);
          *(u32x4*)((bf16_t*)(F.ws + WS_WIN + (size_t)l * WIN_LAYER) + (size_t)(2304 + 384) * D + (size_t)r * 8) = (u32x4){0u, 0u, 0u, 0u}; } }
    LAS float* scr = (LAS float*)(F.lds + 16384) + F.wave * (64 * 65);
    { f32x4 cur[16], nxt[16]; int it = F.gw; TItem tc{}, tn{};
      if (it < L * IT_SMALL) { tc = small_item(F, a.in[4], a.in[19], it); titem_load(tc, cur, F.lane); }
      CONV_PREWAIT();
      for (; it < L * IT_SMALL; it += F.ngw) {
          const bool more = it + F.ngw < L * IT_SMALL;
          if (more) { tn = small_item(F, a.in[4], a.in[19], it + F.ngw); titem_load(tn, nxt, F.lane); }
          titem_store(tc, cur, scr, F.lane);
          if (more) { tc = tn;
#pragma unroll
              for (int i = 0; i < 16; ++i) cur[i] = nxt[i]; }
      } }
}

DI void row_ln(f32x4 (&v)[4], float& mean_out, float& rstd_out) {
    float s = 0.f;
#pragma unroll
    for (int j = 0; j < 4; ++j) s += (v[j][0] + v[j][1]) + (v[j][2] + v[j][3]);
    const float mean = wave_sum(s) * (1.f / D); float q = 0.f;
#pragma unroll
    for (int j = 0; j < 4; ++j) { v[j] = v[j] - mean; q += (v[j][0] * v[j][0] + v[j][1] * v[j][1]) + (v[j][2] * v[j][2] + v[j][3] * v[j][3]); }
    mean_out = mean; rstd_out = 1.f / sqrtf(wave_sum(q) * (1.f / D) + LN_EPS);
}
DI void row_mod_store(f32x4 (&v)[4], const float* md, int off_sh, int off_sc, bf16_t* urow, int lane) {
    float mean, rstd; row_ln(v, mean, rstd);
#pragma unroll
    for (int j = 0; j < 4; ++j) { const int col = 4 * lane + 256 * j;
        const f32x4 scv = *(const f32x4*)(md + off_sc + col), shv = *(const f32x4*)(md + off_sh + col);
        v[j] = v[j] * rstd * (1.f + scv) + shv;
        u32x2 w; w.x = cvtpk(v[j][0], v[j][1]); w.y = cvtpk(v[j][2], v[j][3]);
        *(u32x2*)(urow + col) = w; }
}
DI void p_r0(const Frame& F, const float* x) {
    const float* MOD = (const float*)(F.ws + WS_MOD);
    bf16_t* U = (bf16_t*)(F.ws + WS_U);
    for (int row = F.gw; row < T; row += F.ngw) {
        f32x4 v[4];
#pragma unroll
        for (int j = 0; j < 4; ++j) v[j] = *(const f32x4*)(x + (size_t)row * D + 4 * F.lane + 256 * j);
        row_mod_store(v, MOD + (size_t)(row / S) * MODW, 0, D, U + (size_t)row * D, F.lane);
    }
}

constexpr int NGRP = T / 64;
DI void p_rowpass1(const Frame& F, const Args& a, int l, const float* xin, const bool dry = false) {
    const float* MODl = (const float*)(F.ws + WS_MOD) + (size_t)l * NB * MODW;
    const bf16_t* MIX = (const bf16_t*)(F.ws + WS_MIX);
    float* XA = (float*)(F.ws + WS_XA); bf16_t* U = (bf16_t*)(F.ws + WS_U);
    const float* gain = a.in[20] + (size_t)l * D; const float* bias = a.in[21] + (size_t)l * D;
    const float* wg = a.in[24] + (size_t)l * D * NG; const float* bg = a.in[25] + (size_t)l * NG;
    const float* we = a.in[26] + (size_t)l * D * NE; const float* be = a.in[27] + (size_t)l * NE;
    const size_t dro = dry ? 490 * MiB - WS_BC : 0;
    int* BC = (int*)(F.ws + WS_BC + dro); float* TOKW = (float*)(F.ws + WS_TOKW + dro); int* TOKSLOT = (int*)(F.ws + WS_TOKSLOT + (dry ? 496 * MiB - WS_TOKSLOT : 0));
    LAS float* RT = (LAS float*)F.lds;
    LAS unsigned* cntl = (LAS unsigned*)(F.lds + 36 * D * 4 + NWAVES * 72 * 4);
#ifdef DRY_NOFILL
    if (!dry)
#endif
#pragma unroll
    for (int kk = 0; kk < 2; ++kk) { const int k = F.tid + kk * NTHREADS;
        f32x4 v[9]; v[0] = *(const f32x4*)(wg + (size_t)k * NG);
#pragma unroll
        for (int q = 0; q < 8; ++q) v[1 + q] = *(const f32x4*)(we + (size_t)k * NE + 4 * q);
#pragma unroll
        for (int q = 0; q < 9; ++q)
#pragma unroll
            for (int e = 0; e < 4; ++e) RT[(4 * q + e) * D + k] = v[q][e]; }
    for (int grp = F.vcu; grp < NGRP; grp += F.G) {
    if (F.tid < NE) cntl[F.tid] = 0u;
    __syncthreads();
#ifdef RESBF
    const bool xbf = l > 0; const bf16_t* xinb = (const bf16_t*)xin; bf16_t* XAb = (bf16_t*)(F.ws + WS_XA);
    u32x4 pxa[4], pxb[4]; u32x2 pma[4], pmb[4];
#define RP1_LDX(dst, row_, col_) do { if (xbf) { const u32x2 t_ = *(const u32x2*)(xinb + (size_t)(row_) * D + (col_)); dst.x = t_.x; dst.y = t_.y; } else dst = *(const u32x4*)(xin + (size_t)(row_) * D + (col_)); } while (0)
#define RP1_XV(p_) (xbf ? (f32x4){bflo(p_.x), bfhi(p_.x), bflo(p_.y), bfhi(p_.y)} : __builtin_bit_cast(f32x4, p_))
#else
    f32x4 pxa[4], pxb[4]; u32x2 pma[4], pmb[4];
#define RP1_LDX(dst, row_, col_) dst = *(const f32x4*)(xin + (size_t)(row_) * D + (col_))
#define RP1_XV(p_) (p_)
#endif
    { const int r0 = 64 * grp + 8 * F.wave;
#pragma unroll
      for (int j = 0; j < 4; ++j) { const int col = 4 * F.lane + 256 * j; RP1_LDX(pxa[j], r0, col); RP1_LDX(pxb[j], r0 + 1, col);
          pma[j] = *(const u32x2*)(MIX + (size_t)r0 * D + col); pmb[j] = *(const u32x2*)(MIX + (size_t)(r0 + 1) * D + col); } }
    for (int rp = 0; rp < 4; ++rp) {
        const int row0 = 64 * grp + 8 * F.wave + 2 * rp; const float* md = MODl + (size_t)(row0 / S) * MODW;
        f32x4 va[4], vb[4];
#pragma unroll
        for (int j = 0; j < 4; ++j) { const int col = 4 * F.lane + 256 * j;
            const f32x4 g = *(const f32x4*)(md + 2 * D + col);
            va[j] = RP1_XV(pxa[j]) * ALPHA + g * (f32x4){bflo(pma[j].x), bfhi(pma[j].x), bflo(pma[j].y), bfhi(pma[j].y)};
            vb[j] = RP1_XV(pxb[j]) * ALPHA + g * (f32x4){bflo(pmb[j].x), bfhi(pmb[j].x), bflo(pmb[j].y), bfhi(pmb[j].y)}; }
        if (rp < 3) { const int r0 = row0 + 2;
#pragma unroll
          for (int j = 0; j < 4; ++j) { const int col = 4 * F.lane + 256 * j; RP1_LDX(pxa[j], r0, col); RP1_LDX(pxb[j], r0 + 1, col);
              pma[j] = *(const u32x2*)(MIX + (size_t)r0 * D + col); pmb[j] = *(const u32x2*)(MIX + (size_t)(r0 + 1) * D + col); } }
        float mean, rstd;
        row_ln(va, mean, rstd);
#pragma unroll
        for (int j = 0; j < 4; ++j) { const int col = 4 * F.lane + 256 * j; va[j] = va[j] * rstd * *(const f32x4*)(gain + col) + *(const f32x4*)(bias + col);
#ifdef RESBF
            *(u32x2*)(XAb + (size_t)row0 * D + col) = (u32x2){cvtpk(va[j][0], va[j][1]), cvtpk(va[j][2], va[j][3])}; }
#else
            *(f32x4*)(XA + (size_t)row0 * D + col) = va[j]; }
#endif
        row_ln(vb, mean, rstd);
#pragma unroll
        for (int j = 0; j < 4; ++j) { const int col = 4 * F.lane + 256 * j; vb[j] = vb[j] * rstd * *(const f32x4*)(gain + col) + *(const f32x4*)(bias + col);
#ifdef RESBF
            *(u32x2*)(XAb + (size_t)(row0 + 1) * D + col) = (u32x2){cvtpk(vb[j][0], vb[j][1]), cvtpk(vb[j][2], vb[j][3])}; }
#else
            *(f32x4*)(XA + (size_t)(row0 + 1) * D + col) = vb[j]; }
#endif
        row_mod_store(va, md, 3 * D, 4 * D, U + (size_t)row0 * D, F.lane);
        row_mod_store(vb, md, 3 * D, 4 * D, U + (size_t)(row0 + 1) * D, F.lane);
#ifdef DRY_NOROUTER
        if (dry) continue;
#endif
        LAS float* lg = (LAS float*)(F.lds + 36 * D * 4) + F.wave * 72;
#ifdef ROUTER_FULL
#pragma unroll 1
        for (int n = 0; n < 36; n += 3) { float sa[3], sb[3];
#pragma unroll
            for (int q = 0; q < 3; ++q) { sa[q] = 0.f; sb[q] = 0.f;
#pragma unroll
                for (int j = 0; j < 4; ++j) { const f32x4 w = *(const LAS f32x4*)(RT + (n + q) * D + 4 * F.lane + 256 * j);
                    sa[q] += (va[j][0] * w[0] + va[j][1] * w[1]) + (va[j][2] * w[2] + va[j][3] * w[3]);
                    sb[q] += (vb[j][0] * w[0] + vb[j][1] * w[1]) + (vb[j][2] * w[2] + vb[j][3] * w[3]); } }
#pragma unroll
            for (int q = 0; q < 3; ++q) { sa[q] = wave_sum(sa[q]); sb[q] = wave_sum(sb[q]); }
            if (F.lane == 0) {
#pragma unroll
                for (int q = 0; q < 3; ++q) { lg[n + q] = sa[q]; lg[36 + n + q] = sb[q]; } } }
#else
        int gia, gib;
        { float sa[4], sb[4];
#pragma unroll
          for (int q = 0; q < 4; ++q) { sa[q] = 0.f; sb[q] = 0.f;
#pragma unroll
              for (int j = 0; j < 4; ++j) { const f32x4 w = *(const LAS f32x4*)(RT + q * D + 4 * F.lane + 256 * j);
                  sa[q] += (va[j][0] * w[0] + va[j][1] * w[1]) + (va[j][2] * w[2] + va[j][3] * w[3]);
                  sb[q] += (vb[j][0] * w[0] + vb[j][1] * w[1]) + (vb[j][2] * w[2] + vb[j][3] * w[3]); } }
#pragma unroll
          for (int q = 0; q < 4; ++q) { sa[q] = wave_sum(sa[q]); sb[q] = wave_sum(sb[q]); }
          if (F.lane == 0) {
#pragma unroll
              for (int q = 0; q < 4; ++q) { lg[q] = sa[q]; lg[36 + q] = sb[q]; } }
          gia = 0; gib = 0; float ma = sa[0] + bg[0], mb = sb[0] + bg[0];
#pragma unroll
          for (int q = 1; q < 4; ++q) { const float xa = sa[q] + bg[q], xb = sb[q] + bg[q]; const bool ca = xa > ma, cb = xb > mb; ma = ca ? xa : ma; gia = ca ? q : gia; mb = cb ? xb : mb; gib = cb ? q : gib; }
          gia = __builtin_amdgcn_readfirstlane(gia); gib = __builtin_amdgcn_readfirstlane(gib); }
        { const LAS float* RA = RT + (4 + gia * EPG) * D + 4 * F.lane; const LAS float* RBp = RT + (4 + gib * EPG) * D + 4 * F.lane;
#pragma unroll 1
          for (int e0 = 0; e0 < EPG; e0 += 4) { float sa[4], sb[4];
#pragma unroll
              for (int q = 0; q < 4; ++q) { sa[q] = 0.f; sb[q] = 0.f;
#pragma unroll
                  for (int j = 0; j < 4; ++j) { const f32x4 wa = *(const LAS f32x4*)(RA + (e0 + q) * D + 256 * j), wb = *(const LAS f32x4*)(RBp + (e0 + q) * D + 256 * j);
                      sa[q] += (va[j][0] * wa[0] + va[j][1] * wa[1]) + (va[j][2] * wa[2] + va[j][3] * wa[3]);
                      sb[q] += (vb[j][0] * wb[0] + vb[j][1] * wb[1]) + (vb[j][2] * wb[2] + vb[j][3] * wb[3]); } }
#pragma unroll
              for (int q = 0; q < 4; ++q) { sa[q] = wave_sum(sa[q]); sb[q] = wave_sum(sb[q]); }
              if (F.lane == 0) {
#pragma unroll
                  for (int q = 0; q < 4; ++q) { lg[4 + gia * EPG + e0 + q] = sa[q]; lg[36 + 4 + gib * EPG + e0 + q] = sb[q]; } } } }
#endif
        LDS_WAIT();
#pragma unroll
        for (int rr = 0; rr < 2; ++rr) {
            float gl[4];
#pragma unroll
            for (int n = 0; n < 4; ++n) gl[n] = lg[36 * rr + n] + bg[n];
            int gi = 0; float gm = gl[0];
#pragma unroll
            for (int n = 1; n < 4; ++n) { const bool c = gl[n] > gm; gm = c ? gl[n] : gm; gi = c ? n : gi; }
            float se = 0.f;
#pragma unroll
            for (int n = 0; n < 4; ++n) se += expf(gl[n] - gm);
            const float pg = 1.f / se;
            float l1 = -3.0e38f, l2 = -3.0e38f; int i1 = 0, i2 = 0;
#pragma unroll
            for (int e = 0; e < 8; ++e) { const float v = lg[36 * rr + 4 + gi * EPG + e] + be[gi * EPG + e];
                const bool c1 = v > l1, c2 = v > l2;
                l2 = c1 ? l1 : (c2 ? v : l2); i2 = c1 ? i1 : (c2 ? e : i2); l1 = c1 ? v : l1; i1 = c1 ? e : i1; }
            const float e2 = expf(l2 - l1); const float w1 = pg / (1.f + e2), w2 = pg * e2 / (1.f + e2);
            if (F.lane == 0) {
                const int tok = row0 + rr, ea = gi * EPG + i1, eb = gi * EPG + i2;
                const unsigned pa = __hip_atomic_fetch_add(&cntl[ea], 1u, __ATOMIC_RELAXED, __HIP_MEMORY_SCOPE_WORKGROUP), pb = __hip_atomic_fetch_add(&cntl[eb], 1u, __ATOMIC_RELAXED, __HIP_MEMORY_SCOPE_WORKGROUP);
                TOKSLOT[tok * 2] = (ea << 14) | (int)pa; TOKSLOT[tok * 2 + 1] = (eb << 14) | (int)pb;
                TOKW[tok * 2] = w1; TOKW[tok * 2 + 1] = w2;
            }
        }
    }
    __syncthreads();
    if (F.tid < NE) BC[grp * NE + F.tid] = (int)cntl[F.tid];
    __syncthreads();
    }
}

DI void build_tables(const Frame& F, int l, LAS int* tb) {
    if (F.tid < 64) {
        const int e = F.lane; const int c = e < NE ? ((const int*)(F.ws + WS_CNTF))[e] : 0; const int tl = (c + 255) >> 8;
        int cum = c, tin = tl;
#pragma unroll
        for (int o = 1; o < 32; o <<= 1) { const int a1 = __shfl_up(cum, o), a2 = __shfl_up(tin, o); if (e >= o) { cum += a1; tin += a2; } }
        if (e < NE) { tb[e] = cum - c; tb[33 + e] = (tin - tl) * 256; for (int t2 = 0; t2 < tl; ++t2) tb[66 + (tin - tl) + t2] = e; }
        if (e == NE - 1) { tb[32] = cum; tb[65] = tin; }
    }
    __syncthreads();
}
DI void p_gather(const Frame& F, int l) {
    LAS int* base = (LAS int*)F.lds;
    LAS int* segt = base + NGRP * NE;
    LAS int* offp = segt + 16 * NE;
    const int* BC = (const int*)(F.ws + WS_BC);
    { int tmp[NGRP * NE / NTHREADS];
#pragma unroll
      for (int q = 0; q < NGRP * NE / NTHREADS; ++q) tmp[q] = BC[F.tid + q * NTHREADS];
#pragma unroll
      for (int q = 0; q < NGRP * NE / NTHREADS; ++q) base[F.tid + q * NTHREADS] = tmp[q]; }
    __syncthreads();
    { const int e = F.tid & 31, sg = F.tid >> 5; int run = 0;
      for (int g = 16 * sg; g < 16 * sg + 16; ++g) { const int c = base[g * NE + e]; base[g * NE + e] = run; run += c; }
      segt[sg * NE + e] = run; }
    __syncthreads();
    if (F.tid < NE) { int run = 0; for (int sg = 0; sg < 16; ++sg) { const int c = segt[sg * NE + F.tid]; segt[sg * NE + F.tid] = run; run += c; }
        offp[F.tid] = run;
        if (F.bx == 0) ((int*)(F.ws + WS_CNTF))[F.tid] = run; }
    __syncthreads();
    if (F.tid == 0) { int off = 0; for (int e = 0; e < NE; ++e) { const int c = offp[e]; offp[e] = off; off += ((c + 255) >> 8) * 256; } }
    __syncthreads();
    const int* TOKSLOT = (const int*)(F.ws + WS_TOKSLOT); const float* TOKW = (const float*)(F.ws + WS_TOKW); int* TOKFIN = (int*)(F.ws + WS_TOKFIN);
    float* SLOTW = (float*)(F.ws + WS_SLOTW);
    const int nas = (2 * T - F.gw + F.ngw - 1) / F.ngw;
    int my_slot = 0, my_tok = 0;
    if (F.lane < nas) { const int as = F.gw + F.lane * F.ngw; const int tok = as >> 1, ts = TOKSLOT[as], e = ts >> 14, grp = tok >> 6, sg = grp >> 4;
        my_slot = offp[e] + segt[sg * NE + e] + base[grp * NE + e] + (ts & 16383); my_tok = tok;
        SLOTW[my_slot] = TOKW[as]; TOKFIN[as] = my_slot; ((int*)(F.ws + WS_CTL + WS_SLOTTOK))[my_slot] = tok; }
}
#ifdef RESBF
struct Rp2In { u32x2 x[4]; u32x2 y0[4], y1[4]; };
DI void rp2_load(Rp2In& r, const float* XA, const bf16_t* YS, int row, int s0, int s1, int lane) {
    const bf16_t* XAb = (const bf16_t*)XA;
#pragma unroll
    for (int j = 0; j < 4; ++j) { const int col = 4 * lane + 256 * j;
        r.x[j] = *(const u32x2*)(XAb + (size_t)row * D + col); r.y0[j] = *(const u32x2*)(YS + (size_t)s0 * D + col); r.y1[j] = *(const u32x2*)(YS + (size_t)s1 * D + col); }
}
#define RP2_XV(p_) ((f32x4){bflo(p_.x), bfhi(p_.x), bflo(p_.y), bfhi(p_.y)})
#else
struct Rp2In { f32x4 x[4]; u32x2 y0[4], y1[4]; };
DI void rp2_load(Rp2In& r, const float* XA, const bf16_t* YS, int row, int s0, int s1, int lane) {
#pragma unroll
    for (int j = 0; j < 4; ++j) { const int col = 4 * lane + 256 * j;
        r.x[j] = *(const f32x4*)(XA + (size_t)row * D + col); r.y0[j] = *(const u32x2*)(YS + (size_t)s0 * D + col); r.y1[j] = *(const u32x2*)(YS + (size_t)s1 * D + col); }
}
#define RP2_XV(p_) (p_)
#endif
DI void p_rowpass2(const Frame& F, const Args& a, int l, float* xout) {
    const float* MOD = (const float*)(F.ws + WS_MOD);
    const float* XA = (const float*)(F.ws + WS_XA); const bf16_t* YS = (const bf16_t*)(F.ws + WS_YS); const int* TOKFIN = (const int*)(F.ws + WS_TOKFIN);
    const float* gain = a.in[22] + (size_t)l * D; const float* bias = a.in[23] + (size_t)l * D;
    bf16_t* U = (bf16_t*)(F.ws + WS_U);
    const int nrows = (T - F.gw + F.ngw - 1) / F.ngw;
    int tf = 0; { const int i = F.lane >> 1; if (i < nrows) tf = TOKFIN[(F.gw + i * F.ngw) * 2 + (F.lane & 1)]; }
    Rp2In cur, nxt;
    if (nrows > 0) rp2_load(cur, XA, YS, F.gw, __shfl(tf, 0), __shfl(tf, 1), F.lane);
    for (int i = 0; i < nrows; ++i) {
        const int row = F.gw + i * F.ngw;
        if (i + 1 < nrows) rp2_load(nxt, XA, YS, row + F.ngw, __shfl(tf, 2 * i + 2), __shfl(tf, 2 * i + 3), F.lane);
        const float* md = MOD + (size_t)(l * NB + row / S) * MODW;
        f32x4 v[4];
#pragma unroll
        for (int j = 0; j < 4; ++j) { const int col = 4 * F.lane + 256 * j;
            const f32x4 g = *(const f32x4*)(md + 5 * D + col);
            const u32x2 y0 = cur.y0[j], y1 = cur.y1[j];
            const f32x4 f = (f32x4){bflo(y0.x) + bflo(y1.x), bfhi(y0.x) + bfhi(y1.x), bflo(y0.y) + bflo(y1.y), bfhi(y0.y) + bfhi(y1.y)};
            v[j] = RP2_XV(cur.x[j]) * ALPHA + g * f; }
        float mean, rstd; row_ln(v, mean, rstd);
#pragma unroll
        for (int j = 0; j < 4; ++j) { const int col = 4 * F.lane + 256 * j; v[j] = v[j] * rstd * *(const f32x4*)(gain + col) + *(const f32x4*)(bias + col);
#ifdef TSTAMP
            if (l == L - 1) { const unsigned long long* st = (const unsigned long long*)(F.ws + WS_CTL + 40960); const float sc = 1.f + (float)(long long)(st[TS_B] - st[TS_A]) * 1e-5f; *(f32x4*)(xout + (size_t)row * D + col) = v[j] * sc; } else
#endif
#ifdef RESBF
            if (l + 1 < L) *(u32x2*)((bf16_t*)xout + (size_t)row * D + col) = (u32x2){cvtpk(v[j][0], v[j][1]), cvtpk(v[j][2], v[j][3])}; else
#endif
            *(f32x4*)(xout + (size_t)row * D + col) = v[j]; }
        if (l + 1 < L) row_mod_store(v, MOD + (size_t)((l + 1) * NB + row / S) * MODW, 0, D, U + (size_t)row * D, F.lane);
        if (i + 1 < nrows) {
#pragma unroll
            for (int j = 0; j < 4; ++j) { cur.x[j] = nxt.x[j]; cur.y0[j] = nxt.y0[j]; cur.y1[j] = nxt.y1[j]; } }
    }
}

#define MFMA16(a, b, c) __builtin_amdgcn_mfma_f32_16x16x32_bf16((a), (b), (c), 0, 0, 0)
#define MFMA32(a, b, c) __builtin_amdgcn_mfma_f32_32x32x16_bf16((a), (b), (c), 0, 0, 0)
constexpr int RB = 9216;
#define BUF(i) ((i) * RB)
constexpr int LWOFF = BUF(12), ZAOFF = BUF(0), SEGOFF = BUF(14), SEGXOFF = BUF(14) + 2048, TOTOFF = BUF(14) + 4096, NABFOFF = BUF(15), PCOFF = 16 * RB;
struct RwP { const float *conv, *w0, *w_up, *a0, *a_up, *g_up, *k_k, *k_a, *r_k, *gn_gain, *gn_bias; };

DI void lds_barrier() { asm volatile("s_waitcnt lgkmcnt(0)" ::: "memory"); __builtin_amdgcn_s_barrier(); asm volatile("" ::: "memory"); }
DI int swo(int row, int col) { return row * 144 + (((((col >> 3) ^ (row >> 3)) & 7) << 3) + (col & 7)) * 2; }
DI bf16x8 ldfrag(const LAS unsigned char* lds, int buf, int row, int ks, int lane) { return *(const LAS bf16x8*)(lds + buf + swo(row, 32 * ks + 8 * (lane >> 4))); }
DI f32x4 mm64(const LAS unsigned char* lds, int abuf, int arow0, int bbuf, int brow0, int lane) {
    f32x4 acc = (f32x4){0.f, 0.f, 0.f, 0.f};
#pragma unroll
    for (int ks = 0; ks < 2; ++ks) acc = MFMA16(ldfrag(lds, abuf, arow0 + (lane & 15), ks, lane), ldfrag(lds, bbuf, brow0 + (lane & 15), ks, lane), acc);
    return acc;
}
DI u32x2 pack4(const f32x4 v) { u32x2 w; w.x = cvtpk(v[0], v[1]); w.y = cvtpk(v[2], v[3]); return w; }
DI f32x4 unpack4(const u32x2 w) { return (f32x4){bflo(w.x), bfhi(w.x), bflo(w.y), bfhi(w.y)}; }
DI void st4(LAS unsigned char* lds, int buf, int row, int col, const f32x4 v) { *(LAS u32x2*)(lds + buf + swo(row, col)) = pack4(v); }
DI f32x4 ld4(const LAS unsigned char* lds, int buf, int row, int col) { return unpack4(*(const LAS u32x2*)(lds + buf + swo(row, col))); }
DI void st1(LAS unsigned char* lds, int buf, int row, int col, float v) { *(LAS bf16_t*)(lds + buf + swo(row, col)) = f2bf(v); }
DI float fast_tanh(float x) { const float e = fexp2(x * (2.f * LOG2E)); return 1.f - 2.f * frcp(1.f + e); }

#define OPQZ(z) int z; asm volatile("s_mov_b32 %0, 0" : "=s"(z))
constexpr int CWLOFF = PCOFF + 256;
constexpr int PRMOFF = CWLOFF + 6912;
struct RwPre { u32x2 wv, av; u32x4 gv; f32x4 w4, a4, g0, g1; u32x4 rr[3], kk[3], vv[3]; };
DI void rwkv_prefetch(const Frame& F, const Args& a, const int l, const int unit, RwPre& P) {
    const int tid = F.tid;
    const int c = unit % NCH, hd = (unit / NCH) % BH, b = (unit / (NCH * BH)) % NB, dir = unit / (NCH * BH * NB);
    const bf16_t* HBp = (const bf16_t*)(F.ws + WS_HB);
    const int u = tid >> 3, jg = tid & 7, tloc = 64 * c + u; const size_t tok = (size_t)b * S + tloc;
    const bf16_t* hrow = HBp + tok * HW;
    P.wv = *(const u32x2*)(hrow + HWL + 4 * jg); P.av = *(const u32x2*)(hrow + HAL + 4 * jg); P.gv = *(const u32x4*)(hrow + HGL + 8 * jg);
    OPQZ(z0);
    { const int m = tid >> 4, j4 = (tid & 15) * 4;
      const float* w_up = a.in[8 + z0] + (size_t)l * 2 * RW * BW; const float* a_up = a.in[10 + z0] + (size_t)l * 2 * RA * BW;
      P.w4 = *(const f32x4*)(w_up + (size_t)(dir * RW + m) * BW + hd * HD + j4); P.a4 = *(const f32x4*)(a_up + (size_t)(dir * RA + m) * BW + hd * HD + j4); }
    { const int m = tid >> 3, i8 = (tid & 7) * 8; const float* g_up = a.in[11 + z0] + (size_t)l * RG * BW;
      P.g0 = *(const f32x4*)(g_up + (size_t)m * BW + hd * HD + i8); P.g1 = *(const f32x4*)(g_up + (size_t)m * BW + hd * HD + i8 + 4); }
    const int ch0 = hd * HD + 8 * jg;
#pragma unroll
    for (int x = 0; x < 3; ++x) {
        const int tt = tloc + x - 1; const u32x4 z4 = (u32x4){0u, 0u, 0u, 0u};
        if (tt >= 0 && tt < S) { const bf16_t* hp = HBp + ((size_t)b * S + tt) * HW + HR + ch0; P.rr[x] = *(const u32x4*)hp; P.kk[x] = *(const u32x4*)(hp + BW); P.vv[x] = *(const u32x4*)(hp + 2 * BW); }
        else { P.rr[x] = z4; P.kk[x] = z4; P.vv[x] = z4; }
    }
}
DI void rwkv_local_unit(const Frame& F, const Args& a, const int l, const int unit, RwPre& PF, const int next_unit) {
    LAS unsigned char* lds = F.lds;
    int tid_ = F.tid; asm volatile("" : "+v"(tid_));
    const int tid = tid_, lane = tid_ & 63, wave = F.wave;
    const int c = unit % NCH, hd = (unit / NCH) % BH, b = (unit / (NCH * BH)) % NB, dir = unit / (NCH * BH * NB);
    const bf16_t* HBp = (const bf16_t*)(F.ws + WS_HB);
    const int u = tid >> 3, jg = tid & 7, tau = dir ? 63 - u : u, tloc = 64 * c + u;
    const size_t tok = (size_t)b * S + tloc;
    const int tn = wave & 3, tm0 = 2 * (wave >> 2), g4 = lane >> 4, l15 = lane & 15;
    if (tid < 320) { OPQZ(z2); const int which = tid >> 6, j = tid & 63;
      const float* src = which == 0 ? a.in[7 + z2] + (size_t)l * 2 * BW + dir * BW : which == 1 ? a.in[9 + z2] + (size_t)l * 2 * BW + dir * BW : which == 2 ? a.in[12 + z2] + (size_t)l * BW : which == 3 ? a.in[13 + z2] + (size_t)l * BW : a.in[14 + z2] + (size_t)l * BH * HD;
      *(LAS float*)(lds + PRMOFF + tid * 4) = src[hd * HD + j]; }
    {
        const f32x4 wf = unpack4(PF.wv);
        *(LAS u32x2*)(lds + BUF(8) + swo(tau, 4 * jg)) = pack4((f32x4){fast_tanh(wf[0]), fast_tanh(wf[1]), fast_tanh(wf[2]), fast_tanh(wf[3])});
        *(LAS u32x2*)(lds + BUF(8) + swo(tau, 32 + 4 * jg)) = PF.av;
        const u32x4 gv = PF.gv;
        u32x4 so; so.x = cvtpk(sigm(bflo(gv.x)), sigm(bfhi(gv.x))); so.y = cvtpk(sigm(bflo(gv.y)), sigm(bfhi(gv.y))); so.z = cvtpk(sigm(bflo(gv.z)), sigm(bfhi(gv.z))); so.w = cvtpk(sigm(bflo(gv.w)), sigm(bfhi(gv.w)));
        *(LAS u32x4*)(lds + BUF(9) + swo(tau, 8 * jg)) = so;
        { const int m = tid >> 4, j4 = (tid & 15) * 4;
#pragma unroll
          for (int e = 0; e < 4; ++e) { st1(lds, BUF(10), j4 + e, m, PF.w4[e]); st1(lds, BUF(10), j4 + e, 32 + m, PF.a4[e]); } }
        { const int m = tid >> 3, i8 = (tid & 7) * 8;
#pragma unroll
          for (int e = 0; e < 4; ++e) { st1(lds, BUF(11), i8 + e, m, PF.g0[e]); st1(lds, BUF(11), i8 + 4 + e, m, PF.g1[e]); } }
    }
    lds_barrier();
#pragma unroll
    for (int tmi = 0; tmi < 2; ++tmi) {
        const int tm = tm0 + tmi; const f32x4 z = (f32x4){0.f, 0.f, 0.f, 0.f};
        const f32x4 zw = MFMA16(ldfrag(lds, BUF(10), 16 * tm + l15, 0, lane), ldfrag(lds, BUF(8), 16 * tn + l15, 0, lane), z);
        const f32x4 za = MFMA16(ldfrag(lds, BUF(10), 16 * tm + l15, 1, lane), ldfrag(lds, BUF(8), 16 * tn + l15, 1, lane), z);
        const int trow = 16 * tn + l15, jb = 16 * tm + 4 * g4;
        *(LAS f32x4*)(lds + LWOFF + (trow * 64 + jb) * 4) = zw;
        *(LAS f32x4*)(lds + ZAOFF + (trow * 64 + jb) * 4) = za;
        if (dir == 0) {
            const f32x4 gg = mm64(lds, BUF(11), 16 * tm, BUF(9), 16 * tn, lane);
            *(u32x2*)((bf16_t*)(F.ws + WS_GB) + ((size_t)b * S + 64 * c + trow) * BW + hd * HD + jb) = pack4(gg);
        }
    }
    lds_barrier();
    const int ch0 = hd * HD + 8 * jg;
    float r[8], kd[8], kap[8], bb[8], lw[8];
    {
        float k[8], v[8];
#pragma unroll
        for (int e = 0; e < 8; ++e) { r[e] = 0.f; k[e] = 0.f; v[e] = 0.f; }
#pragma unroll
        for (int x = 0; x < 3; ++x) {
            const LAS unsigned char* cwp = lds + CWLOFF + (((hd * 3 + x) * 3) * 64 + 8 * jg) * 2;
            const u32x4 cr = *(const LAS u32x4*)cwp, ck = *(const LAS u32x4*)(cwp + 128), cv = *(const LAS u32x4*)(cwp + 256);
            const u32x4 rr = PF.rr[x], kk2 = PF.kk[x], vv = PF.vv[x];
            r[0] += bflo(rr.x) * bflo(cr.x); r[1] += bfhi(rr.x) * bfhi(cr.x); r[2] += bflo(rr.y) * bflo(cr.y); r[3] += bfhi(rr.y) * bfhi(cr.y);
            r[4] += bflo(rr.z) * bflo(cr.z); r[5] += bfhi(rr.z) * bfhi(cr.z); r[6] += bflo(rr.w) * bflo(cr.w); r[7] += bfhi(rr.w) * bfhi(cr.w);
            k[0] += bflo(kk2.x) * bflo(ck.x); k[1] += bfhi(kk2.x) * bfhi(ck.x); k[2] += bflo(kk2.y) * bflo(ck.y); k[3] += bfhi(kk2.y) * bfhi(ck.y);
            k[4] += bflo(kk2.z) * bflo(ck.z); k[5] += bfhi(kk2.z) * bfhi(ck.z); k[6] += bflo(kk2.w) * bflo(ck.w); k[7] += bfhi(kk2.w) * bfhi(ck.w);
            v[0] += bflo(vv.x) * bflo(cv.x); v[1] += bfhi(vv.x) * bfhi(cv.x); v[2] += bflo(vv.y) * bflo(cv.y); v[3] += bfhi(vv.y) * bfhi(cv.y);
            v[4] += bflo(vv.z) * bflo(cv.z); v[5] += bfhi(vv.z) * bfhi(cv.z); v[6] += bflo(vv.w) * bflo(cv.w); v[7] += bfhi(vv.w) * bfhi(cv.w);
        }
        const f32x4 zw0 = *(const LAS f32x4*)(lds + LWOFF + (tau * 64 + 8 * jg) * 4), zw1 = *(const LAS f32x4*)(lds + LWOFF + (tau * 64 + 8 * jg + 4) * 4);
        const f32x4 za0 = *(const LAS f32x4*)(lds + ZAOFF + (tau * 64 + 8 * jg) * 4), za1 = *(const LAS f32x4*)(lds + ZAOFF + (tau * 64 + 8 * jg + 4) * 4);
        float ss = 0.f, bsp = 0.f, av[8];
        const LAS f32x4* prm = (const LAS f32x4*)(lds + PRMOFF) + 2 * jg;
        const f32x4 w0a = prm[0], w0b = prm[1], a0a = prm[16], a0b = prm[17], kka = prm[32], kkb = prm[33], kaa = prm[48], kab = prm[49], rka = prm[64], rkb = prm[65];
#pragma unroll
        for (int e = 0; e < 8; ++e) {
            const float zw = (e < 4 ? zw0[e & 3] : zw1[e & 3]) + (e < 4 ? w0a[e & 3] : w0b[e & 3]);
            const float za = (e < 4 ? za0[e & 3] : za1[e & 3]) + (e < 4 ? a0a[e & 3] : a0b[e & 3]);
            lw[e] = (-DECAY * LOG2E) * sigm(zw); av[e] = sigm(za);
            kap[e] = k[e] * (e < 4 ? kka[e & 3] : kkb[e & 3]); ss += kap[e] * kap[e];
            kd[e] = k[e] * (1.f + (av[e] - 1.f) * (e < 4 ? kaa[e & 3] : kab[e & 3]));
            bsp += r[e] * kd[e] * (e < 4 ? rka[e & 3] : rkb[e & 3]);
        }
        ss += __shfl_xor(ss, 1); ss += __shfl_xor(ss, 2); ss += __shfl_xor(ss, 4);
        bsp += __shfl_xor(bsp, 1); bsp += __shfl_xor(bsp, 2); bsp += __shfl_xor(bsp, 4);
        const float rn = __builtin_amdgcn_rsqf(fmaxf(ss, 1e-24f));
#pragma unroll
        for (int e = 0; e < 8; ++e) { kap[e] *= rn; bb[e] = kap[e] * av[e]; }
        if (jg == 0) ((float*)(F.ws + WS_BS))[((size_t)dir * T + tok) * 8 + hd] = bsp;
        *(LAS f32x4*)(lds + LWOFF + (tau * 64 + 8 * jg) * 4) = (f32x4){lw[0], lw[1], lw[2], lw[3]};
        *(LAS f32x4*)(lds + LWOFF + (tau * 64 + 8 * jg + 4) * 4) = (f32x4){lw[4], lw[5], lw[6], lw[7]};
#pragma unroll
        for (int e = 0; e < 8; ++e) st1(lds, BUF(7), 8 * jg + e, tau, v[e]);
        if (dir == 0) {
            u32x4 vo; vo.x = cvtpk(v[0], v[1]); vo.y = cvtpk(v[2], v[3]); vo.z = cvtpk(v[4], v[5]); vo.w = cvtpk(v[6], v[7]);
            *(u32x4*)((bf16_t*)(F.ws + WS_VC) + tok * BW + ch0) = vo;
        }
    }
    lds_barrier();
    if (dir == 0) {
        const size_t ucidx = ((size_t)b * BH + hd) * NCH + c; const int vi = tid >> 3, vc = tid & 7;
        *(u32x4*)((bf16_t*)(F.ws + WS_VTB) + ucidx * 4096 + vi * 64 + vc * 8) = *(const LAS u32x4*)(lds + BUF(7) + swo(vi, 8 * vc));
    }
    { const int seg = tid >> 6, j = tid & 63; float p = 0.f;
#pragma unroll
      for (int i = 0; i < 8; ++i) { LAS float* q = (LAS float*)(lds + LWOFF + ((8 * seg + i) * 64 + j) * 4); p += *q; *q = p; }
      *(LAS float*)(lds + SEGOFF + (seg * 64 + j) * 4) = p; }
    lds_barrier();
    if (tid < 64) { float run = 0.f;
#pragma unroll
      for (int sg = 0; sg < 8; ++sg) { *(LAS float*)(lds + SEGXOFF + (sg * 64 + tid) * 4) = run; run += *(const LAS float*)(lds + SEGOFF + (sg * 64 + tid) * 4); }
      *(LAS float*)(lds + TOTOFF + tid * 4) = run; }
    lds_barrier();
    {
        float At[8], Rt[8], Bt[8], Kt[8], Bh[8], Kh[8], pcs[8];
#pragma unroll
        for (int e = 0; e < 8; ++e) {
            const int j = 8 * jg + e;
            const float lwi = *(const LAS float*)(lds + LWOFF + (tau * 64 + j) * 4) + *(const LAS float*)(lds + SEGXOFF + ((tau >> 3) * 64 + j) * 4);
            const float tot = *(const LAS float*)(lds + TOTOFF + j * 4);
            const float ep = fexp2(lwi - lw[e]), epl = fexp2(lwi), em = fexp2(-lwi), ec = fexp2(tot - lwi);
            At[e] = -kap[e] * ep; Rt[e] = r[e] * epl; Bt[e] = bb[e] * em; Kt[e] = kd[e] * em; Bh[e] = bb[e] * ec; Kh[e] = kd[e] * ec;
            pcs[e] = tot;
        }
        if (u == 0) {
            *(LAS f32x4*)(lds + PCOFF + (8 * jg) * 4) = (f32x4){fexp2(pcs[0]), fexp2(pcs[1]), fexp2(pcs[2]), fexp2(pcs[3])};
            *(LAS f32x4*)(lds + PCOFF + (8 * jg + 4) * 4) = (f32x4){fexp2(pcs[4]), fexp2(pcs[5]), fexp2(pcs[6]), fexp2(pcs[7])}; }
        u32x4 o;
#define PK8(X) (o.x = cvtpk(X[0], X[1]), o.y = cvtpk(X[2], X[3]), o.z = cvtpk(X[4], X[5]), o.w = cvtpk(X[6], X[7]), o)
        *(LAS u32x4*)(lds + BUF(0) + swo(tau, 8 * jg)) = PK8(At);
        *(LAS u32x4*)(lds + BUF(1) + swo(tau, 8 * jg)) = PK8(Bt);
        *(LAS u32x4*)(lds + BUF(2) + swo(tau, 8 * jg)) = PK8(Kt);
        *(LAS u32x4*)(lds + BUF(3) + swo(tau, 8 * jg)) = PK8(Rt);
#undef PK8
#pragma unroll
        for (int e = 0; e < 8; ++e) { const int j = 8 * jg + e; st1(lds, BUF(4), j, tau, At[e]); st1(lds, BUF(5), j, tau, Bh[e]); st1(lds, BUF(6), j, tau, Kh[e]); }
    }
    if (next_unit >= 0) rwkv_prefetch(F, a, l, next_unit, PF);
    lds_barrier();
#pragma unroll
    for (int tmi = 0; tmi < 2; ++tmi) {
        const int tm = tm0 + tmi, mb = 16 * tm + 4 * g4, nn = 16 * tn + l15;
        { f32x4 v = mm64(lds, BUF(1), 16 * tm, BUF(0), 16 * tn, lane);
#pragma unroll
          for (int e = 0; e < 4; ++e) v[e] = (mb + e < nn) ? v[e] : 0.f;
          if (tm == tn) {
#pragma unroll
              for (int e = 0; e < 4; ++e) *(LAS float*)(lds + NABFOFF + ((16 * tm + l15) * 16 + ((mb + e) & 15)) * 4) = v[e];
              v = (f32x4){0.f, 0.f, 0.f, 0.f};
          }
          st4(lds, BUF(11), nn, mb, v); }
        { f32x4 v = mm64(lds, BUF(0), 16 * tm, BUF(2), 16 * tn, lane);
#pragma unroll
          for (int e = 0; e < 4; ++e) v[e] = (nn < mb + e) ? v[e] : 0.f;
          st4(lds, BUF(8), nn, mb, v); }
        { f32x4 v = mm64(lds, BUF(1), 16 * tm, BUF(3), 16 * tn, lane);
#pragma unroll
          for (int e = 0; e < 4; ++e) v[e] = (mb + e <= nn) ? v[e] : 0.f;
          st4(lds, BUF(9), nn, mb, v); }
        { f32x4 v = mm64(lds, BUF(2), 16 * tm, BUF(3), 16 * tn, lane);
#pragma unroll
          for (int e = 0; e < 4; ++e) v[e] = (mb + e <= nn) ? v[e] : 0.f;
          st4(lds, BUF(10), nn, mb, v); }
    }
    lds_barrier();
    if (wave == 0) {
        const int blk = lane >> 4, sr = lane & 15, s = 16 * blk + sr;
        float Tr[16];
#pragma unroll
        for (int t = 0; t < 16; ++t) { float acc = (t == sr) ? 1.f : 0.f;
            const LAS f32x4* col = (const LAS f32x4*)(lds + NABFOFF + ((16 * blk + t) * 16) * 4);
#pragma unroll
            for (int q = 0; q < (t + 3) / 4; ++q) { const f32x4 nv = col[q];
#pragma unroll
                for (int e = 0; e < 4; ++e) if (4 * q + e < t) acc += Tr[4 * q + e] * nv[e]; }
            Tr[t] = acc; __builtin_amdgcn_sched_barrier(0); }
        const u32x4 z4 = (u32x4){0u, 0u, 0u, 0u};
#pragma unroll
        for (int q = 0; q < 9; ++q) { *(LAS u32x4*)(lds + BUF(0) + s * 144 + 16 * q) = z4; *(LAS u32x4*)(lds + BUF(1) + s * 144 + 16 * q) = z4; }
        u32x4 o0, o1; o0.x = cvtpk(Tr[0], Tr[1]); o0.y = cvtpk(Tr[2], Tr[3]); o0.z = cvtpk(Tr[4], Tr[5]); o0.w = cvtpk(Tr[6], Tr[7]);
        o1.x = cvtpk(Tr[8], Tr[9]); o1.y = cvtpk(Tr[10], Tr[11]); o1.z = cvtpk(Tr[12], Tr[13]); o1.w = cvtpk(Tr[14], Tr[15]);
        LDS_WAIT();
        *(LAS u32x4*)(lds + BUF(0) + swo(s, 16 * blk)) = o0; *(LAS u32x4*)(lds + BUF(0) + swo(s, 16 * blk + 8)) = o1;
#pragma unroll
        for (int t = 0; t < 16; ++t) st1(lds, BUF(1), 16 * blk + t, s, Tr[t]);
    }
    lds_barrier();
#pragma unroll
    for (int tmi = 0; tmi < 2; ++tmi) {
        const int tm = tm0 + tmi, mb = 16 * tm + 4 * g4, nn = 16 * tn + l15;
        const f32x4 v = mm64(lds, BUF(0), 16 * tm, BUF(11), 16 * tn, lane);
        st4(lds, BUF(12), nn, mb, v);
#pragma unroll
        for (int e = 0; e < 4; ++e) st1(lds, BUF(2), mb + e, nn, v[e]);
    }
    lds_barrier();
#pragma unroll
    for (int tmi = 0; tmi < 2; ++tmi) {
        const int tm = tm0 + tmi, mb = 16 * tm + 4 * g4, nn = 16 * tn + l15;
        const f32x4 v = mm64(lds, BUF(12), 16 * tm, BUF(2), 16 * tn, lane);
        st4(lds, BUF(13), nn, mb, v);
    }
    lds_barrier();
#pragma unroll
    for (int tmi = 0; tmi < 2; ++tmi) {
        const int tm = tm0 + tmi, mb = 16 * tm + 4 * g4, nn = 16 * tn + l15;
        const f32x4 v = mm64(lds, BUF(13), 16 * tm, BUF(1), 16 * tn, lane) + ld4(lds, BUF(1), nn, mb);
        st4(lds, BUF(14), nn, mb, v);
    }
    lds_barrier();
#pragma unroll
    for (int tmi = 0; tmi < 2; ++tmi) {
        const int tm = tm0 + tmi, mb = 16 * tm + 4 * g4, nn = 16 * tn + l15;
        const f32x4 v = mm64(lds, BUF(2), 16 * tm, BUF(14), 16 * tn, lane) + ld4(lds, BUF(14), nn, mb);
        st4(lds, BUF(15), nn, mb, v);
    }
    lds_barrier();
#pragma unroll
    for (int tmi = 0; tmi < 2; ++tmi) {
        const int tm = tm0 + tmi, mb = 16 * tm + 4 * g4, nn = 16 * tn + l15;
        const f32x4 x1 = mm64(lds, BUF(15), 16 * tm, BUF(4), 16 * tn, lane);
        const f32x4 x2 = mm64(lds, BUF(15), 16 * tm, BUF(8), 16 * tn, lane);
        st4(lds, BUF(0), nn, mb, x1); st4(lds, BUF(1), nn, mb, x2);
    }
    lds_barrier();
    {
        bf16_t* QT = (bf16_t*)(F.ws + WS_QT) + (size_t)unit * 4096; bf16_t* WT = (bf16_t*)(F.ws + WS_WT) + (size_t)unit * 4096; bf16_t* MP = (bf16_t*)(F.ws + WS_MP) + USK(unit) * 4096;
#pragma unroll
        for (int tmi = 0; tmi < 2; ++tmi) {
            const int tm = tm0 + tmi, mb = 16 * tm + 4 * g4, nn = 16 * tn + l15;
            { const f32x4 v = mm64(lds, BUF(0), 16 * tm, BUF(9), 16 * tn, lane) + ld4(lds, BUF(3), nn, mb);
              *(u32x2*)(QT + (dir ? 63 - nn : nn) * 64 + mb) = pack4(v); }
            { const f32x4 v = mm64(lds, BUF(1), 16 * tm, BUF(9), 16 * tn, lane) + ld4(lds, BUF(10), nn, mb);
              if (dir) *(u32x2*)(WT + (63 - nn) * 64 + (60 - mb)) = pack4((f32x4){v[3], v[2], v[1], v[0]});
              else *(u32x2*)(WT + nn * 64 + mb) = pack4(v); }
            { const float pcv = *(const volatile LAS float*)(lds + PCOFF + nn * 4);
              f32x4 v = mm64(lds, BUF(0), 16 * tm, BUF(5), 16 * tn, lane);
#pragma unroll
              for (int e = 0; e < 4; ++e) v[e] += (mb + e == nn) ? pcv : 0.f;
              *(u32x2*)(MP + nn * 64 + swap23(mb)) = pack4(v); }
            { const f32x4 v = mm64(lds, BUF(1), 16 * tm, BUF(5), 16 * tn, lane) + ld4(lds, BUF(6), nn, mb);
              st4(lds, BUF(2), nn, mb, v); }
        }
    }
    lds_barrier();
    {
        bf16_t* NBp = (bf16_t*)(F.ws + WS_NB);
#pragma unroll
        for (int tmi = 0; tmi < 2; ++tmi) {
            const int tm = tm0 + tmi, mb = 16 * tm + 4 * g4, ii = 16 * tn + l15;
            const f32x4 v = mm64(lds, BUF(2), 16 * tm, BUF(7), 16 * tn, lane);
            const int jb = mb >> 5, jl = mb & 31, q = jl >> 3, hic = (jl >> 2) & 1, ih = ii >> 5, Lc = (ii & 31) + 32 * hic;
            *(u32x2*)(NBp + (((USK(unit) * 2 + ih) * 2 + jb) * 2 + (q >> 1)) * 512 + Lc * 8 + 4 * (q & 1)) = pack4(v);
        }
    }
    lds_barrier();
}

#ifdef KV_TILED
#define ATT_KLD(ktok_, ds_) (*(const bf16x8*)(KTp + ((((size_t)hh * (T / 32) + ((ktok_) >> 5)) * 4 + (ds_)) * 32 + q32) * 16 + 8 * hi))
#define ATT_VLD(ktok_, db_, s_) (*(const bf16x8*)(VTp + ((((size_t)hh * (T / 32) + ((ktok_) >> 5)) * 4 + (db_) * 2 + (s_)) * 32 + q32) * 16 + 8 * hi))
#else
#define ATT_KLD(ktok_, ds_) (*(const bf16x8*)(HBp + ((ktok_) + krow_off) * HW + HK + hh * HD + 16 * (ds_) + 8 * hi))
#define ATT_VLD(ktok_, db_, s_) (*(const bf16x8*)(VTp + (size_t)(hh * HD + 32 * (db_) + q32) * T + (ktok_) + 16 * (s_) + 8 * hi))
#endif
DI void attn_unit(const Frame& F, const LAS float* rpbl, const int au) {
    const bf16_t* HBp = (const bf16_t*)(F.ws + WS_HB); const bf16_t* VTp = (const bf16_t*)(F.ws + WS_VT); const bf16_t* KTp = (const bf16_t*)(F.ws + WS_KT); (void)KTp; bf16_t* CONCAT = (bf16_t*)(F.ws + WS_CONCAT);
    const int hh = au % AH, r = (au / AH) % ROWS, b = au / (AH * ROWS);
    int rstart = r - KH / 2; rstart = rstart < 0 ? 0 : (rstart > ROWS - KH ? ROWS - KH : rstart);
    const int lane = F.lane, q32 = lane & 31, hi = lane >> 5;
    const float SC = 0.125f * LOG2E;
    const int krow_off = swap23(q32);
    const int cqA = q32, cqB = 32 + q32;
    int csA = cqA - KW / 2; csA = csA < 0 ? 0 : csA; int csB = cqB - KW / 2; csB = csB > GW - KW ? GW - KW : csB;
    const size_t tokA = (size_t)b * S + r * GW + cqA, tokB = tokA + 32;
    bf16x8 qfA[4], qfB[4];
#pragma unroll
    for (int ds = 0; ds < 4; ++ds) { qfA[ds] = *(const bf16x8*)(HBp + tokA * HW + HQ + hh * HD + 16 * ds + 8 * hi); qfB[ds] = *(const bf16x8*)(HBp + tokB * HW + HQ + hh * HD + 16 * ds + 8 * hi); }
    f32x16 oA0, oA1, oB0, oB1;
#pragma unroll
    for (int i = 0; i < 16; ++i) { oA0[i] = 0.f; oA1[i] = 0.f; oB0[i] = 0.f; oB1[i] = 0.f; }
    float mA = -1e30f, lA = 0.f, mB = -1e30f, lB = 0.f;
#ifdef ATT_PF
    bf16x8 kf[4], kfn[4];
    { const size_t ktok = (size_t)b * S + rstart * GW;
#pragma unroll
      for (int ds = 0; ds < 4; ++ds) kf[ds] = ATT_KLD(ktok, ds); }
    __builtin_amdgcn_s_waitcnt(0x0F70);
#endif
#pragma unroll 1
    for (int kt = 0; kt < 2 * KH; ++kt) {
        const int kr = rstart + (kt >> 1), ckb = 32 * (kt & 1);
        const size_t ktok = (size_t)b * S + kr * GW + ckb;
#ifdef ATT_PF
        { const int ktn = kt + 1 < 2 * KH ? kt + 1 : kt; const size_t ktokn = (size_t)b * S + (rstart + (ktn >> 1)) * GW + 32 * (ktn & 1);
#pragma unroll
          for (int ds = 0; ds < 4; ++ds) kfn[ds] = ATT_KLD(ktokn, ds); }
        bf16x8 vf[2][2];
#pragma unroll
        for (int db = 0; db < 2; ++db)
#pragma unroll
            for (int s = 0; s < 2; ++s) vf[db][s] = ATT_VLD(ktok, db, s);
#else
        bf16x8 kf[4], vf[2][2];
#pragma unroll
        for (int ds = 0; ds < 4; ++ds) kf[ds] = ATT_KLD(ktok, ds);
#pragma unroll
        for (int db = 0; db < 2; ++db)
#pragma unroll
            for (int s = 0; s < 2; ++s) vf[db][s] = ATT_VLD(ktok, db, s);
#endif
        const LAS float* rp = rpbl + (hh * (2 * KH - 1) + (kr - r + KH - 1)) * (2 * KW - 1);
#pragma unroll
        for (int qb = 0; qb < 2; ++qb) {
            const int cq = qb ? cqB : cqA, cs = qb ? csB : csA;
            f32x16 st;
#pragma unroll
            for (int i = 0; i < 16; ++i) st[i] = 0.f;
#pragma unroll
            for (int ds = 0; ds < 4; ++ds) st = MFMA32(kf[ds], qb ? qfB[ds] : qfA[ds], st);
            float sl[16]; float tmax = -1e30f;
            float bia[16];
#pragma unroll
            for (int i = 0; i < 16; ++i) {
                const int ck = ckb + 16 * (i >> 3) + 8 * hi + (i & 7);
                int dc = ck - cq; dc = dc < -(KW - 1) ? -(KW - 1) : (dc > KW - 1 ? KW - 1 : dc); dc += KW - 1;
                bia[i] = *(const volatile LAS float*)(rp + dc);
            }
#pragma unroll
            for (int i = 0; i < 16; ++i) {
                const int ck = ckb + 16 * (i >> 3) + 8 * hi + (i & 7);
                const bool inw = (ck >= cs) && (ck < cs + KW);
                const float sv = st[i] * SC + bia[i];
                sl[i] = inw ? sv : -1e30f;
                tmax = fmaxf(tmax, sl[i]);
            }
            tmax = fmaxf(tmax, __shfl_xor(tmax, 32));
            const float mrun = qb ? mB : mA;
            const float mn = fmaxf(mrun, tmax), corr = __builtin_amdgcn_exp2f(mrun - mn);
            float ps = 0.f;
#pragma unroll
            for (int i = 0; i < 16; ++i) { sl[i] = (sl[i] > -1e29f) ? __builtin_amdgcn_exp2f(sl[i] - mn) : 0.f; ps += sl[i]; }
            u32x4 p0, p1;
            p0.x = cvtpk(sl[0], sl[1]); p0.y = cvtpk(sl[2], sl[3]); p0.z = cvtpk(sl[4], sl[5]); p0.w = cvtpk(sl[6], sl[7]);
            p1.x = cvtpk(sl[8], sl[9]); p1.y = cvtpk(sl[10], sl[11]); p1.z = cvtpk(sl[12], sl[13]); p1.w = cvtpk(sl[14], sl[15]);
            const bf16x8 pf0 = __builtin_bit_cast(bf16x8, p0), pf1 = __builtin_bit_cast(bf16x8, p1);
            if (qb == 0) { lA = lA * corr + ps; mA = mn;
#pragma unroll
                for (int i = 0; i < 16; ++i) { oA0[i] *= corr; oA1[i] *= corr; }
                oA0 = MFMA32(vf[0][0], pf0, oA0); oA0 = MFMA32(vf[0][1], pf1, oA0); oA1 = MFMA32(vf[1][0], pf0, oA1); oA1 = MFMA32(vf[1][1], pf1, oA1);
            } else { lB = lB * corr + ps; mB = mn;
#pragma unroll
                for (int i = 0; i < 16; ++i) { oB0[i] *= corr; oB1[i] *= corr; }
                oB0 = MFMA32(vf[0][0], pf0, oB0); oB0 = MFMA32(vf[0][1], pf1, oB0); oB1 = MFMA32(vf[1][0], pf0, oB1); oB1 = MFMA32(vf[1][1], pf1, oB1);
            }
        }
#ifdef ATT_PF
#pragma unroll
        for (int ds = 0; ds < 4; ++ds) kf[ds] = kfn[ds];
#endif
    }
    { const float inv = 1.f / (lA + __shfl_xor(lA, 32)); bf16_t* op = CONCAT + tokA * D + hh * HD;
#pragma unroll
      for (int g = 0; g < 4; ++g) {
          *(u32x2*)(op + 8 * g + 4 * hi) = pack4((f32x4){oA0[4 * g] * inv, oA0[4 * g + 1] * inv, oA0[4 * g + 2] * inv, oA0[4 * g + 3] * inv});
          *(u32x2*)(op + 32 + 8 * g + 4 * hi) = pack4((f32x4){oA1[4 * g] * inv, oA1[4 * g + 1] * inv, oA1[4 * g + 2] * inv, oA1[4 * g + 3] * inv}); } }
    { const float inv = 1.f / (lB + __shfl_xor(lB, 32)); bf16_t* op = CONCAT + tokB * D + hh * HD;
#pragma unroll
      for (int g = 0; g < 4; ++g) {
          *(u32x2*)(op + 8 * g + 4 * hi) = pack4((f32x4){oB0[4 * g] * inv, oB0[4 * g + 1] * inv, oB0[4 * g + 2] * inv, oB0[4 * g + 3] * inv});
          *(u32x2*)(op + 32 + 8 * g + 4 * hi) = pack4((f32x4){oB1[4 * g] * inv, oB1[4 * g + 1] * inv, oB1[4 * g + 2] * inv, oB1[4 * g + 3] * inv}); } }
}

DI void pool_unit(const Frame& F, const float* pool_w, const float* pool_scale, const int pu) {
    const bf16_t* HBp = (const bf16_t*)(F.ws + WS_HB); bf16_t* CONCAT = (bf16_t*)(F.ws + WS_CONCAT);
    const int g = pu & 3, blk = pu >> 2, b = blk >> 8, t0 = (blk & 255) * 32;
    const int lane = F.lane, q32 = lane & 31, hi = lane >> 5, t = t0 + q32, win = 2 << g;
    int lo = t - win / 2; lo = lo < 0 ? 0 : lo; int hit = t + win / 2 - 1; hit = hit > S - 1 ? S - 1 : hit;
    const float inv = 1.f / (float)(hit - lo + 1);
    f32x16 out0, out1;
#pragma unroll
    for (int i = 0; i < 16; ++i) { out0[i] = 0.f; out1[i] = 0.f; }
    const float* pw = pool_w + (size_t)g * 64 * 64;
#pragma unroll 1
    for (int s = 0; s < 4; ++s) {
        const int c0 = HP + g * 64 + 16 * s + 8 * hi;
        float acc[8];
#pragma unroll
        for (int e = 0; e < 8; ++e) acc[e] = 0.f;
        u32x4 pv[16];
#pragma unroll
        for (int d = 0; d < 16; ++d) { int tt = t - win / 2 + d; const bool ok = d < win && tt >= 0 && tt < S; tt = ok ? tt : t;
            pv[d] = *(const u32x4*)(HBp + ((size_t)b * S + tt) * HW + c0); if (!ok) pv[d] = (u32x4){0u, 0u, 0u, 0u}; }
#pragma unroll
        for (int d = 0; d < 16; ++d) {
            acc[0] += bflo(pv[d].x); acc[1] += bfhi(pv[d].x); acc[2] += bflo(pv[d].y); acc[3] += bfhi(pv[d].y); acc[4] += bflo(pv[d].z); acc[5] += bfhi(pv[d].z); acc[6] += bflo(pv[d].w); acc[7] += bfhi(pv[d].w);
        }
        const u32x4 pc = *(const u32x4*)(HBp + ((size_t)b * S + t) * HW + c0);
        u32x4 o;
        o.x = cvtpk(acc[0] * inv - bflo(pc.x), acc[1] * inv - bfhi(pc.x)); o.y = cvtpk(acc[2] * inv - bflo(pc.y), acc[3] * inv - bfhi(pc.y));
        o.z = cvtpk(acc[4] * inv - bflo(pc.z), acc[5] * inv - bfhi(pc.z)); o.w = cvtpk(acc[6] * inv - bflo(pc.w), acc[7] * inv - bfhi(pc.w));
        const bf16x8 bfr = __builtin_bit_cast(bf16x8, o);
        const float* wp = pw + (size_t)(16 * s + 8 * hi) * 64 + q32;
        u32x4 w0; w0.x = cvtpk(wp[0], wp[64]); w0.y = cvtpk(wp[128], wp[192]); w0.z = cvtpk(wp[256], wp[320]); w0.w = cvtpk(wp[384], wp[448]);
        u32x4 w1; w1.x = cvtpk(wp[32], wp[96]); w1.y = cvtpk(wp[160], wp[224]); w1.z = cvtpk(wp[288], wp[352]); w1.w = cvtpk(wp[416], wp[480]);
        out0 = MFMA32(__builtin_bit_cast(bf16x8, w0), bfr, out0);
        out1 = MFMA32(__builtin_bit_cast(bf16x8, w1), bfr, out1);
    }
    bf16_t* op = CONCAT + ((size_t)b * S + t) * D + AW + BW + g * 64;
    const float* ps = pool_scale + g * 64;
#pragma unroll
    for (int gq = 0; gq < 4; ++gq) {
        const int e0 = 8 * gq + 4 * hi;
        const f32x4 s0 = *(const f32x4*)(ps + e0), s1 = *(const f32x4*)(ps + 32 + e0);
        *(u32x2*)(op + e0) = pack4((f32x4){out0[4 * gq] * s0[0], out0[4 * gq + 1] * s0[1], out0[4 * gq + 2] * s0[2], out0[4 * gq + 3] * s0[3]});
        *(u32x2*)(op + 32 + e0) = pack4((f32x4){out1[4 * gq] * s1[0], out1[4 * gq + 1] * s1[1], out1[4 * gq + 2] * s1[2], out1[4 * gq + 3] * s1[3]});
    }
}

constexpr int SCAN_SLOT = 12288, SCAN_RING = 12;
constexpr int SCAN_FLAGS = SCAN_RING * SCAN_SLOT;
DI void scan_issue(const Frame& F, const int sc, const int ihalf, const int dir, const int step, const int lane) {
    const int c = dir ? NCH - 1 - step : step; const size_t unit = (size_t)sc * NCH + c;
    const int il = lane & 31, hi = lane >> 5;
    LAS unsigned char* slot = F.lds + (step % SCAN_RING) * SCAN_SLOT;
    const bf16_t* MP = (const bf16_t*)(F.ws + WS_MP) + USK(unit) * 4096; const bf16_t* NBp = (const bf16_t*)(F.ws + WS_NB) + (USK(unit) * 2 + ihalf) * 2048;
#pragma unroll
    for (int p = 0; p < 8; ++p) { const int jpb = p >> 2, jb = (p >> 1) & 1, s = p & 1;
        __builtin_amdgcn_global_load_lds((const unsigned*)(MP + (32 * jpb + il) * 64 + 32 * jb + 16 * s + 8 * hi), (LAS unsigned*)(slot + p * 1024), 16, 0, 0); }
#pragma unroll
    for (int p = 0; p < 4; ++p)
        __builtin_amdgcn_global_load_lds((const unsigned*)(NBp + p * 512 + lane * 8), (LAS unsigned*)(slot + 8192 + p * 1024), 16, 0, 0);
}
DI unsigned lds_ld_u32(const volatile LAS unsigned* p) { return __builtin_amdgcn_readfirstlane(*p); }
#ifndef NLD
#define NLD 2
#endif
constexpr int SC_INFL = NLD == 2 ? 5 : (NLD == 3 ? 4 : 3);
DI void scan_loader(const Frame& F, const int sw, const int ld) {
    const int ihalf = sw & 1, sc = sw >> 1, dir = sc / (NB * BH);
    volatile LAS unsigned* ready = (volatile LAS unsigned*)(F.lds + SCAN_FLAGS); volatile LAS unsigned* cons = ready + 16;
    const int nmine = (NCH - ld + NLD - 1) / NLD;
    constexpr int LAG = SC_INFL - 1;
    for (int k = 0; k < nmine + LAG; ++k) {
        if (k < nmine) {
            const int s = NLD * k + ld;
            if (s >= SCAN_RING) { unsigned spins = 0; while ((int)lds_ld_u32(cons) < s - SCAN_RING + 1) { __builtin_amdgcn_s_sleep(1); if (++spins > (1u << 22)) break; } }
            asm volatile("" ::: "memory");
            scan_issue(F, sc, ihalf, dir, s, F.lane);
        }
        if (k >= LAG) {
            const int kd = k - LAG;
            if (kd < nmine) {
                const int rem = nmine - 1 - kd;
                const int out = rem < LAG ? rem : LAG;
                if (out == 4) asm volatile("s_waitcnt vmcnt(48)" ::: "memory");
                else if (out == 3) asm volatile("s_waitcnt vmcnt(36)" ::: "memory");
                else if (out == 2) asm volatile("s_waitcnt vmcnt(24)" ::: "memory");
                else if (out == 1) asm volatile("s_waitcnt vmcnt(12)" ::: "memory");
                else asm volatile("s_waitcnt vmcnt(0)" ::: "memory");
                const int sd = NLD * kd + ld;
                if (F.lane == 0) ready[sd % SCAN_RING] = (unsigned)(sd + 1);
                asm volatile("s_waitcnt lgkmcnt(0)" ::: "memory");
            }
        }
    }
}
constexpr int S0_STAGE = SCAN_FLAGS + 256;
DI void scan_writer(const Frame& F, const int sw) {
    const int ihalf = sw & 1, sc = sw >> 1, dir = sc / (NB * BH);
    volatile LAS unsigned* ready = (volatile LAS unsigned*)(F.lds + SCAN_FLAGS);
    volatile LAS unsigned* s0rdy = ready + 17; volatile LAS unsigned* s0done = ready + 18;
    bf16_t* S0 = (bf16_t*)(F.ws + WS_S0);
    const int lane = F.lane;
#pragma unroll 1
    for (int step = 0; step < NCH; ++step) {
        const int c = dir ? NCH - 1 - step : step; const size_t unit = (size_t)sc * NCH + c;
        { unsigned spins = 0; while ((int)lds_ld_u32(s0rdy) < step + 1) { __builtin_amdgcn_s_sleep(1); if (++spins > (1u << 22)) break; } }
        asm volatile("" ::: "memory");
        const LAS unsigned char* sl = F.lds + S0_STAGE + (step & 1) * (32 * 144);
        u32x4 v[4];
#pragma unroll
        for (int p = 0; p < 4; ++p) { const int idx = p * 64 + lane; v[p] = *(const LAS u32x4*)(sl + (idx >> 3) * 144 + (idx & 7) * 16); }
        asm volatile("s_waitcnt lgkmcnt(0)" ::: "memory");
        if (lane == 0) *s0done = (unsigned)(step + 1);
        bf16_t* dst = S0 + USK(unit) * 4096 + ihalf * 2048;
#pragma unroll
        for (int p = 0; p < 4; ++p) *(u32x4*)(dst + (p * 64 + lane) * 8) = v[p];
    }
}
DI void scan_wave(const Frame& F, const int sw) {
    const int ihalf = sw & 1, sc = sw >> 1, dir = sc / (NB * BH);
    const int lane = F.lane, il = lane & 31, hi = lane >> 5;
    bf16_t* S0 = (bf16_t*)(F.ws + WS_S0);
    volatile LAS unsigned* ready = (volatile LAS unsigned*)(F.lds + SCAN_FLAGS); volatile LAS unsigned* cons = ready + 16;
    volatile LAS unsigned* s0rdy = ready + 17; volatile LAS unsigned* s0done = ready + 18; (void)s0rdy; (void)s0done;
    f32x16 st0, st1;
#pragma unroll
    for (int i = 0; i < 16; ++i) { st0[i] = 0.f; st1[i] = 0.f; }
    bf16x8 ma[8], man[8]; u32x4 nbv[4], nbn[4];
    { unsigned spins = 0; while (lds_ld_u32(ready) != 1u) { __builtin_amdgcn_s_sleep(1); if (++spins > (1u << 22)) break; } }
    asm volatile("" ::: "memory");
#pragma unroll
    for (int p = 0; p < 8; ++p) ma[p] = *(const LAS bf16x8*)(F.lds + p * 1024 + lane * 16);
#pragma unroll
    for (int p = 0; p < 4; ++p) nbv[p] = *(const LAS u32x4*)(F.lds + 8192 + p * 1024 + lane * 16);
#pragma unroll 1
    for (int step = 0; step < NCH; ++step) {
        const int c = dir ? NCH - 1 - step : step; const size_t unit = (size_t)sc * NCH + c;
        const bool more = step + 1 < NCH;
#ifdef S0_WRITER
        if (step >= 2) { unsigned spins = 0; while ((int)lds_ld_u32(s0done) < step - 1) { __builtin_amdgcn_s_sleep(1); if (++spins > (1u << 22)) break; } }
        asm volatile("" ::: "memory");
#endif
        if (more) {
            { unsigned spins = 0; while (lds_ld_u32(ready + ((step + 1) % SCAN_RING)) != (unsigned)(step + 2)) { __builtin_amdgcn_s_sleep(1); if (++spins > (1u << 22)) break; } }
            asm volatile("" ::: "memory");

            const LAS unsigned char* slot = F.lds + ((step + 1) % SCAN_RING) * SCAN_SLOT;
#pragma unroll
            for (int p = 0; p < 8; ++p) man[p] = *(const LAS bf16x8*)(slot + p * 1024 + lane * 16);
#pragma unroll
            for (int p = 0; p < 4; ++p) nbn[p] = *(const LAS u32x4*)(slot + 8192 + p * 1024 + lane * 16);
        }
        bf16_t* sp = S0 + USK(unit) * 4096 + (size_t)(32 * ihalf + il) * 64;
        u32x4 b00, b01, b10, b11;
        b00.x = cvtpk(st0[0], st0[1]); b00.y = cvtpk(st0[2], st0[3]); b00.z = cvtpk(st0[4], st0[5]); b00.w = cvtpk(st0[6], st0[7]);
        b01.x = cvtpk(st0[8], st0[9]); b01.y = cvtpk(st0[10], st0[11]); b01.z = cvtpk(st0[12], st0[13]); b01.w = cvtpk(st0[14], st0[15]);
        b10.x = cvtpk(st1[0], st1[1]); b10.y = cvtpk(st1[2], st1[3]); b10.z = cvtpk(st1[4], st1[5]); b10.w = cvtpk(st1[6], st1[7]);
        b11.x = cvtpk(st1[8], st1[9]); b11.y = cvtpk(st1[10], st1[11]); b11.z = cvtpk(st1[12], st1[13]); b11.w = cvtpk(st1[14], st1[15]);
#ifdef S0_WRITER
        { LAS unsigned char* sl = F.lds + S0_STAGE + (step & 1) * (32 * 144) + il * 144 + 8 * hi;
          {
          *(LAS u32x2*)(sl + 0) = (u32x2){b00.x, b00.y};  *(LAS u32x2*)(sl + 16) = (u32x2){b00.z, b00.w};
          *(LAS u32x2*)(sl + 32) = (u32x2){b01.x, b01.y}; *(LAS u32x2*)(sl + 48) = (u32x2){b01.z, b01.w};
          *(LAS u32x2*)(sl + 64) = (u32x2){b10.x, b10.y}; *(LAS u32x2*)(sl + 80) = (u32x2){b10.z, b10.w};
          *(LAS u32x2*)(sl + 96) = (u32x2){b11.x, b11.y}; *(LAS u32x2*)(sl + 112) = (u32x2){b11.z, b11.w}; }
          asm volatile("" ::: "memory");
          if (lane == 0) *s0rdy = (unsigned)(step + 1); }
        (void)sp;
#else
        *(u32x2*)(sp + 0 + 4 * hi) = (u32x2){b00.x, b00.y};  *(u32x2*)(sp + 8 + 4 * hi) = (u32x2){b00.z, b00.w};
        *(u32x2*)(sp + 16 + 4 * hi) = (u32x2){b01.x, b01.y}; *(u32x2*)(sp + 24 + 4 * hi) = (u32x2){b01.z, b01.w};
        *(u32x2*)(sp + 32 + 4 * hi) = (u32x2){b10.x, b10.y}; *(u32x2*)(sp + 40 + 4 * hi) = (u32x2){b10.z, b10.w};
        *(u32x2*)(sp + 48 + 4 * hi) = (u32x2){b11.x, b11.y}; *(u32x2*)(sp + 56 + 4 * hi) = (u32x2){b11.z, b11.w};
#endif
        const bf16x8 p00 = __builtin_bit_cast(bf16x8, b00), p01 = __builtin_bit_cast(bf16x8, b01), p10 = __builtin_bit_cast(bf16x8, b10), p11 = __builtin_bit_cast(bf16x8, b11);
        f32x16 n0, n1;
#pragma unroll
        for (int h2 = 0; h2 < 2; ++h2) {
            n0[8 * h2 + 0] = bflo(nbv[h2].x); n0[8 * h2 + 1] = bfhi(nbv[h2].x); n0[8 * h2 + 2] = bflo(nbv[h2].y); n0[8 * h2 + 3] = bfhi(nbv[h2].y);
            n0[8 * h2 + 4] = bflo(nbv[h2].z); n0[8 * h2 + 5] = bfhi(nbv[h2].z); n0[8 * h2 + 6] = bflo(nbv[h2].w); n0[8 * h2 + 7] = bfhi(nbv[h2].w);
            n1[8 * h2 + 0] = bflo(nbv[2 + h2].x); n1[8 * h2 + 1] = bfhi(nbv[2 + h2].x); n1[8 * h2 + 2] = bflo(nbv[2 + h2].y); n1[8 * h2 + 3] = bfhi(nbv[2 + h2].y);
            n1[8 * h2 + 4] = bflo(nbv[2 + h2].z); n1[8 * h2 + 5] = bfhi(nbv[2 + h2].z); n1[8 * h2 + 6] = bflo(nbv[2 + h2].w); n1[8 * h2 + 7] = bfhi(nbv[2 + h2].w);
        }
        n0 = MFMA32(ma[0], p00, n0); n1 = MFMA32(ma[4], p00, n1);
        n0 = MFMA32(ma[1], p01, n0); n1 = MFMA32(ma[5], p01, n1);
        n0 = MFMA32(ma[2], p10, n0); n1 = MFMA32(ma[6], p10, n1);
        n0 = MFMA32(ma[3], p11, n0); n1 = MFMA32(ma[7], p11, n1);
        st0 = n0; st1 = n1;
        if (more) {
            asm volatile("s_waitcnt lgkmcnt(0)" ::: "memory");
            if (lane == 0) *cons = (unsigned)(step + 2);
#pragma unroll
            for (int p = 0; p < 8; ++p) ma[p] = man[p];
#pragma unroll
            for (int p = 0; p < 4; ++p) nbv[p] = nbn[p];
        }
    }
}

DI void rwkv_out_unit(const Frame& F, const RwP& P, const int du) {
    const int qd = du & 3, cidx = du >> 2, c = cidx % NCH, hd = (cidx / NCH) % BH, b = cidx / (NCH * BH);
    const int lane = F.lane, n = lane & 15, g = lane >> 4, u = 16 * qd + n;
    const bf16_t* QT = (const bf16_t*)(F.ws + WS_QT); const bf16_t* WT = (const bf16_t*)(F.ws + WS_WT); const bf16_t* S0 = (const bf16_t*)(F.ws + WS_S0);
    const bf16_t* VTB = (const bf16_t*)(F.ws + WS_VTB) + (size_t)cidx * 4096;
    f32x4 acc[4];
#pragma unroll
    for (int tm = 0; tm < 4; ++tm) acc[tm] = (f32x4){0.f, 0.f, 0.f, 0.f};
#pragma unroll
    for (int dir = 0; dir < 2; ++dir) {
        const size_t unit = (((size_t)dir * NB + b) * BH + hd) * NCH + c;
#pragma unroll
        for (int ks = 0; ks < 2; ++ks) {
            const bf16x8 bq = *(const bf16x8*)(QT + unit * 4096 + u * 64 + 32 * ks + 8 * g);
            const bf16x8 bw = *(const bf16x8*)(WT + unit * 4096 + u * 64 + 32 * ks + 8 * g);
#pragma unroll
            for (int tm = 0; tm < 4; ++tm) {
                const bf16x8 as = *(const bf16x8*)(S0 + USK(unit) * 4096 + (16 * tm + n) * 64 + 32 * ks + 8 * g);
                const bf16x8 av = *(const bf16x8*)(VTB + (16 * tm + n) * 64 + 32 * ks + 8 * g);
                acc[tm] = MFMA16(as, bq, acc[tm]); acc[tm] = MFMA16(av, bw, acc[tm]);
            }
        }
    }
    float s = 0.f;
#pragma unroll
    for (int tm = 0; tm < 4; ++tm) s += (acc[tm][0] + acc[tm][1]) + (acc[tm][2] + acc[tm][3]);
    s += __shfl_xor(s, 16); s += __shfl_xor(s, 32);
    const float mu = s * (1.f / HD); float q = 0.f;
#pragma unroll
    for (int tm = 0; tm < 4; ++tm) { acc[tm] = acc[tm] - mu; q += (acc[tm][0] * acc[tm][0] + acc[tm][1] * acc[tm][1]) + (acc[tm][2] * acc[tm][2] + acc[tm][3] * acc[tm][3]); }
    q += __shfl_xor(q, 16); q += __shfl_xor(q, 32);
    const float rstd = 1.f / sqrtf(q * (1.f / HD) + GN_EPS);
    const size_t tok = (size_t)b * S + 64 * c + u;
    const float* BS = (const float*)(F.ws + WS_BS);
    const float bsum = BS[tok * 8 + hd] + BS[((size_t)T + tok) * 8 + hd];
    const bf16_t* VC = (const bf16_t*)(F.ws + WS_VC) + tok * BW + hd * HD; const bf16_t* GBp = (const bf16_t*)(F.ws + WS_GB) + tok * BW + hd * HD;
    bf16_t* op = (bf16_t*)(F.ws + WS_CONCAT) + tok * D + AW + hd * HD;
#pragma unroll
    for (int tm = 0; tm < 4; ++tm) {
        const int i0 = 16 * tm + 4 * g;
        const f32x4 vv = unpack4(*(const u32x2*)(VC + i0)), gg = unpack4(*(const u32x2*)(GBp + i0));
        const f32x4 gn = *(const f32x4*)(P.gn_gain + hd * HD + i0), gb = *(const f32x4*)(P.gn_bias + hd * HD + i0);
        *(u32x2*)(op + i0) = pack4((acc[tm] * rstd * gn + gb + vv * bsum) * gg);
    }
}

DI RwP make_rwp(const Args& a, int l) {
    RwP p;
    p.conv = a.in[6] + (size_t)l * 3 * 3 * BW; p.w0 = a.in[7] + (size_t)l * 2 * BW; p.w_up = a.in[8] + (size_t)l * 2 * RW * BW;
    p.a0 = a.in[9] + (size_t)l * 2 * BW; p.a_up = a.in[10] + (size_t)l * 2 * RA * BW; p.g_up = a.in[11] + (size_t)l * RG * BW;
    p.k_k = a.in[12] + (size_t)l * BW; p.k_a = a.in[13] + (size_t)l * BW; p.r_k = a.in[14] + (size_t)l * BH * HD;
    p.gn_gain = a.in[15] + (size_t)l * BW; p.gn_bias = a.in[16] + (size_t)l * BW;
    return p;
}
DI void conv_moe(const Frame& F, const Args& a, int l, int first, int stride, const int IT_END = IT_MOE) {
    LAS float* scr = (LAS float*)F.lds + F.wave * (64 * 65);
#ifdef CONV3
    f32x4 b0[16], b1[16], b2[16]; TItem t0{}, t1{}, t2{};
    int it = first;
    if (it < IT_MOE) { t0 = moe_item(F, a.in[28], a.in[29], a.in[30], l, it); titem_load(t0, b0, F.lane); }
    if (it + stride < IT_MOE) { t1 = moe_item(F, a.in[28], a.in[29], a.in[30], l, it + stride); titem_load(t1, b1, F.lane); }
    for (; it < IT_MOE; it += 3 * stride) {
        if (it + 2 * stride < IT_MOE) { t2 = moe_item(F, a.in[28], a.in[29], a.in[30], l, it + 2 * stride); titem_load(t2, b2, F.lane); }
        titem_store(t0, b0, scr, F.lane);
        if (it + stride >= IT_MOE) break;
        if (it + 3 * stride < IT_MOE) { t0 = moe_item(F, a.in[28], a.in[29], a.in[30], l, it + 3 * stride); titem_load(t0, b0, F.lane); }
        titem_store(t1, b1, scr, F.lane);
        if (it + 2 * stride >= IT_MOE) break;
        if (it + 4 * stride < IT_MOE) { t1 = moe_item(F, a.in[28], a.in[29], a.in[30], l, it + 4 * stride); titem_load(t1, b1, F.lane); }
        titem_store(t2, b2, scr, F.lane);
    }
#else
    f32x4 cur[16], nxt[16]; int it = first; TItem tc{}, tn{};
    if (it < IT_END) { tc = moe_item(F, a.in[28], a.in[29], a.in[30], l, it); titem_load(tc, cur, F.lane); }
    CONV_PREWAIT();
    for (; it < IT_END; it += stride) {
        const bool more = it + stride < IT_END;
        if (more) { tn = moe_item(F, a.in[28], a.in[29], a.in[30], l, it + stride); titem_load(tn, nxt, F.lane); }
        titem_store(tc, cur, scr, F.lane);
        if (more) { tc = tn;
#pragma unroll
            for (int i = 0; i < 16; ++i) cur[i] = nxt[i]; }
    }
#endif
}
#ifndef NG1
#define NG1 21
#endif
#ifndef N1
#define N1 3360
#endif
DI void p_gemm1(const Frame& F, const Args& a, int l) {
#ifdef CONV_G1
    if (F.G == 256) {
        if (F.bx >= 256 - NG1) { conv_moe(F, a, l, (F.bx - (256 - NG1)) * NWAVES + F.wave, NG1 * NWAVES, N1); return; }
        pg8::Gemm1Order S; S.U = (const bf16_t*)(F.ws + WS_U); S.Win = (const bf16_t*)(F.ws + WS_WIN + (size_t)l * WIN_LAYER); S.Wv = S.Win + (size_t)HW * D; S.G = 256 - NG1; S.c = F.bx;
        #ifdef KV_TILED
        pg8::EpiGemm1 E{(bf16_t*)(F.ws + WS_HB), HW, (bf16_t*)(F.ws + WS_KT), (bf16_t*)(F.ws + WS_VT)};
#else
        pg8::EpiStore E{(bf16_t*)(F.ws + WS_HB), HW, (bf16_t*)(F.ws + WS_VT), T};
#endif
        pg8::gemm_phase(F.lds, F.tid, D, S, E);
        return;
    }
#endif
    pg8::Gemm1Order S; S.U = (const bf16_t*)(F.ws + WS_U); S.Win = (const bf16_t*)(F.ws + WS_WIN + (size_t)l * WIN_LAYER); S.Wv = S.Win + (size_t)HW * D; S.G = F.G; S.c = F.bx;
    #ifdef KV_TILED
        pg8::EpiGemm1 E{(bf16_t*)(F.ws + WS_HB), HW, (bf16_t*)(F.ws + WS_KT), (bf16_t*)(F.ws + WS_VT)};
#else
        pg8::EpiStore E{(bf16_t*)(F.ws + WS_HB), HW, (bf16_t*)(F.ws + WS_VT), T};
#endif
    pg8::gemm_phase(F.lds, F.tid, D, S, E);
}
#ifndef NCB
#define NCB 16
#endif
DI void p_mixer_local(const Frame& F, const Args& a, int l) {
#ifdef CONV_IN_B
    const int GR = F.G - NCB;
    if (F.bx >= GR) { conv_moe(F, a, l, (F.bx - GR) * NWAVES + F.wave, NCB * NWAVES); return; }
    { const float* conv = a.in[6] + (size_t)l * 3 * 3 * BW;
#pragma unroll 7
      for (int i = F.tid; i < BH * 9 * 64; i += NTHREADS) { const int j = i & 63, q = i >> 6, which = q % 3, x = (q / 3) % 3, hd = q / 9;
          *(LAS bf16_t*)(F.lds + CWLOFF + i * 2) = f2bf(conv[x * 3 * BW + which * BW + hd * HD + j]); }
      RwPre PF;
      if (F.bx < NUNIT) rwkv_prefetch(F, a, l, F.bx, PF);
      __syncthreads();
      for (int unit = F.bx; unit < NUNIT; unit += GR) rwkv_local_unit(F, a, l, unit, PF, unit + GR < NUNIT ? unit + GR : -1);
      return;
    }
#endif
    {
      const float* conv = a.in[6] + (size_t)l * 3 * 3 * BW;
#pragma unroll 7
      for (int i = F.tid; i < BH * 9 * 64; i += NTHREADS) { const int j = i & 63, q = i >> 6, which = q % 3, x = (q / 3) % 3, hd = q / 9;
          *(LAS bf16_t*)(F.lds + CWLOFF + i * 2) = f2bf(conv[x * 3 * BW + which * BW + hd * HD + j]); }
      RwPre PF;
      if (F.bx < NUNIT) rwkv_prefetch(F, a, l, F.bx, PF);
      __syncthreads();
      for (int unit = F.bx; unit < NUNIT; unit += F.G) rwkv_local_unit(F, a, l, unit, PF, unit + F.G < NUNIT ? unit + F.G : -1);
    }
}
DI void p_scan(const Frame& F, const Args& a, int l, const int rr = 0) {
#ifndef CVW
#define CVW 3
#endif
    constexpr int NSCAN = 2 * 2 * NB * BH;
    const int NATTW = (F.G - NSCAN) * (NWAVES - CVW);
    if (F.bx < NSCAN) {
        if (rr & 4) return;
        volatile LAS unsigned* fl = (volatile LAS unsigned*)(F.lds + SCAN_FLAGS);
        if (F.tid < 32) fl[F.tid] = 0u;
        __syncthreads();
#ifdef S0_WRITER
        if (F.wave == 0) scan_wave(F, F.bx); else if (F.wave <= NLD) scan_loader(F, F.bx, F.wave - 1); else if (F.wave == NLD + 1) scan_writer(F, F.bx);
#else
        if (F.wave == 0) scan_wave(F, F.bx); else if (F.wave <= NLD) scan_loader(F, F.bx, F.wave - 1);
#endif
#ifdef DBL_SCAN
        __syncthreads();
        if (F.tid < 32) fl[F.tid] = 0u;
        __syncthreads();
        if (F.wave == 0) scan_wave(F, F.bx); else if (F.wave <= NLD) scan_loader(F, F.bx, F.wave - 1);
#endif
        return;
    }
#ifdef SERIAL_C
    {
        LAS float* rpbl8 = (LAS float*)(F.lds + NWAVES * 64 * 65 * 4);
        { const float* rpb = a.in[5] + (size_t)l * AH * (2 * KH - 1) * (2 * KW - 1);
#pragma unroll 6
          for (int i = F.tid; i < AH * (2 * KH - 1) * (2 * KW - 1); i += NTHREADS) rpbl8[i] = rpb[i] * LOG2E; }
        __syncthreads();
        const int aw8 = (F.bx - NSCAN) * NWAVES + F.wave, naw8 = (F.G - NSCAN) * NWAVES;
        if (F.G == 256) {
            constexpr int UPX = NB * ROWS * AH / 8;
            const int x = F.bx & 7, k = (F.bx - NSCAN) >> 3, j = k * NWAVES + F.wave;
            if (j < UPX) { const int v = (x & 3) * UPX + j; attn_unit(F, rpbl8, (((x >> 2) * ROWS) + (v & (ROWS - 1))) * AH + (v >> 7)); }
        } else
            for (int au = aw8; au < NB * ROWS * AH; au += naw8) attn_unit(F, rpbl8, au);
        for (int pu = aw8; pu < NB * (S / 32) * 4; pu += naw8) pool_unit(F, a.in[17] + (size_t)l * NG * 64 * 64, a.in[18] + (size_t)l * CW, pu);
#ifdef CONV_IN_B
        return;
#endif
        LAS float* scr = (LAS float*)F.lds + F.wave * (64 * 65);
        f32x4 cur[16], nxt[16]; const int st = naw8; int it = aw8; TItem tc{}, tn{};
#ifdef DBL_CONV
        for (int rep = 0; rep < 2; ++rep) { it = aw8;
#endif
        if (it < IT_MOE) { tc = moe_item(F, a.in[28], a.in[29], a.in[30], l, it); titem_load(tc, cur, F.lane); }
        for (; it < IT_MOE; it += st) {
            const bool more = it + st < IT_MOE;
            if (more) { tn = moe_item(F, a.in[28], a.in[29], a.in[30], l, it + st); titem_load(tn, nxt, F.lane); }
            titem_store(tc, cur, scr, F.lane);
            if (more) { tc = tn;
#pragma unroll
                for (int i = 0; i < 16; ++i) cur[i] = nxt[i]; }
        }
#ifdef DBL_CONV
        }
#endif
        return;
    }
#endif
    LAS float* rpbl = (LAS float*)(F.lds + CVW * 64 * 65 * 4);
    { const float* rpb = a.in[5] + (size_t)l * AH * (2 * KH - 1) * (2 * KW - 1);
#pragma unroll 6
      for (int i = F.tid; i < AH * (2 * KH - 1) * (2 * KW - 1); i += NTHREADS) rpbl[i] = rpb[i] * LOG2E; }
    __syncthreads();
    if (F.wave < CVW) {
        if (rr & 1) return;
        LAS float* scr = (LAS float*)F.lds + F.wave * (64 * 65);
#ifdef CONV_G1
        const int it0 = F.G == 256 ? N1 : 0;
#else
        const int it0 = 0;
#endif
        f32x4 cur[16], nxt[16]; const int st = (F.G - NSCAN) * CVW; int it = it0 + (F.bx - NSCAN) * CVW + F.wave; TItem tc{}, tn{};
#ifndef CONV_PAIR
        if (it < IT_MOE) { tc = moe_item(F, a.in[28], a.in[29], a.in[30], l, it); titem_load(tc, cur, F.lane); }
        CONV_PREWAIT();
#endif
#ifdef DBL_CONV
        for (int rep = 0; rep < 2; ++rep) { it = (F.bx - NSCAN) * CVW + F.wave; if (it < IT_MOE) { tc = moe_item(F, a.in[28], a.in[29], a.in[30], l, it); titem_load(tc, cur, F.lane); }
#endif
#ifdef CONV_PAIR
        for (int pr = it; pr < IT_MOE / 2; pr += st) {
            tc = moe_item(F, a.in[28], a.in[29], a.in[30], l, 2 * pr); tn = moe_item(F, a.in[28], a.in[29], a.in[30], l, 2 * pr + 1);
#pragma unroll
            for (int i = 0; i < 16; ++i) { cur[i] = *(const f32x4*)(tc.src + (size_t)(4 * i + (F.lane >> 4)) * tc.ldw + 4 * (F.lane & 15)); nxt[i] = *(const f32x4*)(tn.src + (size_t)(4 * i + (F.lane >> 4)) * tn.ldw + 4 * (F.lane & 15)); }
            titem_store(tc, cur, scr, F.lane); titem_store(tn, nxt, scr, F.lane);
        }
        it = IT_MOE;
#endif
        for (; it < IT_MOE; it += st) {
            const bool more = it + st < IT_MOE;
#ifdef CONV_SINGLE
            titem_store(tc, cur, scr, F.lane);
            if (more) { tc = moe_item(F, a.in[28], a.in[29], a.in[30], l, it + st); titem_load(tc, cur, F.lane); }
            continue;
#endif
            if (more) { tn = moe_item(F, a.in[28], a.in[29], a.in[30], l, it + st); titem_load(tn, nxt, F.lane); }
            titem_store(tc, cur, scr, F.lane);
            if (more) { tc = tn;
#pragma unroll
                for (int i = 0; i < 16; ++i) cur[i] = nxt[i]; }
        }
#ifdef DBL_CONV
        }
#endif
    } else {
        if (rr & 2) return;
        const int aw = (F.bx - NSCAN) * (NWAVES - CVW) + (F.wave - CVW), naw = NATTW;
#ifdef ATT_XCD
        if (F.G == 256) {
            constexpr int NW5 = NWAVES - CVW, NBX = (256 - NSCAN) / 8, NWX = NBX * NW5, UPX = NB * ROWS * AH / 8, REM = UPX - NWX, PER = (REM + NBX - 1) / NBX;
            const int x = F.bx & 7, k = (F.bx - NSCAN) >> 3, w5 = F.wave - CVW;
            { const int v = (x & 3) * UPX + k * NW5 + w5; attn_unit(F, rpbl, (((x >> 2) * ROWS) + (v & (ROWS - 1))) * AH + (v >> 7)); }
            if (w5 < PER && k * PER + w5 < REM) { const int v = (x & 3) * UPX + NWX + k * PER + w5; attn_unit(F, rpbl, (((x >> 2) * ROWS) + (v & (ROWS - 1))) * AH + (v >> 7)); }
        } else
#endif
        for (int au = aw; au < NB * ROWS * AH; au += naw) attn_unit(F, rpbl, au);
#ifdef DBL_ATTN
        for (int au = aw; au < NB * ROWS * AH; au += naw) attn_unit(F, rpbl, au);
#endif
        for (int pu = aw; pu < NB * (S / 32) * 4; pu += naw) pool_unit(F, a.in[17] + (size_t)l * NG * 64 * 64, a.in[18] + (size_t)l * CW, pu);
    }
}
DI void p_rwkv_out(const Frame& F, const Args& a, int l) {
    const RwP P = make_rwp(a, l);
    for (int du = F.gw; du < NB * BH * NCH * 4; du += F.ngw) rwkv_out_unit(F, P, du);
}
DI void p_gemm2(const Frame& F, int l) {
    pg8::PlainOrder S; S.init((const bf16_t*)(F.ws + WS_CONCAT), (const bf16_t*)(F.ws + WS_WOUT) + (size_t)l * D * D, T, D, D, F.G, F.bx);
    pg8::EpiStore E{(bf16_t*)(F.ws + WS_MIX), D, nullptr, 0};
    pg8::gemm_phase(F.lds, F.tid, D, S, E);
}
DI void p_gemm2k(const Frame& F, int Kx) {
    pg8::PlainOrder S; S.init((const bf16_t*)(F.ws + WS_CONCAT), (const bf16_t*)(F.ws + WS_WOUT), T, D, Kx, F.G, F.bx);
    pg8::EpiStore E{(bf16_t*)(F.ws + WS_MIX), D, nullptr, 0};
    pg8::gemm_phase(F.lds, F.tid, Kx, S, E);
}
DI void p_moe_a(const Frame& F, int l) {
    LAS int* tb = (LAS int*)(F.lds + LDS_MISC);
    build_tables(F, l, tb);
    pg8::GroupedOrderT<true> S; S.rowtok = (const int*)(F.ws + WS_CTL + WS_SLOTTOK); S.A = (const bf16_t*)(F.ws + WS_U); S.Bt = (const bf16_t*)(F.ws + WS_WGU); S.K = D; S.estride = (size_t)D * D; S.tile_e = tb + 66; S.ntiles = tb[65]; S.nwg = S.ntiles * 4; S.G = F.G; S.c = F.bx;
#ifdef FUSE_MOE
    S.flags = (unsigned*)(F.ws + WS_CTL) + CW_MFL + l * 256;
#endif
    pg8::EpiSwiGlu E{(bf16_t*)(F.ws + WS_HM)};
    pg8::gemm_phase(F.lds, F.tid, D, S, E);
}
DI void p_moe_b(const Frame& F, int l) {
    LAS int* tb = (LAS int*)(F.lds + LDS_MISC);
    build_tables(F, l, tb);
#ifdef FUSE_MOE
    pg8::GroupedOrderB S; S.flags = (unsigned*)(F.ws + WS_CTL) + CW_MFL + l * 256;
#else
    pg8::GroupedOrderT<false> S;
#endif
    S.rowtok = nullptr; S.A = (const bf16_t*)(F.ws + WS_HM); S.Bt = (const bf16_t*)(F.ws + WS_WD); S.K = DE; S.estride = (size_t)D * DE; S.tile_e = tb + 66; S.ntiles = tb[65]; S.nwg = S.ntiles * 4; S.G = F.G; S.c = F.bx;
    pg8::EpiRowScale E{(bf16_t*)(F.ws + WS_YS), (const float*)(F.ws + WS_SLOTW)};
    pg8::gemm_phase(F.lds, F.tid, DE, S, E);
}

#ifndef DBLMASK
#define DBLMASK 0
#endif
constexpr int PH_PER_LAYER = 10, N_PHASES = 2 + L * PH_PER_LAYER;
DI bool in_ph(int k, int lo, int hi) { lo = __builtin_amdgcn_readfirstlane(lo); hi = __builtin_amdgcn_readfirstlane(hi); asm volatile("" : "+s"(lo), "+s"(hi)); return lo <= k && k < hi; }
DI Frame fresh(const Frame& F0) {
    Frame F = F0; int t = F0.tid, b = F0.bx;
    b = __builtin_amdgcn_readfirstlane(b); asm volatile("" : "+v"(t)); asm volatile("" : "+s"(b));
    F.tid = t; F.lane = t & 63; F.wave = __builtin_amdgcn_readfirstlane(t >> 6); F.bx = b;
    F.vcu = (F.G % 8 == 0) ? (b % 8) * (F.G / 8) + b / 8 : b; F.gw = F.vcu * NWAVES + F.wave;
    return F;
}

__global__ void __launch_bounds__(NTHREADS, 2) mk_fwd(Args a) {
    extern __shared__ __attribute__((aligned(16))) unsigned char lds_raw[];
    Frame F;
    F.lds = (LAS unsigned char*)lds_raw;
    F.tid = threadIdx.x; F.lane = F.tid & 63; F.wave = __builtin_amdgcn_readfirstlane(F.tid >> 6);
    F.G = gridDim.x; F.bx = blockIdx.x; { const int bx = blockIdx.x; F.vcu = (F.G % 8 == 0) ? (bx % 8) * (F.G / 8) + bx / 8 : bx; }
    F.gw = F.vcu * NWAVES + F.wave; F.ngw = F.G * NWAVES; F.ws = a.ws;
    volatile LAS unsigned* bst = (volatile LAS unsigned*)(F.lds + LDS_BARST);
    if (F.tid < 16) bst[F.tid] = 0u;
    __syncthreads();
    cg::grid_group grid = cg::this_grid();
    XcdBarrier bar; bar.bar = (unsigned*)(a.ws + WS_CTL) + CW_BAR; bar.x = 0; bar.st = bst;
    const bool multi = (a.ph_hi - a.ph_lo) > 1;
    if (multi && !a.use_cg) bar = xcd_barrier_post((unsigned*)(a.ws + WS_CTL) + CW_BAR, bst);
    const int lo = a.ph_lo, hi = a.ph_hi;
#ifdef TSTAMP
#define STAMP(k) do { if (blockIdx.x == 0 && threadIdx.x == 0) ((unsigned long long*)(a.ws + WS_CTL + 40960))[k] = wall_clock64(); } while (0)
#else
#define STAMP(k) do { } while (0)
#endif
    STAMP(0);
#define IN(k) in_ph((k), lo, hi)
#ifndef DBLSEAM
#define DBLSEAM 0
#endif
#define SEAM(k) do { if (IN(k) && IN((k) + 1)) { if (a.use_cg) grid.sync(); else { xcd_barrier(bar); if (DBLSEAM) xcd_barrier(bar); } } STAMP((k) + 1); } while (0)
    if (IN(0)) { p0_prologue(fresh(F), a); if ((DBLMASK >> 11) & 1) p0_prologue(fresh(F), a); }
    SEAM(0);
    if (IN(1)) { p_r0(fresh(F), a.in[0]); if ((DBLMASK >> 12) & 1) p_r0(fresh(F), a.in[0]); }
    SEAM(1);
#ifdef FUSE_MOE
#define SEAM_MOE(k) do { } while (0)
#else
#define SEAM_MOE(k) SEAM(k)
#endif
#define RUN(k, call) do { if (IN(pb + (k))) { call; if ((DBLMASK >> (k)) & 1) { call; } } } while (0)
#define LAYER(l) do { \
        const int pb = 2 + PH_PER_LAYER * (l); \
        RUN(0, p_gemm1(fresh(F), a, (l))); \
        SEAM(pb + 0); \
        RUN(1, p_mixer_local(fresh(F), a, (l))); \
        SEAM(pb + 1); \
        RUN(2, p_scan(fresh(F), a, (l))); \
        SEAM(pb + 2); \
        RUN(3, p_rwkv_out(fresh(F), a, (l))); \
        SEAM(pb + 3); \
        RUN(4, p_gemm2(fresh(F), (l))); \
        SEAM(pb + 4); \
        RUN(5, p_rowpass1(fresh(F), a, (l), (l) == 0 ? a.in[0] : a.out)); \
        if (IN(pb + 5) && ((DBLMASK >> 10) & 1)) p_rowpass1(fresh(F), a, (l), (l) == 0 ? a.in[0] : a.out, true); \
        SEAM(pb + 5); \
        RUN(6, p_gather(fresh(F), (l))); \
        SEAM(pb + 6); \
        RUN(7, p_moe_a(fresh(F), (l))); \
        SEAM_MOE(pb + 7); \
        RUN(8, p_moe_b(fresh(F), (l))); \
        SEAM(pb + 8); \
        RUN(9, p_rowpass2(fresh(F), a, (l), a.out)); \
        SEAM(pb + 9); \
    } while (0)
    LAYER(0);
    LAYER(1);
#ifdef END_RERUN
#define RERUN(k, call) do { if ((END_RERUN >> (k)) & 1) { xcd_barrier(bar); call; } } while (0)
    if (multi && !a.use_cg) {
        RERUN(0, p_gemm1(fresh(F), a, 1));
        RERUN(1, p_mixer_local(fresh(F), a, 1));
        RERUN(2, p_scan(fresh(F), a, 1));
        RERUN(15, p_scan(fresh(F), a, 1, RRV));
        RERUN(3, p_rwkv_out(fresh(F), a, 1));
        RERUN(4, p_gemm2(fresh(F), 1));
        RERUN(7, p_moe_a(fresh(F), 1); p_moe_b(fresh(F), 1));
        RERUN(12, p_gemm2k(fresh(F), 512));
        RERUN(13, p_gemm2k(fresh(F), 256));
        RERUN(5, p_moe_a(fresh(F), 1));
        RERUN(6, p_moe_b(fresh(F), 1));
        RERUN(10, p_rowpass1(fresh(F), a, 1, a.out, true));
        RERUN(11, p_gather(fresh(F), 1));
        RERUN(14, p_rowpass1(fresh(F), a, 1, a.out, false));
        RERUN(9, p_rowpass2(fresh(F), a, 1, a.out));
    }
#endif
#undef LAYER
#undef IN
#undef SEAM
}

#ifndef MK_MODE
#define MK_MODE 0
#endif
#ifndef TESTMODE
#define TESTMODE 0
#endif

static void fill_args(Args& a, void* const* d_in, void* d_out, void* d_ws) {
    for (int i = 0; i < 31; ++i) a.in[i] = (const float*)d_in[i];
    a.out = (float*)d_out; a.ws = (unsigned char*)d_ws; a.ph_lo = 0; a.ph_hi = N_PHASES; a.use_cg = 0; a.pad = 0;
}
static void launch_phases(Args a, int lo, int hi, hipStream_t stream) {
    for (int p = lo; p < hi; ++p) { a.ph_lo = p; a.ph_hi = p + 1; hipLaunchKernelGGL(mk_fwd, dim3(256), dim3(NTHREADS), LDS_BYTES, stream, a); }
}

#if TESTMODE == 0
extern "C" void kernel_launch(void* const* d_in, const int* in_sizes, int n_in, void* d_out, int out_size, void* d_ws, size_t ws_size, hipStream_t stream) {
    static int grid = 0;
    if (grid == 0) {
        int dev = 0, cus = 0, per_cu = 0;
        (void)hipGetDevice(&dev); (void)hipDeviceGetAttribute(&cus, hipDeviceAttributeMultiprocessorCount, dev);
        (void)hipFuncSetAttribute((const void*)mk_fwd, hipFuncAttributeMaxDynamicSharedMemorySize, LDS_BYTES);
        (void)hipOccupancyMaxActiveBlocksPerMultiprocessor(&per_cu, (const void*)mk_fwd, NTHREADS, LDS_BYTES);
        (void)hipGetLastError();
        grid = (cus > 0 ? cus : 256) * 1;
        if (ws_size < WS_END || n_in != 31) grid = -1;
    }
    if (grid < 0) return;
    (void)hipMemsetAsync((char*)d_ws + WS_CTL, 0, CTL_BYTES, stream);
    Args a{}; fill_args(a, d_in, d_out, d_ws);
#if MK_MODE == 2
    launch_phases(a, 0, N_PHASES, stream);
#else
    a.use_cg = (MK_MODE == 1) ? 1 : 0;
    void* args[] = {&a};
    (void)hipLaunchCooperativeKernel((const void*)mk_fwd, dim3(grid), dim3(NTHREADS), args, LDS_BYTES, stream);
#endif
}
#endif

#if TESTMODE > 0
constexpr int O_A = 1152, O_B = 2304, O_W = 2336, O_AL = 2368, O_G = 2432;
struct HSrc { const bf16_t* HB; const bf16_t* VT;
    DI float at(size_t tok, int n) const { if (n < 768) return bf2f(HB[tok * HW + n]); if (n < 1152) return bf2f(VT[(size_t)(n - 768) * T + tok]); return bf2f(HB[tok * HW + n - 384]); } };
DI float sigm_n(float x) { return 1.f / (1.f + expf(-x)); }

__global__ void k_mod_n(const float* __restrict__ c, const float* __restrict__ w_mod, const float* __restrict__ b_mod, float* __restrict__ mod) {
    __shared__ float sc[NB * D];
    for (int i = threadIdx.x; i < NB * D; i += blockDim.x) { float v = c[i]; sc[i] = v * sigm_n(v); }
    __syncthreads();
    int idx = blockIdx.x * blockDim.x + threadIdx.x; int l = idx / MODW, n = idx % MODW;
    const float* w = w_mod + (size_t)l * D * MODW + n; float a0 = 0.f, a1 = 0.f;
    for (int k = 0; k < D; ++k) { float wv = w[(size_t)k * MODW]; a0 += sc[k] * wv; a1 += sc[D + k] * wv; }
    float bb = b_mod[l * MODW + n];
    mod[(size_t)(l * NB + 0) * MODW + n] = a0 + bb; mod[(size_t)(l * NB + 1) * MODW + n] = a1 + bb;
}
__global__ void k_ln_mod_n(const float* __restrict__ xin, const float* __restrict__ modl, int off_sh, int off_sc, float* __restrict__ uout) {
    int row = (blockIdx.x * blockDim.x + threadIdx.x) >> 6, lane = threadIdx.x & 63; if (row >= T) return; int b = row / S;
    f32x4 v[4];
#pragma unroll
    for (int j = 0; j < 4; ++j) v[j] = *(const f32x4*)(xin + (size_t)row * D + 4 * lane + 256 * j);
    float mean, rstd; row_ln(v, mean, rstd);
    const float* md = modl + (size_t)b * MODW;
#pragma unroll
    for (int j = 0; j < 4; ++j) { int col = 4 * lane + 256 * j; *(f32x4*)(uout + (size_t)row * D + col) = v[j] * rstd * (1.f + *(const f32x4*)(md + off_sc + col)) + *(const f32x4*)(md + off_sh + col); }
}
__global__ void k_post_n(const float* xin, const float* br, const float* __restrict__ modl, int off_gate, const float* __restrict__ gain, const float* __restrict__ bias, float* xout, float* u2out, int off_sh2, int off_sc2) {
    int row = (blockIdx.x * blockDim.x + threadIdx.x) >> 6, lane = threadIdx.x & 63; if (row >= T) return; int b = row / S;
    const float* md = modl + (size_t)b * MODW; f32x4 v[4];
#pragma unroll
    for (int j = 0; j < 4; ++j) { int col = 4 * lane + 256 * j; v[j] = *(const f32x4*)(xin + (size_t)row * D + col) * ALPHA + *(const f32x4*)(md + off_gate + col) * *(const f32x4*)(br + (size_t)row * D + col); }
    float mean, rstd; row_ln(v, mean, rstd);
#pragma unroll
    for (int j = 0; j < 4; ++j) { int col = 4 * lane + 256 * j; v[j] = v[j] * rstd * *(const f32x4*)(gain + col) + *(const f32x4*)(bias + col); *(f32x4*)(xout + (size_t)row * D + col) = v[j]; }
    if (u2out == nullptr) return;
    row_ln(v, mean, rstd);
#pragma unroll
    for (int j = 0; j < 4; ++j) { int col = 4 * lane + 256 * j; *(f32x4*)(u2out + (size_t)row * D + col) = v[j] * rstd * (1.f + *(const f32x4*)(md + off_sc2 + col)) + *(const f32x4*)(md + off_sh2 + col); }
}
__global__ void __launch_bounds__(256) k_gemm_f32(const float* __restrict__ A, int lda, const float* __restrict__ B, int ldb, float* __restrict__ C, int ldc, int K) {
    __shared__ float As[16][65]; __shared__ float Bs[16][64];
    const int tx = threadIdx.x & 15, ty = threadIdx.x >> 4; const int m0 = blockIdx.y * 64, n0 = blockIdx.x * 64;
    float acc[4][4];
#pragma unroll
    for (int i = 0; i < 4; ++i)
#pragma unroll
        for (int j = 0; j < 4; ++j) acc[i][j] = 0.f;
    for (int k0 = 0; k0 < K; k0 += 16) {
#pragma unroll
        for (int i = 0; i < 4; ++i) { int e = threadIdx.x + 256 * i; int m = e >> 4, k = e & 15; As[k][m] = A[(size_t)(m0 + m) * lda + k0 + k]; }
#pragma unroll
        for (int i = 0; i < 4; ++i) { int e = threadIdx.x + 256 * i; int k = e >> 6, n = e & 63; Bs[k][n] = B[(size_t)(k0 + k) * ldb + n0 + n]; }
        __syncthreads();
#pragma unroll
        for (int k = 0; k < 16; ++k) { float a[4], b[4];
#pragma unroll
            for (int i = 0; i < 4; ++i) { a[i] = As[k][ty * 4 + i]; b[i] = Bs[k][tx * 4 + i]; }
#pragma unroll
            for (int i = 0; i < 4; ++i)
#pragma unroll
                for (int j = 0; j < 4; ++j) acc[i][j] += a[i] * b[j]; }
        __syncthreads();
    }
#pragma unroll
    for (int i = 0; i < 4; ++i) *(float4*)(C + (size_t)(m0 + ty * 4 + i) * ldc + n0 + tx * 4) = make_float4(acc[i][0], acc[i][1], acc[i][2], acc[i][3]);
}
__global__ void __launch_bounds__(64) k_attn_n(HSrc h, const float* __restrict__ rpb, float* __restrict__ concat) {
    int idx = blockIdx.x * blockDim.x + threadIdx.x; if (idx >= T * AH) return;
    int head = idx % AH, tok = idx / AH; int b = tok / S, t = tok % S, r = t / GW, cq = t % GW;
    int rstart = r - KH / 2; rstart = rstart < 0 ? 0 : (rstart > ROWS - KH ? ROWS - KH : rstart);
    int cstart = cq - KW / 2; cstart = cstart < 0 ? 0 : (cstart > GW - KW ? GW - KW : cstart);
    float q[HD], acc[HD];
#pragma unroll
    for (int d = 0; d < HD; ++d) { q[d] = h.at(tok, head * HD + d); acc[d] = 0.f; }
    float m = -1e30f, l = 0.f; const float* rp = rpb + (size_t)head * 15 * 31;
    for (int kk = 0; kk < KH; ++kk) { int kr = rstart + kk; int dr = kr - r + (KH - 1);
        for (int j = 0; j < KW; ++j) { int ck = cstart + j; int dc = ck - cq; dc = dc < -15 ? -15 : (dc > 15 ? 15 : dc); dc += 15;
            size_t kt = (size_t)b * S + kr * GW + ck; float s = 0.f;
#pragma unroll
            for (int d = 0; d < HD; ++d) s += q[d] * h.at(kt, AW + head * HD + d);
            s = s * 0.125f + rp[dr * 31 + dc];
            float mn = fmaxf(m, s); float corr = expf(m - mn); float p = expf(s - mn); l = l * corr + p;
#pragma unroll
            for (int d = 0; d < HD; ++d) acc[d] = acc[d] * corr + p * h.at(kt, 2 * AW + head * HD + d);
            m = mn; } }
    float inv = 1.f / l;
#pragma unroll
    for (int d = 0; d < HD; ++d) concat[(size_t)tok * D + head * HD + d] = acc[d] * inv;
}
__global__ void __launch_bounds__(256) k_pool_n(HSrc h, const float* __restrict__ pool_w, const float* __restrict__ pool_scale, float* __restrict__ concat) {
    __shared__ float pooled[CW];
    int tok = blockIdx.x; int b = tok / S, t = tok % S; int ch = threadIdx.x; int g = ch / 64; int win = 2 << g;
    int lo = t - win / 2; lo = lo < 0 ? 0 : lo; int hi = t + win / 2 - 1; hi = hi > S - 1 ? S - 1 : hi;
    float s = 0.f; for (int u = lo; u <= hi; ++u) s += h.at((size_t)b * S + u, O_G + ch);
    pooled[ch] = s / (float)(hi - lo + 1) - h.at(tok, O_G + ch);
    __syncthreads();
    int e = ch % 64; const float* pw = pool_w + (size_t)g * 64 * 64 + e; float a = 0.f;
    for (int c2 = 0; c2 < 64; ++c2) a += pooled[g * 64 + c2] * pw[c2 * 64];
    concat[(size_t)tok * D + AW + BW + ch] = a * pool_scale[ch];
}
__global__ void __launch_bounds__(64) k_rwkv_scan_n(HSrc h, RwP p, float* __restrict__ ys) {
    const int lane = threadIdx.x; const int dir = blockIdx.x / (NB * BH), b = (blockIdx.x / BH) % NB, hd = blockIdx.x % BH; const int ch = hd * HD + lane;
    float st[HD];
#pragma unroll
    for (int j = 0; j < HD; ++j) st[j] = 0.f;
    float wup[RW], aup[RA];
#pragma unroll
    for (int m = 0; m < RW; ++m) { wup[m] = p.w_up[(size_t)(dir * RW + m) * BW + ch]; aup[m] = p.a_up[(size_t)(dir * RA + m) * BW + ch]; }
    const float w0 = p.w0[dir * BW + ch], a0 = p.a0[dir * BW + ch], kkw = p.k_k[ch], kaw = p.k_a[ch];
    float cr[3], ck[3], cv[3];
#pragma unroll
    for (int x = 0; x < 3; ++x) { cr[x] = p.conv[x * 3 * BW + ch]; ck[x] = p.conv[x * 3 * BW + BW + ch]; cv[x] = p.conv[x * 3 * BW + 2 * BW + ch]; }
    for (int step = 0; step < S; ++step) {
        const int t = dir ? (S - 1 - step) : step; const size_t row = (size_t)b * S + t;
        float r = 0.f, k = 0.f, v = 0.f;
#pragma unroll
        for (int x = 0; x < 3; ++x) { int tt = t + x - 1; if (tt >= 0 && tt < S) { size_t rr = (size_t)b * S + tt; r += h.at(rr, O_A + ch) * cr[x]; k += h.at(rr, O_A + BW + ch) * ck[x]; v += h.at(rr, O_A + 2 * BW + ch) * cv[x]; } }
        float lv = h.at(row, O_B + lane); float lt = lane < RW ? tanhf(lv) : lv; float zw = w0, za = a0;
#pragma unroll
        for (int m = 0; m < RW; ++m) { zw += __shfl(lt, m) * wup[m]; za += __shfl(lt, RW + m) * aup[m]; }
        const float w = expf(-DECAY * sigm_n(zw)); const float a = sigm_n(za);
        float kk = k * kkw; float ss = wave_sum(kk * kk); kk = kk * (1.f / sqrtf(fmaxf(ss, 1e-24f)));
        const float kd = k * (1.f + (a - 1.f) * kaw); const float kka = kk * a;
        float sa = 0.f;
#pragma unroll
        for (int j = 0; j < HD; ++j) sa += st[j] * (-__shfl(kk, j));
        float y = 0.f;
#pragma unroll
        for (int j = 0; j < HD; ++j) { st[j] = st[j] * __shfl(w, j) + sa * __shfl(kka, j) + v * __shfl(kd, j); y += st[j] * __shfl(r, j); }
        ys[((size_t)dir * T + b * S + t) * BW + ch] = y;
    }
}
__global__ void __launch_bounds__(384) k_rwkv_finish_n(HSrc h, RwP p, const float* __restrict__ ys, float* __restrict__ concat) {
    __shared__ float lw[RW], la[RA], sg[RG];
    const int tok = blockIdx.x, b = tok / S, t = tok % S, ch = threadIdx.x, hd = ch / HD, j = ch % HD;
    if (ch < RW) lw[ch] = tanhf(h.at(tok, O_B + ch)); else if (ch < RW + RA) la[ch - RW] = h.at(tok, O_W + (ch - RW)); else if (ch < RW + RA + RG) sg[ch - RW - RA] = sigm_n(h.at(tok, O_AL + (ch - RW - RA)));
    __syncthreads();
    float r = 0.f, k = 0.f, v = 0.f;
#pragma unroll
    for (int x = 0; x < 3; ++x) { int tt = t + x - 1; if (tt >= 0 && tt < S) { size_t rr = (size_t)b * S + tt;
        r += h.at(rr, O_A + ch) * p.conv[x * 3 * BW + ch]; k += h.at(rr, O_A + BW + ch) * p.conv[x * 3 * BW + BW + ch]; v += h.at(rr, O_A + 2 * BW + ch) * p.conv[x * 3 * BW + 2 * BW + ch]; } }
    float bon = 0.f;
    for (int dir = 0; dir < 2; ++dir) { float za = p.a0[dir * BW + ch]; for (int m = 0; m < RA; ++m) za += la[m] * p.a_up[(size_t)(dir * RA + m) * BW + ch];
        float a = sigm_n(za); float kd = k * (1.f + (a - 1.f) * p.k_a[ch]); bon += wave_sum(r * kd * p.r_k[hd * HD + j]); }
    bon *= v;
    float y = ys[(size_t)tok * BW + ch] + ys[((size_t)T + tok) * BW + ch];
    float mu = wave_sum(y) * (1.f / HD); float dy = y - mu; float var = wave_sum(dy * dy) * (1.f / HD);
    float yn = dy * (1.f / sqrtf(var + GN_EPS)) * p.gn_gain[ch] + p.gn_bias[ch];
    float g = 0.f; for (int m = 0; m < RG; ++m) g += sg[m] * p.g_up[(size_t)m * BW + ch];
    concat[(size_t)tok * D + AW + ch] = (yn + bon) * g;
}
__global__ void __launch_bounds__(256) k_moe_n(const float* __restrict__ u2, const int* __restrict__ tokslot, const float* __restrict__ ew,
                                                const float* __restrict__ wgate, const float* __restrict__ wup, const float* __restrict__ wdown, float* __restrict__ f) {
    __shared__ float xs[D]; __shared__ float hb[DE];
    const int tok = blockIdx.x, tid = threadIdx.x;
    for (int i = tid; i < D; i += 256) xs[i] = u2[(size_t)tok * D + i];
    float o[4] = {0.f, 0.f, 0.f, 0.f};
    for (int kk = 0; kk < 2; ++kk) {
        const int ts = tokslot[tok * 2 + kk]; const int e = ts >> 14; const float wt = ew[ts];
        __syncthreads();
        const float* g = wgate + (size_t)e * D * DE; const float* u = wup + (size_t)e * D * DE;
        float ag0 = 0.f, ag1 = 0.f, au0 = 0.f, au1 = 0.f;
        for (int k = 0; k < D; ++k) { float x = xs[k]; ag0 += x * g[(size_t)k * DE + tid]; ag1 += x * g[(size_t)k * DE + 256 + tid]; au0 += x * u[(size_t)k * DE + tid]; au1 += x * u[(size_t)k * DE + 256 + tid]; }
        hb[tid] = ag0 * sigm_n(ag0) * au0; hb[256 + tid] = ag1 * sigm_n(ag1) * au1;
        __syncthreads();
        const float* dn = wdown + (size_t)e * DE * D; float a[4] = {0.f, 0.f, 0.f, 0.f};
        for (int k = 0; k < DE; ++k) { float x = hb[k];
#pragma unroll
            for (int j = 0; j < 4; ++j) a[j] += x * dn[(size_t)k * D + tid + 256 * j]; }
#pragma unroll
        for (int j = 0; j < 4; ++j) o[j] += a[j] * wt;
    }
#pragma unroll
    for (int j = 0; j < 4; ++j) f[(size_t)tok * D + tid + 256 * j] = o[j];
}

__global__ void k_router_n(const float* __restrict__ u2, const float* __restrict__ wg, const float* __restrict__ bg, const float* __restrict__ we, const float* __restrict__ be, int* __restrict__ tok_e) {
    int row = (blockIdx.x * blockDim.x + threadIdx.x) >> 6, lane = threadIdx.x & 63; if (row >= T) return;
    float gl[NG], el[NE];
#pragma unroll
    for (int n = 0; n < NG; ++n) gl[n] = 0.f;
#pragma unroll
    for (int n = 0; n < NE; ++n) el[n] = 0.f;
    for (int i = 0; i < 16; ++i) { int k = lane + 64 * i; float x = u2[(size_t)row * D + k];
#pragma unroll
        for (int n = 0; n < NG; ++n) gl[n] += x * wg[k * NG + n];
#pragma unroll
        for (int n = 0; n < NE; ++n) el[n] += x * we[k * NE + n]; }
#pragma unroll
    for (int n = 0; n < NG; ++n) gl[n] = wave_sum(gl[n]) + bg[n];
#pragma unroll
    for (int n = 0; n < NE; ++n) el[n] = wave_sum(el[n]) + be[n];
    int gi = 0; float gm = gl[0];
#pragma unroll
    for (int n = 1; n < NG; ++n) if (gl[n] > gm) { gm = gl[n]; gi = n; }
    float l1 = -3.0e38f, l2 = -3.0e38f; int i1 = 0, i2 = 0;
#pragma unroll
    for (int n = 0; n < NE; ++n) if ((n >> 3) == gi) { float v = el[n]; int e = n & 7; if (v > l1) { l2 = l1; i2 = i1; l1 = v; i1 = e; } else if (v > l2) { l2 = v; i2 = e; } }
    if (lane == 0) { tok_e[row * 2] = gi * EPG + i1; tok_e[row * 2 + 1] = gi * EPG + i2; }
}
__global__ void k_cmp_route(const int* __restrict__ tokslot, const int* __restrict__ tok_e, float* acc, int slot) {
    float mis = 0.f, tot = 0.f;
    for (int t = blockIdx.x * blockDim.x + threadIdx.x; t < T; t += gridDim.x * blockDim.x) { const int a0 = tokslot[2 * t] >> 14, a1 = tokslot[2 * t + 1] >> 14;
        mis += (a0 != tok_e[2 * t] || a1 != tok_e[2 * t + 1]) ? 1.f : 0.f; tot += 1.f; }
    mis = wave_sum(mis); tot = wave_sum(tot);
    if ((threadIdx.x & 63) == 0) { atomicAdd(acc + 2 * slot, mis); atomicAdd(acc + 2 * slot + 1, tot); }
}
__global__ void k_bf2f(const bf16_t* __restrict__ src, float* __restrict__ dst, size_t n) { for (size_t i = (size_t)blockIdx.x * blockDim.x + threadIdx.x; i < n; i += (size_t)gridDim.x * blockDim.x) dst[i] = bf2f(src[i]); }
template <class TA> __global__ void k_cmp(const TA* __restrict__ a, size_t lda, const float* __restrict__ b, size_t ldb, int rows, int cols, float* acc, int slot) {
    float d2 = 0.f, r2 = 0.f;
    for (size_t i = (size_t)blockIdx.x * blockDim.x + threadIdx.x; i < (size_t)rows * cols; i += (size_t)gridDim.x * blockDim.x) {
        const size_t r = i / cols, c = i % cols; float av; if constexpr (sizeof(TA) == 2) av = bf2f(a[r * lda + c]); else av = a[r * lda + c];
        const float bv = b[r * ldb + c]; d2 += (av - bv) * (av - bv); r2 += bv * bv; }
    d2 = wave_sum(d2); r2 = wave_sum(r2);
    if ((threadIdx.x & 63) == 0) { atomicAdd(acc + 2 * slot, d2); atomicAdd(acc + 2 * slot + 1, r2); }
}
__global__ void k_cmp_vt(const bf16_t* __restrict__ vt, const float* __restrict__ b, size_t ldb, float* acc, int slot) {
    float d2 = 0.f, r2 = 0.f;
    for (size_t i = (size_t)blockIdx.x * blockDim.x + threadIdx.x; i < (size_t)T * AW; i += (size_t)gridDim.x * blockDim.x) {
        const size_t r = i % T, c = i / T; const float av = bf2f(vt[c * T + r]), bv = b[r * ldb + c]; d2 += (av - bv) * (av - bv); r2 += bv * bv; }
    d2 = wave_sum(d2); r2 = wave_sum(r2);
    if ((threadIdx.x & 63) == 0) { atomicAdd(acc + 2 * slot, d2); atomicAdd(acc + 2 * slot + 1, r2); }
}
struct Tols { float t[8]; int n; };
__global__ void k_readout(float* out, const float* acc, Tols tl, int total) {
    float mx = 0.f; int am = 0; for (int k = 0; k < tl.n; ++k) { float e = sqrtf(acc[2 * k] / fmaxf(acc[2 * k + 1], 1e-30f)); if (!(e == e)) e = 1e3f; if (e / tl.t[k] > mx) { mx = e / tl.t[k]; am = k; } }
    const float cval = sqrtf(1000.f * mx);
    for (int i = blockIdx.x * blockDim.x + threadIdx.x; i < total; i += gridDim.x * blockDim.x) out[i] = (i < 8) ? 1000.f * (float)(am + 1) : cval;
}
__global__ void __launch_bounds__(256) k_moe_chk(const float* __restrict__ u2, const int* __restrict__ tokslot, const float* __restrict__ ew, const unsigned* __restrict__ cnt,
                                                  const float* __restrict__ wgate, const float* __restrict__ wup, const float* __restrict__ wdown,
                                                  const bf16_t* __restrict__ XS, const bf16_t* __restrict__ HM, const bf16_t* __restrict__ YS, float* acc) {
    __shared__ float xs[D]; __shared__ float hb[DE]; __shared__ int offp[NE];
    const int tok = blockIdx.x, tid = threadIdx.x;
    if (tid == 0) { int off = 0; for (int e = 0; e < NE; ++e) { offp[e] = off; off += (((int)cnt[e] + 255) >> 8) * 256; } }
    for (int i = tid; i < D; i += 256) xs[i] = u2[(size_t)tok * D + i];
    float d0 = 0.f, r0 = 0.f, d1 = 0.f, r1 = 0.f, d2 = 0.f, r2 = 0.f;
    for (int kk = 0; kk < 2; ++kk) {
        __syncthreads();
        const int ts = tokslot[tok * 2 + kk]; const int e = ts >> 14; const float wt = ew[ts]; const size_t slot = (size_t)offp[e] + (ts & 16383);
        for (int i = tid; i < D; i += 256) { const float a = bf2f(XS[slot * D + i]), b = xs[i]; d0 += (a - b) * (a - b); r0 += b * b; }
        const float* g = wgate + (size_t)e * D * DE; const float* u = wup + (size_t)e * D * DE;
        float ag0 = 0.f, ag1 = 0.f, au0 = 0.f, au1 = 0.f;
        for (int k = 0; k < D; ++k) { float x = xs[k]; ag0 += x * g[(size_t)k * DE + tid]; ag1 += x * g[(size_t)k * DE + 256 + tid]; au0 += x * u[(size_t)k * DE + tid]; au1 += x * u[(size_t)k * DE + 256 + tid]; }
        const float h0 = ag0 * sigm_n(ag0) * au0, h1 = ag1 * sigm_n(ag1) * au1;
        hb[tid] = h0; hb[256 + tid] = h1;
        { const float a = bf2f(HM[slot * DE + tid]), b = bf2f(HM[slot * DE + 256 + tid]); d1 += (a - h0) * (a - h0) + (b - h1) * (b - h1); r1 += h0 * h0 + h1 * h1; }
        __syncthreads();
        const float* dn = wdown + (size_t)e * DE * D; float a4[4] = {0.f, 0.f, 0.f, 0.f};
        for (int k = 0; k < DE; ++k) { float x = hb[k];
#pragma unroll
            for (int j = 0; j < 4; ++j) a4[j] += x * dn[(size_t)k * D + tid + 256 * j]; }
#pragma unroll
        for (int j = 0; j < 4; ++j) {
#ifdef MOEB_NOSCALE
            const float y = a4[j];
#else
            const float y = a4[j] * wt;
#endif
            const float a = bf2f(YS[slot * D + tid + 256 * j]); d2 += (a - y) * (a - y); r2 += y * y; }
    }
    d0 = wave_sum(d0); r0 = wave_sum(r0); d1 = wave_sum(d1); r1 = wave_sum(r1); d2 = wave_sum(d2); r2 = wave_sum(r2);
    if ((tid & 63) == 0) { atomicAdd(acc + 0, d0); atomicAdd(acc + 1, r0); atomicAdd(acc + 2, d1); atomicAdd(acc + 3, r1); atomicAdd(acc + 4, d2); atomicAdd(acc + 5, r2); }
}

extern "C" void kernel_launch(void* const* d_in, const int* in_sizes, int n_in, void* d_out, int out_size, void* d_ws, size_t ws_size, hipStream_t stream) {
    static int once = 0; if (!once) { (void)hipFuncSetAttribute((const void*)mk_fwd, hipFuncAttributeMaxDynamicSharedMemorySize, LDS_BYTES); once = 1; }
    (void)hipMemsetAsync((char*)d_ws + WS_CTL, 0, CTL_BYTES, stream);
    Args a{}; fill_args(a, d_in, d_out, d_ws);
    char* ws = (char*)d_ws; float* out = (float*)d_out;
    float* ACC = (float*)(ws + 32768 + 1024);
    const float* x = a.in[0];
    HSrc hs{(const bf16_t*)(ws + WS_HB), (const bf16_t*)(ws + WS_VT)};
    const int l = 0;
    RwP p = { a.in[6], a.in[7], a.in[8], a.in[9], a.in[10], a.in[11], a.in[12], a.in[13], a.in[14], a.in[15], a.in[16] };
    Tols tl{};
#if TESTMODE == 1
    launch_phases(a, 0, 3, stream);
    float* MODn = (float*)(ws + WS_MOD + 512 * 1024); float* Un = (float*)(ws + WS_XA); float* HF = (float*)(ws + WS_CONCAT);
    k_mod_n<<<L * MODW / 256, 256, 0, stream>>>(a.in[1], a.in[2], a.in[3], MODn);
    k_ln_mod_n<<<T / 4, 256, 0, stream>>>(x, MODn, 0, D, Un);
    k_gemm_f32<<<dim3(INW / 64, T / 64), 256, 0, stream>>>(Un, D, a.in[4], INW, HF, INW, D);
    k_cmp<float><<<256, 256, 0, stream>>>((const float*)(ws + WS_MOD), MODW, MODn, MODW, L * NB, MODW, ACC, 0);
    k_cmp<bf16_t><<<1024, 256, 0, stream>>>((const bf16_t*)(ws + WS_U), D, Un, D, T, D, ACC, 1);
    k_cmp<bf16_t><<<1024, 256, 0, stream>>>((const bf16_t*)(ws + WS_HB), HW, HF, INW, T, 768, ACC, 2);
    k_cmp<bf16_t><<<1024, 256, 0, stream>>>((const bf16_t*)(ws + WS_HB) + 768, HW, HF + 1152, INW, T, 1536, ACC, 3);
    k_cmp_vt<<<1024, 256, 0, stream>>>((const bf16_t*)(ws + WS_VT), HF + 768, INW, ACC, 4);
    tl.n = 5; tl.t[0] = 1e-5f; tl.t[1] = 4e-3f; tl.t[2] = 6e-3f; tl.t[3] = 6e-3f; tl.t[4] = 6e-3f;
#elif TESTMODE == 2
    launch_phases(a, 0, 4, stream);
    float* CCn = (float*)(ws + WS_XA); float* YSn = (float*)(ws + WS_WGU);
    k_attn_n<<<T * AH / 64, 64, 0, stream>>>(hs, a.in[5], CCn);
    k_pool_n<<<T, 256, 0, stream>>>(hs, a.in[17], a.in[18], CCn);
    k_rwkv_scan_n<<<2 * NB * BH, 64, 0, stream>>>(hs, p, YSn);
    k_rwkv_finish_n<<<T, 384, 0, stream>>>(hs, p, YSn, CCn);
    launch_phases(a, 4, 6, stream);
    k_cmp<bf16_t><<<1024, 256, 0, stream>>>((const bf16_t*)(ws + WS_CONCAT), D, CCn, D, T, AW, ACC, 0);
    k_cmp<bf16_t><<<1024, 256, 0, stream>>>((const bf16_t*)(ws + WS_CONCAT) + AW, D, CCn + AW, D, T, BW, ACC, 1);
    k_cmp<bf16_t><<<1024, 256, 0, stream>>>((const bf16_t*)(ws + WS_CONCAT) + AW + BW, D, CCn + AW + BW, D, T, CW, ACC, 2);
    tl.n = 3; tl.t[0] = TOL0; tl.t[1] = TOL1; tl.t[2] = TOL2;
#elif TESTMODE == 3
    launch_phases(a, 0, 11, stream);
    { const float* MODf = (const float*)(ws + WS_MOD);
      float* U2f = (float*)(ws + 414 * MiB); float* Fn = (float*)(ws + 213 * MiB); float* X2n = (float*)(ws + 277 * MiB);
      k_bf2f<<<2048, 256, 0, stream>>>((const bf16_t*)(ws + WS_U), U2f, (size_t)T * D);
      launch_phases(a, 11, 12, stream);
      k_moe_n<<<T, 256, 0, stream>>>(U2f, (const int*)(ws + WS_TOKSLOT), (const float*)(ws + WS_EW), a.in[28], a.in[29], a.in[30], Fn);
      k_post_n<<<T / 4, 256, 0, stream>>>((const float*)(ws + WS_XA), Fn, MODf, 5 * D, a.in[22], a.in[23], X2n, nullptr, 0, 0);
      k_cmp<float><<<1024, 256, 0, stream>>>(out, D, X2n, D, T, D, ACC, 0); }
    tl.n = 1; tl.t[0] = TOL0;
#elif TESTMODE == 4
    launch_phases(a, 0, 8, stream);
    { const float* MODf = (const float*)(ws + WS_MOD);
      float* CCn = (float*)(ws + 405 * MiB); float* MIXn = (float*)(ws + 213 * MiB); float* X1n = (float*)(ws + 21 * MiB); float* U2n = (float*)(ws + 333 * MiB); int* TEn = (int*)(ws + 490 * MiB);
      k_bf2f<<<2048, 256, 0, stream>>>((const bf16_t*)(ws + WS_CONCAT), CCn, (size_t)T * D);
      k_gemm_f32<<<dim3(D / 64, T / 64), 256, 0, stream>>>(CCn, D, a.in[19], D, MIXn, D, D);
      k_post_n<<<T / 4, 256, 0, stream>>>(x, MIXn, MODf, 2 * D, a.in[20], a.in[21], X1n, U2n, 3 * D, 4 * D);
      k_router_n<<<T / 4, 256, 0, stream>>>(U2n, a.in[24], a.in[25], a.in[26], a.in[27], TEn);
      k_cmp<float><<<1024, 256, 0, stream>>>((const float*)(ws + WS_XA), D, X1n, D, T, D, ACC, 0);
      k_cmp<bf16_t><<<1024, 256, 0, stream>>>((const bf16_t*)(ws + WS_U), D, U2n, D, T, D, ACC, 1);
      k_cmp_route<<<64, 256, 0, stream>>>((const int*)(ws + WS_TOKSLOT), TEn, ACC, 2); }
    tl.n = 3; tl.t[0] = TOL0; tl.t[1] = TOL1; tl.t[2] = TOL2;
#elif TESTMODE == 5
    launch_phases(a, 0, 11, stream);
    { float* U2f = (float*)(ws + 414 * MiB);
      k_bf2f<<<2048, 256, 0, stream>>>((const bf16_t*)(ws + WS_U), U2f, (size_t)T * D);
      k_moe_chk<<<T, 256, 0, stream>>>(U2f, (const int*)(ws + WS_TOKSLOT), (const float*)(ws + WS_EW), (const unsigned*)(ws + WS_CTL) + CW_CNT, a.in[28], a.in[29], a.in[30],
                                       (const bf16_t*)(ws + WS_XS), (const bf16_t*)(ws + WS_HM), (const bf16_t*)(ws + WS_YS), ACC); }
    tl.n = 3; tl.t[0] = 1e-6f; tl.t[1] = 1e-2f; tl.t[2] = 1e-2f;
#endif
    k_readout<<<256, 256, 0, stream>>>(out, ACC, tl, out_size);
}
#endif
```

```cpp
#define TESTMODE 0
#define MK_MODE 0
#define S0_WRITER 1
#define ATT_XCD 1
#define FUSE_MOE 1
#define MOE_ACQ1 1
#define KV_TILED 1
#define MP_FRAG 1
#define SCAN_U2 1
#define ATT_FAST 1
#include <hip/hip_runtime.h>
#include <hip/hip_cooperative_groups.h>
#include <stdint.h>
namespace cg = cooperative_groups;

#ifndef TESTMODE
#define TESTMODE 0
#endif
#define DI __device__ __forceinline__
#define LAS __attribute__((address_space(3)))
typedef unsigned short bf16_t;
typedef short bf16x8 __attribute__((ext_vector_type(8)));
typedef float f32x4 __attribute__((ext_vector_type(4)));
typedef float f32x16 __attribute__((ext_vector_type(16)));
typedef unsigned u32x4 __attribute__((ext_vector_type(4)));
typedef unsigned u32x2 __attribute__((ext_vector_type(2)));
typedef float f32x2_t __attribute__((ext_vector_type(2)));
typedef __bf16 bf16x2_t __attribute__((ext_vector_type(2)));

namespace cfg {
constexpr int D = 1024, NB = 2, S = 8192, T = NB * S, L = 2;
constexpr int GW = 64, ROWS = 128;
constexpr int HD = 64, AW = 384, BW = 384, CW = 256, AH = 6, BH = 6;
constexpr int KH = 8, KW = 16;
constexpr int RW = 32, RA = 32, RG = 64;
constexpr int INW = 2688;
constexpr int NG = 4, EPG = 8, NE = 32, DE = 512;
constexpr int MODW = 6 * D;
constexpr float ALPHA = 1.41421356237309515f;
constexpr float LN_EPS = 1e-5f, GN_EPS = 64e-5f;
constexpr float DECAY = 0.60653065971263342f;
constexpr float LOG2E = 1.44269504088896341f;
constexpr int HW = 2304, HQ = 0, HK = 384, HR = 768, HWL = 1920, HAL = 1952, HGL = 1984, HP = 2048;
constexpr int NCH = S / 64;
constexpr int NUNIT = 2 * NB * BH * NCH;
constexpr int XSROWS = 2 * T + NE * 256;
}
using namespace cfg;

constexpr size_t MiB = 1u << 20;
constexpr size_t WS_CTL = 0;
constexpr size_t CTL_BYTES = 262144;
constexpr size_t WS_SLOTTOK = 65536;
constexpr int CW_BAR = 0;
constexpr int CW_MFL = 9216;
constexpr int CW_CNT = 8192;
constexpr size_t WS_MOD = 1 * MiB;
constexpr size_t WS_TOKSLOT = 1 * MiB + 128 * 1024;
constexpr size_t WS_SLOTW = 1 * MiB + 256 * 1024;
constexpr size_t WS_BC = 2 * MiB;
constexpr size_t WS_TOKW = 2 * MiB + 64 * 1024;
constexpr size_t WS_TOKFIN = 2 * MiB + 256 * 1024;
constexpr size_t WS_CNTF = 2 * MiB + 512 * 1024;
constexpr size_t WS_WIN = 6 * MiB;
constexpr size_t WIN_LAYER = (size_t)2816 * 1024 * 2;
constexpr size_t WS_WOUT = 17 * MiB;
constexpr size_t WS_WGU = 21 * MiB;
constexpr size_t WS_WD = 85 * MiB;
constexpr size_t WS_XA = 117 * MiB;
constexpr size_t WS_U = 181 * MiB;
constexpr size_t WS_HB = 213 * MiB;
constexpr size_t WS_S0 = 117 * MiB;
constexpr size_t WS_VT = 285 * MiB;
constexpr size_t WS_CONCAT = 301 * MiB;
constexpr size_t WS_MP = 333 * MiB;
constexpr size_t WS_NB = 358 * MiB;
constexpr size_t WS_MIX = 333 * MiB;
constexpr size_t WS_KT = 384 * MiB;
constexpr size_t WS_QT = 405 * MiB;
constexpr size_t WS_WT = 429 * MiB;
constexpr size_t WS_VTB = 453 * MiB;
constexpr size_t WS_GB = 465 * MiB;
constexpr size_t WS_VC = 477 * MiB;
constexpr size_t WS_BS = 489 * MiB;
constexpr size_t WS_XS = 213 * MiB;
constexpr size_t WS_HM = 293 * MiB;
constexpr size_t WS_YS = 333 * MiB;
constexpr size_t WS_END = 490 * MiB;
#ifndef NOSKEW
#define USK(u) ((size_t)(u) + ((size_t)(u) >> 7))
#else
#define USK(u) ((size_t)(u))
#endif

constexpr int NWAVES = 8, NTHREADS = 512;
constexpr int LDS_BYTES = 156 * 1024;

DI unsigned cvtpk(float lo, float hi) { f32x2_t v = {lo, hi}; bf16x2_t b = __builtin_convertvector(v, bf16x2_t); return __builtin_bit_cast(unsigned, b); }
DI float bflo(unsigned w) { return __uint_as_float(w << 16); }
DI float bfhi(unsigned w) { return __uint_as_float(w & 0xffff0000u); }
DI float bf2f(unsigned short h) { return __uint_as_float((unsigned)h << 16); }
DI unsigned short f2bf(float f) { return (unsigned short)(cvtpk(f, 0.f) & 0xffffu); }
DI float wave_sum_shfl(float v) {
#pragma unroll
    for (int o = 32; o > 0; o >>= 1) v += __shfl_xor(v, o);
    return v;
}
template <int CTRL, int ROWMASK> DI float dpp_add(float v) { return v + __builtin_bit_cast(float, __builtin_amdgcn_update_dpp(0, __builtin_bit_cast(int, v), CTRL, ROWMASK, 0xf, false)); }
DI float wave_sum(float v) {
    v = dpp_add<0xb1, 0xf>(v);
    v = dpp_add<0x4e, 0xf>(v);
    v = dpp_add<0x124, 0xf>(v);
    v = dpp_add<0x128, 0xf>(v);
    v = dpp_add<0x142, 0xa>(v);
    v = dpp_add<0x143, 0xc>(v);
    return __builtin_bit_cast(float, __builtin_amdgcn_readlane(__builtin_bit_cast(int, v), 63));
}
DI float fexp2(float x) { return __builtin_amdgcn_exp2f(x); }
DI float frcp(float x) { return __builtin_amdgcn_rcpf(x); }
DI float sigm(float x) { return frcp(1.f + fexp2(x * -LOG2E)); }
#define LDS_WAIT() asm volatile("s_waitcnt lgkmcnt(0)" ::: "memory")
#define VM_WAIT() asm volatile("s_waitcnt vmcnt(0)" ::: "memory")
DI int swap23(int i) { return (i & ~12) | ((i & 4) << 1) | ((i & 8) >> 1); }

namespace pg8 {
constexpr int BM = 256, BK = 64, HALF = 128, HTB = HALF * BK * 2, STAGE_BYTES = 8 * HTB, NXCD = 8, WGM = 8;
__host__ __device__ __forceinline__ int lds_byte(int r, int c) { const int st = (r >> 4) * 2 + (c >> 5), rr = r & 15, cc = c & 31, ob = rr * 64 + cc * 2; return st * 1024 + (ob ^ (((ob >> 9) & 1) << 5)); }
__host__ __device__ __forceinline__ void stage_rc(int b, int& R, int& C) { const int st = b / 1024, sb = b % 1024, swz = sb ^ (((sb >> 9) & 1) << 5); R = (st >> 1) * 16 + swz / 64; C = (st & 1) * 32 + (swz % 64) / 2; }
__host__ __device__ __forceinline__ int perm32(int rho) { const int n = rho >> 4, i = rho & 15; return 8 * (i >> 2) + 4 * n + (i & 3); }

struct Unit { int pm, pn, aux; };

DI int xcd_remap(int L, int nwg) { const int q = nwg / NXCD, r = nwg % NXCD, xcd = L % NXCD, off = L / NXCD; return (xcd < r ? xcd * (q + 1) : r * (q + 1) + (xcd - r) * q) + off; }

struct PlainOrder {
    static constexpr bool GATHER = false, SIGNAL = false, WAIT = false, ACQ1 = false;
    DI void signal(const Unit&) const {} DI void wait(const Unit&) const {}
    const bf16_t* A; const bf16_t* Bt; int K; int nM, nN, nwg, G, c;
    DI void init(const bf16_t* A_, const bf16_t* Bt_, int M, int N, int K_, int G_, int c_) { A = A_; Bt = Bt_; K = K_; nM = M / BM; nN = N / BM; nwg = nM * nN; G = G_; c = c_; }
    DI bool next(int i, Unit& u) const {
        const int Lx = i * G + c; if (Lx >= nwg) return false;
        const int wgid = xcd_remap(Lx, nwg);
        const int nig = WGM * nN, gid = wgid / nig, fm = gid * WGM, gsz = (nM - fm) < WGM ? (nM - fm) : WGM;
        u.pm = fm + ((wgid % nig) % gsz); u.pn = (wgid % nig) / gsz; u.aux = 0; return true;
    }
    DI const char* aptr(const Unit& u) const { return (const char*)A + (size_t)u.pm * (2 * HALF) * K * 2; }
    DI const char* bptr(const Unit& u) const { return (const char*)Bt + (size_t)u.pn * (2 * HALF) * K * 2; }
};
struct Gemm1Order {
    static constexpr bool GATHER = false, SIGNAL = false, WAIT = false, ACQ1 = false;
    DI void signal(const Unit&) const {} DI void wait(const Unit&) const {}
    const bf16_t* U; const bf16_t* Win; const bf16_t* Wv; int G, c;
    static constexpr int nM = T / BM, nN = HW / BM, nMain = nM * nN, nV = 2 * (T / BM), nwg = nMain + nV, K = D;
    DI bool next(int i, Unit& u) const {
        const int Lx = i * G + c; if (Lx >= nwg) return false;
        if (Lx < nMain) {
            const int wgid = xcd_remap(Lx, nMain);
            const int nig = WGM * nN, gid = wgid / nig, fm = gid * WGM, gsz = (nM - fm) < WGM ? (nM - fm) : WGM;
            u.pm = fm + ((wgid % nig) % gsz); u.pn = (wgid % nig) / gsz; u.aux = 0;
        } else { const int v = Lx - nMain; u.pm = v & 1; u.pn = v >> 1; u.aux = 1; }
        return true;
    }
    DI const char* aptr(const Unit& u) const { return (const char*)(u.aux ? Wv : U) + (size_t)u.pm * BM * K * 2; }
    DI const char* bptr(const Unit& u) const { return (const char*)(u.aux ? U : Win) + (size_t)u.pn * BM * K * 2; }
};
template <bool G_> struct GroupedOrderT {
    static constexpr bool GATHER = G_;
#ifdef FUSE_MOE
    static constexpr bool SIGNAL = G_, WAIT = false, ACQ1 = false;
    unsigned* flags;
    DI void signal(const Unit& u) const { (void)__hip_atomic_fetch_add(flags + u.pm, 1u, __ATOMIC_RELAXED, __HIP_MEMORY_SCOPE_AGENT); }
    DI void wait(const Unit&) const {}
#else
    static constexpr bool SIGNAL = false, WAIT = false, ACQ1 = false;
    DI void signal(const Unit&) const {} DI void wait(const Unit&) const {}
#endif
    const bf16_t* A; const bf16_t* Bt; int K; size_t estride; const LAS int* tile_e; int ntiles, nwg, G, c; const int* rowtok;
    DI bool next(int i, Unit& u) const {
        const int Lx = i * G + c; if (Lx >= nwg) return false;
        const int wgid = xcd_remap(Lx, nwg);
        u.pm = wgid >> 2; u.pn = wgid & 3; u.aux = tile_e[u.pm]; return true;
    }
    DI const char* aptr(const Unit& u) const { return GATHER ? (const char*)A : (const char*)A + (size_t)u.pm * BM * K * 2; }
    DI const char* bptr(const Unit& u) const { return (const char*)Bt + ((size_t)u.aux * estride + (size_t)u.pn * BM * K) * 2; }
};

#ifdef FUSE_MOE
struct GroupedOrderB {
    static constexpr bool GATHER = false, SIGNAL = false, WAIT = true;
#ifdef MOE_ACQ1
    static constexpr bool ACQ1 = true;
#else
    static constexpr bool ACQ1 = false;
#endif
    const bf16_t* A; const bf16_t* Bt; int K; size_t estride; const LAS int* tile_e; int ntiles, nwg, G, c; const int* rowtok; unsigned* flags;
    DI bool next(int i, Unit& u) const {
        int wgid;
        if (G % NXCD == 0) {
            const int P = G / NXCD, x = c % NXCD, k = c / NXCD, q = nwg / NXCD, r8 = nwg % NXCD;
            const int qx = q + (x < r8 ? 1 : 0), startx = x < r8 ? x * (q + 1) : r8 * (q + 1) + (x - r8) * q;
            const int remA = qx % P, nL = P - remA, seg1 = remA > 0 ? (2 * nL < qx ? 2 * nL : qx) : 0;
            int n1 = 0;
            if (remA > 0 && k >= remA) { n1 = (k - remA) < seg1 ? 1 : 0; n1 += (k - remA) + nL < seg1 ? 1 : 0; }
            const int ob = i < n1 ? (k - remA) + i * nL : seg1 + k + (i - n1) * P;
            if (ob >= qx) return false;
            wgid = startx + ob;
        } else { const int Lx = i * G + c; if (Lx >= nwg) return false; wgid = Lx; }
        u.pm = wgid >> 2; u.pn = wgid & 3; u.aux = tile_e[u.pm]; return true;
    }
    DI const char* aptr(const Unit& u) const { return (const char*)A + (size_t)u.pm * BM * K * 2; }
    DI const char* bptr(const Unit& u) const { return (const char*)Bt + ((size_t)u.aux * estride + (size_t)u.pn * BM * K) * 2; }
    DI void signal(const Unit&) const {}
    DI void wait(const Unit& u) const {
        unsigned sp = 0;
        while (__hip_atomic_load(flags + u.pm, __ATOMIC_RELAXED, __HIP_MEMORY_SCOPE_AGENT) < 4u) { __builtin_amdgcn_s_sleep(4); if (++sp > (1u << 22)) break; }
#ifdef MOE_ACQ1
        __builtin_amdgcn_fence(__ATOMIC_ACQUIRE, "agent"); asm volatile("s_waitcnt vmcnt(0)" ::: "memory");
#else
        asm volatile("" ::: "memory");
#endif
    }
};
#endif

struct EpiStore {
    bf16_t* O0; int ld0; bf16_t* O1; int ld1;
    DI void operator()(const f32x4 (&acc)[2][2][4][2], const Unit& u, int wr, int wc, int fr, int fq) const {
        bf16_t* base = u.aux ? O1 : O0; const int ldc = u.aux ? ld1 : ld0;
        const int row0 = u.pm * BM + wr * 64 + fr, col0 = u.pn * BM + wc * 32 + 8 * fq;
#pragma unroll
        for (int ai = 0; ai < 2; ++ai)
#pragma unroll
            for (int m = 0; m < 4; ++m) { bf16_t* rowp = base + (size_t)(row0 + ai * HALF + m * 16) * ldc + col0;
#pragma unroll
                for (int bj = 0; bj < 2; ++bj) { const f32x4 v0 = acc[ai][bj][m][0], v1 = acc[ai][bj][m][1];
                    u32x4 w; w.x = cvtpk(v0[0], v0[1]); w.y = cvtpk(v0[2], v0[3]); w.z = cvtpk(v1[0], v1[1]); w.w = cvtpk(v1[2], v1[3]);
                    *(u32x4*)(rowp + bj * HALF) = w; } }
    }
};
#ifdef KV_TILED
struct EpiGemm1 {
    bf16_t* O0; int ld0; bf16_t* Kt; bf16_t* Vt;
    DI void operator()(const f32x4 (&acc)[2][2][4][2], const Unit& u, int wr, int wc, int fr, int fq) const {
        const int row0 = u.pm * BM + wr * 64 + fr, col0 = u.pn * BM + wc * 32 + 8 * fq;
#pragma unroll
        for (int ai = 0; ai < 2; ++ai)
#pragma unroll
            for (int m = 0; m < 4; ++m) { const int row = row0 + ai * HALF + m * 16;
#pragma unroll
                for (int bj = 0; bj < 2; ++bj) { const f32x4 v0 = acc[ai][bj][m][0], v1 = acc[ai][bj][m][1]; const int col = col0 + bj * HALF;
                    u32x4 w; w.x = cvtpk(v0[0], v0[1]); w.y = cvtpk(v0[2], v0[3]); w.z = cvtpk(v1[0], v1[1]); w.w = cvtpk(v1[2], v1[3]);
                    if (u.aux) {
                        if (row < 384) { const int head = row >> 6, dd = row & 63, tl = col >> 5, tk = col & 31;
                            *(u32x4*)(Vt + ((((size_t)head * (T / 32) + tl) * 4 + (dd >> 5) * 2 + (tk >> 4)) * 32 + (dd & 31)) * 16 + (tk & 15)) = w; }
                    } else if (col >= 384 && col < 768) {
                        const int head = (col - 384) >> 6, d = (col - 384) & 63, tl = row >> 5, tk = row & 31, pos = (tk & 19) | ((tk & 4) << 1) | ((tk & 8) >> 1);
                        *(u32x4*)(Kt + ((((size_t)head * (T / 32) + tl) * 4 + (d >> 4)) * 32 + pos) * 16 + (d & 15)) = w;
                    } else *(u32x4*)(O0 + (size_t)row * ld0 + col) = w; } }
    }
};
#endif
struct EpiSwiGlu {
    bf16_t* O;
    DI void operator()(const f32x4 (&acc)[2][2][4][2], const Unit& u, int wr, int wc, int fr, int fq) const {
        const int row0 = u.pm * BM + wr * 64 + fr, col0 = u.pn * HALF + wc * 32 + 8 * fq;
#pragma unroll
        for (int ai = 0; ai < 2; ++ai)
#pragma unroll
            for (int m = 0; m < 4; ++m) { bf16_t* rowp = O + (size_t)(row0 + ai * HALF + m * 16) * DE + col0;
                float hv[8];
#pragma unroll
                for (int n = 0; n < 2; ++n)
#pragma unroll
                    for (int e = 0; e < 4; ++e) { const float g = acc[ai][0][m][n][e], up = acc[ai][1][m][n][e]; hv[4 * n + e] = g * sigm(g) * up; }
                u32x4 w; w.x = cvtpk(hv[0], hv[1]); w.y = cvtpk(hv[2], hv[3]); w.z = cvtpk(hv[4], hv[5]); w.w = cvtpk(hv[6], hv[7]);
#ifdef FUSE_MOE
                asm volatile("global_store_dwordx4 %0, %1, off sc1\n\ts_nop 1" :: "v"(rowp), "v"(w) : "memory");
#else
                *(u32x4*)rowp = w;
#endif
            }
    }
};
struct EpiRowScale {
    bf16_t* O; const float* roww;
    DI void operator()(const f32x4 (&acc)[2][2][4][2], const Unit& u, int wr, int wc, int fr, int fq) const {
        const int row0 = u.pm * BM + wr * 64 + fr, col0 = u.pn * BM + wc * 32 + 8 * fq;
#pragma unroll
        for (int ai = 0; ai < 2; ++ai)
#pragma unroll
            for (int m = 0; m < 4; ++m) { const int row = row0 + ai * HALF + m * 16;
#ifdef MOEB_NOSCALE
                const float s = 1.f;
#else
                const float s = roww[row];
#endif
                bf16_t* rowp = O + (size_t)row * D + col0;
#pragma unroll
                for (int bj = 0; bj < 2; ++bj) { const f32x4 v0 = acc[ai][bj][m][0] * s, v1 = acc[ai][bj][m][1] * s;
                    u32x4 w; w.x = cvtpk(v0[0], v0[1]); w.y = cvtpk(v0[2], v0[3]); w.z = cvtpk(v1[0], v1[1]); w.w = cvtpk(v1[2], v1[3]);
                    *(u32x4*)(rowp + bj * HALF) = w; } }
    }
};

template <class Epi, class Sched>
DI void gemm_phase(LAS unsigned char* lds, const int tid, const int K, const Sched& S, const Epi& E) {
    const int wid = __builtin_amdgcn_readfirstlane(tid >> 6), lane = tid & 63, wr = wid >> 2, wc = wid & 3, fr = lane & 15, fq = lane >> 4;
    const int nt = K / BK;
    unsigned voffA[2], voffB[2];
#pragma unroll
    for (int i = 0; i < 2; ++i) { int R, C; stage_rc(tid * 16 + i * 8192, R, C); const int Rb = (R & ~31) + perm32(R & 31);
        voffA[i] = (unsigned)(R * K + C) * 2u; voffB[i] = (unsigned)(Rb * K + C) * 2u; }
    const size_t kstep = (size_t)(BK * 2);
    const size_t hstep = (size_t)HALF * K * 2;
    const size_t hstepA = Sched::GATHER ? 0 : hstep;
    int RA_[2], CA_[2];
#pragma unroll
    for (int i = 0; i < 2; ++i) stage_rc(tid * 16 + i * 8192, RA_[i], CA_[i]);
    unsigned vgc[2][2], vgn[2][2], vgnn[2][2];
#define PG8_GLOAD(dst, u_) do { if constexpr (Sched::GATHER) { _Pragma("unroll") for (int h_ = 0; h_ < 2; ++h_) _Pragma("unroll") for (int i_ = 0; i_ < 2; ++i_) \
        dst[h_][i_] = ((unsigned)S.rowtok[(u_).pm * BM + h_ * HALF + RA_[i_]] * (unsigned)K + (unsigned)CA_[i_]) * 2u; } } while (0)
    const unsigned ldsw = (unsigned)wid * 1024u;
    const int aoff = lds_byte(wr * 64 + fr, fq * 8), boff = lds_byte(wc * 32 + fr, fq * 8);
#define PG8_SA(b, h) (((b) * 2 + (h)) * HTB)
#define PG8_SB(b, h) ((4 + (b) * 2 + (h)) * HTB)
#define PG8_STAGE(bufoff, gbase, voff) do { _Pragma("unroll") for (int _i = 0; _i < 2; ++_i) \
        __builtin_amdgcn_global_load_lds((const unsigned*)((const char*)(gbase) + (voff)[_i]), (LAS unsigned*)(lds + (bufoff) + ldsw + _i * 8192), 16, 0, 0); } while (0)
#define PG8_STAGE_C(bufoff, gbase, voff) do { _Pragma("unroll") for (int _i = 0; _i < 2; ++_i) \
        __builtin_amdgcn_global_load_lds((const unsigned*)((const char*)(gbase) + (voff)[_i]), (LAS unsigned*)(lds + (bufoff) + ldsw + _i * 8192), 16, 0, 16); } while (0)
#define PG8_STAGE_A(b, h, gbase, cur_) do { if constexpr (Sched::GATHER) { unsigned vo_[2]; vo_[0] = (cur_) ? vgc[h][0] : vgn[h][0]; vo_[1] = (cur_) ? vgc[h][1] : vgn[h][1]; PG8_STAGE(PG8_SA(b, h), gbase, vo_); } else if constexpr (Sched::WAIT && !Sched::ACQ1) PG8_STAGE_C(PG8_SA(b, h), (gbase) + (h) * hstepA, voffA); else PG8_STAGE(PG8_SA(b, h), (gbase) + (h) * hstepA, voffA); } while (0)
#define PG8_LDA(dst, b, h) do { _Pragma("unroll") for (int m = 0; m < 4; ++m) _Pragma("unroll") for (int k = 0; k < 2; ++k) dst[m][k] = *(const LAS bf16x8*)(lds + PG8_SA(b, h) + aoff + m * 2048 + k * 1024); } while (0)
#define PG8_LDB(dst, b, h) do { _Pragma("unroll") for (int n = 0; n < 2; ++n) _Pragma("unroll") for (int k = 0; k < 2; ++k) dst[n][k] = *(const LAS bf16x8*)(lds + PG8_SB(b, h) + boff + n * 2048 + k * 1024); } while (0)
#define PG8_MMA(ai, bj, At, Bt) do { __builtin_amdgcn_s_setprio(1); _Pragma("unroll") for (int m = 0; m < 4; ++m) _Pragma("unroll") for (int n = 0; n < 2; ++n) _Pragma("unroll") for (int k = 0; k < 2; ++k) \
        acc[ai][bj][m][n] = __builtin_amdgcn_mfma_f32_16x16x32_bf16(Bt[n][k], At[m][k], acc[ai][bj][m][n], 0, 0, 0); __builtin_amdgcn_s_setprio(0); } while (0)
#define PG8_WAIT_V(n) asm volatile("s_waitcnt vmcnt(" #n ")" ::: "memory")
#define PG8_WAIT_L(n) asm volatile("s_waitcnt lgkmcnt(" #n ")" ::: "memory")
#define PG8_BAR __builtin_amdgcn_s_barrier()
#define PG8_SCHED __builtin_amdgcn_sched_barrier(0)
    Unit cur, nxt; int ui = 0;
    if (!S.next(0, cur)) return;
    f32x4 acc[2][2][4][2];
#pragma unroll
    for (int a = 0; a < 2; ++a)
#pragma unroll
        for (int b = 0; b < 2; ++b)
#pragma unroll
            for (int m = 0; m < 4; ++m)
#pragma unroll
                for (int n = 0; n < 2; ++n) acc[a][b][m][n] = (f32x4){0.f, 0.f, 0.f, 0.f};
    bf16x8 At[4][2], B0[2][2], B1[2][2];
    const char* cA = S.aptr(cur); const char* cB = S.bptr(cur);
    if constexpr (Sched::WAIT) { if constexpr (Sched::ACQ1) { if (wid == 0) S.wait(cur); PG8_BAR; } else S.wait(cur); }
    if constexpr (Sched::GATHER) { Unit u1_ = cur, u2_ = cur; const bool h1_ = S.next(1, u1_); if (!h1_) u1_ = cur; const bool h2_ = h1_ && S.next(2, u2_); if (!h2_) u2_ = u1_;
        PG8_GLOAD(vgc, cur); PG8_GLOAD(vgn, u1_); PG8_GLOAD(vgnn, u2_); }
    PG8_STAGE(PG8_SB(0, 0), cB, voffB); PG8_STAGE(PG8_SB(0, 1), cB + hstep, voffB); PG8_STAGE_A(0, 0, cA, true); PG8_STAGE_A(0, 1, cA, true);
    if (wr == 1) PG8_BAR;
    PG8_WAIT_V(2); PG8_BAR;
    PG8_STAGE(PG8_SB(1, 0), cB + kstep, voffB); PG8_STAGE_A(1, 0, cA + kstep, true); PG8_STAGE(PG8_SB(1, 1), cB + hstep + kstep, voffB);
    PG8_WAIT_V(6); PG8_BAR;
    for (;;) {
        const bool has_next = S.next(ui + 1, nxt);
        const char* nA = has_next ? S.aptr(nxt) : cA; const char* nB = has_next ? S.bptr(nxt) : cB;

        for (int t = 0; t < nt; t += 2) {
            const bool last = (t == nt - 2);
            if constexpr (Sched::WAIT) { if (last && has_next) { if constexpr (Sched::ACQ1) { if (wid == 0) S.wait(nxt); } else S.wait(nxt); } }
            const char* a1 = cA + (size_t)(t + 1) * kstep;
            const char* a2 = last ? nA : cA + (size_t)(t + 2) * kstep; const char* b2 = last ? nB : cB + (size_t)(t + 2) * kstep;
            const char* a3 = a2 + kstep; const char* b3 = b2 + kstep;
            PG8_LDB(B0, 0, 0); PG8_LDB(B1, 0, 1); PG8_SCHED; PG8_LDA(At, 0, 0); PG8_STAGE_A(1, 1, a1, true);
            PG8_WAIT_V(8); PG8_WAIT_L(0); PG8_BAR; PG8_MMA(0, 0, At, B0); PG8_MMA(0, 1, At, B1); PG8_BAR; PG8_SCHED;
            PG8_LDA(At, 0, 1); PG8_STAGE(PG8_SB(0, 0), b2, voffB); PG8_STAGE(PG8_SB(0, 1), b2 + hstep, voffB); PG8_STAGE_A(0, 0, a2, !last);
            PG8_WAIT_V(8); PG8_WAIT_L(0); PG8_BAR; PG8_MMA(1, 0, At, B0); PG8_MMA(1, 1, At, B1); PG8_BAR; PG8_SCHED;
            PG8_LDB(B0, 1, 0); PG8_LDB(B1, 1, 1); PG8_SCHED; PG8_LDA(At, 1, 0); PG8_STAGE_A(0, 1, a2, !last);
            PG8_WAIT_V(8); PG8_WAIT_L(0); PG8_BAR; PG8_MMA(0, 0, At, B0); PG8_MMA(0, 1, At, B1); PG8_BAR; PG8_SCHED;
            PG8_LDA(At, 1, 1); PG8_STAGE(PG8_SB(1, 0), b3, voffB); PG8_STAGE(PG8_SB(1, 1), b3 + hstep, voffB); PG8_STAGE_A(1, 0, a3, !last);
            PG8_WAIT_V(8); PG8_WAIT_L(0); PG8_BAR; PG8_MMA(1, 0, At, B0); PG8_MMA(1, 1, At, B1); PG8_BAR; PG8_SCHED;
        }
        if (wr == 0) PG8_BAR;
        E(acc, cur, wr, wc, fr, fq);
        if constexpr (Sched::SIGNAL) { PG8_WAIT_V(0); PG8_BAR; if (tid == 0) S.signal(cur); }
        if (!has_next) break;
#pragma unroll
        for (int a = 0; a < 2; ++a)
#pragma unroll
            for (int b = 0; b < 2; ++b)
#pragma unroll
                for (int m = 0; m < 4; ++m)
#pragma unroll
                    for (int n = 0; n < 2; ++n) acc[a][b][m][n] = (f32x4){0.f, 0.f, 0.f, 0.f};
        cur = nxt; cA = nA; cB = nB; ++ui;
        if constexpr (Sched::GATHER) { _Pragma("unroll") for (int h_ = 0; h_ < 2; ++h_) _Pragma("unroll") for (int i_ = 0; i_ < 2; ++i_) { vgc[h_][i_] = vgn[h_][i_]; vgn[h_][i_] = vgnn[h_][i_]; } }
        if (wr == 1) PG8_BAR;
    }
    PG8_WAIT_V(0);
    PG8_BAR;
#undef PG8_SA
#undef PG8_SB
#undef PG8_STAGE
#undef PG8_STAGE_C
#undef PG8_STAGE_A
#undef PG8_GLOAD
#undef PG8_LDA
#undef PG8_LDB
#undef PG8_MMA
#undef PG8_WAIT_V
#undef PG8_WAIT_L
#undef PG8_BAR
#undef PG8_SCHED
}
}

#define XB_TMO      128
#define XB_XCNT(j)  (256  + 64 * (j))
#define XB_XSUB(j)  (1280 + 64 * (j))
#define XB_XGEN(j)  (2304 + 64 * (j))
#define XB_TOP      3328
#define XB_TOPGEN   3392
#define XCD_BAR_WORDS 3456
#define XB_SPIN_CAP (1u << 20)
DI unsigned xb_ld(unsigned* p)              { return __hip_atomic_load(p, __ATOMIC_RELAXED, __HIP_MEMORY_SCOPE_AGENT); }
DI unsigned xb_add(unsigned* p, unsigned v) { return __hip_atomic_fetch_add(p, v, __ATOMIC_RELAXED, __HIP_MEMORY_SCOPE_AGENT); }
DI unsigned xb_xcc_id() { return (unsigned)__builtin_amdgcn_s_getreg((3 << 11) | 20) & 0xFu; }
#define XB_SPIN(cond, bar) do { unsigned _sp = 0; while (cond) { __builtin_amdgcn_s_sleep(1); \
    if ((++_sp & 255u) == 0u) { if (xb_ld(&(bar)[XB_TMO])) break; if (_sp > XB_SPIN_CAP) { atomicAdd(&(bar)[XB_TMO], 1u); break; } } } } while (0)
struct XcdBarrier { unsigned* bar; unsigned x; volatile LAS unsigned* st; };
DI XcdBarrier xcd_barrier_post(unsigned* bar, volatile LAS unsigned* st) {
    XcdBarrier b; b.bar = bar; b.x = xb_xcc_id(); b.st = st;
    if (threadIdx.x == 0) (void)xb_add(&bar[XB_XCNT(b.x)], 1u);
    return b;
}
DI void xcd_barrier_complete(unsigned* bar, unsigned x, unsigned& nloc, unsigned& nx) {
    const unsigned G = gridDim.x * gridDim.y * gridDim.z;
    unsigned sum, cnt, mine, sp = 0u;
    for (;;) {
        sum = 0u; cnt = 0u; mine = 0u;
#pragma unroll
        for (unsigned j = 0; j < 16; ++j) { const unsigned c = xb_ld(&bar[XB_XCNT(j)]); sum += c; cnt += (c > 0u) ? 1u : 0u; mine = (j == x) ? c : mine; }
        if (sum == G) break;
        __builtin_amdgcn_s_sleep(1);
        if ((++sp & 255u) == 0u) { if (xb_ld(&bar[XB_TMO])) break; if (sp > XB_SPIN_CAP) { atomicAdd(&bar[XB_TMO], 1u); break; } }
    }
    nloc = mine > 0u ? mine : 1u; nx = cnt > 0u ? cnt : 1u;
}
DI void xcd_barrier(const XcdBarrier& b) {
    asm volatile("s_waitcnt vmcnt(0)" ::: "memory");
    __syncthreads();
    if (threadIdx.x == 0) {
        unsigned* bar = b.bar;
        __builtin_amdgcn_s_waitcnt(0);
        unsigned nloc = b.st[0], nx = b.st[1];
        if (nloc == 0u) { xcd_barrier_complete(bar, b.x, nloc, nx); b.st[0] = nloc; b.st[1] = nx; }
        const unsigned old = xb_add(&bar[XB_XSUB(b.x)], 1u);
        const unsigned gen = old / nloc;
        if (old + 1u == (gen + 1u) * nloc) {
            __builtin_amdgcn_fence(__ATOMIC_RELEASE, "agent");
            asm volatile("s_waitcnt vmcnt(0)" ::: "memory");
            const unsigned og = xb_add(&bar[XB_TOP], 1u);
            const unsigned tg = og / nx;
            if (og + 1u == (tg + 1u) * nx) xb_add(&bar[XB_TOPGEN], 1u);
            else XB_SPIN(xb_ld(&bar[XB_TOPGEN]) == tg, bar);
            __builtin_amdgcn_fence(__ATOMIC_ACQUIRE, "agent");
            xb_add(&bar[XB_XGEN(b.x)], 1u);
            asm volatile("s_waitcnt vmcnt(0)" ::: "memory");
        } else {
            XB_SPIN(xb_ld(&bar[XB_XGEN(b.x)]) == gen, bar);
            __builtin_amdgcn_fence(__ATOMIC_ACQUIRE, "agent");
            asm volatile("s_waitcnt vmcnt(0)" ::: "memory");
        }
    }
    __syncthreads();
}

struct Args { const float* in[31]; float* out; unsigned char* ws; int ph_lo, ph_hi, use_cg, pad; };
struct Frame {
    LAS unsigned char* lds;
    int tid, lane, wave, G, vcu, gw, ngw, bx;
    unsigned char* ws;
};
constexpr int LDS_MISC = 131072;
constexpr int LDS_BARST = LDS_BYTES - 64;

#ifdef NO_PREWAIT
#define CONV_PREWAIT() do { } while (0)
#else
#define CONV_PREWAIT() __builtin_amdgcn_s_waitcnt(0x0F70)
#endif
struct TItem { const float* src; bf16_t* dst; int ldw, ldt; };
#ifdef TITEM2
DI void titem_load(const TItem& t, f32x4 (&v)[16], int lane) {
#pragma unroll
    for (int i = 0; i < 16; ++i) v[i] = *(const f32x4*)(t.src + (size_t)(16 * (i >> 2) + 4 * (lane >> 4) + (i & 3)) * t.ldw + 4 * (lane & 15));
}
DI void titem_store(const TItem& t, const f32x4 (&v)[16], LAS float* scr, int lane) {
    LAS unsigned char* T = (LAS unsigned char*)scr;
    const int rr = lane >> 4, cc = lane & 15;
#pragma unroll
    for (int q = 0; q < 4; ++q)
#pragma unroll
        for (int e = 0; e < 4; ++e)
            *(LAS u32x2*)(T + (4 * cc + e) * 136 + (16 * q + 4 * rr) * 2) = (u32x2){cvtpk(v[4 * q][e], v[4 * q + 1][e]), cvtpk(v[4 * q + 2][e], v[4 * q + 3][e])};
    LDS_WAIT();
#pragma unroll
    for (int j = 0; j < 8; ++j) {
        const int n = 8 * j + (lane >> 3), c = lane & 7;
        const u32x2 lo = *(const LAS u32x2*)(T + n * 136 + 16 * c), hi = *(const LAS u32x2*)(T + n * 136 + 16 * c + 8);
        *(u32x4*)(t.dst + (size_t)n * t.ldt + 8 * c) = (u32x4){lo.x, lo.y, hi.x, hi.y};
    }
    LDS_WAIT();
}
#else
DI void titem_load(const TItem& t, f32x4 (&v)[16], int lane) {
#pragma unroll
    for (int i = 0; i < 16; ++i) v[i] = *(const f32x4*)(t.src + (size_t)(4 * i + (lane >> 4)) * t.ldw + 4 * (lane & 15));
}
DI void titem_store(const TItem& t, const f32x4 (&v)[16], LAS float* scr, int lane) {
#pragma unroll
    for (int i = 0; i < 16; ++i) { LAS float* s = scr + (4 * i + (lane >> 4)) * 65 + 4 * (lane & 15); s[0] = v[i][0]; s[1] = v[i][1]; s[2] = v[i][2]; s[3] = v[i][3]; }
    LDS_WAIT();
#pragma unroll
    for (int j = 0; j < 8; ++j) {
        const int n = 8 * j + (lane >> 3), c = lane & 7; const LAS float* s = scr + (8 * c) * 65 + n;
        u32x4 o; o.x = cvtpk(s[0], s[65]); o.y = cvtpk(s[130], s[195]); o.z = cvtpk(s[260], s[325]); o.w = cvtpk(s[390], s[455]);
        *(u32x4*)(t.dst + (size_t)n * t.ldt + 8 * c) = o;
    }
    LDS_WAIT();
}
#endif
constexpr int IT_WIN = 16 * 42, IT_WOUT = 16 * 16, IT_SMALL = IT_WIN + IT_WOUT;
constexpr int IT_EXP = 128 * 3, IT_MOE = NE * IT_EXP;
DI TItem small_item(const Frame& F, const float* w_in, const float* w_out, int git) {
    const int l = git / IT_SMALL, it = git % IT_SMALL; TItem t;
    if (it < IT_WIN) {
        const int kt = it / 42, nt = it % 42, n0 = 64 * nt;
        size_t drow; if (n0 < 768) drow = n0; else if (n0 < 1152) drow = 2304 + (n0 - 768); else drow = n0 - 384;
        t.src = w_in + (size_t)l * D * INW + (size_t)(64 * kt) * INW + n0; t.ldw = INW;
        t.dst = (bf16_t*)(F.ws + WS_WIN + (size_t)l * WIN_LAYER) + drow * D + 64 * kt; t.ldt = D;
    } else {
        const int r = it - IT_WIN, kt = r >> 4, nt = r & 15;
        t.src = w_out + (size_t)l * D * D + (size_t)(64 * kt) * D + 64 * nt; t.ldw = D;
        t.dst = (bf16_t*)(F.ws + WS_WOUT) + (size_t)l * D * D + (size_t)(64 * nt) * D + 64 * kt; t.ldt = D;
    }
    return t;
}
DI TItem moe_item(const Frame& F, const float* wg, const float* wu, const float* wd, int l, int it) {
    const int e = it / IT_EXP, r = it % IT_EXP, which = r >> 7, q = r & 127; TItem t;
    if (which < 2) {
        const int kt = q >> 3, nt = q & 7, n0 = 64 * nt;
        t.src = (which ? wu : wg) + ((size_t)l * NE + e) * D * DE + (size_t)(64 * kt) * DE + n0; t.ldw = DE;
        const size_t drow = (size_t)(n0 >> 7) * 256 + (which ? 128 : 0) + (n0 & 127);
        t.dst = (bf16_t*)(F.ws + WS_WGU) + (size_t)e * D * D + drow * D + 64 * kt; t.ldt = D;
    } else {
        const int kt = q >> 4, nt = q & 15;
        t.src = wd + ((size_t)l * NE + e) * DE * D + (size_t)(64 * kt) * D + 64 * nt; t.ldw = D;
        t.dst = (bf16_t*)(F.ws + WS_WD) + (size_t)e * D * DE + (size_t)(64 * nt) * DE + 64 * kt; t.ldt = DE;
    }
    return t;
}
DI void p0_prologue(const Frame& F, const Args& a) {
    const float* c = a.in[1]; const float* w_mod = a.in[2]; const float* b_mod = a.in[3];
    if (F.bx < L * (MODW / 64)) {
        LAS float* sc = (LAS float*)(F.lds);
        LAS float* red = (LAS float*)(F.lds + 8192);
        for (int i = F.tid; i < NB * D; i += NTHREADS) { const float v = c[i]; sc[i] = v / (1.f + expf(-v)); }
        __syncthreads();
        const int l = F.bx / (MODW / 64), cb = F.bx % (MODW / 64), n = cb * 64 + F.lane;
        const float* w = w_mod + (size_t)l * D * MODW + n;
        float a0 = 0.f, a1 = 0.f;
#pragma unroll 8
        for (int k = F.wave * 128; k < F.wave * 128 + 128; ++k) { const float wv = w[(size_t)k * MODW]; a0 += sc[k] * wv; a1 += sc[D + k] * wv; }
        red[(F.wave * 2 + 0) * 64 + F.lane] = a0; red[(F.wave * 2 + 1) * 64 + F.lane] = a1;
        __syncthreads();
        if (F.tid < 128) { const int b = F.tid >> 6, ln = F.tid & 63; float s = 0.f;
#pragma unroll
            for (int w8 = 0; w8 < 8; ++w8) s += red[(w8 * 2 + b) * 64 + ln];
            const int nn = cb * 64 + ln;
            ((float*)(F.ws + WS_MOD))[(size_t)(l * NB + b) * MODW + nn] = s + b_mod[l * MODW + nn]; }
        __syncthreads();
    }
    { const int nzero = L * 128 * D / 8;
      for (int i = F.gw * 64 + F.lane; i < nzero; i += F.ngw * 64) { const int l = i / (128 * D / 8), r = i % (128 * D / 8);
          *(u32x4*)((bf16_t*)(F.ws + WS_WIN + (size_t)l * WIN_LAYER) + (size_t)(2304 + 384) * D + (size_t)r * 8) = (u32x4){0u, 0u, 0u, 0u}; } }
    LAS float* scr = (LAS float*)(F.lds + 16384) + F.wave * (64 * 65);
    { f32x4 cur[16], nxt[16]; int it = F.gw; TItem tc{}, tn{};
      if (it < L * IT_SMALL) { tc = small_item(F, a.in[4], a.in[19], it); titem_load(tc, cur, F.lane); }
      CONV_PREWAIT();
      for (; it < L * IT_SMALL; it += F.ngw) {
          const bool more = it + F.ngw < L * IT_SMALL;
          if (more) { tn = small_item(F, a.in[4], a.in[19], it + F.ngw); titem_load(tn, nxt, F.lane); }
          titem_store(tc, cur, scr, F.lane);
          if (more) { tc = tn;
#pragma unroll
              for (int i = 0; i < 16; ++i) cur[i] = nxt[i]; }
      } }
}

DI void row_ln(f32x4 (&v)[4], float& mean_out, float& rstd_out) {
    float s = 0.f;
#pragma unroll
    for (int j = 0; j < 4; ++j) s += (v[j][0] + v[j][1]) + (v[j][2] + v[j][3]);
    const float mean = wave_sum(s) * (1.f / D); float q = 0.f;
#pragma unroll
    for (int j = 0; j < 4; ++j) { v[j] = v[j] - mean; q += (v[j][0] * v[j][0] + v[j][1] * v[j][1]) + (v[j][2] * v[j][2] + v[j][3] * v[j][3]); }
    mean_out = mean; rstd_out = 1.f / sqrtf(wave_sum(q) * (1.f / D) + LN_EPS);
}
DI void row_mod_store(f32x4 (&v)[4], const float* md, int off_sh, int off_sc, bf16_t* urow, int lane) {
    float mean, rstd; row_ln(v, mean, rstd);
#pragma unroll
    for (int j = 0; j < 4; ++j) { const int col = 4 * lane + 256 * j;
        const f32x4 scv = *(const f32x4*)(md + off_sc + col), shv = *(const f32x4*)(md + off_sh + col);
        v[j] = v[j] * rstd * (1.f + scv) + shv;
        u32x2 w; w.x = cvtpk(v[j][0], v[j][1]); w.y = cvtpk(v[j][2], v[j][3]);
        *(u32x2*)(urow + col) = w; }
}
DI void p_r0(const Frame& F, const float* x) {
    const float* MOD = (const float*)(F.ws + WS_MOD);
    bf16_t* U = (bf16_t*)(F.ws + WS_U);
    for (int row = F.gw; row < T; row += F.ngw) {
        f32x4 v[4];
#pragma unroll
        for (int j = 0; j < 4; ++j) v[j] = *(const f32x4*)(x + (size_t)row * D + 4 * F.lane + 256 * j);
        row_mod_store(v, MOD + (size_t)(row / S) * MODW, 0, D, U + (size_t)row * D, F.lane);
    }
}

constexpr int NGRP = T / 64;
DI void p_rowpass1(const Frame& F, const Args& a, int l, const float* xin, const bool dry = false) {
    const float* MODl = (const float*)(F.ws + WS_MOD) + (size_t)l * NB * MODW;
    const bf16_t* MIX = (const bf16_t*)(F.ws + WS_MIX);
    float* XA = (float*)(F.ws + WS_XA); bf16_t* U = (bf16_t*)(F.ws + WS_U);
    const float* gain = a.in[20] + (size_t)l * D; const float* bias = a.in[21] + (size_t)l * D;
    const float* wg = a.in[24] + (size_t)l * D * NG; const float* bg = a.in[25] + (size_t)l * NG;
    const float* we = a.in[26] + (size_t)l * D * NE; const float* be = a.in[27] + (size_t)l * NE;
    const size_t dro = dry ? 490 * MiB - WS_BC : 0;
    int* BC = (int*)(F.ws + WS_BC + dro); float* TOKW = (float*)(F.ws + WS_TOKW + dro); int* TOKSLOT = (int*)(F.ws + WS_TOKSLOT + (dry ? 496 * MiB - WS_TOKSLOT : 0));
    LAS float* RT = (LAS float*)F.lds;
    LAS unsigned* cntl = (LAS unsigned*)(F.lds + 36 * D * 4 + NWAVES * 72 * 4);
#ifdef DRY_NOFILL
    if (!dry)
#endif
#pragma unroll
    for (int kk = 0; kk < 2; ++kk) { const int k = F.tid + kk * NTHREADS;
        f32x4 v[9]; v[0] = *(const f32x4*)(wg + (size_t)k * NG);
#pragma unroll
        for (int q = 0; q < 8; ++q) v[1 + q] = *(const f32x4*)(we + (size_t)k * NE + 4 * q);
#pragma unroll
        for (int q = 0; q < 9; ++q)
#pragma unroll
            for (int e = 0; e < 4; ++e) RT[(4 * q + e) * D + k] = v[q][e]; }
    for (int grp = F.vcu; grp < NGRP; grp += F.G) {
    if (F.tid < NE) cntl[F.tid] = 0u;
    __syncthreads();
#ifdef RESBF
    const bool xbf = l > 0; const bf16_t* xinb = (const bf16_t*)xin; bf16_t* XAb = (bf16_t*)(F.ws + WS_XA);
    u32x4 pxa[4], pxb[4]; u32x2 pma[4], pmb[4];
#define RP1_LDX(dst, row_, col_) do { if (xbf) { const u32x2 t_ = *(const u32x2*)(xinb + (size_t)(row_) * D + (col_)); dst.x = t_.x; dst.y = t_.y; } else dst = *(const u32x4*)(xin + (size_t)(row_) * D + (col_)); } while (0)
#define RP1_XV(p_) (xbf ? (f32x4){bflo(p_.x), bfhi(p_.x), bflo(p_.y), bfhi(p_.y)} : __builtin_bit_cast(f32x4, p_))
#else
    f32x4 pxa[4], pxb[4]; u32x2 pma[4], pmb[4];
#define RP1_LDX(dst, row_, col_) dst = *(const f32x4*)(xin + (size_t)(row_) * D + (col_))
#define RP1_XV(p_) (p_)
#endif
    { const int r0 = 64 * grp + 8 * F.wave;
#pragma unroll
      for (int j = 0; j < 4; ++j) { const int col = 4 * F.lane + 256 * j; RP1_LDX(pxa[j], r0, col); RP1_LDX(pxb[j], r0 + 1, col);
          pma[j] = *(const u32x2*)(MIX + (size_t)r0 * D + col); pmb[j] = *(const u32x2*)(MIX + (size_t)(r0 + 1) * D + col); } }
    for (int rp = 0; rp < 4; ++rp) {
        const int row0 = 64 * grp + 8 * F.wave + 2 * rp; const float* md = MODl + (size_t)(row0 / S) * MODW;
        f32x4 va[4], vb[4];
#pragma unroll
        for (int j = 0; j < 4; ++j) { const int col = 4 * F.lane + 256 * j;
            const f32x4 g = *(const f32x4*)(md + 2 * D + col);
            va[j] = RP1_XV(pxa[j]) * ALPHA + g * (f32x4){bflo(pma[j].x), bfhi(pma[j].x), bflo(pma[j].y), bfhi(pma[j].y)};
            vb[j] = RP1_XV(pxb[j]) * ALPHA + g * (f32x4){bflo(pmb[j].x), bfhi(pmb[j].x), bflo(pmb[j].y), bfhi(pmb[j].y)}; }
        if (rp < 3) { const int r0 = row0 + 2;
#pragma unroll
          for (int j = 0; j < 4; ++j) { const int col = 4 * F.lane + 256 * j; RP1_LDX(pxa[j], r0, col); RP1_LDX(pxb[j], r0 + 1, col);
              pma[j] = *(const u32x2*)(MIX + (size_t)r0 * D + col); pmb[j] = *(const u32x2*)(MIX + (size_t)(r0 + 1) * D + col); } }
        float mean, rstd;
        row_ln(va, mean, rstd);
#pragma unroll
        for (int j = 0; j < 4; ++j) { const int col = 4 * F.lane + 256 * j; va[j] = va[j] * rstd * *(const f32x4*)(gain + col) + *(const f32x4*)(bias + col);
#ifdef RESBF
            *(u32x2*)(XAb + (size_t)row0 * D + col) = (u32x2){cvtpk(va[j][0], va[j][1]), cvtpk(va[j][2], va[j][3])}; }
#else
            *(f32x4*)(XA + (size_t)row0 * D + col) = va[j]; }
#endif
        row_ln(vb, mean, rstd);
#pragma unroll
        for (int j = 0; j < 4; ++j) { const int col = 4 * F.lane + 256 * j; vb[j] = vb[j] * rstd * *(const f32x4*)(gain + col) + *(const f32x4*)(bias + col);
#ifdef RESBF
            *(u32x2*)(XAb + (size_t)(row0 + 1) * D + col) = (u32x2){cvtpk(vb[j][0], vb[j][1]), cvtpk(vb[j][2], vb[j][3])}; }
#else
            *(f32x4*)(XA + (size_t)(row0 + 1) * D + col) = vb[j]; }
#endif
        row_mod_store(va, md, 3 * D, 4 * D, U + (size_t)row0 * D, F.lane);
        row_mod_store(vb, md, 3 * D, 4 * D, U + (size_t)(row0 + 1) * D, F.lane);
#ifdef DRY_NOROUTER
        if (dry) continue;
#endif
        LAS float* lg = (LAS float*)(F.lds + 36 * D * 4) + F.wave * 72;
#ifdef ROUTER_FULL
#pragma unroll 1
        for (int n = 0; n < 36; n += 3) { float sa[3], sb[3];
#pragma unroll
            for (int q = 0; q < 3; ++q) { sa[q] = 0.f; sb[q] = 0.f;
#pragma unroll
                for (int j = 0; j < 4; ++j) { const f32x4 w = *(const LAS f32x4*)(RT + (n + q) * D + 4 * F.lane + 256 * j);
                    sa[q] += (va[j][0] * w[0] + va[j][1] * w[1]) + (va[j][2] * w[2] + va[j][3] * w[3]);
                    sb[q] += (vb[j][0] * w[0] + vb[j][1] * w[1]) + (vb[j][2] * w[2] + vb[j][3] * w[3]); } }
#pragma unroll
            for (int q = 0; q < 3; ++q) { sa[q] = wave_sum(sa[q]); sb[q] = wave_sum(sb[q]); }
            if (F.lane == 0) {
#pragma unroll
                for (int q = 0; q < 3; ++q) { lg[n + q] = sa[q]; lg[36 + n + q] = sb[q]; } } }
#else
        int gia, gib;
        { float sa[4], sb[4];
#pragma unroll
          for (int q = 0; q < 4; ++q) { sa[q] = 0.f; sb[q] = 0.f;
#pragma unroll
              for (int j = 0; j < 4; ++j) { const f32x4 w = *(const LAS f32x4*)(RT + q * D + 4 * F.lane + 256 * j);
                  sa[q] += (va[j][0] * w[0] + va[j][1] * w[1]) + (va[j][2] * w[2] + va[j][3] * w[3]);
                  sb[q] += (vb[j][0] * w[0] + vb[j][1] * w[1]) + (vb[j][2] * w[2] + vb[j][3] * w[3]); } }
#pragma unroll
          for (int q = 0; q < 4; ++q) { sa[q] = wave_sum(sa[q]); sb[q] = wave_sum(sb[q]); }
          if (F.lane == 0) {
#pragma unroll
              for (int q = 0; q < 4; ++q) { lg[q] = sa[q]; lg[36 + q] = sb[q]; } }
          gia = 0; gib = 0; float ma = sa[0] + bg[0], mb = sb[0] + bg[0];
#pragma unroll
          for (int q = 1; q < 4; ++q) { const float xa = sa[q] + bg[q], xb = sb[q] + bg[q]; const bool ca = xa > ma, cb = xb > mb; ma = ca ? xa : ma; gia = ca ? q : gia; mb = cb ? xb : mb; gib = cb ? q : gib; }
          gia = __builtin_amdgcn_readfirstlane(gia); gib = __builtin_amdgcn_readfirstlane(gib); }
        { const LAS float* RA = RT + (4 + gia * EPG) * D + 4 * F.lane; const LAS float* RBp = RT + (4 + gib * EPG) * D + 4 * F.lane;
#pragma unroll 1
          for (int e0 = 0; e0 < EPG; e0 += 4) { float sa[4], sb[4];
#pragma unroll
              for (int q = 0; q < 4; ++q) { sa[q] = 0.f; sb[q] = 0.f;
#pragma unroll
                  for (int j = 0; j < 4; ++j) { const f32x4 wa = *(const LAS f32x4*)(RA + (e0 + q) * D + 256 * j), wb = *(const LAS f32x4*)(RBp + (e0 + q) * D + 256 * j);
                      sa[q] += (va[j][0] * wa[0] + va[j][1] * wa[1]) + (va[j][2] * wa[2] + va[j][3] * wa[3]);
                      sb[q] += (vb[j][0] * wb[0] + vb[j][1] * wb[1]) + (vb[j][2] * wb[2] + vb[j][3] * wb[3]); } }
#pragma unroll
              for (int q = 0; q < 4; ++q) { sa[q] = wave_sum(sa[q]); sb[q] = wave_sum(sb[q]); }
              if (F.lane == 0) {
#pragma unroll
                  for (int q = 0; q < 4; ++q) { lg[4 + gia * EPG + e0 + q] = sa[q]; lg[36 + 4 + gib * EPG + e0 + q] = sb[q]; } } } }
#endif
        LDS_WAIT();
#pragma unroll
        for (int rr = 0; rr < 2; ++rr) {
            float gl[4];
#pragma unroll
            for (int n = 0; n < 4; ++n) gl[n] = lg[36 * rr + n] + bg[n];
            int gi = 0; float gm = gl[0];
#pragma unroll
            for (int n = 1; n < 4; ++n) { const bool c = gl[n] > gm; gm = c ? gl[n] : gm; gi = c ? n : gi; }
            float se = 0.f;
#pragma unroll
            for (int n = 0; n < 4; ++n) se += expf(gl[n] - gm);
            const float pg = 1.f / se;
            float l1 = -3.0e38f, l2 = -3.0e38f; int i1 = 0, i2 = 0;
#pragma unroll
            for (int e = 0; e < 8; ++e) { const float v = lg[36 * rr + 4 + gi * EPG + e] + be[gi * EPG + e];
                const bool c1 = v > l1, c2 = v > l2;
                l2 = c1 ? l1 : (c2 ? v : l2); i2 = c1 ? i1 : (c2 ? e : i2); l1 = c1 ? v : l1; i1 = c1 ? e : i1; }
            const float e2 = expf(l2 - l1); const float w1 = pg / (1.f + e2), w2 = pg * e2 / (1.f + e2);
            if (F.lane == 0) {
                const int tok = row0 + rr, ea = gi * EPG + i1, eb = gi * EPG + i2;
                const unsigned pa = __hip_atomic_fetch_add(&cntl[ea], 1u, __ATOMIC_RELAXED, __HIP_MEMORY_SCOPE_WORKGROUP), pb = __hip_atomic_fetch_add(&cntl[eb], 1u, __ATOMIC_RELAXED, __HIP_MEMORY_SCOPE_WORKGROUP);
                TOKSLOT[tok * 2] = (ea << 14) | (int)pa; TOKSLOT[tok * 2 + 1] = (eb << 14) | (int)pb;
                TOKW[tok * 2] = w1; TOKW[tok * 2 + 1] = w2;
            }
        }
    }
    __syncthreads();
    if (F.tid < NE) BC[grp * NE + F.tid] = (int)cntl[F.tid];
    __syncthreads();
    }
}

DI void build_tables(const Frame& F, int l, LAS int* tb) {
    if (F.tid < 64) {
        const int e = F.lane; const int c = e < NE ? ((const int*)(F.ws + WS_CNTF))[e] : 0; const int tl = (c + 255) >> 8;
        int cum = c, tin = tl;
#pragma unroll
        for (int o = 1; o < 32; o <<= 1) { const int a1 = __shfl_up(cum, o), a2 = __shfl_up(tin, o); if (e >= o) { cum += a1; tin += a2; } }
        if (e < NE) { tb[e] = cum - c; tb[33 + e] = (tin - tl) * 256; for (int t2 = 0; t2 < tl; ++t2) tb[66 + (tin - tl) + t2] = e; }
        if (e == NE - 1) { tb[32] = cum; tb[65] = tin; }
    }
    __syncthreads();
}
DI void p_gather(const Frame& F, int l) {
    LAS int* base = (LAS int*)F.lds;
    LAS int* segt = base + NGRP * NE;
    LAS int* offp = segt + 16 * NE;
    const int* BC = (const int*)(F.ws + WS_BC);
    { int tmp[NGRP * NE / NTHREADS];
#pragma unroll
      for (int q = 0; q < NGRP * NE / NTHREADS; ++q) tmp[q] = BC[F.tid + q * NTHREADS];
#pragma unroll
      for (int q = 0; q < NGRP * NE / NTHREADS; ++q) base[F.tid + q * NTHREADS] = tmp[q]; }
    __syncthreads();
    { const int e = F.tid & 31, sg = F.tid >> 5; int run = 0;
      for (int g = 16 * sg; g < 16 * sg + 16; ++g) { const int c = base[g * NE + e]; base[g * NE + e] = run; run += c; }
      segt[sg * NE + e] = run; }
    __syncthreads();
    if (F.tid < NE) { int run = 0; for (int sg = 0; sg < 16; ++sg) { const int c = segt[sg * NE + F.tid]; segt[sg * NE + F.tid] = run; run += c; }
        offp[F.tid] = run;
        if (F.bx == 0) ((int*)(F.ws + WS_CNTF))[F.tid] = run; }
    __syncthreads();
    if (F.tid == 0) { int off = 0; for (int e = 0; e < NE; ++e) { const int c = offp[e]; offp[e] = off; off += ((c + 255) >> 8) * 256; } }
    __syncthreads();
    const int* TOKSLOT = (const int*)(F.ws + WS_TOKSLOT); const float* TOKW = (const float*)(F.ws + WS_TOKW); int* TOKFIN = (int*)(F.ws + WS_TOKFIN);
    float* SLOTW = (float*)(F.ws + WS_SLOTW);
    const int nas = (2 * T - F.gw + F.ngw - 1) / F.ngw;
    int my_slot = 0, my_tok = 0;
    if (F.lane < nas) { const int as = F.gw + F.lane * F.ngw; const int tok = as >> 1, ts = TOKSLOT[as], e = ts >> 14, grp = tok >> 6, sg = grp >> 4;
        my_slot = offp[e] + segt[sg * NE + e] + base[grp * NE + e] + (ts & 16383); my_tok = tok;
        SLOTW[my_slot] = TOKW[as]; TOKFIN[as] = my_slot; ((int*)(F.ws + WS_CTL + WS_SLOTTOK))[my_slot] = tok; }
}
#ifdef RESBF
struct Rp2In { u32x2 x[4]; u32x2 y0[4], y1[4]; };
DI void rp2_load(Rp2In& r, const float* XA, const bf16_t* YS, int row, int s0, int s1, int lane) {
    const bf16_t* XAb = (const bf16_t*)XA;
#pragma unroll
    for (int j = 0; j < 4; ++j) { const int col = 4 * lane + 256 * j;
        r.x[j] = *(const u32x2*)(XAb + (size_t)row * D + col); r.y0[j] = *(const u32x2*)(YS + (size_t)s0 * D + col); r.y1[j] = *(const u32x2*)(YS + (size_t)s1 * D + col); }
}
#define RP2_XV(p_) ((f32x4){bflo(p_.x), bfhi(p_.x), bflo(p_.y), bfhi(p_.y)})
#else
struct Rp2In { f32x4 x[4]; u32x2 y0[4], y1[4]; };
DI void rp2_load(Rp2In& r, const float* XA, const bf16_t* YS, int row, int s0, int s1, int lane) {
#pragma unroll
    for (int j = 0; j < 4; ++j) { const int col = 4 * lane + 256 * j;
        r.x[j] = *(const f32x4*)(XA + (size_t)row * D + col); r.y0[j] = *(const u32x2*)(YS + (size_t)s0 * D + col); r.y1[j] = *(const u32x2*)(YS + (size_t)s1 * D + col); }
}
#define RP2_XV(p_) (p_)
#endif
DI void p_rowpass2(const Frame& F, const Args& a, int l, float* xout) {
    const float* MOD = (const float*)(F.ws + WS_MOD);
    const float* XA = (const float*)(F.ws + WS_XA); const bf16_t* YS = (const bf16_t*)(F.ws + WS_YS); const int* TOKFIN = (const int*)(F.ws + WS_TOKFIN);
    const float* gain = a.in[22] + (size_t)l * D; const float* bias = a.in[23] + (size_t)l * D;
    bf16_t* U = (bf16_t*)(F.ws + WS_U);
    const int nrows = (T - F.gw + F.ngw - 1) / F.ngw;
    int tf = 0; { const int i = F.lane >> 1; if (i < nrows) tf = TOKFIN[(F.gw + i * F.ngw) * 2 + (F.lane & 1)]; }
    Rp2In cur, nxt;
    if (nrows > 0) rp2_load(cur, XA, YS, F.gw, __shfl(tf, 0), __shfl(tf, 1), F.lane);
    for (int i = 0; i < nrows; ++i) {
        const int row = F.gw + i * F.ngw;
        if (i + 1 < nrows) rp2_load(nxt, XA, YS, row + F.ngw, __shfl(tf, 2 * i + 2), __shfl(tf, 2 * i + 3), F.lane);
        const float* md = MOD + (size_t)(l * NB + row / S) * MODW;
        f32x4 v[4];
#pragma unroll
        for (int j = 0; j < 4; ++j) { const int col = 4 * F.lane + 256 * j;
            const f32x4 g = *(const f32x4*)(md + 5 * D + col);
            const u32x2 y0 = cur.y0[j], y1 = cur.y1[j];
            const f32x4 f = (f32x4){bflo(y0.x) + bflo(y1.x), bfhi(y0.x) + bfhi(y1.x), bflo(y0.y) + bflo(y1.y), bfhi(y0.y) + bfhi(y1.y)};
            v[j] = RP2_XV(cur.x[j]) * ALPHA + g * f; }
        float mean, rstd; row_ln(v, mean, rstd);
#pragma unroll
        for (int j = 0; j < 4; ++j) { const int col = 4 * F.lane + 256 * j; v[j] = v[j] * rstd * *(const f32x4*)(gain + col) + *(const f32x4*)(bias + col);
#ifdef TSTAMP
            if (l == L - 1) { const unsigned long long* st = (const unsigned long long*)(F.ws + WS_CTL + 40960); const float sc = 1.f + (float)(long long)(st[TS_B] - st[TS_A]) * 1e-5f; *(f32x4*)(xout + (size_t)row * D + col) = v[j] * sc; } else
#endif
#ifdef RESBF
            if (l + 1 < L) *(u32x2*)((bf16_t*)xout + (size_t)row * D + col) = (u32x2){cvtpk(v[j][0], v[j][1]), cvtpk(v[j][2], v[j][3])}; else
#endif
            *(f32x4*)(xout + (size_t)row * D + col) = v[j]; }
        if (l + 1 < L) row_mod_store(v, MOD + (size_t)((l + 1) * NB + row / S) * MODW, 0, D, U + (size_t)row * D, F.lane);
        if (i + 1 < nrows) {
#pragma unroll
            for (int j = 0; j < 4; ++j) { cur.x[j] = nxt.x[j]; cur.y0[j] = nxt.y0[j]; cur.y1[j] = nxt.y1[j]; } }
    }
}

#define MFMA16(a, b, c) __builtin_amdgcn_mfma_f32_16x16x32_bf16((a), (b), (c), 0, 0, 0)
#define MFMA32(a, b, c) __builtin_amdgcn_mfma_f32_32x32x16_bf16((a), (b), (c), 0, 0, 0)
constexpr int RB = 9216;
#define BUF(i) ((i) * RB)
constexpr int LWOFF = BUF(12), ZAOFF = BUF(0), SEGOFF = BUF(14), SEGXOFF = BUF(14) + 2048, TOTOFF = BUF(14) + 4096, NABFOFF = BUF(15), PCOFF = 16 * RB;
struct RwP { const float *conv, *w0, *w_up, *a0, *a_up, *g_up, *k_k, *k_a, *r_k, *gn_gain, *gn_bias; };

DI void lds_barrier() { asm volatile("s_waitcnt lgkmcnt(0)" ::: "memory"); __builtin_amdgcn_s_barrier(); asm volatile("" ::: "memory"); }
DI int swo(int row, int col) { return row * 144 + (((((col >> 3) ^ (row >> 3)) & 7) << 3) + (col & 7)) * 2; }
DI bf16x8 ldfrag(const LAS unsigned char* lds, int buf, int row, int ks, int lane) { return *(const LAS bf16x8*)(lds + buf + swo(row, 32 * ks + 8 * (lane >> 4))); }
DI f32x4 mm64(const LAS unsigned char* lds, int abuf, int arow0, int bbuf, int brow0, int lane) {
    f32x4 acc = (f32x4){0.f, 0.f, 0.f, 0.f};
#pragma unroll
    for (int ks = 0; ks < 2; ++ks) acc = MFMA16(ldfrag(lds, abuf, arow0 + (lane & 15), ks, lane), ldfrag(lds, bbuf, brow0 + (lane & 15), ks, lane), acc);
    return acc;
}
DI u32x2 pack4(const f32x4 v) { u32x2 w; w.x = cvtpk(v[0], v[1]); w.y = cvtpk(v[2], v[3]); return w; }
DI f32x4 unpack4(const u32x2 w) { return (f32x4){bflo(w.x), bfhi(w.x), bflo(w.y), bfhi(w.y)}; }
DI void st4(LAS unsigned char* lds, int buf, int row, int col, const f32x4 v) { *(LAS u32x2*)(lds + buf + swo(row, col)) = pack4(v); }
DI f32x4 ld4(const LAS unsigned char* lds, int buf, int row, int col) { return unpack4(*(const LAS u32x2*)(lds + buf + swo(row, col))); }
DI void st1(LAS unsigned char* lds, int buf, int row, int col, float v) { *(LAS bf16_t*)(lds + buf + swo(row, col)) = f2bf(v); }
DI float fast_tanh(float x) { const float e = fexp2(x * (2.f * LOG2E)); return 1.f - 2.f * frcp(1.f + e); }

#define OPQZ(z) int z; asm volatile("s_mov_b32 %0, 0" : "=s"(z))
constexpr int CWLOFF = PCOFF + 256;
constexpr int PRMOFF = CWLOFF + 6912;
struct RwPre { u32x2 wv, av; u32x4 gv; f32x4 w4, a4, g0, g1; u32x4 rr[3], kk[3], vv[3]; };
DI void rwkv_prefetch(const Frame& F, const Args& a, const int l, const int unit, RwPre& P) {
    const int tid = F.tid;
    const int c = unit % NCH, hd = (unit / NCH) % BH, b = (unit / (NCH * BH)) % NB, dir = unit / (NCH * BH * NB);
    const bf16_t* HBp = (const bf16_t*)(F.ws + WS_HB);
    const int u = tid >> 3, jg = tid & 7, tloc = 64 * c + u; const size_t tok = (size_t)b * S + tloc;
    const bf16_t* hrow = HBp + tok * HW;
    P.wv = *(const u32x2*)(hrow + HWL + 4 * jg); P.av = *(const u32x2*)(hrow + HAL + 4 * jg); P.gv = *(const u32x4*)(hrow + HGL + 8 * jg);
    OPQZ(z0);
    { const int m = tid >> 4, j4 = (tid & 15) * 4;
      const float* w_up = a.in[8 + z0] + (size_t)l * 2 * RW * BW; const float* a_up = a.in[10 + z0] + (size_t)l * 2 * RA * BW;
      P.w4 = *(const f32x4*)(w_up + (size_t)(dir * RW + m) * BW + hd * HD + j4); P.a4 = *(const f32x4*)(a_up + (size_t)(dir * RA + m) * BW + hd * HD + j4); }
    { const int m = tid >> 3, i8 = (tid & 7) * 8; const float* g_up = a.in[11 + z0] + (size_t)l * RG * BW;
      P.g0 = *(const f32x4*)(g_up + (size_t)m * BW + hd * HD + i8); P.g1 = *(const f32x4*)(g_up + (size_t)m * BW + hd * HD + i8 + 4); }
    const int ch0 = hd * HD + 8 * jg;
#pragma unroll
    for (int x = 0; x < 3; ++x) {
        const int tt = tloc + x - 1; const u32x4 z4 = (u32x4){0u, 0u, 0u, 0u};
        if (tt >= 0 && tt < S) { const bf16_t* hp = HBp + ((size_t)b * S + tt) * HW + HR + ch0; P.rr[x] = *(const u32x4*)hp; P.kk[x] = *(const u32x4*)(hp + BW); P.vv[x] = *(const u32x4*)(hp + 2 * BW); }
        else { P.rr[x] = z4; P.kk[x] = z4; P.vv[x] = z4; }
    }
}
DI void rwkv_local_unit(const Frame& F, const Args& a, const int l, const int unit, RwPre& PF, const int next_unit) {
    LAS unsigned char* lds = F.lds;
    int tid_ = F.tid; asm volatile("" : "+v"(tid_));
    const int tid = tid_, lane = tid_ & 63, wave = F.wave;
    const int c = unit % NCH, hd = (unit / NCH) % BH, b = (unit / (NCH * BH)) % NB, dir = unit / (NCH * BH * NB);
    const bf16_t* HBp = (const bf16_t*)(F.ws + WS_HB);
    const int u = tid >> 3, jg = tid & 7, tau = dir ? 63 - u : u, tloc = 64 * c + u;
    const size_t tok = (size_t)b * S + tloc;
    const int tn = wave & 3, tm0 = 2 * (wave >> 2), g4 = lane >> 4, l15 = lane & 15;
    if (tid < 320) { OPQZ(z2); const int which = tid >> 6, j = tid & 63;
      const float* src = which == 0 ? a.in[7 + z2] + (size_t)l * 2 * BW + dir * BW : which == 1 ? a.in[9 + z2] + (size_t)l * 2 * BW + dir * BW : which == 2 ? a.in[12 + z2] + (size_t)l * BW : which == 3 ? a.in[13 + z2] + (size_t)l * BW : a.in[14 + z2] + (size_t)l * BH * HD;
      *(LAS float*)(lds + PRMOFF + tid * 4) = src[hd * HD + j]; }
    {
        const f32x4 wf = unpack4(PF.wv);
        *(LAS u32x2*)(lds + BUF(8) + swo(tau, 4 * jg)) = pack4((f32x4){fast_tanh(wf[0]), fast_tanh(wf[1]), fast_tanh(wf[2]), fast_tanh(wf[3])});
        *(LAS u32x2*)(lds + BUF(8) + swo(tau, 32 + 4 * jg)) = PF.av;
        const u32x4 gv = PF.gv;
        u32x4 so; so.x = cvtpk(sigm(bflo(gv.x)), sigm(bfhi(gv.x))); so.y = cvtpk(sigm(bflo(gv.y)), sigm(bfhi(gv.y))); so.z = cvtpk(sigm(bflo(gv.z)), sigm(bfhi(gv.z))); so.w = cvtpk(sigm(bflo(gv.w)), sigm(bfhi(gv.w)));
        *(LAS u32x4*)(lds + BUF(9) + swo(tau, 8 * jg)) = so;
        { const int m = tid >> 4, j4 = (tid & 15) * 4;
#pragma unroll
          for (int e = 0; e < 4; ++e) { st1(lds, BUF(10), j4 + e, m, PF.w4[e]); st1(lds, BUF(10), j4 + e, 32 + m, PF.a4[e]); } }
        { const int m = tid >> 3, i8 = (tid & 7) * 8;
#pragma unroll
          for (int e = 0; e < 4; ++e) { st1(lds, BUF(11), i8 + e, m, PF.g0[e]); st1(lds, BUF(11), i8 + 4 + e, m, PF.g1[e]); } }
    }
    lds_barrier();
#pragma unroll
    for (int tmi = 0; tmi < 2; ++tmi) {
        const int tm = tm0 + tmi; const f32x4 z = (f32x4){0.f, 0.f, 0.f, 0.f};
        const f32x4 zw = MFMA16(ldfrag(lds, BUF(10), 16 * tm + l15, 0, lane), ldfrag(lds, BUF(8), 16 * tn + l15, 0, lane), z);
        const f32x4 za = MFMA16(ldfrag(lds, BUF(10), 16 * tm + l15, 1, lane), ldfrag(lds, BUF(8), 16 * tn + l15, 1, lane), z);
        const int trow = 16 * tn + l15, jb = 16 * tm + 4 * g4;
        *(LAS f32x4*)(lds + LWOFF + (trow * 64 + jb) * 4) = zw;
        *(LAS f32x4*)(lds + ZAOFF + (trow * 64 + jb) * 4) = za;
        if (dir == 0) {
            const f32x4 gg = mm64(lds, BUF(11), 16 * tm, BUF(9), 16 * tn, lane);
            *(u32x2*)((bf16_t*)(F.ws + WS_GB) + ((size_t)b * S + 64 * c + trow) * BW + hd * HD + jb) = pack4(gg);
        }
    }
    lds_barrier();
    const int ch0 = hd * HD + 8 * jg;
    float r[8], kd[8], kap[8], bb[8], lw[8];
    {
        float k[8], v[8];
#pragma unroll
        for (int e = 0; e < 8; ++e) { r[e] = 0.f; k[e] = 0.f; v[e] = 0.f; }
#pragma unroll
        for (int x = 0; x < 3; ++x) {
            const LAS unsigned char* cwp = lds + CWLOFF + (((hd * 3 + x) * 3) * 64 + 8 * jg) * 2;
            const u32x4 cr = *(const LAS u32x4*)cwp, ck = *(const LAS u32x4*)(cwp + 128), cv = *(const LAS u32x4*)(cwp + 256);
            const u32x4 rr = PF.rr[x], kk2 = PF.kk[x], vv = PF.vv[x];
            r[0] += bflo(rr.x) * bflo(cr.x); r[1] += bfhi(rr.x) * bfhi(cr.x); r[2] += bflo(rr.y) * bflo(cr.y); r[3] += bfhi(rr.y) * bfhi(cr.y);
            r[4] += bflo(rr.z) * bflo(cr.z); r[5] += bfhi(rr.z) * bfhi(cr.z); r[6] += bflo(rr.w) * bflo(cr.w); r[7] += bfhi(rr.w) * bfhi(cr.w);
            k[0] += bflo(kk2.x) * bflo(ck.x); k[1] += bfhi(kk2.x) * bfhi(ck.x); k[2] += bflo(kk2.y) * bflo(ck.y); k[3] += bfhi(kk2.y) * bfhi(ck.y);
            k[4] += bflo(kk2.z) * bflo(ck.z); k[5] += bfhi(kk2.z) * bfhi(ck.z); k[6] += bflo(kk2.w) * bflo(ck.w); k[7] += bfhi(kk2.w) * bfhi(ck.w);
            v[0] += bflo(vv.x) * bflo(cv.x); v[1] += bfhi(vv.x) * bfhi(cv.x); v[2] += bflo(vv.y) * bflo(cv.y); v[3] += bfhi(vv.y) * bfhi(cv.y);
            v[4] += bflo(vv.z) * bflo(cv.z); v[5] += bfhi(vv.z) * bfhi(cv.z); v[6] += bflo(vv.w) * bflo(cv.w); v[7] += bfhi(vv.w) * bfhi(cv.w);
        }
        const f32x4 zw0 = *(const LAS f32x4*)(lds + LWOFF + (tau * 64 + 8 * jg) * 4), zw1 = *(const LAS f32x4*)(lds + LWOFF + (tau * 64 + 8 * jg + 4) * 4);
        const f32x4 za0 = *(const LAS f32x4*)(lds + ZAOFF + (tau * 64 + 8 * jg) * 4), za1 = *(const LAS f32x4*)(lds + ZAOFF + (tau * 64 + 8 * jg + 4) * 4);
        float ss = 0.f, bsp = 0.f, av[8];
        const LAS f32x4* prm = (const LAS f32x4*)(lds + PRMOFF) + 2 * jg;
        const f32x4 w0a = prm[0], w0b = prm[1], a0a = prm[16], a0b = prm[17], kka = prm[32], kkb = prm[33], kaa = prm[48], kab = prm[49], rka = prm[64], rkb = prm[65];
#pragma unroll
        for (int e = 0; e < 8; ++e) {
            const float zw = (e < 4 ? zw0[e & 3] : zw1[e & 3]) + (e < 4 ? w0a[e & 3] : w0b[e & 3]);
            const float za = (e < 4 ? za0[e & 3] : za1[e & 3]) + (e < 4 ? a0a[e & 3] : a0b[e & 3]);
            lw[e] = (-DECAY * LOG2E) * sigm(zw); av[e] = sigm(za);
            kap[e] = k[e] * (e < 4 ? kka[e & 3] : kkb[e & 3]); ss += kap[e] * kap[e];
            kd[e] = k[e] * (1.f + (av[e] - 1.f) * (e < 4 ? kaa[e & 3] : kab[e & 3]));
            bsp += r[e] * kd[e] * (e < 4 ? rka[e & 3] : rkb[e & 3]);
        }
        ss += __shfl_xor(ss, 1); ss += __shfl_xor(ss, 2); ss += __shfl_xor(ss, 4);
        bsp += __shfl_xor(bsp, 1); bsp += __shfl_xor(bsp, 2); bsp += __shfl_xor(bsp, 4);
        const float rn = __builtin_amdgcn_rsqf(fmaxf(ss, 1e-24f));
#pragma unroll
        for (int e = 0; e < 8; ++e) { kap[e] *= rn; bb[e] = kap[e] * av[e]; }
        if (jg == 0) ((float*)(F.ws + WS_BS))[((size_t)dir * T + tok) * 8 + hd] = bsp;
        *(LAS f32x4*)(lds + LWOFF + (tau * 64 + 8 * jg) * 4) = (f32x4){lw[0], lw[1], lw[2], lw[3]};
        *(LAS f32x4*)(lds + LWOFF + (tau * 64 + 8 * jg + 4) * 4) = (f32x4){lw[4], lw[5], lw[6], lw[7]};
#pragma unroll
        for (int e = 0; e < 8; ++e) st1(lds, BUF(7), 8 * jg + e, tau, v[e]);
        if (dir == 0) {
            u32x4 vo; vo.x = cvtpk(v[0], v[1]); vo.y = cvtpk(v[2], v[3]); vo.z = cvtpk(v[4], v[5]); vo.w = cvtpk(v[6], v[7]);
            *(u32x4*)((bf16_t*)(F.ws + WS_VC) + tok * BW + ch0) = vo;
        }
    }
    lds_barrier();
    if (dir == 0) {
        const size_t ucidx = ((size_t)b * BH + hd) * NCH + c; const int vi = tid >> 3, vc = tid & 7;
        *(u32x4*)((bf16_t*)(F.ws + WS_VTB) + ucidx * 4096 + vi * 64 + vc * 8) = *(const LAS u32x4*)(lds + BUF(7) + swo(vi, 8 * vc));
    }
    { const int seg = tid >> 6, j = tid & 63; float p = 0.f;
#pragma unroll
      for (int i = 0; i < 8; ++i) { LAS float* q = (LAS float*)(lds + LWOFF + ((8 * seg + i) * 64 + j) * 4); p += *q; *q = p; }
      *(LAS float*)(lds + SEGOFF + (seg * 64 + j) * 4) = p; }
    lds_barrier();
    if (tid < 64) { float run = 0.f;
#pragma unroll
      for (int sg = 0; sg < 8; ++sg) { *(LAS float*)(lds + SEGXOFF + (sg * 64 + tid) * 4) = run; run += *(const LAS float*)(lds + SEGOFF + (sg * 64 + tid) * 4); }
      *(LAS float*)(lds + TOTOFF + tid * 4) = run; }
    lds_barrier();
    {
        float At[8], Rt[8], Bt[8], Kt[8], Bh[8], Kh[8], pcs[8];
#pragma unroll
        for (int e = 0; e < 8; ++e) {
            const int j = 8 * jg + e;
            const float lwi = *(const LAS float*)(lds + LWOFF + (tau * 64 + j) * 4) + *(const LAS float*)(lds + SEGXOFF + ((tau >> 3) * 64 + j) * 4);
            const float tot = *(const LAS float*)(lds + TOTOFF + j * 4);
            const float ep = fexp2(lwi - lw[e]), epl = fexp2(lwi), em = fexp2(-lwi), ec = fexp2(tot - lwi);
            At[e] = -kap[e] * ep; Rt[e] = r[e] * epl; Bt[e] = bb[e] * em; Kt[e] = kd[e] * em; Bh[e] = bb[e] * ec; Kh[e] = kd[e] * ec;
            pcs[e] = tot;
        }
        if (u == 0) {
            *(LAS f32x4*)(lds + PCOFF + (8 * jg) * 4) = (f32x4){fexp2(pcs[0]), fexp2(pcs[1]), fexp2(pcs[2]), fexp2(pcs[3])};
            *(LAS f32x4*)(lds + PCOFF + (8 * jg + 4) * 4) = (f32x4){fexp2(pcs[4]), fexp2(pcs[5]), fexp2(pcs[6]), fexp2(pcs[7])}; }
        u32x4 o;
#define PK8(X) (o.x = cvtpk(X[0], X[1]), o.y = cvtpk(X[2], X[3]), o.z = cvtpk(X[4], X[5]), o.w = cvtpk(X[6], X[7]), o)
        *(LAS u32x4*)(lds + BUF(0) + swo(tau, 8 * jg)) = PK8(At);
        *(LAS u32x4*)(lds + BUF(1) + swo(tau, 8 * jg)) = PK8(Bt);
        *(LAS u32x4*)(lds + BUF(2) + swo(tau, 8 * jg)) = PK8(Kt);
        *(LAS u32x4*)(lds + BUF(3) + swo(tau, 8 * jg)) = PK8(Rt);
#undef PK8
#pragma unroll
        for (int e = 0; e < 8; ++e) { const int j = 8 * jg + e; st1(lds, BUF(4), j, tau, At[e]); st1(lds, BUF(5), j, tau, Bh[e]); st1(lds, BUF(6), j, tau, Kh[e]); }
    }
    if (next_unit >= 0) rwkv_prefetch(F, a, l, next_unit, PF);
    lds_barrier();
#pragma unroll
    for (int tmi = 0; tmi < 2; ++tmi) {
        const int tm = tm0 + tmi, mb = 16 * tm + 4 * g4, nn = 16 * tn + l15;
        { f32x4 v = mm64(lds, BUF(1), 16 * tm, BUF(0), 16 * tn, lane);
#pragma unroll
          for (int e = 0; e < 4; ++e) v[e] = (mb + e < nn) ? v[e] : 0.f;
          if (tm == tn) {
#pragma unroll
              for (int e = 0; e < 4; ++e) *(LAS float*)(lds + NABFOFF + ((16 * tm + l15) * 16 + ((mb + e) & 15)) * 4) = v[e];
              v = (f32x4){0.f, 0.f, 0.f, 0.f};
          }
          st4(lds, BUF(11), nn, mb, v); }
        { f32x4 v = mm64(lds, BUF(0), 16 * tm, BUF(2), 16 * tn, lane);
#pragma unroll
          for (int e = 0; e < 4; ++e) v[e] = (nn < mb + e) ? v[e] : 0.f;
          st4(lds, BUF(8), nn, mb, v); }
        { f32x4 v = mm64(lds, BUF(1), 16 * tm, BUF(3), 16 * tn, lane);
#pragma unroll
          for (int e = 0; e < 4; ++e) v[e] = (mb + e <= nn) ? v[e] : 0.f;
          st4(lds, BUF(9), nn, mb, v); }
        { f32x4 v = mm64(lds, BUF(2), 16 * tm, BUF(3), 16 * tn, lane);
#pragma unroll
          for (int e = 0; e < 4; ++e) v[e] = (mb + e <= nn) ? v[e] : 0.f;
          st4(lds, BUF(10), nn, mb, v); }
    }
    lds_barrier();
    if (wave == 0) {
        const int blk = lane >> 4, sr = lane & 15, s = 16 * blk + sr;
        float Tr[16];
#pragma unroll
        for (int t = 0; t < 16; ++t) { float acc = (t == sr) ? 1.f : 0.f;
            const LAS f32x4* col = (const LAS f32x4*)(lds + NABFOFF + ((16 * blk + t) * 16) * 4);
#pragma unroll
            for (int q = 0; q < (t + 3) / 4; ++q) { const f32x4 nv = col[q];
#pragma unroll
                for (int e = 0; e < 4; ++e) if (4 * q + e < t) acc += Tr[4 * q + e] * nv[e]; }
            Tr[t] = acc; __builtin_amdgcn_sched_barrier(0); }
        const u32x4 z4 = (u32x4){0u, 0u, 0u, 0u};
#pragma unroll
        for (int q = 0; q < 9; ++q) { *(LAS u32x4*)(lds + BUF(0) + s * 144 + 16 * q) = z4; *(LAS u32x4*)(lds + BUF(1) + s * 144 + 16 * q) = z4; }
        u32x4 o0, o1; o0.x = cvtpk(Tr[0], Tr[1]); o0.y = cvtpk(Tr[2], Tr[3]); o0.z = cvtpk(Tr[4], Tr[5]); o0.w = cvtpk(Tr[6], Tr[7]);
        o1.x = cvtpk(Tr[8], Tr[9]); o1.y = cvtpk(Tr[10], Tr[11]); o1.z = cvtpk(Tr[12], Tr[13]); o1.w = cvtpk(Tr[14], Tr[15]);
        LDS_WAIT();
        *(LAS u32x4*)(lds + BUF(0) + swo(s, 16 * blk)) = o0; *(LAS u32x4*)(lds + BUF(0) + swo(s, 16 * blk + 8)) = o1;
#pragma unroll
        for (int t = 0; t < 16; ++t) st1(lds, BUF(1), 16 * blk + t, s, Tr[t]);
    }
    lds_barrier();
#pragma unroll
    for (int tmi = 0; tmi < 2; ++tmi) {
        const int tm = tm0 + tmi, mb = 16 * tm + 4 * g4, nn = 16 * tn + l15;
        const f32x4 v = mm64(lds, BUF(0), 16 * tm, BUF(11), 16 * tn, lane);
        st4(lds, BUF(12), nn, mb, v);
#pragma unroll
        for (int e = 0; e < 4; ++e) st1(lds, BUF(2), mb + e, nn, v[e]);
    }
    lds_barrier();
#pragma unroll
    for (int tmi = 0; tmi < 2; ++tmi) {
        const int tm = tm0 + tmi, mb = 16 * tm + 4 * g4, nn = 16 * tn + l15;
        const f32x4 v = mm64(lds, BUF(12), 16 * tm, BUF(2), 16 * tn, lane);
        st4(lds, BUF(13), nn, mb, v);
    }
    lds_barrier();
#pragma unroll
    for (int tmi = 0; tmi < 2; ++tmi) {
        const int tm = tm0 + tmi, mb = 16 * tm + 4 * g4, nn = 16 * tn + l15;
        const f32x4 v = mm64(lds, BUF(13), 16 * tm, BUF(1), 16 * tn, lane) + ld4(lds, BUF(1), nn, mb);
        st4(lds, BUF(14), nn, mb, v);
    }
    lds_barrier();
#pragma unroll
    for (int tmi = 0; tmi < 2; ++tmi) {
        const int tm = tm0 + tmi, mb = 16 * tm + 4 * g4, nn = 16 * tn + l15;
        const f32x4 v = mm64(lds, BUF(2), 16 * tm, BUF(14), 16 * tn, lane) + ld4(lds, BUF(14), nn, mb);
        st4(lds, BUF(15), nn, mb, v);
    }
    lds_barrier();
#pragma unroll
    for (int tmi = 0; tmi < 2; ++tmi) {
        const int tm = tm0 + tmi, mb = 16 * tm + 4 * g4, nn = 16 * tn + l15;
        const f32x4 x1 = mm64(lds, BUF(15), 16 * tm, BUF(4), 16 * tn, lane);
        const f32x4 x2 = mm64(lds, BUF(15), 16 * tm, BUF(8), 16 * tn, lane);
        st4(lds, BUF(0), nn, mb, x1); st4(lds, BUF(1), nn, mb, x2);
    }
    lds_barrier();
    {
        bf16_t* QT = (bf16_t*)(F.ws + WS_QT) + (size_t)unit * 4096; bf16_t* WT = (bf16_t*)(F.ws + WS_WT) + (size_t)unit * 4096; bf16_t* MP = (bf16_t*)(F.ws + WS_MP) + USK(unit) * 4096;
#pragma unroll
        for (int tmi = 0; tmi < 2; ++tmi) {
            const int tm = tm0 + tmi, mb = 16 * tm + 4 * g4, nn = 16 * tn + l15;
            { const f32x4 v = mm64(lds, BUF(0), 16 * tm, BUF(9), 16 * tn, lane) + ld4(lds, BUF(3), nn, mb);
              *(u32x2*)(QT + (dir ? 63 - nn : nn) * 64 + mb) = pack4(v); }
            { const f32x4 v = mm64(lds, BUF(1), 16 * tm, BUF(9), 16 * tn, lane) + ld4(lds, BUF(10), nn, mb);
              if (dir) *(u32x2*)(WT + (63 - nn) * 64 + (60 - mb)) = pack4((f32x4){v[3], v[2], v[1], v[0]});
              else *(u32x2*)(WT + nn * 64 + mb) = pack4(v); }
            { const float pcv = *(const volatile LAS float*)(lds + PCOFF + nn * 4);
              f32x4 v = mm64(lds, BUF(0), 16 * tm, BUF(5), 16 * tn, lane);
#pragma unroll
              for (int e = 0; e < 4; ++e) v[e] += (mb + e == nn) ? pcv : 0.f;
#ifdef MP_FRAG
              { const int c = swap23(mb);
                *(u32x2*)(MP + ((nn >> 5) * 4 + (c >> 4)) * 512 + ((nn & 31) + 32 * ((c >> 3) & 1)) * 8 + (c & 7)) = pack4(v); } }
#else
              *(u32x2*)(MP + nn * 64 + swap23(mb)) = pack4(v); }
#endif
            { const f32x4 v = mm64(lds, BUF(1), 16 * tm, BUF(5), 16 * tn, lane) + ld4(lds, BUF(6), nn, mb);
              st4(lds, BUF(2), nn, mb, v); }
        }
    }
    lds_barrier();
    {
        bf16_t* NBp = (bf16_t*)(F.ws + WS_NB);
#pragma unroll
        for (int tmi = 0; tmi < 2; ++tmi) {
            const int tm = tm0 + tmi, mb = 16 * tm + 4 * g4, ii = 16 * tn + l15;
            const f32x4 v = mm64(lds, BUF(2), 16 * tm, BUF(7), 16 * tn, lane);
            const int jb = mb >> 5, jl = mb & 31, q = jl >> 3, hic = (jl >> 2) & 1, ih = ii >> 5, Lc = (ii & 31) + 32 * hic;
            *(u32x2*)(NBp + (((USK(unit) * 2 + ih) * 2 + jb) * 2 + (q >> 1)) * 512 + Lc * 8 + 4 * (q & 1)) = pack4(v);
        }
    }
    lds_barrier();
}

#ifdef KV_TILED
#define ATT_KLD(ktok_, ds_) (*(const bf16x8*)(KTp + ((((size_t)hh * (T / 32) + ((ktok_) >> 5)) * 4 + (ds_)) * 32 + q32) * 16 + 8 * hi))
#define ATT_VLD(ktok_, db_, s_) (*(const bf16x8*)(VTp + ((((size_t)hh * (T / 32) + ((ktok_) >> 5)) * 4 + (db_) * 2 + (s_)) * 32 + q32) * 16 + 8 * hi))
#else
#define ATT_KLD(ktok_, ds_) (*(const bf16x8*)(HBp + ((ktok_) + krow_off) * HW + HK + hh * HD + 16 * (ds_) + 8 * hi))
#define ATT_VLD(ktok_, db_, s_) (*(const bf16x8*)(VTp + (size_t)(hh * HD + 32 * (db_) + q32) * T + (ktok_) + 16 * (s_) + 8 * hi))
#endif
DI void attn_unit(const Frame& F, const LAS float* rpbl, const int au, const int qsel = 0) {
    const bf16_t* HBp = (const bf16_t*)(F.ws + WS_HB); const bf16_t* VTp = (const bf16_t*)(F.ws + WS_VT); const bf16_t* KTp = (const bf16_t*)(F.ws + WS_KT); (void)KTp; bf16_t* CONCAT = (bf16_t*)(F.ws + WS_CONCAT);
    const int hh = au % AH, r = (au / AH) % ROWS, b = au / (AH * ROWS);
    int rstart = r - KH / 2; rstart = rstart < 0 ? 0 : (rstart > ROWS - KH ? ROWS - KH : rstart);
    const int lane = F.lane, q32 = lane & 31, hi = lane >> 5;
    const float SC = 0.125f * LOG2E;
    const int krow_off = swap23(q32);
    const int cqA = q32, cqB = 32 + q32;
    int csA = cqA - KW / 2; csA = csA < 0 ? 0 : csA; int csB = cqB - KW / 2; csB = csB > GW - KW ? GW - KW : csB;
    const size_t tokA = (size_t)b * S + r * GW + cqA, tokB = tokA + 32;
#ifdef ATT_FAST
    unsigned wmA0 = 0u, wmA1 = 0u, wmB0 = 0u, wmB1 = 0u;
#pragma unroll
    for (int i = 0; i < 16; ++i) { const int c0 = 16 * (i >> 3) + 8 * hi + (i & 7), c1 = c0 + 32;
        wmA0 |= ((c0 >= csA) && (c0 < csA + KW)) ? (1u << i) : 0u; wmA1 |= ((c1 >= csA) && (c1 < csA + KW)) ? (1u << i) : 0u;
        wmB0 |= ((c0 >= csB) && (c0 < csB + KW)) ? (1u << i) : 0u; wmB1 |= ((c1 >= csB) && (c1 < csB + KW)) ? (1u << i) : 0u; }
#endif
    bf16x8 qfA[4], qfB[4];
#pragma unroll
    for (int ds = 0; ds < 4; ++ds) { qfA[ds] = *(const bf16x8*)(HBp + tokA * HW + HQ + hh * HD + 16 * ds + 8 * hi); qfB[ds] = *(const bf16x8*)(HBp + tokB * HW + HQ + hh * HD + 16 * ds + 8 * hi); }
    f32x16 oA0, oA1, oB0, oB1;
#pragma unroll
    for (int i = 0; i < 16; ++i) { oA0[i] = 0.f; oA1[i] = 0.f; oB0[i] = 0.f; oB1[i] = 0.f; }
    float mA = -1e30f, lA = 0.f, mB = -1e30f, lB = 0.f;
#ifdef ATT_PF
    bf16x8 kf[4], kfn[4];
    { const size_t ktok = (size_t)b * S + rstart * GW;
#pragma unroll
      for (int ds = 0; ds < 4; ++ds) kf[ds] = ATT_KLD(ktok, ds); }
    __builtin_amdgcn_s_waitcnt(0x0F70);
#endif
#pragma unroll 1
    for (int kt = 0; kt < 2 * KH; ++kt) {
        const int kr = rstart + (kt >> 1), ckb = 32 * (kt & 1);
        const size_t ktok = (size_t)b * S + kr * GW + ckb;
#ifdef ATT_PF
        { const int ktn = kt + 1 < 2 * KH ? kt + 1 : kt; const size_t ktokn = (size_t)b * S + (rstart + (ktn >> 1)) * GW + 32 * (ktn & 1);
#pragma unroll
          for (int ds = 0; ds < 4; ++ds) kfn[ds] = ATT_KLD(ktokn, ds); }
        bf16x8 vf[2][2];
#pragma unroll
        for (int db = 0; db < 2; ++db)
#pragma unroll
            for (int s = 0; s < 2; ++s) vf[db][s] = ATT_VLD(ktok, db, s);
#else
        bf16x8 kf[4], vf[2][2];
#pragma unroll
        for (int ds = 0; ds < 4; ++ds) kf[ds] = ATT_KLD(ktok, ds);
#pragma unroll
        for (int db = 0; db < 2; ++db)
#pragma unroll
            for (int s = 0; s < 2; ++s) vf[db][s] = ATT_VLD(ktok, db, s);
#endif
        const LAS float* rp = rpbl + (hh * (2 * KH - 1) + (kr - r + KH - 1)) * (2 * KW - 1);
#pragma unroll
        for (int qb = 0; qb < 2; ++qb) {
            if (qsel == 2 - qb) continue;
            const int cq = qb ? cqB : cqA, cs = qb ? csB : csA;
            f32x16 st;
#pragma unroll
            for (int i = 0; i < 16; ++i) st[i] = 0.f;
#pragma unroll
            for (int ds = 0; ds < 4; ++ds) st = MFMA32(kf[ds], qb ? qfB[ds] : qfA[ds], st);
            float sl[16]; float tmax = -1e30f;
            float bia[16];
#ifdef ATT_FAST
            { const LAS float* rb = rp + (ckb + 8 * hi - cq + KW - 1);
#pragma unroll
              for (int i = 0; i < 16; ++i) bia[i] = *(const volatile LAS float*)(rb + 16 * (i >> 3) + (i & 7)); }
            const unsigned wm = qb ? (ckb ? wmB1 : wmB0) : (ckb ? wmA1 : wmA0);
#pragma unroll
            for (int i = 0; i < 16; ++i) {
                const float sv = st[i] * SC + bia[i];
                sl[i] = ((wm >> i) & 1u) ? sv : -3e38f;
                tmax = fmaxf(tmax, sl[i]);
            }
            tmax = fmaxf(tmax, __shfl_xor(tmax, 32));
            const float mrun = qb ? mB : mA;
            const float mn = fmaxf(mrun, tmax), corr = __builtin_amdgcn_exp2f(mrun - mn);
            float ps = 0.f;
#pragma unroll
            for (int i = 0; i < 16; ++i) { sl[i] = __builtin_amdgcn_exp2f(sl[i] - mn); ps += sl[i]; }
#else
#pragma unroll
            for (int i = 0; i < 16; ++i) {
                const int ck = ckb + 16 * (i >> 3) + 8 * hi + (i & 7);
                int dc = ck - cq; dc = dc < -(KW - 1) ? -(KW - 1) : (dc > KW - 1 ? KW - 1 : dc); dc += KW - 1;
                bia[i] = *(const volatile LAS float*)(rp + dc);
            }
#pragma unroll
            for (int i = 0; i < 16; ++i) {
                const int ck = ckb + 16 * (i >> 3) + 8 * hi + (i & 7);
                const bool inw = (ck >= cs) && (ck < cs + KW);
                const float sv = st[i] * SC + bia[i];
                sl[i] = inw ? sv : -1e30f;
                tmax = fmaxf(tmax, sl[i]);
            }
            tmax = fmaxf(tmax, __shfl_xor(tmax, 32));
            const float mrun = qb ? mB : mA;
            const float mn = fmaxf(mrun, tmax), corr = __builtin_amdgcn_exp2f(mrun - mn);
            float ps = 0.f;
#pragma unroll
            for (int i = 0; i < 16; ++i) { sl[i] = (sl[i] > -1e29f) ? __builtin_amdgcn_exp2f(sl[i] - mn) : 0.f; ps += sl[i]; }
#endif
            u32x4 p0, p1;
            p0.x = cvtpk(sl[0], sl[1]); p0.y = cvtpk(sl[2], sl[3]); p0.z = cvtpk(sl[4], sl[5]); p0.w = cvtpk(sl[6], sl[7]);
            p1.x = cvtpk(sl[8], sl[9]); p1.y = cvtpk(sl[10], sl[11]); p1.z = cvtpk(sl[12], sl[13]); p1.w = cvtpk(sl[14], sl[15]);
            const bf16x8 pf0 = __builtin_bit_cast(bf16x8, p0), pf1 = __builtin_bit_cast(bf16x8, p1);
            if (qb == 0) { lA = lA * corr + ps; mA = mn;
#pragma unroll
                for (int i = 0; i < 16; ++i) { oA0[i] *= corr; oA1[i] *= corr; }
                oA0 = MFMA32(vf[0][0], pf0, oA0); oA0 = MFMA32(vf[0][1], pf1, oA0); oA1 = MFMA32(vf[1][0], pf0, oA1); oA1 = MFMA32(vf[1][1], pf1, oA1);
            } else { lB = lB * corr + ps; mB = mn;
#pragma unroll
                for (int i = 0; i < 16; ++i) { oB0[i] *= corr; oB1[i] *= corr; }
                oB0 = MFMA32(vf[0][0], pf0, oB0); oB0 = MFMA32(vf[0][1], pf1, oB0); oB1 = MFMA32(vf[1][0], pf0, oB1); oB1 = MFMA32(vf[1][1], pf1, oB1);
            }
        }
#ifdef ATT_PF
#pragma unroll
        for (int ds = 0; ds < 4; ++ds) kf[ds] = kfn[ds];
#endif
    }
    if (qsel != 2) { const float inv = 1.f / (lA + __shfl_xor(lA, 32)); bf16_t* op = CONCAT + tokA * D + hh * HD;
#pragma unroll
      for (int g = 0; g < 4; ++g) {
          *(u32x2*)(op + 8 * g + 4 * hi) = pack4((f32x4){oA0[4 * g] * inv, oA0[4 * g + 1] * inv, oA0[4 * g + 2] * inv, oA0[4 * g + 3] * inv});
          *(u32x2*)(op + 32 + 8 * g + 4 * hi) = pack4((f32x4){oA1[4 * g] * inv, oA1[4 * g + 1] * inv, oA1[4 * g + 2] * inv, oA1[4 * g + 3] * inv}); } }
    if (qsel != 1) { const float inv = 1.f / (lB + __shfl_xor(lB, 32)); bf16_t* op = CONCAT + tokB * D + hh * HD;
#pragma unroll
      for (int g = 0; g < 4; ++g) {
          *(u32x2*)(op + 8 * g + 4 * hi) = pack4((f32x4){oB0[4 * g] * inv, oB0[4 * g + 1] * inv, oB0[4 * g + 2] * inv, oB0[4 * g + 3] * inv});
          *(u32x2*)(op + 32 + 8 * g + 4 * hi) = pack4((f32x4){oB1[4 * g] * inv, oB1[4 * g + 1] * inv, oB1[4 * g + 2] * inv, oB1[4 * g + 3] * inv}); } }
}

DI void pool_unit(const Frame& F, const float* pool_w, const float* pool_scale, const int pu) {
    const bf16_t* HBp = (const bf16_t*)(F.ws + WS_HB); bf16_t* CONCAT = (bf16_t*)(F.ws + WS_CONCAT);
    const int g = pu & 3, blk = pu >> 2, b = blk >> 8, t0 = (blk & 255) * 32;
    const int lane = F.lane, q32 = lane & 31, hi = lane >> 5, t = t0 + q32, win = 2 << g;
    int lo = t - win / 2; lo = lo < 0 ? 0 : lo; int hit = t + win / 2 - 1; hit = hit > S - 1 ? S - 1 : hit;
    const float inv = 1.f / (float)(hit - lo + 1);
    f32x16 out0, out1;
#pragma unroll
    for (int i = 0; i < 16; ++i) { out0[i] = 0.f; out1[i] = 0.f; }
    const float* pw = pool_w + (size_t)g * 64 * 64;
#pragma unroll 1
    for (int s = 0; s < 4; ++s) {
        const int c0 = HP + g * 64 + 16 * s + 8 * hi;
        float acc[8];
#pragma unroll
        for (int e = 0; e < 8; ++e) acc[e] = 0.f;
        u32x4 pv[16];
#pragma unroll
        for (int d = 0; d < 16; ++d) { int tt = t - win / 2 + d; const bool ok = d < win && tt >= 0 && tt < S; tt = ok ? tt : t;
            pv[d] = *(const u32x4*)(HBp + ((size_t)b * S + tt) * HW + c0); if (!ok) pv[d] = (u32x4){0u, 0u, 0u, 0u}; }
#pragma unroll
        for (int d = 0; d < 16; ++d) {
            acc[0] += bflo(pv[d].x); acc[1] += bfhi(pv[d].x); acc[2] += bflo(pv[d].y); acc[3] += bfhi(pv[d].y); acc[4] += bflo(pv[d].z); acc[5] += bfhi(pv[d].z); acc[6] += bflo(pv[d].w); acc[7] += bfhi(pv[d].w);
        }
        const u32x4 pc = *(const u32x4*)(HBp + ((size_t)b * S + t) * HW + c0);
        u32x4 o;
        o.x = cvtpk(acc[0] * inv - bflo(pc.x), acc[1] * inv - bfhi(pc.x)); o.y = cvtpk(acc[2] * inv - bflo(pc.y), acc[3] * inv - bfhi(pc.y));
        o.z = cvtpk(acc[4] * inv - bflo(pc.z), acc[5] * inv - bfhi(pc.z)); o.w = cvtpk(acc[6] * inv - bflo(pc.w), acc[7] * inv - bfhi(pc.w));
        const bf16x8 bfr = __builtin_bit_cast(bf16x8, o);
        const float* wp = pw + (size_t)(16 * s + 8 * hi) * 64 + q32;
        u32x4 w0; w0.x = cvtpk(wp[0], wp[64]); w0.y = cvtpk(wp[128], wp[192]); w0.z = cvtpk(wp[256], wp[320]); w0.w = cvtpk(wp[384], wp[448]);
        u32x4 w1; w1.x = cvtpk(wp[32], wp[96]); w1.y = cvtpk(wp[160], wp[224]); w1.z = cvtpk(wp[288], wp[352]); w1.w = cvtpk(wp[416], wp[480]);
        out0 = MFMA32(__builtin_bit_cast(bf16x8, w0), bfr, out0);
        out1 = MFMA32(__builtin_bit_cast(bf16x8, w1), bfr, out1);
    }
    bf16_t* op = CONCAT + ((size_t)b * S + t) * D + AW + BW + g * 64;
    const float* ps = pool_scale + g * 64;
#pragma unroll
    for (int gq = 0; gq < 4; ++gq) {
        const int e0 = 8 * gq + 4 * hi;
        const f32x4 s0 = *(const f32x4*)(ps + e0), s1 = *(const f32x4*)(ps + 32 + e0);
        *(u32x2*)(op + e0) = pack4((f32x4){out0[4 * gq] * s0[0], out0[4 * gq + 1] * s0[1], out0[4 * gq + 2] * s0[2], out0[4 * gq + 3] * s0[3]});
        *(u32x2*)(op + 32 + e0) = pack4((f32x4){out1[4 * gq] * s1[0], out1[4 * gq + 1] * s1[1], out1[4 * gq + 2] * s1[2], out1[4 * gq + 3] * s1[3]});
    }
}

#ifndef SCAN_RING_N
#define SCAN_RING_N 12
#endif
#ifndef NSTG
#define NSTG 2
#endif
#ifndef NWR
#define NWR 1
#endif
constexpr int SCAN_SLOT = 12288, SCAN_RING = SCAN_RING_N;
constexpr int SCAN_FLAGS = SCAN_RING * SCAN_SLOT;
DI void scan_issue(const Frame& F, const int sc, const int ihalf, const int dir, const int step, const int lane) {
    const int c = dir ? NCH - 1 - step : step; const size_t unit = (size_t)sc * NCH + c;
    const int il = lane & 31, hi = lane >> 5;
    LAS unsigned char* slot = F.lds + (step % SCAN_RING) * SCAN_SLOT;
    const bf16_t* MP = (const bf16_t*)(F.ws + WS_MP) + USK(unit) * 4096; const bf16_t* NBp = (const bf16_t*)(F.ws + WS_NB) + (USK(unit) * 2 + ihalf) * 2048;
#pragma unroll
    for (int p = 0; p < 8; ++p) { const int jpb = p >> 2, jb = (p >> 1) & 1, s = p & 1;
#ifdef MP_FRAG
        (void)jpb; (void)jb; (void)s;
        __builtin_amdgcn_global_load_lds((const unsigned*)(MP + p * 512 + lane * 8), (LAS unsigned*)(slot + p * 1024), 16, 0, 0); }
#else
        __builtin_amdgcn_global_load_lds((const unsigned*)(MP + (32 * jpb + il) * 64 + 32 * jb + 16 * s + 8 * hi), (LAS unsigned*)(slot + p * 1024), 16, 0, 0); }
#endif
#pragma unroll
    for (int p = 0; p < 4; ++p)
        __builtin_amdgcn_global_load_lds((const unsigned*)(NBp + p * 512 + lane * 8), (LAS unsigned*)(slot + 8192 + p * 1024), 16, 0, 0);
}
DI unsigned lds_ld_u32(const volatile LAS unsigned* p) { return __builtin_amdgcn_readfirstlane(*p); }
#ifndef NLD
#define NLD 2
#endif
constexpr int SC_INFL = NLD == 2 ? 5 : (NLD == 3 ? 4 : 3);
DI void scan_loader(const Frame& F, const int sw, const int ld) {
    const int ihalf = sw & 1, sc = sw >> 1, dir = sc / (NB * BH);
    volatile LAS unsigned* ready = (volatile LAS unsigned*)(F.lds + SCAN_FLAGS); volatile LAS unsigned* cons = ready + 16;
    const int nmine = (NCH - ld + NLD - 1) / NLD;
    constexpr int LAG = SC_INFL - 1;
    for (int k = 0; k < nmine + LAG; ++k) {
        if (k < nmine) {
            const int s = NLD * k + ld;
            if (s >= SCAN_RING) { unsigned spins = 0; while ((int)lds_ld_u32(cons) < s - SCAN_RING + 1) { __builtin_amdgcn_s_sleep(1); if (++spins > (1u << 22)) break; } }
            asm volatile("" ::: "memory");
            scan_issue(F, sc, ihalf, dir, s, F.lane);
        }
        if (k >= LAG) {
            const int kd = k - LAG;
            if (kd < nmine) {
                const int rem = nmine - 1 - kd;
                const int out = rem < LAG ? rem : LAG;
                if (out == 4) asm volatile("s_waitcnt vmcnt(48)" ::: "memory");
                else if (out == 3) asm volatile("s_waitcnt vmcnt(36)" ::: "memory");
                else if (out == 2) asm volatile("s_waitcnt vmcnt(24)" ::: "memory");
                else if (out == 1) asm volatile("s_waitcnt vmcnt(12)" ::: "memory");
                else asm volatile("s_waitcnt vmcnt(0)" ::: "memory");
                const int sd = NLD * kd + ld;
                if (F.lane == 0) ready[sd % SCAN_RING] = (unsigned)(sd + 1);
                asm volatile("s_waitcnt lgkmcnt(0)" ::: "memory");
            }
        }
    }
}
constexpr int S0_STAGE = SCAN_FLAGS + 256;
DI void scan_writer(const Frame& F, const int sw, const int wi = 0) {
    const int ihalf = sw & 1, sc = sw >> 1, dir = sc / (NB * BH);
    volatile LAS unsigned* ready = (volatile LAS unsigned*)(F.lds + SCAN_FLAGS);
    volatile LAS unsigned* s0rdy = ready + 17; volatile LAS unsigned* s0done = ready + 18 + wi;
    bf16_t* S0 = (bf16_t*)(F.ws + WS_S0);
    const int lane = F.lane;
#pragma unroll 1
    for (int step = wi; step < NCH; step += NWR) {
        const int c = dir ? NCH - 1 - step : step; const size_t unit = (size_t)sc * NCH + c;
        { unsigned spins = 0; while ((int)lds_ld_u32(s0rdy) < step + 1) { __builtin_amdgcn_s_sleep(1); if (++spins > (1u << 22)) break; } }
        asm volatile("" ::: "memory");
        const LAS unsigned char* sl = F.lds + S0_STAGE + (step % NSTG) * (32 * 144);
        u32x4 v[4];
#pragma unroll
        for (int p = 0; p < 4; ++p) { const int idx = p * 64 + lane; v[p] = *(const LAS u32x4*)(sl + (idx >> 3) * 144 + (idx & 7) * 16); }
        asm volatile("s_waitcnt lgkmcnt(0)" ::: "memory");
        if (lane == 0) *s0done = (unsigned)(step + 1);
        bf16_t* dst = S0 + USK(unit) * 4096 + ihalf * 2048;
#pragma unroll
        for (int p = 0; p < 4; ++p) *(u32x4*)(dst + (p * 64 + lane) * 8) = v[p];
#ifdef DBL_WST
#pragma unroll
        for (int p = 0; p < 4; ++p) *(u32x4*)(dst + (size_t)16 * 1024 * 1024 + (p * 64 + lane) * 8) = v[p];
#endif
    }
}
#ifdef SCAN_U2
#define SCAN_STEP(MA, NBV, MAN, NBN, STEP) do { \
        const int step_ = (STEP); const bool more_ = step_ + 1 < NCH; \
        { const int needd = step_ - NSTG + 1; const unsigned wantr = (unsigned)(step_ + 2); \
          volatile LAS unsigned* pr_ = ready + ((step_ + 1) % SCAN_RING); volatile LAS unsigned* pd_ = s0done + ((step_ >= NSTG ? step_ - NSTG : 0) % NWR); unsigned spins_ = 0; \
          for (;;) { unsigned r_ = *pr_, d_ = *pd_; r_ = __builtin_amdgcn_readfirstlane(r_); d_ = __builtin_amdgcn_readfirstlane(d_); \
              if ((!more_ || r_ == wantr) && (step_ < NSTG || (int)d_ >= needd)) break; __builtin_amdgcn_s_sleep(1); if (++spins_ > (1u << 22)) break; } } \
        asm volatile("" ::: "memory"); \
        if (more_) { const LAS unsigned char* slot_ = F.lds + ((step_ + 1) % SCAN_RING) * SCAN_SLOT; \
            _Pragma("unroll") for (int p = 0; p < 8; ++p) MAN[p] = *(const LAS bf16x8*)(slot_ + p * 1024 + lane * 16); \
            _Pragma("unroll") for (int p = 0; p < 4; ++p) NBN[p] = *(const LAS u32x4*)(slot_ + 8192 + p * 1024 + lane * 16); } \
        u32x4 b00, b01, b10, b11; \
        b00.x = cvtpk(st0[0], st0[1]); b00.y = cvtpk(st0[2], st0[3]); b00.z = cvtpk(st0[4], st0[5]); b00.w = cvtpk(st0[6], st0[7]); \
        b01.x = cvtpk(st0[8], st0[9]); b01.y = cvtpk(st0[10], st0[11]); b01.z = cvtpk(st0[12], st0[13]); b01.w = cvtpk(st0[14], st0[15]); \
        b10.x = cvtpk(st1[0], st1[1]); b10.y = cvtpk(st1[2], st1[3]); b10.z = cvtpk(st1[4], st1[5]); b10.w = cvtpk(st1[6], st1[7]); \
        b11.x = cvtpk(st1[8], st1[9]); b11.y = cvtpk(st1[10], st1[11]); b11.z = cvtpk(st1[12], st1[13]); b11.w = cvtpk(st1[14], st1[15]); \
        { LAS unsigned char* sl_ = F.lds + S0_STAGE + (step_ % NSTG) * (32 * 144) + il * 144 + 8 * hi; \
          *(LAS u32x2*)(sl_ + 0) = (u32x2){b00.x, b00.y};  *(LAS u32x2*)(sl_ + 16) = (u32x2){b00.z, b00.w}; \
          *(LAS u32x2*)(sl_ + 32) = (u32x2){b01.x, b01.y}; *(LAS u32x2*)(sl_ + 48) = (u32x2){b01.z, b01.w}; \
          *(LAS u32x2*)(sl_ + 64) = (u32x2){b10.x, b10.y}; *(LAS u32x2*)(sl_ + 80) = (u32x2){b10.z, b10.w}; \
          *(LAS u32x2*)(sl_ + 96) = (u32x2){b11.x, b11.y}; *(LAS u32x2*)(sl_ + 112) = (u32x2){b11.z, b11.w}; \
          asm volatile("" ::: "memory"); \
          if (lane == 0) *s0rdy = (unsigned)(step_ + 1); } \
        const bf16x8 p00 = __builtin_bit_cast(bf16x8, b00), p01 = __builtin_bit_cast(bf16x8, b01), p10 = __builtin_bit_cast(bf16x8, b10), p11 = __builtin_bit_cast(bf16x8, b11); \
        f32x16 n0, n1; \
        _Pragma("unroll") for (int h2 = 0; h2 < 2; ++h2) { \
            n0[8 * h2 + 0] = bflo(NBV[h2].x); n0[8 * h2 + 1] = bfhi(NBV[h2].x); n0[8 * h2 + 2] = bflo(NBV[h2].y); n0[8 * h2 + 3] = bfhi(NBV[h2].y); \
            n0[8 * h2 + 4] = bflo(NBV[h2].z); n0[8 * h2 + 5] = bfhi(NBV[h2].z); n0[8 * h2 + 6] = bflo(NBV[h2].w); n0[8 * h2 + 7] = bfhi(NBV[h2].w); \
            n1[8 * h2 + 0] = bflo(NBV[2 + h2].x); n1[8 * h2 + 1] = bfhi(NBV[2 + h2].x); n1[8 * h2 + 2] = bflo(NBV[2 + h2].y); n1[8 * h2 + 3] = bfhi(NBV[2 + h2].y); \
            n1[8 * h2 + 4] = bflo(NBV[2 + h2].z); n1[8 * h2 + 5] = bfhi(NBV[2 + h2].z); n1[8 * h2 + 6] = bflo(NBV[2 + h2].w); n1[8 * h2 + 7] = bfhi(NBV[2 + h2].w); } \
        n0 = MFMA32(MA[0], p00, n0); n1 = MFMA32(MA[4], p00, n1); \
        n0 = MFMA32(MA[1], p01, n0); n1 = MFMA32(MA[5], p01, n1); \
        n0 = MFMA32(MA[2], p10, n0); n1 = MFMA32(MA[6], p10, n1); \
        n0 = MFMA32(MA[3], p11, n0); n1 = MFMA32(MA[7], p11, n1); \
        st0 = n0; st1 = n1; \
        if (more_) { asm volatile("s_waitcnt lgkmcnt(0)" ::: "memory"); if (lane == 0) *cons = (unsigned)(step_ + 2); } \
    } while (0)
DI void scan_wave(const Frame& F, const int sw) {
    const int lane = F.lane, il = lane & 31, hi = lane >> 5; (void)sw;
    volatile LAS unsigned* ready = (volatile LAS unsigned*)(F.lds + SCAN_FLAGS); volatile LAS unsigned* cons = ready + 16;
    volatile LAS unsigned* s0rdy = ready + 17; volatile LAS unsigned* s0done = ready + 18;
    f32x16 st0, st1;
#pragma unroll
    for (int i = 0; i < 16; ++i) { st0[i] = 0.f; st1[i] = 0.f; }
    bf16x8 ma[8], man[8]; u32x4 nbv[4], nbn[4];
    { unsigned spins = 0; while (lds_ld_u32(ready) != 1u) { __builtin_amdgcn_s_sleep(1); if (++spins > (1u << 22)) break; } }
    asm volatile("" ::: "memory");
#pragma unroll
    for (int p = 0; p < 8; ++p) ma[p] = *(const LAS bf16x8*)(F.lds + p * 1024 + lane * 16);
#pragma unroll
    for (int p = 0; p < 4; ++p) nbv[p] = *(const LAS u32x4*)(F.lds + 8192 + p * 1024 + lane * 16);
#pragma unroll 1
    for (int step = 0; step < NCH; step += 2) {
        SCAN_STEP(ma, nbv, man, nbn, step);
        SCAN_STEP(man, nbn, ma, nbv, step + 1);
    }
}
#undef SCAN_STEP
#else
DI void scan_wave(const Frame& F, const int sw) {
    const int ihalf = sw & 1, sc = sw >> 1, dir = sc / (NB * BH);
    const int lane = F.lane, il = lane & 31, hi = lane >> 5;
    bf16_t* S0 = (bf16_t*)(F.ws + WS_S0);
    volatile LAS unsigned* ready = (volatile LAS unsigned*)(F.lds + SCAN_FLAGS); volatile LAS unsigned* cons = ready + 16;
    volatile LAS unsigned* s0rdy = ready + 17; volatile LAS unsigned* s0done = ready + 18; (void)s0rdy; (void)s0done;
    f32x16 st0, st1;
#pragma unroll
    for (int i = 0; i < 16; ++i) { st0[i] = 0.f; st1[i] = 0.f; }
    bf16x8 ma[8], man[8]; u32x4 nbv[4], nbn[4];
    { unsigned spins = 0; while (lds_ld_u32(ready) != 1u) { __builtin_amdgcn_s_sleep(1); if (++spins > (1u << 22)) break; } }
    asm volatile("" ::: "memory");
#pragma unroll
    for (int p = 0; p < 8; ++p) ma[p] = *(const LAS bf16x8*)(F.lds + p * 1024 + lane * 16);
#pragma unroll
    for (int p = 0; p < 4; ++p) nbv[p] = *(const LAS u32x4*)(F.lds + 8192 + p * 1024 + lane * 16);
#pragma unroll 1
    for (int step = 0; step < NCH; ++step) {
        const int c = dir ? NCH - 1 - step : step; const size_t unit = (size_t)sc * NCH + c;
        const bool more = step + 1 < NCH;
#ifdef S0_WRITER
        if (step >= NSTG) { unsigned spins = 0; while ((int)lds_ld_u32(s0done + ((step - NSTG) % NWR)) < step - NSTG + 1) { __builtin_amdgcn_s_sleep(1); if (++spins > (1u << 22)) break; } }
        asm volatile("" ::: "memory");
#endif
        if (more) {
            { unsigned spins = 0; while (lds_ld_u32(ready + ((step + 1) % SCAN_RING)) != (unsigned)(step + 2)) { __builtin_amdgcn_s_sleep(1); if (++spins > (1u << 22)) break; } }
            asm volatile("" ::: "memory");

            const LAS unsigned char* slot = F.lds + ((step + 1) % SCAN_RING) * SCAN_SLOT;
#pragma unroll
            for (int p = 0; p < 8; ++p) man[p] = *(const LAS bf16x8*)(slot + p * 1024 + lane * 16);
#pragma unroll
            for (int p = 0; p < 4; ++p) nbn[p] = *(const LAS u32x4*)(slot + 8192 + p * 1024 + lane * 16);
        }
        bf16_t* sp = S0 + USK(unit) * 4096 + (size_t)(32 * ihalf + il) * 64;
        u32x4 b00, b01, b10, b11;
        b00.x = cvtpk(st0[0], st0[1]); b00.y = cvtpk(st0[2], st0[3]); b00.z = cvtpk(st0[4], st0[5]); b00.w = cvtpk(st0[6], st0[7]);
        b01.x = cvtpk(st0[8], st0[9]); b01.y = cvtpk(st0[10], st0[11]); b01.z = cvtpk(st0[12], st0[13]); b01.w = cvtpk(st0[14], st0[15]);
        b10.x = cvtpk(st1[0], st1[1]); b10.y = cvtpk(st1[2], st1[3]); b10.z = cvtpk(st1[4], st1[5]); b10.w = cvtpk(st1[6], st1[7]);
        b11.x = cvtpk(st1[8], st1[9]); b11.y = cvtpk(st1[10], st1[11]); b11.z = cvtpk(st1[12], st1[13]); b11.w = cvtpk(st1[14], st1[15]);
#ifdef S0_WRITER
        { LAS unsigned char* sl = F.lds + S0_STAGE + (step % NSTG) * (32 * 144) + il * 144 + 8 * hi;
          {
          *(LAS u32x2*)(sl + 0) = (u32x2){b00.x, b00.y};  *(LAS u32x2*)(sl + 16) = (u32x2){b00.z, b00.w};
          *(LAS u32x2*)(sl + 32) = (u32x2){b01.x, b01.y}; *(LAS u32x2*)(sl + 48) = (u32x2){b01.z, b01.w};
          *(LAS u32x2*)(sl + 64) = (u32x2){b10.x, b10.y}; *(LAS u32x2*)(sl + 80) = (u32x2){b10.z, b10.w};
          *(LAS u32x2*)(sl + 96) = (u32x2){b11.x, b11.y}; *(LAS u32x2*)(sl + 112) = (u32x2){b11.z, b11.w}; }
          asm volatile("" ::: "memory");
          if (lane == 0) *s0rdy = (unsigned)(step + 1); }
        (void)sp;
#else
        *(u32x2*)(sp + 0 + 4 * hi) = (u32x2){b00.x, b00.y};  *(u32x2*)(sp + 8 + 4 * hi) = (u32x2){b00.z, b00.w};
        *(u32x2*)(sp + 16 + 4 * hi) = (u32x2){b01.x, b01.y}; *(u32x2*)(sp + 24 + 4 * hi) = (u32x2){b01.z, b01.w};
        *(u32x2*)(sp + 32 + 4 * hi) = (u32x2){b10.x, b10.y}; *(u32x2*)(sp + 40 + 4 * hi) = (u32x2){b10.z, b10.w};
        *(u32x2*)(sp + 48 + 4 * hi) = (u32x2){b11.x, b11.y}; *(u32x2*)(sp + 56 + 4 * hi) = (u32x2){b11.z, b11.w};
#endif
        const bf16x8 p00 = __builtin_bit_cast(bf16x8, b00), p01 = __builtin_bit_cast(bf16x8, b01), p10 = __builtin_bit_cast(bf16x8, b10), p11 = __builtin_bit_cast(bf16x8, b11);
        f32x16 n0, n1;
#pragma unroll
        for (int h2 = 0; h2 < 2; ++h2) {
            n0[8 * h2 + 0] = bflo(nbv[h2].x); n0[8 * h2 + 1] = bfhi(nbv[h2].x); n0[8 * h2 + 2] = bflo(nbv[h2].y); n0[8 * h2 + 3] = bfhi(nbv[h2].y);
            n0[8 * h2 + 4] = bflo(nbv[h2].z); n0[8 * h2 + 5] = bfhi(nbv[h2].z); n0[8 * h2 + 6] = bflo(nbv[h2].w); n0[8 * h2 + 7] = bfhi(nbv[h2].w);
            n1[8 * h2 + 0] = bflo(nbv[2 + h2].x); n1[8 * h2 + 1] = bfhi(nbv[2 + h2].x); n1[8 * h2 + 2] = bflo(nbv[2 + h2].y); n1[8 * h2 + 3] = bfhi(nbv[2 + h2].y);
            n1[8 * h2 + 4] = bflo(nbv[2 + h2].z); n1[8 * h2 + 5] = bfhi(nbv[2 + h2].z); n1[8 * h2 + 6] = bflo(nbv[2 + h2].w); n1[8 * h2 + 7] = bfhi(nbv[2 + h2].w);
        }
        n0 = MFMA32(ma[0], p00, n0); n1 = MFMA32(ma[4], p00, n1);
        n0 = MFMA32(ma[1], p01, n0); n1 = MFMA32(ma[5], p01, n1);
        n0 = MFMA32(ma[2], p10, n0); n1 = MFMA32(ma[6], p10, n1);
        n0 = MFMA32(ma[3], p11, n0); n1 = MFMA32(ma[7], p11, n1);
        st0 = n0; st1 = n1;
        if (more) {
            asm volatile("s_waitcnt lgkmcnt(0)" ::: "memory");
            if (lane == 0) *cons = (unsigned)(step + 2);
#pragma unroll
            for (int p = 0; p < 8; ++p) ma[p] = man[p];
#pragma unroll
            for (int p = 0; p < 4; ++p) nbv[p] = nbn[p];
        }
    }
}

#endif
DI void rwkv_out_unit(const Frame& F, const RwP& P, const int du) {
    const int qd = du & 3, cidx = du >> 2, c = cidx % NCH, hd = (cidx / NCH) % BH, b = cidx / (NCH * BH);
    const int lane = F.lane, n = lane & 15, g = lane >> 4, u = 16 * qd + n;
    const bf16_t* QT = (const bf16_t*)(F.ws + WS_QT); const bf16_t* WT = (const bf16_t*)(F.ws + WS_WT); const bf16_t* S0 = (const bf16_t*)(F.ws + WS_S0);
    const bf16_t* VTB = (const bf16_t*)(F.ws + WS_VTB) + (size_t)cidx * 4096;
    f32x4 acc[4];
#pragma unroll
    for (int tm = 0; tm < 4; ++tm) acc[tm] = (f32x4){0.f, 0.f, 0.f, 0.f};
#pragma unroll
    for (int dir = 0; dir < 2; ++dir) {
        const size_t unit = (((size_t)dir * NB + b) * BH + hd) * NCH + c;
#pragma unroll
        for (int ks = 0; ks < 2; ++ks) {
            const bf16x8 bq = *(const bf16x8*)(QT + unit * 4096 + u * 64 + 32 * ks + 8 * g);
            const bf16x8 bw = *(const bf16x8*)(WT + unit * 4096 + u * 64 + 32 * ks + 8 * g);
#pragma unroll
            for (int tm = 0; tm < 4; ++tm) {
                const bf16x8 as = *(const bf16x8*)(S0 + USK(unit) * 4096 + (16 * tm + n) * 64 + 32 * ks + 8 * g);
                const bf16x8 av = *(const bf16x8*)(VTB + (16 * tm + n) * 64 + 32 * ks + 8 * g);
                acc[tm] = MFMA16(as, bq, acc[tm]); acc[tm] = MFMA16(av, bw, acc[tm]);
            }
        }
    }
    float s = 0.f;
#pragma unroll
    for (int tm = 0; tm < 4; ++tm) s += (acc[tm][0] + acc[tm][1]) + (acc[tm][2] + acc[tm][3]);
    s += __shfl_xor(s, 16); s += __shfl_xor(s, 32);
    const float mu = s * (1.f / HD); float q = 0.f;
#pragma unroll
    for (int tm = 0; tm < 4; ++tm) { acc[tm] = acc[tm] - mu; q += (acc[tm][0] * acc[tm][0] + acc[tm][1] * acc[tm][1]) + (acc[tm][2] * acc[tm][2] + acc[tm][3] * acc[tm][3]); }
    q += __shfl_xor(q, 16); q += __shfl_xor(q, 32);
    const float rstd = 1.f / sqrtf(q * (1.f / HD) + GN_EPS);
    const size_t tok = (size_t)b * S + 64 * c + u;
    const float* BS = (const float*)(F.ws + WS_BS);
    const float bsum = BS[tok * 8 + hd] + BS[((size_t)T + tok) * 8 + hd];
    const bf16_t* VC = (const bf16_t*)(F.ws + WS_VC) + tok * BW + hd * HD; const bf16_t* GBp = (const bf16_t*)(F.ws + WS_GB) + tok * BW + hd * HD;
    bf16_t* op = (bf16_t*)(F.ws + WS_CONCAT) + tok * D + AW + hd * HD;
#pragma unroll
    for (int tm = 0; tm < 4; ++tm) {
        const int i0 = 16 * tm + 4 * g;
        const f32x4 vv = unpack4(*(const u32x2*)(VC + i0)), gg = unpack4(*(const u32x2*)(GBp + i0));
        const f32x4 gn = *(const f32x4*)(P.gn_gain + hd * HD + i0), gb = *(const f32x4*)(P.gn_bias + hd * HD + i0);
        *(u32x2*)(op + i0) = pack4((acc[tm] * rstd * gn + gb + vv * bsum) * gg);
    }
}

DI RwP make_rwp(const Args& a, int l) {
    RwP p;
    p.conv = a.in[6] + (size_t)l * 3 * 3 * BW; p.w0 = a.in[7] + (size_t)l * 2 * BW; p.w_up = a.in[8] + (size_t)l * 2 * RW * BW;
    p.a0 = a.in[9] + (size_t)l * 2 * BW; p.a_up = a.in[10] + (size_t)l * 2 * RA * BW; p.g_up = a.in[11] + (size_t)l * RG * BW;
    p.k_k = a.in[12] + (size_t)l * BW; p.k_a = a.in[13] + (size_t)l * BW; p.r_k = a.in[14] + (size_t)l * BH * HD;
    p.gn_gain = a.in[15] + (size_t)l * BW; p.gn_bias = a.in[16] + (size_t)l * BW;
    return p;
}
DI void conv_moe(const Frame& F, const Args& a, int l, int first, int stride, const int IT_END = IT_MOE) {
    LAS float* scr = (LAS float*)F.lds + F.wave * (64 * 65);
#ifdef CONV3
    f32x4 b0[16], b1[16], b2[16]; TItem t0{}, t1{}, t2{};
    int it = first;
    if (it < IT_MOE) { t0 = moe_item(F, a.in[28], a.in[29], a.in[30], l, it); titem_load(t0, b0, F.lane); }
    if (it + stride < IT_MOE) { t1 = moe_item(F, a.in[28], a.in[29], a.in[30], l, it + stride); titem_load(t1, b1, F.lane); }
    for (; it < IT_MOE; it += 3 * stride) {
        if (it + 2 * stride < IT_MOE) { t2 = moe_item(F, a.in[28], a.in[29], a.in[30], l, it + 2 * stride); titem_load(t2, b2, F.lane); }
        titem_store(t0, b0, scr, F.lane);
        if (it + stride >= IT_MOE) break;
        if (it + 3 * stride < IT_MOE) { t0 = moe_item(F, a.in[28], a.in[29], a.in[30], l, it + 3 * stride); titem_load(t0, b0, F.lane); }
        titem_store(t1, b1, scr, F.lane);
        if (it + 2 * stride >= IT_MOE) break;
        if (it + 4 * stride < IT_MOE) { t1 = moe_item(F, a.in[28], a.in[29], a.in[30], l, it + 4 * stride); titem_load(t1, b1, F.lane); }
        titem_store(t2, b2, scr, F.lane);
    }
#else
    f32x4 cur[16], nxt[16]; int it = first; TItem tc{}, tn{};
    if (it < IT_END) { tc = moe_item(F, a.in[28], a.in[29], a.in[30], l, it); titem_load(tc, cur, F.lane); }
    CONV_PREWAIT();
    for (; it < IT_END; it += stride) {
        const bool more = it + stride < IT_END;
        if (more) { tn = moe_item(F, a.in[28], a.in[29], a.in[30], l, it + stride); titem_load(tn, nxt, F.lane); }
        titem_store(tc, cur, scr, F.lane);
        if (more) { tc = tn;
#pragma unroll
            for (int i = 0; i < 16; ++i) cur[i] = nxt[i]; }
    }
#endif
}
#ifndef NG1
#define NG1 21
#endif
#ifndef N1
#define N1 3360
#endif
DI void p_gemm1(const Frame& F, const Args& a, int l) {
#ifdef CONV_G1
    if (F.G == 256) {
        if (F.bx >= 256 - NG1) { conv_moe(F, a, l, (F.bx - (256 - NG1)) * NWAVES + F.wave, NG1 * NWAVES, N1); return; }
        pg8::Gemm1Order S; S.U = (const bf16_t*)(F.ws + WS_U); S.Win = (const bf16_t*)(F.ws + WS_WIN + (size_t)l * WIN_LAYER); S.Wv = S.Win + (size_t)HW * D; S.G = 256 - NG1; S.c = F.bx;
        #ifdef KV_TILED
        pg8::EpiGemm1 E{(bf16_t*)(F.ws + WS_HB), HW, (bf16_t*)(F.ws + WS_KT), (bf16_t*)(F.ws + WS_VT)};
#else
        pg8::EpiStore E{(bf16_t*)(F.ws + WS_HB), HW, (bf16_t*)(F.ws + WS_VT), T};
#endif
        pg8::gemm_phase(F.lds, F.tid, D, S, E);
        return;
    }
#endif
    pg8::Gemm1Order S; S.U = (const bf16_t*)(F.ws + WS_U); S.Win = (const bf16_t*)(F.ws + WS_WIN + (size_t)l * WIN_LAYER); S.Wv = S.Win + (size_t)HW * D; S.G = F.G; S.c = F.bx;
    #ifdef KV_TILED
        pg8::EpiGemm1 E{(bf16_t*)(F.ws + WS_HB), HW, (bf16_t*)(F.ws + WS_KT), (bf16_t*)(F.ws + WS_VT)};
#else
        pg8::EpiStore E{(bf16_t*)(F.ws + WS_HB), HW, (bf16_t*)(F.ws + WS_VT), T};
#endif
    pg8::gemm_phase(F.lds, F.tid, D, S, E);
}
#ifndef NCB
#define NCB 16
#endif
DI void p_mixer_local(const Frame& F, const Args& a, int l) {
#ifdef CONV_IN_B
    const int GR = F.G - NCB;
    if (F.bx >= GR) { conv_moe(F, a, l, (F.bx - GR) * NWAVES + F.wave, NCB * NWAVES); return; }
    { const float* conv = a.in[6] + (size_t)l * 3 * 3 * BW;
#pragma unroll 7
      for (int i = F.tid; i < BH * 9 * 64; i += NTHREADS) { const int j = i & 63, q = i >> 6, which = q % 3, x = (q / 3) % 3, hd = q / 9;
          *(LAS bf16_t*)(F.lds + CWLOFF + i * 2) = f2bf(conv[x * 3 * BW + which * BW + hd * HD + j]); }
      RwPre PF;
      if (F.bx < NUNIT) rwkv_prefetch(F, a, l, F.bx, PF);
      __syncthreads();
      for (int unit = F.bx; unit < NUNIT; unit += GR) rwkv_local_unit(F, a, l, unit, PF, unit + GR < NUNIT ? unit + GR : -1);
      return;
    }
#endif
    {
      const float* conv = a.in[6] + (size_t)l * 3 * 3 * BW;
#pragma unroll 7
      for (int i = F.tid; i < BH * 9 * 64; i += NTHREADS) { const int j = i & 63, q = i >> 6, which = q % 3, x = (q / 3) % 3, hd = q / 9;
          *(LAS bf16_t*)(F.lds + CWLOFF + i * 2) = f2bf(conv[x * 3 * BW + which * BW + hd * HD + j]); }
      RwPre PF;
      if (F.bx < NUNIT) rwkv_prefetch(F, a, l, F.bx, PF);
      __syncthreads();
      for (int unit = F.bx; unit < NUNIT; unit += F.G) rwkv_local_unit(F, a, l, unit, PF, unit + F.G < NUNIT ? unit + F.G : -1);
    }
}
DI void p_scan(const Frame& F, const Args& a, int l, const int rr = 0) {
#ifndef CVW
#define CVW 3
#endif
    constexpr int NSCAN = 2 * 2 * NB * BH;
    const int NATTW = (F.G - NSCAN) * (NWAVES - CVW);
    if (F.bx < NSCAN) {
        if (rr & 4) return;
        volatile LAS unsigned* fl = (volatile LAS unsigned*)(F.lds + SCAN_FLAGS);
        if (F.tid < 32) fl[F.tid] = 0u;
        __syncthreads();
#ifdef S0_WRITER
        if (F.wave == 0) scan_wave(F, F.bx); else if (F.wave <= NLD) scan_loader(F, F.bx, F.wave - 1); else if (F.wave <= NLD + NWR) scan_writer(F, F.bx, F.wave - NLD - 1);
#else
        if (F.wave == 0) scan_wave(F, F.bx); else if (F.wave <= NLD) scan_loader(F, F.bx, F.wave - 1);
#endif
#ifdef DBL_SCAN
        __syncthreads();
        if (F.tid < 32) fl[F.tid] = 0u;
        __syncthreads();
        if (F.wave == 0) scan_wave(F, F.bx); else if (F.wave <= NLD) scan_loader(F, F.bx, F.wave - 1);
#endif
        return;
    }
#ifdef SERIAL_C
    {
        LAS float* rpbl8 = (LAS float*)(F.lds + NWAVES * 64 * 65 * 4);
        { const float* rpb = a.in[5] + (size_t)l * AH * (2 * KH - 1) * (2 * KW - 1);
#pragma unroll 6
          for (int i = F.tid; i < AH * (2 * KH - 1) * (2 * KW - 1); i += NTHREADS) rpbl8[i] = rpb[i] * LOG2E; }
        __syncthreads();
        const int aw8 = (F.bx - NSCAN) * NWAVES + F.wave, naw8 = (F.G - NSCAN) * NWAVES;
        if (F.G == 256) {
            constexpr int UPX = NB * ROWS * AH / 8;
            const int x = F.bx & 7, k = (F.bx - NSCAN) >> 3, j = k * NWAVES + F.wave;
            if (j < UPX) { const int v = (x & 3) * UPX + j; attn_unit(F, rpbl8, (((x >> 2) * ROWS) + (v & (ROWS - 1))) * AH + (v >> 7)); }
        } else
            for (int au = aw8; au < NB * ROWS * AH; au += naw8) attn_unit(F, rpbl8, au);
        for (int pu = aw8; pu < NB * (S / 32) * 4; pu += naw8) pool_unit(F, a.in[17] + (size_t)l * NG * 64 * 64, a.in[18] + (size_t)l * CW, pu);
#ifdef CONV_IN_B
        return;
#endif
        LAS float* scr = (LAS float*)F.lds + F.wave * (64 * 65);
        f32x4 cur[16], nxt[16]; const int st = naw8; int it = aw8; TItem tc{}, tn{};
#ifdef DBL_CONV
        for (int rep = 0; rep < 2; ++rep) { it = aw8;
#endif
        if (it < IT_MOE) { tc = moe_item(F, a.in[28], a.in[29], a.in[30], l, it); titem_load(tc, cur, F.lane); }
        for (; it < IT_MOE; it += st) {
            const bool more = it + st < IT_MOE;
            if (more) { tn = moe_item(F, a.in[28], a.in[29], a.in[30], l, it + st); titem_load(tn, nxt, F.lane); }
            titem_store(tc, cur, scr, F.lane);
            if (more) { tc = tn;
#pragma unroll
                for (int i = 0; i < 16; ++i) cur[i] = nxt[i]; }
        }
#ifdef DBL_CONV
        }
#endif
        return;
    }
#endif
    LAS float* rpbl = (LAS float*)(F.lds + CVW * 64 * 65 * 4);
    { const float* rpb = a.in[5] + (size_t)l * AH * (2 * KH - 1) * (2 * KW - 1);
#pragma unroll 6
      for (int i = F.tid; i < AH * (2 * KH - 1) * (2 * KW - 1); i += NTHREADS) rpbl[i] = rpb[i] * LOG2E; }
    __syncthreads();
    if (F.wave < CVW) {
        if (rr & 1) return;
        LAS float* scr = (LAS float*)F.lds + F.wave * (64 * 65);
#ifdef CONV_G1
        const int it0 = F.G == 256 ? N1 : 0;
#else
        const int it0 = 0;
#endif
        f32x4 cur[16], nxt[16]; const int st = (F.G - NSCAN) * CVW; int it = it0 + (F.bx - NSCAN) * CVW + F.wave; TItem tc{}, tn{};
#ifndef CONV_PAIR
        if (it < IT_MOE) { tc = moe_item(F, a.in[28], a.in[29], a.in[30], l, it); titem_load(tc, cur, F.lane); }
        CONV_PREWAIT();
#endif
#ifdef DBL_CONV
        for (int rep = 0; rep < 2; ++rep) { it = (F.bx - NSCAN) * CVW + F.wave; if (it < IT_MOE) { tc = moe_item(F, a.in[28], a.in[29], a.in[30], l, it); titem_load(tc, cur, F.lane); }
#endif
#ifdef CONV_PAIR
        for (int pr = it; pr < IT_MOE / 2; pr += st) {
            tc = moe_item(F, a.in[28], a.in[29], a.in[30], l, 2 * pr); tn = moe_item(F, a.in[28], a.in[29], a.in[30], l, 2 * pr + 1);
#pragma unroll
            for (int i = 0; i < 16; ++i) { cur[i] = *(const f32x4*)(tc.src + (size_t)(4 * i + (F.lane >> 4)) * tc.ldw + 4 * (F.lane & 15)); nxt[i] = *(const f32x4*)(tn.src + (size_t)(4 * i + (F.lane >> 4)) * tn.ldw + 4 * (F.lane & 15)); }
            titem_store(tc, cur, scr, F.lane); titem_store(tn, nxt, scr, F.lane);
        }
        it = IT_MOE;
#endif
        for (; it < IT_MOE; it += st) {
            const bool more = it + st < IT_MOE;
#ifdef CONV_SINGLE
            titem_store(tc, cur, scr, F.lane);
            if (more) { tc = moe_item(F, a.in[28], a.in[29], a.in[30], l, it + st); titem_load(tc, cur, F.lane); }
            continue;
#endif
            if (more) { tn = moe_item(F, a.in[28], a.in[29], a.in[30], l, it + st); titem_load(tn, nxt, F.lane); }
            titem_store(tc, cur, scr, F.lane);
            if (more) { tc = tn;
#pragma unroll
                for (int i = 0; i < 16; ++i) cur[i] = nxt[i]; }
        }
#ifdef DBL_CONV
        }
#endif
    } else {
        if (rr & 2) return;
        const int aw = (F.bx - NSCAN) * (NWAVES - CVW) + (F.wave - CVW), naw = NATTW;
#ifdef ATT_XCD
        if (F.G == 256) {
            constexpr int NW5 = NWAVES - CVW, NBX = (256 - NSCAN) / 8, NWX = NBX * NW5, UPX = NB * ROWS * AH / 8, REM = UPX - NWX, PER = (REM + NBX - 1) / NBX;
            const int x = F.bx & 7, k = (F.bx - NSCAN) >> 3, w5 = F.wave - CVW;
            { const int v = (x & 3) * UPX + k * NW5 + w5; attn_unit(F, rpbl, (((x >> 2) * ROWS) + (v & (ROWS - 1))) * AH + (v >> 7)); }
#ifdef ATT_HALF
            { const int hu = k * NW5 + w5;
              if (hu < 2 * REM) { const int v = (x & 3) * UPX + NWX + (hu >> 1); attn_unit(F, rpbl, (((x >> 2) * ROWS) + (v & (ROWS - 1))) * AH + (v >> 7), 1 + (hu & 1)); } }
            (void)PER;
#else
            if (w5 < PER && k * PER + w5 < REM) { const int v = (x & 3) * UPX + NWX + k * PER + w5; attn_unit(F, rpbl, (((x >> 2) * ROWS) + (v & (ROWS - 1))) * AH + (v >> 7)); }
#endif
        } else
#endif
        for (int au = aw; au < NB * ROWS * AH; au += naw) attn_unit(F, rpbl, au);
#ifdef DBL_ATTN
        for (int au = aw; au < NB * ROWS * AH; au += naw) attn_unit(F, rpbl, au);
#endif
        for (int pu = aw; pu < NB * (S / 32) * 4; pu += naw) pool_unit(F, a.in[17] + (size_t)l * NG * 64 * 64, a.in[18] + (size_t)l * CW, pu);
    }
}
DI void p_rwkv_out(const Frame& F, const Args& a, int l) {
    const RwP P = make_rwp(a, l);
    for (int du = F.gw; du < NB * BH * NCH * 4; du += F.ngw) rwkv_out_unit(F, P, du);
}
DI void p_gemm2(const Frame& F, int l) {
    pg8::PlainOrder S; S.init((const bf16_t*)(F.ws + WS_CONCAT), (const bf16_t*)(F.ws + WS_WOUT) + (size_t)l * D * D, T, D, D, F.G, F.bx);
    pg8::EpiStore E{(bf16_t*)(F.ws + WS_MIX), D, nullptr, 0};
    pg8::gemm_phase(F.lds, F.tid, D, S, E);
}
DI void p_gemm2k(const Frame& F, int Kx) {
    pg8::PlainOrder S; S.init((const bf16_t*)(F.ws + WS_CONCAT), (const bf16_t*)(F.ws + WS_WOUT), T, D, Kx, F.G, F.bx);
    pg8::EpiStore E{(bf16_t*)(F.ws + WS_MIX), D, nullptr, 0};
    pg8::gemm_phase(F.lds, F.tid, Kx, S, E);
}
DI void p_moe_a(const Frame& F, int l) {
    LAS int* tb = (LAS int*)(F.lds + LDS_MISC);
    build_tables(F, l, tb);
    pg8::GroupedOrderT<true> S; S.rowtok = (const int*)(F.ws + WS_CTL + WS_SLOTTOK); S.A = (const bf16_t*)(F.ws + WS_U); S.Bt = (const bf16_t*)(F.ws + WS_WGU); S.K = D; S.estride = (size_t)D * D; S.tile_e = tb + 66; S.ntiles = tb[65]; S.nwg = S.ntiles * 4; S.G = F.G; S.c = F.bx;
#ifdef FUSE_MOE
    S.flags = (unsigned*)(F.ws + WS_CTL) + CW_MFL + l * 256;
#endif
    pg8::EpiSwiGlu E{(bf16_t*)(F.ws + WS_HM)};
    pg8::gemm_phase(F.lds, F.tid, D, S, E);
}
DI void p_moe_b(const Frame& F, int l) {
    LAS int* tb = (LAS int*)(F.lds + LDS_MISC);
    build_tables(F, l, tb);
#ifdef FUSE_MOE
    pg8::GroupedOrderB S; S.flags = (unsigned*)(F.ws + WS_CTL) + CW_MFL + l * 256;
#else
    pg8::GroupedOrderT<false> S;
#endif
    S.rowtok = nullptr; S.A = (const bf16_t*)(F.ws + WS_HM); S.Bt = (const bf16_t*)(F.ws + WS_WD); S.K = DE; S.estride = (size_t)D * DE; S.tile_e = tb + 66; S.ntiles = tb[65]; S.nwg = S.ntiles * 4; S.G = F.G; S.c = F.bx;
    pg8::EpiRowScale E{(bf16_t*)(F.ws + WS_YS), (const float*)(F.ws + WS_SLOTW)};
    pg8::gemm_phase(F.lds, F.tid, DE, S, E);
}

#ifndef DBLMASK
#define DBLMASK 0
#endif
constexpr int PH_PER_LAYER = 10, N_PHASES = 2 + L * PH_PER_LAYER;
DI bool in_ph(int k, int lo, int hi) { lo = __builtin_amdgcn_readfirstlane(lo); hi = __builtin_amdgcn_readfirstlane(hi); asm volatile("" : "+s"(lo), "+s"(hi)); return lo <= k && k < hi; }
DI Frame fresh(const Frame& F0) {
    Frame F = F0; int t = F0.tid, b = F0.bx;
    b = __builtin_amdgcn_readfirstlane(b); asm volatile("" : "+v"(t)); asm volatile("" : "+s"(b));
    F.tid = t; F.lane = t & 63; F.wave = __builtin_amdgcn_readfirstlane(t >> 6); F.bx = b;
    F.vcu = (F.G % 8 == 0) ? (b % 8) * (F.G / 8) + b / 8 : b; F.gw = F.vcu * NWAVES + F.wave;
    return F;
}

__global__ void __launch_bounds__(NTHREADS, 2) mk_fwd(Args a) {
    extern __shared__ __attribute__((aligned(16))) unsigned char lds_raw[];
    Frame F;
    F.lds = (LAS unsigned char*)lds_raw;
    F.tid = threadIdx.x; F.lane = F.tid & 63; F.wave = __builtin_amdgcn_readfirstlane(F.tid >> 6);
    F.G = gridDim.x; F.bx = blockIdx.x; { const int bx = blockIdx.x; F.vcu = (F.G % 8 == 0) ? (bx % 8) * (F.G / 8) + bx / 8 : bx; }
    F.gw = F.vcu * NWAVES + F.wave; F.ngw = F.G * NWAVES; F.ws = a.ws;
    volatile LAS unsigned* bst = (volatile LAS unsigned*)(F.lds + LDS_BARST);
    if (F.tid < 16) bst[F.tid] = 0u;
    __syncthreads();
    cg::grid_group grid = cg::this_grid();
    XcdBarrier bar; bar.bar = (unsigned*)(a.ws + WS_CTL) + CW_BAR; bar.x = 0; bar.st = bst;
    const bool multi = (a.ph_hi - a.ph_lo) > 1;
    if (multi && !a.use_cg) bar = xcd_barrier_post((unsigned*)(a.ws + WS_CTL) + CW_BAR, bst);
    const int lo = a.ph_lo, hi = a.ph_hi;
#ifdef TSTAMP
#define STAMP(k) do { if (blockIdx.x == 0 && threadIdx.x == 0) ((unsigned long long*)(a.ws + WS_CTL + 40960))[k] = wall_clock64(); } while (0)
#else
#define STAMP(k) do { } while (0)
#endif
    STAMP(0);
#define IN(k) in_ph((k), lo, hi)
#ifndef DBLSEAM
#define DBLSEAM 0
#endif
#define SEAM(k) do { if (IN(k) && IN((k) + 1)) { if (a.use_cg) grid.sync(); else { xcd_barrier(bar); if (DBLSEAM) xcd_barrier(bar); } } STAMP((k) + 1); } while (0)
    if (IN(0)) { p0_prologue(fresh(F), a); if ((DBLMASK >> 11) & 1) p0_prologue(fresh(F), a); }
    SEAM(0);
    if (IN(1)) { p_r0(fresh(F), a.in[0]); if ((DBLMASK >> 12) & 1) p_r0(fresh(F), a.in[0]); }
    SEAM(1);
#ifdef FUSE_MOE
#define SEAM_MOE(k) do { } while (0)
#else
#define SEAM_MOE(k) SEAM(k)
#endif
#define RUN(k, call) do { if (IN(pb + (k))) { call; if ((DBLMASK >> (k)) & 1) { call; } } } while (0)
#define LAYER(l) do { \
        const int pb = 2 + PH_PER_LAYER * (l); \
        RUN(0, p_gemm1(fresh(F), a, (l))); \
        SEAM(pb + 0); \
        RUN(1, p_mixer_local(fresh(F), a, (l))); \
        SEAM(pb + 1); \
        RUN(2, p_scan(fresh(F), a, (l))); \
        SEAM(pb + 2); \
        RUN(3, p_rwkv_out(fresh(F), a, (l))); \
        SEAM(pb + 3); \
        RUN(4, p_gemm2(fresh(F), (l))); \
        SEAM(pb + 4); \
        RUN(5, p_rowpass1(fresh(F), a, (l), (l) == 0 ? a.in[0] : a.out)); \
        if (IN(pb + 5) && ((DBLMASK >> 10) & 1)) p_rowpass1(fresh(F), a, (l), (l) == 0 ? a.in[0] : a.out, true); \
        SEAM(pb + 5); \
        RUN(6, p_gather(fresh(F), (l))); \
        SEAM(pb + 6); \
        RUN(7, p_moe_a(fresh(F), (l))); \
        SEAM_MOE(pb + 7); \
        RUN(8, p_moe_b(fresh(F), (l))); \
        SEAM(pb + 8); \
        RUN(9, p_rowpass2(fresh(F), a, (l), a.out)); \
        SEAM(pb + 9); \
    } while (0)
    LAYER(0);
    LAYER(1);
#ifdef END_RERUN
#define RERUN(k, call) do { if ((END_RERUN >> (k)) & 1) { xcd_barrier(bar); call; } } while (0)
    if (multi && !a.use_cg) {
        RERUN(0, p_gemm1(fresh(F), a, 1));
        RERUN(1, p_mixer_local(fresh(F), a, 1));
        RERUN(2, p_scan(fresh(F), a, 1));
        RERUN(15, p_scan(fresh(F), a, 1, RRV));
        RERUN(3, p_rwkv_out(fresh(F), a, 1));
        RERUN(4, p_gemm2(fresh(F), 1));
        RERUN(7, p_moe_a(fresh(F), 1); p_moe_b(fresh(F), 1));
        RERUN(12, p_gemm2k(fresh(F), 512));
        RERUN(13, p_gemm2k(fresh(F), 256));
        RERUN(5, p_moe_a(fresh(F), 1));
        RERUN(6, p_moe_b(fresh(F), 1));
        RERUN(10, p_rowpass1(fresh(F), a, 1, a.out, true));
        RERUN(11, p_gather(fresh(F), 1));
        RERUN(14, p_rowpass1(fresh(F), a, 1, a.out, false));
        RERUN(9, p_rowpass2(fresh(F), a, 1, a.out));
    }
#endif
#undef LAYER
#undef IN
#undef SEAM
}

#ifndef MK_MODE
#define MK_MODE 0
#endif
#ifndef TESTMODE
#define TESTMODE 0
#endif

static void fill_args(Args& a, void* const* d_in, void* d_out, void* d_ws) {
    for (int i = 0; i < 31; ++i) a.in[i] = (const float*)d_in[i];
    a.out = (float*)d_out; a.ws = (unsigned char*)d_ws; a.ph_lo = 0; a.ph_hi = N_PHASES; a.use_cg = 0; a.pad = 0;
}
static void launch_phases(Args a, int lo, int hi, hipStream_t stream) {
    for (int p = lo; p < hi; ++p) { a.ph_lo = p; a.ph_hi = p + 1; hipLaunchKernelGGL(mk_fwd, dim3(256), dim3(NTHREADS), LDS_BYTES, stream, a); }
}

#if TESTMODE == 0
extern "C" void kernel_launch(void* const* d_in, const int* in_sizes, int n_in, void* d_out, int out_size, void* d_ws, size_t ws_size, hipStream_t stream) {
    static int grid = 0;
    if (grid == 0) {
        int dev = 0, cus = 0, per_cu = 0;
        (void)hipGetDevice(&dev); (void)hipDeviceGetAttribute(&cus, hipDeviceAttributeMultiprocessorCount, dev);
        (void)hipFuncSetAttribute((const void*)mk_fwd, hipFuncAttributeMaxDynamicSharedMemorySize, LDS_BYTES);
        (void)hipOccupancyMaxActiveBlocksPerMultiprocessor(&per_cu, (const void*)mk_fwd, NTHREADS, LDS_BYTES);
        (void)hipGetLastError();
        grid = (cus > 0 ? cus : 256) * 1;
        if (ws_size < WS_END || n_in != 31) grid = -1;
    }
    if (grid < 0) return;
    (void)hipMemsetAsync((char*)d_ws + WS_CTL, 0, CTL_BYTES, stream);
    Args a{}; fill_args(a, d_in, d_out, d_ws);
#if MK_MODE == 2
    launch_phases(a, 0, N_PHASES, stream);
#else
    a.use_cg = (MK_MODE == 1) ? 1 : 0;
    void* args[] = {&a};
    (void)hipLaunchCooperativeKernel((const void*)mk_fwd, dim3(grid), dim3(NTHREADS), args, LDS_BYTES, stream);
#endif
}
#endif

#if TESTMODE > 0
constexpr int O_A = 1152, O_B = 2304, O_W = 2336, O_AL = 2368, O_G = 2432;
struct HSrc { const bf16_t* HB; const bf16_t* VT;
    DI float at(size_t tok, int n) const { if (n < 768) return bf2f(HB[tok * HW + n]); if (n < 1152) return bf2f(VT[(size_t)(n - 768) * T + tok]); return bf2f(HB[tok * HW + n - 384]); } };
DI float sigm_n(float x) { return 1.f / (1.f + expf(-x)); }

__global__ void k_mod_n(const float* __restrict__ c, const float* __restrict__ w_mod, const float* __restrict__ b_mod, float* __restrict__ mod) {
    __shared__ float sc[NB * D];
    for (int i = threadIdx.x; i < NB * D; i += blockDim.x) { float v = c[i]; sc[i] = v * sigm_n(v); }
    __syncthreads();
    int idx = blockIdx.x * blockDim.x + threadIdx.x; int l = idx / MODW, n = idx % MODW;
    const float* w = w_mod + (size_t)l * D * MODW + n; float a0 = 0.f, a1 = 0.f;
    for (int k = 0; k < D; ++k) { float wv = w[(size_t)k * MODW]; a0 += sc[k] * wv; a1 += sc[D + k] * wv; }
    float bb = b_mod[l * MODW + n];
    mod[(size_t)(l * NB + 0) * MODW + n] = a0 + bb; mod[(size_t)(l * NB + 1) * MODW + n] = a1 + bb;
}
__global__ void k_ln_mod_n(const float* __restrict__ xin, const float* __restrict__ modl, int off_sh, int off_sc, float* __restrict__ uout) {
    int row = (blockIdx.x * blockDim.x + threadIdx.x) >> 6, lane = threadIdx.x & 63; if (row >= T) return; int b = row / S;
    f32x4 v[4];
#pragma unroll
    for (int j = 0; j < 4; ++j) v[j] = *(const f32x4*)(xin + (size_t)row * D + 4 * lane + 256 * j);
    float mean, rstd; row_ln(v, mean, rstd);
    const float* md = modl + (size_t)b * MODW;
#pragma unroll
    for (int j = 0; j < 4; ++j) { int col = 4 * lane + 256 * j; *(f32x4*)(uout + (size_t)row * D + col) = v[j] * rstd * (1.f + *(const f32x4*)(md + off_sc + col)) + *(const f32x4*)(md + off_sh + col); }
}
__global__ void k_post_n(const float* xin, const float* br, const float* __restrict__ modl, int off_gate, const float* __restrict__ gain, const float* __restrict__ bias, float* xout, float* u2out, int off_sh2, int off_sc2) {
    int row = (blockIdx.x * blockDim.x + threadIdx.x) >> 6, lane = threadIdx.x & 63; if (row >= T) return; int b = row / S;
    const float* md = modl + (size_t)b * MODW; f32x4 v[4];
#pragma unroll
    for (int j = 0; j < 4; ++j) { int col = 4 * lane + 256 * j; v[j] = *(const f32x4*)(xin + (size_t)row * D + col) * ALPHA + *(const f32x4*)(md + off_gate + col) * *(const f32x4*)(br + (size_t)row * D + col); }
    float mean, rstd; row_ln(v, mean, rstd);
#pragma unroll
    for (int j = 0; j < 4; ++j) { int col = 4 * lane + 256 * j; v[j] = v[j] * rstd * *(const f32x4*)(gain + col) + *(const f32x4*)(bias + col); *(f32x4*)(xout + (size_t)row * D + col) = v[j]; }
    if (u2out == nullptr) return;
    row_ln(v, mean, rstd);
#pragma unroll
    for (int j = 0; j < 4; ++j) { int col = 4 * lane + 256 * j; *(f32x4*)(u2out + (size_t)row * D + col) = v[j] * rstd * (1.f + *(const f32x4*)(md + off_sc2 + col)) + *(const f32x4*)(md + off_sh2 + col); }
}
__global__ void __launch_bounds__(256) k_gemm_f32(const float* __restrict__ A, int lda, const float* __restrict__ B, int ldb, float* __restrict__ C, int ldc, int K) {
    __shared__ float As[16][65]; __shared__ float Bs[16][64];
    const int tx = threadIdx.x & 15, ty = threadIdx.x >> 4; const int m0 = blockIdx.y * 64, n0 = blockIdx.x * 64;
    float acc[4][4];
#pragma unroll
    for (int i = 0; i < 4; ++i)
#pragma unroll
        for (int j = 0; j < 4; ++j) acc[i][j] = 0.f;
    for (int k0 = 0; k0 < K; k0 += 16) {
#pragma unroll
        for (int i = 0; i < 4; ++i) { int e = threadIdx.x + 256 * i; int m = e >> 4, k = e & 15; As[k][m] = A[(size_t)(m0 + m) * lda + k0 + k]; }
#pragma unroll
        for (int i = 0; i < 4; ++i) { int e = threadIdx.x + 256 * i; int k = e >> 6, n = e & 63; Bs[k][n] = B[(size_t)(k0 + k) * ldb + n0 + n]; }
        __syncthreads();
#pragma unroll
        for (int k = 0; k < 16; ++k) { float a[4], b[4];
#pragma unroll
            for (int i = 0; i < 4; ++i) { a[i] = As[k][ty * 4 + i]; b[i] = Bs[k][tx * 4 + i]; }
#pragma unroll
            for (int i = 0; i < 4; ++i)
#pragma unroll
                for (int j = 0; j < 4; ++j) acc[i][j] += a[i] * b[j]; }
        __syncthreads();
    }
#pragma unroll
    for (int i = 0; i < 4; ++i) *(float4*)(C + (size_t)(m0 + ty * 4 + i) * ldc + n0 + tx * 4) = make_float4(acc[i][0], acc[i][1], acc[i][2], acc[i][3]);
}
__global__ void __launch_bounds__(64) k_attn_n(HSrc h, const float* __restrict__ rpb, float* __restrict__ concat) {
    int idx = blockIdx.x * blockDim.x + threadIdx.x; if (idx >= T * AH) return;
    int head = idx % AH, tok = idx / AH; int b = tok / S, t = tok % S, r = t / GW, cq = t % GW;
    int rstart = r - KH / 2; rstart = rstart < 0 ? 0 : (rstart > ROWS - KH ? ROWS - KH : rstart);
    int cstart = cq - KW / 2; cstart = cstart < 0 ? 0 : (cstart > GW - KW ? GW - KW : cstart);
    float q[HD], acc[HD];
#pragma unroll
    for (int d = 0; d < HD; ++d) { q[d] = h.at(tok, head * HD + d); acc[d] = 0.f; }
    float m = -1e30f, l = 0.f; const float* rp = rpb + (size_t)head * 15 * 31;
    for (int kk = 0; kk < KH; ++kk) { int kr = rstart + kk; int dr = kr - r + (KH - 1);
        for (int j = 0; j < KW; ++j) { int ck = cstart + j; int dc = ck - cq; dc = dc < -15 ? -15 : (dc > 15 ? 15 : dc); dc += 15;
            size_t kt = (size_t)b * S + kr * GW + ck; float s = 0.f;
#pragma unroll
            for (int d = 0; d < HD; ++d) s += q[d] * h.at(kt, AW + head * HD + d);
            s = s * 0.125f + rp[dr * 31 + dc];
            float mn = fmaxf(m, s); float corr = expf(m - mn); float p = expf(s - mn); l = l * corr + p;
#pragma unroll
            for (int d = 0; d < HD; ++d) acc[d] = acc[d] * corr + p * h.at(kt, 2 * AW + head * HD + d);
            m = mn; } }
    float inv = 1.f / l;
#pragma unroll
    for (int d = 0; d < HD; ++d) concat[(size_t)tok * D + head * HD + d] = acc[d] * inv;
}
__global__ void __launch_bounds__(256) k_pool_n(HSrc h, const float* __restrict__ pool_w, const float* __restrict__ pool_scale, float* __restrict__ concat) {
    __shared__ float pooled[CW];
    int tok = blockIdx.x; int b = tok / S, t = tok % S; int ch = threadIdx.x; int g = ch / 64; int win = 2 << g;
    int lo = t - win / 2; lo = lo < 0 ? 0 : lo; int hi = t + win / 2 - 1; hi = hi > S - 1 ? S - 1 : hi;
    float s = 0.f; for (int u = lo; u <= hi; ++u) s += h.at((size_t)b * S + u, O_G + ch);
    pooled[ch] = s / (float)(hi - lo + 1) - h.at(tok, O_G + ch);
    __syncthreads();
    int e = ch % 64; const float* pw = pool_w + (size_t)g * 64 * 64 + e; float a = 0.f;
    for (int c2 = 0; c2 < 64; ++c2) a += pooled[g * 64 + c2] * pw[c2 * 64];
    concat[(size_t)tok * D + AW + BW + ch] = a * pool_scale[ch];
}
__global__ void __launch_bounds__(64) k_rwkv_scan_n(HSrc h, RwP p, float* __restrict__ ys) {
    const int lane = threadIdx.x; const int dir = blockIdx.x / (NB * BH), b = (blockIdx.x / BH) % NB, hd = blockIdx.x % BH; const int ch = hd * HD + lane;
    float st[HD];
#pragma unroll
    for (int j = 0; j < HD; ++j) st[j] = 0.f;
    float wup[RW], aup[RA];
#pragma unroll
    for (int m = 0; m < RW; ++m) { wup[m] = p.w_up[(size_t)(dir * RW + m) * BW + ch]; aup[m] = p.a_up[(size_t)(dir * RA + m) * BW + ch]; }
    const float w0 = p.w0[dir * BW + ch], a0 = p.a0[dir * BW + ch], kkw = p.k_k[ch], kaw = p.k_a[ch];
    float cr[3], ck[3], cv[3];
#pragma unroll
    for (int x = 0; x < 3; ++x) { cr[x] = p.conv[x * 3 * BW + ch]; ck[x] = p.conv[x * 3 * BW + BW + ch]; cv[x] = p.conv[x * 3 * BW + 2 * BW + ch]; }
    for (int step = 0; step < S; ++step) {
        const int t = dir ? (S - 1 - step) : step; const size_t row = (size_t)b * S + t;
        float r = 0.f, k = 0.f, v = 0.f;
#pragma unroll
        for (int x = 0; x < 3; ++x) { int tt = t + x - 1; if (tt >= 0 && tt < S) { size_t rr = (size_t)b * S + tt; r += h.at(rr, O_A + ch) * cr[x]; k += h.at(rr, O_A + BW + ch) * ck[x]; v += h.at(rr, O_A + 2 * BW + ch) * cv[x]; } }
        float lv = h.at(row, O_B + lane); float lt = lane < RW ? tanhf(lv) : lv; float zw = w0, za = a0;
#pragma unroll
        for (int m = 0; m < RW; ++m) { zw += __shfl(lt, m) * wup[m]; za += __shfl(lt, RW + m) * aup[m]; }
        const float w = expf(-DECAY * sigm_n(zw)); const float a = sigm_n(za);
        float kk = k * kkw; float ss = wave_sum(kk * kk); kk = kk * (1.f / sqrtf(fmaxf(ss, 1e-24f)));
        const float kd = k * (1.f + (a - 1.f) * kaw); const float kka = kk * a;
        float sa = 0.f;
#pragma unroll
        for (int j = 0; j < HD; ++j) sa += st[j] * (-__shfl(kk, j));
        float y = 0.f;
#pragma unroll
        for (int j = 0; j < HD; ++j) { st[j] = st[j] * __shfl(w, j) + sa * __shfl(kka, j) + v * __shfl(kd, j); y += st[j] * __shfl(r, j); }
        ys[((size_t)dir * T + b * S + t) * BW + ch] = y;
    }
}
__global__ void __launch_bounds__(384) k_rwkv_finish_n(HSrc h, RwP p, const float* __restrict__ ys, float* __restrict__ concat) {
    __shared__ float lw[RW], la[RA], sg[RG];
    const int tok = blockIdx.x, b = tok / S, t = tok % S, ch = threadIdx.x, hd = ch / HD, j = ch % HD;
    if (ch < RW) lw[ch] = tanhf(h.at(tok, O_B + ch)); else if (ch < RW + RA) la[ch - RW] = h.at(tok, O_W + (ch - RW)); else if (ch < RW + RA + RG) sg[ch - RW - RA] = sigm_n(h.at(tok, O_AL + (ch - RW - RA)));
    __syncthreads();
    float r = 0.f, k = 0.f, v = 0.f;
#pragma unroll
    for (int x = 0; x < 3; ++x) { int tt = t + x - 1; if (tt >= 0 && tt < S) { size_t rr = (size_t)b * S + tt;
        r += h.at(rr, O_A + ch) * p.conv[x * 3 * BW + ch]; k += h.at(rr, O_A + BW + ch) * p.conv[x * 3 * BW + BW + ch]; v += h.at(rr, O_A + 2 * BW + ch) * p.conv[x * 3 * BW + 2 * BW + ch]; } }
    float bon = 0.f;
    for (int dir = 0; dir < 2; ++dir) { float za = p.a0[dir * BW + ch]; for (int m = 0; m < RA; ++m) za += la[m] * p.a_up[(size_t)(dir * RA + m) * BW + ch];
        float a = sigm_n(za); float kd = k * (1.f + (a - 1.f) * p.k_a[ch]); bon += wave_sum(r * kd * p.r_k[hd * HD + j]); }
    bon *= v;
    float y = ys[(size_t)tok * BW + ch] + ys[((size_t)T + tok) * BW + ch];
    float mu = wave_sum(y) * (1.f / HD); float dy = y - mu; float var = wave_sum(dy * dy) * (1.f / HD);
    float yn = dy * (1.f / sqrtf(var + GN_EPS)) * p.gn_gain[ch] + p.gn_bias[ch];
    float g = 0.f; for (int m = 0; m < RG; ++m) g += sg[m] * p.g_up[(size_t)m * BW + ch];
    concat[(size_t)tok * D + AW + ch] = (yn + bon) * g;
}
__global__ void __launch_bounds__(256) k_moe_n(const float* __restrict__ u2, const int* __restrict__ tokslot, const float* __restrict__ ew,
                                                const float* __restrict__ wgate, const float* __restrict__ wup, const float* __restrict__ wdown, float* __restrict__ f) {
    __shared__ float xs[D]; __shared__ float hb[DE];
    const int tok = blockIdx.x, tid = threadIdx.x;
    for (int i = tid; i < D; i += 256) xs[i] = u2[(size_t)tok * D + i];
    float o[4] = {0.f, 0.f, 0.f, 0.f};
    for (int kk = 0; kk < 2; ++kk) {
        const int ts = tokslot[tok * 2 + kk]; const int e = ts >> 14; const float wt = ew[ts];
        __syncthreads();
        const float* g = wgate + (size_t)e * D * DE; const float* u = wup + (size_t)e * D * DE;
        float ag0 = 0.f, ag1 = 0.f, au0 = 0.f, au1 = 0.f;
        for (int k = 0; k < D; ++k) { float x = xs[k]; ag0 += x * g[(size_t)k * DE + tid]; ag1 += x * g[(size_t)k * DE + 256 + tid]; au0 += x * u[(size_t)k * DE + tid]; au1 += x * u[(size_t)k * DE + 256 + tid]; }
        hb[tid] = ag0 * sigm_n(ag0) * au0; hb[256 + tid] = ag1 * sigm_n(ag1) * au1;
        __syncthreads();
        const float* dn = wdown + (size_t)e * DE * D; float a[4] = {0.f, 0.f, 0.f, 0.f};
        for (int k = 0; k < DE; ++k) { float x = hb[k];
#pragma unroll
            for (int j = 0; j < 4; ++j) a[j] += x * dn[(size_t)k * D + tid + 256 * j]; }
#pragma unroll
        for (int j = 0; j < 4; ++j) o[j] += a[j] * wt;
    }
#pragma unroll
    for (int j = 0; j < 4; ++j) f[(size_t)tok * D + tid + 256 * j] = o[j];
}

__global__ void k_router_n(const float* __restrict__ u2, const float* __restrict__ wg, const float* __restrict__ bg, const float* __restrict__ we, const float* __restrict__ be, int* __restrict__ tok_e) {
    int row = (blockIdx.x * blockDim.x + threadIdx.x) >> 6, lane = threadIdx.x & 63; if (row >= T) return;
    float gl[NG], el[NE];
#pragma unroll
    for (int n = 0; n < NG; ++n) gl[n] = 0.f;
#pragma unroll
    for (int n = 0; n < NE; ++n) el[n] = 0.f;
    for (int i = 0; i < 16; ++i) { int k = lane + 64 * i; float x = u2[(size_t)row * D + k];
#pragma unroll
        for (int n = 0; n < NG; ++n) gl[n] += x * wg[k * NG + n];
#pragma unroll
        for (int n = 0; n < NE; ++n) el[n] += x * we[k * NE + n]; }
#pragma unroll
    for (int n = 0; n < NG; ++n) gl[n] = wave_sum(gl[n]) + bg[n];
#pragma unroll
    for (int n = 0; n < NE; ++n) el[n] = wave_sum(el[n]) + be[n];
    int gi = 0; float gm = gl[0];
#pragma unroll
    for (int n = 1; n < NG; ++n) if (gl[n] > gm) { gm = gl[n]; gi = n; }
    float l1 = -3.0e38f, l2 = -3.0e38f; int i1 = 0, i2 = 0;
#pragma unroll
    for (int n = 0; n < NE; ++n) if ((n >> 3) == gi) { float v = el[n]; int e = n & 7; if (v > l1) { l2 = l1; i2 = i1; l1 = v; i1 = e; } else if (v > l2) { l2 = v; i2 = e; } }
    if (lane == 0) { tok_e[row * 2] = gi * EPG + i1; tok_e[row * 2 + 1] = gi * EPG + i2; }
}
__global__ void k_cmp_route(const int* __restrict__ tokslot, const int* __restrict__ tok_e, float* acc, int slot) {
    float mis = 0.f, tot = 0.f;
    for (int t = blockIdx.x * blockDim.x + threadIdx.x; t < T; t += gridDim.x * blockDim.x) { const int a0 = tokslot[2 * t] >> 14, a1 = tokslot[2 * t + 1] >> 14;
        mis += (a0 != tok_e[2 * t] || a1 != tok_e[2 * t + 1]) ? 1.f : 0.f; tot += 1.f; }
    mis = wave_sum(mis); tot = wave_sum(tot);
    if ((threadIdx.x & 63) == 0) { atomicAdd(acc + 2 * slot, mis); atomicAdd(acc + 2 * slot + 1, tot); }
}
__global__ void k_bf2f(const bf16_t* __restrict__ src, float* __restrict__ dst, size_t n) { for (size_t i = (size_t)blockIdx.x * blockDim.x + threadIdx.x; i < n; i += (size_t)gridDim.x * blockDim.x) dst[i] = bf2f(src[i]); }
template <class TA> __global__ void k_cmp(const TA* __restrict__ a, size_t lda, const float* __restrict__ b, size_t ldb, int rows, int cols, float* acc, int slot) {
    float d2 = 0.f, r2 = 0.f;
    for (size_t i = (size_t)blockIdx.x * blockDim.x + threadIdx.x; i < (size_t)rows * cols; i += (size_t)gridDim.x * blockDim.x) {
        const size_t r = i / cols, c = i % cols; float av; if constexpr (sizeof(TA) == 2) av = bf2f(a[r * lda + c]); else av = a[r * lda + c];
        const float bv = b[r * ldb + c]; d2 += (av - bv) * (av - bv); r2 += bv * bv; }
    d2 = wave_sum(d2); r2 = wave_sum(r2);
    if ((threadIdx.x & 63) == 0) { atomicAdd(acc + 2 * slot, d2); atomicAdd(acc + 2 * slot + 1, r2); }
}
__global__ void k_cmp_vt(const bf16_t* __restrict__ vt, const float* __restrict__ b, size_t ldb, float* acc, int slot) {
    float d2 = 0.f, r2 = 0.f;
    for (size_t i = (size_t)blockIdx.x * blockDim.x + threadIdx.x; i < (size_t)T * AW; i += (size_t)gridDim.x * blockDim.x) {
        const size_t r = i % T, c = i / T; const float av = bf2f(vt[c * T + r]), bv = b[r * ldb + c]; d2 += (av - bv) * (av - bv); r2 += bv * bv; }
    d2 = wave_sum(d2); r2 = wave_sum(r2);
    if ((threadIdx.x & 63) == 0) { atomicAdd(acc + 2 * slot, d2); atomicAdd(acc + 2 * slot + 1, r2); }
}
struct Tols { float t[8]; int n; };
__global__ void k_readout(float* out, const float* acc, Tols tl, int total) {
    float mx = 0.f; int am = 0; for (int k = 0; k < tl.n; ++k) { float e = sqrtf(acc[2 * k] / fmaxf(acc[2 * k + 1], 1e-30f)); if (!(e == e)) e = 1e3f; if (e / tl.t[k] > mx) { mx = e / tl.t[k]; am = k; } }
    const float cval = sqrtf(1000.f * mx);
    for (int i = blockIdx.x * blockDim.x + threadIdx.x; i < total; i += gridDim.x * blockDim.x) out[i] = (i < 8) ? 1000.f * (float)(am + 1) : cval;
}
__global__ void __launch_bounds__(256) k_moe_chk(const float* __restrict__ u2, const int* __restrict__ tokslot, const float* __restrict__ ew, const unsigned* __restrict__ cnt,
                                                  const float* __restrict__ wgate, const float* __restrict__ wup, const float* __restrict__ wdown,
                                                  const bf16_t* __restrict__ XS, const bf16_t* __restrict__ HM, const bf16_t* __restrict__ YS, float* acc) {
    __shared__ float xs[D]; __shared__ float hb[DE]; __shared__ int offp[NE];
    const int tok = blockIdx.x, tid = threadIdx.x;
    if (tid == 0) { int off = 0; for (int e = 0; e < NE; ++e) { offp[e] = off; off += (((int)cnt[e] + 255) >> 8) * 256; } }
    for (int i = tid; i < D; i += 256) xs[i] = u2[(size_t)tok * D + i];
    float d0 = 0.f, r0 = 0.f, d1 = 0.f, r1 = 0.f, d2 = 0.f, r2 = 0.f;
    for (int kk = 0; kk < 2; ++kk) {
        __syncthreads();
        const int ts = tokslot[tok * 2 + kk]; const int e = ts >> 14; const float wt = ew[ts]; const size_t slot = (size_t)offp[e] + (ts & 16383);
        for (int i = tid; i < D; i += 256) { const float a = bf2f(XS[slot * D + i]), b = xs[i]; d0 += (a - b) * (a - b); r0 += b * b; }
        const float* g = wgate + (size_t)e * D * DE; const float* u = wup + (size_t)e * D * DE;
        float ag0 = 0.f, ag1 = 0.f, au0 = 0.f, au1 = 0.f;
        for (int k = 0; k < D; ++k) { float x = xs[k]; ag0 += x * g[(size_t)k * DE + tid]; ag1 += x * g[(size_t)k * DE + 256 + tid]; au0 += x * u[(size_t)k * DE + tid]; au1 += x * u[(size_t)k * DE + 256 + tid]; }
        const float h0 = ag0 * sigm_n(ag0) * au0, h1 = ag1 * sigm_n(ag1) * au1;
        hb[tid] = h0; hb[256 + tid] = h1;
        { const float a = bf2f(HM[slot * DE + tid]), b = bf2f(HM[slot * DE + 256 + tid]); d1 += (a - h0) * (a - h0) + (b - h1) * (b - h1); r1 += h0 * h0 + h1 * h1; }
        __syncthreads();
        const float* dn = wdown + (size_t)e * DE * D; float a4[4] = {0.f, 0.f, 0.f, 0.f};
        for (int k = 0; k < DE; ++k) { float x = hb[k];
#pragma unroll
            for (int j = 0; j < 4; ++j) a4[j] += x * dn[(size_t)k * D + tid + 256 * j]; }
#pragma unroll
        for (int j = 0; j < 4; ++j) {
#ifdef MOEB_NOSCALE
            const float y = a4[j];
#else
            const float y = a4[j] * wt;
#endif
            const float a = bf2f(YS[slot * D + tid + 256 * j]); d2 += (a - y) * (a - y); r2 += y * y; }
    }
    d0 = wave_sum(d0); r0 = wave_sum(r0); d1 = wave_sum(d1); r1 = wave_sum(r1); d2 = wave_sum(d2); r2 = wave_sum(r2);
    if ((tid & 63) == 0) { atomicAdd(acc + 0, d0); atomicAdd(acc + 1, r0); atomicAdd(acc + 2, d1); atomicAdd(acc + 3, r1); atomicAdd(acc + 4, d2); atomicAdd(acc + 5, r2); }
}

extern "C" void kernel_launch(void* const* d_in, const int* in_sizes, int n_in, void* d_out, int out_size, void* d_ws, size_t ws_size, hipStream_t stream) {
    static int once = 0; if (!once) { (void)hipFuncSetAttribute((const void*)mk_fwd, hipFuncAttributeMaxDynamicSharedMemorySize, LDS_BYTES); once = 1; }
    (void)hipMemsetAsync((char*)d_ws + WS_CTL, 0, CTL_BYTES, stream);
    Args a{}; fill_args(a, d_in, d_out, d_ws);
    char* ws = (char*)d_ws; float* out = (float*)d_out;
    float* ACC = (float*)(ws + 32768 + 1024);
    const float* x = a.in[0];
    HSrc hs{(const bf16_t*)(ws + WS_HB), (const bf16_t*)(ws + WS_VT)};
    const int l = 0;
    RwP p = { a.in[6], a.in[7], a.in[8], a.in[9], a.in[10], a.in[11], a.in[12], a.in[13], a.in[14], a.in[15], a.in[16] };
    Tols tl{};
#if TESTMODE == 1
    launch_phases(a, 0, 3, stream);
    float* MODn = (float*)(ws + WS_MOD + 512 * 1024); float* Un = (float*)(ws + WS_XA); float* HF = (float*)(ws + WS_CONCAT);
    k_mod_n<<<L * MODW / 256, 256, 0, stream>>>(a.in[1], a.in[2], a.in[3], MODn);
    k_ln_mod_n<<<T / 4, 256, 0, stream>>>(x, MODn, 0, D, Un);
    k_gemm_f32<<<dim3(INW / 64, T / 64), 256, 0, stream>>>(Un, D, a.in[4], INW, HF, INW, D);
    k_cmp<float><<<256, 256, 0, stream>>>((const float*)(ws + WS_MOD), MODW, MODn, MODW, L * NB, MODW, ACC, 0);
    k_cmp<bf16_t><<<1024, 256, 0, stream>>>((const bf16_t*)(ws + WS_U), D, Un, D, T, D, ACC, 1);
    k_cmp<bf16_t><<<1024, 256, 0, stream>>>((const bf16_t*)(ws + WS_HB), HW, HF, INW, T, 768, ACC, 2);
    k_cmp<bf16_t><<<1024, 256, 0, stream>>>((const bf16_t*)(ws + WS_HB) + 768, HW, HF + 1152, INW, T, 1536, ACC, 3);
    k_cmp_vt<<<1024, 256, 0, stream>>>((const bf16_t*)(ws + WS_VT), HF + 768, INW, ACC, 4);
    tl.n = 5; tl.t[0] = 1e-5f; tl.t[1] = 4e-3f; tl.t[2] = 6e-3f; tl.t[3] = 6e-3f; tl.t[4] = 6e-3f;
#elif TESTMODE == 2
    launch_phases(a, 0, 4, stream);
    float* CCn = (float*)(ws + WS_XA); float* YSn = (float*)(ws + WS_WGU);
    k_attn_n<<<T * AH / 64, 64, 0, stream>>>(hs, a.in[5], CCn);
    k_pool_n<<<T, 256, 0, stream>>>(hs, a.in[17], a.in[18], CCn);
    k_rwkv_scan_n<<<2 * NB * BH, 64, 0, stream>>>(hs, p, YSn);
    k_rwkv_finish_n<<<T, 384, 0, stream>>>(hs, p, YSn, CCn);
    launch_phases(a, 4, 6, stream);
    k_cmp<bf16_t><<<1024, 256, 0, stream>>>((const bf16_t*)(ws + WS_CONCAT), D, CCn, D, T, AW, ACC, 0);
    k_cmp<bf16_t><<<1024, 256, 0, stream>>>((const bf16_t*)(ws + WS_CONCAT) + AW, D, CCn + AW, D, T, BW, ACC, 1);
    k_cmp<bf16_t><<<1024, 256, 0, stream>>>((const bf16_t*)(ws + WS_CONCAT) + AW + BW, D, CCn + AW + BW, D, T, CW, ACC, 2);
    tl.n = 3; tl.t[0] = TOL0; tl.t[1] = TOL1; tl.t[2] = TOL2;
#elif TESTMODE == 3
    launch_phases(a, 0, 11, stream);
    { const float* MODf = (const float*)(ws + WS_MOD);
      float* U2f = (float*)(ws + 414 * MiB); float* Fn = (float*)(ws + 213 * MiB); float* X2n = (float*)(ws + 277 * MiB);
      k_bf2f<<<2048, 256, 0, stream>>>((const bf16_t*)(ws + WS_U), U2f, (size_t)T * D);
      launch_phases(a, 11, 12, stream);
      k_moe_n<<<T, 256, 0, stream>>>(U2f, (const int*)(ws + WS_TOKSLOT), (const float*)(ws + WS_EW), a.in[28], a.in[29], a.in[30], Fn);
      k_post_n<<<T / 4, 256, 0, stream>>>((const float*)(ws + WS_XA), Fn, MODf, 5 * D, a.in[22], a.in[23], X2n, nullptr, 0, 0);
      k_cmp<float><<<1024, 256, 0, stream>>>(out, D, X2n, D, T, D, ACC, 0); }
    tl.n = 1; tl.t[0] = TOL0;
#elif TESTMODE == 4
    launch_phases(a, 0, 8, stream);
    { const float* MODf = (const float*)(ws + WS_MOD);
      float* CCn = (float*)(ws + 405 * MiB); float* MIXn = (float*)(ws + 213 * MiB); float* X1n = (float*)(ws + 21 * MiB); float* U2n = (float*)(ws + 333 * MiB); int* TEn = (int*)(ws + 490 * MiB);
      k_bf2f<<<2048, 256, 0, stream>>>((const bf16_t*)(ws + WS_CONCAT), CCn, (size_t)T * D);
      k_gemm_f32<<<dim3(D / 64, T / 64), 256, 0, stream>>>(CCn, D, a.in[19], D, MIXn, D, D);
      k_post_n<<<T / 4, 256, 0, stream>>>(x, MIXn, MODf, 2 * D, a.in[20], a.in[21], X1n, U2n, 3 * D, 4 * D);
      k_router_n<<<T / 4, 256, 0, stream>>>(U2n, a.in[24], a.in[25], a.in[26], a.in[27], TEn);
      k_cmp<float><<<1024, 256, 0, stream>>>((const float*)(ws + WS_XA), D, X1n, D, T, D, ACC, 0);
      k_cmp<bf16_t><<<1024, 256, 0, stream>>>((const bf16_t*)(ws + WS_U), D, U2n, D, T, D, ACC, 1);
      k_cmp_route<<<64, 256, 0, stream>>>((const int*)(ws + WS_TOKSLOT), TEn, ACC, 2); }
    tl.n = 3; tl.t[0] = TOL0; tl.t[1] = TOL1; tl.t[2] = TOL2;
#elif TESTMODE == 5
    launch_phases(a, 0, 11, stream);
    { float* U2f = (float*)(ws + 414 * MiB);
      k_bf2f<<<2048, 256, 0, stream>>>((const bf16_t*)(ws + WS_U), U2f, (size_t)T * D);
      k_moe_chk<<<T, 256, 0, stream>>>(U2f, (const int*)(ws + WS_TOKSLOT), (const float*)(ws + WS_EW), (const unsigned*)(ws + WS_CTL) + CW_CNT, a.in[28], a.in[29], a.in[30],
                                       (const bf16_t*)(ws + WS_XS), (const bf16_t*)(ws + WS_HM), (const bf16_t*)(ws + WS_YS), ACC); }
    tl.n = 3; tl.t[0] = 1e-6f; tl.t[1] = 1e-2f; tl.t[2] = 1e-2f;
#endif
    k_readout<<<256, 256, 0, stream>>>(out, ACC, tl, out_size);
}
#endif
```

```cpp
#define TESTMODE 0
#define MK_MODE 0
#define S0_WRITER 1
#define ATT_XCD 1
#define FUSE_MOE 1
#define MOE_ACQ1 1
#define KV_TILED 1
#define MP_FRAG 1
#define SCAN_U2 1
#define ATT_FAST 1
#define RP1_EARLY 1
#define D_FRAG 1
#define SC1_GEMM 1
#define HOIST_VEC 1
#define PRM_PF 1
#define RT_DMA 1
#define ROUTER_BATCH 1
#define YS_PLAIN 1
#define MOE_SWEEP 1
#define CVW 3
#define CONV_TAIL 10240
#define CONV_G1T 2560
#define TITEM2 1
#define ATT_PF 1
#define ATT_PFV 1
#define SC1_CONV 1
#define SC1_RWKV 1
#include <hip/hip_runtime.h>
#include <hip/hip_cooperative_groups.h>
#include <stdint.h>
namespace cg = cooperative_groups;

#ifndef TESTMODE
#define TESTMODE 0
#endif
#define DI __device__ __forceinline__
#define LAS __attribute__((address_space(3)))
typedef unsigned short bf16_t;
typedef short bf16x8 __attribute__((ext_vector_type(8)));
typedef float f32x4 __attribute__((ext_vector_type(4)));
typedef float f32x16 __attribute__((ext_vector_type(16)));
typedef unsigned u32x4 __attribute__((ext_vector_type(4)));
typedef unsigned u32x2 __attribute__((ext_vector_type(2)));
typedef float f32x2_t __attribute__((ext_vector_type(2)));
typedef __bf16 bf16x2_t __attribute__((ext_vector_type(2)));

namespace cfg {
constexpr int D = 1024, NB = 2, S = 8192, T = NB * S, L = 2;
constexpr int GW = 64, ROWS = 128;
constexpr int HD = 64, AW = 384, BW = 384, CW = 256, AH = 6, BH = 6;
constexpr int KH = 8, KW = 16;
constexpr int RW = 32, RA = 32, RG = 64;
constexpr int INW = 2688;
constexpr int NG = 4, EPG = 8, NE = 32, DE = 512;
constexpr int MODW = 6 * D;
constexpr float ALPHA = 1.41421356237309515f;
constexpr float LN_EPS = 1e-5f, GN_EPS = 64e-5f;
constexpr float DECAY = 0.60653065971263342f;
constexpr float LOG2E = 1.44269504088896341f;
constexpr int HW = 2304, HQ = 0, HK = 384, HR = 768, HWL = 1920, HAL = 1952, HGL = 1984, HP = 2048;
constexpr int NCH = S / 64;
constexpr int NUNIT = 2 * NB * BH * NCH;
constexpr int XSROWS = 2 * T + NE * 256;
}
using namespace cfg;

constexpr size_t MiB = 1u << 20;
constexpr size_t WS_CTL = 0;
constexpr size_t CTL_BYTES = 262144;
constexpr size_t WS_SLOTTOK = 65536;
constexpr int CW_BAR = 0;
constexpr int CW_MFL = 9216;
constexpr int CW_CNT = 8192;
constexpr size_t WS_MOD = 1 * MiB;
constexpr size_t WS_TOKSLOT = 1 * MiB + 128 * 1024;
constexpr size_t WS_SLOTW = 1 * MiB + 256 * 1024;
constexpr size_t WS_BC = 2 * MiB;
constexpr size_t WS_TOKW = 2 * MiB + 64 * 1024;
constexpr size_t WS_TOKFIN = 2 * MiB + 256 * 1024;
constexpr size_t WS_CNTF = 2 * MiB + 512 * 1024;
constexpr size_t WS_RTT = 3 * MiB;
constexpr size_t WS_WIN = 6 * MiB;
constexpr size_t WIN_LAYER = (size_t)2816 * 1024 * 2;
constexpr size_t WS_WOUT = 17 * MiB;
constexpr size_t WS_WGU = 21 * MiB;
constexpr size_t WS_WD = 85 * MiB;
constexpr size_t WS_XA = 117 * MiB;
constexpr size_t WS_U = 181 * MiB;
constexpr size_t WS_HB = 213 * MiB;
constexpr size_t WS_S0 = 117 * MiB;
constexpr size_t WS_VT = 285 * MiB;
constexpr size_t WS_CONCAT = 301 * MiB;
constexpr size_t WS_MP = 333 * MiB;
constexpr size_t WS_NB = 358 * MiB;
constexpr size_t WS_MIX = 333 * MiB;
constexpr size_t WS_KT = 384 * MiB;
constexpr size_t WS_QT = 405 * MiB;
constexpr size_t WS_WT = 429 * MiB;
constexpr size_t WS_VTB = 453 * MiB;
constexpr size_t WS_GB = 465 * MiB;
constexpr size_t WS_VC = 477 * MiB;
constexpr size_t WS_BS = 489 * MiB;
constexpr size_t WS_XS = 213 * MiB;
constexpr size_t WS_HM = 293 * MiB;
constexpr size_t WS_YS = 333 * MiB;
constexpr size_t WS_END = 490 * MiB;
DI void st16_plain(void* p, u32x4 w) { *(u32x4*)p = w; }
DI void st16_sc1(void* p, u32x4 w) { asm volatile("global_store_dwordx4 %0, %1, off sc1\n\ts_nop 1" :: "v"(p), "v"(w) : "memory"); }
#ifdef SC1_GEMM
#define ST16G(p, w) st16_sc1((void*)(p), (w))
#else
#define ST16G(p, w) st16_plain((void*)(p), (w))
#endif
#if defined(SC1_GEMM) && !defined(YS_PLAIN)
#define ST16Y(p, w) st16_sc1((void*)(p), (w))
#else
#define ST16Y(p, w) st16_plain((void*)(p), (w))
#endif
#if defined(SC1_GEMM) && !defined(KV_PLAIN)
#define ST16K(p, w) st16_sc1((void*)(p), (w))
#else
#define ST16K(p, w) st16_plain((void*)(p), (w))
#endif
#ifdef SC1_CONV
#define ST16C(p, w) st16_sc1((void*)(p), (w))
#else
#define ST16C(p, w) st16_plain((void*)(p), (w))
#endif
#ifdef SC1_RWKV
#define ST16V(p, w) st16_sc1((void*)(p), (w))
#else
#define ST16V(p, w) st16_plain((void*)(p), (w))
#endif
#if defined(SC1_ROW) || defined(SC1_S0)
#define ST16S(p, w) st16_sc1((void*)(p), (w))
#else
#define ST16S(p, w) st16_plain((void*)(p), (w))
#endif
#ifdef SC1_ROW
#define ST16R(p, w) st16_sc1((void*)(p), (w))
#else
#define ST16R(p, w) st16_plain((void*)(p), (w))
#endif
#ifdef D_FRAG
#define DFRAG(row, col) ((((((row) >> 4) * 2 + ((col) >> 5)) * 64 + ((row) & 15) + 16 * (((col) & 31) >> 3)) * 8) + ((col) & 7))
#else
#define DFRAG(row, col) ((row) * 64 + (col))
#endif
#ifndef NOSKEW
#define USK(u) ((size_t)(u) + ((size_t)(u) >> 7))
#else
#define USK(u) ((size_t)(u))
#endif

constexpr int NWAVES = 8, NTHREADS = 512;
constexpr int LDS_BYTES = 156 * 1024;

DI unsigned cvtpk(float lo, float hi) { f32x2_t v = {lo, hi}; bf16x2_t b = __builtin_convertvector(v, bf16x2_t); return __builtin_bit_cast(unsigned, b); }
DI float bflo(unsigned w) { return __uint_as_float(w << 16); }
DI float bfhi(unsigned w) { return __uint_as_float(w & 0xffff0000u); }
DI float bf2f(unsigned short h) { return __uint_as_float((unsigned)h << 16); }
DI unsigned short f2bf(float f) { return (unsigned short)(cvtpk(f, 0.f) & 0xffffu); }
DI float wave_sum_shfl(float v) {
#pragma unroll
    for (int o = 32; o > 0; o >>= 1) v += __shfl_xor(v, o);
    return v;
}
template <int CTRL, int ROWMASK> DI float dpp_add(float v) { return v + __builtin_bit_cast(float, __builtin_amdgcn_update_dpp(0, __builtin_bit_cast(int, v), CTRL, ROWMASK, 0xf, false)); }
DI float wave_sum(float v) {
    v = dpp_add<0xb1, 0xf>(v);
    v = dpp_add<0x4e, 0xf>(v);
    v = dpp_add<0x124, 0xf>(v);
    v = dpp_add<0x128, 0xf>(v);
    v = dpp_add<0x142, 0xa>(v);
    v = dpp_add<0x143, 0xc>(v);
    return __builtin_bit_cast(float, __builtin_amdgcn_readlane(__builtin_bit_cast(int, v), 63));
}
DI float fexp2(float x) { return __builtin_amdgcn_exp2f(x); }
DI float frcp(float x) { return __builtin_amdgcn_rcpf(x); }
DI float sigm(float x) { return frcp(1.f + fexp2(x * -LOG2E)); }
#define LDS_WAIT() asm volatile("s_waitcnt lgkmcnt(0)" ::: "memory")
#define VM_WAIT() asm volatile("s_waitcnt vmcnt(0)" ::: "memory")
DI int swap23(int i) { return (i & ~12) | ((i & 4) << 1) | ((i & 8) >> 1); }

namespace pg8 {
constexpr int BM = 256, BK = 64, HALF = 128, HTB = HALF * BK * 2, STAGE_BYTES = 8 * HTB, NXCD = 8, WGM = 8;
__host__ __device__ __forceinline__ int lds_byte(int r, int c) { const int st = (r >> 4) * 2 + (c >> 5), rr = r & 15, cc = c & 31, ob = rr * 64 + cc * 2; return st * 1024 + (ob ^ (((ob >> 9) & 1) << 5)); }
__host__ __device__ __forceinline__ void stage_rc(int b, int& R, int& C) { const int st = b / 1024, sb = b % 1024, swz = sb ^ (((sb >> 9) & 1) << 5); R = (st >> 1) * 16 + swz / 64; C = (st & 1) * 32 + (swz % 64) / 2; }
__host__ __device__ __forceinline__ int perm32(int rho) { const int n = rho >> 4, i = rho & 15; return 8 * (i >> 2) + 4 * n + (i & 3); }

struct Unit { int pm, pn, aux; };

DI int xcd_remap(int L, int nwg) { const int q = nwg / NXCD, r = nwg % NXCD, xcd = L % NXCD, off = L / NXCD; return (xcd < r ? xcd * (q + 1) : r * (q + 1) + (xcd - r) * q) + off; }

struct PlainOrder {
    static constexpr bool GATHER = false, SIGNAL = false, WAIT = false, ACQ1 = false;
    DI void signal(const Unit&) const {} DI void wait(const Unit&, int = 0) const {}
    const bf16_t* A; const bf16_t* Bt; int K; int nM, nN, nwg, G, c;
    DI void init(const bf16_t* A_, const bf16_t* Bt_, int M, int N, int K_, int G_, int c_) { A = A_; Bt = Bt_; K = K_; nM = M / BM; nN = N / BM; nwg = nM * nN; G = G_; c = c_; }
    DI bool next(int i, Unit& u) const {
        const int Lx = i * G + c; if (Lx >= nwg) return false;
        const int wgid = xcd_remap(Lx, nwg);
        const int nig = WGM * nN, gid = wgid / nig, fm = gid * WGM, gsz = (nM - fm) < WGM ? (nM - fm) : WGM;
        u.pm = fm + ((wgid % nig) % gsz); u.pn = (wgid % nig) / gsz; u.aux = 0; return true;
    }
    DI const char* aptr(const Unit& u) const { return (const char*)A + (size_t)u.pm * (2 * HALF) * K * 2; }
    DI const char* bptr(const Unit& u) const { return (const char*)Bt + (size_t)u.pn * (2 * HALF) * K * 2; }
};
struct Gemm1Order {
    static constexpr bool GATHER = false, SIGNAL = false, WAIT = false, ACQ1 = false;
    DI void signal(const Unit&) const {} DI void wait(const Unit&, int = 0) const {}
    const bf16_t* U; const bf16_t* Win; const bf16_t* Wv; int G, c;
    static constexpr int nM = T / BM, nN = HW / BM, nMain = nM * nN, nV = 2 * (T / BM), nwg = nMain + nV, K = D;
    DI bool next(int i, Unit& u) const {
        const int Lx = i * G + c; if (Lx >= nwg) return false;
        if (Lx < nMain) {
            const int wgid = xcd_remap(Lx, nMain);
            const int nig = WGM * nN, gid = wgid / nig, fm = gid * WGM, gsz = (nM - fm) < WGM ? (nM - fm) : WGM;
            u.pm = fm + ((wgid % nig) % gsz); u.pn = (wgid % nig) / gsz; u.aux = 0;
        } else { const int v = Lx - nMain; u.pm = v & 1; u.pn = v >> 1; u.aux = 1; }
        return true;
    }
    DI const char* aptr(const Unit& u) const { return (const char*)(u.aux ? Wv : U) + (size_t)u.pm * BM * K * 2; }
    DI const char* bptr(const Unit& u) const { return (const char*)(u.aux ? U : Win) + (size_t)u.pn * BM * K * 2; }
};
template <bool G_> struct GroupedOrderT {
    static constexpr bool GATHER = G_;
#ifdef FUSE_MOE
    static constexpr bool SIGNAL = G_, WAIT = false, ACQ1 = false;
    unsigned* flags; bool quiet = false;
    DI void signal(const Unit& u) const { (void)__hip_atomic_fetch_add(flags + u.pm, 1u, __ATOMIC_RELAXED, __HIP_MEMORY_SCOPE_AGENT); }
    DI void wait(const Unit&, int = 0) const {}
#else
    static constexpr bool SIGNAL = false, WAIT = false, ACQ1 = false;
    DI void signal(const Unit&) const {} DI void wait(const Unit&, int = 0) const {}
#endif
    const bf16_t* A; const bf16_t* Bt; int K; size_t estride; const LAS int* tile_e; int ntiles, nwg, G, c; const int* rowtok;
    DI bool next(int i, Unit& u) const {
        const int Lx = i * G + c; if (Lx >= nwg) return false;
        const int wgid = xcd_remap(Lx, nwg);
        u.pm = wgid >> 2; u.pn = wgid & 3; u.aux = tile_e[u.pm]; return true;
    }
    DI const char* aptr(const Unit& u) const { return GATHER ? (const char*)A : (const char*)A + (size_t)u.pm * BM * K * 2; }
    DI const char* bptr(const Unit& u) const { return (const char*)Bt + ((size_t)u.aux * estride + (size_t)u.pn * BM * K) * 2; }
};

#ifdef FUSE_MOE
struct GroupedOrderB {
    static constexpr bool GATHER = false, SIGNAL = false, WAIT = true;
#ifdef MOE_ACQ1
    static constexpr bool ACQ1 = true;
#else
    static constexpr bool ACQ1 = false;
#endif
    const bf16_t* A; const bf16_t* Bt; int K; size_t estride; const LAS int* tile_e; int ntiles, nwg, G, c; const int* rowtok; unsigned* flags;
    DI bool next(int i, Unit& u) const {
        int wgid;
        if (G % NXCD == 0) {
            const int P = G / NXCD, x = c % NXCD, k = c / NXCD, q = nwg / NXCD, r8 = nwg % NXCD;
            const int qx = q + (x < r8 ? 1 : 0), startx = x < r8 ? x * (q + 1) : r8 * (q + 1) + (x - r8) * q;
            const int remA = qx % P, nL = P - remA, seg1 = remA > 0 ? (2 * nL < qx ? 2 * nL : qx) : 0;
            int n1 = 0;
            if (remA > 0 && k >= remA) { n1 = (k - remA) < seg1 ? 1 : 0; n1 += (k - remA) + nL < seg1 ? 1 : 0; }
            const int ob = i < n1 ? (k - remA) + i * nL : seg1 + k + (i - n1) * P;
            if (ob >= qx) return false;
            wgid = startx + ob;
        } else { const int Lx = i * G + c; if (Lx >= nwg) return false; wgid = Lx; }
        u.pm = wgid >> 2; u.pn = wgid & 3; u.aux = tile_e[u.pm]; return true;
    }
    DI const char* aptr(const Unit& u) const { return (const char*)A + (size_t)u.pm * BM * K * 2; }
    DI const char* bptr(const Unit& u) const { return (const char*)Bt + ((size_t)u.aux * estride + (size_t)u.pn * BM * K) * 2; }
    DI void signal(const Unit&) const {}
    unsigned readymask;
    DI void wait(const Unit& u, int idx = 0) const {
        if (idx < 32 && ((readymask >> idx) & 1u)) return;
        unsigned sp = 0;
        while (__hip_atomic_load(flags + u.pm, __ATOMIC_RELAXED, __HIP_MEMORY_SCOPE_AGENT) < 4u) { __builtin_amdgcn_s_sleep(4); if (++sp > (1u << 22)) break; }
#ifdef MOE_ACQ1
        __builtin_amdgcn_fence(__ATOMIC_ACQUIRE, "agent"); asm volatile("s_waitcnt vmcnt(0)" ::: "memory");
#else
        asm volatile("" ::: "memory");
#endif
    }
};
#endif

struct EpiStore {
    bf16_t* O0; int ld0; bf16_t* O1; int ld1;
    DI void operator()(const f32x4 (&acc)[2][2][4][2], const Unit& u, int wr, int wc, int fr, int fq) const {
        bf16_t* base = u.aux ? O1 : O0; const int ldc = u.aux ? ld1 : ld0;
        const int row0 = u.pm * BM + wr * 64 + fr, col0 = u.pn * BM + wc * 32 + 8 * fq;
#pragma unroll
        for (int ai = 0; ai < 2; ++ai)
#pragma unroll
            for (int m = 0; m < 4; ++m) { bf16_t* rowp = base + (size_t)(row0 + ai * HALF + m * 16) * ldc + col0;
#pragma unroll
                for (int bj = 0; bj < 2; ++bj) { const f32x4 v0 = acc[ai][bj][m][0], v1 = acc[ai][bj][m][1];
                    u32x4 w; w.x = cvtpk(v0[0], v0[1]); w.y = cvtpk(v0[2], v0[3]); w.z = cvtpk(v1[0], v1[1]); w.w = cvtpk(v1[2], v1[3]);
                    ST16G(rowp + bj * HALF, w); } }
    }
};
#ifdef KV_TILED
struct EpiGemm1 {
    bf16_t* O0; int ld0; bf16_t* Kt; bf16_t* Vt;
    DI void operator()(const f32x4 (&acc)[2][2][4][2], const Unit& u, int wr, int wc, int fr, int fq) const {
        const int row0 = u.pm * BM + wr * 64 + fr, col0 = u.pn * BM + wc * 32 + 8 * fq;
#pragma unroll
        for (int ai = 0; ai < 2; ++ai)
#pragma unroll
            for (int m = 0; m < 4; ++m) { const int row = row0 + ai * HALF + m * 16;
#pragma unroll
                for (int bj = 0; bj < 2; ++bj) { const f32x4 v0 = acc[ai][bj][m][0], v1 = acc[ai][bj][m][1]; const int col = col0 + bj * HALF;
                    u32x4 w; w.x = cvtpk(v0[0], v0[1]); w.y = cvtpk(v0[2], v0[3]); w.z = cvtpk(v1[0], v1[1]); w.w = cvtpk(v1[2], v1[3]);
                    if (u.aux) {
                        if (row < 384) { const int head = row >> 6, dd = row & 63, tl = col >> 5, tk = col & 31;
                            ST16K(Vt + ((((size_t)head * (T / 32) + tl) * 4 + (dd >> 5) * 2 + (tk >> 4)) * 32 + (dd & 31)) * 16 + (tk & 15), w); }
                    } else if (col >= 384 && col < 768) {
                        const int head = (col - 384) >> 6, d = (col - 384) & 63, tl = row >> 5, tk = row & 31, pos = (tk & 19) | ((tk & 4) << 1) | ((tk & 8) >> 1);
                        ST16K(Kt + ((((size_t)head * (T / 32) + tl) * 4 + (d >> 4)) * 32 + pos) * 16 + (d & 15), w);
                    } else ST16G(O0 + (size_t)row * ld0 + col, w); } }
    }
};
#endif
struct EpiSwiGlu {
    bf16_t* O;
    DI void operator()(const f32x4 (&acc)[2][2][4][2], const Unit& u, int wr, int wc, int fr, int fq) const {
        const int row0 = u.pm * BM + wr * 64 + fr, col0 = u.pn * HALF + wc * 32 + 8 * fq;
#pragma unroll
        for (int ai = 0; ai < 2; ++ai)
#pragma unroll
            for (int m = 0; m < 4; ++m) { bf16_t* rowp = O + (size_t)(row0 + ai * HALF + m * 16) * DE + col0;
                float hv[8];
#pragma unroll
                for (int n = 0; n < 2; ++n)
#pragma unroll
                    for (int e = 0; e < 4; ++e) { const float g = acc[ai][0][m][n][e], up = acc[ai][1][m][n][e]; hv[4 * n + e] = g * sigm(g) * up; }
                u32x4 w; w.x = cvtpk(hv[0], hv[1]); w.y = cvtpk(hv[2], hv[3]); w.z = cvtpk(hv[4], hv[5]); w.w = cvtpk(hv[6], hv[7]);
#ifdef FUSE_MOE
                asm volatile("global_store_dwordx4 %0, %1, off sc1\n\ts_nop 1" :: "v"(rowp), "v"(w) : "memory");
#else
                *(u32x4*)rowp = w;
#endif
            }
    }
};
struct EpiRowScale {
    bf16_t* O; const float* roww;
    DI void operator()(const f32x4 (&acc)[2][2][4][2], const Unit& u, int wr, int wc, int fr, int fq) const {
        const int row0 = u.pm * BM + wr * 64 + fr, col0 = u.pn * BM + wc * 32 + 8 * fq;
        float sw[2][4];
#pragma unroll
        for (int ai = 0; ai < 2; ++ai)
#pragma unroll
            for (int m = 0; m < 4; ++m) sw[ai][m] = roww[row0 + ai * HALF + m * 16];
#pragma unroll
        for (int ai = 0; ai < 2; ++ai)
#pragma unroll
            for (int m = 0; m < 4; ++m) { const int row = row0 + ai * HALF + m * 16;
#ifdef MOEB_NOSCALE
                const float s = 1.f;
#else
                const float s = sw[ai][m];
#endif
                bf16_t* rowp = O + (size_t)row * D + col0;
#pragma unroll
                for (int bj = 0; bj < 2; ++bj) { const f32x4 v0 = acc[ai][bj][m][0] * s, v1 = acc[ai][bj][m][1] * s;
                    u32x4 w; w.x = cvtpk(v0[0], v0[1]); w.y = cvtpk(v0[2], v0[3]); w.z = cvtpk(v1[0], v1[1]); w.w = cvtpk(v1[2], v1[3]);
                    ST16Y(rowp + bj * HALF, w); } }
    }
};

template <class Epi, class Sched>
DI void gemm_phase(LAS unsigned char* lds, const int tid, const int K, const Sched& S, const Epi& E) {
    const int wid = __builtin_amdgcn_readfirstlane(tid >> 6), lane = tid & 63, wr = wid >> 2, wc = wid & 3, fr = lane & 15, fq = lane >> 4;
    const int nt = K / BK;
    unsigned voffA[2], voffB[2];
#pragma unroll
    for (int i = 0; i < 2; ++i) { int R, C; stage_rc(tid * 16 + i * 8192, R, C); const int Rb = (R & ~31) + perm32(R & 31);
        voffA[i] = (unsigned)(R * K + C) * 2u; voffB[i] = (unsigned)(Rb * K + C) * 2u; }
    const size_t kstep = (size_t)(BK * 2);
    const size_t hstep = (size_t)HALF * K * 2;
    const size_t hstepA = Sched::GATHER ? 0 : hstep;
    int RA_[2], CA_[2];
#pragma unroll
    for (int i = 0; i < 2; ++i) stage_rc(tid * 16 + i * 8192, RA_[i], CA_[i]);
    unsigned vgc[2][2], vgn[2][2], vgnn[2][2];
#define PG8_GLOAD(dst, u_) do { if constexpr (Sched::GATHER) { _Pragma("unroll") for (int h_ = 0; h_ < 2; ++h_) _Pragma("unroll") for (int i_ = 0; i_ < 2; ++i_) \
        dst[h_][i_] = ((unsigned)S.rowtok[(u_).pm * BM + h_ * HALF + RA_[i_]] * (unsigned)K + (unsigned)CA_[i_]) * 2u; } } while (0)
    const unsigned ldsw = (unsigned)wid * 1024u;
    const int aoff = lds_byte(wr * 64 + fr, fq * 8), boff = lds_byte(wc * 32 + fr, fq * 8);
#define PG8_SA(b, h) (((b) * 2 + (h)) * HTB)
#define PG8_SB(b, h) ((4 + (b) * 2 + (h)) * HTB)
#define PG8_STAGE(bufoff, gbase, voff) do { _Pragma("unroll") for (int _i = 0; _i < 2; ++_i) \
        __builtin_amdgcn_global_load_lds((const unsigned*)((const char*)(gbase) + (voff)[_i]), (LAS unsigned*)(lds + (bufoff) + ldsw + _i * 8192), 16, 0, 0); } while (0)
#define PG8_STAGE_C(bufoff, gbase, voff) do { _Pragma("unroll") for (int _i = 0; _i < 2; ++_i) \
        __builtin_amdgcn_global_load_lds((const unsigned*)((const char*)(gbase) + (voff)[_i]), (LAS unsigned*)(lds + (bufoff) + ldsw + _i * 8192), 16, 0, 16); } while (0)
#define PG8_STAGE_A(b, h, gbase, cur_) do { if constexpr (Sched::GATHER) { unsigned vo_[2]; vo_[0] = (cur_) ? vgc[h][0] : vgn[h][0]; vo_[1] = (cur_) ? vgc[h][1] : vgn[h][1]; PG8_STAGE(PG8_SA(b, h), gbase, vo_); } else if constexpr (Sched::WAIT && !Sched::ACQ1) PG8_STAGE_C(PG8_SA(b, h), (gbase) + (h) * hstepA, voffA); else PG8_STAGE(PG8_SA(b, h), (gbase) + (h) * hstepA, voffA); } while (0)
#define PG8_LDA(dst, b, h) do { _Pragma("unroll") for (int m = 0; m < 4; ++m) _Pragma("unroll") for (int k = 0; k < 2; ++k) dst[m][k] = *(const LAS bf16x8*)(lds + PG8_SA(b, h) + aoff + m * 2048 + k * 1024); } while (0)
#define PG8_LDB(dst, b, h) do { _Pragma("unroll") for (int n = 0; n < 2; ++n) _Pragma("unroll") for (int k = 0; k < 2; ++k) dst[n][k] = *(const LAS bf16x8*)(lds + PG8_SB(b, h) + boff + n * 2048 + k * 1024); } while (0)
#define PG8_MMA(ai, bj, At, Bt) do { __builtin_amdgcn_s_setprio(1); _Pragma("unroll") for (int m = 0; m < 4; ++m) _Pragma("unroll") for (int n = 0; n < 2; ++n) _Pragma("unroll") for (int k = 0; k < 2; ++k) \
        acc[ai][bj][m][n] = __builtin_amdgcn_mfma_f32_16x16x32_bf16(Bt[n][k], At[m][k], acc[ai][bj][m][n], 0, 0, 0); __builtin_amdgcn_s_setprio(0); } while (0)
#define PG8_WAIT_V(n) asm volatile("s_waitcnt vmcnt(" #n ")" ::: "memory")
#define PG8_WAIT_L(n) asm volatile("s_waitcnt lgkmcnt(" #n ")" ::: "memory")
#define PG8_BAR __builtin_amdgcn_s_barrier()
#define PG8_SCHED __builtin_amdgcn_sched_barrier(0)
    Unit cur, nxt; int ui = 0;
    if (!S.next(0, cur)) return;
    f32x4 acc[2][2][4][2];
#pragma unroll
    for (int a = 0; a < 2; ++a)
#pragma unroll
        for (int b = 0; b < 2; ++b)
#pragma unroll
            for (int m = 0; m < 4; ++m)
#pragma unroll
                for (int n = 0; n < 2; ++n) acc[a][b][m][n] = (f32x4){0.f, 0.f, 0.f, 0.f};
    bf16x8 At[4][2], B0[2][2], B1[2][2];
    const char* cA = S.aptr(cur); const char* cB = S.bptr(cur);
    if constexpr (Sched::WAIT) { if constexpr (Sched::ACQ1) { if (wid == 0) S.wait(cur, 0); PG8_BAR; } else S.wait(cur, 0); }
    if constexpr (Sched::GATHER) { Unit u1_ = cur, u2_ = cur; const bool h1_ = S.next(1, u1_); if (!h1_) u1_ = cur; const bool h2_ = h1_ && S.next(2, u2_); if (!h2_) u2_ = u1_;
        PG8_GLOAD(vgc, cur); PG8_GLOAD(vgn, u1_); PG8_GLOAD(vgnn, u2_); }
    PG8_STAGE(PG8_SB(0, 0), cB, voffB); PG8_STAGE(PG8_SB(0, 1), cB + hstep, voffB); PG8_STAGE_A(0, 0, cA, true); PG8_STAGE_A(0, 1, cA, true);
    if (wr == 1) PG8_BAR;
    PG8_WAIT_V(2); PG8_BAR;
    PG8_STAGE(PG8_SB(1, 0), cB + kstep, voffB); PG8_STAGE_A(1, 0, cA + kstep, true); PG8_STAGE(PG8_SB(1, 1), cB + hstep + kstep, voffB);
    PG8_WAIT_V(6); PG8_BAR;
    for (;;) {
        const bool has_next = S.next(ui + 1, nxt);
        const char* nA = has_next ? S.aptr(nxt) : cA; const char* nB = has_next ? S.bptr(nxt) : cB;

        for (int t = 0; t < nt; t += 2) {
            const bool last = (t == nt - 2);
            if constexpr (Sched::WAIT) { if (last && has_next) { if constexpr (Sched::ACQ1) { if (wid == 0) S.wait(nxt, ui + 1); } else S.wait(nxt, ui + 1); } }
            const char* a1 = cA + (size_t)(t + 1) * kstep;
            const char* a2 = last ? nA : cA + (size_t)(t + 2) * kstep; const char* b2 = last ? nB : cB + (size_t)(t + 2) * kstep;
            const char* a3 = a2 + kstep; const char* b3 = b2 + kstep;
            PG8_LDB(B0, 0, 0); PG8_LDB(B1, 0, 1); PG8_SCHED; PG8_LDA(At, 0, 0); PG8_STAGE_A(1, 1, a1, true);
            PG8_WAIT_V(8); PG8_WAIT_L(0); PG8_BAR; PG8_MMA(0, 0, At, B0); PG8_MMA(0, 1, At, B1); PG8_BAR; PG8_SCHED;
            PG8_LDA(At, 0, 1); PG8_STAGE(PG8_SB(0, 0), b2, voffB); PG8_STAGE(PG8_SB(0, 1), b2 + hstep, voffB); PG8_STAGE_A(0, 0, a2, !last);
            PG8_WAIT_V(8); PG8_WAIT_L(0); PG8_BAR; PG8_MMA(1, 0, At, B0); PG8_MMA(1, 1, At, B1); PG8_BAR; PG8_SCHED;
            PG8_LDB(B0, 1, 0); PG8_LDB(B1, 1, 1); PG8_SCHED; PG8_LDA(At, 1, 0); PG8_STAGE_A(0, 1, a2, !last);
            PG8_WAIT_V(8); PG8_WAIT_L(0); PG8_BAR; PG8_MMA(0, 0, At, B0); PG8_MMA(0, 1, At, B1); PG8_BAR; PG8_SCHED;
            PG8_LDA(At, 1, 1); PG8_STAGE(PG8_SB(1, 0), b3, voffB); PG8_STAGE(PG8_SB(1, 1), b3 + hstep, voffB); PG8_STAGE_A(1, 0, a3, !last);
            PG8_WAIT_V(8); PG8_WAIT_L(0); PG8_BAR; PG8_MMA(1, 0, At, B0); PG8_MMA(1, 1, At, B1); PG8_BAR; PG8_SCHED;
        }
        if (wr == 0) PG8_BAR;
        E(acc, cur, wr, wc, fr, fq);
        if constexpr (Sched::SIGNAL) { if (!S.quiet) { PG8_WAIT_V(0); PG8_BAR; if (tid == 0) S.signal(cur); } }
        if (!has_next) break;
#pragma unroll
        for (int a = 0; a < 2; ++a)
#pragma unroll
            for (int b = 0; b < 2; ++b)
#pragma unroll
                for (int m = 0; m < 4; ++m)
#pragma unroll
                    for (int n = 0; n < 2; ++n) acc[a][b][m][n] = (f32x4){0.f, 0.f, 0.f, 0.f};
        cur = nxt; cA = nA; cB = nB; ++ui;
        if constexpr (Sched::GATHER) { _Pragma("unroll") for (int h_ = 0; h_ < 2; ++h_) _Pragma("unroll") for (int i_ = 0; i_ < 2; ++i_) { vgc[h_][i_] = vgn[h_][i_]; vgn[h_][i_] = vgnn[h_][i_]; } }
        if (wr == 1) PG8_BAR;
    }
    PG8_WAIT_V(0);
    PG8_BAR;
#undef PG8_SA
#undef PG8_SB
#undef PG8_STAGE
#undef PG8_STAGE_C
#undef PG8_STAGE_A
#undef PG8_GLOAD
#undef PG8_LDA
#undef PG8_LDB
#undef PG8_MMA
#undef PG8_WAIT_V
#undef PG8_WAIT_L
#undef PG8_BAR
#undef PG8_SCHED
}
}

#define XB_TMO      128
#define XB_XCNT(j)  (256  + 64 * (j))
#define XB_XSUB(j)  (1280 + 64 * (j))
#define XB_XGEN(j)  (2304 + 64 * (j))
#define XB_TOP      3328
#define XB_TOPGEN   3392
#define XCD_BAR_WORDS 3456
#define XB_SPIN_CAP (1u << 20)
DI unsigned xb_ld(unsigned* p)              { return __hip_atomic_load(p, __ATOMIC_RELAXED, __HIP_MEMORY_SCOPE_AGENT); }
DI unsigned xb_add(unsigned* p, unsigned v) { return __hip_atomic_fetch_add(p, v, __ATOMIC_RELAXED, __HIP_MEMORY_SCOPE_AGENT); }
DI unsigned xb_xcc_id() { return (unsigned)__builtin_amdgcn_s_getreg((3 << 11) | 20) & 0xFu; }
#define XB_SPIN(cond, bar) do { unsigned _sp = 0; while (cond) { __builtin_amdgcn_s_sleep(1); \
    if ((++_sp & 255u) == 0u) { if (xb_ld(&(bar)[XB_TMO])) break; if (_sp > XB_SPIN_CAP) { atomicAdd(&(bar)[XB_TMO], 1u); break; } } } } while (0)
struct XcdBarrier { unsigned* bar; unsigned x; volatile LAS unsigned* st; };
DI XcdBarrier xcd_barrier_post(unsigned* bar, volatile LAS unsigned* st) {
    XcdBarrier b; b.bar = bar; b.x = xb_xcc_id(); b.st = st;
    if (threadIdx.x == 0) (void)xb_add(&bar[XB_XCNT(b.x)], 1u);
    return b;
}
DI void xcd_barrier_complete(unsigned* bar, unsigned x, unsigned& nloc, unsigned& nx) {
    const unsigned G = gridDim.x * gridDim.y * gridDim.z;
    unsigned sum, cnt, mine, sp = 0u;
    for (;;) {
        sum = 0u; cnt = 0u; mine = 0u;
#pragma unroll
        for (unsigned j = 0; j < 16; ++j) { const unsigned c = xb_ld(&bar[XB_XCNT(j)]); sum += c; cnt += (c > 0u) ? 1u : 0u; mine = (j == x) ? c : mine; }
        if (sum == G) break;
        __builtin_amdgcn_s_sleep(1);
        if ((++sp & 255u) == 0u) { if (xb_ld(&bar[XB_TMO])) break; if (sp > XB_SPIN_CAP) { atomicAdd(&bar[XB_TMO], 1u); break; } }
    }
    nloc = mine > 0u ? mine : 1u; nx = cnt > 0u ? cnt : 1u;
}
DI void xcd_barrier(const XcdBarrier& b) {
    asm volatile("s_waitcnt vmcnt(0)" ::: "memory");
    __syncthreads();
    if (threadIdx.x == 0) {
        unsigned* bar = b.bar;
        __builtin_amdgcn_s_waitcnt(0);
        unsigned nloc = b.st[0], nx = b.st[1];
        if (nloc == 0u) { xcd_barrier_complete(bar, b.x, nloc, nx); b.st[0] = nloc; b.st[1] = nx; }
        const unsigned old = xb_add(&bar[XB_XSUB(b.x)], 1u);
        const unsigned gen = old / nloc;
        if (old + 1u == (gen + 1u) * nloc) {
            __builtin_amdgcn_fence(__ATOMIC_RELEASE, "agent");
            asm volatile("s_waitcnt vmcnt(0)" ::: "memory");
            const unsigned og = xb_add(&bar[XB_TOP], 1u);
            const unsigned tg = og / nx;
            if (og + 1u == (tg + 1u) * nx) xb_add(&bar[XB_TOPGEN], 1u);
            else XB_SPIN(xb_ld(&bar[XB_TOPGEN]) == tg, bar);
            __builtin_amdgcn_fence(__ATOMIC_ACQUIRE, "agent");
            xb_add(&bar[XB_XGEN(b.x)], 1u);
            asm volatile("s_waitcnt vmcnt(0)" ::: "memory");
        } else {
            XB_SPIN(xb_ld(&bar[XB_XGEN(b.x)]) == gen, bar);
            __builtin_amdgcn_fence(__ATOMIC_ACQUIRE, "agent");
            asm volatile("s_waitcnt vmcnt(0)" ::: "memory");
        }
    }
    __syncthreads();
}

struct Args { const float* in[31]; float* out; unsigned char* ws; int ph_lo, ph_hi, use_cg, pad; };
struct Frame {
    LAS unsigned char* lds;
    int tid, lane, wave, G, vcu, gw, ngw, bx;
    unsigned char* ws;
};
constexpr int LDS_MISC = 131072;
constexpr int LDS_BARST = LDS_BYTES - 64;

#ifdef NO_PREWAIT
#define CONV_PREWAIT() do { } while (0)
#else
#define CONV_PREWAIT() __builtin_amdgcn_s_waitcnt(0x0F70)
#endif
struct TItem { const float* src; bf16_t* dst; int ldw, ldt; };
#ifdef TITEM2
DI void titem_load(const TItem& t, f32x4 (&v)[16], int lane) {
#pragma unroll
    for (int i = 0; i < 16; ++i) v[i] = *(const f32x4*)(t.src + (size_t)(16 * (i >> 2) + 4 * (lane >> 4) + (i & 3)) * t.ldw + 4 * (lane & 15));
}
DI void titem_store(const TItem& t, const f32x4 (&v)[16], LAS float* scr, int lane) {
    LAS unsigned char* T = (LAS unsigned char*)scr;
    const int rr = lane >> 4, cc = lane & 15;
#pragma unroll
    for (int q = 0; q < 4; ++q)
#pragma unroll
        for (int e = 0; e < 4; ++e)
            *(LAS u32x2*)(T + (4 * cc + e) * 136 + (16 * q + 4 * rr) * 2) = (u32x2){cvtpk(v[4 * q][e], v[4 * q + 1][e]), cvtpk(v[4 * q + 2][e], v[4 * q + 3][e])};
    LDS_WAIT();
#pragma unroll
    for (int j = 0; j < 8; ++j) {
        const int n = 8 * j + (lane >> 3), c = lane & 7;
        const u32x2 lo = *(const LAS u32x2*)(T + n * 136 + 16 * c), hi = *(const LAS u32x2*)(T + n * 136 + 16 * c + 8);
        ST16C(t.dst + (size_t)n * t.ldt + 8 * c, ((u32x4){lo.x, lo.y, hi.x, hi.y}));
    }
    LDS_WAIT();
}
#else
DI void titem_load(const TItem& t, f32x4 (&v)[16], int lane) {
#pragma unroll
    for (int i = 0; i < 16; ++i) v[i] = *(const f32x4*)(t.src + (size_t)(4 * i + (lane >> 4)) * t.ldw + 4 * (lane & 15));
}
DI void titem_store(const TItem& t, const f32x4 (&v)[16], LAS float* scr, int lane) {
#pragma unroll
    for (int i = 0; i < 16; ++i) { LAS float* s = scr + (4 * i + (lane >> 4)) * 65 + 4 * (lane & 15); s[0] = v[i][0]; s[1] = v[i][1]; s[2] = v[i][2]; s[3] = v[i][3]; }
    LDS_WAIT();
#pragma unroll
    for (int j = 0; j < 8; ++j) {
        const int n = 8 * j + (lane >> 3), c = lane & 7; const LAS float* s = scr + (8 * c) * 65 + n;
        u32x4 o; o.x = cvtpk(s[0], s[65]); o.y = cvtpk(s[130], s[195]); o.z = cvtpk(s[260], s[325]); o.w = cvtpk(s[390], s[455]);
        ST16C(t.dst + (size_t)n * t.ldt + 8 * c, o);
    }
    LDS_WAIT();
}
#endif
constexpr int IT_WIN = 16 * 42, IT_WOUT = 16 * 16, IT_SMALL = IT_WIN + IT_WOUT;
constexpr int IT_EXP = 128 * 3, IT_MOE = NE * IT_EXP;
DI TItem small_item(const Frame& F, const float* w_in, const float* w_out, int git) {
    const int l = git / IT_SMALL, it = git % IT_SMALL; TItem t;
    if (it < IT_WIN) {
        const int kt = it / 42, nt = it % 42, n0 = 64 * nt;
        size_t drow; if (n0 < 768) drow = n0; else if (n0 < 1152) drow = 2304 + (n0 - 768); else drow = n0 - 384;
        t.src = w_in + (size_t)l * D * INW + (size_t)(64 * kt) * INW + n0; t.ldw = INW;
        t.dst = (bf16_t*)(F.ws + WS_WIN + (size_t)l * WIN_LAYER) + drow * D + 64 * kt; t.ldt = D;
    } else {
        const int r = it - IT_WIN, kt = r >> 4, nt = r & 15;
        t.src = w_out + (size_t)l * D * D + (size_t)(64 * kt) * D + 64 * nt; t.ldw = D;
        t.dst = (bf16_t*)(F.ws + WS_WOUT) + (size_t)l * D * D + (size_t)(64 * nt) * D + 64 * kt; t.ldt = D;
    }
    return t;
}
DI TItem moe_item(const Frame& F, const float* wg, const float* wu, const float* wd, int l, int it) {
    const int e = it / IT_EXP, r = it % IT_EXP, which = r >> 7, q = r & 127; TItem t;
    if (which < 2) {
        const int kt = q >> 3, nt = q & 7, n0 = 64 * nt;
        t.src = (which ? wu : wg) + ((size_t)l * NE + e) * D * DE + (size_t)(64 * kt) * DE + n0; t.ldw = DE;
        const size_t drow = (size_t)(n0 >> 7) * 256 + (which ? 128 : 0) + (n0 & 127);
        t.dst = (bf16_t*)(F.ws + WS_WGU) + (size_t)e * D * D + drow * D + 64 * kt; t.ldt = D;
    } else {
        const int kt = q >> 4, nt = q & 15;
        t.src = wd + ((size_t)l * NE + e) * DE * D + (size_t)(64 * kt) * D + 64 * nt; t.ldw = D;
        t.dst = (bf16_t*)(F.ws + WS_WD) + (size_t)e * D * DE + (size_t)(64 * nt) * DE + 64 * kt; t.ldt = DE;
    }
    return t;
}
DI void p0_prologue(const Frame& F, const Args& a) {
    const float* c = a.in[1]; const float* w_mod = a.in[2]; const float* b_mod = a.in[3];
#ifdef RT_DMA
    {
      float* RTt = (float*)(F.ws + WS_RTT);
      for (int i = F.bx * NTHREADS + F.tid; i < L * 36 * D; i += F.G * NTHREADS) { const int k = i % D, n = (i / D) % 36, l = i / (36 * D);
          RTt[i] = n < NG ? a.in[24][((size_t)l * D + k) * NG + n] : a.in[26][((size_t)l * D + k) * NE + (n - NG)]; } }
#endif
    if (F.bx < L * (MODW / 64)) {
        LAS float* sc = (LAS float*)(F.lds);
        LAS float* red = (LAS float*)(F.lds + 8192);
        for (int i = F.tid; i < NB * D; i += NTHREADS) { const float v = c[i]; sc[i] = v / (1.f + expf(-v)); }
        __syncthreads();
        const int l = F.bx / (MODW / 64), cb = F.bx % (MODW / 64), n = cb * 64 + F.lane;
        const float* w = w_mod + (size_t)l * D * MODW + n;
        float a0 = 0.f, a1 = 0.f;
#ifdef GEMV_DEEP
        { float p0[4] = {0.f, 0.f, 0.f, 0.f}, p1[4] = {0.f, 0.f, 0.f, 0.f};
#pragma unroll 1
          for (int k0 = F.wave * 128; k0 < F.wave * 128 + 128; k0 += 32) { float wv[32];
#pragma unroll
              for (int i = 0; i < 32; ++i) wv[i] = w[(size_t)(k0 + i) * MODW];
#pragma unroll
              for (int i = 0; i < 32; ++i) { p0[i & 3] += sc[k0 + i] * wv[i]; p1[i & 3] += sc[D + k0 + i] * wv[i]; } }
          a0 = (p0[0] + p0[1]) + (p0[2] + p0[3]); a1 = (p1[0] + p1[1]) + (p1[2] + p1[3]); }
#else
#pragma unroll 8
        for (int k = F.wave * 128; k < F.wave * 128 + 128; ++k) { const float wv = w[(size_t)k * MODW]; a0 += sc[k] * wv; a1 += sc[D + k] * wv; }
#endif
        red[(F.wave * 2 + 0) * 64 + F.lane] = a0; red[(F.wave * 2 + 1) * 64 + F.lane] = a1;
        __syncthreads();
        if (F.tid < 128) { const int b = F.tid >> 6, ln = F.tid & 63; float s = 0.f;
#pragma unroll
            for (int w8 = 0; w8 < 8; ++w8) s += red[(w8 * 2 + b) * 64 + ln];
            const int nn = cb * 64 + ln;
            ((float*)(F.ws + WS_MOD))[(size_t)(l * NB + b) * MODW + nn] = s + b_mod[l * MODW + nn]; }
        __syncthreads();
    }
    { const int nzero = L * 128 * D / 8;
      for (int i = F.gw * 64 + F.lane; i < nzero; i += F.ngw * 64) { const int l = i / (128 * D / 8), r = i % (128 * D / 8);
          *(u32x4*)((bf16_t*)(F.ws + WS_WIN + (size_t)l * WIN_LAYER) + (size_t)(2304 + 384) * D + (size_t)r * 8) = (u32x4){0u, 0u, 0u, 0u}; } }
    LAS float* scr = (LAS float*)(F.lds + 16384) + F.wave * (64 * 65);
    { f32x4 cur[16], nxt[16]; int it = F.gw; TItem tc{}, tn{};
      if (it < L * IT_SMALL) { tc = small_item(F, a.in[4], a.in[19], it); titem_load(tc, cur, F.lane); }
      CONV_PREWAIT();
      for (; it < L * IT_SMALL; it += F.ngw) {
          const bool more = it + F.ngw < L * IT_SMALL;
          if (more) { tn = small_item(F, a.in[4], a.in[19], it + F.ngw); titem_load(tn, nxt, F.lane); }
          titem_store(tc, cur, scr, F.lane);
          if (more) { tc = tn;
#pragma unroll
              for (int i = 0; i < 16; ++i) cur[i] = nxt[i]; }
      } }
}

DI void row_ln(f32x4 (&v)[4], float& mean_out, float& rstd_out) {
    float s = 0.f;
#pragma unroll
    for (int j = 0; j < 4; ++j) s += (v[j][0] + v[j][1]) + (v[j][2] + v[j][3]);
    const float mean = wave_sum(s) * (1.f / D); float q = 0.f;
#pragma unroll
    for (int j = 0; j < 4; ++j) { v[j] = v[j] - mean; q += (v[j][0] * v[j][0] + v[j][1] * v[j][1]) + (v[j][2] * v[j][2] + v[j][3] * v[j][3]); }
    mean_out = mean; rstd_out = 1.f / sqrtf(wave_sum(q) * (1.f / D) + LN_EPS);
}
DI void row_mod_store(f32x4 (&v)[4], const float* md, int off_sh, int off_sc, bf16_t* urow, int lane) {
    float mean, rstd; row_ln(v, mean, rstd);
#pragma unroll
    for (int j = 0; j < 4; ++j) { const int col = 4 * lane + 256 * j;
        const f32x4 scv = *(const f32x4*)(md + off_sc + col), shv = *(const f32x4*)(md + off_sh + col);
        v[j] = v[j] * rstd * (1.f + scv) + shv;
        u32x2 w; w.x = cvtpk(v[j][0], v[j][1]); w.y = cvtpk(v[j][2], v[j][3]);
        *(u32x2*)(urow + col) = w; }
}
DI void row_mod_store_r(f32x4 (&v)[4], const f32x4 (&shv)[4], const f32x4 (&scv)[4], bf16_t* urow, int lane) {
    float mean, rstd; row_ln(v, mean, rstd);
#pragma unroll
    for (int j = 0; j < 4; ++j) { const int col = 4 * lane + 256 * j;
        v[j] = v[j] * rstd * (1.f + scv[j]) + shv[j];
        u32x2 w; w.x = cvtpk(v[j][0], v[j][1]); w.y = cvtpk(v[j][2], v[j][3]);
        *(u32x2*)(urow + col) = w; }
}
DI void ldvec4(f32x4 (&d)[4], const float* p, int lane) {
#pragma unroll
    for (int j = 0; j < 4; ++j) d[j] = *(const f32x4*)(p + 4 * lane + 256 * j);
}
DI void p_r0(const Frame& F, const float* x) {
    const float* MOD = (const float*)(F.ws + WS_MOD);
    bf16_t* U = (bf16_t*)(F.ws + WS_U);
#ifdef HOIST_VEC
    int cb = -1; f32x4 psh[4], psc[4];
    f32x4 nx[4], n2[4];
    if (F.gw < T) ldvec4(nx, x + (size_t)F.gw * D, F.lane);
    if (F.gw + F.ngw < T) ldvec4(n2, x + (size_t)(F.gw + F.ngw) * D, F.lane);
    for (int row = F.gw; row < T; row += F.ngw) {
        f32x4 v[4];
#pragma unroll
        for (int j = 0; j < 4; ++j) { v[j] = nx[j]; nx[j] = n2[j]; }
        if (row + 2 * F.ngw < T) ldvec4(n2, x + (size_t)(row + 2 * F.ngw) * D, F.lane);
        if (row / S != cb) { cb = row / S; ldvec4(psh, MOD + (size_t)cb * MODW, F.lane); ldvec4(psc, MOD + (size_t)cb * MODW + D, F.lane); }
        row_mod_store_r(v, psh, psc, U + (size_t)row * D, F.lane);
    }
#else
    for (int row = F.gw; row < T; row += F.ngw) {
        f32x4 v[4];
#pragma unroll
        for (int j = 0; j < 4; ++j) v[j] = *(const f32x4*)(x + (size_t)row * D + 4 * F.lane + 256 * j);
        row_mod_store(v, MOD + (size_t)(row / S) * MODW, 0, D, U + (size_t)row * D, F.lane);
    }
#endif
}

#ifdef HOIST_VEC
#define RP1_GB(v_, rstd_, j_, col_) ((v_) * (rstd_) * hgn[j_] + hbs[j_])
#else
#define RP1_GB(v_, rstd_, j_, col_) ((v_) * (rstd_) * *(const f32x4*)(gain + (col_)) + *(const f32x4*)(bias + (col_)))
#endif
constexpr int NGRP = T / 64;
#ifdef RP1_SPREAD
#define RP1_ROW(w, rp) (16 * (rp) + 2 * (w))
#else
#define RP1_ROW(w, rp) (8 * (w) + 2 * (rp))
#endif
DI void p_rowpass1(const Frame& F, const Args& a, int l, const float* xin, const bool dry = false) {
    const float* MODl = (const float*)(F.ws + WS_MOD) + (size_t)l * NB * MODW;
    const bf16_t* MIX = (const bf16_t*)(F.ws + WS_MIX);
    float* XA = (float*)(F.ws + WS_XA); bf16_t* U = (bf16_t*)(F.ws + WS_U);
    const float* gain = a.in[20] + (size_t)l * D; const float* bias = a.in[21] + (size_t)l * D;
    const float* wg = a.in[24] + (size_t)l * D * NG; const float* bg = a.in[25] + (size_t)l * NG;
    const float* we = a.in[26] + (size_t)l * D * NE; const float* be = a.in[27] + (size_t)l * NE;
    const size_t dro = dry ? 490 * MiB - WS_BC : 0;
    int* BC = (int*)(F.ws + WS_BC + dro); float* TOKW = (float*)(F.ws + WS_TOKW + dro); int* TOKSLOT = (int*)(F.ws + WS_TOKSLOT + (dry ? 496 * MiB - WS_TOKSLOT : 0));
    LAS float* RT = (LAS float*)F.lds;
    LAS unsigned* cntl = (LAS unsigned*)(F.lds + 36 * D * 4 + NWAVES * 72 * 4);
#ifdef HOIST_VEC
    LAS float* rbias = (LAS float*)(F.lds + 36 * D * 4 + NWAVES * 72 * 4 + 128);
    if (F.tid < NG) rbias[F.tid] = bg[F.tid]; else if (F.tid < NG + NE) rbias[F.tid] = be[F.tid - NG];
#define RB_G(n_) rbias[n_]
#define RB_E(e_) rbias[NG + (e_)]
#else
#define RB_G(n_) bg[n_]
#define RB_E(e_) be[e_]
#endif
#if defined(RP1_EARLY) && !defined(RESBF)
    f32x4 pxa[4], pxb[4]; u32x2 pma[4], pmb[4];
    if (F.vcu < NGRP) { const int r0 = 64 * F.vcu + RP1_ROW(F.wave, 0);
#pragma unroll
      for (int j = 0; j < 4; ++j) { const int col = 4 * F.lane + 256 * j; pxa[j] = *(const f32x4*)(xin + (size_t)r0 * D + col); pxb[j] = *(const f32x4*)(xin + (size_t)(r0 + 1) * D + col);
          pma[j] = *(const u32x2*)(MIX + (size_t)r0 * D + col); pmb[j] = *(const u32x2*)(MIX + (size_t)(r0 + 1) * D + col); } }
#endif
#ifdef RT_DMA
    { const float* RTt = (const float*)(F.ws + WS_RTT) + (size_t)l * 36 * D;
#pragma unroll
      for (int p = 0; p < 18; ++p) { const int piece = F.wave * 18 + p;
          __builtin_amdgcn_global_load_lds((const unsigned*)(RTt + piece * 256 + F.lane * 4), (LAS unsigned*)(F.lds + piece * 1024), 16, 0, 0); } }
    if (false)
#endif
#ifdef DRY_NOFILL
    if (!dry)
#endif
#pragma unroll
    for (int kk = 0; kk < 2; ++kk) { const int k = F.tid + kk * NTHREADS;
        f32x4 v[9]; v[0] = *(const f32x4*)(wg + (size_t)k * NG);
#pragma unroll
        for (int q = 0; q < 8; ++q) v[1 + q] = *(const f32x4*)(we + (size_t)k * NE + 4 * q);
#pragma unroll
        for (int q = 0; q < 9; ++q)
#pragma unroll
            for (int e = 0; e < 4; ++e) RT[(4 * q + e) * D + k] = v[q][e]; }
    for (int grp = F.vcu; grp < NGRP; grp += F.G) {
    if (F.tid < NE) cntl[F.tid] = 0u;
    __syncthreads();
#ifdef RESBF
    const bool xbf = l > 0; const bf16_t* xinb = (const bf16_t*)xin; bf16_t* XAb = (bf16_t*)(F.ws + WS_XA);
    u32x4 pxa[4], pxb[4]; u32x2 pma[4], pmb[4];
#define RP1_LDX(dst, row_, col_) do { if (xbf) { const u32x2 t_ = *(const u32x2*)(xinb + (size_t)(row_) * D + (col_)); dst.x = t_.x; dst.y = t_.y; } else dst = *(const u32x4*)(xin + (size_t)(row_) * D + (col_)); } while (0)
#define RP1_XV(p_) (xbf ? (f32x4){bflo(p_.x), bfhi(p_.x), bflo(p_.y), bfhi(p_.y)} : __builtin_bit_cast(f32x4, p_))
#else
#ifndef RP1_EARLY
    f32x4 pxa[4], pxb[4]; u32x2 pma[4], pmb[4];
#endif
#define RP1_LDX(dst, row_, col_) dst = *(const f32x4*)(xin + (size_t)(row_) * D + (col_))
#define RP1_XV(p_) (p_)
#endif
#if defined(RP1_EARLY) && !defined(RESBF)
    if (grp != F.vcu)
#endif
    { const int r0 = 64 * grp + RP1_ROW(F.wave, 0);
#pragma unroll
      for (int j = 0; j < 4; ++j) { const int col = 4 * F.lane + 256 * j; RP1_LDX(pxa[j], r0, col); RP1_LDX(pxb[j], r0 + 1, col);
          pma[j] = *(const u32x2*)(MIX + (size_t)r0 * D + col); pmb[j] = *(const u32x2*)(MIX + (size_t)(r0 + 1) * D + col); } }
#ifdef HOIST_VEC
    f32x4 hg[4], hgn[4], hbs[4], hsh[4], hsc[4];
    { const float* mdg = MODl + (size_t)((64 * grp) / S) * MODW;
      ldvec4(hg, mdg + 2 * D, F.lane); ldvec4(hgn, gain, F.lane); ldvec4(hbs, bias, F.lane); ldvec4(hsh, mdg + 3 * D, F.lane); ldvec4(hsc, mdg + 4 * D, F.lane); }
#endif
    for (int rp = 0; rp < 4; ++rp) {
        const int row0 = 64 * grp + RP1_ROW(F.wave, rp); const float* md = MODl + (size_t)(row0 / S) * MODW;
        f32x4 va[4], vb[4];
#pragma unroll
        for (int j = 0; j < 4; ++j) { const int col = 4 * F.lane + 256 * j;
#ifdef HOIST_VEC
            const f32x4 g = hg[j]; (void)col;
#else
            const f32x4 g = *(const f32x4*)(md + 2 * D + col);
#endif
            va[j] = RP1_XV(pxa[j]) * ALPHA + g * (f32x4){bflo(pma[j].x), bfhi(pma[j].x), bflo(pma[j].y), bfhi(pma[j].y)};
            vb[j] = RP1_XV(pxb[j]) * ALPHA + g * (f32x4){bflo(pmb[j].x), bfhi(pmb[j].x), bflo(pmb[j].y), bfhi(pmb[j].y)}; }
        if (rp < 3) { const int r0 = 64 * grp + RP1_ROW(F.wave, rp + 1);
#pragma unroll
          for (int j = 0; j < 4; ++j) { const int col = 4 * F.lane + 256 * j; RP1_LDX(pxa[j], r0, col); RP1_LDX(pxb[j], r0 + 1, col);
              pma[j] = *(const u32x2*)(MIX + (size_t)r0 * D + col); pmb[j] = *(const u32x2*)(MIX + (size_t)(r0 + 1) * D + col); } }
        float mean, rstd;
        row_ln(va, mean, rstd);
#pragma unroll
        for (int j = 0; j < 4; ++j) { const int col = 4 * F.lane + 256 * j; va[j] = RP1_GB(va[j], rstd, j, col);
#ifdef RESBF
            *(u32x2*)(XAb + (size_t)row0 * D + col) = (u32x2){cvtpk(va[j][0], va[j][1]), cvtpk(va[j][2], va[j][3])}; }
#else
            ST16R(XA + (size_t)row0 * D + col, __builtin_bit_cast(u32x4, va[j])); }
#endif
        row_ln(vb, mean, rstd);
#pragma unroll
        for (int j = 0; j < 4; ++j) { const int col = 4 * F.lane + 256 * j; vb[j] = RP1_GB(vb[j], rstd, j, col);
#ifdef RESBF
            *(u32x2*)(XAb + (size_t)(row0 + 1) * D + col) = (u32x2){cvtpk(vb[j][0], vb[j][1]), cvtpk(vb[j][2], vb[j][3])}; }
#else
            ST16R(XA + (size_t)(row0 + 1) * D + col, __builtin_bit_cast(u32x4, vb[j])); }
#endif
#ifdef HOIST_VEC
        row_mod_store_r(va, hsh, hsc, U + (size_t)row0 * D, F.lane);
        row_mod_store_r(vb, hsh, hsc, U + (size_t)(row0 + 1) * D, F.lane);
        (void)md;
#else
        row_mod_store(va, md, 3 * D, 4 * D, U + (size_t)row0 * D, F.lane);
        row_mod_store(vb, md, 3 * D, 4 * D, U + (size_t)(row0 + 1) * D, F.lane);
#endif
#ifdef RT_DMA
        if (rp == 0) { asm volatile("s_waitcnt vmcnt(0)" ::: "memory"); __syncthreads(); }
#endif
#ifdef DRY_NOROUTER
        if (dry) continue;
#endif
        LAS float* lg = (LAS float*)(F.lds + 36 * D * 4) + F.wave * 72;
#ifdef ROUTER_FULL
#pragma unroll 1
        for (int n = 0; n < 36; n += 3) { float sa[3], sb[3];
#pragma unroll
            for (int q = 0; q < 3; ++q) { sa[q] = 0.f; sb[q] = 0.f;
#pragma unroll
                for (int j = 0; j < 4; ++j) { const f32x4 w = *(const LAS f32x4*)(RT + (n + q) * D + 4 * F.lane + 256 * j);
                    sa[q] += (va[j][0] * w[0] + va[j][1] * w[1]) + (va[j][2] * w[2] + va[j][3] * w[3]);
                    sb[q] += (vb[j][0] * w[0] + vb[j][1] * w[1]) + (vb[j][2] * w[2] + vb[j][3] * w[3]); } }
#pragma unroll
            for (int q = 0; q < 3; ++q) { sa[q] = wave_sum(sa[q]); sb[q] = wave_sum(sb[q]); }
            if (F.lane == 0) {
#pragma unroll
                for (int q = 0; q < 3; ++q) { lg[n + q] = sa[q]; lg[36 + n + q] = sb[q]; } } }
#else
        int gia, gib;
        { float sa[4], sb[4];
#pragma unroll
#ifdef ROUTER_BATCH
          for (int qh = 0; qh < 2; ++qh) { f32x4 w[8];
#pragma unroll
              for (int i = 0; i < 8; ++i) w[i] = *(const LAS f32x4*)(RT + (2 * qh + (i >> 2)) * D + 4 * F.lane + 256 * (i & 3));
              __builtin_amdgcn_sched_barrier(0);
#pragma unroll
              for (int i = 0; i < 8; ++i) { const int q = 2 * qh + (i >> 2), j = i & 3; if (j == 0) { sa[q] = 0.f; sb[q] = 0.f; }
                  sa[q] += (va[j][0] * w[i][0] + va[j][1] * w[i][1]) + (va[j][2] * w[i][2] + va[j][3] * w[i][3]);
                  sb[q] += (vb[j][0] * w[i][0] + vb[j][1] * w[i][1]) + (vb[j][2] * w[i][2] + vb[j][3] * w[i][3]); }
              __builtin_amdgcn_sched_barrier(0); }
#else
          for (int q = 0; q < 4; ++q) { sa[q] = 0.f; sb[q] = 0.f;
#pragma unroll
              for (int j = 0; j < 4; ++j) { const f32x4 w = *(const LAS f32x4*)(RT + q * D + 4 * F.lane + 256 * j);
                  sa[q] += (va[j][0] * w[0] + va[j][1] * w[1]) + (va[j][2] * w[2] + va[j][3] * w[3]);
                  sb[q] += (vb[j][0] * w[0] + vb[j][1] * w[1]) + (vb[j][2] * w[2] + vb[j][3] * w[3]); } }
#endif
#pragma unroll
          for (int q = 0; q < 4; ++q) { sa[q] = wave_sum(sa[q]); sb[q] = wave_sum(sb[q]); }
          if (F.lane == 0) {
#pragma unroll
              for (int q = 0; q < 4; ++q) { lg[q] = sa[q]; lg[36 + q] = sb[q]; } }
          gia = 0; gib = 0; float ma = sa[0] + RB_G(0), mb = sb[0] + RB_G(0);
#pragma unroll
          for (int q = 1; q < 4; ++q) { const float xa = sa[q] + RB_G(q), xb = sb[q] + RB_G(q); const bool ca = xa > ma, cb = xb > mb; ma = ca ? xa : ma; gia = ca ? q : gia; mb = cb ? xb : mb; gib = cb ? q : gib; }
          gia = __builtin_amdgcn_readfirstlane(gia); gib = __builtin_amdgcn_readfirstlane(gib); }
        { const LAS float* RA = RT + (4 + gia * EPG) * D + 4 * F.lane; const LAS float* RBp = RT + (4 + gib * EPG) * D + 4 * F.lane;
#pragma unroll 1
          for (int e0 = 0; e0 < EPG; e0 += 4) { float sa[4], sb[4];
#pragma unroll
#ifdef ROUTER_BATCH
              for (int q = 0; q < 4; ++q) { f32x4 wa[4], wb[4];
#pragma unroll
                  for (int j = 0; j < 4; ++j) { wa[j] = *(const LAS f32x4*)(RA + (e0 + q) * D + 256 * j); wb[j] = *(const LAS f32x4*)(RBp + (e0 + q) * D + 256 * j); }
                  __builtin_amdgcn_sched_barrier(0);
                  sa[q] = 0.f; sb[q] = 0.f;
#pragma unroll
                  for (int j = 0; j < 4; ++j) {
                      sa[q] += (va[j][0] * wa[j][0] + va[j][1] * wa[j][1]) + (va[j][2] * wa[j][2] + va[j][3] * wa[j][3]);
                      sb[q] += (vb[j][0] * wb[j][0] + vb[j][1] * wb[j][1]) + (vb[j][2] * wb[j][2] + vb[j][3] * wb[j][3]); }
                  __builtin_amdgcn_sched_barrier(0); }
#else
              for (int q = 0; q < 4; ++q) { sa[q] = 0.f; sb[q] = 0.f;
#pragma unroll
                  for (int j = 0; j < 4; ++j) { const f32x4 wa = *(const LAS f32x4*)(RA + (e0 + q) * D + 256 * j), wb = *(const LAS f32x4*)(RBp + (e0 + q) * D + 256 * j);
                      sa[q] += (va[j][0] * wa[0] + va[j][1] * wa[1]) + (va[j][2] * wa[2] + va[j][3] * wa[3]);
                      sb[q] += (vb[j][0] * wb[0] + vb[j][1] * wb[1]) + (vb[j][2] * wb[2] + vb[j][3] * wb[3]); } }
#endif
#pragma unroll
              for (int q = 0; q < 4; ++q) { sa[q] = wave_sum(sa[q]); sb[q] = wave_sum(sb[q]); }
              if (F.lane == 0) {
#pragma unroll
                  for (int q = 0; q < 4; ++q) { lg[4 + gia * EPG + e0 + q] = sa[q]; lg[36 + 4 + gib * EPG + e0 + q] = sb[q]; } } } }
#endif
        LDS_WAIT();
#pragma unroll
        for (int rr = 0; rr < 2; ++rr) {
            float gl[4];
#pragma unroll
            for (int n = 0; n < 4; ++n) gl[n] = lg[36 * rr + n] + RB_G(n);
            int gi = 0; float gm = gl[0];
#pragma unroll
            for (int n = 1; n < 4; ++n) { const bool c = gl[n] > gm; gm = c ? gl[n] : gm; gi = c ? n : gi; }
            gi = __builtin_amdgcn_readfirstlane(gi);
            float se = 0.f;
#pragma unroll
            for (int n = 0; n < 4; ++n) se += expf(gl[n] - gm);
            const float pg = 1.f / se;
            float l1 = -3.0e38f, l2 = -3.0e38f; int i1 = 0, i2 = 0;
#pragma unroll
            for (int e = 0; e < 8; ++e) { const float v = lg[36 * rr + 4 + gi * EPG + e] + RB_E(gi * EPG + e);
                const bool c1 = v > l1, c2 = v > l2;
                l2 = c1 ? l1 : (c2 ? v : l2); i2 = c1 ? i1 : (c2 ? e : i2); l1 = c1 ? v : l1; i1 = c1 ? e : i1; }
            const float e2 = expf(l2 - l1); const float w1 = pg / (1.f + e2), w2 = pg * e2 / (1.f + e2);
            if (F.lane == 0) {
                const int tok = row0 + rr, ea = gi * EPG + i1, eb = gi * EPG + i2;
                const unsigned pa = __hip_atomic_fetch_add(&cntl[ea], 1u, __ATOMIC_RELAXED, __HIP_MEMORY_SCOPE_WORKGROUP), pb = __hip_atomic_fetch_add(&cntl[eb], 1u, __ATOMIC_RELAXED, __HIP_MEMORY_SCOPE_WORKGROUP);
                TOKSLOT[tok * 2] = (ea << 14) | (int)pa; TOKSLOT[tok * 2 + 1] = (eb << 14) | (int)pb;
                TOKW[tok * 2] = w1; TOKW[tok * 2 + 1] = w2;
            }
        }
    }
    __syncthreads();
    if (F.tid < NE) BC[grp * NE + F.tid] = (int)cntl[F.tid];
    __syncthreads();
    }
}

DI void build_tables(const Frame& F, int l, LAS int* tb) {
    if (F.tid < 64) {
        const int e = F.lane; const int c = e < NE ? ((const int*)(F.ws + WS_CNTF))[e] : 0; const int tl = (c + 255) >> 8;
        int cum = c, tin = tl;
#pragma unroll
        for (int o = 1; o < 32; o <<= 1) { const int a1 = __shfl_up(cum, o), a2 = __shfl_up(tin, o); if (e >= o) { cum += a1; tin += a2; } }
        if (e < NE) { tb[e] = cum - c; tb[33 + e] = (tin - tl) * 256; for (int t2 = 0; t2 < tl; ++t2) tb[66 + (tin - tl) + t2] = e; }
        if (e == NE - 1) { tb[32] = cum; tb[65] = tin; }
    }
    __syncthreads();
}
DI void p_gather(const Frame& F, int l) {
    LAS int* base = (LAS int*)F.lds;
    LAS int* segt = base + NGRP * NE;
    LAS int* offp = segt + 16 * NE;
    const int* BC = (const int*)(F.ws + WS_BC);
    { int tmp[NGRP * NE / NTHREADS];
#pragma unroll
      for (int q = 0; q < NGRP * NE / NTHREADS; ++q) tmp[q] = BC[F.tid + q * NTHREADS];
#pragma unroll
      for (int q = 0; q < NGRP * NE / NTHREADS; ++q) base[F.tid + q * NTHREADS] = tmp[q]; }
    __syncthreads();
    { const int e = F.tid & 31, sg = F.tid >> 5; int run = 0;
      for (int g = 16 * sg; g < 16 * sg + 16; ++g) { const int c = base[g * NE + e]; base[g * NE + e] = run; run += c; }
      segt[sg * NE + e] = run; }
    __syncthreads();
    if (F.tid < NE) { int run = 0; for (int sg = 0; sg < 16; ++sg) { const int c = segt[sg * NE + F.tid]; segt[sg * NE + F.tid] = run; run += c; }
        offp[F.tid] = run;
        if (F.bx == 0) ((int*)(F.ws + WS_CNTF))[F.tid] = run; }
    __syncthreads();
    if (F.tid == 0) { int off = 0; for (int e = 0; e < NE; ++e) { const int c = offp[e]; offp[e] = off; off += ((c + 255) >> 8) * 256; } }
    __syncthreads();
    const int* TOKSLOT = (const int*)(F.ws + WS_TOKSLOT); const float* TOKW = (const float*)(F.ws + WS_TOKW); int* TOKFIN = (int*)(F.ws + WS_TOKFIN);
    float* SLOTW = (float*)(F.ws + WS_SLOTW);
    const int nas = (2 * T - F.gw + F.ngw - 1) / F.ngw;
    int my_slot = 0, my_tok = 0;
    if (F.lane < nas) { const int as = F.gw + F.lane * F.ngw; const int tok = as >> 1, ts = TOKSLOT[as], e = ts >> 14, grp = tok >> 6, sg = grp >> 4;
        my_slot = offp[e] + segt[sg * NE + e] + base[grp * NE + e] + (ts & 16383); my_tok = tok;
        SLOTW[my_slot] = TOKW[as]; TOKFIN[as] = my_slot; ((int*)(F.ws + WS_CTL + WS_SLOTTOK))[my_slot] = tok; }
}
#ifdef RESBF
struct Rp2In { u32x2 x[4]; u32x2 y0[4], y1[4]; };
DI void rp2_load(Rp2In& r, const float* XA, const bf16_t* YS, int row, int s0, int s1, int lane) {
    const bf16_t* XAb = (const bf16_t*)XA;
#pragma unroll
    for (int j = 0; j < 4; ++j) { const int col = 4 * lane + 256 * j;
        r.x[j] = *(const u32x2*)(XAb + (size_t)row * D + col); r.y0[j] = *(const u32x2*)(YS + (size_t)s0 * D + col); r.y1[j] = *(const u32x2*)(YS + (size_t)s1 * D + col); }
}
#define RP2_XV(p_) ((f32x4){bflo(p_.x), bfhi(p_.x), bflo(p_.y), bfhi(p_.y)})
#else
struct Rp2In { f32x4 x[4]; u32x2 y0[4], y1[4]; };
DI void rp2_load(Rp2In& r, const float* XA, const bf16_t* YS, int row, int s0, int s1, int lane) {
#pragma unroll
    for (int j = 0; j < 4; ++j) { const int col = 4 * lane + 256 * j;
        r.x[j] = *(const f32x4*)(XA + (size_t)row * D + col); r.y0[j] = *(const u32x2*)(YS + (size_t)s0 * D + col); r.y1[j] = *(const u32x2*)(YS + (size_t)s1 * D + col); }
}
#define RP2_XV(p_) (p_)
#endif
#ifdef RP2_ROT3
DI void rp2_row(const Frame& F, const Rp2In& cur, const int row, const int l, float* xout, bf16_t* U, const f32x4 (&hg)[4], const f32x4 (&hgn)[4], const f32x4 (&hbs)[4], const f32x4 (&hsh)[4], const f32x4 (&hsc)[4]) {
    f32x4 v[4];
#pragma unroll
    for (int j = 0; j < 4; ++j) { const u32x2 y0 = cur.y0[j], y1 = cur.y1[j];
        const f32x4 f = (f32x4){bflo(y0.x) + bflo(y1.x), bfhi(y0.x) + bfhi(y1.x), bflo(y0.y) + bflo(y1.y), bfhi(y0.y) + bfhi(y1.y)};
        v[j] = RP2_XV(cur.x[j]) * ALPHA + hg[j] * f; }
    float mean, rstd; row_ln(v, mean, rstd);
#pragma unroll
    for (int j = 0; j < 4; ++j) { const int col = 4 * F.lane + 256 * j; v[j] = v[j] * rstd * hgn[j] + hbs[j]; ST16R(xout + (size_t)row * D + col, __builtin_bit_cast(u32x4, v[j])); }
    if (l + 1 < L) row_mod_store_r(v, hsh, hsc, U + (size_t)row * D, F.lane);
}
DI void p_rowpass2(const Frame& F, const Args& a, int l, float* xout) {
    const float* MOD = (const float*)(F.ws + WS_MOD);
    const float* XA = (const float*)(F.ws + WS_XA); const bf16_t* YS = (const bf16_t*)(F.ws + WS_YS); const int* TOKFIN = (const int*)(F.ws + WS_TOKFIN);
    const float* gain = a.in[22] + (size_t)l * D; const float* bias = a.in[23] + (size_t)l * D;
    bf16_t* U = (bf16_t*)(F.ws + WS_U);
    const int nrows = (T - F.gw + F.ngw - 1) / F.ngw;
    int tf = 0; { const int i = F.lane >> 1; if (i < nrows) tf = TOKFIN[(F.gw + i * F.ngw) * 2 + (F.lane & 1)]; }
    int cbat = -1; f32x4 hg[4], hgn[4], hbs[4], hsh[4], hsc[4];
    ldvec4(hgn, gain, F.lane); ldvec4(hbs, bias, F.lane);
#pragma unroll
    for (int j = 0; j < 4; ++j) { hsh[j] = (f32x4){0.f, 0.f, 0.f, 0.f}; hsc[j] = hsh[j]; hg[j] = hsh[j]; }
    Rp2In A, B, C;
#define RP2_LD(buf, i_) do { if ((i_) < nrows) rp2_load(buf, XA, YS, F.gw + (i_) * F.ngw, __shfl(tf, 2 * (i_)), __shfl(tf, 2 * (i_) + 1), F.lane); } while (0)
#define RP2_DO(buf, i_) do { if ((i_) < nrows) { const int row_ = F.gw + (i_) * F.ngw; \
        if (row_ / S != cbat) { cbat = row_ / S; ldvec4(hg, MOD + (size_t)(l * NB + cbat) * MODW + 5 * D, F.lane); \
            if (l + 1 < L) { ldvec4(hsh, MOD + (size_t)((l + 1) * NB + cbat) * MODW, F.lane); ldvec4(hsc, MOD + (size_t)((l + 1) * NB + cbat) * MODW + D, F.lane); } } \
        rp2_row(F, buf, row_, l, xout, U, hg, hgn, hbs, hsh, hsc); } } while (0)
    RP2_LD(A, 0); RP2_LD(B, 1);
#pragma unroll 1
    for (int i = 0; i < nrows; i += 3) {
        RP2_LD(C, i + 2); RP2_DO(A, i);
        RP2_LD(A, i + 3); RP2_DO(B, i + 1);
        RP2_LD(B, i + 4); RP2_DO(C, i + 2);
    }
#undef RP2_LD
#undef RP2_DO
}
#else
DI void p_rowpass2(const Frame& F, const Args& a, int l, float* xout) {
    const float* MOD = (const float*)(F.ws + WS_MOD);
    const float* XA = (const float*)(F.ws + WS_XA); const bf16_t* YS = (const bf16_t*)(F.ws + WS_YS); const int* TOKFIN = (const int*)(F.ws + WS_TOKFIN);
    const float* gain = a.in[22] + (size_t)l * D; const float* bias = a.in[23] + (size_t)l * D;
    bf16_t* U = (bf16_t*)(F.ws + WS_U);
    const int nrows = (T - F.gw + F.ngw - 1) / F.ngw;
    int tf = 0; { const int i = F.lane >> 1; if (i < nrows) tf = TOKFIN[(F.gw + i * F.ngw) * 2 + (F.lane & 1)]; }
    Rp2In cur, nxt;
#ifdef RP2_PF2
    Rp2In nn;
    if (nrows > 0) rp2_load(cur, XA, YS, F.gw, __shfl(tf, 0), __shfl(tf, 1), F.lane);
    if (nrows > 1) rp2_load(nxt, XA, YS, F.gw + F.ngw, __shfl(tf, 2), __shfl(tf, 3), F.lane);
#else
    if (nrows > 0) rp2_load(cur, XA, YS, F.gw, __shfl(tf, 0), __shfl(tf, 1), F.lane);
#endif
#ifdef HOIST_VEC
    int cbat = -1; f32x4 hg[4], hgn[4], hbs[4], hsh[4], hsc[4];
    ldvec4(hgn, gain, F.lane); ldvec4(hbs, bias, F.lane);
#endif
    for (int i = 0; i < nrows; ++i) {
        const int row = F.gw + i * F.ngw;
#ifdef HOIST_VEC
        if (row / S != cbat) { cbat = row / S; ldvec4(hg, MOD + (size_t)(l * NB + cbat) * MODW + 5 * D, F.lane);
            if (l + 1 < L) { ldvec4(hsh, MOD + (size_t)((l + 1) * NB + cbat) * MODW, F.lane); ldvec4(hsc, MOD + (size_t)((l + 1) * NB + cbat) * MODW + D, F.lane); } }
#endif
#ifdef RP2_PF2
        if (i + 2 < nrows) rp2_load(nn, XA, YS, row + 2 * F.ngw, __shfl(tf, 2 * i + 4), __shfl(tf, 2 * i + 5), F.lane);
#else
        if (i + 1 < nrows) rp2_load(nxt, XA, YS, row + F.ngw, __shfl(tf, 2 * i + 2), __shfl(tf, 2 * i + 3), F.lane);
#endif
        const float* md = MOD + (size_t)(l * NB + row / S) * MODW;
        f32x4 v[4];
#pragma unroll
        for (int j = 0; j < 4; ++j) { const int col = 4 * F.lane + 256 * j;
#ifdef HOIST_VEC
            const f32x4 g = hg[j]; (void)md;
#else
            const f32x4 g = *(const f32x4*)(md + 5 * D + col);
#endif
            const u32x2 y0 = cur.y0[j], y1 = cur.y1[j];
            const f32x4 f = (f32x4){bflo(y0.x) + bflo(y1.x), bfhi(y0.x) + bfhi(y1.x), bflo(y0.y) + bflo(y1.y), bfhi(y0.y) + bfhi(y1.y)};
            v[j] = RP2_XV(cur.x[j]) * ALPHA + g * f; }
        float mean, rstd; row_ln(v, mean, rstd);
#pragma unroll
        for (int j = 0; j < 4; ++j) { const int col = 4 * F.lane + 256 * j;
#ifdef HOIST_VEC
            v[j] = v[j] * rstd * hgn[j] + hbs[j];
#else
            v[j] = v[j] * rstd * *(const f32x4*)(gain + col) + *(const f32x4*)(bias + col);
#endif
#ifdef TSTAMP
            if (l == L - 1) { const unsigned long long* st = (const unsigned long long*)(F.ws + WS_CTL + 40960); const float sc = 1.f + (float)(long long)(st[TS_B] - st[TS_A]) * 1e-5f; *(f32x4*)(xout + (size_t)row * D + col) = v[j] * sc; } else
#endif
#ifdef RESBF
            if (l + 1 < L) *(u32x2*)((bf16_t*)xout + (size_t)row * D + col) = (u32x2){cvtpk(v[j][0], v[j][1]), cvtpk(v[j][2], v[j][3])}; else
#endif
            ST16R(xout + (size_t)row * D + col, __builtin_bit_cast(u32x4, v[j])); }
#ifdef HOIST_VEC
        if (l + 1 < L) row_mod_store_r(v, hsh, hsc, U + (size_t)row * D, F.lane);
#else
        if (l + 1 < L) row_mod_store(v, MOD + (size_t)((l + 1) * NB + row / S) * MODW, 0, D, U + (size_t)row * D, F.lane);
#endif
        if (i + 1 < nrows) {
#pragma unroll
            for (int j = 0; j < 4; ++j) { cur.x[j] = nxt.x[j]; cur.y0[j] = nxt.y0[j]; cur.y1[j] = nxt.y1[j]; } }
#ifdef RP2_PF2
        if (i + 2 < nrows) {
#pragma unroll
            for (int j = 0; j < 4; ++j) { nxt.x[j] = nn.x[j]; nxt.y0[j] = nn.y0[j]; nxt.y1[j] = nn.y1[j]; } }
#endif
    }
}
#endif

#define MFMA16(a, b, c) __builtin_amdgcn_mfma_f32_16x16x32_bf16((a), (b), (c), 0, 0, 0)
#define MFMA32(a, b, c) __builtin_amdgcn_mfma_f32_32x32x16_bf16((a), (b), (c), 0, 0, 0)
constexpr int RB = 9216;
#define BUF(i) ((i) * RB)
constexpr int LWOFF = BUF(12), ZAOFF = BUF(0), SEGOFF = BUF(14), SEGXOFF = BUF(14) + 2048, TOTOFF = BUF(14) + 4096, NABFOFF = BUF(15), PCOFF = 16 * RB;
struct RwP { const float *conv, *w0, *w_up, *a0, *a_up, *g_up, *k_k, *k_a, *r_k, *gn_gain, *gn_bias; };

DI void lds_barrier() { asm volatile("s_waitcnt lgkmcnt(0)" ::: "memory"); __builtin_amdgcn_s_barrier(); asm volatile("" ::: "memory"); }
DI int swo(int row, int col) { return row * 144 + (((((col >> 3) ^ (row >> 3)) & 7) << 3) + (col & 7)) * 2; }
DI bf16x8 ldfrag(const LAS unsigned char* lds, int buf, int row, int ks, int lane) { return *(const LAS bf16x8*)(lds + buf + swo(row, 32 * ks + 8 * (lane >> 4))); }
DI f32x4 mm64(const LAS unsigned char* lds, int abuf, int arow0, int bbuf, int brow0, int lane) {
    f32x4 acc = (f32x4){0.f, 0.f, 0.f, 0.f};
#pragma unroll
    for (int ks = 0; ks < 2; ++ks) acc = MFMA16(ldfrag(lds, abuf, arow0 + (lane & 15), ks, lane), ldfrag(lds, bbuf, brow0 + (lane & 15), ks, lane), acc);
    return acc;
}
DI u32x2 pack4(const f32x4 v) { u32x2 w; w.x = cvtpk(v[0], v[1]); w.y = cvtpk(v[2], v[3]); return w; }
DI f32x4 unpack4(const u32x2 w) { return (f32x4){bflo(w.x), bfhi(w.x), bflo(w.y), bfhi(w.y)}; }
DI void st4(LAS unsigned char* lds, int buf, int row, int col, const f32x4 v) { *(LAS u32x2*)(lds + buf + swo(row, col)) = pack4(v); }
DI f32x4 ld4(const LAS unsigned char* lds, int buf, int row, int col) { return unpack4(*(const LAS u32x2*)(lds + buf + swo(row, col))); }
DI void st1(LAS unsigned char* lds, int buf, int row, int col, float v) { *(LAS bf16_t*)(lds + buf + swo(row, col)) = f2bf(v); }
DI float fast_tanh(float x) { const float e = fexp2(x * (2.f * LOG2E)); return 1.f - 2.f * frcp(1.f + e); }

#define OPQZ(z) int z; asm volatile("s_mov_b32 %0, 0" : "=s"(z))
constexpr int CWLOFF = PCOFF + 256;
constexpr int PRMOFF = CWLOFF + 6912;
struct RwPre { u32x2 wv, av; u32x4 gv; f32x4 w4, a4, g0, g1; u32x4 rr[3], kk[3], vv[3]; float prm; };
DI void rwkv_prefetch(const Frame& F, const Args& a, const int l, const int unit, RwPre& P) {
    const int tid = F.tid;
    const int c = unit % NCH, hd = (unit / NCH) % BH, b = (unit / (NCH * BH)) % NB, dir = unit / (NCH * BH * NB);
    const bf16_t* HBp = (const bf16_t*)(F.ws + WS_HB);
    const int u = tid >> 3, jg = tid & 7, tloc = 64 * c + u; const size_t tok = (size_t)b * S + tloc;
    const bf16_t* hrow = HBp + tok * HW;
    P.wv = *(const u32x2*)(hrow + HWL + 4 * jg); P.av = *(const u32x2*)(hrow + HAL + 4 * jg); P.gv = *(const u32x4*)(hrow + HGL + 8 * jg);
    OPQZ(z0);
    { const int m = tid >> 4, j4 = (tid & 15) * 4;
      const float* w_up = a.in[8 + z0] + (size_t)l * 2 * RW * BW; const float* a_up = a.in[10 + z0] + (size_t)l * 2 * RA * BW;
      P.w4 = *(const f32x4*)(w_up + (size_t)(dir * RW + m) * BW + hd * HD + j4); P.a4 = *(const f32x4*)(a_up + (size_t)(dir * RA + m) * BW + hd * HD + j4); }
    { const int m = tid >> 3, i8 = (tid & 7) * 8; const float* g_up = a.in[11 + z0] + (size_t)l * RG * BW;
      P.g0 = *(const f32x4*)(g_up + (size_t)m * BW + hd * HD + i8); P.g1 = *(const f32x4*)(g_up + (size_t)m * BW + hd * HD + i8 + 4); }
#ifdef PRM_PF
    P.prm = 0.f;
    if (tid < 320) { const int which = tid >> 6, j = tid & 63;
      const float* src = which == 0 ? a.in[7 + z0] + (size_t)l * 2 * BW + dir * BW : which == 1 ? a.in[9 + z0] + (size_t)l * 2 * BW + dir * BW : which == 2 ? a.in[12 + z0] + (size_t)l * BW : which == 3 ? a.in[13 + z0] + (size_t)l * BW : a.in[14 + z0] + (size_t)l * BH * HD;
      P.prm = src[hd * HD + j]; }
#endif
    const int ch0 = hd * HD + 8 * jg;
#pragma unroll
    for (int x = 0; x < 3; ++x) {
        const int tt = tloc + x - 1; const u32x4 z4 = (u32x4){0u, 0u, 0u, 0u};
        if (tt >= 0 && tt < S) { const bf16_t* hp = HBp + ((size_t)b * S + tt) * HW + HR + ch0; P.rr[x] = *(const u32x4*)hp; P.kk[x] = *(const u32x4*)(hp + BW); P.vv[x] = *(const u32x4*)(hp + 2 * BW); }
        else { P.rr[x] = z4; P.kk[x] = z4; P.vv[x] = z4; }
    }
}
DI void rwkv_local_unit(const Frame& F, const Args& a, const int l, const int unit, RwPre& PF, const int next_unit, const int rstop = 99) {
    LAS unsigned char* lds = F.lds;
    int tid_ = F.tid; asm volatile("" : "+v"(tid_));
    const int tid = tid_, lane = tid_ & 63, wave = F.wave;
    const int c = unit % NCH, hd = (unit / NCH) % BH, b = (unit / (NCH * BH)) % NB, dir = unit / (NCH * BH * NB);
    const bf16_t* HBp = (const bf16_t*)(F.ws + WS_HB);
    const int u = tid >> 3, jg = tid & 7, tau = dir ? 63 - u : u, tloc = 64 * c + u;
    const size_t tok = (size_t)b * S + tloc;
    const int tn = wave & 3, tm0 = 2 * (wave >> 2), g4 = lane >> 4, l15 = lane & 15;
#ifdef PRM_PF
    if (tid < 320) *(LAS float*)(lds + PRMOFF + tid * 4) = PF.prm;
    if (false) { OPQZ(z2); const int which = tid >> 6, j = tid & 63;
#else
    if (tid < 320) { OPQZ(z2); const int which = tid >> 6, j = tid & 63;
#endif
      const float* src = which == 0 ? a.in[7 + z2] + (size_t)l * 2 * BW + dir * BW : which == 1 ? a.in[9 + z2] + (size_t)l * 2 * BW + dir * BW : which == 2 ? a.in[12 + z2] + (size_t)l * BW : which == 3 ? a.in[13 + z2] + (size_t)l * BW : a.in[14 + z2] + (size_t)l * BH * HD;
      *(LAS float*)(lds + PRMOFF + tid * 4) = src[hd * HD + j]; }
    {
        const f32x4 wf = unpack4(PF.wv);
        *(LAS u32x2*)(lds + BUF(8) + swo(tau, 4 * jg)) = pack4((f32x4){fast_tanh(wf[0]), fast_tanh(wf[1]), fast_tanh(wf[2]), fast_tanh(wf[3])});
        *(LAS u32x2*)(lds + BUF(8) + swo(tau, 32 + 4 * jg)) = PF.av;
        const u32x4 gv = PF.gv;
        u32x4 so; so.x = cvtpk(sigm(bflo(gv.x)), sigm(bfhi(gv.x))); so.y = cvtpk(sigm(bflo(gv.y)), sigm(bfhi(gv.y))); so.z = cvtpk(sigm(bflo(gv.z)), sigm(bfhi(gv.z))); so.w = cvtpk(sigm(bflo(gv.w)), sigm(bfhi(gv.w)));
        *(LAS u32x4*)(lds + BUF(9) + swo(tau, 8 * jg)) = so;
        { const int m = tid >> 4, j4 = (tid & 15) * 4;
#pragma unroll
          for (int e = 0; e < 4; ++e) { st1(lds, BUF(10), j4 + e, m, PF.w4[e]); st1(lds, BUF(10), j4 + e, 32 + m, PF.a4[e]); } }
        { const int m = tid >> 3, i8 = (tid & 7) * 8;
#pragma unroll
          for (int e = 0; e < 4; ++e) { st1(lds, BUF(11), i8 + e, m, PF.g0[e]); st1(lds, BUF(11), i8 + 4 + e, m, PF.g1[e]); } }
    }
    lds_barrier();
#pragma unroll
    for (int tmi = 0; tmi < 2; ++tmi) {
        const int tm = tm0 + tmi; const f32x4 z = (f32x4){0.f, 0.f, 0.f, 0.f};
        const f32x4 zw = MFMA16(ldfrag(lds, BUF(10), 16 * tm + l15, 0, lane), ldfrag(lds, BUF(8), 16 * tn + l15, 0, lane), z);
        const f32x4 za = MFMA16(ldfrag(lds, BUF(10), 16 * tm + l15, 1, lane), ldfrag(lds, BUF(8), 16 * tn + l15, 1, lane), z);
        const int trow = 16 * tn + l15, jb = 16 * tm + 4 * g4;
        *(LAS f32x4*)(lds + LWOFF + (trow * 64 + jb) * 4) = zw;
        *(LAS f32x4*)(lds + ZAOFF + (trow * 64 + jb) * 4) = za;
        if (dir == 0) {
            const f32x4 gg = mm64(lds, BUF(11), 16 * tm, BUF(9), 16 * tn, lane);
            *(u32x2*)((bf16_t*)(F.ws + WS_GB) + ((size_t)b * S + 64 * c + trow) * BW + hd * HD + jb) = pack4(gg);
        }
    }
    lds_barrier();
    if (rstop <= 0) { if (next_unit >= 0) rwkv_prefetch(F, a, l, next_unit, PF); return; }
    const int ch0 = hd * HD + 8 * jg;
    float r[8], kd[8], kap[8], bb[8], lw[8];
    {
        float k[8], v[8];
#pragma unroll
        for (int e = 0; e < 8; ++e) { r[e] = 0.f; k[e] = 0.f; v[e] = 0.f; }
#pragma unroll
        for (int x = 0; x < 3; ++x) {
            const LAS unsigned char* cwp = lds + CWLOFF + (((hd * 3 + x) * 3) * 64 + 8 * jg) * 2;
            const u32x4 cr = *(const LAS u32x4*)cwp, ck = *(const LAS u32x4*)(cwp + 128), cv = *(const LAS u32x4*)(cwp + 256);
            const u32x4 rr = PF.rr[x], kk2 = PF.kk[x], vv = PF.vv[x];
            r[0] += bflo(rr.x) * bflo(cr.x); r[1] += bfhi(rr.x) * bfhi(cr.x); r[2] += bflo(rr.y) * bflo(cr.y); r[3] += bfhi(rr.y) * bfhi(cr.y);
            r[4] += bflo(rr.z) * bflo(cr.z); r[5] += bfhi(rr.z) * bfhi(cr.z); r[6] += bflo(rr.w) * bflo(cr.w); r[7] += bfhi(rr.w) * bfhi(cr.w);
            k[0] += bflo(kk2.x) * bflo(ck.x); k[1] += bfhi(kk2.x) * bfhi(ck.x); k[2] += bflo(kk2.y) * bflo(ck.y); k[3] += bfhi(kk2.y) * bfhi(ck.y);
            k[4] += bflo(kk2.z) * bflo(ck.z); k[5] += bfhi(kk2.z) * bfhi(ck.z); k[6] += bflo(kk2.w) * bflo(ck.w); k[7] += bfhi(kk2.w) * bfhi(ck.w);
            v[0] += bflo(vv.x) * bflo(cv.x); v[1] += bfhi(vv.x) * bfhi(cv.x); v[2] += bflo(vv.y) * bflo(cv.y); v[3] += bfhi(vv.y) * bfhi(cv.y);
            v[4] += bflo(vv.z) * bflo(cv.z); v[5] += bfhi(vv.z) * bfhi(cv.z); v[6] += bflo(vv.w) * bflo(cv.w); v[7] += bfhi(vv.w) * bfhi(cv.w);
        }
        const f32x4 zw0 = *(const LAS f32x4*)(lds + LWOFF + (tau * 64 + 8 * jg) * 4), zw1 = *(const LAS f32x4*)(lds + LWOFF + (tau * 64 + 8 * jg + 4) * 4);
        const f32x4 za0 = *(const LAS f32x4*)(lds + ZAOFF + (tau * 64 + 8 * jg) * 4), za1 = *(const LAS f32x4*)(lds + ZAOFF + (tau * 64 + 8 * jg + 4) * 4);
        float ss = 0.f, bsp = 0.f, av[8];
        const LAS f32x4* prm = (const LAS f32x4*)(lds + PRMOFF) + 2 * jg;
        const f32x4 w0a = prm[0], w0b = prm[1], a0a = prm[16], a0b = prm[17], kka = prm[32], kkb = prm[33], kaa = prm[48], kab = prm[49], rka = prm[64], rkb = prm[65];
#pragma unroll
        for (int e = 0; e < 8; ++e) {
            const float zw = (e < 4 ? zw0[e & 3] : zw1[e & 3]) + (e < 4 ? w0a[e & 3] : w0b[e & 3]);
            const float za = (e < 4 ? za0[e & 3] : za1[e & 3]) + (e < 4 ? a0a[e & 3] : a0b[e & 3]);
            lw[e] = (-DECAY * LOG2E) * sigm(zw); av[e] = sigm(za);
            kap[e] = k[e] * (e < 4 ? kka[e & 3] : kkb[e & 3]); ss += kap[e] * kap[e];
            kd[e] = k[e] * (1.f + (av[e] - 1.f) * (e < 4 ? kaa[e & 3] : kab[e & 3]));
            bsp += r[e] * kd[e] * (e < 4 ? rka[e & 3] : rkb[e & 3]);
        }
        ss += __shfl_xor(ss, 1); ss += __shfl_xor(ss, 2); ss += __shfl_xor(ss, 4);
        bsp += __shfl_xor(bsp, 1); bsp += __shfl_xor(bsp, 2); bsp += __shfl_xor(bsp, 4);
        const float rn = __builtin_amdgcn_rsqf(fmaxf(ss, 1e-24f));
#pragma unroll
        for (int e = 0; e < 8; ++e) { kap[e] *= rn; bb[e] = kap[e] * av[e]; }
        if (jg == 0) ((float*)(F.ws + WS_BS))[((size_t)dir * T + tok) * 8 + hd] = bsp;
        *(LAS f32x4*)(lds + LWOFF + (tau * 64 + 8 * jg) * 4) = (f32x4){lw[0], lw[1], lw[2], lw[3]};
        *(LAS f32x4*)(lds + LWOFF + (tau * 64 + 8 * jg + 4) * 4) = (f32x4){lw[4], lw[5], lw[6], lw[7]};
#pragma unroll
        for (int e = 0; e < 8; ++e) st1(lds, BUF(7), 8 * jg + e, tau, v[e]);
        if (dir == 0) {
            u32x4 vo; vo.x = cvtpk(v[0], v[1]); vo.y = cvtpk(v[2], v[3]); vo.z = cvtpk(v[4], v[5]); vo.w = cvtpk(v[6], v[7]);
            ST16V((bf16_t*)(F.ws + WS_VC) + tok * BW + ch0, vo);
        }
    }
    lds_barrier();
    if (rstop <= 1) { if (next_unit >= 0) rwkv_prefetch(F, a, l, next_unit, PF); return; }
    if (dir == 0) {
        const size_t ucidx = ((size_t)b * BH + hd) * NCH + c; const int vi = tid >> 3, vc = tid & 7;
        ST16V((bf16_t*)(F.ws + WS_VTB) + ucidx * 4096 + DFRAG(vi, vc * 8), *(const LAS u32x4*)(lds + BUF(7) + swo(vi, 8 * vc)));
    }
    { const int seg = tid >> 6, j = tid & 63; float p = 0.f;
#pragma unroll
      for (int i = 0; i < 8; ++i) { LAS float* q = (LAS float*)(lds + LWOFF + ((8 * seg + i) * 64 + j) * 4); p += *q; *q = p; }
      *(LAS float*)(lds + SEGOFF + (seg * 64 + j) * 4) = p; }
    lds_barrier();
    if (tid < 64) { float run = 0.f;
#pragma unroll
      for (int sg = 0; sg < 8; ++sg) { *(LAS float*)(lds + SEGXOFF + (sg * 64 + tid) * 4) = run; run += *(const LAS float*)(lds + SEGOFF + (sg * 64 + tid) * 4); }
      *(LAS float*)(lds + TOTOFF + tid * 4) = run; }
    lds_barrier();
    if (rstop <= 2) { if (next_unit >= 0) rwkv_prefetch(F, a, l, next_unit, PF); return; }
    {
        float At[8], Rt[8], Bt[8], Kt[8], Bh[8], Kh[8], pcs[8];
#pragma unroll
        for (int e = 0; e < 8; ++e) {
            const int j = 8 * jg + e;
            const float lwi = *(const LAS float*)(lds + LWOFF + (tau * 64 + j) * 4) + *(const LAS float*)(lds + SEGXOFF + ((tau >> 3) * 64 + j) * 4);
            const float tot = *(const LAS float*)(lds + TOTOFF + j * 4);
            const float ep = fexp2(lwi - lw[e]), epl = fexp2(lwi), em = fexp2(-lwi), ec = fexp2(tot - lwi);
            At[e] = -kap[e] * ep; Rt[e] = r[e] * epl; Bt[e] = bb[e] * em; Kt[e] = kd[e] * em; Bh[e] = bb[e] * ec; Kh[e] = kd[e] * ec;
            pcs[e] = tot;
        }
        if (u == 0) {
            *(LAS f32x4*)(lds + PCOFF + (8 * jg) * 4) = (f32x4){fexp2(pcs[0]), fexp2(pcs[1]), fexp2(pcs[2]), fexp2(pcs[3])};
            *(LAS f32x4*)(lds + PCOFF + (8 * jg + 4) * 4) = (f32x4){fexp2(pcs[4]), fexp2(pcs[5]), fexp2(pcs[6]), fexp2(pcs[7])}; }
        u32x4 o;
#define PK8(X) (o.x = cvtpk(X[0], X[1]), o.y = cvtpk(X[2], X[3]), o.z = cvtpk(X[4], X[5]), o.w = cvtpk(X[6], X[7]), o)
        *(LAS u32x4*)(lds + BUF(0) + swo(tau, 8 * jg)) = PK8(At);
        *(LAS u32x4*)(lds + BUF(1) + swo(tau, 8 * jg)) = PK8(Bt);
        *(LAS u32x4*)(lds + BUF(2) + swo(tau, 8 * jg)) = PK8(Kt);
        *(LAS u32x4*)(lds + BUF(3) + swo(tau, 8 * jg)) = PK8(Rt);
#undef PK8
#pragma unroll
        for (int e = 0; e < 8; ++e) { const int j = 8 * jg + e; st1(lds, BUF(4), j, tau, At[e]); st1(lds, BUF(5), j, tau, Bh[e]); st1(lds, BUF(6), j, tau, Kh[e]); }
    }
#ifndef PF_LATE
    if (next_unit >= 0) rwkv_prefetch(F, a, l, next_unit, PF);
#endif
    lds_barrier();
    if (rstop <= 3) {
#ifdef PF_LATE
        if (next_unit >= 0) rwkv_prefetch(F, a, l, next_unit, PF);
#endif
        return; }
#pragma unroll
    for (int tmi = 0; tmi < 2; ++tmi) {
        const int tm = tm0 + tmi, mb = 16 * tm + 4 * g4, nn = 16 * tn + l15;
        { f32x4 v = mm64(lds, BUF(1), 16 * tm, BUF(0), 16 * tn, lane);
#pragma unroll
          for (int e = 0; e < 4; ++e) v[e] = (mb + e < nn) ? v[e] : 0.f;
          if (tm == tn) {
#pragma unroll
              for (int e = 0; e < 4; ++e) *(LAS float*)(lds + NABFOFF + ((16 * tm + l15) * 16 + ((mb + e) & 15)) * 4) = v[e];
              v = (f32x4){0.f, 0.f, 0.f, 0.f};
          }
          st4(lds, BUF(11), nn, mb, v); }
        { f32x4 v = mm64(lds, BUF(0), 16 * tm, BUF(2), 16 * tn, lane);
#pragma unroll
          for (int e = 0; e < 4; ++e) v[e] = (nn < mb + e) ? v[e] : 0.f;
          st4(lds, BUF(8), nn, mb, v); }
        { f32x4 v = mm64(lds, BUF(1), 16 * tm, BUF(3), 16 * tn, lane);
#pragma unroll
          for (int e = 0; e < 4; ++e) v[e] = (mb + e <= nn) ? v[e] : 0.f;
          st4(lds, BUF(9), nn, mb, v); }
        { f32x4 v = mm64(lds, BUF(2), 16 * tm, BUF(3), 16 * tn, lane);
#pragma unroll
          for (int e = 0; e < 4; ++e) v[e] = (mb + e <= nn) ? v[e] : 0.f;
          st4(lds, BUF(10), nn, mb, v); }
    }
    lds_barrier();
    if (rstop <= 4) return;
    if (wave == 0) {
        const int blk = lane >> 4, sr = lane & 15, s = 16 * blk + sr;
        float Tr[16];
#ifdef INV_PIPE
        const LAS f32x4* colb = (const LAS f32x4*)(lds + NABFOFF + (16 * blk * 16) * 4);
        f32x4 cA[4], cB[4];
#pragma unroll
        for (int q = 0; q < 4; ++q) { cA[q] = colb[4 * 1 + q]; cB[q] = colb[4 * 2 + q]; }
        Tr[0] = (sr == 0) ? 1.f : 0.f;
#define INV_STEP(CUR, t_) do { constexpr int t = (t_); float a0 = (t == sr) ? 1.f : 0.f, a1 = 0.f, a2 = 0.f, a3 = 0.f; \
            _Pragma("unroll") for (int q = 0; q < (t + 3) / 4; ++q) { \
                if (4 * q + 0 < t) a0 += Tr[4 * q + 0] * CUR[q][0]; if (4 * q + 1 < t) a1 += Tr[4 * q + 1] * CUR[q][1]; \
                if (4 * q + 2 < t) a2 += Tr[4 * q + 2] * CUR[q][2]; if (4 * q + 3 < t) a3 += Tr[4 * q + 3] * CUR[q][3]; } \
            Tr[t] = (a0 + a1) + (a2 + a3); \
            if (t + 2 < 16) { _Pragma("unroll") for (int q = 0; q < (t + 2 + 3) / 4; ++q) CUR[q] = colb[4 * (t + 2) + q]; } \
            __builtin_amdgcn_sched_barrier(0); } while (0)
        INV_STEP(cA, 1); INV_STEP(cB, 2); INV_STEP(cA, 3); INV_STEP(cB, 4); INV_STEP(cA, 5); INV_STEP(cB, 6); INV_STEP(cA, 7); INV_STEP(cB, 8);
        INV_STEP(cA, 9); INV_STEP(cB, 10); INV_STEP(cA, 11); INV_STEP(cB, 12); INV_STEP(cA, 13); INV_STEP(cB, 14); INV_STEP(cA, 15);
#undef INV_STEP
#elif defined(INV_ACC4)
#pragma unroll
        for (int t = 0; t < 16; ++t) { float a0 = (t == sr) ? 1.f : 0.f, a1 = 0.f;
            const LAS f32x4* col = (const LAS f32x4*)(lds + NABFOFF + ((16 * blk + t) * 16) * 4);
#pragma unroll
            for (int q = 0; q < (t + 3) / 4; ++q) { const f32x4 nv = col[q];
                if (4 * q + 0 < t) a0 += Tr[4 * q + 0] * nv[0]; if (4 * q + 1 < t) a1 += Tr[4 * q + 1] * nv[1];
                if (4 * q + 2 < t) a0 += Tr[4 * q + 2] * nv[2]; if (4 * q + 3 < t) a1 += Tr[4 * q + 3] * nv[3]; }
            Tr[t] = a0 + a1; __builtin_amdgcn_sched_barrier(0); }
#else
#pragma unroll
        for (int t = 0; t < 16; ++t) { float acc = (t == sr) ? 1.f : 0.f;
            const LAS f32x4* col = (const LAS f32x4*)(lds + NABFOFF + ((16 * blk + t) * 16) * 4);
#pragma unroll
            for (int q = 0; q < (t + 3) / 4; ++q) { const f32x4 nv = col[q];
#pragma unroll
                for (int e = 0; e < 4; ++e) if (4 * q + e < t) acc += Tr[4 * q + e] * nv[e]; }
            Tr[t] = acc; __builtin_amdgcn_sched_barrier(0); }
#endif
        const u32x4 z4 = (u32x4){0u, 0u, 0u, 0u};
#pragma unroll
        for (int q = 0; q < 9; ++q) { *(LAS u32x4*)(lds + BUF(0) + s * 144 + 16 * q) = z4; *(LAS u32x4*)(lds + BUF(1) + s * 144 + 16 * q) = z4; }
        u32x4 o0, o1; o0.x = cvtpk(Tr[0], Tr[1]); o0.y = cvtpk(Tr[2], Tr[3]); o0.z = cvtpk(Tr[4], Tr[5]); o0.w = cvtpk(Tr[6], Tr[7]);
        o1.x = cvtpk(Tr[8], Tr[9]); o1.y = cvtpk(Tr[10], Tr[11]); o1.z = cvtpk(Tr[12], Tr[13]); o1.w = cvtpk(Tr[14], Tr[15]);
        LDS_WAIT();
        *(LAS u32x4*)(lds + BUF(0) + swo(s, 16 * blk)) = o0; *(LAS u32x4*)(lds + BUF(0) + swo(s, 16 * blk + 8)) = o1;
#pragma unroll
        for (int t = 0; t < 16; ++t) st1(lds, BUF(1), 16 * blk + t, s, Tr[t]);
    }
    lds_barrier();
    if (rstop == 45) return;
#pragma unroll
    for (int tmi = 0; tmi < 2; ++tmi) {
        const int tm = tm0 + tmi, mb = 16 * tm + 4 * g4, nn = 16 * tn + l15;
        const f32x4 v = mm64(lds, BUF(0), 16 * tm, BUF(11), 16 * tn, lane);
        st4(lds, BUF(12), nn, mb, v);
#pragma unroll
        for (int e = 0; e < 4; ++e) st1(lds, BUF(2), mb + e, nn, v[e]);
    }
    lds_barrier();
#pragma unroll
    for (int tmi = 0; tmi < 2; ++tmi) {
        const int tm = tm0 + tmi, mb = 16 * tm + 4 * g4, nn = 16 * tn + l15;
        const f32x4 v = mm64(lds, BUF(12), 16 * tm, BUF(2), 16 * tn, lane);
        st4(lds, BUF(13), nn, mb, v);
    }
    lds_barrier();
#pragma unroll
    for (int tmi = 0; tmi < 2; ++tmi) {
        const int tm = tm0 + tmi, mb = 16 * tm + 4 * g4, nn = 16 * tn + l15;
        const f32x4 v = mm64(lds, BUF(13), 16 * tm, BUF(1), 16 * tn, lane) + ld4(lds, BUF(1), nn, mb);
        st4(lds, BUF(14), nn, mb, v);
    }
    lds_barrier();
#pragma unroll
    for (int tmi = 0; tmi < 2; ++tmi) {
        const int tm = tm0 + tmi, mb = 16 * tm + 4 * g4, nn = 16 * tn + l15;
        const f32x4 v = mm64(lds, BUF(2), 16 * tm, BUF(14), 16 * tn, lane) + ld4(lds, BUF(14), nn, mb);
        st4(lds, BUF(15), nn, mb, v);
    }
    lds_barrier();
    if (rstop <= 5) return;
#ifdef PF_LATE
    if (next_unit >= 0) rwkv_prefetch(F, a, l, next_unit, PF);
#endif
#pragma unroll
    for (int tmi = 0; tmi < 2; ++tmi) {
        const int tm = tm0 + tmi, mb = 16 * tm + 4 * g4, nn = 16 * tn + l15;
        const f32x4 x1 = mm64(lds, BUF(15), 16 * tm, BUF(4), 16 * tn, lane);
        const f32x4 x2 = mm64(lds, BUF(15), 16 * tm, BUF(8), 16 * tn, lane);
        st4(lds, BUF(0), nn, mb, x1); st4(lds, BUF(1), nn, mb, x2);
    }
    lds_barrier();
    if (rstop <= 6) return;
    {
        bf16_t* QT = (bf16_t*)(F.ws + WS_QT) + (size_t)unit * 4096; bf16_t* WT = (bf16_t*)(F.ws + WS_WT) + (size_t)unit * 4096; bf16_t* MP = (bf16_t*)(F.ws + WS_MP) + USK(unit) * 4096;
#pragma unroll
        for (int tmi = 0; tmi < 2; ++tmi) {
            const int tm = tm0 + tmi, mb = 16 * tm + 4 * g4, nn = 16 * tn + l15;
            { const f32x4 v = mm64(lds, BUF(0), 16 * tm, BUF(9), 16 * tn, lane) + ld4(lds, BUF(3), nn, mb);
              *(u32x2*)(QT + DFRAG((dir ? 63 - nn : nn), mb)) = pack4(v); }
            { const f32x4 v = mm64(lds, BUF(1), 16 * tm, BUF(9), 16 * tn, lane) + ld4(lds, BUF(10), nn, mb);
              if (dir) *(u32x2*)(WT + DFRAG(63 - nn, 60 - mb)) = pack4((f32x4){v[3], v[2], v[1], v[0]});
              else *(u32x2*)(WT + DFRAG(nn, mb)) = pack4(v); }
            { const float pcv = *(const volatile LAS float*)(lds + PCOFF + nn * 4);
              f32x4 v = mm64(lds, BUF(0), 16 * tm, BUF(5), 16 * tn, lane);
#pragma unroll
              for (int e = 0; e < 4; ++e) v[e] += (mb + e == nn) ? pcv : 0.f;
#ifdef MP_FRAG
              { const int c = swap23(mb);
                *(u32x2*)(MP + ((nn >> 5) * 4 + (c >> 4)) * 512 + ((nn & 31) + 32 * ((c >> 3) & 1)) * 8 + (c & 7)) = pack4(v); } }
#else
              *(u32x2*)(MP + nn * 64 + swap23(mb)) = pack4(v); }
#endif
            { const f32x4 v = mm64(lds, BUF(1), 16 * tm, BUF(5), 16 * tn, lane) + ld4(lds, BUF(6), nn, mb);
              st4(lds, BUF(2), nn, mb, v); }
        }
    }
    lds_barrier();
    if (rstop <= 7) return;
    {
        bf16_t* NBp = (bf16_t*)(F.ws + WS_NB);
#pragma unroll
        for (int tmi = 0; tmi < 2; ++tmi) {
            const int tm = tm0 + tmi, mb = 16 * tm + 4 * g4, ii = 16 * tn + l15;
            const f32x4 v = mm64(lds, BUF(2), 16 * tm, BUF(7), 16 * tn, lane);
            const int jb = mb >> 5, jl = mb & 31, q = jl >> 3, hic = (jl >> 2) & 1, ih = ii >> 5, Lc = (ii & 31) + 32 * hic;
            *(u32x2*)(NBp + (((USK(unit) * 2 + ih) * 2 + jb) * 2 + (q >> 1)) * 512 + Lc * 8 + 4 * (q & 1)) = pack4(v);
        }
    }
    lds_barrier();
}

#ifdef KV_TILED
#define ATT_KLD(ktok_, ds_) (*(const bf16x8*)(KTp + ((((size_t)hh * (T / 32) + ((ktok_) >> 5)) * 4 + (ds_)) * 32 + q32) * 16 + 8 * hi))
#define ATT_VLD(ktok_, db_, s_) (*(const bf16x8*)(VTp + ((((size_t)hh * (T / 32) + ((ktok_) >> 5)) * 4 + (db_) * 2 + (s_)) * 32 + q32) * 16 + 8 * hi))
#else
#define ATT_KLD(ktok_, ds_) (*(const bf16x8*)(HBp + ((ktok_) + krow_off) * HW + HK + hh * HD + 16 * (ds_) + 8 * hi))
#define ATT_VLD(ktok_, db_, s_) (*(const bf16x8*)(VTp + (size_t)(hh * HD + 32 * (db_) + q32) * T + (ktok_) + 16 * (s_) + 8 * hi))
#endif
template <int QSEL_> DI void attn_unit_t(const Frame& F, const LAS float* rpbl, const int au) {
    constexpr int qsel = QSEL_;
    const bf16_t* HBp = (const bf16_t*)(F.ws + WS_HB); const bf16_t* VTp = (const bf16_t*)(F.ws + WS_VT); const bf16_t* KTp = (const bf16_t*)(F.ws + WS_KT); (void)KTp; bf16_t* CONCAT = (bf16_t*)(F.ws + WS_CONCAT);
    const int hh = au % AH, r = (au / AH) % ROWS, b = au / (AH * ROWS);
    int rstart = r - KH / 2; rstart = rstart < 0 ? 0 : (rstart > ROWS - KH ? ROWS - KH : rstart);
    const int lane = F.lane, q32 = lane & 31, hi = lane >> 5;
    const float SC = 0.125f * LOG2E;
    const int krow_off = swap23(q32);
    const int cqA = q32, cqB = 32 + q32;
    int csA = cqA - KW / 2; csA = csA < 0 ? 0 : csA; int csB = cqB - KW / 2; csB = csB > GW - KW ? GW - KW : csB;
    const size_t tokA = (size_t)b * S + r * GW + cqA, tokB = tokA + 32;
#ifdef ATT_FAST
    unsigned wmA0 = 0u, wmA1 = 0u, wmB0 = 0u, wmB1 = 0u;
#pragma unroll
    for (int i = 0; i < 16; ++i) { const int c0 = 16 * (i >> 3) + 8 * hi + (i & 7), c1 = c0 + 32;
        wmA0 |= ((c0 >= csA) && (c0 < csA + KW)) ? (1u << i) : 0u; wmA1 |= ((c1 >= csA) && (c1 < csA + KW)) ? (1u << i) : 0u;
        wmB0 |= ((c0 >= csB) && (c0 < csB + KW)) ? (1u << i) : 0u; wmB1 |= ((c1 >= csB) && (c1 < csB + KW)) ? (1u << i) : 0u; }
#endif
    bf16x8 qfA[4], qfB[4];
#pragma unroll
    for (int ds = 0; ds < 4; ++ds) { qfA[ds] = *(const bf16x8*)(HBp + tokA * HW + HQ + hh * HD + 16 * ds + 8 * hi); qfB[ds] = *(const bf16x8*)(HBp + tokB * HW + HQ + hh * HD + 16 * ds + 8 * hi); }
    f32x16 oA0, oA1, oB0, oB1;
#pragma unroll
    for (int i = 0; i < 16; ++i) { oA0[i] = 0.f; oA1[i] = 0.f; oB0[i] = 0.f; oB1[i] = 0.f; }
    float mA = -1e30f, lA = 0.f, mB = -1e30f, lB = 0.f;
#ifdef ATT_PF
    bf16x8 kf[4], kfn[4];
#ifdef ATT_PFV
    bf16x8 vf[2][2], vfn[2][2];
#endif
    { const size_t ktok = (size_t)b * S + rstart * GW;
#pragma unroll
      for (int ds = 0; ds < 4; ++ds) kf[ds] = ATT_KLD(ktok, ds);
#ifdef ATT_PFV
#pragma unroll
      for (int db = 0; db < 2; ++db)
#pragma unroll
          for (int s = 0; s < 2; ++s) vf[db][s] = ATT_VLD(ktok, db, s);
#endif
    }
    __builtin_amdgcn_s_waitcnt(0x0F70);
#endif
#pragma unroll 1
    for (int kt = 0; kt < 2 * KH; ++kt) {
        const int kr = rstart + (kt >> 1), ckb = 32 * (kt & 1);
        const size_t ktok = (size_t)b * S + kr * GW + ckb;
#ifdef ATT_PF
        { const int ktn = kt + 1 < 2 * KH ? kt + 1 : kt; const size_t ktokn = (size_t)b * S + (rstart + (ktn >> 1)) * GW + 32 * (ktn & 1);
#pragma unroll
          for (int ds = 0; ds < 4; ++ds) kfn[ds] = ATT_KLD(ktokn, ds);
#ifdef ATT_PFV
#pragma unroll
          for (int db = 0; db < 2; ++db)
#pragma unroll
              for (int s = 0; s < 2; ++s) vfn[db][s] = ATT_VLD(ktokn, db, s);
#endif
        }
#ifndef ATT_PFV
        bf16x8 vf[2][2];
#pragma unroll
        for (int db = 0; db < 2; ++db)
#pragma unroll
            for (int s = 0; s < 2; ++s) vf[db][s] = ATT_VLD(ktok, db, s);
#endif
#else
        bf16x8 kf[4], vf[2][2];
#pragma unroll
        for (int ds = 0; ds < 4; ++ds) kf[ds] = ATT_KLD(ktok, ds);
#pragma unroll
        for (int db = 0; db < 2; ++db)
#pragma unroll
            for (int s = 0; s < 2; ++s) vf[db][s] = ATT_VLD(ktok, db, s);
#endif
        const LAS float* rp = rpbl + (hh * (2 * KH - 1) + (kr - r + KH - 1)) * (2 * KW - 1);
#pragma unroll
        for (int qb = 0; qb < 2; ++qb) {
            if (qsel == 2 - qb) continue;
            const int cq = qb ? cqB : cqA, cs = qb ? csB : csA;
            f32x16 st;
#pragma unroll
            for (int i = 0; i < 16; ++i) st[i] = 0.f;
#pragma unroll
            for (int ds = 0; ds < 4; ++ds) st = MFMA32(kf[ds], qb ? qfB[ds] : qfA[ds], st);
            float sl[16]; float tmax = -1e30f;
            float bia[16];
#ifdef ATT_FAST
            { const LAS float* rb = rp + (ckb + 8 * hi - cq + KW - 1);
#pragma unroll
              for (int i = 0; i < 16; ++i) bia[i] = *(const volatile LAS float*)(rb + 16 * (i >> 3) + (i & 7)); }
            const unsigned wm = qb ? (ckb ? wmB1 : wmB0) : (ckb ? wmA1 : wmA0);
#pragma unroll
            for (int i = 0; i < 16; ++i) {
                const float sv = st[i] * SC + bia[i];
                sl[i] = ((wm >> i) & 1u) ? sv : -3e38f;
                tmax = fmaxf(tmax, sl[i]);
            }
            tmax = fmaxf(tmax, __shfl_xor(tmax, 32));
            const float mrun = qb ? mB : mA;
#ifdef ATT_DEFER
            const bool need_ = tmax > mrun + 8.f;
            float mn = mrun, corr = 1.f;
            if (__builtin_amdgcn_ballot_w64(need_) != 0ull) {
                mn = need_ ? tmax : mrun; corr = need_ ? __builtin_amdgcn_exp2f(mrun - mn) : 1.f;
                if (qb == 0) {
#pragma unroll
                    for (int i = 0; i < 16; ++i) { oA0[i] *= corr; oA1[i] *= corr; }
                } else {
#pragma unroll
                    for (int i = 0; i < 16; ++i) { oB0[i] *= corr; oB1[i] *= corr; }
                }
            }
#else
            const float mn = fmaxf(mrun, tmax), corr = __builtin_amdgcn_exp2f(mrun - mn);
#endif
            float ps = 0.f;
#pragma unroll
            for (int i = 0; i < 16; ++i) { sl[i] = __builtin_amdgcn_exp2f(sl[i] - mn); ps += sl[i]; }
#else
#pragma unroll
            for (int i = 0; i < 16; ++i) {
                const int ck = ckb + 16 * (i >> 3) + 8 * hi + (i & 7);
                int dc = ck - cq; dc = dc < -(KW - 1) ? -(KW - 1) : (dc > KW - 1 ? KW - 1 : dc); dc += KW - 1;
                bia[i] = *(const volatile LAS float*)(rp + dc);
            }
#pragma unroll
            for (int i = 0; i < 16; ++i) {
                const int ck = ckb + 16 * (i >> 3) + 8 * hi + (i & 7);
                const bool inw = (ck >= cs) && (ck < cs + KW);
                const float sv = st[i] * SC + bia[i];
                sl[i] = inw ? sv : -1e30f;
                tmax = fmaxf(tmax, sl[i]);
            }
            tmax = fmaxf(tmax, __shfl_xor(tmax, 32));
            const float mrun = qb ? mB : mA;
            const float mn = fmaxf(mrun, tmax), corr = __builtin_amdgcn_exp2f(mrun - mn);
            float ps = 0.f;
#pragma unroll
            for (int i = 0; i < 16; ++i) { sl[i] = (sl[i] > -1e29f) ? __builtin_amdgcn_exp2f(sl[i] - mn) : 0.f; ps += sl[i]; }
#endif
            u32x4 p0, p1;
            p0.x = cvtpk(sl[0], sl[1]); p0.y = cvtpk(sl[2], sl[3]); p0.z = cvtpk(sl[4], sl[5]); p0.w = cvtpk(sl[6], sl[7]);
            p1.x = cvtpk(sl[8], sl[9]); p1.y = cvtpk(sl[10], sl[11]); p1.z = cvtpk(sl[12], sl[13]); p1.w = cvtpk(sl[14], sl[15]);
            const bf16x8 pf0 = __builtin_bit_cast(bf16x8, p0), pf1 = __builtin_bit_cast(bf16x8, p1);
            if (qb == 0) { lA = lA * corr + ps; mA = mn;
#ifndef ATT_DEFER
#pragma unroll
                for (int i = 0; i < 16; ++i) { oA0[i] *= corr; oA1[i] *= corr; }
#endif
                oA0 = MFMA32(vf[0][0], pf0, oA0); oA0 = MFMA32(vf[0][1], pf1, oA0); oA1 = MFMA32(vf[1][0], pf0, oA1); oA1 = MFMA32(vf[1][1], pf1, oA1);
            } else { lB = lB * corr + ps; mB = mn;
#ifndef ATT_DEFER
#pragma unroll
                for (int i = 0; i < 16; ++i) { oB0[i] *= corr; oB1[i] *= corr; }
#endif
                oB0 = MFMA32(vf[0][0], pf0, oB0); oB0 = MFMA32(vf[0][1], pf1, oB0); oB1 = MFMA32(vf[1][0], pf0, oB1); oB1 = MFMA32(vf[1][1], pf1, oB1);
            }
        }
#ifdef ATT_PF
#pragma unroll
        for (int ds = 0; ds < 4; ++ds) kf[ds] = kfn[ds];
#ifdef ATT_PFV
#pragma unroll
        for (int db = 0; db < 2; ++db)
#pragma unroll
            for (int s = 0; s < 2; ++s) vf[db][s] = vfn[db][s];
#endif
#endif
    }
    if (qsel != 2) { const float inv = 1.f / (lA + __shfl_xor(lA, 32)); bf16_t* op = CONCAT + tokA * D + hh * HD;
#pragma unroll
      for (int g = 0; g < 4; ++g) {
          *(u32x2*)(op + 8 * g + 4 * hi) = pack4((f32x4){oA0[4 * g] * inv, oA0[4 * g + 1] * inv, oA0[4 * g + 2] * inv, oA0[4 * g + 3] * inv});
          *(u32x2*)(op + 32 + 8 * g + 4 * hi) = pack4((f32x4){oA1[4 * g] * inv, oA1[4 * g + 1] * inv, oA1[4 * g + 2] * inv, oA1[4 * g + 3] * inv}); } }
    if (qsel != 1) { const float inv = 1.f / (lB + __shfl_xor(lB, 32)); bf16_t* op = CONCAT + tokB * D + hh * HD;
#pragma unroll
      for (int g = 0; g < 4; ++g) {
          *(u32x2*)(op + 8 * g + 4 * hi) = pack4((f32x4){oB0[4 * g] * inv, oB0[4 * g + 1] * inv, oB0[4 * g + 2] * inv, oB0[4 * g + 3] * inv});
          *(u32x2*)(op + 32 + 8 * g + 4 * hi) = pack4((f32x4){oB1[4 * g] * inv, oB1[4 * g + 1] * inv, oB1[4 * g + 2] * inv, oB1[4 * g + 3] * inv}); } }
}

DI void attn_unit(const Frame& F, const LAS float* rpbl, const int au, const int qsel = 0) {
    if (qsel == 0) attn_unit_t<0>(F, rpbl, au); else if (qsel == 1) attn_unit_t<1>(F, rpbl, au); else attn_unit_t<2>(F, rpbl, au);
}
DI void pool_unit(const Frame& F, const float* pool_w, const float* pool_scale, const int pu) {
    const bf16_t* HBp = (const bf16_t*)(F.ws + WS_HB); bf16_t* CONCAT = (bf16_t*)(F.ws + WS_CONCAT);
    const int g = pu & 3, blk = pu >> 2, b = blk >> 8, t0 = (blk & 255) * 32;
    const int lane = F.lane, q32 = lane & 31, hi = lane >> 5, t = t0 + q32, win = 2 << g;
    int lo = t - win / 2; lo = lo < 0 ? 0 : lo; int hit = t + win / 2 - 1; hit = hit > S - 1 ? S - 1 : hit;
    const float inv = 1.f / (float)(hit - lo + 1);
    f32x16 out0, out1;
#pragma unroll
    for (int i = 0; i < 16; ++i) { out0[i] = 0.f; out1[i] = 0.f; }
    const float* pw = pool_w + (size_t)g * 64 * 64;
#pragma unroll 1
    for (int s = 0; s < 4; ++s) {
        const int c0 = HP + g * 64 + 16 * s + 8 * hi;
        float acc[8];
#pragma unroll
        for (int e = 0; e < 8; ++e) acc[e] = 0.f;
        u32x4 pv[16];
#pragma unroll
        for (int d = 0; d < 16; ++d) { int tt = t - win / 2 + d; const bool ok = d < win && tt >= 0 && tt < S; tt = ok ? tt : t;
            pv[d] = *(const u32x4*)(HBp + ((size_t)b * S + tt) * HW + c0); if (!ok) pv[d] = (u32x4){0u, 0u, 0u, 0u}; }
#pragma unroll
        for (int d = 0; d < 16; ++d) {
            acc[0] += bflo(pv[d].x); acc[1] += bfhi(pv[d].x); acc[2] += bflo(pv[d].y); acc[3] += bfhi(pv[d].y); acc[4] += bflo(pv[d].z); acc[5] += bfhi(pv[d].z); acc[6] += bflo(pv[d].w); acc[7] += bfhi(pv[d].w);
        }
        const u32x4 pc = *(const u32x4*)(HBp + ((size_t)b * S + t) * HW + c0);
        u32x4 o;
        o.x = cvtpk(acc[0] * inv - bflo(pc.x), acc[1] * inv - bfhi(pc.x)); o.y = cvtpk(acc[2] * inv - bflo(pc.y), acc[3] * inv - bfhi(pc.y));
        o.z = cvtpk(acc[4] * inv - bflo(pc.z), acc[5] * inv - bfhi(pc.z)); o.w = cvtpk(acc[6] * inv - bflo(pc.w), acc[7] * inv - bfhi(pc.w));
        const bf16x8 bfr = __builtin_bit_cast(bf16x8, o);
        const float* wp = pw + (size_t)(16 * s + 8 * hi) * 64 + q32;
        u32x4 w0; w0.x = cvtpk(wp[0], wp[64]); w0.y = cvtpk(wp[128], wp[192]); w0.z = cvtpk(wp[256], wp[320]); w0.w = cvtpk(wp[384], wp[448]);
        u32x4 w1; w1.x = cvtpk(wp[32], wp[96]); w1.y = cvtpk(wp[160], wp[224]); w1.z = cvtpk(wp[288], wp[352]); w1.w = cvtpk(wp[416], wp[480]);
        out0 = MFMA32(__builtin_bit_cast(bf16x8, w0), bfr, out0);
        out1 = MFMA32(__builtin_bit_cast(bf16x8, w1), bfr, out1);
    }
    bf16_t* op = CONCAT + ((size_t)b * S + t) * D + AW + BW + g * 64;
    const float* ps = pool_scale + g * 64;
    f32x4 s0r[4], s1r[4];
#pragma unroll
    for (int gq = 0; gq < 4; ++gq) { const int e0 = 8 * gq + 4 * hi; s0r[gq] = *(const f32x4*)(ps + e0); s1r[gq] = *(const f32x4*)(ps + 32 + e0); }
#pragma unroll
    for (int gq = 0; gq < 4; ++gq) {
        const int e0 = 8 * gq + 4 * hi;
        const f32x4 s0 = s0r[gq], s1 = s1r[gq];
        *(u32x2*)(op + e0) = pack4((f32x4){out0[4 * gq] * s0[0], out0[4 * gq + 1] * s0[1], out0[4 * gq + 2] * s0[2], out0[4 * gq + 3] * s0[3]});
        *(u32x2*)(op + 32 + e0) = pack4((f32x4){out1[4 * gq] * s1[0], out1[4 * gq + 1] * s1[1], out1[4 * gq + 2] * s1[2], out1[4 * gq + 3] * s1[3]});
    }
}

#ifndef SCAN_RING_N
#define SCAN_RING_N 12
#endif
#ifndef NSTG
#define NSTG 2
#endif
#ifndef NWR
#define NWR 1
#endif
constexpr int SCAN_SLOT = 12288, SCAN_RING = SCAN_RING_N;
constexpr int SCAN_FLAGS = SCAN_RING * SCAN_SLOT;
DI void scan_issue(const Frame& F, const int sc, const int ihalf, const int dir, const int step, const int lane) {
    const int c = dir ? NCH - 1 - step : step; const size_t unit = (size_t)sc * NCH + c;
    const int il = lane & 31, hi = lane >> 5;
    LAS unsigned char* slot = F.lds + (step % SCAN_RING) * SCAN_SLOT;
    const bf16_t* MP = (const bf16_t*)(F.ws + WS_MP) + USK(unit) * 4096; const bf16_t* NBp = (const bf16_t*)(F.ws + WS_NB) + (USK(unit) * 2 + ihalf) * 2048;
#pragma unroll
    for (int p = 0; p < 8; ++p) { const int jpb = p >> 2, jb = (p >> 1) & 1, s = p & 1;
#ifdef MP_FRAG
        (void)jpb; (void)jb; (void)s;
        __builtin_amdgcn_global_load_lds((const unsigned*)(MP + p * 512 + lane * 8), (LAS unsigned*)(slot + p * 1024), 16, 0, 0); }
#else
        __builtin_amdgcn_global_load_lds((const unsigned*)(MP + (32 * jpb + il) * 64 + 32 * jb + 16 * s + 8 * hi), (LAS unsigned*)(slot + p * 1024), 16, 0, 0); }
#endif
#pragma unroll
    for (int p = 0; p < 4; ++p)
        __builtin_amdgcn_global_load_lds((const unsigned*)(NBp + p * 512 + lane * 8), (LAS unsigned*)(slot + 8192 + p * 1024), 16, 0, 0);
}
DI unsigned lds_ld_u32(const volatile LAS unsigned* p) { return __builtin_amdgcn_readfirstlane(*p); }
#ifndef NLD
#define NLD 2
#endif
constexpr int SC_INFL = NLD == 2 ? 5 : (NLD == 3 ? 4 : 3);
DI void scan_loader(const Frame& F, const int sw, const int ld) {
    const int ihalf = sw & 1, sc = sw >> 1, dir = sc / (NB * BH);
    volatile LAS unsigned* ready = (volatile LAS unsigned*)(F.lds + SCAN_FLAGS); volatile LAS unsigned* cons = ready + 16;
    const int nmine = (NCH - ld + NLD - 1) / NLD;
    constexpr int LAG = SC_INFL - 1;
    for (int k = 0; k < nmine + LAG; ++k) {
        if (k < nmine) {
            const int s = NLD * k + ld;
            if (s >= SCAN_RING) { unsigned spins = 0; while ((int)lds_ld_u32(cons) < s - SCAN_RING + 1) { __builtin_amdgcn_s_sleep(1); if (++spins > (1u << 22)) break; } }
            asm volatile("" ::: "memory");
            scan_issue(F, sc, ihalf, dir, s, F.lane);
        }
        if (k >= LAG) {
            const int kd = k - LAG;
            if (kd < nmine) {
                const int rem = nmine - 1 - kd;
                const int out = rem < LAG ? rem : LAG;
                if (out == 4) asm volatile("s_waitcnt vmcnt(48)" ::: "memory");
                else if (out == 3) asm volatile("s_waitcnt vmcnt(36)" ::: "memory");
                else if (out == 2) asm volatile("s_waitcnt vmcnt(24)" ::: "memory");
                else if (out == 1) asm volatile("s_waitcnt vmcnt(12)" ::: "memory");
                else asm volatile("s_waitcnt vmcnt(0)" ::: "memory");
                const int sd = NLD * kd + ld;
                if (F.lane == 0) ready[sd % SCAN_RING] = (unsigned)(sd + 1);
                asm volatile("s_waitcnt lgkmcnt(0)" ::: "memory");
            }
        }
    }
}
constexpr int S0_STAGE = SCAN_FLAGS + 256;
DI void scan_writer(const Frame& F, const int sw, const int wi = 0) {
    const int ihalf = sw & 1, sc = sw >> 1, dir = sc / (NB * BH);
    volatile LAS unsigned* ready = (volatile LAS unsigned*)(F.lds + SCAN_FLAGS);
    volatile LAS unsigned* s0rdy = ready + 17; volatile LAS unsigned* s0done = ready + 18 + wi;
    bf16_t* S0 = (bf16_t*)(F.ws + WS_S0);
    const int lane = F.lane;
#pragma unroll 1
    for (int step = wi; step < NCH; step += NWR) {
        const int c = dir ? NCH - 1 - step : step; const size_t unit = (size_t)sc * NCH + c;
        { unsigned spins = 0; while ((int)lds_ld_u32(s0rdy) < step + 1) { __builtin_amdgcn_s_sleep(1); if (++spins > (1u << 22)) break; } }
        asm volatile("" ::: "memory");
        const LAS unsigned char* sl = F.lds + S0_STAGE + (step % NSTG) * (32 * 144);
        u32x4 v[4];
#pragma unroll
        for (int p = 0; p < 4; ++p) { const int idx = p * 64 + lane; v[p] = *(const LAS u32x4*)(sl + (idx >> 3) * 144 + (idx & 7) * 16); }
        asm volatile("s_waitcnt lgkmcnt(0)" ::: "memory");
        if (lane == 0) *s0done = (unsigned)(step + 1);
#ifdef D_FRAG
        bf16_t* dst = S0 + USK(unit) * 4096;
#pragma unroll
        for (int p = 0; p < 4; ++p) { const int idx = p * 64 + lane; ST16S(dst + DFRAG(32 * ihalf + (idx >> 3), (idx & 7) * 8), v[p]); }
#else
        bf16_t* dst = S0 + USK(unit) * 4096 + ihalf * 2048;
#pragma unroll
        for (int p = 0; p < 4; ++p) *(u32x4*)(dst + (p * 64 + lane) * 8) = v[p];
#endif
#ifdef DBL_WST
#pragma unroll
        for (int p = 0; p < 4; ++p) *(u32x4*)(dst + (size_t)16 * 1024 * 1024 + (p * 64 + lane) * 8) = v[p];
#endif
    }
}
#ifdef SCAN_U2
#define SCAN_STEP(MA, NBV, MAN, NBN, STEP) do { \
        const int step_ = (STEP); const bool more_ = step_ + 1 < NCH; \
        { const int needd = step_ - NSTG + 1; const unsigned wantr = (unsigned)(step_ + 2); \
          volatile LAS unsigned* pr_ = ready + ((step_ + 1) % SCAN_RING); volatile LAS unsigned* pd_ = s0done + ((step_ >= NSTG ? step_ - NSTG : 0) % NWR); unsigned spins_ = 0; \
          for (;;) { unsigned r_ = *pr_, d_ = *pd_; r_ = __builtin_amdgcn_readfirstlane(r_); d_ = __builtin_amdgcn_readfirstlane(d_); \
              if ((!more_ || r_ == wantr) && (step_ < NSTG || (int)d_ >= needd)) break; __builtin_amdgcn_s_sleep(1); if (++spins_ > (1u << 22)) break; } } \
        asm volatile("" ::: "memory"); \
        if (more_) { const LAS unsigned char* slot_ = F.lds + ((step_ + 1) % SCAN_RING) * SCAN_SLOT; \
            _Pragma("unroll") for (int p = 0; p < 8; ++p) MAN[p] = *(const LAS bf16x8*)(slot_ + p * 1024 + lane * 16); \
            _Pragma("unroll") for (int p = 0; p < 4; ++p) NBN[p] = *(const LAS u32x4*)(slot_ + 8192 + p * 1024 + lane * 16); } \
        u32x4 b00, b01, b10, b11; \
        b00.x = cvtpk(st0[0], st0[1]); b00.y = cvtpk(st0[2], st0[3]); b00.z = cvtpk(st0[4], st0[5]); b00.w = cvtpk(st0[6], st0[7]); \
        b01.x = cvtpk(st0[8], st0[9]); b01.y = cvtpk(st0[10], st0[11]); b01.z = cvtpk(st0[12], st0[13]); b01.w = cvtpk(st0[14], st0[15]); \
        b10.x = cvtpk(st1[0], st1[1]); b10.y = cvtpk(st1[2], st1[3]); b10.z = cvtpk(st1[4], st1[5]); b10.w = cvtpk(st1[6], st1[7]); \
        b11.x = cvtpk(st1[8], st1[9]); b11.y = cvtpk(st1[10], st1[11]); b11.z = cvtpk(st1[12], st1[13]); b11.w = cvtpk(st1[14], st1[15]); \
        { LAS unsigned char* sl_ = F.lds + S0_STAGE + (step_ % NSTG) * (32 * 144) + il * 144 + 8 * hi; \
          *(LAS u32x2*)(sl_ + 0) = (u32x2){b00.x, b00.y};  *(LAS u32x2*)(sl_ + 16) = (u32x2){b00.z, b00.w}; \
          *(LAS u32x2*)(sl_ + 32) = (u32x2){b01.x, b01.y}; *(LAS u32x2*)(sl_ + 48) = (u32x2){b01.z, b01.w}; \
          *(LAS u32x2*)(sl_ + 64) = (u32x2){b10.x, b10.y}; *(LAS u32x2*)(sl_ + 80) = (u32x2){b10.z, b10.w}; \
          *(LAS u32x2*)(sl_ + 96) = (u32x2){b11.x, b11.y}; *(LAS u32x2*)(sl_ + 112) = (u32x2){b11.z, b11.w}; \
          asm volatile("" ::: "memory"); \
          if (lane == 0) *s0rdy = (unsigned)(step_ + 1); } \
        const bf16x8 p00 = __builtin_bit_cast(bf16x8, b00), p01 = __builtin_bit_cast(bf16x8, b01), p10 = __builtin_bit_cast(bf16x8, b10), p11 = __builtin_bit_cast(bf16x8, b11); \
        f32x16 n0, n1; \
        _Pragma("unroll") for (int h2 = 0; h2 < 2; ++h2) { \
            n0[8 * h2 + 0] = bflo(NBV[h2].x); n0[8 * h2 + 1] = bfhi(NBV[h2].x); n0[8 * h2 + 2] = bflo(NBV[h2].y); n0[8 * h2 + 3] = bfhi(NBV[h2].y); \
            n0[8 * h2 + 4] = bflo(NBV[h2].z); n0[8 * h2 + 5] = bfhi(NBV[h2].z); n0[8 * h2 + 6] = bflo(NBV[h2].w); n0[8 * h2 + 7] = bfhi(NBV[h2].w); \
            n1[8 * h2 + 0] = bflo(NBV[2 + h2].x); n1[8 * h2 + 1] = bfhi(NBV[2 + h2].x); n1[8 * h2 + 2] = bflo(NBV[2 + h2].y); n1[8 * h2 + 3] = bfhi(NBV[2 + h2].y); \
            n1[8 * h2 + 4] = bflo(NBV[2 + h2].z); n1[8 * h2 + 5] = bfhi(NBV[2 + h2].z); n1[8 * h2 + 6] = bflo(NBV[2 + h2].w); n1[8 * h2 + 7] = bfhi(NBV[2 + h2].w); } \
        n0 = MFMA32(MA[0], p00, n0); n1 = MFMA32(MA[4], p00, n1); \
        n0 = MFMA32(MA[1], p01, n0); n1 = MFMA32(MA[5], p01, n1); \
        n0 = MFMA32(MA[2], p10, n0); n1 = MFMA32(MA[6], p10, n1); \
        n0 = MFMA32(MA[3], p11, n0); n1 = MFMA32(MA[7], p11, n1); \
        st0 = n0; st1 = n1; \
        if (more_) { asm volatile("s_waitcnt lgkmcnt(0)" ::: "memory"); if (lane == 0) *cons = (unsigned)(step_ + 2); } \
    } while (0)
DI void scan_wave(const Frame& F, const int sw) {
    const int lane = F.lane, il = lane & 31, hi = lane >> 5; (void)sw;
    volatile LAS unsigned* ready = (volatile LAS unsigned*)(F.lds + SCAN_FLAGS); volatile LAS unsigned* cons = ready + 16;
    volatile LAS unsigned* s0rdy = ready + 17; volatile LAS unsigned* s0done = ready + 18;
    f32x16 st0, st1;
#pragma unroll
    for (int i = 0; i < 16; ++i) { st0[i] = 0.f; st1[i] = 0.f; }
    bf16x8 ma[8], man[8]; u32x4 nbv[4], nbn[4];
    { unsigned spins = 0; while (lds_ld_u32(ready) != 1u) { __builtin_amdgcn_s_sleep(1); if (++spins > (1u << 22)) break; } }
    asm volatile("" ::: "memory");
#pragma unroll
    for (int p = 0; p < 8; ++p) ma[p] = *(const LAS bf16x8*)(F.lds + p * 1024 + lane * 16);
#pragma unroll
    for (int p = 0; p < 4; ++p) nbv[p] = *(const LAS u32x4*)(F.lds + 8192 + p * 1024 + lane * 16);
#pragma unroll 1
    for (int step = 0; step < NCH; step += 2) {
        SCAN_STEP(ma, nbv, man, nbn, step);
        SCAN_STEP(man, nbn, ma, nbv, step + 1);
    }
}
#undef SCAN_STEP
#else
DI void scan_wave(const Frame& F, const int sw) {
    const int ihalf = sw & 1, sc = sw >> 1, dir = sc / (NB * BH);
    const int lane = F.lane, il = lane & 31, hi = lane >> 5;
    bf16_t* S0 = (bf16_t*)(F.ws + WS_S0);
    volatile LAS unsigned* ready = (volatile LAS unsigned*)(F.lds + SCAN_FLAGS); volatile LAS unsigned* cons = ready + 16;
    volatile LAS unsigned* s0rdy = ready + 17; volatile LAS unsigned* s0done = ready + 18; (void)s0rdy; (void)s0done;
    f32x16 st0, st1;
#pragma unroll
    for (int i = 0; i < 16; ++i) { st0[i] = 0.f; st1[i] = 0.f; }
    bf16x8 ma[8], man[8]; u32x4 nbv[4], nbn[4];
    { unsigned spins = 0; while (lds_ld_u32(ready) != 1u) { __builtin_amdgcn_s_sleep(1); if (++spins > (1u << 22)) break; } }
    asm volatile("" ::: "memory");
#pragma unroll
    for (int p = 0; p < 8; ++p) ma[p] = *(const LAS bf16x8*)(F.lds + p * 1024 + lane * 16);
#pragma unroll
    for (int p = 0; p < 4; ++p) nbv[p] = *(const LAS u32x4*)(F.lds + 8192 + p * 1024 + lane * 16);
#pragma unroll 1
    for (int step = 0; step < NCH; ++step) {
        const int c = dir ? NCH - 1 - step : step; const size_t unit = (size_t)sc * NCH + c;
        const bool more = step + 1 < NCH;
#ifdef S0_WRITER
        if (step >= NSTG) { unsigned spins = 0; while ((int)lds_ld_u32(s0done + ((step - NSTG) % NWR)) < step - NSTG + 1) { __builtin_amdgcn_s_sleep(1); if (++spins > (1u << 22)) break; } }
        asm volatile("" ::: "memory");
#endif
        if (more) {
            { unsigned spins = 0; while (lds_ld_u32(ready + ((step + 1) % SCAN_RING)) != (unsigned)(step + 2)) { __builtin_amdgcn_s_sleep(1); if (++spins > (1u << 22)) break; } }
            asm volatile("" ::: "memory");

            const LAS unsigned char* slot = F.lds + ((step + 1) % SCAN_RING) * SCAN_SLOT;
#pragma unroll
            for (int p = 0; p < 8; ++p) man[p] = *(const LAS bf16x8*)(slot + p * 1024 + lane * 16);
#pragma unroll
            for (int p = 0; p < 4; ++p) nbn[p] = *(const LAS u32x4*)(slot + 8192 + p * 1024 + lane * 16);
        }
        bf16_t* sp = S0 + USK(unit) * 4096 + (size_t)(32 * ihalf + il) * 64;
        u32x4 b00, b01, b10, b11;
        b00.x = cvtpk(st0[0], st0[1]); b00.y = cvtpk(st0[2], st0[3]); b00.z = cvtpk(st0[4], st0[5]); b00.w = cvtpk(st0[6], st0[7]);
        b01.x = cvtpk(st0[8], st0[9]); b01.y = cvtpk(st0[10], st0[11]); b01.z = cvtpk(st0[12], st0[13]); b01.w = cvtpk(st0[14], st0[15]);
        b10.x = cvtpk(st1[0], st1[1]); b10.y = cvtpk(st1[2], st1[3]); b10.z = cvtpk(st1[4], st1[5]); b10.w = cvtpk(st1[6], st1[7]);
        b11.x = cvtpk(st1[8], st1[9]); b11.y = cvtpk(st1[10], st1[11]); b11.z = cvtpk(st1[12], st1[13]); b11.w = cvtpk(st1[14], st1[15]);
#ifdef S0_WRITER
        { LAS unsigned char* sl = F.lds + S0_STAGE + (step % NSTG) * (32 * 144) + il * 144 + 8 * hi;
          {
          *(LAS u32x2*)(sl + 0) = (u32x2){b00.x, b00.y};  *(LAS u32x2*)(sl + 16) = (u32x2){b00.z, b00.w};
          *(LAS u32x2*)(sl + 32) = (u32x2){b01.x, b01.y}; *(LAS u32x2*)(sl + 48) = (u32x2){b01.z, b01.w};
          *(LAS u32x2*)(sl + 64) = (u32x2){b10.x, b10.y}; *(LAS u32x2*)(sl + 80) = (u32x2){b10.z, b10.w};
          *(LAS u32x2*)(sl + 96) = (u32x2){b11.x, b11.y}; *(LAS u32x2*)(sl + 112) = (u32x2){b11.z, b11.w}; }
          asm volatile("" ::: "memory");
          if (lane == 0) *s0rdy = (unsigned)(step + 1); }
        (void)sp;
#else
        *(u32x2*)(sp + 0 + 4 * hi) = (u32x2){b00.x, b00.y};  *(u32x2*)(sp + 8 + 4 * hi) = (u32x2){b00.z, b00.w};
        *(u32x2*)(sp + 16 + 4 * hi) = (u32x2){b01.x, b01.y}; *(u32x2*)(sp + 24 + 4 * hi) = (u32x2){b01.z, b01.w};
        *(u32x2*)(sp + 32 + 4 * hi) = (u32x2){b10.x, b10.y}; *(u32x2*)(sp + 40 + 4 * hi) = (u32x2){b10.z, b10.w};
        *(u32x2*)(sp + 48 + 4 * hi) = (u32x2){b11.x, b11.y}; *(u32x2*)(sp + 56 + 4 * hi) = (u32x2){b11.z, b11.w};
#endif
        const bf16x8 p00 = __builtin_bit_cast(bf16x8, b00), p01 = __builtin_bit_cast(bf16x8, b01), p10 = __builtin_bit_cast(bf16x8, b10), p11 = __builtin_bit_cast(bf16x8, b11);
        f32x16 n0, n1;
#pragma unroll
        for (int h2 = 0; h2 < 2; ++h2) {
            n0[8 * h2 + 0] = bflo(nbv[h2].x); n0[8 * h2 + 1] = bfhi(nbv[h2].x); n0[8 * h2 + 2] = bflo(nbv[h2].y); n0[8 * h2 + 3] = bfhi(nbv[h2].y);
            n0[8 * h2 + 4] = bflo(nbv[h2].z); n0[8 * h2 + 5] = bfhi(nbv[h2].z); n0[8 * h2 + 6] = bflo(nbv[h2].w); n0[8 * h2 + 7] = bfhi(nbv[h2].w);
            n1[8 * h2 + 0] = bflo(nbv[2 + h2].x); n1[8 * h2 + 1] = bfhi(nbv[2 + h2].x); n1[8 * h2 + 2] = bflo(nbv[2 + h2].y); n1[8 * h2 + 3] = bfhi(nbv[2 + h2].y);
            n1[8 * h2 + 4] = bflo(nbv[2 + h2].z); n1[8 * h2 + 5] = bfhi(nbv[2 + h2].z); n1[8 * h2 + 6] = bflo(nbv[2 + h2].w); n1[8 * h2 + 7] = bfhi(nbv[2 + h2].w);
        }
        n0 = MFMA32(ma[0], p00, n0); n1 = MFMA32(ma[4], p00, n1);
        n0 = MFMA32(ma[1], p01, n0); n1 = MFMA32(ma[5], p01, n1);
        n0 = MFMA32(ma[2], p10, n0); n1 = MFMA32(ma[6], p10, n1);
        n0 = MFMA32(ma[3], p11, n0); n1 = MFMA32(ma[7], p11, n1);
        st0 = n0; st1 = n1;
        if (more) {
            asm volatile("s_waitcnt lgkmcnt(0)" ::: "memory");
            if (lane == 0) *cons = (unsigned)(step + 2);
#pragma unroll
            for (int p = 0; p < 8; ++p) ma[p] = man[p];
#pragma unroll
            for (int p = 0; p < 4; ++p) nbv[p] = nbn[p];
        }
    }
}

#endif
#if defined(D_PIPE) && defined(D_FRAG)
struct DOps { bf16x8 bq[2], bw[2], as[2][4], av[2][4]; };
DI void dops_load(const Frame& F, DOps& o, const int du, const int dir) {
    const int qd = du & 3, cidx = du >> 2, c = cidx % NCH, hd = (cidx / NCH) % BH, b = cidx / (NCH * BH);
    const int lane = F.lane;
    const bf16_t* QT = (const bf16_t*)(F.ws + WS_QT); const bf16_t* WT = (const bf16_t*)(F.ws + WS_WT); const bf16_t* S0 = (const bf16_t*)(F.ws + WS_S0);
    const bf16_t* VTB = (const bf16_t*)(F.ws + WS_VTB) + (size_t)cidx * 4096;
    const size_t unit = (((size_t)dir * NB + b) * BH + hd) * NCH + c;
#pragma unroll
    for (int ks = 0; ks < 2; ++ks) {
        o.bq[ks] = *(const bf16x8*)(QT + unit * 4096 + ((qd * 2 + ks) * 64 + lane) * 8);
        o.bw[ks] = *(const bf16x8*)(WT + unit * 4096 + ((qd * 2 + ks) * 64 + lane) * 8);
#pragma unroll
        for (int tm = 0; tm < 4; ++tm) {
            o.as[ks][tm] = *(const bf16x8*)(S0 + USK(unit) * 4096 + ((tm * 2 + ks) * 64 + lane) * 8);
            o.av[ks][tm] = *(const bf16x8*)(VTB + ((tm * 2 + ks) * 64 + lane) * 8); }
    }
}
DI void dops_mma(const DOps& o, f32x4 (&acc)[4]) {
#pragma unroll
    for (int ks = 0; ks < 2; ++ks)
#pragma unroll
        for (int tm = 0; tm < 4; ++tm) { acc[tm] = MFMA16(o.as[ks][tm], o.bq[ks], acc[tm]); acc[tm] = MFMA16(o.av[ks][tm], o.bw[ks], acc[tm]); }
}
DI void rwkv_out_epi(const Frame& F, const RwP& P, const int du, f32x4 (&acc)[4]) {
    const int qd = du & 3, cidx = du >> 2, c = cidx % NCH, hd = (cidx / NCH) % BH, b = cidx / (NCH * BH);
    const int lane = F.lane, n = lane & 15, g = lane >> 4, u = 16 * qd + n;
    float s = 0.f;
#pragma unroll
    for (int tm = 0; tm < 4; ++tm) s += (acc[tm][0] + acc[tm][1]) + (acc[tm][2] + acc[tm][3]);
    s += __shfl_xor(s, 16); s += __shfl_xor(s, 32);
    const float mu = s * (1.f / HD); float q = 0.f;
#pragma unroll
    for (int tm = 0; tm < 4; ++tm) { acc[tm] = acc[tm] - mu; q += (acc[tm][0] * acc[tm][0] + acc[tm][1] * acc[tm][1]) + (acc[tm][2] * acc[tm][2] + acc[tm][3] * acc[tm][3]); }
    q += __shfl_xor(q, 16); q += __shfl_xor(q, 32);
    const float rstd = 1.f / sqrtf(q * (1.f / HD) + GN_EPS);
    const size_t tok = (size_t)b * S + 64 * c + u;
    const float* BS = (const float*)(F.ws + WS_BS);
    const float bsum = BS[tok * 8 + hd] + BS[((size_t)T + tok) * 8 + hd];
    const bf16_t* VC = (const bf16_t*)(F.ws + WS_VC) + tok * BW + hd * HD; const bf16_t* GBp = (const bf16_t*)(F.ws + WS_GB) + tok * BW + hd * HD;
    bf16_t* op = (bf16_t*)(F.ws + WS_CONCAT) + tok * D + AW + hd * HD;
    u32x2 vvr[4], ggr[4]; f32x4 gnr[4], gbr[4];
#pragma unroll
    for (int tm = 0; tm < 4; ++tm) { const int i0 = 16 * tm + 4 * g;
        vvr[tm] = *(const u32x2*)(VC + i0); ggr[tm] = *(const u32x2*)(GBp + i0);
        gnr[tm] = *(const f32x4*)(P.gn_gain + hd * HD + i0); gbr[tm] = *(const f32x4*)(P.gn_bias + hd * HD + i0); }
#pragma unroll
    for (int tm = 0; tm < 4; ++tm) {
        const int i0 = 16 * tm + 4 * g;
        const f32x4 vv = unpack4(vvr[tm]), gg = unpack4(ggr[tm]);
        *(u32x2*)(op + i0) = pack4((acc[tm] * rstd * gnr[tm] + gbr[tm] + vv * bsum) * gg);
    }
}
DI void rwkv_out_wave(const Frame& F, const RwP& P) {
    constexpr int NDU = NB * BH * NCH * 4;
    DOps A, B;
    if (F.gw < NDU) dops_load(F, A, F.gw, 0);
#pragma unroll 1
    for (int du = F.gw; du < NDU; du += F.ngw) {
        f32x4 acc[4];
#pragma unroll
        for (int tm = 0; tm < 4; ++tm) acc[tm] = (f32x4){0.f, 0.f, 0.f, 0.f};
        dops_load(F, B, du, 1);
        dops_mma(A, acc);
        if (du + F.ngw < NDU) dops_load(F, A, du + F.ngw, 0);
        dops_mma(B, acc);
        rwkv_out_epi(F, P, du, acc);
    }
}
#endif
DI void rwkv_out_unit(const Frame& F, const RwP& P, const int du, int fragt = 0) {
#ifdef D_FRAG
    fragt = 1;
#endif
    const int qd = du & 3, cidx = du >> 2, c = cidx % NCH, hd = (cidx / NCH) % BH, b = cidx / (NCH * BH);
    const int lane = F.lane, n = lane & 15, g = lane >> 4, u = 16 * qd + n;
    const bf16_t* QT = (const bf16_t*)(F.ws + WS_QT); const bf16_t* WT = (const bf16_t*)(F.ws + WS_WT); const bf16_t* S0 = (const bf16_t*)(F.ws + WS_S0);
    const bf16_t* VTB = (const bf16_t*)(F.ws + WS_VTB) + (size_t)cidx * 4096;
    f32x4 acc[4];
#pragma unroll
    for (int tm = 0; tm < 4; ++tm) acc[tm] = (f32x4){0.f, 0.f, 0.f, 0.f};
#pragma unroll
    for (int dir = 0; dir < 2; ++dir) {
        const size_t unit = (((size_t)dir * NB + b) * BH + hd) * NCH + c;
#pragma unroll
        for (int ks = 0; ks < 2; ++ks) {
            const bf16x8 bq = *(const bf16x8*)(QT + unit * 4096 + (fragt ? ((qd * 2 + ks) * 64 + lane) * 8 : u * 64 + 32 * ks + 8 * g));
            const bf16x8 bw = *(const bf16x8*)(WT + unit * 4096 + (fragt ? ((qd * 2 + ks) * 64 + lane) * 8 : u * 64 + 32 * ks + 8 * g));
#pragma unroll
            for (int tm = 0; tm < 4; ++tm) {
                const bf16x8 as = *(const bf16x8*)(S0 + USK(unit) * 4096 + (fragt ? ((tm * 2 + ks) * 64 + lane) * 8 : (16 * tm + n) * 64 + 32 * ks + 8 * g));
                const bf16x8 av = *(const bf16x8*)(VTB + (fragt ? ((tm * 2 + ks) * 64 + lane) * 8 : (16 * tm + n) * 64 + 32 * ks + 8 * g));
                acc[tm] = MFMA16(as, bq, acc[tm]); acc[tm] = MFMA16(av, bw, acc[tm]);
            }
        }
    }
    float s = 0.f;
#pragma unroll
    for (int tm = 0; tm < 4; ++tm) s += (acc[tm][0] + acc[tm][1]) + (acc[tm][2] + acc[tm][3]);
    s += __shfl_xor(s, 16); s += __shfl_xor(s, 32);
    const float mu = s * (1.f / HD); float q = 0.f;
#pragma unroll
    for (int tm = 0; tm < 4; ++tm) { acc[tm] = acc[tm] - mu; q += (acc[tm][0] * acc[tm][0] + acc[tm][1] * acc[tm][1]) + (acc[tm][2] * acc[tm][2] + acc[tm][3] * acc[tm][3]); }
    q += __shfl_xor(q, 16); q += __shfl_xor(q, 32);
    const float rstd = 1.f / sqrtf(q * (1.f / HD) + GN_EPS);
    const size_t tok = (size_t)b * S + 64 * c + u;
    const float* BS = (const float*)(F.ws + WS_BS);
    const float bsum = BS[tok * 8 + hd] + BS[((size_t)T + tok) * 8 + hd];
    const bf16_t* VC = (const bf16_t*)(F.ws + WS_VC) + tok * BW + hd * HD; const bf16_t* GBp = (const bf16_t*)(F.ws + WS_GB) + tok * BW + hd * HD;
    bf16_t* op = (bf16_t*)(F.ws + WS_CONCAT) + tok * D + AW + hd * HD;
    u32x2 vvr[4], ggr[4]; f32x4 gnr[4], gbr[4];
#pragma unroll
    for (int tm = 0; tm < 4; ++tm) { const int i0 = 16 * tm + 4 * g;
        vvr[tm] = *(const u32x2*)(VC + i0); ggr[tm] = *(const u32x2*)(GBp + i0);
        gnr[tm] = *(const f32x4*)(P.gn_gain + hd * HD + i0); gbr[tm] = *(const f32x4*)(P.gn_bias + hd * HD + i0); }
#pragma unroll
    for (int tm = 0; tm < 4; ++tm) {
        const int i0 = 16 * tm + 4 * g;
        const f32x4 vv = unpack4(vvr[tm]), gg = unpack4(ggr[tm]);
        *(u32x2*)(op + i0) = pack4((acc[tm] * rstd * gnr[tm] + gbr[tm] + vv * bsum) * gg);
    }
}

DI RwP make_rwp(const Args& a, int l) {
    RwP p;
    p.conv = a.in[6] + (size_t)l * 3 * 3 * BW; p.w0 = a.in[7] + (size_t)l * 2 * BW; p.w_up = a.in[8] + (size_t)l * 2 * RW * BW;
    p.a0 = a.in[9] + (size_t)l * 2 * BW; p.a_up = a.in[10] + (size_t)l * 2 * RA * BW; p.g_up = a.in[11] + (size_t)l * RG * BW;
    p.k_k = a.in[12] + (size_t)l * BW; p.k_a = a.in[13] + (size_t)l * BW; p.r_k = a.in[14] + (size_t)l * BH * HD;
    p.gn_gain = a.in[15] + (size_t)l * BW; p.gn_bias = a.in[16] + (size_t)l * BW;
    return p;
}
DI void conv_moe(const Frame& F, const Args& a, int l, int first, int stride, const int IT_END = IT_MOE) {
    LAS float* scr = (LAS float*)F.lds + F.wave * (64 * 65);
#ifdef CONV3
    f32x4 b0[16], b1[16], b2[16]; TItem t0{}, t1{}, t2{};
    int it = first;
    if (it < IT_MOE) { t0 = moe_item(F, a.in[28], a.in[29], a.in[30], l, it); titem_load(t0, b0, F.lane); }
    if (it + stride < IT_MOE) { t1 = moe_item(F, a.in[28], a.in[29], a.in[30], l, it + stride); titem_load(t1, b1, F.lane); }
    for (; it < IT_MOE; it += 3 * stride) {
        if (it + 2 * stride < IT_MOE) { t2 = moe_item(F, a.in[28], a.in[29], a.in[30], l, it + 2 * stride); titem_load(t2, b2, F.lane); }
        titem_store(t0, b0, scr, F.lane);
        if (it + stride >= IT_MOE) break;
        if (it + 3 * stride < IT_MOE) { t0 = moe_item(F, a.in[28], a.in[29], a.in[30], l, it + 3 * stride); titem_load(t0, b0, F.lane); }
        titem_store(t1, b1, scr, F.lane);
        if (it + 2 * stride >= IT_MOE) break;
        if (it + 4 * stride < IT_MOE) { t1 = moe_item(F, a.in[28], a.in[29], a.in[30], l, it + 4 * stride); titem_load(t1, b1, F.lane); }
        titem_store(t2, b2, scr, F.lane);
    }
#else
    f32x4 cur[16], nxt[16]; int it = first; TItem tc{}, tn{};
    if (it < IT_END) { tc = moe_item(F, a.in[28], a.in[29], a.in[30], l, it); titem_load(tc, cur, F.lane); }
    CONV_PREWAIT();
    for (; it < IT_END; it += stride) {
        const bool more = it + stride < IT_END;
        if (more) { tn = moe_item(F, a.in[28], a.in[29], a.in[30], l, it + stride); titem_load(tn, nxt, F.lane); }
        titem_store(tc, cur, scr, F.lane);
        if (more) { tc = tn;
#pragma unroll
            for (int i = 0; i < 16; ++i) cur[i] = nxt[i]; }
    }
#endif
}
#ifndef NG1
#define NG1 21
#endif
#ifndef N1
#define N1 3360
#endif
DI void p_gemm1(const Frame& F, const Args& a, int l) {
#ifdef CONV_G1
    if (F.G == 256) {
        if (F.bx >= 256 - NG1) { conv_moe(F, a, l, (F.bx - (256 - NG1)) * NWAVES + F.wave, NG1 * NWAVES, N1); return; }
        pg8::Gemm1Order S; S.U = (const bf16_t*)(F.ws + WS_U); S.Win = (const bf16_t*)(F.ws + WS_WIN + (size_t)l * WIN_LAYER); S.Wv = S.Win + (size_t)HW * D; S.G = 256 - NG1; S.c = F.bx;
        #ifdef KV_TILED
        pg8::EpiGemm1 E{(bf16_t*)(F.ws + WS_HB), HW, (bf16_t*)(F.ws + WS_KT), (bf16_t*)(F.ws + WS_VT)};
#else
        pg8::EpiStore E{(bf16_t*)(F.ws + WS_HB), HW, (bf16_t*)(F.ws + WS_VT), T};
#endif
        pg8::gemm_phase(F.lds, F.tid, D, S, E);
        return;
    }
#endif
    pg8::Gemm1Order S; S.U = (const bf16_t*)(F.ws + WS_U); S.Win = (const bf16_t*)(F.ws + WS_WIN + (size_t)l * WIN_LAYER); S.Wv = S.Win + (size_t)HW * D; S.G = F.G; S.c = F.bx;
    #ifdef KV_TILED
        pg8::EpiGemm1 E{(bf16_t*)(F.ws + WS_HB), HW, (bf16_t*)(F.ws + WS_KT), (bf16_t*)(F.ws + WS_VT)};
#else
        pg8::EpiStore E{(bf16_t*)(F.ws + WS_HB), HW, (bf16_t*)(F.ws + WS_VT), T};
#endif
    pg8::gemm_phase(F.lds, F.tid, D, S, E);
#ifdef CONV_G1T
    if (F.G == 256 && F.bx >= 192) conv_moe(F, a, l, (F.bx - 192) * NWAVES + F.wave, 64 * NWAVES, CONV_G1T);
#endif
}
#ifndef NCB
#define NCB 16
#endif
DI void p_mixer_local(const Frame& F, const Args& a, int l, const int rstop = 99) {
#ifdef CONV_IN_B
    const int GR = F.G - NCB;
    if (F.bx >= GR) { conv_moe(F, a, l, (F.bx - GR) * NWAVES + F.wave, NCB * NWAVES); return; }
    { const float* conv = a.in[6] + (size_t)l * 3 * 3 * BW;
#pragma unroll 7
      for (int i = F.tid; i < BH * 9 * 64; i += NTHREADS) { const int j = i & 63, q = i >> 6, which = q % 3, x = (q / 3) % 3, hd = q / 9;
          *(LAS bf16_t*)(F.lds + CWLOFF + i * 2) = f2bf(conv[x * 3 * BW + which * BW + hd * HD + j]); }
      RwPre PF;
      if (F.bx < NUNIT) rwkv_prefetch(F, a, l, F.bx, PF);
      __syncthreads();
      for (int unit = F.bx; unit < NUNIT; unit += GR) rwkv_local_unit(F, a, l, unit, PF, unit + GR < NUNIT ? unit + GR : -1);
      return;
    }
#endif
    {
      const float* conv = a.in[6] + (size_t)l * 3 * 3 * BW;
#pragma unroll 7
      for (int i = F.tid; i < BH * 9 * 64; i += NTHREADS) { const int j = i & 63, q = i >> 6, which = q % 3, x = (q / 3) % 3, hd = q / 9;
          *(LAS bf16_t*)(F.lds + CWLOFF + i * 2) = f2bf(conv[x * 3 * BW + which * BW + hd * HD + j]); }
      RwPre PF;
      if (F.bx < NUNIT) rwkv_prefetch(F, a, l, F.bx, PF);
      __syncthreads();
      for (int unit = F.bx; unit < NUNIT; unit += F.G) rwkv_local_unit(F, a, l, unit, PF, unit + F.G < NUNIT ? unit + F.G : -1, rstop);
    }
}
DI void p_scan(const Frame& F, const Args& a, int l, const int rr = 0) {
#ifndef CVW
#define CVW 3
#endif
    constexpr int NSCAN = 2 * 2 * NB * BH;
    const int NATTW = (F.G - NSCAN) * (NWAVES - CVW);
    if (F.bx < NSCAN) {
        if (rr & 4) return;
        volatile LAS unsigned* fl = (volatile LAS unsigned*)(F.lds + SCAN_FLAGS);
        if (F.tid < 32) fl[F.tid] = 0u;
        __syncthreads();
#ifdef S0_WRITER
        if (F.wave == 0) scan_wave(F, F.bx); else if (F.wave <= NLD) scan_loader(F, F.bx, F.wave - 1); else if (F.wave <= NLD + NWR) scan_writer(F, F.bx, F.wave - NLD - 1);
#ifdef POOL_ON_SCAN
        else if (F.wave >= 5) {
            for (int pu = F.bx * 3 + (F.wave - 5); pu < NB * (S / 32) * 4; pu += NSCAN * 3) pool_unit(F, a.in[17] + (size_t)l * NG * 64 * 64, a.in[18] + (size_t)l * CW, pu);
        }
#endif
#else
        if (F.wave == 0) scan_wave(F, F.bx); else if (F.wave <= NLD) scan_loader(F, F.bx, F.wave - 1);
#endif
#ifdef CONV_TAIL
        if (!(rr & 1)) { __syncthreads(); conv_moe(F, a, l, CONV_TAIL + F.bx * NWAVES + F.wave, NSCAN * NWAVES, IT_MOE); }
#endif
#ifdef DBL_SCAN
        __syncthreads();
        if (F.tid < 32) fl[F.tid] = 0u;
        __syncthreads();
        if (F.wave == 0) scan_wave(F, F.bx); else if (F.wave <= NLD) scan_loader(F, F.bx, F.wave - 1);
#endif
        return;
    }
#ifdef SERIAL_C
    {
        LAS float* rpbl8 = (LAS float*)(F.lds + NWAVES * 64 * 65 * 4);
        { const float* rpb = a.in[5] + (size_t)l * AH * (2 * KH - 1) * (2 * KW - 1);
#pragma unroll 6
          for (int i = F.tid; i < AH * (2 * KH - 1) * (2 * KW - 1); i += NTHREADS) rpbl8[i] = rpb[i] * LOG2E; }
        __syncthreads();
        const int aw8 = (F.bx - NSCAN) * NWAVES + F.wave, naw8 = (F.G - NSCAN) * NWAVES;
        if (F.G == 256) {
            constexpr int UPX = NB * ROWS * AH / 8;
            const int x = F.bx & 7, k = (F.bx - NSCAN) >> 3, j = k * NWAVES + F.wave;
            if (j < UPX) { const int v = (x & 3) * UPX + j; attn_unit(F, rpbl8, (((x >> 2) * ROWS) + (v & (ROWS - 1))) * AH + (v >> 7)); }
        } else
            for (int au = aw8; au < NB * ROWS * AH; au += naw8) attn_unit(F, rpbl8, au);
        for (int pu = aw8; pu < NB * (S / 32) * 4; pu += naw8) pool_unit(F, a.in[17] + (size_t)l * NG * 64 * 64, a.in[18] + (size_t)l * CW, pu);
#ifdef CONV_IN_B
        return;
#endif
        LAS float* scr = (LAS float*)F.lds + F.wave * (64 * 65);
        f32x4 cur[16], nxt[16]; const int st = naw8; int it = aw8; TItem tc{}, tn{};
#ifdef DBL_CONV
        for (int rep = 0; rep < 2; ++rep) { it = aw8;
#endif
        if (it < IT_MOE) { tc = moe_item(F, a.in[28], a.in[29], a.in[30], l, it); titem_load(tc, cur, F.lane); }
        for (; it < IT_MOE; it += st) {
            const bool more = it + st < IT_MOE;
            if (more) { tn = moe_item(F, a.in[28], a.in[29], a.in[30], l, it + st); titem_load(tn, nxt, F.lane); }
            titem_store(tc, cur, scr, F.lane);
            if (more) { tc = tn;
#pragma unroll
                for (int i = 0; i < 16; ++i) cur[i] = nxt[i]; }
        }
#ifdef DBL_CONV
        }
#endif
        return;
    }
#endif
#ifdef ATT_CONV
    LAS float* rpbl = (LAS float*)(F.lds + NWAVES * 64 * 65 * 4);
#else
    LAS float* rpbl = (LAS float*)(F.lds + CVW * 64 * 65 * 4);
#endif
    { const float* rpb = a.in[5] + (size_t)l * AH * (2 * KH - 1) * (2 * KW - 1);
#pragma unroll 6
      for (int i = F.tid; i < AH * (2 * KH - 1) * (2 * KW - 1); i += NTHREADS) rpbl[i] = rpb[i] * LOG2E; }
    __syncthreads();
    if (F.wave < CVW) {
        if (rr & 1) return;
#ifdef CONV_TAIL
        constexpr int CONV_END0_ = CONV_TAIL;
#else
        constexpr int CONV_END0_ = IT_MOE;
#endif
#ifdef ATT_CONV
        constexpr int CONV_END_ = CONV_END0_ - ATT_CONV;
#else
        constexpr int CONV_END_ = CONV_END0_;
#endif
        LAS float* scr = (LAS float*)F.lds + F.wave * (64 * 65);
#if defined(CONV_G1T)
        const int it0 = F.G == 256 ? CONV_G1T : 0;
#elif defined(CONV_G1)
        const int it0 = F.G == 256 ? N1 : 0;
#else
        const int it0 = 0;
#endif
        f32x4 cur[16], nxt[16]; const int st = (F.G - NSCAN) * CVW; int it = it0 + (F.bx - NSCAN) * CVW + F.wave; TItem tc{}, tn{};
#ifndef CONV_PAIR
        if (it < CONV_END_) { tc = moe_item(F, a.in[28], a.in[29], a.in[30], l, it); titem_load(tc, cur, F.lane); }
        CONV_PREWAIT();
#endif
#ifdef DBL_CONV
        for (int rep = 0; rep < 2; ++rep) { it = (F.bx - NSCAN) * CVW + F.wave; if (it < CONV_END_) { tc = moe_item(F, a.in[28], a.in[29], a.in[30], l, it); titem_load(tc, cur, F.lane); }
#endif
#ifdef CONV_PAIR
        for (int pr = it; pr < CONV_END_ / 2; pr += st) {
            tc = moe_item(F, a.in[28], a.in[29], a.in[30], l, 2 * pr); tn = moe_item(F, a.in[28], a.in[29], a.in[30], l, 2 * pr + 1);
#pragma unroll
            for (int i = 0; i < 16; ++i) { cur[i] = *(const f32x4*)(tc.src + (size_t)(4 * i + (F.lane >> 4)) * tc.ldw + 4 * (F.lane & 15)); nxt[i] = *(const f32x4*)(tn.src + (size_t)(4 * i + (F.lane >> 4)) * tn.ldw + 4 * (F.lane & 15)); }
            titem_store(tc, cur, scr, F.lane); titem_store(tn, nxt, scr, F.lane);
        }
        it = CONV_END_;
#endif
        for (; it < CONV_END_; it += st) {
            const bool more = it + st < CONV_END_;
#ifdef CONV_SINGLE
            titem_store(tc, cur, scr, F.lane);
            if (more) { tc = moe_item(F, a.in[28], a.in[29], a.in[30], l, it + st); titem_load(tc, cur, F.lane); }
            continue;
#endif
            if (more) { tn = moe_item(F, a.in[28], a.in[29], a.in[30], l, it + st); titem_load(tn, nxt, F.lane); }
            titem_store(tc, cur, scr, F.lane);
            if (more) { tc = tn;
#pragma unroll
                for (int i = 0; i < 16; ++i) cur[i] = nxt[i]; }
        }
#ifdef DBL_CONV
        }
#endif
#ifdef POOL_ON_CONV
        if (!(rr & 2)) { const int cw = (F.bx - NSCAN) * CVW + F.wave, ncw = (F.G - NSCAN) * CVW;
            for (int pu = cw; pu < NB * (S / 32) * 4; pu += ncw) pool_unit(F, a.in[17] + (size_t)l * NG * 64 * 64, a.in[18] + (size_t)l * CW, pu); }
#endif
    } else {
        if (rr & 2) return;
        const int aw = (F.bx - NSCAN) * (NWAVES - CVW) + (F.wave - CVW), naw = NATTW;
#ifdef ATT_XCD
        if (F.G == 256) {
            constexpr int NW5 = NWAVES - CVW, NBX = (256 - NSCAN) / 8, NWX = NBX * NW5, UPX = NB * ROWS * AH / 8, REM = UPX - NWX, PER = (REM + NBX - 1) / NBX;
            const int x = F.bx & 7, k = (F.bx - NSCAN) >> 3, w5 = F.wave - CVW;
            { const int v = (x & 3) * UPX + k * NW5 + w5; attn_unit(F, rpbl, (((x >> 2) * ROWS) + (v & (ROWS - 1))) * AH + (v >> 7)); }
#ifdef ATT_HALF
            { const int hu = k * NW5 + w5;
              if (hu < 2 * REM) { const int v = (x & 3) * UPX + NWX + (hu >> 1); attn_unit(F, rpbl, (((x >> 2) * ROWS) + (v & (ROWS - 1))) * AH + (v >> 7), 1 + (hu & 1)); } }
            (void)PER;
#else
            if (w5 < PER && k * PER + w5 < REM) { const int v = (x & 3) * UPX + NWX + k * PER + w5; attn_unit(F, rpbl, (((x >> 2) * ROWS) + (v & (ROWS - 1))) * AH + (v >> 7)); }
#endif
        } else
#endif
        for (int au = aw; au < NB * ROWS * AH; au += naw) attn_unit(F, rpbl, au);
#ifdef DBL_ATTN
        for (int au = aw; au < NB * ROWS * AH; au += naw) attn_unit(F, rpbl, au);
#endif
#if !defined(POOL_ON_SCAN) && !defined(POOL_ON_CONV)
        for (int pu = aw; pu < NB * (S / 32) * 4; pu += naw) pool_unit(F, a.in[17] + (size_t)l * NG * 64 * 64, a.in[18] + (size_t)l * CW, pu);
#endif
#ifdef ATT_CONV
        if (!(rr & 1)) {
#ifdef CONV_TAIL
            constexpr int AEND = CONV_TAIL;
#else
            constexpr int AEND = IT_MOE;
#endif
            conv_moe(F, a, l, AEND - ATT_CONV + aw, naw, AEND);
        }
#endif
    }
}
DI void p_rwkv_out(const Frame& F, const Args& a, int l, const int fragt = 0) {
    const RwP P = make_rwp(a, l);
#if defined(D_PIPE) && defined(D_FRAG)
    if (fragt == 0) { rwkv_out_wave(F, P); return; }
#endif
    for (int du = F.gw; du < NB * BH * NCH * 4; du += F.ngw) rwkv_out_unit(F, P, du, fragt);
}
DI void p_gemm2(const Frame& F, int l) {
    pg8::PlainOrder S; S.init((const bf16_t*)(F.ws + WS_CONCAT), (const bf16_t*)(F.ws + WS_WOUT) + (size_t)l * D * D, T, D, D, F.G, F.bx);
    pg8::EpiStore E{(bf16_t*)(F.ws + WS_MIX), D, nullptr, 0};
    pg8::gemm_phase(F.lds, F.tid, D, S, E);
}
DI void p_gemm2k(const Frame& F, int Kx) {
    pg8::PlainOrder S; S.init((const bf16_t*)(F.ws + WS_CONCAT), (const bf16_t*)(F.ws + WS_WOUT), T, D, Kx, F.G, F.bx);
    pg8::EpiStore E{(bf16_t*)(F.ws + WS_MIX), D, nullptr, 0};
    pg8::gemm_phase(F.lds, F.tid, Kx, S, E);
}
DI void p_moe_a(const Frame& F, int l, const bool quiet = false) {
    LAS int* tb = (LAS int*)(F.lds + LDS_MISC);
    build_tables(F, l, tb);
    pg8::GroupedOrderT<true> S; S.rowtok = (const int*)(F.ws + WS_CTL + WS_SLOTTOK); S.A = (const bf16_t*)(F.ws + WS_U); S.Bt = (const bf16_t*)(F.ws + WS_WGU); S.K = D; S.estride = (size_t)D * D; S.tile_e = tb + 66; S.ntiles = tb[65]; S.nwg = S.ntiles * 4; S.G = F.G; S.c = F.bx;
#ifdef FUSE_MOE
    S.flags = (unsigned*)(F.ws + WS_CTL) + CW_MFL + l * 256; S.quiet = quiet;
#endif
    pg8::EpiSwiGlu E{(bf16_t*)(F.ws + WS_HM)};
    pg8::gemm_phase(F.lds, F.tid, D, S, E);
}
DI void p_moe_b(const Frame& F, int l) {
    LAS int* tb = (LAS int*)(F.lds + LDS_MISC);
    #if !defined(FUSE_MOE) || MK_MODE == 2
    build_tables(F, l, tb);
#endif
#ifdef FUSE_MOE
    pg8::GroupedOrderB S; S.flags = (unsigned*)(F.ws + WS_CTL) + CW_MFL + l * 256; S.readymask = 0u;
#else
    pg8::GroupedOrderT<false> S;
#endif
    S.rowtok = nullptr; S.A = (const bf16_t*)(F.ws + WS_HM); S.Bt = (const bf16_t*)(F.ws + WS_WD); S.K = DE; S.estride = (size_t)D * DE; S.tile_e = tb + 66; S.ntiles = tb[65]; S.nwg = S.ntiles * 4; S.G = F.G; S.c = F.bx;
    pg8::EpiRowScale E{(bf16_t*)(F.ws + WS_YS), (const float*)(F.ws + WS_SLOTW)};
#if defined(FUSE_MOE) && defined(MOE_ACQ1) && defined(MOE_SWEEP)
    {
        LAS unsigned* rm = (LAS unsigned*)(F.lds + LDS_MISC + 4096);
        if (F.wave == 0) {
            pg8::Unit uu; unsigned m = 0u; const int i = F.lane;
            if (i < 8 && S.next(i, uu)) m = __hip_atomic_load(S.flags + uu.pm, __ATOMIC_RELAXED, __HIP_MEMORY_SCOPE_AGENT) >= 4u ? (1u << i) : 0u;
#pragma unroll
            for (int o = 1; o < 8; o <<= 1) m |= __shfl_xor(m, o);
            __builtin_amdgcn_fence(__ATOMIC_ACQUIRE, "agent"); asm volatile("s_waitcnt vmcnt(0)" ::: "memory");
            if (F.lane == 0) *rm = m;
        }
        __syncthreads();
        S.readymask = *rm;
    }
#endif
    pg8::gemm_phase(F.lds, F.tid, DE, S, E);
}

#ifndef DBLMASK
#define DBLMASK 0
#endif
constexpr int PH_PER_LAYER = 10, N_PHASES = 2 + L * PH_PER_LAYER;
DI bool in_ph(int k, int lo, int hi) { lo = __builtin_amdgcn_readfirstlane(lo); hi = __builtin_amdgcn_readfirstlane(hi); asm volatile("" : "+s"(lo), "+s"(hi)); return lo <= k && k < hi; }
DI Frame fresh(const Frame& F0) {
    Frame F = F0; int t = F0.tid, b = F0.bx;
    b = __builtin_amdgcn_readfirstlane(b); asm volatile("" : "+v"(t)); asm volatile("" : "+s"(b));
    F.tid = t; F.lane = t & 63; F.wave = __builtin_amdgcn_readfirstlane(t >> 6); F.bx = b;
    F.vcu = (F.G % 8 == 0) ? (b % 8) * (F.G / 8) + b / 8 : b; F.gw = F.vcu * NWAVES + F.wave;
    return F;
}

__global__ void __launch_bounds__(NTHREADS, 2) mk_fwd(Args a) {
    extern __shared__ __attribute__((aligned(16))) unsigned char lds_raw[];
    Frame F;
    F.lds = (LAS unsigned char*)lds_raw;
    F.tid = threadIdx.x; F.lane = F.tid & 63; F.wave = __builtin_amdgcn_readfirstlane(F.tid >> 6);
    F.G = gridDim.x; F.bx = blockIdx.x; { const int bx = blockIdx.x; F.vcu = (F.G % 8 == 0) ? (bx % 8) * (F.G / 8) + bx / 8 : bx; }
    F.gw = F.vcu * NWAVES + F.wave; F.ngw = F.G * NWAVES; F.ws = a.ws;
    volatile LAS unsigned* bst = (volatile LAS unsigned*)(F.lds + LDS_BARST);
    if (F.tid < 16) bst[F.tid] = 0u;
    __syncthreads();
    cg::grid_group grid = cg::this_grid();
    XcdBarrier bar; bar.bar = (unsigned*)(a.ws + WS_CTL) + CW_BAR; bar.x = 0; bar.st = bst;
    const bool multi = (a.ph_hi - a.ph_lo) > 1;
    if (multi && !a.use_cg) bar = xcd_barrier_post((unsigned*)(a.ws + WS_CTL) + CW_BAR, bst);
    const int lo = a.ph_lo, hi = a.ph_hi;
#ifdef TSTAMP
#define STAMP(k) do { if (blockIdx.x == 0 && threadIdx.x == 0) ((unsigned long long*)(a.ws + WS_CTL + 40960))[k] = wall_clock64(); } while (0)
#else
#define STAMP(k) do { } while (0)
#endif
    STAMP(0);
#define IN(k) in_ph((k), lo, hi)
#ifndef DBLSEAM
#define DBLSEAM 0
#endif
#define SEAM(k) do { if (IN(k) && IN((k) + 1)) { if (a.use_cg) grid.sync(); else { xcd_barrier(bar); if (DBLSEAM) xcd_barrier(bar); } } STAMP((k) + 1); } while (0)
    if (IN(0)) { p0_prologue(fresh(F), a); if ((DBLMASK >> 11) & 1) p0_prologue(fresh(F), a); }
    SEAM(0);
    if (IN(1)) { p_r0(fresh(F), a.in[0]); if ((DBLMASK >> 12) & 1) p_r0(fresh(F), a.in[0]); }
    SEAM(1);
#ifdef FUSE_MOE
#define SEAM_MOE(k) do { } while (0)
#else
#define SEAM_MOE(k) SEAM(k)
#endif
#define RUN(k, call) do { if (IN(pb + (k))) { call; if ((DBLMASK >> (k)) & 1) { call; } } } while (0)
#ifdef CONV_PHASE
#define RUN_SCAN(l) do { if (IN(pb + 2)) { p_scan(fresh(F), a, (l), 1); if (multi && !a.use_cg) xcd_barrier(bar); { const Frame F2 = fresh(F); conv_moe(F2, a, (l), F2.gw, F2.ngw); } } } while (0)
#else
#define RUN_SCAN(l) RUN(2, p_scan(fresh(F), a, (l)))
#endif
#define LAYER(l) do { \
        const int pb = 2 + PH_PER_LAYER * (l); \
        RUN(0, p_gemm1(fresh(F), a, (l))); \
        SEAM(pb + 0); \
        RUN(1, p_mixer_local(fresh(F), a, (l))); \
        SEAM(pb + 1); \
        RUN_SCAN(l); \
        SEAM(pb + 2); \
        RUN(3, p_rwkv_out(fresh(F), a, (l))); \
        SEAM(pb + 3); \
        RUN(4, p_gemm2(fresh(F), (l))); \
        SEAM(pb + 4); \
        RUN(5, p_rowpass1(fresh(F), a, (l), (l) == 0 ? a.in[0] : a.out)); \
        if (IN(pb + 5) && ((DBLMASK >> 10) & 1)) p_rowpass1(fresh(F), a, (l), (l) == 0 ? a.in[0] : a.out, true); \
        SEAM(pb + 5); \
        RUN(6, p_gather(fresh(F), (l))); \
        SEAM(pb + 6); \
        RUN(7, p_moe_a(fresh(F), (l))); \
        SEAM_MOE(pb + 7); \
        RUN(8, p_moe_b(fresh(F), (l))); \
        SEAM(pb + 8); \
        RUN(9, p_rowpass2(fresh(F), a, (l), a.out)); \
        SEAM(pb + 9); \
    } while (0)
    LAYER(0);
    LAYER(1);
#ifdef END_RERUN
#define RERUN(k, call) do { if ((END_RERUN >> (k)) & 1) { xcd_barrier(bar); call; } } while (0)
    if (multi && !a.use_cg) {
        RERUN(0, p_gemm1(fresh(F), a, 1));
        RERUN(1, p_mixer_local(fresh(F), a, 1));
        RERUN(19, p_rwkv_out(fresh(F), a, 1, 1));
        RERUN(17, p0_prologue(fresh(F), a));
        RERUN(18, p_r0(fresh(F), a.in[0]));
        RERUN(16, p_mixer_local(fresh(F), a, 1, RSTOP));
        RERUN(2, p_scan(fresh(F), a, 1));
        RERUN(15, p_scan(fresh(F), a, 1, RRV));
        RERUN(3, p_rwkv_out(fresh(F), a, 1));
        RERUN(4, p_gemm2(fresh(F), 1));
        RERUN(7, p_moe_a(fresh(F), 1); p_moe_b(fresh(F), 1));
        RERUN(12, p_gemm2k(fresh(F), 512));
        RERUN(13, p_gemm2k(fresh(F), 256));
        RERUN(5, p_moe_a(fresh(F), 1));
        RERUN(20, p_moe_a(fresh(F), 1, true));
        RERUN(6, p_moe_b(fresh(F), 1));
        RERUN(10, p_rowpass1(fresh(F), a, 1, a.out, true));
        RERUN(11, p_gather(fresh(F), 1));
        RERUN(14, p_rowpass1(fresh(F), a, 1, a.out, false));
        RERUN(9, p_rowpass2(fresh(F), a, 1, a.out));
    }
#endif
#undef LAYER
#undef IN
#undef SEAM
}

#ifndef MK_MODE
#define MK_MODE 0
#endif
#ifndef TESTMODE
#define TESTMODE 0
#endif

static void fill_args(Args& a, void* const* d_in, void* d_out, void* d_ws) {
    for (int i = 0; i < 31; ++i) a.in[i] = (const float*)d_in[i];
    a.out = (float*)d_out; a.ws = (unsigned char*)d_ws; a.ph_lo = 0; a.ph_hi = N_PHASES; a.use_cg = 0; a.pad = 0;
}
static void launch_phases(Args a, int lo, int hi, hipStream_t stream) {
    for (int p = lo; p < hi; ++p) { a.ph_lo = p; a.ph_hi = p + 1; hipLaunchKernelGGL(mk_fwd, dim3(256), dim3(NTHREADS), LDS_BYTES, stream, a); }
}

#if TESTMODE == 0
extern "C" void kernel_launch(void* const* d_in, const int* in_sizes, int n_in, void* d_out, int out_size, void* d_ws, size_t ws_size, hipStream_t stream) {
    static int grid = 0;
    if (grid == 0) {
        int dev = 0, cus = 0, per_cu = 0;
        (void)hipGetDevice(&dev); (void)hipDeviceGetAttribute(&cus, hipDeviceAttributeMultiprocessorCount, dev);
        (void)hipFuncSetAttribute((const void*)mk_fwd, hipFuncAttributeMaxDynamicSharedMemorySize, LDS_BYTES);
        (void)hipOccupancyMaxActiveBlocksPerMultiprocessor(&per_cu, (const void*)mk_fwd, NTHREADS, LDS_BYTES);
        (void)hipGetLastError();
        grid = (cus > 0 ? cus : 256) * 1;
        if (ws_size < WS_END || n_in != 31) grid = -1;
    }
    if (grid < 0) return;
    (void)hipMemsetAsync((char*)d_ws + WS_CTL, 0, CTL_BYTES, stream);
    Args a{}; fill_args(a, d_in, d_out, d_ws);
#if MK_MODE == 2
    launch_phases(a, 0, N_PHASES, stream);
#else
    a.use_cg = (MK_MODE == 1) ? 1 : 0;
    void* args[] = {&a};
    (void)hipLaunchCooperativeKernel((const void*)mk_fwd, dim3(grid), dim3(NTHREADS), args, LDS_BYTES, stream);
#endif
}
#endif

#if TESTMODE > 0
constexpr int O_A = 1152, O_B = 2304, O_W = 2336, O_AL = 2368, O_G = 2432;
struct HSrc { const bf16_t* HB; const bf16_t* VT;
    DI float at(size_t tok, int n) const { if (n < 768) return bf2f(HB[tok * HW + n]); if (n < 1152) return bf2f(VT[(size_t)(n - 768) * T + tok]); return bf2f(HB[tok * HW + n - 384]); } };
DI float sigm_n(float x) { return 1.f / (1.f + expf(-x)); }

__global__ void k_mod_n(const float* __restrict__ c, const float* __restrict__ w_mod, const float* __restrict__ b_mod, float* __restrict__ mod) {
    __shared__ float sc[NB * D];
    for (int i = threadIdx.x; i < NB * D; i += blockDim.x) { float v = c[i]; sc[i] = v * sigm_n(v); }
    __syncthreads();
    int idx = blockIdx.x * blockDim.x + threadIdx.x; int l = idx / MODW, n = idx % MODW;
    const float* w = w_mod + (size_t)l * D * MODW + n; float a0 = 0.f, a1 = 0.f;
    for (int k = 0; k < D; ++k) { float wv = w[(size_t)k * MODW]; a0 += sc[k] * wv; a1 += sc[D + k] * wv; }
    float bb = b_mod[l * MODW + n];
    mod[(size_t)(l * NB + 0) * MODW + n] = a0 + bb; mod[(size_t)(l * NB + 1) * MODW + n] = a1 + bb;
}
__global__ void k_ln_mod_n(const float* __restrict__ xin, const float* __restrict__ modl, int off_sh, int off_sc, float* __restrict__ uout) {
    int row = (blockIdx.x * blockDim.x + threadIdx.x) >> 6, lane = threadIdx.x & 63; if (row >= T) return; int b = row / S;
    f32x4 v[4];
#pragma unroll
    for (int j = 0; j < 4; ++j) v[j] = *(const f32x4*)(xin + (size_t)row * D + 4 * lane + 256 * j);
    float mean, rstd; row_ln(v, mean, rstd);
    const float* md = modl + (size_t)b * MODW;
#pragma unroll
    for (int j = 0; j < 4; ++j) { int col = 4 * lane + 256 * j; *(f32x4*)(uout + (size_t)row * D + col) = v[j] * rstd * (1.f + *(const f32x4*)(md + off_sc + col)) + *(const f32x4*)(md + off_sh + col); }
}
__global__ void k_post_n(const float* xin, const float* br, const float* __restrict__ modl, int off_gate, const float* __restrict__ gain, const float* __restrict__ bias, float* xout, float* u2out, int off_sh2, int off_sc2) {
    int row = (blockIdx.x * blockDim.x + threadIdx.x) >> 6, lane = threadIdx.x & 63; if (row >= T) return; int b = row / S;
    const float* md = modl + (size_t)b * MODW; f32x4 v[4];
#pragma unroll
    for (int j = 0; j < 4; ++j) { int col = 4 * lane + 256 * j; v[j] = *(const f32x4*)(xin + (size_t)row * D + col) * ALPHA + *(const f32x4*)(md + off_gate + col) * *(const f32x4*)(br + (size_t)row * D + col); }
    float mean, rstd; row_ln(v, mean, rstd);
#pragma unroll
    for (int j = 0; j < 4; ++j) { int col = 4 * lane + 256 * j; v[j] = v[j] * rstd * *(const f32x4*)(gain + col) + *(const f32x4*)(bias + col); *(f32x4*)(xout + (size_t)row * D + col) = v[j]; }
    if (u2out == nullptr) return;
    row_ln(v, mean, rstd);
#pragma unroll
    for (int j = 0; j < 4; ++j) { int col = 4 * lane + 256 * j; *(f32x4*)(u2out + (size_t)row * D + col) = v[j] * rstd * (1.f + *(const f32x4*)(md + off_sc2 + col)) + *(const f32x4*)(md + off_sh2 + col); }
}
__global__ void __launch_bounds__(256) k_gemm_f32(const float* __restrict__ A, int lda, const float* __restrict__ B, int ldb, float* __restrict__ C, int ldc, int K) {
    __shared__ float As[16][65]; __shared__ float Bs[16][64];
    const int tx = threadIdx.x & 15, ty = threadIdx.x >> 4; const int m0 = blockIdx.y * 64, n0 = blockIdx.x * 64;
    float acc[4][4];
#pragma unroll
    for (int i = 0; i < 4; ++i)
#pragma unroll
        for (int j = 0; j < 4; ++j) acc[i][j] = 0.f;
    for (int k0 = 0; k0 < K; k0 += 16) {
#pragma unroll
        for (int i = 0; i < 4; ++i) { int e = threadIdx.x + 256 * i; int m = e >> 4, k = e & 15; As[k][m] = A[(size_t)(m0 + m) * lda + k0 + k]; }
#pragma unroll
        for (int i = 0; i < 4; ++i) { int e = threadIdx.x + 256 * i; int k = e >> 6, n = e & 63; Bs[k][n] = B[(size_t)(k0 + k) * ldb + n0 + n]; }
        __syncthreads();
#pragma unroll
        for (int k = 0; k < 16; ++k) { float a[4], b[4];
#pragma unroll
            for (int i = 0; i < 4; ++i) { a[i] = As[k][ty * 4 + i]; b[i] = Bs[k][tx * 4 + i]; }
#pragma unroll
            for (int i = 0; i < 4; ++i)
#pragma unroll
                for (int j = 0; j < 4; ++j) acc[i][j] += a[i] * b[j]; }
        __syncthreads();
    }
#pragma unroll
    for (int i = 0; i < 4; ++i) *(float4*)(C + (size_t)(m0 + ty * 4 + i) * ldc + n0 + tx * 4) = make_float4(acc[i][0], acc[i][1], acc[i][2], acc[i][3]);
}
__global__ void __launch_bounds__(64) k_attn_n(HSrc h, const float* __restrict__ rpb, float* __restrict__ concat) {
    int idx = blockIdx.x * blockDim.x + threadIdx.x; if (idx >= T * AH) return;
    int head = idx % AH, tok = idx / AH; int b = tok / S, t = tok % S, r = t / GW, cq = t % GW;
    int rstart = r - KH / 2; rstart = rstart < 0 ? 0 : (rstart > ROWS - KH ? ROWS - KH : rstart);
    int cstart = cq - KW / 2; cstart = cstart < 0 ? 0 : (cstart > GW - KW ? GW - KW : cstart);
    float q[HD], acc[HD];
#pragma unroll
    for (int d = 0; d < HD; ++d) { q[d] = h.at(tok, head * HD + d); acc[d] = 0.f; }
    float m = -1e30f, l = 0.f; const float* rp = rpb + (size_t)head * 15 * 31;
    for (int kk = 0; kk < KH; ++kk) { int kr = rstart + kk; int dr = kr - r + (KH - 1);
        for (int j = 0; j < KW; ++j) { int ck = cstart + j; int dc = ck - cq; dc = dc < -15 ? -15 : (dc > 15 ? 15 : dc); dc += 15;
            size_t kt = (size_t)b * S + kr * GW + ck; float s = 0.f;
#pragma unroll
            for (int d = 0; d < HD; ++d) s += q[d] * h.at(kt, AW + head * HD + d);
            s = s * 0.125f + rp[dr * 31 + dc];
            float mn = fmaxf(m, s); float corr = expf(m - mn); float p = expf(s - mn); l = l * corr + p;
#pragma unroll
            for (int d = 0; d < HD; ++d) acc[d] = acc[d] * corr + p * h.at(kt, 2 * AW + head * HD + d);
            m = mn; } }
    float inv = 1.f / l;
#pragma unroll
    for (int d = 0; d < HD; ++d) concat[(size_t)tok * D + head * HD + d] = acc[d] * inv;
}
__global__ void __launch_bounds__(256) k_pool_n(HSrc h, const float* __restrict__ pool_w, const float* __restrict__ pool_scale, float* __restrict__ concat) {
    __shared__ float pooled[CW];
    int tok = blockIdx.x; int b = tok / S, t = tok % S; int ch = threadIdx.x; int g = ch / 64; int win = 2 << g;
    int lo = t - win / 2; lo = lo < 0 ? 0 : lo; int hi = t + win / 2 - 1; hi = hi > S - 1 ? S - 1 : hi;
    float s = 0.f; for (int u = lo; u <= hi; ++u) s += h.at((size_t)b * S + u, O_G + ch);
    pooled[ch] = s / (float)(hi - lo + 1) - h.at(tok, O_G + ch);
    __syncthreads();
    int e = ch % 64; const float* pw = pool_w + (size_t)g * 64 * 64 + e; float a = 0.f;
    for (int c2 = 0; c2 < 64; ++c2) a += pooled[g * 64 + c2] * pw[c2 * 64];
    concat[(size_t)tok * D + AW + BW + ch] = a * pool_scale[ch];
}
__global__ void __launch_bounds__(64) k_rwkv_scan_n(HSrc h, RwP p, float* __restrict__ ys) {
    const int lane = threadIdx.x; const int dir = blockIdx.x / (NB * BH), b = (blockIdx.x / BH) % NB, hd = blockIdx.x % BH; const int ch = hd * HD + lane;
    float st[HD];
#pragma unroll
    for (int j = 0; j < HD; ++j) st[j] = 0.f;
    float wup[RW], aup[RA];
#pragma unroll
    for (int m = 0; m < RW; ++m) { wup[m] = p.w_up[(size_t)(dir * RW + m) * BW + ch]; aup[m] = p.a_up[(size_t)(dir * RA + m) * BW + ch]; }
    const float w0 = p.w0[dir * BW + ch], a0 = p.a0[dir * BW + ch], kkw = p.k_k[ch], kaw = p.k_a[ch];
    float cr[3], ck[3], cv[3];
#pragma unroll
    for (int x = 0; x < 3; ++x) { cr[x] = p.conv[x * 3 * BW + ch]; ck[x] = p.conv[x * 3 * BW + BW + ch]; cv[x] = p.conv[x * 3 * BW + 2 * BW + ch]; }
    for (int step = 0; step < S; ++step) {
        const int t = dir ? (S - 1 - step) : step; const size_t row = (size_t)b * S + t;
        float r = 0.f, k = 0.f, v = 0.f;
#pragma unroll
        for (int x = 0; x < 3; ++x) { int tt = t + x - 1; if (tt >= 0 && tt < S) { size_t rr = (size_t)b * S + tt; r += h.at(rr, O_A + ch) * cr[x]; k += h.at(rr, O_A + BW + ch) * ck[x]; v += h.at(rr, O_A + 2 * BW + ch) * cv[x]; } }
        float lv = h.at(row, O_B + lane); float lt = lane < RW ? tanhf(lv) : lv; float zw = w0, za = a0;
#pragma unroll
        for (int m = 0; m < RW; ++m) { zw += __shfl(lt, m) * wup[m]; za += __shfl(lt, RW + m) * aup[m]; }
        const float w = expf(-DECAY * sigm_n(zw)); const float a = sigm_n(za);
        float kk = k * kkw; float ss = wave_sum(kk * kk); kk = kk * (1.f / sqrtf(fmaxf(ss, 1e-24f)));
        const float kd = k * (1.f + (a - 1.f) * kaw); const float kka = kk * a;
        float sa = 0.f;
#pragma unroll
        for (int j = 0; j < HD; ++j) sa += st[j] * (-__shfl(kk, j));
        float y = 0.f;
#pragma unroll
        for (int j = 0; j < HD; ++j) { st[j] = st[j] * __shfl(w, j) + sa * __shfl(kka, j) + v * __shfl(kd, j); y += st[j] * __shfl(r, j); }
        ys[((size_t)dir * T + b * S + t) * BW + ch] = y;
    }
}
__global__ void __launch_bounds__(384) k_rwkv_finish_n(HSrc h, RwP p, const float* __restrict__ ys, float* __restrict__ concat) {
    __shared__ float lw[RW], la[RA], sg[RG];
    const int tok = blockIdx.x, b = tok / S, t = tok % S, ch = threadIdx.x, hd = ch / HD, j = ch % HD;
    if (ch < RW) lw[ch] = tanhf(h.at(tok, O_B + ch)); else if (ch < RW + RA) la[ch - RW] = h.at(tok, O_W + (ch - RW)); else if (ch < RW + RA + RG) sg[ch - RW - RA] = sigm_n(h.at(tok, O_AL + (ch - RW - RA)));
    __syncthreads();
    float r = 0.f, k = 0.f, v = 0.f;
#pragma unroll
    for (int x = 0; x < 3; ++x) { int tt = t + x - 1; if (tt >= 0 && tt < S) { size_t rr = (size_t)b * S + tt;
        r += h.at(rr, O_A + ch) * p.conv[x * 3 * BW + ch]; k += h.at(rr, O_A + BW + ch) * p.conv[x * 3 * BW + BW + ch]; v += h.at(rr, O_A + 2 * BW + ch) * p.conv[x * 3 * BW + 2 * BW + ch]; } }
    float bon = 0.f;
    for (int dir = 0; dir < 2; ++dir) { float za = p.a0[dir * BW + ch]; for (int m = 0; m < RA; ++m) za += la[m] * p.a_up[(size_t)(dir * RA + m) * BW + ch];
        float a = sigm_n(za); float kd = k * (1.f + (a - 1.f) * p.k_a[ch]); bon += wave_sum(r * kd * p.r_k[hd * HD + j]); }
    bon *= v;
    float y = ys[(size_t)tok * BW + ch] + ys[((size_t)T + tok) * BW + ch];
    float mu = wave_sum(y) * (1.f / HD); float dy = y - mu; float var = wave_sum(dy * dy) * (1.f / HD);
    float yn = dy * (1.f / sqrtf(var + GN_EPS)) * p.gn_gain[ch] + p.gn_bias[ch];
    float g = 0.f; for (int m = 0; m < RG; ++m) g += sg[m] * p.g_up[(size_t)m * BW + ch];
    concat[(size_t)tok * D + AW + ch] = (yn + bon) * g;
}
__global__ void __launch_bounds__(256) k_moe_n(const float* __restrict__ u2, const int* __restrict__ tokslot, const float* __restrict__ ew,
                                                const float* __restrict__ wgate, const float* __restrict__ wup, const float* __restrict__ wdown, float* __restrict__ f) {
    __shared__ float xs[D]; __shared__ float hb[DE];
    const int tok = blockIdx.x, tid = threadIdx.x;
    for (int i = tid; i < D; i += 256) xs[i] = u2[(size_t)tok * D + i];
    float o[4] = {0.f, 0.f, 0.f, 0.f};
    for (int kk = 0; kk < 2; ++kk) {
        const int ts = tokslot[tok * 2 + kk]; const int e = ts >> 14; const float wt = ew[ts];
        __syncthreads();
        const float* g = wgate + (size_t)e * D * DE; const float* u = wup + (size_t)e * D * DE;
        float ag0 = 0.f, ag1 = 0.f, au0 = 0.f, au1 = 0.f;
        for (int k = 0; k < D; ++k) { float x = xs[k]; ag0 += x * g[(size_t)k * DE + tid]; ag1 += x * g[(size_t)k * DE + 256 + tid]; au0 += x * u[(size_t)k * DE + tid]; au1 += x * u[(size_t)k * DE + 256 + tid]; }
        hb[tid] = ag0 * sigm_n(ag0) * au0; hb[256 + tid] = ag1 * sigm_n(ag1) * au1;
        __syncthreads();
        const float* dn = wdown + (size_t)e * DE * D; float a[4] = {0.f, 0.f, 0.f, 0.f};
        for (int k = 0; k < DE; ++k) { float x = hb[k];
#pragma unroll
            for (int j = 0; j < 4; ++j) a[j] += x * dn[(size_t)k * D + tid + 256 * j]; }
#pragma unroll
        for (int j = 0; j < 4; ++j) o[j] += a[j] * wt;
    }
#pragma unroll
    for (int j = 0; j < 4; ++j) f[(size_t)tok * D + tid + 256 * j] = o[j];
}

__global__ void k_router_n(const float* __restrict__ u2, const float* __restrict__ wg, const float* __restrict__ bg, const float* __restrict__ we, const float* __restrict__ be, int* __restrict__ tok_e) {
    int row = (blockIdx.x * blockDim.x + threadIdx.x) >> 6, lane = threadIdx.x & 63; if (row >= T) return;
    float gl[NG], el[NE];
#pragma unroll
    for (int n = 0; n < NG; ++n) gl[n] = 0.f;
#pragma unroll
    for (int n = 0; n < NE; ++n) el[n] = 0.f;
    for (int i = 0; i < 16; ++i) { int k = lane + 64 * i; float x = u2[(size_t)row * D + k];
#pragma unroll
        for (int n = 0; n < NG; ++n) gl[n] += x * wg[k * NG + n];
#pragma unroll
        for (int n = 0; n < NE; ++n) el[n] += x * we[k * NE + n]; }
#pragma unroll
    for (int n = 0; n < NG; ++n) gl[n] = wave_sum(gl[n]) + bg[n];
#pragma unroll
    for (int n = 0; n < NE; ++n) el[n] = wave_sum(el[n]) + be[n];
    int gi = 0; float gm = gl[0];
#pragma unroll
    for (int n = 1; n < NG; ++n) if (gl[n] > gm) { gm = gl[n]; gi = n; }
    float l1 = -3.0e38f, l2 = -3.0e38f; int i1 = 0, i2 = 0;
#pragma unroll
    for (int n = 0; n < NE; ++n) if ((n >> 3) == gi) { float v = el[n]; int e = n & 7; if (v > l1) { l2 = l1; i2 = i1; l1 = v; i1 = e; } else if (v > l2) { l2 = v; i2 = e; } }
    if (lane == 0) { tok_e[row * 2] = gi * EPG + i1; tok_e[row * 2 + 1] = gi * EPG + i2; }
}
__global__ void k_cmp_route(const int* __restrict__ tokslot, const int* __restrict__ tok_e, float* acc, int slot) {
    float mis = 0.f, tot = 0.f;
    for (int t = blockIdx.x * blockDim.x + threadIdx.x; t < T; t += gridDim.x * blockDim.x) { const int a0 = tokslot[2 * t] >> 14, a1 = tokslot[2 * t + 1] >> 14;
        mis += (a0 != tok_e[2 * t] || a1 != tok_e[2 * t + 1]) ? 1.f : 0.f; tot += 1.f; }
    mis = wave_sum(mis); tot = wave_sum(tot);
    if ((threadIdx.x & 63) == 0) { atomicAdd(acc + 2 * slot, mis); atomicAdd(acc + 2 * slot + 1, tot); }
}
__global__ void k_bf2f(const bf16_t* __restrict__ src, float* __restrict__ dst, size_t n) { for (size_t i = (size_t)blockIdx.x * blockDim.x + threadIdx.x; i < n; i += (size_t)gridDim.x * blockDim.x) dst[i] = bf2f(src[i]); }
template <class TA> __global__ void k_cmp(const TA* __restrict__ a, size_t lda, const float* __restrict__ b, size_t ldb, int rows, int cols, float* acc, int slot) {
    float d2 = 0.f, r2 = 0.f;
    for (size_t i = (size_t)blockIdx.x * blockDim.x + threadIdx.x; i < (size_t)rows * cols; i += (size_t)gridDim.x * blockDim.x) {
        const size_t r = i / cols, c = i % cols; float av; if constexpr (sizeof(TA) == 2) av = bf2f(a[r * lda + c]); else av = a[r * lda + c];
        const float bv = b[r * ldb + c]; d2 += (av - bv) * (av - bv); r2 += bv * bv; }
    d2 = wave_sum(d2); r2 = wave_sum(r2);
    if ((threadIdx.x & 63) == 0) { atomicAdd(acc + 2 * slot, d2); atomicAdd(acc + 2 * slot + 1, r2); }
}
__global__ void k_cmp_vt(const bf16_t* __restrict__ vt, const float* __restrict__ b, size_t ldb, float* acc, int slot) {
    float d2 = 0.f, r2 = 0.f;
    for (size_t i = (size_t)blockIdx.x * blockDim.x + threadIdx.x; i < (size_t)T * AW; i += (size_t)gridDim.x * blockDim.x) {
        const size_t r = i % T, c = i / T; const float av = bf2f(vt[c * T + r]), bv = b[r * ldb + c]; d2 += (av - bv) * (av - bv); r2 += bv * bv; }
    d2 = wave_sum(d2); r2 = wave_sum(r2);
    if ((threadIdx.x & 63) == 0) { atomicAdd(acc + 2 * slot, d2); atomicAdd(acc + 2 * slot + 1, r2); }
}
struct Tols { float t[8]; int n; };
__global__ void k_readout(float* out, const float* acc, Tols tl, int total) {
    float mx = 0.f; int am = 0; for (int k = 0; k < tl.n; ++k) { float e = sqrtf(acc[2 * k] / fmaxf(acc[2 * k + 1], 1e-30f)); if (!(e == e)) e = 1e3f; if (e / tl.t[k] > mx) { mx = e / tl.t[k]; am = k; } }
    const float cval = sqrtf(1000.f * mx);
    for (int i = blockIdx.x * blockDim.x + threadIdx.x; i < total; i += gridDim.x * blockDim.x) out[i] = (i < 8) ? 1000.f * (float)(am + 1) : cval;
}
__global__ void __launch_bounds__(256) k_moe_chk(const float* __restrict__ u2, const int* __restrict__ tokslot, const float* __restrict__ ew, const unsigned* __restrict__ cnt,
                                                  const float* __restrict__ wgate, const float* __restrict__ wup, const float* __restrict__ wdown,
                                                  const bf16_t* __restrict__ XS, const bf16_t* __restrict__ HM, const bf16_t* __restrict__ YS, float* acc) {
    __shared__ float xs[D]; __shared__ float hb[DE]; __shared__ int offp[NE];
    const int tok = blockIdx.x, tid = threadIdx.x;
    if (tid == 0) { int off = 0; for (int e = 0; e < NE; ++e) { offp[e] = off; off += (((int)cnt[e] + 255) >> 8) * 256; } }
    for (int i = tid; i < D; i += 256) xs[i] = u2[(size_t)tok * D + i];
    float d0 = 0.f, r0 = 0.f, d1 = 0.f, r1 = 0.f, d2 = 0.f, r2 = 0.f;
    for (int kk = 0; kk < 2; ++kk) {
        __syncthreads();
        const int ts = tokslot[tok * 2 + kk]; const int e = ts >> 14; const float wt = ew[ts]; const size_t slot = (size_t)offp[e] + (ts & 16383);
        for (int i = tid; i < D; i += 256) { const float a = bf2f(XS[slot * D + i]), b = xs[i]; d0 += (a - b) * (a - b); r0 += b * b; }
        const float* g = wgate + (size_t)e * D * DE; const float* u = wup + (size_t)e * D * DE;
        float ag0 = 0.f, ag1 = 0.f, au0 = 0.f, au1 = 0.f;
        for (int k = 0; k < D; ++k) { float x = xs[k]; ag0 += x * g[(size_t)k * DE + tid]; ag1 += x * g[(size_t)k * DE + 256 + tid]; au0 += x * u[(size_t)k * DE + tid]; au1 += x * u[(size_t)k * DE + 256 + tid]; }
        const float h0 = ag0 * sigm_n(ag0) * au0, h1 = ag1 * sigm_n(ag1) * au1;
        hb[tid] = h0; hb[256 + tid] = h1;
        { const float a = bf2f(HM[slot * DE + tid]), b = bf2f(HM[slot * DE + 256 + tid]); d1 += (a - h0) * (a - h0) + (b - h1) * (b - h1); r1 += h0 * h0 + h1 * h1; }
        __syncthreads();
        const float* dn = wdown + (size_t)e * DE * D; float a4[4] = {0.f, 0.f, 0.f, 0.f};
        for (int k = 0; k < DE; ++k) { float x = hb[k];
#pragma unroll
            for (int j = 0; j < 4; ++j) a4[j] += x * dn[(size_t)k * D + tid + 256 * j]; }
#pragma unroll
        for (int j = 0; j < 4; ++j) {
#ifdef MOEB_NOSCALE
            const float y = a4[j];
#else
            const float y = a4[j] * wt;
#endif
            const float a = bf2f(YS[slot * D + tid + 256 * j]); d2 += (a - y) * (a - y); r2 += y * y; }
    }
    d0 = wave_sum(d0); r0 = wave_sum(r0); d1 = wave_sum(d1); r1 = wave_sum(r1); d2 = wave_sum(d2); r2 = wave_sum(r2);
    if ((tid & 63) == 0) { atomicAdd(acc + 0, d0); atomicAdd(acc + 1, r0); atomicAdd(acc + 2, d1); atomicAdd(acc + 3, r1); atomicAdd(acc + 4, d2); atomicAdd(acc + 5, r2); }
}

extern "C" void kernel_launch(void* const* d_in, const int* in_sizes, int n_in, void* d_out, int out_size, void* d_ws, size_t ws_size, hipStream_t stream) {
    static int once = 0; if (!once) { (void)hipFuncSetAttribute((const void*)mk_fwd, hipFuncAttributeMaxDynamicSharedMemorySize, LDS_BYTES); once = 1; }
    (void)hipMemsetAsync((char*)d_ws + WS_CTL, 0, CTL_BYTES, stream);
    Args a{}; fill_args(a, d_in, d_out, d_ws);
    char* ws = (char*)d_ws; float* out = (float*)d_out;
    float* ACC = (float*)(ws + 32768 + 1024);
    const float* x = a.in[0];
    HSrc hs{(const bf16_t*)(ws + WS_HB), (const bf16_t*)(ws + WS_VT)};
    const int l = 0;
    RwP p = { a.in[6], a.in[7], a.in[8], a.in[9], a.in[10], a.in[11], a.in[12], a.in[13], a.in[14], a.in[15], a.in[16] };
    Tols tl{};
#if TESTMODE == 1
    launch_phases(a, 0, 3, stream);
    float* MODn = (float*)(ws + WS_MOD + 512 * 1024); float* Un = (float*)(ws + WS_XA); float* HF = (float*)(ws + WS_CONCAT);
    k_mod_n<<<L * MODW / 256, 256, 0, stream>>>(a.in[1], a.in[2], a.in[3], MODn);
    k_ln_mod_n<<<T / 4, 256, 0, stream>>>(x, MODn, 0, D, Un);
    k_gemm_f32<<<dim3(INW / 64, T / 64), 256, 0, stream>>>(Un, D, a.in[4], INW, HF, INW, D);
    k_cmp<float><<<256, 256, 0, stream>>>((const float*)(ws + WS_MOD), MODW, MODn, MODW, L * NB, MODW, ACC, 0);
    k_cmp<bf16_t><<<1024, 256, 0, stream>>>((const bf16_t*)(ws + WS_U), D, Un, D, T, D, ACC, 1);
    k_cmp<bf16_t><<<1024, 256, 0, stream>>>((const bf16_t*)(ws + WS_HB), HW, HF, INW, T, 768, ACC, 2);
    k_cmp<bf16_t><<<1024, 256, 0, stream>>>((const bf16_t*)(ws + WS_HB) + 768, HW, HF + 1152, INW, T, 1536, ACC, 3);
    k_cmp_vt<<<1024, 256, 0, stream>>>((const bf16_t*)(ws + WS_VT), HF + 768, INW, ACC, 4);
    tl.n = 5; tl.t[0] = 1e-5f; tl.t[1] = 4e-3f; tl.t[2] = 6e-3f; tl.t[3] = 6e-3f; tl.t[4] = 6e-3f;
#elif TESTMODE == 2
    launch_phases(a, 0, 4, stream);
    float* CCn = (float*)(ws + WS_XA); float* YSn = (float*)(ws + WS_WGU);
    k_attn_n<<<T * AH / 64, 64, 0, stream>>>(hs, a.in[5], CCn);
    k_pool_n<<<T, 256, 0, stream>>>(hs, a.in[17], a.in[18], CCn);
    k_rwkv_scan_n<<<2 * NB * BH, 64, 0, stream>>>(hs, p, YSn);
    k_rwkv_finish_n<<<T, 384, 0, stream>>>(hs, p, YSn, CCn);
    launch_phases(a, 4, 6, stream);
    k_cmp<bf16_t><<<1024, 256, 0, stream>>>((const bf16_t*)(ws + WS_CONCAT), D, CCn, D, T, AW, ACC, 0);
    k_cmp<bf16_t><<<1024, 256, 0, stream>>>((const bf16_t*)(ws + WS_CONCAT) + AW, D, CCn + AW, D, T, BW, ACC, 1);
    k_cmp<bf16_t><<<1024, 256, 0, stream>>>((const bf16_t*)(ws + WS_CONCAT) + AW + BW, D, CCn + AW + BW, D, T, CW, ACC, 2);
    tl.n = 3; tl.t[0] = TOL0; tl.t[1] = TOL1; tl.t[2] = TOL2;
#elif TESTMODE == 3
    launch_phases(a, 0, 11, stream);
    { const float* MODf = (const float*)(ws + WS_MOD);
      float* U2f = (float*)(ws + 414 * MiB); float* Fn = (float*)(ws + 213 * MiB); float* X2n = (float*)(ws + 277 * MiB);
      k_bf2f<<<2048, 256, 0, stream>>>((const bf16_t*)(ws + WS_U), U2f, (size_t)T * D);
      launch_phases(a, 11, 12, stream);
      k_moe_n<<<T, 256, 0, stream>>>(U2f, (const int*)(ws + WS_TOKSLOT), (const float*)(ws + WS_EW), a.in[28], a.in[29], a.in[30], Fn);
      k_post_n<<<T / 4, 256, 0, stream>>>((const float*)(ws + WS_XA), Fn, MODf, 5 * D, a.in[22], a.in[23], X2n, nullptr, 0, 0);
      k_cmp<float><<<1024, 256, 0, stream>>>(out, D, X2n, D, T, D, ACC, 0); }
    tl.n = 1; tl.t[0] = TOL0;
#elif TESTMODE == 4
    launch_phases(a, 0, 8, stream);
    { const float* MODf = (const float*)(ws + WS_MOD);
      float* CCn = (float*)(ws + 405 * MiB); float* MIXn = (float*)(ws + 213 * MiB); float* X1n = (float*)(ws + 21 * MiB); float* U2n = (float*)(ws + 333 * MiB); int* TEn = (int*)(ws + 490 * MiB);
      k_bf2f<<<2048, 256, 0, stream>>>((const bf16_t*)(ws + WS_CONCAT), CCn, (size_t)T * D);
      k_gemm_f32<<<dim3(D / 64, T / 64), 256, 0, stream>>>(CCn, D, a.in[19], D, MIXn, D, D);
      k_post_n<<<T / 4, 256, 0, stream>>>(x, MIXn, MODf, 2 * D, a.in[20], a.in[21], X1n, U2n, 3 * D, 4 * D);
      k_router_n<<<T / 4, 256, 0, stream>>>(U2n, a.in[24], a.in[25], a.in[26], a.in[27], TEn);
      k_cmp<float><<<1024, 256, 0, stream>>>((const float*)(ws + WS_XA), D, X1n, D, T, D, ACC, 0);
      k_cmp<bf16_t><<<1024, 256, 0, stream>>>((const bf16_t*)(ws + WS_U), D, U2n, D, T, D, ACC, 1);
      k_cmp_route<<<64, 256, 0, stream>>>((const int*)(ws + WS_TOKSLOT), TEn, ACC, 2); }
    tl.n = 3; tl.t[0] = TOL0; tl.t[1] = TOL1; tl.t[2] = TOL2;
#elif TESTMODE == 5
    launch_phases(a, 0, 11, stream);
    { float* U2f = (float*)(ws + 414 * MiB);
      k_bf2f<<<2048, 256, 0, stream>>>((const bf16_t*)(ws + WS_U), U2f, (size_t)T * D);
      k_moe_chk<<<T, 256, 0, stream>>>(U2f, (const int*)(ws + WS_TOKSLOT), (const float*)(ws + WS_EW), (const unsigned*)(ws + WS_CTL) + CW_CNT, a.in[28], a.in[29], a.in[30],
                                       (const bf16_t*)(ws + WS_XS), (const bf16_t*)(ws + WS_HM), (const bf16_t*)(ws + WS_YS), ACC); }
    tl.n = 3; tl.t[0] = 1e-6f; tl.t[1] = 1e-2f; tl.t[2] = 1e-2f;
#endif
    k_readout<<<256, 256, 0, stream>>>(out, ACC, tl, out_size);
}
#endif
```
